# Optimizing an MI355X kernel written in HIP

```python
import jax
import jax.numpy as jnp
from jax import lax
import numpy as np

D_MODEL = 1024
BATCH = 2
SEQ = 8192
DEPTH = 1

GRID_W = 64
CTX_LEN = 256
N_MOD = 6
EPS = 1e-6
SGU_WIDTH = 1024
SGU_GROUPS = 8
SGU_GROUP_DIM = SGU_WIDTH // SGU_GROUPS
CHUNK = 128
MLA_HEADS = 8
QK_NOPE = 128
QK_ROPE = 64
V_DIM = 128
Q_RANK = 256
KV_RANK = 128
ROPE_THETA = 10000.0
Q_BLOCK = 128
PEER_HEADS = 8
N_KEYS = 128
N_EXPERTS = N_KEYS * N_KEYS
PEER_QK = 256
PEER_HALF = PEER_QK // 2
TOPK_HALF = 16
PEER_TOPK = 16
PEER_BLOCK = 128
OFF_U = 0
OFF_V = OFF_U + SGU_WIDTH
OFF_Q = OFF_V + SGU_WIDTH
OFF_KV = OFF_Q + Q_RANK
OFF_KR = OFF_KV + KV_RANK
OFF_GA = OFF_KR + QK_ROPE
OFF_GB = OFF_GA + D_MODEL
IN_WIDTH = OFF_GB + D_MODEL

kernel_name = 'hybrid_sgu_mla_peer_dit_layer'


def rms_norm(x, g):
    xf = x.astype(jnp.float32)
    y = xf * lax.rsqrt(jnp.mean(xf * xf, axis=-1, keepdims=True) + EPS)
    return (y * g.astype(jnp.float32)).astype(x.dtype)


def modulate(h, shift, scale):
    return h * (1 + scale) + shift


def rope_1d(x, pos):
    quarter = x.shape[-1] // 2
    freqs = ROPE_THETA ** (-jnp.arange(quarter, dtype=jnp.float32) / quarter)
    ang = pos.astype(jnp.float32)[:, None] * freqs[None, :]
    shape = (x.shape[1],) + (1,) * (x.ndim - 3) + (quarter,)
    cos = jnp.cos(ang).reshape(shape).astype(x.dtype)
    sin = jnp.sin(ang).reshape(shape).astype(x.dtype)
    x1, x2 = x[..., :quarter], x[..., quarter:]
    return jnp.concatenate([x1 * cos - x2 * sin, x1 * sin + x2 * cos], axis=-1)


def axial_rope(x, rows, cols):
    half = x.shape[-1] // 2
    return jnp.concatenate([rope_1d(x[..., :half], rows), rope_1d(x[..., half:], cols)], axis=-1)


def mla_q(cq, g_q, w_uq):
    b, t, _ = cq.shape
    q = (rms_norm(cq, g_q) @ w_uq).reshape(b, t, MLA_HEADS, QK_NOPE + QK_ROPE)
    return q[..., :QK_NOPE], q[..., QK_NOPE:]


def mla_kv(ckv, g_kv, w_ukv):
    b, t, _ = ckv.shape
    kv = (rms_norm(ckv, g_kv) @ w_ukv).reshape(b, t, MLA_HEADS, QK_NOPE + V_DIM)
    return kv[..., :QK_NOPE], kv[..., QK_NOPE:]


def attend(qn, qr, kn, kr, v):
    b, t, h, _ = qn.shape
    nb = t // Q_BLOCK
    scale = (QK_NOPE + QK_ROPE) ** -0.5

    def block(args):
        qn_b, qr_b = args
        s = jnp.einsum('bqhd,bkhd->bhqk', qn_b, kn) + jnp.einsum('bqhr,bkr->bhqk', qr_b, kr)
        p = jax.nn.softmax(s.astype(jnp.float32) * scale, axis=-1).astype(v.dtype)
        return jnp.einsum('bhqk,bkhd->bqhd', p, v)

    qn_b = qn.reshape(b, nb, Q_BLOCK, h, QK_NOPE).swapaxes(0, 1)
    qr_b = qr.reshape(b, nb, Q_BLOCK, h, QK_ROPE).swapaxes(0, 1)
    o = lax.map(block, (qn_b, qr_b))
    return o.swapaxes(0, 1).reshape(b, t, h * V_DIM)


def chunk_sgu(u, v, g_sgu, w_s, b_s):
    b, t, _ = u.shape
    v = rms_norm(jax.nn.gelu(v), g_sgu).reshape(b, t // CHUNK, CHUNK, SGU_GROUPS, SGU_GROUP_DIM)
    sv = jnp.einsum('gpq,bnqgc->bnpgc', w_s, v) + b_s.T[:, :, None]
    return jax.nn.gelu(u) * sv.reshape(b, t, SGU_WIDTH)


def merge(o_a, o_b, g_a, g_b, w_pa, w_pb, w_o):
    return (jax.nn.sigmoid(g_a) * (o_a @ w_pa) + jax.nn.sigmoid(g_b) * (o_b @ w_pb)) @ w_o


def peer(h, w_pq, k1, k2, u_exp, v_exp):
    b, t, d = h.shape
    blocks = h.reshape(-1, PEER_BLOCK, d)

    def block(xb):
        q = (xb @ w_pq).reshape(PEER_BLOCK, PEER_HEADS, PEER_QK)
        s1 = jnp.einsum('thd,kd->thk', q[..., :PEER_HALF], k1).astype(jnp.float32)
        s2 = jnp.einsum('thd,kd->thk', q[..., PEER_HALF:], k2).astype(jnp.float32)
        s1t, i1 = lax.top_k(s1, TOPK_HALF)
        s2t, i2 = lax.top_k(s2, TOPK_HALF)
        n_cand = TOPK_HALF * TOPK_HALF
        cand = (s1t[..., :, None] + s2t[..., None, :]).reshape(PEER_BLOCK, PEER_HEADS, n_cand)
        cidx = (i1[..., :, None] * N_KEYS + i2[..., None, :]).reshape(PEER_BLOCK, PEER_HEADS, n_cand)
        top_s, pos = lax.top_k(cand, PEER_TOPK)
        idx = jnp.take_along_axis(cidx, pos, axis=-1)
        gw = jax.nn.softmax(top_s, axis=-1).astype(xb.dtype)
        act = jax.nn.gelu(jnp.einsum('thkd,td->thk', u_exp[idx], xb))
        return jnp.einsum('thk,thkd->td', gw * act, v_exp[idx])

    return lax.map(block, blocks).reshape(b, t, d)


def setup_inputs(seed: int = 0) -> dict:
    key = jax.random.key(seed)
    ks = jax.random.split(key, 26)
    L, D = DEPTH, D_MODEL

    def nrm(k, shape, scale):
        return jax.random.normal(k, shape, jnp.float32) * scale

    def gain(k, shape):
        return 1.0 + 0.05 * jax.random.normal(k, shape, jnp.float32)

    return {
        'x': nrm(ks[0], (BATCH, SEQ, D), 1.0),
        'c': nrm(ks[1], (BATCH, D), 1.0),
        'ctx': nrm(ks[2], (BATCH, CTX_LEN, D), 1.0),
        'c_ctx': nrm(ks[3], (D,), 1.0),
        'w_mod': nrm(ks[4], (L, D, N_MOD * D), 0.5 * D ** -0.5),
        'b_mod': nrm(ks[5], (L, N_MOD * D), 0.02),
        'g_pre1': gain(ks[6], (L, D)),
        'g_post1': gain(ks[7], (L, D)),
        'g_pre2': gain(ks[8], (L, D)),
        'g_post2': gain(ks[9], (L, D)),
        'w_in': nrm(ks[10], (L, D, IN_WIDTH), D ** -0.5),
        'g_q': gain(ks[11], (L, Q_RANK)),
        'g_kv': gain(ks[12], (L, KV_RANK)),
        'w_uq': nrm(ks[13], (L, Q_RANK, MLA_HEADS * (QK_NOPE + QK_ROPE)), Q_RANK ** -0.5),
        'w_ukv': nrm(ks[14], (L, KV_RANK, MLA_HEADS * (QK_NOPE + V_DIM)), KV_RANK ** -0.5),
        'g_sgu': gain(ks[15], (L, SGU_WIDTH)),
        'w_s': nrm(ks[16], (L, SGU_GROUPS, CHUNK, CHUNK), CHUNK ** -0.5),
        'b_s': nrm(ks[17], (L, SGU_GROUPS, CHUNK), 0.02),
        'w_pa': nrm(ks[18], (L, SGU_WIDTH, D), SGU_WIDTH ** -0.5),
        'w_pb': nrm(ks[19], (L, MLA_HEADS * V_DIM, D), (MLA_HEADS * V_DIM) ** -0.5),
        'w_o': nrm(ks[20], (L, D, D), D ** -0.5),
        'w_pq': nrm(ks[21], (L, D, PEER_HEADS * PEER_QK), D ** -0.5),
        'k1': nrm(ks[22], (L, N_KEYS, PEER_HALF), PEER_HALF ** -0.5),
        'k2': nrm(ks[23], (L, N_KEYS, PEER_HALF), PEER_HALF ** -0.5),
        'u_exp': nrm(ks[24], (L, N_EXPERTS, D), D ** -0.5),
        'v_exp': nrm(ks[25], (L, N_EXPERTS, D), D ** -0.5),
    }


def reference(x, c, ctx, c_ctx, w_mod, b_mod, g_pre1, g_post1, g_pre2, g_post2, w_in, g_q, g_kv,
              w_uq, w_ukv, g_sgu, w_s, b_s, w_pa, w_pb, w_o, w_pq, k1, k2, u_exp, v_exp):
    seq_len = x.shape[1]
    n_rows = seq_len // GRID_W
    rr, cc = jnp.meshgrid(jnp.arange(n_rows), jnp.arange(GRID_W), indexing='ij')
    rows, cols = rr.reshape(-1), cc.reshape(-1)
    for l in range(DEPTH):
        update_ctx = l < DEPTH - 1
        sh1x, sc1x, gt1x, sh2x, sc2x, gt2x = jnp.split(
            (jax.nn.silu(c) @ w_mod[l] + b_mod[l])[:, None, :], N_MOD, axis=-1)
        sh1c, sc1c, gt1c, sh2c, sc2c, gt2c = jnp.split(
            (jax.nn.silu(c_ctx) @ w_mod[l] + b_mod[l])[None, None, :], N_MOD, axis=-1)

        hx = modulate(rms_norm(x, g_pre1[l]), sh1x, sc1x)
        hc = modulate(rms_norm(ctx, g_pre1[l]), sh1c, sc1c)
        zx = hx @ w_in[l]
        zc_kv = hc @ w_in[l][:, OFF_KV:OFF_GA]
        kn_c, v_c = mla_kv(zc_kv[..., :KV_RANK], g_kv[l], w_ukv[l])
        kr_c = zc_kv[..., KV_RANK:]
        qn_x, qr_x = mla_q(zx[..., OFF_Q:OFF_KV], g_q[l], w_uq[l])
        qr_x = axial_rope(qr_x, rows, cols)
        kn_x, v_x = mla_kv(zx[..., OFF_KV:OFF_KR], g_kv[l], w_ukv[l])
        kr_x = axial_rope(zx[..., OFF_KR:OFF_GA], rows, cols)
        o_b = attend(qn_x, qr_x,
                     jnp.concatenate([kn_x, kn_c], axis=1),
                     jnp.concatenate([kr_x, kr_c], axis=1),
                     jnp.concatenate([v_x, v_c], axis=1))
        o_a = chunk_sgu(zx[..., OFF_U:OFF_V], zx[..., OFF_V:OFF_Q], g_sgu[l], w_s[l], b_s[l])
        y = merge(o_a, o_b, zx[..., OFF_GA:OFF_GB], zx[..., OFF_GB:], w_pa[l], w_pb[l], w_o[l])
        x = x + gt1x * rms_norm(y, g_post1[l])
        if update_ctx:
            zc = hc @ w_in[l][:, :OFF_KV]
            gc = hc @ w_in[l][:, OFF_GA:]
            qn_c, qr_c = mla_q(zc[..., OFF_Q:OFF_KV], g_q[l], w_uq[l])
            o_bc = attend(qn_c, qr_c, kn_c, kr_c, v_c)
            o_ac = chunk_sgu(zc[..., OFF_U:OFF_V], zc[..., OFF_V:OFF_Q], g_sgu[l], w_s[l], b_s[l])
            yc = merge(o_ac, o_bc, gc[..., :D_MODEL], gc[..., D_MODEL:], w_pa[l], w_pb[l], w_o[l])
            ctx = ctx + gt1c * rms_norm(yc, g_post1[l])

        hx2 = modulate(rms_norm(x, g_pre2[l]), sh2x, sc2x)
        x = x + gt2x * rms_norm(peer(hx2, w_pq[l], k1[l], k2[l], u_exp[l], v_exp[l]), g_post2[l])
        if update_ctx:
            hc2 = modulate(rms_norm(ctx, g_pre2[l]), sh2c, sc2c)
            ctx = ctx + gt2c * rms_norm(peer(hc2, w_pq[l], k1[l], k2[l], u_exp[l], v_exp[l]), g_post2[l])
    return x
```

```cpp
#include <hip/hip_runtime.h>
#include <hip/hip_cooperative_groups.h>
#include <cstdint>
#include <cstdio>
namespace cg = cooperative_groups;

#ifndef MEGA
#define MEGA 0
#endif
#ifndef GEMM_MFMA
#define GEMM_MFMA 0
#endif
#ifndef ATTN_MFMA
#define ATTN_MFMA 0
#endif
#ifndef TOPK_FAST
#define TOPK_FAST 0
#endif

#define DEVI __device__ __forceinline__
typedef unsigned short bf16_t;
using bf16x8 = __attribute__((ext_vector_type(8))) short;
using bf16x4 = __attribute__((ext_vector_type(4))) short;
using f32x4  = __attribute__((ext_vector_type(4))) float;
using f32x16 = __attribute__((ext_vector_type(16))) float;
using u32x4  = __attribute__((ext_vector_type(4))) unsigned;
using u32x2  = __attribute__((ext_vector_type(2))) unsigned;

constexpr int DM = 1024, NB = 2, SEQ = 8192, NTOK = NB * SEQ, CTXL = 256, NCTX = NB * CTXL, NROW = NTOK + NCTX, NKEY = SEQ + CTXL;
constexpr int INW = 4544, INWP = 4608;
constexpr int NPRE = 2560;
constexpr float EPS = 1e-6f;
constexpr int NTHR = 512, NWAVE = 8;
constexpr int LDS_BYTES = 98304;

constexpr size_t al256(size_t x) { return (x + 255) / 256 * 256; }
constexpr size_t O_WIN   = 0;
constexpr size_t O_WUQ   = O_WIN  + al256((size_t)INWP * 1024 * 2);
constexpr size_t O_WUKV  = O_WUQ  + al256((size_t)1536 * 256 * 2);
constexpr size_t O_WPA   = O_WUKV + al256((size_t)2048 * 128 * 2);
constexpr size_t O_WPB   = O_WPA  + al256((size_t)1024 * 1024 * 2);
constexpr size_t O_WO    = O_WPB  + al256((size_t)1024 * 1024 * 2);
constexpr size_t O_WPQ   = O_WO   + al256((size_t)1024 * 1024 * 2);
constexpr size_t O_WS    = O_WPQ  + al256((size_t)2048 * 1024 * 2);
constexpr size_t O_K1    = O_WS   + al256((size_t)8 * 128 * 128 * 2);
constexpr size_t O_K2    = O_K1   + al256((size_t)128 * 128 * 2);
constexpr size_t O_MOD   = O_K2   + al256((size_t)128 * 128 * 2);
constexpr size_t O_ROPE  = O_MOD  + al256((size_t)3 * 6144 * 4);
constexpr size_t O_RSSV  = O_ROPE + al256((size_t)128 * 16 * 2 * 4);
constexpr size_t O_RSSQ  = O_RSSV + (size_t)NTOK * 16 * 4;
constexpr size_t O_RSSKV = O_RSSQ + (size_t)NTOK * 4 * 4;
constexpr size_t O_RSSY  = O_RSSKV + (size_t)NROW * 2 * 4;
constexpr size_t O_RSSEND = O_RSSY + (size_t)NTOK * 16 * 4;
constexpr size_t O_RA    = al256(O_RSSEND);
constexpr size_t O_RB    = O_RA  + al256((size_t)NROW * 1024 * 2);
constexpr size_t O_RC    = O_RB  + al256((size_t)NTOK * 1024 * 2);
constexpr size_t O_CQ    = O_RC  + al256((size_t)NTOK * 1024 * 2);
constexpr size_t O_CKV   = O_CQ  + al256((size_t)NTOK * 256 * 2);
constexpr size_t O_KR    = O_CKV + al256((size_t)NROW * 128 * 2);
constexpr size_t O_RQ    = O_KR  + al256((size_t)NROW * 64 * 2);
constexpr size_t O_RKV   = O_RQ  + al256((size_t)NTOK * 1536 * 2);
constexpr size_t O_END   = O_RKV + al256((size_t)NROW * 2048 * 2);
static_assert(O_END <= (size_t)258 * 1024 * 1024, "workspace too large");

struct Params {
  const float *x, *c, *ctx, *c_ctx, *w_mod, *b_mod, *g_pre1, *g_post1, *g_pre2, *g_post2, *w_in, *g_q, *g_kv, *w_uq, *w_ukv, *g_sgu, *w_s, *b_s,
      *w_pa, *w_pb, *w_o, *w_pq, *k1, *k2, *u_exp, *v_exp;
  float* out; char* ws;
};

DEVI float bf2f(unsigned short h) { return __uint_as_float(((unsigned)h) << 16); }
DEVI unsigned short f2bf(float f) { unsigned u = __float_as_uint(f); u += 0x7fffu + ((u >> 16) & 1u); return (unsigned short)(u >> 16); }
DEVI unsigned pack2(float a, float b) { return (unsigned)f2bf(a) | ((unsigned)f2bf(b) << 16); }
DEVI float lo2f(unsigned w) { return __uint_as_float(w << 16); }
DEVI float hi2f(unsigned w) { return __uint_as_float(w & 0xffff0000u); }
DEVI void unpack8(const u32x4& w, float* f) {
  f[0] = lo2f(w[0]); f[1] = hi2f(w[0]); f[2] = lo2f(w[1]); f[3] = hi2f(w[1]); f[4] = lo2f(w[2]); f[5] = hi2f(w[2]); f[6] = lo2f(w[3]); f[7] = hi2f(w[3]);
}
DEVI float gelu_t(float x) { float z = 0.7978845608028654f * (x + 0.044715f * x * x * x); return x / (1.f + __expf(-2.f * z)); }
DEVI float sigmoidf_(float x) { return 1.f / (1.f + __expf(-x)); }
DEVI float wave_sum(float v) { for (int o = 32; o > 0; o >>= 1) v += __shfl_xor(v, o); return v; }
DEVI float wave_max(float v) { for (int o = 32; o > 0; o >>= 1) v = fmaxf(v, __shfl_xor(v, o)); return v; }
DEVI int keyrow(int row) { if (row < NTOK) return (row >> 13) * NKEY + (row & 8191); int c = row - NTOK; return (c >> 8) * NKEY + SEQ + (c & 255); }

__device__ const float ROPE_FREQ[16] = {1.0f, 0.5623413324356079f, 0.3162277638912201f, 0.17782793939113617f, 0.10000000149011612f, 0.05623413249850273f, 0.03162277489900589f, 0.017782794311642647f, 0.009999999776482582f, 0.005623413249850273f, 0.003162277629598975f, 0.0017782794311642647f, 0.0010000000474974513f, 0.000562341301701963f, 0.0003162277571391314f, 0.00017782794020604342f};
DEVI void sincos_small(double a, double& cs, double& sn) {
  const double k = rint(a * 0.15915494309189535); const double r = fma(-k, 6.283185307179586, a) - k * 2.4492935982947064e-16;
  const double r2 = r * r; double s = 0.0, c = 0.0;
#pragma unroll
  for (int n = 12; n >= 1; --n) { s = (1.0 - s * r2 / (double)((2 * n) * (2 * n + 1))); c = (1.0 - c * r2 / (double)((2 * n - 1) * (2 * n))); }
  sn = r * s; cs = c;
}

DEVI void transpose_job(const float* __restrict__ src, int K, int N, bf16_t* __restrict__ dst, const float* __restrict__ gk, bool isWin, int ntiles, char* smem) {
  const int tid = threadIdx.x; bf16_t* tl = (bf16_t*)smem; const int kt = K / 64;
  for (int idx = blockIdx.x; idx < ntiles; idx += gridDim.x) {
    const int ktile = idx % kt, ntile = idx / kt, k0 = ktile * 64, n0d = ntile * 64;
    int n0s = n0d; bool zero = false;
    if (isWin) { if (n0d == 2496) zero = true; else if (n0d >= 2560) n0s = n0d - 64; }
    { const int kk = tid >> 3, nn8 = (tid & 7) * 8; f32x4 va = {0.f, 0.f, 0.f, 0.f}, vb = va;
      if (!zero) { const float* s = src + (size_t)(k0 + kk) * N + n0s + nn8; const float4 a = *(const float4*)s, b = *(const float4*)(s + 4);
        const float sc = gk ? gk[k0 + kk] : 1.f; va = (f32x4){a.x, a.y, a.z, a.w} * sc; vb = (f32x4){b.x, b.y, b.z, b.w} * sc; }
      bf16_t* tp = tl + nn8 * 72 + kk;
      tp[0] = f2bf(va[0]); tp[72] = f2bf(va[1]); tp[144] = f2bf(va[2]); tp[216] = f2bf(va[3]); tp[288] = f2bf(vb[0]); tp[360] = f2bf(vb[1]); tp[432] = f2bf(vb[2]); tp[504] = f2bf(vb[3]); }
    __syncthreads();
    { const int nn = tid >> 3, kk8 = (tid & 7) * 8;
      const u32x4 o = *(const u32x4*)(tl + nn * 72 + kk8);
      *(u32x4*)(dst + (size_t)(n0d + nn) * K + k0 + kk8) = o; }
    __syncthreads();
  }
}

DEVI void ph_prep(const Params& p, char* smem) {
  const int tid = threadIdx.x, bid = blockIdx.x, nb = gridDim.x;
  char* ws = p.ws;
  if (bid == 0) { float* rope = (float*)(ws + O_ROPE);
    for (int i = tid; i < 128 * 16; i += NTHR) { const int pos = i >> 4, f = i & 15; const float ang = (float)pos * ROPE_FREQ[f];
      double cs, sn; sincos_small((double)ang, cs, sn); rope[i * 2] = (float)cs; rope[i * 2 + 1] = (float)sn; } }
  { float* red = (float*)smem; float* MOD = (float*)(ws + O_MOD);
    for (int it = bid; it < 256; it += nb) {
      const int cgp = tid % 6, kg = tid / 6;
      f32x4 a0 = {0.f, 0.f, 0.f, 0.f}, a1 = a0, a2 = a0;
      if (tid < 510) {
        for (int k = kg; k < 1024; k += 85) {
          const float4 w4 = *(const float4*)(p.w_mod + (size_t)k * 6144 + it * 24 + cgp * 4);
          const f32x4 w = {w4.x, w4.y, w4.z, w4.w};
          const float c0 = p.c[k], c1 = p.c[1024 + k], c2 = p.c_ctx[k];
          a0 += w * (c0 / (1.f + __expf(-c0))); a1 += w * (c1 / (1.f + __expf(-c1))); a2 += w * (c2 / (1.f + __expf(-c2)));
        }
        float* rp = red + kg * 72 + cgp * 4;
        rp[0] = a0[0]; rp[1] = a0[1]; rp[2] = a0[2]; rp[3] = a0[3];
        rp[24] = a1[0]; rp[25] = a1[1]; rp[26] = a1[2]; rp[27] = a1[3];
        rp[48] = a2[0]; rp[49] = a2[1]; rp[50] = a2[2]; rp[51] = a2[3];
      }
      __syncthreads();
      if (tid < 72) { float s = 0.f; for (int g = 0; g < 85; ++g) s += red[g * 72 + tid]; int r = tid / 24, n = it * 24 + tid % 24; MOD[r * 6144 + n] = s + p.b_mod[n]; }
      __syncthreads();
    } }
  transpose_job(p.w_in,  1024, INW,  (bf16_t*)(ws + O_WIN),  nullptr, true,  1152, smem);
  transpose_job(p.w_uq,  256,  1536, (bf16_t*)(ws + O_WUQ),  p.g_q,   false, 96,   smem);
  transpose_job(p.w_ukv, 128,  2048, (bf16_t*)(ws + O_WUKV), p.g_kv,  false, 64,   smem);
  transpose_job(p.w_pa,  1024, 1024, (bf16_t*)(ws + O_WPA),  nullptr, false, 256,  smem);
  transpose_job(p.w_pb,  1024, 1024, (bf16_t*)(ws + O_WPB),  nullptr, false, 256,  smem);
  transpose_job(p.w_o,   1024, 1024, (bf16_t*)(ws + O_WO),   nullptr, false, 256,  smem);
  transpose_job(p.w_pq,  1024, 2048, (bf16_t*)(ws + O_WPQ),  nullptr, false, 512,  smem);
  { const int n8 = (131072 + 16384 + 16384) / 8;
    for (int i = bid * NTHR + tid; i < n8; i += nb * NTHR) {
      int e = i * 8; const float* s; bf16_t* d;
      if (e < 131072) { s = p.w_s + e; d = (bf16_t*)(ws + O_WS) + e; }
      else if (e < 131072 + 16384) { s = p.k1 + (e - 131072); d = (bf16_t*)(ws + O_K1) + (e - 131072); }
      else { s = p.k2 + (e - 131072 - 16384); d = (bf16_t*)(ws + O_K2) + (e - 131072 - 16384); }
      const float4 a = *(const float4*)s, b = *(const float4*)(s + 4);
      u32x4 o = {pack2(a.x, a.y), pack2(a.z, a.w), pack2(b.x, b.y), pack2(b.z, b.w)};
      *(u32x4*)d = o;
    } }
}

DEVI void convert_table(const float* __restrict__ src, bf16_t* __restrict__ dst) {
  const int n8 = 16384 * 1024 / 8;
  for (int i = blockIdx.x * NTHR + threadIdx.x; i < n8; i += gridDim.x * NTHR) {
    const float4 a = *(const float4*)(src + (size_t)i * 8), b = *(const float4*)(src + (size_t)i * 8 + 4);
    u32x4 o = {pack2(a.x, a.y), pack2(a.z, a.w), pack2(b.x, b.y), pack2(b.z, b.w)};
    *(u32x4*)(dst + (size_t)i * 8) = o;
  }
}

DEVI void ph_hx(const Params& p, char* smem) {
  const int tid = threadIdx.x, wave = tid >> 6, lane = tid & 63;
  float* mA = (float*)smem; float* mB = mA + 3 * 1024;
  const float* MOD = (const float*)(p.ws + O_MOD);
  for (int i = tid; i < 3072; i += NTHR) { int r = i >> 10, c = i & 1023; mA[i] = p.g_pre1[c] * (1.f + MOD[r * 6144 + 1024 + c]); mB[i] = MOD[r * 6144 + c]; }
  __syncthreads();
  bf16_t* HX = (bf16_t*)(p.ws + O_RA);
  for (int row = blockIdx.x * NWAVE + wave; row < NROW; row += gridDim.x * NWAVE) {
    const float* src = row < NTOK ? p.x + (size_t)row * 1024 : p.ctx + (size_t)(row - NTOK) * 1024;
    const int mr = row < NTOK ? (row >> 13) : 2;
    float4 v[4]; float ss = 0.f;
#pragma unroll
    for (int i = 0; i < 4; ++i) { v[i] = *(const float4*)(src + i * 256 + lane * 4); ss += v[i].x * v[i].x + v[i].y * v[i].y + v[i].z * v[i].z + v[i].w * v[i].w; }
    ss = wave_sum(ss); const float rstd = rsqrtf(ss * (1.f / 1024.f) + EPS);
#pragma unroll
    for (int i = 0; i < 4; ++i) { const int c = i * 256 + lane * 4; const float* a = mA + mr * 1024 + c; const float* b = mB + mr * 1024 + c;
      u32x2 o = {pack2(v[i].x * rstd * a[0] + b[0], v[i].y * rstd * a[1] + b[1]), pack2(v[i].z * rstd * a[2] + b[2], v[i].w * rstd * a[3] + b[3])};
      *(u32x2*)(HX + (size_t)row * 1024 + c) = o; }
  }
}

template <int BM, bool ACOLMAP, class Epi>
DEVI void gemm_tile_naive(const bf16_t* __restrict__ A, int lda, const bf16_t* __restrict__ Bm, int ldb, int K, int row0, int col0, const Epi& epi, const float* kss) {
  const int t = threadIdx.x, cgp = t & 31, rr = t >> 5;
  for (int rb = 0; rb < BM; rb += 16) {
    const int r = rb + rr;
    const bf16_t* ap = A + (size_t)r * lda;
    const bf16_t* bp = Bm + (size_t)(cgp * 4) * ldb;
    float acc[4] = {0.f, 0.f, 0.f, 0.f};
    for (int k = 0; k < K; k += 8) {
      const int ka = ACOLMAP ? (k + (k >> 7) * 64) : k;
      float af[8]; unpack8(*(const u32x4*)(ap + ka), af);
      if (kss) {
#pragma unroll
        for (int j = 0; j < 8; ++j) af[j] *= kss[k + j]; }
#pragma unroll
      for (int n = 0; n < 4; ++n) { float bf[8]; unpack8(*(const u32x4*)(bp + (size_t)n * ldb + k), bf);
#pragma unroll
        for (int j = 0; j < 8; ++j) acc[n] += af[j] * bf[j]; }
    }
    float sq = epi(row0 + r, col0 + cgp * 4, acc);
    if (Epi::RSS) { for (int o = 16; o > 0; o >>= 1) sq += __shfl_xor(sq, o); if (cgp == 0) { epi.rss(row0 + r, col0, sq); epi.rss(row0 + r, col0 + 64, 0.f); } }
  }
}

template <int BM, bool ACOLMAP, class Epi>
DEVI void gemm_tile(const bf16_t* A, int lda, const bf16_t* Bm, int ldb, int K, int row0, int col0, const Epi& epi, const float* kss, char* smem) {
  gemm_tile_naive<BM, ACOLMAP>(A, lda, Bm, ldb, K, row0, col0, epi, kss);
}

DEVI void st4bf(bf16_t* d, float a, float b, float c, float e) { u32x2 o = {pack2(a, b), pack2(c, e)}; *(u32x2*)d = o; }

struct EpiIn { static constexpr bool RSS = true; bf16_t *GU, *GVT, *CQ, *CKV, *KR; float *rssv, *rssq, *rsskv;
  DEVI float operator()(int row, int col, const float (&v)[4]) const {
    if (col < 1024) { st4bf(GU + (size_t)row * 1024 + col, gelu_t(v[0]), gelu_t(v[1]), gelu_t(v[2]), gelu_t(v[3])); return 0.f; }
    else if (col < 2048) { const int c = col - 1024, chunk = row >> 7, q = row & 127; float s = 0.f;
#pragma unroll
      for (int j = 0; j < 4; ++j) { const float g = gelu_t(v[j]); s += g * g; GVT[((size_t)chunk * 1024 + c + j) * 128 + q] = f2bf(g); }
      return s; }
    else if (col < 2304) { st4bf(CQ + (size_t)row * 256 + (col - 2048), v[0], v[1], v[2], v[3]); return v[0] * v[0] + v[1] * v[1] + v[2] * v[2] + v[3] * v[3]; }
    else if (col < 2432) { st4bf(CKV + (size_t)row * 128 + (col - 2304), v[0], v[1], v[2], v[3]); return v[0] * v[0] + v[1] * v[1] + v[2] * v[2] + v[3] * v[3]; }
    else if (col < 2496) { st4bf(KR + (size_t)keyrow(row) * 64 + (col - 2432), v[0], v[1], v[2], v[3]); return 0.f; }
    return 0.f; }
  DEVI void rss(int row, int col, float s) const {
    if (col >= 1024 && col < 2048) rssv[row * 16 + ((col - 1024) >> 6)] = s; else if (col >= 2048 && col < 2304) rssq[row * 4 + ((col - 2048) >> 6)] = s; else if (col >= 2304 && col < 2432) rsskv[row * 2 + ((col - 2304) >> 6)] = s; }
};
struct EpiQ { static constexpr bool RSS = false; bf16_t* Q; const float* rssq;
  DEVI float operator()(int row, int col, const float (&v)[4]) const { const float4 ps = *(const float4*)(rssq + row * 4); const float r = rsqrtf(((ps.x + ps.y) + (ps.z + ps.w)) * (1.f / 256.f) + EPS);
    st4bf(Q + (size_t)row * 1536 + col, v[0] * r, v[1] * r, v[2] * r, v[3] * r); return 0.f; }
  DEVI void rss(int, int, float) const {} };
struct EpiKV { static constexpr bool RSS = false; bf16_t* KV; const float* rsskv;
  DEVI float operator()(int row, int col, const float (&v)[4]) const { const float r = rsqrtf((rsskv[row * 2] + rsskv[row * 2 + 1]) * (1.f / 128.f) + EPS);
    st4bf(KV + (size_t)keyrow(row) * 2048 + col, v[0] * r, v[1] * r, v[2] * r, v[3] * r); return 0.f; }
  DEVI void rss(int, int, float) const {} };
struct EpiSgu { static constexpr bool RSS = false; bf16_t* GUOA; const float* g_sgu; const float* b_s; int chunk, g;
  DEVI float operator()(int row, int col, const float (&v)[4]) const { const int token = chunk * 128 + row, ch = g * 128 + col; const float bias = b_s[g * 128 + row];
    bf16_t* ptr = GUOA + (size_t)token * 1024 + ch; const u32x2 gu = *(const u32x2*)ptr;
    st4bf(ptr, lo2f(gu[0]) * (g_sgu[ch] * v[0] + bias), hi2f(gu[0]) * (g_sgu[ch + 1] * v[1] + bias), lo2f(gu[1]) * (g_sgu[ch + 2] * v[2] + bias), hi2f(gu[1]) * (g_sgu[ch + 3] * v[3] + bias));
    return 0.f; }
  DEVI void rss(int, int, float) const {} };
struct EpiGate { static constexpr bool RSS = false; bf16_t* G;
  DEVI float operator()(int row, int col, const float (&v)[4]) const { st4bf(G + (size_t)row * 2048 + col, sigmoidf_(v[0]), sigmoidf_(v[1]), sigmoidf_(v[2]), sigmoidf_(v[3])); return 0.f; }
  DEVI void rss(int, int, float) const {} };
template <bool SECOND> struct EpiMerge { static constexpr bool RSS = false; bf16_t* M; const bf16_t* G;
  DEVI float operator()(int row, int col, const float (&v)[4]) const { const u32x2 g = *(const u32x2*)(G + (size_t)row * 2048 + (SECOND ? 1024 : 0) + col);
    float o0 = lo2f(g[0]) * v[0], o1 = hi2f(g[0]) * v[1], o2 = lo2f(g[1]) * v[2], o3 = hi2f(g[1]) * v[3];
    bf16_t* ptr = M + (size_t)row * 1024 + col;
    if (SECOND) { const u32x2 m = *(const u32x2*)ptr; o0 += lo2f(m[0]); o1 += hi2f(m[0]); o2 += lo2f(m[1]); o3 += hi2f(m[1]); }
    st4bf(ptr, o0, o1, o2, o3); return 0.f; }
  DEVI void rss(int, int, float) const {} };
struct EpiO { static constexpr bool RSS = true; bf16_t* Y; float* rssy;
  DEVI float operator()(int row, int col, const float (&v)[4]) const { st4bf(Y + (size_t)row * 1024 + col, v[0], v[1], v[2], v[3]); return v[0] * v[0] + v[1] * v[1] + v[2] * v[2] + v[3] * v[3]; }
  DEVI void rss(int row, int col, float s) const { rssy[row * 16 + (col >> 6)] = s; } };
struct EpiPq { static constexpr bool RSS = false; bf16_t* QP;
  DEVI float operator()(int row, int col, const float (&v)[4]) const { st4bf(QP + (size_t)row * 2048 + col, v[0], v[1], v[2], v[3]); return 0.f; }
  DEVI void rss(int, int, float) const {} };

DEVI void ph_inproj(const Params& p, char* smem) {
  char* ws = p.ws;
  EpiIn epi{(bf16_t*)(ws + O_RB), (bf16_t*)(ws + O_RC), (bf16_t*)(ws + O_CQ), (bf16_t*)(ws + O_CKV), (bf16_t*)(ws + O_KR), (float*)(ws + O_RSSV), (float*)(ws + O_RSSQ), (float*)(ws + O_RSSKV)};
  const bf16_t* HX = (const bf16_t*)(ws + O_RA); const bf16_t* W = (const bf16_t*)(ws + O_WIN);
  for (int i = blockIdx.x; i < 1284; i += gridDim.x) {
    int mt, nt; if (i < 1280) { mt = i / 20; nt = i % 20; } else { mt = 64 + ((i - 1280) >> 1); nt = 18 + ((i - 1280) & 1); }
    gemm_tile<256, false>(HX + (size_t)mt * 256 * 1024, 1024, W + (size_t)nt * 128 * 1024, 1024, 1024, mt * 256, nt * 128, epi, nullptr, smem);
  }
}
DEVI void rope_kr(const Params& p) {
  bf16_t* KR = (bf16_t*)(p.ws + O_KR); const float* rope = (const float*)(p.ws + O_ROPE);
  for (int i = blockIdx.x * NTHR + threadIdx.x; i < NTOK * 32; i += gridDim.x * NTHR) {
    const int tok = i >> 5, j = i & 15, which = (i >> 4) & 1, pos = tok & 8191, pp = which ? (pos & 63) : (pos >> 6);
    const float cs = rope[(pp * 16 + j) * 2], sn = rope[(pp * 16 + j) * 2 + 1];
    bf16_t* r = KR + (size_t)keyrow(tok) * 64 + which * 32 + j;
    const float x1 = bf2f(r[0]), x2 = bf2f(r[16]);
    r[0] = f2bf(x1 * cs - x2 * sn); r[16] = f2bf(x1 * sn + x2 * cs);
  }
}
DEVI void ph_mid(const Params& p, char* smem) {
  char* ws = p.ws;
  { EpiQ epi{(bf16_t*)(ws + O_RQ), (const float*)(ws + O_RSSQ)};
    const bf16_t* A = (const bf16_t*)(ws + O_CQ); const bf16_t* W = (const bf16_t*)(ws + O_WUQ);
    for (int i = blockIdx.x; i < 64 * 12; i += gridDim.x) { const int mt = i / 12, nt = i % 12;
      gemm_tile<256, false>(A + (size_t)mt * 256 * 256, 256, W + (size_t)nt * 128 * 256, 256, 256, mt * 256, nt * 128, epi, nullptr, smem); } }
  { EpiKV epi{(bf16_t*)(ws + O_RKV), (const float*)(ws + O_RSSKV)};
    const bf16_t* A = (const bf16_t*)(ws + O_CKV); const bf16_t* W = (const bf16_t*)(ws + O_WUKV);
    for (int i = blockIdx.x; i < 66 * 16; i += gridDim.x) { const int mt = i / 16, nt = i % 16;
      gemm_tile<256, false>(A + (size_t)mt * 256 * 128, 128, W + (size_t)nt * 128 * 128, 128, 128, mt * 256, nt * 128, epi, nullptr, smem); } }
  { const bf16_t* WS = (const bf16_t*)(ws + O_WS); const bf16_t* GVT = (const bf16_t*)(ws + O_RC);
    float* ksc = (float*)(smem + LDS_BYTES - 512); const float* rssv = (const float*)(ws + O_RSSV);
    for (int i = blockIdx.x; i < 1024; i += gridDim.x) { const int chunk = i >> 3, g = i & 7;
      __syncthreads();
      if (threadIdx.x < 128) { const float* pr = rssv + (size_t)(chunk * 128 + threadIdx.x) * 16; float t = 0.f;
#pragma unroll
        for (int j = 0; j < 16; ++j) t += pr[j];
        ksc[threadIdx.x] = rsqrtf(t * (1.f / 1024.f) + EPS); }
      __syncthreads();
      EpiSgu epi{(bf16_t*)(ws + O_RB), p.g_sgu, p.b_s, chunk, g};
      gemm_tile<128, false>(WS + (size_t)g * 16384, 128, GVT + ((size_t)chunk * 1024 + g * 128) * 128, 128, 128, 0, 0, epi, ksc, smem); } }
  rope_kr(p);
}
DEVI void ph_gates(const Params& p, char* smem) {
  char* ws = p.ws; EpiGate epi{(bf16_t*)(ws + O_RKV)};
  const bf16_t* HX = (const bf16_t*)(ws + O_RA); const bf16_t* W = (const bf16_t*)(ws + O_WIN) + (size_t)NPRE * 1024;
  for (int i = blockIdx.x; i < 64 * 16; i += gridDim.x) { const int mt = i / 16, nt = i % 16;
    gemm_tile<256, false>(HX + (size_t)mt * 256 * 1024, 1024, W + (size_t)nt * 128 * 1024, 1024, 1024, mt * 256, nt * 128, epi, nullptr, smem); }
}
DEVI void ph_merge(const Params& p, char* smem) {
  char* ws = p.ws; bf16_t* M = (bf16_t*)(ws + O_RC); const bf16_t* G = (const bf16_t*)(ws + O_RKV);
  EpiMerge<false> e1{M, G}; EpiMerge<true> e2{M, G};
  const bf16_t* OA = (const bf16_t*)(ws + O_RB); const bf16_t* OB = (const bf16_t*)(ws + O_RQ);
  const bf16_t* WA = (const bf16_t*)(ws + O_WPA); const bf16_t* WB = (const bf16_t*)(ws + O_WPB);
  for (int i = blockIdx.x; i < 64 * 8; i += gridDim.x) { const int mt = i / 8, nt = i % 8;
    gemm_tile<256, false>(OA + (size_t)mt * 256 * 1024, 1024, WA + (size_t)nt * 128 * 1024, 1024, 1024, mt * 256, nt * 128, e1, nullptr, smem);
    gemm_tile<256, true>(OB + (size_t)mt * 256 * 1536, 1536, WB + (size_t)nt * 128 * 1024, 1024, 1024, mt * 256, nt * 128, e2, nullptr, smem); }
}
DEVI void ph_wo(const Params& p, char* smem) {
  char* ws = p.ws; EpiO epi{(bf16_t*)(ws + O_RA), (float*)(ws + O_RSSY)};
  const bf16_t* M = (const bf16_t*)(ws + O_RC); const bf16_t* W = (const bf16_t*)(ws + O_WO);
  for (int i = blockIdx.x; i < 64 * 8; i += gridDim.x) { const int mt = i / 8, nt = i % 8;
    gemm_tile<256, false>(M + (size_t)mt * 256 * 1024, 1024, W + (size_t)nt * 128 * 1024, 1024, 1024, mt * 256, nt * 128, epi, nullptr, smem); }
}
DEVI void ph_wpq(const Params& p, char* smem) {
  char* ws = p.ws; EpiPq epi{(bf16_t*)(ws + O_RKV)};
  const bf16_t* A = (const bf16_t*)(ws + O_RB); const bf16_t* W = (const bf16_t*)(ws + O_WPQ);
  for (int i = blockIdx.x; i < 64 * 16; i += gridDim.x) { const int mt = i / 16, nt = i % 16;
    gemm_tile<256, false>(A + (size_t)mt * 256 * 1024, 1024, W + (size_t)nt * 128 * 1024, 1024, 1024, mt * 256, nt * 128, epi, nullptr, smem); }
  convert_table(p.v_exp, (bf16_t*)(ws + O_RA));
}

DEVI void attn_naive(const Params& p, char* smem) {
  const int tid = threadIdx.x, wave = tid >> 6, lane = tid & 63;
  float* qs = (float*)smem + wave * 256; float* ps = qs + 192;
  bf16_t* Q = (bf16_t*)(p.ws + O_RQ); const bf16_t* KV = (const bf16_t*)(p.ws + O_RKV); const bf16_t* KR = (const bf16_t*)(p.ws + O_KR);
  const float* rope = (const float*)(p.ws + O_ROPE);
  const float scale = 0.07216878364870322f;
  for (int base = blockIdx.x * NWAVE; base < NB * 8 * SEQ; base += gridDim.x * NWAVE) {
    const int it = base + wave, bh = it >> 13, qi = it & 8191, b = bh >> 3, h = bh & 7;
    const size_t qoff = (size_t)(b * SEQ + qi) * 1536 + h * 192;
    __syncthreads();
    for (int d = lane; d < 192; d += 64) qs[d] = bf2f(Q[qoff + d]);
    __syncthreads();
    if (lane < 32) { const int j = lane & 15, which = lane >> 4, pp = which ? (qi & 63) : (qi >> 6);
      const float cs = rope[(pp * 16 + j) * 2], sn = rope[(pp * 16 + j) * 2 + 1]; const int d1 = 128 + which * 32 + j, d2 = d1 + 16;
      const float x1 = qs[d1], x2 = qs[d2]; qs[d1] = x1 * cs - x2 * sn; qs[d2] = x1 * sn + x2 * cs; }
    __syncthreads();
    float m = -1e30f, l = 0.f, o0 = 0.f, o1 = 0.f;
    for (int k0 = 0; k0 < NKEY; k0 += 64) {
      const size_t kr = (size_t)(b * NKEY + k0 + lane);
      const bf16_t* kn = KV + kr * 2048 + h * 256; const bf16_t* krp = KR + kr * 64;
      float s = 0.f;
#pragma unroll 4
      for (int d8 = 0; d8 < 16; ++d8) { float kf[8]; unpack8(*(const u32x4*)(kn + d8 * 8), kf); const float4 q0 = *(const float4*)(qs + d8 * 8), q1 = *(const float4*)(qs + d8 * 8 + 4);
        s += q0.x * kf[0] + q0.y * kf[1] + q0.z * kf[2] + q0.w * kf[3] + q1.x * kf[4] + q1.y * kf[5] + q1.z * kf[6] + q1.w * kf[7]; }
#pragma unroll 4
      for (int d8 = 0; d8 < 8; ++d8) { float kf[8]; unpack8(*(const u32x4*)(krp + d8 * 8), kf); const float4 q0 = *(const float4*)(qs + 128 + d8 * 8), q1 = *(const float4*)(qs + 128 + d8 * 8 + 4);
        s += q0.x * kf[0] + q0.y * kf[1] + q0.z * kf[2] + q0.w * kf[3] + q1.x * kf[4] + q1.y * kf[5] + q1.z * kf[6] + q1.w * kf[7]; }
      s *= scale;
      const float mn = fmaxf(m, wave_max(s)), al = __expf(m - mn), pe = __expf(s - mn);
      l = l * al + wave_sum(pe); m = mn; o0 *= al; o1 *= al;
      __syncthreads();
      ps[lane] = pe;
      __syncthreads();
      const bf16_t* vp = KV + (size_t)(b * NKEY + k0) * 2048 + h * 256 + 128 + lane * 2;
#pragma unroll 8
      for (int kk = 0; kk < 64; ++kk) { const unsigned w = *(const unsigned*)(vp + (size_t)kk * 2048); const float pk = ps[kk]; o0 += pk * lo2f(w); o1 += pk * hi2f(w); }
    }
    const float invL = 1.f / l;
    *(unsigned*)(Q + qoff + lane * 2) = pack2(o0 * invL, o1 * invL);
  }
}
DEVI void ph_attn(const Params& p, char* smem) { attn_naive(p, smem); }

DEVI void ph_rows(const Params& p, char* smem) {
  const int tid = threadIdx.x, wave = tid >> 6, lane = tid & 63;
  const float* MOD = (const float*)(p.ws + O_MOD); const bf16_t* Y = (const bf16_t*)(p.ws + O_RA); const float* rssy = (const float*)(p.ws + O_RSSY);
  bf16_t* HX2 = (bf16_t*)(p.ws + O_RB);
  for (int row = blockIdx.x * NWAVE + wave; row < NTOK; row += gridDim.x * NWAVE) {
    const int b = row >> 13; const float* md = MOD + b * 6144;
    float ty = 0.f; { const float* pr = rssy + (size_t)row * 16;
#pragma unroll
      for (int j = 0; j < 16; ++j) ty += pr[j]; }
    const float ry = rsqrtf(ty * (1.f / 1024.f) + EPS);
    float x1[16]; float ss = 0.f;
#pragma unroll
    for (int i = 0; i < 4; ++i) { const int c = i * 256 + lane * 4; const float4 xv = *(const float4*)(p.x + (size_t)row * 1024 + c); const u32x2 yv = *(const u32x2*)(Y + (size_t)row * 1024 + c);
      const float4 gp = *(const float4*)(p.g_post1 + c), gt = *(const float4*)(md + 2048 + c);
      x1[i * 4 + 0] = xv.x + gt.x * (lo2f(yv[0]) * ry * gp.x); x1[i * 4 + 1] = xv.y + gt.y * (hi2f(yv[0]) * ry * gp.y);
      x1[i * 4 + 2] = xv.z + gt.z * (lo2f(yv[1]) * ry * gp.z); x1[i * 4 + 3] = xv.w + gt.w * (hi2f(yv[1]) * ry * gp.w);
#pragma unroll
      for (int j = 0; j < 4; ++j) ss += x1[i * 4 + j] * x1[i * 4 + j];
      *(float4*)(p.out + (size_t)row * 1024 + c) = make_float4(x1[i * 4], x1[i * 4 + 1], x1[i * 4 + 2], x1[i * 4 + 3]); }
    ss = wave_sum(ss); const float r2 = rsqrtf(ss * (1.f / 1024.f) + EPS);
#pragma unroll
    for (int i = 0; i < 4; ++i) { const int c = i * 256 + lane * 4; const float4 g2 = *(const float4*)(p.g_pre2 + c), sc = *(const float4*)(md + 4096 + c), sh = *(const float4*)(md + 3072 + c);
      st4bf(HX2 + (size_t)row * 1024 + c, x1[i * 4] * r2 * g2.x * (1.f + sc.x) + sh.x, x1[i * 4 + 1] * r2 * g2.y * (1.f + sc.y) + sh.y,
            x1[i * 4 + 2] * r2 * g2.z * (1.f + sc.z) + sh.z, x1[i * 4 + 3] * r2 * g2.w * (1.f + sc.w) + sh.w); }
  }
  convert_table(p.u_exp, (bf16_t*)(p.ws + O_RC));
}

DEVI void topk_naive(const Params& p, char* smem) {
  const int tid = threadIdx.x, wave = tid >> 6, lane = tid & 63;
  float* wl = (float*)smem + wave * 512; int* wi = (int*)wl;
  const bf16_t* QP = (const bf16_t*)(p.ws + O_RKV); const bf16_t* K1 = (const bf16_t*)(p.ws + O_K1); const bf16_t* K2 = (const bf16_t*)(p.ws + O_K2);
  int* IDX = (int*)(p.ws + O_RQ); float* GW = (float*)(p.ws + O_RQ + (size_t)NTOK * 128 * 4);
  for (int base = blockIdx.x * NWAVE; base < NTOK * 8; base += gridDim.x * NWAVE) {
    const int it = base + wave, token = it >> 3, h = it & 7;
    __syncthreads();
    const bf16_t* q = QP + (size_t)token * 2048 + h * 256;
    for (int d = lane; d < 256; d += 64) wl[d] = bf2f(q[d]);
    __syncthreads();
    float s[4] = {0.f, 0.f, 0.f, 0.f};
#pragma unroll 2
    for (int d8 = 0; d8 < 16; ++d8) {
      const float4 qa0 = *(const float4*)(wl + d8 * 8), qa1 = *(const float4*)(wl + d8 * 8 + 4), qb0 = *(const float4*)(wl + 128 + d8 * 8), qb1 = *(const float4*)(wl + 128 + d8 * 8 + 4);
#pragma unroll
      for (int w = 0; w < 4; ++w) { const int key = lane + (w & 1) * 64; const bf16_t* kp = (w < 2 ? K1 : K2) + key * 128;
        float kf[8]; unpack8(*(const u32x4*)(kp + d8 * 8), kf); const float4 q0 = w < 2 ? qa0 : qb0, q1 = w < 2 ? qa1 : qb1;
        s[w] += q0.x * kf[0] + q0.y * kf[1] + q0.z * kf[2] + q0.w * kf[3] + q1.x * kf[4] + q1.y * kf[5] + q1.z * kf[6] + q1.w * kf[7]; }
    }
#pragma unroll
    for (int half = 0; half < 2; ++half) { float a0 = s[half * 2], a1 = s[half * 2 + 1];
#pragma unroll 1
      for (int r = 0; r < 16; ++r) { float v; int i; if (a0 >= a1) { v = a0; i = lane; } else { v = a1; i = lane + 64; }
        for (int o = 32; o > 0; o >>= 1) { const float ov = __shfl_xor(v, o); const int oi = __shfl_xor(i, o); if (ov > v || (ov == v && oi < i)) { v = ov; i = oi; } }
        if (i == lane) a0 = -3.0e38f; else if (i == lane + 64) a1 = -3.0e38f;
        if (lane == 0) { wl[256 + half * 32 + r] = v; wi[256 + half * 32 + 16 + r] = i; } } }
    __syncthreads();
    float cv[4]; int ci[4];
#pragma unroll
    for (int j = 0; j < 4; ++j) { const int cidx = lane * 4 + j, i = cidx >> 4, jj = cidx & 15; cv[j] = wl[256 + i] + wl[256 + 32 + jj]; ci[j] = wi[256 + 16 + i] * 128 + wi[256 + 32 + 16 + jj]; }
    float myv = 0.f, vmax = 0.f; int myi = 0;
#pragma unroll 1
    for (int r = 0; r < 16; ++r) { float v = cv[0]; int pos = lane * 4, ei = ci[0];
#pragma unroll
      for (int j = 1; j < 4; ++j) if (cv[j] > v) { v = cv[j]; pos = lane * 4 + j; ei = ci[j]; }
      for (int o = 32; o > 0; o >>= 1) { const float ov = __shfl_xor(v, o); const int op = __shfl_xor(pos, o), oe = __shfl_xor(ei, o); if (ov > v || (ov == v && op < pos)) { v = ov; pos = op; ei = oe; } }
#pragma unroll
      for (int j = 0; j < 4; ++j) if (pos == lane * 4 + j) cv[j] = -3.0e38f;
      if (r == 0) vmax = v;
      if (lane == r) { myv = v; myi = ei; } }
    const float e = lane < 16 ? __expf(myv - vmax) : 0.f; const float sum = wave_sum(e);
    if (lane < 16) { IDX[(size_t)token * 128 + h * 16 + lane] = myi; GW[(size_t)token * 128 + h * 16 + lane] = e / sum; }
  }
}
DEVI void ph_topk(const Params& p, char* smem) { topk_naive(p, smem); }

DEVI void ph_gather(const Params& p, char* smem) {
  const int tid = threadIdx.x, wave = tid >> 6, lane = tid & 63;
  const bf16_t* HX2 = (const bf16_t*)(p.ws + O_RB); const bf16_t* UT = (const bf16_t*)(p.ws + O_RC); const bf16_t* VT = (const bf16_t*)(p.ws + O_RA);
  const int* IDX = (const int*)(p.ws + O_RQ); const float* GW = (const float*)(p.ws + O_RQ + (size_t)NTOK * 128 * 4);
  const float* MOD = (const float*)(p.ws + O_MOD);
  for (int t = blockIdx.x * NWAVE + wave; t < NTOK; t += gridDim.x * NWAVE) {
    float xf[16];
    unpack8(*(const u32x4*)(HX2 + (size_t)t * 1024 + lane * 8), xf); unpack8(*(const u32x4*)(HX2 + (size_t)t * 1024 + 512 + lane * 8), xf + 8);
    const int my_i0 = IDX[(size_t)t * 128 + lane], my_i1 = IDX[(size_t)t * 128 + 64 + lane];
    const float my_g0 = GW[(size_t)t * 128 + lane], my_g1 = GW[(size_t)t * 128 + 64 + lane];
    float acc[16];
#pragma unroll
    for (int j = 0; j < 16; ++j) acc[j] = 0.f;
    for (int e0 = 0; e0 < 128; e0 += 4) {
      int id[4]; float g[4]; u32x4 ua[4], ub[4], va[4], vb[4];
#pragma unroll
      for (int j = 0; j < 4; ++j) { const int e = e0 + j; id[j] = e0 < 64 ? __shfl(my_i0, e) : __shfl(my_i1, e - 64); g[j] = e0 < 64 ? __shfl(my_g0, e) : __shfl(my_g1, e - 64);
        const bf16_t* ur = UT + (size_t)id[j] * 1024; const bf16_t* vr = VT + (size_t)id[j] * 1024;
        ua[j] = *(const u32x4*)(ur + lane * 8); ub[j] = *(const u32x4*)(ur + 512 + lane * 8); va[j] = *(const u32x4*)(vr + lane * 8); vb[j] = *(const u32x4*)(vr + 512 + lane * 8); }
      float d[4];
#pragma unroll
      for (int j = 0; j < 4; ++j) { float uf[16]; unpack8(ua[j], uf); unpack8(ub[j], uf + 8); float s = 0.f;
#pragma unroll
        for (int k = 0; k < 16; ++k) s += xf[k] * uf[k];
        d[j] = s; }
#pragma unroll
      for (int j = 0; j < 4; ++j) d[j] = wave_sum(d[j]);
#pragma unroll
      for (int j = 0; j < 4; ++j) { const float cf = g[j] * gelu_t(d[j]); float vf[16]; unpack8(va[j], vf); unpack8(vb[j], vf + 8);
#pragma unroll
        for (int k = 0; k < 16; ++k) acc[k] += cf * vf[k]; }
    }
    float ss = 0.f;
#pragma unroll
    for (int k = 0; k < 16; ++k) ss += acc[k] * acc[k];
    ss = wave_sum(ss); const float rstd = rsqrtf(ss * (1.f / 1024.f) + EPS);
    const int b = t >> 13; const float* gt2 = MOD + b * 6144 + 5120;
#pragma unroll
    for (int hh = 0; hh < 2; ++hh) { const int c = hh * 512 + lane * 8; float* op = p.out + (size_t)t * 1024 + c;
#pragma unroll
      for (int q4 = 0; q4 < 2; ++q4) { float4 xv = *(const float4*)(op + q4 * 4); const float4 gt = *(const float4*)(gt2 + c + q4 * 4), gp = *(const float4*)(p.g_post2 + c + q4 * 4);
        xv.x += gt.x * (acc[hh * 8 + q4 * 4 + 0] * rstd * gp.x); xv.y += gt.y * (acc[hh * 8 + q4 * 4 + 1] * rstd * gp.y);
        xv.z += gt.z * (acc[hh * 8 + q4 * 4 + 2] * rstd * gp.z); xv.w += gt.w * (acc[hh * 8 + q4 * 4 + 3] * rstd * gp.w);
        *(float4*)(op + q4 * 4) = xv; } }
  }
}

constexpr int NPHASE = 12;
template <int PH> DEVI void run_phase(const Params& p, char* smem) {
  if constexpr (PH == 0) ph_prep(p, smem);
  else if constexpr (PH == 1) ph_hx(p, smem);
  else if constexpr (PH == 2) ph_inproj(p, smem);
  else if constexpr (PH == 3) ph_mid(p, smem);
  else if constexpr (PH == 4) ph_attn(p, smem);
  else if constexpr (PH == 5) ph_gates(p, smem);
  else if constexpr (PH == 6) ph_merge(p, smem);
  else if constexpr (PH == 7) ph_wo(p, smem);
  else if constexpr (PH == 8) ph_rows(p, smem);
  else if constexpr (PH == 9) ph_wpq(p, smem);
  else if constexpr (PH == 10) ph_topk(p, smem);
  else if constexpr (PH == 11) ph_gather(p, smem);
}

template <int PH> __global__ __launch_bounds__(NTHR) void k_phase(Params p) {
  extern __shared__ __attribute__((aligned(16))) char smem[];
  run_phase<PH>(p, smem);
}

#if MEGA
__global__ __launch_bounds__(NTHR) void k_mega(Params p) {
  extern __shared__ __attribute__((aligned(16))) char smem[];
  cg::grid_group grid = cg::this_grid();
  run_phase<0>(p, smem); grid.sync();
  run_phase<1>(p, smem); grid.sync();
  run_phase<2>(p, smem); grid.sync();
  run_phase<3>(p, smem); grid.sync();
  run_phase<4>(p, smem); grid.sync();
  run_phase<5>(p, smem); grid.sync();
  run_phase<6>(p, smem); grid.sync();
  run_phase<7>(p, smem); grid.sync();
  run_phase<8>(p, smem); grid.sync();
  run_phase<9>(p, smem); grid.sync();
  run_phase<10>(p, smem); grid.sync();
  run_phase<11>(p, smem);
}
#endif

template <int PH> static void launch_phase(const Params& p, int grid, hipStream_t stream) {
  hipLaunchKernelGGL(k_phase<PH>, dim3(grid), dim3(NTHR), LDS_BYTES, stream, p);
}
template <int PH> static void set_attr() { (void)hipFuncSetAttribute((const void*)k_phase<PH>, hipFuncAttributeMaxDynamicSharedMemorySize, LDS_BYTES); }

extern "C" void kernel_launch(void* const* d_in, const int* in_sizes, int n_in, void* d_out, int out_size, void* d_ws, size_t ws_size, hipStream_t stream) {
  static int grid = 0;
  if (grid == 0) {
    if (n_in != 26 || out_size != NTOK * DM || ws_size < O_END) { fprintf(stderr, "kernel_launch: unexpected shapes n_in %d out %d ws %zu (need %zu)\n", n_in, out_size, ws_size, (size_t)O_END); grid = -1; return; }
#if MEGA
    (void)hipFuncSetAttribute((const void*)k_mega, hipFuncAttributeMaxDynamicSharedMemorySize, LDS_BYTES);
    int dev = 0, cus = 0, per_cu = 0; (void)hipGetDevice(&dev); (void)hipDeviceGetAttribute(&cus, hipDeviceAttributeMultiprocessorCount, dev);
    (void)hipOccupancyMaxActiveBlocksPerMultiprocessor(&per_cu, (const void*)k_mega, NTHR, LDS_BYTES);
    if (per_cu < 1) { fprintf(stderr, "kernel_launch: occupancy query says %d blocks per CU\n", per_cu); grid = -1; return; }
    grid = cus;
#else
    set_attr<0>(); set_attr<1>(); set_attr<2>(); set_attr<3>(); set_attr<4>(); set_attr<5>(); set_attr<6>(); set_attr<7>(); set_attr<8>(); set_attr<9>(); set_attr<10>(); set_attr<11>();
    grid = 256;
#endif
  }
  if (grid < 0) return;
  Params p{};
  const float** pp = (const float**)&p;
  for (int i = 0; i < 26; ++i) pp[i] = (const float*)d_in[i];
  p.out = (float*)d_out; p.ws = (char*)d_ws;
#if MEGA
  void* args[] = {&p};
  hipError_t e = hipLaunchCooperativeKernel((const void*)k_mega, dim3(grid), dim3(NTHR), args, LDS_BYTES, stream);
  if (e != hipSuccess) fprintf(stderr, "cooperative launch failed: %s (grid %d)\n", hipGetErrorString(e), grid);
#else
  launch_phase<0>(p, grid, stream); launch_phase<1>(p, grid, stream); launch_phase<2>(p, grid, stream); launch_phase<3>(p, grid, stream);
  launch_phase<4>(p, grid, stream); launch_phase<5>(p, grid, stream); launch_phase<6>(p, grid, stream); launch_phase<7>(p, grid, stream);
  launch_phase<8>(p, grid, stream); launch_phase<9>(p, grid, stream); launch_phase<10>(p, grid, stream); launch_phase<11>(p, grid, stream);
#endif
}
```

```cpp
#include <hip/hip_runtime.h>
#include <hip/hip_cooperative_groups.h>
#include <cstdint>
#include <cstdio>
namespace cg = cooperative_groups;

#ifndef MEGA
#define MEGA 1
#endif
#ifndef GEMM_MFMA
#define GEMM_MFMA 0
#endif
#ifndef ATTN_MFMA
#define ATTN_MFMA 0
#endif
#ifndef TOPK_FAST
#define TOPK_FAST 0
#endif

#define DEVI __device__ __forceinline__
typedef unsigned short bf16_t;
using bf16x8 = __attribute__((ext_vector_type(8))) short;
using bf16x4 = __attribute__((ext_vector_type(4))) short;
using f32x4  = __attribute__((ext_vector_type(4))) float;
using f32x16 = __attribute__((ext_vector_type(16))) float;
using u32x4  = __attribute__((ext_vector_type(4))) unsigned;
using u32x2  = __attribute__((ext_vector_type(2))) unsigned;

constexpr int DM = 1024, NB = 2, SEQ = 8192, NTOK = NB * SEQ, CTXL = 256, NCTX = NB * CTXL, NROW = NTOK + NCTX, NKEY = SEQ + CTXL;
constexpr int INW = 4544, INWP = 4608;
constexpr int NPRE = 2560;
constexpr float EPS = 1e-6f;
constexpr int NTHR = 512, NWAVE = 8;
constexpr int LDS_BYTES = 98304;

constexpr size_t al256(size_t x) { return (x + 255) / 256 * 256; }
constexpr size_t O_WIN   = 0;
constexpr size_t O_WUQ   = O_WIN  + al256((size_t)INWP * 1024 * 2);
constexpr size_t O_WUKV  = O_WUQ  + al256((size_t)1536 * 256 * 2);
constexpr size_t O_WPA   = O_WUKV + al256((size_t)2048 * 128 * 2);
constexpr size_t O_WPB   = O_WPA  + al256((size_t)1024 * 1024 * 2);
constexpr size_t O_WO    = O_WPB  + al256((size_t)1024 * 1024 * 2);
constexpr size_t O_WPQ   = O_WO   + al256((size_t)1024 * 1024 * 2);
constexpr size_t O_WS    = O_WPQ  + al256((size_t)2048 * 1024 * 2);
constexpr size_t O_K1    = O_WS   + al256((size_t)8 * 128 * 128 * 2);
constexpr size_t O_K2    = O_K1   + al256((size_t)128 * 128 * 2);
constexpr size_t O_MOD   = O_K2   + al256((size_t)128 * 128 * 2);
constexpr size_t O_ROPE  = O_MOD  + al256((size_t)3 * 6144 * 4);
constexpr size_t O_RSSV  = O_ROPE + al256((size_t)128 * 16 * 2 * 4);
constexpr size_t O_RSSQ  = O_RSSV + (size_t)NTOK * 16 * 4;
constexpr size_t O_RSSKV = O_RSSQ + (size_t)NTOK * 4 * 4;
constexpr size_t O_RSSY  = O_RSSKV + (size_t)NROW * 2 * 4;
constexpr size_t O_RSSEND = O_RSSY + (size_t)NTOK * 16 * 4;
constexpr size_t O_RA    = al256(O_RSSEND);
constexpr size_t O_RB    = O_RA  + al256((size_t)NROW * 1024 * 2);
constexpr size_t O_RC    = O_RB  + al256((size_t)NTOK * 1024 * 2);
constexpr size_t O_CQ    = O_RC  + al256((size_t)NTOK * 1024 * 2);
constexpr size_t O_CKV   = O_CQ  + al256((size_t)NTOK * 256 * 2);
constexpr size_t O_KR    = O_CKV + al256((size_t)NROW * 128 * 2);
constexpr size_t O_RQ    = O_KR  + al256((size_t)NROW * 64 * 2);
constexpr size_t O_RKV   = O_RQ  + al256((size_t)NTOK * 1536 * 2);
constexpr size_t O_END   = O_RKV + al256((size_t)NROW * 2048 * 2);
static_assert(O_END <= (size_t)258 * 1024 * 1024, "workspace too large");

struct Params {
  const float *x, *c, *ctx, *c_ctx, *w_mod, *b_mod, *g_pre1, *g_post1, *g_pre2, *g_post2, *w_in, *g_q, *g_kv, *w_uq, *w_ukv, *g_sgu, *w_s, *b_s,
      *w_pa, *w_pb, *w_o, *w_pq, *k1, *k2, *u_exp, *v_exp;
  float* out; char* ws;
};

DEVI float bf2f(unsigned short h) { return __uint_as_float(((unsigned)h) << 16); }
DEVI unsigned short f2bf(float f) { unsigned u = __float_as_uint(f); u += 0x7fffu + ((u >> 16) & 1u); return (unsigned short)(u >> 16); }
DEVI unsigned pack2(float a, float b) { return (unsigned)f2bf(a) | ((unsigned)f2bf(b) << 16); }
DEVI float lo2f(unsigned w) { return __uint_as_float(w << 16); }
DEVI float hi2f(unsigned w) { return __uint_as_float(w & 0xffff0000u); }
DEVI void unpack8(const u32x4& w, float* f) {
  f[0] = lo2f(w[0]); f[1] = hi2f(w[0]); f[2] = lo2f(w[1]); f[3] = hi2f(w[1]); f[4] = lo2f(w[2]); f[5] = hi2f(w[2]); f[6] = lo2f(w[3]); f[7] = hi2f(w[3]);
}
DEVI float gelu_t(float x) { float z = 0.7978845608028654f * (x + 0.044715f * x * x * x); return x / (1.f + __expf(-2.f * z)); }
DEVI float sigmoidf_(float x) { return 1.f / (1.f + __expf(-x)); }
DEVI float wave_sum(float v) { for (int o = 32; o > 0; o >>= 1) v += __shfl_xor(v, o); return v; }
DEVI float wave_max(float v) { for (int o = 32; o > 0; o >>= 1) v = fmaxf(v, __shfl_xor(v, o)); return v; }
DEVI int keyrow(int row) { if (row < NTOK) return (row >> 13) * NKEY + (row & 8191); int c = row - NTOK; return (c >> 8) * NKEY + SEQ + (c & 255); }

__device__ const float ROPE_FREQ[16] = {1.0f, 0.5623413324356079f, 0.3162277638912201f, 0.17782793939113617f, 0.10000000149011612f, 0.05623413249850273f, 0.03162277489900589f, 0.017782794311642647f, 0.009999999776482582f, 0.005623413249850273f, 0.003162277629598975f, 0.0017782794311642647f, 0.0010000000474974513f, 0.000562341301701963f, 0.0003162277571391314f, 0.00017782794020604342f};
DEVI void sincos_small(double a, double& cs, double& sn) {
  const double k = rint(a * 0.15915494309189535); const double r = fma(-k, 6.283185307179586, a) - k * 2.4492935982947064e-16;
  const double r2 = r * r; double s = 0.0, c = 0.0;
#pragma unroll
  for (int n = 12; n >= 1; --n) { s = (1.0 - s * r2 / (double)((2 * n) * (2 * n + 1))); c = (1.0 - c * r2 / (double)((2 * n - 1) * (2 * n))); }
  sn = r * s; cs = c;
}

DEVI void transpose_job(const float* __restrict__ src, int K, int N, bf16_t* __restrict__ dst, const float* __restrict__ gk, bool isWin, int ntiles, char* smem) {
  const int tid = threadIdx.x; bf16_t* tl = (bf16_t*)smem; const int kt = K / 64;
  for (int idx = blockIdx.x; idx < ntiles; idx += gridDim.x) {
    const int ktile = idx % kt, ntile = idx / kt, k0 = ktile * 64, n0d = ntile * 64;
    int n0s = n0d; bool zero = false;
    if (isWin) { if (n0d == 2496) zero = true; else if (n0d >= 2560) n0s = n0d - 64; }
    { const int kk = tid >> 3, nn8 = (tid & 7) * 8; f32x4 va = {0.f, 0.f, 0.f, 0.f}, vb = va;
      if (!zero) { const float* s = src + (size_t)(k0 + kk) * N + n0s + nn8; const float4 a = *(const float4*)s, b = *(const float4*)(s + 4);
        const float sc = gk ? gk[k0 + kk] : 1.f; va = (f32x4){a.x, a.y, a.z, a.w} * sc; vb = (f32x4){b.x, b.y, b.z, b.w} * sc; }
      bf16_t* tp = tl + nn8 * 72 + kk;
      tp[0] = f2bf(va[0]); tp[72] = f2bf(va[1]); tp[144] = f2bf(va[2]); tp[216] = f2bf(va[3]); tp[288] = f2bf(vb[0]); tp[360] = f2bf(vb[1]); tp[432] = f2bf(vb[2]); tp[504] = f2bf(vb[3]); }
    __syncthreads();
    { const int nn = tid >> 3, kk8 = (tid & 7) * 8;
      const u32x4 o = *(const u32x4*)(tl + nn * 72 + kk8);
      *(u32x4*)(dst + (size_t)(n0d + nn) * K + k0 + kk8) = o; }
    __syncthreads();
  }
}

DEVI void ph_prep(const Params& p, char* smem) {
  const int tid = threadIdx.x, bid = blockIdx.x, nb = gridDim.x;
  char* ws = p.ws;
  if (bid == 0) { float* rope = (float*)(ws + O_ROPE);
    for (int i = tid; i < 128 * 16; i += NTHR) { const int pos = i >> 4, f = i & 15; const float ang = (float)pos * ROPE_FREQ[f];
      double cs, sn; sincos_small((double)ang, cs, sn); rope[i * 2] = (float)cs; rope[i * 2 + 1] = (float)sn; } }
  { float* red = (float*)smem; float* MOD = (float*)(ws + O_MOD);
    for (int it = bid; it < 256; it += nb) {
      const int cgp = tid % 6, kg = tid / 6;
      f32x4 a0 = {0.f, 0.f, 0.f, 0.f}, a1 = a0, a2 = a0;
      if (tid < 510) {
        for (int k = kg; k < 1024; k += 85) {
          const float4 w4 = *(const float4*)(p.w_mod + (size_t)k * 6144 + it * 24 + cgp * 4);
          const f32x4 w = {w4.x, w4.y, w4.z, w4.w};
          const float c0 = p.c[k], c1 = p.c[1024 + k], c2 = p.c_ctx[k];
          a0 += w * (c0 / (1.f + __expf(-c0))); a1 += w * (c1 / (1.f + __expf(-c1))); a2 += w * (c2 / (1.f + __expf(-c2)));
        }
        float* rp = red + kg * 72 + cgp * 4;
        rp[0] = a0[0]; rp[1] = a0[1]; rp[2] = a0[2]; rp[3] = a0[3];
        rp[24] = a1[0]; rp[25] = a1[1]; rp[26] = a1[2]; rp[27] = a1[3];
        rp[48] = a2[0]; rp[49] = a2[1]; rp[50] = a2[2]; rp[51] = a2[3];
      }
      __syncthreads();
      if (tid < 72) { float s = 0.f; for (int g = 0; g < 85; ++g) s += red[g * 72 + tid]; int r = tid / 24, n = it * 24 + tid % 24; MOD[r * 6144 + n] = s + p.b_mod[n]; }
      __syncthreads();
    } }
  transpose_job(p.w_in,  1024, INW,  (bf16_t*)(ws + O_WIN),  nullptr, true,  1152, smem);
  transpose_job(p.w_uq,  256,  1536, (bf16_t*)(ws + O_WUQ),  p.g_q,   false, 96,   smem);
  transpose_job(p.w_ukv, 128,  2048, (bf16_t*)(ws + O_WUKV), p.g_kv,  false, 64,   smem);
  transpose_job(p.w_pa,  1024, 1024, (bf16_t*)(ws + O_WPA),  nullptr, false, 256,  smem);
  transpose_job(p.w_pb,  1024, 1024, (bf16_t*)(ws + O_WPB),  nullptr, false, 256,  smem);
  transpose_job(p.w_o,   1024, 1024, (bf16_t*)(ws + O_WO),   nullptr, false, 256,  smem);
  transpose_job(p.w_pq,  1024, 2048, (bf16_t*)(ws + O_WPQ),  nullptr, false, 512,  smem);
  { const int n8 = (131072 + 16384 + 16384) / 8;
    for (int i = bid * NTHR + tid; i < n8; i += nb * NTHR) {
      int e = i * 8; const float* s; bf16_t* d;
      if (e < 131072) { s = p.w_s + e; d = (bf16_t*)(ws + O_WS) + e; }
      else if (e < 131072 + 16384) { s = p.k1 + (e - 131072); d = (bf16_t*)(ws + O_K1) + (e - 131072); }
      else { s = p.k2 + (e - 131072 - 16384); d = (bf16_t*)(ws + O_K2) + (e - 131072 - 16384); }
      const float4 a = *(const float4*)s, b = *(const float4*)(s + 4);
      u32x4 o = {pack2(a.x, a.y), pack2(a.z, a.w), pack2(b.x, b.y), pack2(b.z, b.w)};
      *(u32x4*)d = o;
    } }
}

DEVI void convert_table(const float* __restrict__ src, bf16_t* __restrict__ dst) {
  const int n8 = 16384 * 1024 / 8;
  for (int i = blockIdx.x * NTHR + threadIdx.x; i < n8; i += gridDim.x * NTHR) {
    const float4 a = *(const float4*)(src + (size_t)i * 8), b = *(const float4*)(src + (size_t)i * 8 + 4);
    u32x4 o = {pack2(a.x, a.y), pack2(a.z, a.w), pack2(b.x, b.y), pack2(b.z, b.w)};
    *(u32x4*)(dst + (size_t)i * 8) = o;
  }
}

DEVI void ph_hx(const Params& p, char* smem) {
  const int tid = threadIdx.x, wave = tid >> 6, lane = tid & 63;
  float* mA = (float*)smem; float* mB = mA + 3 * 1024;
  const float* MOD = (const float*)(p.ws + O_MOD);
  for (int i = tid; i < 3072; i += NTHR) { int r = i >> 10, c = i & 1023; mA[i] = p.g_pre1[c] * (1.f + MOD[r * 6144 + 1024 + c]); mB[i] = MOD[r * 6144 + c]; }
  __syncthreads();
  bf16_t* HX = (bf16_t*)(p.ws + O_RA);
  for (int row = blockIdx.x * NWAVE + wave; row < NROW; row += gridDim.x * NWAVE) {
    const float* src = row < NTOK ? p.x + (size_t)row * 1024 : p.ctx + (size_t)(row - NTOK) * 1024;
    const int mr = row < NTOK ? (row >> 13) : 2;
    float4 v[4]; float ss = 0.f;
#pragma unroll
    for (int i = 0; i < 4; ++i) { v[i] = *(const float4*)(src + i * 256 + lane * 4); ss += v[i].x * v[i].x + v[i].y * v[i].y + v[i].z * v[i].z + v[i].w * v[i].w; }
    ss = wave_sum(ss); const float rstd = rsqrtf(ss * (1.f / 1024.f) + EPS);
#pragma unroll
    for (int i = 0; i < 4; ++i) { const int c = i * 256 + lane * 4; const float* a = mA + mr * 1024 + c; const float* b = mB + mr * 1024 + c;
      u32x2 o = {pack2(v[i].x * rstd * a[0] + b[0], v[i].y * rstd * a[1] + b[1]), pack2(v[i].z * rstd * a[2] + b[2], v[i].w * rstd * a[3] + b[3])};
      *(u32x2*)(HX + (size_t)row * 1024 + c) = o; }
  }
}

template <int BM, bool ACOLMAP, class Epi>
DEVI void gemm_tile_naive(const bf16_t* __restrict__ A, int lda, const bf16_t* __restrict__ Bm, int ldb, int K, int row0, int col0, const Epi& epi, const float* kss) {
  const int t = threadIdx.x, cgp = t & 31, rr = t >> 5;
  for (int rb = 0; rb < BM; rb += 16) {
    const int r = rb + rr;
    const bf16_t* ap = A + (size_t)r * lda;
    const bf16_t* bp = Bm + (size_t)(cgp * 4) * ldb;
    float acc[4] = {0.f, 0.f, 0.f, 0.f};
    for (int k = 0; k < K; k += 8) {
      const int ka = ACOLMAP ? (k + (k >> 7) * 64) : k;
      float af[8]; unpack8(*(const u32x4*)(ap + ka), af);
      if (kss) {
#pragma unroll
        for (int j = 0; j < 8; ++j) af[j] *= kss[k + j]; }
#pragma unroll
      for (int n = 0; n < 4; ++n) { float bf[8]; unpack8(*(const u32x4*)(bp + (size_t)n * ldb + k), bf);
#pragma unroll
        for (int j = 0; j < 8; ++j) acc[n] += af[j] * bf[j]; }
    }
    float sq = epi(row0 + r, col0 + cgp * 4, acc);
    if (Epi::RSS) { for (int o = 16; o > 0; o >>= 1) sq += __shfl_xor(sq, o); if (cgp == 0) { epi.rss(row0 + r, col0, sq); epi.rss(row0 + r, col0 + 64, 0.f); } }
  }
}

template <int BM, bool ACOLMAP, class Epi>
DEVI void gemm_tile(const bf16_t* A, int lda, const bf16_t* Bm, int ldb, int K, int row0, int col0, const Epi& epi, const float* kss, char* smem) {
  gemm_tile_naive<BM, ACOLMAP>(A, lda, Bm, ldb, K, row0, col0, epi, kss);
}

DEVI void st4bf(bf16_t* d, float a, float b, float c, float e) { u32x2 o = {pack2(a, b), pack2(c, e)}; *(u32x2*)d = o; }

struct EpiIn { static constexpr bool RSS = true; bf16_t *GU, *GVT, *CQ, *CKV, *KR; float *rssv, *rssq, *rsskv;
  DEVI float operator()(int row, int col, const float (&v)[4]) const {
    if (col < 1024) { st4bf(GU + (size_t)row * 1024 + col, gelu_t(v[0]), gelu_t(v[1]), gelu_t(v[2]), gelu_t(v[3])); return 0.f; }
    else if (col < 2048) { const int c = col - 1024, chunk = row >> 7, q = row & 127; float s = 0.f;
#pragma unroll
      for (int j = 0; j < 4; ++j) { const float g = gelu_t(v[j]); s += g * g; GVT[((size_t)chunk * 1024 + c + j) * 128 + q] = f2bf(g); }
      return s; }
    else if (col < 2304) { st4bf(CQ + (size_t)row * 256 + (col - 2048), v[0], v[1], v[2], v[3]); return v[0] * v[0] + v[1] * v[1] + v[2] * v[2] + v[3] * v[3]; }
    else if (col < 2432) { st4bf(CKV + (size_t)row * 128 + (col - 2304), v[0], v[1], v[2], v[3]); return v[0] * v[0] + v[1] * v[1] + v[2] * v[2] + v[3] * v[3]; }
    else if (col < 2496) { st4bf(KR + (size_t)keyrow(row) * 64 + (col - 2432), v[0], v[1], v[2], v[3]); return 0.f; }
    return 0.f; }
  DEVI void rss(int row, int col, float s) const {
    if (col >= 1024 && col < 2048) rssv[row * 16 + ((col - 1024) >> 6)] = s; else if (col >= 2048 && col < 2304) rssq[row * 4 + ((col - 2048) >> 6)] = s; else if (col >= 2304 && col < 2432) rsskv[row * 2 + ((col - 2304) >> 6)] = s; }
};
struct EpiQ { static constexpr bool RSS = false; bf16_t* Q; const float* rssq;
  DEVI float operator()(int row, int col, const float (&v)[4]) const { const float4 ps = *(const float4*)(rssq + row * 4); const float r = rsqrtf(((ps.x + ps.y) + (ps.z + ps.w)) * (1.f / 256.f) + EPS);
    st4bf(Q + (size_t)row * 1536 + col, v[0] * r, v[1] * r, v[2] * r, v[3] * r); return 0.f; }
  DEVI void rss(int, int, float) const {} };
struct EpiKV { static constexpr bool RSS = false; bf16_t* KV; const float* rsskv;
  DEVI float operator()(int row, int col, const float (&v)[4]) const { const float r = rsqrtf((rsskv[row * 2] + rsskv[row * 2 + 1]) * (1.f / 128.f) + EPS);
    st4bf(KV + (size_t)keyrow(row) * 2048 + col, v[0] * r, v[1] * r, v[2] * r, v[3] * r); return 0.f; }
  DEVI void rss(int, int, float) const {} };
struct EpiSgu { static constexpr bool RSS = false; bf16_t* GUOA; const float* g_sgu; const float* b_s; int chunk, g;
  DEVI float operator()(int row, int col, const float (&v)[4]) const { const int token = chunk * 128 + row, ch = g * 128 + col; const float bias = b_s[g * 128 + row];
    bf16_t* ptr = GUOA + (size_t)token * 1024 + ch; const u32x2 gu = *(const u32x2*)ptr;
    st4bf(ptr, lo2f(gu[0]) * (g_sgu[ch] * v[0] + bias), hi2f(gu[0]) * (g_sgu[ch + 1] * v[1] + bias), lo2f(gu[1]) * (g_sgu[ch + 2] * v[2] + bias), hi2f(gu[1]) * (g_sgu[ch + 3] * v[3] + bias));
    return 0.f; }
  DEVI void rss(int, int, float) const {} };
struct EpiGate { static constexpr bool RSS = false; bf16_t* G;
  DEVI float operator()(int row, int col, const float (&v)[4]) const { st4bf(G + (size_t)row * 2048 + col, sigmoidf_(v[0]), sigmoidf_(v[1]), sigmoidf_(v[2]), sigmoidf_(v[3])); return 0.f; }
  DEVI void rss(int, int, float) const {} };
template <bool SECOND> struct EpiMerge { static constexpr bool RSS = false; bf16_t* M; const bf16_t* G;
  DEVI float operator()(int row, int col, const float (&v)[4]) const { const u32x2 g = *(const u32x2*)(G + (size_t)row * 2048 + (SECOND ? 1024 : 0) + col);
    float o0 = lo2f(g[0]) * v[0], o1 = hi2f(g[0]) * v[1], o2 = lo2f(g[1]) * v[2], o3 = hi2f(g[1]) * v[3];
    bf16_t* ptr = M + (size_t)row * 1024 + col;
    if (SECOND) { const u32x2 m = *(const u32x2*)ptr; o0 += lo2f(m[0]); o1 += hi2f(m[0]); o2 += lo2f(m[1]); o3 += hi2f(m[1]); }
    st4bf(ptr, o0, o1, o2, o3); return 0.f; }
  DEVI void rss(int, int, float) const {} };
struct EpiO { static constexpr bool RSS = true; bf16_t* Y; float* rssy;
  DEVI float operator()(int row, int col, const float (&v)[4]) const { st4bf(Y + (size_t)row * 1024 + col, v[0], v[1], v[2], v[3]); return v[0] * v[0] + v[1] * v[1] + v[2] * v[2] + v[3] * v[3]; }
  DEVI void rss(int row, int col, float s) const { rssy[row * 16 + (col >> 6)] = s; } };
struct EpiPq { static constexpr bool RSS = false; bf16_t* QP;
  DEVI float operator()(int row, int col, const float (&v)[4]) const { st4bf(QP + (size_t)row * 2048 + col, v[0], v[1], v[2], v[3]); return 0.f; }
  DEVI void rss(int, int, float) const {} };

DEVI void ph_inproj(const Params& p, char* smem) {
  char* ws = p.ws;
  EpiIn epi{(bf16_t*)(ws + O_RB), (bf16_t*)(ws + O_RC), (bf16_t*)(ws + O_CQ), (bf16_t*)(ws + O_CKV), (bf16_t*)(ws + O_KR), (float*)(ws + O_RSSV), (float*)(ws + O_RSSQ), (float*)(ws + O_RSSKV)};
  const bf16_t* HX = (const bf16_t*)(ws + O_RA); const bf16_t* W = (const bf16_t*)(ws + O_WIN);
  for (int i = blockIdx.x; i < 1284; i += gridDim.x) {
    int mt, nt; if (i < 1280) { mt = i / 20; nt = i % 20; } else { mt = 64 + ((i - 1280) >> 1); nt = 18 + ((i - 1280) & 1); }
    gemm_tile<256, false>(HX + (size_t)mt * 256 * 1024, 1024, W + (size_t)nt * 128 * 1024, 1024, 1024, mt * 256, nt * 128, epi, nullptr, smem);
  }
}
DEVI void rope_kr(const Params& p) {
  bf16_t* KR = (bf16_t*)(p.ws + O_KR); const float* rope = (const float*)(p.ws + O_ROPE);
  for (int i = blockIdx.x * NTHR + threadIdx.x; i < NTOK * 32; i += gridDim.x * NTHR) {
    const int tok = i >> 5, j = i & 15, which = (i >> 4) & 1, pos = tok & 8191, pp = which ? (pos & 63) : (pos >> 6);
    const float cs = rope[(pp * 16 + j) * 2], sn = rope[(pp * 16 + j) * 2 + 1];
    bf16_t* r = KR + (size_t)keyrow(tok) * 64 + which * 32 + j;
    const float x1 = bf2f(r[0]), x2 = bf2f(r[16]);
    r[0] = f2bf(x1 * cs - x2 * sn); r[16] = f2bf(x1 * sn + x2 * cs);
  }
}
DEVI void ph_mid(const Params& p, char* smem) {
  char* ws = p.ws;
  { EpiQ epi{(bf16_t*)(ws + O_RQ), (const float*)(ws + O_RSSQ)};
    const bf16_t* A = (const bf16_t*)(ws + O_CQ); const bf16_t* W = (const bf16_t*)(ws + O_WUQ);
    for (int i = blockIdx.x; i < 64 * 12; i += gridDim.x) { const int mt = i / 12, nt = i % 12;
      gemm_tile<256, false>(A + (size_t)mt * 256 * 256, 256, W + (size_t)nt * 128 * 256, 256, 256, mt * 256, nt * 128, epi, nullptr, smem); } }
  { EpiKV epi{(bf16_t*)(ws + O_RKV), (const float*)(ws + O_RSSKV)};
    const bf16_t* A = (const bf16_t*)(ws + O_CKV); const bf16_t* W = (const bf16_t*)(ws + O_WUKV);
    for (int i = blockIdx.x; i < 66 * 16; i += gridDim.x) { const int mt = i / 16, nt = i % 16;
      gemm_tile<256, false>(A + (size_t)mt * 256 * 128, 128, W + (size_t)nt * 128 * 128, 128, 128, mt * 256, nt * 128, epi, nullptr, smem); } }
  { const bf16_t* WS = (const bf16_t*)(ws + O_WS); const bf16_t* GVT = (const bf16_t*)(ws + O_RC);
    float* ksc = (float*)(smem + LDS_BYTES - 512); const float* rssv = (const float*)(ws + O_RSSV);
    for (int i = blockIdx.x; i < 1024; i += gridDim.x) { const int chunk = i >> 3, g = i & 7;
      __syncthreads();
      if (threadIdx.x < 128) { const float* pr = rssv + (size_t)(chunk * 128 + threadIdx.x) * 16; float t = 0.f;
#pragma unroll
        for (int j = 0; j < 16; ++j) t += pr[j];
        ksc[threadIdx.x] = rsqrtf(t * (1.f / 1024.f) + EPS); }
      __syncthreads();
      EpiSgu epi{(bf16_t*)(ws + O_RB), p.g_sgu, p.b_s, chunk, g};
      gemm_tile<128, false>(WS + (size_t)g * 16384, 128, GVT + ((size_t)chunk * 1024 + g * 128) * 128, 128, 128, 0, 0, epi, ksc, smem); } }
  rope_kr(p);
}
DEVI void ph_gates(const Params& p, char* smem) {
  char* ws = p.ws; EpiGate epi{(bf16_t*)(ws + O_RKV)};
  const bf16_t* HX = (const bf16_t*)(ws + O_RA); const bf16_t* W = (const bf16_t*)(ws + O_WIN) + (size_t)NPRE * 1024;
  for (int i = blockIdx.x; i < 64 * 16; i += gridDim.x) { const int mt = i / 16, nt = i % 16;
    gemm_tile<256, false>(HX + (size_t)mt * 256 * 1024, 1024, W + (size_t)nt * 128 * 1024, 1024, 1024, mt * 256, nt * 128, epi, nullptr, smem); }
}
DEVI void ph_merge(const Params& p, char* smem) {
  char* ws = p.ws; bf16_t* M = (bf16_t*)(ws + O_RC); const bf16_t* G = (const bf16_t*)(ws + O_RKV);
  EpiMerge<false> e1{M, G}; EpiMerge<true> e2{M, G};
  const bf16_t* OA = (const bf16_t*)(ws + O_RB); const bf16_t* OB = (const bf16_t*)(ws + O_RQ);
  const bf16_t* WA = (const bf16_t*)(ws + O_WPA); const bf16_t* WB = (const bf16_t*)(ws + O_WPB);
  for (int i = blockIdx.x; i < 64 * 8; i += gridDim.x) { const int mt = i / 8, nt = i % 8;
    gemm_tile<256, false>(OA + (size_t)mt * 256 * 1024, 1024, WA + (size_t)nt * 128 * 1024, 1024, 1024, mt * 256, nt * 128, e1, nullptr, smem);
    gemm_tile<256, true>(OB + (size_t)mt * 256 * 1536, 1536, WB + (size_t)nt * 128 * 1024, 1024, 1024, mt * 256, nt * 128, e2, nullptr, smem); }
}
DEVI void ph_wo(const Params& p, char* smem) {
  char* ws = p.ws; EpiO epi{(bf16_t*)(ws + O_RA), (float*)(ws + O_RSSY)};
  const bf16_t* M = (const bf16_t*)(ws + O_RC); const bf16_t* W = (const bf16_t*)(ws + O_WO);
  for (int i = blockIdx.x; i < 64 * 8; i += gridDim.x) { const int mt = i / 8, nt = i % 8;
    gemm_tile<256, false>(M + (size_t)mt * 256 * 1024, 1024, W + (size_t)nt * 128 * 1024, 1024, 1024, mt * 256, nt * 128, epi, nullptr, smem); }
}
DEVI void ph_wpq(const Params& p, char* smem) {
  char* ws = p.ws; EpiPq epi{(bf16_t*)(ws + O_RKV)};
  const bf16_t* A = (const bf16_t*)(ws + O_RB); const bf16_t* W = (const bf16_t*)(ws + O_WPQ);
  for (int i = blockIdx.x; i < 64 * 16; i += gridDim.x) { const int mt = i / 16, nt = i % 16;
    gemm_tile<256, false>(A + (size_t)mt * 256 * 1024, 1024, W + (size_t)nt * 128 * 1024, 1024, 1024, mt * 256, nt * 128, epi, nullptr, smem); }
  convert_table(p.v_exp, (bf16_t*)(ws + O_RA));
}

DEVI void attn_naive(const Params& p, char* smem) {
  const int tid = threadIdx.x, wave = tid >> 6, lane = tid & 63;
  float* qs = (float*)smem + wave * 256; float* ps = qs + 192;
  bf16_t* Q = (bf16_t*)(p.ws + O_RQ); const bf16_t* KV = (const bf16_t*)(p.ws + O_RKV); const bf16_t* KR = (const bf16_t*)(p.ws + O_KR);
  const float* rope = (const float*)(p.ws + O_ROPE);
  const float scale = 0.07216878364870322f;
  for (int base = blockIdx.x * NWAVE; base < NB * 8 * SEQ; base += gridDim.x * NWAVE) {
    const int it = base + wave, bh = it >> 13, qi = it & 8191, b = bh >> 3, h = bh & 7;
    const size_t qoff = (size_t)(b * SEQ + qi) * 1536 + h * 192;
    __syncthreads();
    for (int d = lane; d < 192; d += 64) qs[d] = bf2f(Q[qoff + d]);
    __syncthreads();
    if (lane < 32) { const int j = lane & 15, which = lane >> 4, pp = which ? (qi & 63) : (qi >> 6);
      const float cs = rope[(pp * 16 + j) * 2], sn = rope[(pp * 16 + j) * 2 + 1]; const int d1 = 128 + which * 32 + j, d2 = d1 + 16;
      const float x1 = qs[d1], x2 = qs[d2]; qs[d1] = x1 * cs - x2 * sn; qs[d2] = x1 * sn + x2 * cs; }
    __syncthreads();
    float m = -1e30f, l = 0.f, o0 = 0.f, o1 = 0.f;
    for (int k0 = 0; k0 < NKEY; k0 += 64) {
      const size_t kr = (size_t)(b * NKEY + k0 + lane);
      const bf16_t* kn = KV + kr * 2048 + h * 256; const bf16_t* krp = KR + kr * 64;
      float s = 0.f;
#pragma unroll 4
      for (int d8 = 0; d8 < 16; ++d8) { float kf[8]; unpack8(*(const u32x4*)(kn + d8 * 8), kf); const float4 q0 = *(const float4*)(qs + d8 * 8), q1 = *(const float4*)(qs + d8 * 8 + 4);
        s += q0.x * kf[0] + q0.y * kf[1] + q0.z * kf[2] + q0.w * kf[3] + q1.x * kf[4] + q1.y * kf[5] + q1.z * kf[6] + q1.w * kf[7]; }
#pragma unroll 4
      for (int d8 = 0; d8 < 8; ++d8) { float kf[8]; unpack8(*(const u32x4*)(krp + d8 * 8), kf); const float4 q0 = *(const float4*)(qs + 128 + d8 * 8), q1 = *(const float4*)(qs + 128 + d8 * 8 + 4);
        s += q0.x * kf[0] + q0.y * kf[1] + q0.z * kf[2] + q0.w * kf[3] + q1.x * kf[4] + q1.y * kf[5] + q1.z * kf[6] + q1.w * kf[7]; }
      s *= scale;
      const float mn = fmaxf(m, wave_max(s)), al = __expf(m - mn), pe = __expf(s - mn);
      l = l * al + wave_sum(pe); m = mn; o0 *= al; o1 *= al;
      __syncthreads();
      ps[lane] = pe;
      __syncthreads();
      const bf16_t* vp = KV + (size_t)(b * NKEY + k0) * 2048 + h * 256 + 128 + lane * 2;
#pragma unroll 8
      for (int kk = 0; kk < 64; ++kk) { const unsigned w = *(const unsigned*)(vp + (size_t)kk * 2048); const float pk = ps[kk]; o0 += pk * lo2f(w); o1 += pk * hi2f(w); }
    }
    const float invL = 1.f / l;
    *(unsigned*)(Q + qoff + lane * 2) = pack2(o0 * invL, o1 * invL);
  }
}
DEVI void ph_attn(const Params& p, char* smem) { attn_naive(p, smem); }

DEVI void ph_rows(const Params& p, char* smem) {
  const int tid = threadIdx.x, wave = tid >> 6, lane = tid & 63;
  const float* MOD = (const float*)(p.ws + O_MOD); const bf16_t* Y = (const bf16_t*)(p.ws + O_RA); const float* rssy = (const float*)(p.ws + O_RSSY);
  bf16_t* HX2 = (bf16_t*)(p.ws + O_RB);
  for (int row = blockIdx.x * NWAVE + wave; row < NTOK; row += gridDim.x * NWAVE) {
    const int b = row >> 13; const float* md = MOD + b * 6144;
    float ty = 0.f; { const float* pr = rssy + (size_t)row * 16;
#pragma unroll
      for (int j = 0; j < 16; ++j) ty += pr[j]; }
    const float ry = rsqrtf(ty * (1.f / 1024.f) + EPS);
    float x1[16]; float ss = 0.f;
#pragma unroll
    for (int i = 0; i < 4; ++i) { const int c = i * 256 + lane * 4; const float4 xv = *(const float4*)(p.x + (size_t)row * 1024 + c); const u32x2 yv = *(const u32x2*)(Y + (size_t)row * 1024 + c);
      const float4 gp = *(const float4*)(p.g_post1 + c), gt = *(const float4*)(md + 2048 + c);
      x1[i * 4 + 0] = xv.x + gt.x * (lo2f(yv[0]) * ry * gp.x); x1[i * 4 + 1] = xv.y + gt.y * (hi2f(yv[0]) * ry * gp.y);
      x1[i * 4 + 2] = xv.z + gt.z * (lo2f(yv[1]) * ry * gp.z); x1[i * 4 + 3] = xv.w + gt.w * (hi2f(yv[1]) * ry * gp.w);
#pragma unroll
      for (int j = 0; j < 4; ++j) ss += x1[i * 4 + j] * x1[i * 4 + j];
      *(float4*)(p.out + (size_t)row * 1024 + c) = make_float4(x1[i * 4], x1[i * 4 + 1], x1[i * 4 + 2], x1[i * 4 + 3]); }
    ss = wave_sum(ss); const float r2 = rsqrtf(ss * (1.f / 1024.f) + EPS);
#pragma unroll
    for (int i = 0; i < 4; ++i) { const int c = i * 256 + lane * 4; const float4 g2 = *(const float4*)(p.g_pre2 + c), sc = *(const float4*)(md + 4096 + c), sh = *(const float4*)(md + 3072 + c);
      st4bf(HX2 + (size_t)row * 1024 + c, x1[i * 4] * r2 * g2.x * (1.f + sc.x) + sh.x, x1[i * 4 + 1] * r2 * g2.y * (1.f + sc.y) + sh.y,
            x1[i * 4 + 2] * r2 * g2.z * (1.f + sc.z) + sh.z, x1[i * 4 + 3] * r2 * g2.w * (1.f + sc.w) + sh.w); }
  }
  convert_table(p.u_exp, (bf16_t*)(p.ws + O_RC));
}

DEVI void topk_naive(const Params& p, char* smem) {
  const int tid = threadIdx.x, wave = tid >> 6, lane = tid & 63;
  float* wl = (float*)smem + wave * 512; int* wi = (int*)wl;
  const bf16_t* QP = (const bf16_t*)(p.ws + O_RKV); const bf16_t* K1 = (const bf16_t*)(p.ws + O_K1); const bf16_t* K2 = (const bf16_t*)(p.ws + O_K2);
  int* IDX = (int*)(p.ws + O_RQ); float* GW = (float*)(p.ws + O_RQ + (size_t)NTOK * 128 * 4);
  for (int base = blockIdx.x * NWAVE; base < NTOK * 8; base += gridDim.x * NWAVE) {
    const int it = base + wave, token = it >> 3, h = it & 7;
    __syncthreads();
    const bf16_t* q = QP + (size_t)token * 2048 + h * 256;
    for (int d = lane; d < 256; d += 64) wl[d] = bf2f(q[d]);
    __syncthreads();
    float s[4] = {0.f, 0.f, 0.f, 0.f};
#pragma unroll 2
    for (int d8 = 0; d8 < 16; ++d8) {
      const float4 qa0 = *(const float4*)(wl + d8 * 8), qa1 = *(const float4*)(wl + d8 * 8 + 4), qb0 = *(const float4*)(wl + 128 + d8 * 8), qb1 = *(const float4*)(wl + 128 + d8 * 8 + 4);
#pragma unroll
      for (int w = 0; w < 4; ++w) { const int key = lane + (w & 1) * 64; const bf16_t* kp = (w < 2 ? K1 : K2) + key * 128;
        float kf[8]; unpack8(*(const u32x4*)(kp + d8 * 8), kf); const float4 q0 = w < 2 ? qa0 : qb0, q1 = w < 2 ? qa1 : qb1;
        s[w] += q0.x * kf[0] + q0.y * kf[1] + q0.z * kf[2] + q0.w * kf[3] + q1.x * kf[4] + q1.y * kf[5] + q1.z * kf[6] + q1.w * kf[7]; }
    }
#pragma unroll
    for (int half = 0; half < 2; ++half) { float a0 = s[half * 2], a1 = s[half * 2 + 1];
#pragma unroll 1
      for (int r = 0; r < 16; ++r) { float v; int i; if (a0 >= a1) { v = a0; i = lane; } else { v = a1; i = lane + 64; }
        for (int o = 32; o > 0; o >>= 1) { const float ov = __shfl_xor(v, o); const int oi = __shfl_xor(i, o); if (ov > v || (ov == v && oi < i)) { v = ov; i = oi; } }
        if (i == lane) a0 = -3.0e38f; else if (i == lane + 64) a1 = -3.0e38f;
        if (lane == 0) { wl[256 + half * 32 + r] = v; wi[256 + half * 32 + 16 + r] = i; } } }
    __syncthreads();
    float cv[4]; int ci[4];
#pragma unroll
    for (int j = 0; j < 4; ++j) { const int cidx = lane * 4 + j, i = cidx >> 4, jj = cidx & 15; cv[j] = wl[256 + i] + wl[256 + 32 + jj]; ci[j] = wi[256 + 16 + i] * 128 + wi[256 + 32 + 16 + jj]; }
    float myv = 0.f, vmax = 0.f; int myi = 0;
#pragma unroll 1
    for (int r = 0; r < 16; ++r) { float v = cv[0]; int pos = lane * 4, ei = ci[0];
#pragma unroll
      for (int j = 1; j < 4; ++j) if (cv[j] > v) { v = cv[j]; pos = lane * 4 + j; ei = ci[j]; }
      for (int o = 32; o > 0; o >>= 1) { const float ov = __shfl_xor(v, o); const int op = __shfl_xor(pos, o), oe = __shfl_xor(ei, o); if (ov > v || (ov == v && op < pos)) { v = ov; pos = op; ei = oe; } }
#pragma unroll
      for (int j = 0; j < 4; ++j) if (pos == lane * 4 + j) cv[j] = -3.0e38f;
      if (r == 0) vmax = v;
      if (lane == r) { myv = v; myi = ei; } }
    const float e = lane < 16 ? __expf(myv - vmax) : 0.f; const float sum = wave_sum(e);
    if (lane < 16) { IDX[(size_t)token * 128 + h * 16 + lane] = myi; GW[(size_t)token * 128 + h * 16 + lane] = e / sum; }
  }
}
DEVI void ph_topk(const Params& p, char* smem) { topk_naive(p, smem); }

DEVI void ph_gather(const Params& p, char* smem) {
  const int tid = threadIdx.x, wave = tid >> 6, lane = tid & 63;
  const bf16_t* HX2 = (const bf16_t*)(p.ws + O_RB); const bf16_t* UT = (const bf16_t*)(p.ws + O_RC); const bf16_t* VT = (const bf16_t*)(p.ws + O_RA);
  const int* IDX = (const int*)(p.ws + O_RQ); const float* GW = (const float*)(p.ws + O_RQ + (size_t)NTOK * 128 * 4);
  const float* MOD = (const float*)(p.ws + O_MOD);
  for (int t = blockIdx.x * NWAVE + wave; t < NTOK; t += gridDim.x * NWAVE) {
    float xf[16];
    unpack8(*(const u32x4*)(HX2 + (size_t)t * 1024 + lane * 8), xf); unpack8(*(const u32x4*)(HX2 + (size_t)t * 1024 + 512 + lane * 8), xf + 8);
    const int my_i0 = IDX[(size_t)t * 128 + lane], my_i1 = IDX[(size_t)t * 128 + 64 + lane];
    const float my_g0 = GW[(size_t)t * 128 + lane], my_g1 = GW[(size_t)t * 128 + 64 + lane];
    float acc[16];
#pragma unroll
    for (int j = 0; j < 16; ++j) acc[j] = 0.f;
    for (int e0 = 0; e0 < 128; e0 += 4) {
      int id[4]; float g[4]; u32x4 ua[4], ub[4], va[4], vb[4];
#pragma unroll
      for (int j = 0; j < 4; ++j) { const int e = e0 + j; id[j] = e0 < 64 ? __shfl(my_i0, e) : __shfl(my_i1, e - 64); g[j] = e0 < 64 ? __shfl(my_g0, e) : __shfl(my_g1, e - 64);
        const bf16_t* ur = UT + (size_t)id[j] * 1024; const bf16_t* vr = VT + (size_t)id[j] * 1024;
        ua[j] = *(const u32x4*)(ur + lane * 8); ub[j] = *(const u32x4*)(ur + 512 + lane * 8); va[j] = *(const u32x4*)(vr + lane * 8); vb[j] = *(const u32x4*)(vr + 512 + lane * 8); }
      float d[4];
#pragma unroll
      for (int j = 0; j < 4; ++j) { float uf[16]; unpack8(ua[j], uf); unpack8(ub[j], uf + 8); float s = 0.f;
#pragma unroll
        for (int k = 0; k < 16; ++k) s += xf[k] * uf[k];
        d[j] = s; }
#pragma unroll
      for (int j = 0; j < 4; ++j) d[j] = wave_sum(d[j]);
#pragma unroll
      for (int j = 0; j < 4; ++j) { const float cf = g[j] * gelu_t(d[j]); float vf[16]; unpack8(va[j], vf); unpack8(vb[j], vf + 8);
#pragma unroll
        for (int k = 0; k < 16; ++k) acc[k] += cf * vf[k]; }
    }
    float ss = 0.f;
#pragma unroll
    for (int k = 0; k < 16; ++k) ss += acc[k] * acc[k];
    ss = wave_sum(ss); const float rstd = rsqrtf(ss * (1.f / 1024.f) + EPS);
    const int b = t >> 13; const float* gt2 = MOD + b * 6144 + 5120;
#pragma unroll
    for (int hh = 0; hh < 2; ++hh) { const int c = hh * 512 + lane * 8; float* op = p.out + (size_t)t * 1024 + c;
#pragma unroll
      for (int q4 = 0; q4 < 2; ++q4) { float4 xv = *(const float4*)(op + q4 * 4); const float4 gt = *(const float4*)(gt2 + c + q4 * 4), gp = *(const float4*)(p.g_post2 + c + q4 * 4);
        xv.x += gt.x * (acc[hh * 8 + q4 * 4 + 0] * rstd * gp.x); xv.y += gt.y * (acc[hh * 8 + q4 * 4 + 1] * rstd * gp.y);
        xv.z += gt.z * (acc[hh * 8 + q4 * 4 + 2] * rstd * gp.z); xv.w += gt.w * (acc[hh * 8 + q4 * 4 + 3] * rstd * gp.w);
        *(float4*)(op + q4 * 4) = xv; } }
  }
}

constexpr int NPHASE = 12;
template <int PH> DEVI void run_phase(const Params& p, char* smem) {
  if constexpr (PH == 0) ph_prep(p, smem);
  else if constexpr (PH == 1) ph_hx(p, smem);
  else if constexpr (PH == 2) ph_inproj(p, smem);
  else if constexpr (PH == 3) ph_mid(p, smem);
  else if constexpr (PH == 4) ph_attn(p, smem);
  else if constexpr (PH == 5) ph_gates(p, smem);
  else if constexpr (PH == 6) ph_merge(p, smem);
  else if constexpr (PH == 7) ph_wo(p, smem);
  else if constexpr (PH == 8) ph_rows(p, smem);
  else if constexpr (PH == 9) ph_wpq(p, smem);
  else if constexpr (PH == 10) ph_topk(p, smem);
  else if constexpr (PH == 11) ph_gather(p, smem);
}

template <int PH> __global__ __launch_bounds__(NTHR) void k_phase(Params p) {
  extern __shared__ __attribute__((aligned(16))) char smem[];
  run_phase<PH>(p, smem);
}

#if MEGA
__global__ __launch_bounds__(NTHR) void k_mega(Params p) {
  extern __shared__ __attribute__((aligned(16))) char smem[];
  cg::grid_group grid = cg::this_grid();
  run_phase<0>(p, smem); grid.sync();
  run_phase<1>(p, smem); grid.sync();
  run_phase<2>(p, smem); grid.sync();
  run_phase<3>(p, smem); grid.sync();
  run_phase<4>(p, smem); grid.sync();
  run_phase<5>(p, smem); grid.sync();
  run_phase<6>(p, smem); grid.sync();
  run_phase<7>(p, smem); grid.sync();
  run_phase<8>(p, smem); grid.sync();
  run_phase<9>(p, smem); grid.sync();
  run_phase<10>(p, smem); grid.sync();
  run_phase<11>(p, smem);
}
#endif

template <int PH> static void launch_phase(const Params& p, int grid, hipStream_t stream) {
  hipLaunchKernelGGL(k_phase<PH>, dim3(grid), dim3(NTHR), LDS_BYTES, stream, p);
}
template <int PH> static void set_attr() { (void)hipFuncSetAttribute((const void*)k_phase<PH>, hipFuncAttributeMaxDynamicSharedMemorySize, LDS_BYTES); }

extern "C" void kernel_launch(void* const* d_in, const int* in_sizes, int n_in, void* d_out, int out_size, void* d_ws, size_t ws_size, hipStream_t stream) {
  static int grid = 0;
  if (grid == 0) {
    if (n_in != 26 || out_size != NTOK * DM || ws_size < O_END) { fprintf(stderr, "kernel_launch: unexpected shapes n_in %d out %d ws %zu (need %zu)\n", n_in, out_size, ws_size, (size_t)O_END); grid = -1; return; }
#if MEGA
    (void)hipFuncSetAttribute((const void*)k_mega, hipFuncAttributeMaxDynamicSharedMemorySize, LDS_BYTES);
    int dev = 0, cus = 0, per_cu = 0; (void)hipGetDevice(&dev); (void)hipDeviceGetAttribute(&cus, hipDeviceAttributeMultiprocessorCount, dev);
    (void)hipOccupancyMaxActiveBlocksPerMultiprocessor(&per_cu, (const void*)k_mega, NTHR, LDS_BYTES);
    if (per_cu < 1) { fprintf(stderr, "kernel_launch: occupancy query says %d blocks per CU\n", per_cu); grid = -1; return; }
    grid = cus;
#else
    set_attr<0>(); set_attr<1>(); set_attr<2>(); set_attr<3>(); set_attr<4>(); set_attr<5>(); set_attr<6>(); set_attr<7>(); set_attr<8>(); set_attr<9>(); set_attr<10>(); set_attr<11>();
    grid = 256;
#endif
  }
  if (grid < 0) return;
  Params p{};
  const float** pp = (const float**)&p;
  for (int i = 0; i < 26; ++i) pp[i] = (const float*)d_in[i];
  p.out = (float*)d_out; p.ws = (char*)d_ws;
#if MEGA
  void* args[] = {&p};
  hipError_t e = hipLaunchCooperativeKernel((const void*)k_mega, dim3(grid), dim3(NTHR), args, LDS_BYTES, stream);
  if (e != hipSuccess) fprintf(stderr, "cooperative launch failed: %s (grid %d)\n", hipGetErrorString(e), grid);
#else
  launch_phase<0>(p, grid, stream); launch_phase<1>(p, grid, stream); launch_phase<2>(p, grid, stream); launch_phase<3>(p, grid, stream);
  launch_phase<4>(p, grid, stream); launch_phase<5>(p, grid, stream); launch_phase<6>(p, grid, stream); launch_phase<7>(p, grid, stream);
  launch_phase<8>(p, grid, stream); launch_phase<9>(p, grid, stream); launch_phase<10>(p, grid, stream); launch_phase<11>(p, grid, stream);
#endif
}
```

```cpp
#include <hip/hip_runtime.h>
#include <hip/hip_cooperative_groups.h>
#include <cstdint>
#include <cstdio>
namespace cg = cooperative_groups;

#ifndef MEGA
#define MEGA 1
#endif
#ifndef GEMM_MFMA
#define GEMM_MFMA 1
#endif
#ifndef ATTN_MFMA
#define ATTN_MFMA 1
#endif
#ifndef TOPK_FAST
#define TOPK_FAST 0
#endif

#define DEVI __device__ __forceinline__
typedef unsigned short bf16_t;
using bf16x8 = __attribute__((ext_vector_type(8))) short;
using bf16x4 = __attribute__((ext_vector_type(4))) short;
using f32x4  = __attribute__((ext_vector_type(4))) float;
using f32x16 = __attribute__((ext_vector_type(16))) float;
using u32x4  = __attribute__((ext_vector_type(4))) unsigned;
using u32x2  = __attribute__((ext_vector_type(2))) unsigned;

constexpr int DM = 1024, NB = 2, SEQ = 8192, NTOK = NB * SEQ, CTXL = 256, NCTX = NB * CTXL, NROW = NTOK + NCTX, NKEY = SEQ + CTXL;
constexpr int INW = 4544, INWP = 4608;
constexpr int NPRE = 2560;
constexpr float EPS = 1e-6f;
constexpr int NTHR = 512, NWAVE = 8;
constexpr int LDS_BYTES = 122880;

constexpr size_t al256(size_t x) { return (x + 255) / 256 * 256; }
constexpr size_t O_WIN   = 0;
constexpr size_t O_WUQ   = O_WIN  + al256((size_t)INWP * 1024 * 2);
constexpr size_t O_WUKV  = O_WUQ  + al256((size_t)1536 * 256 * 2);
constexpr size_t O_WPA   = O_WUKV + al256((size_t)2048 * 128 * 2);
constexpr size_t O_WPB   = O_WPA  + al256((size_t)1024 * 1024 * 2);
constexpr size_t O_WO    = O_WPB  + al256((size_t)1024 * 1024 * 2);
constexpr size_t O_WPQ   = O_WO   + al256((size_t)1024 * 1024 * 2);
constexpr size_t O_WS    = O_WPQ  + al256((size_t)2048 * 1024 * 2);
constexpr size_t O_K1    = O_WS   + al256((size_t)8 * 128 * 128 * 2);
constexpr size_t O_K2    = O_K1   + al256((size_t)128 * 128 * 2);
constexpr size_t O_MOD   = O_K2   + al256((size_t)128 * 128 * 2);
constexpr size_t O_ROPE  = O_MOD  + al256((size_t)3 * 6144 * 4);
constexpr size_t O_RSSV  = O_ROPE + al256((size_t)128 * 16 * 2 * 4);
constexpr size_t O_RSSQ  = O_RSSV + (size_t)NTOK * 16 * 4;
constexpr size_t O_RSSKV = O_RSSQ + (size_t)NTOK * 4 * 4;
constexpr size_t O_RSSY  = O_RSSKV + (size_t)NROW * 2 * 4;
constexpr size_t O_RSSEND = O_RSSY + (size_t)NTOK * 16 * 4;
constexpr size_t O_RA    = al256(O_RSSEND);
constexpr size_t O_RB    = O_RA  + al256((size_t)NROW * 1024 * 2);
constexpr size_t O_RC    = O_RB  + al256((size_t)NTOK * 1024 * 2);
constexpr size_t O_CQ    = O_RC  + al256((size_t)NTOK * 1024 * 2);
constexpr size_t O_CKV   = O_CQ  + al256((size_t)NTOK * 256 * 2);
constexpr size_t O_KR    = O_CKV + al256((size_t)NROW * 128 * 2);
constexpr size_t O_RQ    = O_KR  + al256((size_t)NROW * 64 * 2);
constexpr size_t O_RKV   = O_RQ  + al256((size_t)NTOK * 1536 * 2);
constexpr size_t O_END   = O_RKV + al256((size_t)NROW * 2048 * 2);
static_assert(O_END <= (size_t)258 * 1024 * 1024, "workspace too large");

struct Params {
  const float *x, *c, *ctx, *c_ctx, *w_mod, *b_mod, *g_pre1, *g_post1, *g_pre2, *g_post2, *w_in, *g_q, *g_kv, *w_uq, *w_ukv, *g_sgu, *w_s, *b_s,
      *w_pa, *w_pb, *w_o, *w_pq, *k1, *k2, *u_exp, *v_exp;
  float* out; char* ws;
};

DEVI float bf2f(unsigned short h) { return __uint_as_float(((unsigned)h) << 16); }
DEVI unsigned short f2bf(float f) { unsigned u = __float_as_uint(f); u += 0x7fffu + ((u >> 16) & 1u); return (unsigned short)(u >> 16); }
DEVI unsigned pack2(float a, float b) { return (unsigned)f2bf(a) | ((unsigned)f2bf(b) << 16); }
DEVI float lo2f(unsigned w) { return __uint_as_float(w << 16); }
DEVI float hi2f(unsigned w) { return __uint_as_float(w & 0xffff0000u); }
DEVI void unpack8(const u32x4& w, float* f) {
  f[0] = lo2f(w[0]); f[1] = hi2f(w[0]); f[2] = lo2f(w[1]); f[3] = hi2f(w[1]); f[4] = lo2f(w[2]); f[5] = hi2f(w[2]); f[6] = lo2f(w[3]); f[7] = hi2f(w[3]);
}
DEVI float gelu_t(float x) { float z = 0.7978845608028654f * (x + 0.044715f * x * x * x); return x / (1.f + __expf(-2.f * z)); }
DEVI float sigmoidf_(float x) { return 1.f / (1.f + __expf(-x)); }
DEVI float wave_sum(float v) { for (int o = 32; o > 0; o >>= 1) v += __shfl_xor(v, o); return v; }
DEVI float wave_max(float v) { for (int o = 32; o > 0; o >>= 1) v = fmaxf(v, __shfl_xor(v, o)); return v; }
DEVI int keyrow(int row) { if (row < NTOK) return (row >> 13) * NKEY + (row & 8191); int c = row - NTOK; return (c >> 8) * NKEY + SEQ + (c & 255); }

__device__ const float ROPE_FREQ[16] = {1.0f, 0.5623413324356079f, 0.3162277638912201f, 0.17782793939113617f, 0.10000000149011612f, 0.05623413249850273f, 0.03162277489900589f, 0.017782794311642647f, 0.009999999776482582f, 0.005623413249850273f, 0.003162277629598975f, 0.0017782794311642647f, 0.0010000000474974513f, 0.000562341301701963f, 0.0003162277571391314f, 0.00017782794020604342f};
DEVI void sincos_small(double a, double& cs, double& sn) {
  const double k = rint(a * 0.15915494309189535); const double r = fma(-k, 6.283185307179586, a) - k * 2.4492935982947064e-16;
  const double r2 = r * r; double s = 0.0, c = 0.0;
#pragma unroll
  for (int n = 12; n >= 1; --n) { s = (1.0 - s * r2 / (double)((2 * n) * (2 * n + 1))); c = (1.0 - c * r2 / (double)((2 * n - 1) * (2 * n))); }
  sn = r * s; cs = c;
}

DEVI void transpose_job(const float* __restrict__ src, int K, int N, bf16_t* __restrict__ dst, const float* __restrict__ gk, bool isWin, int ntiles, char* smem) {
  const int tid = threadIdx.x; bf16_t* tl = (bf16_t*)smem; const int kt = K / 64;
  for (int idx = blockIdx.x; idx < ntiles; idx += gridDim.x) {
    const int ktile = idx % kt, ntile = idx / kt, k0 = ktile * 64, n0d = ntile * 64;
    int n0s = n0d; bool zero = false;
    if (isWin) { if (n0d == 2496) zero = true; else if (n0d >= 2560) n0s = n0d - 64; }
    { const int kk = tid >> 3, nn8 = (tid & 7) * 8; f32x4 va = {0.f, 0.f, 0.f, 0.f}, vb = va;
      if (!zero) { const float* s = src + (size_t)(k0 + kk) * N + n0s + nn8; const float4 a = *(const float4*)s, b = *(const float4*)(s + 4);
        const float sc = gk ? gk[k0 + kk] : 1.f; va = (f32x4){a.x, a.y, a.z, a.w} * sc; vb = (f32x4){b.x, b.y, b.z, b.w} * sc; }
      bf16_t* tp = tl + nn8 * 72 + kk;
      tp[0] = f2bf(va[0]); tp[72] = f2bf(va[1]); tp[144] = f2bf(va[2]); tp[216] = f2bf(va[3]); tp[288] = f2bf(vb[0]); tp[360] = f2bf(vb[1]); tp[432] = f2bf(vb[2]); tp[504] = f2bf(vb[3]); }
    __syncthreads();
    { const int nn = tid >> 3, kk8 = (tid & 7) * 8;
      const u32x4 o = *(const u32x4*)(tl + nn * 72 + kk8);
      *(u32x4*)(dst + (size_t)(n0d + nn) * K + k0 + kk8) = o; }
    __syncthreads();
  }
}

DEVI void ph_prep(const Params& p, char* smem) {
  const int tid = threadIdx.x, bid = blockIdx.x, nb = gridDim.x;
  char* ws = p.ws;
  if (bid == 0) { float* rope = (float*)(ws + O_ROPE);
    for (int i = tid; i < 128 * 16; i += NTHR) { const int pos = i >> 4, f = i & 15; const float ang = (float)pos * ROPE_FREQ[f];
      double cs, sn; sincos_small((double)ang, cs, sn); rope[i * 2] = (float)cs; rope[i * 2 + 1] = (float)sn; } }
  { float* red = (float*)smem; float* MOD = (float*)(ws + O_MOD);
    for (int it = bid; it < 256; it += nb) {
      const int cgp = tid % 6, kg = tid / 6;
      f32x4 a0 = {0.f, 0.f, 0.f, 0.f}, a1 = a0, a2 = a0;
      if (tid < 510) {
        for (int k = kg; k < 1024; k += 85) {
          const float4 w4 = *(const float4*)(p.w_mod + (size_t)k * 6144 + it * 24 + cgp * 4);
          const f32x4 w = {w4.x, w4.y, w4.z, w4.w};
          const float c0 = p.c[k], c1 = p.c[1024 + k], c2 = p.c_ctx[k];
          a0 += w * (c0 / (1.f + __expf(-c0))); a1 += w * (c1 / (1.f + __expf(-c1))); a2 += w * (c2 / (1.f + __expf(-c2)));
        }
        float* rp = red + kg * 72 + cgp * 4;
        rp[0] = a0[0]; rp[1] = a0[1]; rp[2] = a0[2]; rp[3] = a0[3];
        rp[24] = a1[0]; rp[25] = a1[1]; rp[26] = a1[2]; rp[27] = a1[3];
        rp[48] = a2[0]; rp[49] = a2[1]; rp[50] = a2[2]; rp[51] = a2[3];
      }
      __syncthreads();
      if (tid < 72) { float s = 0.f; for (int g = 0; g < 85; ++g) s += red[g * 72 + tid]; int r = tid / 24, n = it * 24 + tid % 24; MOD[r * 6144 + n] = s + p.b_mod[n]; }
      __syncthreads();
    } }
  transpose_job(p.w_in,  1024, INW,  (bf16_t*)(ws + O_WIN),  nullptr, true,  1152, smem);
  transpose_job(p.w_uq,  256,  1536, (bf16_t*)(ws + O_WUQ),  p.g_q,   false, 96,   smem);
  transpose_job(p.w_ukv, 128,  2048, (bf16_t*)(ws + O_WUKV), p.g_kv,  false, 64,   smem);
  transpose_job(p.w_pa,  1024, 1024, (bf16_t*)(ws + O_WPA),  nullptr, false, 256,  smem);
  transpose_job(p.w_pb,  1024, 1024, (bf16_t*)(ws + O_WPB),  nullptr, false, 256,  smem);
  transpose_job(p.w_o,   1024, 1024, (bf16_t*)(ws + O_WO),   nullptr, false, 256,  smem);
  transpose_job(p.w_pq,  1024, 2048, (bf16_t*)(ws + O_WPQ),  nullptr, false, 512,  smem);
  { const int n8 = (131072 + 16384 + 16384) / 8;
    for (int i = bid * NTHR + tid; i < n8; i += nb * NTHR) {
      int e = i * 8; const float* s; bf16_t* d;
      if (e < 131072) { s = p.w_s + e; d = (bf16_t*)(ws + O_WS) + e; }
      else if (e < 131072 + 16384) { s = p.k1 + (e - 131072); d = (bf16_t*)(ws + O_K1) + (e - 131072); }
      else { s = p.k2 + (e - 131072 - 16384); d = (bf16_t*)(ws + O_K2) + (e - 131072 - 16384); }
      const float4 a = *(const float4*)s, b = *(const float4*)(s + 4);
      u32x4 o = {pack2(a.x, a.y), pack2(a.z, a.w), pack2(b.x, b.y), pack2(b.z, b.w)};
      *(u32x4*)d = o;
    } }
}

DEVI void convert_table(const float* __restrict__ src, bf16_t* __restrict__ dst) {
  const int n8 = 16384 * 1024 / 8;
  for (int i = blockIdx.x * NTHR + threadIdx.x; i < n8; i += gridDim.x * NTHR) {
    const float4 a = *(const float4*)(src + (size_t)i * 8), b = *(const float4*)(src + (size_t)i * 8 + 4);
    u32x4 o = {pack2(a.x, a.y), pack2(a.z, a.w), pack2(b.x, b.y), pack2(b.z, b.w)};
    *(u32x4*)(dst + (size_t)i * 8) = o;
  }
}

DEVI void ph_hx(const Params& p, char* smem) {
  const int tid = threadIdx.x, wave = tid >> 6, lane = tid & 63;
  float* mA = (float*)smem; float* mB = mA + 3 * 1024;
  const float* MOD = (const float*)(p.ws + O_MOD);
  for (int i = tid; i < 3072; i += NTHR) { int r = i >> 10, c = i & 1023; mA[i] = p.g_pre1[c] * (1.f + MOD[r * 6144 + 1024 + c]); mB[i] = MOD[r * 6144 + c]; }
  __syncthreads();
  bf16_t* HX = (bf16_t*)(p.ws + O_RA);
  for (int row = blockIdx.x * NWAVE + wave; row < NROW; row += gridDim.x * NWAVE) {
    const float* src = row < NTOK ? p.x + (size_t)row * 1024 : p.ctx + (size_t)(row - NTOK) * 1024;
    const int mr = row < NTOK ? (row >> 13) : 2;
    float4 v[4]; float ss = 0.f;
#pragma unroll
    for (int i = 0; i < 4; ++i) { v[i] = *(const float4*)(src + i * 256 + lane * 4); ss += v[i].x * v[i].x + v[i].y * v[i].y + v[i].z * v[i].z + v[i].w * v[i].w; }
    ss = wave_sum(ss); const float rstd = rsqrtf(ss * (1.f / 1024.f) + EPS);
#pragma unroll
    for (int i = 0; i < 4; ++i) { const int c = i * 256 + lane * 4; const float* a = mA + mr * 1024 + c; const float* b = mB + mr * 1024 + c;
      u32x2 o = {pack2(v[i].x * rstd * a[0] + b[0], v[i].y * rstd * a[1] + b[1]), pack2(v[i].z * rstd * a[2] + b[2], v[i].w * rstd * a[3] + b[3])};
      *(u32x2*)(HX + (size_t)row * 1024 + c) = o; }
  }
}

template <int BM, bool ACOLMAP, class Epi>
DEVI void gemm_tile_naive(const bf16_t* __restrict__ A, int lda, const bf16_t* __restrict__ Bm, int ldb, int K, int row0, int col0, const Epi& epi, const float* kss) {
  const int t = threadIdx.x, cgp = t & 31, rr = t >> 5;
  for (int rb = 0; rb < BM; rb += 16) {
    const int r = rb + rr;
    const bf16_t* ap = A + (size_t)r * lda;
    const bf16_t* bp = Bm + (size_t)(cgp * 4) * ldb;
    float acc[4] = {0.f, 0.f, 0.f, 0.f};
    for (int k = 0; k < K; k += 8) {
      const int ka = ACOLMAP ? (k + (k >> 7) * 64) : k;
      float af[8]; unpack8(*(const u32x4*)(ap + ka), af);
      if (kss) {
#pragma unroll
        for (int j = 0; j < 8; ++j) af[j] *= kss[k + j]; }
#pragma unroll
      for (int n = 0; n < 4; ++n) { float bf[8]; unpack8(*(const u32x4*)(bp + (size_t)n * ldb + k), bf);
#pragma unroll
        for (int j = 0; j < 8; ++j) acc[n] += af[j] * bf[j]; }
    }
    float sq = epi(row0 + r, col0 + cgp * 4, acc);
    if (Epi::RSS) { for (int o = 16; o > 0; o >>= 1) sq += __shfl_xor(sq, o); if (cgp == 0) { epi.rss(row0 + r, col0, sq); epi.rss(row0 + r, col0 + 64, 0.f); } }
  }
}

DEVI int lds_sw(int row, int c) { return row * 128 + ((c ^ (row & 7)) << 4); }
template <int BM, bool ACOLMAP, class Epi>
DEVI void gemm_tile_mfma(const bf16_t* __restrict__ A, int lda, const bf16_t* __restrict__ Bm, int ldb, int K, int row0, int col0, const Epi& epi, const float* kscale, char* smem) {
  constexpr int MI = BM / 64, ACH = BM / 64, ABYTES = BM * 128, BBYTES = 128 * 128, STAGE = ABYTES + BBYTES;
  const int tid = threadIdx.x, wave = tid >> 6, lane = tid & 63, wm = wave >> 1, wn = wave & 1, l15 = lane & 15, lq = lane >> 4;
  f32x4 acc[MI][4];
#pragma unroll
  for (int mi = 0; mi < MI; ++mi)
#pragma unroll
    for (int ni = 0; ni < 4; ++ni) acc[mi][ni] = (f32x4){0.f, 0.f, 0.f, 0.f};
  u32x4 ra[ACH], rb[2];
  const int nk = K >> 6;
  auto gload = [&](int kt) {
    const int k0 = kt * 64, ka = ACOLMAP ? k0 + (k0 >> 7) * 64 : k0;
#pragma unroll
    for (int i = 0; i < ACH; ++i) { const int id = tid + NTHR * i, r = id >> 3, c = id & 7; ra[i] = *(const u32x4*)(A + (size_t)r * lda + ka + c * 8); }
#pragma unroll
    for (int i = 0; i < 2; ++i) { const int id = tid + NTHR * i, r = id >> 3, c = id & 7; rb[i] = *(const u32x4*)(Bm + (size_t)r * ldb + k0 + c * 8); }
  };
  auto lstore = [&](int buf, int kt) {
    char* sa = smem + buf * STAGE; char* sb = sa + ABYTES;
#pragma unroll
    for (int i = 0; i < ACH; ++i) { const int id = tid + NTHR * i, r = id >> 3, c = id & 7; u32x4 v = ra[i];
      if (kscale) { float f[8]; unpack8(v, f); const float* ks = kscale + kt * 64 + c * 8;
        v = (u32x4){pack2(f[0] * ks[0], f[1] * ks[1]), pack2(f[2] * ks[2], f[3] * ks[3]), pack2(f[4] * ks[4], f[5] * ks[5]), pack2(f[6] * ks[6], f[7] * ks[7])}; }
      *(u32x4*)(sa + lds_sw(r, c)) = v; }
#pragma unroll
    for (int i = 0; i < 2; ++i) { const int id = tid + NTHR * i, r = id >> 3, c = id & 7; *(u32x4*)(sb + lds_sw(r, c)) = rb[i]; }
  };
  gload(0); lstore(0, 0); __syncthreads();
  for (int kt = 0; kt < nk; ++kt) {
    if (kt + 1 < nk) gload(kt + 1);
    const char* sa = smem + (kt & 1) * STAGE; const char* sb = sa + ABYTES;
#pragma unroll
    for (int ks = 0; ks < 2; ++ks) { const int kc = ks * 4 + lq; bf16x8 af[MI], bfr[4];
#pragma unroll
      for (int mi = 0; mi < MI; ++mi) af[mi] = *(const bf16x8*)(sa + lds_sw(wm * (BM / 4) + mi * 16 + l15, kc));
#pragma unroll
      for (int ni = 0; ni < 4; ++ni) bfr[ni] = *(const bf16x8*)(sb + lds_sw(wn * 64 + ni * 16 + l15, kc));
#pragma unroll
      for (int mi = 0; mi < MI; ++mi)
#pragma unroll
        for (int ni = 0; ni < 4; ++ni) acc[mi][ni] = __builtin_amdgcn_mfma_f32_16x16x32_bf16(bfr[ni], af[mi], acc[mi][ni], 0, 0, 0); }
    if (kt + 1 < nk) lstore((kt + 1) & 1, kt + 1);
    __syncthreads();
  }
#pragma unroll
  for (int mi = 0; mi < MI; ++mi) { const int row = row0 + wm * (BM / 4) + mi * 16 + l15; float sq = 0.f;
#pragma unroll
    for (int ni = 0; ni < 4; ++ni) { const float v[4] = {acc[mi][ni][0], acc[mi][ni][1], acc[mi][ni][2], acc[mi][ni][3]}; sq += epi(row, col0 + wn * 64 + ni * 16 + lq * 4, v); }
    if (Epi::RSS) { sq += __shfl_xor(sq, 16); sq += __shfl_xor(sq, 32); if (lq == 0) epi.rss(row, col0 + wn * 64, sq); } }
}

template <int BM, bool ACOLMAP, class Epi>
DEVI void gemm_tile(const bf16_t* A, int lda, const bf16_t* Bm, int ldb, int K, int row0, int col0, const Epi& epi, const float* kss, char* smem) {
#if GEMM_MFMA
  gemm_tile_mfma<BM, ACOLMAP>(A, lda, Bm, ldb, K, row0, col0, epi, kss, smem);
#else
  gemm_tile_naive<BM, ACOLMAP>(A, lda, Bm, ldb, K, row0, col0, epi, kss);
#endif
}

DEVI void st4bf(bf16_t* d, float a, float b, float c, float e) { u32x2 o = {pack2(a, b), pack2(c, e)}; *(u32x2*)d = o; }

struct EpiIn { static constexpr bool RSS = true; bf16_t *GU, *GVT, *CQ, *CKV, *KR; float *rssv, *rssq, *rsskv;
  DEVI float operator()(int row, int col, const float (&v)[4]) const {
    if (col < 1024) { st4bf(GU + (size_t)row * 1024 + col, gelu_t(v[0]), gelu_t(v[1]), gelu_t(v[2]), gelu_t(v[3])); return 0.f; }
    else if (col < 2048) { const int c = col - 1024, chunk = row >> 7, q = row & 127; float s = 0.f;
#pragma unroll
      for (int j = 0; j < 4; ++j) { const float g = gelu_t(v[j]); s += g * g; GVT[((size_t)chunk * 1024 + c + j) * 128 + q] = f2bf(g); }
      return s; }
    else if (col < 2304) { st4bf(CQ + (size_t)row * 256 + (col - 2048), v[0], v[1], v[2], v[3]); return v[0] * v[0] + v[1] * v[1] + v[2] * v[2] + v[3] * v[3]; }
    else if (col < 2432) { st4bf(CKV + (size_t)row * 128 + (col - 2304), v[0], v[1], v[2], v[3]); return v[0] * v[0] + v[1] * v[1] + v[2] * v[2] + v[3] * v[3]; }
    else if (col < 2496) { st4bf(KR + (size_t)keyrow(row) * 64 + (col - 2432), v[0], v[1], v[2], v[3]); return 0.f; }
    return 0.f; }
  DEVI void rss(int row, int col, float s) const {
    if (col >= 1024 && col < 2048) rssv[row * 16 + ((col - 1024) >> 6)] = s; else if (col >= 2048 && col < 2304) rssq[row * 4 + ((col - 2048) >> 6)] = s; else if (col >= 2304 && col < 2432) rsskv[row * 2 + ((col - 2304) >> 6)] = s; }
};
struct EpiQ { static constexpr bool RSS = false; bf16_t* Q; const float* rssq;
  DEVI float operator()(int row, int col, const float (&v)[4]) const { const float4 ps = *(const float4*)(rssq + row * 4); const float r = rsqrtf(((ps.x + ps.y) + (ps.z + ps.w)) * (1.f / 256.f) + EPS);
    st4bf(Q + (size_t)row * 1536 + col, v[0] * r, v[1] * r, v[2] * r, v[3] * r); return 0.f; }
  DEVI void rss(int, int, float) const {} };
struct EpiKV { static constexpr bool RSS = false; bf16_t* KV; const float* rsskv;
  DEVI float operator()(int row, int col, const float (&v)[4]) const { const float r = rsqrtf((rsskv[row * 2] + rsskv[row * 2 + 1]) * (1.f / 128.f) + EPS);
    st4bf(KV + (size_t)keyrow(row) * 2048 + col, v[0] * r, v[1] * r, v[2] * r, v[3] * r); return 0.f; }
  DEVI void rss(int, int, float) const {} };
struct EpiSgu { static constexpr bool RSS = false; bf16_t* GUOA; const float* g_sgu; const float* b_s; int chunk, g;
  DEVI float operator()(int row, int col, const float (&v)[4]) const { const int token = chunk * 128 + row, ch = g * 128 + col; const float bias = b_s[g * 128 + row];
    bf16_t* ptr = GUOA + (size_t)token * 1024 + ch; const u32x2 gu = *(const u32x2*)ptr;
    st4bf(ptr, lo2f(gu[0]) * (g_sgu[ch] * v[0] + bias), hi2f(gu[0]) * (g_sgu[ch + 1] * v[1] + bias), lo2f(gu[1]) * (g_sgu[ch + 2] * v[2] + bias), hi2f(gu[1]) * (g_sgu[ch + 3] * v[3] + bias));
    return 0.f; }
  DEVI void rss(int, int, float) const {} };
struct EpiGate { static constexpr bool RSS = false; bf16_t* G;
  DEVI float operator()(int row, int col, const float (&v)[4]) const { st4bf(G + (size_t)row * 2048 + col, sigmoidf_(v[0]), sigmoidf_(v[1]), sigmoidf_(v[2]), sigmoidf_(v[3])); return 0.f; }
  DEVI void rss(int, int, float) const {} };
template <bool SECOND> struct EpiMerge { static constexpr bool RSS = false; bf16_t* M; const bf16_t* G;
  DEVI float operator()(int row, int col, const float (&v)[4]) const { const u32x2 g = *(const u32x2*)(G + (size_t)row * 2048 + (SECOND ? 1024 : 0) + col);
    float o0 = lo2f(g[0]) * v[0], o1 = hi2f(g[0]) * v[1], o2 = lo2f(g[1]) * v[2], o3 = hi2f(g[1]) * v[3];
    bf16_t* ptr = M + (size_t)row * 1024 + col;
    if (SECOND) { const u32x2 m = *(const u32x2*)ptr; o0 += lo2f(m[0]); o1 += hi2f(m[0]); o2 += lo2f(m[1]); o3 += hi2f(m[1]); }
    st4bf(ptr, o0, o1, o2, o3); return 0.f; }
  DEVI void rss(int, int, float) const {} };
struct EpiO { static constexpr bool RSS = true; bf16_t* Y; float* rssy;
  DEVI float operator()(int row, int col, const float (&v)[4]) const { st4bf(Y + (size_t)row * 1024 + col, v[0], v[1], v[2], v[3]); return v[0] * v[0] + v[1] * v[1] + v[2] * v[2] + v[3] * v[3]; }
  DEVI void rss(int row, int col, float s) const { rssy[row * 16 + (col >> 6)] = s; } };
struct EpiPq { static constexpr bool RSS = false; bf16_t* QP;
  DEVI float operator()(int row, int col, const float (&v)[4]) const { st4bf(QP + (size_t)row * 2048 + col, v[0], v[1], v[2], v[3]); return 0.f; }
  DEVI void rss(int, int, float) const {} };

DEVI void ph_inproj(const Params& p, char* smem) {
  char* ws = p.ws;
  EpiIn epi{(bf16_t*)(ws + O_RB), (bf16_t*)(ws + O_RC), (bf16_t*)(ws + O_CQ), (bf16_t*)(ws + O_CKV), (bf16_t*)(ws + O_KR), (float*)(ws + O_RSSV), (float*)(ws + O_RSSQ), (float*)(ws + O_RSSKV)};
  const bf16_t* HX = (const bf16_t*)(ws + O_RA); const bf16_t* W = (const bf16_t*)(ws + O_WIN);
  for (int i = blockIdx.x; i < 1284; i += gridDim.x) {
    int mt, nt; if (i < 1280) { mt = i / 20; nt = i % 20; } else { mt = 64 + ((i - 1280) >> 1); nt = 18 + ((i - 1280) & 1); }
    gemm_tile<256, false>(HX + (size_t)mt * 256 * 1024, 1024, W + (size_t)nt * 128 * 1024, 1024, 1024, mt * 256, nt * 128, epi, nullptr, smem);
  }
}
DEVI void rope_kr(const Params& p) {
  bf16_t* KR = (bf16_t*)(p.ws + O_KR); const float* rope = (const float*)(p.ws + O_ROPE);
  for (int i = blockIdx.x * NTHR + threadIdx.x; i < NTOK * 32; i += gridDim.x * NTHR) {
    const int tok = i >> 5, j = i & 15, which = (i >> 4) & 1, pos = tok & 8191, pp = which ? (pos & 63) : (pos >> 6);
    const float cs = rope[(pp * 16 + j) * 2], sn = rope[(pp * 16 + j) * 2 + 1];
    bf16_t* r = KR + (size_t)keyrow(tok) * 64 + which * 32 + j;
    const float x1 = bf2f(r[0]), x2 = bf2f(r[16]);
    r[0] = f2bf(x1 * cs - x2 * sn); r[16] = f2bf(x1 * sn + x2 * cs);
  }
}
DEVI void ph_mid(const Params& p, char* smem) {
  char* ws = p.ws;
  { EpiQ epi{(bf16_t*)(ws + O_RQ), (const float*)(ws + O_RSSQ)};
    const bf16_t* A = (const bf16_t*)(ws + O_CQ); const bf16_t* W = (const bf16_t*)(ws + O_WUQ);
    for (int i = blockIdx.x; i < 64 * 12; i += gridDim.x) { const int mt = i / 12, nt = i % 12;
      gemm_tile<256, false>(A + (size_t)mt * 256 * 256, 256, W + (size_t)nt * 128 * 256, 256, 256, mt * 256, nt * 128, epi, nullptr, smem); } }
  { EpiKV epi{(bf16_t*)(ws + O_RKV), (const float*)(ws + O_RSSKV)};
    const bf16_t* A = (const bf16_t*)(ws + O_CKV); const bf16_t* W = (const bf16_t*)(ws + O_WUKV);
    for (int i = blockIdx.x; i < 66 * 16; i += gridDim.x) { const int mt = i / 16, nt = i % 16;
      gemm_tile<256, false>(A + (size_t)mt * 256 * 128, 128, W + (size_t)nt * 128 * 128, 128, 128, mt * 256, nt * 128, epi, nullptr, smem); } }
  { const bf16_t* WS = (const bf16_t*)(ws + O_WS); const bf16_t* GVT = (const bf16_t*)(ws + O_RC);
    float* ksc = (float*)(smem + LDS_BYTES - 512); const float* rssv = (const float*)(ws + O_RSSV);
    for (int i = blockIdx.x; i < 1024; i += gridDim.x) { const int chunk = i >> 3, g = i & 7;
      __syncthreads();
      if (threadIdx.x < 128) { const float* pr = rssv + (size_t)(chunk * 128 + threadIdx.x) * 16; float t = 0.f;
#pragma unroll
        for (int j = 0; j < 16; ++j) t += pr[j];
        ksc[threadIdx.x] = rsqrtf(t * (1.f / 1024.f) + EPS); }
      __syncthreads();
      EpiSgu epi{(bf16_t*)(ws + O_RB), p.g_sgu, p.b_s, chunk, g};
      gemm_tile<128, false>(WS + (size_t)g * 16384, 128, GVT + ((size_t)chunk * 1024 + g * 128) * 128, 128, 128, 0, 0, epi, ksc, smem); } }
  rope_kr(p);
}
DEVI void ph_gates(const Params& p, char* smem) {
  char* ws = p.ws; EpiGate epi{(bf16_t*)(ws + O_RKV)};
  const bf16_t* HX = (const bf16_t*)(ws + O_RA); const bf16_t* W = (const bf16_t*)(ws + O_WIN) + (size_t)NPRE * 1024;
  for (int i = blockIdx.x; i < 64 * 16; i += gridDim.x) { const int mt = i / 16, nt = i % 16;
    gemm_tile<256, false>(HX + (size_t)mt * 256 * 1024, 1024, W + (size_t)nt * 128 * 1024, 1024, 1024, mt * 256, nt * 128, epi, nullptr, smem); }
}
DEVI void ph_merge(const Params& p, char* smem) {
  char* ws = p.ws; bf16_t* M = (bf16_t*)(ws + O_RC); const bf16_t* G = (const bf16_t*)(ws + O_RKV);
  EpiMerge<false> e1{M, G}; EpiMerge<true> e2{M, G};
  const bf16_t* OA = (const bf16_t*)(ws + O_RB); const bf16_t* OB = (const bf16_t*)(ws + O_RQ);
  const bf16_t* WA = (const bf16_t*)(ws + O_WPA); const bf16_t* WB = (const bf16_t*)(ws + O_WPB);
  for (int i = blockIdx.x; i < 64 * 8; i += gridDim.x) { const int mt = i / 8, nt = i % 8;
    gemm_tile<256, false>(OA + (size_t)mt * 256 * 1024, 1024, WA + (size_t)nt * 128 * 1024, 1024, 1024, mt * 256, nt * 128, e1, nullptr, smem);
    gemm_tile<256, true>(OB + (size_t)mt * 256 * 1536, 1536, WB + (size_t)nt * 128 * 1024, 1024, 1024, mt * 256, nt * 128, e2, nullptr, smem); }
}
DEVI void ph_wo(const Params& p, char* smem) {
  char* ws = p.ws; EpiO epi{(bf16_t*)(ws + O_RA), (float*)(ws + O_RSSY)};
  const bf16_t* M = (const bf16_t*)(ws + O_RC); const bf16_t* W = (const bf16_t*)(ws + O_WO);
  for (int i = blockIdx.x; i < 64 * 8; i += gridDim.x) { const int mt = i / 8, nt = i % 8;
    gemm_tile<256, false>(M + (size_t)mt * 256 * 1024, 1024, W + (size_t)nt * 128 * 1024, 1024, 1024, mt * 256, nt * 128, epi, nullptr, smem); }
}
DEVI void ph_wpq(const Params& p, char* smem) {
  char* ws = p.ws; EpiPq epi{(bf16_t*)(ws + O_RKV)};
  const bf16_t* A = (const bf16_t*)(ws + O_RB); const bf16_t* W = (const bf16_t*)(ws + O_WPQ);
  for (int i = blockIdx.x; i < 64 * 16; i += gridDim.x) { const int mt = i / 16, nt = i % 16;
    gemm_tile<256, false>(A + (size_t)mt * 256 * 1024, 1024, W + (size_t)nt * 128 * 1024, 1024, 1024, mt * 256, nt * 128, epi, nullptr, smem); }
  convert_table(p.v_exp, (bf16_t*)(ws + O_RA));
}

DEVI void attn_naive(const Params& p, char* smem) {
  const int tid = threadIdx.x, wave = tid >> 6, lane = tid & 63;
  float* qs = (float*)smem + wave * 256; float* ps = qs + 192;
  bf16_t* Q = (bf16_t*)(p.ws + O_RQ); const bf16_t* KV = (const bf16_t*)(p.ws + O_RKV); const bf16_t* KR = (const bf16_t*)(p.ws + O_KR);
  const float* rope = (const float*)(p.ws + O_ROPE);
  const float scale = 0.07216878364870322f;
  for (int base = blockIdx.x * NWAVE; base < NB * 8 * SEQ; base += gridDim.x * NWAVE) {
    const int it = base + wave, bh = it >> 13, qi = it & 8191, b = bh >> 3, h = bh & 7;
    const size_t qoff = (size_t)(b * SEQ + qi) * 1536 + h * 192;
    __syncthreads();
    for (int d = lane; d < 192; d += 64) qs[d] = bf2f(Q[qoff + d]);
    __syncthreads();
    if (lane < 32) { const int j = lane & 15, which = lane >> 4, pp = which ? (qi & 63) : (qi >> 6);
      const float cs = rope[(pp * 16 + j) * 2], sn = rope[(pp * 16 + j) * 2 + 1]; const int d1 = 128 + which * 32 + j, d2 = d1 + 16;
      const float x1 = qs[d1], x2 = qs[d2]; qs[d1] = x1 * cs - x2 * sn; qs[d2] = x1 * sn + x2 * cs; }
    __syncthreads();
    float m = -1e30f, l = 0.f, o0 = 0.f, o1 = 0.f;
    for (int k0 = 0; k0 < NKEY; k0 += 64) {
      const size_t kr = (size_t)(b * NKEY + k0 + lane);
      const bf16_t* kn = KV + kr * 2048 + h * 256; const bf16_t* krp = KR + kr * 64;
      float s = 0.f;
#pragma unroll 4
      for (int d8 = 0; d8 < 16; ++d8) { float kf[8]; unpack8(*(const u32x4*)(kn + d8 * 8), kf); const float4 q0 = *(const float4*)(qs + d8 * 8), q1 = *(const float4*)(qs + d8 * 8 + 4);
        s += q0.x * kf[0] + q0.y * kf[1] + q0.z * kf[2] + q0.w * kf[3] + q1.x * kf[4] + q1.y * kf[5] + q1.z * kf[6] + q1.w * kf[7]; }
#pragma unroll 4
      for (int d8 = 0; d8 < 8; ++d8) { float kf[8]; unpack8(*(const u32x4*)(krp + d8 * 8), kf); const float4 q0 = *(const float4*)(qs + 128 + d8 * 8), q1 = *(const float4*)(qs + 128 + d8 * 8 + 4);
        s += q0.x * kf[0] + q0.y * kf[1] + q0.z * kf[2] + q0.w * kf[3] + q1.x * kf[4] + q1.y * kf[5] + q1.z * kf[6] + q1.w * kf[7]; }
      s *= scale;
      const float mn = fmaxf(m, wave_max(s)), al = __expf(m - mn), pe = __expf(s - mn);
      l = l * al + wave_sum(pe); m = mn; o0 *= al; o1 *= al;
      __syncthreads();
      ps[lane] = pe;
      __syncthreads();
      const bf16_t* vp = KV + (size_t)(b * NKEY + k0) * 2048 + h * 256 + 128 + lane * 2;
#pragma unroll 8
      for (int kk = 0; kk < 64; ++kk) { const unsigned w = *(const unsigned*)(vp + (size_t)kk * 2048); const float pk = ps[kk]; o0 += pk * lo2f(w); o1 += pk * hi2f(w); }
    }
    const float invL = 1.f / l;
    *(unsigned*)(Q + qoff + lane * 2) = pack2(o0 * invL, o1 * invL);
  }
}

namespace at {
constexpr int QBLK = 32, KVBLK = 64;
constexpr float SCALE = 0.07216878364870322f;
constexpr float THR = 8.f;
constexpr int SHM_V = KVBLK * 128 * 2, SHM_K = KVBLK * 192 * 2;
using s16x4 = __attribute__((ext_vector_type(4))) short;
#define KSWZ(row, colB) ((row) * 384 + ((colB) ^ (((row) & 7) << 4)))
#define SBAR() __builtin_amdgcn_sched_barrier(0)
DEVI int crow(int r, int hi) { return (r & 3) + 8 * (r >> 2) + 4 * hi; }
DEVI unsigned cvtpk(float lo, float hi) { unsigned r; asm volatile("v_cvt_pk_bf16_f32 %0, %1, %2" : "=v"(r) : "v"(lo), "v"(hi)); return r; }
DEVI void partialSM(f32x16& p0, f32x16& p1, float& m_reg, float& mn, float& alpha) {
  constexpr float C = SCALE * 1.4426950408889634f;
  float pmax = p0[0];
#pragma unroll
  for (int r = 1; r < 16; ++r) pmax = fmaxf(pmax, p0[r]);
#pragma unroll
  for (int r = 0; r < 16; ++r) pmax = fmaxf(pmax, p1[r]);
  { auto rr = __builtin_amdgcn_permlane32_swap(__float_as_uint(pmax), __float_as_uint(pmax), false, false);
    pmax = fmaxf(__uint_as_float(rr[0]), __uint_as_float(rr[1])); }
  if (__builtin_expect(__all(pmax - m_reg <= THR / SCALE), 1)) { mn = m_reg; alpha = 1.f; }
  else { mn = fmaxf(m_reg, pmax); alpha = __builtin_amdgcn_exp2f((m_reg - mn) * C); m_reg = mn; }
  const float mnC = -mn * C;
#pragma unroll
  for (int r = 0; r < 16; ++r) p0[r] = fmaf(p0[r], C, mnC);
#pragma unroll
  for (int r = 0; r < 16; ++r) p1[r] = fmaf(p1[r], C, mnC);
#pragma unroll
  for (int r = 0; r < 16; ++r) p0[r] = __builtin_amdgcn_exp2f(p0[r]);
}
DEVI void finishSM(f32x16& p0, f32x16& p1, float alpha, float& l_reg, bf16x8& pa0, bf16x8& pa1, bf16x8& pa2, bf16x8& pa3) {
#pragma unroll
  for (int r = 0; r < 16; ++r) p1[r] = __builtin_amdgcn_exp2f(p1[r]);
  float ps = 0;
#pragma unroll
  for (int r = 0; r < 16; ++r) ps += p0[r];
#pragma unroll
  for (int r = 0; r < 16; ++r) ps += p1[r];
  { auto rr = __builtin_amdgcn_permlane32_swap(__float_as_uint(ps), __float_as_uint(ps), false, false);
    ps = __uint_as_float(rr[0]) + __uint_as_float(rr[1]); }
  l_reg = l_reg * alpha + ps;
#define PK4(P, BASE, OUT) do { unsigned a0 = cvtpk(P[BASE + 0], P[BASE + 1]), a1 = cvtpk(P[BASE + 2], P[BASE + 3]);   \
    unsigned b0 = cvtpk(P[BASE + 4], P[BASE + 5]), b1 = cvtpk(P[BASE + 6], P[BASE + 7]);                              \
    auto r0 = __builtin_amdgcn_permlane32_swap(a0, b0, false, false); auto r1 = __builtin_amdgcn_permlane32_swap(a1, b1, false, false); \
    u32x4 w = {r0[0], r1[0], r0[1], r1[1]}; OUT = *reinterpret_cast<bf16x8*>(&w); } while (0)
  PK4(p0, 0, pa0); PK4(p0, 8, pa1); PK4(p1, 0, pa2); PK4(p1, 8, pa3);
#undef PK4
}
DEVI void qkt(f32x16& p0, f32x16& p1, const char* Ks, const bf16x8* qr, const char* qrl, int r32, int hi) {
  p0 = f32x16{}; p1 = f32x16{};
#pragma unroll
  for (int d0 = 0; d0 < 12; ++d0) { const int cb = (d0 * 16 + hi * 8) * 2;
    const bf16x8 b0 = *reinterpret_cast<const bf16x8*>(Ks + KSWZ(r32, cb));
    const bf16x8 b1 = *reinterpret_cast<const bf16x8*>(Ks + KSWZ(32 + r32, cb));
    const bf16x8 q = d0 < 8 ? qr[d0 < 8 ? d0 : 0] : *reinterpret_cast<const bf16x8*>(qrl + (d0 - 8) * 1024);
    p0 = __builtin_amdgcn_mfma_f32_32x32x16_bf16(b0, q, p0, 0, 0, 0);
    p1 = __builtin_amdgcn_mfma_f32_32x32x16_bf16(b1, q, p1, 0, 0, 0); }
}
DEVI int v_st(int k, int c) { const int kk = (k & ~0xC) | ((k & 4) << 1) | ((k & 8) >> 1); return ((kk >> 3) * 4 + (c >> 5)) * 512 + ((kk & 7) * 32 + (c & 31)) * 2; }
DEVI int v_rd_base(int lane) { return ((lane & 3) << 3) | (((lane >> 2) & 3) << 6) | (((lane >> 4) & 1) << 5) | (((lane >> 5) & 1) << 8); }
constexpr int v_rd_off(int d0, int ks, int half) { return d0 * 512 + ks * 4096 + half * 2048; }
template <int OFF> DEVI s16x4 tr_read(int vb) { s16x4 r; asm volatile("ds_read_b64_tr_b16 %0, %1 offset:%2" : "=&v"(r) : "v"(vb), "i"(OFF) : "memory"); return r; }
template <int D0> DEVI void pv_one(f32x16& od, int vb, bf16x8 pa0, bf16x8 pa1, bf16x8 pa2, bf16x8 pa3) {
  const s16x4 l0 = tr_read<v_rd_off(D0, 0, 0)>(vb), h0 = tr_read<v_rd_off(D0, 0, 1)>(vb), l1 = tr_read<v_rd_off(D0, 1, 0)>(vb), h1 = tr_read<v_rd_off(D0, 1, 1)>(vb);
  const s16x4 l2 = tr_read<v_rd_off(D0, 2, 0)>(vb), h2 = tr_read<v_rd_off(D0, 2, 1)>(vb), l3 = tr_read<v_rd_off(D0, 3, 0)>(vb), h3 = tr_read<v_rd_off(D0, 3, 1)>(vb);
  asm volatile("s_waitcnt lgkmcnt(0)" ::: "memory"); SBAR();
#define PK(L, H) (bf16x8){L[0], L[1], L[2], L[3], H[0], H[1], H[2], H[3]}
  od = __builtin_amdgcn_mfma_f32_32x32x16_bf16(pa0, PK(l0, h0), od, 0, 0, 0);
  od = __builtin_amdgcn_mfma_f32_32x32x16_bf16(pa1, PK(l1, h1), od, 0, 0, 0);
  od = __builtin_amdgcn_mfma_f32_32x32x16_bf16(pa2, PK(l2, h2), od, 0, 0, 0);
  od = __builtin_amdgcn_mfma_f32_32x32x16_bf16(pa3, PK(l3, h3), od, 0, 0, 0);
#undef PK
}
DEVI void pv_d0(f32x16* o, int vb, bf16x8 pa0, bf16x8 pa1, bf16x8 pa2, bf16x8 pa3) {
  pv_one<0>(o[0], vb, pa0, pa1, pa2, pa3); pv_one<1>(o[1], vb, pa0, pa1, pa2, pa3); pv_one<2>(o[2], vb, pa0, pa1, pa2, pa3); pv_one<3>(o[3], vb, pa0, pa1, pa2, pa3);
}
DEVI void rope_frag(bf16x8& f1, bf16x8& f2, const float* cs) {
  u32x4 w1 = *reinterpret_cast<u32x4*>(&f1), w2 = *reinterpret_cast<u32x4*>(&f2); float a[8], b[8]; unpack8(w1, a); unpack8(w2, b);
  float c[8], s[8];
#pragma unroll
  for (int q = 0; q < 4; ++q) { const float4 t = *(const float4*)(cs + q * 4); c[q * 2] = t.x; s[q * 2] = t.y; c[q * 2 + 1] = t.z; s[q * 2 + 1] = t.w; }
  float x[8], y[8];
#pragma unroll
  for (int j = 0; j < 8; ++j) { x[j] = a[j] * c[j] - b[j] * s[j]; y[j] = a[j] * s[j] + b[j] * c[j]; }
  w1 = (u32x4){cvtpk(x[0], x[1]), cvtpk(x[2], x[3]), cvtpk(x[4], x[5]), cvtpk(x[6], x[7])};
  w2 = (u32x4){cvtpk(y[0], y[1]), cvtpk(y[2], y[3]), cvtpk(y[4], y[5]), cvtpk(y[6], y[7])};
  f1 = *reinterpret_cast<bf16x8*>(&w1); f2 = *reinterpret_cast<bf16x8*>(&w2);
}
DEVI void attn_item(bf16_t* __restrict__ Qb, const bf16_t* __restrict__ Kn, const bf16_t* __restrict__ Vh, const bf16_t* __restrict__ Kr, const float* __restrict__ rope, int pos0, char* lds) {
  const int tid = threadIdx.x, wid = tid >> 6, lane = tid & 63, r32 = lane & 31, hi = lane >> 5;
  char* V_lds = lds; char* K_lds = lds + 2 * SHM_V;
  float* wsl = (float*)(lds + 2 * SHM_V + 2 * SHM_K) + wid * 64; float* li_l = wsl; float* al_l = wsl + 32;
  char* qrl = lds + 2 * SHM_V + 2 * SHM_K + 2048 + wid * 4096 + lane * 16;
  float m_reg = -1e30f, l_reg = 0; f32x16 o[4] = {}; bf16x8 qr[8];
  bf16_t* Qw = Qb + (size_t)(wid * QBLK + r32) * 1536 + hi * 8;
#pragma unroll
  for (int d0 = 0; d0 < 8; ++d0) qr[d0] = *reinterpret_cast<const bf16x8*>(Qw + d0 * 16);
  { bf16x8 q8 = *reinterpret_cast<const bf16x8*>(Qw + 128), q9 = *reinterpret_cast<const bf16x8*>(Qw + 144), q10 = *reinterpret_cast<const bf16x8*>(Qw + 160), q11 = *reinterpret_cast<const bf16x8*>(Qw + 176);
    const int pos = pos0 + wid * QBLK + r32;
    rope_frag(q8, q9, rope + ((pos >> 6) * 16 + hi * 8) * 2); rope_frag(q10, q11, rope + ((pos & 63) * 16 + hi * 8) * 2);
    *reinterpret_cast<bf16x8*>(qrl) = q8; *reinterpret_cast<bf16x8*>(qrl + 1024) = q9; *reinterpret_cast<bf16x8*>(qrl + 2048) = q10; *reinterpret_cast<bf16x8*>(qrl + 3072) = q11; }
  const int sr = tid >> 4, sc = (tid & 15) * 8, vst0 = v_st(sr, sc), vst1 = v_st(32 + sr, sc);
  const int kst0 = KSWZ(sr, sc * 2), kst1 = KSWZ(32 + sr, sc * 2), kst2 = KSWZ(tid >> 3, 256 + (tid & 7) * 16);
  const int goff = sr * 2048 + sc, goffr = (tid >> 3) * 64 + (tid & 7) * 8;
  const int vb0 = (int)(uintptr_t)V_lds + v_rd_base(lane);
  u32x4 sv0, sv1, sk0, sk1, sk2;
#define SLOAD(k0) do { const bf16_t* vp = Vh + (size_t)(k0) * 2048 + goff; const bf16_t* kp = Kn + (size_t)(k0) * 2048 + goff; \
    sv0 = *(const u32x4*)vp; sv1 = *(const u32x4*)(vp + 32 * 2048); sk0 = *(const u32x4*)kp; sk1 = *(const u32x4*)(kp + 32 * 2048); \
    sk2 = *(const u32x4*)(Kr + (size_t)(k0) * 64 + goffr); } while (0)
#define SWRITE(b) do { *(u32x4*)(V_lds + (b) * SHM_V + vst0) = sv0; *(u32x4*)(V_lds + (b) * SHM_V + vst1) = sv1; \
    *(u32x4*)(K_lds + (b) * SHM_K + kst0) = sk0; *(u32x4*)(K_lds + (b) * SHM_K + kst1) = sk1; *(u32x4*)(K_lds + (b) * SHM_K + kst2) = sk2; } while (0)
#define SWAIT() asm volatile("s_waitcnt vmcnt(0)" ::: "memory")
#define RESC(a) do { if (__any((a) < 1.f)) { if (hi == 0) al_l[r32] = (a); asm volatile("s_waitcnt lgkmcnt(0)" ::: "memory"); \
    _Pragma("unroll") for (int d = 0; d < 4; ++d) _Pragma("unroll") for (int r = 0; r < 16; ++r) o[d][r] *= al_l[crow(r, hi)]; } } while (0)
  f32x16 pA0, pA1, pB0, pB1; float mnA, mnB, alA, alB; bf16x8 pa0, pa1, pa2, pa3; constexpr int NT = NKEY / KVBLK;
  SLOAD(0); SWAIT(); SWRITE(0); __syncthreads();
  qkt(pA0, pA1, K_lds, qr, qrl, r32, hi); partialSM(pA0, pA1, m_reg, mnA, alA);
  SLOAD(KVBLK);
  SWAIT(); SWRITE(1); __syncthreads();
  for (int j = 1; j + 1 < NT; j += 2) {
    SBAR(); qkt(pB0, pB1, K_lds + SHM_K, qr, qrl, r32, hi);
    finishSM(pA0, pA1, alA, l_reg, pa0, pa1, pa2, pa3); SBAR();
    SLOAD((j + 1) * KVBLK); SBAR();
    pv_d0(o, vb0, pa0, pa1, pa2, pa3); partialSM(pB0, pB1, m_reg, mnB, alB);
    __syncthreads(); SWAIT(); SWRITE(0);
    RESC(alB); __syncthreads();
    SBAR(); qkt(pA0, pA1, K_lds, qr, qrl, r32, hi);
    finishSM(pB0, pB1, alB, l_reg, pa0, pa1, pa2, pa3); SBAR();
    SLOAD((j + 2) * KVBLK); SBAR();
    pv_d0(o, vb0 + SHM_V, pa0, pa1, pa2, pa3); partialSM(pA0, pA1, m_reg, mnA, alA);
    __syncthreads(); SWAIT(); SWRITE(1);
    RESC(alA); __syncthreads();
  }
  SBAR(); qkt(pB0, pB1, K_lds + SHM_K, qr, qrl, r32, hi);
  finishSM(pA0, pA1, alA, l_reg, pa0, pa1, pa2, pa3); SBAR();
  pv_d0(o, vb0, pa0, pa1, pa2, pa3); partialSM(pB0, pB1, m_reg, mnB, alB);
  __syncthreads(); RESC(alB);
  finishSM(pB0, pB1, alB, l_reg, pa0, pa1, pa2, pa3); SBAR();
  pv_d0(o, vb0 + SHM_V, pa0, pa1, pa2, pa3);
  if (hi == 0) li_l[r32] = l_reg; asm volatile("s_waitcnt lgkmcnt(0)" ::: "memory");
  float rli[16];
#pragma unroll
  for (int r = 0; r < 16; ++r) rli[r] = __builtin_amdgcn_rcpf(li_l[crow(r, hi)]);
  bf16_t* Ow = Qb + (size_t)(wid * QBLK) * 1536;
#pragma unroll
  for (int r = 0; r < 16; ++r) { const int orow = crow(r, hi);
#pragma unroll
    for (int d0 = 0; d0 < 4; ++d0) Ow[(size_t)orow * 1536 + d0 * 32 + r32] = f2bf(o[d0][r] * rli[r]); }
  __syncthreads();
#undef SLOAD
#undef SWRITE
#undef SWAIT
#undef RESC
}
}
DEVI void attn_mfma(const Params& p, char* smem) {
  bf16_t* Q = (bf16_t*)(p.ws + O_RQ); const bf16_t* KV = (const bf16_t*)(p.ws + O_RKV); const bf16_t* KR = (const bf16_t*)(p.ws + O_KR);
  const float* rope = (const float*)(p.ws + O_ROPE);
  for (int it = blockIdx.x; it < NB * 8 * (SEQ / 256); it += gridDim.x) {
    const int bh = (it >> 8) * 8 + (it & 7), qb = (it & 255) >> 3, b = bh >> 3, h = bh & 7;
    at::attn_item(Q + (size_t)(b * SEQ + qb * 256) * 1536 + h * 192, KV + (size_t)b * NKEY * 2048 + h * 256, KV + (size_t)b * NKEY * 2048 + h * 256 + 128,
                  KR + (size_t)b * NKEY * 64, rope, qb * 256, smem);
  }
}
#if ATTN_MFMA
DEVI void ph_attn(const Params& p, char* smem) { attn_mfma(p, smem); }
#else
DEVI void ph_attn(const Params& p, char* smem) { attn_naive(p, smem); }
#endif

DEVI void ph_rows(const Params& p, char* smem) {
  const int tid = threadIdx.x, wave = tid >> 6, lane = tid & 63;
  const float* MOD = (const float*)(p.ws + O_MOD); const bf16_t* Y = (const bf16_t*)(p.ws + O_RA); const float* rssy = (const float*)(p.ws + O_RSSY);
  bf16_t* HX2 = (bf16_t*)(p.ws + O_RB);
  for (int row = blockIdx.x * NWAVE + wave; row < NTOK; row += gridDim.x * NWAVE) {
    const int b = row >> 13; const float* md = MOD + b * 6144;
    float ty = 0.f; { const float* pr = rssy + (size_t)row * 16;
#pragma unroll
      for (int j = 0; j < 16; ++j) ty += pr[j]; }
    const float ry = rsqrtf(ty * (1.f / 1024.f) + EPS);
    float x1[16]; float ss = 0.f;
#pragma unroll
    for (int i = 0; i < 4; ++i) { const int c = i * 256 + lane * 4; const float4 xv = *(const float4*)(p.x + (size_t)row * 1024 + c); const u32x2 yv = *(const u32x2*)(Y + (size_t)row * 1024 + c);
      const float4 gp = *(const float4*)(p.g_post1 + c), gt = *(const float4*)(md + 2048 + c);
      x1[i * 4 + 0] = xv.x + gt.x * (lo2f(yv[0]) * ry * gp.x); x1[i * 4 + 1] = xv.y + gt.y * (hi2f(yv[0]) * ry * gp.y);
      x1[i * 4 + 2] = xv.z + gt.z * (lo2f(yv[1]) * ry * gp.z); x1[i * 4 + 3] = xv.w + gt.w * (hi2f(yv[1]) * ry * gp.w);
#pragma unroll
      for (int j = 0; j < 4; ++j) ss += x1[i * 4 + j] * x1[i * 4 + j];
      *(float4*)(p.out + (size_t)row * 1024 + c) = make_float4(x1[i * 4], x1[i * 4 + 1], x1[i * 4 + 2], x1[i * 4 + 3]); }
    ss = wave_sum(ss); const float r2 = rsqrtf(ss * (1.f / 1024.f) + EPS);
#pragma unroll
    for (int i = 0; i < 4; ++i) { const int c = i * 256 + lane * 4; const float4 g2 = *(const float4*)(p.g_pre2 + c), sc = *(const float4*)(md + 4096 + c), sh = *(const float4*)(md + 3072 + c);
      st4bf(HX2 + (size_t)row * 1024 + c, x1[i * 4] * r2 * g2.x * (1.f + sc.x) + sh.x, x1[i * 4 + 1] * r2 * g2.y * (1.f + sc.y) + sh.y,
            x1[i * 4 + 2] * r2 * g2.z * (1.f + sc.z) + sh.z, x1[i * 4 + 3] * r2 * g2.w * (1.f + sc.w) + sh.w); }
  }
  convert_table(p.u_exp, (bf16_t*)(p.ws + O_RC));
}

DEVI void topk_naive(const Params& p, char* smem) {
  const int tid = threadIdx.x, wave = tid >> 6, lane = tid & 63;
  float* wl = (float*)smem + wave * 512; int* wi = (int*)wl;
  const bf16_t* QP = (const bf16_t*)(p.ws + O_RKV); const bf16_t* K1 = (const bf16_t*)(p.ws + O_K1); const bf16_t* K2 = (const bf16_t*)(p.ws + O_K2);
  int* IDX = (int*)(p.ws + O_RQ); float* GW = (float*)(p.ws + O_RQ + (size_t)NTOK * 128 * 4);
  for (int base = blockIdx.x * NWAVE; base < NTOK * 8; base += gridDim.x * NWAVE) {
    const int it = base + wave, token = it >> 3, h = it & 7;
    __syncthreads();
    const bf16_t* q = QP + (size_t)token * 2048 + h * 256;
    for (int d = lane; d < 256; d += 64) wl[d] = bf2f(q[d]);
    __syncthreads();
    float s[4] = {0.f, 0.f, 0.f, 0.f};
#pragma unroll 2
    for (int d8 = 0; d8 < 16; ++d8) {
      const float4 qa0 = *(const float4*)(wl + d8 * 8), qa1 = *(const float4*)(wl + d8 * 8 + 4), qb0 = *(const float4*)(wl + 128 + d8 * 8), qb1 = *(const float4*)(wl + 128 + d8 * 8 + 4);
#pragma unroll
      for (int w = 0; w < 4; ++w) { const int key = lane + (w & 1) * 64; const bf16_t* kp = (w < 2 ? K1 : K2) + key * 128;
        float kf[8]; unpack8(*(const u32x4*)(kp + d8 * 8), kf); const float4 q0 = w < 2 ? qa0 : qb0, q1 = w < 2 ? qa1 : qb1;
        s[w] += q0.x * kf[0] + q0.y * kf[1] + q0.z * kf[2] + q0.w * kf[3] + q1.x * kf[4] + q1.y * kf[5] + q1.z * kf[6] + q1.w * kf[7]; }
    }
#pragma unroll
    for (int half = 0; half < 2; ++half) { float a0 = s[half * 2], a1 = s[half * 2 + 1];
#pragma unroll 1
      for (int r = 0; r < 16; ++r) { float v; int i; if (a0 >= a1) { v = a0; i = lane; } else { v = a1; i = lane + 64; }
        for (int o = 32; o > 0; o >>= 1) { const float ov = __shfl_xor(v, o); const int oi = __shfl_xor(i, o); if (ov > v || (ov == v && oi < i)) { v = ov; i = oi; } }
        if (i == lane) a0 = -3.0e38f; else if (i == lane + 64) a1 = -3.0e38f;
        if (lane == 0) { wl[256 + half * 32 + r] = v; wi[256 + half * 32 + 16 + r] = i; } } }
    __syncthreads();
    float cv[4]; int ci[4];
#pragma unroll
    for (int j = 0; j < 4; ++j) { const int cidx = lane * 4 + j, i = cidx >> 4, jj = cidx & 15; cv[j] = wl[256 + i] + wl[256 + 32 + jj]; ci[j] = wi[256 + 16 + i] * 128 + wi[256 + 32 + 16 + jj]; }
    float myv = 0.f, vmax = 0.f; int myi = 0;
#pragma unroll 1
    for (int r = 0; r < 16; ++r) { float v = cv[0]; int pos = lane * 4, ei = ci[0];
#pragma unroll
      for (int j = 1; j < 4; ++j) if (cv[j] > v) { v = cv[j]; pos = lane * 4 + j; ei = ci[j]; }
      for (int o = 32; o > 0; o >>= 1) { const float ov = __shfl_xor(v, o); const int op = __shfl_xor(pos, o), oe = __shfl_xor(ei, o); if (ov > v || (ov == v && op < pos)) { v = ov; pos = op; ei = oe; } }
#pragma unroll
      for (int j = 0; j < 4; ++j) if (pos == lane * 4 + j) cv[j] = -3.0e38f;
      if (r == 0) vmax = v;
      if (lane == r) { myv = v; myi = ei; } }
    const float e = lane < 16 ? __expf(myv - vmax) : 0.f; const float sum = wave_sum(e);
    if (lane < 16) { IDX[(size_t)token * 128 + h * 16 + lane] = myi; GW[(size_t)token * 128 + h * 16 + lane] = e / sum; }
  }
}
DEVI void ph_topk(const Params& p, char* smem) { topk_naive(p, smem); }

DEVI void ph_gather(const Params& p, char* smem) {
  const int tid = threadIdx.x, wave = tid >> 6, lane = tid & 63;
  const bf16_t* HX2 = (const bf16_t*)(p.ws + O_RB); const bf16_t* UT = (const bf16_t*)(p.ws + O_RC); const bf16_t* VT = (const bf16_t*)(p.ws + O_RA);
  const int* IDX = (const int*)(p.ws + O_RQ); const float* GW = (const float*)(p.ws + O_RQ + (size_t)NTOK * 128 * 4);
  const float* MOD = (const float*)(p.ws + O_MOD);
  for (int t = blockIdx.x * NWAVE + wave; t < NTOK; t += gridDim.x * NWAVE) {
    float xf[16];
    unpack8(*(const u32x4*)(HX2 + (size_t)t * 1024 + lane * 8), xf); unpack8(*(const u32x4*)(HX2 + (size_t)t * 1024 + 512 + lane * 8), xf + 8);
    const int my_i0 = IDX[(size_t)t * 128 + lane], my_i1 = IDX[(size_t)t * 128 + 64 + lane];
    const float my_g0 = GW[(size_t)t * 128 + lane], my_g1 = GW[(size_t)t * 128 + 64 + lane];
    float acc[16];
#pragma unroll
    for (int j = 0; j < 16; ++j) acc[j] = 0.f;
    for (int e0 = 0; e0 < 128; e0 += 4) {
      int id[4]; float g[4]; u32x4 ua[4], ub[4], va[4], vb[4];
#pragma unroll
      for (int j = 0; j < 4; ++j) { const int e = e0 + j; id[j] = e0 < 64 ? __shfl(my_i0, e) : __shfl(my_i1, e - 64); g[j] = e0 < 64 ? __shfl(my_g0, e) : __shfl(my_g1, e - 64);
        const bf16_t* ur = UT + (size_t)id[j] * 1024; const bf16_t* vr = VT + (size_t)id[j] * 1024;
        ua[j] = *(const u32x4*)(ur + lane * 8); ub[j] = *(const u32x4*)(ur + 512 + lane * 8); va[j] = *(const u32x4*)(vr + lane * 8); vb[j] = *(const u32x4*)(vr + 512 + lane * 8); }
      float d[4];
#pragma unroll
      for (int j = 0; j < 4; ++j) { float uf[16]; unpack8(ua[j], uf); unpack8(ub[j], uf + 8); float s = 0.f;
#pragma unroll
        for (int k = 0; k < 16; ++k) s += xf[k] * uf[k];
        d[j] = s; }
#pragma unroll
      for (int j = 0; j < 4; ++j) d[j] = wave_sum(d[j]);
#pragma unroll
      for (int j = 0; j < 4; ++j) { const float cf = g[j] * gelu_t(d[j]); float vf[16]; unpack8(va[j], vf); unpack8(vb[j], vf + 8);
#pragma unroll
        for (int k = 0; k < 16; ++k) acc[k] += cf * vf[k]; }
    }
    float ss = 0.f;
#pragma unroll
    for (int k = 0; k < 16; ++k) ss += acc[k] * acc[k];
    ss = wave_sum(ss); const float rstd = rsqrtf(ss * (1.f / 1024.f) + EPS);
    const int b = t >> 13; const float* gt2 = MOD + b * 6144 + 5120;
#pragma unroll
    for (int hh = 0; hh < 2; ++hh) { const int c = hh * 512 + lane * 8; float* op = p.out + (size_t)t * 1024 + c;
#pragma unroll
      for (int q4 = 0; q4 < 2; ++q4) { float4 xv = *(const float4*)(op + q4 * 4); const float4 gt = *(const float4*)(gt2 + c + q4 * 4), gp = *(const float4*)(p.g_post2 + c + q4 * 4);
        xv.x += gt.x * (acc[hh * 8 + q4 * 4 + 0] * rstd * gp.x); xv.y += gt.y * (acc[hh * 8 + q4 * 4 + 1] * rstd * gp.y);
        xv.z += gt.z * (acc[hh * 8 + q4 * 4 + 2] * rstd * gp.z); xv.w += gt.w * (acc[hh * 8 + q4 * 4 + 3] * rstd * gp.w);
        *(float4*)(op + q4 * 4) = xv; } }
  }
}

constexpr int NPHASE = 12;
template <int PH> DEVI void run_phase(const Params& p, char* smem) {
  if constexpr (PH == 0) ph_prep(p, smem);
  else if constexpr (PH == 1) ph_hx(p, smem);
  else if constexpr (PH == 2) ph_inproj(p, smem);
  else if constexpr (PH == 3) ph_mid(p, smem);
  else if constexpr (PH == 4) ph_attn(p, smem);
  else if constexpr (PH == 5) ph_gates(p, smem);
  else if constexpr (PH == 6) ph_merge(p, smem);
  else if constexpr (PH == 7) ph_wo(p, smem);
  else if constexpr (PH == 8) ph_rows(p, smem);
  else if constexpr (PH == 9) ph_wpq(p, smem);
  else if constexpr (PH == 10) ph_topk(p, smem);
  else if constexpr (PH == 11) ph_gather(p, smem);
}

template <int PH> __global__ __launch_bounds__(NTHR) void k_phase(Params p) {
  extern __shared__ __attribute__((aligned(16))) char smem[];
  run_phase<PH>(p, smem);
}

#if MEGA
__global__ __launch_bounds__(NTHR) void k_mega(Params p) {
  extern __shared__ __attribute__((aligned(16))) char smem[];
  cg::grid_group grid = cg::this_grid();
  run_phase<0>(p, smem); grid.sync();
  run_phase<1>(p, smem); grid.sync();
  run_phase<2>(p, smem); grid.sync();
  run_phase<3>(p, smem); grid.sync();
  run_phase<4>(p, smem); grid.sync();
  run_phase<5>(p, smem); grid.sync();
  run_phase<6>(p, smem); grid.sync();
  run_phase<7>(p, smem); grid.sync();
  run_phase<8>(p, smem); grid.sync();
  run_phase<9>(p, smem); grid.sync();
  run_phase<10>(p, smem); grid.sync();
  run_phase<11>(p, smem);
}
#endif

template <int PH> static void launch_phase(const Params& p, int grid, hipStream_t stream) {
  hipLaunchKernelGGL(k_phase<PH>, dim3(grid), dim3(NTHR), LDS_BYTES, stream, p);
}
template <int PH> static void set_attr() { (void)hipFuncSetAttribute((const void*)k_phase<PH>, hipFuncAttributeMaxDynamicSharedMemorySize, LDS_BYTES); }

extern "C" void kernel_launch(void* const* d_in, const int* in_sizes, int n_in, void* d_out, int out_size, void* d_ws, size_t ws_size, hipStream_t stream) {
  static int grid = 0;
  if (grid == 0) {
    if (n_in != 26 || out_size != NTOK * DM || ws_size < O_END) { fprintf(stderr, "kernel_launch: unexpected shapes n_in %d out %d ws %zu (need %zu)\n", n_in, out_size, ws_size, (size_t)O_END); grid = -1; return; }
#if MEGA
    (void)hipFuncSetAttribute((const void*)k_mega, hipFuncAttributeMaxDynamicSharedMemorySize, LDS_BYTES);
    int dev = 0, cus = 0, per_cu = 0; (void)hipGetDevice(&dev); (void)hipDeviceGetAttribute(&cus, hipDeviceAttributeMultiprocessorCount, dev);
    (void)hipOccupancyMaxActiveBlocksPerMultiprocessor(&per_cu, (const void*)k_mega, NTHR, LDS_BYTES);
    if (per_cu < 1) { fprintf(stderr, "kernel_launch: occupancy query says %d blocks per CU\n", per_cu); grid = -1; return; }
    grid = cus;
#else
    set_attr<0>(); set_attr<1>(); set_attr<2>(); set_attr<3>(); set_attr<4>(); set_attr<5>(); set_attr<6>(); set_attr<7>(); set_attr<8>(); set_attr<9>(); set_attr<10>(); set_attr<11>();
    grid = 256;
#endif
  }
  if (grid < 0) return;
  Params p{};
  const float** pp = (const float**)&p;
  for (int i = 0; i < 26; ++i) pp[i] = (const float*)d_in[i];
  p.out = (float*)d_out; p.ws = (char*)d_ws;
#if MEGA
  void* args[] = {&p};
  hipError_t e = hipLaunchCooperativeKernel((const void*)k_mega, dim3(grid), dim3(NTHR), args, LDS_BYTES, stream);
  if (e != hipSuccess) fprintf(stderr, "cooperative launch failed: %s (grid %d)\n", hipGetErrorString(e), grid);
#else
  launch_phase<0>(p, grid, stream); launch_phase<1>(p, grid, stream); launch_phase<2>(p, grid, stream); launch_phase<3>(p, grid, stream);
  launch_phase<4>(p, grid, stream); launch_phase<5>(p, grid, stream); launch_phase<6>(p, grid, stream); launch_phase<7>(p, grid, stream);
  launch_phase<8>(p, grid, stream); launch_phase<9>(p, grid, stream); launch_phase<10>(p, grid, stream); launch_phase<11>(p, grid, stream);
#endif
}
```

```cpp
#include <hip/hip_runtime.h>
#include <hip/hip_cooperative_groups.h>
#include <cstdint>
#include <cstdio>
namespace cg = cooperative_groups;

#ifndef MEGA
#define MEGA 1
#endif
#ifndef GEMM_MFMA
#define GEMM_MFMA 1
#endif
#ifndef ATTN_MFMA
#define ATTN_MFMA 1
#endif
#ifndef TOPK_FAST
#define TOPK_FAST 1
#endif

#define DEVI __device__ __forceinline__
typedef unsigned short bf16_t;
using bf16x8 = __attribute__((ext_vector_type(8))) short;
using bf16x4 = __attribute__((ext_vector_type(4))) short;
using f32x4  = __attribute__((ext_vector_type(4))) float;
using f32x16 = __attribute__((ext_vector_type(16))) float;
using u32x4  = __attribute__((ext_vector_type(4))) unsigned;
using u32x2  = __attribute__((ext_vector_type(2))) unsigned;

constexpr int DM = 1024, NB = 2, SEQ = 8192, NTOK = NB * SEQ, CTXL = 256, NCTX = NB * CTXL, NROW = NTOK + NCTX, NKEY = SEQ + CTXL;
constexpr int INW = 4544, INWP = 4608;
constexpr int NPRE = 2560;
constexpr float EPS = 1e-6f;
constexpr int NTHR = 512, NWAVE = 8;
constexpr int LDS_BYTES = 122880;

constexpr size_t al256(size_t x) { return (x + 255) / 256 * 256; }
constexpr size_t O_WIN   = 0;
constexpr size_t O_WUQ   = O_WIN  + al256((size_t)INWP * 1024 * 2);
constexpr size_t O_WUKV  = O_WUQ  + al256((size_t)1536 * 256 * 2);
constexpr size_t O_WPA   = O_WUKV + al256((size_t)2048 * 128 * 2);
constexpr size_t O_WPB   = O_WPA  + al256((size_t)1024 * 1024 * 2);
constexpr size_t O_WO    = O_WPB  + al256((size_t)1024 * 1024 * 2);
constexpr size_t O_WPQ   = O_WO   + al256((size_t)1024 * 1024 * 2);
constexpr size_t O_WS    = O_WPQ  + al256((size_t)2048 * 1024 * 2);
constexpr size_t O_K1    = O_WS   + al256((size_t)8 * 128 * 128 * 2);
constexpr size_t O_K2    = O_K1   + al256((size_t)128 * 128 * 2);
constexpr size_t O_MOD   = O_K2   + al256((size_t)128 * 128 * 2);
constexpr size_t O_ROPE  = O_MOD  + al256((size_t)3 * 6144 * 4);
constexpr size_t O_RSSV  = O_ROPE + al256((size_t)128 * 16 * 2 * 4);
constexpr size_t O_RSSQ  = O_RSSV + (size_t)NTOK * 16 * 4;
constexpr size_t O_RSSKV = O_RSSQ + (size_t)NTOK * 4 * 4;
constexpr size_t O_RSSY  = O_RSSKV + (size_t)NROW * 2 * 4;
constexpr size_t O_RSSEND = O_RSSY + (size_t)NTOK * 16 * 4;
constexpr size_t O_RA    = al256(O_RSSEND);
constexpr size_t O_RB    = O_RA  + al256((size_t)NROW * 1024 * 2);
constexpr size_t O_RC    = O_RB  + al256((size_t)NTOK * 1024 * 2);
constexpr size_t O_CQ    = O_RC  + al256((size_t)NTOK * 1024 * 2);
constexpr size_t O_CKV   = O_CQ  + al256((size_t)NTOK * 256 * 2);
constexpr size_t O_KR    = O_CKV + al256((size_t)NROW * 128 * 2);
constexpr size_t O_RQ    = O_KR  + al256((size_t)NROW * 64 * 2);
constexpr size_t O_RKV   = O_RQ  + al256((size_t)NTOK * 1536 * 2);
constexpr size_t O_END   = O_RKV + al256((size_t)NROW * 2048 * 2);
static_assert(O_END <= (size_t)258 * 1024 * 1024, "workspace too large");

struct Params {
  const float *x, *c, *ctx, *c_ctx, *w_mod, *b_mod, *g_pre1, *g_post1, *g_pre2, *g_post2, *w_in, *g_q, *g_kv, *w_uq, *w_ukv, *g_sgu, *w_s, *b_s,
      *w_pa, *w_pb, *w_o, *w_pq, *k1, *k2, *u_exp, *v_exp;
  float* out; char* ws;
};

DEVI float bf2f(unsigned short h) { return __uint_as_float(((unsigned)h) << 16); }
DEVI unsigned short f2bf(float f) { unsigned u = __float_as_uint(f); u += 0x7fffu + ((u >> 16) & 1u); return (unsigned short)(u >> 16); }
DEVI unsigned pack2(float a, float b) { return (unsigned)f2bf(a) | ((unsigned)f2bf(b) << 16); }
DEVI float lo2f(unsigned w) { return __uint_as_float(w << 16); }
DEVI float hi2f(unsigned w) { return __uint_as_float(w & 0xffff0000u); }
DEVI void unpack8(const u32x4& w, float* f) {
  f[0] = lo2f(w[0]); f[1] = hi2f(w[0]); f[2] = lo2f(w[1]); f[3] = hi2f(w[1]); f[4] = lo2f(w[2]); f[5] = hi2f(w[2]); f[6] = lo2f(w[3]); f[7] = hi2f(w[3]);
}
DEVI float gelu_t(float x) { float z = 0.7978845608028654f * (x + 0.044715f * x * x * x); return x / (1.f + __expf(-2.f * z)); }
DEVI float sigmoidf_(float x) { return 1.f / (1.f + __expf(-x)); }
DEVI float wave_sum(float v) { for (int o = 32; o > 0; o >>= 1) v += __shfl_xor(v, o); return v; }
DEVI float wave_max(float v) { for (int o = 32; o > 0; o >>= 1) v = fmaxf(v, __shfl_xor(v, o)); return v; }
DEVI int keyrow(int row) { if (row < NTOK) return (row >> 13) * NKEY + (row & 8191); int c = row - NTOK; return (c >> 8) * NKEY + SEQ + (c & 255); }

__device__ const float ROPE_FREQ[16] = {1.0f, 0.5623413324356079f, 0.3162277638912201f, 0.17782793939113617f, 0.10000000149011612f, 0.05623413249850273f, 0.03162277489900589f, 0.017782794311642647f, 0.009999999776482582f, 0.005623413249850273f, 0.003162277629598975f, 0.0017782794311642647f, 0.0010000000474974513f, 0.000562341301701963f, 0.0003162277571391314f, 0.00017782794020604342f};
DEVI void sincos_small(double a, double& cs, double& sn) {
  const double k = rint(a * 0.15915494309189535); const double r = fma(-k, 6.283185307179586, a) - k * 2.4492935982947064e-16;
  const double r2 = r * r; double s = 0.0, c = 0.0;
#pragma unroll
  for (int n = 12; n >= 1; --n) { s = (1.0 - s * r2 / (double)((2 * n) * (2 * n + 1))); c = (1.0 - c * r2 / (double)((2 * n - 1) * (2 * n))); }
  sn = r * s; cs = c;
}

DEVI void transpose_job(const float* __restrict__ src, int K, int N, bf16_t* __restrict__ dst, const float* __restrict__ gk, bool isWin, int ntiles, char* smem) {
  const int tid = threadIdx.x; bf16_t* tl = (bf16_t*)smem; const int kt = K / 64;
  for (int idx = blockIdx.x; idx < ntiles; idx += gridDim.x) {
    const int ktile = idx % kt, ntile = idx / kt, k0 = ktile * 64, n0d = ntile * 64;
    int n0s = n0d; bool zero = false;
    if (isWin) { if (n0d == 2496) zero = true; else if (n0d >= 2560) n0s = n0d - 64; }
    { const int kk = tid >> 3, nn8 = (tid & 7) * 8; f32x4 va = {0.f, 0.f, 0.f, 0.f}, vb = va;
      if (!zero) { const float* s = src + (size_t)(k0 + kk) * N + n0s + nn8; const float4 a = *(const float4*)s, b = *(const float4*)(s + 4);
        const float sc = gk ? gk[k0 + kk] : 1.f; va = (f32x4){a.x, a.y, a.z, a.w} * sc; vb = (f32x4){b.x, b.y, b.z, b.w} * sc; }
      bf16_t* tp = tl + nn8 * 72 + kk;
      tp[0] = f2bf(va[0]); tp[72] = f2bf(va[1]); tp[144] = f2bf(va[2]); tp[216] = f2bf(va[3]); tp[288] = f2bf(vb[0]); tp[360] = f2bf(vb[1]); tp[432] = f2bf(vb[2]); tp[504] = f2bf(vb[3]); }
    __syncthreads();
    { const int nn = tid >> 3, kk8 = (tid & 7) * 8;
      const u32x4 o = *(const u32x4*)(tl + nn * 72 + kk8);
      *(u32x4*)(dst + (size_t)(n0d + nn) * K + k0 + kk8) = o; }
    __syncthreads();
  }
}

DEVI void ph_prep(const Params& p, char* smem) {
  const int tid = threadIdx.x, bid = blockIdx.x, nb = gridDim.x;
  char* ws = p.ws;
  if (bid == 0) { float* rope = (float*)(ws + O_ROPE);
    for (int i = tid; i < 128 * 16; i += NTHR) { const int pos = i >> 4, f = i & 15; const float ang = (float)pos * ROPE_FREQ[f];
      double cs, sn; sincos_small((double)ang, cs, sn); rope[i * 2] = (float)cs; rope[i * 2 + 1] = (float)sn; } }
  { float* red = (float*)smem; float* MOD = (float*)(ws + O_MOD);
    for (int it = bid; it < 256; it += nb) {
      const int cgp = tid % 6, kg = tid / 6;
      f32x4 a0 = {0.f, 0.f, 0.f, 0.f}, a1 = a0, a2 = a0;
      if (tid < 510) {
        for (int k = kg; k < 1024; k += 85) {
          const float4 w4 = *(const float4*)(p.w_mod + (size_t)k * 6144 + it * 24 + cgp * 4);
          const f32x4 w = {w4.x, w4.y, w4.z, w4.w};
          const float c0 = p.c[k], c1 = p.c[1024 + k], c2 = p.c_ctx[k];
          a0 += w * (c0 / (1.f + __expf(-c0))); a1 += w * (c1 / (1.f + __expf(-c1))); a2 += w * (c2 / (1.f + __expf(-c2)));
        }
        float* rp = red + kg * 72 + cgp * 4;
        rp[0] = a0[0]; rp[1] = a0[1]; rp[2] = a0[2]; rp[3] = a0[3];
        rp[24] = a1[0]; rp[25] = a1[1]; rp[26] = a1[2]; rp[27] = a1[3];
        rp[48] = a2[0]; rp[49] = a2[1]; rp[50] = a2[2]; rp[51] = a2[3];
      }
      __syncthreads();
      if (tid < 72) { float s = 0.f; for (int g = 0; g < 85; ++g) s += red[g * 72 + tid]; int r = tid / 24, n = it * 24 + tid % 24; MOD[r * 6144 + n] = s + p.b_mod[n]; }
      __syncthreads();
    } }
  transpose_job(p.w_in,  1024, INW,  (bf16_t*)(ws + O_WIN),  nullptr, true,  1152, smem);
  transpose_job(p.w_uq,  256,  1536, (bf16_t*)(ws + O_WUQ),  p.g_q,   false, 96,   smem);
  transpose_job(p.w_ukv, 128,  2048, (bf16_t*)(ws + O_WUKV), p.g_kv,  false, 64,   smem);
  transpose_job(p.w_pa,  1024, 1024, (bf16_t*)(ws + O_WPA),  nullptr, false, 256,  smem);
  transpose_job(p.w_pb,  1024, 1024, (bf16_t*)(ws + O_WPB),  nullptr, false, 256,  smem);
  transpose_job(p.w_o,   1024, 1024, (bf16_t*)(ws + O_WO),   nullptr, false, 256,  smem);
  transpose_job(p.w_pq,  1024, 2048, (bf16_t*)(ws + O_WPQ),  nullptr, false, 512,  smem);
  { const int n8 = (131072 + 16384 + 16384) / 8;
    for (int i = bid * NTHR + tid; i < n8; i += nb * NTHR) {
      int e = i * 8; const float* s; bf16_t* d;
      if (e < 131072) { s = p.w_s + e; d = (bf16_t*)(ws + O_WS) + e; }
      else if (e < 131072 + 16384) { s = p.k1 + (e - 131072); d = (bf16_t*)(ws + O_K1) + (e - 131072); }
      else { s = p.k2 + (e - 131072 - 16384); d = (bf16_t*)(ws + O_K2) + (e - 131072 - 16384); }
      const float4 a = *(const float4*)s, b = *(const float4*)(s + 4);
      u32x4 o = {pack2(a.x, a.y), pack2(a.z, a.w), pack2(b.x, b.y), pack2(b.z, b.w)};
      *(u32x4*)d = o;
    } }
}

DEVI void convert_table(const float* __restrict__ src, bf16_t* __restrict__ dst) {
  const int n8 = 16384 * 1024 / 8;
  for (int i = blockIdx.x * NTHR + threadIdx.x; i < n8; i += gridDim.x * NTHR) {
    const float4 a = *(const float4*)(src + (size_t)i * 8), b = *(const float4*)(src + (size_t)i * 8 + 4);
    u32x4 o = {pack2(a.x, a.y), pack2(a.z, a.w), pack2(b.x, b.y), pack2(b.z, b.w)};
    *(u32x4*)(dst + (size_t)i * 8) = o;
  }
}

DEVI void ph_hx(const Params& p, char* smem) {
  const int tid = threadIdx.x, wave = tid >> 6, lane = tid & 63;
  float* mA = (float*)smem; float* mB = mA + 3 * 1024;
  const float* MOD = (const float*)(p.ws + O_MOD);
  for (int i = tid; i < 3072; i += NTHR) { int r = i >> 10, c = i & 1023; mA[i] = p.g_pre1[c] * (1.f + MOD[r * 6144 + 1024 + c]); mB[i] = MOD[r * 6144 + c]; }
  __syncthreads();
  bf16_t* HX = (bf16_t*)(p.ws + O_RA);
  for (int row = blockIdx.x * NWAVE + wave; row < NROW; row += gridDim.x * NWAVE) {
    const float* src = row < NTOK ? p.x + (size_t)row * 1024 : p.ctx + (size_t)(row - NTOK) * 1024;
    const int mr = row < NTOK ? (row >> 13) : 2;
    float4 v[4]; float ss = 0.f;
#pragma unroll
    for (int i = 0; i < 4; ++i) { v[i] = *(const float4*)(src + i * 256 + lane * 4); ss += v[i].x * v[i].x + v[i].y * v[i].y + v[i].z * v[i].z + v[i].w * v[i].w; }
    ss = wave_sum(ss); const float rstd = rsqrtf(ss * (1.f / 1024.f) + EPS);
#pragma unroll
    for (int i = 0; i < 4; ++i) { const int c = i * 256 + lane * 4; const float* a = mA + mr * 1024 + c; const float* b = mB + mr * 1024 + c;
      u32x2 o = {pack2(v[i].x * rstd * a[0] + b[0], v[i].y * rstd * a[1] + b[1]), pack2(v[i].z * rstd * a[2] + b[2], v[i].w * rstd * a[3] + b[3])};
      *(u32x2*)(HX + (size_t)row * 1024 + c) = o; }
  }
}

template <int BM, bool ACOLMAP, class Epi>
DEVI void gemm_tile_naive(const bf16_t* __restrict__ A, int lda, const bf16_t* __restrict__ Bm, int ldb, int K, int row0, int col0, const Epi& epi, const float* kss) {
  const int t = threadIdx.x, cgp = t & 31, rr = t >> 5;
  for (int rb = 0; rb < BM; rb += 16) {
    const int r = rb + rr;
    const bf16_t* ap = A + (size_t)r * lda;
    const bf16_t* bp = Bm + (size_t)(cgp * 4) * ldb;
    float acc[4] = {0.f, 0.f, 0.f, 0.f};
    for (int k = 0; k < K; k += 8) {
      const int ka = ACOLMAP ? (k + (k >> 7) * 64) : k;
      float af[8]; unpack8(*(const u32x4*)(ap + ka), af);
      if (kss) {
#pragma unroll
        for (int j = 0; j < 8; ++j) af[j] *= kss[k + j]; }
#pragma unroll
      for (int n = 0; n < 4; ++n) { float bf[8]; unpack8(*(const u32x4*)(bp + (size_t)n * ldb + k), bf);
#pragma unroll
        for (int j = 0; j < 8; ++j) acc[n] += af[j] * bf[j]; }
    }
    float sq = epi(row0 + r, col0 + cgp * 4, acc);
    if (Epi::RSS) { for (int o = 16; o > 0; o >>= 1) sq += __shfl_xor(sq, o); if (cgp == 0) { epi.rss(row0 + r, col0, sq); epi.rss(row0 + r, col0 + 64, 0.f); } }
  }
}

DEVI int lds_sw(int row, int c) { return row * 128 + ((c ^ (row & 7)) << 4); }
template <int BM, bool ACOLMAP, class Epi>
DEVI void gemm_tile_mfma(const bf16_t* __restrict__ A, int lda, const bf16_t* __restrict__ Bm, int ldb, int K, int row0, int col0, const Epi& epi, const float* kscale, char* smem) {
  constexpr int MI = BM / 64, ACH = BM / 64, ABYTES = BM * 128, BBYTES = 128 * 128, STAGE = ABYTES + BBYTES;
  const int tid = threadIdx.x, wave = tid >> 6, lane = tid & 63, wm = wave >> 1, wn = wave & 1, l15 = lane & 15, lq = lane >> 4;
  f32x4 acc[MI][4];
#pragma unroll
  for (int mi = 0; mi < MI; ++mi)
#pragma unroll
    for (int ni = 0; ni < 4; ++ni) acc[mi][ni] = (f32x4){0.f, 0.f, 0.f, 0.f};
  u32x4 ra[ACH], rb[2];
  const int nk = K >> 6;
  auto gload = [&](int kt) {
    const int k0 = kt * 64, ka = ACOLMAP ? k0 + (k0 >> 7) * 64 : k0;
#pragma unroll
    for (int i = 0; i < ACH; ++i) { const int id = tid + NTHR * i, r = id >> 3, c = id & 7; ra[i] = *(const u32x4*)(A + (size_t)r * lda + ka + c * 8); }
#pragma unroll
    for (int i = 0; i < 2; ++i) { const int id = tid + NTHR * i, r = id >> 3, c = id & 7; rb[i] = *(const u32x4*)(Bm + (size_t)r * ldb + k0 + c * 8); }
  };
  auto lstore = [&](int buf, int kt) {
    char* sa = smem + buf * STAGE; char* sb = sa + ABYTES;
#pragma unroll
    for (int i = 0; i < ACH; ++i) { const int id = tid + NTHR * i, r = id >> 3, c = id & 7; u32x4 v = ra[i];
      if (kscale) { float f[8]; unpack8(v, f); const float* ks = kscale + kt * 64 + c * 8;
        v = (u32x4){pack2(f[0] * ks[0], f[1] * ks[1]), pack2(f[2] * ks[2], f[3] * ks[3]), pack2(f[4] * ks[4], f[5] * ks[5]), pack2(f[6] * ks[6], f[7] * ks[7])}; }
      *(u32x4*)(sa + lds_sw(r, c)) = v; }
#pragma unroll
    for (int i = 0; i < 2; ++i) { const int id = tid + NTHR * i, r = id >> 3, c = id & 7; *(u32x4*)(sb + lds_sw(r, c)) = rb[i]; }
  };
  gload(0); lstore(0, 0); __syncthreads();
  for (int kt = 0; kt < nk; ++kt) {
    if (kt + 1 < nk) gload(kt + 1);
    const char* sa = smem + (kt & 1) * STAGE; const char* sb = sa + ABYTES;
#pragma unroll
    for (int ks = 0; ks < 2; ++ks) { const int kc = ks * 4 + lq; bf16x8 af[MI], bfr[4];
#pragma unroll
      for (int mi = 0; mi < MI; ++mi) af[mi] = *(const bf16x8*)(sa + lds_sw(wm * (BM / 4) + mi * 16 + l15, kc));
#pragma unroll
      for (int ni = 0; ni < 4; ++ni) bfr[ni] = *(const bf16x8*)(sb + lds_sw(wn * 64 + ni * 16 + l15, kc));
#pragma unroll
      for (int mi = 0; mi < MI; ++mi)
#pragma unroll
        for (int ni = 0; ni < 4; ++ni) acc[mi][ni] = __builtin_amdgcn_mfma_f32_16x16x32_bf16(bfr[ni], af[mi], acc[mi][ni], 0, 0, 0); }
    if (kt + 1 < nk) lstore((kt + 1) & 1, kt + 1);
    __syncthreads();
  }
#pragma unroll
  for (int mi = 0; mi < MI; ++mi) { const int row = row0 + wm * (BM / 4) + mi * 16 + l15; float sq = 0.f;
#pragma unroll
    for (int ni = 0; ni < 4; ++ni) { const float v[4] = {acc[mi][ni][0], acc[mi][ni][1], acc[mi][ni][2], acc[mi][ni][3]}; sq += epi(row, col0 + wn * 64 + ni * 16 + lq * 4, v); }
    if (Epi::RSS) { sq += __shfl_xor(sq, 16); sq += __shfl_xor(sq, 32); if (lq == 0) epi.rss(row, col0 + wn * 64, sq); } }
}

template <int BM, bool ACOLMAP, class Epi>
DEVI void gemm_tile(const bf16_t* A, int lda, const bf16_t* Bm, int ldb, int K, int row0, int col0, const Epi& epi, const float* kss, char* smem) {
#if GEMM_MFMA
  gemm_tile_mfma<BM, ACOLMAP>(A, lda, Bm, ldb, K, row0, col0, epi, kss, smem);
#else
  gemm_tile_naive<BM, ACOLMAP>(A, lda, Bm, ldb, K, row0, col0, epi, kss);
#endif
}

DEVI void st4bf(bf16_t* d, float a, float b, float c, float e) { u32x2 o = {pack2(a, b), pack2(c, e)}; *(u32x2*)d = o; }

struct EpiIn { static constexpr bool RSS = true; bf16_t *GU, *GVT, *CQ, *CKV, *KR; float *rssv, *rssq, *rsskv;
  DEVI float operator()(int row, int col, const float (&v)[4]) const {
    if (col < 1024) { st4bf(GU + (size_t)row * 1024 + col, gelu_t(v[0]), gelu_t(v[1]), gelu_t(v[2]), gelu_t(v[3])); return 0.f; }
    else if (col < 2048) { const int c = col - 1024, chunk = row >> 7, q = row & 127; float s = 0.f;
#pragma unroll
      for (int j = 0; j < 4; ++j) { const float g = gelu_t(v[j]); s += g * g; GVT[((size_t)chunk * 1024 + c + j) * 128 + q] = f2bf(g); }
      return s; }
    else if (col < 2304) { st4bf(CQ + (size_t)row * 256 + (col - 2048), v[0], v[1], v[2], v[3]); return v[0] * v[0] + v[1] * v[1] + v[2] * v[2] + v[3] * v[3]; }
    else if (col < 2432) { st4bf(CKV + (size_t)row * 128 + (col - 2304), v[0], v[1], v[2], v[3]); return v[0] * v[0] + v[1] * v[1] + v[2] * v[2] + v[3] * v[3]; }
    else if (col < 2496) { st4bf(KR + (size_t)keyrow(row) * 64 + (col - 2432), v[0], v[1], v[2], v[3]); return 0.f; }
    return 0.f; }
  DEVI void rss(int row, int col, float s) const {
    if (col >= 1024 && col < 2048) rssv[row * 16 + ((col - 1024) >> 6)] = s; else if (col >= 2048 && col < 2304) rssq[row * 4 + ((col - 2048) >> 6)] = s; else if (col >= 2304 && col < 2432) rsskv[row * 2 + ((col - 2304) >> 6)] = s; }
};
struct EpiQ { static constexpr bool RSS = false; bf16_t* Q; const float* rssq;
  DEVI float operator()(int row, int col, const float (&v)[4]) const { const float4 ps = *(const float4*)(rssq + row * 4); const float r = rsqrtf(((ps.x + ps.y) + (ps.z + ps.w)) * (1.f / 256.f) + EPS);
    st4bf(Q + (size_t)row * 1536 + col, v[0] * r, v[1] * r, v[2] * r, v[3] * r); return 0.f; }
  DEVI void rss(int, int, float) const {} };
struct EpiKV { static constexpr bool RSS = false; bf16_t* KV; const float* rsskv;
  DEVI float operator()(int row, int col, const float (&v)[4]) const { const float r = rsqrtf((rsskv[row * 2] + rsskv[row * 2 + 1]) * (1.f / 128.f) + EPS);
    st4bf(KV + (size_t)keyrow(row) * 2048 + col, v[0] * r, v[1] * r, v[2] * r, v[3] * r); return 0.f; }
  DEVI void rss(int, int, float) const {} };
struct EpiSgu { static constexpr bool RSS = false; bf16_t* GUOA; const float* g_sgu; const float* b_s; int chunk, g;
  DEVI float operator()(int row, int col, const float (&v)[4]) const { const int token = chunk * 128 + row, ch = g * 128 + col; const float bias = b_s[g * 128 + row];
    bf16_t* ptr = GUOA + (size_t)token * 1024 + ch; const u32x2 gu = *(const u32x2*)ptr;
    st4bf(ptr, lo2f(gu[0]) * (g_sgu[ch] * v[0] + bias), hi2f(gu[0]) * (g_sgu[ch + 1] * v[1] + bias), lo2f(gu[1]) * (g_sgu[ch + 2] * v[2] + bias), hi2f(gu[1]) * (g_sgu[ch + 3] * v[3] + bias));
    return 0.f; }
  DEVI void rss(int, int, float) const {} };
struct EpiGate { static constexpr bool RSS = false; bf16_t* G;
  DEVI float operator()(int row, int col, const float (&v)[4]) const { st4bf(G + (size_t)row * 2048 + col, sigmoidf_(v[0]), sigmoidf_(v[1]), sigmoidf_(v[2]), sigmoidf_(v[3])); return 0.f; }
  DEVI void rss(int, int, float) const {} };
template <bool SECOND> struct EpiMerge { static constexpr bool RSS = false; bf16_t* M; const bf16_t* G;
  DEVI float operator()(int row, int col, const float (&v)[4]) const { const u32x2 g = *(const u32x2*)(G + (size_t)row * 2048 + (SECOND ? 1024 : 0) + col);
    float o0 = lo2f(g[0]) * v[0], o1 = hi2f(g[0]) * v[1], o2 = lo2f(g[1]) * v[2], o3 = hi2f(g[1]) * v[3];
    bf16_t* ptr = M + (size_t)row * 1024 + col;
    if (SECOND) { const u32x2 m = *(const u32x2*)ptr; o0 += lo2f(m[0]); o1 += hi2f(m[0]); o2 += lo2f(m[1]); o3 += hi2f(m[1]); }
    st4bf(ptr, o0, o1, o2, o3); return 0.f; }
  DEVI void rss(int, int, float) const {} };
struct EpiO { static constexpr bool RSS = true; bf16_t* Y; float* rssy;
  DEVI float operator()(int row, int col, const float (&v)[4]) const { st4bf(Y + (size_t)row * 1024 + col, v[0], v[1], v[2], v[3]); return v[0] * v[0] + v[1] * v[1] + v[2] * v[2] + v[3] * v[3]; }
  DEVI void rss(int row, int col, float s) const { rssy[row * 16 + (col >> 6)] = s; } };
struct EpiPq { static constexpr bool RSS = false; bf16_t* QP;
  DEVI float operator()(int row, int col, const float (&v)[4]) const { st4bf(QP + (size_t)row * 2048 + col, v[0], v[1], v[2], v[3]); return 0.f; }
  DEVI void rss(int, int, float) const {} };

DEVI void ph_inproj(const Params& p, char* smem) {
  char* ws = p.ws;
  EpiIn epi{(bf16_t*)(ws + O_RB), (bf16_t*)(ws + O_RC), (bf16_t*)(ws + O_CQ), (bf16_t*)(ws + O_CKV), (bf16_t*)(ws + O_KR), (float*)(ws + O_RSSV), (float*)(ws + O_RSSQ), (float*)(ws + O_RSSKV)};
  const bf16_t* HX = (const bf16_t*)(ws + O_RA); const bf16_t* W = (const bf16_t*)(ws + O_WIN);
  for (int i = blockIdx.x; i < 1284; i += gridDim.x) {
    int mt, nt; if (i < 1280) { mt = i / 20; nt = i % 20; } else { mt = 64 + ((i - 1280) >> 1); nt = 18 + ((i - 1280) & 1); }
    gemm_tile<256, false>(HX + (size_t)mt * 256 * 1024, 1024, W + (size_t)nt * 128 * 1024, 1024, 1024, mt * 256, nt * 128, epi, nullptr, smem);
  }
}
DEVI void rope_kr(const Params& p) {
  bf16_t* KR = (bf16_t*)(p.ws + O_KR); const float* rope = (const float*)(p.ws + O_ROPE);
  for (int i = blockIdx.x * NTHR + threadIdx.x; i < NTOK * 32; i += gridDim.x * NTHR) {
    const int tok = i >> 5, j = i & 15, which = (i >> 4) & 1, pos = tok & 8191, pp = which ? (pos & 63) : (pos >> 6);
    const float cs = rope[(pp * 16 + j) * 2], sn = rope[(pp * 16 + j) * 2 + 1];
    bf16_t* r = KR + (size_t)keyrow(tok) * 64 + which * 32 + j;
    const float x1 = bf2f(r[0]), x2 = bf2f(r[16]);
    r[0] = f2bf(x1 * cs - x2 * sn); r[16] = f2bf(x1 * sn + x2 * cs);
  }
}
DEVI void ph_mid(const Params& p, char* smem) {
  char* ws = p.ws;
  { EpiQ epi{(bf16_t*)(ws + O_RQ), (const float*)(ws + O_RSSQ)};
    const bf16_t* A = (const bf16_t*)(ws + O_CQ); const bf16_t* W = (const bf16_t*)(ws + O_WUQ);
    for (int i = blockIdx.x; i < 64 * 12; i += gridDim.x) { const int mt = i / 12, nt = i % 12;
      gemm_tile<256, false>(A + (size_t)mt * 256 * 256, 256, W + (size_t)nt * 128 * 256, 256, 256, mt * 256, nt * 128, epi, nullptr, smem); } }
  { EpiKV epi{(bf16_t*)(ws + O_RKV), (const float*)(ws + O_RSSKV)};
    const bf16_t* A = (const bf16_t*)(ws + O_CKV); const bf16_t* W = (const bf16_t*)(ws + O_WUKV);
    for (int i = blockIdx.x; i < 66 * 16; i += gridDim.x) { const int mt = i / 16, nt = i % 16;
      gemm_tile<256, false>(A + (size_t)mt * 256 * 128, 128, W + (size_t)nt * 128 * 128, 128, 128, mt * 256, nt * 128, epi, nullptr, smem); } }
  { const bf16_t* WS = (const bf16_t*)(ws + O_WS); const bf16_t* GVT = (const bf16_t*)(ws + O_RC);
    float* ksc = (float*)(smem + LDS_BYTES - 512); const float* rssv = (const float*)(ws + O_RSSV);
    for (int i = blockIdx.x; i < 1024; i += gridDim.x) { const int chunk = i >> 3, g = i & 7;
      __syncthreads();
      if (threadIdx.x < 128) { const float* pr = rssv + (size_t)(chunk * 128 + threadIdx.x) * 16; float t = 0.f;
#pragma unroll
        for (int j = 0; j < 16; ++j) t += pr[j];
        ksc[threadIdx.x] = rsqrtf(t * (1.f / 1024.f) + EPS); }
      __syncthreads();
      EpiSgu epi{(bf16_t*)(ws + O_RB), p.g_sgu, p.b_s, chunk, g};
      gemm_tile<128, false>(WS + (size_t)g * 16384, 128, GVT + ((size_t)chunk * 1024 + g * 128) * 128, 128, 128, 0, 0, epi, ksc, smem); } }
  rope_kr(p);
}
DEVI void ph_gates(const Params& p, char* smem) {
  char* ws = p.ws; EpiGate epi{(bf16_t*)(ws + O_RKV)};
  const bf16_t* HX = (const bf16_t*)(ws + O_RA); const bf16_t* W = (const bf16_t*)(ws + O_WIN) + (size_t)NPRE * 1024;
  for (int i = blockIdx.x; i < 64 * 16; i += gridDim.x) { const int mt = i / 16, nt = i % 16;
    gemm_tile<256, false>(HX + (size_t)mt * 256 * 1024, 1024, W + (size_t)nt * 128 * 1024, 1024, 1024, mt * 256, nt * 128, epi, nullptr, smem); }
}
DEVI void ph_merge(const Params& p, char* smem) {
  char* ws = p.ws; bf16_t* M = (bf16_t*)(ws + O_RC); const bf16_t* G = (const bf16_t*)(ws + O_RKV);
  EpiMerge<false> e1{M, G}; EpiMerge<true> e2{M, G};
  const bf16_t* OA = (const bf16_t*)(ws + O_RB); const bf16_t* OB = (const bf16_t*)(ws + O_RQ);
  const bf16_t* WA = (const bf16_t*)(ws + O_WPA); const bf16_t* WB = (const bf16_t*)(ws + O_WPB);
  for (int i = blockIdx.x; i < 64 * 8; i += gridDim.x) { const int mt = i / 8, nt = i % 8;
    gemm_tile<256, false>(OA + (size_t)mt * 256 * 1024, 1024, WA + (size_t)nt * 128 * 1024, 1024, 1024, mt * 256, nt * 128, e1, nullptr, smem);
    gemm_tile<256, true>(OB + (size_t)mt * 256 * 1536, 1536, WB + (size_t)nt * 128 * 1024, 1024, 1024, mt * 256, nt * 128, e2, nullptr, smem); }
}
DEVI void ph_wo(const Params& p, char* smem) {
  char* ws = p.ws; EpiO epi{(bf16_t*)(ws + O_RA), (float*)(ws + O_RSSY)};
  const bf16_t* M = (const bf16_t*)(ws + O_RC); const bf16_t* W = (const bf16_t*)(ws + O_WO);
  for (int i = blockIdx.x; i < 64 * 8; i += gridDim.x) { const int mt = i / 8, nt = i % 8;
    gemm_tile<256, false>(M + (size_t)mt * 256 * 1024, 1024, W + (size_t)nt * 128 * 1024, 1024, 1024, mt * 256, nt * 128, epi, nullptr, smem); }
}
DEVI void ph_wpq(const Params& p, char* smem) {
  char* ws = p.ws; EpiPq epi{(bf16_t*)(ws + O_RKV)};
  const bf16_t* A = (const bf16_t*)(ws + O_RB); const bf16_t* W = (const bf16_t*)(ws + O_WPQ);
  for (int i = blockIdx.x; i < 64 * 16; i += gridDim.x) { const int mt = i / 16, nt = i % 16;
    gemm_tile<256, false>(A + (size_t)mt * 256 * 1024, 1024, W + (size_t)nt * 128 * 1024, 1024, 1024, mt * 256, nt * 128, epi, nullptr, smem); }
  convert_table(p.v_exp, (bf16_t*)(ws + O_RA));
}

DEVI void attn_naive(const Params& p, char* smem) {
  const int tid = threadIdx.x, wave = tid >> 6, lane = tid & 63;
  float* qs = (float*)smem + wave * 256; float* ps = qs + 192;
  bf16_t* Q = (bf16_t*)(p.ws + O_RQ); const bf16_t* KV = (const bf16_t*)(p.ws + O_RKV); const bf16_t* KR = (const bf16_t*)(p.ws + O_KR);
  const float* rope = (const float*)(p.ws + O_ROPE);
  const float scale = 0.07216878364870322f;
  for (int base = blockIdx.x * NWAVE; base < NB * 8 * SEQ; base += gridDim.x * NWAVE) {
    const int it = base + wave, bh = it >> 13, qi = it & 8191, b = bh >> 3, h = bh & 7;
    const size_t qoff = (size_t)(b * SEQ + qi) * 1536 + h * 192;
    __syncthreads();
    for (int d = lane; d < 192; d += 64) qs[d] = bf2f(Q[qoff + d]);
    __syncthreads();
    if (lane < 32) { const int j = lane & 15, which = lane >> 4, pp = which ? (qi & 63) : (qi >> 6);
      const float cs = rope[(pp * 16 + j) * 2], sn = rope[(pp * 16 + j) * 2 + 1]; const int d1 = 128 + which * 32 + j, d2 = d1 + 16;
      const float x1 = qs[d1], x2 = qs[d2]; qs[d1] = x1 * cs - x2 * sn; qs[d2] = x1 * sn + x2 * cs; }
    __syncthreads();
    float m = -1e30f, l = 0.f, o0 = 0.f, o1 = 0.f;
    for (int k0 = 0; k0 < NKEY; k0 += 64) {
      const size_t kr = (size_t)(b * NKEY + k0 + lane);
      const bf16_t* kn = KV + kr * 2048 + h * 256; const bf16_t* krp = KR + kr * 64;
      float s = 0.f;
#pragma unroll 4
      for (int d8 = 0; d8 < 16; ++d8) { float kf[8]; unpack8(*(const u32x4*)(kn + d8 * 8), kf); const float4 q0 = *(const float4*)(qs + d8 * 8), q1 = *(const float4*)(qs + d8 * 8 + 4);
        s += q0.x * kf[0] + q0.y * kf[1] + q0.z * kf[2] + q0.w * kf[3] + q1.x * kf[4] + q1.y * kf[5] + q1.z * kf[6] + q1.w * kf[7]; }
#pragma unroll 4
      for (int d8 = 0; d8 < 8; ++d8) { float kf[8]; unpack8(*(const u32x4*)(krp + d8 * 8), kf); const float4 q0 = *(const float4*)(qs + 128 + d8 * 8), q1 = *(const float4*)(qs + 128 + d8 * 8 + 4);
        s += q0.x * kf[0] + q0.y * kf[1] + q0.z * kf[2] + q0.w * kf[3] + q1.x * kf[4] + q1.y * kf[5] + q1.z * kf[6] + q1.w * kf[7]; }
      s *= scale;
      const float mn = fmaxf(m, wave_max(s)), al = __expf(m - mn), pe = __expf(s - mn);
      l = l * al + wave_sum(pe); m = mn; o0 *= al; o1 *= al;
      __syncthreads();
      ps[lane] = pe;
      __syncthreads();
      const bf16_t* vp = KV + (size_t)(b * NKEY + k0) * 2048 + h * 256 + 128 + lane * 2;
#pragma unroll 8
      for (int kk = 0; kk < 64; ++kk) { const unsigned w = *(const unsigned*)(vp + (size_t)kk * 2048); const float pk = ps[kk]; o0 += pk * lo2f(w); o1 += pk * hi2f(w); }
    }
    const float invL = 1.f / l;
    *(unsigned*)(Q + qoff + lane * 2) = pack2(o0 * invL, o1 * invL);
  }
}

namespace at {
constexpr int QBLK = 32, KVBLK = 64;
constexpr float SCALE = 0.07216878364870322f;
constexpr float THR = 8.f;
constexpr int SHM_V = KVBLK * 128 * 2, SHM_K = KVBLK * 192 * 2;
using s16x4 = __attribute__((ext_vector_type(4))) short;
#define KSWZ(row, colB) ((row) * 384 + ((colB) ^ (((row) & 7) << 4)))
#define SBAR() __builtin_amdgcn_sched_barrier(0)
DEVI int crow(int r, int hi) { return (r & 3) + 8 * (r >> 2) + 4 * hi; }
DEVI unsigned cvtpk(float lo, float hi) { unsigned r; asm volatile("v_cvt_pk_bf16_f32 %0, %1, %2" : "=v"(r) : "v"(lo), "v"(hi)); return r; }
DEVI void partialSM(f32x16& p0, f32x16& p1, float& m_reg, float& mn, float& alpha) {
  constexpr float C = SCALE * 1.4426950408889634f;
  float pmax = p0[0];
#pragma unroll
  for (int r = 1; r < 16; ++r) pmax = fmaxf(pmax, p0[r]);
#pragma unroll
  for (int r = 0; r < 16; ++r) pmax = fmaxf(pmax, p1[r]);
  { auto rr = __builtin_amdgcn_permlane32_swap(__float_as_uint(pmax), __float_as_uint(pmax), false, false);
    pmax = fmaxf(__uint_as_float(rr[0]), __uint_as_float(rr[1])); }
  if (__builtin_expect(__all(pmax - m_reg <= THR / SCALE), 1)) { mn = m_reg; alpha = 1.f; }
  else { mn = fmaxf(m_reg, pmax); alpha = __builtin_amdgcn_exp2f((m_reg - mn) * C); m_reg = mn; }
  const float mnC = -mn * C;
#pragma unroll
  for (int r = 0; r < 16; ++r) p0[r] = fmaf(p0[r], C, mnC);
#pragma unroll
  for (int r = 0; r < 16; ++r) p1[r] = fmaf(p1[r], C, mnC);
#pragma unroll
  for (int r = 0; r < 16; ++r) p0[r] = __builtin_amdgcn_exp2f(p0[r]);
}
DEVI void finishSM(f32x16& p0, f32x16& p1, float alpha, float& l_reg, bf16x8& pa0, bf16x8& pa1, bf16x8& pa2, bf16x8& pa3) {
#pragma unroll
  for (int r = 0; r < 16; ++r) p1[r] = __builtin_amdgcn_exp2f(p1[r]);
  float ps = 0;
#pragma unroll
  for (int r = 0; r < 16; ++r) ps += p0[r];
#pragma unroll
  for (int r = 0; r < 16; ++r) ps += p1[r];
  { auto rr = __builtin_amdgcn_permlane32_swap(__float_as_uint(ps), __float_as_uint(ps), false, false);
    ps = __uint_as_float(rr[0]) + __uint_as_float(rr[1]); }
  l_reg = l_reg * alpha + ps;
#define PK4(P, BASE, OUT) do { unsigned a0 = cvtpk(P[BASE + 0], P[BASE + 1]), a1 = cvtpk(P[BASE + 2], P[BASE + 3]);   \
    unsigned b0 = cvtpk(P[BASE + 4], P[BASE + 5]), b1 = cvtpk(P[BASE + 6], P[BASE + 7]);                              \
    auto r0 = __builtin_amdgcn_permlane32_swap(a0, b0, false, false); auto r1 = __builtin_amdgcn_permlane32_swap(a1, b1, false, false); \
    u32x4 w = {r0[0], r1[0], r0[1], r1[1]}; OUT = *reinterpret_cast<bf16x8*>(&w); } while (0)
  PK4(p0, 0, pa0); PK4(p0, 8, pa1); PK4(p1, 0, pa2); PK4(p1, 8, pa3);
#undef PK4
}
DEVI void qkt(f32x16& p0, f32x16& p1, const char* Ks, const bf16x8* qr, const char* qrl, int r32, int hi) {
  p0 = f32x16{}; p1 = f32x16{};
#pragma unroll
  for (int d0 = 0; d0 < 12; ++d0) { const int cb = (d0 * 16 + hi * 8) * 2;
    const bf16x8 b0 = *reinterpret_cast<const bf16x8*>(Ks + KSWZ(r32, cb));
    const bf16x8 b1 = *reinterpret_cast<const bf16x8*>(Ks + KSWZ(32 + r32, cb));
    const bf16x8 q = d0 < 8 ? qr[d0 < 8 ? d0 : 0] : *reinterpret_cast<const bf16x8*>(qrl + (d0 - 8) * 1024);
    p0 = __builtin_amdgcn_mfma_f32_32x32x16_bf16(b0, q, p0, 0, 0, 0);
    p1 = __builtin_amdgcn_mfma_f32_32x32x16_bf16(b1, q, p1, 0, 0, 0); }
}
DEVI int v_st(int k, int c) { const int kk = (k & ~0xC) | ((k & 4) << 1) | ((k & 8) >> 1); return ((kk >> 3) * 4 + (c >> 5)) * 512 + ((kk & 7) * 32 + (c & 31)) * 2; }
DEVI int v_rd_base(int lane) { return ((lane & 3) << 3) | (((lane >> 2) & 3) << 6) | (((lane >> 4) & 1) << 5) | (((lane >> 5) & 1) << 8); }
constexpr int v_rd_off(int d0, int ks, int half) { return d0 * 512 + ks * 4096 + half * 2048; }
template <int OFF> DEVI s16x4 tr_read(int vb) { s16x4 r; asm volatile("ds_read_b64_tr_b16 %0, %1 offset:%2" : "=&v"(r) : "v"(vb), "i"(OFF) : "memory"); return r; }
template <int D0> DEVI void pv_one(f32x16& od, int vb, bf16x8 pa0, bf16x8 pa1, bf16x8 pa2, bf16x8 pa3) {
  const s16x4 l0 = tr_read<v_rd_off(D0, 0, 0)>(vb), h0 = tr_read<v_rd_off(D0, 0, 1)>(vb), l1 = tr_read<v_rd_off(D0, 1, 0)>(vb), h1 = tr_read<v_rd_off(D0, 1, 1)>(vb);
  const s16x4 l2 = tr_read<v_rd_off(D0, 2, 0)>(vb), h2 = tr_read<v_rd_off(D0, 2, 1)>(vb), l3 = tr_read<v_rd_off(D0, 3, 0)>(vb), h3 = tr_read<v_rd_off(D0, 3, 1)>(vb);
  asm volatile("s_waitcnt lgkmcnt(0)" ::: "memory"); SBAR();
#define PK(L, H) (bf16x8){L[0], L[1], L[2], L[3], H[0], H[1], H[2], H[3]}
  od = __builtin_amdgcn_mfma_f32_32x32x16_bf16(pa0, PK(l0, h0), od, 0, 0, 0);
  od = __builtin_amdgcn_mfma_f32_32x32x16_bf16(pa1, PK(l1, h1), od, 0, 0, 0);
  od = __builtin_amdgcn_mfma_f32_32x32x16_bf16(pa2, PK(l2, h2), od, 0, 0, 0);
  od = __builtin_amdgcn_mfma_f32_32x32x16_bf16(pa3, PK(l3, h3), od, 0, 0, 0);
#undef PK
}
DEVI void pv_d0(f32x16* o, int vb, bf16x8 pa0, bf16x8 pa1, bf16x8 pa2, bf16x8 pa3) {
  pv_one<0>(o[0], vb, pa0, pa1, pa2, pa3); pv_one<1>(o[1], vb, pa0, pa1, pa2, pa3); pv_one<2>(o[2], vb, pa0, pa1, pa2, pa3); pv_one<3>(o[3], vb, pa0, pa1, pa2, pa3);
}
DEVI void rope_frag(bf16x8& f1, bf16x8& f2, const float* cs) {
  u32x4 w1 = *reinterpret_cast<u32x4*>(&f1), w2 = *reinterpret_cast<u32x4*>(&f2); float a[8], b[8]; unpack8(w1, a); unpack8(w2, b);
  float c[8], s[8];
#pragma unroll
  for (int q = 0; q < 4; ++q) { const float4 t = *(const float4*)(cs + q * 4); c[q * 2] = t.x; s[q * 2] = t.y; c[q * 2 + 1] = t.z; s[q * 2 + 1] = t.w; }
  float x[8], y[8];
#pragma unroll
  for (int j = 0; j < 8; ++j) { x[j] = a[j] * c[j] - b[j] * s[j]; y[j] = a[j] * s[j] + b[j] * c[j]; }
  w1 = (u32x4){cvtpk(x[0], x[1]), cvtpk(x[2], x[3]), cvtpk(x[4], x[5]), cvtpk(x[6], x[7])};
  w2 = (u32x4){cvtpk(y[0], y[1]), cvtpk(y[2], y[3]), cvtpk(y[4], y[5]), cvtpk(y[6], y[7])};
  f1 = *reinterpret_cast<bf16x8*>(&w1); f2 = *reinterpret_cast<bf16x8*>(&w2);
}
DEVI void attn_item(bf16_t* __restrict__ Qb, const bf16_t* __restrict__ Kn, const bf16_t* __restrict__ Vh, const bf16_t* __restrict__ Kr, const float* __restrict__ rope, int pos0, char* lds) {
  const int tid = threadIdx.x, wid = tid >> 6, lane = tid & 63, r32 = lane & 31, hi = lane >> 5;
  char* V_lds = lds; char* K_lds = lds + 2 * SHM_V;
  float* wsl = (float*)(lds + 2 * SHM_V + 2 * SHM_K) + wid * 64; float* li_l = wsl; float* al_l = wsl + 32;
  char* qrl = lds + 2 * SHM_V + 2 * SHM_K + 2048 + wid * 4096 + lane * 16;
  float m_reg = -1e30f, l_reg = 0; f32x16 o[4] = {}; bf16x8 qr[8];
  bf16_t* Qw = Qb + (size_t)(wid * QBLK + r32) * 1536 + hi * 8;
#pragma unroll
  for (int d0 = 0; d0 < 8; ++d0) qr[d0] = *reinterpret_cast<const bf16x8*>(Qw + d0 * 16);
  { bf16x8 q8 = *reinterpret_cast<const bf16x8*>(Qw + 128), q9 = *reinterpret_cast<const bf16x8*>(Qw + 144), q10 = *reinterpret_cast<const bf16x8*>(Qw + 160), q11 = *reinterpret_cast<const bf16x8*>(Qw + 176);
    const int pos = pos0 + wid * QBLK + r32;
    rope_frag(q8, q9, rope + ((pos >> 6) * 16 + hi * 8) * 2); rope_frag(q10, q11, rope + ((pos & 63) * 16 + hi * 8) * 2);
    *reinterpret_cast<bf16x8*>(qrl) = q8; *reinterpret_cast<bf16x8*>(qrl + 1024) = q9; *reinterpret_cast<bf16x8*>(qrl + 2048) = q10; *reinterpret_cast<bf16x8*>(qrl + 3072) = q11; }
  const int sr = tid >> 4, sc = (tid & 15) * 8, vst0 = v_st(sr, sc), vst1 = v_st(32 + sr, sc);
  const int kst0 = KSWZ(sr, sc * 2), kst1 = KSWZ(32 + sr, sc * 2), kst2 = KSWZ(tid >> 3, 256 + (tid & 7) * 16);
  const int goff = sr * 2048 + sc, goffr = (tid >> 3) * 64 + (tid & 7) * 8;
  const int vb0 = (int)(uintptr_t)V_lds + v_rd_base(lane);
  u32x4 sv0, sv1, sk0, sk1, sk2;
#define SLOAD(k0) do { const bf16_t* vp = Vh + (size_t)(k0) * 2048 + goff; const bf16_t* kp = Kn + (size_t)(k0) * 2048 + goff; \
    sv0 = *(const u32x4*)vp; sv1 = *(const u32x4*)(vp + 32 * 2048); sk0 = *(const u32x4*)kp; sk1 = *(const u32x4*)(kp + 32 * 2048); \
    sk2 = *(const u32x4*)(Kr + (size_t)(k0) * 64 + goffr); } while (0)
#define SWRITE(b) do { *(u32x4*)(V_lds + (b) * SHM_V + vst0) = sv0; *(u32x4*)(V_lds + (b) * SHM_V + vst1) = sv1; \
    *(u32x4*)(K_lds + (b) * SHM_K + kst0) = sk0; *(u32x4*)(K_lds + (b) * SHM_K + kst1) = sk1; *(u32x4*)(K_lds + (b) * SHM_K + kst2) = sk2; } while (0)
#define SWAIT() asm volatile("s_waitcnt vmcnt(0)" ::: "memory")
#define RESC(a) do { if (__any((a) < 1.f)) { if (hi == 0) al_l[r32] = (a); asm volatile("s_waitcnt lgkmcnt(0)" ::: "memory"); \
    _Pragma("unroll") for (int d = 0; d < 4; ++d) _Pragma("unroll") for (int r = 0; r < 16; ++r) o[d][r] *= al_l[crow(r, hi)]; } } while (0)
  f32x16 pA0, pA1, pB0, pB1; float mnA, mnB, alA, alB; bf16x8 pa0, pa1, pa2, pa3; constexpr int NT = NKEY / KVBLK;
  SLOAD(0); SWAIT(); SWRITE(0); __syncthreads();
  qkt(pA0, pA1, K_lds, qr, qrl, r32, hi); partialSM(pA0, pA1, m_reg, mnA, alA);
  SLOAD(KVBLK);
  SWAIT(); SWRITE(1); __syncthreads();
  for (int j = 1; j + 1 < NT; j += 2) {
    SBAR(); qkt(pB0, pB1, K_lds + SHM_K, qr, qrl, r32, hi);
    finishSM(pA0, pA1, alA, l_reg, pa0, pa1, pa2, pa3); SBAR();
    SLOAD((j + 1) * KVBLK); SBAR();
    pv_d0(o, vb0, pa0, pa1, pa2, pa3); partialSM(pB0, pB1, m_reg, mnB, alB);
    __syncthreads(); SWAIT(); SWRITE(0);
    RESC(alB); __syncthreads();
    SBAR(); qkt(pA0, pA1, K_lds, qr, qrl, r32, hi);
    finishSM(pB0, pB1, alB, l_reg, pa0, pa1, pa2, pa3); SBAR();
    SLOAD((j + 2) * KVBLK); SBAR();
    pv_d0(o, vb0 + SHM_V, pa0, pa1, pa2, pa3); partialSM(pA0, pA1, m_reg, mnA, alA);
    __syncthreads(); SWAIT(); SWRITE(1);
    RESC(alA); __syncthreads();
  }
  SBAR(); qkt(pB0, pB1, K_lds + SHM_K, qr, qrl, r32, hi);
  finishSM(pA0, pA1, alA, l_reg, pa0, pa1, pa2, pa3); SBAR();
  pv_d0(o, vb0, pa0, pa1, pa2, pa3); partialSM(pB0, pB1, m_reg, mnB, alB);
  __syncthreads(); RESC(alB);
  finishSM(pB0, pB1, alB, l_reg, pa0, pa1, pa2, pa3); SBAR();
  pv_d0(o, vb0 + SHM_V, pa0, pa1, pa2, pa3);
  if (hi == 0) li_l[r32] = l_reg; asm volatile("s_waitcnt lgkmcnt(0)" ::: "memory");
  float rli[16];
#pragma unroll
  for (int r = 0; r < 16; ++r) rli[r] = __builtin_amdgcn_rcpf(li_l[crow(r, hi)]);
  bf16_t* Ow = Qb + (size_t)(wid * QBLK) * 1536;
#pragma unroll
  for (int r = 0; r < 16; ++r) { const int orow = crow(r, hi);
#pragma unroll
    for (int d0 = 0; d0 < 4; ++d0) Ow[(size_t)orow * 1536 + d0 * 32 + r32] = f2bf(o[d0][r] * rli[r]); }
  __syncthreads();
#undef SLOAD
#undef SWRITE
#undef SWAIT
#undef RESC
}
}
DEVI void attn_mfma(const Params& p, char* smem) {
  bf16_t* Q = (bf16_t*)(p.ws + O_RQ); const bf16_t* KV = (const bf16_t*)(p.ws + O_RKV); const bf16_t* KR = (const bf16_t*)(p.ws + O_KR);
  const float* rope = (const float*)(p.ws + O_ROPE);
  for (int it = blockIdx.x; it < NB * 8 * (SEQ / 256); it += gridDim.x) {
    const int bh = (it >> 8) * 8 + (it & 7), qb = (it & 255) >> 3, b = bh >> 3, h = bh & 7;
    at::attn_item(Q + (size_t)(b * SEQ + qb * 256) * 1536 + h * 192, KV + (size_t)b * NKEY * 2048 + h * 256, KV + (size_t)b * NKEY * 2048 + h * 256 + 128,
                  KR + (size_t)b * NKEY * 64, rope, qb * 256, smem);
  }
}
#if ATTN_MFMA
DEVI void ph_attn(const Params& p, char* smem) { attn_mfma(p, smem); }
#else
DEVI void ph_attn(const Params& p, char* smem) { attn_naive(p, smem); }
#endif

DEVI void ph_rows(const Params& p, char* smem) {
  const int tid = threadIdx.x, wave = tid >> 6, lane = tid & 63;
  const float* MOD = (const float*)(p.ws + O_MOD); const bf16_t* Y = (const bf16_t*)(p.ws + O_RA); const float* rssy = (const float*)(p.ws + O_RSSY);
  bf16_t* HX2 = (bf16_t*)(p.ws + O_RB);
  for (int row = blockIdx.x * NWAVE + wave; row < NTOK; row += gridDim.x * NWAVE) {
    const int b = row >> 13; const float* md = MOD + b * 6144;
    float ty = 0.f; { const float* pr = rssy + (size_t)row * 16;
#pragma unroll
      for (int j = 0; j < 16; ++j) ty += pr[j]; }
    const float ry = rsqrtf(ty * (1.f / 1024.f) + EPS);
    float x1[16]; float ss = 0.f;
#pragma unroll
    for (int i = 0; i < 4; ++i) { const int c = i * 256 + lane * 4; const float4 xv = *(const float4*)(p.x + (size_t)row * 1024 + c); const u32x2 yv = *(const u32x2*)(Y + (size_t)row * 1024 + c);
      const float4 gp = *(const float4*)(p.g_post1 + c), gt = *(const float4*)(md + 2048 + c);
      x1[i * 4 + 0] = xv.x + gt.x * (lo2f(yv[0]) * ry * gp.x); x1[i * 4 + 1] = xv.y + gt.y * (hi2f(yv[0]) * ry * gp.y);
      x1[i * 4 + 2] = xv.z + gt.z * (lo2f(yv[1]) * ry * gp.z); x1[i * 4 + 3] = xv.w + gt.w * (hi2f(yv[1]) * ry * gp.w);
#pragma unroll
      for (int j = 0; j < 4; ++j) ss += x1[i * 4 + j] * x1[i * 4 + j];
      *(float4*)(p.out + (size_t)row * 1024 + c) = make_float4(x1[i * 4], x1[i * 4 + 1], x1[i * 4 + 2], x1[i * 4 + 3]); }
    ss = wave_sum(ss); const float r2 = rsqrtf(ss * (1.f / 1024.f) + EPS);
#pragma unroll
    for (int i = 0; i < 4; ++i) { const int c = i * 256 + lane * 4; const float4 g2 = *(const float4*)(p.g_pre2 + c), sc = *(const float4*)(md + 4096 + c), sh = *(const float4*)(md + 3072 + c);
      st4bf(HX2 + (size_t)row * 1024 + c, x1[i * 4] * r2 * g2.x * (1.f + sc.x) + sh.x, x1[i * 4 + 1] * r2 * g2.y * (1.f + sc.y) + sh.y,
            x1[i * 4 + 2] * r2 * g2.z * (1.f + sc.z) + sh.z, x1[i * 4 + 3] * r2 * g2.w * (1.f + sc.w) + sh.w); }
  }
  convert_table(p.u_exp, (bf16_t*)(p.ws + O_RC));
}

DEVI void topk_naive(const Params& p, char* smem) {
  const int tid = threadIdx.x, wave = tid >> 6, lane = tid & 63;
  float* wl = (float*)smem + wave * 512; int* wi = (int*)wl;
  const bf16_t* QP = (const bf16_t*)(p.ws + O_RKV); const bf16_t* K1 = (const bf16_t*)(p.ws + O_K1); const bf16_t* K2 = (const bf16_t*)(p.ws + O_K2);
  int* IDX = (int*)(p.ws + O_RQ); float* GW = (float*)(p.ws + O_RQ + (size_t)NTOK * 128 * 4);
  for (int base = blockIdx.x * NWAVE; base < NTOK * 8; base += gridDim.x * NWAVE) {
    const int it = base + wave, token = it >> 3, h = it & 7;
    __syncthreads();
    const bf16_t* q = QP + (size_t)token * 2048 + h * 256;
    for (int d = lane; d < 256; d += 64) wl[d] = bf2f(q[d]);
    __syncthreads();
    float s[4] = {0.f, 0.f, 0.f, 0.f};
#pragma unroll 2
    for (int d8 = 0; d8 < 16; ++d8) {
      const float4 qa0 = *(const float4*)(wl + d8 * 8), qa1 = *(const float4*)(wl + d8 * 8 + 4), qb0 = *(const float4*)(wl + 128 + d8 * 8), qb1 = *(const float4*)(wl + 128 + d8 * 8 + 4);
#pragma unroll
      for (int w = 0; w < 4; ++w) { const int key = lane + (w & 1) * 64; const bf16_t* kp = (w < 2 ? K1 : K2) + key * 128;
        float kf[8]; unpack8(*(const u32x4*)(kp + d8 * 8), kf); const float4 q0 = w < 2 ? qa0 : qb0, q1 = w < 2 ? qa1 : qb1;
        s[w] += q0.x * kf[0] + q0.y * kf[1] + q0.z * kf[2] + q0.w * kf[3] + q1.x * kf[4] + q1.y * kf[5] + q1.z * kf[6] + q1.w * kf[7]; }
    }
#pragma unroll
    for (int half = 0; half < 2; ++half) { float a0 = s[half * 2], a1 = s[half * 2 + 1];
#pragma unroll 1
      for (int r = 0; r < 16; ++r) { float v; int i; if (a0 >= a1) { v = a0; i = lane; } else { v = a1; i = lane + 64; }
        for (int o = 32; o > 0; o >>= 1) { const float ov = __shfl_xor(v, o); const int oi = __shfl_xor(i, o); if (ov > v || (ov == v && oi < i)) { v = ov; i = oi; } }
        if (i == lane) a0 = -3.0e38f; else if (i == lane + 64) a1 = -3.0e38f;
        if (lane == 0) { wl[256 + half * 32 + r] = v; wi[256 + half * 32 + 16 + r] = i; } } }
    __syncthreads();
    float cv[4]; int ci[4];
#pragma unroll
    for (int j = 0; j < 4; ++j) { const int cidx = lane * 4 + j, i = cidx >> 4, jj = cidx & 15; cv[j] = wl[256 + i] + wl[256 + 32 + jj]; ci[j] = wi[256 + 16 + i] * 128 + wi[256 + 32 + 16 + jj]; }
    float myv = 0.f, vmax = 0.f; int myi = 0;
#pragma unroll 1
    for (int r = 0; r < 16; ++r) { float v = cv[0]; int pos = lane * 4, ei = ci[0];
#pragma unroll
      for (int j = 1; j < 4; ++j) if (cv[j] > v) { v = cv[j]; pos = lane * 4 + j; ei = ci[j]; }
      for (int o = 32; o > 0; o >>= 1) { const float ov = __shfl_xor(v, o); const int op = __shfl_xor(pos, o), oe = __shfl_xor(ei, o); if (ov > v || (ov == v && op < pos)) { v = ov; pos = op; ei = oe; } }
#pragma unroll
      for (int j = 0; j < 4; ++j) if (pos == lane * 4 + j) cv[j] = -3.0e38f;
      if (r == 0) vmax = v;
      if (lane == r) { myv = v; myi = ei; } }
    const float e = lane < 16 ? __expf(myv - vmax) : 0.f; const float sum = wave_sum(e);
    if (lane < 16) { IDX[(size_t)token * 128 + h * 16 + lane] = myi; GW[(size_t)token * 128 + h * 16 + lane] = e / sum; }
  }
}

namespace tk {
DEVI int f2sort(float f) { const int i = __float_as_int(f); return i ^ ((i >> 31) & 0x7fffffff); }
DEVI float sort2f(int s) { return __int_as_float(s ^ ((s >> 31) & 0x7fffffff)); }
DEVI void ce_desc(int& a, int& b) { const int hi = max(a, b), lo = min(a, b); a = hi; b = lo; }
DEVI void sort16_desc(int* a) {
#pragma unroll
  for (int lk = 1; lk <= 4; ++lk)
#pragma unroll
    for (int lj = lk - 1; lj >= 0; --lj)
#pragma unroll
      for (int i = 0; i < 16; ++i) { const int j = 1 << lj, k = 1 << lk, l = i ^ j;
        if (l > i) { const int hi = max(a[i], a[l]), lo = min(a[i], a[l]); if ((i & k) == 0) { a[i] = hi; a[l] = lo; } else { a[i] = lo; a[l] = hi; } } }
}
DEVI void bitonic_merge16_desc(int* a) {
#pragma unroll
  for (int lj = 3; lj >= 0; --lj)
#pragma unroll
    for (int i = 0; i < 16; ++i) { const int l = i ^ (1 << lj); if (l > i) ce_desc(a[i], a[l]); }
}
DEVI void merge_top16(int* a, const int* b) {
#pragma unroll
  for (int i = 0; i < 16; ++i) a[i] = max(a[i], b[15 - i]);
  bitonic_merge16_desc(a);
}
DEVI void half_top16(const bf16_t* __restrict__ qrow, const char* Kl, int r32, int hi, int* out) {
  bf16x8 qf[8];
#pragma unroll
  for (int d0 = 0; d0 < 8; ++d0) qf[d0] = *reinterpret_cast<const bf16x8*>(qrow + d0 * 16 + hi * 8);
  int a[64];
#pragma unroll
  for (int kt = 0; kt < 4; ++kt) { f32x16 acc = {};
    const int key = kt * 32 + r32;
#pragma unroll
    for (int d0 = 0; d0 < 8; ++d0) { const bf16x8 kf = *reinterpret_cast<const bf16x8*>(Kl + key * 256 + (((d0 * 2 + hi) ^ (key & 15)) << 4));
      acc = __builtin_amdgcn_mfma_f32_32x32x16_bf16(kf, qf[d0], acc, 0, 0, 0); }
#pragma unroll
    for (int r = 0; r < 16; ++r) { const int kidx = kt * 32 + (r & 3) + 8 * (r >> 2) + 4 * hi; a[kt * 16 + r] = (f2sort(acc[r]) & ~127) | (127 - kidx); } }
  sort16_desc(a); sort16_desc(a + 16); sort16_desc(a + 32); sort16_desc(a + 48);
  merge_top16(a, a + 16); merge_top16(a + 32, a + 48); merge_top16(a, a + 32);
  int L[16], H[16];
#pragma unroll
  for (int i = 0; i < 16; ++i) { auto rr = __builtin_amdgcn_permlane32_swap((unsigned)a[i], (unsigned)a[i], false, false); L[i] = (int)rr[0]; H[i] = (int)rr[1]; }
  merge_top16(L, H);
#pragma unroll
  for (int i = 0; i < 16; ++i) out[i] = L[i];
}
}
DEVI void topk_fast(const Params& p, char* smem) {
  const int tid = threadIdx.x, wave = tid >> 6, lane = tid & 63, r32 = lane & 31, hi = lane >> 5;
  const bf16_t* QP = (const bf16_t*)(p.ws + O_RKV);
  int* IDX = (int*)(p.ws + O_RQ); float* GW = (float*)(p.ws + O_RQ + (size_t)NTOK * 128 * 4);
  char* K1l = smem; char* K2l = smem + 32768; int* tab = (int*)(smem + 65536) + wave * (32 * 33);
  __syncthreads();
  { const bf16_t* K1 = (const bf16_t*)(p.ws + O_K1);
    for (int id = tid; id < 4096; id += NTHR) { const int key = id >> 4, c = id & 15; const u32x4 v = *(const u32x4*)(K1 + (size_t)key * 128 + c * 8);
      *(u32x4*)(smem + key * 256 + ((c ^ (key & 15)) << 4)) = v; } }
  __syncthreads();
  for (int item = blockIdx.x; item < NTOK * 8 / 256; item += gridDim.x) {
    const int row = item * 256 + wave * 32 + r32;
    const bf16_t* qrow = QP + (size_t)row * 256;
    int t1[16], t2[16];
    tk::half_top16(qrow, K1l, r32, hi, t1);
    tk::half_top16(qrow + 128, K2l, r32, hi, t2);
    float v1[16], v2[16];
#pragma unroll
    for (int i = 0; i < 16; ++i) { v1[i] = tk::sort2f(t1[i] & ~127); v2[i] = tk::sort2f(t2[i] & ~127); }
    if (hi == 0) {
#pragma unroll
      for (int i = 0; i < 16; ++i) { tab[r32 * 33 + i] = 127 - (t1[i] & 127); tab[r32 * 33 + 16 + i] = 127 - (t2[i] & 127); } }
#define CAND(i, j) ((tk::f2sort(v1[i] + v2[j]) & ~255) | (255 - ((i) * 16 + (j))))
    int g0[16], g1[16], g2[16];
#pragma unroll
    for (int j = 0; j < 16; ++j) g0[j] = CAND(0, j);
#pragma unroll
    for (int j = 0; j < 8; ++j) g1[j] = CAND(1, j);
#pragma unroll
    for (int j = 0; j < 5; ++j) g1[8 + j] = CAND(2, j);
#pragma unroll
    for (int j = 0; j < 3; ++j) g1[13 + j] = CAND(4, j);
#pragma unroll
    for (int j = 0; j < 4; ++j) g2[j] = CAND(3, j);
    g2[4] = CAND(5, 0); g2[5] = CAND(5, 1); g2[6] = CAND(6, 0); g2[7] = CAND(6, 1); g2[8] = CAND(7, 0); g2[9] = CAND(7, 1);
    g2[10] = CAND(8, 0); g2[11] = CAND(9, 0); g2[12] = CAND(10, 0); g2[13] = CAND(11, 0); g2[14] = CAND(12, 0); g2[15] = CAND(13, 0);
    tk::sort16_desc(g1); tk::sort16_desc(g2);
    tk::merge_top16(g0, g1); tk::merge_top16(g0, g2);
    { int x = CAND(14, 0);
#pragma unroll
      for (int i = 0; i < 16; ++i) { const int h = max(g0[i], x); x = min(g0[i], x); g0[i] = h; }
      x = CAND(15, 0);
#pragma unroll
      for (int i = 0; i < 16; ++i) { const int h = max(g0[i], x); x = min(g0[i], x); g0[i] = h; } }
#undef CAND
    asm volatile("s_waitcnt lgkmcnt(0)" ::: "memory");
    if (hi == 0) {
      int ex[16];
#pragma unroll
      for (int k = 0; k < 16; ++k) { const int pos = 255 - (g0[k] & 255); ex[k] = tab[r32 * 33 + (pos >> 4)] * 128 + tab[r32 * 33 + 16 + (pos & 15)]; }
      int* dst = IDX + (size_t)row * 16;
#pragma unroll
      for (int q = 0; q < 4; ++q) *(int4*)(dst + q * 4) = make_int4(ex[q * 4], ex[q * 4 + 1], ex[q * 4 + 2], ex[q * 4 + 3]);
    } else {
      float e[16]; const float vmax = tk::sort2f(g0[0] & ~255); float sum = 0.f;
#pragma unroll
      for (int k = 0; k < 16; ++k) { e[k] = __expf(tk::sort2f(g0[k] & ~255) - vmax); sum += e[k]; }
      const float inv = 1.f / sum; float* dst = GW + (size_t)row * 16;
#pragma unroll
      for (int q = 0; q < 4; ++q) *(float4*)(dst + q * 4) = make_float4(e[q * 4] * inv, e[q * 4 + 1] * inv, e[q * 4 + 2] * inv, e[q * 4 + 3] * inv);
    }
  }
}
#if TOPK_FAST
DEVI void ph_topk(const Params& p, char* smem) { topk_fast(p, smem); }
#else
DEVI void ph_topk(const Params& p, char* smem) { topk_naive(p, smem); }
#endif

DEVI void ph_gather(const Params& p, char* smem) {
  const int tid = threadIdx.x, wave = tid >> 6, lane = tid & 63;
  const bf16_t* HX2 = (const bf16_t*)(p.ws + O_RB); const bf16_t* UT = (const bf16_t*)(p.ws + O_RC); const bf16_t* VT = (const bf16_t*)(p.ws + O_RA);
  const int* IDX = (const int*)(p.ws + O_RQ); const float* GW = (const float*)(p.ws + O_RQ + (size_t)NTOK * 128 * 4);
  const float* MOD = (const float*)(p.ws + O_MOD);
  for (int t = blockIdx.x * NWAVE + wave; t < NTOK; t += gridDim.x * NWAVE) {
    float xf[16];
    unpack8(*(const u32x4*)(HX2 + (size_t)t * 1024 + lane * 8), xf); unpack8(*(const u32x4*)(HX2 + (size_t)t * 1024 + 512 + lane * 8), xf + 8);
    const int my_i0 = IDX[(size_t)t * 128 + lane], my_i1 = IDX[(size_t)t * 128 + 64 + lane];
    const float my_g0 = GW[(size_t)t * 128 + lane], my_g1 = GW[(size_t)t * 128 + 64 + lane];
    float acc[16];
#pragma unroll
    for (int j = 0; j < 16; ++j) acc[j] = 0.f;
    for (int e0 = 0; e0 < 128; e0 += 4) {
      int id[4]; float g[4]; u32x4 ua[4], ub[4], va[4], vb[4];
#pragma unroll
      for (int j = 0; j < 4; ++j) { const int e = e0 + j; id[j] = e0 < 64 ? __shfl(my_i0, e) : __shfl(my_i1, e - 64); g[j] = e0 < 64 ? __shfl(my_g0, e) : __shfl(my_g1, e - 64);
        const bf16_t* ur = UT + (size_t)id[j] * 1024; const bf16_t* vr = VT + (size_t)id[j] * 1024;
        ua[j] = *(const u32x4*)(ur + lane * 8); ub[j] = *(const u32x4*)(ur + 512 + lane * 8); va[j] = *(const u32x4*)(vr + lane * 8); vb[j] = *(const u32x4*)(vr + 512 + lane * 8); }
      float d[4];
#pragma unroll
      for (int j = 0; j < 4; ++j) { float uf[16]; unpack8(ua[j], uf); unpack8(ub[j], uf + 8); float s = 0.f;
#pragma unroll
        for (int k = 0; k < 16; ++k) s += xf[k] * uf[k];
        d[j] = s; }
#pragma unroll
      for (int j = 0; j < 4; ++j) d[j] = wave_sum(d[j]);
#pragma unroll
      for (int j = 0; j < 4; ++j) { const float cf = g[j] * gelu_t(d[j]); float vf[16]; unpack8(va[j], vf); unpack8(vb[j], vf + 8);
#pragma unroll
        for (int k = 0; k < 16; ++k) acc[k] += cf * vf[k]; }
    }
    float ss = 0.f;
#pragma unroll
    for (int k = 0; k < 16; ++k) ss += acc[k] * acc[k];
    ss = wave_sum(ss); const float rstd = rsqrtf(ss * (1.f / 1024.f) + EPS);
    const int b = t >> 13; const float* gt2 = MOD + b * 6144 + 5120;
#pragma unroll
    for (int hh = 0; hh < 2; ++hh) { const int c = hh * 512 + lane * 8; float* op = p.out + (size_t)t * 1024 + c;
#pragma unroll
      for (int q4 = 0; q4 < 2; ++q4) { float4 xv = *(const float4*)(op + q4 * 4); const float4 gt = *(const float4*)(gt2 + c + q4 * 4), gp = *(const float4*)(p.g_post2 + c + q4 * 4);
        xv.x += gt.x * (acc[hh * 8 + q4 * 4 + 0] * rstd * gp.x); xv.y += gt.y * (acc[hh * 8 + q4 * 4 + 1] * rstd * gp.y);
        xv.z += gt.z * (acc[hh * 8 + q4 * 4 + 2] * rstd * gp.z); xv.w += gt.w * (acc[hh * 8 + q4 * 4 + 3] * rstd * gp.w);
        *(float4*)(op + q4 * 4) = xv; } }
  }
}

constexpr int NPHASE = 12;
template <int PH> DEVI void run_phase(const Params& p, char* smem) {
  if constexpr (PH == 0) ph_prep(p, smem);
  else if constexpr (PH == 1) ph_hx(p, smem);
  else if constexpr (PH == 2) ph_inproj(p, smem);
  else if constexpr (PH == 3) ph_mid(p, smem);
  else if constexpr (PH == 4) ph_attn(p, smem);
  else if constexpr (PH == 5) ph_gates(p, smem);
  else if constexpr (PH == 6) ph_merge(p, smem);
  else if constexpr (PH == 7) ph_wo(p, smem);
  else if constexpr (PH == 8) ph_rows(p, smem);
  else if constexpr (PH == 9) ph_wpq(p, smem);
  else if constexpr (PH == 10) ph_topk(p, smem);
  else if constexpr (PH == 11) ph_gather(p, smem);
}

template <int PH> __global__ __launch_bounds__(NTHR) void k_phase(Params p) {
  extern __shared__ __attribute__((aligned(16))) char smem[];
  run_phase<PH>(p, smem);
}

#ifndef PROBE_PH
#define PROBE_PH -1
#endif
#if MEGA
#define RUNPH(N) do { if (PROBE_PH == N) t0 = __builtin_amdgcn_s_memrealtime(); run_phase<N>(p, smem); if (N < NPHASE - 1) grid.sync(); \
    if (PROBE_PH == N) t1 = __builtin_amdgcn_s_memrealtime(); } while (0)
__global__ __launch_bounds__(NTHR) void k_mega(Params p) {
  extern __shared__ __attribute__((aligned(16))) char smem[];
  cg::grid_group grid = cg::this_grid();
  unsigned long long t0 = 0, t1 = 0;
  RUNPH(0); RUNPH(1); RUNPH(2); RUNPH(3); RUNPH(4); RUNPH(5); RUNPH(6); RUNPH(7); RUNPH(8); RUNPH(9); RUNPH(10); RUNPH(11);
  if (PROBE_PH >= 0) { __syncthreads(); if (blockIdx.x == 0 && threadIdx.x == 0) p.out[0] += exp2f(rintf(log2f((float)(t1 - t0) * 1e-3f) * 5.f) * 0.2f); }
}
#endif

template <int PH> static void launch_phase(const Params& p, int grid, hipStream_t stream) {
  hipLaunchKernelGGL(k_phase<PH>, dim3(grid), dim3(NTHR), LDS_BYTES, stream, p);
}
template <int PH> static void set_attr() { (void)hipFuncSetAttribute((const void*)k_phase<PH>, hipFuncAttributeMaxDynamicSharedMemorySize, LDS_BYTES); }

extern "C" void kernel_launch(void* const* d_in, const int* in_sizes, int n_in, void* d_out, int out_size, void* d_ws, size_t ws_size, hipStream_t stream) {
  static int grid = 0;
  if (grid == 0) {
    if (n_in != 26 || out_size != NTOK * DM || ws_size < O_END) { fprintf(stderr, "kernel_launch: unexpected shapes n_in %d out %d ws %zu (need %zu)\n", n_in, out_size, ws_size, (size_t)O_END); grid = -1; return; }
#if MEGA
    (void)hipFuncSetAttribute((const void*)k_mega, hipFuncAttributeMaxDynamicSharedMemorySize, LDS_BYTES);
    int dev = 0, cus = 0, per_cu = 0; (void)hipGetDevice(&dev); (void)hipDeviceGetAttribute(&cus, hipDeviceAttributeMultiprocessorCount, dev);
    (void)hipOccupancyMaxActiveBlocksPerMultiprocessor(&per_cu, (const void*)k_mega, NTHR, LDS_BYTES);
    if (per_cu < 1) { fprintf(stderr, "kernel_launch: occupancy query says %d blocks per CU\n", per_cu); grid = -1; return; }
    grid = cus;
#else
    set_attr<0>(); set_attr<1>(); set_attr<2>(); set_attr<3>(); set_attr<4>(); set_attr<5>(); set_attr<6>(); set_attr<7>(); set_attr<8>(); set_attr<9>(); set_attr<10>(); set_attr<11>();
    grid = 256;
#endif
  }
  if (grid < 0) return;
  Params p{};
  const float** pp = (const float**)&p;
  for (int i = 0; i < 26; ++i) pp[i] = (const float*)d_in[i];
  p.out = (float*)d_out; p.ws = (char*)d_ws;
#if MEGA
  void* args[] = {&p};
  hipError_t e = hipLaunchCooperativeKernel((const void*)k_mega, dim3(grid), dim3(NTHR), args, LDS_BYTES, stream);
  if (e != hipSuccess) fprintf(stderr, "cooperative launch failed: %s (grid %d)\n", hipGetErrorString(e), grid);
#else
  launch_phase<0>(p, grid, stream); launch_phase<1>(p, grid, stream); launch_phase<2>(p, grid, stream); launch_phase<3>(p, grid, stream);
  launch_phase<4>(p, grid, stream); launch_phase<5>(p, grid, stream); launch_phase<6>(p, grid, stream); launch_phase<7>(p, grid, stream);
  launch_phase<8>(p, grid, stream); launch_phase<9>(p, grid, stream); launch_phase<10>(p, grid, stream); launch_phase<11>(p, grid, stream);
#endif
}
```

```cpp
#include <hip/hip_runtime.h>
#include <hip/hip_cooperative_groups.h>
#include <cstdint>
#include <cstdio>
namespace cg = cooperative_groups;

#ifndef MEGA
#define MEGA 1
#endif
#ifndef GEMM_MFMA
#define GEMM_MFMA 1
#endif
#ifndef ATTN_MFMA
#define ATTN_MFMA 1
#endif
#ifndef TOPK_FAST
#define TOPK_FAST 1
#endif

#define DEVI __device__ __forceinline__
typedef unsigned short bf16_t;
using bf16x8 = __attribute__((ext_vector_type(8))) short;
using bf16x4 = __attribute__((ext_vector_type(4))) short;
using f32x4  = __attribute__((ext_vector_type(4))) float;
using f32x16 = __attribute__((ext_vector_type(16))) float;
using u32x4  = __attribute__((ext_vector_type(4))) unsigned;
using u32x2  = __attribute__((ext_vector_type(2))) unsigned;

constexpr int DM = 1024, NB = 2, SEQ = 8192, NTOK = NB * SEQ, CTXL = 256, NCTX = NB * CTXL, NROW = NTOK + NCTX, NKEY = SEQ + CTXL;
constexpr int INW = 4544, INWP = 4608;
constexpr int NPRE = 2560;
constexpr float EPS = 1e-6f;
constexpr int NTHR = 512, NWAVE = 8;
constexpr int LDS_BYTES = 147456;

constexpr size_t al256(size_t x) { return (x + 255) / 256 * 256; }
constexpr size_t O_WIN   = 0;
constexpr size_t O_WUQ   = O_WIN  + al256((size_t)INWP * 1024 * 2);
constexpr size_t O_WUKV  = O_WUQ  + al256((size_t)1536 * 256 * 2);
constexpr size_t O_WPA   = O_WUKV + al256((size_t)2048 * 128 * 2);
constexpr size_t O_WPB   = O_WPA  + al256((size_t)1024 * 1024 * 2);
constexpr size_t O_WO    = O_WPB  + al256((size_t)1024 * 1024 * 2);
constexpr size_t O_WPQ   = O_WO   + al256((size_t)1024 * 1024 * 2);
constexpr size_t O_WS    = O_WPQ  + al256((size_t)2048 * 1024 * 2);
constexpr size_t O_K1    = O_WS   + al256((size_t)8 * 128 * 128 * 2);
constexpr size_t O_K2    = O_K1   + al256((size_t)128 * 128 * 2);
constexpr size_t O_MOD   = O_K2   + al256((size_t)128 * 128 * 2);
constexpr size_t O_ROPE  = O_MOD  + al256((size_t)3 * 6144 * 4);
constexpr size_t O_BAR   = O_ROPE + al256((size_t)128 * 16 * 2 * 4);
constexpr size_t O_RSSV  = O_BAR + al256((size_t)3456 * 4);
constexpr size_t O_RSSQ  = O_RSSV + (size_t)NTOK * 16 * 4;
constexpr size_t O_RSSKV = O_RSSQ + (size_t)NTOK * 4 * 4;
constexpr size_t O_RSSY  = O_RSSKV + (size_t)NROW * 2 * 4;
constexpr size_t O_RSSEND = O_RSSY + (size_t)NTOK * 16 * 4;
constexpr size_t O_RA    = al256(O_RSSEND);
constexpr size_t O_RB    = O_RA  + al256((size_t)NROW * 1024 * 2);
constexpr size_t O_RC    = O_RB  + al256((size_t)NTOK * 1024 * 2);
constexpr size_t O_CQ    = O_RC  + al256((size_t)NTOK * 1024 * 2);
constexpr size_t O_CKV   = O_CQ  + al256((size_t)NTOK * 256 * 2);
constexpr size_t O_KR    = O_CKV + al256((size_t)NROW * 128 * 2);
constexpr size_t O_RQ    = O_KR  + al256((size_t)NROW * 64 * 2);
constexpr size_t O_RKV   = O_RQ  + al256((size_t)NTOK * 1536 * 2);
constexpr size_t O_END   = O_RKV + al256((size_t)NROW * 2048 * 2);
static_assert(O_END <= (size_t)258 * 1024 * 1024, "workspace too large");

struct Params {
  const float *x, *c, *ctx, *c_ctx, *w_mod, *b_mod, *g_pre1, *g_post1, *g_pre2, *g_post2, *w_in, *g_q, *g_kv, *w_uq, *w_ukv, *g_sgu, *w_s, *b_s,
      *w_pa, *w_pb, *w_o, *w_pq, *k1, *k2, *u_exp, *v_exp;
  float* out; char* ws;
};

DEVI float bf2f(unsigned short h) { return __uint_as_float(((unsigned)h) << 16); }
DEVI unsigned short f2bf(float f) { unsigned u = __float_as_uint(f); u += 0x7fffu + ((u >> 16) & 1u); return (unsigned short)(u >> 16); }
DEVI unsigned pack2(float a, float b) { return (unsigned)f2bf(a) | ((unsigned)f2bf(b) << 16); }
DEVI float lo2f(unsigned w) { return __uint_as_float(w << 16); }
DEVI float hi2f(unsigned w) { return __uint_as_float(w & 0xffff0000u); }
DEVI void unpack8(const u32x4& w, float* f) {
  f[0] = lo2f(w[0]); f[1] = hi2f(w[0]); f[2] = lo2f(w[1]); f[3] = hi2f(w[1]); f[4] = lo2f(w[2]); f[5] = hi2f(w[2]); f[6] = lo2f(w[3]); f[7] = hi2f(w[3]);
}
DEVI float gelu_t(float x) { float z = 0.7978845608028654f * (x + 0.044715f * x * x * x); return x / (1.f + __expf(-2.f * z)); }
DEVI float sigmoidf_(float x) { return 1.f / (1.f + __expf(-x)); }
DEVI float wave_sum(float v) { for (int o = 32; o > 0; o >>= 1) v += __shfl_xor(v, o); return v; }
DEVI float wave_max(float v) { for (int o = 32; o > 0; o >>= 1) v = fmaxf(v, __shfl_xor(v, o)); return v; }
DEVI int keyrow(int row) { if (row < NTOK) return (row >> 13) * NKEY + (row & 8191); int c = row - NTOK; return (c >> 8) * NKEY + SEQ + (c & 255); }

__device__ const float ROPE_FREQ[16] = {1.0f, 0.5623413324356079f, 0.3162277638912201f, 0.17782793939113617f, 0.10000000149011612f, 0.05623413249850273f, 0.03162277489900589f, 0.017782794311642647f, 0.009999999776482582f, 0.005623413249850273f, 0.003162277629598975f, 0.0017782794311642647f, 0.0010000000474974513f, 0.000562341301701963f, 0.0003162277571391314f, 0.00017782794020604342f};
DEVI void sincos_small(double a, double& cs, double& sn) {
  const double k = rint(a * 0.15915494309189535); const double r = fma(-k, 6.283185307179586, a) - k * 2.4492935982947064e-16;
  const double r2 = r * r; double s = 0.0, c = 0.0;
#pragma unroll
  for (int n = 12; n >= 1; --n) { s = (1.0 - s * r2 / (double)((2 * n) * (2 * n + 1))); c = (1.0 - c * r2 / (double)((2 * n - 1) * (2 * n))); }
  sn = r * s; cs = c;
}

DEVI void transpose_job(const float* __restrict__ src, int K, int N, bf16_t* __restrict__ dst, const float* __restrict__ gk, bool isWin, int ntiles, char* smem) {
  const int tid = threadIdx.x; bf16_t* tl = (bf16_t*)smem; const int kt = K / 64;
  for (int idx = blockIdx.x; idx < ntiles; idx += gridDim.x) {
    const int ktile = idx % kt, ntile = idx / kt, k0 = ktile * 64, n0d = ntile * 64;
    int n0s = n0d; bool zero = false;
    if (isWin) { if (n0d == 2496) zero = true; else if (n0d >= 2560) n0s = n0d - 64; }
    { const int kk = tid >> 3, nn8 = (tid & 7) * 8; f32x4 va = {0.f, 0.f, 0.f, 0.f}, vb = va;
      if (!zero) { const float* s = src + (size_t)(k0 + kk) * N + n0s + nn8; const float4 a = *(const float4*)s, b = *(const float4*)(s + 4);
        const float sc = gk ? gk[k0 + kk] : 1.f; va = (f32x4){a.x, a.y, a.z, a.w} * sc; vb = (f32x4){b.x, b.y, b.z, b.w} * sc; }
      bf16_t* tp = tl + nn8 * 72 + kk;
      tp[0] = f2bf(va[0]); tp[72] = f2bf(va[1]); tp[144] = f2bf(va[2]); tp[216] = f2bf(va[3]); tp[288] = f2bf(vb[0]); tp[360] = f2bf(vb[1]); tp[432] = f2bf(vb[2]); tp[504] = f2bf(vb[3]); }
    __syncthreads();
    { const int nn = tid >> 3, kk8 = (tid & 7) * 8;
      const u32x4 o = *(const u32x4*)(tl + nn * 72 + kk8);
      *(u32x4*)(dst + (size_t)(n0d + nn) * K + k0 + kk8) = o; }
    __syncthreads();
  }
}

DEVI void ph_prep(const Params& p, char* smem) {
  const int tid = threadIdx.x, bid = blockIdx.x, nb = gridDim.x;
  char* ws = p.ws;
  if (bid == 0) { float* rope = (float*)(ws + O_ROPE);
    for (int i = tid; i < 128 * 16; i += NTHR) { const int pos = i >> 4, f = i & 15; const float ang = (float)pos * ROPE_FREQ[f];
      double cs, sn; sincos_small((double)ang, cs, sn); rope[i * 2] = (float)cs; rope[i * 2 + 1] = (float)sn; } }
  { float* red = (float*)smem; float* MOD = (float*)(ws + O_MOD);
    for (int it = bid; it < 256; it += nb) {
      const int cgp = tid % 6, kg = tid / 6;
      f32x4 a0 = {0.f, 0.f, 0.f, 0.f}, a1 = a0, a2 = a0;
      if (tid < 510) {
        for (int k = kg; k < 1024; k += 85) {
          const float4 w4 = *(const float4*)(p.w_mod + (size_t)k * 6144 + it * 24 + cgp * 4);
          const f32x4 w = {w4.x, w4.y, w4.z, w4.w};
          const float c0 = p.c[k], c1 = p.c[1024 + k], c2 = p.c_ctx[k];
          a0 += w * (c0 / (1.f + __expf(-c0))); a1 += w * (c1 / (1.f + __expf(-c1))); a2 += w * (c2 / (1.f + __expf(-c2)));
        }
        float* rp = red + kg * 72 + cgp * 4;
        rp[0] = a0[0]; rp[1] = a0[1]; rp[2] = a0[2]; rp[3] = a0[3];
        rp[24] = a1[0]; rp[25] = a1[1]; rp[26] = a1[2]; rp[27] = a1[3];
        rp[48] = a2[0]; rp[49] = a2[1]; rp[50] = a2[2]; rp[51] = a2[3];
      }
      __syncthreads();
      if (tid < 72) { float s = 0.f; for (int g = 0; g < 85; ++g) s += red[g * 72 + tid]; int r = tid / 24, n = it * 24 + tid % 24; MOD[r * 6144 + n] = s + p.b_mod[n]; }
      __syncthreads();
    } }
  transpose_job(p.w_in,  1024, INW,  (bf16_t*)(ws + O_WIN),  nullptr, true,  1152, smem);
  transpose_job(p.w_uq,  256,  1536, (bf16_t*)(ws + O_WUQ),  p.g_q,   false, 96,   smem);
  transpose_job(p.w_ukv, 128,  2048, (bf16_t*)(ws + O_WUKV), p.g_kv,  false, 64,   smem);
  transpose_job(p.w_pa,  1024, 1024, (bf16_t*)(ws + O_WPA),  nullptr, false, 256,  smem);
  transpose_job(p.w_pb,  1024, 1024, (bf16_t*)(ws + O_WPB),  nullptr, false, 256,  smem);
  transpose_job(p.w_o,   1024, 1024, (bf16_t*)(ws + O_WO),   nullptr, false, 256,  smem);
  transpose_job(p.w_pq,  1024, 2048, (bf16_t*)(ws + O_WPQ),  nullptr, false, 512,  smem);
  { const int n8 = (131072 + 16384 + 16384) / 8;
    for (int i = bid * NTHR + tid; i < n8; i += nb * NTHR) {
      int e = i * 8; const float* s; bf16_t* d;
      if (e < 131072) { s = p.w_s + e; d = (bf16_t*)(ws + O_WS) + e; }
      else if (e < 131072 + 16384) { s = p.k1 + (e - 131072); d = (bf16_t*)(ws + O_K1) + (e - 131072); }
      else { s = p.k2 + (e - 131072 - 16384); d = (bf16_t*)(ws + O_K2) + (e - 131072 - 16384); }
      const float4 a = *(const float4*)s, b = *(const float4*)(s + 4);
      u32x4 o = {pack2(a.x, a.y), pack2(a.z, a.w), pack2(b.x, b.y), pack2(b.z, b.w)};
      *(u32x4*)d = o;
    } }
}

DEVI void convert_table(const float* __restrict__ src, bf16_t* __restrict__ dst) {
  const int n8 = 16384 * 1024 / 8;
  for (int i = blockIdx.x * NTHR + threadIdx.x; i < n8; i += gridDim.x * NTHR) {
    const float4 a = *(const float4*)(src + (size_t)i * 8), b = *(const float4*)(src + (size_t)i * 8 + 4);
    u32x4 o = {pack2(a.x, a.y), pack2(a.z, a.w), pack2(b.x, b.y), pack2(b.z, b.w)};
    *(u32x4*)(dst + (size_t)i * 8) = o;
  }
}

DEVI void ph_hx(const Params& p, char* smem) {
  const int tid = threadIdx.x, wave = tid >> 6, lane = tid & 63;
  float* mA = (float*)smem; float* mB = mA + 3 * 1024;
  const float* MOD = (const float*)(p.ws + O_MOD);
  for (int i = tid; i < 3072; i += NTHR) { int r = i >> 10, c = i & 1023; mA[i] = p.g_pre1[c] * (1.f + MOD[r * 6144 + 1024 + c]); mB[i] = MOD[r * 6144 + c]; }
  __syncthreads();
  bf16_t* HX = (bf16_t*)(p.ws + O_RA);
  for (int row = blockIdx.x * NWAVE + wave; row < NROW; row += gridDim.x * NWAVE) {
    const float* src = row < NTOK ? p.x + (size_t)row * 1024 : p.ctx + (size_t)(row - NTOK) * 1024;
    const int mr = row < NTOK ? (row >> 13) : 2;
    float4 v[4]; float ss = 0.f;
#pragma unroll
    for (int i = 0; i < 4; ++i) { v[i] = *(const float4*)(src + i * 256 + lane * 4); ss += v[i].x * v[i].x + v[i].y * v[i].y + v[i].z * v[i].z + v[i].w * v[i].w; }
    ss = wave_sum(ss); const float rstd = rsqrtf(ss * (1.f / 1024.f) + EPS);
#pragma unroll
    for (int i = 0; i < 4; ++i) { const int c = i * 256 + lane * 4; const float* a = mA + mr * 1024 + c; const float* b = mB + mr * 1024 + c;
      u32x2 o = {pack2(v[i].x * rstd * a[0] + b[0], v[i].y * rstd * a[1] + b[1]), pack2(v[i].z * rstd * a[2] + b[2], v[i].w * rstd * a[3] + b[3])};
      *(u32x2*)(HX + (size_t)row * 1024 + c) = o; }
  }
}

template <int BM, bool ACOLMAP, class Epi>
DEVI void gemm_tile_naive(const bf16_t* __restrict__ A, int lda, const bf16_t* __restrict__ Bm, int ldb, int K, int row0, int col0, const Epi& epi, const float* kss) {
  const int t = threadIdx.x, cgp = t & 31, rr = t >> 5;
  for (int rb = 0; rb < BM; rb += 16) {
    const int r = rb + rr;
    const bf16_t* ap = A + (size_t)r * lda;
    const bf16_t* bp = Bm + (size_t)(cgp * 4) * ldb;
    float acc[4] = {0.f, 0.f, 0.f, 0.f};
    for (int k = 0; k < K; k += 8) {
      const int ka = ACOLMAP ? (k + (k >> 7) * 64) : k;
      float af[8]; unpack8(*(const u32x4*)(ap + ka), af);
      if (kss) {
#pragma unroll
        for (int j = 0; j < 8; ++j) af[j] *= kss[k + j]; }
#pragma unroll
      for (int n = 0; n < 4; ++n) { float bf[8]; unpack8(*(const u32x4*)(bp + (size_t)n * ldb + k), bf);
#pragma unroll
        for (int j = 0; j < 8; ++j) acc[n] += af[j] * bf[j]; }
    }
    float sq = epi(row0 + r, col0 + cgp * 4, acc);
    if (Epi::RSS) { for (int o = 16; o > 0; o >>= 1) sq += __shfl_xor(sq, o); if (cgp == 0) { epi.rss(row0 + r, col0, sq); epi.rss(row0 + r, col0 + 64, 0.f); } }
  }
}

DEVI int lds_sw(int row, int c) { return row * 128 + ((c ^ (row & 7)) << 4); }
template <int BM, bool ACOLMAP, class Epi>
DEVI void gemm_tile_mfma(const bf16_t* __restrict__ A, int lda, const bf16_t* __restrict__ Bm, int ldb, int K, int row0, int col0, const Epi& epi, const float* kscale, char* smem) {
  constexpr int MI = BM / 64, ACH = BM / 64, ABYTES = BM * 128, BBYTES = 128 * 128, STAGE = ABYTES + BBYTES;
  const int tid = threadIdx.x, wave = tid >> 6, lane = tid & 63, wm = wave >> 1, wn = wave & 1, l15 = lane & 15, lq = lane >> 4;
  f32x4 acc[MI][4];
#pragma unroll
  for (int mi = 0; mi < MI; ++mi)
#pragma unroll
    for (int ni = 0; ni < 4; ++ni) acc[mi][ni] = (f32x4){0.f, 0.f, 0.f, 0.f};
  u32x4 ra[ACH], rb[2];
  const int nk = K >> 6;
  auto gload = [&](int kt) {
    const int k0 = kt * 64, ka = ACOLMAP ? k0 + (k0 >> 7) * 64 : k0;
#pragma unroll
    for (int i = 0; i < ACH; ++i) { const int id = tid + NTHR * i, r = id >> 3, c = id & 7; ra[i] = *(const u32x4*)(A + (size_t)r * lda + ka + c * 8); }
#pragma unroll
    for (int i = 0; i < 2; ++i) { const int id = tid + NTHR * i, r = id >> 3, c = id & 7; rb[i] = *(const u32x4*)(Bm + (size_t)r * ldb + k0 + c * 8); }
  };
  auto lstore = [&](int buf, int kt) {
    char* sa = smem + buf * STAGE; char* sb = sa + ABYTES;
#pragma unroll
    for (int i = 0; i < ACH; ++i) { const int id = tid + NTHR * i, r = id >> 3, c = id & 7; u32x4 v = ra[i];
      if (kscale) { float f[8]; unpack8(v, f); const float* ks = kscale + kt * 64 + c * 8;
        v = (u32x4){pack2(f[0] * ks[0], f[1] * ks[1]), pack2(f[2] * ks[2], f[3] * ks[3]), pack2(f[4] * ks[4], f[5] * ks[5]), pack2(f[6] * ks[6], f[7] * ks[7])}; }
      *(u32x4*)(sa + lds_sw(r, c)) = v; }
#pragma unroll
    for (int i = 0; i < 2; ++i) { const int id = tid + NTHR * i, r = id >> 3, c = id & 7; *(u32x4*)(sb + lds_sw(r, c)) = rb[i]; }
  };
  gload(0); lstore(0, 0); __syncthreads();
  for (int kt = 0; kt < nk; ++kt) {
    if (kt + 1 < nk) gload(kt + 1);
    const char* sa = smem + (kt & 1) * STAGE; const char* sb = sa + ABYTES;
#pragma unroll
    for (int ks = 0; ks < 2; ++ks) { const int kc = ks * 4 + lq; bf16x8 af[MI], bfr[4];
#pragma unroll
      for (int mi = 0; mi < MI; ++mi) af[mi] = *(const bf16x8*)(sa + lds_sw(wm * (BM / 4) + mi * 16 + l15, kc));
#pragma unroll
      for (int ni = 0; ni < 4; ++ni) bfr[ni] = *(const bf16x8*)(sb + lds_sw(wn * 64 + ni * 16 + l15, kc));
#pragma unroll
      for (int mi = 0; mi < MI; ++mi)
#pragma unroll
        for (int ni = 0; ni < 4; ++ni) acc[mi][ni] = __builtin_amdgcn_mfma_f32_16x16x32_bf16(bfr[ni], af[mi], acc[mi][ni], 0, 0, 0); }
    if (kt + 1 < nk) lstore((kt + 1) & 1, kt + 1);
    __syncthreads();
  }
#pragma unroll
  for (int mi = 0; mi < MI; ++mi) { const int row = row0 + wm * (BM / 4) + mi * 16 + l15; float sq = 0.f;
#pragma unroll
    for (int ni = 0; ni < 4; ++ni) { const float v[4] = {acc[mi][ni][0], acc[mi][ni][1], acc[mi][ni][2], acc[mi][ni][3]}; sq += epi(row, col0 + wn * 64 + ni * 16 + lq * 4, v); }
    if (Epi::RSS) { sq += __shfl_xor(sq, 16); sq += __shfl_xor(sq, 32); if (lq == 0) epi.rss(row, col0 + wn * 64, sq); } }
}

template <int BM, bool ACOLMAP, class Epi>
DEVI void gemm_tile(const bf16_t* A, int lda, const bf16_t* Bm, int ldb, int K, int row0, int col0, const Epi& epi, const float* kss, char* smem) {
#if GEMM_MFMA
  gemm_tile_mfma<BM, ACOLMAP>(A, lda, Bm, ldb, K, row0, col0, epi, kss, smem);
#else
  gemm_tile_naive<BM, ACOLMAP>(A, lda, Bm, ldb, K, row0, col0, epi, kss);
#endif
}

DEVI void st4bf(bf16_t* d, float a, float b, float c, float e) { u32x2 o = {pack2(a, b), pack2(c, e)}; *(u32x2*)d = o; }

struct EpiIn { static constexpr bool RSS = true; bf16_t *GU, *GVT, *CQ, *CKV, *KR; float *rssv, *rssq, *rsskv;
  DEVI float operator()(int row, int col, const float (&v)[4]) const {
    if (col < 1024) { st4bf(GU + (size_t)row * 1024 + col, gelu_t(v[0]), gelu_t(v[1]), gelu_t(v[2]), gelu_t(v[3])); return 0.f; }
    else if (col < 2048) { const int c = col - 1024, chunk = row >> 7, q = row & 127; float s = 0.f;
#pragma unroll
      for (int j = 0; j < 4; ++j) { const float g = gelu_t(v[j]); s += g * g; GVT[((size_t)chunk * 1024 + c + j) * 128 + q] = f2bf(g); }
      return s; }
    else if (col < 2304) { st4bf(CQ + (size_t)row * 256 + (col - 2048), v[0], v[1], v[2], v[3]); return v[0] * v[0] + v[1] * v[1] + v[2] * v[2] + v[3] * v[3]; }
    else if (col < 2432) { st4bf(CKV + (size_t)row * 128 + (col - 2304), v[0], v[1], v[2], v[3]); return v[0] * v[0] + v[1] * v[1] + v[2] * v[2] + v[3] * v[3]; }
    else if (col < 2496) { st4bf(KR + (size_t)keyrow(row) * 64 + (col - 2432), v[0], v[1], v[2], v[3]); return 0.f; }
    return 0.f; }
  DEVI void rss(int row, int col, float s) const {
    if (col >= 1024 && col < 2048) rssv[row * 16 + ((col - 1024) >> 6)] = s; else if (col >= 2048 && col < 2304) rssq[row * 4 + ((col - 2048) >> 6)] = s; else if (col >= 2304 && col < 2432) rsskv[row * 2 + ((col - 2304) >> 6)] = s; }
};
struct EpiQ { static constexpr bool RSS = false; bf16_t* Q; const float* rssq;
  DEVI float operator()(int row, int col, const float (&v)[4]) const { const float4 ps = *(const float4*)(rssq + row * 4); const float r = rsqrtf(((ps.x + ps.y) + (ps.z + ps.w)) * (1.f / 256.f) + EPS);
    st4bf(Q + (size_t)row * 1536 + col, v[0] * r, v[1] * r, v[2] * r, v[3] * r); return 0.f; }
  DEVI void rss(int, int, float) const {} };
struct EpiKV { static constexpr bool RSS = false; bf16_t* KV; const float* rsskv;
  DEVI float operator()(int row, int col, const float (&v)[4]) const { const float r = rsqrtf((rsskv[row * 2] + rsskv[row * 2 + 1]) * (1.f / 128.f) + EPS);
    st4bf(KV + (size_t)keyrow(row) * 2048 + col, v[0] * r, v[1] * r, v[2] * r, v[3] * r); return 0.f; }
  DEVI void rss(int, int, float) const {} };
struct EpiSgu { static constexpr bool RSS = false; bf16_t* GUOA; const float* g_sgu; const float* b_s; int chunk, g;
  DEVI float operator()(int row, int col, const float (&v)[4]) const { const int token = chunk * 128 + row, ch = g * 128 + col; const float bias = b_s[g * 128 + row];
    bf16_t* ptr = GUOA + (size_t)token * 1024 + ch; const u32x2 gu = *(const u32x2*)ptr;
    st4bf(ptr, lo2f(gu[0]) * (g_sgu[ch] * v[0] + bias), hi2f(gu[0]) * (g_sgu[ch + 1] * v[1] + bias), lo2f(gu[1]) * (g_sgu[ch + 2] * v[2] + bias), hi2f(gu[1]) * (g_sgu[ch + 3] * v[3] + bias));
    return 0.f; }
  DEVI void rss(int, int, float) const {} };
struct EpiGate { static constexpr bool RSS = false; bf16_t* G;
  DEVI float operator()(int row, int col, const float (&v)[4]) const { st4bf(G + (size_t)row * 2048 + col, sigmoidf_(v[0]), sigmoidf_(v[1]), sigmoidf_(v[2]), sigmoidf_(v[3])); return 0.f; }
  DEVI void rss(int, int, float) const {} };
template <bool SECOND> struct EpiMerge { static constexpr bool RSS = false; bf16_t* M; const bf16_t* G;
  DEVI float operator()(int row, int col, const float (&v)[4]) const { const u32x2 g = *(const u32x2*)(G + (size_t)row * 2048 + (SECOND ? 1024 : 0) + col);
    float o0 = lo2f(g[0]) * v[0], o1 = hi2f(g[0]) * v[1], o2 = lo2f(g[1]) * v[2], o3 = hi2f(g[1]) * v[3];
    bf16_t* ptr = M + (size_t)row * 1024 + col;
    if (SECOND) { const u32x2 m = *(const u32x2*)ptr; o0 += lo2f(m[0]); o1 += hi2f(m[0]); o2 += lo2f(m[1]); o3 += hi2f(m[1]); }
    st4bf(ptr, o0, o1, o2, o3); return 0.f; }
  DEVI void rss(int, int, float) const {} };
struct EpiO { static constexpr bool RSS = true; bf16_t* Y; float* rssy;
  DEVI float operator()(int row, int col, const float (&v)[4]) const { st4bf(Y + (size_t)row * 1024 + col, v[0], v[1], v[2], v[3]); return v[0] * v[0] + v[1] * v[1] + v[2] * v[2] + v[3] * v[3]; }
  DEVI void rss(int row, int col, float s) const { rssy[row * 16 + (col >> 6)] = s; } };
struct EpiPq { static constexpr bool RSS = false; bf16_t* QP;
  DEVI float operator()(int row, int col, const float (&v)[4]) const { st4bf(QP + (size_t)row * 2048 + col, v[0], v[1], v[2], v[3]); return 0.f; }
  DEVI void rss(int, int, float) const {} };

DEVI void ph_inproj(const Params& p, char* smem) {
  char* ws = p.ws;
  EpiIn epi{(bf16_t*)(ws + O_RB), (bf16_t*)(ws + O_RC), (bf16_t*)(ws + O_CQ), (bf16_t*)(ws + O_CKV), (bf16_t*)(ws + O_KR), (float*)(ws + O_RSSV), (float*)(ws + O_RSSQ), (float*)(ws + O_RSSKV)};
  const bf16_t* HX = (const bf16_t*)(ws + O_RA); const bf16_t* W = (const bf16_t*)(ws + O_WIN);
  for (int i = blockIdx.x; i < 1284; i += gridDim.x) {
    int mt, nt; if (i < 1280) { mt = i / 20; nt = i % 20; } else { mt = 64 + ((i - 1280) >> 1); nt = 18 + ((i - 1280) & 1); }
    gemm_tile<256, false>(HX + (size_t)mt * 256 * 1024, 1024, W + (size_t)nt * 128 * 1024, 1024, 1024, mt * 256, nt * 128, epi, nullptr, smem);
  }
}
DEVI void rope_kr(const Params& p) {
  bf16_t* KR = (bf16_t*)(p.ws + O_KR); const float* rope = (const float*)(p.ws + O_ROPE);
  for (int i = blockIdx.x * NTHR + threadIdx.x; i < NTOK * 32; i += gridDim.x * NTHR) {
    const int tok = i >> 5, j = i & 15, which = (i >> 4) & 1, pos = tok & 8191, pp = which ? (pos & 63) : (pos >> 6);
    const float cs = rope[(pp * 16 + j) * 2], sn = rope[(pp * 16 + j) * 2 + 1];
    bf16_t* r = KR + (size_t)keyrow(tok) * 64 + which * 32 + j;
    const float x1 = bf2f(r[0]), x2 = bf2f(r[16]);
    r[0] = f2bf(x1 * cs - x2 * sn); r[16] = f2bf(x1 * sn + x2 * cs);
  }
}
DEVI void ph_mid(const Params& p, char* smem) {
  char* ws = p.ws;
  { EpiQ epi{(bf16_t*)(ws + O_RQ), (const float*)(ws + O_RSSQ)};
    const bf16_t* A = (const bf16_t*)(ws + O_CQ); const bf16_t* W = (const bf16_t*)(ws + O_WUQ);
    for (int i = blockIdx.x; i < 64 * 12; i += gridDim.x) { const int mt = i / 12, nt = i % 12;
      gemm_tile<256, false>(A + (size_t)mt * 256 * 256, 256, W + (size_t)nt * 128 * 256, 256, 256, mt * 256, nt * 128, epi, nullptr, smem); } }
  { EpiKV epi{(bf16_t*)(ws + O_RKV), (const float*)(ws + O_RSSKV)};
    const bf16_t* A = (const bf16_t*)(ws + O_CKV); const bf16_t* W = (const bf16_t*)(ws + O_WUKV);
    for (int i = blockIdx.x; i < 66 * 16; i += gridDim.x) { const int mt = i / 16, nt = i % 16;
      gemm_tile<256, false>(A + (size_t)mt * 256 * 128, 128, W + (size_t)nt * 128 * 128, 128, 128, mt * 256, nt * 128, epi, nullptr, smem); } }
  { const bf16_t* WS = (const bf16_t*)(ws + O_WS); const bf16_t* GVT = (const bf16_t*)(ws + O_RC);
    float* ksc = (float*)(smem + LDS_BYTES - 1024); const float* rssv = (const float*)(ws + O_RSSV);
    for (int i = blockIdx.x; i < 1024; i += gridDim.x) { const int chunk = i >> 3, g = i & 7;
      __syncthreads();
      if (threadIdx.x < 128) { const float* pr = rssv + (size_t)(chunk * 128 + threadIdx.x) * 16; float t = 0.f;
#pragma unroll
        for (int j = 0; j < 16; ++j) t += pr[j];
        ksc[threadIdx.x] = rsqrtf(t * (1.f / 1024.f) + EPS); }
      __syncthreads();
      EpiSgu epi{(bf16_t*)(ws + O_RB), p.g_sgu, p.b_s, chunk, g};
      gemm_tile<128, false>(WS + (size_t)g * 16384, 128, GVT + ((size_t)chunk * 1024 + g * 128) * 128, 128, 128, 0, 0, epi, ksc, smem); } }
  rope_kr(p);
}
DEVI void ph_gates(const Params& p, char* smem) {
  char* ws = p.ws; EpiGate epi{(bf16_t*)(ws + O_RKV)};
  const bf16_t* HX = (const bf16_t*)(ws + O_RA); const bf16_t* W = (const bf16_t*)(ws + O_WIN) + (size_t)NPRE * 1024;
  for (int i = blockIdx.x; i < 64 * 16; i += gridDim.x) { const int mt = i / 16, nt = i % 16;
    gemm_tile<256, false>(HX + (size_t)mt * 256 * 1024, 1024, W + (size_t)nt * 128 * 1024, 1024, 1024, mt * 256, nt * 128, epi, nullptr, smem); }
}
DEVI void ph_merge(const Params& p, char* smem) {
  char* ws = p.ws; bf16_t* M = (bf16_t*)(ws + O_RC); const bf16_t* G = (const bf16_t*)(ws + O_RKV);
  EpiMerge<false> e1{M, G}; EpiMerge<true> e2{M, G};
  const bf16_t* OA = (const bf16_t*)(ws + O_RB); const bf16_t* OB = (const bf16_t*)(ws + O_RQ);
  const bf16_t* WA = (const bf16_t*)(ws + O_WPA); const bf16_t* WB = (const bf16_t*)(ws + O_WPB);
  for (int i = blockIdx.x; i < 64 * 8; i += gridDim.x) { const int mt = i / 8, nt = i % 8;
    gemm_tile<256, false>(OA + (size_t)mt * 256 * 1024, 1024, WA + (size_t)nt * 128 * 1024, 1024, 1024, mt * 256, nt * 128, e1, nullptr, smem);
    gemm_tile<256, true>(OB + (size_t)mt * 256 * 1536, 1536, WB + (size_t)nt * 128 * 1024, 1024, 1024, mt * 256, nt * 128, e2, nullptr, smem); }
}
DEVI void ph_wo(const Params& p, char* smem) {
  char* ws = p.ws; EpiO epi{(bf16_t*)(ws + O_RA), (float*)(ws + O_RSSY)};
  const bf16_t* M = (const bf16_t*)(ws + O_RC); const bf16_t* W = (const bf16_t*)(ws + O_WO);
  for (int i = blockIdx.x; i < 64 * 8; i += gridDim.x) { const int mt = i / 8, nt = i % 8;
    gemm_tile<256, false>(M + (size_t)mt * 256 * 1024, 1024, W + (size_t)nt * 128 * 1024, 1024, 1024, mt * 256, nt * 128, epi, nullptr, smem); }
}
DEVI void ph_wpq(const Params& p, char* smem) {
  char* ws = p.ws; EpiPq epi{(bf16_t*)(ws + O_RKV)};
  const bf16_t* A = (const bf16_t*)(ws + O_RB); const bf16_t* W = (const bf16_t*)(ws + O_WPQ);
  for (int i = blockIdx.x; i < 64 * 16; i += gridDim.x) { const int mt = i / 16, nt = i % 16;
    gemm_tile<256, false>(A + (size_t)mt * 256 * 1024, 1024, W + (size_t)nt * 128 * 1024, 1024, 1024, mt * 256, nt * 128, epi, nullptr, smem); }
  convert_table(p.v_exp, (bf16_t*)(ws + O_RA));
}

DEVI void attn_naive(const Params& p, char* smem) {
  const int tid = threadIdx.x, wave = tid >> 6, lane = tid & 63;
  float* qs = (float*)smem + wave * 256; float* ps = qs + 192;
  bf16_t* Q = (bf16_t*)(p.ws + O_RQ); const bf16_t* KV = (const bf16_t*)(p.ws + O_RKV); const bf16_t* KR = (const bf16_t*)(p.ws + O_KR);
  const float* rope = (const float*)(p.ws + O_ROPE);
  const float scale = 0.07216878364870322f;
  for (int base = blockIdx.x * NWAVE; base < NB * 8 * SEQ; base += gridDim.x * NWAVE) {
    const int it = base + wave, bh = it >> 13, qi = it & 8191, b = bh >> 3, h = bh & 7;
    const size_t qoff = (size_t)(b * SEQ + qi) * 1536 + h * 192;
    __syncthreads();
    for (int d = lane; d < 192; d += 64) qs[d] = bf2f(Q[qoff + d]);
    __syncthreads();
    if (lane < 32) { const int j = lane & 15, which = lane >> 4, pp = which ? (qi & 63) : (qi >> 6);
      const float cs = rope[(pp * 16 + j) * 2], sn = rope[(pp * 16 + j) * 2 + 1]; const int d1 = 128 + which * 32 + j, d2 = d1 + 16;
      const float x1 = qs[d1], x2 = qs[d2]; qs[d1] = x1 * cs - x2 * sn; qs[d2] = x1 * sn + x2 * cs; }
    __syncthreads();
    float m = -1e30f, l = 0.f, o0 = 0.f, o1 = 0.f;
    for (int k0 = 0; k0 < NKEY; k0 += 64) {
      const size_t kr = (size_t)(b * NKEY + k0 + lane);
      const bf16_t* kn = KV + kr * 2048 + h * 256; const bf16_t* krp = KR + kr * 64;
      float s = 0.f;
#pragma unroll 4
      for (int d8 = 0; d8 < 16; ++d8) { float kf[8]; unpack8(*(const u32x4*)(kn + d8 * 8), kf); const float4 q0 = *(const float4*)(qs + d8 * 8), q1 = *(const float4*)(qs + d8 * 8 + 4);
        s += q0.x * kf[0] + q0.y * kf[1] + q0.z * kf[2] + q0.w * kf[3] + q1.x * kf[4] + q1.y * kf[5] + q1.z * kf[6] + q1.w * kf[7]; }
#pragma unroll 4
      for (int d8 = 0; d8 < 8; ++d8) { float kf[8]; unpack8(*(const u32x4*)(krp + d8 * 8), kf); const float4 q0 = *(const float4*)(qs + 128 + d8 * 8), q1 = *(const float4*)(qs + 128 + d8 * 8 + 4);
        s += q0.x * kf[0] + q0.y * kf[1] + q0.z * kf[2] + q0.w * kf[3] + q1.x * kf[4] + q1.y * kf[5] + q1.z * kf[6] + q1.w * kf[7]; }
      s *= scale;
      const float mn = fmaxf(m, wave_max(s)), al = __expf(m - mn), pe = __expf(s - mn);
      l = l * al + wave_sum(pe); m = mn; o0 *= al; o1 *= al;
      __syncthreads();
      ps[lane] = pe;
      __syncthreads();
      const bf16_t* vp = KV + (size_t)(b * NKEY + k0) * 2048 + h * 256 + 128 + lane * 2;
#pragma unroll 8
      for (int kk = 0; kk < 64; ++kk) { const unsigned w = *(const unsigned*)(vp + (size_t)kk * 2048); const float pk = ps[kk]; o0 += pk * lo2f(w); o1 += pk * hi2f(w); }
    }
    const float invL = 1.f / l;
    *(unsigned*)(Q + qoff + lane * 2) = pack2(o0 * invL, o1 * invL);
  }
}

namespace at {
constexpr int QBLK = 32, KVBLK = 64;
constexpr float SCALE = 0.07216878364870322f;
constexpr float THR = 8.f;
constexpr int SHM_V = KVBLK * 128 * 2, SHM_K = KVBLK * 192 * 2;
using s16x4 = __attribute__((ext_vector_type(4))) short;
#define KSWZ(row, colB) ((row) * 384 + ((colB) ^ (((row) & 7) << 4)))
#define SBAR() __builtin_amdgcn_sched_barrier(0)
DEVI int crow(int r, int hi) { return (r & 3) + 8 * (r >> 2) + 4 * hi; }
DEVI unsigned cvtpk(float lo, float hi) { unsigned r; asm volatile("v_cvt_pk_bf16_f32 %0, %1, %2" : "=v"(r) : "v"(lo), "v"(hi)); return r; }
DEVI void partialSM(f32x16& p0, f32x16& p1, float& m_reg, float& mn, float& alpha) {
  constexpr float C = SCALE * 1.4426950408889634f;
  float pmax = p0[0];
#pragma unroll
  for (int r = 1; r < 16; ++r) pmax = fmaxf(pmax, p0[r]);
#pragma unroll
  for (int r = 0; r < 16; ++r) pmax = fmaxf(pmax, p1[r]);
  { auto rr = __builtin_amdgcn_permlane32_swap(__float_as_uint(pmax), __float_as_uint(pmax), false, false);
    pmax = fmaxf(__uint_as_float(rr[0]), __uint_as_float(rr[1])); }
  if (__builtin_expect(__all(pmax - m_reg <= THR / SCALE), 1)) { mn = m_reg; alpha = 1.f; }
  else { mn = fmaxf(m_reg, pmax); alpha = __builtin_amdgcn_exp2f((m_reg - mn) * C); m_reg = mn; }
  const float mnC = -mn * C;
#pragma unroll
  for (int r = 0; r < 16; ++r) p0[r] = fmaf(p0[r], C, mnC);
#pragma unroll
  for (int r = 0; r < 16; ++r) p1[r] = fmaf(p1[r], C, mnC);
#pragma unroll
  for (int r = 0; r < 16; ++r) p0[r] = __builtin_amdgcn_exp2f(p0[r]);
}
DEVI void finishSM(f32x16& p0, f32x16& p1, float alpha, float& l_reg, bf16x8& pa0, bf16x8& pa1, bf16x8& pa2, bf16x8& pa3) {
#pragma unroll
  for (int r = 0; r < 16; ++r) p1[r] = __builtin_amdgcn_exp2f(p1[r]);
  float ps = 0;
#pragma unroll
  for (int r = 0; r < 16; ++r) ps += p0[r];
#pragma unroll
  for (int r = 0; r < 16; ++r) ps += p1[r];
  { auto rr = __builtin_amdgcn_permlane32_swap(__float_as_uint(ps), __float_as_uint(ps), false, false);
    ps = __uint_as_float(rr[0]) + __uint_as_float(rr[1]); }
  l_reg = l_reg * alpha + ps;
#define PK4(P, BASE, OUT) do { unsigned a0 = cvtpk(P[BASE + 0], P[BASE + 1]), a1 = cvtpk(P[BASE + 2], P[BASE + 3]);   \
    unsigned b0 = cvtpk(P[BASE + 4], P[BASE + 5]), b1 = cvtpk(P[BASE + 6], P[BASE + 7]);                              \
    auto r0 = __builtin_amdgcn_permlane32_swap(a0, b0, false, false); auto r1 = __builtin_amdgcn_permlane32_swap(a1, b1, false, false); \
    u32x4 w = {r0[0], r1[0], r0[1], r1[1]}; OUT = *reinterpret_cast<bf16x8*>(&w); } while (0)
  PK4(p0, 0, pa0); PK4(p0, 8, pa1); PK4(p1, 0, pa2); PK4(p1, 8, pa3);
#undef PK4
}
DEVI void qkt(f32x16& p0, f32x16& p1, const char* Ks, const bf16x8* qr, const char* qrl, int r32, int hi) {
  p0 = f32x16{}; p1 = f32x16{};
#pragma unroll
  for (int d0 = 0; d0 < 12; ++d0) { const int cb = (d0 * 16 + hi * 8) * 2;
    const bf16x8 b0 = *reinterpret_cast<const bf16x8*>(Ks + KSWZ(r32, cb));
    const bf16x8 b1 = *reinterpret_cast<const bf16x8*>(Ks + KSWZ(32 + r32, cb));
    const bf16x8 q = d0 < 8 ? qr[d0 < 8 ? d0 : 0] : *reinterpret_cast<const bf16x8*>(qrl + (d0 - 8) * 1024);
    p0 = __builtin_amdgcn_mfma_f32_32x32x16_bf16(b0, q, p0, 0, 0, 0);
    p1 = __builtin_amdgcn_mfma_f32_32x32x16_bf16(b1, q, p1, 0, 0, 0); }
}
DEVI int v_st(int k, int c) { const int kk = (k & ~0xC) | ((k & 4) << 1) | ((k & 8) >> 1); return ((kk >> 3) * 4 + (c >> 5)) * 512 + ((kk & 7) * 32 + (c & 31)) * 2; }
DEVI int v_rd_base(int lane) { return ((lane & 3) << 3) | (((lane >> 2) & 3) << 6) | (((lane >> 4) & 1) << 5) | (((lane >> 5) & 1) << 8); }
constexpr int v_rd_off(int d0, int ks, int half) { return d0 * 512 + ks * 4096 + half * 2048; }
template <int OFF> DEVI s16x4 tr_read(int vb) { s16x4 r; asm volatile("ds_read_b64_tr_b16 %0, %1 offset:%2" : "=&v"(r) : "v"(vb), "i"(OFF) : "memory"); return r; }
template <int D0> DEVI void pv_one(f32x16& od, int vb, bf16x8 pa0, bf16x8 pa1, bf16x8 pa2, bf16x8 pa3) {
  const s16x4 l0 = tr_read<v_rd_off(D0, 0, 0)>(vb), h0 = tr_read<v_rd_off(D0, 0, 1)>(vb), l1 = tr_read<v_rd_off(D0, 1, 0)>(vb), h1 = tr_read<v_rd_off(D0, 1, 1)>(vb);
  const s16x4 l2 = tr_read<v_rd_off(D0, 2, 0)>(vb), h2 = tr_read<v_rd_off(D0, 2, 1)>(vb), l3 = tr_read<v_rd_off(D0, 3, 0)>(vb), h3 = tr_read<v_rd_off(D0, 3, 1)>(vb);
  asm volatile("s_waitcnt lgkmcnt(0)" ::: "memory"); SBAR();
#define PK(L, H) (bf16x8){L[0], L[1], L[2], L[3], H[0], H[1], H[2], H[3]}
  od = __builtin_amdgcn_mfma_f32_32x32x16_bf16(pa0, PK(l0, h0), od, 0, 0, 0);
  od = __builtin_amdgcn_mfma_f32_32x32x16_bf16(pa1, PK(l1, h1), od, 0, 0, 0);
  od = __builtin_amdgcn_mfma_f32_32x32x16_bf16(pa2, PK(l2, h2), od, 0, 0, 0);
  od = __builtin_amdgcn_mfma_f32_32x32x16_bf16(pa3, PK(l3, h3), od, 0, 0, 0);
#undef PK
}
DEVI void pv_d0(f32x16* o, int vb, bf16x8 pa0, bf16x8 pa1, bf16x8 pa2, bf16x8 pa3) {
  pv_one<0>(o[0], vb, pa0, pa1, pa2, pa3); pv_one<1>(o[1], vb, pa0, pa1, pa2, pa3); pv_one<2>(o[2], vb, pa0, pa1, pa2, pa3); pv_one<3>(o[3], vb, pa0, pa1, pa2, pa3);
}
DEVI void rope_frag(bf16x8& f1, bf16x8& f2, const float* cs) {
  u32x4 w1 = *reinterpret_cast<u32x4*>(&f1), w2 = *reinterpret_cast<u32x4*>(&f2); float a[8], b[8]; unpack8(w1, a); unpack8(w2, b);
  float c[8], s[8];
#pragma unroll
  for (int q = 0; q < 4; ++q) { const float4 t = *(const float4*)(cs + q * 4); c[q * 2] = t.x; s[q * 2] = t.y; c[q * 2 + 1] = t.z; s[q * 2 + 1] = t.w; }
  float x[8], y[8];
#pragma unroll
  for (int j = 0; j < 8; ++j) { x[j] = a[j] * c[j] - b[j] * s[j]; y[j] = a[j] * s[j] + b[j] * c[j]; }
  w1 = (u32x4){cvtpk(x[0], x[1]), cvtpk(x[2], x[3]), cvtpk(x[4], x[5]), cvtpk(x[6], x[7])};
  w2 = (u32x4){cvtpk(y[0], y[1]), cvtpk(y[2], y[3]), cvtpk(y[4], y[5]), cvtpk(y[6], y[7])};
  f1 = *reinterpret_cast<bf16x8*>(&w1); f2 = *reinterpret_cast<bf16x8*>(&w2);
}
DEVI void attn_item(bf16_t* __restrict__ Qb, const bf16_t* __restrict__ Kn, const bf16_t* __restrict__ Vh, const bf16_t* __restrict__ Kr, const float* __restrict__ rope, int pos0, char* lds) {
  const int tid = threadIdx.x, wid = tid >> 6, lane = tid & 63, r32 = lane & 31, hi = lane >> 5;
  char* V_lds = lds; char* K_lds = lds + 2 * SHM_V;
  float* wsl = (float*)(lds + 2 * SHM_V + 2 * SHM_K) + wid * 64; float* li_l = wsl; float* al_l = wsl + 32;
  char* qrl = lds + 2 * SHM_V + 2 * SHM_K + 2048 + wid * 4096 + lane * 16;
  float m_reg = -1e30f, l_reg = 0; f32x16 o[4] = {}; bf16x8 qr[8];
  bf16_t* Qw = Qb + (size_t)(wid * QBLK + r32) * 1536 + hi * 8;
#pragma unroll
  for (int d0 = 0; d0 < 8; ++d0) qr[d0] = *reinterpret_cast<const bf16x8*>(Qw + d0 * 16);
  { bf16x8 q8 = *reinterpret_cast<const bf16x8*>(Qw + 128), q9 = *reinterpret_cast<const bf16x8*>(Qw + 144), q10 = *reinterpret_cast<const bf16x8*>(Qw + 160), q11 = *reinterpret_cast<const bf16x8*>(Qw + 176);
    const int pos = pos0 + wid * QBLK + r32;
    rope_frag(q8, q9, rope + ((pos >> 6) * 16 + hi * 8) * 2); rope_frag(q10, q11, rope + ((pos & 63) * 16 + hi * 8) * 2);
    *reinterpret_cast<bf16x8*>(qrl) = q8; *reinterpret_cast<bf16x8*>(qrl + 1024) = q9; *reinterpret_cast<bf16x8*>(qrl + 2048) = q10; *reinterpret_cast<bf16x8*>(qrl + 3072) = q11; }
  const int sr = tid >> 4, sc = (tid & 15) * 8, vst0 = v_st(sr, sc), vst1 = v_st(32 + sr, sc);
  const int kst0 = KSWZ(sr, sc * 2), kst1 = KSWZ(32 + sr, sc * 2), kst2 = KSWZ(tid >> 3, 256 + (tid & 7) * 16);
  const int goff = sr * 2048 + sc, goffr = (tid >> 3) * 64 + (tid & 7) * 8;
  const int vb0 = (int)(uintptr_t)V_lds + v_rd_base(lane);
  u32x4 sv0, sv1, sk0, sk1, sk2;
#define SLOAD(k0) do { const bf16_t* vp = Vh + (size_t)(k0) * 2048 + goff; const bf16_t* kp = Kn + (size_t)(k0) * 2048 + goff; \
    sv0 = *(const u32x4*)vp; sv1 = *(const u32x4*)(vp + 32 * 2048); sk0 = *(const u32x4*)kp; sk1 = *(const u32x4*)(kp + 32 * 2048); \
    sk2 = *(const u32x4*)(Kr + (size_t)(k0) * 64 + goffr); } while (0)
#define SWRITE(b) do { *(u32x4*)(V_lds + (b) * SHM_V + vst0) = sv0; *(u32x4*)(V_lds + (b) * SHM_V + vst1) = sv1; \
    *(u32x4*)(K_lds + (b) * SHM_K + kst0) = sk0; *(u32x4*)(K_lds + (b) * SHM_K + kst1) = sk1; *(u32x4*)(K_lds + (b) * SHM_K + kst2) = sk2; } while (0)
#define SWAIT() asm volatile("s_waitcnt vmcnt(0)" ::: "memory")
#define RESC(a) do { if (__any((a) < 1.f)) { if (hi == 0) al_l[r32] = (a); asm volatile("s_waitcnt lgkmcnt(0)" ::: "memory"); \
    _Pragma("unroll") for (int d = 0; d < 4; ++d) _Pragma("unroll") for (int r = 0; r < 16; ++r) o[d][r] *= al_l[crow(r, hi)]; } } while (0)
  f32x16 pA0, pA1, pB0, pB1; float mnA, mnB, alA, alB; bf16x8 pa0, pa1, pa2, pa3; constexpr int NT = NKEY / KVBLK;
  SLOAD(0); SWAIT(); SWRITE(0); __syncthreads();
  qkt(pA0, pA1, K_lds, qr, qrl, r32, hi); partialSM(pA0, pA1, m_reg, mnA, alA);
  SLOAD(KVBLK);
  SWAIT(); SWRITE(1); __syncthreads();
  for (int j = 1; j + 1 < NT; j += 2) {
    SBAR(); qkt(pB0, pB1, K_lds + SHM_K, qr, qrl, r32, hi);
    finishSM(pA0, pA1, alA, l_reg, pa0, pa1, pa2, pa3); SBAR();
    SLOAD((j + 1) * KVBLK); SBAR();
    pv_d0(o, vb0, pa0, pa1, pa2, pa3); partialSM(pB0, pB1, m_reg, mnB, alB);
    __syncthreads(); SWAIT(); SWRITE(0);
    RESC(alB); __syncthreads();
    SBAR(); qkt(pA0, pA1, K_lds, qr, qrl, r32, hi);
    finishSM(pB0, pB1, alB, l_reg, pa0, pa1, pa2, pa3); SBAR();
    SLOAD((j + 2) * KVBLK); SBAR();
    pv_d0(o, vb0 + SHM_V, pa0, pa1, pa2, pa3); partialSM(pA0, pA1, m_reg, mnA, alA);
    __syncthreads(); SWAIT(); SWRITE(1);
    RESC(alA); __syncthreads();
  }
  SBAR(); qkt(pB0, pB1, K_lds + SHM_K, qr, qrl, r32, hi);
  finishSM(pA0, pA1, alA, l_reg, pa0, pa1, pa2, pa3); SBAR();
  pv_d0(o, vb0, pa0, pa1, pa2, pa3); partialSM(pB0, pB1, m_reg, mnB, alB);
  __syncthreads(); RESC(alB);
  finishSM(pB0, pB1, alB, l_reg, pa0, pa1, pa2, pa3); SBAR();
  pv_d0(o, vb0 + SHM_V, pa0, pa1, pa2, pa3);
  if (hi == 0) li_l[r32] = l_reg; asm volatile("s_waitcnt lgkmcnt(0)" ::: "memory");
  float rli[16];
#pragma unroll
  for (int r = 0; r < 16; ++r) rli[r] = __builtin_amdgcn_rcpf(li_l[crow(r, hi)]);
  bf16_t* Ow = Qb + (size_t)(wid * QBLK) * 1536;
#pragma unroll
  for (int r = 0; r < 16; ++r) { const int orow = crow(r, hi);
#pragma unroll
    for (int d0 = 0; d0 < 4; ++d0) Ow[(size_t)orow * 1536 + d0 * 32 + r32] = f2bf(o[d0][r] * rli[r]); }
  __syncthreads();
#undef SLOAD
#undef SWRITE
#undef SWAIT
#undef RESC
}
}
DEVI void attn_mfma(const Params& p, char* smem) {
  bf16_t* Q = (bf16_t*)(p.ws + O_RQ); const bf16_t* KV = (const bf16_t*)(p.ws + O_RKV); const bf16_t* KR = (const bf16_t*)(p.ws + O_KR);
  const float* rope = (const float*)(p.ws + O_ROPE);
  for (int it = blockIdx.x; it < NB * 8 * (SEQ / 256); it += gridDim.x) {
    const int bh = (it >> 8) * 8 + (it & 7), qb = (it & 255) >> 3, b = bh >> 3, h = bh & 7;
    at::attn_item(Q + (size_t)(b * SEQ + qb * 256) * 1536 + h * 192, KV + (size_t)b * NKEY * 2048 + h * 256, KV + (size_t)b * NKEY * 2048 + h * 256 + 128,
                  KR + (size_t)b * NKEY * 64, rope, qb * 256, smem);
  }
}
#if ATTN_MFMA
DEVI void ph_attn(const Params& p, char* smem) { attn_mfma(p, smem); }
#else
DEVI void ph_attn(const Params& p, char* smem) { attn_naive(p, smem); }
#endif

DEVI void ph_rows(const Params& p, char* smem) {
  const int tid = threadIdx.x, wave = tid >> 6, lane = tid & 63;
  const float* MOD = (const float*)(p.ws + O_MOD); const bf16_t* Y = (const bf16_t*)(p.ws + O_RA); const float* rssy = (const float*)(p.ws + O_RSSY);
  bf16_t* HX2 = (bf16_t*)(p.ws + O_RB);
  for (int row = blockIdx.x * NWAVE + wave; row < NTOK; row += gridDim.x * NWAVE) {
    const int b = row >> 13; const float* md = MOD + b * 6144;
    float ty = 0.f; { const float* pr = rssy + (size_t)row * 16;
#pragma unroll
      for (int j = 0; j < 16; ++j) ty += pr[j]; }
    const float ry = rsqrtf(ty * (1.f / 1024.f) + EPS);
    float x1[16]; float ss = 0.f;
#pragma unroll
    for (int i = 0; i < 4; ++i) { const int c = i * 256 + lane * 4; const float4 xv = *(const float4*)(p.x + (size_t)row * 1024 + c); const u32x2 yv = *(const u32x2*)(Y + (size_t)row * 1024 + c);
      const float4 gp = *(const float4*)(p.g_post1 + c), gt = *(const float4*)(md + 2048 + c);
      x1[i * 4 + 0] = xv.x + gt.x * (lo2f(yv[0]) * ry * gp.x); x1[i * 4 + 1] = xv.y + gt.y * (hi2f(yv[0]) * ry * gp.y);
      x1[i * 4 + 2] = xv.z + gt.z * (lo2f(yv[1]) * ry * gp.z); x1[i * 4 + 3] = xv.w + gt.w * (hi2f(yv[1]) * ry * gp.w);
#pragma unroll
      for (int j = 0; j < 4; ++j) ss += x1[i * 4 + j] * x1[i * 4 + j];
      *(float4*)(p.out + (size_t)row * 1024 + c) = make_float4(x1[i * 4], x1[i * 4 + 1], x1[i * 4 + 2], x1[i * 4 + 3]); }
    ss = wave_sum(ss); const float r2 = rsqrtf(ss * (1.f / 1024.f) + EPS);
#pragma unroll
    for (int i = 0; i < 4; ++i) { const int c = i * 256 + lane * 4; const float4 g2 = *(const float4*)(p.g_pre2 + c), sc = *(const float4*)(md + 4096 + c), sh = *(const float4*)(md + 3072 + c);
      st4bf(HX2 + (size_t)row * 1024 + c, x1[i * 4] * r2 * g2.x * (1.f + sc.x) + sh.x, x1[i * 4 + 1] * r2 * g2.y * (1.f + sc.y) + sh.y,
            x1[i * 4 + 2] * r2 * g2.z * (1.f + sc.z) + sh.z, x1[i * 4 + 3] * r2 * g2.w * (1.f + sc.w) + sh.w); }
  }
  convert_table(p.u_exp, (bf16_t*)(p.ws + O_RC));
}

DEVI void topk_naive(const Params& p, char* smem) {
  const int tid = threadIdx.x, wave = tid >> 6, lane = tid & 63;
  float* wl = (float*)smem + wave * 512; int* wi = (int*)wl;
  const bf16_t* QP = (const bf16_t*)(p.ws + O_RKV); const bf16_t* K1 = (const bf16_t*)(p.ws + O_K1); const bf16_t* K2 = (const bf16_t*)(p.ws + O_K2);
  int* IDX = (int*)(p.ws + O_RQ); float* GW = (float*)(p.ws + O_RQ + (size_t)NTOK * 128 * 4);
  for (int base = blockIdx.x * NWAVE; base < NTOK * 8; base += gridDim.x * NWAVE) {
    const int it = base + wave, token = it >> 3, h = it & 7;
    __syncthreads();
    const bf16_t* q = QP + (size_t)token * 2048 + h * 256;
    for (int d = lane; d < 256; d += 64) wl[d] = bf2f(q[d]);
    __syncthreads();
    float s[4] = {0.f, 0.f, 0.f, 0.f};
#pragma unroll 2
    for (int d8 = 0; d8 < 16; ++d8) {
      const float4 qa0 = *(const float4*)(wl + d8 * 8), qa1 = *(const float4*)(wl + d8 * 8 + 4), qb0 = *(const float4*)(wl + 128 + d8 * 8), qb1 = *(const float4*)(wl + 128 + d8 * 8 + 4);
#pragma unroll
      for (int w = 0; w < 4; ++w) { const int key = lane + (w & 1) * 64; const bf16_t* kp = (w < 2 ? K1 : K2) + key * 128;
        float kf[8]; unpack8(*(const u32x4*)(kp + d8 * 8), kf); const float4 q0 = w < 2 ? qa0 : qb0, q1 = w < 2 ? qa1 : qb1;
        s[w] += q0.x * kf[0] + q0.y * kf[1] + q0.z * kf[2] + q0.w * kf[3] + q1.x * kf[4] + q1.y * kf[5] + q1.z * kf[6] + q1.w * kf[7]; }
    }
#pragma unroll
    for (int half = 0; half < 2; ++half) { float a0 = s[half * 2], a1 = s[half * 2 + 1];
#pragma unroll 1
      for (int r = 0; r < 16; ++r) { float v; int i; if (a0 >= a1) { v = a0; i = lane; } else { v = a1; i = lane + 64; }
        for (int o = 32; o > 0; o >>= 1) { const float ov = __shfl_xor(v, o); const int oi = __shfl_xor(i, o); if (ov > v || (ov == v && oi < i)) { v = ov; i = oi; } }
        if (i == lane) a0 = -3.0e38f; else if (i == lane + 64) a1 = -3.0e38f;
        if (lane == 0) { wl[256 + half * 32 + r] = v; wi[256 + half * 32 + 16 + r] = i; } } }
    __syncthreads();
    float cv[4]; int ci[4];
#pragma unroll
    for (int j = 0; j < 4; ++j) { const int cidx = lane * 4 + j, i = cidx >> 4, jj = cidx & 15; cv[j] = wl[256 + i] + wl[256 + 32 + jj]; ci[j] = wi[256 + 16 + i] * 128 + wi[256 + 32 + 16 + jj]; }
    float myv = 0.f, vmax = 0.f; int myi = 0;
#pragma unroll 1
    for (int r = 0; r < 16; ++r) { float v = cv[0]; int pos = lane * 4, ei = ci[0];
#pragma unroll
      for (int j = 1; j < 4; ++j) if (cv[j] > v) { v = cv[j]; pos = lane * 4 + j; ei = ci[j]; }
      for (int o = 32; o > 0; o >>= 1) { const float ov = __shfl_xor(v, o); const int op = __shfl_xor(pos, o), oe = __shfl_xor(ei, o); if (ov > v || (ov == v && op < pos)) { v = ov; pos = op; ei = oe; } }
#pragma unroll
      for (int j = 0; j < 4; ++j) if (pos == lane * 4 + j) cv[j] = -3.0e38f;
      if (r == 0) vmax = v;
      if (lane == r) { myv = v; myi = ei; } }
    const float e = lane < 16 ? __expf(myv - vmax) : 0.f; const float sum = wave_sum(e);
    if (lane < 16) { IDX[(size_t)token * 128 + h * 16 + lane] = myi; GW[(size_t)token * 128 + h * 16 + lane] = e / sum; }
  }
}

namespace tk {
DEVI int f2sort(float f) { const int i = __float_as_int(f); return i ^ ((i >> 31) & 0x7fffffff); }
DEVI float sort2f(int s) { return __int_as_float(s ^ ((s >> 31) & 0x7fffffff)); }
DEVI void ce_desc(int& a, int& b) { const int hi = max(a, b), lo = min(a, b); a = hi; b = lo; }
DEVI void sort16_desc(int* a) {
#pragma unroll
  for (int lk = 1; lk <= 4; ++lk)
#pragma unroll
    for (int lj = lk - 1; lj >= 0; --lj)
#pragma unroll
      for (int i = 0; i < 16; ++i) { const int j = 1 << lj, k = 1 << lk, l = i ^ j;
        if (l > i) { const int hi = max(a[i], a[l]), lo = min(a[i], a[l]); if ((i & k) == 0) { a[i] = hi; a[l] = lo; } else { a[i] = lo; a[l] = hi; } } }
}
DEVI void bitonic_merge16_desc(int* a) {
#pragma unroll
  for (int lj = 3; lj >= 0; --lj)
#pragma unroll
    for (int i = 0; i < 16; ++i) { const int l = i ^ (1 << lj); if (l > i) ce_desc(a[i], a[l]); }
}
DEVI void merge_top16(int* a, const int* b) {
#pragma unroll
  for (int i = 0; i < 16; ++i) a[i] = max(a[i], b[15 - i]);
  bitonic_merge16_desc(a);
}
DEVI void half_top16(const bf16_t* __restrict__ qrow, const char* Kl, int r32, int hi, int* out) {
  bf16x8 qf[8];
#pragma unroll
  for (int d0 = 0; d0 < 8; ++d0) qf[d0] = *reinterpret_cast<const bf16x8*>(qrow + d0 * 16 + hi * 8);
  int a[64];
#pragma unroll
  for (int kt = 0; kt < 4; ++kt) { f32x16 acc = {};
    const int key = kt * 32 + r32;
#pragma unroll
    for (int d0 = 0; d0 < 8; ++d0) { const bf16x8 kf = *reinterpret_cast<const bf16x8*>(Kl + key * 256 + (((d0 * 2 + hi) ^ (key & 15)) << 4));
      acc = __builtin_amdgcn_mfma_f32_32x32x16_bf16(kf, qf[d0], acc, 0, 0, 0); }
#pragma unroll
    for (int r = 0; r < 16; ++r) { const int kidx = kt * 32 + (r & 3) + 8 * (r >> 2) + 4 * hi; a[kt * 16 + r] = (f2sort(acc[r]) & ~127) | (127 - kidx); } }
  sort16_desc(a); sort16_desc(a + 16); sort16_desc(a + 32); sort16_desc(a + 48);
  merge_top16(a, a + 16); merge_top16(a + 32, a + 48); merge_top16(a, a + 32);
  int L[16], H[16];
#pragma unroll
  for (int i = 0; i < 16; ++i) { auto rr = __builtin_amdgcn_permlane32_swap((unsigned)a[i], (unsigned)a[i], false, false); L[i] = (int)rr[0]; H[i] = (int)rr[1]; }
  merge_top16(L, H);
#pragma unroll
  for (int i = 0; i < 16; ++i) out[i] = L[i];
}
}
DEVI void topk_fast(const Params& p, char* smem) {
  const int tid = threadIdx.x, wave = tid >> 6, lane = tid & 63, r32 = lane & 31, hi = lane >> 5;
  const bf16_t* QP = (const bf16_t*)(p.ws + O_RKV);
  int* IDX = (int*)(p.ws + O_RQ); float* GW = (float*)(p.ws + O_RQ + (size_t)NTOK * 128 * 4);
  char* K1l = smem; char* K2l = smem + 32768; int* tab = (int*)(smem + 65536) + wave * (32 * 33);
  __syncthreads();
  { const bf16_t* K1 = (const bf16_t*)(p.ws + O_K1);
    for (int id = tid; id < 4096; id += NTHR) { const int key = id >> 4, c = id & 15; const u32x4 v = *(const u32x4*)(K1 + (size_t)key * 128 + c * 8);
      *(u32x4*)(smem + key * 256 + ((c ^ (key & 15)) << 4)) = v; } }
  __syncthreads();
  for (int item = blockIdx.x; item < NTOK * 8 / 256; item += gridDim.x) {
    const int row = item * 256 + wave * 32 + r32;
    const bf16_t* qrow = QP + (size_t)row * 256;
    int t1[16], t2[16];
    tk::half_top16(qrow, K1l, r32, hi, t1);
    tk::half_top16(qrow + 128, K2l, r32, hi, t2);
    float v1[16], v2[16];
#pragma unroll
    for (int i = 0; i < 16; ++i) { v1[i] = tk::sort2f(t1[i] & ~127); v2[i] = tk::sort2f(t2[i] & ~127); }
    if (hi == 0) {
#pragma unroll
      for (int i = 0; i < 16; ++i) { tab[r32 * 33 + i] = 127 - (t1[i] & 127); tab[r32 * 33 + 16 + i] = 127 - (t2[i] & 127); } }
#define CAND(i, j) ((tk::f2sort(v1[i] + v2[j]) & ~255) | (255 - ((i) * 16 + (j))))
    int g0[16], g1[16], g2[16];
#pragma unroll
    for (int j = 0; j < 16; ++j) g0[j] = CAND(0, j);
#pragma unroll
    for (int j = 0; j < 8; ++j) g1[j] = CAND(1, j);
#pragma unroll
    for (int j = 0; j < 5; ++j) g1[8 + j] = CAND(2, j);
#pragma unroll
    for (int j = 0; j < 3; ++j) g1[13 + j] = CAND(4, j);
#pragma unroll
    for (int j = 0; j < 4; ++j) g2[j] = CAND(3, j);
    g2[4] = CAND(5, 0); g2[5] = CAND(5, 1); g2[6] = CAND(6, 0); g2[7] = CAND(6, 1); g2[8] = CAND(7, 0); g2[9] = CAND(7, 1);
    g2[10] = CAND(8, 0); g2[11] = CAND(9, 0); g2[12] = CAND(10, 0); g2[13] = CAND(11, 0); g2[14] = CAND(12, 0); g2[15] = CAND(13, 0);
    tk::sort16_desc(g1); tk::sort16_desc(g2);
    tk::merge_top16(g0, g1); tk::merge_top16(g0, g2);
    { int x = CAND(14, 0);
#pragma unroll
      for (int i = 0; i < 16; ++i) { const int h = max(g0[i], x); x = min(g0[i], x); g0[i] = h; }
      x = CAND(15, 0);
#pragma unroll
      for (int i = 0; i < 16; ++i) { const int h = max(g0[i], x); x = min(g0[i], x); g0[i] = h; } }
#undef CAND
    asm volatile("s_waitcnt lgkmcnt(0)" ::: "memory");
    if (hi == 0) {
      int ex[16];
#pragma unroll
      for (int k = 0; k < 16; ++k) { const int pos = 255 - (g0[k] & 255); ex[k] = tab[r32 * 33 + (pos >> 4)] * 128 + tab[r32 * 33 + 16 + (pos & 15)]; }
      int* dst = IDX + (size_t)row * 16;
#pragma unroll
      for (int q = 0; q < 4; ++q) *(int4*)(dst + q * 4) = make_int4(ex[q * 4], ex[q * 4 + 1], ex[q * 4 + 2], ex[q * 4 + 3]);
    } else {
      float e[16]; const float vmax = tk::sort2f(g0[0] & ~255); float sum = 0.f;
#pragma unroll
      for (int k = 0; k < 16; ++k) { e[k] = __expf(tk::sort2f(g0[k] & ~255) - vmax); sum += e[k]; }
      const float inv = 1.f / sum; float* dst = GW + (size_t)row * 16;
#pragma unroll
      for (int q = 0; q < 4; ++q) *(float4*)(dst + q * 4) = make_float4(e[q * 4] * inv, e[q * 4 + 1] * inv, e[q * 4 + 2] * inv, e[q * 4 + 3] * inv);
    }
  }
}
#if TOPK_FAST
DEVI void ph_topk(const Params& p, char* smem) { topk_fast(p, smem); }
#else
DEVI void ph_topk(const Params& p, char* smem) { topk_naive(p, smem); }
#endif

DEVI void ph_gather(const Params& p, char* smem) {
  const int tid = threadIdx.x, wave = tid >> 6, lane = tid & 63;
  const bf16_t* HX2 = (const bf16_t*)(p.ws + O_RB); const bf16_t* UT = (const bf16_t*)(p.ws + O_RC); const bf16_t* VT = (const bf16_t*)(p.ws + O_RA);
  const int* IDX = (const int*)(p.ws + O_RQ); const float* GW = (const float*)(p.ws + O_RQ + (size_t)NTOK * 128 * 4);
  const float* MOD = (const float*)(p.ws + O_MOD);
  for (int t = blockIdx.x * NWAVE + wave; t < NTOK; t += gridDim.x * NWAVE) {
    float xf[16];
    unpack8(*(const u32x4*)(HX2 + (size_t)t * 1024 + lane * 8), xf); unpack8(*(const u32x4*)(HX2 + (size_t)t * 1024 + 512 + lane * 8), xf + 8);
    const int my_i0 = IDX[(size_t)t * 128 + lane], my_i1 = IDX[(size_t)t * 128 + 64 + lane];
    const float my_g0 = GW[(size_t)t * 128 + lane], my_g1 = GW[(size_t)t * 128 + 64 + lane];
    float acc[16];
#pragma unroll
    for (int j = 0; j < 16; ++j) acc[j] = 0.f;
    for (int e0 = 0; e0 < 128; e0 += 4) {
      int id[4]; float g[4]; u32x4 ua[4], ub[4], va[4], vb[4];
#pragma unroll
      for (int j = 0; j < 4; ++j) { const int e = e0 + j; id[j] = e0 < 64 ? __shfl(my_i0, e) : __shfl(my_i1, e - 64); g[j] = e0 < 64 ? __shfl(my_g0, e) : __shfl(my_g1, e - 64);
        const bf16_t* ur = UT + (size_t)id[j] * 1024; const bf16_t* vr = VT + (size_t)id[j] * 1024;
        ua[j] = *(const u32x4*)(ur + lane * 8); ub[j] = *(const u32x4*)(ur + 512 + lane * 8); va[j] = *(const u32x4*)(vr + lane * 8); vb[j] = *(const u32x4*)(vr + 512 + lane * 8); }
      float d[4];
#pragma unroll
      for (int j = 0; j < 4; ++j) { float uf[16]; unpack8(ua[j], uf); unpack8(ub[j], uf + 8); float s = 0.f;
#pragma unroll
        for (int k = 0; k < 16; ++k) s += xf[k] * uf[k];
        d[j] = s; }
#pragma unroll
      for (int j = 0; j < 4; ++j) d[j] = wave_sum(d[j]);
#pragma unroll
      for (int j = 0; j < 4; ++j) { const float cf = g[j] * gelu_t(d[j]); float vf[16]; unpack8(va[j], vf); unpack8(vb[j], vf + 8);
#pragma unroll
        for (int k = 0; k < 16; ++k) acc[k] += cf * vf[k]; }
    }
    float ss = 0.f;
#pragma unroll
    for (int k = 0; k < 16; ++k) ss += acc[k] * acc[k];
    ss = wave_sum(ss); const float rstd = rsqrtf(ss * (1.f / 1024.f) + EPS);
    const int b = t >> 13; const float* gt2 = MOD + b * 6144 + 5120;
#pragma unroll
    for (int hh = 0; hh < 2; ++hh) { const int c = hh * 512 + lane * 8; float* op = p.out + (size_t)t * 1024 + c;
#pragma unroll
      for (int q4 = 0; q4 < 2; ++q4) { float4 xv = *(const float4*)(op + q4 * 4); const float4 gt = *(const float4*)(gt2 + c + q4 * 4), gp = *(const float4*)(p.g_post2 + c + q4 * 4);
        xv.x += gt.x * (acc[hh * 8 + q4 * 4 + 0] * rstd * gp.x); xv.y += gt.y * (acc[hh * 8 + q4 * 4 + 1] * rstd * gp.y);
        xv.z += gt.z * (acc[hh * 8 + q4 * 4 + 2] * rstd * gp.z); xv.w += gt.w * (acc[hh * 8 + q4 * 4 + 3] * rstd * gp.w);
        *(float4*)(op + q4 * 4) = xv; } }
  }
}


#define XB_TMO      128
#define XB_XCNT(j)  (256  + 64 * (j))
#define XB_XSUB(j)  (1280 + 64 * (j))
#define XB_XGEN(j)  (2304 + 64 * (j))
#define XB_TOP      3328
#define XB_TOPGEN   3392
#define XCD_BAR_WORDS 3456
#define XB_SPIN_CAP (1u << 18)
#define LAS __attribute__((address_space(3)))
DEVI unsigned xb_ld(unsigned* p)              { return __hip_atomic_load(p, __ATOMIC_RELAXED, __HIP_MEMORY_SCOPE_AGENT); }
DEVI unsigned xb_add(unsigned* p, unsigned v) { return __hip_atomic_fetch_add(p, v, __ATOMIC_RELAXED, __HIP_MEMORY_SCOPE_AGENT); }
DEVI unsigned xb_xcc_id() { return (unsigned)__builtin_amdgcn_s_getreg((3 << 11) | 20) & 0xFu; }
#define XB_SPIN(cond, bar) do { unsigned _sp = 0; while (cond) { __builtin_amdgcn_s_sleep(1); \
    if ((++_sp & 255u) == 0u) { if (xb_ld(&(bar)[XB_TMO])) break; if (_sp > XB_SPIN_CAP) { atomicAdd(&(bar)[XB_TMO], 1u); break; } } } } while (0)
struct XcdBarrier { unsigned* bar; unsigned x; volatile LAS unsigned* st; };
DEVI XcdBarrier xcd_barrier_post(unsigned* bar, volatile LAS unsigned* st) {
  XcdBarrier b; b.bar = bar; b.x = xb_xcc_id(); b.st = st;
  if (threadIdx.x == 0) (void)xb_add(&bar[XB_XCNT(b.x)], 1u);
  return b;
}
DEVI void xcd_barrier_complete(unsigned* bar, unsigned x, unsigned& nloc, unsigned& nx) {
  const unsigned G = gridDim.x * gridDim.y * gridDim.z;
  unsigned sum, cnt, mine, sp = 0u;
  for (;;) {
    sum = 0u; cnt = 0u; mine = 0u;
#pragma unroll
    for (unsigned j = 0; j < 16; ++j) { const unsigned c = xb_ld(&bar[XB_XCNT(j)]); sum += c; cnt += (c > 0u) ? 1u : 0u; mine = (j == x) ? c : mine; }
    if (sum == G) break;
    __builtin_amdgcn_s_sleep(1);
    if ((++sp & 255u) == 0u) { if (xb_ld(&bar[XB_TMO])) break; if (sp > XB_SPIN_CAP) { atomicAdd(&bar[XB_TMO], 1u); break; } }
  }
  nloc = mine > 0u ? mine : 1u; nx = cnt > 0u ? cnt : 1u;
}
DEVI void xcd_barrier(const XcdBarrier& b) {
  asm volatile("s_waitcnt vmcnt(0)" ::: "memory");
  __syncthreads();
  if (threadIdx.x == 0) {
    unsigned* bar = b.bar;
    __builtin_amdgcn_s_waitcnt(0);
    unsigned nloc = b.st[0], nx = b.st[1];
    if (nloc == 0u) { xcd_barrier_complete(bar, b.x, nloc, nx); b.st[0] = nloc; b.st[1] = nx; }
    const unsigned old = xb_add(&bar[XB_XSUB(b.x)], 1u);
    const unsigned gen = old / nloc;
    if (old + 1u == (gen + 1u) * nloc) {
      __builtin_amdgcn_fence(__ATOMIC_RELEASE, "agent");
      asm volatile("s_waitcnt vmcnt(0)" ::: "memory");
      const unsigned og = xb_add(&bar[XB_TOP], 1u);
      const unsigned tg = og / nx;
      if (og + 1u == (tg + 1u) * nx) xb_add(&bar[XB_TOPGEN], 1u);
      else XB_SPIN(xb_ld(&bar[XB_TOPGEN]) == tg, bar);
      __builtin_amdgcn_fence(__ATOMIC_ACQUIRE, "agent");
      xb_add(&bar[XB_XGEN(b.x)], 1u);
      asm volatile("s_waitcnt vmcnt(0)" ::: "memory");
    } else {
      XB_SPIN(xb_ld(&bar[XB_XGEN(b.x)]) == gen, bar);
      __builtin_amdgcn_fence(__ATOMIC_ACQUIRE, "agent");
      asm volatile("s_waitcnt vmcnt(0)" ::: "memory");
    }
  }
  __syncthreads();
}

constexpr int NPHASE = 12;
template <int PH> DEVI void run_phase(const Params& p, char* smem) {
  if constexpr (PH == 0) ph_prep(p, smem);
  else if constexpr (PH == 1) ph_hx(p, smem);
  else if constexpr (PH == 2) ph_inproj(p, smem);
  else if constexpr (PH == 3) ph_mid(p, smem);
  else if constexpr (PH == 4) ph_attn(p, smem);
  else if constexpr (PH == 5) ph_gates(p, smem);
  else if constexpr (PH == 6) ph_merge(p, smem);
  else if constexpr (PH == 7) ph_wo(p, smem);
  else if constexpr (PH == 8) ph_rows(p, smem);
  else if constexpr (PH == 9) ph_wpq(p, smem);
  else if constexpr (PH == 10) ph_topk(p, smem);
  else if constexpr (PH == 11) ph_gather(p, smem);
}

template <int PH> __global__ __launch_bounds__(NTHR) void k_phase(Params p) {
  extern __shared__ __attribute__((aligned(16))) char smem[];
  run_phase<PH>(p, smem);
}

#ifndef PROBE_PH
#define PROBE_PH -1
#endif
#if MEGA
#define RUNPH(N) do { if (PROBE_PH == N) t0 = __builtin_amdgcn_s_memrealtime(); run_phase<N>(p, smem); if (N < NPHASE - 1) xcd_barrier(xb); \
    if (PROBE_PH == N) t1 = __builtin_amdgcn_s_memrealtime(); } while (0)
__global__ __launch_bounds__(NTHR) void k_mega(Params p) {
  extern __shared__ __attribute__((aligned(16))) char smem[];
  cg::grid_group grid = cg::this_grid();
  unsigned long long t0 = 0, t1 = 0;
  unsigned* bar = (unsigned*)(p.ws + O_BAR);
  volatile LAS unsigned* xst = (volatile LAS unsigned*)(smem + LDS_BYTES - 16);
  if (threadIdx.x == 0) { xst[0] = 0u; xst[1] = 0u; }
  if (blockIdx.x == 0) for (int i = threadIdx.x; i < XCD_BAR_WORDS; i += NTHR) bar[i] = 0u;
  if (PROBE_PH == 0) t0 = __builtin_amdgcn_s_memrealtime();
  run_phase<0>(p, smem);
  grid.sync();
  if (PROBE_PH == 0) t1 = __builtin_amdgcn_s_memrealtime();
  const XcdBarrier xb = xcd_barrier_post(bar, xst);
  RUNPH(1); RUNPH(2); RUNPH(3); RUNPH(4); RUNPH(5); RUNPH(6); RUNPH(7); RUNPH(8); RUNPH(9); RUNPH(10); RUNPH(11);
  if (PROBE_PH >= 0) { __syncthreads(); if (blockIdx.x == 0 && threadIdx.x == 0) p.out[0] += exp2f(rintf(log2f((float)(t1 - t0) * 1e-3f) * 5.f) * 0.2f); }
}
#endif

template <int PH> static void launch_phase(const Params& p, int grid, hipStream_t stream) {
  hipLaunchKernelGGL(k_phase<PH>, dim3(grid), dim3(NTHR), LDS_BYTES, stream, p);
}
template <int PH> static void set_attr() { (void)hipFuncSetAttribute((const void*)k_phase<PH>, hipFuncAttributeMaxDynamicSharedMemorySize, LDS_BYTES); }

extern "C" void kernel_launch(void* const* d_in, const int* in_sizes, int n_in, void* d_out, int out_size, void* d_ws, size_t ws_size, hipStream_t stream) {
  static int grid = 0;
  if (grid == 0) {
    if (n_in != 26 || out_size != NTOK * DM || ws_size < O_END) { fprintf(stderr, "kernel_launch: unexpected shapes n_in %d out %d ws %zu (need %zu)\n", n_in, out_size, ws_size, (size_t)O_END); grid = -1; return; }
#if MEGA
    (void)hipFuncSetAttribute((const void*)k_mega, hipFuncAttributeMaxDynamicSharedMemorySize, LDS_BYTES);
    int dev = 0, cus = 0, per_cu = 0; (void)hipGetDevice(&dev); (void)hipDeviceGetAttribute(&cus, hipDeviceAttributeMultiprocessorCount, dev);
    (void)hipOccupancyMaxActiveBlocksPerMultiprocessor(&per_cu, (const void*)k_mega, NTHR, LDS_BYTES);
    if (per_cu < 1) { fprintf(stderr, "kernel_launch: occupancy query says %d blocks per CU\n", per_cu); grid = -1; return; }
    grid = cus;
#else
    set_attr<0>(); set_attr<1>(); set_attr<2>(); set_attr<3>(); set_attr<4>(); set_attr<5>(); set_attr<6>(); set_attr<7>(); set_attr<8>(); set_attr<9>(); set_attr<10>(); set_attr<11>();
    grid = 256;
#endif
  }
  if (grid < 0) return;
  Params p{};
  const float** pp = (const float**)&p;
  for (int i = 0; i < 26; ++i) pp[i] = (const float*)d_in[i];
  p.out = (float*)d_out; p.ws = (char*)d_ws;
#if MEGA
  void* args[] = {&p};
  hipError_t e = hipLaunchCooperativeKernel((const void*)k_mega, dim3(grid), dim3(NTHR), args, LDS_BYTES, stream);
  if (e != hipSuccess) fprintf(stderr, "cooperative launch failed: %s (grid %d)\n", hipGetErrorString(e), grid);
#else
  launch_phase<0>(p, grid, stream); launch_phase<1>(p, grid, stream); launch_phase<2>(p, grid, stream); launch_phase<3>(p, grid, stream);
  launch_phase<4>(p, grid, stream); launch_phase<5>(p, grid, stream); launch_phase<6>(p, grid, stream); launch_phase<7>(p, grid, stream);
  launch_phase<8>(p, grid, stream); launch_phase<9>(p, grid, stream); launch_phase<10>(p, grid, stream); launch_phase<11>(p, grid, stream);
#endif
}
```

```cpp
#include <hip/hip_runtime.h>
#include <hip/hip_cooperative_groups.h>
#include <cstdint>
#include <cstdio>
namespace cg = cooperative_groups;

#ifndef MEGA
#define MEGA 1
#endif
#ifndef GEMM_MFMA
#define GEMM_MFMA 1
#endif
#ifndef ATTN_MFMA
#define ATTN_MFMA 1
#endif
#ifndef TOPK_FAST
#define TOPK_FAST 1
#endif

#define DEVI __device__ __forceinline__
typedef unsigned short bf16_t;
using bf16x8 = __attribute__((ext_vector_type(8))) short;
using bf16x4 = __attribute__((ext_vector_type(4))) short;
using f32x4  = __attribute__((ext_vector_type(4))) float;
using f32x16 = __attribute__((ext_vector_type(16))) float;
using u32x4  = __attribute__((ext_vector_type(4))) unsigned;
using u32x2  = __attribute__((ext_vector_type(2))) unsigned;

constexpr int DM = 1024, NB = 2, SEQ = 8192, NTOK = NB * SEQ, CTXL = 256, NCTX = NB * CTXL, NROW = NTOK + NCTX, NKEY = SEQ + CTXL;
constexpr int INW = 4544, INWP = 4608;
constexpr int NPRE = 2560;
constexpr float EPS = 1e-6f;
constexpr int NTHR = 512, NWAVE = 8;
constexpr int LDS_BYTES = 147456;

constexpr size_t al256(size_t x) { return (x + 255) / 256 * 256; }
constexpr size_t O_WIN   = 0;
constexpr size_t O_WUQ   = O_WIN  + al256((size_t)INWP * 1024 * 2);
constexpr size_t O_WUKV  = O_WUQ  + al256((size_t)1536 * 256 * 2);
constexpr size_t O_WPA   = O_WUKV + al256((size_t)2048 * 128 * 2);
constexpr size_t O_WPB   = O_WPA  + al256((size_t)1024 * 1024 * 2);
constexpr size_t O_WO    = O_WPB  + al256((size_t)1024 * 1024 * 2);
constexpr size_t O_WPQ   = O_WO   + al256((size_t)1024 * 1024 * 2);
constexpr size_t O_WS    = O_WPQ  + al256((size_t)2048 * 1024 * 2);
constexpr size_t O_K1    = O_WS   + al256((size_t)8 * 128 * 128 * 2);
constexpr size_t O_K2    = O_K1   + al256((size_t)128 * 128 * 2);
constexpr size_t O_MOD   = O_K2   + al256((size_t)128 * 128 * 2);
constexpr size_t O_ROPE  = O_MOD  + al256((size_t)3 * 6144 * 4);
constexpr size_t O_BAR   = O_ROPE + al256((size_t)128 * 16 * 2 * 4);
constexpr size_t O_RSSV  = O_BAR + al256((size_t)3456 * 4);
constexpr size_t O_RSSQ  = O_RSSV + (size_t)NTOK * 16 * 4;
constexpr size_t O_RSSKV = O_RSSQ + (size_t)NTOK * 4 * 4;
constexpr size_t O_RSSY  = O_RSSKV + (size_t)NROW * 2 * 4;
constexpr size_t O_RSSEND = O_RSSY + (size_t)NTOK * 16 * 4;
constexpr size_t O_RA    = al256(O_RSSEND);
constexpr size_t O_RB    = O_RA  + al256((size_t)NROW * 1024 * 2);
constexpr size_t O_RC    = O_RB  + al256((size_t)NTOK * 1024 * 2);
constexpr size_t O_CQ    = O_RC  + al256((size_t)NTOK * 1024 * 2);
constexpr size_t O_CKV   = O_CQ  + al256((size_t)NTOK * 256 * 2);
constexpr size_t O_KR    = O_CKV + al256((size_t)NROW * 128 * 2);
constexpr size_t O_RQ    = O_KR  + al256((size_t)NROW * 64 * 2);
constexpr size_t O_RKV   = O_RQ  + al256((size_t)NTOK * 1536 * 2);
constexpr size_t O_END   = O_RKV + al256((size_t)NROW * 2048 * 2);
static_assert(O_END <= (size_t)258 * 1024 * 1024, "workspace too large");

struct Params {
  const float *x, *c, *ctx, *c_ctx, *w_mod, *b_mod, *g_pre1, *g_post1, *g_pre2, *g_post2, *w_in, *g_q, *g_kv, *w_uq, *w_ukv, *g_sgu, *w_s, *b_s,
      *w_pa, *w_pb, *w_o, *w_pq, *k1, *k2, *u_exp, *v_exp;
  float* out; char* ws;
};

DEVI float bf2f(unsigned short h) { return __uint_as_float(((unsigned)h) << 16); }
DEVI unsigned short f2bf(float f) { unsigned u = __float_as_uint(f); u += 0x7fffu + ((u >> 16) & 1u); return (unsigned short)(u >> 16); }
DEVI unsigned pack2(float a, float b) { return (unsigned)f2bf(a) | ((unsigned)f2bf(b) << 16); }
DEVI float lo2f(unsigned w) { return __uint_as_float(w << 16); }
DEVI float hi2f(unsigned w) { return __uint_as_float(w & 0xffff0000u); }
DEVI void unpack8(const u32x4& w, float* f) {
  f[0] = lo2f(w[0]); f[1] = hi2f(w[0]); f[2] = lo2f(w[1]); f[3] = hi2f(w[1]); f[4] = lo2f(w[2]); f[5] = hi2f(w[2]); f[6] = lo2f(w[3]); f[7] = hi2f(w[3]);
}
DEVI float gelu_t(float x) { float z = 0.7978845608028654f * (x + 0.044715f * x * x * x); return x / (1.f + __expf(-2.f * z)); }
DEVI float sigmoidf_(float x) { return 1.f / (1.f + __expf(-x)); }
DEVI float wave_sum(float v) { for (int o = 32; o > 0; o >>= 1) v += __shfl_xor(v, o); return v; }
DEVI float wave_max(float v) { for (int o = 32; o > 0; o >>= 1) v = fmaxf(v, __shfl_xor(v, o)); return v; }
DEVI int keyrow(int row) { if (row < NTOK) return (row >> 13) * NKEY + (row & 8191); int c = row - NTOK; return (c >> 8) * NKEY + SEQ + (c & 255); }

__device__ const float ROPE_FREQ[16] = {1.0f, 0.5623413324356079f, 0.3162277638912201f, 0.17782793939113617f, 0.10000000149011612f, 0.05623413249850273f, 0.03162277489900589f, 0.017782794311642647f, 0.009999999776482582f, 0.005623413249850273f, 0.003162277629598975f, 0.0017782794311642647f, 0.0010000000474974513f, 0.000562341301701963f, 0.0003162277571391314f, 0.00017782794020604342f};
DEVI void sincos_small(double a, double& cs, double& sn) {
  const double k = rint(a * 0.15915494309189535); const double r = fma(-k, 6.283185307179586, a) - k * 2.4492935982947064e-16;
  const double r2 = r * r; double s = 0.0, c = 0.0;
#pragma unroll
  for (int n = 12; n >= 1; --n) { s = (1.0 - s * r2 / (double)((2 * n) * (2 * n + 1))); c = (1.0 - c * r2 / (double)((2 * n - 1) * (2 * n))); }
  sn = r * s; cs = c;
}

DEVI void transpose_job(const float* __restrict__ src, int K, int N, bf16_t* __restrict__ dst, const float* __restrict__ gk, bool isWin, int ntiles, char* smem) {
  const int tid = threadIdx.x; bf16_t* tl = (bf16_t*)smem; const int kt = K / 64;
  for (int idx = blockIdx.x; idx < ntiles; idx += gridDim.x) {
    const int ktile = idx % kt, ntile = idx / kt, k0 = ktile * 64, n0d = ntile * 64;
    int n0s = n0d; bool zero = false;
    if (isWin) { if (n0d == 2496) zero = true; else if (n0d >= 2560) n0s = n0d - 64; }
    { const int kk = tid >> 3, nn8 = (tid & 7) * 8; f32x4 va = {0.f, 0.f, 0.f, 0.f}, vb = va;
      if (!zero) { const float* s = src + (size_t)(k0 + kk) * N + n0s + nn8; const float4 a = *(const float4*)s, b = *(const float4*)(s + 4);
        const float sc = gk ? gk[k0 + kk] : 1.f; va = (f32x4){a.x, a.y, a.z, a.w} * sc; vb = (f32x4){b.x, b.y, b.z, b.w} * sc; }
      bf16_t* tp = tl + nn8 * 72 + kk;
      tp[0] = f2bf(va[0]); tp[72] = f2bf(va[1]); tp[144] = f2bf(va[2]); tp[216] = f2bf(va[3]); tp[288] = f2bf(vb[0]); tp[360] = f2bf(vb[1]); tp[432] = f2bf(vb[2]); tp[504] = f2bf(vb[3]); }
    __syncthreads();
    { const int nn = tid >> 3, kk8 = (tid & 7) * 8;
      const u32x4 o = *(const u32x4*)(tl + nn * 72 + kk8);
      *(u32x4*)(dst + (size_t)(n0d + nn) * K + k0 + kk8) = o; }
    __syncthreads();
  }
}

DEVI void ph_prep(const Params& p, char* smem) {
  const int tid = threadIdx.x, bid = blockIdx.x, nb = gridDim.x;
  char* ws = p.ws;
  if (bid == 0) { float* rope = (float*)(ws + O_ROPE);
    for (int i = tid; i < 128 * 16; i += NTHR) { const int pos = i >> 4, f = i & 15; const float ang = (float)pos * ROPE_FREQ[f];
      double cs, sn; sincos_small((double)ang, cs, sn); rope[i * 2] = (float)cs; rope[i * 2 + 1] = (float)sn; } }
  { float* red = (float*)smem; float* MOD = (float*)(ws + O_MOD);
    for (int it = bid; it < 256; it += nb) {
      const int cgp = tid % 6, kg = tid / 6;
      f32x4 a0 = {0.f, 0.f, 0.f, 0.f}, a1 = a0, a2 = a0;
      if (tid < 510) {
        for (int k = kg; k < 1024; k += 85) {
          const float4 w4 = *(const float4*)(p.w_mod + (size_t)k * 6144 + it * 24 + cgp * 4);
          const f32x4 w = {w4.x, w4.y, w4.z, w4.w};
          const float c0 = p.c[k], c1 = p.c[1024 + k], c2 = p.c_ctx[k];
          a0 += w * (c0 / (1.f + __expf(-c0))); a1 += w * (c1 / (1.f + __expf(-c1))); a2 += w * (c2 / (1.f + __expf(-c2)));
        }
        float* rp = red + kg * 72 + cgp * 4;
        rp[0] = a0[0]; rp[1] = a0[1]; rp[2] = a0[2]; rp[3] = a0[3];
        rp[24] = a1[0]; rp[25] = a1[1]; rp[26] = a1[2]; rp[27] = a1[3];
        rp[48] = a2[0]; rp[49] = a2[1]; rp[50] = a2[2]; rp[51] = a2[3];
      }
      __syncthreads();
      if (tid < 72) { float s = 0.f; for (int g = 0; g < 85; ++g) s += red[g * 72 + tid]; int r = tid / 24, n = it * 24 + tid % 24; MOD[r * 6144 + n] = s + p.b_mod[n]; }
      __syncthreads();
    } }
  transpose_job(p.w_in,  1024, INW,  (bf16_t*)(ws + O_WIN),  nullptr, true,  1152, smem);
  transpose_job(p.w_uq,  256,  1536, (bf16_t*)(ws + O_WUQ),  p.g_q,   false, 96,   smem);
  transpose_job(p.w_ukv, 128,  2048, (bf16_t*)(ws + O_WUKV), p.g_kv,  false, 64,   smem);
  transpose_job(p.w_pa,  1024, 1024, (bf16_t*)(ws + O_WPA),  nullptr, false, 256,  smem);
  transpose_job(p.w_pb,  1024, 1024, (bf16_t*)(ws + O_WPB),  nullptr, false, 256,  smem);
  transpose_job(p.w_o,   1024, 1024, (bf16_t*)(ws + O_WO),   nullptr, false, 256,  smem);
  transpose_job(p.w_pq,  1024, 2048, (bf16_t*)(ws + O_WPQ),  nullptr, false, 512,  smem);
  { const int n8 = (131072 + 16384 + 16384) / 8;
    for (int i = bid * NTHR + tid; i < n8; i += nb * NTHR) {
      int e = i * 8; const float* s; bf16_t* d;
      if (e < 131072) { s = p.w_s + e; d = (bf16_t*)(ws + O_WS) + e; }
      else if (e < 131072 + 16384) { s = p.k1 + (e - 131072); d = (bf16_t*)(ws + O_K1) + (e - 131072); }
      else { s = p.k2 + (e - 131072 - 16384); d = (bf16_t*)(ws + O_K2) + (e - 131072 - 16384); }
      const float4 a = *(const float4*)s, b = *(const float4*)(s + 4);
      u32x4 o = {pack2(a.x, a.y), pack2(a.z, a.w), pack2(b.x, b.y), pack2(b.z, b.w)};
      *(u32x4*)d = o;
    } }
}

DEVI void convert_table(const float* __restrict__ src, bf16_t* __restrict__ dst) {
  const int n8 = 16384 * 1024 / 8;
  for (int i = blockIdx.x * NTHR + threadIdx.x; i < n8; i += gridDim.x * NTHR) {
    const float4 a = *(const float4*)(src + (size_t)i * 8), b = *(const float4*)(src + (size_t)i * 8 + 4);
    u32x4 o = {pack2(a.x, a.y), pack2(a.z, a.w), pack2(b.x, b.y), pack2(b.z, b.w)};
    *(u32x4*)(dst + (size_t)i * 8) = o;
  }
}

DEVI void ph_hx(const Params& p, char* smem) {
  const int tid = threadIdx.x, wave = tid >> 6, lane = tid & 63;
  float* mA = (float*)smem; float* mB = mA + 3 * 1024;
  const float* MOD = (const float*)(p.ws + O_MOD);
  for (int i = tid; i < 3072; i += NTHR) { int r = i >> 10, c = i & 1023; mA[i] = p.g_pre1[c] * (1.f + MOD[r * 6144 + 1024 + c]); mB[i] = MOD[r * 6144 + c]; }
  __syncthreads();
  bf16_t* HX = (bf16_t*)(p.ws + O_RA);
  for (int row = blockIdx.x * NWAVE + wave; row < NROW; row += gridDim.x * NWAVE) {
    const float* src = row < NTOK ? p.x + (size_t)row * 1024 : p.ctx + (size_t)(row - NTOK) * 1024;
    const int mr = row < NTOK ? (row >> 13) : 2;
    float4 v[4]; float ss = 0.f;
#pragma unroll
    for (int i = 0; i < 4; ++i) { v[i] = *(const float4*)(src + i * 256 + lane * 4); ss += v[i].x * v[i].x + v[i].y * v[i].y + v[i].z * v[i].z + v[i].w * v[i].w; }
    ss = wave_sum(ss); const float rstd = rsqrtf(ss * (1.f / 1024.f) + EPS);
#pragma unroll
    for (int i = 0; i < 4; ++i) { const int c = i * 256 + lane * 4; const float* a = mA + mr * 1024 + c; const float* b = mB + mr * 1024 + c;
      u32x2 o = {pack2(v[i].x * rstd * a[0] + b[0], v[i].y * rstd * a[1] + b[1]), pack2(v[i].z * rstd * a[2] + b[2], v[i].w * rstd * a[3] + b[3])};
      *(u32x2*)(HX + (size_t)row * 1024 + c) = o; }
  }
}

DEVI int lds_sw(int row, int c) { return row * 128 + ((c ^ (row & 7)) << 4); }
template <int BM, int BN, bool ACOLMAP, bool GLDS, class Epi>
DEVI void gemm_tile_mfma(const bf16_t* __restrict__ A, int lda, const bf16_t* __restrict__ Bm, int ldb, int K, int row0, int col0, const Epi& epi, const float* kscale, char* smem) {
  constexpr int WNW = BN / 64, WMW = 8 / WNW, WTM = BM / WMW, MI = WTM / 16, ACH = BM / 64, BCH = BN / 64, ABYTES = BM * 128, BBYTES = BN * 128, STAGE = ABYTES + BBYTES;
  const int tid = threadIdx.x, wave = tid >> 6, lane = tid & 63, wm = wave / WNW, wn = wave % WNW, l15 = lane & 15, lq = lane >> 4;
  f32x4 acc[MI][4];
#pragma unroll
  for (int mi = 0; mi < MI; ++mi)
#pragma unroll
    for (int ni = 0; ni < 4; ++ni) acc[mi][ni] = (f32x4){0.f, 0.f, 0.f, 0.f};
  const int nk = K >> 6;
  const int sr = tid >> 3, scc = tid & 7;
  auto compute = [&](int buf) {
    const char* sa = smem + buf * STAGE; const char* sb = sa + ABYTES;
#pragma unroll
    for (int ks = 0; ks < 2; ++ks) { const int kc = ks * 4 + lq; bf16x8 bfr[4];
#pragma unroll
      for (int ni = 0; ni < 4; ++ni) bfr[ni] = *(const bf16x8*)(sb + lds_sw(wn * 64 + ni * 16 + l15, kc));
#pragma unroll
      for (int mi = 0; mi < MI; ++mi) { const bf16x8 af = *(const bf16x8*)(sa + lds_sw(wm * WTM + mi * 16 + l15, kc));
#pragma unroll
        for (int ni = 0; ni < 4; ++ni) acc[mi][ni] = __builtin_amdgcn_mfma_f32_16x16x32_bf16(bfr[ni], af, acc[mi][ni], 0, 0, 0); }
      if (MI > 4) __builtin_amdgcn_sched_barrier(0); }
  };
  if constexpr (GLDS) {
    const unsigned aoff = (unsigned)(sr * lda + ((scc ^ (sr & 7)) * 8)) * 2u, boff = (unsigned)(sr * ldb + ((scc ^ (sr & 7)) * 8)) * 2u;
    auto gstage = [&](int buf, int kt) {
      const int k0 = kt * 64, ka = ACOLMAP ? k0 + (k0 >> 7) * 64 : k0;
      char* sa = smem + buf * STAGE + wave * 1024; char* sb = sa + ABYTES;
#pragma unroll
      for (int i = 0; i < ACH; ++i) __builtin_amdgcn_global_load_lds((const unsigned*)((const char*)(A + (size_t)(64 * i) * lda + ka) + aoff), (unsigned*)(sa + i * 8192), 16, 0, 0);
#pragma unroll
      for (int i = 0; i < BCH; ++i) __builtin_amdgcn_global_load_lds((const unsigned*)((const char*)(Bm + (size_t)(64 * i) * ldb + k0) + boff), (unsigned*)(sb + i * 8192), 16, 0, 0);
    };
    gstage(0, 0); asm volatile("s_waitcnt vmcnt(0)" ::: "memory"); __syncthreads();
    for (int kt = 0; kt < nk; ++kt) {
      if (kt + 1 < nk) gstage((kt + 1) & 1, kt + 1);
      compute(kt & 1);
      asm volatile("s_waitcnt vmcnt(0)" ::: "memory"); __syncthreads();
    }
  } else {
    u32x4 ra[ACH], rb[BCH];
    const unsigned aoff = (unsigned)(sr * lda + scc * 8) * 2u, boff = (unsigned)(sr * ldb + scc * 8) * 2u;
    const int sdst = lds_sw(sr, scc);
    auto gload = [&](int kt) {
      const int k0 = kt * 64, ka = ACOLMAP ? k0 + (k0 >> 7) * 64 : k0;
#pragma unroll
      for (int i = 0; i < ACH; ++i) { const char* ub = (const char*)(A + (size_t)(64 * i) * lda + ka); ra[i] = *(const u32x4*)(ub + aoff); }
#pragma unroll
      for (int i = 0; i < BCH; ++i) { const char* ub = (const char*)(Bm + (size_t)(64 * i) * ldb + k0); rb[i] = *(const u32x4*)(ub + boff); }
    };
    auto lstore = [&](int buf, int kt) {
      char* sa = smem + buf * STAGE + sdst; char* sb = sa + ABYTES;
#pragma unroll
      for (int i = 0; i < ACH; ++i) { u32x4 v = ra[i];
        if (kscale) { float f[8]; unpack8(v, f); const float* ks = kscale + kt * 64 + scc * 8;
          v = (u32x4){pack2(f[0] * ks[0], f[1] * ks[1]), pack2(f[2] * ks[2], f[3] * ks[3]), pack2(f[4] * ks[4], f[5] * ks[5]), pack2(f[6] * ks[6], f[7] * ks[7])}; }
        *(u32x4*)(sa + i * 8192) = v; }
#pragma unroll
      for (int i = 0; i < BCH; ++i) *(u32x4*)(sb + i * 8192) = rb[i];
    };
    gload(0); lstore(0, 0); __syncthreads();
    for (int kt = 0; kt < nk; ++kt) {
      if (kt + 1 < nk) gload(kt + 1);
      compute(kt & 1);
      if (kt + 1 < nk) lstore((kt + 1) & 1, kt + 1);
      __syncthreads();
    }
  }
#pragma unroll
  for (int mi = 0; mi < MI; ++mi) { const int row = row0 + wm * WTM + mi * 16 + l15; float sq = 0.f;
#pragma unroll
    for (int ni = 0; ni < 4; ++ni) { const float v[4] = {acc[mi][ni][0], acc[mi][ni][1], acc[mi][ni][2], acc[mi][ni][3]}; sq += epi(row, col0 + wn * 64 + ni * 16 + lq * 4, v); }
    if (Epi::RSS) { sq += __shfl_xor(sq, 16); sq += __shfl_xor(sq, 32); if (lq == 0) epi.rss(row, col0 + wn * 64, sq); }
    __builtin_amdgcn_sched_barrier(0); }
}

template <int BM, int BN, bool ACOLMAP, class Epi>
DEVI void gemm_tile(const bf16_t* A, int lda, const bf16_t* Bm, int ldb, int K, int row0, int col0, const Epi& epi, const float* kss, char* smem) {
  if (kss) gemm_tile_mfma<BM, BN, ACOLMAP, false>(A, lda, Bm, ldb, K, row0, col0, epi, kss, smem);
  else gemm_tile_mfma<BM, BN, ACOLMAP, true>(A, lda, Bm, ldb, K, row0, col0, epi, nullptr, smem);
}

DEVI void st4bf(bf16_t* d, float a, float b, float c, float e) { u32x2 o = {pack2(a, b), pack2(c, e)}; *(u32x2*)d = o; }

struct EpiIn { static constexpr bool RSS = true; bf16_t *GU, *GVT, *CQ, *CKV, *KR; float *rssv, *rssq, *rsskv;
  DEVI float operator()(int row, int col, const float (&v)[4]) const {
    if (col < 1024) { st4bf(GU + (size_t)row * 1024 + col, gelu_t(v[0]), gelu_t(v[1]), gelu_t(v[2]), gelu_t(v[3])); return 0.f; }
    else if (col < 2048) { const int c = col - 1024, chunk = row >> 7, q = row & 127; float s = 0.f;
#pragma unroll
      for (int j = 0; j < 4; ++j) { const float g = gelu_t(v[j]); s += g * g; GVT[((size_t)chunk * 1024 + c + j) * 128 + q] = f2bf(g); }
      return s; }
    else if (col < 2304) { st4bf(CQ + (size_t)row * 256 + (col - 2048), v[0], v[1], v[2], v[3]); return v[0] * v[0] + v[1] * v[1] + v[2] * v[2] + v[3] * v[3]; }
    else if (col < 2432) { st4bf(CKV + (size_t)row * 128 + (col - 2304), v[0], v[1], v[2], v[3]); return v[0] * v[0] + v[1] * v[1] + v[2] * v[2] + v[3] * v[3]; }
    else if (col < 2496) { st4bf(KR + (size_t)keyrow(row) * 64 + (col - 2432), v[0], v[1], v[2], v[3]); return 0.f; }
    return 0.f; }
  DEVI void rss(int row, int col, float s) const {
    if (col >= 1024 && col < 2048) rssv[row * 16 + ((col - 1024) >> 6)] = s; else if (col >= 2048 && col < 2304) rssq[row * 4 + ((col - 2048) >> 6)] = s; else if (col >= 2304 && col < 2432) rsskv[row * 2 + ((col - 2304) >> 6)] = s; }
};
struct EpiQ { static constexpr bool RSS = false; bf16_t* Q; const float* rssq;
  DEVI float operator()(int row, int col, const float (&v)[4]) const { const float4 ps = *(const float4*)(rssq + row * 4); const float r = rsqrtf(((ps.x + ps.y) + (ps.z + ps.w)) * (1.f / 256.f) + EPS);
    st4bf(Q + (size_t)row * 1536 + col, v[0] * r, v[1] * r, v[2] * r, v[3] * r); return 0.f; }
  DEVI void rss(int, int, float) const {} };
struct EpiKV { static constexpr bool RSS = false; bf16_t* KV; const float* rsskv;
  DEVI float operator()(int row, int col, const float (&v)[4]) const { const float r = rsqrtf((rsskv[row * 2] + rsskv[row * 2 + 1]) * (1.f / 128.f) + EPS);
    st4bf(KV + (size_t)keyrow(row) * 2048 + col, v[0] * r, v[1] * r, v[2] * r, v[3] * r); return 0.f; }
  DEVI void rss(int, int, float) const {} };
struct EpiSgu { static constexpr bool RSS = false; bf16_t* GUOA; const float* g_sgu; const float* b_s; int chunk, g;
  DEVI float operator()(int row, int col, const float (&v)[4]) const { const int token = chunk * 128 + row, ch = g * 128 + col; const float bias = b_s[g * 128 + row];
    bf16_t* ptr = GUOA + (size_t)token * 1024 + ch; const u32x2 gu = *(const u32x2*)ptr;
    st4bf(ptr, lo2f(gu[0]) * (g_sgu[ch] * v[0] + bias), hi2f(gu[0]) * (g_sgu[ch + 1] * v[1] + bias), lo2f(gu[1]) * (g_sgu[ch + 2] * v[2] + bias), hi2f(gu[1]) * (g_sgu[ch + 3] * v[3] + bias));
    return 0.f; }
  DEVI void rss(int, int, float) const {} };
struct EpiGate { static constexpr bool RSS = false; bf16_t* G;
  DEVI float operator()(int row, int col, const float (&v)[4]) const { st4bf(G + (size_t)row * 2048 + col, sigmoidf_(v[0]), sigmoidf_(v[1]), sigmoidf_(v[2]), sigmoidf_(v[3])); return 0.f; }
  DEVI void rss(int, int, float) const {} };
template <bool SECOND> struct EpiMerge { static constexpr bool RSS = false; bf16_t* M; const bf16_t* G;
  DEVI float operator()(int row, int col, const float (&v)[4]) const { const u32x2 g = *(const u32x2*)(G + (size_t)row * 2048 + (SECOND ? 1024 : 0) + col);
    float o0 = lo2f(g[0]) * v[0], o1 = hi2f(g[0]) * v[1], o2 = lo2f(g[1]) * v[2], o3 = hi2f(g[1]) * v[3];
    bf16_t* ptr = M + (size_t)row * 1024 + col;
    if (SECOND) { const u32x2 m = *(const u32x2*)ptr; o0 += lo2f(m[0]); o1 += hi2f(m[0]); o2 += lo2f(m[1]); o3 += hi2f(m[1]); }
    st4bf(ptr, o0, o1, o2, o3); return 0.f; }
  DEVI void rss(int, int, float) const {} };
struct EpiO { static constexpr bool RSS = true; bf16_t* Y; float* rssy;
  DEVI float operator()(int row, int col, const float (&v)[4]) const { st4bf(Y + (size_t)row * 1024 + col, v[0], v[1], v[2], v[3]); return v[0] * v[0] + v[1] * v[1] + v[2] * v[2] + v[3] * v[3]; }
  DEVI void rss(int row, int col, float s) const { rssy[row * 16 + (col >> 6)] = s; } };
struct EpiPq { static constexpr bool RSS = false; bf16_t* QP;
  DEVI float operator()(int row, int col, const float (&v)[4]) const { st4bf(QP + (size_t)row * 2048 + col, v[0], v[1], v[2], v[3]); return 0.f; }
  DEVI void rss(int, int, float) const {} };

template <class F> DEVI void for_tiles_xcd(int MT, int NT, F f) {
  const int nb = gridDim.x;
  if ((nb & 7) == 0 && (MT & 7) == 0) { const int xcd = blockIdx.x & 7, slot = blockIdx.x >> 3, slots = nb >> 3, mper = MT >> 3, tot = mper * NT;
    for (int j = slot; j < tot; j += slots) f(xcd * mper + j / NT, j % NT); }
  else for (int i = blockIdx.x; i < MT * NT; i += nb) f(i / NT, i % NT);
}

DEVI void ph_inproj(const Params& p, char* smem) {
  char* ws = p.ws;
  EpiIn epi{(bf16_t*)(ws + O_RB), (bf16_t*)(ws + O_RC), (bf16_t*)(ws + O_CQ), (bf16_t*)(ws + O_CKV), (bf16_t*)(ws + O_KR), (float*)(ws + O_RSSV), (float*)(ws + O_RSSQ), (float*)(ws + O_RSSKV)};
  const bf16_t* HX = (const bf16_t*)(ws + O_RA); const bf16_t* W = (const bf16_t*)(ws + O_WIN);
  auto tile = [&](int mt, int nt) { gemm_tile<256, 256, false>(HX + (size_t)mt * 256 * 1024, 1024, W + (size_t)nt * 256 * 1024, 1024, 1024, mt * 256, nt * 256, epi, nullptr, smem); };
  for_tiles_xcd(64, 10, tile);
  for (int i = (int)gridDim.x - 1 - (int)blockIdx.x; i < 2; i += gridDim.x) tile(64 + i, 9);
}
DEVI void rope_kr(const Params& p) {
  bf16_t* KR = (bf16_t*)(p.ws + O_KR); const float* rope = (const float*)(p.ws + O_ROPE);
  for (int i = blockIdx.x * NTHR + threadIdx.x; i < NTOK * 32; i += gridDim.x * NTHR) {
    const int tok = i >> 5, j = i & 15, which = (i >> 4) & 1, pos = tok & 8191, pp = which ? (pos & 63) : (pos >> 6);
    const float cs = rope[(pp * 16 + j) * 2], sn = rope[(pp * 16 + j) * 2 + 1];
    bf16_t* r = KR + (size_t)keyrow(tok) * 64 + which * 32 + j;
    const float x1 = bf2f(r[0]), x2 = bf2f(r[16]);
    r[0] = f2bf(x1 * cs - x2 * sn); r[16] = f2bf(x1 * sn + x2 * cs);
  }
}
DEVI void ph_mid(const Params& p, char* smem) {
  char* ws = p.ws;
  { EpiQ epi{(bf16_t*)(ws + O_RQ), (const float*)(ws + O_RSSQ)};
    const bf16_t* A = (const bf16_t*)(ws + O_CQ); const bf16_t* W = (const bf16_t*)(ws + O_WUQ);
    for_tiles_xcd(64, 12, [&](int mt, int nt) { gemm_tile<256, 128, false>(A + (size_t)mt * 256 * 256, 256, W + (size_t)nt * 128 * 256, 256, 256, mt * 256, nt * 128, epi, nullptr, smem); }); }
  { EpiKV epi{(bf16_t*)(ws + O_RKV), (const float*)(ws + O_RSSKV)};
    const bf16_t* A = (const bf16_t*)(ws + O_CKV); const bf16_t* W = (const bf16_t*)(ws + O_WUKV);
    auto tile = [&](int mt, int nt) { gemm_tile<256, 128, false>(A + (size_t)mt * 256 * 128, 128, W + (size_t)nt * 128 * 128, 128, 128, mt * 256, nt * 128, epi, nullptr, smem); };
    for_tiles_xcd(64, 16, tile);
    for (int i = blockIdx.x; i < 32; i += gridDim.x) tile(64 + (i >> 4), i & 15); }
  { const bf16_t* WS = (const bf16_t*)(ws + O_WS); const bf16_t* GVT = (const bf16_t*)(ws + O_RC);
    float* ksc = (float*)(smem + LDS_BYTES - 1024); const float* rssv = (const float*)(ws + O_RSSV);
    for (int i = blockIdx.x; i < 1024; i += gridDim.x) { const int chunk = i >> 3, g = i & 7;
      __syncthreads();
      if (threadIdx.x < 128) { const float* pr = rssv + (size_t)(chunk * 128 + threadIdx.x) * 16; float t = 0.f;
#pragma unroll
        for (int j = 0; j < 16; ++j) t += pr[j];
        ksc[threadIdx.x] = rsqrtf(t * (1.f / 1024.f) + EPS); }
      __syncthreads();
      EpiSgu epi{(bf16_t*)(ws + O_RB), p.g_sgu, p.b_s, chunk, g};
      gemm_tile<128, 128, false>(WS + (size_t)g * 16384, 128, GVT + ((size_t)chunk * 1024 + g * 128) * 128, 128, 128, 0, 0, epi, ksc, smem); } }
  rope_kr(p);
}
DEVI void ph_gates(const Params& p, char* smem) {
  char* ws = p.ws; EpiGate epi{(bf16_t*)(ws + O_RKV)};
  const bf16_t* HX = (const bf16_t*)(ws + O_RA); const bf16_t* W = (const bf16_t*)(ws + O_WIN) + (size_t)NPRE * 1024;
  for_tiles_xcd(64, 8, [&](int mt, int nt) { gemm_tile<256, 256, false>(HX + (size_t)mt * 256 * 1024, 1024, W + (size_t)nt * 256 * 1024, 1024, 1024, mt * 256, nt * 256, epi, nullptr, smem); });
}
DEVI void ph_merge(const Params& p, char* smem) {
  char* ws = p.ws; bf16_t* M = (bf16_t*)(ws + O_RC); const bf16_t* G = (const bf16_t*)(ws + O_RKV);
  EpiMerge<false> e1{M, G}; EpiMerge<true> e2{M, G};
  const bf16_t* OA = (const bf16_t*)(ws + O_RB); const bf16_t* OB = (const bf16_t*)(ws + O_RQ);
  const bf16_t* WA = (const bf16_t*)(ws + O_WPA); const bf16_t* WB = (const bf16_t*)(ws + O_WPB);
  for_tiles_xcd(64, 4, [&](int mt, int nt) { gemm_tile<256, 256, false>(OA + (size_t)mt * 256 * 1024, 1024, WA + (size_t)nt * 256 * 1024, 1024, 1024, mt * 256, nt * 256, e1, nullptr, smem); });
  for_tiles_xcd(64, 4, [&](int mt, int nt) { gemm_tile<256, 256, true>(OB + (size_t)mt * 256 * 1536, 1536, WB + (size_t)nt * 256 * 1024, 1024, 1024, mt * 256, nt * 256, e2, nullptr, smem); });
}
DEVI void ph_wo(const Params& p, char* smem) {
  char* ws = p.ws; EpiO epi{(bf16_t*)(ws + O_RA), (float*)(ws + O_RSSY)};
  const bf16_t* M = (const bf16_t*)(ws + O_RC); const bf16_t* W = (const bf16_t*)(ws + O_WO);
  for_tiles_xcd(64, 4, [&](int mt, int nt) { gemm_tile<256, 256, false>(M + (size_t)mt * 256 * 1024, 1024, W + (size_t)nt * 256 * 1024, 1024, 1024, mt * 256, nt * 256, epi, nullptr, smem); });
}
DEVI void ph_wpq(const Params& p, char* smem) {
  char* ws = p.ws; EpiPq epi{(bf16_t*)(ws + O_RKV)};
  const bf16_t* A = (const bf16_t*)(ws + O_RB); const bf16_t* W = (const bf16_t*)(ws + O_WPQ);
  for_tiles_xcd(64, 8, [&](int mt, int nt) { gemm_tile<256, 256, false>(A + (size_t)mt * 256 * 1024, 1024, W + (size_t)nt * 256 * 1024, 1024, 1024, mt * 256, nt * 256, epi, nullptr, smem); });
  convert_table(p.v_exp, (bf16_t*)(ws + O_RA));
}

DEVI void attn_naive(const Params& p, char* smem) {
  const int tid = threadIdx.x, wave = tid >> 6, lane = tid & 63;
  float* qs = (float*)smem + wave * 256; float* ps = qs + 192;
  bf16_t* Q = (bf16_t*)(p.ws + O_RQ); const bf16_t* KV = (const bf16_t*)(p.ws + O_RKV); const bf16_t* KR = (const bf16_t*)(p.ws + O_KR);
  const float* rope = (const float*)(p.ws + O_ROPE);
  const float scale = 0.07216878364870322f;
  for (int base = blockIdx.x * NWAVE; base < NB * 8 * SEQ; base += gridDim.x * NWAVE) {
    const int it = base + wave, bh = it >> 13, qi = it & 8191, b = bh >> 3, h = bh & 7;
    const size_t qoff = (size_t)(b * SEQ + qi) * 1536 + h * 192;
    __syncthreads();
    for (int d = lane; d < 192; d += 64) qs[d] = bf2f(Q[qoff + d]);
    __syncthreads();
    if (lane < 32) { const int j = lane & 15, which = lane >> 4, pp = which ? (qi & 63) : (qi >> 6);
      const float cs = rope[(pp * 16 + j) * 2], sn = rope[(pp * 16 + j) * 2 + 1]; const int d1 = 128 + which * 32 + j, d2 = d1 + 16;
      const float x1 = qs[d1], x2 = qs[d2]; qs[d1] = x1 * cs - x2 * sn; qs[d2] = x1 * sn + x2 * cs; }
    __syncthreads();
    float m = -1e30f, l = 0.f, o0 = 0.f, o1 = 0.f;
    for (int k0 = 0; k0 < NKEY; k0 += 64) {
      const size_t kr = (size_t)(b * NKEY + k0 + lane);
      const bf16_t* kn = KV + kr * 2048 + h * 256; const bf16_t* krp = KR + kr * 64;
      float s = 0.f;
#pragma unroll 4
      for (int d8 = 0; d8 < 16; ++d8) { float kf[8]; unpack8(*(const u32x4*)(kn + d8 * 8), kf); const float4 q0 = *(const float4*)(qs + d8 * 8), q1 = *(const float4*)(qs + d8 * 8 + 4);
        s += q0.x * kf[0] + q0.y * kf[1] + q0.z * kf[2] + q0.w * kf[3] + q1.x * kf[4] + q1.y * kf[5] + q1.z * kf[6] + q1.w * kf[7]; }
#pragma unroll 4
      for (int d8 = 0; d8 < 8; ++d8) { float kf[8]; unpack8(*(const u32x4*)(krp + d8 * 8), kf); const float4 q0 = *(const float4*)(qs + 128 + d8 * 8), q1 = *(const float4*)(qs + 128 + d8 * 8 + 4);
        s += q0.x * kf[0] + q0.y * kf[1] + q0.z * kf[2] + q0.w * kf[3] + q1.x * kf[4] + q1.y * kf[5] + q1.z * kf[6] + q1.w * kf[7]; }
      s *= scale;
      const float mn = fmaxf(m, wave_max(s)), al = __expf(m - mn), pe = __expf(s - mn);
      l = l * al + wave_sum(pe); m = mn; o0 *= al; o1 *= al;
      __syncthreads();
      ps[lane] = pe;
      __syncthreads();
      const bf16_t* vp = KV + (size_t)(b * NKEY + k0) * 2048 + h * 256 + 128 + lane * 2;
#pragma unroll 8
      for (int kk = 0; kk < 64; ++kk) { const unsigned w = *(const unsigned*)(vp + (size_t)kk * 2048); const float pk = ps[kk]; o0 += pk * lo2f(w); o1 += pk * hi2f(w); }
    }
    const float invL = 1.f / l;
    *(unsigned*)(Q + qoff + lane * 2) = pack2(o0 * invL, o1 * invL);
  }
}

namespace at {
constexpr int QBLK = 32, KVBLK = 64;
constexpr float SCALE = 0.07216878364870322f;
constexpr float THR = 8.f;
constexpr int SHM_V = KVBLK * 128 * 2, SHM_K = KVBLK * 192 * 2;
using s16x4 = __attribute__((ext_vector_type(4))) short;
#define KSWZ(row, colB) ((row) * 384 + ((colB) ^ (((row) & 7) << 4)))
#define SBAR() __builtin_amdgcn_sched_barrier(0)
DEVI int crow(int r, int hi) { return (r & 3) + 8 * (r >> 2) + 4 * hi; }
DEVI unsigned cvtpk(float lo, float hi) { unsigned r; asm volatile("v_cvt_pk_bf16_f32 %0, %1, %2" : "=v"(r) : "v"(lo), "v"(hi)); return r; }
DEVI void partialSM(f32x16& p0, f32x16& p1, float& m_reg, float& mn, float& alpha) {
  constexpr float C = SCALE * 1.4426950408889634f;
  float pmax = p0[0];
#pragma unroll
  for (int r = 1; r < 16; ++r) pmax = fmaxf(pmax, p0[r]);
#pragma unroll
  for (int r = 0; r < 16; ++r) pmax = fmaxf(pmax, p1[r]);
  { auto rr = __builtin_amdgcn_permlane32_swap(__float_as_uint(pmax), __float_as_uint(pmax), false, false);
    pmax = fmaxf(__uint_as_float(rr[0]), __uint_as_float(rr[1])); }
  if (__builtin_expect(__all(pmax - m_reg <= THR / SCALE), 1)) { mn = m_reg; alpha = 1.f; }
  else { mn = fmaxf(m_reg, pmax); alpha = __builtin_amdgcn_exp2f((m_reg - mn) * C); m_reg = mn; }
  const float mnC = -mn * C;
#pragma unroll
  for (int r = 0; r < 16; ++r) p0[r] = fmaf(p0[r], C, mnC);
#pragma unroll
  for (int r = 0; r < 16; ++r) p1[r] = fmaf(p1[r], C, mnC);
#pragma unroll
  for (int r = 0; r < 16; ++r) p0[r] = __builtin_amdgcn_exp2f(p0[r]);
}
DEVI void finishSM(f32x16& p0, f32x16& p1, float alpha, float& l_reg, bf16x8& pa0, bf16x8& pa1, bf16x8& pa2, bf16x8& pa3) {
#pragma unroll
  for (int r = 0; r < 16; ++r) p1[r] = __builtin_amdgcn_exp2f(p1[r]);
  float ps = 0;
#pragma unroll
  for (int r = 0; r < 16; ++r) ps += p0[r];
#pragma unroll
  for (int r = 0; r < 16; ++r) ps += p1[r];
  { auto rr = __builtin_amdgcn_permlane32_swap(__float_as_uint(ps), __float_as_uint(ps), false, false);
    ps = __uint_as_float(rr[0]) + __uint_as_float(rr[1]); }
  l_reg = l_reg * alpha + ps;
#define PK4(P, BASE, OUT) do { unsigned a0 = cvtpk(P[BASE + 0], P[BASE + 1]), a1 = cvtpk(P[BASE + 2], P[BASE + 3]);   \
    unsigned b0 = cvtpk(P[BASE + 4], P[BASE + 5]), b1 = cvtpk(P[BASE + 6], P[BASE + 7]);                              \
    auto r0 = __builtin_amdgcn_permlane32_swap(a0, b0, false, false); auto r1 = __builtin_amdgcn_permlane32_swap(a1, b1, false, false); \
    u32x4 w = {r0[0], r1[0], r0[1], r1[1]}; OUT = *reinterpret_cast<bf16x8*>(&w); } while (0)
  PK4(p0, 0, pa0); PK4(p0, 8, pa1); PK4(p1, 0, pa2); PK4(p1, 8, pa3);
#undef PK4
}
DEVI void qkt(f32x16& p0, f32x16& p1, const char* Ks, const bf16x8* qr, const char* qrl, int r32, int hi) {
  p0 = f32x16{}; p1 = f32x16{};
#pragma unroll
  for (int d0 = 0; d0 < 12; ++d0) { const int cb = (d0 * 16 + hi * 8) * 2;
    const bf16x8 b0 = *reinterpret_cast<const bf16x8*>(Ks + KSWZ(r32, cb));
    const bf16x8 b1 = *reinterpret_cast<const bf16x8*>(Ks + KSWZ(32 + r32, cb));
    const bf16x8 q = d0 < 8 ? qr[d0 < 8 ? d0 : 0] : *reinterpret_cast<const bf16x8*>(qrl + (d0 - 8) * 1024);
    p0 = __builtin_amdgcn_mfma_f32_32x32x16_bf16(b0, q, p0, 0, 0, 0);
    p1 = __builtin_amdgcn_mfma_f32_32x32x16_bf16(b1, q, p1, 0, 0, 0); }
}
DEVI int v_st(int k, int c) { const int kk = (k & ~0xC) | ((k & 4) << 1) | ((k & 8) >> 1); return ((kk >> 3) * 4 + (c >> 5)) * 512 + ((kk & 7) * 32 + (c & 31)) * 2; }
DEVI int v_rd_base(int lane) { return ((lane & 3) << 3) | (((lane >> 2) & 3) << 6) | (((lane >> 4) & 1) << 5) | (((lane >> 5) & 1) << 8); }
constexpr int v_rd_off(int d0, int ks, int half) { return d0 * 512 + ks * 4096 + half * 2048; }
template <int OFF> DEVI s16x4 tr_read(int vb) { s16x4 r; asm volatile("ds_read_b64_tr_b16 %0, %1 offset:%2" : "=&v"(r) : "v"(vb), "i"(OFF) : "memory"); return r; }
template <int D0> DEVI void pv_one(f32x16& od, int vb, bf16x8 pa0, bf16x8 pa1, bf16x8 pa2, bf16x8 pa3) {
  const s16x4 l0 = tr_read<v_rd_off(D0, 0, 0)>(vb), h0 = tr_read<v_rd_off(D0, 0, 1)>(vb), l1 = tr_read<v_rd_off(D0, 1, 0)>(vb), h1 = tr_read<v_rd_off(D0, 1, 1)>(vb);
  const s16x4 l2 = tr_read<v_rd_off(D0, 2, 0)>(vb), h2 = tr_read<v_rd_off(D0, 2, 1)>(vb), l3 = tr_read<v_rd_off(D0, 3, 0)>(vb), h3 = tr_read<v_rd_off(D0, 3, 1)>(vb);
  asm volatile("s_waitcnt lgkmcnt(0)" ::: "memory"); SBAR();
#define PK(L, H) (bf16x8){L[0], L[1], L[2], L[3], H[0], H[1], H[2], H[3]}
  od = __builtin_amdgcn_mfma_f32_32x32x16_bf16(pa0, PK(l0, h0), od, 0, 0, 0);
  od = __builtin_amdgcn_mfma_f32_32x32x16_bf16(pa1, PK(l1, h1), od, 0, 0, 0);
  od = __builtin_amdgcn_mfma_f32_32x32x16_bf16(pa2, PK(l2, h2), od, 0, 0, 0);
  od = __builtin_amdgcn_mfma_f32_32x32x16_bf16(pa3, PK(l3, h3), od, 0, 0, 0);
#undef PK
}
DEVI void pv_d0(f32x16* o, int vb, bf16x8 pa0, bf16x8 pa1, bf16x8 pa2, bf16x8 pa3) {
  pv_one<0>(o[0], vb, pa0, pa1, pa2, pa3); pv_one<1>(o[1], vb, pa0, pa1, pa2, pa3); pv_one<2>(o[2], vb, pa0, pa1, pa2, pa3); pv_one<3>(o[3], vb, pa0, pa1, pa2, pa3);
}
DEVI void rope_frag(bf16x8& f1, bf16x8& f2, const float* cs) {
  u32x4 w1 = *reinterpret_cast<u32x4*>(&f1), w2 = *reinterpret_cast<u32x4*>(&f2); float a[8], b[8]; unpack8(w1, a); unpack8(w2, b);
  float c[8], s[8];
#pragma unroll
  for (int q = 0; q < 4; ++q) { const float4 t = *(const float4*)(cs + q * 4); c[q * 2] = t.x; s[q * 2] = t.y; c[q * 2 + 1] = t.z; s[q * 2 + 1] = t.w; }
  float x[8], y[8];
#pragma unroll
  for (int j = 0; j < 8; ++j) { x[j] = a[j] * c[j] - b[j] * s[j]; y[j] = a[j] * s[j] + b[j] * c[j]; }
  w1 = (u32x4){cvtpk(x[0], x[1]), cvtpk(x[2], x[3]), cvtpk(x[4], x[5]), cvtpk(x[6], x[7])};
  w2 = (u32x4){cvtpk(y[0], y[1]), cvtpk(y[2], y[3]), cvtpk(y[4], y[5]), cvtpk(y[6], y[7])};
  f1 = *reinterpret_cast<bf16x8*>(&w1); f2 = *reinterpret_cast<bf16x8*>(&w2);
}
DEVI void attn_item(bf16_t* __restrict__ Qb, const bf16_t* __restrict__ Kn, const bf16_t* __restrict__ Vh, const bf16_t* __restrict__ Kr, const float* __restrict__ rope, int pos0, char* lds) {
  const int tid = threadIdx.x, wid = tid >> 6, lane = tid & 63, r32 = lane & 31, hi = lane >> 5;
  char* V_lds = lds; char* K_lds = lds + 2 * SHM_V;
  float* wsl = (float*)(lds + 2 * SHM_V + 2 * SHM_K) + wid * 64; float* li_l = wsl; float* al_l = wsl + 32;
  char* qrl = lds + 2 * SHM_V + 2 * SHM_K + 2048 + wid * 4096 + lane * 16;
  float m_reg = -1e30f, l_reg = 0; f32x16 o[4] = {}; bf16x8 qr[8];
  bf16_t* Qw = Qb + (size_t)(wid * QBLK + r32) * 1536 + hi * 8;
#pragma unroll
  for (int d0 = 0; d0 < 8; ++d0) qr[d0] = *reinterpret_cast<const bf16x8*>(Qw + d0 * 16);
  { bf16x8 q8 = *reinterpret_cast<const bf16x8*>(Qw + 128), q9 = *reinterpret_cast<const bf16x8*>(Qw + 144), q10 = *reinterpret_cast<const bf16x8*>(Qw + 160), q11 = *reinterpret_cast<const bf16x8*>(Qw + 176);
    const int pos = pos0 + wid * QBLK + r32;
    rope_frag(q8, q9, rope + ((pos >> 6) * 16 + hi * 8) * 2); rope_frag(q10, q11, rope + ((pos & 63) * 16 + hi * 8) * 2);
    *reinterpret_cast<bf16x8*>(qrl) = q8; *reinterpret_cast<bf16x8*>(qrl + 1024) = q9; *reinterpret_cast<bf16x8*>(qrl + 2048) = q10; *reinterpret_cast<bf16x8*>(qrl + 3072) = q11; }
  const int sr = tid >> 4, sc = (tid & 15) * 8, vst0 = v_st(sr, sc), vst1 = v_st(32 + sr, sc);
  const int kst0 = KSWZ(sr, sc * 2), kst1 = KSWZ(32 + sr, sc * 2), kst2 = KSWZ(tid >> 3, 256 + (tid & 7) * 16);
  const int goff = sr * 2048 + sc, goffr = (tid >> 3) * 64 + (tid & 7) * 8;
  const int vb0 = (int)(uintptr_t)V_lds + v_rd_base(lane);
  u32x4 sv0, sv1, sk0, sk1, sk2;
#define SLOAD(k0) do { const bf16_t* vp = Vh + (size_t)(k0) * 2048 + goff; const bf16_t* kp = Kn + (size_t)(k0) * 2048 + goff; \
    sv0 = *(const u32x4*)vp; sv1 = *(const u32x4*)(vp + 32 * 2048); sk0 = *(const u32x4*)kp; sk1 = *(const u32x4*)(kp + 32 * 2048); \
    sk2 = *(const u32x4*)(Kr + (size_t)(k0) * 64 + goffr); } while (0)
#define SWRITE(b) do { *(u32x4*)(V_lds + (b) * SHM_V + vst0) = sv0; *(u32x4*)(V_lds + (b) * SHM_V + vst1) = sv1; \
    *(u32x4*)(K_lds + (b) * SHM_K + kst0) = sk0; *(u32x4*)(K_lds + (b) * SHM_K + kst1) = sk1; *(u32x4*)(K_lds + (b) * SHM_K + kst2) = sk2; } while (0)
#define SWAIT() asm volatile("s_waitcnt vmcnt(0)" ::: "memory")
#define RESC(a) do { if (__any((a) < 1.f)) { if (hi == 0) al_l[r32] = (a); asm volatile("s_waitcnt lgkmcnt(0)" ::: "memory"); \
    _Pragma("unroll") for (int d = 0; d < 4; ++d) _Pragma("unroll") for (int r = 0; r < 16; ++r) o[d][r] *= al_l[crow(r, hi)]; } } while (0)
  f32x16 pA0, pA1, pB0, pB1; float mnA, mnB, alA, alB; bf16x8 pa0, pa1, pa2, pa3; constexpr int NT = NKEY / KVBLK;
  SLOAD(0); SWAIT(); SWRITE(0); __syncthreads();
  qkt(pA0, pA1, K_lds, qr, qrl, r32, hi); partialSM(pA0, pA1, m_reg, mnA, alA);
  SLOAD(KVBLK);
  SWAIT(); SWRITE(1); __syncthreads();
  for (int j = 1; j + 1 < NT; j += 2) {
    SBAR(); qkt(pB0, pB1, K_lds + SHM_K, qr, qrl, r32, hi);
    finishSM(pA0, pA1, alA, l_reg, pa0, pa1, pa2, pa3); SBAR();
    SLOAD((j + 1) * KVBLK); SBAR();
    pv_d0(o, vb0, pa0, pa1, pa2, pa3); partialSM(pB0, pB1, m_reg, mnB, alB);
    __syncthreads(); SWAIT(); SWRITE(0);
    RESC(alB); __syncthreads();
    SBAR(); qkt(pA0, pA1, K_lds, qr, qrl, r32, hi);
    finishSM(pB0, pB1, alB, l_reg, pa0, pa1, pa2, pa3); SBAR();
    SLOAD((j + 2) * KVBLK); SBAR();
    pv_d0(o, vb0 + SHM_V, pa0, pa1, pa2, pa3); partialSM(pA0, pA1, m_reg, mnA, alA);
    __syncthreads(); SWAIT(); SWRITE(1);
    RESC(alA); __syncthreads();
  }
  SBAR(); qkt(pB0, pB1, K_lds + SHM_K, qr, qrl, r32, hi);
  finishSM(pA0, pA1, alA, l_reg, pa0, pa1, pa2, pa3); SBAR();
  pv_d0(o, vb0, pa0, pa1, pa2, pa3); partialSM(pB0, pB1, m_reg, mnB, alB);
  __syncthreads(); RESC(alB);
  finishSM(pB0, pB1, alB, l_reg, pa0, pa1, pa2, pa3); SBAR();
  pv_d0(o, vb0 + SHM_V, pa0, pa1, pa2, pa3);
  if (hi == 0) li_l[r32] = l_reg; asm volatile("s_waitcnt lgkmcnt(0)" ::: "memory");
  float rli[16];
#pragma unroll
  for (int r = 0; r < 16; ++r) rli[r] = __builtin_amdgcn_rcpf(li_l[crow(r, hi)]);
  bf16_t* Ow = Qb + (size_t)(wid * QBLK) * 1536;
#pragma unroll
  for (int r = 0; r < 16; ++r) { const int orow = crow(r, hi);
#pragma unroll
    for (int d0 = 0; d0 < 4; ++d0) Ow[(size_t)orow * 1536 + d0 * 32 + r32] = f2bf(o[d0][r] * rli[r]); }
  __syncthreads();
#undef SLOAD
#undef SWRITE
#undef SWAIT
#undef RESC
}
}
DEVI void attn_mfma(const Params& p, char* smem) {
  bf16_t* Q = (bf16_t*)(p.ws + O_RQ); const bf16_t* KV = (const bf16_t*)(p.ws + O_RKV); const bf16_t* KR = (const bf16_t*)(p.ws + O_KR);
  const float* rope = (const float*)(p.ws + O_ROPE);
  for (int it = blockIdx.x; it < NB * 8 * (SEQ / 256); it += gridDim.x) {
    const int bh = (it >> 8) * 8 + (it & 7), qb = (it & 255) >> 3, b = bh >> 3, h = bh & 7;
    at::attn_item(Q + (size_t)(b * SEQ + qb * 256) * 1536 + h * 192, KV + (size_t)b * NKEY * 2048 + h * 256, KV + (size_t)b * NKEY * 2048 + h * 256 + 128,
                  KR + (size_t)b * NKEY * 64, rope, qb * 256, smem);
  }
}
#if ATTN_MFMA
DEVI void ph_attn(const Params& p, char* smem) { attn_mfma(p, smem); }
#else
DEVI void ph_attn(const Params& p, char* smem) { attn_naive(p, smem); }
#endif

DEVI void ph_rows(const Params& p, char* smem) {
  const int tid = threadIdx.x, wave = tid >> 6, lane = tid & 63;
  const float* MOD = (const float*)(p.ws + O_MOD); const bf16_t* Y = (const bf16_t*)(p.ws + O_RA); const float* rssy = (const float*)(p.ws + O_RSSY);
  bf16_t* HX2 = (bf16_t*)(p.ws + O_RB);
  for (int row = blockIdx.x * NWAVE + wave; row < NTOK; row += gridDim.x * NWAVE) {
    const int b = row >> 13; const float* md = MOD + b * 6144;
    float ty = 0.f; { const float* pr = rssy + (size_t)row * 16;
#pragma unroll
      for (int j = 0; j < 16; ++j) ty += pr[j]; }
    const float ry = rsqrtf(ty * (1.f / 1024.f) + EPS);
    float x1[16]; float ss = 0.f;
#pragma unroll
    for (int i = 0; i < 4; ++i) { const int c = i * 256 + lane * 4; const float4 xv = *(const float4*)(p.x + (size_t)row * 1024 + c); const u32x2 yv = *(const u32x2*)(Y + (size_t)row * 1024 + c);
      const float4 gp = *(const float4*)(p.g_post1 + c), gt = *(const float4*)(md + 2048 + c);
      x1[i * 4 + 0] = xv.x + gt.x * (lo2f(yv[0]) * ry * gp.x); x1[i * 4 + 1] = xv.y + gt.y * (hi2f(yv[0]) * ry * gp.y);
      x1[i * 4 + 2] = xv.z + gt.z * (lo2f(yv[1]) * ry * gp.z); x1[i * 4 + 3] = xv.w + gt.w * (hi2f(yv[1]) * ry * gp.w);
#pragma unroll
      for (int j = 0; j < 4; ++j) ss += x1[i * 4 + j] * x1[i * 4 + j];
      *(float4*)(p.out + (size_t)row * 1024 + c) = make_float4(x1[i * 4], x1[i * 4 + 1], x1[i * 4 + 2], x1[i * 4 + 3]); }
    ss = wave_sum(ss); const float r2 = rsqrtf(ss * (1.f / 1024.f) + EPS);
#pragma unroll
    for (int i = 0; i < 4; ++i) { const int c = i * 256 + lane * 4; const float4 g2 = *(const float4*)(p.g_pre2 + c), sc = *(const float4*)(md + 4096 + c), sh = *(const float4*)(md + 3072 + c);
      st4bf(HX2 + (size_t)row * 1024 + c, x1[i * 4] * r2 * g2.x * (1.f + sc.x) + sh.x, x1[i * 4 + 1] * r2 * g2.y * (1.f + sc.y) + sh.y,
            x1[i * 4 + 2] * r2 * g2.z * (1.f + sc.z) + sh.z, x1[i * 4 + 3] * r2 * g2.w * (1.f + sc.w) + sh.w); }
  }
  convert_table(p.u_exp, (bf16_t*)(p.ws + O_RC));
}

DEVI void topk_naive(const Params& p, char* smem) {
  const int tid = threadIdx.x, wave = tid >> 6, lane = tid & 63;
  float* wl = (float*)smem + wave * 512; int* wi = (int*)wl;
  const bf16_t* QP = (const bf16_t*)(p.ws + O_RKV); const bf16_t* K1 = (const bf16_t*)(p.ws + O_K1); const bf16_t* K2 = (const bf16_t*)(p.ws + O_K2);
  int* IDX = (int*)(p.ws + O_RQ); float* GW = (float*)(p.ws + O_RQ + (size_t)NTOK * 128 * 4);
  for (int base = blockIdx.x * NWAVE; base < NTOK * 8; base += gridDim.x * NWAVE) {
    const int it = base + wave, token = it >> 3, h = it & 7;
    __syncthreads();
    const bf16_t* q = QP + (size_t)token * 2048 + h * 256;
    for (int d = lane; d < 256; d += 64) wl[d] = bf2f(q[d]);
    __syncthreads();
    float s[4] = {0.f, 0.f, 0.f, 0.f};
#pragma unroll 2
    for (int d8 = 0; d8 < 16; ++d8) {
      const float4 qa0 = *(const float4*)(wl + d8 * 8), qa1 = *(const float4*)(wl + d8 * 8 + 4), qb0 = *(const float4*)(wl + 128 + d8 * 8), qb1 = *(const float4*)(wl + 128 + d8 * 8 + 4);
#pragma unroll
      for (int w = 0; w < 4; ++w) { const int key = lane + (w & 1) * 64; const bf16_t* kp = (w < 2 ? K1 : K2) + key * 128;
        float kf[8]; unpack8(*(const u32x4*)(kp + d8 * 8), kf); const float4 q0 = w < 2 ? qa0 : qb0, q1 = w < 2 ? qa1 : qb1;
        s[w] += q0.x * kf[0] + q0.y * kf[1] + q0.z * kf[2] + q0.w * kf[3] + q1.x * kf[4] + q1.y * kf[5] + q1.z * kf[6] + q1.w * kf[7]; }
    }
#pragma unroll
    for (int half = 0; half < 2; ++half) { float a0 = s[half * 2], a1 = s[half * 2 + 1];
#pragma unroll 1
      for (int r = 0; r < 16; ++r) { float v; int i; if (a0 >= a1) { v = a0; i = lane; } else { v = a1; i = lane + 64; }
        for (int o = 32; o > 0; o >>= 1) { const float ov = __shfl_xor(v, o); const int oi = __shfl_xor(i, o); if (ov > v || (ov == v && oi < i)) { v = ov; i = oi; } }
        if (i == lane) a0 = -3.0e38f; else if (i == lane + 64) a1 = -3.0e38f;
        if (lane == 0) { wl[256 + half * 32 + r] = v; wi[256 + half * 32 + 16 + r] = i; } } }
    __syncthreads();
    float cv[4]; int ci[4];
#pragma unroll
    for (int j = 0; j < 4; ++j) { const int cidx = lane * 4 + j, i = cidx >> 4, jj = cidx & 15; cv[j] = wl[256 + i] + wl[256 + 32 + jj]; ci[j] = wi[256 + 16 + i] * 128 + wi[256 + 32 + 16 + jj]; }
    float myv = 0.f, vmax = 0.f; int myi = 0;
#pragma unroll 1
    for (int r = 0; r < 16; ++r) { float v = cv[0]; int pos = lane * 4, ei = ci[0];
#pragma unroll
      for (int j = 1; j < 4; ++j) if (cv[j] > v) { v = cv[j]; pos = lane * 4 + j; ei = ci[j]; }
      for (int o = 32; o > 0; o >>= 1) { const float ov = __shfl_xor(v, o); const int op = __shfl_xor(pos, o), oe = __shfl_xor(ei, o); if (ov > v || (ov == v && op < pos)) { v = ov; pos = op; ei = oe; } }
#pragma unroll
      for (int j = 0; j < 4; ++j) if (pos == lane * 4 + j) cv[j] = -3.0e38f;
      if (r == 0) vmax = v;
      if (lane == r) { myv = v; myi = ei; } }
    const float e = lane < 16 ? __expf(myv - vmax) : 0.f; const float sum = wave_sum(e);
    if (lane < 16) { IDX[(size_t)token * 128 + h * 16 + lane] = myi; GW[(size_t)token * 128 + h * 16 + lane] = e / sum; }
  }
}

namespace tk {
DEVI int f2sort(float f) { const int i = __float_as_int(f); return i ^ ((i >> 31) & 0x7fffffff); }
DEVI float sort2f(int s) { return __int_as_float(s ^ ((s >> 31) & 0x7fffffff)); }
DEVI void ce_desc(int& a, int& b) { const int hi = max(a, b), lo = min(a, b); a = hi; b = lo; }
DEVI void sort16_desc(int* a) {
#pragma unroll
  for (int lk = 1; lk <= 4; ++lk)
#pragma unroll
    for (int lj = lk - 1; lj >= 0; --lj)
#pragma unroll
      for (int i = 0; i < 16; ++i) { const int j = 1 << lj, k = 1 << lk, l = i ^ j;
        if (l > i) { const int hi = max(a[i], a[l]), lo = min(a[i], a[l]); if ((i & k) == 0) { a[i] = hi; a[l] = lo; } else { a[i] = lo; a[l] = hi; } } }
}
DEVI void bitonic_merge16_desc(int* a) {
#pragma unroll
  for (int lj = 3; lj >= 0; --lj)
#pragma unroll
    for (int i = 0; i < 16; ++i) { const int l = i ^ (1 << lj); if (l > i) ce_desc(a[i], a[l]); }
}
DEVI void merge_top16(int* a, const int* b) {
#pragma unroll
  for (int i = 0; i < 16; ++i) a[i] = max(a[i], b[15 - i]);
  bitonic_merge16_desc(a);
}
DEVI void half_top16(const bf16_t* __restrict__ qrow, const char* Kl, int r32, int hi, int* out) {
  bf16x8 qf[8];
#pragma unroll
  for (int d0 = 0; d0 < 8; ++d0) qf[d0] = *reinterpret_cast<const bf16x8*>(qrow + d0 * 16 + hi * 8);
  int a[64];
#pragma unroll
  for (int kt = 0; kt < 4; ++kt) { f32x16 acc = {};
    const int key = kt * 32 + r32;
#pragma unroll
    for (int d0 = 0; d0 < 8; ++d0) { const bf16x8 kf = *reinterpret_cast<const bf16x8*>(Kl + key * 256 + (((d0 * 2 + hi) ^ (key & 15)) << 4));
      acc = __builtin_amdgcn_mfma_f32_32x32x16_bf16(kf, qf[d0], acc, 0, 0, 0); }
#pragma unroll
    for (int r = 0; r < 16; ++r) { const int kidx = kt * 32 + (r & 3) + 8 * (r >> 2) + 4 * hi; a[kt * 16 + r] = (f2sort(acc[r]) & ~127) | (127 - kidx); } }
  sort16_desc(a); sort16_desc(a + 16); sort16_desc(a + 32); sort16_desc(a + 48);
  merge_top16(a, a + 16); merge_top16(a + 32, a + 48); merge_top16(a, a + 32);
  int L[16], H[16];
#pragma unroll
  for (int i = 0; i < 16; ++i) { auto rr = __builtin_amdgcn_permlane32_swap((unsigned)a[i], (unsigned)a[i], false, false); L[i] = (int)rr[0]; H[i] = (int)rr[1]; }
  merge_top16(L, H);
#pragma unroll
  for (int i = 0; i < 16; ++i) out[i] = L[i];
}
}
DEVI void topk_fast(const Params& p, char* smem) {
  const int tid = threadIdx.x, wave = tid >> 6, lane = tid & 63, r32 = lane & 31, hi = lane >> 5;
  const bf16_t* QP = (const bf16_t*)(p.ws + O_RKV);
  int* IDX = (int*)(p.ws + O_RQ); float* GW = (float*)(p.ws + O_RQ + (size_t)NTOK * 128 * 4);
  char* K1l = smem; char* K2l = smem + 32768; int* tab = (int*)(smem + 65536) + wave * (32 * 33);
  __syncthreads();
  { const bf16_t* K1 = (const bf16_t*)(p.ws + O_K1);
    for (int id = tid; id < 4096; id += NTHR) { const int key = id >> 4, c = id & 15; const u32x4 v = *(const u32x4*)(K1 + (size_t)key * 128 + c * 8);
      *(u32x4*)(smem + key * 256 + ((c ^ (key & 15)) << 4)) = v; } }
  __syncthreads();
  for (int item = blockIdx.x; item < NTOK * 8 / 256; item += gridDim.x) {
    const int row = item * 256 + wave * 32 + r32;
    const bf16_t* qrow = QP + (size_t)row * 256;
    int t1[16], t2[16];
    tk::half_top16(qrow, K1l, r32, hi, t1);
    tk::half_top16(qrow + 128, K2l, r32, hi, t2);
    float v1[16], v2[16];
#pragma unroll
    for (int i = 0; i < 16; ++i) { v1[i] = tk::sort2f(t1[i] & ~127); v2[i] = tk::sort2f(t2[i] & ~127); }
    if (hi == 0) {
#pragma unroll
      for (int i = 0; i < 16; ++i) { tab[r32 * 33 + i] = 127 - (t1[i] & 127); tab[r32 * 33 + 16 + i] = 127 - (t2[i] & 127); } }
#define CAND(i, j) ((tk::f2sort(v1[i] + v2[j]) & ~255) | (255 - ((i) * 16 + (j))))
    int g0[16], g1[16], g2[16];
#pragma unroll
    for (int j = 0; j < 16; ++j) g0[j] = CAND(0, j);
#pragma unroll
    for (int j = 0; j < 8; ++j) g1[j] = CAND(1, j);
#pragma unroll
    for (int j = 0; j < 5; ++j) g1[8 + j] = CAND(2, j);
#pragma unroll
    for (int j = 0; j < 3; ++j) g1[13 + j] = CAND(4, j);
#pragma unroll
    for (int j = 0; j < 4; ++j) g2[j] = CAND(3, j);
    g2[4] = CAND(5, 0); g2[5] = CAND(5, 1); g2[6] = CAND(6, 0); g2[7] = CAND(6, 1); g2[8] = CAND(7, 0); g2[9] = CAND(7, 1);
    g2[10] = CAND(8, 0); g2[11] = CAND(9, 0); g2[12] = CAND(10, 0); g2[13] = CAND(11, 0); g2[14] = CAND(12, 0); g2[15] = CAND(13, 0);
    tk::sort16_desc(g1); tk::sort16_desc(g2);
    tk::merge_top16(g0, g1); tk::merge_top16(g0, g2);
    { int x = CAND(14, 0);
#pragma unroll
      for (int i = 0; i < 16; ++i) { const int h = max(g0[i], x); x = min(g0[i], x); g0[i] = h; }
      x = CAND(15, 0);
#pragma unroll
      for (int i = 0; i < 16; ++i) { const int h = max(g0[i], x); x = min(g0[i], x); g0[i] = h; } }
#undef CAND
    asm volatile("s_waitcnt lgkmcnt(0)" ::: "memory");
    if (hi == 0) {
      int ex[16];
#pragma unroll
      for (int k = 0; k < 16; ++k) { const int pos = 255 - (g0[k] & 255); ex[k] = tab[r32 * 33 + (pos >> 4)] * 128 + tab[r32 * 33 + 16 + (pos & 15)]; }
      int* dst = IDX + (size_t)row * 16;
#pragma unroll
      for (int q = 0; q < 4; ++q) *(int4*)(dst + q * 4) = make_int4(ex[q * 4], ex[q * 4 + 1], ex[q * 4 + 2], ex[q * 4 + 3]);
    } else {
      float e[16]; const float vmax = tk::sort2f(g0[0] & ~255); float sum = 0.f;
#pragma unroll
      for (int k = 0; k < 16; ++k) { e[k] = __expf(tk::sort2f(g0[k] & ~255) - vmax); sum += e[k]; }
      const float inv = 1.f / sum; float* dst = GW + (size_t)row * 16;
#pragma unroll
      for (int q = 0; q < 4; ++q) *(float4*)(dst + q * 4) = make_float4(e[q * 4] * inv, e[q * 4 + 1] * inv, e[q * 4 + 2] * inv, e[q * 4 + 3] * inv);
    }
  }
}
#if TOPK_FAST
DEVI void ph_topk(const Params& p, char* smem) { topk_fast(p, smem); }
#else
DEVI void ph_topk(const Params& p, char* smem) { topk_naive(p, smem); }
#endif

DEVI void ph_gather(const Params& p, char* smem) {
  const int tid = threadIdx.x, wave = tid >> 6, lane = tid & 63;
  const bf16_t* HX2 = (const bf16_t*)(p.ws + O_RB); const bf16_t* UT = (const bf16_t*)(p.ws + O_RC); const bf16_t* VT = (const bf16_t*)(p.ws + O_RA);
  const int* IDX = (const int*)(p.ws + O_RQ); const float* GW = (const float*)(p.ws + O_RQ + (size_t)NTOK * 128 * 4);
  const float* MOD = (const float*)(p.ws + O_MOD);
  for (int t = blockIdx.x * NWAVE + wave; t < NTOK; t += gridDim.x * NWAVE) {
    float xf[16];
    unpack8(*(const u32x4*)(HX2 + (size_t)t * 1024 + lane * 8), xf); unpack8(*(const u32x4*)(HX2 + (size_t)t * 1024 + 512 + lane * 8), xf + 8);
    const int my_i0 = IDX[(size_t)t * 128 + lane], my_i1 = IDX[(size_t)t * 128 + 64 + lane];
    const float my_g0 = GW[(size_t)t * 128 + lane], my_g1 = GW[(size_t)t * 128 + 64 + lane];
    float acc[16];
#pragma unroll
    for (int j = 0; j < 16; ++j) acc[j] = 0.f;
    for (int e0 = 0; e0 < 128; e0 += 4) {
      int id[4]; float g[4]; u32x4 ua[4], ub[4], va[4], vb[4];
#pragma unroll
      for (int j = 0; j < 4; ++j) { const int e = e0 + j; id[j] = e0 < 64 ? __shfl(my_i0, e) : __shfl(my_i1, e - 64); g[j] = e0 < 64 ? __shfl(my_g0, e) : __shfl(my_g1, e - 64);
        const bf16_t* ur = UT + (size_t)id[j] * 1024; const bf16_t* vr = VT + (size_t)id[j] * 1024;
        ua[j] = *(const u32x4*)(ur + lane * 8); ub[j] = *(const u32x4*)(ur + 512 + lane * 8); va[j] = *(const u32x4*)(vr + lane * 8); vb[j] = *(const u32x4*)(vr + 512 + lane * 8); }
      float d[4];
#pragma unroll
      for (int j = 0; j < 4; ++j) { float uf[16]; unpack8(ua[j], uf); unpack8(ub[j], uf + 8); float s = 0.f;
#pragma unroll
        for (int k = 0; k < 16; ++k) s += xf[k] * uf[k];
        d[j] = s; }
#pragma unroll
      for (int j = 0; j < 4; ++j) d[j] = wave_sum(d[j]);
#pragma unroll
      for (int j = 0; j < 4; ++j) { const float cf = g[j] * gelu_t(d[j]); float vf[16]; unpack8(va[j], vf); unpack8(vb[j], vf + 8);
#pragma unroll
        for (int k = 0; k < 16; ++k) acc[k] += cf * vf[k]; }
    }
    float ss = 0.f;
#pragma unroll
    for (int k = 0; k < 16; ++k) ss += acc[k] * acc[k];
    ss = wave_sum(ss); const float rstd = rsqrtf(ss * (1.f / 1024.f) + EPS);
    const int b = t >> 13; const float* gt2 = MOD + b * 6144 + 5120;
#pragma unroll
    for (int hh = 0; hh < 2; ++hh) { const int c = hh * 512 + lane * 8; float* op = p.out + (size_t)t * 1024 + c;
#pragma unroll
      for (int q4 = 0; q4 < 2; ++q4) { float4 xv = *(const float4*)(op + q4 * 4); const float4 gt = *(const float4*)(gt2 + c + q4 * 4), gp = *(const float4*)(p.g_post2 + c + q4 * 4);
        xv.x += gt.x * (acc[hh * 8 + q4 * 4 + 0] * rstd * gp.x); xv.y += gt.y * (acc[hh * 8 + q4 * 4 + 1] * rstd * gp.y);
        xv.z += gt.z * (acc[hh * 8 + q4 * 4 + 2] * rstd * gp.z); xv.w += gt.w * (acc[hh * 8 + q4 * 4 + 3] * rstd * gp.w);
        *(float4*)(op + q4 * 4) = xv; } }
  }
}


#define XB_TMO      128
#define XB_XCNT(j)  (256  + 64 * (j))
#define XB_XSUB(j)  (1280 + 64 * (j))
#define XB_XGEN(j)  (2304 + 64 * (j))
#define XB_TOP      3328
#define XB_TOPGEN   3392
#define XCD_BAR_WORDS 3456
#define XB_SPIN_CAP (1u << 18)
#define LAS __attribute__((address_space(3)))
DEVI unsigned xb_ld(unsigned* p)              { return __hip_atomic_load(p, __ATOMIC_RELAXED, __HIP_MEMORY_SCOPE_AGENT); }
DEVI unsigned xb_add(unsigned* p, unsigned v) { return __hip_atomic_fetch_add(p, v, __ATOMIC_RELAXED, __HIP_MEMORY_SCOPE_AGENT); }
DEVI unsigned xb_xcc_id() { return (unsigned)__builtin_amdgcn_s_getreg((3 << 11) | 20) & 0xFu; }
#define XB_SPIN(cond, bar) do { unsigned _sp = 0; while (cond) { __builtin_amdgcn_s_sleep(1); \
    if ((++_sp & 255u) == 0u) { if (xb_ld(&(bar)[XB_TMO])) break; if (_sp > XB_SPIN_CAP) { atomicAdd(&(bar)[XB_TMO], 1u); break; } } } } while (0)
struct XcdBarrier { unsigned* bar; unsigned x; volatile LAS unsigned* st; };
DEVI XcdBarrier xcd_barrier_post(unsigned* bar, volatile LAS unsigned* st) {
  XcdBarrier b; b.bar = bar; b.x = xb_xcc_id(); b.st = st;
  if (threadIdx.x == 0) (void)xb_add(&bar[XB_XCNT(b.x)], 1u);
  return b;
}
DEVI void xcd_barrier_complete(unsigned* bar, unsigned x, unsigned& nloc, unsigned& nx) {
  const unsigned G = gridDim.x * gridDim.y * gridDim.z;
  unsigned sum, cnt, mine, sp = 0u;
  for (;;) {
    sum = 0u; cnt = 0u; mine = 0u;
#pragma unroll
    for (unsigned j = 0; j < 16; ++j) { const unsigned c = xb_ld(&bar[XB_XCNT(j)]); sum += c; cnt += (c > 0u) ? 1u : 0u; mine = (j == x) ? c : mine; }
    if (sum == G) break;
    __builtin_amdgcn_s_sleep(1);
    if ((++sp & 255u) == 0u) { if (xb_ld(&bar[XB_TMO])) break; if (sp > XB_SPIN_CAP) { atomicAdd(&bar[XB_TMO], 1u); break; } }
  }
  nloc = mine > 0u ? mine : 1u; nx = cnt > 0u ? cnt : 1u;
}
DEVI void xcd_barrier(const XcdBarrier& b) {
  asm volatile("s_waitcnt vmcnt(0)" ::: "memory");
  __syncthreads();
  if (threadIdx.x == 0) {
    unsigned* bar = b.bar;
    __builtin_amdgcn_s_waitcnt(0);
    unsigned nloc = b.st[0], nx = b.st[1];
    if (nloc == 0u) { xcd_barrier_complete(bar, b.x, nloc, nx); b.st[0] = nloc; b.st[1] = nx; }
    const unsigned old = xb_add(&bar[XB_XSUB(b.x)], 1u);
    const unsigned gen = old / nloc;
    if (old + 1u == (gen + 1u) * nloc) {
      __builtin_amdgcn_fence(__ATOMIC_RELEASE, "agent");
      asm volatile("s_waitcnt vmcnt(0)" ::: "memory");
      const unsigned og = xb_add(&bar[XB_TOP], 1u);
      const unsigned tg = og / nx;
      if (og + 1u == (tg + 1u) * nx) xb_add(&bar[XB_TOPGEN], 1u);
      else XB_SPIN(xb_ld(&bar[XB_TOPGEN]) == tg, bar);
      __builtin_amdgcn_fence(__ATOMIC_ACQUIRE, "agent");
      xb_add(&bar[XB_XGEN(b.x)], 1u);
      asm volatile("s_waitcnt vmcnt(0)" ::: "memory");
    } else {
      XB_SPIN(xb_ld(&bar[XB_XGEN(b.x)]) == gen, bar);
      __builtin_amdgcn_fence(__ATOMIC_ACQUIRE, "agent");
      asm volatile("s_waitcnt vmcnt(0)" ::: "memory");
    }
  }
  __syncthreads();
}

constexpr int NPHASE = 12;
template <int PH> DEVI void run_phase(const Params& p, char* smem) {
  if constexpr (PH == 0) ph_prep(p, smem);
  else if constexpr (PH == 1) ph_hx(p, smem);
  else if constexpr (PH == 2) ph_inproj(p, smem);
  else if constexpr (PH == 3) ph_mid(p, smem);
  else if constexpr (PH == 4) ph_attn(p, smem);
  else if constexpr (PH == 5) ph_gates(p, smem);
  else if constexpr (PH == 6) ph_merge(p, smem);
  else if constexpr (PH == 7) ph_wo(p, smem);
  else if constexpr (PH == 8) ph_rows(p, smem);
  else if constexpr (PH == 9) ph_wpq(p, smem);
  else if constexpr (PH == 10) ph_topk(p, smem);
  else if constexpr (PH == 11) ph_gather(p, smem);
}

template <int PH> __global__ __launch_bounds__(NTHR) void k_phase(Params p) {
  extern __shared__ __attribute__((aligned(16))) char smem[];
  run_phase<PH>(p, smem);
}

#ifndef PROBE_PH
#define PROBE_PH -1
#endif
#if MEGA
#define RUNPH(N) do { if (PROBE_PH == N) t0 = __builtin_amdgcn_s_memrealtime(); run_phase<N>(p, smem); if (N < NPHASE - 1) xcd_barrier(xb); \
    if (PROBE_PH == N) t1 = __builtin_amdgcn_s_memrealtime(); } while (0)
__global__ __launch_bounds__(NTHR) void k_mega(Params p) {
  extern __shared__ __attribute__((aligned(16))) char smem[];
  cg::grid_group grid = cg::this_grid();
  unsigned long long t0 = 0, t1 = 0;
  unsigned* bar = (unsigned*)(p.ws + O_BAR);
  volatile LAS unsigned* xst = (volatile LAS unsigned*)(smem + LDS_BYTES - 16);
  if (threadIdx.x == 0) { xst[0] = 0u; xst[1] = 0u; }
  if (blockIdx.x == 0) for (int i = threadIdx.x; i < XCD_BAR_WORDS; i += NTHR) bar[i] = 0u;
  if (PROBE_PH == 0) t0 = __builtin_amdgcn_s_memrealtime();
  run_phase<0>(p, smem);
  grid.sync();
  if (PROBE_PH == 0) t1 = __builtin_amdgcn_s_memrealtime();
  const XcdBarrier xb = xcd_barrier_post(bar, xst);
  RUNPH(1); RUNPH(2); RUNPH(3); RUNPH(4); RUNPH(5); RUNPH(6); RUNPH(7); RUNPH(8); RUNPH(9); RUNPH(10); RUNPH(11);
  if (PROBE_PH >= 0) { __syncthreads(); if (blockIdx.x == 0 && threadIdx.x == 0) p.out[0] += exp2f(rintf(log2f((float)(t1 - t0) * 1e-3f) * 5.f) * 0.2f); }
}
#endif

template <int PH> static void launch_phase(const Params& p, int grid, hipStream_t stream) {
  hipLaunchKernelGGL(k_phase<PH>, dim3(grid), dim3(NTHR), LDS_BYTES, stream, p);
}
template <int PH> static void set_attr() { (void)hipFuncSetAttribute((const void*)k_phase<PH>, hipFuncAttributeMaxDynamicSharedMemorySize, LDS_BYTES); }

extern "C" void kernel_launch(void* const* d_in, const int* in_sizes, int n_in, void* d_out, int out_size, void* d_ws, size_t ws_size, hipStream_t stream) {
  static int grid = 0;
  if (grid == 0) {
    if (n_in != 26 || out_size != NTOK * DM || ws_size < O_END) { fprintf(stderr, "kernel_launch: unexpected shapes n_in %d out %d ws %zu (need %zu)\n", n_in, out_size, ws_size, (size_t)O_END); grid = -1; return; }
#if MEGA
    (void)hipFuncSetAttribute((const void*)k_mega, hipFuncAttributeMaxDynamicSharedMemorySize, LDS_BYTES);
    int dev = 0, cus = 0, per_cu = 0; (void)hipGetDevice(&dev); (void)hipDeviceGetAttribute(&cus, hipDeviceAttributeMultiprocessorCount, dev);
    (void)hipOccupancyMaxActiveBlocksPerMultiprocessor(&per_cu, (const void*)k_mega, NTHR, LDS_BYTES);
    if (per_cu < 1) { fprintf(stderr, "kernel_launch: occupancy query says %d blocks per CU\n", per_cu); grid = -1; return; }
    grid = cus;
#else
    set_attr<0>(); set_attr<1>(); set_attr<2>(); set_attr<3>(); set_attr<4>(); set_attr<5>(); set_attr<6>(); set_attr<7>(); set_attr<8>(); set_attr<9>(); set_attr<10>(); set_attr<11>();
    grid = 256;
#endif
  }
  if (grid < 0) return;
  Params p{};
  const float** pp = (const float**)&p;
  for (int i = 0; i < 26; ++i) pp[i] = (const float*)d_in[i];
  p.out = (float*)d_out; p.ws = (char*)d_ws;
#if MEGA
  void* args[] = {&p};
  hipError_t e = hipLaunchCooperativeKernel((const void*)k_mega, dim3(grid), dim3(NTHR), args, LDS_BYTES, stream);
  if (e != hipSuccess) fprintf(stderr, "cooperative launch failed: %s (grid %d)\n", hipGetErrorString(e), grid);
#else
  launch_phase<0>(p, grid, stream); launch_phase<1>(p, grid, stream); launch_phase<2>(p, grid, stream); launch_phase<3>(p, grid, stream);
  launch_phase<4>(p, grid, stream); launch_phase<5>(p, grid, stream); launch_phase<6>(p, grid, stream); launch_phase<7>(p, grid, stream);
  launch_phase<8>(p, grid, stream); launch_phase<9>(p, grid, stream); launch_phase<10>(p, grid, stream); launch_phase<11>(p, grid, stream);
#endif
}
```

```cpp
#include <hip/hip_runtime.h>
#include <hip/hip_cooperative_groups.h>
#include <cstdint>
#include <cstdio>
namespace cg = cooperative_groups;

#ifndef MEGA
#define MEGA 1
#endif
#ifndef GEMM_MFMA
#define GEMM_MFMA 1
#endif
#ifndef ATTN_MFMA
#define ATTN_MFMA 1
#endif
#ifndef TOPK_FAST
#define TOPK_FAST 1
#endif

#define DEVI __device__ __forceinline__
typedef unsigned short bf16_t;
using bf16x8 = __attribute__((ext_vector_type(8))) short;
using bf16x4 = __attribute__((ext_vector_type(4))) short;
using f32x4  = __attribute__((ext_vector_type(4))) float;
using f32x16 = __attribute__((ext_vector_type(16))) float;
using u32x4  = __attribute__((ext_vector_type(4))) unsigned;
using u32x2  = __attribute__((ext_vector_type(2))) unsigned;

constexpr int DM = 1024, NB = 2, SEQ = 8192, NTOK = NB * SEQ, CTXL = 256, NCTX = NB * CTXL, NROW = NTOK + NCTX, NKEY = SEQ + CTXL;
constexpr int INW = 4544, INWP = 4608;
constexpr int NPRE = 2560;
constexpr float EPS = 1e-6f;
constexpr int NTHR = 512, NWAVE = 8;
constexpr int LDS_BYTES = 147456;

constexpr size_t al256(size_t x) { return (x + 255) / 256 * 256; }
constexpr size_t O_WIN   = 0;
constexpr size_t O_WUQ   = O_WIN  + al256((size_t)INWP * 1024 * 2);
constexpr size_t O_WUKV  = O_WUQ  + al256((size_t)1536 * 256 * 2);
constexpr size_t O_WPA   = O_WUKV + al256((size_t)2048 * 128 * 2);
constexpr size_t O_WPB   = O_WPA  + al256((size_t)1024 * 1024 * 2);
constexpr size_t O_WO    = O_WPB  + al256((size_t)1024 * 1024 * 2);
constexpr size_t O_WPQ   = O_WO   + al256((size_t)1024 * 1024 * 2);
constexpr size_t O_WS    = O_WPQ  + al256((size_t)2048 * 1024 * 2);
constexpr size_t O_K1    = O_WS   + al256((size_t)8 * 128 * 128 * 2);
constexpr size_t O_K2    = O_K1   + al256((size_t)128 * 128 * 2);
constexpr size_t O_MOD   = O_K2   + al256((size_t)128 * 128 * 2);
constexpr size_t O_ROPE  = O_MOD  + al256((size_t)3 * 6144 * 4);
constexpr size_t O_BAR   = O_ROPE + al256((size_t)128 * 16 * 2 * 4);
constexpr size_t O_RSSV  = O_BAR + al256((size_t)3456 * 4);
constexpr size_t O_RSSQ  = O_RSSV + (size_t)NTOK * 16 * 4;
constexpr size_t O_RSSKV = O_RSSQ + (size_t)NTOK * 4 * 4;
constexpr size_t O_RSSY  = O_RSSKV + (size_t)NROW * 2 * 4;
constexpr size_t O_RSSEND = O_RSSY + (size_t)NTOK * 16 * 4;
constexpr size_t O_RA    = al256(O_RSSEND);
constexpr size_t O_RB    = O_RA  + al256((size_t)NROW * 1024 * 2);
constexpr size_t O_RC    = O_RB  + al256((size_t)NTOK * 1024 * 2);
constexpr size_t O_CQ    = O_RC  + al256((size_t)NTOK * 1024 * 2);
constexpr size_t O_CKV   = O_CQ  + al256((size_t)NTOK * 256 * 2);
constexpr size_t O_KR    = O_CKV + al256((size_t)NROW * 128 * 2);
constexpr size_t O_RQ    = O_KR  + al256((size_t)NROW * 64 * 2);
constexpr size_t O_RKV   = O_RQ  + al256((size_t)NTOK * 1536 * 2);
constexpr size_t O_END   = O_RKV + al256((size_t)NROW * 2048 * 2);
static_assert(O_END <= (size_t)258 * 1024 * 1024, "workspace too large");

struct Params {
  const float *x, *c, *ctx, *c_ctx, *w_mod, *b_mod, *g_pre1, *g_post1, *g_pre2, *g_post2, *w_in, *g_q, *g_kv, *w_uq, *w_ukv, *g_sgu, *w_s, *b_s,
      *w_pa, *w_pb, *w_o, *w_pq, *k1, *k2, *u_exp, *v_exp;
  float* out; char* ws;
};

DEVI float bf2f(unsigned short h) { return __uint_as_float(((unsigned)h) << 16); }
DEVI unsigned short f2bf(float f) { unsigned u = __float_as_uint(f); u += 0x7fffu + ((u >> 16) & 1u); return (unsigned short)(u >> 16); }
DEVI unsigned pack2(float a, float b) { return (unsigned)f2bf(a) | ((unsigned)f2bf(b) << 16); }
DEVI float lo2f(unsigned w) { return __uint_as_float(w << 16); }
DEVI float hi2f(unsigned w) { return __uint_as_float(w & 0xffff0000u); }
DEVI void unpack8(const u32x4& w, float* f) {
  f[0] = lo2f(w[0]); f[1] = hi2f(w[0]); f[2] = lo2f(w[1]); f[3] = hi2f(w[1]); f[4] = lo2f(w[2]); f[5] = hi2f(w[2]); f[6] = lo2f(w[3]); f[7] = hi2f(w[3]);
}
DEVI float gelu_t(float x) { float z = 0.7978845608028654f * (x + 0.044715f * x * x * x); return x / (1.f + __expf(-2.f * z)); }
DEVI float sigmoidf_(float x) { return 1.f / (1.f + __expf(-x)); }
DEVI float wave_sum(float v) { for (int o = 32; o > 0; o >>= 1) v += __shfl_xor(v, o); return v; }
DEVI float wave_max(float v) { for (int o = 32; o > 0; o >>= 1) v = fmaxf(v, __shfl_xor(v, o)); return v; }
DEVI int keyrow(int row) { if (row < NTOK) return (row >> 13) * NKEY + (row & 8191); int c = row - NTOK; return (c >> 8) * NKEY + SEQ + (c & 255); }

__device__ const float ROPE_FREQ[16] = {1.0f, 0.5623413324356079f, 0.3162277638912201f, 0.17782793939113617f, 0.10000000149011612f, 0.05623413249850273f, 0.03162277489900589f, 0.017782794311642647f, 0.009999999776482582f, 0.005623413249850273f, 0.003162277629598975f, 0.0017782794311642647f, 0.0010000000474974513f, 0.000562341301701963f, 0.0003162277571391314f, 0.00017782794020604342f};
DEVI void sincos_small(double a, double& cs, double& sn) {
  const double k = rint(a * 0.15915494309189535); const double r = fma(-k, 6.283185307179586, a) - k * 2.4492935982947064e-16;
  const double r2 = r * r; double s = 0.0, c = 0.0;
#pragma unroll
  for (int n = 12; n >= 1; --n) { s = (1.0 - s * r2 / (double)((2 * n) * (2 * n + 1))); c = (1.0 - c * r2 / (double)((2 * n - 1) * (2 * n))); }
  sn = r * s; cs = c;
}

DEVI void transpose_job(const float* __restrict__ src, int K, int N, bf16_t* __restrict__ dst, const float* __restrict__ gk, bool isWin, int ntiles, char* smem) {
  const int tid = threadIdx.x; bf16_t* tl = (bf16_t*)smem; const int kt = K / 64;
  for (int idx = blockIdx.x; idx < ntiles; idx += gridDim.x) {
    const int ktile = idx % kt, ntile = idx / kt, k0 = ktile * 64, n0d = ntile * 64;
    int n0s = n0d; bool zero = false;
    if (isWin) { if (n0d == 2496) zero = true; else if (n0d >= 2560) n0s = n0d - 64; }
    { const int kk = tid >> 3, nn8 = (tid & 7) * 8; f32x4 va = {0.f, 0.f, 0.f, 0.f}, vb = va;
      if (!zero) { const float* s = src + (size_t)(k0 + kk) * N + n0s + nn8; const float4 a = *(const float4*)s, b = *(const float4*)(s + 4);
        const float sc = gk ? gk[k0 + kk] : 1.f; va = (f32x4){a.x, a.y, a.z, a.w} * sc; vb = (f32x4){b.x, b.y, b.z, b.w} * sc; }
      bf16_t* tp = tl + nn8 * 72 + kk;
      tp[0] = f2bf(va[0]); tp[72] = f2bf(va[1]); tp[144] = f2bf(va[2]); tp[216] = f2bf(va[3]); tp[288] = f2bf(vb[0]); tp[360] = f2bf(vb[1]); tp[432] = f2bf(vb[2]); tp[504] = f2bf(vb[3]); }
    __syncthreads();
    { const int nn = tid >> 3, kk8 = (tid & 7) * 8;
      const u32x4 o = *(const u32x4*)(tl + nn * 72 + kk8);
      *(u32x4*)(dst + (size_t)(n0d + nn) * K + k0 + kk8) = o; }
    __syncthreads();
  }
}

DEVI void ph_prep(const Params& p, char* smem) {
  const int tid = threadIdx.x, bid = blockIdx.x, nb = gridDim.x;
  char* ws = p.ws;
  if (bid == 0) { float* rope = (float*)(ws + O_ROPE);
    for (int i = tid; i < 128 * 16; i += NTHR) { const int pos = i >> 4, f = i & 15; const float ang = (float)pos * ROPE_FREQ[f];
      double cs, sn; sincos_small((double)ang, cs, sn); rope[i * 2] = (float)cs; rope[i * 2 + 1] = (float)sn; } }
  { float* red = (float*)smem; float* MOD = (float*)(ws + O_MOD);
    for (int it = bid; it < 256; it += nb) {
      const int cgp = tid % 6, kg = tid / 6;
      f32x4 a0 = {0.f, 0.f, 0.f, 0.f}, a1 = a0, a2 = a0;
      if (tid < 510) {
        for (int k = kg; k < 1024; k += 85) {
          const float4 w4 = *(const float4*)(p.w_mod + (size_t)k * 6144 + it * 24 + cgp * 4);
          const f32x4 w = {w4.x, w4.y, w4.z, w4.w};
          const float c0 = p.c[k], c1 = p.c[1024 + k], c2 = p.c_ctx[k];
          a0 += w * (c0 / (1.f + __expf(-c0))); a1 += w * (c1 / (1.f + __expf(-c1))); a2 += w * (c2 / (1.f + __expf(-c2)));
        }
        float* rp = red + kg * 72 + cgp * 4;
        rp[0] = a0[0]; rp[1] = a0[1]; rp[2] = a0[2]; rp[3] = a0[3];
        rp[24] = a1[0]; rp[25] = a1[1]; rp[26] = a1[2]; rp[27] = a1[3];
        rp[48] = a2[0]; rp[49] = a2[1]; rp[50] = a2[2]; rp[51] = a2[3];
      }
      __syncthreads();
      if (tid < 72) { float s = 0.f; for (int g = 0; g < 85; ++g) s += red[g * 72 + tid]; int r = tid / 24, n = it * 24 + tid % 24; MOD[r * 6144 + n] = s + p.b_mod[n]; }
      __syncthreads();
    } }
  transpose_job(p.w_in,  1024, INW,  (bf16_t*)(ws + O_WIN),  nullptr, true,  1152, smem);
  transpose_job(p.w_uq,  256,  1536, (bf16_t*)(ws + O_WUQ),  p.g_q,   false, 96,   smem);
  transpose_job(p.w_ukv, 128,  2048, (bf16_t*)(ws + O_WUKV), p.g_kv,  false, 64,   smem);
  transpose_job(p.w_pa,  1024, 1024, (bf16_t*)(ws + O_WPA),  nullptr, false, 256,  smem);
  transpose_job(p.w_pb,  1024, 1024, (bf16_t*)(ws + O_WPB),  nullptr, false, 256,  smem);
  transpose_job(p.w_o,   1024, 1024, (bf16_t*)(ws + O_WO),   nullptr, false, 256,  smem);
  transpose_job(p.w_pq,  1024, 2048, (bf16_t*)(ws + O_WPQ),  nullptr, false, 512,  smem);
  { const int n8 = (131072 + 16384 + 16384) / 8;
    for (int i = bid * NTHR + tid; i < n8; i += nb * NTHR) {
      int e = i * 8; const float* s; bf16_t* d;
      if (e < 131072) { s = p.w_s + e; d = (bf16_t*)(ws + O_WS) + e; }
      else if (e < 131072 + 16384) { s = p.k1 + (e - 131072); d = (bf16_t*)(ws + O_K1) + (e - 131072); }
      else { s = p.k2 + (e - 131072 - 16384); d = (bf16_t*)(ws + O_K2) + (e - 131072 - 16384); }
      const float4 a = *(const float4*)s, b = *(const float4*)(s + 4);
      u32x4 o = {pack2(a.x, a.y), pack2(a.z, a.w), pack2(b.x, b.y), pack2(b.z, b.w)};
      *(u32x4*)d = o;
    } }
}

typedef float f32x2_t __attribute__((ext_vector_type(2)));
DEVI void convert_table_fp8(const float* __restrict__ src, unsigned char* __restrict__ dst, float* __restrict__ scale) {
  const int wave = threadIdx.x >> 6, lane = threadIdx.x & 63;
  for (int row = blockIdx.x * NWAVE + wave; row < 16384; row += gridDim.x * NWAVE) {
    const float* sp = src + (size_t)row * 1024 + lane * 16;
    float4 v[4]; float am = 0.f;
#pragma unroll
    for (int j = 0; j < 4; ++j) { v[j] = *(const float4*)(sp + j * 4); am = fmaxf(am, fmaxf(fmaxf(fabsf(v[j].x), fabsf(v[j].y)), fmaxf(fabsf(v[j].z), fabsf(v[j].w)))); }
    am = wave_max(am);
    const float inv = am > 0.f ? 240.f / am : 0.f;
    u32x4 o;
#pragma unroll
    for (int j = 0; j < 4; ++j) { int w = __builtin_amdgcn_cvt_pk_fp8_f32(v[j].x * inv, v[j].y * inv, 0, false); w = __builtin_amdgcn_cvt_pk_fp8_f32(v[j].z * inv, v[j].w * inv, w, true); o[j] = (unsigned)w; }
    *(u32x4*)(dst + (size_t)row * 1024 + lane * 16) = o;
    if (lane == 0) scale[row] = am * (1.f / 240.f);
  }
}

DEVI void ph_hx(const Params& p, char* smem) {
  const int tid = threadIdx.x, wave = tid >> 6, lane = tid & 63;
  float* mA = (float*)smem; float* mB = mA + 3 * 1024;
  const float* MOD = (const float*)(p.ws + O_MOD);
  for (int i = tid; i < 3072; i += NTHR) { int r = i >> 10, c = i & 1023; mA[i] = p.g_pre1[c] * (1.f + MOD[r * 6144 + 1024 + c]); mB[i] = MOD[r * 6144 + c]; }
  __syncthreads();
  bf16_t* HX = (bf16_t*)(p.ws + O_RA);
  for (int row = blockIdx.x * NWAVE + wave; row < NROW; row += gridDim.x * NWAVE) {
    const float* src = row < NTOK ? p.x + (size_t)row * 1024 : p.ctx + (size_t)(row - NTOK) * 1024;
    const int mr = row < NTOK ? (row >> 13) : 2;
    float4 v[4]; float ss = 0.f;
#pragma unroll
    for (int i = 0; i < 4; ++i) { v[i] = *(const float4*)(src + i * 256 + lane * 4); ss += v[i].x * v[i].x + v[i].y * v[i].y + v[i].z * v[i].z + v[i].w * v[i].w; }
    ss = wave_sum(ss); const float rstd = rsqrtf(ss * (1.f / 1024.f) + EPS);
#pragma unroll
    for (int i = 0; i < 4; ++i) { const int c = i * 256 + lane * 4; const float* a = mA + mr * 1024 + c; const float* b = mB + mr * 1024 + c;
      u32x2 o = {pack2(v[i].x * rstd * a[0] + b[0], v[i].y * rstd * a[1] + b[1]), pack2(v[i].z * rstd * a[2] + b[2], v[i].w * rstd * a[3] + b[3])};
      *(u32x2*)(HX + (size_t)row * 1024 + c) = o; }
  }
}

DEVI int lds_sw(int row, int c) { return row * 128 + ((c ^ (row & 7)) << 4); }
template <int BM, int BN, bool ACOLMAP, bool GLDS, class Epi>
DEVI void gemm_tile_mfma(const bf16_t* __restrict__ A, int lda, const bf16_t* __restrict__ Bm, int ldb, int K, int row0, int col0, const Epi& epi, const float* kscale, char* smem) {
  constexpr int WNW = BN / 64, WMW = 8 / WNW, WTM = BM / WMW, MI = WTM / 16, ACH = BM / 64, BCH = BN / 64, ABYTES = BM * 128, BBYTES = BN * 128, STAGE = ABYTES + BBYTES;
  const int tid = threadIdx.x, wave = tid >> 6, lane = tid & 63, wm = wave / WNW, wn = wave % WNW, l15 = lane & 15, lq = lane >> 4;
  f32x4 acc[MI][4];
#pragma unroll
  for (int mi = 0; mi < MI; ++mi)
#pragma unroll
    for (int ni = 0; ni < 4; ++ni) acc[mi][ni] = (f32x4){0.f, 0.f, 0.f, 0.f};
  const int nk = K >> 6;
  const int sr = tid >> 3, scc = tid & 7;
  auto compute = [&](int buf) {
    const char* sa = smem + buf * STAGE; const char* sb = sa + ABYTES;
#pragma unroll
    for (int ks = 0; ks < 2; ++ks) { const int kc = ks * 4 + lq; bf16x8 bfr[4];
#pragma unroll
      for (int ni = 0; ni < 4; ++ni) bfr[ni] = *(const bf16x8*)(sb + lds_sw(wn * 64 + ni * 16 + l15, kc));
#pragma unroll
      for (int mi = 0; mi < MI; ++mi) { const bf16x8 af = *(const bf16x8*)(sa + lds_sw(wm * WTM + mi * 16 + l15, kc));
#pragma unroll
        for (int ni = 0; ni < 4; ++ni) acc[mi][ni] = __builtin_amdgcn_mfma_f32_16x16x32_bf16(bfr[ni], af, acc[mi][ni], 0, 0, 0); }
      if (MI > 4) __builtin_amdgcn_sched_barrier(0); }
  };
  if constexpr (GLDS) {
    const unsigned aoff = (unsigned)(sr * lda + ((scc ^ (sr & 7)) * 8)) * 2u, boff = (unsigned)(sr * ldb + ((scc ^ (sr & 7)) * 8)) * 2u;
    auto gstage = [&](int buf, int kt) {
      const int k0 = kt * 64, ka = ACOLMAP ? k0 + (k0 >> 7) * 64 : k0;
      char* sa = smem + buf * STAGE + wave * 1024; char* sb = sa + ABYTES;
#pragma unroll
      for (int i = 0; i < ACH; ++i) __builtin_amdgcn_global_load_lds((const unsigned*)((const char*)(A + (size_t)(64 * i) * lda + ka) + aoff), (unsigned*)(sa + i * 8192), 16, 0, 0);
#pragma unroll
      for (int i = 0; i < BCH; ++i) __builtin_amdgcn_global_load_lds((const unsigned*)((const char*)(Bm + (size_t)(64 * i) * ldb + k0) + boff), (unsigned*)(sb + i * 8192), 16, 0, 0);
    };
    gstage(0, 0); asm volatile("s_waitcnt vmcnt(0)" ::: "memory"); __syncthreads();
    for (int kt = 0; kt < nk; ++kt) {
      if (kt + 1 < nk) gstage((kt + 1) & 1, kt + 1);
      compute(kt & 1);
      asm volatile("s_waitcnt vmcnt(0)" ::: "memory"); __syncthreads();
    }
  } else {
    u32x4 ra[ACH], rb[BCH];
    const unsigned aoff = (unsigned)(sr * lda + scc * 8) * 2u, boff = (unsigned)(sr * ldb + scc * 8) * 2u;
    const int sdst = lds_sw(sr, scc);
    auto gload = [&](int kt) {
      const int k0 = kt * 64, ka = ACOLMAP ? k0 + (k0 >> 7) * 64 : k0;
#pragma unroll
      for (int i = 0; i < ACH; ++i) { const char* ub = (const char*)(A + (size_t)(64 * i) * lda + ka); ra[i] = *(const u32x4*)(ub + aoff); }
#pragma unroll
      for (int i = 0; i < BCH; ++i) { const char* ub = (const char*)(Bm + (size_t)(64 * i) * ldb + k0); rb[i] = *(const u32x4*)(ub + boff); }
    };
    auto lstore = [&](int buf, int kt) {
      char* sa = smem + buf * STAGE + sdst; char* sb = sa + ABYTES;
#pragma unroll
      for (int i = 0; i < ACH; ++i) { u32x4 v = ra[i];
        if (kscale) { float f[8]; unpack8(v, f); const float* ks = kscale + kt * 64 + scc * 8;
          v = (u32x4){pack2(f[0] * ks[0], f[1] * ks[1]), pack2(f[2] * ks[2], f[3] * ks[3]), pack2(f[4] * ks[4], f[5] * ks[5]), pack2(f[6] * ks[6], f[7] * ks[7])}; }
        *(u32x4*)(sa + i * 8192) = v; }
#pragma unroll
      for (int i = 0; i < BCH; ++i) *(u32x4*)(sb + i * 8192) = rb[i];
    };
    gload(0); lstore(0, 0); __syncthreads();
    for (int kt = 0; kt < nk; ++kt) {
      if (kt + 1 < nk) gload(kt + 1);
      compute(kt & 1);
      if (kt + 1 < nk) lstore((kt + 1) & 1, kt + 1);
      __syncthreads();
    }
  }
#pragma unroll
  for (int mi = 0; mi < MI; ++mi) { const int row = row0 + wm * WTM + mi * 16 + l15; float sq = 0.f;
#pragma unroll
    for (int ni = 0; ni < 4; ++ni) { const float v[4] = {acc[mi][ni][0], acc[mi][ni][1], acc[mi][ni][2], acc[mi][ni][3]}; sq += epi(row, col0 + wn * 64 + ni * 16 + lq * 4, v); }
    if (Epi::RSS) { sq += __shfl_xor(sq, 16); sq += __shfl_xor(sq, 32); if (lq == 0) epi.rss(row, col0 + wn * 64, sq); }
    __builtin_amdgcn_sched_barrier(0); }
}

template <int BM, int BN, bool ACOLMAP, class Epi>
DEVI void gemm_tile(const bf16_t* A, int lda, const bf16_t* Bm, int ldb, int K, int row0, int col0, const Epi& epi, const float* kss, char* smem) {
  if (kss) gemm_tile_mfma<BM, BN, ACOLMAP, false>(A, lda, Bm, ldb, K, row0, col0, epi, kss, smem);
  else gemm_tile_mfma<BM, BN, ACOLMAP, true>(A, lda, Bm, ldb, K, row0, col0, epi, nullptr, smem);
}

DEVI void st4bf(bf16_t* d, float a, float b, float c, float e) { u32x2 o = {pack2(a, b), pack2(c, e)}; *(u32x2*)d = o; }

struct EpiIn { static constexpr bool RSS = true; bf16_t *GU, *GVT, *CQ, *CKV, *KR; float *rssv, *rssq, *rsskv;
  DEVI float operator()(int row, int col, const float (&v)[4]) const {
    if (col < 1024) { st4bf(GU + (size_t)row * 1024 + col, gelu_t(v[0]), gelu_t(v[1]), gelu_t(v[2]), gelu_t(v[3])); return 0.f; }
    else if (col < 2048) { const int c = col - 1024, chunk = row >> 7, q = row & 127; float s = 0.f;
#pragma unroll
      for (int j = 0; j < 4; ++j) { const float g = gelu_t(v[j]); s += g * g; GVT[((size_t)chunk * 1024 + c + j) * 128 + q] = f2bf(g); }
      return s; }
    else if (col < 2304) { st4bf(CQ + (size_t)row * 256 + (col - 2048), v[0], v[1], v[2], v[3]); return v[0] * v[0] + v[1] * v[1] + v[2] * v[2] + v[3] * v[3]; }
    else if (col < 2432) { st4bf(CKV + (size_t)row * 128 + (col - 2304), v[0], v[1], v[2], v[3]); return v[0] * v[0] + v[1] * v[1] + v[2] * v[2] + v[3] * v[3]; }
    else if (col < 2496) { st4bf(KR + (size_t)keyrow(row) * 64 + (col - 2432), v[0], v[1], v[2], v[3]); return 0.f; }
    return 0.f; }
  DEVI void rss(int row, int col, float s) const {
    if (col >= 1024 && col < 2048) rssv[row * 16 + ((col - 1024) >> 6)] = s; else if (col >= 2048 && col < 2304) rssq[row * 4 + ((col - 2048) >> 6)] = s; else if (col >= 2304 && col < 2432) rsskv[row * 2 + ((col - 2304) >> 6)] = s; }
};
struct EpiQ { static constexpr bool RSS = false; bf16_t* Q; const float* rssq;
  DEVI float operator()(int row, int col, const float (&v)[4]) const { const float4 ps = *(const float4*)(rssq + row * 4); const float r = rsqrtf(((ps.x + ps.y) + (ps.z + ps.w)) * (1.f / 256.f) + EPS);
    st4bf(Q + (size_t)row * 1536 + col, v[0] * r, v[1] * r, v[2] * r, v[3] * r); return 0.f; }
  DEVI void rss(int, int, float) const {} };
struct EpiKV { static constexpr bool RSS = false; bf16_t* KV; const float* rsskv;
  DEVI float operator()(int row, int col, const float (&v)[4]) const { const float r = rsqrtf((rsskv[row * 2] + rsskv[row * 2 + 1]) * (1.f / 128.f) + EPS);
    st4bf(KV + (size_t)keyrow(row) * 2048 + col, v[0] * r, v[1] * r, v[2] * r, v[3] * r); return 0.f; }
  DEVI void rss(int, int, float) const {} };
struct EpiSgu { static constexpr bool RSS = false; bf16_t* GUOA; const float* g_sgu; const float* b_s; int chunk, g;
  DEVI float operator()(int row, int col, const float (&v)[4]) const { const int token = chunk * 128 + row, ch = g * 128 + col; const float bias = b_s[g * 128 + row];
    bf16_t* ptr = GUOA + (size_t)token * 1024 + ch; const u32x2 gu = *(const u32x2*)ptr;
    st4bf(ptr, lo2f(gu[0]) * (g_sgu[ch] * v[0] + bias), hi2f(gu[0]) * (g_sgu[ch + 1] * v[1] + bias), lo2f(gu[1]) * (g_sgu[ch + 2] * v[2] + bias), hi2f(gu[1]) * (g_sgu[ch + 3] * v[3] + bias));
    return 0.f; }
  DEVI void rss(int, int, float) const {} };
struct EpiGate { static constexpr bool RSS = false; bf16_t* G;
  DEVI float operator()(int row, int col, const float (&v)[4]) const { st4bf(G + (size_t)row * 2048 + col, sigmoidf_(v[0]), sigmoidf_(v[1]), sigmoidf_(v[2]), sigmoidf_(v[3])); return 0.f; }
  DEVI void rss(int, int, float) const {} };
template <bool SECOND> struct EpiMerge { static constexpr bool RSS = false; bf16_t* M; const bf16_t* G;
  DEVI float operator()(int row, int col, const float (&v)[4]) const { const u32x2 g = *(const u32x2*)(G + (size_t)row * 2048 + (SECOND ? 1024 : 0) + col);
    float o0 = lo2f(g[0]) * v[0], o1 = hi2f(g[0]) * v[1], o2 = lo2f(g[1]) * v[2], o3 = hi2f(g[1]) * v[3];
    bf16_t* ptr = M + (size_t)row * 1024 + col;
    if (SECOND) { const u32x2 m = *(const u32x2*)ptr; o0 += lo2f(m[0]); o1 += hi2f(m[0]); o2 += lo2f(m[1]); o3 += hi2f(m[1]); }
    st4bf(ptr, o0, o1, o2, o3); return 0.f; }
  DEVI void rss(int, int, float) const {} };
struct EpiO { static constexpr bool RSS = true; bf16_t* Y; float* rssy;
  DEVI float operator()(int row, int col, const float (&v)[4]) const { st4bf(Y + (size_t)row * 1024 + col, v[0], v[1], v[2], v[3]); return v[0] * v[0] + v[1] * v[1] + v[2] * v[2] + v[3] * v[3]; }
  DEVI void rss(int row, int col, float s) const { rssy[row * 16 + (col >> 6)] = s; } };
struct EpiPq { static constexpr bool RSS = false; bf16_t* QP;
  DEVI float operator()(int row, int col, const float (&v)[4]) const { st4bf(QP + (size_t)row * 2048 + col, v[0], v[1], v[2], v[3]); return 0.f; }
  DEVI void rss(int, int, float) const {} };

template <class F> DEVI void for_tiles_xcd(int MT, int NT, F f) {
  const int nb = gridDim.x;
  if ((nb & 7) == 0 && (MT & 7) == 0) { const int xcd = blockIdx.x & 7, slot = blockIdx.x >> 3, slots = nb >> 3, mper = MT >> 3, tot = mper * NT;
    for (int j = slot; j < tot; j += slots) f(xcd * mper + j / NT, j % NT); }
  else for (int i = blockIdx.x; i < MT * NT; i += nb) f(i / NT, i % NT);
}

DEVI void ph_inproj(const Params& p, char* smem) {
  char* ws = p.ws;
  EpiIn epi{(bf16_t*)(ws + O_RB), (bf16_t*)(ws + O_RC), (bf16_t*)(ws + O_CQ), (bf16_t*)(ws + O_CKV), (bf16_t*)(ws + O_KR), (float*)(ws + O_RSSV), (float*)(ws + O_RSSQ), (float*)(ws + O_RSSKV)};
  const bf16_t* HX = (const bf16_t*)(ws + O_RA); const bf16_t* W = (const bf16_t*)(ws + O_WIN);
  auto tile = [&](int mt, int nt) { gemm_tile<256, 256, false>(HX + (size_t)mt * 256 * 1024, 1024, W + (size_t)nt * 256 * 1024, 1024, 1024, mt * 256, nt * 256, epi, nullptr, smem); };
  for_tiles_xcd(64, 10, tile);
  for (int i = (int)gridDim.x - 1 - (int)blockIdx.x; i < 2; i += gridDim.x) tile(64 + i, 9);
}
DEVI void rope_kr(const Params& p) {
  bf16_t* KR = (bf16_t*)(p.ws + O_KR); const float* rope = (const float*)(p.ws + O_ROPE);
  for (int i = blockIdx.x * NTHR + threadIdx.x; i < NTOK * 32; i += gridDim.x * NTHR) {
    const int tok = i >> 5, j = i & 15, which = (i >> 4) & 1, pos = tok & 8191, pp = which ? (pos & 63) : (pos >> 6);
    const float cs = rope[(pp * 16 + j) * 2], sn = rope[(pp * 16 + j) * 2 + 1];
    bf16_t* r = KR + (size_t)keyrow(tok) * 64 + which * 32 + j;
    const float x1 = bf2f(r[0]), x2 = bf2f(r[16]);
    r[0] = f2bf(x1 * cs - x2 * sn); r[16] = f2bf(x1 * sn + x2 * cs);
  }
}
DEVI void ph_mid(const Params& p, char* smem) {
  char* ws = p.ws;
  { EpiQ epi{(bf16_t*)(ws + O_RQ), (const float*)(ws + O_RSSQ)};
    const bf16_t* A = (const bf16_t*)(ws + O_CQ); const bf16_t* W = (const bf16_t*)(ws + O_WUQ);
    for_tiles_xcd(64, 12, [&](int mt, int nt) { gemm_tile<256, 128, false>(A + (size_t)mt * 256 * 256, 256, W + (size_t)nt * 128 * 256, 256, 256, mt * 256, nt * 128, epi, nullptr, smem); }); }
  { EpiKV epi{(bf16_t*)(ws + O_RKV), (const float*)(ws + O_RSSKV)};
    const bf16_t* A = (const bf16_t*)(ws + O_CKV); const bf16_t* W = (const bf16_t*)(ws + O_WUKV);
    auto tile = [&](int mt, int nt) { gemm_tile<256, 128, false>(A + (size_t)mt * 256 * 128, 128, W + (size_t)nt * 128 * 128, 128, 128, mt * 256, nt * 128, epi, nullptr, smem); };
    for_tiles_xcd(64, 16, tile);
    for (int i = blockIdx.x; i < 32; i += gridDim.x) tile(64 + (i >> 4), i & 15); }
  { const bf16_t* WS = (const bf16_t*)(ws + O_WS); const bf16_t* GVT = (const bf16_t*)(ws + O_RC);
    float* ksc = (float*)(smem + LDS_BYTES - 1024); const float* rssv = (const float*)(ws + O_RSSV);
    for (int i = blockIdx.x; i < 1024; i += gridDim.x) { const int chunk = i >> 3, g = i & 7;
      __syncthreads();
      if (threadIdx.x < 128) { const float* pr = rssv + (size_t)(chunk * 128 + threadIdx.x) * 16; float t = 0.f;
#pragma unroll
        for (int j = 0; j < 16; ++j) t += pr[j];
        ksc[threadIdx.x] = rsqrtf(t * (1.f / 1024.f) + EPS); }
      __syncthreads();
      EpiSgu epi{(bf16_t*)(ws + O_RB), p.g_sgu, p.b_s, chunk, g};
      gemm_tile<128, 128, false>(WS + (size_t)g * 16384, 128, GVT + ((size_t)chunk * 1024 + g * 128) * 128, 128, 128, 0, 0, epi, ksc, smem); } }
  rope_kr(p);
}
DEVI void ph_gates(const Params& p, char* smem) {
  char* ws = p.ws; EpiGate epi{(bf16_t*)(ws + O_RKV)};
  const bf16_t* HX = (const bf16_t*)(ws + O_RA); const bf16_t* W = (const bf16_t*)(ws + O_WIN) + (size_t)NPRE * 1024;
  for_tiles_xcd(64, 8, [&](int mt, int nt) { gemm_tile<256, 256, false>(HX + (size_t)mt * 256 * 1024, 1024, W + (size_t)nt * 256 * 1024, 1024, 1024, mt * 256, nt * 256, epi, nullptr, smem); });
}
DEVI void ph_merge(const Params& p, char* smem) {
  char* ws = p.ws; bf16_t* M = (bf16_t*)(ws + O_RC); const bf16_t* G = (const bf16_t*)(ws + O_RKV);
  EpiMerge<false> e1{M, G}; EpiMerge<true> e2{M, G};
  const bf16_t* OA = (const bf16_t*)(ws + O_RB); const bf16_t* OB = (const bf16_t*)(ws + O_RQ);
  const bf16_t* WA = (const bf16_t*)(ws + O_WPA); const bf16_t* WB = (const bf16_t*)(ws + O_WPB);
  for_tiles_xcd(64, 4, [&](int mt, int nt) { gemm_tile<256, 256, false>(OA + (size_t)mt * 256 * 1024, 1024, WA + (size_t)nt * 256 * 1024, 1024, 1024, mt * 256, nt * 256, e1, nullptr, smem); });
  for_tiles_xcd(64, 4, [&](int mt, int nt) { gemm_tile<256, 256, true>(OB + (size_t)mt * 256 * 1536, 1536, WB + (size_t)nt * 256 * 1024, 1024, 1024, mt * 256, nt * 256, e2, nullptr, smem); });
}
DEVI void ph_wo(const Params& p, char* smem) {
  char* ws = p.ws; EpiO epi{(bf16_t*)(ws + O_RA), (float*)(ws + O_RSSY)};
  const bf16_t* M = (const bf16_t*)(ws + O_RC); const bf16_t* W = (const bf16_t*)(ws + O_WO);
  for_tiles_xcd(64, 4, [&](int mt, int nt) { gemm_tile<256, 256, false>(M + (size_t)mt * 256 * 1024, 1024, W + (size_t)nt * 256 * 1024, 1024, 1024, mt * 256, nt * 256, epi, nullptr, smem); });
}
DEVI void ph_wpq(const Params& p, char* smem) {
  char* ws = p.ws; EpiPq epi{(bf16_t*)(ws + O_RKV)};
  const bf16_t* A = (const bf16_t*)(ws + O_RB); const bf16_t* W = (const bf16_t*)(ws + O_WPQ);
  for_tiles_xcd(64, 8, [&](int mt, int nt) { gemm_tile<256, 256, false>(A + (size_t)mt * 256 * 1024, 1024, W + (size_t)nt * 256 * 1024, 1024, 1024, mt * 256, nt * 256, epi, nullptr, smem); });
  convert_table_fp8(p.v_exp, (unsigned char*)(ws + O_RA), (float*)(ws + O_RA + (size_t)16384 * 1024));
}

DEVI void attn_naive(const Params& p, char* smem) {
  const int tid = threadIdx.x, wave = tid >> 6, lane = tid & 63;
  float* qs = (float*)smem + wave * 256; float* ps = qs + 192;
  bf16_t* Q = (bf16_t*)(p.ws + O_RQ); const bf16_t* KV = (const bf16_t*)(p.ws + O_RKV); const bf16_t* KR = (const bf16_t*)(p.ws + O_KR);
  const float* rope = (const float*)(p.ws + O_ROPE);
  const float scale = 0.07216878364870322f;
  for (int base = blockIdx.x * NWAVE; base < NB * 8 * SEQ; base += gridDim.x * NWAVE) {
    const int it = base + wave, bh = it >> 13, qi = it & 8191, b = bh >> 3, h = bh & 7;
    const size_t qoff = (size_t)(b * SEQ + qi) * 1536 + h * 192;
    __syncthreads();
    for (int d = lane; d < 192; d += 64) qs[d] = bf2f(Q[qoff + d]);
    __syncthreads();
    if (lane < 32) { const int j = lane & 15, which = lane >> 4, pp = which ? (qi & 63) : (qi >> 6);
      const float cs = rope[(pp * 16 + j) * 2], sn = rope[(pp * 16 + j) * 2 + 1]; const int d1 = 128 + which * 32 + j, d2 = d1 + 16;
      const float x1 = qs[d1], x2 = qs[d2]; qs[d1] = x1 * cs - x2 * sn; qs[d2] = x1 * sn + x2 * cs; }
    __syncthreads();
    float m = -1e30f, l = 0.f, o0 = 0.f, o1 = 0.f;
    for (int k0 = 0; k0 < NKEY; k0 += 64) {
      const size_t kr = (size_t)(b * NKEY + k0 + lane);
      const bf16_t* kn = KV + kr * 2048 + h * 256; const bf16_t* krp = KR + kr * 64;
      float s = 0.f;
#pragma unroll 4
      for (int d8 = 0; d8 < 16; ++d8) { float kf[8]; unpack8(*(const u32x4*)(kn + d8 * 8), kf); const float4 q0 = *(const float4*)(qs + d8 * 8), q1 = *(const float4*)(qs + d8 * 8 + 4);
        s += q0.x * kf[0] + q0.y * kf[1] + q0.z * kf[2] + q0.w * kf[3] + q1.x * kf[4] + q1.y * kf[5] + q1.z * kf[6] + q1.w * kf[7]; }
#pragma unroll 4
      for (int d8 = 0; d8 < 8; ++d8) { float kf[8]; unpack8(*(const u32x4*)(krp + d8 * 8), kf); const float4 q0 = *(const float4*)(qs + 128 + d8 * 8), q1 = *(const float4*)(qs + 128 + d8 * 8 + 4);
        s += q0.x * kf[0] + q0.y * kf[1] + q0.z * kf[2] + q0.w * kf[3] + q1.x * kf[4] + q1.y * kf[5] + q1.z * kf[6] + q1.w * kf[7]; }
      s *= scale;
      const float mn = fmaxf(m, wave_max(s)), al = __expf(m - mn), pe = __expf(s - mn);
      l = l * al + wave_sum(pe); m = mn; o0 *= al; o1 *= al;
      __syncthreads();
      ps[lane] = pe;
      __syncthreads();
      const bf16_t* vp = KV + (size_t)(b * NKEY + k0) * 2048 + h * 256 + 128 + lane * 2;
#pragma unroll 8
      for (int kk = 0; kk < 64; ++kk) { const unsigned w = *(const unsigned*)(vp + (size_t)kk * 2048); const float pk = ps[kk]; o0 += pk * lo2f(w); o1 += pk * hi2f(w); }
    }
    const float invL = 1.f / l;
    *(unsigned*)(Q + qoff + lane * 2) = pack2(o0 * invL, o1 * invL);
  }
}

namespace at {
constexpr int QBLK = 32, KVBLK = 64;
constexpr float SCALE = 0.07216878364870322f;
constexpr float THR = 8.f;
constexpr int SHM_V = KVBLK * 128 * 2, SHM_K = KVBLK * 192 * 2;
using s16x4 = __attribute__((ext_vector_type(4))) short;
#define KSWZ(row, colB) ((row) * 384 + ((colB) ^ (((row) & 7) << 4)))
#define SBAR() __builtin_amdgcn_sched_barrier(0)
DEVI int crow(int r, int hi) { return (r & 3) + 8 * (r >> 2) + 4 * hi; }
DEVI unsigned cvtpk(float lo, float hi) { unsigned r; asm volatile("v_cvt_pk_bf16_f32 %0, %1, %2" : "=v"(r) : "v"(lo), "v"(hi)); return r; }
DEVI void partialSM(f32x16& p0, f32x16& p1, float& m_reg, float& mn, float& alpha) {
  constexpr float C = SCALE * 1.4426950408889634f;
  float pmax = p0[0];
#pragma unroll
  for (int r = 1; r < 16; ++r) pmax = fmaxf(pmax, p0[r]);
#pragma unroll
  for (int r = 0; r < 16; ++r) pmax = fmaxf(pmax, p1[r]);
  { auto rr = __builtin_amdgcn_permlane32_swap(__float_as_uint(pmax), __float_as_uint(pmax), false, false);
    pmax = fmaxf(__uint_as_float(rr[0]), __uint_as_float(rr[1])); }
  if (__builtin_expect(__all(pmax - m_reg <= THR / SCALE), 1)) { mn = m_reg; alpha = 1.f; }
  else { mn = fmaxf(m_reg, pmax); alpha = __builtin_amdgcn_exp2f((m_reg - mn) * C); m_reg = mn; }
  const float mnC = -mn * C;
#pragma unroll
  for (int r = 0; r < 16; ++r) p0[r] = fmaf(p0[r], C, mnC);
#pragma unroll
  for (int r = 0; r < 16; ++r) p1[r] = fmaf(p1[r], C, mnC);
#pragma unroll
  for (int r = 0; r < 16; ++r) p0[r] = __builtin_amdgcn_exp2f(p0[r]);
}
DEVI void finishSM(f32x16& p0, f32x16& p1, float alpha, float& l_reg, bf16x8& pa0, bf16x8& pa1, bf16x8& pa2, bf16x8& pa3) {
#pragma unroll
  for (int r = 0; r < 16; ++r) p1[r] = __builtin_amdgcn_exp2f(p1[r]);
  float ps = 0;
#pragma unroll
  for (int r = 0; r < 16; ++r) ps += p0[r];
#pragma unroll
  for (int r = 0; r < 16; ++r) ps += p1[r];
  { auto rr = __builtin_amdgcn_permlane32_swap(__float_as_uint(ps), __float_as_uint(ps), false, false);
    ps = __uint_as_float(rr[0]) + __uint_as_float(rr[1]); }
  l_reg = l_reg * alpha + ps;
#define PK4(P, BASE, OUT) do { unsigned a0 = cvtpk(P[BASE + 0], P[BASE + 1]), a1 = cvtpk(P[BASE + 2], P[BASE + 3]);   \
    unsigned b0 = cvtpk(P[BASE + 4], P[BASE + 5]), b1 = cvtpk(P[BASE + 6], P[BASE + 7]);                              \
    auto r0 = __builtin_amdgcn_permlane32_swap(a0, b0, false, false); auto r1 = __builtin_amdgcn_permlane32_swap(a1, b1, false, false); \
    u32x4 w = {r0[0], r1[0], r0[1], r1[1]}; OUT = *reinterpret_cast<bf16x8*>(&w); } while (0)
  PK4(p0, 0, pa0); PK4(p0, 8, pa1); PK4(p1, 0, pa2); PK4(p1, 8, pa3);
#undef PK4
}
DEVI void qkt(f32x16& p0, f32x16& p1, const char* Ks, const bf16x8* qr, const char* qrl, int r32, int hi) {
  p0 = f32x16{}; p1 = f32x16{};
#pragma unroll
  for (int d0 = 0; d0 < 12; ++d0) { const int cb = (d0 * 16 + hi * 8) * 2;
    const bf16x8 b0 = *reinterpret_cast<const bf16x8*>(Ks + KSWZ(r32, cb));
    const bf16x8 b1 = *reinterpret_cast<const bf16x8*>(Ks + KSWZ(32 + r32, cb));
    const bf16x8 q = d0 < 8 ? qr[d0 < 8 ? d0 : 0] : *reinterpret_cast<const bf16x8*>(qrl + (d0 - 8) * 1024);
    p0 = __builtin_amdgcn_mfma_f32_32x32x16_bf16(b0, q, p0, 0, 0, 0);
    p1 = __builtin_amdgcn_mfma_f32_32x32x16_bf16(b1, q, p1, 0, 0, 0); }
}
DEVI int v_st(int k, int c) { const int kk = (k & ~0xC) | ((k & 4) << 1) | ((k & 8) >> 1); return ((kk >> 3) * 4 + (c >> 5)) * 512 + ((kk & 7) * 32 + (c & 31)) * 2; }
DEVI int v_rd_base(int lane) { return ((lane & 3) << 3) | (((lane >> 2) & 3) << 6) | (((lane >> 4) & 1) << 5) | (((lane >> 5) & 1) << 8); }
constexpr int v_rd_off(int d0, int ks, int half) { return d0 * 512 + ks * 4096 + half * 2048; }
template <int OFF> DEVI s16x4 tr_read(int vb) { s16x4 r; asm volatile("ds_read_b64_tr_b16 %0, %1 offset:%2" : "=&v"(r) : "v"(vb), "i"(OFF) : "memory"); return r; }
template <int D0> DEVI void pv_one(f32x16& od, int vb, bf16x8 pa0, bf16x8 pa1, bf16x8 pa2, bf16x8 pa3) {
  const s16x4 l0 = tr_read<v_rd_off(D0, 0, 0)>(vb), h0 = tr_read<v_rd_off(D0, 0, 1)>(vb), l1 = tr_read<v_rd_off(D0, 1, 0)>(vb), h1 = tr_read<v_rd_off(D0, 1, 1)>(vb);
  const s16x4 l2 = tr_read<v_rd_off(D0, 2, 0)>(vb), h2 = tr_read<v_rd_off(D0, 2, 1)>(vb), l3 = tr_read<v_rd_off(D0, 3, 0)>(vb), h3 = tr_read<v_rd_off(D0, 3, 1)>(vb);
  asm volatile("s_waitcnt lgkmcnt(0)" ::: "memory"); SBAR();
#define PK(L, H) (bf16x8){L[0], L[1], L[2], L[3], H[0], H[1], H[2], H[3]}
  od = __builtin_amdgcn_mfma_f32_32x32x16_bf16(pa0, PK(l0, h0), od, 0, 0, 0);
  od = __builtin_amdgcn_mfma_f32_32x32x16_bf16(pa1, PK(l1, h1), od, 0, 0, 0);
  od = __builtin_amdgcn_mfma_f32_32x32x16_bf16(pa2, PK(l2, h2), od, 0, 0, 0);
  od = __builtin_amdgcn_mfma_f32_32x32x16_bf16(pa3, PK(l3, h3), od, 0, 0, 0);
#undef PK
}
DEVI void pv_d0(f32x16* o, int vb, bf16x8 pa0, bf16x8 pa1, bf16x8 pa2, bf16x8 pa3) {
  pv_one<0>(o[0], vb, pa0, pa1, pa2, pa3); pv_one<1>(o[1], vb, pa0, pa1, pa2, pa3); pv_one<2>(o[2], vb, pa0, pa1, pa2, pa3); pv_one<3>(o[3], vb, pa0, pa1, pa2, pa3);
}
DEVI void rope_frag(bf16x8& f1, bf16x8& f2, const float* cs) {
  u32x4 w1 = *reinterpret_cast<u32x4*>(&f1), w2 = *reinterpret_cast<u32x4*>(&f2); float a[8], b[8]; unpack8(w1, a); unpack8(w2, b);
  float c[8], s[8];
#pragma unroll
  for (int q = 0; q < 4; ++q) { const float4 t = *(const float4*)(cs + q * 4); c[q * 2] = t.x; s[q * 2] = t.y; c[q * 2 + 1] = t.z; s[q * 2 + 1] = t.w; }
  float x[8], y[8];
#pragma unroll
  for (int j = 0; j < 8; ++j) { x[j] = a[j] * c[j] - b[j] * s[j]; y[j] = a[j] * s[j] + b[j] * c[j]; }
  w1 = (u32x4){cvtpk(x[0], x[1]), cvtpk(x[2], x[3]), cvtpk(x[4], x[5]), cvtpk(x[6], x[7])};
  w2 = (u32x4){cvtpk(y[0], y[1]), cvtpk(y[2], y[3]), cvtpk(y[4], y[5]), cvtpk(y[6], y[7])};
  f1 = *reinterpret_cast<bf16x8*>(&w1); f2 = *reinterpret_cast<bf16x8*>(&w2);
}
DEVI void attn_item(bf16_t* __restrict__ Qb, const bf16_t* __restrict__ Kn, const bf16_t* __restrict__ Vh, const bf16_t* __restrict__ Kr, const float* __restrict__ rope, int pos0, char* lds) {
  const int tid = threadIdx.x, wid = tid >> 6, lane = tid & 63, r32 = lane & 31, hi = lane >> 5;
  char* V_lds = lds; char* K_lds = lds + 2 * SHM_V;
  float* wsl = (float*)(lds + 2 * SHM_V + 2 * SHM_K) + wid * 64; float* li_l = wsl; float* al_l = wsl + 32;
  char* qrl = lds + 2 * SHM_V + 2 * SHM_K + 2048 + wid * 4096 + lane * 16;
  float m_reg = -1e30f, l_reg = 0; f32x16 o[4] = {}; bf16x8 qr[8];
  bf16_t* Qw = Qb + (size_t)(wid * QBLK + r32) * 1536 + hi * 8;
#pragma unroll
  for (int d0 = 0; d0 < 8; ++d0) qr[d0] = *reinterpret_cast<const bf16x8*>(Qw + d0 * 16);
  { bf16x8 q8 = *reinterpret_cast<const bf16x8*>(Qw + 128), q9 = *reinterpret_cast<const bf16x8*>(Qw + 144), q10 = *reinterpret_cast<const bf16x8*>(Qw + 160), q11 = *reinterpret_cast<const bf16x8*>(Qw + 176);
    const int pos = pos0 + wid * QBLK + r32;
    rope_frag(q8, q9, rope + ((pos >> 6) * 16 + hi * 8) * 2); rope_frag(q10, q11, rope + ((pos & 63) * 16 + hi * 8) * 2);
    *reinterpret_cast<bf16x8*>(qrl) = q8; *reinterpret_cast<bf16x8*>(qrl + 1024) = q9; *reinterpret_cast<bf16x8*>(qrl + 2048) = q10; *reinterpret_cast<bf16x8*>(qrl + 3072) = q11; }
  const int sr = tid >> 4, sc = (tid & 15) * 8, vst0 = v_st(sr, sc), vst1 = v_st(32 + sr, sc);
  const int kst0 = KSWZ(sr, sc * 2), kst1 = KSWZ(32 + sr, sc * 2), kst2 = KSWZ(tid >> 3, 256 + (tid & 7) * 16);
  const int goff = sr * 2048 + sc, goffr = (tid >> 3) * 64 + (tid & 7) * 8;
  const int vb0 = (int)(uintptr_t)V_lds + v_rd_base(lane);
  u32x4 sv0, sv1, sk0, sk1, sk2;
#define SLOAD(k0) do { const bf16_t* vp = Vh + (size_t)(k0) * 2048 + goff; const bf16_t* kp = Kn + (size_t)(k0) * 2048 + goff; \
    sv0 = *(const u32x4*)vp; sv1 = *(const u32x4*)(vp + 32 * 2048); sk0 = *(const u32x4*)kp; sk1 = *(const u32x4*)(kp + 32 * 2048); \
    sk2 = *(const u32x4*)(Kr + (size_t)(k0) * 64 + goffr); } while (0)
#define SWRITE(b) do { *(u32x4*)(V_lds + (b) * SHM_V + vst0) = sv0; *(u32x4*)(V_lds + (b) * SHM_V + vst1) = sv1; \
    *(u32x4*)(K_lds + (b) * SHM_K + kst0) = sk0; *(u32x4*)(K_lds + (b) * SHM_K + kst1) = sk1; *(u32x4*)(K_lds + (b) * SHM_K + kst2) = sk2; } while (0)
#define SWAIT() asm volatile("s_waitcnt vmcnt(0)" ::: "memory")
#define RESC(a) do { if (__any((a) < 1.f)) { if (hi == 0) al_l[r32] = (a); asm volatile("s_waitcnt lgkmcnt(0)" ::: "memory"); \
    _Pragma("unroll") for (int d = 0; d < 4; ++d) _Pragma("unroll") for (int r = 0; r < 16; ++r) o[d][r] *= al_l[crow(r, hi)]; } } while (0)
  f32x16 pA0, pA1, pB0, pB1; float mnA, mnB, alA, alB; bf16x8 pa0, pa1, pa2, pa3; constexpr int NT = NKEY / KVBLK;
  SLOAD(0); SWAIT(); SWRITE(0); __syncthreads();
  qkt(pA0, pA1, K_lds, qr, qrl, r32, hi); partialSM(pA0, pA1, m_reg, mnA, alA);
  SLOAD(KVBLK);
  SWAIT(); SWRITE(1); __syncthreads();
  for (int j = 1; j + 1 < NT; j += 2) {
    SBAR(); qkt(pB0, pB1, K_lds + SHM_K, qr, qrl, r32, hi);
    finishSM(pA0, pA1, alA, l_reg, pa0, pa1, pa2, pa3); SBAR();
    SLOAD((j + 1) * KVBLK); SBAR();
    pv_d0(o, vb0, pa0, pa1, pa2, pa3); partialSM(pB0, pB1, m_reg, mnB, alB);
    __syncthreads(); SWAIT(); SWRITE(0);
    RESC(alB); __syncthreads();
    SBAR(); qkt(pA0, pA1, K_lds, qr, qrl, r32, hi);
    finishSM(pB0, pB1, alB, l_reg, pa0, pa1, pa2, pa3); SBAR();
    SLOAD((j + 2) * KVBLK); SBAR();
    pv_d0(o, vb0 + SHM_V, pa0, pa1, pa2, pa3); partialSM(pA0, pA1, m_reg, mnA, alA);
    __syncthreads(); SWAIT(); SWRITE(1);
    RESC(alA); __syncthreads();
  }
  SBAR(); qkt(pB0, pB1, K_lds + SHM_K, qr, qrl, r32, hi);
  finishSM(pA0, pA1, alA, l_reg, pa0, pa1, pa2, pa3); SBAR();
  pv_d0(o, vb0, pa0, pa1, pa2, pa3); partialSM(pB0, pB1, m_reg, mnB, alB);
  __syncthreads(); RESC(alB);
  finishSM(pB0, pB1, alB, l_reg, pa0, pa1, pa2, pa3); SBAR();
  pv_d0(o, vb0 + SHM_V, pa0, pa1, pa2, pa3);
  if (hi == 0) li_l[r32] = l_reg; asm volatile("s_waitcnt lgkmcnt(0)" ::: "memory");
  float rli[16];
#pragma unroll
  for (int r = 0; r < 16; ++r) rli[r] = __builtin_amdgcn_rcpf(li_l[crow(r, hi)]);
  bf16_t* Ow = Qb + (size_t)(wid * QBLK) * 1536;
#pragma unroll
  for (int r = 0; r < 16; ++r) { const int orow = crow(r, hi);
#pragma unroll
    for (int d0 = 0; d0 < 4; ++d0) Ow[(size_t)orow * 1536 + d0 * 32 + r32] = f2bf(o[d0][r] * rli[r]); }
  __syncthreads();
#undef SLOAD
#undef SWRITE
#undef SWAIT
#undef RESC
}
}
DEVI void attn_mfma(const Params& p, char* smem) {
  bf16_t* Q = (bf16_t*)(p.ws + O_RQ); const bf16_t* KV = (const bf16_t*)(p.ws + O_RKV); const bf16_t* KR = (const bf16_t*)(p.ws + O_KR);
  const float* rope = (const float*)(p.ws + O_ROPE);
  for (int it = blockIdx.x; it < NB * 8 * (SEQ / 256); it += gridDim.x) {
    const int bh = (it >> 8) * 8 + (it & 7), qb = (it & 255) >> 3, b = bh >> 3, h = bh & 7;
    at::attn_item(Q + (size_t)(b * SEQ + qb * 256) * 1536 + h * 192, KV + (size_t)b * NKEY * 2048 + h * 256, KV + (size_t)b * NKEY * 2048 + h * 256 + 128,
                  KR + (size_t)b * NKEY * 64, rope, qb * 256, smem);
  }
}
#if ATTN_MFMA
DEVI void ph_attn(const Params& p, char* smem) { attn_mfma(p, smem); }
#else
DEVI void ph_attn(const Params& p, char* smem) { attn_naive(p, smem); }
#endif

DEVI void ph_rows(const Params& p, char* smem) {
  const int tid = threadIdx.x, wave = tid >> 6, lane = tid & 63;
  const float* MOD = (const float*)(p.ws + O_MOD); const bf16_t* Y = (const bf16_t*)(p.ws + O_RA); const float* rssy = (const float*)(p.ws + O_RSSY);
  bf16_t* HX2 = (bf16_t*)(p.ws + O_RB);
  for (int row = blockIdx.x * NWAVE + wave; row < NTOK; row += gridDim.x * NWAVE) {
    const int b = row >> 13; const float* md = MOD + b * 6144;
    float ty = 0.f; { const float* pr = rssy + (size_t)row * 16;
#pragma unroll
      for (int j = 0; j < 16; ++j) ty += pr[j]; }
    const float ry = rsqrtf(ty * (1.f / 1024.f) + EPS);
    float x1[16]; float ss = 0.f;
#pragma unroll
    for (int i = 0; i < 4; ++i) { const int c = i * 256 + lane * 4; const float4 xv = *(const float4*)(p.x + (size_t)row * 1024 + c); const u32x2 yv = *(const u32x2*)(Y + (size_t)row * 1024 + c);
      const float4 gp = *(const float4*)(p.g_post1 + c), gt = *(const float4*)(md + 2048 + c);
      x1[i * 4 + 0] = xv.x + gt.x * (lo2f(yv[0]) * ry * gp.x); x1[i * 4 + 1] = xv.y + gt.y * (hi2f(yv[0]) * ry * gp.y);
      x1[i * 4 + 2] = xv.z + gt.z * (lo2f(yv[1]) * ry * gp.z); x1[i * 4 + 3] = xv.w + gt.w * (hi2f(yv[1]) * ry * gp.w);
#pragma unroll
      for (int j = 0; j < 4; ++j) ss += x1[i * 4 + j] * x1[i * 4 + j];
      *(float4*)(p.out + (size_t)row * 1024 + c) = make_float4(x1[i * 4], x1[i * 4 + 1], x1[i * 4 + 2], x1[i * 4 + 3]); }
    ss = wave_sum(ss); const float r2 = rsqrtf(ss * (1.f / 1024.f) + EPS);
#pragma unroll
    for (int i = 0; i < 4; ++i) { const int c = i * 256 + lane * 4; const float4 g2 = *(const float4*)(p.g_pre2 + c), sc = *(const float4*)(md + 4096 + c), sh = *(const float4*)(md + 3072 + c);
      st4bf(HX2 + (size_t)row * 1024 + c, x1[i * 4] * r2 * g2.x * (1.f + sc.x) + sh.x, x1[i * 4 + 1] * r2 * g2.y * (1.f + sc.y) + sh.y,
            x1[i * 4 + 2] * r2 * g2.z * (1.f + sc.z) + sh.z, x1[i * 4 + 3] * r2 * g2.w * (1.f + sc.w) + sh.w); }
  }
  convert_table_fp8(p.u_exp, (unsigned char*)(p.ws + O_RC), (float*)(p.ws + O_RC + (size_t)16384 * 1024));
}

DEVI void topk_naive(const Params& p, char* smem) {
  const int tid = threadIdx.x, wave = tid >> 6, lane = tid & 63;
  float* wl = (float*)smem + wave * 512; int* wi = (int*)wl;
  const bf16_t* QP = (const bf16_t*)(p.ws + O_RKV); const bf16_t* K1 = (const bf16_t*)(p.ws + O_K1); const bf16_t* K2 = (const bf16_t*)(p.ws + O_K2);
  int* IDX = (int*)(p.ws + O_RQ); float* GW = (float*)(p.ws + O_RQ + (size_t)NTOK * 128 * 4);
  for (int base = blockIdx.x * NWAVE; base < NTOK * 8; base += gridDim.x * NWAVE) {
    const int it = base + wave, token = it >> 3, h = it & 7;
    __syncthreads();
    const bf16_t* q = QP + (size_t)token * 2048 + h * 256;
    for (int d = lane; d < 256; d += 64) wl[d] = bf2f(q[d]);
    __syncthreads();
    float s[4] = {0.f, 0.f, 0.f, 0.f};
#pragma unroll 2
    for (int d8 = 0; d8 < 16; ++d8) {
      const float4 qa0 = *(const float4*)(wl + d8 * 8), qa1 = *(const float4*)(wl + d8 * 8 + 4), qb0 = *(const float4*)(wl + 128 + d8 * 8), qb1 = *(const float4*)(wl + 128 + d8 * 8 + 4);
#pragma unroll
      for (int w = 0; w < 4; ++w) { const int key = lane + (w & 1) * 64; const bf16_t* kp = (w < 2 ? K1 : K2) + key * 128;
        float kf[8]; unpack8(*(const u32x4*)(kp + d8 * 8), kf); const float4 q0 = w < 2 ? qa0 : qb0, q1 = w < 2 ? qa1 : qb1;
        s[w] += q0.x * kf[0] + q0.y * kf[1] + q0.z * kf[2] + q0.w * kf[3] + q1.x * kf[4] + q1.y * kf[5] + q1.z * kf[6] + q1.w * kf[7]; }
    }
#pragma unroll
    for (int half = 0; half < 2; ++half) { float a0 = s[half * 2], a1 = s[half * 2 + 1];
#pragma unroll 1
      for (int r = 0; r < 16; ++r) { float v; int i; if (a0 >= a1) { v = a0; i = lane; } else { v = a1; i = lane + 64; }
        for (int o = 32; o > 0; o >>= 1) { const float ov = __shfl_xor(v, o); const int oi = __shfl_xor(i, o); if (ov > v || (ov == v && oi < i)) { v = ov; i = oi; } }
        if (i == lane) a0 = -3.0e38f; else if (i == lane + 64) a1 = -3.0e38f;
        if (lane == 0) { wl[256 + half * 32 + r] = v; wi[256 + half * 32 + 16 + r] = i; } } }
    __syncthreads();
    float cv[4]; int ci[4];
#pragma unroll
    for (int j = 0; j < 4; ++j) { const int cidx = lane * 4 + j, i = cidx >> 4, jj = cidx & 15; cv[j] = wl[256 + i] + wl[256 + 32 + jj]; ci[j] = wi[256 + 16 + i] * 128 + wi[256 + 32 + 16 + jj]; }
    float myv = 0.f, vmax = 0.f; int myi = 0;
#pragma unroll 1
    for (int r = 0; r < 16; ++r) { float v = cv[0]; int pos = lane * 4, ei = ci[0];
#pragma unroll
      for (int j = 1; j < 4; ++j) if (cv[j] > v) { v = cv[j]; pos = lane * 4 + j; ei = ci[j]; }
      for (int o = 32; o > 0; o >>= 1) { const float ov = __shfl_xor(v, o); const int op = __shfl_xor(pos, o), oe = __shfl_xor(ei, o); if (ov > v || (ov == v && op < pos)) { v = ov; pos = op; ei = oe; } }
#pragma unroll
      for (int j = 0; j < 4; ++j) if (pos == lane * 4 + j) cv[j] = -3.0e38f;
      if (r == 0) vmax = v;
      if (lane == r) { myv = v; myi = ei; } }
    const float e = lane < 16 ? __expf(myv - vmax) : 0.f; const float sum = wave_sum(e);
    if (lane < 16) { IDX[(size_t)token * 128 + h * 16 + lane] = myi; GW[(size_t)token * 128 + h * 16 + lane] = e / sum; }
  }
}

namespace tk {
DEVI int f2sort(float f) { const int i = __float_as_int(f); return i ^ ((i >> 31) & 0x7fffffff); }
DEVI float sort2f(int s) { return __int_as_float(s ^ ((s >> 31) & 0x7fffffff)); }
DEVI void ce_desc(int& a, int& b) { const int hi = max(a, b), lo = min(a, b); a = hi; b = lo; }
DEVI void sort16_desc(int* a) {
#pragma unroll
  for (int lk = 1; lk <= 4; ++lk)
#pragma unroll
    for (int lj = lk - 1; lj >= 0; --lj)
#pragma unroll
      for (int i = 0; i < 16; ++i) { const int j = 1 << lj, k = 1 << lk, l = i ^ j;
        if (l > i) { const int hi = max(a[i], a[l]), lo = min(a[i], a[l]); if ((i & k) == 0) { a[i] = hi; a[l] = lo; } else { a[i] = lo; a[l] = hi; } } }
}
DEVI void bitonic_merge16_desc(int* a) {
#pragma unroll
  for (int lj = 3; lj >= 0; --lj)
#pragma unroll
    for (int i = 0; i < 16; ++i) { const int l = i ^ (1 << lj); if (l > i) ce_desc(a[i], a[l]); }
}
DEVI void merge_top16(int* a, const int* b) {
#pragma unroll
  for (int i = 0; i < 16; ++i) a[i] = max(a[i], b[15 - i]);
  bitonic_merge16_desc(a);
}
DEVI void half_top16(const bf16_t* __restrict__ qrow, const char* Kl, int r32, int hi, int* out) {
  bf16x8 qf[8];
#pragma unroll
  for (int d0 = 0; d0 < 8; ++d0) qf[d0] = *reinterpret_cast<const bf16x8*>(qrow + d0 * 16 + hi * 8);
  int a[64];
#pragma unroll
  for (int kt = 0; kt < 4; ++kt) { f32x16 acc = {};
    const int key = kt * 32 + r32;
#pragma unroll
    for (int d0 = 0; d0 < 8; ++d0) { const bf16x8 kf = *reinterpret_cast<const bf16x8*>(Kl + key * 256 + (((d0 * 2 + hi) ^ (key & 15)) << 4));
      acc = __builtin_amdgcn_mfma_f32_32x32x16_bf16(kf, qf[d0], acc, 0, 0, 0); }
#pragma unroll
    for (int r = 0; r < 16; ++r) { const int kidx = kt * 32 + (r & 3) + 8 * (r >> 2) + 4 * hi; a[kt * 16 + r] = (f2sort(acc[r]) & ~127) | (127 - kidx); } }
  sort16_desc(a); sort16_desc(a + 16); sort16_desc(a + 32); sort16_desc(a + 48);
  merge_top16(a, a + 16); merge_top16(a + 32, a + 48); merge_top16(a, a + 32);
  int L[16], H[16];
#pragma unroll
  for (int i = 0; i < 16; ++i) { auto rr = __builtin_amdgcn_permlane32_swap((unsigned)a[i], (unsigned)a[i], false, false); L[i] = (int)rr[0]; H[i] = (int)rr[1]; }
  merge_top16(L, H);
#pragma unroll
  for (int i = 0; i < 16; ++i) out[i] = L[i];
}
}
DEVI void topk_fast(const Params& p, char* smem) {
  const int tid = threadIdx.x, wave = tid >> 6, lane = tid & 63, r32 = lane & 31, hi = lane >> 5;
  const bf16_t* QP = (const bf16_t*)(p.ws + O_RKV);
  int* IDX = (int*)(p.ws + O_RQ); float* GW = (float*)(p.ws + O_RQ + (size_t)NTOK * 128 * 4);
  char* K1l = smem; char* K2l = smem + 32768; int* tab = (int*)(smem + 65536) + wave * (32 * 33);
  __syncthreads();
  { const bf16_t* K1 = (const bf16_t*)(p.ws + O_K1);
    for (int id = tid; id < 4096; id += NTHR) { const int key = id >> 4, c = id & 15; const u32x4 v = *(const u32x4*)(K1 + (size_t)key * 128 + c * 8);
      *(u32x4*)(smem + key * 256 + ((c ^ (key & 15)) << 4)) = v; } }
  __syncthreads();
  for (int item = blockIdx.x; item < NTOK * 8 / 256; item += gridDim.x) {
    const int row = item * 256 + wave * 32 + r32;
    const bf16_t* qrow = QP + (size_t)row * 256;
    int t1[16], t2[16];
    tk::half_top16(qrow, K1l, r32, hi, t1);
    tk::half_top16(qrow + 128, K2l, r32, hi, t2);
    float v1[16], v2[16];
#pragma unroll
    for (int i = 0; i < 16; ++i) { v1[i] = tk::sort2f(t1[i] & ~127); v2[i] = tk::sort2f(t2[i] & ~127); }
    if (hi == 0) {
#pragma unroll
      for (int i = 0; i < 16; ++i) { tab[r32 * 33 + i] = 127 - (t1[i] & 127); tab[r32 * 33 + 16 + i] = 127 - (t2[i] & 127); } }
#define CAND(i, j) ((tk::f2sort(v1[i] + v2[j]) & ~255) | (255 - ((i) * 16 + (j))))
    int g0[16], g1[16], g2[16];
#pragma unroll
    for (int j = 0; j < 16; ++j) g0[j] = CAND(0, j);
#pragma unroll
    for (int j = 0; j < 8; ++j) g1[j] = CAND(1, j);
#pragma unroll
    for (int j = 0; j < 5; ++j) g1[8 + j] = CAND(2, j);
#pragma unroll
    for (int j = 0; j < 3; ++j) g1[13 + j] = CAND(4, j);
#pragma unroll
    for (int j = 0; j < 4; ++j) g2[j] = CAND(3, j);
    g2[4] = CAND(5, 0); g2[5] = CAND(5, 1); g2[6] = CAND(6, 0); g2[7] = CAND(6, 1); g2[8] = CAND(7, 0); g2[9] = CAND(7, 1);
    g2[10] = CAND(8, 0); g2[11] = CAND(9, 0); g2[12] = CAND(10, 0); g2[13] = CAND(11, 0); g2[14] = CAND(12, 0); g2[15] = CAND(13, 0);
    tk::sort16_desc(g1); tk::sort16_desc(g2);
    tk::merge_top16(g0, g1); tk::merge_top16(g0, g2);
    { int x = CAND(14, 0);
#pragma unroll
      for (int i = 0; i < 16; ++i) { const int h = max(g0[i], x); x = min(g0[i], x); g0[i] = h; }
      x = CAND(15, 0);
#pragma unroll
      for (int i = 0; i < 16; ++i) { const int h = max(g0[i], x); x = min(g0[i], x); g0[i] = h; } }
#undef CAND
    asm volatile("s_waitcnt lgkmcnt(0)" ::: "memory");
    if (hi == 0) {
      int ex[16];
#pragma unroll
      for (int k = 0; k < 16; ++k) { const int pos = 255 - (g0[k] & 255); ex[k] = tab[r32 * 33 + (pos >> 4)] * 128 + tab[r32 * 33 + 16 + (pos & 15)]; }
      int* dst = IDX + (size_t)row * 16;
#pragma unroll
      for (int q = 0; q < 4; ++q) *(int4*)(dst + q * 4) = make_int4(ex[q * 4], ex[q * 4 + 1], ex[q * 4 + 2], ex[q * 4 + 3]);
    } else {
      float e[16]; const float vmax = tk::sort2f(g0[0] & ~255); float sum = 0.f;
#pragma unroll
      for (int k = 0; k < 16; ++k) { e[k] = __expf(tk::sort2f(g0[k] & ~255) - vmax); sum += e[k]; }
      const float inv = 1.f / sum; float* dst = GW + (size_t)row * 16;
#pragma unroll
      for (int q = 0; q < 4; ++q) *(float4*)(dst + q * 4) = make_float4(e[q * 4] * inv, e[q * 4 + 1] * inv, e[q * 4 + 2] * inv, e[q * 4 + 3] * inv);
    }
  }
}
#if TOPK_FAST
DEVI void ph_topk(const Params& p, char* smem) { topk_fast(p, smem); }
#else
DEVI void ph_topk(const Params& p, char* smem) { topk_naive(p, smem); }
#endif

DEVI float wave_sum_dpp(float v) {
  v += __builtin_bit_cast(float, __builtin_amdgcn_update_dpp(0, __builtin_bit_cast(int, v), 0xB1, 0xf, 0xf, true));
  v += __builtin_bit_cast(float, __builtin_amdgcn_update_dpp(0, __builtin_bit_cast(int, v), 0x4E, 0xf, 0xf, true));
  v += __builtin_bit_cast(float, __builtin_amdgcn_update_dpp(0, __builtin_bit_cast(int, v), 0x141, 0xf, 0xf, true));
  v += __builtin_bit_cast(float, __builtin_amdgcn_update_dpp(0, __builtin_bit_cast(int, v), 0x140, 0xf, 0xf, true));
  const int iv = __builtin_bit_cast(int, v);
  return (__builtin_bit_cast(float, __builtin_amdgcn_readlane(iv, 0)) + __builtin_bit_cast(float, __builtin_amdgcn_readlane(iv, 16))) +
         (__builtin_bit_cast(float, __builtin_amdgcn_readlane(iv, 32)) + __builtin_bit_cast(float, __builtin_amdgcn_readlane(iv, 48)));
}
DEVI void fp8x16_to_f32(const u32x4& w, float* f) {
#pragma unroll
  for (int j = 0; j < 4; ++j) { const f32x2_t a = __builtin_amdgcn_cvt_pk_f32_fp8((int)w[j], false), b = __builtin_amdgcn_cvt_pk_f32_fp8((int)w[j], true);
    f[j * 4] = a[0]; f[j * 4 + 1] = a[1]; f[j * 4 + 2] = b[0]; f[j * 4 + 3] = b[1]; }
}
DEVI void ph_gather(const Params& p, char* smem) {
  const int tid = threadIdx.x, wave = tid >> 6, lane = tid & 63;
  const bf16_t* HX2 = (const bf16_t*)(p.ws + O_RB);
  const unsigned char* UT = (const unsigned char*)(p.ws + O_RC); const float* SU = (const float*)(p.ws + O_RC + (size_t)16384 * 1024);
  const unsigned char* VT = (const unsigned char*)(p.ws + O_RA); const float* SV = (const float*)(p.ws + O_RA + (size_t)16384 * 1024);
  const int* IDX = (const int*)(p.ws + O_RQ); const float* GW = (const float*)(p.ws + O_RQ + (size_t)NTOK * 128 * 4);
  const float* MOD = (const float*)(p.ws + O_MOD);
  for (int t = blockIdx.x * NWAVE + wave; t < NTOK; t += gridDim.x * NWAVE) {
    float xf[16];
    unpack8(*(const u32x4*)(HX2 + (size_t)t * 1024 + lane * 16), xf); unpack8(*(const u32x4*)(HX2 + (size_t)t * 1024 + lane * 16 + 8), xf + 8);
    float acc[16];
#pragma unroll
    for (int j = 0; j < 16; ++j) acc[j] = 0.f;
#pragma unroll 1
    for (int half = 0; half < 2; ++half) {
      const int my_i = IDX[(size_t)t * 128 + half * 64 + lane]; const float my_g = GW[(size_t)t * 128 + half * 64 + lane];
      const float my_su = SU[my_i], my_sv = SV[my_i];
#pragma unroll 1
      for (int e0 = 0; e0 < 64; e0 += 8) {
        u32x4 uq[8], vq[8]; float cs[8];
#pragma unroll
        for (int j = 0; j < 8; ++j) { const int id = __builtin_amdgcn_readlane(my_i, e0 + j);
          uq[j] = *(const u32x4*)(UT + (size_t)id * 1024 + lane * 16); vq[j] = *(const u32x4*)(VT + (size_t)id * 1024 + lane * 16); }
#pragma unroll
        for (int j = 0; j < 8; ++j) { float uf[16]; fp8x16_to_f32(uq[j], uf); float d = 0.f;
#pragma unroll
          for (int k = 0; k < 16; ++k) d += xf[k] * uf[k];
          cs[j] = d; }
#pragma unroll
        for (int j = 0; j < 8; ++j) { const float d = wave_sum_dpp(cs[j]);
          const float g = __builtin_bit_cast(float, __builtin_amdgcn_readlane(__builtin_bit_cast(int, my_g), e0 + j));
          const float su = __builtin_bit_cast(float, __builtin_amdgcn_readlane(__builtin_bit_cast(int, my_su), e0 + j));
          const float sv = __builtin_bit_cast(float, __builtin_amdgcn_readlane(__builtin_bit_cast(int, my_sv), e0 + j));
          cs[j] = g * gelu_t(d * su) * sv; }
#pragma unroll
        for (int j = 0; j < 8; ++j) { float vf[16]; fp8x16_to_f32(vq[j], vf);
#pragma unroll
          for (int k = 0; k < 16; ++k) acc[k] += cs[j] * vf[k]; }
      }
    }
    float ss = 0.f;
#pragma unroll
    for (int k = 0; k < 16; ++k) ss += acc[k] * acc[k];
    ss = wave_sum(ss); const float rstd = rsqrtf(ss * (1.f / 1024.f) + EPS);
    const int b = t >> 13; const float* gt2 = MOD + b * 6144 + 5120;
    float* op = p.out + (size_t)t * 1024 + lane * 16;
#pragma unroll
    for (int q4 = 0; q4 < 4; ++q4) { float4 xv = *(const float4*)(op + q4 * 4); const float4 gt = *(const float4*)(gt2 + lane * 16 + q4 * 4), gp = *(const float4*)(p.g_post2 + lane * 16 + q4 * 4);
      xv.x += gt.x * (acc[q4 * 4 + 0] * rstd * gp.x); xv.y += gt.y * (acc[q4 * 4 + 1] * rstd * gp.y);
      xv.z += gt.z * (acc[q4 * 4 + 2] * rstd * gp.z); xv.w += gt.w * (acc[q4 * 4 + 3] * rstd * gp.w);
      *(float4*)(op + q4 * 4) = xv; }
  }
}

#define XB_TMO      128
#define XB_XCNT(j)  (256  + 64 * (j))
#define XB_XSUB(j)  (1280 + 64 * (j))
#define XB_XGEN(j)  (2304 + 64 * (j))
#define XB_TOP      3328
#define XB_TOPGEN   3392
#define XCD_BAR_WORDS 3456
#define XB_SPIN_CAP (1u << 18)
#define LAS __attribute__((address_space(3)))
DEVI unsigned xb_ld(unsigned* p)              { return __hip_atomic_load(p, __ATOMIC_RELAXED, __HIP_MEMORY_SCOPE_AGENT); }
DEVI unsigned xb_add(unsigned* p, unsigned v) { return __hip_atomic_fetch_add(p, v, __ATOMIC_RELAXED, __HIP_MEMORY_SCOPE_AGENT); }
DEVI unsigned xb_xcc_id() { return (unsigned)__builtin_amdgcn_s_getreg((3 << 11) | 20) & 0xFu; }
#define XB_SPIN(cond, bar) do { unsigned _sp = 0; while (cond) { __builtin_amdgcn_s_sleep(1); \
    if ((++_sp & 255u) == 0u) { if (xb_ld(&(bar)[XB_TMO])) break; if (_sp > XB_SPIN_CAP) { atomicAdd(&(bar)[XB_TMO], 1u); break; } } } } while (0)
struct XcdBarrier { unsigned* bar; unsigned x; volatile LAS unsigned* st; };
DEVI XcdBarrier xcd_barrier_post(unsigned* bar, volatile LAS unsigned* st) {
  XcdBarrier b; b.bar = bar; b.x = xb_xcc_id(); b.st = st;
  if (threadIdx.x == 0) (void)xb_add(&bar[XB_XCNT(b.x)], 1u);
  return b;
}
DEVI void xcd_barrier_complete(unsigned* bar, unsigned x, unsigned& nloc, unsigned& nx) {
  const unsigned G = gridDim.x * gridDim.y * gridDim.z;
  unsigned sum, cnt, mine, sp = 0u;
  for (;;) {
    sum = 0u; cnt = 0u; mine = 0u;
#pragma unroll
    for (unsigned j = 0; j < 16; ++j) { const unsigned c = xb_ld(&bar[XB_XCNT(j)]); sum += c; cnt += (c > 0u) ? 1u : 0u; mine = (j == x) ? c : mine; }
    if (sum == G) break;
    __builtin_amdgcn_s_sleep(1);
    if ((++sp & 255u) == 0u) { if (xb_ld(&bar[XB_TMO])) break; if (sp > XB_SPIN_CAP) { atomicAdd(&bar[XB_TMO], 1u); break; } }
  }
  nloc = mine > 0u ? mine : 1u; nx = cnt > 0u ? cnt : 1u;
}
DEVI void xcd_barrier(const XcdBarrier& b) {
  asm volatile("s_waitcnt vmcnt(0)" ::: "memory");
  __syncthreads();
  if (threadIdx.x == 0) {
    unsigned* bar = b.bar;
    __builtin_amdgcn_s_waitcnt(0);
    unsigned nloc = b.st[0], nx = b.st[1];
    if (nloc == 0u) { xcd_barrier_complete(bar, b.x, nloc, nx); b.st[0] = nloc; b.st[1] = nx; }
    const unsigned old = xb_add(&bar[XB_XSUB(b.x)], 1u);
    const unsigned gen = old / nloc;
    if (old + 1u == (gen + 1u) * nloc) {
      __builtin_amdgcn_fence(__ATOMIC_RELEASE, "agent");
      asm volatile("s_waitcnt vmcnt(0)" ::: "memory");
      const unsigned og = xb_add(&bar[XB_TOP], 1u);
      const unsigned tg = og / nx;
      if (og + 1u == (tg + 1u) * nx) xb_add(&bar[XB_TOPGEN], 1u);
      else XB_SPIN(xb_ld(&bar[XB_TOPGEN]) == tg, bar);
      __builtin_amdgcn_fence(__ATOMIC_ACQUIRE, "agent");
      xb_add(&bar[XB_XGEN(b.x)], 1u);
      asm volatile("s_waitcnt vmcnt(0)" ::: "memory");
    } else {
      XB_SPIN(xb_ld(&bar[XB_XGEN(b.x)]) == gen, bar);
      __builtin_amdgcn_fence(__ATOMIC_ACQUIRE, "agent");
      asm volatile("s_waitcnt vmcnt(0)" ::: "memory");
    }
  }
  __syncthreads();
}

constexpr int NPHASE = 12;
template <int PH> DEVI void run_phase(const Params& p, char* smem) {
  if constexpr (PH == 0) ph_prep(p, smem);
  else if constexpr (PH == 1) ph_hx(p, smem);
  else if constexpr (PH == 2) ph_inproj(p, smem);
  else if constexpr (PH == 3) ph_mid(p, smem);
  else if constexpr (PH == 4) ph_attn(p, smem);
  else if constexpr (PH == 5) ph_gates(p, smem);
  else if constexpr (PH == 6) ph_merge(p, smem);
  else if constexpr (PH == 7) ph_wo(p, smem);
  else if constexpr (PH == 8) ph_rows(p, smem);
  else if constexpr (PH == 9) ph_wpq(p, smem);
  else if constexpr (PH == 10) ph_topk(p, smem);
  else if constexpr (PH == 11) ph_gather(p, smem);
}

template <int PH> __global__ __launch_bounds__(NTHR) void k_phase(Params p) {
  extern __shared__ __attribute__((aligned(16))) char smem[];
  run_phase<PH>(p, smem);
}

#ifndef PROBE_PH
#define PROBE_PH -1
#endif
#if MEGA
#define RUNPH(N) do { if (PROBE_PH == N) t0 = __builtin_amdgcn_s_memrealtime(); run_phase<N>(p, smem); if (N < NPHASE - 1) xcd_barrier(xb); \
    if (PROBE_PH == N) t1 = __builtin_amdgcn_s_memrealtime(); } while (0)
__global__ __launch_bounds__(NTHR) void k_mega(Params p) {
  extern __shared__ __attribute__((aligned(16))) char smem[];
  cg::grid_group grid = cg::this_grid();
  unsigned long long t0 = 0, t1 = 0;
  unsigned* bar = (unsigned*)(p.ws + O_BAR);
  volatile LAS unsigned* xst = (volatile LAS unsigned*)(smem + LDS_BYTES - 16);
  if (threadIdx.x == 0) { xst[0] = 0u; xst[1] = 0u; }
  if (blockIdx.x == 0) for (int i = threadIdx.x; i < XCD_BAR_WORDS; i += NTHR) bar[i] = 0u;
  if (PROBE_PH == 0) t0 = __builtin_amdgcn_s_memrealtime();
  run_phase<0>(p, smem);
  grid.sync();
  if (PROBE_PH == 0) t1 = __builtin_amdgcn_s_memrealtime();
  const XcdBarrier xb = xcd_barrier_post(bar, xst);
  RUNPH(1); RUNPH(2); RUNPH(3); RUNPH(4); RUNPH(5); RUNPH(6); RUNPH(7); RUNPH(8); RUNPH(9); RUNPH(10); RUNPH(11);
  if (PROBE_PH >= 0) { __syncthreads(); if (blockIdx.x == 0 && threadIdx.x == 0) p.out[0] += exp2f(rintf(log2f((float)(t1 - t0) * 1e-3f) * 5.f) * 0.2f); }
}
#endif

template <int PH> static void launch_phase(const Params& p, int grid, hipStream_t stream) {
  hipLaunchKernelGGL(k_phase<PH>, dim3(grid), dim3(NTHR), LDS_BYTES, stream, p);
}
template <int PH> static void set_attr() { (void)hipFuncSetAttribute((const void*)k_phase<PH>, hipFuncAttributeMaxDynamicSharedMemorySize, LDS_BYTES); }

extern "C" void kernel_launch(void* const* d_in, const int* in_sizes, int n_in, void* d_out, int out_size, void* d_ws, size_t ws_size, hipStream_t stream) {
  static int grid = 0;
  if (grid == 0) {
    if (n_in != 26 || out_size != NTOK * DM || ws_size < O_END) { fprintf(stderr, "kernel_launch: unexpected shapes n_in %d out %d ws %zu (need %zu)\n", n_in, out_size, ws_size, (size_t)O_END); grid = -1; return; }
#if MEGA
    (void)hipFuncSetAttribute((const void*)k_mega, hipFuncAttributeMaxDynamicSharedMemorySize, LDS_BYTES);
    int dev = 0, cus = 0, per_cu = 0; (void)hipGetDevice(&dev); (void)hipDeviceGetAttribute(&cus, hipDeviceAttributeMultiprocessorCount, dev);
    (void)hipOccupancyMaxActiveBlocksPerMultiprocessor(&per_cu, (const void*)k_mega, NTHR, LDS_BYTES);
    if (per_cu < 1) { fprintf(stderr, "kernel_launch: occupancy query says %d blocks per CU\n", per_cu); grid = -1; return; }
    grid = cus;
#else
    set_attr<0>(); set_attr<1>(); set_attr<2>(); set_attr<3>(); set_attr<4>(); set_attr<5>(); set_attr<6>(); set_attr<7>(); set_attr<8>(); set_attr<9>(); set_attr<10>(); set_attr<11>();
    grid = 256;
#endif
  }
  if (grid < 0) return;
  Params p{};
  const float** pp = (const float**)&p;
  for (int i = 0; i < 26; ++i) pp[i] = (const float*)d_in[i];
  p.out = (float*)d_out; p.ws = (char*)d_ws;
#if MEGA
  void* args[] = {&p};
  hipError_t e = hipLaunchCooperativeKernel((const void*)k_mega, dim3(grid), dim3(NTHR), args, LDS_BYTES, stream);
  if (e != hipSuccess) fprintf(stderr, "cooperative launch failed: %s (grid %d)\n", hipGetErrorString(e), grid);
#else
  launch_phase<0>(p, grid, stream); launch_phase<1>(p, grid, stream); launch_phase<2>(p, grid, stream); launch_phase<3>(p, grid, stream);
  launch_phase<4>(p, grid, stream); launch_phase<5>(p, grid, stream); launch_phase<6>(p, grid, stream); launch_phase<7>(p, grid, stream);
  launch_phase<8>(p, grid, stream); launch_phase<9>(p, grid, stream); launch_phase<10>(p, grid, stream); launch_phase<11>(p, grid, stream);
#endif
}
```

```cpp
#include <hip/hip_runtime.h>
#include <hip/hip_cooperative_groups.h>
#include <cstdint>
#include <cstdio>
namespace cg = cooperative_groups;

#ifndef MEGA
#define MEGA 1
#endif
#ifndef GEMM_MFMA
#define GEMM_MFMA 1
#endif
#ifndef ATTN_MFMA
#define ATTN_MFMA 1
#endif
#ifndef ATTN_FP8
#define ATTN_FP8 1
#endif
#ifndef TOPK_FAST
#define TOPK_FAST 1
#endif

#define DEVI __device__ __forceinline__
typedef unsigned short bf16_t;
using bf16x8 = __attribute__((ext_vector_type(8))) short;
using bf16x4 = __attribute__((ext_vector_type(4))) short;
using f32x4  = __attribute__((ext_vector_type(4))) float;
using f32x16 = __attribute__((ext_vector_type(16))) float;
using u32x4  = __attribute__((ext_vector_type(4))) unsigned;
using u32x2  = __attribute__((ext_vector_type(2))) unsigned;

constexpr int DM = 1024, NB = 2, SEQ = 8192, NTOK = NB * SEQ, CTXL = 256, NCTX = NB * CTXL, NROW = NTOK + NCTX, NKEY = SEQ + CTXL;
constexpr int INW = 4544, INWP = 4608;
constexpr int NPRE = 2560;
constexpr float EPS = 1e-6f;
constexpr int NTHR = 512, NWAVE = 8;
constexpr int LDS_BYTES = 147456;

constexpr size_t al256(size_t x) { return (x + 255) / 256 * 256; }
constexpr size_t O_WIN   = 0;
constexpr size_t O_WUQ   = O_WIN  + al256((size_t)INWP * 1024 * 2);
constexpr size_t O_WUKV  = O_WUQ  + al256((size_t)1536 * 256 * 2);
constexpr size_t O_WPA   = O_WUKV + al256((size_t)2048 * 128 * 2);
constexpr size_t O_WPB   = O_WPA  + al256((size_t)1024 * 1024 * 2);
constexpr size_t O_WO    = O_WPB  + al256((size_t)1024 * 1024 * 2);
constexpr size_t O_WPQ   = O_WO   + al256((size_t)1024 * 1024 * 2);
constexpr size_t O_WS    = O_WPQ  + al256((size_t)2048 * 1024 * 2);
constexpr size_t O_K1    = O_WS   + al256((size_t)8 * 128 * 128 * 2);
constexpr size_t O_K2    = O_K1   + al256((size_t)128 * 128 * 2);
constexpr size_t O_MOD   = O_K2   + al256((size_t)128 * 128 * 2);
constexpr size_t O_ROPE  = O_MOD  + al256((size_t)3 * 6144 * 4);
constexpr size_t O_BAR   = O_ROPE + al256((size_t)128 * 16 * 2 * 4);
constexpr size_t O_RSSV  = O_BAR + al256((size_t)3456 * 4);
constexpr size_t O_RSSQ  = O_RSSV + (size_t)NTOK * 16 * 4;
constexpr size_t O_RSSKV = O_RSSQ + (size_t)NTOK * 4 * 4;
constexpr size_t O_RSSY  = O_RSSKV + (size_t)NROW * 2 * 4;
constexpr size_t O_RSSEND = O_RSSY + (size_t)NTOK * 16 * 4;
constexpr size_t O_RA    = al256(O_RSSEND);
constexpr size_t O_RB    = O_RA  + al256((size_t)NROW * 1024 * 2);
constexpr size_t O_RC    = O_RB  + al256((size_t)NTOK * 1024 * 2);
constexpr size_t O_CQ    = O_RC  + al256((size_t)NTOK * 1024 * 2);
constexpr size_t O_CKV   = O_CQ  + al256((size_t)NTOK * 256 * 2);
constexpr size_t O_KR    = O_CKV + al256((size_t)NROW * 128 * 2);
constexpr size_t O_RQ    = O_KR  + al256((size_t)NROW * 64 * 2);
constexpr size_t O_RKV   = O_RQ  + al256((size_t)NTOK * 1536 * 2);
constexpr size_t O_END   = O_RKV + al256((size_t)NROW * 2048 * 2);
static_assert(O_END <= (size_t)258 * 1024 * 1024, "workspace too large");

struct Params {
  const float *x, *c, *ctx, *c_ctx, *w_mod, *b_mod, *g_pre1, *g_post1, *g_pre2, *g_post2, *w_in, *g_q, *g_kv, *w_uq, *w_ukv, *g_sgu, *w_s, *b_s,
      *w_pa, *w_pb, *w_o, *w_pq, *k1, *k2, *u_exp, *v_exp;
  float* out; char* ws;
};

DEVI float bf2f(unsigned short h) { return __uint_as_float(((unsigned)h) << 16); }
DEVI unsigned short f2bf(float f) { unsigned u = __float_as_uint(f); u += 0x7fffu + ((u >> 16) & 1u); return (unsigned short)(u >> 16); }
DEVI unsigned pack2(float a, float b) { return (unsigned)f2bf(a) | ((unsigned)f2bf(b) << 16); }
DEVI float lo2f(unsigned w) { return __uint_as_float(w << 16); }
DEVI float hi2f(unsigned w) { return __uint_as_float(w & 0xffff0000u); }
DEVI void unpack8(const u32x4& w, float* f) {
  f[0] = lo2f(w[0]); f[1] = hi2f(w[0]); f[2] = lo2f(w[1]); f[3] = hi2f(w[1]); f[4] = lo2f(w[2]); f[5] = hi2f(w[2]); f[6] = lo2f(w[3]); f[7] = hi2f(w[3]);
}
DEVI float gelu_t(float x) { float z = 0.7978845608028654f * (x + 0.044715f * x * x * x); return x / (1.f + __expf(-2.f * z)); }
DEVI float sigmoidf_(float x) { return 1.f / (1.f + __expf(-x)); }
DEVI float wave_sum(float v) { for (int o = 32; o > 0; o >>= 1) v += __shfl_xor(v, o); return v; }
DEVI float wave_max(float v) { for (int o = 32; o > 0; o >>= 1) v = fmaxf(v, __shfl_xor(v, o)); return v; }
DEVI int keyrow(int row) { if (row < NTOK) return (row >> 13) * NKEY + (row & 8191); int c = row - NTOK; return (c >> 8) * NKEY + SEQ + (c & 255); }

__device__ const float ROPE_FREQ[16] = {1.0f, 0.5623413324356079f, 0.3162277638912201f, 0.17782793939113617f, 0.10000000149011612f, 0.05623413249850273f, 0.03162277489900589f, 0.017782794311642647f, 0.009999999776482582f, 0.005623413249850273f, 0.003162277629598975f, 0.0017782794311642647f, 0.0010000000474974513f, 0.000562341301701963f, 0.0003162277571391314f, 0.00017782794020604342f};
DEVI void sincos_small(double a, double& cs, double& sn) {
  const double k = rint(a * 0.15915494309189535); const double r = fma(-k, 6.283185307179586, a) - k * 2.4492935982947064e-16;
  const double r2 = r * r; double s = 0.0, c = 0.0;
#pragma unroll
  for (int n = 12; n >= 1; --n) { s = (1.0 - s * r2 / (double)((2 * n) * (2 * n + 1))); c = (1.0 - c * r2 / (double)((2 * n - 1) * (2 * n))); }
  sn = r * s; cs = c;
}

DEVI void transpose_job(const float* __restrict__ src, int K, int N, bf16_t* __restrict__ dst, const float* __restrict__ gk, bool isWin, int ntiles, char* smem) {
  const int tid = threadIdx.x; bf16_t* tl = (bf16_t*)smem; const int kt = K / 64;
  for (int idx = blockIdx.x; idx < ntiles; idx += gridDim.x) {
    const int ktile = idx % kt, ntile = idx / kt, k0 = ktile * 64, n0d = ntile * 64;
    int n0s = n0d; bool zero = false;
    if (isWin) { if (n0d == 2496) zero = true; else if (n0d >= 2560) n0s = n0d - 64; }
    { const int kk = tid >> 3, nn8 = (tid & 7) * 8; f32x4 va = {0.f, 0.f, 0.f, 0.f}, vb = va;
      if (!zero) { const float* s = src + (size_t)(k0 + kk) * N + n0s + nn8; const float4 a = *(const float4*)s, b = *(const float4*)(s + 4);
        const float sc = gk ? gk[k0 + kk] : 1.f; va = (f32x4){a.x, a.y, a.z, a.w} * sc; vb = (f32x4){b.x, b.y, b.z, b.w} * sc; }
      bf16_t* tp = tl + nn8 * 72 + kk;
      tp[0] = f2bf(va[0]); tp[72] = f2bf(va[1]); tp[144] = f2bf(va[2]); tp[216] = f2bf(va[3]); tp[288] = f2bf(vb[0]); tp[360] = f2bf(vb[1]); tp[432] = f2bf(vb[2]); tp[504] = f2bf(vb[3]); }
    __syncthreads();
    { const int nn = tid >> 3, kk8 = (tid & 7) * 8;
      const u32x4 o = *(const u32x4*)(tl + nn * 72 + kk8);
      *(u32x4*)(dst + (size_t)(n0d + nn) * K + k0 + kk8) = o; }
    __syncthreads();
  }
}

DEVI void ph_prep(const Params& p, char* smem) {
  const int tid = threadIdx.x, bid = blockIdx.x, nb = gridDim.x;
  char* ws = p.ws;
  if (bid == 0) { float* rope = (float*)(ws + O_ROPE);
    for (int i = tid; i < 128 * 16; i += NTHR) { const int pos = i >> 4, f = i & 15; const float ang = (float)pos * ROPE_FREQ[f];
      double cs, sn; sincos_small((double)ang, cs, sn); rope[i * 2] = (float)cs; rope[i * 2 + 1] = (float)sn; } }
  { float* red = (float*)smem; float* MOD = (float*)(ws + O_MOD);
    for (int it = bid; it < 256; it += nb) {
      const int cgp = tid % 6, kg = tid / 6;
      f32x4 a0 = {0.f, 0.f, 0.f, 0.f}, a1 = a0, a2 = a0;
      if (tid < 510) {
        for (int k = kg; k < 1024; k += 85) {
          const float4 w4 = *(const float4*)(p.w_mod + (size_t)k * 6144 + it * 24 + cgp * 4);
          const f32x4 w = {w4.x, w4.y, w4.z, w4.w};
          const float c0 = p.c[k], c1 = p.c[1024 + k], c2 = p.c_ctx[k];
          a0 += w * (c0 / (1.f + __expf(-c0))); a1 += w * (c1 / (1.f + __expf(-c1))); a2 += w * (c2 / (1.f + __expf(-c2)));
        }
        float* rp = red + kg * 72 + cgp * 4;
        rp[0] = a0[0]; rp[1] = a0[1]; rp[2] = a0[2]; rp[3] = a0[3];
        rp[24] = a1[0]; rp[25] = a1[1]; rp[26] = a1[2]; rp[27] = a1[3];
        rp[48] = a2[0]; rp[49] = a2[1]; rp[50] = a2[2]; rp[51] = a2[3];
      }
      __syncthreads();
      if (tid < 72) { float s = 0.f; for (int g = 0; g < 85; ++g) s += red[g * 72 + tid]; int r = tid / 24, n = it * 24 + tid % 24; MOD[r * 6144 + n] = s + p.b_mod[n]; }
      __syncthreads();
    } }
  transpose_job(p.w_in,  1024, INW,  (bf16_t*)(ws + O_WIN),  nullptr, true,  1152, smem);
  transpose_job(p.w_uq,  256,  1536, (bf16_t*)(ws + O_WUQ),  p.g_q,   false, 96,   smem);
  transpose_job(p.w_ukv, 128,  2048, (bf16_t*)(ws + O_WUKV), p.g_kv,  false, 64,   smem);
  transpose_job(p.w_pa,  1024, 1024, (bf16_t*)(ws + O_WPA),  nullptr, false, 256,  smem);
  transpose_job(p.w_pb,  1024, 1024, (bf16_t*)(ws + O_WPB),  nullptr, false, 256,  smem);
  transpose_job(p.w_o,   1024, 1024, (bf16_t*)(ws + O_WO),   nullptr, false, 256,  smem);
  transpose_job(p.w_pq,  1024, 2048, (bf16_t*)(ws + O_WPQ),  nullptr, false, 512,  smem);
  { const int n8 = (131072 + 16384 + 16384) / 8;
    for (int i = bid * NTHR + tid; i < n8; i += nb * NTHR) {
      int e = i * 8; const float* s; bf16_t* d;
      if (e < 131072) { s = p.w_s + e; d = (bf16_t*)(ws + O_WS) + e; }
      else if (e < 131072 + 16384) { s = p.k1 + (e - 131072); d = (bf16_t*)(ws + O_K1) + (e - 131072); }
      else { s = p.k2 + (e - 131072 - 16384); d = (bf16_t*)(ws + O_K2) + (e - 131072 - 16384); }
      const float4 a = *(const float4*)s, b = *(const float4*)(s + 4);
      u32x4 o = {pack2(a.x, a.y), pack2(a.z, a.w), pack2(b.x, b.y), pack2(b.z, b.w)};
      *(u32x4*)d = o;
    } }
}

typedef float f32x2_t __attribute__((ext_vector_type(2)));
DEVI void convert_table_fp8(const float* __restrict__ src, unsigned char* __restrict__ dst, float* __restrict__ scale) {
  const int wave = threadIdx.x >> 6, lane = threadIdx.x & 63;
  for (int row = blockIdx.x * NWAVE + wave; row < 16384; row += gridDim.x * NWAVE) {
    const float* sp = src + (size_t)row * 1024 + lane * 16;
    float4 v[4]; float am = 0.f;
#pragma unroll
    for (int j = 0; j < 4; ++j) { v[j] = *(const float4*)(sp + j * 4); am = fmaxf(am, fmaxf(fmaxf(fabsf(v[j].x), fabsf(v[j].y)), fmaxf(fabsf(v[j].z), fabsf(v[j].w)))); }
    am = wave_max(am);
    const float inv = am > 0.f ? 240.f / am : 0.f;
    u32x4 o;
#pragma unroll
    for (int j = 0; j < 4; ++j) { int w = __builtin_amdgcn_cvt_pk_fp8_f32(v[j].x * inv, v[j].y * inv, 0, false); w = __builtin_amdgcn_cvt_pk_fp8_f32(v[j].z * inv, v[j].w * inv, w, true); o[j] = (unsigned)w; }
    *(u32x4*)(dst + (size_t)row * 1024 + lane * 16) = o;
    if (lane == 0) scale[row] = am * (1.f / 240.f);
  }
}

DEVI void ph_hx(const Params& p, char* smem) {
  const int tid = threadIdx.x, wave = tid >> 6, lane = tid & 63;
  float* mA = (float*)smem; float* mB = mA + 3 * 1024;
  const float* MOD = (const float*)(p.ws + O_MOD);
  for (int i = tid; i < 3072; i += NTHR) { int r = i >> 10, c = i & 1023; mA[i] = p.g_pre1[c] * (1.f + MOD[r * 6144 + 1024 + c]); mB[i] = MOD[r * 6144 + c]; }
  __syncthreads();
  bf16_t* HX = (bf16_t*)(p.ws + O_RA);
  for (int row = blockIdx.x * NWAVE + wave; row < NROW; row += gridDim.x * NWAVE) {
    const float* src = row < NTOK ? p.x + (size_t)row * 1024 : p.ctx + (size_t)(row - NTOK) * 1024;
    const int mr = row < NTOK ? (row >> 13) : 2;
    float4 v[4]; float ss = 0.f;
#pragma unroll
    for (int i = 0; i < 4; ++i) { v[i] = *(const float4*)(src + i * 256 + lane * 4); ss += v[i].x * v[i].x + v[i].y * v[i].y + v[i].z * v[i].z + v[i].w * v[i].w; }
    ss = wave_sum(ss); const float rstd = rsqrtf(ss * (1.f / 1024.f) + EPS);
#pragma unroll
    for (int i = 0; i < 4; ++i) { const int c = i * 256 + lane * 4; const float* a = mA + mr * 1024 + c; const float* b = mB + mr * 1024 + c;
      u32x2 o = {pack2(v[i].x * rstd * a[0] + b[0], v[i].y * rstd * a[1] + b[1]), pack2(v[i].z * rstd * a[2] + b[2], v[i].w * rstd * a[3] + b[3])};
      *(u32x2*)(HX + (size_t)row * 1024 + c) = o; }
  }
}

DEVI int lds_sw(int row, int c) { return row * 128 + ((c ^ (row & 7)) << 4); }
template <int BM, int BN, bool ACOLMAP, bool GLDS, class Epi>
DEVI void gemm_tile_mfma(const bf16_t* __restrict__ A, int lda, const bf16_t* __restrict__ Bm, int ldb, int K, int row0, int col0, const Epi& epi, const float* kscale, char* smem) {
  constexpr int WNW = BN / 64, WMW = 8 / WNW, WTM = BM / WMW, MI = WTM / 16, ACH = BM / 64, BCH = BN / 64, ABYTES = BM * 128, BBYTES = BN * 128, STAGE = ABYTES + BBYTES;
  const int tid = threadIdx.x, wave = tid >> 6, lane = tid & 63, wm = wave / WNW, wn = wave % WNW, l15 = lane & 15, lq = lane >> 4;
  f32x4 acc[MI][4];
#pragma unroll
  for (int mi = 0; mi < MI; ++mi)
#pragma unroll
    for (int ni = 0; ni < 4; ++ni) acc[mi][ni] = (f32x4){0.f, 0.f, 0.f, 0.f};
  const int nk = K >> 6;
  const int sr = tid >> 3, scc = tid & 7;
  auto compute = [&](int buf) {
    const char* sa = smem + buf * STAGE; const char* sb = sa + ABYTES;
#pragma unroll
    for (int ks = 0; ks < 2; ++ks) { const int kc = ks * 4 + lq; bf16x8 bfr[4];
#pragma unroll
      for (int ni = 0; ni < 4; ++ni) bfr[ni] = *(const bf16x8*)(sb + lds_sw(wn * 64 + ni * 16 + l15, kc));
#pragma unroll
      for (int mi = 0; mi < MI; ++mi) { const bf16x8 af = *(const bf16x8*)(sa + lds_sw(wm * WTM + mi * 16 + l15, kc));
#pragma unroll
        for (int ni = 0; ni < 4; ++ni) acc[mi][ni] = __builtin_amdgcn_mfma_f32_16x16x32_bf16(bfr[ni], af, acc[mi][ni], 0, 0, 0); }
      if (MI > 4) __builtin_amdgcn_sched_barrier(0); }
  };
  if constexpr (GLDS) {
    const unsigned aoff = (unsigned)(sr * lda + ((scc ^ (sr & 7)) * 8)) * 2u, boff = (unsigned)(sr * ldb + ((scc ^ (sr & 7)) * 8)) * 2u;
    auto gstage = [&](int buf, int kt) {
      const int k0 = kt * 64, ka = ACOLMAP ? k0 + (k0 >> 7) * 64 : k0;
      char* sa = smem + buf * STAGE + wave * 1024; char* sb = sa + ABYTES;
#pragma unroll
      for (int i = 0; i < ACH; ++i) __builtin_amdgcn_global_load_lds((const unsigned*)((const char*)(A + (size_t)(64 * i) * lda + ka) + aoff), (unsigned*)(sa + i * 8192), 16, 0, 0);
#pragma unroll
      for (int i = 0; i < BCH; ++i) __builtin_amdgcn_global_load_lds((const unsigned*)((const char*)(Bm + (size_t)(64 * i) * ldb + k0) + boff), (unsigned*)(sb + i * 8192), 16, 0, 0);
    };
    gstage(0, 0); asm volatile("s_waitcnt vmcnt(0)" ::: "memory"); __syncthreads();
    for (int kt = 0; kt < nk; ++kt) {
      if (kt + 1 < nk) gstage((kt + 1) & 1, kt + 1);
      compute(kt & 1);
      asm volatile("s_waitcnt vmcnt(0)" ::: "memory"); __syncthreads();
    }
  } else {
    u32x4 ra[ACH], rb[BCH];
    const unsigned aoff = (unsigned)(sr * lda + scc * 8) * 2u, boff = (unsigned)(sr * ldb + scc * 8) * 2u;
    const int sdst = lds_sw(sr, scc);
    auto gload = [&](int kt) {
      const int k0 = kt * 64, ka = ACOLMAP ? k0 + (k0 >> 7) * 64 : k0;
#pragma unroll
      for (int i = 0; i < ACH; ++i) { const char* ub = (const char*)(A + (size_t)(64 * i) * lda + ka); ra[i] = *(const u32x4*)(ub + aoff); }
#pragma unroll
      for (int i = 0; i < BCH; ++i) { const char* ub = (const char*)(Bm + (size_t)(64 * i) * ldb + k0); rb[i] = *(const u32x4*)(ub + boff); }
    };
    auto lstore = [&](int buf, int kt) {
      char* sa = smem + buf * STAGE + sdst; char* sb = sa + ABYTES;
#pragma unroll
      for (int i = 0; i < ACH; ++i) { u32x4 v = ra[i];
        if (kscale) { float f[8]; unpack8(v, f); const float* ks = kscale + kt * 64 + scc * 8;
          v = (u32x4){pack2(f[0] * ks[0], f[1] * ks[1]), pack2(f[2] * ks[2], f[3] * ks[3]), pack2(f[4] * ks[4], f[5] * ks[5]), pack2(f[6] * ks[6], f[7] * ks[7])}; }
        *(u32x4*)(sa + i * 8192) = v; }
#pragma unroll
      for (int i = 0; i < BCH; ++i) *(u32x4*)(sb + i * 8192) = rb[i];
    };
    gload(0); lstore(0, 0); __syncthreads();
    for (int kt = 0; kt < nk; ++kt) {
      if (kt + 1 < nk) gload(kt + 1);
      compute(kt & 1);
      if (kt + 1 < nk) lstore((kt + 1) & 1, kt + 1);
      __syncthreads();
    }
  }
#pragma unroll
  for (int mi = 0; mi < MI; ++mi) { const int row = row0 + wm * WTM + mi * 16 + l15; float sq = 0.f;
#pragma unroll
    for (int ni = 0; ni < 4; ++ni) { const float v[4] = {acc[mi][ni][0], acc[mi][ni][1], acc[mi][ni][2], acc[mi][ni][3]}; sq += epi(row, col0 + wn * 64 + ni * 16 + lq * 4, v); }
    if (Epi::RSS) { sq += __shfl_xor(sq, 16); sq += __shfl_xor(sq, 32); if (lq == 0) epi.rss(row, col0 + wn * 64, sq); }
    __builtin_amdgcn_sched_barrier(0); }
}

template <int BM, int BN, bool ACOLMAP, class Epi>
DEVI void gemm_tile(const bf16_t* A, int lda, const bf16_t* Bm, int ldb, int K, int row0, int col0, const Epi& epi, const float* kss, char* smem) {
  if (kss) gemm_tile_mfma<BM, BN, ACOLMAP, false>(A, lda, Bm, ldb, K, row0, col0, epi, kss, smem);
  else gemm_tile_mfma<BM, BN, ACOLMAP, true>(A, lda, Bm, ldb, K, row0, col0, epi, nullptr, smem);
}

DEVI void st4bf(bf16_t* d, float a, float b, float c, float e) { u32x2 o = {pack2(a, b), pack2(c, e)}; *(u32x2*)d = o; }

struct EpiIn { static constexpr bool RSS = true; bf16_t *GU, *GVT, *CQ, *CKV, *KR; float *rssv, *rssq, *rsskv;
  DEVI float operator()(int row, int col, const float (&v)[4]) const {
    if (col < 1024) { st4bf(GU + (size_t)row * 1024 + col, gelu_t(v[0]), gelu_t(v[1]), gelu_t(v[2]), gelu_t(v[3])); return 0.f; }
    else if (col < 2048) { const int c = col - 1024, chunk = row >> 7, q = row & 127; float s = 0.f;
#pragma unroll
      for (int j = 0; j < 4; ++j) { const float g = gelu_t(v[j]); s += g * g; GVT[((size_t)chunk * 1024 + c + j) * 128 + q] = f2bf(g); }
      return s; }
    else if (col < 2304) { st4bf(CQ + (size_t)row * 256 + (col - 2048), v[0], v[1], v[2], v[3]); return v[0] * v[0] + v[1] * v[1] + v[2] * v[2] + v[3] * v[3]; }
    else if (col < 2432) { st4bf(CKV + (size_t)row * 128 + (col - 2304), v[0], v[1], v[2], v[3]); return v[0] * v[0] + v[1] * v[1] + v[2] * v[2] + v[3] * v[3]; }
    else if (col < 2496) { st4bf(KR + (size_t)keyrow(row) * 64 + (col - 2432), v[0], v[1], v[2], v[3]); return 0.f; }
    return 0.f; }
  DEVI void rss(int row, int col, float s) const {
    if (col >= 1024 && col < 2048) rssv[row * 16 + ((col - 1024) >> 6)] = s; else if (col >= 2048 && col < 2304) rssq[row * 4 + ((col - 2048) >> 6)] = s; else if (col >= 2304 && col < 2432) rsskv[row * 2 + ((col - 2304) >> 6)] = s; }
};
struct EpiQ { static constexpr bool RSS = false; bf16_t* Q; const float* rssq;
  DEVI float operator()(int row, int col, const float (&v)[4]) const { const float4 ps = *(const float4*)(rssq + row * 4); const float r = rsqrtf(((ps.x + ps.y) + (ps.z + ps.w)) * (1.f / 256.f) + EPS);
    st4bf(Q + (size_t)row * 1536 + col, v[0] * r, v[1] * r, v[2] * r, v[3] * r); return 0.f; }
  DEVI void rss(int, int, float) const {} };
struct EpiKV { static constexpr bool RSS = false; bf16_t* KV; const float* rsskv;
  DEVI float operator()(int row, int col, const float (&v)[4]) const { const float r = rsqrtf((rsskv[row * 2] + rsskv[row * 2 + 1]) * (1.f / 128.f) + EPS);
    st4bf(KV + (size_t)keyrow(row) * 2048 + col, v[0] * r, v[1] * r, v[2] * r, v[3] * r); return 0.f; }
  DEVI void rss(int, int, float) const {} };
DEVI int pk4_fp8(float a, float b, float c, float d) { int w = __builtin_amdgcn_cvt_pk_fp8_f32(a, b, 0, false); return __builtin_amdgcn_cvt_pk_fp8_f32(c, d, w, true); }
constexpr size_t O_K8 = O_RKV, O_V8T = O_RKV + al256((size_t)NB * 8 * NKEY * 192);
struct EpiK8 { static constexpr bool RSS = false; unsigned char* K8; const float* rsskv;
  DEVI float operator()(int row, int col, const float (&v)[4]) const { const float r = rsqrtf((rsskv[row * 2] + rsskv[row * 2 + 1]) * (1.f / 128.f) + EPS);
    const int kr = keyrow(row), b = kr / NKEY, key = kr - b * NKEY, h = col >> 7, d = col & 127;
    *(int*)(K8 + ((size_t)(b * 8 + h) * NKEY + key) * 192 + d) = pk4_fp8(v[0] * r, v[1] * r, v[2] * r, v[3] * r); return 0.f; }
  DEVI void rss(int, int, float) const {} };
struct EpiV8T { static constexpr bool RSS = false; unsigned char* V8; const float* rsskv;
  DEVI float operator()(int row, int col, const float (&v)[4]) const {
    float r[4];
#pragma unroll
    for (int j = 0; j < 4; ++j) r[j] = rsqrtf((rsskv[(col + j) * 2] + rsskv[(col + j) * 2 + 1]) * (1.f / 128.f) + EPS);
    const int kr = keyrow(col), b = kr / NKEY, key = kr - b * NKEY, h = row >> 7, d = row & 127, kk = key & 63;
    const int off = 32 * ((kk >> 2) & 1) + 16 * (kk >> 5) + 4 * ((kk >> 3) & 3);
    *(int*)(V8 + ((size_t)(b * 8 + h) * 128 + d) * NKEY + (key & ~63) + off) = pk4_fp8(v[0] * r[0], v[1] * r[1], v[2] * r[2], v[3] * r[3]); return 0.f; }
  DEVI void rss(int, int, float) const {} };
struct EpiSgu { static constexpr bool RSS = false; bf16_t* GUOA; const float* g_sgu; const float* b_s; int chunk, g;
  DEVI float operator()(int row, int col, const float (&v)[4]) const { const int token = chunk * 128 + row, ch = g * 128 + col; const float bias = b_s[g * 128 + row];
    bf16_t* ptr = GUOA + (size_t)token * 1024 + ch; const u32x2 gu = *(const u32x2*)ptr;
    st4bf(ptr, lo2f(gu[0]) * (g_sgu[ch] * v[0] + bias), hi2f(gu[0]) * (g_sgu[ch + 1] * v[1] + bias), lo2f(gu[1]) * (g_sgu[ch + 2] * v[2] + bias), hi2f(gu[1]) * (g_sgu[ch + 3] * v[3] + bias));
    return 0.f; }
  DEVI void rss(int, int, float) const {} };
struct EpiGate { static constexpr bool RSS = false; bf16_t* G;
  DEVI float operator()(int row, int col, const float (&v)[4]) const { st4bf(G + (size_t)row * 2048 + col, sigmoidf_(v[0]), sigmoidf_(v[1]), sigmoidf_(v[2]), sigmoidf_(v[3])); return 0.f; }
  DEVI void rss(int, int, float) const {} };
template <bool SECOND> struct EpiMerge { static constexpr bool RSS = false; bf16_t* M; const bf16_t* G;
  DEVI float operator()(int row, int col, const float (&v)[4]) const { const u32x2 g = *(const u32x2*)(G + (size_t)row * 2048 + (SECOND ? 1024 : 0) + col);
    float o0 = lo2f(g[0]) * v[0], o1 = hi2f(g[0]) * v[1], o2 = lo2f(g[1]) * v[2], o3 = hi2f(g[1]) * v[3];
    bf16_t* ptr = M + (size_t)row * 1024 + col;
    if (SECOND) { const u32x2 m = *(const u32x2*)ptr; o0 += lo2f(m[0]); o1 += hi2f(m[0]); o2 += lo2f(m[1]); o3 += hi2f(m[1]); }
    st4bf(ptr, o0, o1, o2, o3); return 0.f; }
  DEVI void rss(int, int, float) const {} };
struct EpiO { static constexpr bool RSS = true; bf16_t* Y; float* rssy;
  DEVI float operator()(int row, int col, const float (&v)[4]) const { st4bf(Y + (size_t)row * 1024 + col, v[0], v[1], v[2], v[3]); return v[0] * v[0] + v[1] * v[1] + v[2] * v[2] + v[3] * v[3]; }
  DEVI void rss(int row, int col, float s) const { rssy[row * 16 + (col >> 6)] = s; } };
struct EpiPq { static constexpr bool RSS = false; bf16_t* QP;
  DEVI float operator()(int row, int col, const float (&v)[4]) const { st4bf(QP + (size_t)row * 2048 + col, v[0], v[1], v[2], v[3]); return 0.f; }
  DEVI void rss(int, int, float) const {} };

template <class F> DEVI void for_tiles_xcd(int MT, int NT, F f) {
  const int nb = gridDim.x;
  if ((nb & 7) == 0 && (MT & 7) == 0) { const int xcd = blockIdx.x & 7, slot = blockIdx.x >> 3, slots = nb >> 3, mper = MT >> 3, tot = mper * NT;
    for (int j = slot; j < tot; j += slots) f(xcd * mper + j / NT, j % NT); }
  else for (int i = blockIdx.x; i < MT * NT; i += nb) f(i / NT, i % NT);
}

DEVI void ph_inproj(const Params& p, char* smem) {
  char* ws = p.ws;
  EpiIn epi{(bf16_t*)(ws + O_RB), (bf16_t*)(ws + O_RC), (bf16_t*)(ws + O_CQ), (bf16_t*)(ws + O_CKV), (bf16_t*)(ws + O_KR), (float*)(ws + O_RSSV), (float*)(ws + O_RSSQ), (float*)(ws + O_RSSKV)};
  const bf16_t* HX = (const bf16_t*)(ws + O_RA); const bf16_t* W = (const bf16_t*)(ws + O_WIN);
  auto tile = [&](int mt, int nt) { gemm_tile<256, 256, false>(HX + (size_t)mt * 256 * 1024, 1024, W + (size_t)nt * 256 * 1024, 1024, 1024, mt * 256, nt * 256, epi, nullptr, smem); };
  for_tiles_xcd(64, 10, tile);
  for (int i = (int)gridDim.x - 1 - (int)blockIdx.x; i < 2; i += gridDim.x) tile(64 + i, 9);
}
DEVI void rope_kr(const Params& p) {
  bf16_t* KR = (bf16_t*)(p.ws + O_KR); const float* rope = (const float*)(p.ws + O_ROPE);
  for (int i = blockIdx.x * NTHR + threadIdx.x; i < NTOK * 32; i += gridDim.x * NTHR) {
    const int tok = i >> 5, j = i & 15, which = (i >> 4) & 1, pos = tok & 8191, pp = which ? (pos & 63) : (pos >> 6);
    const float cs = rope[(pp * 16 + j) * 2], sn = rope[(pp * 16 + j) * 2 + 1];
    bf16_t* r = KR + (size_t)keyrow(tok) * 64 + which * 32 + j;
    const float x1 = bf2f(r[0]), x2 = bf2f(r[16]);
    r[0] = f2bf(x1 * cs - x2 * sn); r[16] = f2bf(x1 * sn + x2 * cs);
  }
}
DEVI void rope_kr_fp8(const Params& p) {
  const bf16_t* KR = (const bf16_t*)(p.ws + O_KR); const float* rope = (const float*)(p.ws + O_ROPE); unsigned char* K8 = (unsigned char*)(p.ws + O_K8);
  for (int i = blockIdx.x * NTHR + threadIdx.x; i < NROW * 2; i += gridDim.x * NTHR) {
    const int row = i >> 1, which = i & 1, kr = keyrow(row), b = kr / NKEY, key = kr - b * NKEY;
    float x[32];
    const bf16_t* src = KR + (size_t)kr * 64 + which * 32;
#pragma unroll
    for (int q = 0; q < 4; ++q) unpack8(*(const u32x4*)(src + q * 8), x + q * 8);
    if (row < NTOK) { const int pos = row & 8191, pp = which ? (pos & 63) : (pos >> 6); const float* cs = rope + pp * 32;
#pragma unroll
      for (int j = 0; j < 16; ++j) { const float c = cs[j * 2], sn = cs[j * 2 + 1], x1 = x[j], x2 = x[16 + j]; x[j] = x1 * c - x2 * sn; x[16 + j] = x1 * sn + x2 * c; } }
    u32x4 o0, o1;
#pragma unroll
    for (int q = 0; q < 4; ++q) { o0[q] = (unsigned)pk4_fp8(x[q * 4], x[q * 4 + 1], x[q * 4 + 2], x[q * 4 + 3]); o1[q] = (unsigned)pk4_fp8(x[16 + q * 4], x[17 + q * 4], x[18 + q * 4], x[19 + q * 4]); }
#pragma unroll
    for (int h = 0; h < 8; ++h) { unsigned char* d = K8 + ((size_t)(b * 8 + h) * NKEY + key) * 192 + 128 + which * 32; *(u32x4*)d = o0; *(u32x4*)(d + 16) = o1; }
  }
}
DEVI void ph_mid(const Params& p, char* smem) {
  char* ws = p.ws;
  { EpiQ epi{(bf16_t*)(ws + O_RQ), (const float*)(ws + O_RSSQ)};
    const bf16_t* A = (const bf16_t*)(ws + O_CQ); const bf16_t* W = (const bf16_t*)(ws + O_WUQ);
    for_tiles_xcd(64, 12, [&](int mt, int nt) { gemm_tile<256, 128, false>(A + (size_t)mt * 256 * 256, 256, W + (size_t)nt * 128 * 256, 256, 256, mt * 256, nt * 128, epi, nullptr, smem); }); }
#if ATTN_FP8
  { EpiK8 epi{(unsigned char*)(ws + O_K8), (const float*)(ws + O_RSSKV)};
    const bf16_t* A = (const bf16_t*)(ws + O_CKV); const bf16_t* W = (const bf16_t*)(ws + O_WUKV);
    auto tile = [&](int mt, int nt) { gemm_tile<256, 128, false>(A + (size_t)mt * 256 * 128, 128, W + (size_t)nt * 256 * 128, 128, 128, mt * 256, nt * 128, epi, nullptr, smem); };
    for_tiles_xcd(64, 8, tile);
    for (int i = blockIdx.x; i < 16; i += gridDim.x) tile(64 + (i >> 3), i & 7); }
  { EpiV8T epi{(unsigned char*)(ws + O_V8T), (const float*)(ws + O_RSSKV)};
    const bf16_t* A = (const bf16_t*)(ws + O_WUKV); const bf16_t* Bc = (const bf16_t*)(ws + O_CKV);
    for (int i = blockIdx.x; i < 8 * 132; i += gridDim.x) { const int mt = i & 7, nt = i >> 3;
      gemm_tile<128, 128, false>(A + (size_t)(mt * 256 + 128) * 128, 128, Bc + (size_t)nt * 128 * 128, 128, 128, mt * 128, nt * 128, epi, nullptr, smem); } }
#else
  { EpiKV epi{(bf16_t*)(ws + O_RKV), (const float*)(ws + O_RSSKV)};
    const bf16_t* A = (const bf16_t*)(ws + O_CKV); const bf16_t* W = (const bf16_t*)(ws + O_WUKV);
    auto tile = [&](int mt, int nt) { gemm_tile<256, 128, false>(A + (size_t)mt * 256 * 128, 128, W + (size_t)nt * 128 * 128, 128, 128, mt * 256, nt * 128, epi, nullptr, smem); };
    for_tiles_xcd(64, 16, tile);
    for (int i = blockIdx.x; i < 32; i += gridDim.x) tile(64 + (i >> 4), i & 15); }
#endif
  { const bf16_t* WS = (const bf16_t*)(ws + O_WS); const bf16_t* GVT = (const bf16_t*)(ws + O_RC);
    float* ksc = (float*)(smem + LDS_BYTES - 1024); const float* rssv = (const float*)(ws + O_RSSV);
    for (int i = blockIdx.x; i < 1024; i += gridDim.x) { const int chunk = i >> 3, g = i & 7;
      __syncthreads();
      if (threadIdx.x < 128) { const float* pr = rssv + (size_t)(chunk * 128 + threadIdx.x) * 16; float t = 0.f;
#pragma unroll
        for (int j = 0; j < 16; ++j) t += pr[j];
        ksc[threadIdx.x] = rsqrtf(t * (1.f / 1024.f) + EPS); }
      __syncthreads();
      EpiSgu epi{(bf16_t*)(ws + O_RB), p.g_sgu, p.b_s, chunk, g};
      gemm_tile<128, 128, false>(WS + (size_t)g * 16384, 128, GVT + ((size_t)chunk * 1024 + g * 128) * 128, 128, 128, 0, 0, epi, ksc, smem); } }
#if ATTN_FP8
  rope_kr_fp8(p);
#else
  rope_kr(p);
#endif
}
DEVI void ph_gates(const Params& p, char* smem) {
  char* ws = p.ws; EpiGate epi{(bf16_t*)(ws + O_RKV)};
  const bf16_t* HX = (const bf16_t*)(ws + O_RA); const bf16_t* W = (const bf16_t*)(ws + O_WIN) + (size_t)NPRE * 1024;
  for_tiles_xcd(64, 8, [&](int mt, int nt) { gemm_tile<256, 256, false>(HX + (size_t)mt * 256 * 1024, 1024, W + (size_t)nt * 256 * 1024, 1024, 1024, mt * 256, nt * 256, epi, nullptr, smem); });
}
DEVI void ph_merge(const Params& p, char* smem) {
  char* ws = p.ws; bf16_t* M = (bf16_t*)(ws + O_RC); const bf16_t* G = (const bf16_t*)(ws + O_RKV);
  EpiMerge<false> e1{M, G}; EpiMerge<true> e2{M, G};
  const bf16_t* OA = (const bf16_t*)(ws + O_RB); const bf16_t* OB = (const bf16_t*)(ws + O_RQ);
  const bf16_t* WA = (const bf16_t*)(ws + O_WPA); const bf16_t* WB = (const bf16_t*)(ws + O_WPB);
  for_tiles_xcd(64, 4, [&](int mt, int nt) { gemm_tile<256, 256, false>(OA + (size_t)mt * 256 * 1024, 1024, WA + (size_t)nt * 256 * 1024, 1024, 1024, mt * 256, nt * 256, e1, nullptr, smem); });
  for_tiles_xcd(64, 4, [&](int mt, int nt) { gemm_tile<256, 256, true>(OB + (size_t)mt * 256 * 1536, 1536, WB + (size_t)nt * 256 * 1024, 1024, 1024, mt * 256, nt * 256, e2, nullptr, smem); });
}
DEVI void ph_wo(const Params& p, char* smem) {
  char* ws = p.ws; EpiO epi{(bf16_t*)(ws + O_RA), (float*)(ws + O_RSSY)};
  const bf16_t* M = (const bf16_t*)(ws + O_RC); const bf16_t* W = (const bf16_t*)(ws + O_WO);
  for_tiles_xcd(64, 4, [&](int mt, int nt) { gemm_tile<256, 256, false>(M + (size_t)mt * 256 * 1024, 1024, W + (size_t)nt * 256 * 1024, 1024, 1024, mt * 256, nt * 256, epi, nullptr, smem); });
}
DEVI void ph_wpq(const Params& p, char* smem) {
  char* ws = p.ws; EpiPq epi{(bf16_t*)(ws + O_RKV)};
  const bf16_t* A = (const bf16_t*)(ws + O_RB); const bf16_t* W = (const bf16_t*)(ws + O_WPQ);
  for_tiles_xcd(64, 8, [&](int mt, int nt) { gemm_tile<256, 256, false>(A + (size_t)mt * 256 * 1024, 1024, W + (size_t)nt * 256 * 1024, 1024, 1024, mt * 256, nt * 256, epi, nullptr, smem); });
  convert_table_fp8(p.v_exp, (unsigned char*)(ws + O_RA), (float*)(ws + O_RA + (size_t)16384 * 1024));
}

DEVI void attn_naive(const Params& p, char* smem) {
  const int tid = threadIdx.x, wave = tid >> 6, lane = tid & 63;
  float* qs = (float*)smem + wave * 256; float* ps = qs + 192;
  bf16_t* Q = (bf16_t*)(p.ws + O_RQ); const bf16_t* KV = (const bf16_t*)(p.ws + O_RKV); const bf16_t* KR = (const bf16_t*)(p.ws + O_KR);
  const float* rope = (const float*)(p.ws + O_ROPE);
  const float scale = 0.07216878364870322f;
  for (int base = blockIdx.x * NWAVE; base < NB * 8 * SEQ; base += gridDim.x * NWAVE) {
    const int it = base + wave, bh = it >> 13, qi = it & 8191, b = bh >> 3, h = bh & 7;
    const size_t qoff = (size_t)(b * SEQ + qi) * 1536 + h * 192;
    __syncthreads();
    for (int d = lane; d < 192; d += 64) qs[d] = bf2f(Q[qoff + d]);
    __syncthreads();
    if (lane < 32) { const int j = lane & 15, which = lane >> 4, pp = which ? (qi & 63) : (qi >> 6);
      const float cs = rope[(pp * 16 + j) * 2], sn = rope[(pp * 16 + j) * 2 + 1]; const int d1 = 128 + which * 32 + j, d2 = d1 + 16;
      const float x1 = qs[d1], x2 = qs[d2]; qs[d1] = x1 * cs - x2 * sn; qs[d2] = x1 * sn + x2 * cs; }
    __syncthreads();
    float m = -1e30f, l = 0.f, o0 = 0.f, o1 = 0.f;
    for (int k0 = 0; k0 < NKEY; k0 += 64) {
      const size_t kr = (size_t)(b * NKEY + k0 + lane);
      const bf16_t* kn = KV + kr * 2048 + h * 256; const bf16_t* krp = KR + kr * 64;
      float s = 0.f;
#pragma unroll 4
      for (int d8 = 0; d8 < 16; ++d8) { float kf[8]; unpack8(*(const u32x4*)(kn + d8 * 8), kf); const float4 q0 = *(const float4*)(qs + d8 * 8), q1 = *(const float4*)(qs + d8 * 8 + 4);
        s += q0.x * kf[0] + q0.y * kf[1] + q0.z * kf[2] + q0.w * kf[3] + q1.x * kf[4] + q1.y * kf[5] + q1.z * kf[6] + q1.w * kf[7]; }
#pragma unroll 4
      for (int d8 = 0; d8 < 8; ++d8) { float kf[8]; unpack8(*(const u32x4*)(krp + d8 * 8), kf); const float4 q0 = *(const float4*)(qs + 128 + d8 * 8), q1 = *(const float4*)(qs + 128 + d8 * 8 + 4);
        s += q0.x * kf[0] + q0.y * kf[1] + q0.z * kf[2] + q0.w * kf[3] + q1.x * kf[4] + q1.y * kf[5] + q1.z * kf[6] + q1.w * kf[7]; }
      s *= scale;
      const float mn = fmaxf(m, wave_max(s)), al = __expf(m - mn), pe = __expf(s - mn);
      l = l * al + wave_sum(pe); m = mn; o0 *= al; o1 *= al;
      __syncthreads();
      ps[lane] = pe;
      __syncthreads();
      const bf16_t* vp = KV + (size_t)(b * NKEY + k0) * 2048 + h * 256 + 128 + lane * 2;
#pragma unroll 8
      for (int kk = 0; kk < 64; ++kk) { const unsigned w = *(const unsigned*)(vp + (size_t)kk * 2048); const float pk = ps[kk]; o0 += pk * lo2f(w); o1 += pk * hi2f(w); }
    }
    const float invL = 1.f / l;
    *(unsigned*)(Q + qoff + lane * 2) = pack2(o0 * invL, o1 * invL);
  }
}

namespace at {
constexpr int QBLK = 32, KVBLK = 64;
constexpr float SCALE = 0.07216878364870322f;
constexpr float THR = 8.f;
constexpr int SHM_V = KVBLK * 128 * 2, SHM_K = KVBLK * 192 * 2;
using s16x4 = __attribute__((ext_vector_type(4))) short;
#define KSWZ(row, colB) ((row) * 384 + ((colB) ^ (((row) & 7) << 4)))
#define SBAR() __builtin_amdgcn_sched_barrier(0)
DEVI int crow(int r, int hi) { return (r & 3) + 8 * (r >> 2) + 4 * hi; }
DEVI unsigned cvtpk(float lo, float hi) { unsigned r; asm volatile("v_cvt_pk_bf16_f32 %0, %1, %2" : "=v"(r) : "v"(lo), "v"(hi)); return r; }
DEVI void partialSM(f32x16& p0, f32x16& p1, float& m_reg, float& mn, float& alpha) {
  constexpr float C = SCALE * 1.4426950408889634f;
  float pmax = p0[0];
#pragma unroll
  for (int r = 1; r < 16; ++r) pmax = fmaxf(pmax, p0[r]);
#pragma unroll
  for (int r = 0; r < 16; ++r) pmax = fmaxf(pmax, p1[r]);
  { auto rr = __builtin_amdgcn_permlane32_swap(__float_as_uint(pmax), __float_as_uint(pmax), false, false);
    pmax = fmaxf(__uint_as_float(rr[0]), __uint_as_float(rr[1])); }
  if (__builtin_expect(__all(pmax - m_reg <= THR / SCALE), 1)) { mn = m_reg; alpha = 1.f; }
  else { mn = fmaxf(m_reg, pmax); alpha = __builtin_amdgcn_exp2f((m_reg - mn) * C); m_reg = mn; }
  const float mnC = -mn * C;
#pragma unroll
  for (int r = 0; r < 16; ++r) p0[r] = fmaf(p0[r], C, mnC);
#pragma unroll
  for (int r = 0; r < 16; ++r) p1[r] = fmaf(p1[r], C, mnC);
#pragma unroll
  for (int r = 0; r < 16; ++r) p0[r] = __builtin_amdgcn_exp2f(p0[r]);
}
DEVI void finishSM(f32x16& p0, f32x16& p1, float alpha, float& l_reg, bf16x8& pa0, bf16x8& pa1, bf16x8& pa2, bf16x8& pa3) {
#pragma unroll
  for (int r = 0; r < 16; ++r) p1[r] = __builtin_amdgcn_exp2f(p1[r]);
  float ps = 0;
#pragma unroll
  for (int r = 0; r < 16; ++r) ps += p0[r];
#pragma unroll
  for (int r = 0; r < 16; ++r) ps += p1[r];
  { auto rr = __builtin_amdgcn_permlane32_swap(__float_as_uint(ps), __float_as_uint(ps), false, false);
    ps = __uint_as_float(rr[0]) + __uint_as_float(rr[1]); }
  l_reg = l_reg * alpha + ps;
#define PK4(P, BASE, OUT) do { unsigned a0 = cvtpk(P[BASE + 0], P[BASE + 1]), a1 = cvtpk(P[BASE + 2], P[BASE + 3]);   \
    unsigned b0 = cvtpk(P[BASE + 4], P[BASE + 5]), b1 = cvtpk(P[BASE + 6], P[BASE + 7]);                              \
    auto r0 = __builtin_amdgcn_permlane32_swap(a0, b0, false, false); auto r1 = __builtin_amdgcn_permlane32_swap(a1, b1, false, false); \
    u32x4 w = {r0[0], r1[0], r0[1], r1[1]}; OUT = *reinterpret_cast<bf16x8*>(&w); } while (0)
  PK4(p0, 0, pa0); PK4(p0, 8, pa1); PK4(p1, 0, pa2); PK4(p1, 8, pa3);
#undef PK4
}
DEVI void qkt(f32x16& p0, f32x16& p1, const char* Ks, const bf16x8* qr, const char* qrl, int r32, int hi) {
  p0 = f32x16{}; p1 = f32x16{};
#pragma unroll
  for (int d0 = 0; d0 < 12; ++d0) { const int cb = (d0 * 16 + hi * 8) * 2;
    const bf16x8 b0 = *reinterpret_cast<const bf16x8*>(Ks + KSWZ(r32, cb));
    const bf16x8 b1 = *reinterpret_cast<const bf16x8*>(Ks + KSWZ(32 + r32, cb));
    const bf16x8 q = d0 < 8 ? qr[d0 < 8 ? d0 : 0] : *reinterpret_cast<const bf16x8*>(qrl + (d0 - 8) * 1024);
    p0 = __builtin_amdgcn_mfma_f32_32x32x16_bf16(b0, q, p0, 0, 0, 0);
    p1 = __builtin_amdgcn_mfma_f32_32x32x16_bf16(b1, q, p1, 0, 0, 0); }
}
DEVI int v_st(int k, int c) { const int kk = (k & ~0xC) | ((k & 4) << 1) | ((k & 8) >> 1); return ((kk >> 3) * 4 + (c >> 5)) * 512 + ((kk & 7) * 32 + (c & 31)) * 2; }
DEVI int v_rd_base(int lane) { return ((lane & 3) << 3) | (((lane >> 2) & 3) << 6) | (((lane >> 4) & 1) << 5) | (((lane >> 5) & 1) << 8); }
constexpr int v_rd_off(int d0, int ks, int half) { return d0 * 512 + ks * 4096 + half * 2048; }
template <int OFF> DEVI s16x4 tr_read(int vb) { s16x4 r; asm volatile("ds_read_b64_tr_b16 %0, %1 offset:%2" : "=&v"(r) : "v"(vb), "i"(OFF) : "memory"); return r; }
template <int D0> DEVI void pv_one(f32x16& od, int vb, bf16x8 pa0, bf16x8 pa1, bf16x8 pa2, bf16x8 pa3) {
  const s16x4 l0 = tr_read<v_rd_off(D0, 0, 0)>(vb), h0 = tr_read<v_rd_off(D0, 0, 1)>(vb), l1 = tr_read<v_rd_off(D0, 1, 0)>(vb), h1 = tr_read<v_rd_off(D0, 1, 1)>(vb);
  const s16x4 l2 = tr_read<v_rd_off(D0, 2, 0)>(vb), h2 = tr_read<v_rd_off(D0, 2, 1)>(vb), l3 = tr_read<v_rd_off(D0, 3, 0)>(vb), h3 = tr_read<v_rd_off(D0, 3, 1)>(vb);
  asm volatile("s_waitcnt lgkmcnt(0)" ::: "memory"); SBAR();
#define PK(L, H) (bf16x8){L[0], L[1], L[2], L[3], H[0], H[1], H[2], H[3]}
  od = __builtin_amdgcn_mfma_f32_32x32x16_bf16(pa0, PK(l0, h0), od, 0, 0, 0);
  od = __builtin_amdgcn_mfma_f32_32x32x16_bf16(pa1, PK(l1, h1), od, 0, 0, 0);
  od = __builtin_amdgcn_mfma_f32_32x32x16_bf16(pa2, PK(l2, h2), od, 0, 0, 0);
  od = __builtin_amdgcn_mfma_f32_32x32x16_bf16(pa3, PK(l3, h3), od, 0, 0, 0);
#undef PK
}
DEVI void pv_d0(f32x16* o, int vb, bf16x8 pa0, bf16x8 pa1, bf16x8 pa2, bf16x8 pa3) {
  pv_one<0>(o[0], vb, pa0, pa1, pa2, pa3); pv_one<1>(o[1], vb, pa0, pa1, pa2, pa3); pv_one<2>(o[2], vb, pa0, pa1, pa2, pa3); pv_one<3>(o[3], vb, pa0, pa1, pa2, pa3);
}
DEVI void rope_frag(bf16x8& f1, bf16x8& f2, const float* cs) {
  u32x4 w1 = *reinterpret_cast<u32x4*>(&f1), w2 = *reinterpret_cast<u32x4*>(&f2); float a[8], b[8]; unpack8(w1, a); unpack8(w2, b);
  float c[8], s[8];
#pragma unroll
  for (int q = 0; q < 4; ++q) { const float4 t = *(const float4*)(cs + q * 4); c[q * 2] = t.x; s[q * 2] = t.y; c[q * 2 + 1] = t.z; s[q * 2 + 1] = t.w; }
  float x[8], y[8];
#pragma unroll
  for (int j = 0; j < 8; ++j) { x[j] = a[j] * c[j] - b[j] * s[j]; y[j] = a[j] * s[j] + b[j] * c[j]; }
  w1 = (u32x4){cvtpk(x[0], x[1]), cvtpk(x[2], x[3]), cvtpk(x[4], x[5]), cvtpk(x[6], x[7])};
  w2 = (u32x4){cvtpk(y[0], y[1]), cvtpk(y[2], y[3]), cvtpk(y[4], y[5]), cvtpk(y[6], y[7])};
  f1 = *reinterpret_cast<bf16x8*>(&w1); f2 = *reinterpret_cast<bf16x8*>(&w2);
}
DEVI void attn_item(bf16_t* __restrict__ Qb, const bf16_t* __restrict__ Kn, const bf16_t* __restrict__ Vh, const bf16_t* __restrict__ Kr, const float* __restrict__ rope, int pos0, char* lds) {
  const int tid = threadIdx.x, wid = tid >> 6, lane = tid & 63, r32 = lane & 31, hi = lane >> 5;
  char* V_lds = lds; char* K_lds = lds + 2 * SHM_V;
  float* wsl = (float*)(lds + 2 * SHM_V + 2 * SHM_K) + wid * 64; float* li_l = wsl; float* al_l = wsl + 32;
  char* qrl = lds + 2 * SHM_V + 2 * SHM_K + 2048 + wid * 4096 + lane * 16;
  float m_reg = -1e30f, l_reg = 0; f32x16 o[4] = {}; bf16x8 qr[8];
  bf16_t* Qw = Qb + (size_t)(wid * QBLK + r32) * 1536 + hi * 8;
#pragma unroll
  for (int d0 = 0; d0 < 8; ++d0) qr[d0] = *reinterpret_cast<const bf16x8*>(Qw + d0 * 16);
  { bf16x8 q8 = *reinterpret_cast<const bf16x8*>(Qw + 128), q9 = *reinterpret_cast<const bf16x8*>(Qw + 144), q10 = *reinterpret_cast<const bf16x8*>(Qw + 160), q11 = *reinterpret_cast<const bf16x8*>(Qw + 176);
    const int pos = pos0 + wid * QBLK + r32;
    rope_frag(q8, q9, rope + ((pos >> 6) * 16 + hi * 8) * 2); rope_frag(q10, q11, rope + ((pos & 63) * 16 + hi * 8) * 2);
    *reinterpret_cast<bf16x8*>(qrl) = q8; *reinterpret_cast<bf16x8*>(qrl + 1024) = q9; *reinterpret_cast<bf16x8*>(qrl + 2048) = q10; *reinterpret_cast<bf16x8*>(qrl + 3072) = q11; }
  const int sr = tid >> 4, sc = (tid & 15) * 8, vst0 = v_st(sr, sc), vst1 = v_st(32 + sr, sc);
  const int kst0 = KSWZ(sr, sc * 2), kst1 = KSWZ(32 + sr, sc * 2), kst2 = KSWZ(tid >> 3, 256 + (tid & 7) * 16);
  const int goff = sr * 2048 + sc, goffr = (tid >> 3) * 64 + (tid & 7) * 8;
  const int vb0 = (int)(uintptr_t)V_lds + v_rd_base(lane);
  u32x4 sv0, sv1, sk0, sk1, sk2;
#define SLOAD(k0) do { const bf16_t* vp = Vh + (size_t)(k0) * 2048 + goff; const bf16_t* kp = Kn + (size_t)(k0) * 2048 + goff; \
    sv0 = *(const u32x4*)vp; sv1 = *(const u32x4*)(vp + 32 * 2048); sk0 = *(const u32x4*)kp; sk1 = *(const u32x4*)(kp + 32 * 2048); \
    sk2 = *(const u32x4*)(Kr + (size_t)(k0) * 64 + goffr); } while (0)
#define SWRITE(b) do { *(u32x4*)(V_lds + (b) * SHM_V + vst0) = sv0; *(u32x4*)(V_lds + (b) * SHM_V + vst1) = sv1; \
    *(u32x4*)(K_lds + (b) * SHM_K + kst0) = sk0; *(u32x4*)(K_lds + (b) * SHM_K + kst1) = sk1; *(u32x4*)(K_lds + (b) * SHM_K + kst2) = sk2; } while (0)
#define SWAIT() asm volatile("s_waitcnt vmcnt(0)" ::: "memory")
#define RESC(a) do { if (__any((a) < 1.f)) { if (hi == 0) al_l[r32] = (a); asm volatile("s_waitcnt lgkmcnt(0)" ::: "memory"); \
    _Pragma("unroll") for (int d = 0; d < 4; ++d) _Pragma("unroll") for (int r = 0; r < 16; ++r) o[d][r] *= al_l[crow(r, hi)]; } } while (0)
  f32x16 pA0, pA1, pB0, pB1; float mnA, mnB, alA, alB; bf16x8 pa0, pa1, pa2, pa3; constexpr int NT = NKEY / KVBLK;
  SLOAD(0); SWAIT(); SWRITE(0); __syncthreads();
  qkt(pA0, pA1, K_lds, qr, qrl, r32, hi); partialSM(pA0, pA1, m_reg, mnA, alA);
  SLOAD(KVBLK);
  SWAIT(); SWRITE(1); __syncthreads();
  for (int j = 1; j + 1 < NT; j += 2) {
    SBAR(); qkt(pB0, pB1, K_lds + SHM_K, qr, qrl, r32, hi);
    finishSM(pA0, pA1, alA, l_reg, pa0, pa1, pa2, pa3); SBAR();
    SLOAD((j + 1) * KVBLK); SBAR();
    pv_d0(o, vb0, pa0, pa1, pa2, pa3); partialSM(pB0, pB1, m_reg, mnB, alB);
    __syncthreads(); SWAIT(); SWRITE(0);
    RESC(alB); __syncthreads();
    SBAR(); qkt(pA0, pA1, K_lds, qr, qrl, r32, hi);
    finishSM(pB0, pB1, alB, l_reg, pa0, pa1, pa2, pa3); SBAR();
    SLOAD((j + 2) * KVBLK); SBAR();
    pv_d0(o, vb0 + SHM_V, pa0, pa1, pa2, pa3); partialSM(pA0, pA1, m_reg, mnA, alA);
    __syncthreads(); SWAIT(); SWRITE(1);
    RESC(alA); __syncthreads();
  }
  SBAR(); qkt(pB0, pB1, K_lds + SHM_K, qr, qrl, r32, hi);
  finishSM(pA0, pA1, alA, l_reg, pa0, pa1, pa2, pa3); SBAR();
  pv_d0(o, vb0, pa0, pa1, pa2, pa3); partialSM(pB0, pB1, m_reg, mnB, alB);
  __syncthreads(); RESC(alB);
  finishSM(pB0, pB1, alB, l_reg, pa0, pa1, pa2, pa3); SBAR();
  pv_d0(o, vb0 + SHM_V, pa0, pa1, pa2, pa3);
  if (hi == 0) li_l[r32] = l_reg; asm volatile("s_waitcnt lgkmcnt(0)" ::: "memory");
  float rli[16];
#pragma unroll
  for (int r = 0; r < 16; ++r) rli[r] = __builtin_amdgcn_rcpf(li_l[crow(r, hi)]);
  bf16_t* Ow = Qb + (size_t)(wid * QBLK) * 1536;
#pragma unroll
  for (int r = 0; r < 16; ++r) { const int orow = crow(r, hi);
#pragma unroll
    for (int d0 = 0; d0 < 4; ++d0) Ow[(size_t)orow * 1536 + d0 * 32 + r32] = f2bf(o[d0][r] * rli[r]); }
  __syncthreads();
#undef SLOAD
#undef SWRITE
#undef SWAIT
#undef RESC
}
}
DEVI void attn_mfma(const Params& p, char* smem) {
  bf16_t* Q = (bf16_t*)(p.ws + O_RQ); const bf16_t* KV = (const bf16_t*)(p.ws + O_RKV); const bf16_t* KR = (const bf16_t*)(p.ws + O_KR);
  const float* rope = (const float*)(p.ws + O_ROPE);
  for (int it = blockIdx.x; it < NB * 8 * (SEQ / 256); it += gridDim.x) {
    const int bh = (it >> 8) * 8 + (it & 7), qb = (it & 255) >> 3, b = bh >> 3, h = bh & 7;
    at::attn_item(Q + (size_t)(b * SEQ + qb * 256) * 1536 + h * 192, KV + (size_t)b * NKEY * 2048 + h * 256, KV + (size_t)b * NKEY * 2048 + h * 256 + 128,
                  KR + (size_t)b * NKEY * 64, rope, qb * 256, smem);
  }
}

namespace a8 {
constexpr int KVBLK = 64, SHM_K = KVBLK * 192, SHM_V = 128 * KVBLK;
constexpr float SCALE = 0.07216878364870322f, THR = 1.5f;
using i32x8 = __attribute__((ext_vector_type(8))) int;
DEVI int crow(int r, int hi) { return (r & 3) + 8 * (r >> 2) + 4 * hi; }
DEVI f32x16 mma(const i32x8& a, const i32x8& b, const f32x16& c) { return __builtin_amdgcn_mfma_scale_f32_32x32x64_f8f6f4(a, b, c, 0, 0, 0, 0x7f7f7f7f, 0, 0x7f7f7f7f); }
DEVI void partialSM(f32x16& p0, f32x16& p1, float& m_reg, float& mn, float& alpha) {
  constexpr float C = SCALE * 1.4426950408889634f;
  float pmax = p0[0];
#pragma unroll
  for (int r = 1; r < 16; ++r) pmax = fmaxf(pmax, p0[r]);
#pragma unroll
  for (int r = 0; r < 16; ++r) pmax = fmaxf(pmax, p1[r]);
  { auto rr = __builtin_amdgcn_permlane32_swap(__float_as_uint(pmax), __float_as_uint(pmax), false, false);
    pmax = fmaxf(__uint_as_float(rr[0]), __uint_as_float(rr[1])); }
  if (__builtin_expect(__all(pmax - m_reg <= THR / SCALE), 1)) { mn = m_reg; alpha = 1.f; }
  else { mn = fmaxf(m_reg, pmax); alpha = __builtin_amdgcn_exp2f((m_reg - mn) * C); m_reg = mn; }
  const float mnC = 6.f - mn * C;
#pragma unroll
  for (int r = 0; r < 16; ++r) p0[r] = fmaf(p0[r], C, mnC);
#pragma unroll
  for (int r = 0; r < 16; ++r) p1[r] = fmaf(p1[r], C, mnC);
#pragma unroll
  for (int r = 0; r < 16; ++r) p0[r] = __builtin_amdgcn_exp2f(p0[r]);
}
DEVI void finishSM(f32x16& p0, f32x16& p1, float alpha, float& l_reg, i32x8& pa) {
#pragma unroll
  for (int r = 0; r < 16; ++r) p1[r] = __builtin_amdgcn_exp2f(p1[r]);
  float ps = 0;
#pragma unroll
  for (int r = 0; r < 16; ++r) ps += p0[r];
#pragma unroll
  for (int r = 0; r < 16; ++r) ps += p1[r];
  { auto rr = __builtin_amdgcn_permlane32_swap(__float_as_uint(ps), __float_as_uint(ps), false, false);
    ps = __uint_as_float(rr[0]) + __uint_as_float(rr[1]); }
  l_reg = l_reg * alpha + ps;
#pragma unroll
  for (int j = 0; j < 4; ++j) { pa[j] = pk4_fp8(p0[4 * j], p0[4 * j + 1], p0[4 * j + 2], p0[4 * j + 3]); pa[4 + j] = pk4_fp8(p1[4 * j], p1[4 * j + 1], p1[4 * j + 2], p1[4 * j + 3]); }
}
DEVI i32x8 ld32(const char* p0, const char* p1) { const u32x4 a = *(const u32x4*)p0, b = *(const u32x4*)p1; return (i32x8){(int)a[0], (int)a[1], (int)a[2], (int)a[3], (int)b[0], (int)b[1], (int)b[2], (int)b[3]}; }
DEVI void qkt(f32x16& p0, f32x16& p1, const char* Ks, const i32x8* qf, int r32, int hi) {
  p0 = f32x16{}; p1 = f32x16{};
  const int sw = (r32 >> 2) & 3; const char* k0 = Ks + r32 * 192; const char* k1 = k0 + 32 * 192;
#pragma unroll
  for (int m = 0; m < 3; ++m) { const int c0 = ((4 * m + 2 * hi) ^ sw) << 4, c1 = ((4 * m + 2 * hi + 1) ^ sw) << 4;
    p0 = mma(ld32(k0 + c0, k0 + c1), qf[m], p0);
    p1 = mma(ld32(k1 + c0, k1 + c1), qf[m], p1); }
}
DEVI void pv(f32x16* o, const char* Vs, const i32x8& pa, int r32, int hi) {
  const int sw = (r32 >> 2) & 3, c0 = ((2 * hi) ^ sw) << 4, c1 = ((2 * hi + 1) ^ sw) << 4;
#pragma unroll
  for (int db = 0; db < 4; ++db) { const char* vr = Vs + (32 * db + r32) * 64; o[db] = mma(pa, ld32(vr + c0, vr + c1), o[db]); }
}
DEVI void attn_item(bf16_t* __restrict__ Qb, const unsigned char* __restrict__ Kg, const unsigned char* __restrict__ Vg, const float* __restrict__ rope, int pos0, char* lds) {
  const int tid = threadIdx.x, wid = tid >> 6, lane = tid & 63, r32 = lane & 31, hi = lane >> 5;
  char* V_lds = lds; char* K_lds = lds + 3 * SHM_V;
  float* wsl = (float*)(lds + 3 * SHM_V + 2 * SHM_K) + wid * 64; float* li_l = wsl; float* al_l = wsl + 32;
  float m_reg = -1e30f, l_reg = 0; f32x16 o[4] = {}; i32x8 qf[3];
  { const bf16_t* Qw = Qb + (size_t)(wid * 32 + r32) * 1536 + hi * 32;
#pragma unroll
    for (int m = 0; m < 3; ++m) { float x[32];
#pragma unroll
      for (int q = 0; q < 4; ++q) unpack8(*(const u32x4*)(Qw + m * 64 + q * 8), x + q * 8);
      if (m == 2) { const int pos = pos0 + wid * 32 + r32, pp = hi ? (pos & 63) : (pos >> 6); const float* cs = rope + pp * 32;
#pragma unroll
        for (int j = 0; j < 16; ++j) { const float c = cs[j * 2], sn = cs[j * 2 + 1], x1 = x[j], x2 = x[16 + j]; x[j] = x1 * c - x2 * sn; x[16 + j] = x1 * sn + x2 * c; } }
#pragma unroll
      for (int q = 0; q < 8; ++q) qf[m][q] = pk4_fp8(x[q * 4], x[q * 4 + 1], x[q * 4 + 2], x[q * 4 + 3]);
      __builtin_amdgcn_sched_barrier(0); } }
  const int kp0 = wid * 64 + lane, kkey0 = kp0 / 12, kc0 = kp0 - kkey0 * 12, kp1 = kp0 + 512, kkey1 = kp1 / 12, kc1 = kp1 - kkey1 * 12;
  const unsigned koff0 = (unsigned)(kkey0 * 192 + ((kc0 ^ ((kkey0 >> 2) & 3)) << 4)), koff1 = (unsigned)(kkey1 * 192 + ((kc1 ^ ((kkey1 >> 2) & 3)) << 4));
  const int vd = kp0 >> 2, vc = kp0 & 3; const unsigned voff = (unsigned)(vd * NKEY + ((vc ^ ((vd >> 2) & 3)) << 4));
  const bool two = __builtin_amdgcn_readfirstlane(wid) < 4;
#define GSTAGE(t, kb, vb) do { const unsigned char* ks = Kg + (size_t)(t) * SHM_K; const unsigned char* vs = Vg + (t) * KVBLK; \
    __builtin_amdgcn_global_load_lds((const unsigned*)(ks + koff0), (unsigned*)(K_lds + (kb) * SHM_K + wid * 1024), 16, 0, 0); \
    if (two) __builtin_amdgcn_global_load_lds((const unsigned*)(ks + koff1), (unsigned*)(K_lds + (kb) * SHM_K + 8192 + wid * 1024), 16, 0, 0); \
    __builtin_amdgcn_global_load_lds((const unsigned*)(vs + voff), (unsigned*)(V_lds + (vb) + wid * 1024), 16, 0, 0); } while (0)
#define SWAIT() asm volatile("s_waitcnt vmcnt(0)" ::: "memory")
#define SBAR() __builtin_amdgcn_sched_barrier(0)
#define RESC(a) do { if (__any((a) < 1.f)) { if (hi == 0) al_l[r32] = (a); asm volatile("s_waitcnt lgkmcnt(0)" ::: "memory"); \
    _Pragma("unroll") for (int d = 0; d < 4; ++d) _Pragma("unroll") for (int r = 0; r < 16; ++r) o[d][r] *= al_l[crow(r, hi)]; } } while (0)
  f32x16 pA0, pA1, pB0, pB1; float mnA, mnB, alA, alB; i32x8 pa; constexpr int NT = NKEY / KVBLK;
  int v0 = 0, v1 = SHM_V, v2 = 2 * SHM_V;
  GSTAGE(0, 0, v0); SWAIT(); __syncthreads();
  qkt(pA0, pA1, K_lds, qf, r32, hi); partialSM(pA0, pA1, m_reg, mnA, alA);
  GSTAGE(1, 1, v1); SWAIT(); __syncthreads();
  for (int j = 1; j + 1 < NT; j += 2) {
    SBAR(); qkt(pB0, pB1, K_lds + SHM_K, qf, r32, hi);
    finishSM(pA0, pA1, alA, l_reg, pa); SBAR();
    GSTAGE(j + 1, 0, v2); SBAR();
    pv(o, V_lds + v0, pa, r32, hi); partialSM(pB0, pB1, m_reg, mnB, alB);
    SWAIT(); __syncthreads();
    RESC(alB);
    SBAR(); qkt(pA0, pA1, K_lds, qf, r32, hi);
    finishSM(pB0, pB1, alB, l_reg, pa); SBAR();
    GSTAGE(j + 2, 1, v0); SBAR();
    pv(o, V_lds + v1, pa, r32, hi); partialSM(pA0, pA1, m_reg, mnA, alA);
    SWAIT(); __syncthreads();
    RESC(alA);
    { const int t = v0; v0 = v2; v2 = v1; v1 = t; }
  }
  SBAR(); qkt(pB0, pB1, K_lds + SHM_K, qf, r32, hi);
  finishSM(pA0, pA1, alA, l_reg, pa); SBAR();
  pv(o, V_lds + v0, pa, r32, hi); partialSM(pB0, pB1, m_reg, mnB, alB);
  RESC(alB);
  finishSM(pB0, pB1, alB, l_reg, pa); SBAR();
  pv(o, V_lds + v1, pa, r32, hi);
  if (hi == 0) li_l[r32] = l_reg; asm volatile("s_waitcnt lgkmcnt(0)" ::: "memory");
  float rli[16];
#pragma unroll
  for (int r = 0; r < 16; ++r) rli[r] = __builtin_amdgcn_rcpf(li_l[crow(r, hi)]);
  bf16_t* Ow = Qb + (size_t)(wid * 32) * 1536;
#pragma unroll
  for (int r = 0; r < 16; ++r) { const int orow = crow(r, hi);
#pragma unroll
    for (int d0 = 0; d0 < 4; ++d0) Ow[(size_t)orow * 1536 + d0 * 32 + r32] = f2bf(o[d0][r] * rli[r]); }
  __syncthreads();
#undef GSTAGE
#undef SWAIT
#undef SBAR
#undef RESC
}
}
DEVI void attn_fp8(const Params& p, char* smem) {
  bf16_t* Q = (bf16_t*)(p.ws + O_RQ); const unsigned char* K8 = (const unsigned char*)(p.ws + O_K8); const unsigned char* V8 = (const unsigned char*)(p.ws + O_V8T);
  const float* rope = (const float*)(p.ws + O_ROPE);
  for (int it = blockIdx.x; it < NB * 8 * (SEQ / 256); it += gridDim.x) {
    const int bh = (it >> 8) * 8 + (it & 7), qb = (it & 255) >> 3, b = bh >> 3, h = bh & 7;
    a8::attn_item(Q + (size_t)(b * SEQ + qb * 256) * 1536 + h * 192, K8 + (size_t)bh * NKEY * 192, V8 + (size_t)bh * 128 * NKEY, rope, qb * 256, smem);
  }
}
#if ATTN_FP8
DEVI void ph_attn(const Params& p, char* smem) { attn_fp8(p, smem); }
#elif ATTN_MFMA
DEVI void ph_attn(const Params& p, char* smem) { attn_mfma(p, smem); }
#else
DEVI void ph_attn(const Params& p, char* smem) { attn_naive(p, smem); }
#endif

DEVI void ph_rows(const Params& p, char* smem) {
  const int tid = threadIdx.x, wave = tid >> 6, lane = tid & 63;
  const float* MOD = (const float*)(p.ws + O_MOD); const bf16_t* Y = (const bf16_t*)(p.ws + O_RA); const float* rssy = (const float*)(p.ws + O_RSSY);
  bf16_t* HX2 = (bf16_t*)(p.ws + O_RB);
  for (int row = blockIdx.x * NWAVE + wave; row < NTOK; row += gridDim.x * NWAVE) {
    const int b = row >> 13; const float* md = MOD + b * 6144;
    float ty = 0.f; { const float* pr = rssy + (size_t)row * 16;
#pragma unroll
      for (int j = 0; j < 16; ++j) ty += pr[j]; }
    const float ry = rsqrtf(ty * (1.f / 1024.f) + EPS);
    float x1[16]; float ss = 0.f;
#pragma unroll
    for (int i = 0; i < 4; ++i) { const int c = i * 256 + lane * 4; const float4 xv = *(const float4*)(p.x + (size_t)row * 1024 + c); const u32x2 yv = *(const u32x2*)(Y + (size_t)row * 1024 + c);
      const float4 gp = *(const float4*)(p.g_post1 + c), gt = *(const float4*)(md + 2048 + c);
      x1[i * 4 + 0] = xv.x + gt.x * (lo2f(yv[0]) * ry * gp.x); x1[i * 4 + 1] = xv.y + gt.y * (hi2f(yv[0]) * ry * gp.y);
      x1[i * 4 + 2] = xv.z + gt.z * (lo2f(yv[1]) * ry * gp.z); x1[i * 4 + 3] = xv.w + gt.w * (hi2f(yv[1]) * ry * gp.w);
#pragma unroll
      for (int j = 0; j < 4; ++j) ss += x1[i * 4 + j] * x1[i * 4 + j];
      *(float4*)(p.out + (size_t)row * 1024 + c) = make_float4(x1[i * 4], x1[i * 4 + 1], x1[i * 4 + 2], x1[i * 4 + 3]); }
    ss = wave_sum(ss); const float r2 = rsqrtf(ss * (1.f / 1024.f) + EPS);
#pragma unroll
    for (int i = 0; i < 4; ++i) { const int c = i * 256 + lane * 4; const float4 g2 = *(const float4*)(p.g_pre2 + c), sc = *(const float4*)(md + 4096 + c), sh = *(const float4*)(md + 3072 + c);
      st4bf(HX2 + (size_t)row * 1024 + c, x1[i * 4] * r2 * g2.x * (1.f + sc.x) + sh.x, x1[i * 4 + 1] * r2 * g2.y * (1.f + sc.y) + sh.y,
            x1[i * 4 + 2] * r2 * g2.z * (1.f + sc.z) + sh.z, x1[i * 4 + 3] * r2 * g2.w * (1.f + sc.w) + sh.w); }
  }
  convert_table_fp8(p.u_exp, (unsigned char*)(p.ws + O_RC), (float*)(p.ws + O_RC + (size_t)16384 * 1024));
}

DEVI void topk_naive(const Params& p, char* smem) {
  const int tid = threadIdx.x, wave = tid >> 6, lane = tid & 63;
  float* wl = (float*)smem + wave * 512; int* wi = (int*)wl;
  const bf16_t* QP = (const bf16_t*)(p.ws + O_RKV); const bf16_t* K1 = (const bf16_t*)(p.ws + O_K1); const bf16_t* K2 = (const bf16_t*)(p.ws + O_K2);
  int* IDX = (int*)(p.ws + O_RQ); float* GW = (float*)(p.ws + O_RQ + (size_t)NTOK * 128 * 4);
  for (int base = blockIdx.x * NWAVE; base < NTOK * 8; base += gridDim.x * NWAVE) {
    const int it = base + wave, token = it >> 3, h = it & 7;
    __syncthreads();
    const bf16_t* q = QP + (size_t)token * 2048 + h * 256;
    for (int d = lane; d < 256; d += 64) wl[d] = bf2f(q[d]);
    __syncthreads();
    float s[4] = {0.f, 0.f, 0.f, 0.f};
#pragma unroll 2
    for (int d8 = 0; d8 < 16; ++d8) {
      const float4 qa0 = *(const float4*)(wl + d8 * 8), qa1 = *(const float4*)(wl + d8 * 8 + 4), qb0 = *(const float4*)(wl + 128 + d8 * 8), qb1 = *(const float4*)(wl + 128 + d8 * 8 + 4);
#pragma unroll
      for (int w = 0; w < 4; ++w) { const int key = lane + (w & 1) * 64; const bf16_t* kp = (w < 2 ? K1 : K2) + key * 128;
        float kf[8]; unpack8(*(const u32x4*)(kp + d8 * 8), kf); const float4 q0 = w < 2 ? qa0 : qb0, q1 = w < 2 ? qa1 : qb1;
        s[w] += q0.x * kf[0] + q0.y * kf[1] + q0.z * kf[2] + q0.w * kf[3] + q1.x * kf[4] + q1.y * kf[5] + q1.z * kf[6] + q1.w * kf[7]; }
    }
#pragma unroll
    for (int half = 0; half < 2; ++half) { float a0 = s[half * 2], a1 = s[half * 2 + 1];
#pragma unroll 1
      for (int r = 0; r < 16; ++r) { float v; int i; if (a0 >= a1) { v = a0; i = lane; } else { v = a1; i = lane + 64; }
        for (int o = 32; o > 0; o >>= 1) { const float ov = __shfl_xor(v, o); const int oi = __shfl_xor(i, o); if (ov > v || (ov == v && oi < i)) { v = ov; i = oi; } }
        if (i == lane) a0 = -3.0e38f; else if (i == lane + 64) a1 = -3.0e38f;
        if (lane == 0) { wl[256 + half * 32 + r] = v; wi[256 + half * 32 + 16 + r] = i; } } }
    __syncthreads();
    float cv[4]; int ci[4];
#pragma unroll
    for (int j = 0; j < 4; ++j) { const int cidx = lane * 4 + j, i = cidx >> 4, jj = cidx & 15; cv[j] = wl[256 + i] + wl[256 + 32 + jj]; ci[j] = wi[256 + 16 + i] * 128 + wi[256 + 32 + 16 + jj]; }
    float myv = 0.f, vmax = 0.f; int myi = 0;
#pragma unroll 1
    for (int r = 0; r < 16; ++r) { float v = cv[0]; int pos = lane * 4, ei = ci[0];
#pragma unroll
      for (int j = 1; j < 4; ++j) if (cv[j] > v) { v = cv[j]; pos = lane * 4 + j; ei = ci[j]; }
      for (int o = 32; o > 0; o >>= 1) { const float ov = __shfl_xor(v, o); const int op = __shfl_xor(pos, o), oe = __shfl_xor(ei, o); if (ov > v || (ov == v && op < pos)) { v = ov; pos = op; ei = oe; } }
#pragma unroll
      for (int j = 0; j < 4; ++j) if (pos == lane * 4 + j) cv[j] = -3.0e38f;
      if (r == 0) vmax = v;
      if (lane == r) { myv = v; myi = ei; } }
    const float e = lane < 16 ? __expf(myv - vmax) : 0.f; const float sum = wave_sum(e);
    if (lane < 16) { IDX[(size_t)token * 128 + h * 16 + lane] = myi; GW[(size_t)token * 128 + h * 16 + lane] = e / sum; }
  }
}

namespace tk {
DEVI int f2sort(float f) { const int i = __float_as_int(f); return i ^ ((i >> 31) & 0x7fffffff); }
DEVI float sort2f(int s) { return __int_as_float(s ^ ((s >> 31) & 0x7fffffff)); }
DEVI void ce_desc(int& a, int& b) { const int hi = max(a, b), lo = min(a, b); a = hi; b = lo; }
DEVI void sort16_desc(int* a) {
#pragma unroll
  for (int lk = 1; lk <= 4; ++lk)
#pragma unroll
    for (int lj = lk - 1; lj >= 0; --lj)
#pragma unroll
      for (int i = 0; i < 16; ++i) { const int j = 1 << lj, k = 1 << lk, l = i ^ j;
        if (l > i) { const int hi = max(a[i], a[l]), lo = min(a[i], a[l]); if ((i & k) == 0) { a[i] = hi; a[l] = lo; } else { a[i] = lo; a[l] = hi; } } }
}
DEVI void bitonic_merge16_desc(int* a) {
#pragma unroll
  for (int lj = 3; lj >= 0; --lj)
#pragma unroll
    for (int i = 0; i < 16; ++i) { const int l = i ^ (1 << lj); if (l > i) ce_desc(a[i], a[l]); }
}
DEVI void merge_top16(int* a, const int* b) {
#pragma unroll
  for (int i = 0; i < 16; ++i) a[i] = max(a[i], b[15 - i]);
  bitonic_merge16_desc(a);
}
DEVI void half_top16(const bf16_t* __restrict__ qrow, const char* Kl, int r32, int hi, int* out) {
  bf16x8 qf[8];
#pragma unroll
  for (int d0 = 0; d0 < 8; ++d0) qf[d0] = *reinterpret_cast<const bf16x8*>(qrow + d0 * 16 + hi * 8);
  int a[64];
#pragma unroll
  for (int kt = 0; kt < 4; ++kt) { f32x16 acc = {};
    const int key = kt * 32 + r32;
#pragma unroll
    for (int d0 = 0; d0 < 8; ++d0) { const bf16x8 kf = *reinterpret_cast<const bf16x8*>(Kl + key * 256 + (((d0 * 2 + hi) ^ (key & 15)) << 4));
      acc = __builtin_amdgcn_mfma_f32_32x32x16_bf16(kf, qf[d0], acc, 0, 0, 0); }
#pragma unroll
    for (int r = 0; r < 16; ++r) { const int kidx = kt * 32 + (r & 3) + 8 * (r >> 2) + 4 * hi; a[kt * 16 + r] = (f2sort(acc[r]) & ~127) | (127 - kidx); } }
  sort16_desc(a); sort16_desc(a + 16); sort16_desc(a + 32); sort16_desc(a + 48);
  merge_top16(a, a + 16); merge_top16(a + 32, a + 48); merge_top16(a, a + 32);
  int L[16], H[16];
#pragma unroll
  for (int i = 0; i < 16; ++i) { auto rr = __builtin_amdgcn_permlane32_swap((unsigned)a[i], (unsigned)a[i], false, false); L[i] = (int)rr[0]; H[i] = (int)rr[1]; }
  merge_top16(L, H);
#pragma unroll
  for (int i = 0; i < 16; ++i) out[i] = L[i];
}
}
DEVI void topk_fast(const Params& p, char* smem) {
  const int tid = threadIdx.x, wave = tid >> 6, lane = tid & 63, r32 = lane & 31, hi = lane >> 5;
  const bf16_t* QP = (const bf16_t*)(p.ws + O_RKV);
  int* IDX = (int*)(p.ws + O_RQ); float* GW = (float*)(p.ws + O_RQ + (size_t)NTOK * 128 * 4);
  char* K1l = smem; char* K2l = smem + 32768; int* tab = (int*)(smem + 65536) + wave * (32 * 33);
  __syncthreads();
  { const bf16_t* K1 = (const bf16_t*)(p.ws + O_K1);
    for (int id = tid; id < 4096; id += NTHR) { const int key = id >> 4, c = id & 15; const u32x4 v = *(const u32x4*)(K1 + (size_t)key * 128 + c * 8);
      *(u32x4*)(smem + key * 256 + ((c ^ (key & 15)) << 4)) = v; } }
  __syncthreads();
  for (int item = blockIdx.x; item < NTOK * 8 / 256; item += gridDim.x) {
    const int row = item * 256 + wave * 32 + r32;
    const bf16_t* qrow = QP + (size_t)row * 256;
    int t1[16], t2[16];
    tk::half_top16(qrow, K1l, r32, hi, t1);
    tk::half_top16(qrow + 128, K2l, r32, hi, t2);
    float v1[16], v2[16];
#pragma unroll
    for (int i = 0; i < 16; ++i) { v1[i] = tk::sort2f(t1[i] & ~127); v2[i] = tk::sort2f(t2[i] & ~127); }
    if (hi == 0) {
#pragma unroll
      for (int i = 0; i < 16; ++i) { tab[r32 * 33 + i] = 127 - (t1[i] & 127); tab[r32 * 33 + 16 + i] = 127 - (t2[i] & 127); } }
#define CAND(i, j) ((tk::f2sort(v1[i] + v2[j]) & ~255) | (255 - ((i) * 16 + (j))))
    int g0[16], g1[16], g2[16];
#pragma unroll
    for (int j = 0; j < 16; ++j) g0[j] = CAND(0, j);
#pragma unroll
    for (int j = 0; j < 8; ++j) g1[j] = CAND(1, j);
#pragma unroll
    for (int j = 0; j < 5; ++j) g1[8 + j] = CAND(2, j);
#pragma unroll
    for (int j = 0; j < 3; ++j) g1[13 + j] = CAND(4, j);
#pragma unroll
    for (int j = 0; j < 4; ++j) g2[j] = CAND(3, j);
    g2[4] = CAND(5, 0); g2[5] = CAND(5, 1); g2[6] = CAND(6, 0); g2[7] = CAND(6, 1); g2[8] = CAND(7, 0); g2[9] = CAND(7, 1);
    g2[10] = CAND(8, 0); g2[11] = CAND(9, 0); g2[12] = CAND(10, 0); g2[13] = CAND(11, 0); g2[14] = CAND(12, 0); g2[15] = CAND(13, 0);
    tk::sort16_desc(g1); tk::sort16_desc(g2);
    tk::merge_top16(g0, g1); tk::merge_top16(g0, g2);
    { int x = CAND(14, 0);
#pragma unroll
      for (int i = 0; i < 16; ++i) { const int h = max(g0[i], x); x = min(g0[i], x); g0[i] = h; }
      x = CAND(15, 0);
#pragma unroll
      for (int i = 0; i < 16; ++i) { const int h = max(g0[i], x); x = min(g0[i], x); g0[i] = h; } }
#undef CAND
    asm volatile("s_waitcnt lgkmcnt(0)" ::: "memory");
    if (hi == 0) {
      int ex[16];
#pragma unroll
      for (int k = 0; k < 16; ++k) { const int pos = 255 - (g0[k] & 255); ex[k] = tab[r32 * 33 + (pos >> 4)] * 128 + tab[r32 * 33 + 16 + (pos & 15)]; }
      int* dst = IDX + (size_t)row * 16;
#pragma unroll
      for (int q = 0; q < 4; ++q) *(int4*)(dst + q * 4) = make_int4(ex[q * 4], ex[q * 4 + 1], ex[q * 4 + 2], ex[q * 4 + 3]);
    } else {
      float e[16]; const float vmax = tk::sort2f(g0[0] & ~255); float sum = 0.f;
#pragma unroll
      for (int k = 0; k < 16; ++k) { e[k] = __expf(tk::sort2f(g0[k] & ~255) - vmax); sum += e[k]; }
      const float inv = 1.f / sum; float* dst = GW + (size_t)row * 16;
#pragma unroll
      for (int q = 0; q < 4; ++q) *(float4*)(dst + q * 4) = make_float4(e[q * 4] * inv, e[q * 4 + 1] * inv, e[q * 4 + 2] * inv, e[q * 4 + 3] * inv);
    }
  }
}
#if TOPK_FAST
DEVI void ph_topk(const Params& p, char* smem) { topk_fast(p, smem); }
#else
DEVI void ph_topk(const Params& p, char* smem) { topk_naive(p, smem); }
#endif

DEVI float wave_sum_dpp(float v) {
  v += __builtin_bit_cast(float, __builtin_amdgcn_update_dpp(0, __builtin_bit_cast(int, v), 0xB1, 0xf, 0xf, true));
  v += __builtin_bit_cast(float, __builtin_amdgcn_update_dpp(0, __builtin_bit_cast(int, v), 0x4E, 0xf, 0xf, true));
  v += __builtin_bit_cast(float, __builtin_amdgcn_update_dpp(0, __builtin_bit_cast(int, v), 0x141, 0xf, 0xf, true));
  v += __builtin_bit_cast(float, __builtin_amdgcn_update_dpp(0, __builtin_bit_cast(int, v), 0x140, 0xf, 0xf, true));
  const int iv = __builtin_bit_cast(int, v);
  return (__builtin_bit_cast(float, __builtin_amdgcn_readlane(iv, 0)) + __builtin_bit_cast(float, __builtin_amdgcn_readlane(iv, 16))) +
         (__builtin_bit_cast(float, __builtin_amdgcn_readlane(iv, 32)) + __builtin_bit_cast(float, __builtin_amdgcn_readlane(iv, 48)));
}
DEVI void fp8x16_to_f32(const u32x4& w, float* f) {
#pragma unroll
  for (int j = 0; j < 4; ++j) { const f32x2_t a = __builtin_amdgcn_cvt_pk_f32_fp8((int)w[j], false), b = __builtin_amdgcn_cvt_pk_f32_fp8((int)w[j], true);
    f[j * 4] = a[0]; f[j * 4 + 1] = a[1]; f[j * 4 + 2] = b[0]; f[j * 4 + 3] = b[1]; }
}
DEVI void ph_gather(const Params& p, char* smem) {
  const int tid = threadIdx.x, wave = tid >> 6, lane = tid & 63;
  const bf16_t* HX2 = (const bf16_t*)(p.ws + O_RB);
  const unsigned char* UT = (const unsigned char*)(p.ws + O_RC); const float* SU = (const float*)(p.ws + O_RC + (size_t)16384 * 1024);
  const unsigned char* VT = (const unsigned char*)(p.ws + O_RA); const float* SV = (const float*)(p.ws + O_RA + (size_t)16384 * 1024);
  const int* IDX = (const int*)(p.ws + O_RQ); const float* GW = (const float*)(p.ws + O_RQ + (size_t)NTOK * 128 * 4);
  const float* MOD = (const float*)(p.ws + O_MOD);
  for (int t = blockIdx.x * NWAVE + wave; t < NTOK; t += gridDim.x * NWAVE) {
    float xf[16];
    unpack8(*(const u32x4*)(HX2 + (size_t)t * 1024 + lane * 16), xf); unpack8(*(const u32x4*)(HX2 + (size_t)t * 1024 + lane * 16 + 8), xf + 8);
    float acc[16];
#pragma unroll
    for (int j = 0; j < 16; ++j) acc[j] = 0.f;
#pragma unroll 1
    for (int half = 0; half < 2; ++half) {
      const int my_i = IDX[(size_t)t * 128 + half * 64 + lane]; const float my_g = GW[(size_t)t * 128 + half * 64 + lane];
      const float my_su = SU[my_i], my_sv = SV[my_i];
#pragma unroll 1
      for (int e0 = 0; e0 < 64; e0 += 8) {
        u32x4 uq[8], vq[8]; float cs[8];
#pragma unroll
        for (int j = 0; j < 8; ++j) { const int id = __builtin_amdgcn_readlane(my_i, e0 + j);
          uq[j] = *(const u32x4*)(UT + (size_t)id * 1024 + lane * 16); vq[j] = *(const u32x4*)(VT + (size_t)id * 1024 + lane * 16); }
#pragma unroll
        for (int j = 0; j < 8; ++j) { float uf[16]; fp8x16_to_f32(uq[j], uf); float d = 0.f;
#pragma unroll
          for (int k = 0; k < 16; ++k) d += xf[k] * uf[k];
          cs[j] = d; }
#pragma unroll
        for (int j = 0; j < 8; ++j) { const float d = wave_sum_dpp(cs[j]);
          const float g = __builtin_bit_cast(float, __builtin_amdgcn_readlane(__builtin_bit_cast(int, my_g), e0 + j));
          const float su = __builtin_bit_cast(float, __builtin_amdgcn_readlane(__builtin_bit_cast(int, my_su), e0 + j));
          const float sv = __builtin_bit_cast(float, __builtin_amdgcn_readlane(__builtin_bit_cast(int, my_sv), e0 + j));
          cs[j] = g * gelu_t(d * su) * sv; }
#pragma unroll
        for (int j = 0; j < 8; ++j) { float vf[16]; fp8x16_to_f32(vq[j], vf);
#pragma unroll
          for (int k = 0; k < 16; ++k) acc[k] += cs[j] * vf[k]; }
      }
    }
    float ss = 0.f;
#pragma unroll
    for (int k = 0; k < 16; ++k) ss += acc[k] * acc[k];
    ss = wave_sum(ss); const float rstd = rsqrtf(ss * (1.f / 1024.f) + EPS);
    const int b = t >> 13; const float* gt2 = MOD + b * 6144 + 5120;
    float* op = p.out + (size_t)t * 1024 + lane * 16;
#pragma unroll
    for (int q4 = 0; q4 < 4; ++q4) { float4 xv = *(const float4*)(op + q4 * 4); const float4 gt = *(const float4*)(gt2 + lane * 16 + q4 * 4), gp = *(const float4*)(p.g_post2 + lane * 16 + q4 * 4);
      xv.x += gt.x * (acc[q4 * 4 + 0] * rstd * gp.x); xv.y += gt.y * (acc[q4 * 4 + 1] * rstd * gp.y);
      xv.z += gt.z * (acc[q4 * 4 + 2] * rstd * gp.z); xv.w += gt.w * (acc[q4 * 4 + 3] * rstd * gp.w);
      *(float4*)(op + q4 * 4) = xv; }
  }
}

#define XB_TMO      128
#define XB_XCNT(j)  (256  + 64 * (j))
#define XB_XSUB(j)  (1280 + 64 * (j))
#define XB_XGEN(j)  (2304 + 64 * (j))
#define XB_TOP      3328
#define XB_TOPGEN   3392
#define XCD_BAR_WORDS 3456
#define XB_SPIN_CAP (1u << 18)
#define LAS __attribute__((address_space(3)))
DEVI unsigned xb_ld(unsigned* p)              { return __hip_atomic_load(p, __ATOMIC_RELAXED, __HIP_MEMORY_SCOPE_AGENT); }
DEVI unsigned xb_add(unsigned* p, unsigned v) { return __hip_atomic_fetch_add(p, v, __ATOMIC_RELAXED, __HIP_MEMORY_SCOPE_AGENT); }
DEVI unsigned xb_xcc_id() { return (unsigned)__builtin_amdgcn_s_getreg((3 << 11) | 20) & 0xFu; }
#define XB_SPIN(cond, bar) do { unsigned _sp = 0; while (cond) { __builtin_amdgcn_s_sleep(1); \
    if ((++_sp & 255u) == 0u) { if (xb_ld(&(bar)[XB_TMO])) break; if (_sp > XB_SPIN_CAP) { atomicAdd(&(bar)[XB_TMO], 1u); break; } } } } while (0)
struct XcdBarrier { unsigned* bar; unsigned x; volatile LAS unsigned* st; };
DEVI XcdBarrier xcd_barrier_post(unsigned* bar, volatile LAS unsigned* st) {
  XcdBarrier b; b.bar = bar; b.x = xb_xcc_id(); b.st = st;
  if (threadIdx.x == 0) (void)xb_add(&bar[XB_XCNT(b.x)], 1u);
  return b;
}
DEVI void xcd_barrier_complete(unsigned* bar, unsigned x, unsigned& nloc, unsigned& nx) {
  const unsigned G = gridDim.x * gridDim.y * gridDim.z;
  unsigned sum, cnt, mine, sp = 0u;
  for (;;) {
    sum = 0u; cnt = 0u; mine = 0u;
#pragma unroll
    for (unsigned j = 0; j < 16; ++j) { const unsigned c = xb_ld(&bar[XB_XCNT(j)]); sum += c; cnt += (c > 0u) ? 1u : 0u; mine = (j == x) ? c : mine; }
    if (sum == G) break;
    __builtin_amdgcn_s_sleep(1);
    if ((++sp & 255u) == 0u) { if (xb_ld(&bar[XB_TMO])) break; if (sp > XB_SPIN_CAP) { atomicAdd(&bar[XB_TMO], 1u); break; } }
  }
  nloc = mine > 0u ? mine : 1u; nx = cnt > 0u ? cnt : 1u;
}
DEVI void xcd_barrier(const XcdBarrier& b) {
  asm volatile("s_waitcnt vmcnt(0)" ::: "memory");
  __syncthreads();
  if (threadIdx.x == 0) {
    unsigned* bar = b.bar;
    __builtin_amdgcn_s_waitcnt(0);
    unsigned nloc = b.st[0], nx = b.st[1];
    if (nloc == 0u) { xcd_barrier_complete(bar, b.x, nloc, nx); b.st[0] = nloc; b.st[1] = nx; }
    const unsigned old = xb_add(&bar[XB_XSUB(b.x)], 1u);
    const unsigned gen = old / nloc;
    if (old + 1u == (gen + 1u) * nloc) {
      __builtin_amdgcn_fence(__ATOMIC_RELEASE, "agent");
      asm volatile("s_waitcnt vmcnt(0)" ::: "memory");
      const unsigned og = xb_add(&bar[XB_TOP], 1u);
      const unsigned tg = og / nx;
      if (og + 1u == (tg + 1u) * nx) xb_add(&bar[XB_TOPGEN], 1u);
      else XB_SPIN(xb_ld(&bar[XB_TOPGEN]) == tg, bar);
      __builtin_amdgcn_fence(__ATOMIC_ACQUIRE, "agent");
      xb_add(&bar[XB_XGEN(b.x)], 1u);
      asm volatile("s_waitcnt vmcnt(0)" ::: "memory");
    } else {
      XB_SPIN(xb_ld(&bar[XB_XGEN(b.x)]) == gen, bar);
      __builtin_amdgcn_fence(__ATOMIC_ACQUIRE, "agent");
      asm volatile("s_waitcnt vmcnt(0)" ::: "memory");
    }
  }
  __syncthreads();
}

constexpr int NPHASE = 12;
template <int PH> DEVI void run_phase(const Params& p, char* smem) {
  if constexpr (PH == 0) ph_prep(p, smem);
  else if constexpr (PH == 1) ph_hx(p, smem);
  else if constexpr (PH == 2) ph_inproj(p, smem);
  else if constexpr (PH == 3) ph_mid(p, smem);
  else if constexpr (PH == 4) ph_attn(p, smem);
  else if constexpr (PH == 5) ph_gates(p, smem);
  else if constexpr (PH == 6) ph_merge(p, smem);
  else if constexpr (PH == 7) ph_wo(p, smem);
  else if constexpr (PH == 8) ph_rows(p, smem);
  else if constexpr (PH == 9) ph_wpq(p, smem);
  else if constexpr (PH == 10) ph_topk(p, smem);
  else if constexpr (PH == 11) ph_gather(p, smem);
}

template <int PH> __global__ __launch_bounds__(NTHR) void k_phase(Params p) {
  extern __shared__ __attribute__((aligned(16))) char smem[];
  run_phase<PH>(p, smem);
}

#ifndef PROBE_PH
#define PROBE_PH -1
#endif
#if MEGA
#define RUNPH(N) do { if (PROBE_PH == N) t0 = __builtin_amdgcn_s_memrealtime(); run_phase<N>(p, smem); if (N < NPHASE - 1) xcd_barrier(xb); \
    if (PROBE_PH == N) t1 = __builtin_amdgcn_s_memrealtime(); } while (0)
__global__ __launch_bounds__(NTHR) void k_mega(Params p) {
  extern __shared__ __attribute__((aligned(16))) char smem[];
  cg::grid_group grid = cg::this_grid();
  unsigned long long t0 = 0, t1 = 0;
  unsigned* bar = (unsigned*)(p.ws + O_BAR);
  volatile LAS unsigned* xst = (volatile LAS unsigned*)(smem + LDS_BYTES - 16);
  if (threadIdx.x == 0) { xst[0] = 0u; xst[1] = 0u; }
  if (blockIdx.x == 0) for (int i = threadIdx.x; i < XCD_BAR_WORDS; i += NTHR) bar[i] = 0u;
  if (PROBE_PH == 0) t0 = __builtin_amdgcn_s_memrealtime();
  run_phase<0>(p, smem);
  grid.sync();
  if (PROBE_PH == 0) t1 = __builtin_amdgcn_s_memrealtime();
  const XcdBarrier xb = xcd_barrier_post(bar, xst);
  RUNPH(1); RUNPH(2); RUNPH(3); RUNPH(4); RUNPH(5); RUNPH(6); RUNPH(7); RUNPH(8); RUNPH(9); RUNPH(10); RUNPH(11);
  if (PROBE_PH >= 0) { __syncthreads(); if (blockIdx.x == 0 && threadIdx.x == 0) p.out[0] += exp2f(rintf(log2f((float)(t1 - t0) * 1e-3f) * 5.f) * 0.2f); }
}
#endif

template <int PH> static void launch_phase(const Params& p, int grid, hipStream_t stream) {
  hipLaunchKernelGGL(k_phase<PH>, dim3(grid), dim3(NTHR), LDS_BYTES, stream, p);
}
template <int PH> static void set_attr() { (void)hipFuncSetAttribute((const void*)k_phase<PH>, hipFuncAttributeMaxDynamicSharedMemorySize, LDS_BYTES); }

extern "C" void kernel_launch(void* const* d_in, const int* in_sizes, int n_in, void* d_out, int out_size, void* d_ws, size_t ws_size, hipStream_t stream) {
  static int grid = 0;
  if (grid == 0) {
    if (n_in != 26 || out_size != NTOK * DM || ws_size < O_END) { fprintf(stderr, "kernel_launch: unexpected shapes n_in %d out %d ws %zu (need %zu)\n", n_in, out_size, ws_size, (size_t)O_END); grid = -1; return; }
#if MEGA
    (void)hipFuncSetAttribute((const void*)k_mega, hipFuncAttributeMaxDynamicSharedMemorySize, LDS_BYTES);
    int dev = 0, cus = 0, per_cu = 0; (void)hipGetDevice(&dev); (void)hipDeviceGetAttribute(&cus, hipDeviceAttributeMultiprocessorCount, dev);
    (void)hipOccupancyMaxActiveBlocksPerMultiprocessor(&per_cu, (const void*)k_mega, NTHR, LDS_BYTES);
    if (per_cu < 1) { fprintf(stderr, "kernel_launch: occupancy query says %d blocks per CU\n", per_cu); grid = -1; return; }
    grid = cus;
#else
    set_attr<0>(); set_attr<1>(); set_attr<2>(); set_attr<3>(); set_attr<4>(); set_attr<5>(); set_attr<6>(); set_attr<7>(); set_attr<8>(); set_attr<9>(); set_attr<10>(); set_attr<11>();
    grid = 256;
#endif
  }
  if (grid < 0) return;
  Params p{};
  const float** pp = (const float**)&p;
  for (int i = 0; i < 26; ++i) pp[i] = (const float*)d_in[i];
  p.out = (float*)d_out; p.ws = (char*)d_ws;
#if MEGA
  void* args[] = {&p};
  hipError_t e = hipLaunchCooperativeKernel((const void*)k_mega, dim3(grid), dim3(NTHR), args, LDS_BYTES, stream);
  if (e != hipSuccess) fprintf(stderr, "cooperative launch failed: %s (grid %d)\n", hipGetErrorString(e), grid);
#else
  launch_phase<0>(p, grid, stream); launch_phase<1>(p, grid, stream); launch_phase<2>(p, grid, stream); launch_phase<3>(p, grid, stream);
  launch_phase<4>(p, grid, stream); launch_phase<5>(p, grid, stream); launch_phase<6>(p, grid, stream); launch_phase<7>(p, grid, stream);
  launch_phase<8>(p, grid, stream); launch_phase<9>(p, grid, stream); launch_phase<10>(p, grid, stream); launch_phase<11>(p, grid, stream);
#endif
}
```

```cpp
#include <hip/hip_runtime.h>
#include <hip/hip_cooperative_groups.h>
#include <cstdint>
#include <cstdio>
namespace cg = cooperative_groups;

#ifndef MEGA
#define MEGA 1
#endif
#ifndef GEMM_MFMA
#define GEMM_MFMA 1
#endif
#ifndef ATTN_MFMA
#define ATTN_MFMA 1
#endif
#ifndef GEMM_8PH
#define GEMM_8PH 1
#endif
#ifndef GEMM_KS_SBAR
#define GEMM_KS_SBAR 0
#endif
#ifndef ATTN_FP8
#define ATTN_FP8 1
#endif
#ifndef TOPK_FAST
#define TOPK_FAST 1
#endif

#define DEVI __device__ __forceinline__
typedef unsigned short bf16_t;
using bf16x8 = __attribute__((ext_vector_type(8))) short;
using bf16x4 = __attribute__((ext_vector_type(4))) short;
using f32x4  = __attribute__((ext_vector_type(4))) float;
using f32x16 = __attribute__((ext_vector_type(16))) float;
using u32x4  = __attribute__((ext_vector_type(4))) unsigned;
using u32x2  = __attribute__((ext_vector_type(2))) unsigned;

constexpr int DM = 1024, NB = 2, SEQ = 8192, NTOK = NB * SEQ, CTXL = 256, NCTX = NB * CTXL, NROW = NTOK + NCTX, NKEY = SEQ + CTXL;
constexpr int INW = 4544, INWP = 4608;
constexpr int NPRE = 2560;
constexpr float EPS = 1e-6f;
constexpr int NTHR = 512, NWAVE = 8;
constexpr int LDS_BYTES = 147456;

constexpr size_t al256(size_t x) { return (x + 255) / 256 * 256; }
constexpr size_t O_WIN   = 0;
constexpr size_t O_WUQ   = O_WIN  + al256((size_t)INWP * 1024 * 2);
constexpr size_t O_WUKV  = O_WUQ  + al256((size_t)1536 * 256 * 2);
constexpr size_t O_WPA   = O_WUKV + al256((size_t)2048 * 128 * 2);
constexpr size_t O_WPB   = O_WPA  + al256((size_t)1024 * 1024 * 2);
constexpr size_t O_WO    = O_WPB  + al256((size_t)1024 * 1024 * 2);
constexpr size_t O_WPQ   = O_WO   + al256((size_t)1024 * 1024 * 2);
constexpr size_t O_WS    = O_WPQ  + al256((size_t)2048 * 1024 * 2);
constexpr size_t O_K1    = O_WS   + al256((size_t)8 * 128 * 128 * 2);
constexpr size_t O_K2    = O_K1   + al256((size_t)128 * 128 * 2);
constexpr size_t O_MOD   = O_K2   + al256((size_t)128 * 128 * 2);
constexpr size_t O_ROPE  = O_MOD  + al256((size_t)3 * 6144 * 4);
constexpr size_t O_BAR   = O_ROPE + al256((size_t)128 * 16 * 2 * 4);
constexpr size_t O_RSSV  = O_BAR + al256((size_t)3456 * 4);
constexpr size_t O_RSSQ  = O_RSSV + (size_t)NTOK * 32 * 4;
constexpr size_t O_RSSKV = O_RSSQ + (size_t)NTOK * 8 * 4;
constexpr size_t O_RSSY  = O_RSSKV + (size_t)NROW * 4 * 4;
constexpr size_t O_RSSEND = O_RSSY + (size_t)NTOK * 32 * 4;
constexpr size_t O_RA    = al256(O_RSSEND);
constexpr size_t O_RB    = O_RA  + al256((size_t)NROW * 1024 * 2);
constexpr size_t O_RC    = O_RB  + al256((size_t)NTOK * 1024 * 2);
constexpr size_t O_CQ    = O_RC  + al256((size_t)NTOK * 1024 * 2);
constexpr size_t O_CKV   = O_CQ  + al256((size_t)NTOK * 256 * 2);
constexpr size_t O_KR    = O_CKV + al256((size_t)NROW * 128 * 2);
constexpr size_t O_RQ    = O_KR  + al256((size_t)NROW * 64 * 2);
constexpr size_t O_RKV   = O_RQ  + al256((size_t)NTOK * 1536 * 2);
constexpr size_t O_END   = O_RKV + al256((size_t)NROW * 2048 * 2);
static_assert(O_END <= (size_t)258 * 1024 * 1024, "workspace too large");

struct Params {
  const float *x, *c, *ctx, *c_ctx, *w_mod, *b_mod, *g_pre1, *g_post1, *g_pre2, *g_post2, *w_in, *g_q, *g_kv, *w_uq, *w_ukv, *g_sgu, *w_s, *b_s,
      *w_pa, *w_pb, *w_o, *w_pq, *k1, *k2, *u_exp, *v_exp;
  float* out; char* ws;
};

DEVI float bf2f(unsigned short h) { return __uint_as_float(((unsigned)h) << 16); }
DEVI unsigned short f2bf(float f) { unsigned u = __float_as_uint(f); u += 0x7fffu + ((u >> 16) & 1u); return (unsigned short)(u >> 16); }
DEVI unsigned pack2(float a, float b) { return (unsigned)f2bf(a) | ((unsigned)f2bf(b) << 16); }
DEVI float lo2f(unsigned w) { return __uint_as_float(w << 16); }
DEVI float hi2f(unsigned w) { return __uint_as_float(w & 0xffff0000u); }
DEVI void unpack8(const u32x4& w, float* f) {
  f[0] = lo2f(w[0]); f[1] = hi2f(w[0]); f[2] = lo2f(w[1]); f[3] = hi2f(w[1]); f[4] = lo2f(w[2]); f[5] = hi2f(w[2]); f[6] = lo2f(w[3]); f[7] = hi2f(w[3]);
}
DEVI float gelu_t(float x) { float z = 0.7978845608028654f * (x + 0.044715f * x * x * x); return x / (1.f + __expf(-2.f * z)); }
DEVI float sigmoidf_(float x) { return 1.f / (1.f + __expf(-x)); }
DEVI float wave_sum(float v) { for (int o = 32; o > 0; o >>= 1) v += __shfl_xor(v, o); return v; }
DEVI float wave_max(float v) { for (int o = 32; o > 0; o >>= 1) v = fmaxf(v, __shfl_xor(v, o)); return v; }
DEVI int keyrow(int row) { if (row < NTOK) return (row >> 13) * NKEY + (row & 8191); int c = row - NTOK; return (c >> 8) * NKEY + SEQ + (c & 255); }

__device__ const float ROPE_FREQ[16] = {1.0f, 0.5623413324356079f, 0.3162277638912201f, 0.17782793939113617f, 0.10000000149011612f, 0.05623413249850273f, 0.03162277489900589f, 0.017782794311642647f, 0.009999999776482582f, 0.005623413249850273f, 0.003162277629598975f, 0.0017782794311642647f, 0.0010000000474974513f, 0.000562341301701963f, 0.0003162277571391314f, 0.00017782794020604342f};
DEVI void sincos_small(double a, double& cs, double& sn) {
  const double k = rint(a * 0.15915494309189535); const double r = fma(-k, 6.283185307179586, a) - k * 2.4492935982947064e-16;
  const double r2 = r * r; double s = 0.0, c = 0.0;
#pragma unroll
  for (int n = 12; n >= 1; --n) { s = (1.0 - s * r2 / (double)((2 * n) * (2 * n + 1))); c = (1.0 - c * r2 / (double)((2 * n - 1) * (2 * n))); }
  sn = r * s; cs = c;
}

DEVI void transpose_job(const float* __restrict__ src, int K, int N, bf16_t* __restrict__ dst, const float* __restrict__ gk, bool isWin, int ntiles, char* smem) {
  const int tid = threadIdx.x; bf16_t* tl = (bf16_t*)smem; const int kt = K / 64;
  for (int idx = blockIdx.x; idx < ntiles; idx += gridDim.x) {
    const int ktile = idx % kt, ntile = idx / kt, k0 = ktile * 64, n0d = ntile * 64;
    int n0s = n0d; bool zero = false;
    if (isWin) { if (n0d == 2496) zero = true; else if (n0d >= 2560) n0s = n0d - 64; }
    { const int kk = tid >> 3, nn8 = (tid & 7) * 8; f32x4 va = {0.f, 0.f, 0.f, 0.f}, vb = va;
      if (!zero) { const float* s = src + (size_t)(k0 + kk) * N + n0s + nn8; const float4 a = *(const float4*)s, b = *(const float4*)(s + 4);
        const float sc = gk ? gk[k0 + kk] : 1.f; va = (f32x4){a.x, a.y, a.z, a.w} * sc; vb = (f32x4){b.x, b.y, b.z, b.w} * sc; }
      bf16_t* tp = tl + nn8 * 72 + kk;
      tp[0] = f2bf(va[0]); tp[72] = f2bf(va[1]); tp[144] = f2bf(va[2]); tp[216] = f2bf(va[3]); tp[288] = f2bf(vb[0]); tp[360] = f2bf(vb[1]); tp[432] = f2bf(vb[2]); tp[504] = f2bf(vb[3]); }
    __syncthreads();
    { const int nn = tid >> 3, kk8 = (tid & 7) * 8;
      const u32x4 o = *(const u32x4*)(tl + nn * 72 + kk8);
      *(u32x4*)(dst + (size_t)(n0d + nn) * K + k0 + kk8) = o; }
    __syncthreads();
  }
}

DEVI void ph_prep(const Params& p, char* smem) {
  const int tid = threadIdx.x, bid = blockIdx.x, nb = gridDim.x;
  char* ws = p.ws;
  if (bid == 0) { float* rope = (float*)(ws + O_ROPE);
    for (int i = tid; i < 128 * 16; i += NTHR) { const int pos = i >> 4, f = i & 15; const float ang = (float)pos * ROPE_FREQ[f];
      double cs, sn; sincos_small((double)ang, cs, sn); rope[i * 2] = (float)cs; rope[i * 2 + 1] = (float)sn; } }
  { float* red = (float*)smem; float* MOD = (float*)(ws + O_MOD);
    for (int it = bid; it < 256; it += nb) {
      const int cgp = tid % 6, kg = tid / 6;
      f32x4 a0 = {0.f, 0.f, 0.f, 0.f}, a1 = a0, a2 = a0;
      if (tid < 510) {
        for (int k = kg; k < 1024; k += 85) {
          const float4 w4 = *(const float4*)(p.w_mod + (size_t)k * 6144 + it * 24 + cgp * 4);
          const f32x4 w = {w4.x, w4.y, w4.z, w4.w};
          const float c0 = p.c[k], c1 = p.c[1024 + k], c2 = p.c_ctx[k];
          a0 += w * (c0 / (1.f + __expf(-c0))); a1 += w * (c1 / (1.f + __expf(-c1))); a2 += w * (c2 / (1.f + __expf(-c2)));
        }
        float* rp = red + kg * 72 + cgp * 4;
        rp[0] = a0[0]; rp[1] = a0[1]; rp[2] = a0[2]; rp[3] = a0[3];
        rp[24] = a1[0]; rp[25] = a1[1]; rp[26] = a1[2]; rp[27] = a1[3];
        rp[48] = a2[0]; rp[49] = a2[1]; rp[50] = a2[2]; rp[51] = a2[3];
      }
      __syncthreads();
      if (tid < 72) { float s = 0.f; for (int g = 0; g < 85; ++g) s += red[g * 72 + tid]; int r = tid / 24, n = it * 24 + tid % 24; MOD[r * 6144 + n] = s + p.b_mod[n]; }
      __syncthreads();
    } }
  transpose_job(p.w_in,  1024, INW,  (bf16_t*)(ws + O_WIN),  nullptr, true,  1152, smem);
  transpose_job(p.w_uq,  256,  1536, (bf16_t*)(ws + O_WUQ),  p.g_q,   false, 96,   smem);
  transpose_job(p.w_ukv, 128,  2048, (bf16_t*)(ws + O_WUKV), p.g_kv,  false, 64,   smem);
  transpose_job(p.w_pa,  1024, 1024, (bf16_t*)(ws + O_WPA),  nullptr, false, 256,  smem);
  transpose_job(p.w_pb,  1024, 1024, (bf16_t*)(ws + O_WPB),  nullptr, false, 256,  smem);
  transpose_job(p.w_o,   1024, 1024, (bf16_t*)(ws + O_WO),   nullptr, false, 256,  smem);
  transpose_job(p.w_pq,  1024, 2048, (bf16_t*)(ws + O_WPQ),  nullptr, false, 512,  smem);
  { const int n8 = (131072 + 16384 + 16384) / 8;
    for (int i = bid * NTHR + tid; i < n8; i += nb * NTHR) {
      int e = i * 8; const float* s; bf16_t* d;
      if (e < 131072) { s = p.w_s + e; d = (bf16_t*)(ws + O_WS) + e; }
      else if (e < 131072 + 16384) { s = p.k1 + (e - 131072); d = (bf16_t*)(ws + O_K1) + (e - 131072); }
      else { s = p.k2 + (e - 131072 - 16384); d = (bf16_t*)(ws + O_K2) + (e - 131072 - 16384); }
      const float4 a = *(const float4*)s, b = *(const float4*)(s + 4);
      u32x4 o = {pack2(a.x, a.y), pack2(a.z, a.w), pack2(b.x, b.y), pack2(b.z, b.w)};
      *(u32x4*)d = o;
    } }
}

typedef float f32x2_t __attribute__((ext_vector_type(2)));
DEVI void convert_table_fp8(const float* __restrict__ src, unsigned char* __restrict__ dst, float* __restrict__ scale) {
  const int wave = threadIdx.x >> 6, lane = threadIdx.x & 63;
  for (int row = blockIdx.x * NWAVE + wave; row < 16384; row += gridDim.x * NWAVE) {
    const float* sp = src + (size_t)row * 1024 + lane * 16;
    float4 v[4]; float am = 0.f;
#pragma unroll
    for (int j = 0; j < 4; ++j) { v[j] = *(const float4*)(sp + j * 4); am = fmaxf(am, fmaxf(fmaxf(fabsf(v[j].x), fabsf(v[j].y)), fmaxf(fabsf(v[j].z), fabsf(v[j].w)))); }
    am = wave_max(am);
    const float inv = am > 0.f ? 240.f / am : 0.f;
    u32x4 o;
#pragma unroll
    for (int j = 0; j < 4; ++j) { int w = __builtin_amdgcn_cvt_pk_fp8_f32(v[j].x * inv, v[j].y * inv, 0, false); w = __builtin_amdgcn_cvt_pk_fp8_f32(v[j].z * inv, v[j].w * inv, w, true); o[j] = (unsigned)w; }
    *(u32x4*)(dst + (size_t)row * 1024 + lane * 16) = o;
    if (lane == 0) scale[row] = am * (1.f / 240.f);
  }
}

DEVI void ph_hx(const Params& p, char* smem) {
  const int tid = threadIdx.x, wave = tid >> 6, lane = tid & 63;
  float* mA = (float*)smem; float* mB = mA + 3 * 1024;
  const float* MOD = (const float*)(p.ws + O_MOD);
  for (int i = tid; i < 3072; i += NTHR) { int r = i >> 10, c = i & 1023; mA[i] = p.g_pre1[c] * (1.f + MOD[r * 6144 + 1024 + c]); mB[i] = MOD[r * 6144 + c]; }
  __syncthreads();
  bf16_t* HX = (bf16_t*)(p.ws + O_RA);
  for (int row = blockIdx.x * NWAVE + wave; row < NROW; row += gridDim.x * NWAVE) {
    const float* src = row < NTOK ? p.x + (size_t)row * 1024 : p.ctx + (size_t)(row - NTOK) * 1024;
    const int mr = row < NTOK ? (row >> 13) : 2;
    float4 v[4]; float ss = 0.f;
#pragma unroll
    for (int i = 0; i < 4; ++i) { v[i] = *(const float4*)(src + i * 256 + lane * 4); ss += v[i].x * v[i].x + v[i].y * v[i].y + v[i].z * v[i].z + v[i].w * v[i].w; }
    ss = wave_sum(ss); const float rstd = rsqrtf(ss * (1.f / 1024.f) + EPS);
#pragma unroll
    for (int i = 0; i < 4; ++i) { const int c = i * 256 + lane * 4; const float* a = mA + mr * 1024 + c; const float* b = mB + mr * 1024 + c;
      u32x2 o = {pack2(v[i].x * rstd * a[0] + b[0], v[i].y * rstd * a[1] + b[1]), pack2(v[i].z * rstd * a[2] + b[2], v[i].w * rstd * a[3] + b[3])};
      *(u32x2*)(HX + (size_t)row * 1024 + c) = o; }
  }
}

DEVI int lds_sw(int row, int c) { return row * 128 + ((c ^ (row & 7)) << 4); }
template <int BM, int BN, bool ACOLMAP, bool GLDS, class Epi>
DEVI void gemm_tile_mfma(const bf16_t* __restrict__ A, int lda, const bf16_t* __restrict__ Bm, int ldb, int K, int row0, int col0, const Epi& epi, const float* kscale, char* smem) {
  constexpr int WNW = BN / 64, WMW = 8 / WNW, WTM = BM / WMW, MI = WTM / 16, ACH = BM / 64, BCH = BN / 64, ABYTES = BM * 128, BBYTES = BN * 128, STAGE = ABYTES + BBYTES;
  const int tid = threadIdx.x, wave = __builtin_amdgcn_readfirstlane(tid >> 6), lane = tid & 63, wm = wave / WNW, wn = wave % WNW, l15 = lane & 15, lq = lane >> 4;
  f32x4 acc[MI][4];
#pragma unroll
  for (int mi = 0; mi < MI; ++mi)
#pragma unroll
    for (int ni = 0; ni < 4; ++ni) acc[mi][ni] = (f32x4){0.f, 0.f, 0.f, 0.f};
  const int nk = K >> 6;
  const int sr = tid >> 3, scc = tid & 7;
  auto compute = [&](int buf) {
    const char* sa = smem + buf * STAGE; const char* sb = sa + ABYTES;
#pragma unroll
    for (int ks = 0; ks < 2; ++ks) { const int kc = ks * 4 + lq; bf16x8 bfr[4];
#pragma unroll
      for (int ni = 0; ni < 4; ++ni) bfr[ni] = *(const bf16x8*)(sb + lds_sw(wn * 64 + ni * 16 + l15, kc));
#pragma unroll
      for (int mi = 0; mi < MI; ++mi) { const bf16x8 af = *(const bf16x8*)(sa + lds_sw(wm * WTM + mi * 16 + l15, kc));
#pragma unroll
        for (int ni = 0; ni < 4; ++ni) acc[mi][ni] = __builtin_amdgcn_mfma_f32_16x16x32_bf16(bfr[ni], af, acc[mi][ni], 0, 0, 0); }
      if (MI > 4 && GEMM_KS_SBAR) __builtin_amdgcn_sched_barrier(0); }
  };
  if constexpr (GLDS) {
    const unsigned aoff = (unsigned)(sr * lda + ((scc ^ (sr & 7)) * 8)) * 2u, boff = (unsigned)(sr * ldb + ((scc ^ (sr & 7)) * 8)) * 2u;
    auto gstage = [&](int buf, int kt) {
      const int k0 = kt * 64, ka = ACOLMAP ? k0 + (k0 >> 7) * 64 : k0;
      char* sa = smem + buf * STAGE + wave * 1024; char* sb = sa + ABYTES;
#pragma unroll
      for (int i = 0; i < ACH; ++i) __builtin_amdgcn_global_load_lds((const unsigned*)((const char*)(A + (size_t)(64 * i) * lda + ka) + aoff), (unsigned*)(sa + i * 8192), 16, 0, 0);
#pragma unroll
      for (int i = 0; i < BCH; ++i) __builtin_amdgcn_global_load_lds((const unsigned*)((const char*)(Bm + (size_t)(64 * i) * ldb + k0) + boff), (unsigned*)(sb + i * 8192), 16, 0, 0);
    };
    gstage(0, 0); asm volatile("s_waitcnt vmcnt(0)" ::: "memory"); __syncthreads();
    for (int kt = 0; kt < nk; ++kt) {
      if (kt + 1 < nk) gstage((kt + 1) & 1, kt + 1);
      compute(kt & 1);
      asm volatile("s_waitcnt vmcnt(0)" ::: "memory"); __syncthreads();
    }
  } else {
    u32x4 ra[ACH], rb[BCH];
    const unsigned aoff = (unsigned)(sr * lda + scc * 8) * 2u, boff = (unsigned)(sr * ldb + scc * 8) * 2u;
    const int sdst = lds_sw(sr, scc);
    auto gload = [&](int kt) {
      const int k0 = kt * 64, ka = ACOLMAP ? k0 + (k0 >> 7) * 64 : k0;
#pragma unroll
      for (int i = 0; i < ACH; ++i) { const char* ub = (const char*)(A + (size_t)(64 * i) * lda + ka); ra[i] = *(const u32x4*)(ub + aoff); }
#pragma unroll
      for (int i = 0; i < BCH; ++i) { const char* ub = (const char*)(Bm + (size_t)(64 * i) * ldb + k0); rb[i] = *(const u32x4*)(ub + boff); }
    };
    auto lstore = [&](int buf, int kt) {
      char* sa = smem + buf * STAGE + sdst; char* sb = sa + ABYTES;
#pragma unroll
      for (int i = 0; i < ACH; ++i) { u32x4 v = ra[i];
        if (kscale) { float f[8]; unpack8(v, f); const float* ks = kscale + kt * 64 + scc * 8;
          v = (u32x4){pack2(f[0] * ks[0], f[1] * ks[1]), pack2(f[2] * ks[2], f[3] * ks[3]), pack2(f[4] * ks[4], f[5] * ks[5]), pack2(f[6] * ks[6], f[7] * ks[7])}; }
        *(u32x4*)(sa + i * 8192) = v; }
#pragma unroll
      for (int i = 0; i < BCH; ++i) *(u32x4*)(sb + i * 8192) = rb[i];
    };
    gload(0); lstore(0, 0); __syncthreads();
    for (int kt = 0; kt < nk; ++kt) {
      if (kt + 1 < nk) gload(kt + 1);
      compute(kt & 1);
      if (kt + 1 < nk) lstore((kt + 1) & 1, kt + 1);
      __syncthreads();
    }
  }
#pragma unroll
  for (int mi = 0; mi < MI; ++mi) { const int row = row0 + wm * WTM + mi * 16 + l15; float sq = 0.f;
#pragma unroll
    for (int ni = 0; ni < 4; ++ni) { const float v[4] = {acc[mi][ni][0], acc[mi][ni][1], acc[mi][ni][2], acc[mi][ni][3]}; const float q = epi(row, col0 + wn * 64 + ni * 16 + lq * 4, v);
      if (Epi::RSS) { sq += q; if (ni & 1) { sq += __shfl_xor(sq, 16); sq += __shfl_xor(sq, 32); if (lq == 0) epi.rss(row, col0 + wn * 64 + (ni >> 1) * 32, sq); sq = 0.f; } } }
    __builtin_amdgcn_sched_barrier(0); }
}


namespace g8 {
constexpr int BK = 64, HALF = 128, HT = HALF * BK;
DEVI int lds_byte(int r, int c) { const int st = (r >> 4) * 2 + (c >> 5), rr = r & 15, cc = c & 31, ob = rr * 64 + cc * 2; return st * 1024 + (ob ^ (((ob >> 9) & 1) << 5)); }
DEVI void stage_rc(int b, int& R, int& C) { const int st = b / 1024, sb = b % 1024, swz = sb ^ (((sb >> 9) & 1) << 5); R = (st >> 1) * 16 + swz / 64; C = (st & 1) * 32 + (swz % 64) / 2; }
}
template <bool ACOLMAP, class Epi>
DEVI void gemm_tile_8ph(const bf16_t* __restrict__ A, int lda, const bf16_t* __restrict__ Bt, int ldb, int K, int row0, int col0, const Epi& epi, char* smem) {
  using namespace g8;
  bf16_t* shm = (bf16_t*)smem;
#define SA(b, h) (shm + ((b) * 2 + (h)) * HT)
#define SB(b, h) (shm + (4 + (b) * 2 + (h)) * HT)
#define STAGE_A(P, r0, kt) do { const int _k0 = (kt) * BK, _ka = ACOLMAP ? _k0 + (_k0 >> 7) * 64 : _k0; \
    __builtin_amdgcn_global_load_lds((const unsigned*)((const char*)(A + (size_t)(r0) * lda + _ka) + ao0), (unsigned*)((char*)(P) + wid * 1024), 16, 0, 0); \
    __builtin_amdgcn_global_load_lds((const unsigned*)((const char*)(A + (size_t)((r0) + 64) * lda + _ka) + ao0), (unsigned*)((char*)(P) + wid * 1024 + 8192), 16, 0, 0); } while (0)
#define STAGE_B(P, r0, kt) do { const int _k0 = (kt) * BK; \
    __builtin_amdgcn_global_load_lds((const unsigned*)((const char*)(Bt + (size_t)(r0) * ldb + _k0) + bo0), (unsigned*)((char*)(P) + wid * 1024), 16, 0, 0); \
    __builtin_amdgcn_global_load_lds((const unsigned*)((const char*)(Bt + (size_t)((r0) + 64) * ldb + _k0) + bo0), (unsigned*)((char*)(P) + wid * 1024 + 8192), 16, 0, 0); } while (0)
#define LDA(dst, b, h) _Pragma("unroll") for (int m = 0; m < 4; ++m) _Pragma("unroll") for (int k = 0; k < 2; ++k) \
    dst[m][k] = *reinterpret_cast<const bf16x8*>((const char*)SA(b, h) + lds_byte(wr * 64 + m * 16 + fr, k * 32 + fq * 8))
#define LDB(dst, b, h) _Pragma("unroll") for (int n = 0; n < 2; ++n) _Pragma("unroll") for (int k = 0; k < 2; ++k) \
    dst[n][k] = *reinterpret_cast<const bf16x8*>((const char*)SB(b, h) + lds_byte(wc * 32 + n * 16 + fr, k * 32 + fq * 8))
#define MMA(ai, bj, At_, Bt_) do { __builtin_amdgcn_s_setprio(1); \
    _Pragma("unroll") for (int m = 0; m < 4; ++m) _Pragma("unroll") for (int n = 0; n < 2; ++n) _Pragma("unroll") for (int k = 0; k < 2; ++k) \
      acc[ai][bj][m][n] = __builtin_amdgcn_mfma_f32_16x16x32_bf16(Bt_[n][k], At_[m][k], acc[ai][bj][m][n], 0, 0, 0); \
    __builtin_amdgcn_s_setprio(0); } while (0)
#define WAIT_V(n) asm volatile("s_waitcnt vmcnt(" #n ")" ::: "memory")
#define WAIT_L(n) asm volatile("s_waitcnt lgkmcnt(" #n ")" ::: "memory")
#define BAR __builtin_amdgcn_s_barrier()
#define SCHED __builtin_amdgcn_sched_barrier(0)
  int tid = threadIdx.x; asm volatile("" : "+v"(tid));
  const int wid = __builtin_amdgcn_readfirstlane(tid >> 6), lane = tid & 63, wr = wid >> 2, wc = wid & 3, fr = lane & 15, fq = lane >> 4;
  unsigned ao0, bo0;
  { int r, c; stage_rc(tid * 16, r, c); ao0 = (unsigned)(r * lda + c) * 2u; bo0 = (unsigned)(r * ldb + c) * 2u; }
  f32x4 acc[2][2][4][2];
#pragma unroll
  for (int a = 0; a < 2; ++a)
#pragma unroll
    for (int b = 0; b < 2; ++b)
#pragma unroll
      for (int m = 0; m < 4; ++m)
#pragma unroll
        for (int n = 0; n < 2; ++n) acc[a][b][m][n] = (f32x4){0.f, 0.f, 0.f, 0.f};
  bf16x8 At[4][2], B0[2][2], B1[2][2];
  const int nt = K / BK;
  STAGE_B(SB(0, 0), 0, 0); STAGE_A(SA(0, 0), 0, 0);
  STAGE_B(SB(0, 1), HALF, 0); STAGE_A(SA(0, 1), HALF, 0);
  if (wr == 1) BAR;
  WAIT_V(4); BAR;
  STAGE_B(SB(1, 0), 0, 1); STAGE_A(SA(1, 0), 0, 1); STAGE_B(SB(1, 1), HALF, 1);
  WAIT_V(6); BAR;
  for (int t = 0; t < nt - 2; t += 2) {
    LDB(B0, 0, 0); SCHED; LDA(At, 0, 0); STAGE_A(SA(1, 1), HALF, t + 1);
    WAIT_L(8); BAR; WAIT_L(0); MMA(0, 0, At, B0); BAR; SCHED;
    LDB(B1, 0, 1); STAGE_B(SB(0, 0), 0, t + 2);
    BAR; WAIT_L(0); MMA(0, 1, At, B1); BAR;
    LDA(At, 0, 1); STAGE_A(SA(0, 0), 0, t + 2);
    BAR; WAIT_L(0); MMA(1, 0, At, B0); BAR; SCHED;
    STAGE_B(SB(0, 1), HALF, t + 2);
    WAIT_V(6); BAR; MMA(1, 1, At, B1); BAR;
    LDB(B0, 1, 0); SCHED; LDA(At, 1, 0); STAGE_A(SA(0, 1), HALF, t + 2);
    WAIT_L(8); BAR; WAIT_L(0); MMA(0, 0, At, B0); BAR; SCHED;
    LDB(B1, 1, 1); STAGE_B(SB(1, 0), 0, t + 3);
    BAR; WAIT_L(0); MMA(0, 1, At, B1); BAR;
    LDA(At, 1, 1); STAGE_A(SA(1, 0), 0, t + 3);
    BAR; WAIT_L(0); MMA(1, 0, At, B0); BAR; SCHED;
    STAGE_B(SB(1, 1), HALF, t + 3);
    WAIT_V(6); BAR; MMA(1, 1, At, B1); BAR;
  }
  { LDB(B0, 0, 0); LDA(At, 0, 0); STAGE_A(SA(1, 1), HALF, nt - 1);
    BAR; WAIT_L(0); MMA(0, 0, At, B0); BAR;
    LDB(B1, 0, 1); BAR; WAIT_L(0); MMA(0, 1, At, B1); BAR;
    LDA(At, 0, 1); WAIT_V(4); BAR; WAIT_L(0); MMA(1, 0, At, B0); MMA(1, 1, At, B1); BAR; }
  { LDB(B0, 1, 0); LDA(At, 1, 0); WAIT_V(2); BAR; WAIT_L(0); MMA(0, 0, At, B0); BAR;
    LDB(B1, 1, 1); WAIT_V(0); BAR; WAIT_L(0); MMA(0, 1, At, B1); BAR;
    LDA(At, 1, 1); BAR; WAIT_L(0); MMA(1, 0, At, B0); MMA(1, 1, At, B1); BAR; }
  if (wr == 0) BAR;
  int tide = threadIdx.x; asm volatile("" : "+v"(tide));
  const int fre = tide & 15, fqe = (tide >> 4) & 3;
#pragma unroll
  for (int ai = 0; ai < 2; ++ai)
#pragma unroll
    for (int m = 0; m < 4; ++m) { const int row = row0 + ai * HALF + wr * 64 + m * 16 + fre;
#pragma unroll
      for (int bj = 0; bj < 2; ++bj) { float sq = 0.f;
#pragma unroll
        for (int n = 0; n < 2; ++n) { const float v[4] = {acc[ai][bj][m][n][0], acc[ai][bj][m][n][1], acc[ai][bj][m][n][2], acc[ai][bj][m][n][3]};
          sq += epi(row, col0 + bj * HALF + wc * 32 + n * 16 + fqe * 4, v); }
        if (Epi::RSS) { sq += __shfl_xor(sq, 16); sq += __shfl_xor(sq, 32); if (fqe == 0) epi.rss(row, col0 + bj * HALF + wc * 32, sq); } }
      __builtin_amdgcn_sched_barrier(0); }
#undef SA
#undef SB
#undef STAGE_A
#undef STAGE_B
#undef LDA
#undef LDB
#undef MMA
#undef WAIT_V
#undef WAIT_L
#undef BAR
#undef SCHED
}

template <int BM, int BN, bool ACOLMAP, class Epi>
DEVI void gemm_tile(const bf16_t* A, int lda, const bf16_t* Bm, int ldb, int K, int row0, int col0, const Epi& epi, const float* kss, char* smem) {
  if constexpr (BM == 256 && BN == 256 && GEMM_8PH) gemm_tile_8ph<ACOLMAP>(A, lda, Bm, ldb, K, row0, col0, epi, smem);
  else if (kss) gemm_tile_mfma<BM, BN, ACOLMAP, false>(A, lda, Bm, ldb, K, row0, col0, epi, kss, smem);
  else gemm_tile_mfma<BM, BN, ACOLMAP, true>(A, lda, Bm, ldb, K, row0, col0, epi, nullptr, smem);
}

DEVI void st4bf(bf16_t* d, float a, float b, float c, float e) { u32x2 o = {pack2(a, b), pack2(c, e)}; *(u32x2*)d = o; }

struct EpiIn { static constexpr bool RSS = true; bf16_t *GU, *GVT, *CQ, *CKV, *KR; float *rssv, *rssq, *rsskv;
  DEVI float operator()(int row, int col, const float (&v)[4]) const {
    if (col < 1024) { st4bf(GU + (size_t)row * 1024 + col, gelu_t(v[0]), gelu_t(v[1]), gelu_t(v[2]), gelu_t(v[3])); return 0.f; }
    else if (col < 2048) { const int c = col - 1024, chunk = row >> 7, q = row & 127; float s = 0.f;
#pragma unroll
      for (int j = 0; j < 4; ++j) { const float g = gelu_t(v[j]); s += g * g; GVT[((size_t)chunk * 1024 + c + j) * 128 + q] = f2bf(g); }
      return s; }
    else if (col < 2304) { st4bf(CQ + (size_t)row * 256 + (col - 2048), v[0], v[1], v[2], v[3]); return v[0] * v[0] + v[1] * v[1] + v[2] * v[2] + v[3] * v[3]; }
    else if (col < 2432) { st4bf(CKV + (size_t)row * 128 + (col - 2304), v[0], v[1], v[2], v[3]); return v[0] * v[0] + v[1] * v[1] + v[2] * v[2] + v[3] * v[3]; }
    else if (col < 2496) { st4bf(KR + (size_t)keyrow(row) * 64 + (col - 2432), v[0], v[1], v[2], v[3]); return 0.f; }
    return 0.f; }
  DEVI void rss(int row, int col, float s) const {
    if (col >= 1024 && col < 2048) rssv[row * 32 + ((col - 1024) >> 5)] = s; else if (col >= 2048 && col < 2304) rssq[row * 8 + ((col - 2048) >> 5)] = s; else if (col >= 2304 && col < 2432) rsskv[row * 4 + ((col - 2304) >> 5)] = s; }
};
struct EpiQ { static constexpr bool RSS = false; bf16_t* Q; const float* rssq;
  DEVI float operator()(int row, int col, const float (&v)[4]) const { const float4 ps = *(const float4*)(rssq + row * 8), pt = *(const float4*)(rssq + row * 8 + 4); const float r = rsqrtf((((ps.x + ps.y) + (ps.z + ps.w)) + ((pt.x + pt.y) + (pt.z + pt.w))) * (1.f / 256.f) + EPS);
    st4bf(Q + (size_t)row * 1536 + col, v[0] * r, v[1] * r, v[2] * r, v[3] * r); return 0.f; }
  DEVI void rss(int, int, float) const {} };
struct EpiKV { static constexpr bool RSS = false; bf16_t* KV; const float* rsskv;
  DEVI float operator()(int row, int col, const float (&v)[4]) const { const float4 pk = *(const float4*)(rsskv + row * 4); const float r = rsqrtf(((pk.x + pk.y) + (pk.z + pk.w)) * (1.f / 128.f) + EPS);
    st4bf(KV + (size_t)keyrow(row) * 2048 + col, v[0] * r, v[1] * r, v[2] * r, v[3] * r); return 0.f; }
  DEVI void rss(int, int, float) const {} };
DEVI int pk4_fp8(float a, float b, float c, float d) { int w = __builtin_amdgcn_cvt_pk_fp8_f32(a, b, 0, false); return __builtin_amdgcn_cvt_pk_fp8_f32(c, d, w, true); }
constexpr size_t O_K8 = O_RKV, O_V8T = O_RKV + al256((size_t)NB * 8 * NKEY * 192);
struct EpiK8 { static constexpr bool RSS = false; unsigned char* K8; const float* rsskv;
  DEVI float operator()(int row, int col, const float (&v)[4]) const { const float4 pk = *(const float4*)(rsskv + row * 4); const float r = rsqrtf(((pk.x + pk.y) + (pk.z + pk.w)) * (1.f / 128.f) + EPS);
    const int kr = keyrow(row), b = kr / NKEY, key = kr - b * NKEY, h = col >> 7, d = col & 127;
    *(int*)(K8 + ((size_t)(b * 8 + h) * NKEY + key) * 192 + d) = pk4_fp8(v[0] * r, v[1] * r, v[2] * r, v[3] * r); return 0.f; }
  DEVI void rss(int, int, float) const {} };
struct EpiV8T { static constexpr bool RSS = false; unsigned char* V8; const float* rsskv;
  DEVI float operator()(int row, int col, const float (&v)[4]) const {
    float r[4];
#pragma unroll
    for (int j = 0; j < 4; ++j) { const float4 pk = *(const float4*)(rsskv + (col + j) * 4); r[j] = rsqrtf(((pk.x + pk.y) + (pk.z + pk.w)) * (1.f / 128.f) + EPS); }
    const int kr = keyrow(col), b = kr / NKEY, key = kr - b * NKEY, h = row >> 7, d = row & 127, kk = key & 63;
    const int off = 32 * ((kk >> 2) & 1) + 16 * (kk >> 5) + 4 * ((kk >> 3) & 3);
    *(int*)(V8 + ((size_t)(b * 8 + h) * 128 + d) * NKEY + (key & ~63) + off) = pk4_fp8(v[0] * r[0], v[1] * r[1], v[2] * r[2], v[3] * r[3]); return 0.f; }
  DEVI void rss(int, int, float) const {} };
struct EpiSgu { static constexpr bool RSS = false; bf16_t* GUOA; const float* g_sgu; const float* b_s; int chunk, g;
  DEVI float operator()(int row, int col, const float (&v)[4]) const { const int token = chunk * 128 + row, ch = g * 128 + col; const float bias = b_s[g * 128 + row];
    bf16_t* ptr = GUOA + (size_t)token * 1024 + ch; const u32x2 gu = *(const u32x2*)ptr;
    st4bf(ptr, lo2f(gu[0]) * (g_sgu[ch] * v[0] + bias), hi2f(gu[0]) * (g_sgu[ch + 1] * v[1] + bias), lo2f(gu[1]) * (g_sgu[ch + 2] * v[2] + bias), hi2f(gu[1]) * (g_sgu[ch + 3] * v[3] + bias));
    return 0.f; }
  DEVI void rss(int, int, float) const {} };
struct EpiGate { static constexpr bool RSS = false; bf16_t* G;
  DEVI float operator()(int row, int col, const float (&v)[4]) const { st4bf(G + (size_t)row * 2048 + col, sigmoidf_(v[0]), sigmoidf_(v[1]), sigmoidf_(v[2]), sigmoidf_(v[3])); return 0.f; }
  DEVI void rss(int, int, float) const {} };
template <bool SECOND> struct EpiMerge { static constexpr bool RSS = false; bf16_t* M; const bf16_t* G;
  DEVI float operator()(int row, int col, const float (&v)[4]) const { const u32x2 g = *(const u32x2*)(G + (size_t)row * 2048 + (SECOND ? 1024 : 0) + col);
    float o0 = lo2f(g[0]) * v[0], o1 = hi2f(g[0]) * v[1], o2 = lo2f(g[1]) * v[2], o3 = hi2f(g[1]) * v[3];
    bf16_t* ptr = M + (size_t)row * 1024 + col;
    if (SECOND) { const u32x2 m = *(const u32x2*)ptr; o0 += lo2f(m[0]); o1 += hi2f(m[0]); o2 += lo2f(m[1]); o3 += hi2f(m[1]); }
    st4bf(ptr, o0, o1, o2, o3); return 0.f; }
  DEVI void rss(int, int, float) const {} };
struct EpiO { static constexpr bool RSS = true; bf16_t* Y; float* rssy;
  DEVI float operator()(int row, int col, const float (&v)[4]) const { st4bf(Y + (size_t)row * 1024 + col, v[0], v[1], v[2], v[3]); return v[0] * v[0] + v[1] * v[1] + v[2] * v[2] + v[3] * v[3]; }
  DEVI void rss(int row, int col, float s) const { rssy[row * 32 + (col >> 5)] = s; } };
struct EpiPq { static constexpr bool RSS = false; bf16_t* QP;
  DEVI float operator()(int row, int col, const float (&v)[4]) const { st4bf(QP + (size_t)row * 2048 + col, v[0], v[1], v[2], v[3]); return 0.f; }
  DEVI void rss(int, int, float) const {} };

template <class F> DEVI void for_tiles_xcd(int MT, int NT, F f) {
  const int nb = gridDim.x;
  if ((nb & 7) == 0 && (MT & 7) == 0) { const int xcd = blockIdx.x & 7, slot = blockIdx.x >> 3, slots = nb >> 3, mper = MT >> 3, tot = mper * NT;
    for (int j = slot; j < tot; j += slots) f(xcd * mper + j / NT, j % NT); }
  else for (int i = blockIdx.x; i < MT * NT; i += nb) f(i / NT, i % NT);
}

DEVI void ph_inproj(const Params& p, char* smem) {
  char* ws = p.ws;
  EpiIn epi{(bf16_t*)(ws + O_RB), (bf16_t*)(ws + O_RC), (bf16_t*)(ws + O_CQ), (bf16_t*)(ws + O_CKV), (bf16_t*)(ws + O_KR), (float*)(ws + O_RSSV), (float*)(ws + O_RSSQ), (float*)(ws + O_RSSKV)};
  const bf16_t* HX = (const bf16_t*)(ws + O_RA); const bf16_t* W = (const bf16_t*)(ws + O_WIN);
  auto tile = [&](int mt, int nt) { gemm_tile<256, 256, false>(HX + (size_t)mt * 256 * 1024, 1024, W + (size_t)nt * 256 * 1024, 1024, 1024, mt * 256, nt * 256, epi, nullptr, smem); };
  for_tiles_xcd(64, 10, tile);
  for (int i = (int)gridDim.x - 1 - (int)blockIdx.x; i < 2; i += gridDim.x) tile(64 + i, 9);
}
DEVI void rope_kr(const Params& p) {
  bf16_t* KR = (bf16_t*)(p.ws + O_KR); const float* rope = (const float*)(p.ws + O_ROPE);
  for (int i = blockIdx.x * NTHR + threadIdx.x; i < NTOK * 32; i += gridDim.x * NTHR) {
    const int tok = i >> 5, j = i & 15, which = (i >> 4) & 1, pos = tok & 8191, pp = which ? (pos & 63) : (pos >> 6);
    const float cs = rope[(pp * 16 + j) * 2], sn = rope[(pp * 16 + j) * 2 + 1];
    bf16_t* r = KR + (size_t)keyrow(tok) * 64 + which * 32 + j;
    const float x1 = bf2f(r[0]), x2 = bf2f(r[16]);
    r[0] = f2bf(x1 * cs - x2 * sn); r[16] = f2bf(x1 * sn + x2 * cs);
  }
}
DEVI void rope_kr_fp8(const Params& p) {
  const bf16_t* KR = (const bf16_t*)(p.ws + O_KR); const float* rope = (const float*)(p.ws + O_ROPE); unsigned char* K8 = (unsigned char*)(p.ws + O_K8);
  for (int i = blockIdx.x * NTHR + threadIdx.x; i < NROW * 2; i += gridDim.x * NTHR) {
    const int row = i >> 1, which = i & 1, kr = keyrow(row), b = kr / NKEY, key = kr - b * NKEY;
    float x[32];
    const bf16_t* src = KR + (size_t)kr * 64 + which * 32;
#pragma unroll
    for (int q = 0; q < 4; ++q) unpack8(*(const u32x4*)(src + q * 8), x + q * 8);
    if (row < NTOK) { const int pos = row & 8191, pp = which ? (pos & 63) : (pos >> 6); const float* cs = rope + pp * 32;
#pragma unroll
      for (int j = 0; j < 16; ++j) { const float c = cs[j * 2], sn = cs[j * 2 + 1], x1 = x[j], x2 = x[16 + j]; x[j] = x1 * c - x2 * sn; x[16 + j] = x1 * sn + x2 * c; } }
    u32x4 o0, o1;
#pragma unroll
    for (int q = 0; q < 4; ++q) { o0[q] = (unsigned)pk4_fp8(x[q * 4], x[q * 4 + 1], x[q * 4 + 2], x[q * 4 + 3]); o1[q] = (unsigned)pk4_fp8(x[16 + q * 4], x[17 + q * 4], x[18 + q * 4], x[19 + q * 4]); }
#pragma unroll
    for (int h = 0; h < 8; ++h) { unsigned char* d = K8 + ((size_t)(b * 8 + h) * NKEY + key) * 192 + 128 + which * 32; *(u32x4*)d = o0; *(u32x4*)(d + 16) = o1; }
  }
}
DEVI void ph_mid(const Params& p, char* smem) {
  char* ws = p.ws;
  { EpiQ epi{(bf16_t*)(ws + O_RQ), (const float*)(ws + O_RSSQ)};
    const bf16_t* A = (const bf16_t*)(ws + O_CQ); const bf16_t* W = (const bf16_t*)(ws + O_WUQ);
    for_tiles_xcd(64, 12, [&](int mt, int nt) { gemm_tile<256, 128, false>(A + (size_t)mt * 256 * 256, 256, W + (size_t)nt * 128 * 256, 256, 256, mt * 256, nt * 128, epi, nullptr, smem); }); }
#if ATTN_FP8
  { EpiK8 epi{(unsigned char*)(ws + O_K8), (const float*)(ws + O_RSSKV)};
    const bf16_t* A = (const bf16_t*)(ws + O_CKV); const bf16_t* W = (const bf16_t*)(ws + O_WUKV);
    auto tile = [&](int mt, int nt) { gemm_tile<256, 128, false>(A + (size_t)mt * 256 * 128, 128, W + (size_t)nt * 256 * 128, 128, 128, mt * 256, nt * 128, epi, nullptr, smem); };
    for_tiles_xcd(64, 8, tile);
    for (int i = blockIdx.x; i < 16; i += gridDim.x) tile(64 + (i >> 3), i & 7); }
  { EpiV8T epi{(unsigned char*)(ws + O_V8T), (const float*)(ws + O_RSSKV)};
    const bf16_t* A = (const bf16_t*)(ws + O_WUKV); const bf16_t* Bc = (const bf16_t*)(ws + O_CKV);
    for (int i = blockIdx.x; i < 8 * 132; i += gridDim.x) { const int mt = i & 7, nt = i >> 3;
      gemm_tile<128, 128, false>(A + (size_t)(mt * 256 + 128) * 128, 128, Bc + (size_t)nt * 128 * 128, 128, 128, mt * 128, nt * 128, epi, nullptr, smem); } }
#else
  { EpiKV epi{(bf16_t*)(ws + O_RKV), (const float*)(ws + O_RSSKV)};
    const bf16_t* A = (const bf16_t*)(ws + O_CKV); const bf16_t* W = (const bf16_t*)(ws + O_WUKV);
    auto tile = [&](int mt, int nt) { gemm_tile<256, 128, false>(A + (size_t)mt * 256 * 128, 128, W + (size_t)nt * 128 * 128, 128, 128, mt * 256, nt * 128, epi, nullptr, smem); };
    for_tiles_xcd(64, 16, tile);
    for (int i = blockIdx.x; i < 32; i += gridDim.x) tile(64 + (i >> 4), i & 15); }
#endif
  { const bf16_t* WS = (const bf16_t*)(ws + O_WS); const bf16_t* GVT = (const bf16_t*)(ws + O_RC);
    float* ksc = (float*)(smem + LDS_BYTES - 1024); const float* rssv = (const float*)(ws + O_RSSV);
    for (int i = blockIdx.x; i < 1024; i += gridDim.x) { const int chunk = i >> 3, g = i & 7;
      __syncthreads();
      if (threadIdx.x < 128) { const float* pr = rssv + (size_t)(chunk * 128 + threadIdx.x) * 32; float t = 0.f;
#pragma unroll
        for (int j = 0; j < 32; ++j) t += pr[j];
        ksc[threadIdx.x] = rsqrtf(t * (1.f / 1024.f) + EPS); }
      __syncthreads();
      EpiSgu epi{(bf16_t*)(ws + O_RB), p.g_sgu, p.b_s, chunk, g};
      gemm_tile<128, 128, false>(WS + (size_t)g * 16384, 128, GVT + ((size_t)chunk * 1024 + g * 128) * 128, 128, 128, 0, 0, epi, ksc, smem); } }
#if ATTN_FP8
  rope_kr_fp8(p);
#else
  rope_kr(p);
#endif
}
DEVI void ph_gates(const Params& p, char* smem) {
  char* ws = p.ws; EpiGate epi{(bf16_t*)(ws + O_RKV)};
  const bf16_t* HX = (const bf16_t*)(ws + O_RA); const bf16_t* W = (const bf16_t*)(ws + O_WIN) + (size_t)NPRE * 1024;
  for_tiles_xcd(64, 8, [&](int mt, int nt) { gemm_tile<256, 256, false>(HX + (size_t)mt * 256 * 1024, 1024, W + (size_t)nt * 256 * 1024, 1024, 1024, mt * 256, nt * 256, epi, nullptr, smem); });
}
DEVI void ph_merge(const Params& p, char* smem) {
  char* ws = p.ws; bf16_t* M = (bf16_t*)(ws + O_RC); const bf16_t* G = (const bf16_t*)(ws + O_RKV);
  EpiMerge<false> e1{M, G}; EpiMerge<true> e2{M, G};
  const bf16_t* OA = (const bf16_t*)(ws + O_RB); const bf16_t* OB = (const bf16_t*)(ws + O_RQ);
  const bf16_t* WA = (const bf16_t*)(ws + O_WPA); const bf16_t* WB = (const bf16_t*)(ws + O_WPB);
  for_tiles_xcd(64, 4, [&](int mt, int nt) { gemm_tile<256, 256, false>(OA + (size_t)mt * 256 * 1024, 1024, WA + (size_t)nt * 256 * 1024, 1024, 1024, mt * 256, nt * 256, e1, nullptr, smem); });
  for_tiles_xcd(64, 4, [&](int mt, int nt) { gemm_tile<256, 256, true>(OB + (size_t)mt * 256 * 1536, 1536, WB + (size_t)nt * 256 * 1024, 1024, 1024, mt * 256, nt * 256, e2, nullptr, smem); });
}
DEVI void ph_wo(const Params& p, char* smem) {
  char* ws = p.ws; EpiO epi{(bf16_t*)(ws + O_RA), (float*)(ws + O_RSSY)};
  const bf16_t* M = (const bf16_t*)(ws + O_RC); const bf16_t* W = (const bf16_t*)(ws + O_WO);
  for_tiles_xcd(64, 4, [&](int mt, int nt) { gemm_tile<256, 256, false>(M + (size_t)mt * 256 * 1024, 1024, W + (size_t)nt * 256 * 1024, 1024, 1024, mt * 256, nt * 256, epi, nullptr, smem); });
}
DEVI void ph_wpq(const Params& p, char* smem) {
  char* ws = p.ws; EpiPq epi{(bf16_t*)(ws + O_RKV)};
  const bf16_t* A = (const bf16_t*)(ws + O_RB); const bf16_t* W = (const bf16_t*)(ws + O_WPQ);
  for_tiles_xcd(64, 8, [&](int mt, int nt) { gemm_tile<256, 256, false>(A + (size_t)mt * 256 * 1024, 1024, W + (size_t)nt * 256 * 1024, 1024, 1024, mt * 256, nt * 256, epi, nullptr, smem); });
  convert_table_fp8(p.v_exp, (unsigned char*)(ws + O_RA), (float*)(ws + O_RA + (size_t)16384 * 1024));
}

DEVI void attn_naive(const Params& p, char* smem) {
  const int tid = threadIdx.x, wave = tid >> 6, lane = tid & 63;
  float* qs = (float*)smem + wave * 256; float* ps = qs + 192;
  bf16_t* Q = (bf16_t*)(p.ws + O_RQ); const bf16_t* KV = (const bf16_t*)(p.ws + O_RKV); const bf16_t* KR = (const bf16_t*)(p.ws + O_KR);
  const float* rope = (const float*)(p.ws + O_ROPE);
  const float scale = 0.07216878364870322f;
  for (int base = blockIdx.x * NWAVE; base < NB * 8 * SEQ; base += gridDim.x * NWAVE) {
    const int it = base + wave, bh = it >> 13, qi = it & 8191, b = bh >> 3, h = bh & 7;
    const size_t qoff = (size_t)(b * SEQ + qi) * 1536 + h * 192;
    __syncthreads();
    for (int d = lane; d < 192; d += 64) qs[d] = bf2f(Q[qoff + d]);
    __syncthreads();
    if (lane < 32) { const int j = lane & 15, which = lane >> 4, pp = which ? (qi & 63) : (qi >> 6);
      const float cs = rope[(pp * 16 + j) * 2], sn = rope[(pp * 16 + j) * 2 + 1]; const int d1 = 128 + which * 32 + j, d2 = d1 + 16;
      const float x1 = qs[d1], x2 = qs[d2]; qs[d1] = x1 * cs - x2 * sn; qs[d2] = x1 * sn + x2 * cs; }
    __syncthreads();
    float m = -1e30f, l = 0.f, o0 = 0.f, o1 = 0.f;
    for (int k0 = 0; k0 < NKEY; k0 += 64) {
      const size_t kr = (size_t)(b * NKEY + k0 + lane);
      const bf16_t* kn = KV + kr * 2048 + h * 256; const bf16_t* krp = KR + kr * 64;
      float s = 0.f;
#pragma unroll 4
      for (int d8 = 0; d8 < 16; ++d8) { float kf[8]; unpack8(*(const u32x4*)(kn + d8 * 8), kf); const float4 q0 = *(const float4*)(qs + d8 * 8), q1 = *(const float4*)(qs + d8 * 8 + 4);
        s += q0.x * kf[0] + q0.y * kf[1] + q0.z * kf[2] + q0.w * kf[3] + q1.x * kf[4] + q1.y * kf[5] + q1.z * kf[6] + q1.w * kf[7]; }
#pragma unroll 4
      for (int d8 = 0; d8 < 8; ++d8) { float kf[8]; unpack8(*(const u32x4*)(krp + d8 * 8), kf); const float4 q0 = *(const float4*)(qs + 128 + d8 * 8), q1 = *(const float4*)(qs + 128 + d8 * 8 + 4);
        s += q0.x * kf[0] + q0.y * kf[1] + q0.z * kf[2] + q0.w * kf[3] + q1.x * kf[4] + q1.y * kf[5] + q1.z * kf[6] + q1.w * kf[7]; }
      s *= scale;
      const float mn = fmaxf(m, wave_max(s)), al = __expf(m - mn), pe = __expf(s - mn);
      l = l * al + wave_sum(pe); m = mn; o0 *= al; o1 *= al;
      __syncthreads();
      ps[lane] = pe;
      __syncthreads();
      const bf16_t* vp = KV + (size_t)(b * NKEY + k0) * 2048 + h * 256 + 128 + lane * 2;
#pragma unroll 8
      for (int kk = 0; kk < 64; ++kk) { const unsigned w = *(const unsigned*)(vp + (size_t)kk * 2048); const float pk = ps[kk]; o0 += pk * lo2f(w); o1 += pk * hi2f(w); }
    }
    const float invL = 1.f / l;
    *(unsigned*)(Q + qoff + lane * 2) = pack2(o0 * invL, o1 * invL);
  }
}

namespace at {
constexpr int QBLK = 32, KVBLK = 64;
constexpr float SCALE = 0.07216878364870322f;
constexpr float THR = 8.f;
constexpr int SHM_V = KVBLK * 128 * 2, SHM_K = KVBLK * 192 * 2;
using s16x4 = __attribute__((ext_vector_type(4))) short;
#define KSWZ(row, colB) ((row) * 384 + ((colB) ^ (((row) & 7) << 4)))
#define SBAR() __builtin_amdgcn_sched_barrier(0)
DEVI int crow(int r, int hi) { return (r & 3) + 8 * (r >> 2) + 4 * hi; }
DEVI unsigned cvtpk(float lo, float hi) { unsigned r; asm volatile("v_cvt_pk_bf16_f32 %0, %1, %2" : "=v"(r) : "v"(lo), "v"(hi)); return r; }
DEVI void partialSM(f32x16& p0, f32x16& p1, float& m_reg, float& mn, float& alpha) {
  constexpr float C = SCALE * 1.4426950408889634f;
  float pmax = p0[0];
#pragma unroll
  for (int r = 1; r < 16; ++r) pmax = fmaxf(pmax, p0[r]);
#pragma unroll
  for (int r = 0; r < 16; ++r) pmax = fmaxf(pmax, p1[r]);
  { auto rr = __builtin_amdgcn_permlane32_swap(__float_as_uint(pmax), __float_as_uint(pmax), false, false);
    pmax = fmaxf(__uint_as_float(rr[0]), __uint_as_float(rr[1])); }
  if (__builtin_expect(__all(pmax - m_reg <= THR / SCALE), 1)) { mn = m_reg; alpha = 1.f; }
  else { mn = fmaxf(m_reg, pmax); alpha = __builtin_amdgcn_exp2f((m_reg - mn) * C); m_reg = mn; }
  const float mnC = -mn * C;
#pragma unroll
  for (int r = 0; r < 16; ++r) p0[r] = fmaf(p0[r], C, mnC);
#pragma unroll
  for (int r = 0; r < 16; ++r) p1[r] = fmaf(p1[r], C, mnC);
#pragma unroll
  for (int r = 0; r < 16; ++r) p0[r] = __builtin_amdgcn_exp2f(p0[r]);
}
DEVI void finishSM(f32x16& p0, f32x16& p1, float alpha, float& l_reg, bf16x8& pa0, bf16x8& pa1, bf16x8& pa2, bf16x8& pa3) {
#pragma unroll
  for (int r = 0; r < 16; ++r) p1[r] = __builtin_amdgcn_exp2f(p1[r]);
  float ps = 0;
#pragma unroll
  for (int r = 0; r < 16; ++r) ps += p0[r];
#pragma unroll
  for (int r = 0; r < 16; ++r) ps += p1[r];
  { auto rr = __builtin_amdgcn_permlane32_swap(__float_as_uint(ps), __float_as_uint(ps), false, false);
    ps = __uint_as_float(rr[0]) + __uint_as_float(rr[1]); }
  l_reg = l_reg * alpha + ps;
#define PK4(P, BASE, OUT) do { unsigned a0 = cvtpk(P[BASE + 0], P[BASE + 1]), a1 = cvtpk(P[BASE + 2], P[BASE + 3]);   \
    unsigned b0 = cvtpk(P[BASE + 4], P[BASE + 5]), b1 = cvtpk(P[BASE + 6], P[BASE + 7]);                              \
    auto r0 = __builtin_amdgcn_permlane32_swap(a0, b0, false, false); auto r1 = __builtin_amdgcn_permlane32_swap(a1, b1, false, false); \
    u32x4 w = {r0[0], r1[0], r0[1], r1[1]}; OUT = *reinterpret_cast<bf16x8*>(&w); } while (0)
  PK4(p0, 0, pa0); PK4(p0, 8, pa1); PK4(p1, 0, pa2); PK4(p1, 8, pa3);
#undef PK4
}
DEVI void qkt(f32x16& p0, f32x16& p1, const char* Ks, const bf16x8* qr, const char* qrl, int r32, int hi) {
  p0 = f32x16{}; p1 = f32x16{};
#pragma unroll
  for (int d0 = 0; d0 < 12; ++d0) { const int cb = (d0 * 16 + hi * 8) * 2;
    const bf16x8 b0 = *reinterpret_cast<const bf16x8*>(Ks + KSWZ(r32, cb));
    const bf16x8 b1 = *reinterpret_cast<const bf16x8*>(Ks + KSWZ(32 + r32, cb));
    const bf16x8 q = d0 < 8 ? qr[d0 < 8 ? d0 : 0] : *reinterpret_cast<const bf16x8*>(qrl + (d0 - 8) * 1024);
    p0 = __builtin_amdgcn_mfma_f32_32x32x16_bf16(b0, q, p0, 0, 0, 0);
    p1 = __builtin_amdgcn_mfma_f32_32x32x16_bf16(b1, q, p1, 0, 0, 0); }
}
DEVI int v_st(int k, int c) { const int kk = (k & ~0xC) | ((k & 4) << 1) | ((k & 8) >> 1); return ((kk >> 3) * 4 + (c >> 5)) * 512 + ((kk & 7) * 32 + (c & 31)) * 2; }
DEVI int v_rd_base(int lane) { return ((lane & 3) << 3) | (((lane >> 2) & 3) << 6) | (((lane >> 4) & 1) << 5) | (((lane >> 5) & 1) << 8); }
constexpr int v_rd_off(int d0, int ks, int half) { return d0 * 512 + ks * 4096 + half * 2048; }
template <int OFF> DEVI s16x4 tr_read(int vb) { s16x4 r; asm volatile("ds_read_b64_tr_b16 %0, %1 offset:%2" : "=&v"(r) : "v"(vb), "i"(OFF) : "memory"); return r; }
template <int D0> DEVI void pv_one(f32x16& od, int vb, bf16x8 pa0, bf16x8 pa1, bf16x8 pa2, bf16x8 pa3) {
  const s16x4 l0 = tr_read<v_rd_off(D0, 0, 0)>(vb), h0 = tr_read<v_rd_off(D0, 0, 1)>(vb), l1 = tr_read<v_rd_off(D0, 1, 0)>(vb), h1 = tr_read<v_rd_off(D0, 1, 1)>(vb);
  const s16x4 l2 = tr_read<v_rd_off(D0, 2, 0)>(vb), h2 = tr_read<v_rd_off(D0, 2, 1)>(vb), l3 = tr_read<v_rd_off(D0, 3, 0)>(vb), h3 = tr_read<v_rd_off(D0, 3, 1)>(vb);
  asm volatile("s_waitcnt lgkmcnt(0)" ::: "memory"); SBAR();
#define PK(L, H) (bf16x8){L[0], L[1], L[2], L[3], H[0], H[1], H[2], H[3]}
  od = __builtin_amdgcn_mfma_f32_32x32x16_bf16(pa0, PK(l0, h0), od, 0, 0, 0);
  od = __builtin_amdgcn_mfma_f32_32x32x16_bf16(pa1, PK(l1, h1), od, 0, 0, 0);
  od = __builtin_amdgcn_mfma_f32_32x32x16_bf16(pa2, PK(l2, h2), od, 0, 0, 0);
  od = __builtin_amdgcn_mfma_f32_32x32x16_bf16(pa3, PK(l3, h3), od, 0, 0, 0);
#undef PK
}
DEVI void pv_d0(f32x16* o, int vb, bf16x8 pa0, bf16x8 pa1, bf16x8 pa2, bf16x8 pa3) {
  pv_one<0>(o[0], vb, pa0, pa1, pa2, pa3); pv_one<1>(o[1], vb, pa0, pa1, pa2, pa3); pv_one<2>(o[2], vb, pa0, pa1, pa2, pa3); pv_one<3>(o[3], vb, pa0, pa1, pa2, pa3);
}
DEVI void rope_frag(bf16x8& f1, bf16x8& f2, const float* cs) {
  u32x4 w1 = *reinterpret_cast<u32x4*>(&f1), w2 = *reinterpret_cast<u32x4*>(&f2); float a[8], b[8]; unpack8(w1, a); unpack8(w2, b);
  float c[8], s[8];
#pragma unroll
  for (int q = 0; q < 4; ++q) { const float4 t = *(const float4*)(cs + q * 4); c[q * 2] = t.x; s[q * 2] = t.y; c[q * 2 + 1] = t.z; s[q * 2 + 1] = t.w; }
  float x[8], y[8];
#pragma unroll
  for (int j = 0; j < 8; ++j) { x[j] = a[j] * c[j] - b[j] * s[j]; y[j] = a[j] * s[j] + b[j] * c[j]; }
  w1 = (u32x4){cvtpk(x[0], x[1]), cvtpk(x[2], x[3]), cvtpk(x[4], x[5]), cvtpk(x[6], x[7])};
  w2 = (u32x4){cvtpk(y[0], y[1]), cvtpk(y[2], y[3]), cvtpk(y[4], y[5]), cvtpk(y[6], y[7])};
  f1 = *reinterpret_cast<bf16x8*>(&w1); f2 = *reinterpret_cast<bf16x8*>(&w2);
}
DEVI void attn_item(bf16_t* __restrict__ Qb, const bf16_t* __restrict__ Kn, const bf16_t* __restrict__ Vh, const bf16_t* __restrict__ Kr, const float* __restrict__ rope, int pos0, char* lds) {
  const int tid = threadIdx.x, wid = tid >> 6, lane = tid & 63, r32 = lane & 31, hi = lane >> 5;
  char* V_lds = lds; char* K_lds = lds + 2 * SHM_V;
  float* wsl = (float*)(lds + 2 * SHM_V + 2 * SHM_K) + wid * 64; float* li_l = wsl; float* al_l = wsl + 32;
  char* qrl = lds + 2 * SHM_V + 2 * SHM_K + 2048 + wid * 4096 + lane * 16;
  float m_reg = -1e30f, l_reg = 0; f32x16 o[4] = {}; bf16x8 qr[8];
  bf16_t* Qw = Qb + (size_t)(wid * QBLK + r32) * 1536 + hi * 8;
#pragma unroll
  for (int d0 = 0; d0 < 8; ++d0) qr[d0] = *reinterpret_cast<const bf16x8*>(Qw + d0 * 16);
  { bf16x8 q8 = *reinterpret_cast<const bf16x8*>(Qw + 128), q9 = *reinterpret_cast<const bf16x8*>(Qw + 144), q10 = *reinterpret_cast<const bf16x8*>(Qw + 160), q11 = *reinterpret_cast<const bf16x8*>(Qw + 176);
    const int pos = pos0 + wid * QBLK + r32;
    rope_frag(q8, q9, rope + ((pos >> 6) * 16 + hi * 8) * 2); rope_frag(q10, q11, rope + ((pos & 63) * 16 + hi * 8) * 2);
    *reinterpret_cast<bf16x8*>(qrl) = q8; *reinterpret_cast<bf16x8*>(qrl + 1024) = q9; *reinterpret_cast<bf16x8*>(qrl + 2048) = q10; *reinterpret_cast<bf16x8*>(qrl + 3072) = q11; }
  const int sr = tid >> 4, sc = (tid & 15) * 8, vst0 = v_st(sr, sc), vst1 = v_st(32 + sr, sc);
  const int kst0 = KSWZ(sr, sc * 2), kst1 = KSWZ(32 + sr, sc * 2), kst2 = KSWZ(tid >> 3, 256 + (tid & 7) * 16);
  const int goff = sr * 2048 + sc, goffr = (tid >> 3) * 64 + (tid & 7) * 8;
  const int vb0 = (int)(uintptr_t)V_lds + v_rd_base(lane);
  u32x4 sv0, sv1, sk0, sk1, sk2;
#define SLOAD(k0) do { const bf16_t* vp = Vh + (size_t)(k0) * 2048 + goff; const bf16_t* kp = Kn + (size_t)(k0) * 2048 + goff; \
    sv0 = *(const u32x4*)vp; sv1 = *(const u32x4*)(vp + 32 * 2048); sk0 = *(const u32x4*)kp; sk1 = *(const u32x4*)(kp + 32 * 2048); \
    sk2 = *(const u32x4*)(Kr + (size_t)(k0) * 64 + goffr); } while (0)
#define SWRITE(b) do { *(u32x4*)(V_lds + (b) * SHM_V + vst0) = sv0; *(u32x4*)(V_lds + (b) * SHM_V + vst1) = sv1; \
    *(u32x4*)(K_lds + (b) * SHM_K + kst0) = sk0; *(u32x4*)(K_lds + (b) * SHM_K + kst1) = sk1; *(u32x4*)(K_lds + (b) * SHM_K + kst2) = sk2; } while (0)
#define SWAIT() asm volatile("s_waitcnt vmcnt(0)" ::: "memory")
#define RESC(a) do { if (__any((a) < 1.f)) { if (hi == 0) al_l[r32] = (a); asm volatile("s_waitcnt lgkmcnt(0)" ::: "memory"); \
    _Pragma("unroll") for (int d = 0; d < 4; ++d) _Pragma("unroll") for (int r = 0; r < 16; ++r) o[d][r] *= al_l[crow(r, hi)]; } } while (0)
  f32x16 pA0, pA1, pB0, pB1; float mnA, mnB, alA, alB; bf16x8 pa0, pa1, pa2, pa3; constexpr int NT = NKEY / KVBLK;
  SLOAD(0); SWAIT(); SWRITE(0); __syncthreads();
  qkt(pA0, pA1, K_lds, qr, qrl, r32, hi); partialSM(pA0, pA1, m_reg, mnA, alA);
  SLOAD(KVBLK);
  SWAIT(); SWRITE(1); __syncthreads();
  for (int j = 1; j + 1 < NT; j += 2) {
    SBAR(); qkt(pB0, pB1, K_lds + SHM_K, qr, qrl, r32, hi);
    finishSM(pA0, pA1, alA, l_reg, pa0, pa1, pa2, pa3); SBAR();
    SLOAD((j + 1) * KVBLK); SBAR();
    pv_d0(o, vb0, pa0, pa1, pa2, pa3); partialSM(pB0, pB1, m_reg, mnB, alB);
    __syncthreads(); SWAIT(); SWRITE(0);
    RESC(alB); __syncthreads();
    SBAR(); qkt(pA0, pA1, K_lds, qr, qrl, r32, hi);
    finishSM(pB0, pB1, alB, l_reg, pa0, pa1, pa2, pa3); SBAR();
    SLOAD((j + 2) * KVBLK); SBAR();
    pv_d0(o, vb0 + SHM_V, pa0, pa1, pa2, pa3); partialSM(pA0, pA1, m_reg, mnA, alA);
    __syncthreads(); SWAIT(); SWRITE(1);
    RESC(alA); __syncthreads();
  }
  SBAR(); qkt(pB0, pB1, K_lds + SHM_K, qr, qrl, r32, hi);
  finishSM(pA0, pA1, alA, l_reg, pa0, pa1, pa2, pa3); SBAR();
  pv_d0(o, vb0, pa0, pa1, pa2, pa3); partialSM(pB0, pB1, m_reg, mnB, alB);
  __syncthreads(); RESC(alB);
  finishSM(pB0, pB1, alB, l_reg, pa0, pa1, pa2, pa3); SBAR();
  pv_d0(o, vb0 + SHM_V, pa0, pa1, pa2, pa3);
  if (hi == 0) li_l[r32] = l_reg; asm volatile("s_waitcnt lgkmcnt(0)" ::: "memory");
  float rli[16];
#pragma unroll
  for (int r = 0; r < 16; ++r) rli[r] = __builtin_amdgcn_rcpf(li_l[crow(r, hi)]);
  bf16_t* Ow = Qb + (size_t)(wid * QBLK) * 1536;
#pragma unroll
  for (int r = 0; r < 16; ++r) { const int orow = crow(r, hi);
#pragma unroll
    for (int d0 = 0; d0 < 4; ++d0) Ow[(size_t)orow * 1536 + d0 * 32 + r32] = f2bf(o[d0][r] * rli[r]); }
  __syncthreads();
#undef SLOAD
#undef SWRITE
#undef SWAIT
#undef RESC
}
}
DEVI void attn_mfma(const Params& p, char* smem) {
  bf16_t* Q = (bf16_t*)(p.ws + O_RQ); const bf16_t* KV = (const bf16_t*)(p.ws + O_RKV); const bf16_t* KR = (const bf16_t*)(p.ws + O_KR);
  const float* rope = (const float*)(p.ws + O_ROPE);
  for (int it = blockIdx.x; it < NB * 8 * (SEQ / 256); it += gridDim.x) {
    const int bh = (it >> 8) * 8 + (it & 7), qb = (it & 255) >> 3, b = bh >> 3, h = bh & 7;
    at::attn_item(Q + (size_t)(b * SEQ + qb * 256) * 1536 + h * 192, KV + (size_t)b * NKEY * 2048 + h * 256, KV + (size_t)b * NKEY * 2048 + h * 256 + 128,
                  KR + (size_t)b * NKEY * 64, rope, qb * 256, smem);
  }
}

namespace a8 {
constexpr int KVBLK = 64, SHM_K = KVBLK * 192, SHM_V = 128 * KVBLK;
constexpr float SCALE = 0.07216878364870322f, THR = 1.5f;
using i32x8 = __attribute__((ext_vector_type(8))) int;
DEVI int crow(int r, int hi) { return (r & 3) + 8 * (r >> 2) + 4 * hi; }
DEVI f32x16 mma(const i32x8& a, const i32x8& b, const f32x16& c) { return __builtin_amdgcn_mfma_scale_f32_32x32x64_f8f6f4(a, b, c, 0, 0, 0, 0x7f7f7f7f, 0, 0x7f7f7f7f); }
DEVI void partialSM(f32x16& p0, f32x16& p1, float& m_reg, float& mn, float& alpha) {
  constexpr float C = SCALE * 1.4426950408889634f;
  float pmax = p0[0];
#pragma unroll
  for (int r = 1; r < 16; ++r) pmax = fmaxf(pmax, p0[r]);
#pragma unroll
  for (int r = 0; r < 16; ++r) pmax = fmaxf(pmax, p1[r]);
  { auto rr = __builtin_amdgcn_permlane32_swap(__float_as_uint(pmax), __float_as_uint(pmax), false, false);
    pmax = fmaxf(__uint_as_float(rr[0]), __uint_as_float(rr[1])); }
  if (__builtin_expect(__all(pmax - m_reg <= THR / SCALE), 1)) { mn = m_reg; alpha = 1.f; }
  else { mn = fmaxf(m_reg, pmax); alpha = __builtin_amdgcn_exp2f((m_reg - mn) * C); m_reg = mn; }
  const float mnC = 6.f - mn * C;
#pragma unroll
  for (int r = 0; r < 16; ++r) p0[r] = fmaf(p0[r], C, mnC);
#pragma unroll
  for (int r = 0; r < 16; ++r) p1[r] = fmaf(p1[r], C, mnC);
#pragma unroll
  for (int r = 0; r < 16; ++r) p0[r] = __builtin_amdgcn_exp2f(p0[r]);
}
DEVI void finishSM(f32x16& p0, f32x16& p1, float alpha, float& l_reg, i32x8& pa) {
#pragma unroll
  for (int r = 0; r < 16; ++r) p1[r] = __builtin_amdgcn_exp2f(p1[r]);
  float ps = 0;
#pragma unroll
  for (int r = 0; r < 16; ++r) ps += p0[r];
#pragma unroll
  for (int r = 0; r < 16; ++r) ps += p1[r];
  { auto rr = __builtin_amdgcn_permlane32_swap(__float_as_uint(ps), __float_as_uint(ps), false, false);
    ps = __uint_as_float(rr[0]) + __uint_as_float(rr[1]); }
  l_reg = l_reg * alpha + ps;
#pragma unroll
  for (int j = 0; j < 4; ++j) { pa[j] = pk4_fp8(p0[4 * j], p0[4 * j + 1], p0[4 * j + 2], p0[4 * j + 3]); pa[4 + j] = pk4_fp8(p1[4 * j], p1[4 * j + 1], p1[4 * j + 2], p1[4 * j + 3]); }
}
DEVI i32x8 ld32(const char* p0, const char* p1) { const u32x4 a = *(const u32x4*)p0, b = *(const u32x4*)p1; return (i32x8){(int)a[0], (int)a[1], (int)a[2], (int)a[3], (int)b[0], (int)b[1], (int)b[2], (int)b[3]}; }
DEVI void qkt(f32x16& p0, f32x16& p1, const char* Ks, const i32x8* qf, int r32, int hi) {
  p0 = f32x16{}; p1 = f32x16{};
  const int sw = (r32 >> 2) & 3; const char* k0 = Ks + r32 * 192; const char* k1 = k0 + 32 * 192;
#pragma unroll
  for (int m = 0; m < 3; ++m) { const int c0 = ((4 * m + 2 * hi) ^ sw) << 4, c1 = ((4 * m + 2 * hi + 1) ^ sw) << 4;
    p0 = mma(ld32(k0 + c0, k0 + c1), qf[m], p0);
    p1 = mma(ld32(k1 + c0, k1 + c1), qf[m], p1); }
}
DEVI void pv(f32x16* o, const char* Vs, const i32x8& pa, int r32, int hi) {
  const int sw = (r32 >> 2) & 3, c0 = ((2 * hi) ^ sw) << 4, c1 = ((2 * hi + 1) ^ sw) << 4;
#pragma unroll
  for (int db = 0; db < 4; ++db) { const char* vr = Vs + (32 * db + r32) * 64; o[db] = mma(pa, ld32(vr + c0, vr + c1), o[db]); }
}
DEVI void attn_item(bf16_t* __restrict__ Qb, const unsigned char* __restrict__ Kg, const unsigned char* __restrict__ Vg, const float* __restrict__ rope, int pos0, char* lds) {
  const int tid = threadIdx.x, wid = tid >> 6, lane = tid & 63, r32 = lane & 31, hi = lane >> 5;
  char* V_lds = lds; char* K_lds = lds + 3 * SHM_V;
  float* wsl = (float*)(lds + 3 * SHM_V + 2 * SHM_K) + wid * 64; float* li_l = wsl; float* al_l = wsl + 32;
  float m_reg = -1e30f, l_reg = 0; f32x16 o[4] = {}; i32x8 qf[3];
  { const bf16_t* Qw = Qb + (size_t)(wid * 32 + r32) * 1536 + hi * 32;
#pragma unroll
    for (int m = 0; m < 3; ++m) { float x[32];
#pragma unroll
      for (int q = 0; q < 4; ++q) unpack8(*(const u32x4*)(Qw + m * 64 + q * 8), x + q * 8);
      if (m == 2) { const int pos = pos0 + wid * 32 + r32, pp = hi ? (pos & 63) : (pos >> 6); const float* cs = rope + pp * 32;
#pragma unroll
        for (int j = 0; j < 16; ++j) { const float c = cs[j * 2], sn = cs[j * 2 + 1], x1 = x[j], x2 = x[16 + j]; x[j] = x1 * c - x2 * sn; x[16 + j] = x1 * sn + x2 * c; } }
#pragma unroll
      for (int q = 0; q < 8; ++q) qf[m][q] = pk4_fp8(x[q * 4], x[q * 4 + 1], x[q * 4 + 2], x[q * 4 + 3]);
      __builtin_amdgcn_sched_barrier(0); } }
  const int kp0 = wid * 64 + lane, kkey0 = kp0 / 12, kc0 = kp0 - kkey0 * 12, kp1 = kp0 + 512, kkey1 = kp1 / 12, kc1 = kp1 - kkey1 * 12;
  const unsigned koff0 = (unsigned)(kkey0 * 192 + ((kc0 ^ ((kkey0 >> 2) & 3)) << 4)), koff1 = (unsigned)(kkey1 * 192 + ((kc1 ^ ((kkey1 >> 2) & 3)) << 4));
  const int vd = kp0 >> 2, vc = kp0 & 3; const unsigned voff = (unsigned)(vd * NKEY + ((vc ^ ((vd >> 2) & 3)) << 4));
  const bool two = __builtin_amdgcn_readfirstlane(wid) < 4;
#define GSTAGE(t, kb, vb) do { const unsigned char* ks = Kg + (size_t)(t) * SHM_K; const unsigned char* vs = Vg + (t) * KVBLK; \
    __builtin_amdgcn_global_load_lds((const unsigned*)(ks + koff0), (unsigned*)(K_lds + (kb) * SHM_K + wid * 1024), 16, 0, 0); \
    if (two) __builtin_amdgcn_global_load_lds((const unsigned*)(ks + koff1), (unsigned*)(K_lds + (kb) * SHM_K + 8192 + wid * 1024), 16, 0, 0); \
    __builtin_amdgcn_global_load_lds((const unsigned*)(vs + voff), (unsigned*)(V_lds + (vb) + wid * 1024), 16, 0, 0); } while (0)
#define SWAIT() asm volatile("s_waitcnt vmcnt(0)" ::: "memory")
#define SBAR() __builtin_amdgcn_sched_barrier(0)
#define RESC(a) do { if (__any((a) < 1.f)) { if (hi == 0) al_l[r32] = (a); asm volatile("s_waitcnt lgkmcnt(0)" ::: "memory"); \
    _Pragma("unroll") for (int d = 0; d < 4; ++d) _Pragma("unroll") for (int r = 0; r < 16; ++r) o[d][r] *= al_l[crow(r, hi)]; } } while (0)
  f32x16 pA0, pA1, pB0, pB1; float mnA, mnB, alA, alB; i32x8 pa; constexpr int NT = NKEY / KVBLK;
  int v0 = 0, v1 = SHM_V, v2 = 2 * SHM_V;
  GSTAGE(0, 0, v0); SWAIT(); __syncthreads();
  qkt(pA0, pA1, K_lds, qf, r32, hi); partialSM(pA0, pA1, m_reg, mnA, alA);
  GSTAGE(1, 1, v1); SWAIT(); __syncthreads();
  for (int j = 1; j + 1 < NT; j += 2) {
    SBAR(); qkt(pB0, pB1, K_lds + SHM_K, qf, r32, hi);
    finishSM(pA0, pA1, alA, l_reg, pa); SBAR();
    GSTAGE(j + 1, 0, v2); SBAR();
    pv(o, V_lds + v0, pa, r32, hi); partialSM(pB0, pB1, m_reg, mnB, alB);
    SWAIT(); __syncthreads();
    RESC(alB);
    SBAR(); qkt(pA0, pA1, K_lds, qf, r32, hi);
    finishSM(pB0, pB1, alB, l_reg, pa); SBAR();
    GSTAGE(j + 2, 1, v0); SBAR();
    pv(o, V_lds + v1, pa, r32, hi); partialSM(pA0, pA1, m_reg, mnA, alA);
    SWAIT(); __syncthreads();
    RESC(alA);
    { const int t = v0; v0 = v2; v2 = v1; v1 = t; }
  }
  SBAR(); qkt(pB0, pB1, K_lds + SHM_K, qf, r32, hi);
  finishSM(pA0, pA1, alA, l_reg, pa); SBAR();
  pv(o, V_lds + v0, pa, r32, hi); partialSM(pB0, pB1, m_reg, mnB, alB);
  RESC(alB);
  finishSM(pB0, pB1, alB, l_reg, pa); SBAR();
  pv(o, V_lds + v1, pa, r32, hi);
  if (hi == 0) li_l[r32] = l_reg; asm volatile("s_waitcnt lgkmcnt(0)" ::: "memory");
  float rli[16];
#pragma unroll
  for (int r = 0; r < 16; ++r) rli[r] = __builtin_amdgcn_rcpf(li_l[crow(r, hi)]);
  bf16_t* Ow = Qb + (size_t)(wid * 32) * 1536;
#pragma unroll
  for (int r = 0; r < 16; ++r) { const int orow = crow(r, hi);
#pragma unroll
    for (int d0 = 0; d0 < 4; ++d0) Ow[(size_t)orow * 1536 + d0 * 32 + r32] = f2bf(o[d0][r] * rli[r]); }
  __syncthreads();
#undef GSTAGE
#undef SWAIT
#undef SBAR
#undef RESC
}
}
DEVI void attn_fp8(const Params& p, char* smem) {
  bf16_t* Q = (bf16_t*)(p.ws + O_RQ); const unsigned char* K8 = (const unsigned char*)(p.ws + O_K8); const unsigned char* V8 = (const unsigned char*)(p.ws + O_V8T);
  const float* rope = (const float*)(p.ws + O_ROPE);
  for (int it = blockIdx.x; it < NB * 8 * (SEQ / 256); it += gridDim.x) {
    const int bh = (it >> 8) * 8 + (it & 7), qb = (it & 255) >> 3, b = bh >> 3, h = bh & 7;
    a8::attn_item(Q + (size_t)(b * SEQ + qb * 256) * 1536 + h * 192, K8 + (size_t)bh * NKEY * 192, V8 + (size_t)bh * 128 * NKEY, rope, qb * 256, smem);
  }
}
#if ATTN_FP8
DEVI void ph_attn(const Params& p, char* smem) { attn_fp8(p, smem); }
#elif ATTN_MFMA
DEVI void ph_attn(const Params& p, char* smem) { attn_mfma(p, smem); }
#else
DEVI void ph_attn(const Params& p, char* smem) { attn_naive(p, smem); }
#endif

DEVI void ph_rows(const Params& p, char* smem) {
  const int tid = threadIdx.x, wave = tid >> 6, lane = tid & 63;
  const float* MOD = (const float*)(p.ws + O_MOD); const bf16_t* Y = (const bf16_t*)(p.ws + O_RA); const float* rssy = (const float*)(p.ws + O_RSSY);
  bf16_t* HX2 = (bf16_t*)(p.ws + O_RB);
  for (int row = blockIdx.x * NWAVE + wave; row < NTOK; row += gridDim.x * NWAVE) {
    const int b = row >> 13; const float* md = MOD + b * 6144;
    float ty = 0.f; { const float* pr = rssy + (size_t)row * 32;
#pragma unroll
      for (int j = 0; j < 32; ++j) ty += pr[j]; }
    const float ry = rsqrtf(ty * (1.f / 1024.f) + EPS);
    float x1[16]; float ss = 0.f;
#pragma unroll
    for (int i = 0; i < 4; ++i) { const int c = i * 256 + lane * 4; const float4 xv = *(const float4*)(p.x + (size_t)row * 1024 + c); const u32x2 yv = *(const u32x2*)(Y + (size_t)row * 1024 + c);
      const float4 gp = *(const float4*)(p.g_post1 + c), gt = *(const float4*)(md + 2048 + c);
      x1[i * 4 + 0] = xv.x + gt.x * (lo2f(yv[0]) * ry * gp.x); x1[i * 4 + 1] = xv.y + gt.y * (hi2f(yv[0]) * ry * gp.y);
      x1[i * 4 + 2] = xv.z + gt.z * (lo2f(yv[1]) * ry * gp.z); x1[i * 4 + 3] = xv.w + gt.w * (hi2f(yv[1]) * ry * gp.w);
#pragma unroll
      for (int j = 0; j < 4; ++j) ss += x1[i * 4 + j] * x1[i * 4 + j];
      *(float4*)(p.out + (size_t)row * 1024 + c) = make_float4(x1[i * 4], x1[i * 4 + 1], x1[i * 4 + 2], x1[i * 4 + 3]); }
    ss = wave_sum(ss); const float r2 = rsqrtf(ss * (1.f / 1024.f) + EPS);
#pragma unroll
    for (int i = 0; i < 4; ++i) { const int c = i * 256 + lane * 4; const float4 g2 = *(const float4*)(p.g_pre2 + c), sc = *(const float4*)(md + 4096 + c), sh = *(const float4*)(md + 3072 + c);
      st4bf(HX2 + (size_t)row * 1024 + c, x1[i * 4] * r2 * g2.x * (1.f + sc.x) + sh.x, x1[i * 4 + 1] * r2 * g2.y * (1.f + sc.y) + sh.y,
            x1[i * 4 + 2] * r2 * g2.z * (1.f + sc.z) + sh.z, x1[i * 4 + 3] * r2 * g2.w * (1.f + sc.w) + sh.w); }
  }
  convert_table_fp8(p.u_exp, (unsigned char*)(p.ws + O_RC), (float*)(p.ws + O_RC + (size_t)16384 * 1024));
}

DEVI void topk_naive(const Params& p, char* smem) {
  const int tid = threadIdx.x, wave = tid >> 6, lane = tid & 63;
  float* wl = (float*)smem + wave * 512; int* wi = (int*)wl;
  const bf16_t* QP = (const bf16_t*)(p.ws + O_RKV); const bf16_t* K1 = (const bf16_t*)(p.ws + O_K1); const bf16_t* K2 = (const bf16_t*)(p.ws + O_K2);
  int* IDX = (int*)(p.ws + O_RQ); float* GW = (float*)(p.ws + O_RQ + (size_t)NTOK * 128 * 4);
  for (int base = blockIdx.x * NWAVE; base < NTOK * 8; base += gridDim.x * NWAVE) {
    const int it = base + wave, token = it >> 3, h = it & 7;
    __syncthreads();
    const bf16_t* q = QP + (size_t)token * 2048 + h * 256;
    for (int d = lane; d < 256; d += 64) wl[d] = bf2f(q[d]);
    __syncthreads();
    float s[4] = {0.f, 0.f, 0.f, 0.f};
#pragma unroll 2
    for (int d8 = 0; d8 < 16; ++d8) {
      const float4 qa0 = *(const float4*)(wl + d8 * 8), qa1 = *(const float4*)(wl + d8 * 8 + 4), qb0 = *(const float4*)(wl + 128 + d8 * 8), qb1 = *(const float4*)(wl + 128 + d8 * 8 + 4);
#pragma unroll
      for (int w = 0; w < 4; ++w) { const int key = lane + (w & 1) * 64; const bf16_t* kp = (w < 2 ? K1 : K2) + key * 128;
        float kf[8]; unpack8(*(const u32x4*)(kp + d8 * 8), kf); const float4 q0 = w < 2 ? qa0 : qb0, q1 = w < 2 ? qa1 : qb1;
        s[w] += q0.x * kf[0] + q0.y * kf[1] + q0.z * kf[2] + q0.w * kf[3] + q1.x * kf[4] + q1.y * kf[5] + q1.z * kf[6] + q1.w * kf[7]; }
    }
#pragma unroll
    for (int half = 0; half < 2; ++half) { float a0 = s[half * 2], a1 = s[half * 2 + 1];
#pragma unroll 1
      for (int r = 0; r < 16; ++r) { float v; int i; if (a0 >= a1) { v = a0; i = lane; } else { v = a1; i = lane + 64; }
        for (int o = 32; o > 0; o >>= 1) { const float ov = __shfl_xor(v, o); const int oi = __shfl_xor(i, o); if (ov > v || (ov == v && oi < i)) { v = ov; i = oi; } }
        if (i == lane) a0 = -3.0e38f; else if (i == lane + 64) a1 = -3.0e38f;
        if (lane == 0) { wl[256 + half * 32 + r] = v; wi[256 + half * 32 + 16 + r] = i; } } }
    __syncthreads();
    float cv[4]; int ci[4];
#pragma unroll
    for (int j = 0; j < 4; ++j) { const int cidx = lane * 4 + j, i = cidx >> 4, jj = cidx & 15; cv[j] = wl[256 + i] + wl[256 + 32 + jj]; ci[j] = wi[256 + 16 + i] * 128 + wi[256 + 32 + 16 + jj]; }
    float myv = 0.f, vmax = 0.f; int myi = 0;
#pragma unroll 1
    for (int r = 0; r < 16; ++r) { float v = cv[0]; int pos = lane * 4, ei = ci[0];
#pragma unroll
      for (int j = 1; j < 4; ++j) if (cv[j] > v) { v = cv[j]; pos = lane * 4 + j; ei = ci[j]; }
      for (int o = 32; o > 0; o >>= 1) { const float ov = __shfl_xor(v, o); const int op = __shfl_xor(pos, o), oe = __shfl_xor(ei, o); if (ov > v || (ov == v && op < pos)) { v = ov; pos = op; ei = oe; } }
#pragma unroll
      for (int j = 0; j < 4; ++j) if (pos == lane * 4 + j) cv[j] = -3.0e38f;
      if (r == 0) vmax = v;
      if (lane == r) { myv = v; myi = ei; } }
    const float e = lane < 16 ? __expf(myv - vmax) : 0.f; const float sum = wave_sum(e);
    if (lane < 16) { IDX[(size_t)token * 128 + h * 16 + lane] = myi; GW[(size_t)token * 128 + h * 16 + lane] = e / sum; }
  }
}

namespace tk {
DEVI int f2sort(float f) { const int i = __float_as_int(f); return i ^ ((i >> 31) & 0x7fffffff); }
DEVI float sort2f(int s) { return __int_as_float(s ^ ((s >> 31) & 0x7fffffff)); }
DEVI void ce_desc(int& a, int& b) { const int hi = max(a, b), lo = min(a, b); a = hi; b = lo; }
DEVI void sort16_desc(int* a) {
#pragma unroll
  for (int lk = 1; lk <= 4; ++lk)
#pragma unroll
    for (int lj = lk - 1; lj >= 0; --lj)
#pragma unroll
      for (int i = 0; i < 16; ++i) { const int j = 1 << lj, k = 1 << lk, l = i ^ j;
        if (l > i) { const int hi = max(a[i], a[l]), lo = min(a[i], a[l]); if ((i & k) == 0) { a[i] = hi; a[l] = lo; } else { a[i] = lo; a[l] = hi; } } }
}
DEVI void bitonic_merge16_desc(int* a) {
#pragma unroll
  for (int lj = 3; lj >= 0; --lj)
#pragma unroll
    for (int i = 0; i < 16; ++i) { const int l = i ^ (1 << lj); if (l > i) ce_desc(a[i], a[l]); }
}
DEVI void merge_top16(int* a, const int* b) {
#pragma unroll
  for (int i = 0; i < 16; ++i) a[i] = max(a[i], b[15 - i]);
  bitonic_merge16_desc(a);
}
DEVI void half_top16(const bf16_t* __restrict__ qrow, const char* Kl, int r32, int hi, int* out) {
  bf16x8 qf[8];
#pragma unroll
  for (int d0 = 0; d0 < 8; ++d0) qf[d0] = *reinterpret_cast<const bf16x8*>(qrow + d0 * 16 + hi * 8);
  int a[64]; const int hi4 = 4 * hi;
#pragma unroll
  for (int kt = 0; kt < 4; ++kt) { f32x16 acc = {};
    const int key = kt * 32 + r32;
#pragma unroll
    for (int d0 = 0; d0 < 8; ++d0) { const bf16x8 kf = *reinterpret_cast<const bf16x8*>(Kl + key * 256 + (((d0 * 2 + hi) ^ (key & 15)) << 4));
      acc = __builtin_amdgcn_mfma_f32_32x32x16_bf16(kf, qf[d0], acc, 0, 0, 0); }
#pragma unroll
    for (int r = 0; r < 16; ++r) { const int kc = kt * 32 + (r & 3) + 8 * (r >> 2); a[kt * 16 + r] = ((f2sort(acc[r]) & ~127) | (127 - kc)) - hi4; } }
  sort16_desc(a); sort16_desc(a + 16); sort16_desc(a + 32); sort16_desc(a + 48);
  merge_top16(a, a + 16); merge_top16(a + 32, a + 48); merge_top16(a, a + 32);
  int L[16], H[16];
#pragma unroll
  for (int i = 0; i < 16; ++i) { auto rr = __builtin_amdgcn_permlane32_swap((unsigned)a[i], (unsigned)a[i], false, false); L[i] = (int)rr[0]; H[i] = (int)rr[1]; }
  merge_top16(L, H);
#pragma unroll
  for (int i = 0; i < 16; ++i) out[i] = L[i];
}
}
DEVI void gather_token(const Params& p, int t, const int* idx, const float* gw);
DEVI void topk_fast(const Params& p, char* smem) {
  const int tid = threadIdx.x, wave = __builtin_amdgcn_readfirstlane(tid >> 6), lane = tid & 63, r32 = lane & 31, hi = lane >> 5;
  const bf16_t* QP = (const bf16_t*)(p.ws + O_RKV);
  char* K1l = smem; char* K2l = smem + 32768; int* tab = (int*)(smem + 65536) + wave * (32 * 33);
  int* idxl = (int*)(smem + 65536 + 8 * 32 * 33 * 4) + wave * 512; float* gwl = (float*)(smem + 65536 + 8 * 32 * 33 * 4 + 8 * 2048) + wave * 512;
  __syncthreads();
  { const bf16_t* K1 = (const bf16_t*)(p.ws + O_K1);
    for (int id = tid; id < 4096; id += NTHR) { const int key = id >> 4, c = id & 15; const u32x4 v = *(const u32x4*)(K1 + (size_t)key * 128 + c * 8);
      *(u32x4*)(smem + key * 256 + ((c ^ (key & 15)) << 4)) = v; } }
  __syncthreads();
  for (int item = blockIdx.x; item < NTOK * 8 / 256; item += gridDim.x) {
    const int row = item * 256 + wave * 32 + r32;
    const bf16_t* qrow = QP + (size_t)row * 256;
    int t1[16], t2[16];
    tk::half_top16(qrow, K1l, r32, hi, t1);
    __builtin_amdgcn_sched_barrier(0);
    tk::half_top16(qrow + 128, K2l, r32, hi, t2);
    __builtin_amdgcn_sched_barrier(0);
    float v1[16], v2[16];
#pragma unroll
    for (int i = 0; i < 16; ++i) { v1[i] = tk::sort2f(t1[i] & ~127); v2[i] = tk::sort2f(t2[i] & ~127); }
    if (hi == 0) {
#pragma unroll
      for (int i = 0; i < 16; ++i) { tab[r32 * 33 + i] = 127 - (t1[i] & 127); tab[r32 * 33 + 16 + i] = 127 - (t2[i] & 127); } }
#define CAND(i, j) ((tk::f2sort(v1[i] + v2[j]) & ~255) | (255 - ((i) * 16 + (j))))
    int g0[16], g1[16], g2[16];
#pragma unroll
    for (int j = 0; j < 16; ++j) g0[j] = CAND(0, j);
#pragma unroll
    for (int j = 0; j < 8; ++j) g1[j] = CAND(1, j);
#pragma unroll
    for (int j = 0; j < 5; ++j) g1[8 + j] = CAND(2, j);
#pragma unroll
    for (int j = 0; j < 3; ++j) g1[13 + j] = CAND(4, j);
#pragma unroll
    for (int j = 0; j < 4; ++j) g2[j] = CAND(3, j);
    g2[4] = CAND(5, 0); g2[5] = CAND(5, 1); g2[6] = CAND(6, 0); g2[7] = CAND(6, 1); g2[8] = CAND(7, 0); g2[9] = CAND(7, 1);
    g2[10] = CAND(8, 0); g2[11] = CAND(9, 0); g2[12] = CAND(10, 0); g2[13] = CAND(11, 0); g2[14] = CAND(12, 0); g2[15] = CAND(13, 0);
    tk::sort16_desc(g1); tk::sort16_desc(g2);
    tk::merge_top16(g0, g1); tk::merge_top16(g0, g2);
    { int x = CAND(14, 0);
#pragma unroll
      for (int i = 0; i < 16; ++i) { const int h = max(g0[i], x); x = min(g0[i], x); g0[i] = h; }
      x = CAND(15, 0);
#pragma unroll
      for (int i = 0; i < 16; ++i) { const int h = max(g0[i], x); x = min(g0[i], x); g0[i] = h; } }
#undef CAND
    asm volatile("s_waitcnt lgkmcnt(0)" ::: "memory");
    if (hi == 0) {
      int ex[16];
#pragma unroll
      for (int k = 0; k < 16; ++k) { const int pos = 255 - (g0[k] & 255); ex[k] = tab[r32 * 33 + (pos >> 4)] * 128 + tab[r32 * 33 + 16 + (pos & 15)]; }
      int* dst = idxl + r32 * 16;
#pragma unroll
      for (int q = 0; q < 4; ++q) *(int4*)(dst + q * 4) = make_int4(ex[q * 4], ex[q * 4 + 1], ex[q * 4 + 2], ex[q * 4 + 3]);
    } else {
      float e[16]; const float vmax = tk::sort2f(g0[0] & ~255); float sum = 0.f;
#pragma unroll
      for (int k = 0; k < 16; ++k) { e[k] = __expf(tk::sort2f(g0[k] & ~255) - vmax); sum += e[k]; }
      const float inv = 1.f / sum; float* dst = gwl + r32 * 16;
#pragma unroll
      for (int q = 0; q < 4; ++q) *(float4*)(dst + q * 4) = make_float4(e[q * 4] * inv, e[q * 4 + 1] * inv, e[q * 4 + 2] * inv, e[q * 4 + 3] * inv);
    }
    asm volatile("s_waitcnt lgkmcnt(0)" ::: "memory"); __builtin_amdgcn_sched_barrier(0);
#pragma unroll 1
    for (int tl = 0; tl < 4; ++tl) gather_token(p, item * 32 + wave * 4 + tl, idxl + tl * 128, gwl + tl * 128);
    asm volatile("s_waitcnt lgkmcnt(0)" ::: "memory"); __builtin_amdgcn_sched_barrier(0);
  }
}
#if TOPK_FAST
DEVI void ph_topk(const Params& p, char* smem) { topk_fast(p, smem); }
#else
DEVI void ph_topk(const Params& p, char* smem) { topk_naive(p, smem); }
#endif

DEVI float wave_sum_dpp(float v) {
  v += __builtin_bit_cast(float, __builtin_amdgcn_update_dpp(0, __builtin_bit_cast(int, v), 0xB1, 0xf, 0xf, true));
  v += __builtin_bit_cast(float, __builtin_amdgcn_update_dpp(0, __builtin_bit_cast(int, v), 0x4E, 0xf, 0xf, true));
  v += __builtin_bit_cast(float, __builtin_amdgcn_update_dpp(0, __builtin_bit_cast(int, v), 0x141, 0xf, 0xf, true));
  v += __builtin_bit_cast(float, __builtin_amdgcn_update_dpp(0, __builtin_bit_cast(int, v), 0x140, 0xf, 0xf, true));
  const int iv = __builtin_bit_cast(int, v);
  return (__builtin_bit_cast(float, __builtin_amdgcn_readlane(iv, 0)) + __builtin_bit_cast(float, __builtin_amdgcn_readlane(iv, 16))) +
         (__builtin_bit_cast(float, __builtin_amdgcn_readlane(iv, 32)) + __builtin_bit_cast(float, __builtin_amdgcn_readlane(iv, 48)));
}
DEVI void fp8x16_to_f32(const u32x4& w, float* f) {
#pragma unroll
  for (int j = 0; j < 4; ++j) { const f32x2_t a = __builtin_amdgcn_cvt_pk_f32_fp8((int)w[j], false), b = __builtin_amdgcn_cvt_pk_f32_fp8((int)w[j], true);
    f[j * 4] = a[0]; f[j * 4 + 1] = a[1]; f[j * 4 + 2] = b[0]; f[j * 4 + 3] = b[1]; }
}
DEVI void gather_token(const Params& p, int t, const int* idx, const float* gw) {
  int lane = threadIdx.x & 63; asm volatile("" : "+v"(lane));
  char* ws = p.ws; asm volatile("" : "+s"(ws));
  const bf16_t* HX2 = (const bf16_t*)(ws + O_RB);
  const unsigned char* UT = (const unsigned char*)(ws + O_RC); const float* SU = (const float*)(ws + O_RC + (size_t)16384 * 1024);
  const unsigned char* VT = (const unsigned char*)(ws + O_RA); const float* SV = (const float*)(ws + O_RA + (size_t)16384 * 1024);
  const float* MOD = (const float*)(ws + O_MOD);
  float xf[16];
  unpack8(*(const u32x4*)(HX2 + (size_t)t * 1024 + lane * 16), xf); unpack8(*(const u32x4*)(HX2 + (size_t)t * 1024 + lane * 16 + 8), xf + 8);
  float acc[16];
#pragma unroll
  for (int j = 0; j < 16; ++j) acc[j] = 0.f;
#pragma unroll 1
  for (int half = 0; half < 2; ++half) {
    const int my_i = idx[half * 64 + lane]; const float my_g = gw[half * 64 + lane];
    const float my_su = SU[my_i], my_sv = SV[my_i];
#pragma unroll 1
    for (int e0 = 0; e0 < 64; e0 += 8) {
      u32x4 uq[8], vq[8]; float cs[8];
#pragma unroll
      for (int j = 0; j < 8; ++j) { const int id = __builtin_amdgcn_readlane(my_i, e0 + j);
        uq[j] = *(const u32x4*)(UT + (size_t)id * 1024 + lane * 16); vq[j] = *(const u32x4*)(VT + (size_t)id * 1024 + lane * 16); }
#pragma unroll
      for (int j = 0; j < 8; ++j) { float uf[16]; fp8x16_to_f32(uq[j], uf); float d = 0.f;
#pragma unroll
        for (int k = 0; k < 16; ++k) d += xf[k] * uf[k];
        cs[j] = d; }
#pragma unroll
      for (int j = 0; j < 8; ++j) { const float d = wave_sum_dpp(cs[j]);
        const float g = __builtin_bit_cast(float, __builtin_amdgcn_readlane(__builtin_bit_cast(int, my_g), e0 + j));
        const float su = __builtin_bit_cast(float, __builtin_amdgcn_readlane(__builtin_bit_cast(int, my_su), e0 + j));
        const float sv = __builtin_bit_cast(float, __builtin_amdgcn_readlane(__builtin_bit_cast(int, my_sv), e0 + j));
        cs[j] = g * gelu_t(d * su) * sv; }
#pragma unroll
      for (int j = 0; j < 8; ++j) { float vf[16]; fp8x16_to_f32(vq[j], vf);
#pragma unroll
        for (int k = 0; k < 16; ++k) acc[k] += cs[j] * vf[k]; }
    }
  }
  float ss = 0.f;
#pragma unroll
  for (int k = 0; k < 16; ++k) ss += acc[k] * acc[k];
  ss = wave_sum(ss); const float rstd = rsqrtf(ss * (1.f / 1024.f) + EPS);
  const int b = t >> 13; const float* gt2 = MOD + b * 6144 + 5120;
  float* op = p.out + (size_t)t * 1024 + lane * 16;
#pragma unroll
  for (int q4 = 0; q4 < 4; ++q4) { float4 xv = *(const float4*)(op + q4 * 4); const float4 gt = *(const float4*)(gt2 + lane * 16 + q4 * 4), gp = *(const float4*)(p.g_post2 + lane * 16 + q4 * 4);
    xv.x += gt.x * (acc[q4 * 4 + 0] * rstd * gp.x); xv.y += gt.y * (acc[q4 * 4 + 1] * rstd * gp.y);
    xv.z += gt.z * (acc[q4 * 4 + 2] * rstd * gp.z); xv.w += gt.w * (acc[q4 * 4 + 3] * rstd * gp.w);
    *(float4*)(op + q4 * 4) = xv; }
}

#define XB_TMO      128
#define XB_XCNT(j)  (256  + 64 * (j))
#define XB_XSUB(j)  (1280 + 64 * (j))
#define XB_XGEN(j)  (2304 + 64 * (j))
#define XB_TOP      3328
#define XB_TOPGEN   3392
#define XCD_BAR_WORDS 3456
#define XB_SPIN_CAP (1u << 18)
#define LAS __attribute__((address_space(3)))
DEVI unsigned xb_ld(unsigned* p)              { return __hip_atomic_load(p, __ATOMIC_RELAXED, __HIP_MEMORY_SCOPE_AGENT); }
DEVI unsigned xb_add(unsigned* p, unsigned v) { return __hip_atomic_fetch_add(p, v, __ATOMIC_RELAXED, __HIP_MEMORY_SCOPE_AGENT); }
DEVI unsigned xb_xcc_id() { return (unsigned)__builtin_amdgcn_s_getreg((3 << 11) | 20) & 0xFu; }
#define XB_SPIN(cond, bar) do { unsigned _sp = 0; while (cond) { __builtin_amdgcn_s_sleep(1); \
    if ((++_sp & 255u) == 0u) { if (xb_ld(&(bar)[XB_TMO])) break; if (_sp > XB_SPIN_CAP) { atomicAdd(&(bar)[XB_TMO], 1u); break; } } } } while (0)
struct XcdBarrier { unsigned* bar; unsigned x; volatile LAS unsigned* st; };
DEVI XcdBarrier xcd_barrier_post(unsigned* bar, volatile LAS unsigned* st) {
  XcdBarrier b; b.bar = bar; b.x = xb_xcc_id(); b.st = st;
  if (threadIdx.x == 0) (void)xb_add(&bar[XB_XCNT(b.x)], 1u);
  return b;
}
DEVI void xcd_barrier_complete(unsigned* bar, unsigned x, unsigned& nloc, unsigned& nx) {
  const unsigned G = gridDim.x * gridDim.y * gridDim.z;
  unsigned sum, cnt, mine, sp = 0u;
  for (;;) {
    sum = 0u; cnt = 0u; mine = 0u;
#pragma unroll
    for (unsigned j = 0; j < 16; ++j) { const unsigned c = xb_ld(&bar[XB_XCNT(j)]); sum += c; cnt += (c > 0u) ? 1u : 0u; mine = (j == x) ? c : mine; }
    if (sum == G) break;
    __builtin_amdgcn_s_sleep(1);
    if ((++sp & 255u) == 0u) { if (xb_ld(&bar[XB_TMO])) break; if (sp > XB_SPIN_CAP) { atomicAdd(&bar[XB_TMO], 1u); break; } }
  }
  nloc = mine > 0u ? mine : 1u; nx = cnt > 0u ? cnt : 1u;
}
DEVI void xcd_barrier(const XcdBarrier& b) {
  asm volatile("s_waitcnt vmcnt(0)" ::: "memory");
  __syncthreads();
  if (threadIdx.x == 0) {
    unsigned* bar = b.bar;
    __builtin_amdgcn_s_waitcnt(0);
    unsigned nloc = b.st[0], nx = b.st[1];
    if (nloc == 0u) { xcd_barrier_complete(bar, b.x, nloc, nx); b.st[0] = nloc; b.st[1] = nx; }
    const unsigned old = xb_add(&bar[XB_XSUB(b.x)], 1u);
    const unsigned gen = old / nloc;
    if (old + 1u == (gen + 1u) * nloc) {
      __builtin_amdgcn_fence(__ATOMIC_RELEASE, "agent");
      asm volatile("s_waitcnt vmcnt(0)" ::: "memory");
      const unsigned og = xb_add(&bar[XB_TOP], 1u);
      const unsigned tg = og / nx;
      if (og + 1u == (tg + 1u) * nx) xb_add(&bar[XB_TOPGEN], 1u);
      else XB_SPIN(xb_ld(&bar[XB_TOPGEN]) == tg, bar);
      __builtin_amdgcn_fence(__ATOMIC_ACQUIRE, "agent");
      xb_add(&bar[XB_XGEN(b.x)], 1u);
      asm volatile("s_waitcnt vmcnt(0)" ::: "memory");
    } else {
      XB_SPIN(xb_ld(&bar[XB_XGEN(b.x)]) == gen, bar);
      __builtin_amdgcn_fence(__ATOMIC_ACQUIRE, "agent");
      asm volatile("s_waitcnt vmcnt(0)" ::: "memory");
    }
  }
  __syncthreads();
}

constexpr int NPHASE = 11;
template <int PH> DEVI void run_phase(const Params& p, char* smem) {
  if constexpr (PH == 0) ph_prep(p, smem);
  else if constexpr (PH == 1) ph_hx(p, smem);
  else if constexpr (PH == 2) ph_inproj(p, smem);
  else if constexpr (PH == 3) ph_mid(p, smem);
  else if constexpr (PH == 4) ph_attn(p, smem);
  else if constexpr (PH == 5) ph_gates(p, smem);
  else if constexpr (PH == 6) ph_merge(p, smem);
  else if constexpr (PH == 7) ph_wo(p, smem);
  else if constexpr (PH == 8) ph_rows(p, smem);
  else if constexpr (PH == 9) ph_wpq(p, smem);
  else if constexpr (PH == 10) ph_topk(p, smem);
}

template <int PH> __global__ __launch_bounds__(NTHR) void k_phase(Params p) {
  extern __shared__ __attribute__((aligned(16))) char smem[];
  run_phase<PH>(p, smem);
}

#ifndef PROBE_PH
#define PROBE_PH -1
#endif
#if MEGA
#define RUNPH(N) do { if (PROBE_PH == N) t0 = __builtin_amdgcn_s_memrealtime(); run_phase<N>(p, smem); if (N < NPHASE - 1) xcd_barrier(xb); \
    if (PROBE_PH == N) t1 = __builtin_amdgcn_s_memrealtime(); } while (0)
__global__ __launch_bounds__(NTHR) void k_mega(Params p) {
  extern __shared__ __attribute__((aligned(16))) char smem[];
  cg::grid_group grid = cg::this_grid();
  unsigned long long t0 = 0, t1 = 0;
  unsigned* bar = (unsigned*)(p.ws + O_BAR);
  volatile LAS unsigned* xst = (volatile LAS unsigned*)(smem + LDS_BYTES - 16);
  if (threadIdx.x == 0) { xst[0] = 0u; xst[1] = 0u; }
  __syncthreads();
  const XcdBarrier xb = xcd_barrier_post(bar, xst);
  if (p.out == nullptr) grid.sync();
  RUNPH(0);
  RUNPH(1); RUNPH(2); RUNPH(3); RUNPH(4); RUNPH(5); RUNPH(6); RUNPH(7); RUNPH(8); RUNPH(9); RUNPH(10);
  if (PROBE_PH >= 0) { __syncthreads(); if (blockIdx.x == 0 && threadIdx.x == 0) p.out[0] += exp2f(rintf(log2f((float)(t1 - t0) * 1e-3f) * 5.f) * 0.2f); }
}
#endif

template <int PH> static void launch_phase(const Params& p, int grid, hipStream_t stream) {
  hipLaunchKernelGGL(k_phase<PH>, dim3(grid), dim3(NTHR), LDS_BYTES, stream, p);
}
template <int PH> static void set_attr() { (void)hipFuncSetAttribute((const void*)k_phase<PH>, hipFuncAttributeMaxDynamicSharedMemorySize, LDS_BYTES); }

extern "C" void kernel_launch(void* const* d_in, const int* in_sizes, int n_in, void* d_out, int out_size, void* d_ws, size_t ws_size, hipStream_t stream) {
  static int grid = 0;
  if (grid == 0) {
    if (n_in != 26 || out_size != NTOK * DM || ws_size < O_END) { fprintf(stderr, "kernel_launch: unexpected shapes n_in %d out %d ws %zu (need %zu)\n", n_in, out_size, ws_size, (size_t)O_END); grid = -1; return; }
#if MEGA
    (void)hipFuncSetAttribute((const void*)k_mega, hipFuncAttributeMaxDynamicSharedMemorySize, LDS_BYTES);
    int dev = 0, cus = 0, per_cu = 0; (void)hipGetDevice(&dev); (void)hipDeviceGetAttribute(&cus, hipDeviceAttributeMultiprocessorCount, dev);
    (void)hipOccupancyMaxActiveBlocksPerMultiprocessor(&per_cu, (const void*)k_mega, NTHR, LDS_BYTES);
    if (per_cu < 1) { fprintf(stderr, "kernel_launch: occupancy query says %d blocks per CU\n", per_cu); grid = -1; return; }
    grid = cus;
#else
    set_attr<0>(); set_attr<1>(); set_attr<2>(); set_attr<3>(); set_attr<4>(); set_attr<5>(); set_attr<6>(); set_attr<7>(); set_attr<8>(); set_attr<9>(); set_attr<10>(); set_attr<11>();
    grid = 256;
#endif
  }
  if (grid < 0) return;
  Params p{};
  const float** pp = (const float**)&p;
  for (int i = 0; i < 26; ++i) pp[i] = (const float*)d_in[i];
  p.out = (float*)d_out; p.ws = (char*)d_ws;
#if MEGA
  (void)hipMemsetAsync((char*)d_ws + O_BAR, 0, (size_t)XCD_BAR_WORDS * 4, stream);
  void* args[] = {&p};
  hipError_t e = hipLaunchCooperativeKernel((const void*)k_mega, dim3(grid), dim3(NTHR), args, LDS_BYTES, stream);
  if (e != hipSuccess) fprintf(stderr, "cooperative launch failed: %s (grid %d)\n", hipGetErrorString(e), grid);
#else
  launch_phase<0>(p, grid, stream); launch_phase<1>(p, grid, stream); launch_phase<2>(p, grid, stream); launch_phase<3>(p, grid, stream);
  launch_phase<4>(p, grid, stream); launch_phase<5>(p, grid, stream); launch_phase<6>(p, grid, stream); launch_phase<7>(p, grid, stream);
  launch_phase<8>(p, grid, stream); launch_phase<9>(p, grid, stream); launch_phase<10>(p, grid, stream); launch_phase<11>(p, grid, stream);
#endif
}
```

```cpp
#include <hip/hip_runtime.h>
#include <hip/hip_cooperative_groups.h>
#include <cstdint>
#include <cstdio>
namespace cg = cooperative_groups;

#ifndef MEGA
#define MEGA 1
#endif
#ifndef GEMM_MFMA
#define GEMM_MFMA 1
#endif
#ifndef ATTN_MFMA
#define ATTN_MFMA 1
#endif
#ifndef GATHER_FP6
#define GATHER_FP6 1
#endif
#ifndef GEMM_8PH
#define GEMM_8PH 1
#endif
#ifndef GEMM_KS_SBAR
#define GEMM_KS_SBAR 0
#endif
#ifndef ATTN_FP8
#define ATTN_FP8 1
#endif
#ifndef TOPK_FAST
#define TOPK_FAST 1
#endif

#define DEVI __device__ __forceinline__
typedef unsigned short bf16_t;
using bf16x8 = __attribute__((ext_vector_type(8))) short;
using bf16x4 = __attribute__((ext_vector_type(4))) short;
using f32x4  = __attribute__((ext_vector_type(4))) float;
using f32x16 = __attribute__((ext_vector_type(16))) float;
using u32x4  = __attribute__((ext_vector_type(4))) unsigned;
using u32x2  = __attribute__((ext_vector_type(2))) unsigned;

constexpr int DM = 1024, NB = 2, SEQ = 8192, NTOK = NB * SEQ, CTXL = 256, NCTX = NB * CTXL, NROW = NTOK + NCTX, NKEY = SEQ + CTXL;
constexpr int INW = 4544, INWP = 4608;
constexpr int NPRE = 2560;
constexpr float EPS = 1e-6f;
constexpr int NTHR = 512, NWAVE = 8;
constexpr int LDS_BYTES = 147456;

constexpr size_t al256(size_t x) { return (x + 255) / 256 * 256; }
constexpr size_t O_WIN   = 0;
constexpr size_t O_WUQ   = O_WIN  + al256((size_t)INWP * 1024 * 2);
constexpr size_t O_WUKV  = O_WUQ  + al256((size_t)1536 * 256 * 2);
constexpr size_t O_WPA   = O_WUKV + al256((size_t)2048 * 128 * 2);
constexpr size_t O_WPB   = O_WPA  + al256((size_t)1024 * 1024 * 2);
constexpr size_t O_WO    = O_WPB  + al256((size_t)1024 * 1024 * 2);
constexpr size_t O_WPQ   = O_WO   + al256((size_t)1024 * 1024 * 2);
constexpr size_t O_WS    = O_WPQ  + al256((size_t)2048 * 1024 * 2);
constexpr size_t O_K1    = O_WS   + al256((size_t)8 * 128 * 128 * 2);
constexpr size_t O_K2    = O_K1   + al256((size_t)128 * 128 * 2);
constexpr size_t O_MOD   = O_K2   + al256((size_t)128 * 128 * 2);
constexpr size_t O_ROPE  = O_MOD  + al256((size_t)3 * 6144 * 4);
constexpr size_t O_BAR   = O_ROPE + al256((size_t)128 * 16 * 2 * 4);
constexpr size_t O_RSSV  = O_BAR + al256((size_t)3456 * 4);
constexpr size_t O_RSSQ  = O_RSSV + (size_t)NTOK * 32 * 4;
constexpr size_t O_RSSKV = O_RSSQ + (size_t)NTOK * 8 * 4;
constexpr size_t O_RSSY  = O_RSSKV + (size_t)NROW * 4 * 4;
constexpr size_t O_RSSEND = O_RSSY + (size_t)NTOK * 32 * 4;
constexpr size_t O_RA    = al256(O_RSSEND);
constexpr size_t O_RB    = O_RA  + al256((size_t)NROW * 1024 * 2);
constexpr size_t O_RC    = O_RB  + al256((size_t)NTOK * 1024 * 2);
constexpr size_t O_CQ    = O_RC  + al256((size_t)NTOK * 1024 * 2);
constexpr size_t O_CKV   = O_CQ  + al256((size_t)NTOK * 256 * 2);
constexpr size_t O_KR    = O_CKV + al256((size_t)NROW * 128 * 2);
constexpr size_t O_RQ    = O_KR  + al256((size_t)NROW * 64 * 2);
constexpr size_t O_RKV   = O_RQ  + al256((size_t)NTOK * 1536 * 2);
constexpr size_t O_END   = O_RKV + al256((size_t)NROW * 2048 * 2);
static_assert(O_END <= (size_t)258 * 1024 * 1024, "workspace too large");

struct Params {
  const float *x, *c, *ctx, *c_ctx, *w_mod, *b_mod, *g_pre1, *g_post1, *g_pre2, *g_post2, *w_in, *g_q, *g_kv, *w_uq, *w_ukv, *g_sgu, *w_s, *b_s,
      *w_pa, *w_pb, *w_o, *w_pq, *k1, *k2, *u_exp, *v_exp;
  float* out; char* ws;
};

DEVI float bf2f(unsigned short h) { return __uint_as_float(((unsigned)h) << 16); }
DEVI unsigned short f2bf(float f) { unsigned u = __float_as_uint(f); u += 0x7fffu + ((u >> 16) & 1u); return (unsigned short)(u >> 16); }
DEVI unsigned pack2(float a, float b) { return (unsigned)f2bf(a) | ((unsigned)f2bf(b) << 16); }
DEVI float lo2f(unsigned w) { return __uint_as_float(w << 16); }
DEVI float hi2f(unsigned w) { return __uint_as_float(w & 0xffff0000u); }
DEVI void unpack8(const u32x4& w, float* f) {
  f[0] = lo2f(w[0]); f[1] = hi2f(w[0]); f[2] = lo2f(w[1]); f[3] = hi2f(w[1]); f[4] = lo2f(w[2]); f[5] = hi2f(w[2]); f[6] = lo2f(w[3]); f[7] = hi2f(w[3]);
}
DEVI float gelu_t(float x) { float z = 0.7978845608028654f * (x + 0.044715f * x * x * x); return x / (1.f + __expf(-2.f * z)); }
DEVI float sigmoidf_(float x) { return 1.f / (1.f + __expf(-x)); }
DEVI float wave_sum(float v) { for (int o = 32; o > 0; o >>= 1) v += __shfl_xor(v, o); return v; }
DEVI float wave_max(float v) { for (int o = 32; o > 0; o >>= 1) v = fmaxf(v, __shfl_xor(v, o)); return v; }
DEVI int keyrow(int row) { if (row < NTOK) return (row >> 13) * NKEY + (row & 8191); int c = row - NTOK; return (c >> 8) * NKEY + SEQ + (c & 255); }

__device__ const float ROPE_FREQ[16] = {1.0f, 0.5623413324356079f, 0.3162277638912201f, 0.17782793939113617f, 0.10000000149011612f, 0.05623413249850273f, 0.03162277489900589f, 0.017782794311642647f, 0.009999999776482582f, 0.005623413249850273f, 0.003162277629598975f, 0.0017782794311642647f, 0.0010000000474974513f, 0.000562341301701963f, 0.0003162277571391314f, 0.00017782794020604342f};
DEVI void sincos_small(double a, double& cs, double& sn) {
  const double k = rint(a * 0.15915494309189535); const double r = fma(-k, 6.283185307179586, a) - k * 2.4492935982947064e-16;
  const double r2 = r * r; double s = 0.0, c = 0.0;
#pragma unroll
  for (int n = 12; n >= 1; --n) { s = (1.0 - s * r2 / (double)((2 * n) * (2 * n + 1))); c = (1.0 - c * r2 / (double)((2 * n - 1) * (2 * n))); }
  sn = r * s; cs = c;
}

DEVI void transpose_job(const float* __restrict__ src, int K, int N, bf16_t* __restrict__ dst, const float* __restrict__ gk, bool isWin, int ntiles, char* smem) {
  const int tid = threadIdx.x; bf16_t* tl = (bf16_t*)smem; const int kt = K / 64;
  for (int idx = blockIdx.x; idx < ntiles; idx += gridDim.x) {
    const int ktile = idx % kt, ntile = idx / kt, k0 = ktile * 64, n0d = ntile * 64;
    int n0s = n0d; bool zero = false;
    if (isWin) { if (n0d == 2496) zero = true; else if (n0d >= 2560) n0s = n0d - 64; }
    { const int kk = tid >> 3, nn8 = (tid & 7) * 8; f32x4 va = {0.f, 0.f, 0.f, 0.f}, vb = va;
      if (!zero) { const float* s = src + (size_t)(k0 + kk) * N + n0s + nn8; const float4 a = *(const float4*)s, b = *(const float4*)(s + 4);
        const float sc = gk ? gk[k0 + kk] : 1.f; va = (f32x4){a.x, a.y, a.z, a.w} * sc; vb = (f32x4){b.x, b.y, b.z, b.w} * sc; }
      bf16_t* tp = tl + nn8 * 72 + kk;
      tp[0] = f2bf(va[0]); tp[72] = f2bf(va[1]); tp[144] = f2bf(va[2]); tp[216] = f2bf(va[3]); tp[288] = f2bf(vb[0]); tp[360] = f2bf(vb[1]); tp[432] = f2bf(vb[2]); tp[504] = f2bf(vb[3]); }
    __syncthreads();
    { const int nn = tid >> 3, kk8 = (tid & 7) * 8;
      const u32x4 o = *(const u32x4*)(tl + nn * 72 + kk8);
      *(u32x4*)(dst + (size_t)(n0d + nn) * K + k0 + kk8) = o; }
    __syncthreads();
  }
}

DEVI void ph_prep(const Params& p, char* smem) {
  const int tid = threadIdx.x, bid = blockIdx.x, nb = gridDim.x;
  char* ws = p.ws;
  if (bid == 0) { float* rope = (float*)(ws + O_ROPE);
    for (int i = tid; i < 128 * 16; i += NTHR) { const int pos = i >> 4, f = i & 15; const float ang = (float)pos * ROPE_FREQ[f];
      double cs, sn; sincos_small((double)ang, cs, sn); rope[i * 2] = (float)cs; rope[i * 2 + 1] = (float)sn; } }
  { float* red = (float*)smem; float* MOD = (float*)(ws + O_MOD);
    for (int it = bid; it < 256; it += nb) {
      const int cgp = tid % 6, kg = tid / 6;
      f32x4 a0 = {0.f, 0.f, 0.f, 0.f}, a1 = a0, a2 = a0;
      if (tid < 510) {
        for (int k = kg; k < 1024; k += 85) {
          const float4 w4 = *(const float4*)(p.w_mod + (size_t)k * 6144 + it * 24 + cgp * 4);
          const f32x4 w = {w4.x, w4.y, w4.z, w4.w};
          const float c0 = p.c[k], c1 = p.c[1024 + k], c2 = p.c_ctx[k];
          a0 += w * (c0 / (1.f + __expf(-c0))); a1 += w * (c1 / (1.f + __expf(-c1))); a2 += w * (c2 / (1.f + __expf(-c2)));
        }
        float* rp = red + kg * 72 + cgp * 4;
        rp[0] = a0[0]; rp[1] = a0[1]; rp[2] = a0[2]; rp[3] = a0[3];
        rp[24] = a1[0]; rp[25] = a1[1]; rp[26] = a1[2]; rp[27] = a1[3];
        rp[48] = a2[0]; rp[49] = a2[1]; rp[50] = a2[2]; rp[51] = a2[3];
      }
      __syncthreads();
      if (tid < 72) { float s = 0.f; for (int g = 0; g < 85; ++g) s += red[g * 72 + tid]; int r = tid / 24, n = it * 24 + tid % 24; MOD[r * 6144 + n] = s + p.b_mod[n]; }
      __syncthreads();
    } }
  transpose_job(p.w_in,  1024, INW,  (bf16_t*)(ws + O_WIN),  nullptr, true,  1152, smem);
  transpose_job(p.w_uq,  256,  1536, (bf16_t*)(ws + O_WUQ),  p.g_q,   false, 96,   smem);
  transpose_job(p.w_ukv, 128,  2048, (bf16_t*)(ws + O_WUKV), p.g_kv,  false, 64,   smem);
  transpose_job(p.w_pa,  1024, 1024, (bf16_t*)(ws + O_WPA),  nullptr, false, 256,  smem);
  transpose_job(p.w_pb,  1024, 1024, (bf16_t*)(ws + O_WPB),  nullptr, false, 256,  smem);
  transpose_job(p.w_o,   1024, 1024, (bf16_t*)(ws + O_WO),   nullptr, false, 256,  smem);
  transpose_job(p.w_pq,  1024, 2048, (bf16_t*)(ws + O_WPQ),  nullptr, false, 512,  smem);
  { const int n8 = (131072 + 16384 + 16384) / 8;
    for (int i = bid * NTHR + tid; i < n8; i += nb * NTHR) {
      int e = i * 8; const float* s; bf16_t* d;
      if (e < 131072) { s = p.w_s + e; d = (bf16_t*)(ws + O_WS) + e; }
      else if (e < 131072 + 16384) { s = p.k1 + (e - 131072); d = (bf16_t*)(ws + O_K1) + (e - 131072); }
      else { s = p.k2 + (e - 131072 - 16384); d = (bf16_t*)(ws + O_K2) + (e - 131072 - 16384); }
      const float4 a = *(const float4*)s, b = *(const float4*)(s + 4);
      u32x4 o = {pack2(a.x, a.y), pack2(a.z, a.w), pack2(b.x, b.y), pack2(b.z, b.w)};
      *(u32x4*)d = o;
    } }
}

typedef float f32x2_t __attribute__((ext_vector_type(2)));
DEVI void convert_table_fp8(const float* __restrict__ src, unsigned char* __restrict__ dst, float* __restrict__ scale) {
  const int wave = threadIdx.x >> 6, lane = threadIdx.x & 63;
  for (int row = blockIdx.x * NWAVE + wave; row < 16384; row += gridDim.x * NWAVE) {
    const float* sp = src + (size_t)row * 1024 + lane * 16;
    float4 v[4]; float am = 0.f;
#pragma unroll
    for (int j = 0; j < 4; ++j) { v[j] = *(const float4*)(sp + j * 4); am = fmaxf(am, fmaxf(fmaxf(fabsf(v[j].x), fabsf(v[j].y)), fmaxf(fabsf(v[j].z), fabsf(v[j].w)))); }
    am = wave_max(am);
    const float inv = am > 0.f ? 240.f / am : 0.f;
    u32x4 o;
#pragma unroll
    for (int j = 0; j < 4; ++j) { int w = __builtin_amdgcn_cvt_pk_fp8_f32(v[j].x * inv, v[j].y * inv, 0, false); w = __builtin_amdgcn_cvt_pk_fp8_f32(v[j].z * inv, v[j].w * inv, w, true); o[j] = (unsigned)w; }
    *(u32x4*)(dst + (size_t)row * 1024 + lane * 16) = o;
    if (lane == 0) scale[row] = am * (1.f / 240.f);
  }
}


using f32x32 = __attribute__((ext_vector_type(32))) float;
using u32x6 = __attribute__((ext_vector_type(6))) unsigned;
typedef u32x4 __attribute__((aligned(4))) u32x4_u;
typedef u32x2 __attribute__((aligned(4))) u32x2_u;
DEVI void convert_table_fp6(const float* __restrict__ src, unsigned char* __restrict__ dst, float* __restrict__ scale) {
  const int wave = threadIdx.x >> 6, lane = threadIdx.x & 63, h = lane >> 5, g = lane & 31;
  for (int rp = blockIdx.x * NWAVE + wave; rp < 8192; rp += gridDim.x * NWAVE) {
    const int row = rp * 2 + h;
    const float* sp = src + (size_t)row * 1024 + g * 32;
    f32x16 a, b; float am = 0.f;
#pragma unroll
    for (int j = 0; j < 4; ++j) { const float4 t = *(const float4*)(sp + j * 4), u = *(const float4*)(sp + 16 + j * 4);
      a[j * 4] = t.x; a[j * 4 + 1] = t.y; a[j * 4 + 2] = t.z; a[j * 4 + 3] = t.w; b[j * 4] = u.x; b[j * 4 + 1] = u.y; b[j * 4 + 2] = u.z; b[j * 4 + 3] = u.w;
      am = fmaxf(am, fmaxf(fmaxf(fmaxf(fabsf(t.x), fabsf(t.y)), fmaxf(fabsf(t.z), fabsf(t.w))), fmaxf(fmaxf(fabsf(u.x), fabsf(u.y)), fmaxf(fabsf(u.z), fabsf(u.w))))); }
    for (int o = 16; o > 0; o >>= 1) am = fmaxf(am, __shfl_xor(am, o));
    const float inv = am > 0.f ? 7.5f / am : 0.f;
    const u32x6 w = __builtin_amdgcn_cvt_scalef32_2xpk16_fp6_f32(a * inv, b * inv, 1.0f);
    unsigned char* dp = dst + (size_t)row * 768 + g * 24;
    *(u32x4_u*)dp = (u32x4){w[0], w[1], w[2], w[3]}; *(u32x2_u*)(dp + 16) = (u32x2){w[4], w[5]};
    if (g == 0) scale[row] = am * (1.f / 7.5f);
  }
}

DEVI void ph_hx(const Params& p, char* smem) {
  const int tid = threadIdx.x, wave = tid >> 6, lane = tid & 63;
  float* mA = (float*)smem; float* mB = mA + 3 * 1024;
  const float* MOD = (const float*)(p.ws + O_MOD);
  for (int i = tid; i < 3072; i += NTHR) { int r = i >> 10, c = i & 1023; mA[i] = p.g_pre1[c] * (1.f + MOD[r * 6144 + 1024 + c]); mB[i] = MOD[r * 6144 + c]; }
  __syncthreads();
  bf16_t* HX = (bf16_t*)(p.ws + O_RA);
  for (int row = blockIdx.x * NWAVE + wave; row < NROW; row += gridDim.x * NWAVE) {
    const float* src = row < NTOK ? p.x + (size_t)row * 1024 : p.ctx + (size_t)(row - NTOK) * 1024;
    const int mr = row < NTOK ? (row >> 13) : 2;
    float4 v[4]; float ss = 0.f;
#pragma unroll
    for (int i = 0; i < 4; ++i) { v[i] = *(const float4*)(src + i * 256 + lane * 4); ss += v[i].x * v[i].x + v[i].y * v[i].y + v[i].z * v[i].z + v[i].w * v[i].w; }
    ss = wave_sum(ss); const float rstd = rsqrtf(ss * (1.f / 1024.f) + EPS);
#pragma unroll
    for (int i = 0; i < 4; ++i) { const int c = i * 256 + lane * 4; const float* a = mA + mr * 1024 + c; const float* b = mB + mr * 1024 + c;
      u32x2 o = {pack2(v[i].x * rstd * a[0] + b[0], v[i].y * rstd * a[1] + b[1]), pack2(v[i].z * rstd * a[2] + b[2], v[i].w * rstd * a[3] + b[3])};
      *(u32x2*)(HX + (size_t)row * 1024 + c) = o; }
  }
}

DEVI int lds_sw(int row, int c) { return row * 128 + ((c ^ (row & 7)) << 4); }
template <int BM, int BN, bool ACOLMAP, bool GLDS, class Epi>
DEVI void gemm_tile_mfma(const bf16_t* __restrict__ A, int lda, const bf16_t* __restrict__ Bm, int ldb, int K, int row0, int col0, const Epi& epi, const float* kscale, char* smem) {
  constexpr int WNW = BN / 64, WMW = 8 / WNW, WTM = BM / WMW, MI = WTM / 16, ACH = BM / 64, BCH = BN / 64, ABYTES = BM * 128, BBYTES = BN * 128, STAGE = ABYTES + BBYTES;
  int tid = threadIdx.x; asm volatile("" : "+v"(tid));
  const int wave = __builtin_amdgcn_readfirstlane(tid >> 6), lane = tid & 63, wm = wave / WNW, wn = wave % WNW, l15 = lane & 15, lq = lane >> 4;
  f32x4 acc[MI][4];
#pragma unroll
  for (int mi = 0; mi < MI; ++mi)
#pragma unroll
    for (int ni = 0; ni < 4; ++ni) acc[mi][ni] = (f32x4){0.f, 0.f, 0.f, 0.f};
  const int nk = K >> 6;
  const int sr = tid >> 3, scc = tid & 7;
  auto compute = [&](int buf) {
    const char* sa = smem + buf * STAGE; const char* sb = sa + ABYTES;
#pragma unroll
    for (int ks = 0; ks < 2; ++ks) { const int kc = ks * 4 + lq; bf16x8 bfr[4];
#pragma unroll
      for (int ni = 0; ni < 4; ++ni) bfr[ni] = *(const bf16x8*)(sb + lds_sw(wn * 64 + ni * 16 + l15, kc));
#pragma unroll
      for (int mi = 0; mi < MI; ++mi) { const bf16x8 af = *(const bf16x8*)(sa + lds_sw(wm * WTM + mi * 16 + l15, kc));
#pragma unroll
        for (int ni = 0; ni < 4; ++ni) acc[mi][ni] = __builtin_amdgcn_mfma_f32_16x16x32_bf16(bfr[ni], af, acc[mi][ni], 0, 0, 0); }
      if (MI > 4 && GEMM_KS_SBAR) __builtin_amdgcn_sched_barrier(0); }
  };
  if constexpr (GLDS) {
    const unsigned aoff = (unsigned)(sr * lda + ((scc ^ (sr & 7)) * 8)) * 2u, boff = (unsigned)(sr * ldb + ((scc ^ (sr & 7)) * 8)) * 2u;
    auto gstage = [&](int buf, int kt) {
      const int k0 = kt * 64, ka = ACOLMAP ? k0 + (k0 >> 7) * 64 : k0;
      char* sa = smem + buf * STAGE + wave * 1024; char* sb = sa + ABYTES;
#pragma unroll
      for (int i = 0; i < ACH; ++i) __builtin_amdgcn_global_load_lds((const unsigned*)((const char*)(A + (size_t)(64 * i) * lda + ka) + aoff), (unsigned*)(sa + i * 8192), 16, 0, 0);
#pragma unroll
      for (int i = 0; i < BCH; ++i) __builtin_amdgcn_global_load_lds((const unsigned*)((const char*)(Bm + (size_t)(64 * i) * ldb + k0) + boff), (unsigned*)(sb + i * 8192), 16, 0, 0);
    };
    gstage(0, 0); asm volatile("s_waitcnt vmcnt(0)" ::: "memory"); __syncthreads();
    for (int kt = 0; kt < nk; ++kt) {
      if (kt + 1 < nk) gstage((kt + 1) & 1, kt + 1);
      compute(kt & 1);
      asm volatile("s_waitcnt vmcnt(0)" ::: "memory"); __syncthreads();
    }
  } else {
    u32x4 ra[ACH], rb[BCH];
    const unsigned aoff = (unsigned)(sr * lda + scc * 8) * 2u, boff = (unsigned)(sr * ldb + scc * 8) * 2u;
    const int sdst = lds_sw(sr, scc);
    auto gload = [&](int kt) {
      const int k0 = kt * 64, ka = ACOLMAP ? k0 + (k0 >> 7) * 64 : k0;
#pragma unroll
      for (int i = 0; i < ACH; ++i) { const char* ub = (const char*)(A + (size_t)(64 * i) * lda + ka); ra[i] = *(const u32x4*)(ub + aoff); }
#pragma unroll
      for (int i = 0; i < BCH; ++i) { const char* ub = (const char*)(Bm + (size_t)(64 * i) * ldb + k0); rb[i] = *(const u32x4*)(ub + boff); }
    };
    auto lstore = [&](int buf, int kt) {
      char* sa = smem + buf * STAGE + sdst; char* sb = sa + ABYTES;
#pragma unroll
      for (int i = 0; i < ACH; ++i) { u32x4 v = ra[i];
        if (kscale) { float f[8]; unpack8(v, f); const float* ks = kscale + kt * 64 + scc * 8;
          v = (u32x4){pack2(f[0] * ks[0], f[1] * ks[1]), pack2(f[2] * ks[2], f[3] * ks[3]), pack2(f[4] * ks[4], f[5] * ks[5]), pack2(f[6] * ks[6], f[7] * ks[7])}; }
        *(u32x4*)(sa + i * 8192) = v; }
#pragma unroll
      for (int i = 0; i < BCH; ++i) *(u32x4*)(sb + i * 8192) = rb[i];
    };
    gload(0); lstore(0, 0); __syncthreads();
    for (int kt = 0; kt < nk; ++kt) {
      if (kt + 1 < nk) gload(kt + 1);
      compute(kt & 1);
      if (kt + 1 < nk) lstore((kt + 1) & 1, kt + 1);
      __syncthreads();
    }
  }
  int tide = threadIdx.x; asm volatile("" : "+v"(tide));
  const int l15e = tide & 15, lqe = (tide >> 4) & 3;
#pragma unroll
  for (int mi = 0; mi < MI; ++mi) { const int row = row0 + wm * WTM + mi * 16 + l15e; float sq = 0.f;
#pragma unroll
    for (int ni = 0; ni < 4; ++ni) { const float v[4] = {acc[mi][ni][0], acc[mi][ni][1], acc[mi][ni][2], acc[mi][ni][3]}; const float q = epi(row, col0 + wn * 64 + ni * 16 + lqe * 4, v);
      if (Epi::RSS) { sq += q; if (ni & 1) { sq += __shfl_xor(sq, 16); sq += __shfl_xor(sq, 32); if (lqe == 0) epi.rss(row, col0 + wn * 64 + (ni >> 1) * 32, sq); sq = 0.f; } } }
    __builtin_amdgcn_sched_barrier(0); }
}


namespace g8 {
constexpr int BK = 64, HALF = 128, HT = HALF * BK;
DEVI int lds_byte(int r, int c) { const int st = (r >> 4) * 2 + (c >> 5), rr = r & 15, cc = c & 31, ob = rr * 64 + cc * 2; return st * 1024 + (ob ^ (((ob >> 9) & 1) << 5)); }
DEVI void stage_rc(int b, int& R, int& C) { const int st = b / 1024, sb = b % 1024, swz = sb ^ (((sb >> 9) & 1) << 5); R = (st >> 1) * 16 + swz / 64; C = (st & 1) * 32 + (swz % 64) / 2; }
}
template <bool ACOLMAP, class Epi>
DEVI void gemm_tile_8ph(const bf16_t* __restrict__ A, int lda, const bf16_t* __restrict__ Bt, int ldb, int K, int row0, int col0, const Epi& epi, char* smem) {
  using namespace g8;
  bf16_t* shm = (bf16_t*)smem;
#define SA(b, h) (shm + ((b) * 2 + (h)) * HT)
#define SB(b, h) (shm + (4 + (b) * 2 + (h)) * HT)
#define STAGE_A(P, r0, kt) do { const int _k0 = (kt) * BK, _ka = ACOLMAP ? _k0 + (_k0 >> 7) * 64 : _k0; \
    __builtin_amdgcn_global_load_lds((const unsigned*)((const char*)(A + (size_t)(r0) * lda + _ka) + ao0), (unsigned*)((char*)(P) + wid * 1024), 16, 0, 0); \
    __builtin_amdgcn_global_load_lds((const unsigned*)((const char*)(A + (size_t)((r0) + 64) * lda + _ka) + ao0), (unsigned*)((char*)(P) + wid * 1024 + 8192), 16, 0, 0); } while (0)
#define STAGE_B(P, r0, kt) do { const int _k0 = (kt) * BK; \
    __builtin_amdgcn_global_load_lds((const unsigned*)((const char*)(Bt + (size_t)(r0) * ldb + _k0) + bo0), (unsigned*)((char*)(P) + wid * 1024), 16, 0, 0); \
    __builtin_amdgcn_global_load_lds((const unsigned*)((const char*)(Bt + (size_t)((r0) + 64) * ldb + _k0) + bo0), (unsigned*)((char*)(P) + wid * 1024 + 8192), 16, 0, 0); } while (0)
#define LDA(dst, b, h) _Pragma("unroll") for (int m = 0; m < 4; ++m) _Pragma("unroll") for (int k = 0; k < 2; ++k) \
    dst[m][k] = *reinterpret_cast<const bf16x8*>((const char*)SA(b, h) + lds_byte(wr * 64 + m * 16 + fr, k * 32 + fq * 8))
#define LDB(dst, b, h) _Pragma("unroll") for (int n = 0; n < 2; ++n) _Pragma("unroll") for (int k = 0; k < 2; ++k) \
    dst[n][k] = *reinterpret_cast<const bf16x8*>((const char*)SB(b, h) + lds_byte(wc * 32 + n * 16 + fr, k * 32 + fq * 8))
#define MMA(ai, bj, At_, Bt_) do { __builtin_amdgcn_s_setprio(1); \
    _Pragma("unroll") for (int m = 0; m < 4; ++m) _Pragma("unroll") for (int n = 0; n < 2; ++n) _Pragma("unroll") for (int k = 0; k < 2; ++k) \
      acc[ai][bj][m][n] = __builtin_amdgcn_mfma_f32_16x16x32_bf16(Bt_[n][k], At_[m][k], acc[ai][bj][m][n], 0, 0, 0); \
    __builtin_amdgcn_s_setprio(0); } while (0)
#define WAIT_V(n) asm volatile("s_waitcnt vmcnt(" #n ")" ::: "memory")
#define WAIT_L(n) asm volatile("s_waitcnt lgkmcnt(" #n ")" ::: "memory")
#define BAR __builtin_amdgcn_s_barrier()
#define SCHED __builtin_amdgcn_sched_barrier(0)
  int tid = threadIdx.x; asm volatile("" : "+v"(tid));
  const int wid = __builtin_amdgcn_readfirstlane(tid >> 6), lane = tid & 63, wr = wid >> 2, wc = wid & 3, fr = lane & 15, fq = lane >> 4;
  unsigned ao0, bo0;
  { int r, c; stage_rc(tid * 16, r, c); ao0 = (unsigned)(r * lda + c) * 2u; bo0 = (unsigned)(r * ldb + c) * 2u; }
  f32x4 acc[2][2][4][2];
#pragma unroll
  for (int a = 0; a < 2; ++a)
#pragma unroll
    for (int b = 0; b < 2; ++b)
#pragma unroll
      for (int m = 0; m < 4; ++m)
#pragma unroll
        for (int n = 0; n < 2; ++n) acc[a][b][m][n] = (f32x4){0.f, 0.f, 0.f, 0.f};
  bf16x8 At[4][2], B0[2][2], B1[2][2];
  const int nt = K / BK;
  STAGE_B(SB(0, 0), 0, 0); STAGE_A(SA(0, 0), 0, 0);
  STAGE_B(SB(0, 1), HALF, 0); STAGE_A(SA(0, 1), HALF, 0);
  if (wr == 1) BAR;
  WAIT_V(4); BAR;
  STAGE_B(SB(1, 0), 0, 1); STAGE_A(SA(1, 0), 0, 1); STAGE_B(SB(1, 1), HALF, 1);
  WAIT_V(6); BAR;
  for (int t = 0; t < nt - 2; t += 2) {
    LDB(B0, 0, 0); SCHED; LDA(At, 0, 0); STAGE_A(SA(1, 1), HALF, t + 1);
    WAIT_L(8); BAR; WAIT_L(0); MMA(0, 0, At, B0); BAR; SCHED;
    LDB(B1, 0, 1); STAGE_B(SB(0, 0), 0, t + 2);
    BAR; WAIT_L(0); MMA(0, 1, At, B1); BAR;
    LDA(At, 0, 1); STAGE_A(SA(0, 0), 0, t + 2);
    BAR; WAIT_L(0); MMA(1, 0, At, B0); BAR; SCHED;
    STAGE_B(SB(0, 1), HALF, t + 2);
    WAIT_V(6); BAR; MMA(1, 1, At, B1); BAR;
    LDB(B0, 1, 0); SCHED; LDA(At, 1, 0); STAGE_A(SA(0, 1), HALF, t + 2);
    WAIT_L(8); BAR; WAIT_L(0); MMA(0, 0, At, B0); BAR; SCHED;
    LDB(B1, 1, 1); STAGE_B(SB(1, 0), 0, t + 3);
    BAR; WAIT_L(0); MMA(0, 1, At, B1); BAR;
    LDA(At, 1, 1); STAGE_A(SA(1, 0), 0, t + 3);
    BAR; WAIT_L(0); MMA(1, 0, At, B0); BAR; SCHED;
    STAGE_B(SB(1, 1), HALF, t + 3);
    WAIT_V(6); BAR; MMA(1, 1, At, B1); BAR;
  }
  { LDB(B0, 0, 0); LDA(At, 0, 0); STAGE_A(SA(1, 1), HALF, nt - 1);
    BAR; WAIT_L(0); MMA(0, 0, At, B0); BAR;
    LDB(B1, 0, 1); BAR; WAIT_L(0); MMA(0, 1, At, B1); BAR;
    LDA(At, 0, 1); WAIT_V(4); BAR; WAIT_L(0); MMA(1, 0, At, B0); MMA(1, 1, At, B1); BAR; }
  { LDB(B0, 1, 0); LDA(At, 1, 0); WAIT_V(2); BAR; WAIT_L(0); MMA(0, 0, At, B0); BAR;
    LDB(B1, 1, 1); WAIT_V(0); BAR; WAIT_L(0); MMA(0, 1, At, B1); BAR;
    LDA(At, 1, 1); BAR; WAIT_L(0); MMA(1, 0, At, B0); MMA(1, 1, At, B1); BAR; }
  if (wr == 0) BAR;
  int tide = threadIdx.x; asm volatile("" : "+v"(tide));
  const int fre = tide & 15, fqe = (tide >> 4) & 3;
#pragma unroll
  for (int ai = 0; ai < 2; ++ai)
#pragma unroll
    for (int m = 0; m < 4; ++m) { const int row = row0 + ai * HALF + wr * 64 + m * 16 + fre;
#pragma unroll
      for (int bj = 0; bj < 2; ++bj) { float sq = 0.f;
#pragma unroll
        for (int n = 0; n < 2; ++n) { const float v[4] = {acc[ai][bj][m][n][0], acc[ai][bj][m][n][1], acc[ai][bj][m][n][2], acc[ai][bj][m][n][3]};
          sq += epi(row, col0 + bj * HALF + wc * 32 + n * 16 + fqe * 4, v); }
        if (Epi::RSS) { sq += __shfl_xor(sq, 16); sq += __shfl_xor(sq, 32); if (fqe == 0) epi.rss(row, col0 + bj * HALF + wc * 32, sq); } }
      __builtin_amdgcn_sched_barrier(0); }
#undef SA
#undef SB
#undef STAGE_A
#undef STAGE_B
#undef LDA
#undef LDB
#undef MMA
#undef WAIT_V
#undef WAIT_L
#undef BAR
#undef SCHED
}

template <int BM, int BN, bool ACOLMAP, class Epi>
DEVI void gemm_tile(const bf16_t* A, int lda, const bf16_t* Bm, int ldb, int K, int row0, int col0, const Epi& epi, const float* kss, char* smem) {
  if constexpr (BM == 256 && BN == 256 && GEMM_8PH) gemm_tile_8ph<ACOLMAP>(A, lda, Bm, ldb, K, row0, col0, epi, smem);
  else if (kss) gemm_tile_mfma<BM, BN, ACOLMAP, false>(A, lda, Bm, ldb, K, row0, col0, epi, kss, smem);
  else gemm_tile_mfma<BM, BN, ACOLMAP, true>(A, lda, Bm, ldb, K, row0, col0, epi, nullptr, smem);
}

DEVI void st4bf(bf16_t* d, float a, float b, float c, float e) { u32x2 o = {pack2(a, b), pack2(c, e)}; *(u32x2*)d = o; }

struct EpiIn { static constexpr bool RSS = true; bf16_t *GU, *GVT, *CQ, *CKV, *KR; float *rssv, *rssq, *rsskv;
  DEVI float operator()(int row, int col, const float (&v)[4]) const {
    if (col < 1024) { st4bf(GU + (size_t)row * 1024 + col, gelu_t(v[0]), gelu_t(v[1]), gelu_t(v[2]), gelu_t(v[3])); return 0.f; }
    else if (col < 2048) { const int c = col - 1024, chunk = row >> 7, q = row & 127; float s = 0.f;
#pragma unroll
      for (int j = 0; j < 4; ++j) { const float g = gelu_t(v[j]); s += g * g; GVT[((size_t)chunk * 1024 + c + j) * 128 + q] = f2bf(g); }
      return s; }
    else if (col < 2304) { st4bf(CQ + (size_t)row * 256 + (col - 2048), v[0], v[1], v[2], v[3]); return v[0] * v[0] + v[1] * v[1] + v[2] * v[2] + v[3] * v[3]; }
    else if (col < 2432) { st4bf(CKV + (size_t)row * 128 + (col - 2304), v[0], v[1], v[2], v[3]); return v[0] * v[0] + v[1] * v[1] + v[2] * v[2] + v[3] * v[3]; }
    else if (col < 2496) { st4bf(KR + (size_t)keyrow(row) * 64 + (col - 2432), v[0], v[1], v[2], v[3]); return 0.f; }
    return 0.f; }
  DEVI void rss(int row, int col, float s) const {
    if (col >= 1024 && col < 2048) rssv[row * 32 + ((col - 1024) >> 5)] = s; else if (col >= 2048 && col < 2304) rssq[row * 8 + ((col - 2048) >> 5)] = s; else if (col >= 2304 && col < 2432) rsskv[row * 4 + ((col - 2304) >> 5)] = s; }
};
struct EpiQ { static constexpr bool RSS = false; bf16_t* Q; const float* rssq;
  DEVI float operator()(int row, int col, const float (&v)[4]) const { const float4 ps = *(const float4*)(rssq + row * 8), pt = *(const float4*)(rssq + row * 8 + 4); const float r = rsqrtf((((ps.x + ps.y) + (ps.z + ps.w)) + ((pt.x + pt.y) + (pt.z + pt.w))) * (1.f / 256.f) + EPS);
    st4bf(Q + (size_t)row * 1536 + col, v[0] * r, v[1] * r, v[2] * r, v[3] * r); return 0.f; }
  DEVI void rss(int, int, float) const {} };
struct EpiKV { static constexpr bool RSS = false; bf16_t* KV; const float* rsskv;
  DEVI float operator()(int row, int col, const float (&v)[4]) const { const float4 pk = *(const float4*)(rsskv + row * 4); const float r = rsqrtf(((pk.x + pk.y) + (pk.z + pk.w)) * (1.f / 128.f) + EPS);
    st4bf(KV + (size_t)keyrow(row) * 2048 + col, v[0] * r, v[1] * r, v[2] * r, v[3] * r); return 0.f; }
  DEVI void rss(int, int, float) const {} };
DEVI int pk4_fp8(float a, float b, float c, float d) { int w = __builtin_amdgcn_cvt_pk_fp8_f32(a, b, 0, false); return __builtin_amdgcn_cvt_pk_fp8_f32(c, d, w, true); }
constexpr size_t O_K8 = O_RKV, O_V8T = O_RKV + al256((size_t)NB * 8 * NKEY * 192);
struct EpiK8 { static constexpr bool RSS = false; unsigned char* K8; const float* rsskv;
  DEVI float operator()(int row, int col, const float (&v)[4]) const { const float4 pk = *(const float4*)(rsskv + row * 4); const float r = rsqrtf(((pk.x + pk.y) + (pk.z + pk.w)) * (1.f / 128.f) + EPS);
    const int kr = keyrow(row), b = kr / NKEY, key = kr - b * NKEY, h = col >> 7, d = col & 127;
    *(int*)(K8 + ((size_t)(b * 8 + h) * NKEY + key) * 192 + d) = pk4_fp8(v[0] * r, v[1] * r, v[2] * r, v[3] * r); return 0.f; }
  DEVI void rss(int, int, float) const {} };
struct EpiV8T { static constexpr bool RSS = false; unsigned char* V8; const float* rsskv;
  DEVI float operator()(int row, int col, const float (&v)[4]) const {
    float r[4];
#pragma unroll
    for (int j = 0; j < 4; ++j) { const float4 pk = *(const float4*)(rsskv + (col + j) * 4); r[j] = rsqrtf(((pk.x + pk.y) + (pk.z + pk.w)) * (1.f / 128.f) + EPS); }
    const int kr = keyrow(col), b = kr / NKEY, key = kr - b * NKEY, h = row >> 7, d = row & 127, kk = key & 63;
    const int off = 32 * ((kk >> 2) & 1) + 16 * (kk >> 5) + 4 * ((kk >> 3) & 3);
    *(int*)(V8 + ((size_t)(b * 8 + h) * 128 + d) * NKEY + (key & ~63) + off) = pk4_fp8(v[0] * r[0], v[1] * r[1], v[2] * r[2], v[3] * r[3]); return 0.f; }
  DEVI void rss(int, int, float) const {} };
struct EpiSgu { static constexpr bool RSS = false; bf16_t* GUOA; const float* g_sgu; const float* b_s; int chunk, g;
  DEVI float operator()(int row, int col, const float (&v)[4]) const { const int token = chunk * 128 + row, ch = g * 128 + col; const float bias = b_s[g * 128 + row];
    bf16_t* ptr = GUOA + (size_t)token * 1024 + ch; const u32x2 gu = *(const u32x2*)ptr;
    st4bf(ptr, lo2f(gu[0]) * (g_sgu[ch] * v[0] + bias), hi2f(gu[0]) * (g_sgu[ch + 1] * v[1] + bias), lo2f(gu[1]) * (g_sgu[ch + 2] * v[2] + bias), hi2f(gu[1]) * (g_sgu[ch + 3] * v[3] + bias));
    return 0.f; }
  DEVI void rss(int, int, float) const {} };
struct EpiGate { static constexpr bool RSS = false; bf16_t* G;
  DEVI float operator()(int row, int col, const float (&v)[4]) const { st4bf(G + (size_t)row * 2048 + col, sigmoidf_(v[0]), sigmoidf_(v[1]), sigmoidf_(v[2]), sigmoidf_(v[3])); return 0.f; }
  DEVI void rss(int, int, float) const {} };
template <bool SECOND> struct EpiMerge { static constexpr bool RSS = false; bf16_t* M; const bf16_t* G;
  DEVI float operator()(int row, int col, const float (&v)[4]) const { const u32x2 g = *(const u32x2*)(G + (size_t)row * 2048 + (SECOND ? 1024 : 0) + col);
    float o0 = lo2f(g[0]) * v[0], o1 = hi2f(g[0]) * v[1], o2 = lo2f(g[1]) * v[2], o3 = hi2f(g[1]) * v[3];
    bf16_t* ptr = M + (size_t)row * 1024 + col;
    if (SECOND) { const u32x2 m = *(const u32x2*)ptr; o0 += lo2f(m[0]); o1 += hi2f(m[0]); o2 += lo2f(m[1]); o3 += hi2f(m[1]); }
    st4bf(ptr, o0, o1, o2, o3); return 0.f; }
  DEVI void rss(int, int, float) const {} };
struct EpiO { static constexpr bool RSS = true; bf16_t* Y; float* rssy;
  DEVI float operator()(int row, int col, const float (&v)[4]) const { st4bf(Y + (size_t)row * 1024 + col, v[0], v[1], v[2], v[3]); return v[0] * v[0] + v[1] * v[1] + v[2] * v[2] + v[3] * v[3]; }
  DEVI void rss(int row, int col, float s) const { rssy[row * 32 + (col >> 5)] = s; } };
struct EpiPq { static constexpr bool RSS = false; bf16_t* QP;
  DEVI float operator()(int row, int col, const float (&v)[4]) const { st4bf(QP + (size_t)row * 2048 + col, v[0], v[1], v[2], v[3]); return 0.f; }
  DEVI void rss(int, int, float) const {} };

template <class F> DEVI void for_tiles_xcd(int MT, int NT, F f) {
  const int nb = gridDim.x;
  if ((nb & 7) == 0 && (MT & 7) == 0) { const int xcd = blockIdx.x & 7, slot = blockIdx.x >> 3, slots = nb >> 3, mper = MT >> 3, tot = mper * NT;
    for (int j = slot; j < tot; j += slots) f(xcd * mper + j / NT, j % NT); }
  else for (int i = blockIdx.x; i < MT * NT; i += nb) f(i / NT, i % NT);
}

DEVI void ph_inproj(const Params& p, char* smem) {
  char* ws = p.ws;
  EpiIn epi{(bf16_t*)(ws + O_RB), (bf16_t*)(ws + O_RC), (bf16_t*)(ws + O_CQ), (bf16_t*)(ws + O_CKV), (bf16_t*)(ws + O_KR), (float*)(ws + O_RSSV), (float*)(ws + O_RSSQ), (float*)(ws + O_RSSKV)};
  const bf16_t* HX = (const bf16_t*)(ws + O_RA); const bf16_t* W = (const bf16_t*)(ws + O_WIN);
  auto tile = [&](int mt, int nt) { gemm_tile<256, 256, false>(HX + (size_t)mt * 256 * 1024, 1024, W + (size_t)nt * 256 * 1024, 1024, 1024, mt * 256, nt * 256, epi, nullptr, smem); };
  for_tiles_xcd(64, 10, tile);
  for (int i = (int)gridDim.x - 1 - (int)blockIdx.x; i < 2; i += gridDim.x) tile(64 + i, 9);
}
DEVI void rope_kr(const Params& p) {
  bf16_t* KR = (bf16_t*)(p.ws + O_KR); const float* rope = (const float*)(p.ws + O_ROPE);
  for (int i = blockIdx.x * NTHR + threadIdx.x; i < NTOK * 32; i += gridDim.x * NTHR) {
    const int tok = i >> 5, j = i & 15, which = (i >> 4) & 1, pos = tok & 8191, pp = which ? (pos & 63) : (pos >> 6);
    const float cs = rope[(pp * 16 + j) * 2], sn = rope[(pp * 16 + j) * 2 + 1];
    bf16_t* r = KR + (size_t)keyrow(tok) * 64 + which * 32 + j;
    const float x1 = bf2f(r[0]), x2 = bf2f(r[16]);
    r[0] = f2bf(x1 * cs - x2 * sn); r[16] = f2bf(x1 * sn + x2 * cs);
  }
}
DEVI void rope_kr_fp8(const Params& p) {
  const bf16_t* KR = (const bf16_t*)(p.ws + O_KR); const float* rope = (const float*)(p.ws + O_ROPE); unsigned char* K8 = (unsigned char*)(p.ws + O_K8);
  for (int i = blockIdx.x * NTHR + threadIdx.x; i < NROW * 2; i += gridDim.x * NTHR) {
    const int row = i >> 1, which = i & 1, kr = keyrow(row), b = kr / NKEY, key = kr - b * NKEY;
    float x[32];
    const bf16_t* src = KR + (size_t)kr * 64 + which * 32;
#pragma unroll
    for (int q = 0; q < 4; ++q) unpack8(*(const u32x4*)(src + q * 8), x + q * 8);
    if (row < NTOK) { const int pos = row & 8191, pp = which ? (pos & 63) : (pos >> 6); const float* cs = rope + pp * 32;
#pragma unroll
      for (int j = 0; j < 16; ++j) { const float c = cs[j * 2], sn = cs[j * 2 + 1], x1 = x[j], x2 = x[16 + j]; x[j] = x1 * c - x2 * sn; x[16 + j] = x1 * sn + x2 * c; } }
    u32x4 o0, o1;
#pragma unroll
    for (int q = 0; q < 4; ++q) { o0[q] = (unsigned)pk4_fp8(x[q * 4], x[q * 4 + 1], x[q * 4 + 2], x[q * 4 + 3]); o1[q] = (unsigned)pk4_fp8(x[16 + q * 4], x[17 + q * 4], x[18 + q * 4], x[19 + q * 4]); }
#pragma unroll
    for (int h = 0; h < 8; ++h) { unsigned char* d = K8 + ((size_t)(b * 8 + h) * NKEY + key) * 192 + 128 + which * 32; *(u32x4*)d = o0; *(u32x4*)(d + 16) = o1; }
  }
}
DEVI void ph_mid(const Params& p, char* smem) {
  char* ws = p.ws;
  { EpiQ epi{(bf16_t*)(ws + O_RQ), (const float*)(ws + O_RSSQ)};
    const bf16_t* A = (const bf16_t*)(ws + O_CQ); const bf16_t* W = (const bf16_t*)(ws + O_WUQ);
    for_tiles_xcd(64, 12, [&](int mt, int nt) { gemm_tile<256, 128, false>(A + (size_t)mt * 256 * 256, 256, W + (size_t)nt * 128 * 256, 256, 256, mt * 256, nt * 128, epi, nullptr, smem); }); }
#if ATTN_FP8
  { EpiK8 epi{(unsigned char*)(ws + O_K8), (const float*)(ws + O_RSSKV)};
    const bf16_t* A = (const bf16_t*)(ws + O_CKV); const bf16_t* W = (const bf16_t*)(ws + O_WUKV);
    auto tile = [&](int mt, int nt) { gemm_tile<256, 128, false>(A + (size_t)mt * 256 * 128, 128, W + (size_t)nt * 256 * 128, 128, 128, mt * 256, nt * 128, epi, nullptr, smem); };
    for_tiles_xcd(64, 8, tile);
    for (int i = blockIdx.x; i < 16; i += gridDim.x) tile(64 + (i >> 3), i & 7); }
  { EpiV8T epi{(unsigned char*)(ws + O_V8T), (const float*)(ws + O_RSSKV)};
    const bf16_t* A = (const bf16_t*)(ws + O_WUKV); const bf16_t* Bc = (const bf16_t*)(ws + O_CKV);
    for (int i = blockIdx.x; i < 8 * 132; i += gridDim.x) { const int mt = i & 7, nt = i >> 3;
      gemm_tile<128, 128, false>(A + (size_t)(mt * 256 + 128) * 128, 128, Bc + (size_t)nt * 128 * 128, 128, 128, mt * 128, nt * 128, epi, nullptr, smem); } }
#else
  { EpiKV epi{(bf16_t*)(ws + O_RKV), (const float*)(ws + O_RSSKV)};
    const bf16_t* A = (const bf16_t*)(ws + O_CKV); const bf16_t* W = (const bf16_t*)(ws + O_WUKV);
    auto tile = [&](int mt, int nt) { gemm_tile<256, 128, false>(A + (size_t)mt * 256 * 128, 128, W + (size_t)nt * 128 * 128, 128, 128, mt * 256, nt * 128, epi, nullptr, smem); };
    for_tiles_xcd(64, 16, tile);
    for (int i = blockIdx.x; i < 32; i += gridDim.x) tile(64 + (i >> 4), i & 15); }
#endif
  { const bf16_t* WS = (const bf16_t*)(ws + O_WS); const bf16_t* GVT = (const bf16_t*)(ws + O_RC);
    float* ksc = (float*)(smem + LDS_BYTES - 1024); const float* rssv = (const float*)(ws + O_RSSV);
    for (int i = blockIdx.x; i < 1024; i += gridDim.x) { const int chunk = i >> 3, g = i & 7;
      __syncthreads();
      if (threadIdx.x < 128) { const float* pr = rssv + (size_t)(chunk * 128 + threadIdx.x) * 32; float t = 0.f;
#pragma unroll
        for (int j = 0; j < 32; ++j) t += pr[j];
        ksc[threadIdx.x] = rsqrtf(t * (1.f / 1024.f) + EPS); }
      __syncthreads();
      EpiSgu epi{(bf16_t*)(ws + O_RB), p.g_sgu, p.b_s, chunk, g};
      gemm_tile<128, 128, false>(WS + (size_t)g * 16384, 128, GVT + ((size_t)chunk * 1024 + g * 128) * 128, 128, 128, 0, 0, epi, ksc, smem); } }
#if ATTN_FP8
  rope_kr_fp8(p);
#else
  rope_kr(p);
#endif
}
DEVI void ph_gates(const Params& p, char* smem) {
  char* ws = p.ws; EpiGate epi{(bf16_t*)(ws + O_RKV)};
  const bf16_t* HX = (const bf16_t*)(ws + O_RA); const bf16_t* W = (const bf16_t*)(ws + O_WIN) + (size_t)NPRE * 1024;
  for_tiles_xcd(64, 8, [&](int mt, int nt) { gemm_tile<256, 256, false>(HX + (size_t)mt * 256 * 1024, 1024, W + (size_t)nt * 256 * 1024, 1024, 1024, mt * 256, nt * 256, epi, nullptr, smem); });
}
DEVI void ph_merge(const Params& p, char* smem) {
  char* ws = p.ws; bf16_t* M = (bf16_t*)(ws + O_RC); const bf16_t* G = (const bf16_t*)(ws + O_RKV);
  EpiMerge<false> e1{M, G}; EpiMerge<true> e2{M, G};
  const bf16_t* OA = (const bf16_t*)(ws + O_RB); const bf16_t* OB = (const bf16_t*)(ws + O_RQ);
  const bf16_t* WA = (const bf16_t*)(ws + O_WPA); const bf16_t* WB = (const bf16_t*)(ws + O_WPB);
  for_tiles_xcd(64, 4, [&](int mt, int nt) { gemm_tile<256, 256, false>(OA + (size_t)mt * 256 * 1024, 1024, WA + (size_t)nt * 256 * 1024, 1024, 1024, mt * 256, nt * 256, e1, nullptr, smem); });
  for_tiles_xcd(64, 4, [&](int mt, int nt) { gemm_tile<256, 256, true>(OB + (size_t)mt * 256 * 1536, 1536, WB + (size_t)nt * 256 * 1024, 1024, 1024, mt * 256, nt * 256, e2, nullptr, smem); });
}
DEVI void ph_wo(const Params& p, char* smem) {
  char* ws = p.ws; EpiO epi{(bf16_t*)(ws + O_RA), (float*)(ws + O_RSSY)};
  const bf16_t* M = (const bf16_t*)(ws + O_RC); const bf16_t* W = (const bf16_t*)(ws + O_WO);
  for_tiles_xcd(64, 4, [&](int mt, int nt) { gemm_tile<256, 256, false>(M + (size_t)mt * 256 * 1024, 1024, W + (size_t)nt * 256 * 1024, 1024, 1024, mt * 256, nt * 256, epi, nullptr, smem); });
}
DEVI void ph_wpq(const Params& p, char* smem) {
  char* ws = p.ws; EpiPq epi{(bf16_t*)(ws + O_RKV)};
  const bf16_t* A = (const bf16_t*)(ws + O_RB); const bf16_t* W = (const bf16_t*)(ws + O_WPQ);
  for_tiles_xcd(64, 8, [&](int mt, int nt) { gemm_tile<256, 256, false>(A + (size_t)mt * 256 * 1024, 1024, W + (size_t)nt * 256 * 1024, 1024, 1024, mt * 256, nt * 256, epi, nullptr, smem); });
#if GATHER_FP6
  convert_table_fp6(p.v_exp, (unsigned char*)(ws + O_RA), (float*)(ws + O_RA + (size_t)16384 * 1024));
#else
  convert_table_fp8(p.v_exp, (unsigned char*)(ws + O_RA), (float*)(ws + O_RA + (size_t)16384 * 1024));
#endif
}

DEVI void attn_naive(const Params& p, char* smem) {
  const int tid = threadIdx.x, wave = tid >> 6, lane = tid & 63;
  float* qs = (float*)smem + wave * 256; float* ps = qs + 192;
  bf16_t* Q = (bf16_t*)(p.ws + O_RQ); const bf16_t* KV = (const bf16_t*)(p.ws + O_RKV); const bf16_t* KR = (const bf16_t*)(p.ws + O_KR);
  const float* rope = (const float*)(p.ws + O_ROPE);
  const float scale = 0.07216878364870322f;
  for (int base = blockIdx.x * NWAVE; base < NB * 8 * SEQ; base += gridDim.x * NWAVE) {
    const int it = base + wave, bh = it >> 13, qi = it & 8191, b = bh >> 3, h = bh & 7;
    const size_t qoff = (size_t)(b * SEQ + qi) * 1536 + h * 192;
    __syncthreads();
    for (int d = lane; d < 192; d += 64) qs[d] = bf2f(Q[qoff + d]);
    __syncthreads();
    if (lane < 32) { const int j = lane & 15, which = lane >> 4, pp = which ? (qi & 63) : (qi >> 6);
      const float cs = rope[(pp * 16 + j) * 2], sn = rope[(pp * 16 + j) * 2 + 1]; const int d1 = 128 + which * 32 + j, d2 = d1 + 16;
      const float x1 = qs[d1], x2 = qs[d2]; qs[d1] = x1 * cs - x2 * sn; qs[d2] = x1 * sn + x2 * cs; }
    __syncthreads();
    float m = -1e30f, l = 0.f, o0 = 0.f, o1 = 0.f;
    for (int k0 = 0; k0 < NKEY; k0 += 64) {
      const size_t kr = (size_t)(b * NKEY + k0 + lane);
      const bf16_t* kn = KV + kr * 2048 + h * 256; const bf16_t* krp = KR + kr * 64;
      float s = 0.f;
#pragma unroll 4
      for (int d8 = 0; d8 < 16; ++d8) { float kf[8]; unpack8(*(const u32x4*)(kn + d8 * 8), kf); const float4 q0 = *(const float4*)(qs + d8 * 8), q1 = *(const float4*)(qs + d8 * 8 + 4);
        s += q0.x * kf[0] + q0.y * kf[1] + q0.z * kf[2] + q0.w * kf[3] + q1.x * kf[4] + q1.y * kf[5] + q1.z * kf[6] + q1.w * kf[7]; }
#pragma unroll 4
      for (int d8 = 0; d8 < 8; ++d8) { float kf[8]; unpack8(*(const u32x4*)(krp + d8 * 8), kf); const float4 q0 = *(const float4*)(qs + 128 + d8 * 8), q1 = *(const float4*)(qs + 128 + d8 * 8 + 4);
        s += q0.x * kf[0] + q0.y * kf[1] + q0.z * kf[2] + q0.w * kf[3] + q1.x * kf[4] + q1.y * kf[5] + q1.z * kf[6] + q1.w * kf[7]; }
      s *= scale;
      const float mn = fmaxf(m, wave_max(s)), al = __expf(m - mn), pe = __expf(s - mn);
      l = l * al + wave_sum(pe); m = mn; o0 *= al; o1 *= al;
      __syncthreads();
      ps[lane] = pe;
      __syncthreads();
      const bf16_t* vp = KV + (size_t)(b * NKEY + k0) * 2048 + h * 256 + 128 + lane * 2;
#pragma unroll 8
      for (int kk = 0; kk < 64; ++kk) { const unsigned w = *(const unsigned*)(vp + (size_t)kk * 2048); const float pk = ps[kk]; o0 += pk * lo2f(w); o1 += pk * hi2f(w); }
    }
    const float invL = 1.f / l;
    *(unsigned*)(Q + qoff + lane * 2) = pack2(o0 * invL, o1 * invL);
  }
}

namespace at {
constexpr int QBLK = 32, KVBLK = 64;
constexpr float SCALE = 0.07216878364870322f;
constexpr float THR = 8.f;
constexpr int SHM_V = KVBLK * 128 * 2, SHM_K = KVBLK * 192 * 2;
using s16x4 = __attribute__((ext_vector_type(4))) short;
#define KSWZ(row, colB) ((row) * 384 + ((colB) ^ (((row) & 7) << 4)))
#define SBAR() __builtin_amdgcn_sched_barrier(0)
DEVI int crow(int r, int hi) { return (r & 3) + 8 * (r >> 2) + 4 * hi; }
DEVI unsigned cvtpk(float lo, float hi) { unsigned r; asm volatile("v_cvt_pk_bf16_f32 %0, %1, %2" : "=v"(r) : "v"(lo), "v"(hi)); return r; }
DEVI void partialSM(f32x16& p0, f32x16& p1, float& m_reg, float& mn, float& alpha) {
  constexpr float C = SCALE * 1.4426950408889634f;
  float pmax = p0[0];
#pragma unroll
  for (int r = 1; r < 16; ++r) pmax = fmaxf(pmax, p0[r]);
#pragma unroll
  for (int r = 0; r < 16; ++r) pmax = fmaxf(pmax, p1[r]);
  { auto rr = __builtin_amdgcn_permlane32_swap(__float_as_uint(pmax), __float_as_uint(pmax), false, false);
    pmax = fmaxf(__uint_as_float(rr[0]), __uint_as_float(rr[1])); }
  if (__builtin_expect(__all(pmax - m_reg <= THR / SCALE), 1)) { mn = m_reg; alpha = 1.f; }
  else { mn = fmaxf(m_reg, pmax); alpha = __builtin_amdgcn_exp2f((m_reg - mn) * C); m_reg = mn; }
  const float mnC = -mn * C;
#pragma unroll
  for (int r = 0; r < 16; ++r) p0[r] = fmaf(p0[r], C, mnC);
#pragma unroll
  for (int r = 0; r < 16; ++r) p1[r] = fmaf(p1[r], C, mnC);
#pragma unroll
  for (int r = 0; r < 16; ++r) p0[r] = __builtin_amdgcn_exp2f(p0[r]);
}
DEVI void finishSM(f32x16& p0, f32x16& p1, float alpha, float& l_reg, bf16x8& pa0, bf16x8& pa1, bf16x8& pa2, bf16x8& pa3) {
#pragma unroll
  for (int r = 0; r < 16; ++r) p1[r] = __builtin_amdgcn_exp2f(p1[r]);
  float ps = 0;
#pragma unroll
  for (int r = 0; r < 16; ++r) ps += p0[r];
#pragma unroll
  for (int r = 0; r < 16; ++r) ps += p1[r];
  { auto rr = __builtin_amdgcn_permlane32_swap(__float_as_uint(ps), __float_as_uint(ps), false, false);
    ps = __uint_as_float(rr[0]) + __uint_as_float(rr[1]); }
  l_reg = l_reg * alpha + ps;
#define PK4(P, BASE, OUT) do { unsigned a0 = cvtpk(P[BASE + 0], P[BASE + 1]), a1 = cvtpk(P[BASE + 2], P[BASE + 3]);   \
    unsigned b0 = cvtpk(P[BASE + 4], P[BASE + 5]), b1 = cvtpk(P[BASE + 6], P[BASE + 7]);                              \
    auto r0 = __builtin_amdgcn_permlane32_swap(a0, b0, false, false); auto r1 = __builtin_amdgcn_permlane32_swap(a1, b1, false, false); \
    u32x4 w = {r0[0], r1[0], r0[1], r1[1]}; OUT = *reinterpret_cast<bf16x8*>(&w); } while (0)
  PK4(p0, 0, pa0); PK4(p0, 8, pa1); PK4(p1, 0, pa2); PK4(p1, 8, pa3);
#undef PK4
}
DEVI void qkt(f32x16& p0, f32x16& p1, const char* Ks, const bf16x8* qr, const char* qrl, int r32, int hi) {
  p0 = f32x16{}; p1 = f32x16{};
#pragma unroll
  for (int d0 = 0; d0 < 12; ++d0) { const int cb = (d0 * 16 + hi * 8) * 2;
    const bf16x8 b0 = *reinterpret_cast<const bf16x8*>(Ks + KSWZ(r32, cb));
    const bf16x8 b1 = *reinterpret_cast<const bf16x8*>(Ks + KSWZ(32 + r32, cb));
    const bf16x8 q = d0 < 8 ? qr[d0 < 8 ? d0 : 0] : *reinterpret_cast<const bf16x8*>(qrl + (d0 - 8) * 1024);
    p0 = __builtin_amdgcn_mfma_f32_32x32x16_bf16(b0, q, p0, 0, 0, 0);
    p1 = __builtin_amdgcn_mfma_f32_32x32x16_bf16(b1, q, p1, 0, 0, 0); }
}
DEVI int v_st(int k, int c) { const int kk = (k & ~0xC) | ((k & 4) << 1) | ((k & 8) >> 1); return ((kk >> 3) * 4 + (c >> 5)) * 512 + ((kk & 7) * 32 + (c & 31)) * 2; }
DEVI int v_rd_base(int lane) { return ((lane & 3) << 3) | (((lane >> 2) & 3) << 6) | (((lane >> 4) & 1) << 5) | (((lane >> 5) & 1) << 8); }
constexpr int v_rd_off(int d0, int ks, int half) { return d0 * 512 + ks * 4096 + half * 2048; }
template <int OFF> DEVI s16x4 tr_read(int vb) { s16x4 r; asm volatile("ds_read_b64_tr_b16 %0, %1 offset:%2" : "=&v"(r) : "v"(vb), "i"(OFF) : "memory"); return r; }
template <int D0> DEVI void pv_one(f32x16& od, int vb, bf16x8 pa0, bf16x8 pa1, bf16x8 pa2, bf16x8 pa3) {
  const s16x4 l0 = tr_read<v_rd_off(D0, 0, 0)>(vb), h0 = tr_read<v_rd_off(D0, 0, 1)>(vb), l1 = tr_read<v_rd_off(D0, 1, 0)>(vb), h1 = tr_read<v_rd_off(D0, 1, 1)>(vb);
  const s16x4 l2 = tr_read<v_rd_off(D0, 2, 0)>(vb), h2 = tr_read<v_rd_off(D0, 2, 1)>(vb), l3 = tr_read<v_rd_off(D0, 3, 0)>(vb), h3 = tr_read<v_rd_off(D0, 3, 1)>(vb);
  asm volatile("s_waitcnt lgkmcnt(0)" ::: "memory"); SBAR();
#define PK(L, H) (bf16x8){L[0], L[1], L[2], L[3], H[0], H[1], H[2], H[3]}
  od = __builtin_amdgcn_mfma_f32_32x32x16_bf16(pa0, PK(l0, h0), od, 0, 0, 0);
  od = __builtin_amdgcn_mfma_f32_32x32x16_bf16(pa1, PK(l1, h1), od, 0, 0, 0);
  od = __builtin_amdgcn_mfma_f32_32x32x16_bf16(pa2, PK(l2, h2), od, 0, 0, 0);
  od = __builtin_amdgcn_mfma_f32_32x32x16_bf16(pa3, PK(l3, h3), od, 0, 0, 0);
#undef PK
}
DEVI void pv_d0(f32x16* o, int vb, bf16x8 pa0, bf16x8 pa1, bf16x8 pa2, bf16x8 pa3) {
  pv_one<0>(o[0], vb, pa0, pa1, pa2, pa3); pv_one<1>(o[1], vb, pa0, pa1, pa2, pa3); pv_one<2>(o[2], vb, pa0, pa1, pa2, pa3); pv_one<3>(o[3], vb, pa0, pa1, pa2, pa3);
}
DEVI void rope_frag(bf16x8& f1, bf16x8& f2, const float* cs) {
  u32x4 w1 = *reinterpret_cast<u32x4*>(&f1), w2 = *reinterpret_cast<u32x4*>(&f2); float a[8], b[8]; unpack8(w1, a); unpack8(w2, b);
  float c[8], s[8];
#pragma unroll
  for (int q = 0; q < 4; ++q) { const float4 t = *(const float4*)(cs + q * 4); c[q * 2] = t.x; s[q * 2] = t.y; c[q * 2 + 1] = t.z; s[q * 2 + 1] = t.w; }
  float x[8], y[8];
#pragma unroll
  for (int j = 0; j < 8; ++j) { x[j] = a[j] * c[j] - b[j] * s[j]; y[j] = a[j] * s[j] + b[j] * c[j]; }
  w1 = (u32x4){cvtpk(x[0], x[1]), cvtpk(x[2], x[3]), cvtpk(x[4], x[5]), cvtpk(x[6], x[7])};
  w2 = (u32x4){cvtpk(y[0], y[1]), cvtpk(y[2], y[3]), cvtpk(y[4], y[5]), cvtpk(y[6], y[7])};
  f1 = *reinterpret_cast<bf16x8*>(&w1); f2 = *reinterpret_cast<bf16x8*>(&w2);
}
DEVI void attn_item(bf16_t* __restrict__ Qb, const bf16_t* __restrict__ Kn, const bf16_t* __restrict__ Vh, const bf16_t* __restrict__ Kr, const float* __restrict__ rope, int pos0, char* lds) {
  const int tid = threadIdx.x, wid = tid >> 6, lane = tid & 63, r32 = lane & 31, hi = lane >> 5;
  char* V_lds = lds; char* K_lds = lds + 2 * SHM_V;
  float* wsl = (float*)(lds + 2 * SHM_V + 2 * SHM_K) + wid * 64; float* li_l = wsl; float* al_l = wsl + 32;
  char* qrl = lds + 2 * SHM_V + 2 * SHM_K + 2048 + wid * 4096 + lane * 16;
  float m_reg = -1e30f, l_reg = 0; f32x16 o[4] = {}; bf16x8 qr[8];
  bf16_t* Qw = Qb + (size_t)(wid * QBLK + r32) * 1536 + hi * 8;
#pragma unroll
  for (int d0 = 0; d0 < 8; ++d0) qr[d0] = *reinterpret_cast<const bf16x8*>(Qw + d0 * 16);
  { bf16x8 q8 = *reinterpret_cast<const bf16x8*>(Qw + 128), q9 = *reinterpret_cast<const bf16x8*>(Qw + 144), q10 = *reinterpret_cast<const bf16x8*>(Qw + 160), q11 = *reinterpret_cast<const bf16x8*>(Qw + 176);
    const int pos = pos0 + wid * QBLK + r32;
    rope_frag(q8, q9, rope + ((pos >> 6) * 16 + hi * 8) * 2); rope_frag(q10, q11, rope + ((pos & 63) * 16 + hi * 8) * 2);
    *reinterpret_cast<bf16x8*>(qrl) = q8; *reinterpret_cast<bf16x8*>(qrl + 1024) = q9; *reinterpret_cast<bf16x8*>(qrl + 2048) = q10; *reinterpret_cast<bf16x8*>(qrl + 3072) = q11; }
  const int sr = tid >> 4, sc = (tid & 15) * 8, vst0 = v_st(sr, sc), vst1 = v_st(32 + sr, sc);
  const int kst0 = KSWZ(sr, sc * 2), kst1 = KSWZ(32 + sr, sc * 2), kst2 = KSWZ(tid >> 3, 256 + (tid & 7) * 16);
  const int goff = sr * 2048 + sc, goffr = (tid >> 3) * 64 + (tid & 7) * 8;
  const int vb0 = (int)(uintptr_t)V_lds + v_rd_base(lane);
  u32x4 sv0, sv1, sk0, sk1, sk2;
#define SLOAD(k0) do { const bf16_t* vp = Vh + (size_t)(k0) * 2048 + goff; const bf16_t* kp = Kn + (size_t)(k0) * 2048 + goff; \
    sv0 = *(const u32x4*)vp; sv1 = *(const u32x4*)(vp + 32 * 2048); sk0 = *(const u32x4*)kp; sk1 = *(const u32x4*)(kp + 32 * 2048); \
    sk2 = *(const u32x4*)(Kr + (size_t)(k0) * 64 + goffr); } while (0)
#define SWRITE(b) do { *(u32x4*)(V_lds + (b) * SHM_V + vst0) = sv0; *(u32x4*)(V_lds + (b) * SHM_V + vst1) = sv1; \
    *(u32x4*)(K_lds + (b) * SHM_K + kst0) = sk0; *(u32x4*)(K_lds + (b) * SHM_K + kst1) = sk1; *(u32x4*)(K_lds + (b) * SHM_K + kst2) = sk2; } while (0)
#define SWAIT() asm volatile("s_waitcnt vmcnt(0)" ::: "memory")
#define RESC(a) do { if (__any((a) < 1.f)) { if (hi == 0) al_l[r32] = (a); asm volatile("s_waitcnt lgkmcnt(0)" ::: "memory"); \
    _Pragma("unroll") for (int d = 0; d < 4; ++d) _Pragma("unroll") for (int r = 0; r < 16; ++r) o[d][r] *= al_l[crow(r, hi)]; } } while (0)
  f32x16 pA0, pA1, pB0, pB1; float mnA, mnB, alA, alB; bf16x8 pa0, pa1, pa2, pa3; constexpr int NT = NKEY / KVBLK;
  SLOAD(0); SWAIT(); SWRITE(0); __syncthreads();
  qkt(pA0, pA1, K_lds, qr, qrl, r32, hi); partialSM(pA0, pA1, m_reg, mnA, alA);
  SLOAD(KVBLK);
  SWAIT(); SWRITE(1); __syncthreads();
  for (int j = 1; j + 1 < NT; j += 2) {
    SBAR(); qkt(pB0, pB1, K_lds + SHM_K, qr, qrl, r32, hi);
    finishSM(pA0, pA1, alA, l_reg, pa0, pa1, pa2, pa3); SBAR();
    SLOAD((j + 1) * KVBLK); SBAR();
    pv_d0(o, vb0, pa0, pa1, pa2, pa3); partialSM(pB0, pB1, m_reg, mnB, alB);
    __syncthreads(); SWAIT(); SWRITE(0);
    RESC(alB); __syncthreads();
    SBAR(); qkt(pA0, pA1, K_lds, qr, qrl, r32, hi);
    finishSM(pB0, pB1, alB, l_reg, pa0, pa1, pa2, pa3); SBAR();
    SLOAD((j + 2) * KVBLK); SBAR();
    pv_d0(o, vb0 + SHM_V, pa0, pa1, pa2, pa3); partialSM(pA0, pA1, m_reg, mnA, alA);
    __syncthreads(); SWAIT(); SWRITE(1);
    RESC(alA); __syncthreads();
  }
  SBAR(); qkt(pB0, pB1, K_lds + SHM_K, qr, qrl, r32, hi);
  finishSM(pA0, pA1, alA, l_reg, pa0, pa1, pa2, pa3); SBAR();
  pv_d0(o, vb0, pa0, pa1, pa2, pa3); partialSM(pB0, pB1, m_reg, mnB, alB);
  __syncthreads(); RESC(alB);
  finishSM(pB0, pB1, alB, l_reg, pa0, pa1, pa2, pa3); SBAR();
  pv_d0(o, vb0 + SHM_V, pa0, pa1, pa2, pa3);
  if (hi == 0) li_l[r32] = l_reg; asm volatile("s_waitcnt lgkmcnt(0)" ::: "memory");
  float rli[16];
#pragma unroll
  for (int r = 0; r < 16; ++r) rli[r] = __builtin_amdgcn_rcpf(li_l[crow(r, hi)]);
  bf16_t* Ow = Qb + (size_t)(wid * QBLK) * 1536;
#pragma unroll
  for (int r = 0; r < 16; ++r) { const int orow = crow(r, hi);
#pragma unroll
    for (int d0 = 0; d0 < 4; ++d0) Ow[(size_t)orow * 1536 + d0 * 32 + r32] = f2bf(o[d0][r] * rli[r]); }
  __syncthreads();
#undef SLOAD
#undef SWRITE
#undef SWAIT
#undef RESC
}
}
DEVI void attn_mfma(const Params& p, char* smem) {
  bf16_t* Q = (bf16_t*)(p.ws + O_RQ); const bf16_t* KV = (const bf16_t*)(p.ws + O_RKV); const bf16_t* KR = (const bf16_t*)(p.ws + O_KR);
  const float* rope = (const float*)(p.ws + O_ROPE);
  for (int it = blockIdx.x; it < NB * 8 * (SEQ / 256); it += gridDim.x) {
    const int bh = (it >> 8) * 8 + (it & 7), qb = (it & 255) >> 3, b = bh >> 3, h = bh & 7;
    at::attn_item(Q + (size_t)(b * SEQ + qb * 256) * 1536 + h * 192, KV + (size_t)b * NKEY * 2048 + h * 256, KV + (size_t)b * NKEY * 2048 + h * 256 + 128,
                  KR + (size_t)b * NKEY * 64, rope, qb * 256, smem);
  }
}

namespace a8 {
constexpr int KVBLK = 64, SHM_K = KVBLK * 192, SHM_V = 128 * KVBLK;
constexpr float SCALE = 0.07216878364870322f, THR = 1.5f;
using i32x8 = __attribute__((ext_vector_type(8))) int;
DEVI int crow(int r, int hi) { return (r & 3) + 8 * (r >> 2) + 4 * hi; }
DEVI f32x16 mma(const i32x8& a, const i32x8& b, const f32x16& c) { return __builtin_amdgcn_mfma_scale_f32_32x32x64_f8f6f4(a, b, c, 0, 0, 0, 0x7f7f7f7f, 0, 0x7f7f7f7f); }
DEVI void partialSM(f32x16& p0, f32x16& p1, float& m_reg, float& mn, float& alpha) {
  constexpr float C = SCALE * 1.4426950408889634f;
  float pmax = p0[0];
#pragma unroll
  for (int r = 1; r < 16; ++r) pmax = fmaxf(pmax, p0[r]);
#pragma unroll
  for (int r = 0; r < 16; ++r) pmax = fmaxf(pmax, p1[r]);
  { auto rr = __builtin_amdgcn_permlane32_swap(__float_as_uint(pmax), __float_as_uint(pmax), false, false);
    pmax = fmaxf(__uint_as_float(rr[0]), __uint_as_float(rr[1])); }
  if (__builtin_expect(__all(pmax - m_reg <= THR / SCALE), 1)) { mn = m_reg; alpha = 1.f; }
  else { mn = fmaxf(m_reg, pmax); alpha = __builtin_amdgcn_exp2f((m_reg - mn) * C); m_reg = mn; }
  const float mnC = 6.f - mn * C;
#pragma unroll
  for (int r = 0; r < 16; ++r) p0[r] = fmaf(p0[r], C, mnC);
#pragma unroll
  for (int r = 0; r < 16; ++r) p1[r] = fmaf(p1[r], C, mnC);
#pragma unroll
  for (int r = 0; r < 16; ++r) p0[r] = __builtin_amdgcn_exp2f(p0[r]);
}
DEVI void finishSM(f32x16& p0, f32x16& p1, float alpha, float& l_reg, i32x8& pa) {
#pragma unroll
  for (int r = 0; r < 16; ++r) p1[r] = __builtin_amdgcn_exp2f(p1[r]);
  float ps = 0;
#pragma unroll
  for (int r = 0; r < 16; ++r) ps += p0[r];
#pragma unroll
  for (int r = 0; r < 16; ++r) ps += p1[r];
  { auto rr = __builtin_amdgcn_permlane32_swap(__float_as_uint(ps), __float_as_uint(ps), false, false);
    ps = __uint_as_float(rr[0]) + __uint_as_float(rr[1]); }
  l_reg = l_reg * alpha + ps;
#pragma unroll
  for (int j = 0; j < 4; ++j) { pa[j] = pk4_fp8(p0[4 * j], p0[4 * j + 1], p0[4 * j + 2], p0[4 * j + 3]); pa[4 + j] = pk4_fp8(p1[4 * j], p1[4 * j + 1], p1[4 * j + 2], p1[4 * j + 3]); }
}
DEVI i32x8 ld32(const char* p0, const char* p1) { const u32x4 a = *(const u32x4*)p0, b = *(const u32x4*)p1; return (i32x8){(int)a[0], (int)a[1], (int)a[2], (int)a[3], (int)b[0], (int)b[1], (int)b[2], (int)b[3]}; }
DEVI void qkt(f32x16& p0, f32x16& p1, const char* Ks, const i32x8* qf, int r32, int hi) {
  p0 = f32x16{}; p1 = f32x16{};
  const int sw = (r32 >> 2) & 3; const char* k0 = Ks + r32 * 192; const char* k1 = k0 + 32 * 192;
#pragma unroll
  for (int m = 0; m < 3; ++m) { const int c0 = ((4 * m + 2 * hi) ^ sw) << 4, c1 = ((4 * m + 2 * hi + 1) ^ sw) << 4;
    p0 = mma(ld32(k0 + c0, k0 + c1), qf[m], p0);
    p1 = mma(ld32(k1 + c0, k1 + c1), qf[m], p1); }
}
DEVI void pv(f32x16* o, const char* Vs, const i32x8& pa, int r32, int hi) {
  const int sw = (r32 >> 2) & 3, c0 = ((2 * hi) ^ sw) << 4, c1 = ((2 * hi + 1) ^ sw) << 4;
#pragma unroll
  for (int db = 0; db < 4; ++db) { const char* vr = Vs + (32 * db + r32) * 64; o[db] = mma(pa, ld32(vr + c0, vr + c1), o[db]); }
}
DEVI void attn_item(bf16_t* __restrict__ Qb, const unsigned char* __restrict__ Kg, const unsigned char* __restrict__ Vg, const float* __restrict__ rope, int pos0, char* lds) {
  const int tid = threadIdx.x, wid = tid >> 6, lane = tid & 63, r32 = lane & 31, hi = lane >> 5;
  char* V_lds = lds; char* K_lds = lds + 3 * SHM_V;
  float* wsl = (float*)(lds + 3 * SHM_V + 2 * SHM_K) + wid * 64; float* li_l = wsl; float* al_l = wsl + 32;
  float m_reg = -1e30f, l_reg = 0; f32x16 o[4] = {}; i32x8 qf[3];
  { const bf16_t* Qw = Qb + (size_t)(wid * 32 + r32) * 1536 + hi * 32;
#pragma unroll
    for (int m = 0; m < 3; ++m) { float x[32];
#pragma unroll
      for (int q = 0; q < 4; ++q) unpack8(*(const u32x4*)(Qw + m * 64 + q * 8), x + q * 8);
      if (m == 2) { const int pos = pos0 + wid * 32 + r32, pp = hi ? (pos & 63) : (pos >> 6); const float* cs = rope + pp * 32;
#pragma unroll
        for (int j = 0; j < 16; ++j) { const float c = cs[j * 2], sn = cs[j * 2 + 1], x1 = x[j], x2 = x[16 + j]; x[j] = x1 * c - x2 * sn; x[16 + j] = x1 * sn + x2 * c; } }
#pragma unroll
      for (int q = 0; q < 8; ++q) qf[m][q] = pk4_fp8(x[q * 4], x[q * 4 + 1], x[q * 4 + 2], x[q * 4 + 3]);
      __builtin_amdgcn_sched_barrier(0); } }
  const int kp0 = wid * 64 + lane, kkey0 = kp0 / 12, kc0 = kp0 - kkey0 * 12, kp1 = kp0 + 512, kkey1 = kp1 / 12, kc1 = kp1 - kkey1 * 12;
  const unsigned koff0 = (unsigned)(kkey0 * 192 + ((kc0 ^ ((kkey0 >> 2) & 3)) << 4)), koff1 = (unsigned)(kkey1 * 192 + ((kc1 ^ ((kkey1 >> 2) & 3)) << 4));
  const int vd = kp0 >> 2, vc = kp0 & 3; const unsigned voff = (unsigned)(vd * NKEY + ((vc ^ ((vd >> 2) & 3)) << 4));
  const bool two = __builtin_amdgcn_readfirstlane(wid) < 4;
#define GSTAGE(t, kb, vb) do { const unsigned char* ks = Kg + (size_t)(t) * SHM_K; const unsigned char* vs = Vg + (t) * KVBLK; \
    __builtin_amdgcn_global_load_lds((const unsigned*)(ks + koff0), (unsigned*)(K_lds + (kb) * SHM_K + wid * 1024), 16, 0, 0); \
    if (two) __builtin_amdgcn_global_load_lds((const unsigned*)(ks + koff1), (unsigned*)(K_lds + (kb) * SHM_K + 8192 + wid * 1024), 16, 0, 0); \
    __builtin_amdgcn_global_load_lds((const unsigned*)(vs + voff), (unsigned*)(V_lds + (vb) + wid * 1024), 16, 0, 0); } while (0)
#define SWAIT() asm volatile("s_waitcnt vmcnt(0)" ::: "memory")
#define SBAR() __builtin_amdgcn_sched_barrier(0)
#define RESC(a) do { if (__any((a) < 1.f)) { if (hi == 0) al_l[r32] = (a); asm volatile("s_waitcnt lgkmcnt(0)" ::: "memory"); \
    _Pragma("unroll") for (int d = 0; d < 4; ++d) _Pragma("unroll") for (int r = 0; r < 16; ++r) o[d][r] *= al_l[crow(r, hi)]; } } while (0)
  f32x16 pA0, pA1, pB0, pB1; float mnA, mnB, alA, alB; i32x8 pa; constexpr int NT = NKEY / KVBLK;
  int v0 = 0, v1 = SHM_V, v2 = 2 * SHM_V;
  GSTAGE(0, 0, v0); SWAIT(); __syncthreads();
  qkt(pA0, pA1, K_lds, qf, r32, hi); partialSM(pA0, pA1, m_reg, mnA, alA);
  GSTAGE(1, 1, v1); SWAIT(); __syncthreads();
  for (int j = 1; j + 1 < NT; j += 2) {
    SBAR(); qkt(pB0, pB1, K_lds + SHM_K, qf, r32, hi);
    finishSM(pA0, pA1, alA, l_reg, pa); SBAR();
    GSTAGE(j + 1, 0, v2); SBAR();
    pv(o, V_lds + v0, pa, r32, hi); partialSM(pB0, pB1, m_reg, mnB, alB);
    SWAIT(); __syncthreads();
    RESC(alB);
    SBAR(); qkt(pA0, pA1, K_lds, qf, r32, hi);
    finishSM(pB0, pB1, alB, l_reg, pa); SBAR();
    GSTAGE(j + 2, 1, v0); SBAR();
    pv(o, V_lds + v1, pa, r32, hi); partialSM(pA0, pA1, m_reg, mnA, alA);
    SWAIT(); __syncthreads();
    RESC(alA);
    { const int t = v0; v0 = v2; v2 = v1; v1 = t; }
  }
  SBAR(); qkt(pB0, pB1, K_lds + SHM_K, qf, r32, hi);
  finishSM(pA0, pA1, alA, l_reg, pa); SBAR();
  pv(o, V_lds + v0, pa, r32, hi); partialSM(pB0, pB1, m_reg, mnB, alB);
  RESC(alB);
  finishSM(pB0, pB1, alB, l_reg, pa); SBAR();
  pv(o, V_lds + v1, pa, r32, hi);
  if (hi == 0) li_l[r32] = l_reg; asm volatile("s_waitcnt lgkmcnt(0)" ::: "memory");
  float rli[16];
#pragma unroll
  for (int r = 0; r < 16; ++r) rli[r] = __builtin_amdgcn_rcpf(li_l[crow(r, hi)]);
  bf16_t* Ow = Qb + (size_t)(wid * 32) * 1536;
#pragma unroll
  for (int r = 0; r < 16; ++r) { const int orow = crow(r, hi);
#pragma unroll
    for (int d0 = 0; d0 < 4; ++d0) Ow[(size_t)orow * 1536 + d0 * 32 + r32] = f2bf(o[d0][r] * rli[r]); }
  __syncthreads();
#undef GSTAGE
#undef SWAIT
#undef SBAR
#undef RESC
}
}
DEVI void attn_fp8(const Params& p, char* smem) {
  bf16_t* Q = (bf16_t*)(p.ws + O_RQ); const unsigned char* K8 = (const unsigned char*)(p.ws + O_K8); const unsigned char* V8 = (const unsigned char*)(p.ws + O_V8T);
  const float* rope = (const float*)(p.ws + O_ROPE);
  for (int it = blockIdx.x; it < NB * 8 * (SEQ / 256); it += gridDim.x) {
    const int bh = (it >> 8) * 8 + (it & 7), qb = (it & 255) >> 3, b = bh >> 3, h = bh & 7;
    a8::attn_item(Q + (size_t)(b * SEQ + qb * 256) * 1536 + h * 192, K8 + (size_t)bh * NKEY * 192, V8 + (size_t)bh * 128 * NKEY, rope, qb * 256, smem);
  }
}
#if ATTN_FP8
DEVI void ph_attn(const Params& p, char* smem) { attn_fp8(p, smem); }
#elif ATTN_MFMA
DEVI void ph_attn(const Params& p, char* smem) { attn_mfma(p, smem); }
#else
DEVI void ph_attn(const Params& p, char* smem) { attn_naive(p, smem); }
#endif

DEVI void ph_rows(const Params& p, char* smem) {
  const int tid = threadIdx.x, wave = tid >> 6, lane = tid & 63;
  const float* MOD = (const float*)(p.ws + O_MOD); const bf16_t* Y = (const bf16_t*)(p.ws + O_RA); const float* rssy = (const float*)(p.ws + O_RSSY);
  bf16_t* HX2 = (bf16_t*)(p.ws + O_RB);
  for (int row = blockIdx.x * NWAVE + wave; row < NTOK; row += gridDim.x * NWAVE) {
    const int b = row >> 13; const float* md = MOD + b * 6144;
    float ty = 0.f; { const float* pr = rssy + (size_t)row * 32;
#pragma unroll
      for (int j = 0; j < 32; ++j) ty += pr[j]; }
    const float ry = rsqrtf(ty * (1.f / 1024.f) + EPS);
    float x1[16]; float ss = 0.f;
#pragma unroll
    for (int i = 0; i < 4; ++i) { const int c = i * 256 + lane * 4; const float4 xv = *(const float4*)(p.x + (size_t)row * 1024 + c); const u32x2 yv = *(const u32x2*)(Y + (size_t)row * 1024 + c);
      const float4 gp = *(const float4*)(p.g_post1 + c), gt = *(const float4*)(md + 2048 + c);
      x1[i * 4 + 0] = xv.x + gt.x * (lo2f(yv[0]) * ry * gp.x); x1[i * 4 + 1] = xv.y + gt.y * (hi2f(yv[0]) * ry * gp.y);
      x1[i * 4 + 2] = xv.z + gt.z * (lo2f(yv[1]) * ry * gp.z); x1[i * 4 + 3] = xv.w + gt.w * (hi2f(yv[1]) * ry * gp.w);
#pragma unroll
      for (int j = 0; j < 4; ++j) ss += x1[i * 4 + j] * x1[i * 4 + j];
      *(float4*)(p.out + (size_t)row * 1024 + c) = make_float4(x1[i * 4], x1[i * 4 + 1], x1[i * 4 + 2], x1[i * 4 + 3]); }
    ss = wave_sum(ss); const float r2 = rsqrtf(ss * (1.f / 1024.f) + EPS);
#pragma unroll
    for (int i = 0; i < 4; ++i) { const int c = i * 256 + lane * 4; const float4 g2 = *(const float4*)(p.g_pre2 + c), sc = *(const float4*)(md + 4096 + c), sh = *(const float4*)(md + 3072 + c);
      st4bf(HX2 + (size_t)row * 1024 + c, x1[i * 4] * r2 * g2.x * (1.f + sc.x) + sh.x, x1[i * 4 + 1] * r2 * g2.y * (1.f + sc.y) + sh.y,
            x1[i * 4 + 2] * r2 * g2.z * (1.f + sc.z) + sh.z, x1[i * 4 + 3] * r2 * g2.w * (1.f + sc.w) + sh.w); }
  }
#if GATHER_FP6
  convert_table_fp6(p.u_exp, (unsigned char*)(p.ws + O_RC), (float*)(p.ws + O_RC + (size_t)16384 * 1024));
#else
  convert_table_fp8(p.u_exp, (unsigned char*)(p.ws + O_RC), (float*)(p.ws + O_RC + (size_t)16384 * 1024));
#endif
}

DEVI void topk_naive(const Params& p, char* smem) {
  const int tid = threadIdx.x, wave = tid >> 6, lane = tid & 63;
  float* wl = (float*)smem + wave * 512; int* wi = (int*)wl;
  const bf16_t* QP = (const bf16_t*)(p.ws + O_RKV); const bf16_t* K1 = (const bf16_t*)(p.ws + O_K1); const bf16_t* K2 = (const bf16_t*)(p.ws + O_K2);
  int* IDX = (int*)(p.ws + O_RQ); float* GW = (float*)(p.ws + O_RQ + (size_t)NTOK * 128 * 4);
  for (int base = blockIdx.x * NWAVE; base < NTOK * 8; base += gridDim.x * NWAVE) {
    const int it = base + wave, token = it >> 3, h = it & 7;
    __syncthreads();
    const bf16_t* q = QP + (size_t)token * 2048 + h * 256;
    for (int d = lane; d < 256; d += 64) wl[d] = bf2f(q[d]);
    __syncthreads();
    float s[4] = {0.f, 0.f, 0.f, 0.f};
#pragma unroll 2
    for (int d8 = 0; d8 < 16; ++d8) {
      const float4 qa0 = *(const float4*)(wl + d8 * 8), qa1 = *(const float4*)(wl + d8 * 8 + 4), qb0 = *(const float4*)(wl + 128 + d8 * 8), qb1 = *(const float4*)(wl + 128 + d8 * 8 + 4);
#pragma unroll
      for (int w = 0; w < 4; ++w) { const int key = lane + (w & 1) * 64; const bf16_t* kp = (w < 2 ? K1 : K2) + key * 128;
        float kf[8]; unpack8(*(const u32x4*)(kp + d8 * 8), kf); const float4 q0 = w < 2 ? qa0 : qb0, q1 = w < 2 ? qa1 : qb1;
        s[w] += q0.x * kf[0] + q0.y * kf[1] + q0.z * kf[2] + q0.w * kf[3] + q1.x * kf[4] + q1.y * kf[5] + q1.z * kf[6] + q1.w * kf[7]; }
    }
#pragma unroll
    for (int half = 0; half < 2; ++half) { float a0 = s[half * 2], a1 = s[half * 2 + 1];
#pragma unroll 1
      for (int r = 0; r < 16; ++r) { float v; int i; if (a0 >= a1) { v = a0; i = lane; } else { v = a1; i = lane + 64; }
        for (int o = 32; o > 0; o >>= 1) { const float ov = __shfl_xor(v, o); const int oi = __shfl_xor(i, o); if (ov > v || (ov == v && oi < i)) { v = ov; i = oi; } }
        if (i == lane) a0 = -3.0e38f; else if (i == lane + 64) a1 = -3.0e38f;
        if (lane == 0) { wl[256 + half * 32 + r] = v; wi[256 + half * 32 + 16 + r] = i; } } }
    __syncthreads();
    float cv[4]; int ci[4];
#pragma unroll
    for (int j = 0; j < 4; ++j) { const int cidx = lane * 4 + j, i = cidx >> 4, jj = cidx & 15; cv[j] = wl[256 + i] + wl[256 + 32 + jj]; ci[j] = wi[256 + 16 + i] * 128 + wi[256 + 32 + 16 + jj]; }
    float myv = 0.f, vmax = 0.f; int myi = 0;
#pragma unroll 1
    for (int r = 0; r < 16; ++r) { float v = cv[0]; int pos = lane * 4, ei = ci[0];
#pragma unroll
      for (int j = 1; j < 4; ++j) if (cv[j] > v) { v = cv[j]; pos = lane * 4 + j; ei = ci[j]; }
      for (int o = 32; o > 0; o >>= 1) { const float ov = __shfl_xor(v, o); const int op = __shfl_xor(pos, o), oe = __shfl_xor(ei, o); if (ov > v || (ov == v && op < pos)) { v = ov; pos = op; ei = oe; } }
#pragma unroll
      for (int j = 0; j < 4; ++j) if (pos == lane * 4 + j) cv[j] = -3.0e38f;
      if (r == 0) vmax = v;
      if (lane == r) { myv = v; myi = ei; } }
    const float e = lane < 16 ? __expf(myv - vmax) : 0.f; const float sum = wave_sum(e);
    if (lane < 16) { IDX[(size_t)token * 128 + h * 16 + lane] = myi; GW[(size_t)token * 128 + h * 16 + lane] = e / sum; }
  }
}

namespace tk {
DEVI int f2sort(float f) { const int i = __float_as_int(f); return i ^ ((i >> 31) & 0x7fffffff); }
DEVI float sort2f(int s) { return __int_as_float(s ^ ((s >> 31) & 0x7fffffff)); }
DEVI void ce_desc(int& a, int& b) { const int hi = max(a, b), lo = min(a, b); a = hi; b = lo; }
DEVI void sort16_desc(int* a) {
#pragma unroll
  for (int lk = 1; lk <= 4; ++lk)
#pragma unroll
    for (int lj = lk - 1; lj >= 0; --lj)
#pragma unroll
      for (int i = 0; i < 16; ++i) { const int j = 1 << lj, k = 1 << lk, l = i ^ j;
        if (l > i) { const int hi = max(a[i], a[l]), lo = min(a[i], a[l]); if ((i & k) == 0) { a[i] = hi; a[l] = lo; } else { a[i] = lo; a[l] = hi; } } }
}
DEVI void bitonic_merge16_desc(int* a) {
#pragma unroll
  for (int lj = 3; lj >= 0; --lj)
#pragma unroll
    for (int i = 0; i < 16; ++i) { const int l = i ^ (1 << lj); if (l > i) ce_desc(a[i], a[l]); }
}
DEVI void merge_top16(int* a, const int* b) {
#pragma unroll
  for (int i = 0; i < 16; ++i) a[i] = max(a[i], b[15 - i]);
  bitonic_merge16_desc(a);
}
DEVI void half_top16(const bf16_t* __restrict__ qrow, const char* Kl, int r32, int hi, int* out) {
  bf16x8 qf[8];
#pragma unroll
  for (int d0 = 0; d0 < 8; ++d0) qf[d0] = *reinterpret_cast<const bf16x8*>(qrow + d0 * 16 + hi * 8);
  int a[64]; const int hi4 = 4 * hi;
#pragma unroll
  for (int kt = 0; kt < 4; ++kt) { f32x16 acc = {};
    const int key = kt * 32 + r32;
#pragma unroll
    for (int d0 = 0; d0 < 8; ++d0) { const bf16x8 kf = *reinterpret_cast<const bf16x8*>(Kl + key * 256 + (((d0 * 2 + hi) ^ (key & 15)) << 4));
      acc = __builtin_amdgcn_mfma_f32_32x32x16_bf16(kf, qf[d0], acc, 0, 0, 0); }
#pragma unroll
    for (int r = 0; r < 16; ++r) { const int kc = kt * 32 + (r & 3) + 8 * (r >> 2); a[kt * 16 + r] = ((f2sort(acc[r]) & ~127) | (127 - kc)) - hi4; } }
  sort16_desc(a); sort16_desc(a + 16); sort16_desc(a + 32); sort16_desc(a + 48);
  merge_top16(a, a + 16); merge_top16(a + 32, a + 48); merge_top16(a, a + 32);
  int L[16], H[16];
#pragma unroll
  for (int i = 0; i < 16; ++i) { auto rr = __builtin_amdgcn_permlane32_swap((unsigned)a[i], (unsigned)a[i], false, false); L[i] = (int)rr[0]; H[i] = (int)rr[1]; }
  merge_top16(L, H);
#pragma unroll
  for (int i = 0; i < 16; ++i) out[i] = L[i];
}
}
DEVI void gather_token(const Params& p, int t, const int* idx, const float* gw);
DEVI void gather_token_fp6(const Params& p, int t, const int* idx, const float* gw, float* xs, const int* sig);
DEVI void fp6_sigma(int* sig);
DEVI void topk_fast(const Params& p, char* smem) {
  const int tid = threadIdx.x, wave = __builtin_amdgcn_readfirstlane(tid >> 6), lane = tid & 63, r32 = lane & 31, hi = lane >> 5;
  const bf16_t* QP = (const bf16_t*)(p.ws + O_RKV);
  char* K1l = smem; char* K2l = smem + 32768; int* tab = (int*)(smem + 65536) + wave * (32 * 33);
  int* idxl = (int*)(smem + 65536 + 8 * 32 * 33 * 4) + wave * 512; float* gwl = (float*)(smem + 65536 + 8 * 32 * 33 * 4 + 8 * 2048) + wave * 512;
  int* sigl = (int*)(smem + 65536 + 8 * 32 * 33 * 4 + 16 * 2048) + wave * 32;
#if GATHER_FP6
  fp6_sigma(sigl);
#endif
  __syncthreads();
  { const bf16_t* K1 = (const bf16_t*)(p.ws + O_K1);
    for (int id = tid; id < 4096; id += NTHR) { const int key = id >> 4, c = id & 15; const u32x4 v = *(const u32x4*)(K1 + (size_t)key * 128 + c * 8);
      *(u32x4*)(smem + key * 256 + ((c ^ (key & 15)) << 4)) = v; } }
  __syncthreads();
  for (int item = blockIdx.x; item < NTOK * 8 / 256; item += gridDim.x) {
    const int row = item * 256 + wave * 32 + r32;
    const bf16_t* qrow = QP + (size_t)row * 256;
    int t1[16], t2[16];
    tk::half_top16(qrow, K1l, r32, hi, t1);
    __builtin_amdgcn_sched_barrier(0);
    tk::half_top16(qrow + 128, K2l, r32, hi, t2);
    __builtin_amdgcn_sched_barrier(0);
    float v1[16], v2[16];
#pragma unroll
    for (int i = 0; i < 16; ++i) { v1[i] = tk::sort2f(t1[i] & ~127); v2[i] = tk::sort2f(t2[i] & ~127); }
    if (hi == 0) {
#pragma unroll
      for (int i = 0; i < 16; ++i) { tab[r32 * 33 + i] = 127 - (t1[i] & 127); tab[r32 * 33 + 16 + i] = 127 - (t2[i] & 127); } }
#define CAND(i, j) ((tk::f2sort(v1[i] + v2[j]) & ~255) | (255 - ((i) * 16 + (j))))
    int g0[16], g1[16], g2[16];
#pragma unroll
    for (int j = 0; j < 16; ++j) g0[j] = CAND(0, j);
#pragma unroll
    for (int j = 0; j < 8; ++j) g1[j] = CAND(1, j);
#pragma unroll
    for (int j = 0; j < 5; ++j) g1[8 + j] = CAND(2, j);
#pragma unroll
    for (int j = 0; j < 3; ++j) g1[13 + j] = CAND(4, j);
#pragma unroll
    for (int j = 0; j < 4; ++j) g2[j] = CAND(3, j);
    g2[4] = CAND(5, 0); g2[5] = CAND(5, 1); g2[6] = CAND(6, 0); g2[7] = CAND(6, 1); g2[8] = CAND(7, 0); g2[9] = CAND(7, 1);
    g2[10] = CAND(8, 0); g2[11] = CAND(9, 0); g2[12] = CAND(10, 0); g2[13] = CAND(11, 0); g2[14] = CAND(12, 0); g2[15] = CAND(13, 0);
    tk::sort16_desc(g1); tk::sort16_desc(g2);
    tk::merge_top16(g0, g1); tk::merge_top16(g0, g2);
    { int x = CAND(14, 0);
#pragma unroll
      for (int i = 0; i < 16; ++i) { const int h = max(g0[i], x); x = min(g0[i], x); g0[i] = h; }
      x = CAND(15, 0);
#pragma unroll
      for (int i = 0; i < 16; ++i) { const int h = max(g0[i], x); x = min(g0[i], x); g0[i] = h; } }
#undef CAND
    asm volatile("s_waitcnt lgkmcnt(0)" ::: "memory");
    if (hi == 0) {
      int ex[16];
#pragma unroll
      for (int k = 0; k < 16; ++k) { const int pos = 255 - (g0[k] & 255); ex[k] = tab[r32 * 33 + (pos >> 4)] * 128 + tab[r32 * 33 + 16 + (pos & 15)]; }
      int* dst = idxl + r32 * 16;
#pragma unroll
      for (int q = 0; q < 4; ++q) *(int4*)(dst + q * 4) = make_int4(ex[q * 4], ex[q * 4 + 1], ex[q * 4 + 2], ex[q * 4 + 3]);
    } else {
      float e[16]; const float vmax = tk::sort2f(g0[0] & ~255); float sum = 0.f;
#pragma unroll
      for (int k = 0; k < 16; ++k) { e[k] = __expf(tk::sort2f(g0[k] & ~255) - vmax); sum += e[k]; }
      const float inv = 1.f / sum; float* dst = gwl + r32 * 16;
#pragma unroll
      for (int q = 0; q < 4; ++q) *(float4*)(dst + q * 4) = make_float4(e[q * 4] * inv, e[q * 4 + 1] * inv, e[q * 4 + 2] * inv, e[q * 4 + 3] * inv);
    }
    asm volatile("s_waitcnt lgkmcnt(0)" ::: "memory"); __builtin_amdgcn_sched_barrier(0);
#pragma unroll 1
#if GATHER_FP6
    for (int tl = 0; tl < 4; ++tl) gather_token_fp6(p, item * 32 + wave * 4 + tl, idxl + tl * 128, gwl + tl * 128, (float*)tab, sigl);
#else
    for (int tl = 0; tl < 4; ++tl) gather_token(p, item * 32 + wave * 4 + tl, idxl + tl * 128, gwl + tl * 128);
#endif
    asm volatile("s_waitcnt lgkmcnt(0)" ::: "memory"); __builtin_amdgcn_sched_barrier(0);
  }
}
#if TOPK_FAST
DEVI void ph_topk(const Params& p, char* smem) { topk_fast(p, smem); }
#else
DEVI void ph_topk(const Params& p, char* smem) { topk_naive(p, smem); }
#endif

DEVI float wave_sum_dpp(float v) {
  v += __builtin_bit_cast(float, __builtin_amdgcn_update_dpp(0, __builtin_bit_cast(int, v), 0xB1, 0xf, 0xf, true));
  v += __builtin_bit_cast(float, __builtin_amdgcn_update_dpp(0, __builtin_bit_cast(int, v), 0x4E, 0xf, 0xf, true));
  v += __builtin_bit_cast(float, __builtin_amdgcn_update_dpp(0, __builtin_bit_cast(int, v), 0x141, 0xf, 0xf, true));
  v += __builtin_bit_cast(float, __builtin_amdgcn_update_dpp(0, __builtin_bit_cast(int, v), 0x140, 0xf, 0xf, true));
  const int iv = __builtin_bit_cast(int, v);
  return (__builtin_bit_cast(float, __builtin_amdgcn_readlane(iv, 0)) + __builtin_bit_cast(float, __builtin_amdgcn_readlane(iv, 16))) +
         (__builtin_bit_cast(float, __builtin_amdgcn_readlane(iv, 32)) + __builtin_bit_cast(float, __builtin_amdgcn_readlane(iv, 48)));
}
DEVI void fp8x16_to_f32(const u32x4& w, float* f) {
#pragma unroll
  for (int j = 0; j < 4; ++j) { const f32x2_t a = __builtin_amdgcn_cvt_pk_f32_fp8((int)w[j], false), b = __builtin_amdgcn_cvt_pk_f32_fp8((int)w[j], true);
    f[j * 4] = a[0]; f[j * 4 + 1] = a[1]; f[j * 4 + 2] = b[0]; f[j * 4 + 3] = b[1]; }
}
DEVI void gather_token(const Params& p, int t, const int* idx, const float* gw) {
  int lane = threadIdx.x & 63; asm volatile("" : "+v"(lane));
  char* ws = p.ws; asm volatile("" : "+s"(ws));
  const bf16_t* HX2 = (const bf16_t*)(ws + O_RB);
  const unsigned char* UT = (const unsigned char*)(ws + O_RC); const float* SU = (const float*)(ws + O_RC + (size_t)16384 * 1024);
  const unsigned char* VT = (const unsigned char*)(ws + O_RA); const float* SV = (const float*)(ws + O_RA + (size_t)16384 * 1024);
  const float* MOD = (const float*)(ws + O_MOD);
  float xf[16];
  unpack8(*(const u32x4*)(HX2 + (size_t)t * 1024 + lane * 16), xf); unpack8(*(const u32x4*)(HX2 + (size_t)t * 1024 + lane * 16 + 8), xf + 8);
  float acc[16];
#pragma unroll
  for (int j = 0; j < 16; ++j) acc[j] = 0.f;
#pragma unroll 1
  for (int half = 0; half < 2; ++half) {
    const int my_i = idx[half * 64 + lane]; const float my_g = gw[half * 64 + lane];
    const float my_su = SU[my_i], my_sv = SV[my_i];
#pragma unroll 1
    for (int e0 = 0; e0 < 64; e0 += 8) {
      u32x4 uq[8], vq[8]; float cs[8];
#pragma unroll
      for (int j = 0; j < 8; ++j) { const int id = __builtin_amdgcn_readlane(my_i, e0 + j);
        uq[j] = *(const u32x4*)(UT + (size_t)id * 1024 + lane * 16); vq[j] = *(const u32x4*)(VT + (size_t)id * 1024 + lane * 16); }
#pragma unroll
      for (int j = 0; j < 8; ++j) { float uf[16]; fp8x16_to_f32(uq[j], uf); float d = 0.f;
#pragma unroll
        for (int k = 0; k < 16; ++k) d += xf[k] * uf[k];
        cs[j] = d; }
#pragma unroll
      for (int j = 0; j < 8; ++j) { const float d = wave_sum_dpp(cs[j]);
        const float g = __builtin_bit_cast(float, __builtin_amdgcn_readlane(__builtin_bit_cast(int, my_g), e0 + j));
        const float su = __builtin_bit_cast(float, __builtin_amdgcn_readlane(__builtin_bit_cast(int, my_su), e0 + j));
        const float sv = __builtin_bit_cast(float, __builtin_amdgcn_readlane(__builtin_bit_cast(int, my_sv), e0 + j));
        cs[j] = g * gelu_t(d * su) * sv; }
#pragma unroll
      for (int j = 0; j < 8; ++j) { float vf[16]; fp8x16_to_f32(vq[j], vf);
#pragma unroll
        for (int k = 0; k < 16; ++k) acc[k] += cs[j] * vf[k]; }
    }
  }
  float ss = 0.f;
#pragma unroll
  for (int k = 0; k < 16; ++k) ss += acc[k] * acc[k];
  ss = wave_sum(ss); const float rstd = rsqrtf(ss * (1.f / 1024.f) + EPS);
  const int b = t >> 13; const float* gt2 = MOD + b * 6144 + 5120;
  float* op = p.out + (size_t)t * 1024 + lane * 16;
#pragma unroll
  for (int q4 = 0; q4 < 4; ++q4) { float4 xv = *(const float4*)(op + q4 * 4); const float4 gt = *(const float4*)(gt2 + lane * 16 + q4 * 4), gp = *(const float4*)(p.g_post2 + lane * 16 + q4 * 4);
    xv.x += gt.x * (acc[q4 * 4 + 0] * rstd * gp.x); xv.y += gt.y * (acc[q4 * 4 + 1] * rstd * gp.y);
    xv.z += gt.z * (acc[q4 * 4 + 2] * rstd * gp.z); xv.w += gt.w * (acc[q4 * 4 + 3] * rstd * gp.w);
    *(float4*)(op + q4 * 4) = xv; }
}


DEVI void fp6_sigma(int* sig) {
  f32x16 ra, rb;
#pragma unroll
  for (int i = 0; i < 16; ++i) { ra[i] = i < 8 ? i * 0.125f : 1.f + (i - 8) * 0.125f; rb[i] = i < 8 ? 2.f + i * 0.25f : 4.f + (i - 8) * 0.5f; }
  const u32x6 w = __builtin_amdgcn_cvt_scalef32_2xpk16_fp6_f32(ra, rb, 1.0f);
  const f32x32 d = __builtin_amdgcn_cvt_scalef32_pk32_f32_fp6(w, 1.0f);
  if ((threadIdx.x & 63) == 0) {
#pragma unroll
    for (int i = 0; i < 32; ++i) { const float v = d[i]; sig[i] = v < 1.f ? (int)(v * 8.f + 0.5f) : v < 2.f ? 8 + (int)((v - 1.f) * 8.f + 0.5f) : v < 4.f ? 16 + (int)((v - 2.f) * 4.f + 0.5f) : 24 + (int)((v - 4.f) * 2.f + 0.5f); } }
}
constexpr int G6 = 4;
DEVI void gather_token_fp6(const Params& p, int t, const int* idx, const float* gw, float* xs, const int* sig) {
  int lane = threadIdx.x & 63; asm volatile("" : "+v"(lane));
  const int h = lane >> 5, g = lane & 31;
  const bf16_t* HX2 = (const bf16_t*)(p.ws + O_RB);
  const unsigned char* UT = (const unsigned char*)(p.ws + O_RC); const float* SU = (const float*)(p.ws + O_RC + (size_t)16384 * 1024);
  const unsigned char* VT = (const unsigned char*)(p.ws + O_RA); const float* SV = (const float*)(p.ws + O_RA + (size_t)16384 * 1024);
  const float* MOD = (const float*)(p.ws + O_MOD);
  if (h == 0) { float xf[32];
#pragma unroll
    for (int q = 0; q < 4; ++q) unpack8(*(const u32x4*)(HX2 + (size_t)t * 1024 + g * 32 + q * 8), xf + q * 8);
#pragma unroll
    for (int j = 0; j < 32; ++j) xs[j * 32 + g] = xf[j]; }
  asm volatile("s_waitcnt lgkmcnt(0)" ::: "memory"); __builtin_amdgcn_sched_barrier(0);
  float xp[32], acc[32];
#pragma unroll
  for (int i = 0; i < 32; ++i) { xp[i] = xs[sig[i] * 32 + g]; acc[i] = 0.f; }
#pragma unroll 1
  for (int half = 0; half < 2; ++half) {
    const int my_i = idx[half * 64 + lane]; const float my_g = gw[half * 64 + lane];
    const float my_su = SU[my_i], my_sv = SV[my_i];
#pragma unroll 1
    for (int e0 = 0; e0 < 64; e0 += 2 * G6) {
      u32x6 uq[G6], vq[G6]; float cs[G6];
#pragma unroll
      for (int j = 0; j < G6; ++j) { const int ia = __builtin_amdgcn_readlane(my_i, e0 + 2 * j), ib = __builtin_amdgcn_readlane(my_i, e0 + 2 * j + 1); const int id = h ? ib : ia;
        const unsigned char* up = UT + (size_t)id * 768 + g * 24; const unsigned char* vp = VT + (size_t)id * 768 + g * 24;
        const u32x4 u0 = *(const u32x4_u*)up; const u32x2 u1 = *(const u32x2_u*)(up + 16); const u32x4 v0 = *(const u32x4_u*)vp; const u32x2 v1 = *(const u32x2_u*)(vp + 16);
        uq[j] = (u32x6){u0[0], u0[1], u0[2], u0[3], u1[0], u1[1]}; vq[j] = (u32x6){v0[0], v0[1], v0[2], v0[3], v1[0], v1[1]}; }
#pragma unroll
      for (int j = 0; j < G6; ++j) { const f32x32 uf = __builtin_amdgcn_cvt_scalef32_pk32_f32_fp6(uq[j], 1.0f); float d = 0.f;
#pragma unroll
        for (int k = 0; k < 32; ++k) d += xp[k] * uf[k];
        cs[j] = d; __builtin_amdgcn_sched_barrier(0); }
#pragma unroll
      for (int j = 0; j < G6; ++j) { float v = cs[j];
        v += __builtin_bit_cast(float, __builtin_amdgcn_update_dpp(0, __builtin_bit_cast(int, v), 0xB1, 0xf, 0xf, true));
        v += __builtin_bit_cast(float, __builtin_amdgcn_update_dpp(0, __builtin_bit_cast(int, v), 0x4E, 0xf, 0xf, true));
        v += __builtin_bit_cast(float, __builtin_amdgcn_update_dpp(0, __builtin_bit_cast(int, v), 0x141, 0xf, 0xf, true));
        v += __builtin_bit_cast(float, __builtin_amdgcn_update_dpp(0, __builtin_bit_cast(int, v), 0x140, 0xf, 0xf, true));
        const int iv = __builtin_bit_cast(int, v);
        const float s0 = __builtin_bit_cast(float, __builtin_amdgcn_readlane(iv, 0)) + __builtin_bit_cast(float, __builtin_amdgcn_readlane(iv, 16));
        const float s1 = __builtin_bit_cast(float, __builtin_amdgcn_readlane(iv, 32)) + __builtin_bit_cast(float, __builtin_amdgcn_readlane(iv, 48));
        const int ea = e0 + 2 * j, eb = ea + 1;
        const float ga = __builtin_bit_cast(float, __builtin_amdgcn_readlane(__builtin_bit_cast(int, my_g), ea)), gb = __builtin_bit_cast(float, __builtin_amdgcn_readlane(__builtin_bit_cast(int, my_g), eb));
        const float sua = __builtin_bit_cast(float, __builtin_amdgcn_readlane(__builtin_bit_cast(int, my_su), ea)), sub = __builtin_bit_cast(float, __builtin_amdgcn_readlane(__builtin_bit_cast(int, my_su), eb));
        const float sva = __builtin_bit_cast(float, __builtin_amdgcn_readlane(__builtin_bit_cast(int, my_sv), ea)), svb = __builtin_bit_cast(float, __builtin_amdgcn_readlane(__builtin_bit_cast(int, my_sv), eb));
        const float ca = ga * gelu_t(s0 * sua) * sva, cb = gb * gelu_t(s1 * sub) * svb;
        cs[j] = h ? cb : ca; }
#pragma unroll
      for (int j = 0; j < G6; ++j) { const f32x32 vf = __builtin_amdgcn_cvt_scalef32_pk32_f32_fp6(vq[j], 1.0f);
#pragma unroll
        for (int k = 0; k < 32; ++k) acc[k] += cs[j] * vf[k];
        __builtin_amdgcn_sched_barrier(0); }
    }
  }
#pragma unroll
  for (int i = 0; i < 32; ++i) { auto rr = __builtin_amdgcn_permlane32_swap(__float_as_uint(acc[i]), __float_as_uint(acc[i]), false, false); acc[i] = __uint_as_float(rr[0]) + __uint_as_float(rr[1]); }
  if (h == 0) {
#pragma unroll
    for (int i = 0; i < 32; ++i) xs[sig[i] * 32 + g] = acc[i]; }
  asm volatile("s_waitcnt lgkmcnt(0)" ::: "memory"); __builtin_amdgcn_sched_barrier(0);
  float o[16]; float ss = 0.f;
#pragma unroll
  for (int j = 0; j < 16; ++j) { o[j] = xs[(16 * h + j) * 32 + g]; ss += o[j] * o[j]; }
  ss = wave_sum(ss); const float rstd = rsqrtf(ss * (1.f / 1024.f) + EPS);
  const int b = t >> 13, c0 = g * 32 + h * 16; const float* gt2 = MOD + b * 6144 + 5120 + c0;
  float* op = p.out + (size_t)t * 1024 + c0;
#pragma unroll
  for (int q4 = 0; q4 < 4; ++q4) { float4 xv = *(const float4*)(op + q4 * 4); const float4 gt = *(const float4*)(gt2 + q4 * 4), gp = *(const float4*)(p.g_post2 + c0 + q4 * 4);
    xv.x += gt.x * (o[q4 * 4 + 0] * rstd * gp.x); xv.y += gt.y * (o[q4 * 4 + 1] * rstd * gp.y);
    xv.z += gt.z * (o[q4 * 4 + 2] * rstd * gp.z); xv.w += gt.w * (o[q4 * 4 + 3] * rstd * gp.w);
    *(float4*)(op + q4 * 4) = xv; }
  asm volatile("s_waitcnt lgkmcnt(0)" ::: "memory"); __builtin_amdgcn_sched_barrier(0);
}

#define XB_TMO      128
#define XB_XCNT(j)  (256  + 64 * (j))
#define XB_XSUB(j)  (1280 + 64 * (j))
#define XB_XGEN(j)  (2304 + 64 * (j))
#define XB_TOP      3328
#define XB_TOPGEN   3392
#define XCD_BAR_WORDS 3456
#define XB_SPIN_CAP (1u << 18)
#define LAS __attribute__((address_space(3)))
DEVI unsigned xb_ld(unsigned* p)              { return __hip_atomic_load(p, __ATOMIC_RELAXED, __HIP_MEMORY_SCOPE_AGENT); }
DEVI unsigned xb_add(unsigned* p, unsigned v) { return __hip_atomic_fetch_add(p, v, __ATOMIC_RELAXED, __HIP_MEMORY_SCOPE_AGENT); }
DEVI unsigned xb_xcc_id() { return (unsigned)__builtin_amdgcn_s_getreg((3 << 11) | 20) & 0xFu; }
#define XB_SPIN(cond, bar) do { unsigned _sp = 0; while (cond) { __builtin_amdgcn_s_sleep(1); \
    if ((++_sp & 255u) == 0u) { if (xb_ld(&(bar)[XB_TMO])) break; if (_sp > XB_SPIN_CAP) { atomicAdd(&(bar)[XB_TMO], 1u); break; } } } } while (0)
struct XcdBarrier { unsigned* bar; unsigned x; volatile LAS unsigned* st; };
DEVI XcdBarrier xcd_barrier_post(unsigned* bar, volatile LAS unsigned* st) {
  XcdBarrier b; b.bar = bar; b.x = xb_xcc_id(); b.st = st;
  if (threadIdx.x == 0) (void)xb_add(&bar[XB_XCNT(b.x)], 1u);
  return b;
}
DEVI void xcd_barrier_complete(unsigned* bar, unsigned x, unsigned& nloc, unsigned& nx) {
  const unsigned G = gridDim.x * gridDim.y * gridDim.z;
  unsigned sum, cnt, mine, sp = 0u;
  for (;;) {
    sum = 0u; cnt = 0u; mine = 0u;
#pragma unroll
    for (unsigned j = 0; j < 16; ++j) { const unsigned c = xb_ld(&bar[XB_XCNT(j)]); sum += c; cnt += (c > 0u) ? 1u : 0u; mine = (j == x) ? c : mine; }
    if (sum == G) break;
    __builtin_amdgcn_s_sleep(1);
    if ((++sp & 255u) == 0u) { if (xb_ld(&bar[XB_TMO])) break; if (sp > XB_SPIN_CAP) { atomicAdd(&bar[XB_TMO], 1u); break; } }
  }
  nloc = mine > 0u ? mine : 1u; nx = cnt > 0u ? cnt : 1u;
}
DEVI void xcd_barrier(const XcdBarrier& b) {
  asm volatile("s_waitcnt vmcnt(0)" ::: "memory");
  __syncthreads();
  if (threadIdx.x == 0) {
    unsigned* bar = b.bar;
    __builtin_amdgcn_s_waitcnt(0);
    unsigned nloc = b.st[0], nx = b.st[1];
    if (nloc == 0u) { xcd_barrier_complete(bar, b.x, nloc, nx); b.st[0] = nloc; b.st[1] = nx; }
    const unsigned old = xb_add(&bar[XB_XSUB(b.x)], 1u);
    const unsigned gen = old / nloc;
    if (old + 1u == (gen + 1u) * nloc) {
      __builtin_amdgcn_fence(__ATOMIC_RELEASE, "agent");
      asm volatile("s_waitcnt vmcnt(0)" ::: "memory");
      const unsigned og = xb_add(&bar[XB_TOP], 1u);
      const unsigned tg = og / nx;
      if (og + 1u == (tg + 1u) * nx) xb_add(&bar[XB_TOPGEN], 1u);
      else XB_SPIN(xb_ld(&bar[XB_TOPGEN]) == tg, bar);
      __builtin_amdgcn_fence(__ATOMIC_ACQUIRE, "agent");
      xb_add(&bar[XB_XGEN(b.x)], 1u);
      asm volatile("s_waitcnt vmcnt(0)" ::: "memory");
    } else {
      XB_SPIN(xb_ld(&bar[XB_XGEN(b.x)]) == gen, bar);
      __builtin_amdgcn_fence(__ATOMIC_ACQUIRE, "agent");
      asm volatile("s_waitcnt vmcnt(0)" ::: "memory");
    }
  }
  __syncthreads();
}

constexpr int NPHASE = 11;
template <int PH> DEVI void run_phase(const Params& p, char* smem) {
  if constexpr (PH == 0) ph_prep(p, smem);
  else if constexpr (PH == 1) ph_hx(p, smem);
  else if constexpr (PH == 2) ph_inproj(p, smem);
  else if constexpr (PH == 3) ph_mid(p, smem);
  else if constexpr (PH == 4) ph_attn(p, smem);
  else if constexpr (PH == 5) ph_gates(p, smem);
  else if constexpr (PH == 6) ph_merge(p, smem);
  else if constexpr (PH == 7) ph_wo(p, smem);
  else if constexpr (PH == 8) ph_rows(p, smem);
  else if constexpr (PH == 9) ph_wpq(p, smem);
  else if constexpr (PH == 10) ph_topk(p, smem);
}

template <int PH> __global__ __launch_bounds__(NTHR) void k_phase(Params p) {
  extern __shared__ __attribute__((aligned(16))) char smem[];
  run_phase<PH>(p, smem);
}

#ifndef PROBE_PH
#define PROBE_PH -1
#endif
#if MEGA
#define RUNPH(N) do { if (PROBE_PH == N) t0 = __builtin_amdgcn_s_memrealtime(); run_phase<N>(p, smem); if (N < NPHASE - 1) xcd_barrier(xb); \
    if (PROBE_PH == N) t1 = __builtin_amdgcn_s_memrealtime(); } while (0)
__global__ __launch_bounds__(NTHR) void k_mega(Params p) {
  extern __shared__ __attribute__((aligned(16))) char smem[];
  cg::grid_group grid = cg::this_grid();
  unsigned long long t0 = 0, t1 = 0;
  unsigned* bar = (unsigned*)(p.ws + O_BAR);
  volatile LAS unsigned* xst = (volatile LAS unsigned*)(smem + LDS_BYTES - 16);
  if (threadIdx.x == 0) { xst[0] = 0u; xst[1] = 0u; }
  __syncthreads();
  const XcdBarrier xb = xcd_barrier_post(bar, xst);
  if (p.out == nullptr) grid.sync();
  RUNPH(0);
  RUNPH(1); RUNPH(2); RUNPH(3); RUNPH(4); RUNPH(5); RUNPH(6); RUNPH(7); RUNPH(8); RUNPH(9); RUNPH(10);
  if (PROBE_PH >= 0) { __syncthreads(); if (blockIdx.x == 0 && threadIdx.x == 0) p.out[0] += exp2f(rintf(log2f((float)(t1 - t0) * 1e-3f) * 5.f) * 0.2f); }
}
#endif

template <int PH> static void launch_phase(const Params& p, int grid, hipStream_t stream) {
  hipLaunchKernelGGL(k_phase<PH>, dim3(grid), dim3(NTHR), LDS_BYTES, stream, p);
}
template <int PH> static void set_attr() { (void)hipFuncSetAttribute((const void*)k_phase<PH>, hipFuncAttributeMaxDynamicSharedMemorySize, LDS_BYTES); }

extern "C" void kernel_launch(void* const* d_in, const int* in_sizes, int n_in, void* d_out, int out_size, void* d_ws, size_t ws_size, hipStream_t stream) {
  static int grid = 0;
  if (grid == 0) {
    if (n_in != 26 || out_size != NTOK * DM || ws_size < O_END) { fprintf(stderr, "kernel_launch: unexpected shapes n_in %d out %d ws %zu (need %zu)\n", n_in, out_size, ws_size, (size_t)O_END); grid = -1; return; }
#if MEGA
    (void)hipFuncSetAttribute((const void*)k_mega, hipFuncAttributeMaxDynamicSharedMemorySize, LDS_BYTES);
    int dev = 0, cus = 0, per_cu = 0; (void)hipGetDevice(&dev); (void)hipDeviceGetAttribute(&cus, hipDeviceAttributeMultiprocessorCount, dev);
    (void)hipOccupancyMaxActiveBlocksPerMultiprocessor(&per_cu, (const void*)k_mega, NTHR, LDS_BYTES);
    if (per_cu < 1) { fprintf(stderr, "kernel_launch: occupancy query says %d blocks per CU\n", per_cu); grid = -1; return; }
    grid = cus;
#else
    set_attr<0>(); set_attr<1>(); set_attr<2>(); set_attr<3>(); set_attr<4>(); set_attr<5>(); set_attr<6>(); set_attr<7>(); set_attr<8>(); set_attr<9>(); set_attr<10>(); set_attr<11>();
    grid = 256;
#endif
  }
  if (grid < 0) return;
  Params p{};
  const float** pp = (const float**)&p;
  for (int i = 0; i < 26; ++i) pp[i] = (const float*)d_in[i];
  p.out = (float*)d_out; p.ws = (char*)d_ws;
#if MEGA
  (void)hipMemsetAsync((char*)d_ws + O_BAR, 0, (size_t)XCD_BAR_WORDS * 4, stream);
  void* args[] = {&p};
  hipError_t e = hipLaunchCooperativeKernel((const void*)k_mega, dim3(grid), dim3(NTHR), args, LDS_BYTES, stream);
  if (e != hipSuccess) fprintf(stderr, "cooperative launch failed: %s (grid %d)\n", hipGetErrorString(e), grid);
#else
  launch_phase<0>(p, grid, stream); launch_phase<1>(p, grid, stream); launch_phase<2>(p, grid, stream); launch_phase<3>(p, grid, stream);
  launch_phase<4>(p, grid, stream); launch_phase<5>(p, grid, stream); launch_phase<6>(p, grid, stream); launch_phase<7>(p, grid, stream);
  launch_phase<8>(p, grid, stream); launch_phase<9>(p, grid, stream); launch_phase<10>(p, grid, stream); launch_phase<11>(p, grid, stream);
#endif
}
```

```cpp
#include <hip/hip_runtime.h>
#include <hip/hip_cooperative_groups.h>
#include <cstdint>
#include <cstdio>
namespace cg = cooperative_groups;

#ifndef MEGA
#define MEGA 1
#endif
#ifndef GEMM_MFMA
#define GEMM_MFMA 1
#endif
#ifndef ATTN_MFMA
#define ATTN_MFMA 1
#endif
#ifndef GATHER_FP6
#define GATHER_FP6 1
#endif
#ifndef GEMM_8PH
#define GEMM_8PH 1
#endif
#ifndef GEMM_KS_SBAR
#define GEMM_KS_SBAR 0
#endif
#ifndef ATTN_FP8
#define ATTN_FP8 1
#endif
#ifndef TOPK_FAST
#define TOPK_FAST 1
#endif

#define DEVI __device__ __forceinline__
typedef unsigned short bf16_t;
using bf16x8 = __attribute__((ext_vector_type(8))) short;
using bf16x4 = __attribute__((ext_vector_type(4))) short;
using f32x4  = __attribute__((ext_vector_type(4))) float;
using f32x16 = __attribute__((ext_vector_type(16))) float;
using u32x4  = __attribute__((ext_vector_type(4))) unsigned;
using u32x2  = __attribute__((ext_vector_type(2))) unsigned;

constexpr int DM = 1024, NB = 2, SEQ = 8192, NTOK = NB * SEQ, CTXL = 256, NCTX = NB * CTXL, NROW = NTOK + NCTX, NKEY = SEQ + CTXL;
constexpr int INW = 4544, INWP = 4608;
constexpr int NPRE = 2560;
constexpr float EPS = 1e-6f;
constexpr int NTHR = 512, NWAVE = 8;
constexpr int LDS_BYTES = 147456;

constexpr size_t al256(size_t x) { return (x + 255) / 256 * 256; }
constexpr size_t O_WIN   = 0;
constexpr size_t O_WUQ   = O_WIN  + al256((size_t)INWP * 1024 * 2);
constexpr size_t O_WUKV  = O_WUQ  + al256((size_t)1536 * 256 * 2);
constexpr size_t O_WPA   = O_WUKV + al256((size_t)2048 * 128 * 2);
constexpr size_t O_WPB   = O_WPA  + al256((size_t)1024 * 1024 * 2);
constexpr size_t O_WO    = O_WPB  + al256((size_t)1024 * 1024 * 2);
constexpr size_t O_WPQ   = O_WO   + al256((size_t)1024 * 1024 * 2);
constexpr size_t O_WS    = O_WPQ  + al256((size_t)2048 * 1024 * 2);
constexpr size_t O_K1    = O_WS   + al256((size_t)8 * 128 * 128 * 2);
constexpr size_t O_K2    = O_K1   + al256((size_t)128 * 128 * 2);
constexpr size_t O_MOD   = O_K2   + al256((size_t)128 * 128 * 2);
constexpr size_t O_ROPE  = O_MOD  + al256((size_t)3 * 6144 * 4);
constexpr size_t O_BAR   = O_ROPE + al256((size_t)128 * 16 * 2 * 4);
constexpr size_t O_RSSV  = O_BAR + al256((size_t)3456 * 4);
constexpr size_t O_RSSQ  = O_RSSV + (size_t)NTOK * 32 * 4;
constexpr size_t O_RSSKV = O_RSSQ + (size_t)NTOK * 8 * 4;
constexpr size_t O_RSSY  = O_RSSKV + (size_t)NROW * 4 * 4;
constexpr size_t O_RSSEND = O_RSSY + (size_t)NTOK * 32 * 4;
constexpr size_t O_RA    = al256(O_RSSEND);
constexpr size_t O_RB    = O_RA  + al256((size_t)NROW * 1024 * 2);
constexpr size_t O_RC    = O_RB  + al256((size_t)NTOK * 1024 * 2);
constexpr size_t O_CQ    = O_RC  + al256((size_t)NTOK * 1024 * 2);
constexpr size_t O_CKV   = O_CQ  + al256((size_t)NTOK * 256 * 2);
constexpr size_t O_KR    = O_CKV + al256((size_t)NROW * 128 * 2);
constexpr size_t O_RQ    = O_KR  + al256((size_t)NROW * 64 * 2);
constexpr size_t O_RKV   = O_RQ  + al256((size_t)NTOK * 1536 * 2);
constexpr size_t O_END   = O_RKV + al256((size_t)NROW * 2048 * 2);
static_assert(O_END <= (size_t)258 * 1024 * 1024, "workspace too large");

struct Params {
  const float *x, *c, *ctx, *c_ctx, *w_mod, *b_mod, *g_pre1, *g_post1, *g_pre2, *g_post2, *w_in, *g_q, *g_kv, *w_uq, *w_ukv, *g_sgu, *w_s, *b_s,
      *w_pa, *w_pb, *w_o, *w_pq, *k1, *k2, *u_exp, *v_exp;
  float* out; char* ws;
};

DEVI float bf2f(unsigned short h) { return __uint_as_float(((unsigned)h) << 16); }
DEVI unsigned short f2bf(float f) { unsigned u = __float_as_uint(f); u += 0x7fffu + ((u >> 16) & 1u); return (unsigned short)(u >> 16); }
DEVI unsigned pack2(float a, float b) { return (unsigned)f2bf(a) | ((unsigned)f2bf(b) << 16); }
DEVI float lo2f(unsigned w) { return __uint_as_float(w << 16); }
DEVI float hi2f(unsigned w) { return __uint_as_float(w & 0xffff0000u); }
DEVI void unpack8(const u32x4& w, float* f) {
  f[0] = lo2f(w[0]); f[1] = hi2f(w[0]); f[2] = lo2f(w[1]); f[3] = hi2f(w[1]); f[4] = lo2f(w[2]); f[5] = hi2f(w[2]); f[6] = lo2f(w[3]); f[7] = hi2f(w[3]);
}
DEVI float gelu_t(float x) { float z = 0.7978845608028654f * (x + 0.044715f * x * x * x); return x / (1.f + __expf(-2.f * z)); }
DEVI float sigmoidf_(float x) { return 1.f / (1.f + __expf(-x)); }
DEVI float wave_sum(float v) { for (int o = 32; o > 0; o >>= 1) v += __shfl_xor(v, o); return v; }
DEVI float wave_max(float v) { for (int o = 32; o > 0; o >>= 1) v = fmaxf(v, __shfl_xor(v, o)); return v; }
DEVI int keyrow(int row) { if (row < NTOK) return (row >> 13) * NKEY + (row & 8191); int c = row - NTOK; return (c >> 8) * NKEY + SEQ + (c & 255); }

__device__ const float ROPE_FREQ[16] = {1.0f, 0.5623413324356079f, 0.3162277638912201f, 0.17782793939113617f, 0.10000000149011612f, 0.05623413249850273f, 0.03162277489900589f, 0.017782794311642647f, 0.009999999776482582f, 0.005623413249850273f, 0.003162277629598975f, 0.0017782794311642647f, 0.0010000000474974513f, 0.000562341301701963f, 0.0003162277571391314f, 0.00017782794020604342f};
DEVI void sincos_small(double a, double& cs, double& sn) {
  const double k = rint(a * 0.15915494309189535); const double r = fma(-k, 6.283185307179586, a) - k * 2.4492935982947064e-16;
  const double r2 = r * r; double s = 0.0, c = 0.0;
#pragma unroll
  for (int n = 12; n >= 1; --n) { s = (1.0 - s * r2 / (double)((2 * n) * (2 * n + 1))); c = (1.0 - c * r2 / (double)((2 * n - 1) * (2 * n))); }
  sn = r * s; cs = c;
}

DEVI void transpose_job(const float* __restrict__ src, int K, int N, bf16_t* __restrict__ dst, const float* __restrict__ gk, bool isWin, int ntiles, char* smem) {
  const int tid = threadIdx.x; bf16_t* tl = (bf16_t*)smem; const int kt = K / 64;
  for (int idx = blockIdx.x; idx < ntiles; idx += gridDim.x) {
    const int ktile = idx % kt, ntile = idx / kt, k0 = ktile * 64, n0d = ntile * 64;
    int n0s = n0d; bool zero = false;
    if (isWin) { if (n0d == 2496) zero = true; else if (n0d >= 2560) n0s = n0d - 64; }
    { const int kk = tid >> 3, nn8 = (tid & 7) * 8; f32x4 va = {0.f, 0.f, 0.f, 0.f}, vb = va;
      if (!zero) { const float* s = src + (size_t)(k0 + kk) * N + n0s + nn8; const float4 a = *(const float4*)s, b = *(const float4*)(s + 4);
        const float sc = gk ? gk[k0 + kk] : 1.f; va = (f32x4){a.x, a.y, a.z, a.w} * sc; vb = (f32x4){b.x, b.y, b.z, b.w} * sc; }
      bf16_t* tp = tl + nn8 * 72 + kk;
      tp[0] = f2bf(va[0]); tp[72] = f2bf(va[1]); tp[144] = f2bf(va[2]); tp[216] = f2bf(va[3]); tp[288] = f2bf(vb[0]); tp[360] = f2bf(vb[1]); tp[432] = f2bf(vb[2]); tp[504] = f2bf(vb[3]); }
    __syncthreads();
    { const int nn = tid >> 3, kk8 = (tid & 7) * 8;
      const u32x4 o = *(const u32x4*)(tl + nn * 72 + kk8);
      *(u32x4*)(dst + (size_t)(n0d + nn) * K + k0 + kk8) = o; }
    __syncthreads();
  }
}

DEVI void ph_prep(const Params& p, char* smem) {
  const int tid = threadIdx.x, bid = blockIdx.x, nb = gridDim.x;
  char* ws = p.ws;
  if (bid == 0) { float* rope = (float*)(ws + O_ROPE);
    for (int i = tid; i < 128 * 16; i += NTHR) { const int pos = i >> 4, f = i & 15; const float ang = (float)pos * ROPE_FREQ[f];
      double cs, sn; sincos_small((double)ang, cs, sn); rope[i * 2] = (float)cs; rope[i * 2 + 1] = (float)sn; } }
  { float* red = (float*)smem; float* MOD = (float*)(ws + O_MOD);
    for (int it = bid; it < 256; it += nb) {
      const int cgp = tid % 6, kg = tid / 6;
      f32x4 a0 = {0.f, 0.f, 0.f, 0.f}, a1 = a0, a2 = a0;
      if (tid < 510) {
        for (int k = kg; k < 1024; k += 85) {
          const float4 w4 = *(const float4*)(p.w_mod + (size_t)k * 6144 + it * 24 + cgp * 4);
          const f32x4 w = {w4.x, w4.y, w4.z, w4.w};
          const float c0 = p.c[k], c1 = p.c[1024 + k], c2 = p.c_ctx[k];
          a0 += w * (c0 / (1.f + __expf(-c0))); a1 += w * (c1 / (1.f + __expf(-c1))); a2 += w * (c2 / (1.f + __expf(-c2)));
        }
        float* rp = red + kg * 72 + cgp * 4;
        rp[0] = a0[0]; rp[1] = a0[1]; rp[2] = a0[2]; rp[3] = a0[3];
        rp[24] = a1[0]; rp[25] = a1[1]; rp[26] = a1[2]; rp[27] = a1[3];
        rp[48] = a2[0]; rp[49] = a2[1]; rp[50] = a2[2]; rp[51] = a2[3];
      }
      __syncthreads();
      if (tid < 72) { float s = 0.f; for (int g = 0; g < 85; ++g) s += red[g * 72 + tid]; int r = tid / 24, n = it * 24 + tid % 24; MOD[r * 6144 + n] = s + p.b_mod[n]; }
      __syncthreads();
    } }
  transpose_job(p.w_in,  1024, INW,  (bf16_t*)(ws + O_WIN),  nullptr, true,  1152, smem);
  transpose_job(p.w_uq,  256,  1536, (bf16_t*)(ws + O_WUQ),  p.g_q,   false, 96,   smem);
  transpose_job(p.w_ukv, 128,  2048, (bf16_t*)(ws + O_WUKV), p.g_kv,  false, 64,   smem);
  transpose_job(p.w_pa,  1024, 1024, (bf16_t*)(ws + O_WPA),  nullptr, false, 256,  smem);
  transpose_job(p.w_pb,  1024, 1024, (bf16_t*)(ws + O_WPB),  nullptr, false, 256,  smem);
  transpose_job(p.w_o,   1024, 1024, (bf16_t*)(ws + O_WO),   nullptr, false, 256,  smem);
  transpose_job(p.w_pq,  1024, 2048, (bf16_t*)(ws + O_WPQ),  nullptr, false, 512,  smem);
  { const int n8 = (131072 + 16384 + 16384) / 8;
    for (int i = bid * NTHR + tid; i < n8; i += nb * NTHR) {
      int e = i * 8; const float* s; bf16_t* d;
      if (e < 131072) { s = p.w_s + e; d = (bf16_t*)(ws + O_WS) + e; }
      else if (e < 131072 + 16384) { s = p.k1 + (e - 131072); d = (bf16_t*)(ws + O_K1) + (e - 131072); }
      else { s = p.k2 + (e - 131072 - 16384); d = (bf16_t*)(ws + O_K2) + (e - 131072 - 16384); }
      const float4 a = *(const float4*)s, b = *(const float4*)(s + 4);
      u32x4 o = {pack2(a.x, a.y), pack2(a.z, a.w), pack2(b.x, b.y), pack2(b.z, b.w)};
      *(u32x4*)d = o;
    } }
}

typedef float f32x2_t __attribute__((ext_vector_type(2)));
DEVI void convert_table_fp8(const float* __restrict__ src, unsigned char* __restrict__ dst, float* __restrict__ scale) {
  const int wave = threadIdx.x >> 6, lane = threadIdx.x & 63;
  for (int row = blockIdx.x * NWAVE + wave; row < 16384; row += gridDim.x * NWAVE) {
    const float* sp = src + (size_t)row * 1024 + lane * 16;
    float4 v[4]; float am = 0.f;
#pragma unroll
    for (int j = 0; j < 4; ++j) { v[j] = *(const float4*)(sp + j * 4); am = fmaxf(am, fmaxf(fmaxf(fabsf(v[j].x), fabsf(v[j].y)), fmaxf(fabsf(v[j].z), fabsf(v[j].w)))); }
    am = wave_max(am);
    const float inv = am > 0.f ? 240.f / am : 0.f;
    u32x4 o;
#pragma unroll
    for (int j = 0; j < 4; ++j) { int w = __builtin_amdgcn_cvt_pk_fp8_f32(v[j].x * inv, v[j].y * inv, 0, false); w = __builtin_amdgcn_cvt_pk_fp8_f32(v[j].z * inv, v[j].w * inv, w, true); o[j] = (unsigned)w; }
    *(u32x4*)(dst + (size_t)row * 1024 + lane * 16) = o;
    if (lane == 0) scale[row] = am * (1.f / 240.f);
  }
}


using f32x32 = __attribute__((ext_vector_type(32))) float;
using u32x6 = __attribute__((ext_vector_type(6))) unsigned;
typedef u32x4 __attribute__((aligned(4))) u32x4_u;
typedef u32x2 __attribute__((aligned(4))) u32x2_u;
DEVI void convert_table_fp6(const float* __restrict__ src, unsigned char* __restrict__ dst, float* __restrict__ scale) {
  const int wave = threadIdx.x >> 6, lane = threadIdx.x & 63, h = lane >> 5, g = lane & 31;
  for (int rp = blockIdx.x * NWAVE + wave; rp < 8192; rp += gridDim.x * NWAVE) {
    const int row = rp * 2 + h;
    const float* sp = src + (size_t)row * 1024 + g * 32;
    f32x16 a, b; float am = 0.f;
#pragma unroll
    for (int j = 0; j < 4; ++j) { const float4 t = *(const float4*)(sp + j * 4), u = *(const float4*)(sp + 16 + j * 4);
      a[j * 4] = t.x; a[j * 4 + 1] = t.y; a[j * 4 + 2] = t.z; a[j * 4 + 3] = t.w; b[j * 4] = u.x; b[j * 4 + 1] = u.y; b[j * 4 + 2] = u.z; b[j * 4 + 3] = u.w;
      am = fmaxf(am, fmaxf(fmaxf(fmaxf(fabsf(t.x), fabsf(t.y)), fmaxf(fabsf(t.z), fabsf(t.w))), fmaxf(fmaxf(fabsf(u.x), fabsf(u.y)), fmaxf(fabsf(u.z), fabsf(u.w))))); }
    for (int o = 16; o > 0; o >>= 1) am = fmaxf(am, __shfl_xor(am, o));
    const float inv = am > 0.f ? 7.5f / am : 0.f;
    const u32x6 w = __builtin_amdgcn_cvt_scalef32_2xpk16_fp6_f32(a * inv, b * inv, 1.0f);
    unsigned char* dp = dst + (size_t)row * 768 + g * 24;
    *(u32x4_u*)dp = (u32x4){w[0], w[1], w[2], w[3]}; *(u32x2_u*)(dp + 16) = (u32x2){w[4], w[5]};
    if (g == 0) scale[row] = am * (1.f / 7.5f);
  }
}

DEVI void ph_hx(const Params& p, char* smem) {
  const int tid = threadIdx.x, wave = tid >> 6, lane = tid & 63;
  float* mA = (float*)smem; float* mB = mA + 3 * 1024;
  const float* MOD = (const float*)(p.ws + O_MOD);
  for (int i = tid; i < 3072; i += NTHR) { int r = i >> 10, c = i & 1023; mA[i] = p.g_pre1[c] * (1.f + MOD[r * 6144 + 1024 + c]); mB[i] = MOD[r * 6144 + c]; }
  __syncthreads();
  bf16_t* HX = (bf16_t*)(p.ws + O_RA);
  for (int row = blockIdx.x * NWAVE + wave; row < NROW; row += gridDim.x * NWAVE) {
    const float* src = row < NTOK ? p.x + (size_t)row * 1024 : p.ctx + (size_t)(row - NTOK) * 1024;
    const int mr = row < NTOK ? (row >> 13) : 2;
    float4 v[4]; float ss = 0.f;
#pragma unroll
    for (int i = 0; i < 4; ++i) { v[i] = *(const float4*)(src + i * 256 + lane * 4); ss += v[i].x * v[i].x + v[i].y * v[i].y + v[i].z * v[i].z + v[i].w * v[i].w; }
    ss = wave_sum(ss); const float rstd = rsqrtf(ss * (1.f / 1024.f) + EPS);
#pragma unroll
    for (int i = 0; i < 4; ++i) { const int c = i * 256 + lane * 4; const float* a = mA + mr * 1024 + c; const float* b = mB + mr * 1024 + c;
      u32x2 o = {pack2(v[i].x * rstd * a[0] + b[0], v[i].y * rstd * a[1] + b[1]), pack2(v[i].z * rstd * a[2] + b[2], v[i].w * rstd * a[3] + b[3])};
      *(u32x2*)(HX + (size_t)row * 1024 + c) = o; }
  }
}

DEVI int lds_sw(int row, int c) { return row * 128 + ((c ^ (row & 7)) << 4); }
template <int BM, int BN, bool ACOLMAP, bool GLDS, class Epi>
DEVI void gemm_tile_mfma(const bf16_t* __restrict__ A, int lda, const bf16_t* __restrict__ Bm, int ldb, int K, int row0, int col0, const Epi& epi, const float* kscale, char* smem) {
  constexpr int WNW = BN / 64, WMW = 8 / WNW, WTM = BM / WMW, MI = WTM / 16, ACH = BM / 64, BCH = BN / 64, ABYTES = BM * 128, BBYTES = BN * 128, STAGE = ABYTES + BBYTES;
  int tid = threadIdx.x; asm volatile("" : "+v"(tid));
  const int wave = __builtin_amdgcn_readfirstlane(tid >> 6), lane = tid & 63, wm = wave / WNW, wn = wave % WNW, l15 = lane & 15, lq = lane >> 4;
  f32x4 acc[MI][4];
#pragma unroll
  for (int mi = 0; mi < MI; ++mi)
#pragma unroll
    for (int ni = 0; ni < 4; ++ni) acc[mi][ni] = (f32x4){0.f, 0.f, 0.f, 0.f};
  const int nk = K >> 6;
  const int sr = tid >> 3, scc = tid & 7;
  auto compute = [&](int buf) {
    const char* sa = smem + buf * STAGE; const char* sb = sa + ABYTES;
#pragma unroll
    for (int ks = 0; ks < 2; ++ks) { const int kc = ks * 4 + lq; bf16x8 bfr[4];
#pragma unroll
      for (int ni = 0; ni < 4; ++ni) bfr[ni] = *(const bf16x8*)(sb + lds_sw(wn * 64 + ni * 16 + l15, kc));
#pragma unroll
      for (int mi = 0; mi < MI; ++mi) { const bf16x8 af = *(const bf16x8*)(sa + lds_sw(wm * WTM + mi * 16 + l15, kc));
#pragma unroll
        for (int ni = 0; ni < 4; ++ni) acc[mi][ni] = __builtin_amdgcn_mfma_f32_16x16x32_bf16(bfr[ni], af, acc[mi][ni], 0, 0, 0); }
      if (MI > 4 && GEMM_KS_SBAR) __builtin_amdgcn_sched_barrier(0); }
  };
  if constexpr (GLDS) {
    const unsigned aoff = (unsigned)(sr * lda + ((scc ^ (sr & 7)) * 8)) * 2u, boff = (unsigned)(sr * ldb + ((scc ^ (sr & 7)) * 8)) * 2u;
    auto gstage = [&](int buf, int kt) {
      const int k0 = kt * 64, ka = ACOLMAP ? k0 + (k0 >> 7) * 64 : k0;
      char* sa = smem + buf * STAGE + wave * 1024; char* sb = sa + ABYTES;
#pragma unroll
      for (int i = 0; i < ACH; ++i) __builtin_amdgcn_global_load_lds((const unsigned*)((const char*)(A + (size_t)(64 * i) * lda + ka) + aoff), (unsigned*)(sa + i * 8192), 16, 0, 0);
#pragma unroll
      for (int i = 0; i < BCH; ++i) __builtin_amdgcn_global_load_lds((const unsigned*)((const char*)(Bm + (size_t)(64 * i) * ldb + k0) + boff), (unsigned*)(sb + i * 8192), 16, 0, 0);
    };
    gstage(0, 0); asm volatile("s_waitcnt vmcnt(0)" ::: "memory"); __syncthreads();
    for (int kt = 0; kt < nk; ++kt) {
      if (kt + 1 < nk) gstage((kt + 1) & 1, kt + 1);
      compute(kt & 1);
      asm volatile("s_waitcnt vmcnt(0)" ::: "memory"); __syncthreads();
    }
  } else {
    u32x4 ra[ACH], rb[BCH];
    const unsigned aoff = (unsigned)(sr * lda + scc * 8) * 2u, boff = (unsigned)(sr * ldb + scc * 8) * 2u;
    const int sdst = lds_sw(sr, scc);
    auto gload = [&](int kt) {
      const int k0 = kt * 64, ka = ACOLMAP ? k0 + (k0 >> 7) * 64 : k0;
#pragma unroll
      for (int i = 0; i < ACH; ++i) { const char* ub = (const char*)(A + (size_t)(64 * i) * lda + ka); ra[i] = *(const u32x4*)(ub + aoff); }
#pragma unroll
      for (int i = 0; i < BCH; ++i) { const char* ub = (const char*)(Bm + (size_t)(64 * i) * ldb + k0); rb[i] = *(const u32x4*)(ub + boff); }
    };
    auto lstore = [&](int buf, int kt) {
      char* sa = smem + buf * STAGE + sdst; char* sb = sa + ABYTES;
#pragma unroll
      for (int i = 0; i < ACH; ++i) { u32x4 v = ra[i];
        if (kscale) { float f[8]; unpack8(v, f); const float* ks = kscale + kt * 64 + scc * 8;
          v = (u32x4){pack2(f[0] * ks[0], f[1] * ks[1]), pack2(f[2] * ks[2], f[3] * ks[3]), pack2(f[4] * ks[4], f[5] * ks[5]), pack2(f[6] * ks[6], f[7] * ks[7])}; }
        *(u32x4*)(sa + i * 8192) = v; }
#pragma unroll
      for (int i = 0; i < BCH; ++i) *(u32x4*)(sb + i * 8192) = rb[i];
    };
    gload(0); lstore(0, 0); __syncthreads();
    for (int kt = 0; kt < nk; ++kt) {
      if (kt + 1 < nk) gload(kt + 1);
      compute(kt & 1);
      if (kt + 1 < nk) lstore((kt + 1) & 1, kt + 1);
      __syncthreads();
    }
  }
  int tide = threadIdx.x; asm volatile("" : "+v"(tide));
  const int l15e = tide & 15, lqe = (tide >> 4) & 3;
#pragma unroll
  for (int mi = 0; mi < MI; ++mi) { const int row = row0 + wm * WTM + mi * 16 + l15e; float sq = 0.f;
#pragma unroll
    for (int ni = 0; ni < 4; ++ni) { const float v[4] = {acc[mi][ni][0], acc[mi][ni][1], acc[mi][ni][2], acc[mi][ni][3]}; const float q = epi(row, col0 + wn * 64 + ni * 16 + lqe * 4, v);
      if (Epi::RSS) { sq += q; if (ni & 1) { sq += __shfl_xor(sq, 16); sq += __shfl_xor(sq, 32); if (lqe == 0) epi.rss(row, col0 + wn * 64 + (ni >> 1) * 32, sq); sq = 0.f; } } }
    __builtin_amdgcn_sched_barrier(0); }
}


namespace g8 {
constexpr int BK = 64, HALF = 128, HT = HALF * BK;
DEVI int lds_byte(int r, int c) { const int st = (r >> 4) * 2 + (c >> 5), rr = r & 15, cc = c & 31, ob = rr * 64 + cc * 2; return st * 1024 + (ob ^ (((ob >> 9) & 1) << 5)); }
DEVI void stage_rc(int b, int& R, int& C) { const int st = b / 1024, sb = b % 1024, swz = sb ^ (((sb >> 9) & 1) << 5); R = (st >> 1) * 16 + swz / 64; C = (st & 1) * 32 + (swz % 64) / 2; }
}
template <bool ACOLMAP, class Epi>
DEVI void gemm_tile_8ph(const bf16_t* __restrict__ A, int lda, const bf16_t* __restrict__ Bt, int ldb, int K, int row0, int col0, const Epi& epi, char* smem) {
  using namespace g8;
  bf16_t* shm = (bf16_t*)smem;
#define SA(b, h) (shm + ((b) * 2 + (h)) * HT)
#define SB(b, h) (shm + (4 + (b) * 2 + (h)) * HT)
#define STAGE_A(P, r0, kt) do { const int _k0 = (kt) * BK, _ka = ACOLMAP ? _k0 + (_k0 >> 7) * 64 : _k0; \
    __builtin_amdgcn_global_load_lds((const unsigned*)((const char*)(A + (size_t)(r0) * lda + _ka) + ao0), (unsigned*)((char*)(P) + wid * 1024), 16, 0, 0); \
    __builtin_amdgcn_global_load_lds((const unsigned*)((const char*)(A + (size_t)((r0) + 64) * lda + _ka) + ao0), (unsigned*)((char*)(P) + wid * 1024 + 8192), 16, 0, 0); } while (0)
#define STAGE_B(P, r0, kt) do { const int _k0 = (kt) * BK; \
    __builtin_amdgcn_global_load_lds((const unsigned*)((const char*)(Bt + (size_t)(r0) * ldb + _k0) + bo0), (unsigned*)((char*)(P) + wid * 1024), 16, 0, 0); \
    __builtin_amdgcn_global_load_lds((const unsigned*)((const char*)(Bt + (size_t)((r0) + 64) * ldb + _k0) + bo0), (unsigned*)((char*)(P) + wid * 1024 + 8192), 16, 0, 0); } while (0)
#define LDA(dst, b, h) _Pragma("unroll") for (int m = 0; m < 4; ++m) _Pragma("unroll") for (int k = 0; k < 2; ++k) \
    dst[m][k] = *reinterpret_cast<const bf16x8*>((const char*)SA(b, h) + lds_byte(wr * 64 + m * 16 + fr, k * 32 + fq * 8))
#define LDB(dst, b, h) _Pragma("unroll") for (int n = 0; n < 2; ++n) _Pragma("unroll") for (int k = 0; k < 2; ++k) \
    dst[n][k] = *reinterpret_cast<const bf16x8*>((const char*)SB(b, h) + lds_byte(wc * 32 + n * 16 + fr, k * 32 + fq * 8))
#define MMA(ai, bj, At_, Bt_) do { __builtin_amdgcn_s_setprio(1); \
    _Pragma("unroll") for (int m = 0; m < 4; ++m) _Pragma("unroll") for (int n = 0; n < 2; ++n) _Pragma("unroll") for (int k = 0; k < 2; ++k) \
      acc[ai][bj][m][n] = __builtin_amdgcn_mfma_f32_16x16x32_bf16(Bt_[n][k], At_[m][k], acc[ai][bj][m][n], 0, 0, 0); \
    __builtin_amdgcn_s_setprio(0); } while (0)
#define WAIT_V(n) asm volatile("s_waitcnt vmcnt(" #n ")" ::: "memory")
#define WAIT_L(n) asm volatile("s_waitcnt lgkmcnt(" #n ")" ::: "memory")
#define BAR __builtin_amdgcn_s_barrier()
#define SCHED __builtin_amdgcn_sched_barrier(0)
  int tid = threadIdx.x; asm volatile("" : "+v"(tid));
  const int wid = __builtin_amdgcn_readfirstlane(tid >> 6), lane = tid & 63, wr = wid >> 2, wc = wid & 3, fr = lane & 15, fq = lane >> 4;
  unsigned ao0, bo0;
  { int r, c; stage_rc(tid * 16, r, c); ao0 = (unsigned)(r * lda + c) * 2u; bo0 = (unsigned)(r * ldb + c) * 2u; }
  f32x4 acc[2][2][4][2];
#pragma unroll
  for (int a = 0; a < 2; ++a)
#pragma unroll
    for (int b = 0; b < 2; ++b)
#pragma unroll
      for (int m = 0; m < 4; ++m)
#pragma unroll
        for (int n = 0; n < 2; ++n) acc[a][b][m][n] = (f32x4){0.f, 0.f, 0.f, 0.f};
  bf16x8 At[4][2], B0[2][2], B1[2][2];
  const int nt = K / BK;
  STAGE_B(SB(0, 0), 0, 0); STAGE_A(SA(0, 0), 0, 0);
  STAGE_B(SB(0, 1), HALF, 0); STAGE_A(SA(0, 1), HALF, 0);
  if (wr == 1) BAR;
  WAIT_V(4); BAR;
  STAGE_B(SB(1, 0), 0, 1); STAGE_A(SA(1, 0), 0, 1); STAGE_B(SB(1, 1), HALF, 1);
  WAIT_V(6); BAR;
  for (int t = 0; t < nt - 2; t += 2) {
    LDB(B0, 0, 0); SCHED; LDA(At, 0, 0); STAGE_A(SA(1, 1), HALF, t + 1);
    WAIT_L(8); BAR; WAIT_L(0); MMA(0, 0, At, B0); BAR; SCHED;
    LDB(B1, 0, 1); STAGE_B(SB(0, 0), 0, t + 2);
    BAR; WAIT_L(0); MMA(0, 1, At, B1); BAR;
    LDA(At, 0, 1); STAGE_A(SA(0, 0), 0, t + 2);
    BAR; WAIT_L(0); MMA(1, 0, At, B0); BAR; SCHED;
    STAGE_B(SB(0, 1), HALF, t + 2);
    WAIT_V(6); BAR; MMA(1, 1, At, B1); BAR;
    LDB(B0, 1, 0); SCHED; LDA(At, 1, 0); STAGE_A(SA(0, 1), HALF, t + 2);
    WAIT_L(8); BAR; WAIT_L(0); MMA(0, 0, At, B0); BAR; SCHED;
    LDB(B1, 1, 1); STAGE_B(SB(1, 0), 0, t + 3);
    BAR; WAIT_L(0); MMA(0, 1, At, B1); BAR;
    LDA(At, 1, 1); STAGE_A(SA(1, 0), 0, t + 3);
    BAR; WAIT_L(0); MMA(1, 0, At, B0); BAR; SCHED;
    STAGE_B(SB(1, 1), HALF, t + 3);
    WAIT_V(6); BAR; MMA(1, 1, At, B1); BAR;
  }
  { LDB(B0, 0, 0); LDA(At, 0, 0); STAGE_A(SA(1, 1), HALF, nt - 1);
    BAR; WAIT_L(0); MMA(0, 0, At, B0); BAR;
    LDB(B1, 0, 1); BAR; WAIT_L(0); MMA(0, 1, At, B1); BAR;
    LDA(At, 0, 1); WAIT_V(4); BAR; WAIT_L(0); MMA(1, 0, At, B0); MMA(1, 1, At, B1); BAR; }
  { LDB(B0, 1, 0); LDA(At, 1, 0); WAIT_V(2); BAR; WAIT_L(0); MMA(0, 0, At, B0); BAR;
    LDB(B1, 1, 1); WAIT_V(0); BAR; WAIT_L(0); MMA(0, 1, At, B1); BAR;
    LDA(At, 1, 1); BAR; WAIT_L(0); MMA(1, 0, At, B0); MMA(1, 1, At, B1); BAR; }
  if (wr == 0) BAR;
  int tide = threadIdx.x; asm volatile("" : "+v"(tide));
  const int fre = tide & 15, fqe = (tide >> 4) & 3;
#pragma unroll
  for (int ai = 0; ai < 2; ++ai)
#pragma unroll
    for (int m = 0; m < 4; ++m) { const int row = row0 + ai * HALF + wr * 64 + m * 16 + fre;
#pragma unroll
      for (int bj = 0; bj < 2; ++bj) { float sq = 0.f;
#pragma unroll
        for (int n = 0; n < 2; ++n) { const float v[4] = {acc[ai][bj][m][n][0], acc[ai][bj][m][n][1], acc[ai][bj][m][n][2], acc[ai][bj][m][n][3]};
          sq += epi(row, col0 + bj * HALF + wc * 32 + n * 16 + fqe * 4, v); }
        if (Epi::RSS) { sq += __shfl_xor(sq, 16); sq += __shfl_xor(sq, 32); if (fqe == 0) epi.rss(row, col0 + bj * HALF + wc * 32, sq); } }
      __builtin_amdgcn_sched_barrier(0); }
#undef SA
#undef SB
#undef STAGE_A
#undef STAGE_B
#undef LDA
#undef LDB
#undef MMA
#undef WAIT_V
#undef WAIT_L
#undef BAR
#undef SCHED
}

template <int BM, int BN, bool ACOLMAP, class Epi>
DEVI void gemm_tile(const bf16_t* A, int lda, const bf16_t* Bm, int ldb, int K, int row0, int col0, const Epi& epi, const float* kss, char* smem) {
  if constexpr (BM == 256 && BN == 256 && GEMM_8PH) gemm_tile_8ph<ACOLMAP>(A, lda, Bm, ldb, K, row0, col0, epi, smem);
  else if (kss) gemm_tile_mfma<BM, BN, ACOLMAP, false>(A, lda, Bm, ldb, K, row0, col0, epi, kss, smem);
  else gemm_tile_mfma<BM, BN, ACOLMAP, true>(A, lda, Bm, ldb, K, row0, col0, epi, nullptr, smem);
}

DEVI void st4bf(bf16_t* d, float a, float b, float c, float e) { u32x2 o = {pack2(a, b), pack2(c, e)}; *(u32x2*)d = o; }

struct EpiIn { static constexpr bool RSS = true; bf16_t *GU, *GVT, *CQ, *CKV, *KR; float *rssv, *rssq, *rsskv;
  DEVI float operator()(int row, int col, const float (&v)[4]) const {
    if (col < 1024) { st4bf(GU + (size_t)row * 1024 + col, gelu_t(v[0]), gelu_t(v[1]), gelu_t(v[2]), gelu_t(v[3])); return 0.f; }
    else if (col < 2048) { const int c = col - 1024, chunk = row >> 7, q = row & 127; float s = 0.f;
#pragma unroll
      for (int j = 0; j < 4; ++j) { const float g = gelu_t(v[j]); s += g * g; GVT[((size_t)chunk * 1024 + c + j) * 128 + q] = f2bf(g); }
      return s; }
    else if (col < 2304) { st4bf(CQ + (size_t)row * 256 + (col - 2048), v[0], v[1], v[2], v[3]); return v[0] * v[0] + v[1] * v[1] + v[2] * v[2] + v[3] * v[3]; }
    else if (col < 2432) { st4bf(CKV + (size_t)row * 128 + (col - 2304), v[0], v[1], v[2], v[3]); return v[0] * v[0] + v[1] * v[1] + v[2] * v[2] + v[3] * v[3]; }
    else if (col < 2496) { st4bf(KR + (size_t)keyrow(row) * 64 + (col - 2432), v[0], v[1], v[2], v[3]); return 0.f; }
    return 0.f; }
  DEVI void rss(int row, int col, float s) const {
    if (col >= 1024 && col < 2048) rssv[row * 32 + ((col - 1024) >> 5)] = s; else if (col >= 2048 && col < 2304) rssq[row * 8 + ((col - 2048) >> 5)] = s; else if (col >= 2304 && col < 2432) rsskv[row * 4 + ((col - 2304) >> 5)] = s; }
};
struct EpiQ { static constexpr bool RSS = false; bf16_t* Q; const float* rssq;
  DEVI float operator()(int row, int col, const float (&v)[4]) const { const float4 ps = *(const float4*)(rssq + row * 8), pt = *(const float4*)(rssq + row * 8 + 4); const float r = rsqrtf((((ps.x + ps.y) + (ps.z + ps.w)) + ((pt.x + pt.y) + (pt.z + pt.w))) * (1.f / 256.f) + EPS);
    st4bf(Q + (size_t)row * 1536 + col, v[0] * r, v[1] * r, v[2] * r, v[3] * r); return 0.f; }
  DEVI void rss(int, int, float) const {} };
struct EpiKV { static constexpr bool RSS = false; bf16_t* KV; const float* rsskv;
  DEVI float operator()(int row, int col, const float (&v)[4]) const { const float4 pk = *(const float4*)(rsskv + row * 4); const float r = rsqrtf(((pk.x + pk.y) + (pk.z + pk.w)) * (1.f / 128.f) + EPS);
    st4bf(KV + (size_t)keyrow(row) * 2048 + col, v[0] * r, v[1] * r, v[2] * r, v[3] * r); return 0.f; }
  DEVI void rss(int, int, float) const {} };
DEVI int pk4_fp8(float a, float b, float c, float d) { int w = __builtin_amdgcn_cvt_pk_fp8_f32(a, b, 0, false); return __builtin_amdgcn_cvt_pk_fp8_f32(c, d, w, true); }
constexpr size_t O_K8 = O_RKV, O_V8T = O_RKV + al256((size_t)NB * 8 * NKEY * 192);
struct EpiK8 { static constexpr bool RSS = false; unsigned char* K8; const float* rsskv;
  DEVI float operator()(int row, int col, const float (&v)[4]) const { const float4 pk = *(const float4*)(rsskv + row * 4); const float r = rsqrtf(((pk.x + pk.y) + (pk.z + pk.w)) * (1.f / 128.f) + EPS);
    const int kr = keyrow(row), b = kr / NKEY, key = kr - b * NKEY, h = col >> 7, d = col & 127;
    *(int*)(K8 + ((size_t)(b * 8 + h) * NKEY + key) * 192 + d) = pk4_fp8(v[0] * r, v[1] * r, v[2] * r, v[3] * r); return 0.f; }
  DEVI void rss(int, int, float) const {} };
struct EpiV8T { static constexpr bool RSS = false; unsigned char* V8; const float* rsskv;
  DEVI float operator()(int row, int col, const float (&v)[4]) const {
    float r[4];
#pragma unroll
    for (int j = 0; j < 4; ++j) { const float4 pk = *(const float4*)(rsskv + (col + j) * 4); r[j] = rsqrtf(((pk.x + pk.y) + (pk.z + pk.w)) * (1.f / 128.f) + EPS); }
    const int kr = keyrow(col), b = kr / NKEY, key = kr - b * NKEY, h = row >> 7, d = row & 127, kk = key & 63;
    const int off = 32 * ((kk >> 2) & 1) + 16 * (kk >> 5) + 4 * ((kk >> 3) & 3);
    *(int*)(V8 + ((size_t)(b * 8 + h) * 128 + d) * NKEY + (key & ~63) + off) = pk4_fp8(v[0] * r[0], v[1] * r[1], v[2] * r[2], v[3] * r[3]); return 0.f; }
  DEVI void rss(int, int, float) const {} };
struct EpiSgu { static constexpr bool RSS = false; bf16_t* GUOA; const float* g_sgu; const float* b_s; int chunk, g;
  DEVI float operator()(int row, int col, const float (&v)[4]) const { const int token = chunk * 128 + row, ch = g * 128 + col; const float bias = b_s[g * 128 + row];
    bf16_t* ptr = GUOA + (size_t)token * 1024 + ch; const u32x2 gu = *(const u32x2*)ptr;
    st4bf(ptr, lo2f(gu[0]) * (g_sgu[ch] * v[0] + bias), hi2f(gu[0]) * (g_sgu[ch + 1] * v[1] + bias), lo2f(gu[1]) * (g_sgu[ch + 2] * v[2] + bias), hi2f(gu[1]) * (g_sgu[ch + 3] * v[3] + bias));
    return 0.f; }
  DEVI void rss(int, int, float) const {} };
struct EpiGate { static constexpr bool RSS = false; bf16_t* G;
  DEVI float operator()(int row, int col, const float (&v)[4]) const { st4bf(G + (size_t)row * 2048 + col, sigmoidf_(v[0]), sigmoidf_(v[1]), sigmoidf_(v[2]), sigmoidf_(v[3])); return 0.f; }
  DEVI void rss(int, int, float) const {} };
template <bool SECOND> struct EpiMerge { static constexpr bool RSS = false; bf16_t* M; const bf16_t* G;
  DEVI float operator()(int row, int col, const float (&v)[4]) const { const u32x2 g = *(const u32x2*)(G + (size_t)row * 2048 + (SECOND ? 1024 : 0) + col);
    float o0 = lo2f(g[0]) * v[0], o1 = hi2f(g[0]) * v[1], o2 = lo2f(g[1]) * v[2], o3 = hi2f(g[1]) * v[3];
    bf16_t* ptr = M + (size_t)row * 1024 + col;
    if (SECOND) { const u32x2 m = *(const u32x2*)ptr; o0 += lo2f(m[0]); o1 += hi2f(m[0]); o2 += lo2f(m[1]); o3 += hi2f(m[1]); }
    st4bf(ptr, o0, o1, o2, o3); return 0.f; }
  DEVI void rss(int, int, float) const {} };
struct EpiO { static constexpr bool RSS = true; bf16_t* Y; float* rssy;
  DEVI float operator()(int row, int col, const float (&v)[4]) const { st4bf(Y + (size_t)row * 1024 + col, v[0], v[1], v[2], v[3]); return v[0] * v[0] + v[1] * v[1] + v[2] * v[2] + v[3] * v[3]; }
  DEVI void rss(int row, int col, float s) const { rssy[row * 32 + (col >> 5)] = s; } };
struct EpiPq { static constexpr bool RSS = false; bf16_t* QP;
  DEVI float operator()(int row, int col, const float (&v)[4]) const { st4bf(QP + (size_t)row * 2048 + col, v[0], v[1], v[2], v[3]); return 0.f; }
  DEVI void rss(int, int, float) const {} };

template <class F> DEVI void for_tiles_xcd(int MT, int NT, F f) {
  const int nb = gridDim.x;
  if ((nb & 7) == 0 && (MT & 7) == 0) { const int xcd = blockIdx.x & 7, slot = blockIdx.x >> 3, slots = nb >> 3, mper = MT >> 3, tot = mper * NT;
    for (int j = slot; j < tot; j += slots) f(xcd * mper + j / NT, j % NT); }
  else for (int i = blockIdx.x; i < MT * NT; i += nb) f(i / NT, i % NT);
}

DEVI void ph_inproj(const Params& p, char* smem) {
  char* ws = p.ws;
  EpiIn epi{(bf16_t*)(ws + O_RB), (bf16_t*)(ws + O_RC), (bf16_t*)(ws + O_CQ), (bf16_t*)(ws + O_CKV), (bf16_t*)(ws + O_KR), (float*)(ws + O_RSSV), (float*)(ws + O_RSSQ), (float*)(ws + O_RSSKV)};
  const bf16_t* HX = (const bf16_t*)(ws + O_RA); const bf16_t* W = (const bf16_t*)(ws + O_WIN);
  auto tile = [&](int mt, int nt) { gemm_tile<256, 256, false>(HX + (size_t)mt * 256 * 1024, 1024, W + (size_t)nt * 256 * 1024, 1024, 1024, mt * 256, nt * 256, epi, nullptr, smem); };
  for_tiles_xcd(64, 10, tile);
  for (int i = (int)gridDim.x - 1 - (int)blockIdx.x; i < 2; i += gridDim.x) tile(64 + i, 9);
}
DEVI void rope_kr(const Params& p) {
  bf16_t* KR = (bf16_t*)(p.ws + O_KR); const float* rope = (const float*)(p.ws + O_ROPE);
  for (int i = blockIdx.x * NTHR + threadIdx.x; i < NTOK * 32; i += gridDim.x * NTHR) {
    const int tok = i >> 5, j = i & 15, which = (i >> 4) & 1, pos = tok & 8191, pp = which ? (pos & 63) : (pos >> 6);
    const float cs = rope[(pp * 16 + j) * 2], sn = rope[(pp * 16 + j) * 2 + 1];
    bf16_t* r = KR + (size_t)keyrow(tok) * 64 + which * 32 + j;
    const float x1 = bf2f(r[0]), x2 = bf2f(r[16]);
    r[0] = f2bf(x1 * cs - x2 * sn); r[16] = f2bf(x1 * sn + x2 * cs);
  }
}
DEVI void rope_kr_fp8(const Params& p) {
  const bf16_t* KR = (const bf16_t*)(p.ws + O_KR); const float* rope = (const float*)(p.ws + O_ROPE); unsigned char* K8 = (unsigned char*)(p.ws + O_K8);
  for (int i = blockIdx.x * NTHR + threadIdx.x; i < NROW * 2; i += gridDim.x * NTHR) {
    const int row = i >> 1, which = i & 1, kr = keyrow(row), b = kr / NKEY, key = kr - b * NKEY;
    float x[32];
    const bf16_t* src = KR + (size_t)kr * 64 + which * 32;
#pragma unroll
    for (int q = 0; q < 4; ++q) unpack8(*(const u32x4*)(src + q * 8), x + q * 8);
    if (row < NTOK) { const int pos = row & 8191, pp = which ? (pos & 63) : (pos >> 6); const float* cs = rope + pp * 32;
#pragma unroll
      for (int j = 0; j < 16; ++j) { const float c = cs[j * 2], sn = cs[j * 2 + 1], x1 = x[j], x2 = x[16 + j]; x[j] = x1 * c - x2 * sn; x[16 + j] = x1 * sn + x2 * c; } }
    u32x4 o0, o1;
#pragma unroll
    for (int q = 0; q < 4; ++q) { o0[q] = (unsigned)pk4_fp8(x[q * 4], x[q * 4 + 1], x[q * 4 + 2], x[q * 4 + 3]); o1[q] = (unsigned)pk4_fp8(x[16 + q * 4], x[17 + q * 4], x[18 + q * 4], x[19 + q * 4]); }
#pragma unroll
    for (int h = 0; h < 8; ++h) { unsigned char* d = K8 + ((size_t)(b * 8 + h) * NKEY + key) * 192 + 128 + which * 32; *(u32x4*)d = o0; *(u32x4*)(d + 16) = o1; }
  }
}
DEVI void ph_mid(const Params& p, char* smem) {
  char* ws = p.ws;
  { EpiQ epi{(bf16_t*)(ws + O_RQ), (const float*)(ws + O_RSSQ)};
    const bf16_t* A = (const bf16_t*)(ws + O_CQ); const bf16_t* W = (const bf16_t*)(ws + O_WUQ);
    for_tiles_xcd(64, 12, [&](int mt, int nt) { gemm_tile<256, 128, false>(A + (size_t)mt * 256 * 256, 256, W + (size_t)nt * 128 * 256, 256, 256, mt * 256, nt * 128, epi, nullptr, smem); }); }
#if ATTN_FP8
  { EpiK8 epi{(unsigned char*)(ws + O_K8), (const float*)(ws + O_RSSKV)};
    const bf16_t* A = (const bf16_t*)(ws + O_CKV); const bf16_t* W = (const bf16_t*)(ws + O_WUKV);
    auto tile = [&](int mt, int nt) { gemm_tile<256, 128, false>(A + (size_t)mt * 256 * 128, 128, W + (size_t)nt * 256 * 128, 128, 128, mt * 256, nt * 128, epi, nullptr, smem); };
    for_tiles_xcd(64, 8, tile);
    for (int i = blockIdx.x; i < 16; i += gridDim.x) tile(64 + (i >> 3), i & 7); }
  { EpiV8T epi{(unsigned char*)(ws + O_V8T), (const float*)(ws + O_RSSKV)};
    const bf16_t* A = (const bf16_t*)(ws + O_WUKV); const bf16_t* Bc = (const bf16_t*)(ws + O_CKV);
    for (int i = blockIdx.x; i < 8 * 132; i += gridDim.x) { const int mt = i & 7, nt = i >> 3;
      gemm_tile<128, 128, false>(A + (size_t)(mt * 256 + 128) * 128, 128, Bc + (size_t)nt * 128 * 128, 128, 128, mt * 128, nt * 128, epi, nullptr, smem); } }
#else
  { EpiKV epi{(bf16_t*)(ws + O_RKV), (const float*)(ws + O_RSSKV)};
    const bf16_t* A = (const bf16_t*)(ws + O_CKV); const bf16_t* W = (const bf16_t*)(ws + O_WUKV);
    auto tile = [&](int mt, int nt) { gemm_tile<256, 128, false>(A + (size_t)mt * 256 * 128, 128, W + (size_t)nt * 128 * 128, 128, 128, mt * 256, nt * 128, epi, nullptr, smem); };
    for_tiles_xcd(64, 16, tile);
    for (int i = blockIdx.x; i < 32; i += gridDim.x) tile(64 + (i >> 4), i & 15); }
#endif
  { const bf16_t* WS = (const bf16_t*)(ws + O_WS); const bf16_t* GVT = (const bf16_t*)(ws + O_RC);
    float* ksc = (float*)(smem + LDS_BYTES - 1024); const float* rssv = (const float*)(ws + O_RSSV);
    for (int i = blockIdx.x; i < 1024; i += gridDim.x) { const int chunk = i >> 3, g = i & 7;
      __syncthreads();
      if (threadIdx.x < 128) { const float* pr = rssv + (size_t)(chunk * 128 + threadIdx.x) * 32; float t = 0.f;
#pragma unroll
        for (int j = 0; j < 32; ++j) t += pr[j];
        ksc[threadIdx.x] = rsqrtf(t * (1.f / 1024.f) + EPS); }
      __syncthreads();
      EpiSgu epi{(bf16_t*)(ws + O_RB), p.g_sgu, p.b_s, chunk, g};
      gemm_tile<128, 128, false>(WS + (size_t)g * 16384, 128, GVT + ((size_t)chunk * 1024 + g * 128) * 128, 128, 128, 0, 0, epi, ksc, smem); } }
#if ATTN_FP8
  rope_kr_fp8(p);
#else
  rope_kr(p);
#endif
}
DEVI void ph_gates(const Params& p, char* smem) {
  char* ws = p.ws; EpiGate epi{(bf16_t*)(ws + O_RKV)};
  const bf16_t* HX = (const bf16_t*)(ws + O_RA); const bf16_t* W = (const bf16_t*)(ws + O_WIN) + (size_t)NPRE * 1024;
  for_tiles_xcd(64, 8, [&](int mt, int nt) { gemm_tile<256, 256, false>(HX + (size_t)mt * 256 * 1024, 1024, W + (size_t)nt * 256 * 1024, 1024, 1024, mt * 256, nt * 256, epi, nullptr, smem); });
}
DEVI void ph_merge(const Params& p, char* smem) {
  char* ws = p.ws; bf16_t* M = (bf16_t*)(ws + O_RC); const bf16_t* G = (const bf16_t*)(ws + O_RKV);
  EpiMerge<false> e1{M, G}; EpiMerge<true> e2{M, G};
  const bf16_t* OA = (const bf16_t*)(ws + O_RB); const bf16_t* OB = (const bf16_t*)(ws + O_RQ);
  const bf16_t* WA = (const bf16_t*)(ws + O_WPA); const bf16_t* WB = (const bf16_t*)(ws + O_WPB);
  for_tiles_xcd(64, 4, [&](int mt, int nt) { gemm_tile<256, 256, false>(OA + (size_t)mt * 256 * 1024, 1024, WA + (size_t)nt * 256 * 1024, 1024, 1024, mt * 256, nt * 256, e1, nullptr, smem); });
  for_tiles_xcd(64, 4, [&](int mt, int nt) { gemm_tile<256, 256, true>(OB + (size_t)mt * 256 * 1536, 1536, WB + (size_t)nt * 256 * 1024, 1024, 1024, mt * 256, nt * 256, e2, nullptr, smem); });
}
DEVI void ph_wo(const Params& p, char* smem) {
  char* ws = p.ws; EpiO epi{(bf16_t*)(ws + O_RA), (float*)(ws + O_RSSY)};
  const bf16_t* M = (const bf16_t*)(ws + O_RC); const bf16_t* W = (const bf16_t*)(ws + O_WO);
  for_tiles_xcd(64, 4, [&](int mt, int nt) { gemm_tile<256, 256, false>(M + (size_t)mt * 256 * 1024, 1024, W + (size_t)nt * 256 * 1024, 1024, 1024, mt * 256, nt * 256, epi, nullptr, smem); });
}
DEVI void ph_wpq(const Params& p, char* smem) {
  char* ws = p.ws; EpiPq epi{(bf16_t*)(ws + O_RKV)};
  const bf16_t* A = (const bf16_t*)(ws + O_RB); const bf16_t* W = (const bf16_t*)(ws + O_WPQ);
  for_tiles_xcd(64, 8, [&](int mt, int nt) { gemm_tile<256, 256, false>(A + (size_t)mt * 256 * 1024, 1024, W + (size_t)nt * 256 * 1024, 1024, 1024, mt * 256, nt * 256, epi, nullptr, smem); });
#if GATHER_FP6
  convert_table_fp6(p.v_exp, (unsigned char*)(ws + O_RA), (float*)(ws + O_RA + (size_t)16384 * 1024));
#else
  convert_table_fp8(p.v_exp, (unsigned char*)(ws + O_RA), (float*)(ws + O_RA + (size_t)16384 * 1024));
#endif
}

DEVI void attn_naive(const Params& p, char* smem) {
  const int tid = threadIdx.x, wave = tid >> 6, lane = tid & 63;
  float* qs = (float*)smem + wave * 256; float* ps = qs + 192;
  bf16_t* Q = (bf16_t*)(p.ws + O_RQ); const bf16_t* KV = (const bf16_t*)(p.ws + O_RKV); const bf16_t* KR = (const bf16_t*)(p.ws + O_KR);
  const float* rope = (const float*)(p.ws + O_ROPE);
  const float scale = 0.07216878364870322f;
  for (int base = blockIdx.x * NWAVE; base < NB * 8 * SEQ; base += gridDim.x * NWAVE) {
    const int it = base + wave, bh = it >> 13, qi = it & 8191, b = bh >> 3, h = bh & 7;
    const size_t qoff = (size_t)(b * SEQ + qi) * 1536 + h * 192;
    __syncthreads();
    for (int d = lane; d < 192; d += 64) qs[d] = bf2f(Q[qoff + d]);
    __syncthreads();
    if (lane < 32) { const int j = lane & 15, which = lane >> 4, pp = which ? (qi & 63) : (qi >> 6);
      const float cs = rope[(pp * 16 + j) * 2], sn = rope[(pp * 16 + j) * 2 + 1]; const int d1 = 128 + which * 32 + j, d2 = d1 + 16;
      const float x1 = qs[d1], x2 = qs[d2]; qs[d1] = x1 * cs - x2 * sn; qs[d2] = x1 * sn + x2 * cs; }
    __syncthreads();
    float m = -1e30f, l = 0.f, o0 = 0.f, o1 = 0.f;
    for (int k0 = 0; k0 < NKEY; k0 += 64) {
      const size_t kr = (size_t)(b * NKEY + k0 + lane);
      const bf16_t* kn = KV + kr * 2048 + h * 256; const bf16_t* krp = KR + kr * 64;
      float s = 0.f;
#pragma unroll 4
      for (int d8 = 0; d8 < 16; ++d8) { float kf[8]; unpack8(*(const u32x4*)(kn + d8 * 8), kf); const float4 q0 = *(const float4*)(qs + d8 * 8), q1 = *(const float4*)(qs + d8 * 8 + 4);
        s += q0.x * kf[0] + q0.y * kf[1] + q0.z * kf[2] + q0.w * kf[3] + q1.x * kf[4] + q1.y * kf[5] + q1.z * kf[6] + q1.w * kf[7]; }
#pragma unroll 4
      for (int d8 = 0; d8 < 8; ++d8) { float kf[8]; unpack8(*(const u32x4*)(krp + d8 * 8), kf); const float4 q0 = *(const float4*)(qs + 128 + d8 * 8), q1 = *(const float4*)(qs + 128 + d8 * 8 + 4);
        s += q0.x * kf[0] + q0.y * kf[1] + q0.z * kf[2] + q0.w * kf[3] + q1.x * kf[4] + q1.y * kf[5] + q1.z * kf[6] + q1.w * kf[7]; }
      s *= scale;
      const float mn = fmaxf(m, wave_max(s)), al = __expf(m - mn), pe = __expf(s - mn);
      l = l * al + wave_sum(pe); m = mn; o0 *= al; o1 *= al;
      __syncthreads();
      ps[lane] = pe;
      __syncthreads();
      const bf16_t* vp = KV + (size_t)(b * NKEY + k0) * 2048 + h * 256 + 128 + lane * 2;
#pragma unroll 8
      for (int kk = 0; kk < 64; ++kk) { const unsigned w = *(const unsigned*)(vp + (size_t)kk * 2048); const float pk = ps[kk]; o0 += pk * lo2f(w); o1 += pk * hi2f(w); }
    }
    const float invL = 1.f / l;
    *(unsigned*)(Q + qoff + lane * 2) = pack2(o0 * invL, o1 * invL);
  }
}

namespace at {
constexpr int QBLK = 32, KVBLK = 64;
constexpr float SCALE = 0.07216878364870322f;
constexpr float THR = 8.f;
constexpr int SHM_V = KVBLK * 128 * 2, SHM_K = KVBLK * 192 * 2;
using s16x4 = __attribute__((ext_vector_type(4))) short;
#define KSWZ(row, colB) ((row) * 384 + ((colB) ^ (((row) & 7) << 4)))
#define SBAR() __builtin_amdgcn_sched_barrier(0)
DEVI int crow(int r, int hi) { return (r & 3) + 8 * (r >> 2) + 4 * hi; }
DEVI unsigned cvtpk(float lo, float hi) { unsigned r; asm volatile("v_cvt_pk_bf16_f32 %0, %1, %2" : "=v"(r) : "v"(lo), "v"(hi)); return r; }
DEVI void partialSM(f32x16& p0, f32x16& p1, float& m_reg, float& mn, float& alpha) {
  constexpr float C = SCALE * 1.4426950408889634f;
  float pmax = p0[0];
#pragma unroll
  for (int r = 1; r < 16; ++r) pmax = fmaxf(pmax, p0[r]);
#pragma unroll
  for (int r = 0; r < 16; ++r) pmax = fmaxf(pmax, p1[r]);
  { auto rr = __builtin_amdgcn_permlane32_swap(__float_as_uint(pmax), __float_as_uint(pmax), false, false);
    pmax = fmaxf(__uint_as_float(rr[0]), __uint_as_float(rr[1])); }
  if (__builtin_expect(__all(pmax - m_reg <= THR / SCALE), 1)) { mn = m_reg; alpha = 1.f; }
  else { mn = fmaxf(m_reg, pmax); alpha = __builtin_amdgcn_exp2f((m_reg - mn) * C); m_reg = mn; }
  const float mnC = -mn * C;
#pragma unroll
  for (int r = 0; r < 16; ++r) p0[r] = fmaf(p0[r], C, mnC);
#pragma unroll
  for (int r = 0; r < 16; ++r) p1[r] = fmaf(p1[r], C, mnC);
#pragma unroll
  for (int r = 0; r < 16; ++r) p0[r] = __builtin_amdgcn_exp2f(p0[r]);
}
DEVI void finishSM(f32x16& p0, f32x16& p1, float alpha, float& l_reg, bf16x8& pa0, bf16x8& pa1, bf16x8& pa2, bf16x8& pa3) {
#pragma unroll
  for (int r = 0; r < 16; ++r) p1[r] = __builtin_amdgcn_exp2f(p1[r]);
  float ps = 0;
#pragma unroll
  for (int r = 0; r < 16; ++r) ps += p0[r];
#pragma unroll
  for (int r = 0; r < 16; ++r) ps += p1[r];
  { auto rr = __builtin_amdgcn_permlane32_swap(__float_as_uint(ps), __float_as_uint(ps), false, false);
    ps = __uint_as_float(rr[0]) + __uint_as_float(rr[1]); }
  l_reg = l_reg * alpha + ps;
#define PK4(P, BASE, OUT) do { unsigned a0 = cvtpk(P[BASE + 0], P[BASE + 1]), a1 = cvtpk(P[BASE + 2], P[BASE + 3]);   \
    unsigned b0 = cvtpk(P[BASE + 4], P[BASE + 5]), b1 = cvtpk(P[BASE + 6], P[BASE + 7]);                              \
    auto r0 = __builtin_amdgcn_permlane32_swap(a0, b0, false, false); auto r1 = __builtin_amdgcn_permlane32_swap(a1, b1, false, false); \
    u32x4 w = {r0[0], r1[0], r0[1], r1[1]}; OUT = *reinterpret_cast<bf16x8*>(&w); } while (0)
  PK4(p0, 0, pa0); PK4(p0, 8, pa1); PK4(p1, 0, pa2); PK4(p1, 8, pa3);
#undef PK4
}
DEVI void qkt(f32x16& p0, f32x16& p1, const char* Ks, const bf16x8* qr, const char* qrl, int r32, int hi) {
  p0 = f32x16{}; p1 = f32x16{};
#pragma unroll
  for (int d0 = 0; d0 < 12; ++d0) { const int cb = (d0 * 16 + hi * 8) * 2;
    const bf16x8 b0 = *reinterpret_cast<const bf16x8*>(Ks + KSWZ(r32, cb));
    const bf16x8 b1 = *reinterpret_cast<const bf16x8*>(Ks + KSWZ(32 + r32, cb));
    const bf16x8 q = d0 < 8 ? qr[d0 < 8 ? d0 : 0] : *reinterpret_cast<const bf16x8*>(qrl + (d0 - 8) * 1024);
    p0 = __builtin_amdgcn_mfma_f32_32x32x16_bf16(b0, q, p0, 0, 0, 0);
    p1 = __builtin_amdgcn_mfma_f32_32x32x16_bf16(b1, q, p1, 0, 0, 0); }
}
DEVI int v_st(int k, int c) { const int kk = (k & ~0xC) | ((k & 4) << 1) | ((k & 8) >> 1); return ((kk >> 3) * 4 + (c >> 5)) * 512 + ((kk & 7) * 32 + (c & 31)) * 2; }
DEVI int v_rd_base(int lane) { return ((lane & 3) << 3) | (((lane >> 2) & 3) << 6) | (((lane >> 4) & 1) << 5) | (((lane >> 5) & 1) << 8); }
constexpr int v_rd_off(int d0, int ks, int half) { return d0 * 512 + ks * 4096 + half * 2048; }
template <int OFF> DEVI s16x4 tr_read(int vb) { s16x4 r; asm volatile("ds_read_b64_tr_b16 %0, %1 offset:%2" : "=&v"(r) : "v"(vb), "i"(OFF) : "memory"); return r; }
template <int D0> DEVI void pv_one(f32x16& od, int vb, bf16x8 pa0, bf16x8 pa1, bf16x8 pa2, bf16x8 pa3) {
  const s16x4 l0 = tr_read<v_rd_off(D0, 0, 0)>(vb), h0 = tr_read<v_rd_off(D0, 0, 1)>(vb), l1 = tr_read<v_rd_off(D0, 1, 0)>(vb), h1 = tr_read<v_rd_off(D0, 1, 1)>(vb);
  const s16x4 l2 = tr_read<v_rd_off(D0, 2, 0)>(vb), h2 = tr_read<v_rd_off(D0, 2, 1)>(vb), l3 = tr_read<v_rd_off(D0, 3, 0)>(vb), h3 = tr_read<v_rd_off(D0, 3, 1)>(vb);
  asm volatile("s_waitcnt lgkmcnt(0)" ::: "memory"); SBAR();
#define PK(L, H) (bf16x8){L[0], L[1], L[2], L[3], H[0], H[1], H[2], H[3]}
  od = __builtin_amdgcn_mfma_f32_32x32x16_bf16(pa0, PK(l0, h0), od, 0, 0, 0);
  od = __builtin_amdgcn_mfma_f32_32x32x16_bf16(pa1, PK(l1, h1), od, 0, 0, 0);
  od = __builtin_amdgcn_mfma_f32_32x32x16_bf16(pa2, PK(l2, h2), od, 0, 0, 0);
  od = __builtin_amdgcn_mfma_f32_32x32x16_bf16(pa3, PK(l3, h3), od, 0, 0, 0);
#undef PK
}
DEVI void pv_d0(f32x16* o, int vb, bf16x8 pa0, bf16x8 pa1, bf16x8 pa2, bf16x8 pa3) {
  pv_one<0>(o[0], vb, pa0, pa1, pa2, pa3); pv_one<1>(o[1], vb, pa0, pa1, pa2, pa3); pv_one<2>(o[2], vb, pa0, pa1, pa2, pa3); pv_one<3>(o[3], vb, pa0, pa1, pa2, pa3);
}
DEVI void rope_frag(bf16x8& f1, bf16x8& f2, const float* cs) {
  u32x4 w1 = *reinterpret_cast<u32x4*>(&f1), w2 = *reinterpret_cast<u32x4*>(&f2); float a[8], b[8]; unpack8(w1, a); unpack8(w2, b);
  float c[8], s[8];
#pragma unroll
  for (int q = 0; q < 4; ++q) { const float4 t = *(const float4*)(cs + q * 4); c[q * 2] = t.x; s[q * 2] = t.y; c[q * 2 + 1] = t.z; s[q * 2 + 1] = t.w; }
  float x[8], y[8];
#pragma unroll
  for (int j = 0; j < 8; ++j) { x[j] = a[j] * c[j] - b[j] * s[j]; y[j] = a[j] * s[j] + b[j] * c[j]; }
  w1 = (u32x4){cvtpk(x[0], x[1]), cvtpk(x[2], x[3]), cvtpk(x[4], x[5]), cvtpk(x[6], x[7])};
  w2 = (u32x4){cvtpk(y[0], y[1]), cvtpk(y[2], y[3]), cvtpk(y[4], y[5]), cvtpk(y[6], y[7])};
  f1 = *reinterpret_cast<bf16x8*>(&w1); f2 = *reinterpret_cast<bf16x8*>(&w2);
}
DEVI void attn_item(bf16_t* __restrict__ Qb, const bf16_t* __restrict__ Kn, const bf16_t* __restrict__ Vh, const bf16_t* __restrict__ Kr, const float* __restrict__ rope, int pos0, char* lds) {
  const int tid = threadIdx.x, wid = tid >> 6, lane = tid & 63, r32 = lane & 31, hi = lane >> 5;
  char* V_lds = lds; char* K_lds = lds + 2 * SHM_V;
  float* wsl = (float*)(lds + 2 * SHM_V + 2 * SHM_K) + wid * 64; float* li_l = wsl; float* al_l = wsl + 32;
  char* qrl = lds + 2 * SHM_V + 2 * SHM_K + 2048 + wid * 4096 + lane * 16;
  float m_reg = -1e30f, l_reg = 0; f32x16 o[4] = {}; bf16x8 qr[8];
  bf16_t* Qw = Qb + (size_t)(wid * QBLK + r32) * 1536 + hi * 8;
#pragma unroll
  for (int d0 = 0; d0 < 8; ++d0) qr[d0] = *reinterpret_cast<const bf16x8*>(Qw + d0 * 16);
  { bf16x8 q8 = *reinterpret_cast<const bf16x8*>(Qw + 128), q9 = *reinterpret_cast<const bf16x8*>(Qw + 144), q10 = *reinterpret_cast<const bf16x8*>(Qw + 160), q11 = *reinterpret_cast<const bf16x8*>(Qw + 176);
    const int pos = pos0 + wid * QBLK + r32;
    rope_frag(q8, q9, rope + ((pos >> 6) * 16 + hi * 8) * 2); rope_frag(q10, q11, rope + ((pos & 63) * 16 + hi * 8) * 2);
    *reinterpret_cast<bf16x8*>(qrl) = q8; *reinterpret_cast<bf16x8*>(qrl + 1024) = q9; *reinterpret_cast<bf16x8*>(qrl + 2048) = q10; *reinterpret_cast<bf16x8*>(qrl + 3072) = q11; }
  const int sr = tid >> 4, sc = (tid & 15) * 8, vst0 = v_st(sr, sc), vst1 = v_st(32 + sr, sc);
  const int kst0 = KSWZ(sr, sc * 2), kst1 = KSWZ(32 + sr, sc * 2), kst2 = KSWZ(tid >> 3, 256 + (tid & 7) * 16);
  const int goff = sr * 2048 + sc, goffr = (tid >> 3) * 64 + (tid & 7) * 8;
  const int vb0 = (int)(uintptr_t)V_lds + v_rd_base(lane);
  u32x4 sv0, sv1, sk0, sk1, sk2;
#define SLOAD(k0) do { const bf16_t* vp = Vh + (size_t)(k0) * 2048 + goff; const bf16_t* kp = Kn + (size_t)(k0) * 2048 + goff; \
    sv0 = *(const u32x4*)vp; sv1 = *(const u32x4*)(vp + 32 * 2048); sk0 = *(const u32x4*)kp; sk1 = *(const u32x4*)(kp + 32 * 2048); \
    sk2 = *(const u32x4*)(Kr + (size_t)(k0) * 64 + goffr); } while (0)
#define SWRITE(b) do { *(u32x4*)(V_lds + (b) * SHM_V + vst0) = sv0; *(u32x4*)(V_lds + (b) * SHM_V + vst1) = sv1; \
    *(u32x4*)(K_lds + (b) * SHM_K + kst0) = sk0; *(u32x4*)(K_lds + (b) * SHM_K + kst1) = sk1; *(u32x4*)(K_lds + (b) * SHM_K + kst2) = sk2; } while (0)
#define SWAIT() asm volatile("s_waitcnt vmcnt(0)" ::: "memory")
#define RESC(a) do { if (__any((a) < 1.f)) { if (hi == 0) al_l[r32] = (a); asm volatile("s_waitcnt lgkmcnt(0)" ::: "memory"); \
    _Pragma("unroll") for (int d = 0; d < 4; ++d) _Pragma("unroll") for (int r = 0; r < 16; ++r) o[d][r] *= al_l[crow(r, hi)]; } } while (0)
  f32x16 pA0, pA1, pB0, pB1; float mnA, mnB, alA, alB; bf16x8 pa0, pa1, pa2, pa3; constexpr int NT = NKEY / KVBLK;
  SLOAD(0); SWAIT(); SWRITE(0); __syncthreads();
  qkt(pA0, pA1, K_lds, qr, qrl, r32, hi); partialSM(pA0, pA1, m_reg, mnA, alA);
  SLOAD(KVBLK);
  SWAIT(); SWRITE(1); __syncthreads();
  for (int j = 1; j + 1 < NT; j += 2) {
    SBAR(); qkt(pB0, pB1, K_lds + SHM_K, qr, qrl, r32, hi);
    finishSM(pA0, pA1, alA, l_reg, pa0, pa1, pa2, pa3); SBAR();
    SLOAD((j + 1) * KVBLK); SBAR();
    pv_d0(o, vb0, pa0, pa1, pa2, pa3); partialSM(pB0, pB1, m_reg, mnB, alB);
    __syncthreads(); SWAIT(); SWRITE(0);
    RESC(alB); __syncthreads();
    SBAR(); qkt(pA0, pA1, K_lds, qr, qrl, r32, hi);
    finishSM(pB0, pB1, alB, l_reg, pa0, pa1, pa2, pa3); SBAR();
    SLOAD((j + 2) * KVBLK); SBAR();
    pv_d0(o, vb0 + SHM_V, pa0, pa1, pa2, pa3); partialSM(pA0, pA1, m_reg, mnA, alA);
    __syncthreads(); SWAIT(); SWRITE(1);
    RESC(alA); __syncthreads();
  }
  SBAR(); qkt(pB0, pB1, K_lds + SHM_K, qr, qrl, r32, hi);
  finishSM(pA0, pA1, alA, l_reg, pa0, pa1, pa2, pa3); SBAR();
  pv_d0(o, vb0, pa0, pa1, pa2, pa3); partialSM(pB0, pB1, m_reg, mnB, alB);
  __syncthreads(); RESC(alB);
  finishSM(pB0, pB1, alB, l_reg, pa0, pa1, pa2, pa3); SBAR();
  pv_d0(o, vb0 + SHM_V, pa0, pa1, pa2, pa3);
  if (hi == 0) li_l[r32] = l_reg; asm volatile("s_waitcnt lgkmcnt(0)" ::: "memory");
  float rli[16];
#pragma unroll
  for (int r = 0; r < 16; ++r) rli[r] = __builtin_amdgcn_rcpf(li_l[crow(r, hi)]);
  bf16_t* Ow = Qb + (size_t)(wid * QBLK) * 1536;
#pragma unroll
  for (int r = 0; r < 16; ++r) { const int orow = crow(r, hi);
#pragma unroll
    for (int d0 = 0; d0 < 4; ++d0) Ow[(size_t)orow * 1536 + d0 * 32 + r32] = f2bf(o[d0][r] * rli[r]); }
  __syncthreads();
#undef SLOAD
#undef SWRITE
#undef SWAIT
#undef RESC
}
}
DEVI void attn_mfma(const Params& p, char* smem) {
  bf16_t* Q = (bf16_t*)(p.ws + O_RQ); const bf16_t* KV = (const bf16_t*)(p.ws + O_RKV); const bf16_t* KR = (const bf16_t*)(p.ws + O_KR);
  const float* rope = (const float*)(p.ws + O_ROPE);
  for (int it = blockIdx.x; it < NB * 8 * (SEQ / 256); it += gridDim.x) {
    const int bh = (it >> 8) * 8 + (it & 7), qb = (it & 255) >> 3, b = bh >> 3, h = bh & 7;
    at::attn_item(Q + (size_t)(b * SEQ + qb * 256) * 1536 + h * 192, KV + (size_t)b * NKEY * 2048 + h * 256, KV + (size_t)b * NKEY * 2048 + h * 256 + 128,
                  KR + (size_t)b * NKEY * 64, rope, qb * 256, smem);
  }
}

namespace a8 {
constexpr int KVBLK = 64, SHM_K = KVBLK * 192, SHM_V = 128 * KVBLK;
constexpr int SHM_K2 = 2 * SHM_K, SHM_V2 = 2 * SHM_V;
constexpr float SCALE = 0.07216878364870322f, THR = 1.5f;
using i32x8 = __attribute__((ext_vector_type(8))) int;
DEVI int crow(int r, int hi) { return (r & 3) + 8 * (r >> 2) + 4 * hi; }
DEVI f32x16 mma(const i32x8& a, const i32x8& b, const f32x16& c) { return __builtin_amdgcn_mfma_scale_f32_32x32x64_f8f6f4(a, b, c, 0, 0, 0, 0x7f7f7f7f, 0, 0x7f7f7f7f); }
DEVI void partialSM(f32x16& p0, f32x16& p1, float& m_reg, float& mn, float& alpha) {
  constexpr float C = SCALE * 1.4426950408889634f;
  float pmax = p0[0];
#pragma unroll
  for (int r = 1; r < 16; ++r) pmax = fmaxf(pmax, p0[r]);
#pragma unroll
  for (int r = 0; r < 16; ++r) pmax = fmaxf(pmax, p1[r]);
  { auto rr = __builtin_amdgcn_permlane32_swap(__float_as_uint(pmax), __float_as_uint(pmax), false, false);
    pmax = fmaxf(__uint_as_float(rr[0]), __uint_as_float(rr[1])); }
  if (__builtin_expect(__all(pmax - m_reg <= THR / SCALE), 1)) { mn = m_reg; alpha = 1.f; }
  else { mn = fmaxf(m_reg, pmax); alpha = __builtin_amdgcn_exp2f((m_reg - mn) * C); m_reg = mn; }
  const float mnC = 6.f - mn * C;
#pragma unroll
  for (int r = 0; r < 16; ++r) p0[r] = fmaf(p0[r], C, mnC);
#pragma unroll
  for (int r = 0; r < 16; ++r) p1[r] = fmaf(p1[r], C, mnC);
#pragma unroll
  for (int r = 0; r < 16; ++r) p0[r] = __builtin_amdgcn_exp2f(p0[r]);
}
DEVI void finishSM(f32x16& p0, f32x16& p1, float alpha, float& l_reg, i32x8& pa) {
#pragma unroll
  for (int r = 0; r < 16; ++r) p1[r] = __builtin_amdgcn_exp2f(p1[r]);
  float ps = 0;
#pragma unroll
  for (int r = 0; r < 16; ++r) ps += p0[r];
#pragma unroll
  for (int r = 0; r < 16; ++r) ps += p1[r];
  { auto rr = __builtin_amdgcn_permlane32_swap(__float_as_uint(ps), __float_as_uint(ps), false, false);
    ps = __uint_as_float(rr[0]) + __uint_as_float(rr[1]); }
  l_reg = l_reg * alpha + ps;
#pragma unroll
  for (int j = 0; j < 4; ++j) { pa[j] = pk4_fp8(p0[4 * j], p0[4 * j + 1], p0[4 * j + 2], p0[4 * j + 3]); pa[4 + j] = pk4_fp8(p1[4 * j], p1[4 * j + 1], p1[4 * j + 2], p1[4 * j + 3]); }
}
DEVI i32x8 ld32(const char* p0, const char* p1) { const u32x4 a = *(const u32x4*)p0, b = *(const u32x4*)p1; return (i32x8){(int)a[0], (int)a[1], (int)a[2], (int)a[3], (int)b[0], (int)b[1], (int)b[2], (int)b[3]}; }
DEVI void qkt(f32x16& p0, f32x16& p1, const char* Ks, const i32x8* qf, int r32, int hi) {
  p0 = f32x16{}; p1 = f32x16{};
  const int sw = (r32 >> 2) & 3; const char* k0 = Ks + r32 * 192; const char* k1 = k0 + 32 * 192;
#pragma unroll
  for (int m = 0; m < 3; ++m) { const int c0 = ((4 * m + 2 * hi) ^ sw) << 4, c1 = ((4 * m + 2 * hi + 1) ^ sw) << 4;
    p0 = mma(ld32(k0 + c0, k0 + c1), qf[m], p0);
    p1 = mma(ld32(k1 + c0, k1 + c1), qf[m], p1); }
}
DEVI void pv(f32x16* o, const char* Vs, int tile, const i32x8& pa, int r32, int hi) {
  const int sw = (r32 >> 1) & 7, c0 = ((4 * tile + 2 * hi) ^ sw) << 4, c1 = ((4 * tile + 2 * hi + 1) ^ sw) << 4;
#pragma unroll
  for (int db = 0; db < 4; ++db) { const char* vr = Vs + (32 * db + r32) * 128; o[db] = mma(pa, ld32(vr + c0, vr + c1), o[db]); }
}
DEVI void attn_item(bf16_t* __restrict__ Qb, const unsigned char* __restrict__ Kg, const unsigned char* __restrict__ Vg, const float* __restrict__ rope, int pos0, char* lds) {
  const int tid = threadIdx.x, wid = tid >> 6, lane = tid & 63, r32 = lane & 31, hi = lane >> 5;
  char* V_lds = lds; char* K_lds = lds + 3 * SHM_V2;
  float* wsl = (float*)(lds + 3 * SHM_V2 + 3 * SHM_K2) + wid * 64; float* li_l = wsl; float* al_l = wsl + 32;
  float m_reg = -1e30f, l_reg = 0; f32x16 o[4] = {}; i32x8 qf[3];
  { const bf16_t* Qw = Qb + (size_t)(wid * 32 + r32) * 1536 + hi * 32;
#pragma unroll
    for (int m = 0; m < 3; ++m) { float x[32];
#pragma unroll
      for (int q = 0; q < 4; ++q) unpack8(*(const u32x4*)(Qw + m * 64 + q * 8), x + q * 8);
      if (m == 2) { const int pos = pos0 + wid * 32 + r32, pp = hi ? (pos & 63) : (pos >> 6); const float* cs = rope + pp * 32;
#pragma unroll
        for (int j = 0; j < 16; ++j) { const float c = cs[j * 2], sn = cs[j * 2 + 1], x1 = x[j], x2 = x[16 + j]; x[j] = x1 * c - x2 * sn; x[16 + j] = x1 * sn + x2 * c; } }
#pragma unroll
      for (int q = 0; q < 8; ++q) qf[m][q] = pk4_fp8(x[q * 4], x[q * 4 + 1], x[q * 4 + 2], x[q * 4 + 3]);
      __builtin_amdgcn_sched_barrier(0); } }
  unsigned koff[3], voff[2];
#pragma unroll
  for (int i = 0; i < 3; ++i) { const int pp = wid * 64 + lane + 512 * i, key = pp / 12, c = pp - key * 12; koff[i] = (unsigned)(key * 192 + ((c ^ ((key >> 2) & 3)) << 4)); }
#pragma unroll
  for (int i = 0; i < 2; ++i) { const int pp = wid * 64 + lane + 512 * i, d = pp >> 3, c = pp & 7; voff[i] = (unsigned)(d * NKEY + ((c ^ ((d >> 1) & 7)) << 4)); }
#define GSTAGE(s_, kb, vb) do { const unsigned char* ks = Kg + (size_t)(s_) * SHM_K2; const unsigned char* vs = Vg + (s_) * 128; \
    _Pragma("unroll") for (int i = 0; i < 3; ++i) __builtin_amdgcn_global_load_lds((const unsigned*)(ks + koff[i]), (unsigned*)(K_lds + (kb) + i * 8192 + wid * 1024), 16, 0, 0); \
    _Pragma("unroll") for (int i = 0; i < 2; ++i) __builtin_amdgcn_global_load_lds((const unsigned*)(vs + voff[i]), (unsigned*)(V_lds + (vb) + i * 8192 + wid * 1024), 16, 0, 0); } while (0)
#define SWAIT() asm volatile("s_waitcnt vmcnt(0)" ::: "memory")
#define SBAR() __builtin_amdgcn_sched_barrier(0)
#define RESC(a) do { if (__any((a) < 1.f)) { if (hi == 0) al_l[r32] = (a); asm volatile("s_waitcnt lgkmcnt(0)" ::: "memory"); \
    _Pragma("unroll") for (int d = 0; d < 4; ++d) _Pragma("unroll") for (int r = 0; r < 16; ++r) o[d][r] *= al_l[crow(r, hi)]; } } while (0)
  f32x16 pA0, pA1, pB0, pB1; float mnA, mnB, alA, alB; i32x8 pa; constexpr int NS = NKEY / 128;
  int kp = 0, kc = SHM_K2, kn = 2 * SHM_K2, vp = 0, vc = SHM_V2, vn = 2 * SHM_V2;
  GSTAGE(0, kp, vp); GSTAGE(1, kc, vc); SWAIT(); __syncthreads();
  qkt(pA0, pA1, K_lds + kp, qf, r32, hi); partialSM(pA0, pA1, m_reg, mnA, alA);
  SBAR(); qkt(pB0, pB1, K_lds + kp + SHM_K, qf, r32, hi);
  finishSM(pA0, pA1, alA, l_reg, pa); SBAR();
  pv(o, V_lds + vp, 0, pa, r32, hi); partialSM(pB0, pB1, m_reg, mnB, alB);
  RESC(alB);
  for (int s_ = 1; s_ < NS; ++s_) {
    if (s_ + 1 < NS) GSTAGE(s_ + 1, kn, vn);
    SBAR(); qkt(pA0, pA1, K_lds + kc, qf, r32, hi);
    finishSM(pB0, pB1, alB, l_reg, pa); SBAR();
    pv(o, V_lds + vp, 1, pa, r32, hi); partialSM(pA0, pA1, m_reg, mnA, alA);
    RESC(alA);
    SBAR(); qkt(pB0, pB1, K_lds + kc + SHM_K, qf, r32, hi);
    finishSM(pA0, pA1, alA, l_reg, pa); SBAR();
    pv(o, V_lds + vc, 0, pa, r32, hi); partialSM(pB0, pB1, m_reg, mnB, alB);
    SWAIT(); __syncthreads();
    RESC(alB);
    { const int tk = kp; kp = kc; kc = kn; kn = tk; const int tv = vp; vp = vc; vc = vn; vn = tv; }
  }
  finishSM(pB0, pB1, alB, l_reg, pa); SBAR();
  pv(o, V_lds + vp, 1, pa, r32, hi);
  if (hi == 0) li_l[r32] = l_reg; asm volatile("s_waitcnt lgkmcnt(0)" ::: "memory");
  float rli[16];
#pragma unroll
  for (int r = 0; r < 16; ++r) rli[r] = __builtin_amdgcn_rcpf(li_l[crow(r, hi)]);
  bf16_t* Ow = Qb + (size_t)(wid * 32) * 1536;
#pragma unroll
  for (int r = 0; r < 16; ++r) { const int orow = crow(r, hi);
#pragma unroll
    for (int d0 = 0; d0 < 4; ++d0) Ow[(size_t)orow * 1536 + d0 * 32 + r32] = f2bf(o[d0][r] * rli[r]); }
  __syncthreads();
#undef GSTAGE
#undef SWAIT
#undef SBAR
#undef RESC
}
}
DEVI void attn_fp8(const Params& p, char* smem) {
  bf16_t* Q = (bf16_t*)(p.ws + O_RQ); const unsigned char* K8 = (const unsigned char*)(p.ws + O_K8); const unsigned char* V8 = (const unsigned char*)(p.ws + O_V8T);
  const float* rope = (const float*)(p.ws + O_ROPE);
  for (int it = blockIdx.x; it < NB * 8 * (SEQ / 256); it += gridDim.x) {
    const int bh = (it >> 8) * 8 + (it & 7), qb = (it & 255) >> 3, b = bh >> 3, h = bh & 7;
    a8::attn_item(Q + (size_t)(b * SEQ + qb * 256) * 1536 + h * 192, K8 + (size_t)bh * NKEY * 192, V8 + (size_t)bh * 128 * NKEY, rope, qb * 256, smem);
  }
}
#if ATTN_FP8
DEVI void ph_attn(const Params& p, char* smem) { attn_fp8(p, smem); }
#elif ATTN_MFMA
DEVI void ph_attn(const Params& p, char* smem) { attn_mfma(p, smem); }
#else
DEVI void ph_attn(const Params& p, char* smem) { attn_naive(p, smem); }
#endif

DEVI void ph_rows(const Params& p, char* smem) {
  const int tid = threadIdx.x, wave = tid >> 6, lane = tid & 63;
  const float* MOD = (const float*)(p.ws + O_MOD); const bf16_t* Y = (const bf16_t*)(p.ws + O_RA); const float* rssy = (const float*)(p.ws + O_RSSY);
  bf16_t* HX2 = (bf16_t*)(p.ws + O_RB);
  for (int row = blockIdx.x * NWAVE + wave; row < NTOK; row += gridDim.x * NWAVE) {
    const int b = row >> 13; const float* md = MOD + b * 6144;
    float ty = 0.f; { const float* pr = rssy + (size_t)row * 32;
#pragma unroll
      for (int j = 0; j < 32; ++j) ty += pr[j]; }
    const float ry = rsqrtf(ty * (1.f / 1024.f) + EPS);
    float x1[16]; float ss = 0.f;
#pragma unroll
    for (int i = 0; i < 4; ++i) { const int c = i * 256 + lane * 4; const float4 xv = *(const float4*)(p.x + (size_t)row * 1024 + c); const u32x2 yv = *(const u32x2*)(Y + (size_t)row * 1024 + c);
      const float4 gp = *(const float4*)(p.g_post1 + c), gt = *(const float4*)(md + 2048 + c);
      x1[i * 4 + 0] = xv.x + gt.x * (lo2f(yv[0]) * ry * gp.x); x1[i * 4 + 1] = xv.y + gt.y * (hi2f(yv[0]) * ry * gp.y);
      x1[i * 4 + 2] = xv.z + gt.z * (lo2f(yv[1]) * ry * gp.z); x1[i * 4 + 3] = xv.w + gt.w * (hi2f(yv[1]) * ry * gp.w);
#pragma unroll
      for (int j = 0; j < 4; ++j) ss += x1[i * 4 + j] * x1[i * 4 + j];
      *(float4*)(p.out + (size_t)row * 1024 + c) = make_float4(x1[i * 4], x1[i * 4 + 1], x1[i * 4 + 2], x1[i * 4 + 3]); }
    ss = wave_sum(ss); const float r2 = rsqrtf(ss * (1.f / 1024.f) + EPS);
#pragma unroll
    for (int i = 0; i < 4; ++i) { const int c = i * 256 + lane * 4; const float4 g2 = *(const float4*)(p.g_pre2 + c), sc = *(const float4*)(md + 4096 + c), sh = *(const float4*)(md + 3072 + c);
      st4bf(HX2 + (size_t)row * 1024 + c, x1[i * 4] * r2 * g2.x * (1.f + sc.x) + sh.x, x1[i * 4 + 1] * r2 * g2.y * (1.f + sc.y) + sh.y,
            x1[i * 4 + 2] * r2 * g2.z * (1.f + sc.z) + sh.z, x1[i * 4 + 3] * r2 * g2.w * (1.f + sc.w) + sh.w); }
  }
#if GATHER_FP6
  convert_table_fp6(p.u_exp, (unsigned char*)(p.ws + O_RC), (float*)(p.ws + O_RC + (size_t)16384 * 1024));
#else
  convert_table_fp8(p.u_exp, (unsigned char*)(p.ws + O_RC), (float*)(p.ws + O_RC + (size_t)16384 * 1024));
#endif
}

DEVI void topk_naive(const Params& p, char* smem) {
  const int tid = threadIdx.x, wave = tid >> 6, lane = tid & 63;
  float* wl = (float*)smem + wave * 512; int* wi = (int*)wl;
  const bf16_t* QP = (const bf16_t*)(p.ws + O_RKV); const bf16_t* K1 = (const bf16_t*)(p.ws + O_K1); const bf16_t* K2 = (const bf16_t*)(p.ws + O_K2);
  int* IDX = (int*)(p.ws + O_RQ); float* GW = (float*)(p.ws + O_RQ + (size_t)NTOK * 128 * 4);
  for (int base = blockIdx.x * NWAVE; base < NTOK * 8; base += gridDim.x * NWAVE) {
    const int it = base + wave, token = it >> 3, h = it & 7;
    __syncthreads();
    const bf16_t* q = QP + (size_t)token * 2048 + h * 256;
    for (int d = lane; d < 256; d += 64) wl[d] = bf2f(q[d]);
    __syncthreads();
    float s[4] = {0.f, 0.f, 0.f, 0.f};
#pragma unroll 2
    for (int d8 = 0; d8 < 16; ++d8) {
      const float4 qa0 = *(const float4*)(wl + d8 * 8), qa1 = *(const float4*)(wl + d8 * 8 + 4), qb0 = *(const float4*)(wl + 128 + d8 * 8), qb1 = *(const float4*)(wl + 128 + d8 * 8 + 4);
#pragma unroll
      for (int w = 0; w < 4; ++w) { const int key = lane + (w & 1) * 64; const bf16_t* kp = (w < 2 ? K1 : K2) + key * 128;
        float kf[8]; unpack8(*(const u32x4*)(kp + d8 * 8), kf); const float4 q0 = w < 2 ? qa0 : qb0, q1 = w < 2 ? qa1 : qb1;
        s[w] += q0.x * kf[0] + q0.y * kf[1] + q0.z * kf[2] + q0.w * kf[3] + q1.x * kf[4] + q1.y * kf[5] + q1.z * kf[6] + q1.w * kf[7]; }
    }
#pragma unroll
    for (int half = 0; half < 2; ++half) { float a0 = s[half * 2], a1 = s[half * 2 + 1];
#pragma unroll 1
      for (int r = 0; r < 16; ++r) { float v; int i; if (a0 >= a1) { v = a0; i = lane; } else { v = a1; i = lane + 64; }
        for (int o = 32; o > 0; o >>= 1) { const float ov = __shfl_xor(v, o); const int oi = __shfl_xor(i, o); if (ov > v || (ov == v && oi < i)) { v = ov; i = oi; } }
        if (i == lane) a0 = -3.0e38f; else if (i == lane + 64) a1 = -3.0e38f;
        if (lane == 0) { wl[256 + half * 32 + r] = v; wi[256 + half * 32 + 16 + r] = i; } } }
    __syncthreads();
    float cv[4]; int ci[4];
#pragma unroll
    for (int j = 0; j < 4; ++j) { const int cidx = lane * 4 + j, i = cidx >> 4, jj = cidx & 15; cv[j] = wl[256 + i] + wl[256 + 32 + jj]; ci[j] = wi[256 + 16 + i] * 128 + wi[256 + 32 + 16 + jj]; }
    float myv = 0.f, vmax = 0.f; int myi = 0;
#pragma unroll 1
    for (int r = 0; r < 16; ++r) { float v = cv[0]; int pos = lane * 4, ei = ci[0];
#pragma unroll
      for (int j = 1; j < 4; ++j) if (cv[j] > v) { v = cv[j]; pos = lane * 4 + j; ei = ci[j]; }
      for (int o = 32; o > 0; o >>= 1) { const float ov = __shfl_xor(v, o); const int op = __shfl_xor(pos, o), oe = __shfl_xor(ei, o); if (ov > v || (ov == v && op < pos)) { v = ov; pos = op; ei = oe; } }
#pragma unroll
      for (int j = 0; j < 4; ++j) if (pos == lane * 4 + j) cv[j] = -3.0e38f;
      if (r == 0) vmax = v;
      if (lane == r) { myv = v; myi = ei; } }
    const float e = lane < 16 ? __expf(myv - vmax) : 0.f; const float sum = wave_sum(e);
    if (lane < 16) { IDX[(size_t)token * 128 + h * 16 + lane] = myi; GW[(size_t)token * 128 + h * 16 + lane] = e / sum; }
  }
}

namespace tk {
DEVI int f2sort(float f) { const int i = __float_as_int(f); return i ^ ((i >> 31) & 0x7fffffff); }
DEVI float sort2f(int s) { return __int_as_float(s ^ ((s >> 31) & 0x7fffffff)); }
DEVI void ce_desc(int& a, int& b) { const int hi = max(a, b), lo = min(a, b); a = hi; b = lo; }
DEVI void sort16_desc(int* a) {
#pragma unroll
  for (int lk = 1; lk <= 4; ++lk)
#pragma unroll
    for (int lj = lk - 1; lj >= 0; --lj)
#pragma unroll
      for (int i = 0; i < 16; ++i) { const int j = 1 << lj, k = 1 << lk, l = i ^ j;
        if (l > i) { const int hi = max(a[i], a[l]), lo = min(a[i], a[l]); if ((i & k) == 0) { a[i] = hi; a[l] = lo; } else { a[i] = lo; a[l] = hi; } } }
}
DEVI void bitonic_merge16_desc(int* a) {
#pragma unroll
  for (int lj = 3; lj >= 0; --lj)
#pragma unroll
    for (int i = 0; i < 16; ++i) { const int l = i ^ (1 << lj); if (l > i) ce_desc(a[i], a[l]); }
}
DEVI void merge_top16(int* a, const int* b) {
#pragma unroll
  for (int i = 0; i < 16; ++i) a[i] = max(a[i], b[15 - i]);
  bitonic_merge16_desc(a);
}
DEVI void half_top16(const bf16_t* __restrict__ qrow, const char* Kl, int r32, int hi, int* out) {
  bf16x8 qf[8];
#pragma unroll
  for (int d0 = 0; d0 < 8; ++d0) qf[d0] = *reinterpret_cast<const bf16x8*>(qrow + d0 * 16 + hi * 8);
  int a[64]; const int hi4 = 4 * hi;
#pragma unroll
  for (int kt = 0; kt < 4; ++kt) { f32x16 acc = {};
    const int key = kt * 32 + r32;
#pragma unroll
    for (int d0 = 0; d0 < 8; ++d0) { const bf16x8 kf = *reinterpret_cast<const bf16x8*>(Kl + key * 256 + (((d0 * 2 + hi) ^ (key & 15)) << 4));
      acc = __builtin_amdgcn_mfma_f32_32x32x16_bf16(kf, qf[d0], acc, 0, 0, 0); }
#pragma unroll
    for (int r = 0; r < 16; ++r) { const int kc = kt * 32 + (r & 3) + 8 * (r >> 2); a[kt * 16 + r] = ((f2sort(acc[r]) & ~127) | (127 - kc)) - hi4; } }
  sort16_desc(a); sort16_desc(a + 16); sort16_desc(a + 32); sort16_desc(a + 48);
  merge_top16(a, a + 16); merge_top16(a + 32, a + 48); merge_top16(a, a + 32);
  int L[16], H[16];
#pragma unroll
  for (int i = 0; i < 16; ++i) { auto rr = __builtin_amdgcn_permlane32_swap((unsigned)a[i], (unsigned)a[i], false, false); L[i] = (int)rr[0]; H[i] = (int)rr[1]; }
  merge_top16(L, H);
#pragma unroll
  for (int i = 0; i < 16; ++i) out[i] = L[i];
}
}
DEVI void gather_token(const Params& p, int t, const int* idx, const float* gw);
DEVI void gather_token_fp6(const Params& p, int t, const int* idx, const float* gw, float* xs, const int* sig);
DEVI void fp6_sigma(int* sig);
DEVI void topk_fast(const Params& p, char* smem) {
  const int tid = threadIdx.x, wave = __builtin_amdgcn_readfirstlane(tid >> 6), lane = tid & 63, r32 = lane & 31, hi = lane >> 5;
  const bf16_t* QP = (const bf16_t*)(p.ws + O_RKV);
  char* K1l = smem; char* K2l = smem + 32768; int* tab = (int*)(smem + 65536) + wave * (32 * 33);
  int* idxl = (int*)(smem + 65536 + 8 * 32 * 33 * 4) + wave * 512; float* gwl = (float*)(smem + 65536 + 8 * 32 * 33 * 4 + 8 * 2048) + wave * 512;
  int* sigl = (int*)(smem + 65536 + 8 * 32 * 33 * 4 + 16 * 2048) + wave * 32;
#if GATHER_FP6
  fp6_sigma(sigl);
#endif
  __syncthreads();
  { const bf16_t* K1 = (const bf16_t*)(p.ws + O_K1);
    for (int id = tid; id < 4096; id += NTHR) { const int key = id >> 4, c = id & 15; const u32x4 v = *(const u32x4*)(K1 + (size_t)key * 128 + c * 8);
      *(u32x4*)(smem + key * 256 + ((c ^ (key & 15)) << 4)) = v; } }
  __syncthreads();
  for (int item = blockIdx.x; item < NTOK * 8 / 256; item += gridDim.x) {
    const int row = item * 256 + wave * 32 + r32;
    const bf16_t* qrow = QP + (size_t)row * 256;
    int t1[16], t2[16];
    tk::half_top16(qrow, K1l, r32, hi, t1);
    __builtin_amdgcn_sched_barrier(0);
    tk::half_top16(qrow + 128, K2l, r32, hi, t2);
    __builtin_amdgcn_sched_barrier(0);
    float v1[16], v2[16];
#pragma unroll
    for (int i = 0; i < 16; ++i) { v1[i] = tk::sort2f(t1[i] & ~127); v2[i] = tk::sort2f(t2[i] & ~127); }
    if (hi == 0) {
#pragma unroll
      for (int i = 0; i < 16; ++i) { tab[r32 * 33 + i] = 127 - (t1[i] & 127); tab[r32 * 33 + 16 + i] = 127 - (t2[i] & 127); } }
#define CAND(i, j) ((tk::f2sort(v1[i] + v2[j]) & ~255) | (255 - ((i) * 16 + (j))))
    int g0[16], g1[16], g2[16];
#pragma unroll
    for (int j = 0; j < 16; ++j) g0[j] = CAND(0, j);
#pragma unroll
    for (int j = 0; j < 8; ++j) g1[j] = CAND(1, j);
#pragma unroll
    for (int j = 0; j < 5; ++j) g1[8 + j] = CAND(2, j);
#pragma unroll
    for (int j = 0; j < 3; ++j) g1[13 + j] = CAND(4, j);
#pragma unroll
    for (int j = 0; j < 4; ++j) g2[j] = CAND(3, j);
    g2[4] = CAND(5, 0); g2[5] = CAND(5, 1); g2[6] = CAND(6, 0); g2[7] = CAND(6, 1); g2[8] = CAND(7, 0); g2[9] = CAND(7, 1);
    g2[10] = CAND(8, 0); g2[11] = CAND(9, 0); g2[12] = CAND(10, 0); g2[13] = CAND(11, 0); g2[14] = CAND(12, 0); g2[15] = CAND(13, 0);
    tk::sort16_desc(g1); tk::sort16_desc(g2);
    tk::merge_top16(g0, g1); tk::merge_top16(g0, g2);
    { int x = CAND(14, 0);
#pragma unroll
      for (int i = 0; i < 16; ++i) { const int h = max(g0[i], x); x = min(g0[i], x); g0[i] = h; }
      x = CAND(15, 0);
#pragma unroll
      for (int i = 0; i < 16; ++i) { const int h = max(g0[i], x); x = min(g0[i], x); g0[i] = h; } }
#undef CAND
    asm volatile("s_waitcnt lgkmcnt(0)" ::: "memory");
    if (hi == 0) {
      int ex[16];
#pragma unroll
      for (int k = 0; k < 16; ++k) { const int pos = 255 - (g0[k] & 255); ex[k] = tab[r32 * 33 + (pos >> 4)] * 128 + tab[r32 * 33 + 16 + (pos & 15)]; }
      int* dst = idxl + r32 * 16;
#pragma unroll
      for (int q = 0; q < 4; ++q) *(int4*)(dst + q * 4) = make_int4(ex[q * 4], ex[q * 4 + 1], ex[q * 4 + 2], ex[q * 4 + 3]);
    } else {
      float e[16]; const float vmax = tk::sort2f(g0[0] & ~255); float sum = 0.f;
#pragma unroll
      for (int k = 0; k < 16; ++k) { e[k] = __expf(tk::sort2f(g0[k] & ~255) - vmax); sum += e[k]; }
      const float inv = 1.f / sum; float* dst = gwl + r32 * 16;
#pragma unroll
      for (int q = 0; q < 4; ++q) *(float4*)(dst + q * 4) = make_float4(e[q * 4] * inv, e[q * 4 + 1] * inv, e[q * 4 + 2] * inv, e[q * 4 + 3] * inv);
    }
    asm volatile("s_waitcnt lgkmcnt(0)" ::: "memory"); __builtin_amdgcn_sched_barrier(0);
#pragma unroll 1
#if GATHER_FP6
    for (int tl = 0; tl < 4; ++tl) gather_token_fp6(p, item * 32 + wave * 4 + tl, idxl + tl * 128, gwl + tl * 128, (float*)tab, sigl);
#else
    for (int tl = 0; tl < 4; ++tl) gather_token(p, item * 32 + wave * 4 + tl, idxl + tl * 128, gwl + tl * 128);
#endif
    asm volatile("s_waitcnt lgkmcnt(0)" ::: "memory"); __builtin_amdgcn_sched_barrier(0);
  }
}
#if TOPK_FAST
DEVI void ph_topk(const Params& p, char* smem) { topk_fast(p, smem); }
#else
DEVI void ph_topk(const Params& p, char* smem) { topk_naive(p, smem); }
#endif

DEVI float wave_sum_dpp(float v) {
  v += __builtin_bit_cast(float, __builtin_amdgcn_update_dpp(0, __builtin_bit_cast(int, v), 0xB1, 0xf, 0xf, true));
  v += __builtin_bit_cast(float, __builtin_amdgcn_update_dpp(0, __builtin_bit_cast(int, v), 0x4E, 0xf, 0xf, true));
  v += __builtin_bit_cast(float, __builtin_amdgcn_update_dpp(0, __builtin_bit_cast(int, v), 0x141, 0xf, 0xf, true));
  v += __builtin_bit_cast(float, __builtin_amdgcn_update_dpp(0, __builtin_bit_cast(int, v), 0x140, 0xf, 0xf, true));
  const int iv = __builtin_bit_cast(int, v);
  return (__builtin_bit_cast(float, __builtin_amdgcn_readlane(iv, 0)) + __builtin_bit_cast(float, __builtin_amdgcn_readlane(iv, 16))) +
         (__builtin_bit_cast(float, __builtin_amdgcn_readlane(iv, 32)) + __builtin_bit_cast(float, __builtin_amdgcn_readlane(iv, 48)));
}
DEVI void fp8x16_to_f32(const u32x4& w, float* f) {
#pragma unroll
  for (int j = 0; j < 4; ++j) { const f32x2_t a = __builtin_amdgcn_cvt_pk_f32_fp8((int)w[j], false), b = __builtin_amdgcn_cvt_pk_f32_fp8((int)w[j], true);
    f[j * 4] = a[0]; f[j * 4 + 1] = a[1]; f[j * 4 + 2] = b[0]; f[j * 4 + 3] = b[1]; }
}
DEVI void gather_token(const Params& p, int t, const int* idx, const float* gw) {
  int lane = threadIdx.x & 63; asm volatile("" : "+v"(lane));
  char* ws = p.ws; asm volatile("" : "+s"(ws));
  const bf16_t* HX2 = (const bf16_t*)(ws + O_RB);
  const unsigned char* UT = (const unsigned char*)(ws + O_RC); const float* SU = (const float*)(ws + O_RC + (size_t)16384 * 1024);
  const unsigned char* VT = (const unsigned char*)(ws + O_RA); const float* SV = (const float*)(ws + O_RA + (size_t)16384 * 1024);
  const float* MOD = (const float*)(ws + O_MOD);
  float xf[16];
  unpack8(*(const u32x4*)(HX2 + (size_t)t * 1024 + lane * 16), xf); unpack8(*(const u32x4*)(HX2 + (size_t)t * 1024 + lane * 16 + 8), xf + 8);
  float acc[16];
#pragma unroll
  for (int j = 0; j < 16; ++j) acc[j] = 0.f;
#pragma unroll 1
  for (int half = 0; half < 2; ++half) {
    const int my_i = idx[half * 64 + lane]; const float my_g = gw[half * 64 + lane];
    const float my_su = SU[my_i], my_sv = SV[my_i];
#pragma unroll 1
    for (int e0 = 0; e0 < 64; e0 += 8) {
      u32x4 uq[8], vq[8]; float cs[8];
#pragma unroll
      for (int j = 0; j < 8; ++j) { const int id = __builtin_amdgcn_readlane(my_i, e0 + j);
        uq[j] = *(const u32x4*)(UT + (size_t)id * 1024 + lane * 16); vq[j] = *(const u32x4*)(VT + (size_t)id * 1024 + lane * 16); }
#pragma unroll
      for (int j = 0; j < 8; ++j) { float uf[16]; fp8x16_to_f32(uq[j], uf); float d = 0.f;
#pragma unroll
        for (int k = 0; k < 16; ++k) d += xf[k] * uf[k];
        cs[j] = d; }
#pragma unroll
      for (int j = 0; j < 8; ++j) { const float d = wave_sum_dpp(cs[j]);
        const float g = __builtin_bit_cast(float, __builtin_amdgcn_readlane(__builtin_bit_cast(int, my_g), e0 + j));
        const float su = __builtin_bit_cast(float, __builtin_amdgcn_readlane(__builtin_bit_cast(int, my_su), e0 + j));
        const float sv = __builtin_bit_cast(float, __builtin_amdgcn_readlane(__builtin_bit_cast(int, my_sv), e0 + j));
        cs[j] = g * gelu_t(d * su) * sv; }
#pragma unroll
      for (int j = 0; j < 8; ++j) { float vf[16]; fp8x16_to_f32(vq[j], vf);
#pragma unroll
        for (int k = 0; k < 16; ++k) acc[k] += cs[j] * vf[k]; }
    }
  }
  float ss = 0.f;
#pragma unroll
  for (int k = 0; k < 16; ++k) ss += acc[k] * acc[k];
  ss = wave_sum(ss); const float rstd = rsqrtf(ss * (1.f / 1024.f) + EPS);
  const int b = t >> 13; const float* gt2 = MOD + b * 6144 + 5120;
  float* op = p.out + (size_t)t * 1024 + lane * 16;
#pragma unroll
  for (int q4 = 0; q4 < 4; ++q4) { float4 xv = *(const float4*)(op + q4 * 4); const float4 gt = *(const float4*)(gt2 + lane * 16 + q4 * 4), gp = *(const float4*)(p.g_post2 + lane * 16 + q4 * 4);
    xv.x += gt.x * (acc[q4 * 4 + 0] * rstd * gp.x); xv.y += gt.y * (acc[q4 * 4 + 1] * rstd * gp.y);
    xv.z += gt.z * (acc[q4 * 4 + 2] * rstd * gp.z); xv.w += gt.w * (acc[q4 * 4 + 3] * rstd * gp.w);
    *(float4*)(op + q4 * 4) = xv; }
}


DEVI void fp6_sigma(int* sig) {
  f32x16 ra, rb;
#pragma unroll
  for (int i = 0; i < 16; ++i) { ra[i] = i < 8 ? i * 0.125f : 1.f + (i - 8) * 0.125f; rb[i] = i < 8 ? 2.f + i * 0.25f : 4.f + (i - 8) * 0.5f; }
  const u32x6 w = __builtin_amdgcn_cvt_scalef32_2xpk16_fp6_f32(ra, rb, 1.0f);
  const f32x32 d = __builtin_amdgcn_cvt_scalef32_pk32_f32_fp6(w, 1.0f);
  if ((threadIdx.x & 63) == 0) {
#pragma unroll
    for (int i = 0; i < 32; ++i) { const float v = d[i]; sig[i] = v < 1.f ? (int)(v * 8.f + 0.5f) : v < 2.f ? 8 + (int)((v - 1.f) * 8.f + 0.5f) : v < 4.f ? 16 + (int)((v - 2.f) * 4.f + 0.5f) : 24 + (int)((v - 4.f) * 2.f + 0.5f); } }
}
constexpr int G6 = 4;
DEVI void gather_token_fp6(const Params& p, int t, const int* idx, const float* gw, float* xs, const int* sig) {
  int lane = threadIdx.x & 63; asm volatile("" : "+v"(lane));
  const int h = lane >> 5, g = lane & 31;
  const bf16_t* HX2 = (const bf16_t*)(p.ws + O_RB);
  const unsigned char* UT = (const unsigned char*)(p.ws + O_RC); const float* SU = (const float*)(p.ws + O_RC + (size_t)16384 * 1024);
  const unsigned char* VT = (const unsigned char*)(p.ws + O_RA); const float* SV = (const float*)(p.ws + O_RA + (size_t)16384 * 1024);
  const float* MOD = (const float*)(p.ws + O_MOD);
  if (h == 0) { float xf[32];
#pragma unroll
    for (int q = 0; q < 4; ++q) unpack8(*(const u32x4*)(HX2 + (size_t)t * 1024 + g * 32 + q * 8), xf + q * 8);
#pragma unroll
    for (int j = 0; j < 32; ++j) xs[j * 32 + g] = xf[j]; }
  asm volatile("s_waitcnt lgkmcnt(0)" ::: "memory"); __builtin_amdgcn_sched_barrier(0);
  float xp[32], acc[32];
#pragma unroll
  for (int i = 0; i < 32; ++i) { xp[i] = xs[sig[i] * 32 + g]; acc[i] = 0.f; }
#pragma unroll 1
  for (int half = 0; half < 2; ++half) {
    const int my_i = idx[half * 64 + lane]; const float my_g = gw[half * 64 + lane];
    const float my_su = SU[my_i], my_sv = SV[my_i];
#pragma unroll 1
    for (int e0 = 0; e0 < 64; e0 += 2 * G6) {
      u32x6 uq[G6], vq[G6]; float cs[G6];
#pragma unroll
      for (int j = 0; j < G6; ++j) { const int ia = __builtin_amdgcn_readlane(my_i, e0 + 2 * j), ib = __builtin_amdgcn_readlane(my_i, e0 + 2 * j + 1); const int id = h ? ib : ia;
        const unsigned char* up = UT + (size_t)id * 768 + g * 24; const unsigned char* vp = VT + (size_t)id * 768 + g * 24;
        const u32x4 u0 = *(const u32x4_u*)up; const u32x2 u1 = *(const u32x2_u*)(up + 16); const u32x4 v0 = *(const u32x4_u*)vp; const u32x2 v1 = *(const u32x2_u*)(vp + 16);
        uq[j] = (u32x6){u0[0], u0[1], u0[2], u0[3], u1[0], u1[1]}; vq[j] = (u32x6){v0[0], v0[1], v0[2], v0[3], v1[0], v1[1]}; }
#pragma unroll
      for (int j = 0; j < G6; ++j) { const f32x32 uf = __builtin_amdgcn_cvt_scalef32_pk32_f32_fp6(uq[j], 1.0f); float d = 0.f;
#pragma unroll
        for (int k = 0; k < 32; ++k) d += xp[k] * uf[k];
        cs[j] = d; __builtin_amdgcn_sched_barrier(0); }
#pragma unroll
      for (int j = 0; j < G6; ++j) { float v = cs[j];
        v += __builtin_bit_cast(float, __builtin_amdgcn_update_dpp(0, __builtin_bit_cast(int, v), 0xB1, 0xf, 0xf, true));
        v += __builtin_bit_cast(float, __builtin_amdgcn_update_dpp(0, __builtin_bit_cast(int, v), 0x4E, 0xf, 0xf, true));
        v += __builtin_bit_cast(float, __builtin_amdgcn_update_dpp(0, __builtin_bit_cast(int, v), 0x141, 0xf, 0xf, true));
        v += __builtin_bit_cast(float, __builtin_amdgcn_update_dpp(0, __builtin_bit_cast(int, v), 0x140, 0xf, 0xf, true));
        const int iv = __builtin_bit_cast(int, v);
        const float s0 = __builtin_bit_cast(float, __builtin_amdgcn_readlane(iv, 0)) + __builtin_bit_cast(float, __builtin_amdgcn_readlane(iv, 16));
        const float s1 = __builtin_bit_cast(float, __builtin_amdgcn_readlane(iv, 32)) + __builtin_bit_cast(float, __builtin_amdgcn_readlane(iv, 48));
        const int ea = e0 + 2 * j, eb = ea + 1;
        const float ga = __builtin_bit_cast(float, __builtin_amdgcn_readlane(__builtin_bit_cast(int, my_g), ea)), gb = __builtin_bit_cast(float, __builtin_amdgcn_readlane(__builtin_bit_cast(int, my_g), eb));
        const float sua = __builtin_bit_cast(float, __builtin_amdgcn_readlane(__builtin_bit_cast(int, my_su), ea)), sub = __builtin_bit_cast(float, __builtin_amdgcn_readlane(__builtin_bit_cast(int, my_su), eb));
        const float sva = __builtin_bit_cast(float, __builtin_amdgcn_readlane(__builtin_bit_cast(int, my_sv), ea)), svb = __builtin_bit_cast(float, __builtin_amdgcn_readlane(__builtin_bit_cast(int, my_sv), eb));
        const float ca = ga * gelu_t(s0 * sua) * sva, cb = gb * gelu_t(s1 * sub) * svb;
        cs[j] = h ? cb : ca; }
#pragma unroll
      for (int j = 0; j < G6; ++j) { const f32x32 vf = __builtin_amdgcn_cvt_scalef32_pk32_f32_fp6(vq[j], 1.0f);
#pragma unroll
        for (int k = 0; k < 32; ++k) acc[k] += cs[j] * vf[k];
        __builtin_amdgcn_sched_barrier(0); }
    }
  }
#pragma unroll
  for (int i = 0; i < 32; ++i) { auto rr = __builtin_amdgcn_permlane32_swap(__float_as_uint(acc[i]), __float_as_uint(acc[i]), false, false); acc[i] = __uint_as_float(rr[0]) + __uint_as_float(rr[1]); }
  if (h == 0) {
#pragma unroll
    for (int i = 0; i < 32; ++i) xs[sig[i] * 32 + g] = acc[i]; }
  asm volatile("s_waitcnt lgkmcnt(0)" ::: "memory"); __builtin_amdgcn_sched_barrier(0);
  float o[16]; float ss = 0.f;
#pragma unroll
  for (int j = 0; j < 16; ++j) { o[j] = xs[(16 * h + j) * 32 + g]; ss += o[j] * o[j]; }
  ss = wave_sum(ss); const float rstd = rsqrtf(ss * (1.f / 1024.f) + EPS);
  const int b = t >> 13, c0 = g * 32 + h * 16; const float* gt2 = MOD + b * 6144 + 5120 + c0;
  float* op = p.out + (size_t)t * 1024 + c0;
#pragma unroll
  for (int q4 = 0; q4 < 4; ++q4) { float4 xv = *(const float4*)(op + q4 * 4); const float4 gt = *(const float4*)(gt2 + q4 * 4), gp = *(const float4*)(p.g_post2 + c0 + q4 * 4);
    xv.x += gt.x * (o[q4 * 4 + 0] * rstd * gp.x); xv.y += gt.y * (o[q4 * 4 + 1] * rstd * gp.y);
    xv.z += gt.z * (o[q4 * 4 + 2] * rstd * gp.z); xv.w += gt.w * (o[q4 * 4 + 3] * rstd * gp.w);
    *(float4*)(op + q4 * 4) = xv; }
  asm volatile("s_waitcnt lgkmcnt(0)" ::: "memory"); __builtin_amdgcn_sched_barrier(0);
}

#define XB_TMO      128
#define XB_XCNT(j)  (256  + 64 * (j))
#define XB_XSUB(j)  (1280 + 64 * (j))
#define XB_XGEN(j)  (2304 + 64 * (j))
#define XB_TOP      3328
#define XB_TOPGEN   3392
#define XCD_BAR_WORDS 3456
#define XB_SPIN_CAP (1u << 18)
#define LAS __attribute__((address_space(3)))
DEVI unsigned xb_ld(unsigned* p)              { return __hip_atomic_load(p, __ATOMIC_RELAXED, __HIP_MEMORY_SCOPE_AGENT); }
DEVI unsigned xb_add(unsigned* p, unsigned v) { return __hip_atomic_fetch_add(p, v, __ATOMIC_RELAXED, __HIP_MEMORY_SCOPE_AGENT); }
DEVI unsigned xb_xcc_id() { return (unsigned)__builtin_amdgcn_s_getreg((3 << 11) | 20) & 0xFu; }
#define XB_SPIN(cond, bar) do { unsigned _sp = 0; while (cond) { __builtin_amdgcn_s_sleep(1); \
    if ((++_sp & 255u) == 0u) { if (xb_ld(&(bar)[XB_TMO])) break; if (_sp > XB_SPIN_CAP) { atomicAdd(&(bar)[XB_TMO], 1u); break; } } } } while (0)
struct XcdBarrier { unsigned* bar; unsigned x; volatile LAS unsigned* st; };
DEVI XcdBarrier xcd_barrier_post(unsigned* bar, volatile LAS unsigned* st) {
  XcdBarrier b; b.bar = bar; b.x = xb_xcc_id(); b.st = st;
  if (threadIdx.x == 0) (void)xb_add(&bar[XB_XCNT(b.x)], 1u);
  return b;
}
DEVI void xcd_barrier_complete(unsigned* bar, unsigned x, unsigned& nloc, unsigned& nx) {
  const unsigned G = gridDim.x * gridDim.y * gridDim.z;
  unsigned sum, cnt, mine, sp = 0u;
  for (;;) {
    sum = 0u; cnt = 0u; mine = 0u;
#pragma unroll
    for (unsigned j = 0; j < 16; ++j) { const unsigned c = xb_ld(&bar[XB_XCNT(j)]); sum += c; cnt += (c > 0u) ? 1u : 0u; mine = (j == x) ? c : mine; }
    if (sum == G) break;
    __builtin_amdgcn_s_sleep(1);
    if ((++sp & 255u) == 0u) { if (xb_ld(&bar[XB_TMO])) break; if (sp > XB_SPIN_CAP) { atomicAdd(&bar[XB_TMO], 1u); break; } }
  }
  nloc = mine > 0u ? mine : 1u; nx = cnt > 0u ? cnt : 1u;
}
DEVI void xcd_barrier(const XcdBarrier& b) {
  asm volatile("s_waitcnt vmcnt(0)" ::: "memory");
  __syncthreads();
  if (threadIdx.x == 0) {
    unsigned* bar = b.bar;
    __builtin_amdgcn_s_waitcnt(0);
    unsigned nloc = b.st[0], nx = b.st[1];
    if (nloc == 0u) { xcd_barrier_complete(bar, b.x, nloc, nx); b.st[0] = nloc; b.st[1] = nx; }
    const unsigned old = xb_add(&bar[XB_XSUB(b.x)], 1u);
    const unsigned gen = old / nloc;
    if (old + 1u == (gen + 1u) * nloc) {
      __builtin_amdgcn_fence(__ATOMIC_RELEASE, "agent");
      asm volatile("s_waitcnt vmcnt(0)" ::: "memory");
      const unsigned og = xb_add(&bar[XB_TOP], 1u);
      const unsigned tg = og / nx;
      if (og + 1u == (tg + 1u) * nx) xb_add(&bar[XB_TOPGEN], 1u);
      else XB_SPIN(xb_ld(&bar[XB_TOPGEN]) == tg, bar);
      __builtin_amdgcn_fence(__ATOMIC_ACQUIRE, "agent");
      xb_add(&bar[XB_XGEN(b.x)], 1u);
      asm volatile("s_waitcnt vmcnt(0)" ::: "memory");
    } else {
      XB_SPIN(xb_ld(&bar[XB_XGEN(b.x)]) == gen, bar);
      __builtin_amdgcn_fence(__ATOMIC_ACQUIRE, "agent");
      asm volatile("s_waitcnt vmcnt(0)" ::: "memory");
    }
  }
  __syncthreads();
}

constexpr int NPHASE = 11;
template <int PH> DEVI void run_phase(const Params& p, char* smem) {
  if constexpr (PH == 0) ph_prep(p, smem);
  else if constexpr (PH == 1) ph_hx(p, smem);
  else if constexpr (PH == 2) ph_inproj(p, smem);
  else if constexpr (PH == 3) ph_mid(p, smem);
  else if constexpr (PH == 4) ph_attn(p, smem);
  else if constexpr (PH == 5) ph_gates(p, smem);
  else if constexpr (PH == 6) ph_merge(p, smem);
  else if constexpr (PH == 7) ph_wo(p, smem);
  else if constexpr (PH == 8) ph_rows(p, smem);
  else if constexpr (PH == 9) ph_wpq(p, smem);
  else if constexpr (PH == 10) ph_topk(p, smem);
}

template <int PH> __global__ __launch_bounds__(NTHR) void k_phase(Params p) {
  extern __shared__ __attribute__((aligned(16))) char smem[];
  run_phase<PH>(p, smem);
}

#ifndef PROBE_PH
#define PROBE_PH -1
#endif
#if MEGA
#define RUNPH(N) do { if (PROBE_PH == N) t0 = __builtin_amdgcn_s_memrealtime(); run_phase<N>(p, smem); if (N < NPHASE - 1) xcd_barrier(xb); \
    if (PROBE_PH == N) t1 = __builtin_amdgcn_s_memrealtime(); } while (0)
__global__ __launch_bounds__(NTHR) void k_mega(Params p) {
  extern __shared__ __attribute__((aligned(16))) char smem[];
  cg::grid_group grid = cg::this_grid();
  unsigned long long t0 = 0, t1 = 0;
  unsigned* bar = (unsigned*)(p.ws + O_BAR);
  volatile LAS unsigned* xst = (volatile LAS unsigned*)(smem + LDS_BYTES - 16);
  if (threadIdx.x == 0) { xst[0] = 0u; xst[1] = 0u; }
  __syncthreads();
  const XcdBarrier xb = xcd_barrier_post(bar, xst);
  if (p.out == nullptr) grid.sync();
  RUNPH(0);
  RUNPH(1); RUNPH(2); RUNPH(3); RUNPH(4); RUNPH(5); RUNPH(6); RUNPH(7); RUNPH(8); RUNPH(9); RUNPH(10);
  if (PROBE_PH >= 0) { __syncthreads(); if (blockIdx.x == 0 && threadIdx.x == 0) p.out[0] += exp2f(rintf(log2f((float)(t1 - t0) * 1e-3f) * 5.f) * 0.2f); }
}
#endif

template <int PH> static void launch_phase(const Params& p, int grid, hipStream_t stream) {
  hipLaunchKernelGGL(k_phase<PH>, dim3(grid), dim3(NTHR), LDS_BYTES, stream, p);
}
template <int PH> static void set_attr() { (void)hipFuncSetAttribute((const void*)k_phase<PH>, hipFuncAttributeMaxDynamicSharedMemorySize, LDS_BYTES); }

extern "C" void kernel_launch(void* const* d_in, const int* in_sizes, int n_in, void* d_out, int out_size, void* d_ws, size_t ws_size, hipStream_t stream) {
  static int grid = 0;
  if (grid == 0) {
    if (n_in != 26 || out_size != NTOK * DM || ws_size < O_END) { fprintf(stderr, "kernel_launch: unexpected shapes n_in %d out %d ws %zu (need %zu)\n", n_in, out_size, ws_size, (size_t)O_END); grid = -1; return; }
#if MEGA
    (void)hipFuncSetAttribute((const void*)k_mega, hipFuncAttributeMaxDynamicSharedMemorySize, LDS_BYTES);
    int dev = 0, cus = 0, per_cu = 0; (void)hipGetDevice(&dev); (void)hipDeviceGetAttribute(&cus, hipDeviceAttributeMultiprocessorCount, dev);
    (void)hipOccupancyMaxActiveBlocksPerMultiprocessor(&per_cu, (const void*)k_mega, NTHR, LDS_BYTES);
    if (per_cu < 1) { fprintf(stderr, "kernel_launch: occupancy query says %d blocks per CU\n", per_cu); grid = -1; return; }
    grid = cus;
#else
    set_attr<0>(); set_attr<1>(); set_attr<2>(); set_attr<3>(); set_attr<4>(); set_attr<5>(); set_attr<6>(); set_attr<7>(); set_attr<8>(); set_attr<9>(); set_attr<10>(); set_attr<11>();
    grid = 256;
#endif
  }
  if (grid < 0) return;
  Params p{};
  const float** pp = (const float**)&p;
  for (int i = 0; i < 26; ++i) pp[i] = (const float*)d_in[i];
  p.out = (float*)d_out; p.ws = (char*)d_ws;
#if MEGA
  (void)hipMemsetAsync((char*)d_ws + O_BAR, 0, (size_t)XCD_BAR_WORDS * 4, stream);
  void* args[] = {&p};
  hipError_t e = hipLaunchCooperativeKernel((const void*)k_mega, dim3(grid), dim3(NTHR), args, LDS_BYTES, stream);
  if (e != hipSuccess) fprintf(stderr, "cooperative launch failed: %s (grid %d)\n", hipGetErrorString(e), grid);
#else
  launch_phase<0>(p, grid, stream); launch_phase<1>(p, grid, stream); launch_phase<2>(p, grid, stream); launch_phase<3>(p, grid, stream);
  launch_phase<4>(p, grid, stream); launch_phase<5>(p, grid, stream); launch_phase<6>(p, grid, stream); launch_phase<7>(p, grid, stream);
  launch_phase<8>(p, grid, stream); launch_phase<9>(p, grid, stream); launch_phase<10>(p, grid, stream); launch_phase<11>(p, grid, stream);
#endif
}
```

```cpp
#include <hip/hip_runtime.h>
#include <hip/hip_cooperative_groups.h>
#include <cstdint>
#include <cstdio>
namespace cg = cooperative_groups;

#define DEVI __device__ __forceinline__
typedef unsigned short bf16_t;
using bf16x8 = __attribute__((ext_vector_type(8))) short;
using bf16x4 = __attribute__((ext_vector_type(4))) short;
using f32x4  = __attribute__((ext_vector_type(4))) float;
using f32x16 = __attribute__((ext_vector_type(16))) float;
using u32x4  = __attribute__((ext_vector_type(4))) unsigned;
using u32x2  = __attribute__((ext_vector_type(2))) unsigned;

constexpr int DM = 1024, NB = 2, SEQ = 8192, NTOK = NB * SEQ, CTXL = 256, NCTX = NB * CTXL, NROW = NTOK + NCTX, NKEY = SEQ + CTXL;
constexpr int INW = 4544, INWP = 4608;
constexpr int NPRE = 2560;
constexpr float EPS = 1e-6f;
constexpr int NTHR = 512, NWAVE = 8;
constexpr int LDS_BYTES = 147456;

constexpr size_t al256(size_t x) { return (x + 255) / 256 * 256; }
constexpr size_t O_WIN   = 0;
constexpr size_t O_WUQ   = O_WIN  + al256((size_t)INWP * 1024 * 2);
constexpr size_t O_WUKV  = O_WUQ  + al256((size_t)1536 * 256 * 2);
constexpr size_t O_WPA   = O_WUKV + al256((size_t)2048 * 128 * 2);
constexpr size_t O_WPB   = O_WPA  + al256((size_t)1024 * 1024 * 2);
constexpr size_t O_WO    = O_WPB  + al256((size_t)1024 * 1024 * 2);
constexpr size_t O_WPQ   = O_WO   + al256((size_t)1024 * 1024 * 2);
constexpr size_t O_WS    = O_WPQ  + al256((size_t)2048 * 1024 * 2);
constexpr size_t O_K1    = O_WS   + al256((size_t)8 * 128 * 128 * 2);
constexpr size_t O_K2    = O_K1   + al256((size_t)128 * 128 * 2);
constexpr size_t O_MOD   = O_K2   + al256((size_t)128 * 128 * 2);
constexpr size_t O_ROPE  = O_MOD  + al256((size_t)3 * 6144 * 4);
constexpr size_t O_BAR   = O_ROPE + al256((size_t)128 * 16 * 2 * 4);
constexpr size_t O_RSSV  = O_BAR + al256((size_t)3456 * 4);
constexpr size_t O_RSSQ  = O_RSSV + (size_t)NTOK * 32 * 4;
constexpr size_t O_RSSKV = O_RSSQ + (size_t)NTOK * 8 * 4;
constexpr size_t O_RSSY  = O_RSSKV + (size_t)NROW * 4 * 4;
constexpr size_t O_RSSEND = O_RSSY + (size_t)NTOK * 32 * 4;
constexpr size_t O_RA    = al256(O_RSSEND);
constexpr size_t O_RB    = O_RA  + al256((size_t)NROW * 1024 * 2);
constexpr size_t O_RC    = O_RB  + al256((size_t)NTOK * 1024 * 2);
constexpr size_t O_CQ    = O_RC  + al256((size_t)NTOK * 1024 * 2);
constexpr size_t O_CKV   = O_CQ  + al256((size_t)NTOK * 256 * 2);
constexpr size_t O_KR    = O_CKV + al256((size_t)NROW * 128 * 2);
constexpr size_t O_RQ    = O_KR  + al256((size_t)NROW * 64 * 2);
constexpr size_t O_RKV   = O_RQ  + al256((size_t)NTOK * 1536 * 2);
constexpr size_t O_END   = O_RKV + al256((size_t)NROW * 2048 * 2);
static_assert(O_END <= (size_t)258 * 1024 * 1024, "workspace too large");

struct Params {
  const float *x, *c, *ctx, *c_ctx, *w_mod, *b_mod, *g_pre1, *g_post1, *g_pre2, *g_post2, *w_in, *g_q, *g_kv, *w_uq, *w_ukv, *g_sgu, *w_s, *b_s,
      *w_pa, *w_pb, *w_o, *w_pq, *k1, *k2, *u_exp, *v_exp;
  float* out; char* ws;
};

DEVI float bf2f(unsigned short h) { return __uint_as_float(((unsigned)h) << 16); }
DEVI unsigned short f2bf(float f) { unsigned u = __float_as_uint(f); u += 0x7fffu + ((u >> 16) & 1u); return (unsigned short)(u >> 16); }
DEVI unsigned pack2(float a, float b) { return (unsigned)f2bf(a) | ((unsigned)f2bf(b) << 16); }
DEVI float lo2f(unsigned w) { return __uint_as_float(w << 16); }
DEVI float hi2f(unsigned w) { return __uint_as_float(w & 0xffff0000u); }
DEVI void unpack8(const u32x4& w, float* f) {
  f[0] = lo2f(w[0]); f[1] = hi2f(w[0]); f[2] = lo2f(w[1]); f[3] = hi2f(w[1]); f[4] = lo2f(w[2]); f[5] = hi2f(w[2]); f[6] = lo2f(w[3]); f[7] = hi2f(w[3]);
}
DEVI float gelu_t(float x) { float z = 0.7978845608028654f * (x + 0.044715f * x * x * x); return x / (1.f + __expf(-2.f * z)); }
DEVI float sigmoidf_(float x) { return 1.f / (1.f + __expf(-x)); }
DEVI float wave_sum(float v) { for (int o = 32; o > 0; o >>= 1) v += __shfl_xor(v, o); return v; }
DEVI float wave_max(float v) { for (int o = 32; o > 0; o >>= 1) v = fmaxf(v, __shfl_xor(v, o)); return v; }
DEVI int keyrow(int row) { if (row < NTOK) return (row >> 13) * NKEY + (row & 8191); int c = row - NTOK; return (c >> 8) * NKEY + SEQ + (c & 255); }

__device__ const float ROPE_FREQ[16] = {1.0f, 0.5623413324356079f, 0.3162277638912201f, 0.17782793939113617f, 0.10000000149011612f, 0.05623413249850273f, 0.03162277489900589f, 0.017782794311642647f, 0.009999999776482582f, 0.005623413249850273f, 0.003162277629598975f, 0.0017782794311642647f, 0.0010000000474974513f, 0.000562341301701963f, 0.0003162277571391314f, 0.00017782794020604342f};
DEVI void sincos_small(double a, double& cs, double& sn) {
  const double k = rint(a * 0.15915494309189535); const double r = fma(-k, 6.283185307179586, a) - k * 2.4492935982947064e-16;
  const double r2 = r * r; double s = 0.0, c = 0.0;
#pragma unroll
  for (int n = 12; n >= 1; --n) { s = (1.0 - s * r2 / (double)((2 * n) * (2 * n + 1))); c = (1.0 - c * r2 / (double)((2 * n - 1) * (2 * n))); }
  sn = r * s; cs = c;
}

DEVI void transpose_job(const float* __restrict__ src, int K, int N, bf16_t* __restrict__ dst, const float* __restrict__ gk, bool isWin, int ntiles, char* smem) {
  const int tid = threadIdx.x; bf16_t* tl = (bf16_t*)smem; const int kt = K / 64;
  for (int idx = blockIdx.x; idx < ntiles; idx += gridDim.x) {
    const int ktile = idx % kt, ntile = idx / kt, k0 = ktile * 64, n0d = ntile * 64;
    int n0s = n0d; bool zero = false;
    if (isWin) { if (n0d == 2496) zero = true; else if (n0d >= 2560) n0s = n0d - 64; }
    { const int kk = tid >> 3, nn8 = (tid & 7) * 8; f32x4 va = {0.f, 0.f, 0.f, 0.f}, vb = va;
      if (!zero) { const float* s = src + (size_t)(k0 + kk) * N + n0s + nn8; const float4 a = *(const float4*)s, b = *(const float4*)(s + 4);
        const float sc = gk ? gk[k0 + kk] : 1.f; va = (f32x4){a.x, a.y, a.z, a.w} * sc; vb = (f32x4){b.x, b.y, b.z, b.w} * sc; }
      bf16_t* tp = tl + nn8 * 72 + kk;
      tp[0] = f2bf(va[0]); tp[72] = f2bf(va[1]); tp[144] = f2bf(va[2]); tp[216] = f2bf(va[3]); tp[288] = f2bf(vb[0]); tp[360] = f2bf(vb[1]); tp[432] = f2bf(vb[2]); tp[504] = f2bf(vb[3]); }
    __syncthreads();
    { const int nn = tid >> 3, kk8 = (tid & 7) * 8;
      const u32x4 o = *(const u32x4*)(tl + nn * 72 + kk8);
      *(u32x4*)(dst + (size_t)(n0d + nn) * K + k0 + kk8) = o; }
    __syncthreads();
  }
}

DEVI void ph_prep(const Params& p, char* smem) {
  const int tid = threadIdx.x, bid = blockIdx.x, nb = gridDim.x;
  char* ws = p.ws;
  if (bid == 0) { float* rope = (float*)(ws + O_ROPE);
    for (int i = tid; i < 128 * 16; i += NTHR) { const int pos = i >> 4, f = i & 15; const float ang = (float)pos * ROPE_FREQ[f];
      double cs, sn; sincos_small((double)ang, cs, sn); rope[i * 2] = (float)cs; rope[i * 2 + 1] = (float)sn; } }
  { float* red = (float*)smem; float* MOD = (float*)(ws + O_MOD);
    for (int it = bid; it < 256; it += nb) {
      const int cgp = tid % 6, kg = tid / 6;
      f32x4 a0 = {0.f, 0.f, 0.f, 0.f}, a1 = a0, a2 = a0;
      if (tid < 510) {
        for (int k = kg; k < 1024; k += 85) {
          const float4 w4 = *(const float4*)(p.w_mod + (size_t)k * 6144 + it * 24 + cgp * 4);
          const f32x4 w = {w4.x, w4.y, w4.z, w4.w};
          const float c0 = p.c[k], c1 = p.c[1024 + k], c2 = p.c_ctx[k];
          a0 += w * (c0 / (1.f + __expf(-c0))); a1 += w * (c1 / (1.f + __expf(-c1))); a2 += w * (c2 / (1.f + __expf(-c2)));
        }
        float* rp = red + kg * 72 + cgp * 4;
        rp[0] = a0[0]; rp[1] = a0[1]; rp[2] = a0[2]; rp[3] = a0[3];
        rp[24] = a1[0]; rp[25] = a1[1]; rp[26] = a1[2]; rp[27] = a1[3];
        rp[48] = a2[0]; rp[49] = a2[1]; rp[50] = a2[2]; rp[51] = a2[3];
      }
      __syncthreads();
      if (tid < 72) { float s = 0.f; for (int g = 0; g < 85; ++g) s += red[g * 72 + tid]; int r = tid / 24, n = it * 24 + tid % 24; MOD[r * 6144 + n] = s + p.b_mod[n]; }
      __syncthreads();
    } }
  transpose_job(p.w_in,  1024, INW,  (bf16_t*)(ws + O_WIN),  nullptr, true,  1152, smem);
  transpose_job(p.w_uq,  256,  1536, (bf16_t*)(ws + O_WUQ),  p.g_q,   false, 96,   smem);
  transpose_job(p.w_ukv, 128,  2048, (bf16_t*)(ws + O_WUKV), p.g_kv,  false, 64,   smem);
  transpose_job(p.w_pa,  1024, 1024, (bf16_t*)(ws + O_WPA),  nullptr, false, 256,  smem);
  transpose_job(p.w_pb,  1024, 1024, (bf16_t*)(ws + O_WPB),  nullptr, false, 256,  smem);
  transpose_job(p.w_o,   1024, 1024, (bf16_t*)(ws + O_WO),   nullptr, false, 256,  smem);
  transpose_job(p.w_pq,  1024, 2048, (bf16_t*)(ws + O_WPQ),  nullptr, false, 512,  smem);
  { const int n8 = (131072 + 16384 + 16384) / 8;
    for (int i = bid * NTHR + tid; i < n8; i += nb * NTHR) {
      int e = i * 8; const float* s; bf16_t* d;
      if (e < 131072) { s = p.w_s + e; d = (bf16_t*)(ws + O_WS) + e; }
      else if (e < 131072 + 16384) { s = p.k1 + (e - 131072); d = (bf16_t*)(ws + O_K1) + (e - 131072); }
      else { s = p.k2 + (e - 131072 - 16384); d = (bf16_t*)(ws + O_K2) + (e - 131072 - 16384); }
      const float4 a = *(const float4*)s, b = *(const float4*)(s + 4);
      u32x4 o = {pack2(a.x, a.y), pack2(a.z, a.w), pack2(b.x, b.y), pack2(b.z, b.w)};
      *(u32x4*)d = o;
    } }
}


using f32x32 = __attribute__((ext_vector_type(32))) float;
using u32x6 = __attribute__((ext_vector_type(6))) unsigned;
typedef u32x4 __attribute__((aligned(4))) u32x4_u;
typedef u32x2 __attribute__((aligned(4))) u32x2_u;
DEVI void convert_table_fp6(const float* __restrict__ src, unsigned char* __restrict__ dst, float* __restrict__ scale) {
  const int wave = threadIdx.x >> 6, lane = threadIdx.x & 63, h = lane >> 5, g = lane & 31;
  for (int rp = blockIdx.x * NWAVE + wave; rp < 8192; rp += gridDim.x * NWAVE) {
    const int row = rp * 2 + h;
    const float* sp = src + (size_t)row * 1024 + g * 32;
    f32x16 a, b; float am = 0.f;
#pragma unroll
    for (int j = 0; j < 4; ++j) { const float4 t = *(const float4*)(sp + j * 4), u = *(const float4*)(sp + 16 + j * 4);
      a[j * 4] = t.x; a[j * 4 + 1] = t.y; a[j * 4 + 2] = t.z; a[j * 4 + 3] = t.w; b[j * 4] = u.x; b[j * 4 + 1] = u.y; b[j * 4 + 2] = u.z; b[j * 4 + 3] = u.w;
      am = fmaxf(am, fmaxf(fmaxf(fmaxf(fabsf(t.x), fabsf(t.y)), fmaxf(fabsf(t.z), fabsf(t.w))), fmaxf(fmaxf(fabsf(u.x), fabsf(u.y)), fmaxf(fabsf(u.z), fabsf(u.w))))); }
    for (int o = 16; o > 0; o >>= 1) am = fmaxf(am, __shfl_xor(am, o));
    const float inv = am > 0.f ? 7.5f / am : 0.f;
    const u32x6 w = __builtin_amdgcn_cvt_scalef32_2xpk16_fp6_f32(a * inv, b * inv, 1.0f);
    unsigned char* dp = dst + (size_t)row * 768 + g * 24;
    *(u32x4_u*)dp = (u32x4){w[0], w[1], w[2], w[3]}; *(u32x2_u*)(dp + 16) = (u32x2){w[4], w[5]};
    if (g == 0) scale[row] = am * (1.f / 7.5f);
  }
}

DEVI void ph_hx(const Params& p, char* smem) {
  const int tid = threadIdx.x, wave = tid >> 6, lane = tid & 63;
  float* mA = (float*)smem; float* mB = mA + 3 * 1024;
  const float* MOD = (const float*)(p.ws + O_MOD);
  for (int i = tid; i < 3072; i += NTHR) { int r = i >> 10, c = i & 1023; mA[i] = p.g_pre1[c] * (1.f + MOD[r * 6144 + 1024 + c]); mB[i] = MOD[r * 6144 + c]; }
  __syncthreads();
  bf16_t* HX = (bf16_t*)(p.ws + O_RA);
  for (int row = blockIdx.x * NWAVE + wave; row < NROW; row += gridDim.x * NWAVE) {
    const float* src = row < NTOK ? p.x + (size_t)row * 1024 : p.ctx + (size_t)(row - NTOK) * 1024;
    const int mr = row < NTOK ? (row >> 13) : 2;
    float4 v[4]; float ss = 0.f;
#pragma unroll
    for (int i = 0; i < 4; ++i) { v[i] = *(const float4*)(src + i * 256 + lane * 4); ss += v[i].x * v[i].x + v[i].y * v[i].y + v[i].z * v[i].z + v[i].w * v[i].w; }
    ss = wave_sum(ss); const float rstd = rsqrtf(ss * (1.f / 1024.f) + EPS);
#pragma unroll
    for (int i = 0; i < 4; ++i) { const int c = i * 256 + lane * 4; const float* a = mA + mr * 1024 + c; const float* b = mB + mr * 1024 + c;
      u32x2 o = {pack2(v[i].x * rstd * a[0] + b[0], v[i].y * rstd * a[1] + b[1]), pack2(v[i].z * rstd * a[2] + b[2], v[i].w * rstd * a[3] + b[3])};
      *(u32x2*)(HX + (size_t)row * 1024 + c) = o; }
  }
}

DEVI int lds_sw(int row, int c) { return row * 128 + ((c ^ (row & 7)) << 4); }
template <int BM, int BN, bool ACOLMAP, bool GLDS, class Epi>
DEVI void gemm_tile_mfma(const bf16_t* __restrict__ A, int lda, const bf16_t* __restrict__ Bm, int ldb, int K, int row0, int col0, const Epi& epi, const float* kscale, char* smem) {
  constexpr int WNW = BN / 64, WMW = 8 / WNW, WTM = BM / WMW, MI = WTM / 16, ACH = BM / 64, BCH = BN / 64, ABYTES = BM * 128, BBYTES = BN * 128, STAGE = ABYTES + BBYTES;
  int tid = threadIdx.x; asm volatile("" : "+v"(tid));
  const int wave = __builtin_amdgcn_readfirstlane(tid >> 6), lane = tid & 63, wm = wave / WNW, wn = wave % WNW, l15 = lane & 15, lq = lane >> 4;
  f32x4 acc[MI][4];
#pragma unroll
  for (int mi = 0; mi < MI; ++mi)
#pragma unroll
    for (int ni = 0; ni < 4; ++ni) acc[mi][ni] = (f32x4){0.f, 0.f, 0.f, 0.f};
  const int nk = K >> 6;
  const int sr = tid >> 3, scc = tid & 7;
  auto compute = [&](int buf) {
    const char* sa = smem + buf * STAGE; const char* sb = sa + ABYTES;
#pragma unroll
    for (int ks = 0; ks < 2; ++ks) { const int kc = ks * 4 + lq; bf16x8 bfr[4];
#pragma unroll
      for (int ni = 0; ni < 4; ++ni) bfr[ni] = *(const bf16x8*)(sb + lds_sw(wn * 64 + ni * 16 + l15, kc));
#pragma unroll
      for (int mi = 0; mi < MI; ++mi) { const bf16x8 af = *(const bf16x8*)(sa + lds_sw(wm * WTM + mi * 16 + l15, kc));
#pragma unroll
        for (int ni = 0; ni < 4; ++ni) acc[mi][ni] = __builtin_amdgcn_mfma_f32_16x16x32_bf16(bfr[ni], af, acc[mi][ni], 0, 0, 0); }
    }
  };
  if constexpr (GLDS) {
    const unsigned aoff = (unsigned)(sr * lda + ((scc ^ (sr & 7)) * 8)) * 2u, boff = (unsigned)(sr * ldb + ((scc ^ (sr & 7)) * 8)) * 2u;
    auto gstage = [&](int buf, int kt) {
      const int k0 = kt * 64, ka = ACOLMAP ? k0 + (k0 >> 7) * 64 : k0;
      char* sa = smem + buf * STAGE + wave * 1024; char* sb = sa + ABYTES;
#pragma unroll
      for (int i = 0; i < ACH; ++i) __builtin_amdgcn_global_load_lds((const unsigned*)((const char*)(A + (size_t)(64 * i) * lda + ka) + aoff), (unsigned*)(sa + i * 8192), 16, 0, 0);
#pragma unroll
      for (int i = 0; i < BCH; ++i) __builtin_amdgcn_global_load_lds((const unsigned*)((const char*)(Bm + (size_t)(64 * i) * ldb + k0) + boff), (unsigned*)(sb + i * 8192), 16, 0, 0);
    };
    gstage(0, 0); asm volatile("s_waitcnt vmcnt(0)" ::: "memory"); __syncthreads();
    for (int kt = 0; kt < nk; ++kt) {
      if (kt + 1 < nk) gstage((kt + 1) & 1, kt + 1);
      compute(kt & 1);
      asm volatile("s_waitcnt vmcnt(0)" ::: "memory"); __syncthreads();
    }
  } else {
    u32x4 ra[ACH], rb[BCH];
    const unsigned aoff = (unsigned)(sr * lda + scc * 8) * 2u, boff = (unsigned)(sr * ldb + scc * 8) * 2u;
    const int sdst = lds_sw(sr, scc);
    auto gload = [&](int kt) {
      const int k0 = kt * 64, ka = ACOLMAP ? k0 + (k0 >> 7) * 64 : k0;
#pragma unroll
      for (int i = 0; i < ACH; ++i) { const char* ub = (const char*)(A + (size_t)(64 * i) * lda + ka); ra[i] = *(const u32x4*)(ub + aoff); }
#pragma unroll
      for (int i = 0; i < BCH; ++i) { const char* ub = (const char*)(Bm + (size_t)(64 * i) * ldb + k0); rb[i] = *(const u32x4*)(ub + boff); }
    };
    auto lstore = [&](int buf, int kt) {
      char* sa = smem + buf * STAGE + sdst; char* sb = sa + ABYTES;
#pragma unroll
      for (int i = 0; i < ACH; ++i) { u32x4 v = ra[i];
        if (kscale) { float f[8]; unpack8(v, f); const float* ks = kscale + kt * 64 + scc * 8;
          v = (u32x4){pack2(f[0] * ks[0], f[1] * ks[1]), pack2(f[2] * ks[2], f[3] * ks[3]), pack2(f[4] * ks[4], f[5] * ks[5]), pack2(f[6] * ks[6], f[7] * ks[7])}; }
        *(u32x4*)(sa + i * 8192) = v; }
#pragma unroll
      for (int i = 0; i < BCH; ++i) *(u32x4*)(sb + i * 8192) = rb[i];
    };
    gload(0); lstore(0, 0); __syncthreads();
    for (int kt = 0; kt < nk; ++kt) {
      if (kt + 1 < nk) gload(kt + 1);
      compute(kt & 1);
      if (kt + 1 < nk) lstore((kt + 1) & 1, kt + 1);
      __syncthreads();
    }
  }
  int tide = threadIdx.x; asm volatile("" : "+v"(tide));
  const int l15e = tide & 15, lqe = (tide >> 4) & 3;
#pragma unroll
  for (int mi = 0; mi < MI; ++mi) { const int row = row0 + wm * WTM + mi * 16 + l15e; float sq = 0.f;
#pragma unroll
    for (int ni = 0; ni < 4; ++ni) { const float v[4] = {acc[mi][ni][0], acc[mi][ni][1], acc[mi][ni][2], acc[mi][ni][3]}; const float q = epi(row, col0 + wn * 64 + ni * 16 + lqe * 4, v);
      if (Epi::RSS) { sq += q; if (ni & 1) { sq += __shfl_xor(sq, 16); sq += __shfl_xor(sq, 32); if (lqe == 0) epi.rss(row, col0 + wn * 64 + (ni >> 1) * 32, sq); sq = 0.f; } } }
    __builtin_amdgcn_sched_barrier(0); }
}


namespace g8 {
constexpr int BK = 64, HALF = 128, HT = HALF * BK;
DEVI int lds_byte(int r, int c) { const int st = (r >> 4) * 2 + (c >> 5), rr = r & 15, cc = c & 31, ob = rr * 64 + cc * 2; return st * 1024 + (ob ^ (((ob >> 9) & 1) << 5)); }
DEVI void stage_rc(int b, int& R, int& C) { const int st = b / 1024, sb = b % 1024, swz = sb ^ (((sb >> 9) & 1) << 5); R = (st >> 1) * 16 + swz / 64; C = (st & 1) * 32 + (swz % 64) / 2; }
}
template <bool ACOLMAP, class Epi>
DEVI void gemm_tile_8ph(const bf16_t* __restrict__ A, int lda, const bf16_t* __restrict__ Bt, int ldb, int K, int row0, int col0, const Epi& epi, char* smem) {
  using namespace g8;
  bf16_t* shm = (bf16_t*)smem;
#define SA(b, h) (shm + ((b) * 2 + (h)) * HT)
#define SB(b, h) (shm + (4 + (b) * 2 + (h)) * HT)
#define STAGE_A(P, r0, kt) do { const int _k0 = (kt) * BK, _ka = ACOLMAP ? _k0 + (_k0 >> 7) * 64 : _k0; \
    __builtin_amdgcn_global_load_lds((const unsigned*)((const char*)(A + (size_t)(r0) * lda + _ka) + ao0), (unsigned*)((char*)(P) + wid * 1024), 16, 0, 0); \
    __builtin_amdgcn_global_load_lds((const unsigned*)((const char*)(A + (size_t)((r0) + 64) * lda + _ka) + ao0), (unsigned*)((char*)(P) + wid * 1024 + 8192), 16, 0, 0); } while (0)
#define STAGE_B(P, r0, kt) do { const int _k0 = (kt) * BK; \
    __builtin_amdgcn_global_load_lds((const unsigned*)((const char*)(Bt + (size_t)(r0) * ldb + _k0) + bo0), (unsigned*)((char*)(P) + wid * 1024), 16, 0, 0); \
    __builtin_amdgcn_global_load_lds((const unsigned*)((const char*)(Bt + (size_t)((r0) + 64) * ldb + _k0) + bo0), (unsigned*)((char*)(P) + wid * 1024 + 8192), 16, 0, 0); } while (0)
#define LDA(dst, b, h) _Pragma("unroll") for (int m = 0; m < 4; ++m) _Pragma("unroll") for (int k = 0; k < 2; ++k) \
    dst[m][k] = *reinterpret_cast<const bf16x8*>((const char*)SA(b, h) + lds_byte(wr * 64 + m * 16 + fr, k * 32 + fq * 8))
#define LDB(dst, b, h) _Pragma("unroll") for (int n = 0; n < 2; ++n) _Pragma("unroll") for (int k = 0; k < 2; ++k) \
    dst[n][k] = *reinterpret_cast<const bf16x8*>((const char*)SB(b, h) + lds_byte(wc * 32 + n * 16 + fr, k * 32 + fq * 8))
#define MMA(ai, bj, At_, Bt_) do { __builtin_amdgcn_s_setprio(1); \
    _Pragma("unroll") for (int m = 0; m < 4; ++m) _Pragma("unroll") for (int n = 0; n < 2; ++n) _Pragma("unroll") for (int k = 0; k < 2; ++k) \
      acc[ai][bj][m][n] = __builtin_amdgcn_mfma_f32_16x16x32_bf16(Bt_[n][k], At_[m][k], acc[ai][bj][m][n], 0, 0, 0); \
    __builtin_amdgcn_s_setprio(0); } while (0)
#define WAIT_V(n) asm volatile("s_waitcnt vmcnt(" #n ")" ::: "memory")
#define WAIT_L(n) asm volatile("s_waitcnt lgkmcnt(" #n ")" ::: "memory")
#define BAR __builtin_amdgcn_s_barrier()
#define SCHED __builtin_amdgcn_sched_barrier(0)
  int tid = threadIdx.x; asm volatile("" : "+v"(tid));
  const int wid = __builtin_amdgcn_readfirstlane(tid >> 6), lane = tid & 63, wr = wid >> 2, wc = wid & 3, fr = lane & 15, fq = lane >> 4;
  unsigned ao0, bo0;
  { int r, c; stage_rc(tid * 16, r, c); ao0 = (unsigned)(r * lda + c) * 2u; bo0 = (unsigned)(r * ldb + c) * 2u; }
  f32x4 acc[2][2][4][2];
#pragma unroll
  for (int a = 0; a < 2; ++a)
#pragma unroll
    for (int b = 0; b < 2; ++b)
#pragma unroll
      for (int m = 0; m < 4; ++m)
#pragma unroll
        for (int n = 0; n < 2; ++n) acc[a][b][m][n] = (f32x4){0.f, 0.f, 0.f, 0.f};
  bf16x8 At[4][2], B0[2][2], B1[2][2];
  const int nt = K / BK;
  STAGE_B(SB(0, 0), 0, 0); STAGE_A(SA(0, 0), 0, 0);
  STAGE_B(SB(0, 1), HALF, 0); STAGE_A(SA(0, 1), HALF, 0);
  if (wr == 1) BAR;
  WAIT_V(4); BAR;
  STAGE_B(SB(1, 0), 0, 1); STAGE_A(SA(1, 0), 0, 1); STAGE_B(SB(1, 1), HALF, 1);
  WAIT_V(6); BAR;
  for (int t = 0; t < nt - 2; t += 2) {
    LDB(B0, 0, 0); SCHED; LDA(At, 0, 0); STAGE_A(SA(1, 1), HALF, t + 1);
    WAIT_L(8); BAR; WAIT_L(0); MMA(0, 0, At, B0); BAR; SCHED;
    LDB(B1, 0, 1); STAGE_B(SB(0, 0), 0, t + 2);
    BAR; WAIT_L(0); MMA(0, 1, At, B1); BAR;
    LDA(At, 0, 1); STAGE_A(SA(0, 0), 0, t + 2);
    BAR; WAIT_L(0); MMA(1, 0, At, B0); BAR; SCHED;
    STAGE_B(SB(0, 1), HALF, t + 2);
    WAIT_V(6); BAR; MMA(1, 1, At, B1); BAR;
    LDB(B0, 1, 0); SCHED; LDA(At, 1, 0); STAGE_A(SA(0, 1), HALF, t + 2);
    WAIT_L(8); BAR; WAIT_L(0); MMA(0, 0, At, B0); BAR; SCHED;
    LDB(B1, 1, 1); STAGE_B(SB(1, 0), 0, t + 3);
    BAR; WAIT_L(0); MMA(0, 1, At, B1); BAR;
    LDA(At, 1, 1); STAGE_A(SA(1, 0), 0, t + 3);
    BAR; WAIT_L(0); MMA(1, 0, At, B0); BAR; SCHED;
    STAGE_B(SB(1, 1), HALF, t + 3);
    WAIT_V(6); BAR; MMA(1, 1, At, B1); BAR;
  }
  { LDB(B0, 0, 0); LDA(At, 0, 0); STAGE_A(SA(1, 1), HALF, nt - 1);
    BAR; WAIT_L(0); MMA(0, 0, At, B0); BAR;
    LDB(B1, 0, 1); BAR; WAIT_L(0); MMA(0, 1, At, B1); BAR;
    LDA(At, 0, 1); WAIT_V(4); BAR; WAIT_L(0); MMA(1, 0, At, B0); MMA(1, 1, At, B1); BAR; }
  { LDB(B0, 1, 0); LDA(At, 1, 0); WAIT_V(2); BAR; WAIT_L(0); MMA(0, 0, At, B0); BAR;
    LDB(B1, 1, 1); WAIT_V(0); BAR; WAIT_L(0); MMA(0, 1, At, B1); BAR;
    LDA(At, 1, 1); BAR; WAIT_L(0); MMA(1, 0, At, B0); MMA(1, 1, At, B1); BAR; }
  if (wr == 0) BAR;
  int tide = threadIdx.x; asm volatile("" : "+v"(tide));
  const int fre = tide & 15, fqe = (tide >> 4) & 3;
#pragma unroll
  for (int ai = 0; ai < 2; ++ai)
#pragma unroll
    for (int m = 0; m < 4; ++m) { const int row = row0 + ai * HALF + wr * 64 + m * 16 + fre;
#pragma unroll
      for (int bj = 0; bj < 2; ++bj) { float sq = 0.f;
#pragma unroll
        for (int n = 0; n < 2; ++n) { const float v[4] = {acc[ai][bj][m][n][0], acc[ai][bj][m][n][1], acc[ai][bj][m][n][2], acc[ai][bj][m][n][3]};
          sq += epi(row, col0 + bj * HALF + wc * 32 + n * 16 + fqe * 4, v); }
        if (Epi::RSS) { sq += __shfl_xor(sq, 16); sq += __shfl_xor(sq, 32); if (fqe == 0) epi.rss(row, col0 + bj * HALF + wc * 32, sq); } }
      __builtin_amdgcn_sched_barrier(0); }
#undef SA
#undef SB
#undef STAGE_A
#undef STAGE_B
#undef LDA
#undef LDB
#undef MMA
#undef WAIT_V
#undef WAIT_L
#undef BAR
#undef SCHED
}

template <int BM, int BN, bool ACOLMAP, class Epi>
DEVI void gemm_tile(const bf16_t* A, int lda, const bf16_t* Bm, int ldb, int K, int row0, int col0, const Epi& epi, const float* kss, char* smem) {
  if constexpr (BM == 256 && BN == 256) gemm_tile_8ph<ACOLMAP>(A, lda, Bm, ldb, K, row0, col0, epi, smem);
  else if (kss) gemm_tile_mfma<BM, BN, ACOLMAP, false>(A, lda, Bm, ldb, K, row0, col0, epi, kss, smem);
  else gemm_tile_mfma<BM, BN, ACOLMAP, true>(A, lda, Bm, ldb, K, row0, col0, epi, nullptr, smem);
}

DEVI void st4bf(bf16_t* d, float a, float b, float c, float e) { u32x2 o = {pack2(a, b), pack2(c, e)}; *(u32x2*)d = o; }

struct EpiIn { static constexpr bool RSS = true; bf16_t *GU, *GVT, *CQ, *CKV, *KR; float *rssv, *rssq, *rsskv;
  DEVI float operator()(int row, int col, const float (&v)[4]) const {
    if (col < 1024) { st4bf(GU + (size_t)row * 1024 + col, gelu_t(v[0]), gelu_t(v[1]), gelu_t(v[2]), gelu_t(v[3])); return 0.f; }
    else if (col < 2048) { const int c = col - 1024, chunk = row >> 7, q = row & 127; float s = 0.f;
#pragma unroll
      for (int j = 0; j < 4; ++j) { const float g = gelu_t(v[j]); s += g * g; GVT[((size_t)chunk * 1024 + c + j) * 128 + q] = f2bf(g); }
      return s; }
    else if (col < 2304) { st4bf(CQ + (size_t)row * 256 + (col - 2048), v[0], v[1], v[2], v[3]); return v[0] * v[0] + v[1] * v[1] + v[2] * v[2] + v[3] * v[3]; }
    else if (col < 2432) { st4bf(CKV + (size_t)row * 128 + (col - 2304), v[0], v[1], v[2], v[3]); return v[0] * v[0] + v[1] * v[1] + v[2] * v[2] + v[3] * v[3]; }
    else if (col < 2496) { st4bf(KR + (size_t)keyrow(row) * 64 + (col - 2432), v[0], v[1], v[2], v[3]); return 0.f; }
    return 0.f; }
  DEVI void rss(int row, int col, float s) const {
    if (col >= 1024 && col < 2048) rssv[row * 32 + ((col - 1024) >> 5)] = s; else if (col >= 2048 && col < 2304) rssq[row * 8 + ((col - 2048) >> 5)] = s; else if (col >= 2304 && col < 2432) rsskv[row * 4 + ((col - 2304) >> 5)] = s; }
};
struct EpiQ { static constexpr bool RSS = false; bf16_t* Q; const float* rssq;
  DEVI float operator()(int row, int col, const float (&v)[4]) const { const float4 ps = *(const float4*)(rssq + row * 8), pt = *(const float4*)(rssq + row * 8 + 4); const float r = rsqrtf((((ps.x + ps.y) + (ps.z + ps.w)) + ((pt.x + pt.y) + (pt.z + pt.w))) * (1.f / 256.f) + EPS);
    st4bf(Q + (size_t)row * 1536 + col, v[0] * r, v[1] * r, v[2] * r, v[3] * r); return 0.f; }
  DEVI void rss(int, int, float) const {} };
DEVI int pk4_fp8(float a, float b, float c, float d) { int w = __builtin_amdgcn_cvt_pk_fp8_f32(a, b, 0, false); return __builtin_amdgcn_cvt_pk_fp8_f32(c, d, w, true); }
constexpr size_t O_K8 = O_RKV, O_V8T = O_RKV + al256((size_t)NB * 8 * NKEY * 192);
struct EpiK8 { static constexpr bool RSS = false; unsigned char* K8; const float* rsskv;
  DEVI float operator()(int row, int col, const float (&v)[4]) const { const float4 pk = *(const float4*)(rsskv + row * 4); const float r = rsqrtf(((pk.x + pk.y) + (pk.z + pk.w)) * (1.f / 128.f) + EPS);
    const int kr = keyrow(row), b = kr / NKEY, key = kr - b * NKEY, h = col >> 7, d = col & 127;
    *(int*)(K8 + ((size_t)(b * 8 + h) * NKEY + key) * 192 + d) = pk4_fp8(v[0] * r, v[1] * r, v[2] * r, v[3] * r); return 0.f; }
  DEVI void rss(int, int, float) const {} };
struct EpiV8T { static constexpr bool RSS = false; unsigned char* V8; const float* rsskv;
  DEVI float operator()(int row, int col, const float (&v)[4]) const {
    float r[4];
#pragma unroll
    for (int j = 0; j < 4; ++j) { const float4 pk = *(const float4*)(rsskv + (col + j) * 4); r[j] = rsqrtf(((pk.x + pk.y) + (pk.z + pk.w)) * (1.f / 128.f) + EPS); }
    const int kr = keyrow(col), b = kr / NKEY, key = kr - b * NKEY, h = row >> 7, d = row & 127, kk = key & 63;
    const int off = 32 * ((kk >> 2) & 1) + 16 * (kk >> 5) + 4 * ((kk >> 3) & 3);
    *(int*)(V8 + ((size_t)(b * 8 + h) * 128 + d) * NKEY + (key & ~63) + off) = pk4_fp8(v[0] * r[0], v[1] * r[1], v[2] * r[2], v[3] * r[3]); return 0.f; }
  DEVI void rss(int, int, float) const {} };
struct EpiSgu { static constexpr bool RSS = false; bf16_t* GUOA; const float* g_sgu; const float* b_s; int chunk, g;
  DEVI float operator()(int row, int col, const float (&v)[4]) const { const int token = chunk * 128 + row, ch = g * 128 + col; const float bias = b_s[g * 128 + row];
    bf16_t* ptr = GUOA + (size_t)token * 1024 + ch; const u32x2 gu = *(const u32x2*)ptr;
    st4bf(ptr, lo2f(gu[0]) * (g_sgu[ch] * v[0] + bias), hi2f(gu[0]) * (g_sgu[ch + 1] * v[1] + bias), lo2f(gu[1]) * (g_sgu[ch + 2] * v[2] + bias), hi2f(gu[1]) * (g_sgu[ch + 3] * v[3] + bias));
    return 0.f; }
  DEVI void rss(int, int, float) const {} };
struct EpiGate { static constexpr bool RSS = false; bf16_t* G;
  DEVI float operator()(int row, int col, const float (&v)[4]) const { st4bf(G + (size_t)row * 2048 + col, sigmoidf_(v[0]), sigmoidf_(v[1]), sigmoidf_(v[2]), sigmoidf_(v[3])); return 0.f; }
  DEVI void rss(int, int, float) const {} };
template <bool SECOND> struct EpiMerge { static constexpr bool RSS = false; bf16_t* M; const bf16_t* G;
  DEVI float operator()(int row, int col, const float (&v)[4]) const { const u32x2 g = *(const u32x2*)(G + (size_t)row * 2048 + (SECOND ? 1024 : 0) + col);
    float o0 = lo2f(g[0]) * v[0], o1 = hi2f(g[0]) * v[1], o2 = lo2f(g[1]) * v[2], o3 = hi2f(g[1]) * v[3];
    bf16_t* ptr = M + (size_t)row * 1024 + col;
    if (SECOND) { const u32x2 m = *(const u32x2*)ptr; o0 += lo2f(m[0]); o1 += hi2f(m[0]); o2 += lo2f(m[1]); o3 += hi2f(m[1]); }
    st4bf(ptr, o0, o1, o2, o3); return 0.f; }
  DEVI void rss(int, int, float) const {} };
struct EpiO { static constexpr bool RSS = true; bf16_t* Y; float* rssy;
  DEVI float operator()(int row, int col, const float (&v)[4]) const { st4bf(Y + (size_t)row * 1024 + col, v[0], v[1], v[2], v[3]); return v[0] * v[0] + v[1] * v[1] + v[2] * v[2] + v[3] * v[3]; }
  DEVI void rss(int row, int col, float s) const { rssy[row * 32 + (col >> 5)] = s; } };
struct EpiPq { static constexpr bool RSS = false; bf16_t* QP;
  DEVI float operator()(int row, int col, const float (&v)[4]) const { st4bf(QP + (size_t)row * 2048 + col, v[0], v[1], v[2], v[3]); return 0.f; }
  DEVI void rss(int, int, float) const {} };

template <class F> DEVI void for_tiles_xcd(int MT, int NT, F f) {
  const int nb = gridDim.x;
  if ((nb & 7) == 0 && (MT & 7) == 0) { const int xcd = blockIdx.x & 7, slot = blockIdx.x >> 3, slots = nb >> 3, mper = MT >> 3, tot = mper * NT;
    for (int j = slot; j < tot; j += slots) f(xcd * mper + j / NT, j % NT); }
  else for (int i = blockIdx.x; i < MT * NT; i += nb) f(i / NT, i % NT);
}

DEVI void ph_inproj(const Params& p, char* smem) {
  char* ws = p.ws;
  EpiIn epi{(bf16_t*)(ws + O_RB), (bf16_t*)(ws + O_RC), (bf16_t*)(ws + O_CQ), (bf16_t*)(ws + O_CKV), (bf16_t*)(ws + O_KR), (float*)(ws + O_RSSV), (float*)(ws + O_RSSQ), (float*)(ws + O_RSSKV)};
  const bf16_t* HX = (const bf16_t*)(ws + O_RA); const bf16_t* W = (const bf16_t*)(ws + O_WIN);
  auto tile = [&](int mt, int nt) { gemm_tile<256, 256, false>(HX + (size_t)mt * 256 * 1024, 1024, W + (size_t)nt * 256 * 1024, 1024, 1024, mt * 256, nt * 256, epi, nullptr, smem); };
  for_tiles_xcd(64, 10, tile);
  for (int i = (int)gridDim.x - 1 - (int)blockIdx.x; i < 2; i += gridDim.x) tile(64 + i, 9);
}
DEVI void rope_kr_fp8(const Params& p) {
  const bf16_t* KR = (const bf16_t*)(p.ws + O_KR); const float* rope = (const float*)(p.ws + O_ROPE); unsigned char* K8 = (unsigned char*)(p.ws + O_K8);
  for (int i = blockIdx.x * NTHR + threadIdx.x; i < NROW * 2; i += gridDim.x * NTHR) {
    const int row = i >> 1, which = i & 1, kr = keyrow(row), b = kr / NKEY, key = kr - b * NKEY;
    float x[32];
    const bf16_t* src = KR + (size_t)kr * 64 + which * 32;
#pragma unroll
    for (int q = 0; q < 4; ++q) unpack8(*(const u32x4*)(src + q * 8), x + q * 8);
    if (row < NTOK) { const int pos = row & 8191, pp = which ? (pos & 63) : (pos >> 6); const float* cs = rope + pp * 32;
#pragma unroll
      for (int j = 0; j < 16; ++j) { const float c = cs[j * 2], sn = cs[j * 2 + 1], x1 = x[j], x2 = x[16 + j]; x[j] = x1 * c - x2 * sn; x[16 + j] = x1 * sn + x2 * c; } }
    u32x4 o0, o1;
#pragma unroll
    for (int q = 0; q < 4; ++q) { o0[q] = (unsigned)pk4_fp8(x[q * 4], x[q * 4 + 1], x[q * 4 + 2], x[q * 4 + 3]); o1[q] = (unsigned)pk4_fp8(x[16 + q * 4], x[17 + q * 4], x[18 + q * 4], x[19 + q * 4]); }
#pragma unroll
    for (int h = 0; h < 8; ++h) { unsigned char* d = K8 + ((size_t)(b * 8 + h) * NKEY + key) * 192 + 128 + which * 32; *(u32x4*)d = o0; *(u32x4*)(d + 16) = o1; }
  }
}
DEVI void ph_mid(const Params& p, char* smem) {
  char* ws = p.ws;
  { EpiQ epi{(bf16_t*)(ws + O_RQ), (const float*)(ws + O_RSSQ)};
    const bf16_t* A = (const bf16_t*)(ws + O_CQ); const bf16_t* W = (const bf16_t*)(ws + O_WUQ);
    for_tiles_xcd(64, 12, [&](int mt, int nt) { gemm_tile<256, 128, false>(A + (size_t)mt * 256 * 256, 256, W + (size_t)nt * 128 * 256, 256, 256, mt * 256, nt * 128, epi, nullptr, smem); }); }
  { EpiK8 epi{(unsigned char*)(ws + O_K8), (const float*)(ws + O_RSSKV)};
    const bf16_t* A = (const bf16_t*)(ws + O_CKV); const bf16_t* W = (const bf16_t*)(ws + O_WUKV);
    auto tile = [&](int mt, int nt) { gemm_tile<256, 128, false>(A + (size_t)mt * 256 * 128, 128, W + (size_t)nt * 256 * 128, 128, 128, mt * 256, nt * 128, epi, nullptr, smem); };
    for_tiles_xcd(64, 8, tile);
    for (int i = blockIdx.x; i < 16; i += gridDim.x) tile(64 + (i >> 3), i & 7); }
  { EpiV8T epi{(unsigned char*)(ws + O_V8T), (const float*)(ws + O_RSSKV)};
    const bf16_t* A = (const bf16_t*)(ws + O_WUKV); const bf16_t* Bc = (const bf16_t*)(ws + O_CKV);
    for (int i = blockIdx.x; i < 8 * 132; i += gridDim.x) { const int mt = i & 7, nt = i >> 3;
      gemm_tile<128, 128, false>(A + (size_t)(mt * 256 + 128) * 128, 128, Bc + (size_t)nt * 128 * 128, 128, 128, mt * 128, nt * 128, epi, nullptr, smem); } }
  { const bf16_t* WS = (const bf16_t*)(ws + O_WS); const bf16_t* GVT = (const bf16_t*)(ws + O_RC);
    float* ksc = (float*)(smem + LDS_BYTES - 1024); const float* rssv = (const float*)(ws + O_RSSV);
    for (int i = blockIdx.x; i < 1024; i += gridDim.x) { const int chunk = i >> 3, g = i & 7;
      __syncthreads();
      if (threadIdx.x < 128) { const float* pr = rssv + (size_t)(chunk * 128 + threadIdx.x) * 32; float t = 0.f;
#pragma unroll
        for (int j = 0; j < 32; ++j) t += pr[j];
        ksc[threadIdx.x] = rsqrtf(t * (1.f / 1024.f) + EPS); }
      __syncthreads();
      EpiSgu epi{(bf16_t*)(ws + O_RB), p.g_sgu, p.b_s, chunk, g};
      gemm_tile<128, 128, false>(WS + (size_t)g * 16384, 128, GVT + ((size_t)chunk * 1024 + g * 128) * 128, 128, 128, 0, 0, epi, ksc, smem); } }
  rope_kr_fp8(p);
}
DEVI void ph_gates(const Params& p, char* smem) {
  char* ws = p.ws; EpiGate epi{(bf16_t*)(ws + O_RKV)};
  const bf16_t* HX = (const bf16_t*)(ws + O_RA); const bf16_t* W = (const bf16_t*)(ws + O_WIN) + (size_t)NPRE * 1024;
  for_tiles_xcd(64, 8, [&](int mt, int nt) { gemm_tile<256, 256, false>(HX + (size_t)mt * 256 * 1024, 1024, W + (size_t)nt * 256 * 1024, 1024, 1024, mt * 256, nt * 256, epi, nullptr, smem); });
}
DEVI void ph_merge(const Params& p, char* smem) {
  char* ws = p.ws; bf16_t* M = (bf16_t*)(ws + O_RC); const bf16_t* G = (const bf16_t*)(ws + O_RKV);
  EpiMerge<false> e1{M, G}; EpiMerge<true> e2{M, G};
  const bf16_t* OA = (const bf16_t*)(ws + O_RB); const bf16_t* OB = (const bf16_t*)(ws + O_RQ);
  const bf16_t* WA = (const bf16_t*)(ws + O_WPA); const bf16_t* WB = (const bf16_t*)(ws + O_WPB);
  for_tiles_xcd(64, 4, [&](int mt, int nt) { gemm_tile<256, 256, false>(OA + (size_t)mt * 256 * 1024, 1024, WA + (size_t)nt * 256 * 1024, 1024, 1024, mt * 256, nt * 256, e1, nullptr, smem); });
  for_tiles_xcd(64, 4, [&](int mt, int nt) { gemm_tile<256, 256, true>(OB + (size_t)mt * 256 * 1536, 1536, WB + (size_t)nt * 256 * 1024, 1024, 1024, mt * 256, nt * 256, e2, nullptr, smem); });
}
DEVI void ph_wo(const Params& p, char* smem) {
  char* ws = p.ws; EpiO epi{(bf16_t*)(ws + O_RA), (float*)(ws + O_RSSY)};
  const bf16_t* M = (const bf16_t*)(ws + O_RC); const bf16_t* W = (const bf16_t*)(ws + O_WO);
  for_tiles_xcd(64, 4, [&](int mt, int nt) { gemm_tile<256, 256, false>(M + (size_t)mt * 256 * 1024, 1024, W + (size_t)nt * 256 * 1024, 1024, 1024, mt * 256, nt * 256, epi, nullptr, smem); });
}
DEVI void ph_wpq(const Params& p, char* smem) {
  char* ws = p.ws; EpiPq epi{(bf16_t*)(ws + O_RKV)};
  const bf16_t* A = (const bf16_t*)(ws + O_RB); const bf16_t* W = (const bf16_t*)(ws + O_WPQ);
  for_tiles_xcd(64, 8, [&](int mt, int nt) { gemm_tile<256, 256, false>(A + (size_t)mt * 256 * 1024, 1024, W + (size_t)nt * 256 * 1024, 1024, 1024, mt * 256, nt * 256, epi, nullptr, smem); });
  convert_table_fp6(p.v_exp, (unsigned char*)(ws + O_RA), (float*)(ws + O_RA + (size_t)16384 * 1024));
}

namespace a8 {
constexpr int KVBLK = 64, SHM_K = KVBLK * 192, SHM_V = 128 * KVBLK;
constexpr int SHM_K2 = 2 * SHM_K, SHM_V2 = 2 * SHM_V;
constexpr float SCALE = 0.07216878364870322f, THR = 1.5f;
using i32x8 = __attribute__((ext_vector_type(8))) int;
DEVI int crow(int r, int hi) { return (r & 3) + 8 * (r >> 2) + 4 * hi; }
DEVI f32x16 mma(const i32x8& a, const i32x8& b, const f32x16& c) { return __builtin_amdgcn_mfma_scale_f32_32x32x64_f8f6f4(a, b, c, 0, 0, 0, 0x7f7f7f7f, 0, 0x7f7f7f7f); }
DEVI void partialSM(f32x16& p0, f32x16& p1, float& m_reg, float& mn, float& alpha) {
  constexpr float C = SCALE * 1.4426950408889634f;
  float pmax = p0[0];
#pragma unroll
  for (int r = 1; r < 16; ++r) pmax = fmaxf(pmax, p0[r]);
#pragma unroll
  for (int r = 0; r < 16; ++r) pmax = fmaxf(pmax, p1[r]);
  { auto rr = __builtin_amdgcn_permlane32_swap(__float_as_uint(pmax), __float_as_uint(pmax), false, false);
    pmax = fmaxf(__uint_as_float(rr[0]), __uint_as_float(rr[1])); }
  if (__builtin_expect(__all(pmax - m_reg <= THR / SCALE), 1)) { mn = m_reg; alpha = 1.f; }
  else { mn = fmaxf(m_reg, pmax); alpha = __builtin_amdgcn_exp2f((m_reg - mn) * C); m_reg = mn; }
  const float mnC = 6.f - mn * C;
#pragma unroll
  for (int r = 0; r < 16; ++r) p0[r] = fmaf(p0[r], C, mnC);
#pragma unroll
  for (int r = 0; r < 16; ++r) p1[r] = fmaf(p1[r], C, mnC);
#pragma unroll
  for (int r = 0; r < 16; ++r) p0[r] = __builtin_amdgcn_exp2f(p0[r]);
}
DEVI void finishSM(f32x16& p0, f32x16& p1, float alpha, float& l_reg, i32x8& pa) {
#pragma unroll
  for (int r = 0; r < 16; ++r) p1[r] = __builtin_amdgcn_exp2f(p1[r]);
  float ps = 0;
#pragma unroll
  for (int r = 0; r < 16; ++r) ps += p0[r];
#pragma unroll
  for (int r = 0; r < 16; ++r) ps += p1[r];
  { auto rr = __builtin_amdgcn_permlane32_swap(__float_as_uint(ps), __float_as_uint(ps), false, false);
    ps = __uint_as_float(rr[0]) + __uint_as_float(rr[1]); }
  l_reg = l_reg * alpha + ps;
#pragma unroll
  for (int j = 0; j < 4; ++j) { pa[j] = pk4_fp8(p0[4 * j], p0[4 * j + 1], p0[4 * j + 2], p0[4 * j + 3]); pa[4 + j] = pk4_fp8(p1[4 * j], p1[4 * j + 1], p1[4 * j + 2], p1[4 * j + 3]); }
}
DEVI i32x8 ld32(const char* p0, const char* p1) { const u32x4 a = *(const u32x4*)p0, b = *(const u32x4*)p1; return (i32x8){(int)a[0], (int)a[1], (int)a[2], (int)a[3], (int)b[0], (int)b[1], (int)b[2], (int)b[3]}; }
DEVI void qkt(f32x16& p0, f32x16& p1, const char* Ks, const i32x8* qf, int r32, int hi) {
  p0 = f32x16{}; p1 = f32x16{};
  const int sw = (r32 >> 2) & 3; const char* k0 = Ks + r32 * 192; const char* k1 = k0 + 32 * 192;
#pragma unroll
  for (int m = 0; m < 3; ++m) { const int c0 = ((4 * m + 2 * hi) ^ sw) << 4, c1 = ((4 * m + 2 * hi + 1) ^ sw) << 4;
    p0 = mma(ld32(k0 + c0, k0 + c1), qf[m], p0);
    p1 = mma(ld32(k1 + c0, k1 + c1), qf[m], p1); }
}
DEVI void pv(f32x16* o, const char* Vs, int tile, const i32x8& pa, int r32, int hi) {
  const int sw = (r32 >> 1) & 7, c0 = ((4 * tile + 2 * hi) ^ sw) << 4, c1 = ((4 * tile + 2 * hi + 1) ^ sw) << 4;
#pragma unroll
  for (int db = 0; db < 4; ++db) { const char* vr = Vs + (32 * db + r32) * 128; o[db] = mma(pa, ld32(vr + c0, vr + c1), o[db]); }
}
DEVI void attn_item(bf16_t* __restrict__ Qb, const unsigned char* __restrict__ Kg, const unsigned char* __restrict__ Vg, const float* __restrict__ rope, int pos0, char* lds) {
  const int tid = threadIdx.x, wid = tid >> 6, lane = tid & 63, r32 = lane & 31, hi = lane >> 5;
  char* V_lds = lds; char* K_lds = lds + 3 * SHM_V2;
  float* wsl = (float*)(lds + 3 * SHM_V2 + 3 * SHM_K2) + wid * 64; float* li_l = wsl; float* al_l = wsl + 32;
  float m_reg = -1e30f, l_reg = 0; f32x16 o[4] = {}; i32x8 qf[3];
  { const bf16_t* Qw = Qb + (size_t)(wid * 32 + r32) * 1536 + hi * 32;
#pragma unroll
    for (int m = 0; m < 3; ++m) { float x[32];
#pragma unroll
      for (int q = 0; q < 4; ++q) unpack8(*(const u32x4*)(Qw + m * 64 + q * 8), x + q * 8);
      if (m == 2) { const int pos = pos0 + wid * 32 + r32, pp = hi ? (pos & 63) : (pos >> 6); const float* cs = rope + pp * 32;
#pragma unroll
        for (int j = 0; j < 16; ++j) { const float c = cs[j * 2], sn = cs[j * 2 + 1], x1 = x[j], x2 = x[16 + j]; x[j] = x1 * c - x2 * sn; x[16 + j] = x1 * sn + x2 * c; } }
#pragma unroll
      for (int q = 0; q < 8; ++q) qf[m][q] = pk4_fp8(x[q * 4], x[q * 4 + 1], x[q * 4 + 2], x[q * 4 + 3]);
      __builtin_amdgcn_sched_barrier(0); } }
  unsigned koff[3], voff[2];
#pragma unroll
  for (int i = 0; i < 3; ++i) { const int pp = wid * 64 + lane + 512 * i, key = pp / 12, c = pp - key * 12; koff[i] = (unsigned)(key * 192 + ((c ^ ((key >> 2) & 3)) << 4)); }
#pragma unroll
  for (int i = 0; i < 2; ++i) { const int pp = wid * 64 + lane + 512 * i, d = pp >> 3, c = pp & 7; voff[i] = (unsigned)(d * NKEY + ((c ^ ((d >> 1) & 7)) << 4)); }
#define GSTAGE(s_, kb, vb) do { const unsigned char* ks = Kg + (size_t)(s_) * SHM_K2; const unsigned char* vs = Vg + (s_) * 128; \
    _Pragma("unroll") for (int i = 0; i < 3; ++i) __builtin_amdgcn_global_load_lds((const unsigned*)(ks + koff[i]), (unsigned*)(K_lds + (kb) + i * 8192 + wid * 1024), 16, 0, 0); \
    _Pragma("unroll") for (int i = 0; i < 2; ++i) __builtin_amdgcn_global_load_lds((const unsigned*)(vs + voff[i]), (unsigned*)(V_lds + (vb) + i * 8192 + wid * 1024), 16, 0, 0); } while (0)
#define SWAIT() asm volatile("s_waitcnt vmcnt(0)" ::: "memory")
#define SBAR() __builtin_amdgcn_sched_barrier(0)
#define RESC(a) do { if (__any((a) < 1.f)) { if (hi == 0) al_l[r32] = (a); asm volatile("s_waitcnt lgkmcnt(0)" ::: "memory"); \
    _Pragma("unroll") for (int d = 0; d < 4; ++d) _Pragma("unroll") for (int r = 0; r < 16; ++r) o[d][r] *= al_l[crow(r, hi)]; } } while (0)
  f32x16 pA0, pA1, pB0, pB1; float mnA, mnB, alA, alB; i32x8 pa; constexpr int NS = NKEY / 128;
  int kp = 0, kc = SHM_K2, kn = 2 * SHM_K2, vp = 0, vc = SHM_V2, vn = 2 * SHM_V2;
  GSTAGE(0, kp, vp); GSTAGE(1, kc, vc); SWAIT(); __syncthreads();
  qkt(pA0, pA1, K_lds + kp, qf, r32, hi); partialSM(pA0, pA1, m_reg, mnA, alA);
  SBAR(); qkt(pB0, pB1, K_lds + kp + SHM_K, qf, r32, hi);
  finishSM(pA0, pA1, alA, l_reg, pa); SBAR();
  pv(o, V_lds + vp, 0, pa, r32, hi); partialSM(pB0, pB1, m_reg, mnB, alB);
  RESC(alB);
  for (int s_ = 1; s_ < NS; ++s_) {
    if (s_ + 1 < NS) GSTAGE(s_ + 1, kn, vn);
    SBAR(); qkt(pA0, pA1, K_lds + kc, qf, r32, hi);
    finishSM(pB0, pB1, alB, l_reg, pa); SBAR();
    pv(o, V_lds + vp, 1, pa, r32, hi); partialSM(pA0, pA1, m_reg, mnA, alA);
    RESC(alA);
    SBAR(); qkt(pB0, pB1, K_lds + kc + SHM_K, qf, r32, hi);
    finishSM(pA0, pA1, alA, l_reg, pa); SBAR();
    pv(o, V_lds + vc, 0, pa, r32, hi); partialSM(pB0, pB1, m_reg, mnB, alB);
    SWAIT(); __syncthreads();
    RESC(alB);
    { const int tk = kp; kp = kc; kc = kn; kn = tk; const int tv = vp; vp = vc; vc = vn; vn = tv; }
  }
  finishSM(pB0, pB1, alB, l_reg, pa); SBAR();
  pv(o, V_lds + vp, 1, pa, r32, hi);
  if (hi == 0) li_l[r32] = l_reg; asm volatile("s_waitcnt lgkmcnt(0)" ::: "memory");
  float rli[16];
#pragma unroll
  for (int r = 0; r < 16; ++r) rli[r] = __builtin_amdgcn_rcpf(li_l[crow(r, hi)]);
  bf16_t* Ow = Qb + (size_t)(wid * 32) * 1536;
#pragma unroll
  for (int r = 0; r < 16; ++r) { const int orow = crow(r, hi);
#pragma unroll
    for (int d0 = 0; d0 < 4; ++d0) Ow[(size_t)orow * 1536 + d0 * 32 + r32] = f2bf(o[d0][r] * rli[r]); }
  __syncthreads();
#undef GSTAGE
#undef SWAIT
#undef SBAR
#undef RESC
}
}
DEVI void attn_fp8(const Params& p, char* smem) {
  bf16_t* Q = (bf16_t*)(p.ws + O_RQ); const unsigned char* K8 = (const unsigned char*)(p.ws + O_K8); const unsigned char* V8 = (const unsigned char*)(p.ws + O_V8T);
  const float* rope = (const float*)(p.ws + O_ROPE);
  for (int it = blockIdx.x; it < NB * 8 * (SEQ / 256); it += gridDim.x) {
    const int bh = (it >> 8) * 8 + (it & 7), qb = (it & 255) >> 3, b = bh >> 3, h = bh & 7;
    a8::attn_item(Q + (size_t)(b * SEQ + qb * 256) * 1536 + h * 192, K8 + (size_t)bh * NKEY * 192, V8 + (size_t)bh * 128 * NKEY, rope, qb * 256, smem);
  }
}
DEVI void ph_attn(const Params& p, char* smem) { attn_fp8(p, smem); }

DEVI void ph_rows(const Params& p, char* smem) {
  const int tid = threadIdx.x, wave = tid >> 6, lane = tid & 63;
  const float* MOD = (const float*)(p.ws + O_MOD); const bf16_t* Y = (const bf16_t*)(p.ws + O_RA); const float* rssy = (const float*)(p.ws + O_RSSY);
  bf16_t* HX2 = (bf16_t*)(p.ws + O_RB);
  for (int row = blockIdx.x * NWAVE + wave; row < NTOK; row += gridDim.x * NWAVE) {
    const int b = row >> 13; const float* md = MOD + b * 6144;
    float ty = 0.f; { const float* pr = rssy + (size_t)row * 32;
#pragma unroll
      for (int j = 0; j < 32; ++j) ty += pr[j]; }
    const float ry = rsqrtf(ty * (1.f / 1024.f) + EPS);
    float x1[16]; float ss = 0.f;
#pragma unroll
    for (int i = 0; i < 4; ++i) { const int c = i * 256 + lane * 4; const float4 xv = *(const float4*)(p.x + (size_t)row * 1024 + c); const u32x2 yv = *(const u32x2*)(Y + (size_t)row * 1024 + c);
      const float4 gp = *(const float4*)(p.g_post1 + c), gt = *(const float4*)(md + 2048 + c);
      x1[i * 4 + 0] = xv.x + gt.x * (lo2f(yv[0]) * ry * gp.x); x1[i * 4 + 1] = xv.y + gt.y * (hi2f(yv[0]) * ry * gp.y);
      x1[i * 4 + 2] = xv.z + gt.z * (lo2f(yv[1]) * ry * gp.z); x1[i * 4 + 3] = xv.w + gt.w * (hi2f(yv[1]) * ry * gp.w);
#pragma unroll
      for (int j = 0; j < 4; ++j) ss += x1[i * 4 + j] * x1[i * 4 + j];
      *(float4*)(p.out + (size_t)row * 1024 + c) = make_float4(x1[i * 4], x1[i * 4 + 1], x1[i * 4 + 2], x1[i * 4 + 3]); }
    ss = wave_sum(ss); const float r2 = rsqrtf(ss * (1.f / 1024.f) + EPS);
#pragma unroll
    for (int i = 0; i < 4; ++i) { const int c = i * 256 + lane * 4; const float4 g2 = *(const float4*)(p.g_pre2 + c), sc = *(const float4*)(md + 4096 + c), sh = *(const float4*)(md + 3072 + c);
      st4bf(HX2 + (size_t)row * 1024 + c, x1[i * 4] * r2 * g2.x * (1.f + sc.x) + sh.x, x1[i * 4 + 1] * r2 * g2.y * (1.f + sc.y) + sh.y,
            x1[i * 4 + 2] * r2 * g2.z * (1.f + sc.z) + sh.z, x1[i * 4 + 3] * r2 * g2.w * (1.f + sc.w) + sh.w); }
  }
  convert_table_fp6(p.u_exp, (unsigned char*)(p.ws + O_RC), (float*)(p.ws + O_RC + (size_t)16384 * 1024));
}

namespace tk {
DEVI int f2sort(float f) { const int i = __float_as_int(f); return i ^ ((i >> 31) & 0x7fffffff); }
DEVI float sort2f(int s) { return __int_as_float(s ^ ((s >> 31) & 0x7fffffff)); }
DEVI void ce_desc(int& a, int& b) { const int hi = max(a, b), lo = min(a, b); a = hi; b = lo; }
DEVI void sort16_desc(int* a) {
#pragma unroll
  for (int lk = 1; lk <= 4; ++lk)
#pragma unroll
    for (int lj = lk - 1; lj >= 0; --lj)
#pragma unroll
      for (int i = 0; i < 16; ++i) { const int j = 1 << lj, k = 1 << lk, l = i ^ j;
        if (l > i) { const int hi = max(a[i], a[l]), lo = min(a[i], a[l]); if ((i & k) == 0) { a[i] = hi; a[l] = lo; } else { a[i] = lo; a[l] = hi; } } }
}
DEVI void bitonic_merge16_desc(int* a) {
#pragma unroll
  for (int lj = 3; lj >= 0; --lj)
#pragma unroll
    for (int i = 0; i < 16; ++i) { const int l = i ^ (1 << lj); if (l > i) ce_desc(a[i], a[l]); }
}
DEVI void merge_top16(int* a, const int* b) {
#pragma unroll
  for (int i = 0; i < 16; ++i) a[i] = max(a[i], b[15 - i]);
  bitonic_merge16_desc(a);
}
DEVI void half_top16(const bf16_t* __restrict__ qrow, const char* Kl, int r32, int hi, int* out) {
  bf16x8 qf[8];
#pragma unroll
  for (int d0 = 0; d0 < 8; ++d0) qf[d0] = *reinterpret_cast<const bf16x8*>(qrow + d0 * 16 + hi * 8);
  int a[64]; const int hi4 = 4 * hi;
#pragma unroll
  for (int kt = 0; kt < 4; ++kt) { f32x16 acc = {};
    const int key = kt * 32 + r32;
#pragma unroll
    for (int d0 = 0; d0 < 8; ++d0) { const bf16x8 kf = *reinterpret_cast<const bf16x8*>(Kl + key * 256 + (((d0 * 2 + hi) ^ (key & 15)) << 4));
      acc = __builtin_amdgcn_mfma_f32_32x32x16_bf16(kf, qf[d0], acc, 0, 0, 0); }
#pragma unroll
    for (int r = 0; r < 16; ++r) { const int kc = kt * 32 + (r & 3) + 8 * (r >> 2); a[kt * 16 + r] = ((f2sort(acc[r]) & ~127) | (127 - kc)) - hi4; } }
  sort16_desc(a); sort16_desc(a + 16); sort16_desc(a + 32); sort16_desc(a + 48);
  merge_top16(a, a + 16); merge_top16(a + 32, a + 48); merge_top16(a, a + 32);
  int L[16], H[16];
#pragma unroll
  for (int i = 0; i < 16; ++i) { auto rr = __builtin_amdgcn_permlane32_swap((unsigned)a[i], (unsigned)a[i], false, false); L[i] = (int)rr[0]; H[i] = (int)rr[1]; }
  merge_top16(L, H);
#pragma unroll
  for (int i = 0; i < 16; ++i) out[i] = L[i];
}
}
DEVI void gather_token_fp6(const Params& p, int t, const int* idx, const float* gw, float* xs, const int* sig);
DEVI void fp6_sigma(int* sig);
DEVI void topk_fast(const Params& p, char* smem) {
  const int tid = threadIdx.x, wave = __builtin_amdgcn_readfirstlane(tid >> 6), lane = tid & 63, r32 = lane & 31, hi = lane >> 5;
  const bf16_t* QP = (const bf16_t*)(p.ws + O_RKV);
  char* K1l = smem; char* K2l = smem + 32768; int* tab = (int*)(smem + 65536) + wave * (32 * 33);
  int* idxl = (int*)(smem + 65536 + 8 * 32 * 33 * 4) + wave * 512; float* gwl = (float*)(smem + 65536 + 8 * 32 * 33 * 4 + 8 * 2048) + wave * 512;
  int* sigl = (int*)(smem + 65536 + 8 * 32 * 33 * 4 + 16 * 2048) + wave * 32;
  fp6_sigma(sigl);
  __syncthreads();
  { const bf16_t* K1 = (const bf16_t*)(p.ws + O_K1);
    for (int id = tid; id < 4096; id += NTHR) { const int key = id >> 4, c = id & 15; const u32x4 v = *(const u32x4*)(K1 + (size_t)key * 128 + c * 8);
      *(u32x4*)(smem + key * 256 + ((c ^ (key & 15)) << 4)) = v; } }
  __syncthreads();
  for (int item = blockIdx.x; item < NTOK * 8 / 256; item += gridDim.x) {
    const int row = item * 256 + wave * 32 + r32;
    const bf16_t* qrow = QP + (size_t)row * 256;
    int t1[16], t2[16];
    tk::half_top16(qrow, K1l, r32, hi, t1);
    __builtin_amdgcn_sched_barrier(0);
    tk::half_top16(qrow + 128, K2l, r32, hi, t2);
    __builtin_amdgcn_sched_barrier(0);
    float v1[16], v2[16];
#pragma unroll
    for (int i = 0; i < 16; ++i) { v1[i] = tk::sort2f(t1[i] & ~127); v2[i] = tk::sort2f(t2[i] & ~127); }
    if (hi == 0) {
#pragma unroll
      for (int i = 0; i < 16; ++i) { tab[r32 * 33 + i] = 127 - (t1[i] & 127); tab[r32 * 33 + 16 + i] = 127 - (t2[i] & 127); } }
#define CAND(i, j) ((tk::f2sort(v1[i] + v2[j]) & ~255) | (255 - ((i) * 16 + (j))))
    int g0[16], g1[16], g2[16];
#pragma unroll
    for (int j = 0; j < 16; ++j) g0[j] = CAND(0, j);
#pragma unroll
    for (int j = 0; j < 8; ++j) g1[j] = CAND(1, j);
#pragma unroll
    for (int j = 0; j < 5; ++j) g1[8 + j] = CAND(2, j);
#pragma unroll
    for (int j = 0; j < 3; ++j) g1[13 + j] = CAND(4, j);
#pragma unroll
    for (int j = 0; j < 4; ++j) g2[j] = CAND(3, j);
    g2[4] = CAND(5, 0); g2[5] = CAND(5, 1); g2[6] = CAND(6, 0); g2[7] = CAND(6, 1); g2[8] = CAND(7, 0); g2[9] = CAND(7, 1);
    g2[10] = CAND(8, 0); g2[11] = CAND(9, 0); g2[12] = CAND(10, 0); g2[13] = CAND(11, 0); g2[14] = CAND(12, 0); g2[15] = CAND(13, 0);
    tk::sort16_desc(g1); tk::sort16_desc(g2);
    tk::merge_top16(g0, g1); tk::merge_top16(g0, g2);
    { int x = CAND(14, 0);
#pragma unroll
      for (int i = 0; i < 16; ++i) { const int h = max(g0[i], x); x = min(g0[i], x); g0[i] = h; }
      x = CAND(15, 0);
#pragma unroll
      for (int i = 0; i < 16; ++i) { const int h = max(g0[i], x); x = min(g0[i], x); g0[i] = h; } }
#undef CAND
    asm volatile("s_waitcnt lgkmcnt(0)" ::: "memory");
    if (hi == 0) {
      int ex[16];
#pragma unroll
      for (int k = 0; k < 16; ++k) { const int pos = 255 - (g0[k] & 255); ex[k] = tab[r32 * 33 + (pos >> 4)] * 128 + tab[r32 * 33 + 16 + (pos & 15)]; }
      int* dst = idxl + r32 * 16;
#pragma unroll
      for (int q = 0; q < 4; ++q) *(int4*)(dst + q * 4) = make_int4(ex[q * 4], ex[q * 4 + 1], ex[q * 4 + 2], ex[q * 4 + 3]);
    } else {
      float e[16]; const float vmax = tk::sort2f(g0[0] & ~255); float sum = 0.f;
#pragma unroll
      for (int k = 0; k < 16; ++k) { e[k] = __expf(tk::sort2f(g0[k] & ~255) - vmax); sum += e[k]; }
      const float inv = 1.f / sum; float* dst = gwl + r32 * 16;
#pragma unroll
      for (int q = 0; q < 4; ++q) *(float4*)(dst + q * 4) = make_float4(e[q * 4] * inv, e[q * 4 + 1] * inv, e[q * 4 + 2] * inv, e[q * 4 + 3] * inv);
    }
    asm volatile("s_waitcnt lgkmcnt(0)" ::: "memory"); __builtin_amdgcn_sched_barrier(0);
#pragma unroll 1
    for (int tl = 0; tl < 4; ++tl) gather_token_fp6(p, item * 32 + wave * 4 + tl, idxl + tl * 128, gwl + tl * 128, (float*)tab, sigl);
    asm volatile("s_waitcnt lgkmcnt(0)" ::: "memory"); __builtin_amdgcn_sched_barrier(0);
  }
}
DEVI void ph_topk(const Params& p, char* smem) { topk_fast(p, smem); }

DEVI void fp6_sigma(int* sig) {
  f32x16 ra, rb;
#pragma unroll
  for (int i = 0; i < 16; ++i) { ra[i] = i < 8 ? i * 0.125f : 1.f + (i - 8) * 0.125f; rb[i] = i < 8 ? 2.f + i * 0.25f : 4.f + (i - 8) * 0.5f; }
  const u32x6 w = __builtin_amdgcn_cvt_scalef32_2xpk16_fp6_f32(ra, rb, 1.0f);
  const f32x32 d = __builtin_amdgcn_cvt_scalef32_pk32_f32_fp6(w, 1.0f);
  if ((threadIdx.x & 63) == 0) {
#pragma unroll
    for (int i = 0; i < 32; ++i) { const float v = d[i]; sig[i] = v < 1.f ? (int)(v * 8.f + 0.5f) : v < 2.f ? 8 + (int)((v - 1.f) * 8.f + 0.5f) : v < 4.f ? 16 + (int)((v - 2.f) * 4.f + 0.5f) : 24 + (int)((v - 4.f) * 2.f + 0.5f); } }
}
constexpr int G6 = 4;
DEVI void gather_token_fp6(const Params& p, int t, const int* idx, const float* gw, float* xs, const int* sig) {
  int lane = threadIdx.x & 63; asm volatile("" : "+v"(lane));
  const int h = lane >> 5, g = lane & 31;
  const bf16_t* HX2 = (const bf16_t*)(p.ws + O_RB);
  const unsigned char* UT = (const unsigned char*)(p.ws + O_RC); const float* SU = (const float*)(p.ws + O_RC + (size_t)16384 * 1024);
  const unsigned char* VT = (const unsigned char*)(p.ws + O_RA); const float* SV = (const float*)(p.ws + O_RA + (size_t)16384 * 1024);
  const float* MOD = (const float*)(p.ws + O_MOD);
  if (h == 0) { float xf[32];
#pragma unroll
    for (int q = 0; q < 4; ++q) unpack8(*(const u32x4*)(HX2 + (size_t)t * 1024 + g * 32 + q * 8), xf + q * 8);
#pragma unroll
    for (int j = 0; j < 32; ++j) xs[j * 32 + g] = xf[j]; }
  asm volatile("s_waitcnt lgkmcnt(0)" ::: "memory"); __builtin_amdgcn_sched_barrier(0);
  float xp[32], acc[32];
#pragma unroll
  for (int i = 0; i < 32; ++i) { xp[i] = xs[sig[i] * 32 + g]; acc[i] = 0.f; }
#pragma unroll 1
  for (int half = 0; half < 2; ++half) {
    const int my_i = idx[half * 64 + lane]; const float my_g = gw[half * 64 + lane];
    const float my_su = SU[my_i], my_sv = SV[my_i];
#pragma unroll 1
    for (int e0 = 0; e0 < 64; e0 += 2 * G6) {
      u32x6 uq[G6], vq[G6]; float cs[G6];
#pragma unroll
      for (int j = 0; j < G6; ++j) { const int ia = __builtin_amdgcn_readlane(my_i, e0 + 2 * j), ib = __builtin_amdgcn_readlane(my_i, e0 + 2 * j + 1); const int id = h ? ib : ia;
        const unsigned char* up = UT + (size_t)id * 768 + g * 24; const unsigned char* vp = VT + (size_t)id * 768 + g * 24;
        const u32x4 u0 = *(const u32x4_u*)up; const u32x2 u1 = *(const u32x2_u*)(up + 16); const u32x4 v0 = *(const u32x4_u*)vp; const u32x2 v1 = *(const u32x2_u*)(vp + 16);
        uq[j] = (u32x6){u0[0], u0[1], u0[2], u0[3], u1[0], u1[1]}; vq[j] = (u32x6){v0[0], v0[1], v0[2], v0[3], v1[0], v1[1]}; }
#pragma unroll
      for (int j = 0; j < G6; ++j) { const f32x32 uf = __builtin_amdgcn_cvt_scalef32_pk32_f32_fp6(uq[j], 1.0f); float d = 0.f;
#pragma unroll
        for (int k = 0; k < 32; ++k) d += xp[k] * uf[k];
        cs[j] = d; __builtin_amdgcn_sched_barrier(0); }
#pragma unroll
      for (int j = 0; j < G6; ++j) { float v = cs[j];
        v += __builtin_bit_cast(float, __builtin_amdgcn_update_dpp(0, __builtin_bit_cast(int, v), 0xB1, 0xf, 0xf, true));
        v += __builtin_bit_cast(float, __builtin_amdgcn_update_dpp(0, __builtin_bit_cast(int, v), 0x4E, 0xf, 0xf, true));
        v += __builtin_bit_cast(float, __builtin_amdgcn_update_dpp(0, __builtin_bit_cast(int, v), 0x141, 0xf, 0xf, true));
        v += __builtin_bit_cast(float, __builtin_amdgcn_update_dpp(0, __builtin_bit_cast(int, v), 0x140, 0xf, 0xf, true));
        const int iv = __builtin_bit_cast(int, v);
        const float s0 = __builtin_bit_cast(float, __builtin_amdgcn_readlane(iv, 0)) + __builtin_bit_cast(float, __builtin_amdgcn_readlane(iv, 16));
        const float s1 = __builtin_bit_cast(float, __builtin_amdgcn_readlane(iv, 32)) + __builtin_bit_cast(float, __builtin_amdgcn_readlane(iv, 48));
        const int ea = e0 + 2 * j, eb = ea + 1;
        const float ga = __builtin_bit_cast(float, __builtin_amdgcn_readlane(__builtin_bit_cast(int, my_g), ea)), gb = __builtin_bit_cast(float, __builtin_amdgcn_readlane(__builtin_bit_cast(int, my_g), eb));
        const float sua = __builtin_bit_cast(float, __builtin_amdgcn_readlane(__builtin_bit_cast(int, my_su), ea)), sub = __builtin_bit_cast(float, __builtin_amdgcn_readlane(__builtin_bit_cast(int, my_su), eb));
        const float sva = __builtin_bit_cast(float, __builtin_amdgcn_readlane(__builtin_bit_cast(int, my_sv), ea)), svb = __builtin_bit_cast(float, __builtin_amdgcn_readlane(__builtin_bit_cast(int, my_sv), eb));
        const float ca = ga * gelu_t(s0 * sua) * sva, cb = gb * gelu_t(s1 * sub) * svb;
        cs[j] = h ? cb : ca; }
#pragma unroll
      for (int j = 0; j < G6; ++j) { const f32x32 vf = __builtin_amdgcn_cvt_scalef32_pk32_f32_fp6(vq[j], 1.0f);
#pragma unroll
        for (int k = 0; k < 32; ++k) acc[k] += cs[j] * vf[k];
        __builtin_amdgcn_sched_barrier(0); }
    }
  }
#pragma unroll
  for (int i = 0; i < 32; ++i) { auto rr = __builtin_amdgcn_permlane32_swap(__float_as_uint(acc[i]), __float_as_uint(acc[i]), false, false); acc[i] = __uint_as_float(rr[0]) + __uint_as_float(rr[1]); }
  if (h == 0) {
#pragma unroll
    for (int i = 0; i < 32; ++i) xs[sig[i] * 32 + g] = acc[i]; }
  asm volatile("s_waitcnt lgkmcnt(0)" ::: "memory"); __builtin_amdgcn_sched_barrier(0);
  float o[16]; float ss = 0.f;
#pragma unroll
  for (int j = 0; j < 16; ++j) { o[j] = xs[(16 * h + j) * 32 + g]; ss += o[j] * o[j]; }
  ss = wave_sum(ss); const float rstd = rsqrtf(ss * (1.f / 1024.f) + EPS);
  const int b = t >> 13, c0 = g * 32 + h * 16; const float* gt2 = MOD + b * 6144 + 5120 + c0;
  float* op = p.out + (size_t)t * 1024 + c0;
#pragma unroll
  for (int q4 = 0; q4 < 4; ++q4) { float4 xv = *(const float4*)(op + q4 * 4); const float4 gt = *(const float4*)(gt2 + q4 * 4), gp = *(const float4*)(p.g_post2 + c0 + q4 * 4);
    xv.x += gt.x * (o[q4 * 4 + 0] * rstd * gp.x); xv.y += gt.y * (o[q4 * 4 + 1] * rstd * gp.y);
    xv.z += gt.z * (o[q4 * 4 + 2] * rstd * gp.z); xv.w += gt.w * (o[q4 * 4 + 3] * rstd * gp.w);
    *(float4*)(op + q4 * 4) = xv; }
  asm volatile("s_waitcnt lgkmcnt(0)" ::: "memory"); __builtin_amdgcn_sched_barrier(0);
}

#define XB_TMO      128
#define XB_XCNT(j)  (256  + 64 * (j))
#define XB_XSUB(j)  (1280 + 64 * (j))
#define XB_XGEN(j)  (2304 + 64 * (j))
#define XB_TOP      3328
#define XB_TOPGEN   3392
#define XCD_BAR_WORDS 3456
#define XB_SPIN_CAP (1u << 18)
#define LAS __attribute__((address_space(3)))
DEVI unsigned xb_ld(unsigned* p)              { return __hip_atomic_load(p, __ATOMIC_RELAXED, __HIP_MEMORY_SCOPE_AGENT); }
DEVI unsigned xb_add(unsigned* p, unsigned v) { return __hip_atomic_fetch_add(p, v, __ATOMIC_RELAXED, __HIP_MEMORY_SCOPE_AGENT); }
DEVI unsigned xb_xcc_id() { return (unsigned)__builtin_amdgcn_s_getreg((3 << 11) | 20) & 0xFu; }
#define XB_SPIN(cond, bar) do { unsigned _sp = 0; while (cond) { __builtin_amdgcn_s_sleep(1); \
    if ((++_sp & 255u) == 0u) { if (xb_ld(&(bar)[XB_TMO])) break; if (_sp > XB_SPIN_CAP) { atomicAdd(&(bar)[XB_TMO], 1u); break; } } } } while (0)
struct XcdBarrier { unsigned* bar; unsigned x; volatile LAS unsigned* st; };
DEVI XcdBarrier xcd_barrier_post(unsigned* bar, volatile LAS unsigned* st) {
  XcdBarrier b; b.bar = bar; b.x = xb_xcc_id(); b.st = st;
  if (threadIdx.x == 0) (void)xb_add(&bar[XB_XCNT(b.x)], 1u);
  return b;
}
DEVI void xcd_barrier_complete(unsigned* bar, unsigned x, unsigned& nloc, unsigned& nx) {
  const unsigned G = gridDim.x * gridDim.y * gridDim.z;
  unsigned sum, cnt, mine, sp = 0u;
  for (;;) {
    sum = 0u; cnt = 0u; mine = 0u;
#pragma unroll
    for (unsigned j = 0; j < 16; ++j) { const unsigned c = xb_ld(&bar[XB_XCNT(j)]); sum += c; cnt += (c > 0u) ? 1u : 0u; mine = (j == x) ? c : mine; }
    if (sum == G) break;
    __builtin_amdgcn_s_sleep(1);
    if ((++sp & 255u) == 0u) { if (xb_ld(&bar[XB_TMO])) break; if (sp > XB_SPIN_CAP) { atomicAdd(&bar[XB_TMO], 1u); break; } }
  }
  nloc = mine > 0u ? mine : 1u; nx = cnt > 0u ? cnt : 1u;
}
DEVI void xcd_barrier(const XcdBarrier& b) {
  asm volatile("s_waitcnt vmcnt(0)" ::: "memory");
  __syncthreads();
  if (threadIdx.x == 0) {
    unsigned* bar = b.bar;
    __builtin_amdgcn_s_waitcnt(0);
    unsigned nloc = b.st[0], nx = b.st[1];
    if (nloc == 0u) { xcd_barrier_complete(bar, b.x, nloc, nx); b.st[0] = nloc; b.st[1] = nx; }
    const unsigned old = xb_add(&bar[XB_XSUB(b.x)], 1u);
    const unsigned gen = old / nloc;
    if (old + 1u == (gen + 1u) * nloc) {
      __builtin_amdgcn_fence(__ATOMIC_RELEASE, "agent");
      asm volatile("s_waitcnt vmcnt(0)" ::: "memory");
      const unsigned og = xb_add(&bar[XB_TOP], 1u);
      const unsigned tg = og / nx;
      if (og + 1u == (tg + 1u) * nx) xb_add(&bar[XB_TOPGEN], 1u);
      else XB_SPIN(xb_ld(&bar[XB_TOPGEN]) == tg, bar);
      __builtin_amdgcn_fence(__ATOMIC_ACQUIRE, "agent");
      xb_add(&bar[XB_XGEN(b.x)], 1u);
      asm volatile("s_waitcnt vmcnt(0)" ::: "memory");
    } else {
      XB_SPIN(xb_ld(&bar[XB_XGEN(b.x)]) == gen, bar);
      __builtin_amdgcn_fence(__ATOMIC_ACQUIRE, "agent");
      asm volatile("s_waitcnt vmcnt(0)" ::: "memory");
    }
  }
  __syncthreads();
}

constexpr int NPHASE = 11;
template <int PH> DEVI void run_phase(const Params& p, char* smem) {
  if constexpr (PH == 0) ph_prep(p, smem);
  else if constexpr (PH == 1) ph_hx(p, smem);
  else if constexpr (PH == 2) ph_inproj(p, smem);
  else if constexpr (PH == 3) ph_mid(p, smem);
  else if constexpr (PH == 4) ph_attn(p, smem);
  else if constexpr (PH == 5) ph_gates(p, smem);
  else if constexpr (PH == 6) ph_merge(p, smem);
  else if constexpr (PH == 7) ph_wo(p, smem);
  else if constexpr (PH == 8) ph_rows(p, smem);
  else if constexpr (PH == 9) ph_wpq(p, smem);
  else if constexpr (PH == 10) ph_topk(p, smem);
}

#ifndef PROBE_PH
#define PROBE_PH -1
#endif
#define RUNPH(N) do { if (PROBE_PH == N) t0 = __builtin_amdgcn_s_memrealtime(); run_phase<N>(p, smem); if (N < NPHASE - 1) xcd_barrier(xb); \
    if (PROBE_PH == N) t1 = __builtin_amdgcn_s_memrealtime(); } while (0)
__global__ __launch_bounds__(NTHR) void k_mega(Params p) {
  extern __shared__ __attribute__((aligned(16))) char smem[];
  cg::grid_group grid = cg::this_grid();
  unsigned long long t0 = 0, t1 = 0;
  unsigned* bar = (unsigned*)(p.ws + O_BAR);
  volatile LAS unsigned* xst = (volatile LAS unsigned*)(smem + LDS_BYTES - 16);
  if (threadIdx.x == 0) { xst[0] = 0u; xst[1] = 0u; }
  __syncthreads();
  const XcdBarrier xb = xcd_barrier_post(bar, xst);
  if (p.out == nullptr) grid.sync();
  RUNPH(0);
  RUNPH(1); RUNPH(2); RUNPH(3); RUNPH(4); RUNPH(5); RUNPH(6); RUNPH(7); RUNPH(8); RUNPH(9); RUNPH(10);
  if (PROBE_PH >= 0) { __syncthreads(); if (blockIdx.x == 0 && threadIdx.x == 0) p.out[0] += exp2f(rintf(log2f((float)(t1 - t0) * 1e-3f) * 5.f) * 0.2f); }
}

extern "C" void kernel_launch(void* const* d_in, const int* in_sizes, int n_in, void* d_out, int out_size, void* d_ws, size_t ws_size, hipStream_t stream) {
  static int grid = 0;
  if (grid == 0) {
    if (n_in != 26 || out_size != NTOK * DM || ws_size < O_END) { fprintf(stderr, "kernel_launch: unexpected shapes n_in %d out %d ws %zu (need %zu)\n", n_in, out_size, ws_size, (size_t)O_END); grid = -1; return; }
    (void)hipFuncSetAttribute((const void*)k_mega, hipFuncAttributeMaxDynamicSharedMemorySize, LDS_BYTES);
    int dev = 0, cus = 0, per_cu = 0; (void)hipGetDevice(&dev); (void)hipDeviceGetAttribute(&cus, hipDeviceAttributeMultiprocessorCount, dev);
    (void)hipOccupancyMaxActiveBlocksPerMultiprocessor(&per_cu, (const void*)k_mega, NTHR, LDS_BYTES);
    if (per_cu < 1) { fprintf(stderr, "kernel_launch: occupancy query says %d blocks per CU\n", per_cu); grid = -1; return; }
    grid = cus;
  }
  if (grid < 0) return;
  Params p{};
  const float** pp = (const float**)&p;
  for (int i = 0; i < 26; ++i) pp[i] = (const float*)d_in[i];
  p.out = (float*)d_out; p.ws = (char*)d_ws;
  (void)hipMemsetAsync((char*)d_ws + O_BAR, 0, (size_t)XCD_BAR_WORDS * 4, stream);
  void* args[] = {&p};
  hipError_t e = hipLaunchCooperativeKernel((const void*)k_mega, dim3(grid), dim3(NTHR), args, LDS_BYTES, stream);
  if (e != hipSuccess) fprintf(stderr, "cooperative launch failed: %s (grid %d)\n", hipGetErrorString(e), grid);
}
```

```cpp
#include <hip/hip_runtime.h>
#include <hip/hip_cooperative_groups.h>
#include <cstdint>
#include <cstdio>
namespace cg = cooperative_groups;

#define DEVI __device__ __forceinline__
typedef unsigned short bf16_t;
using bf16x8 = __attribute__((ext_vector_type(8))) short;
using bf16x4 = __attribute__((ext_vector_type(4))) short;
using f32x4  = __attribute__((ext_vector_type(4))) float;
using f32x16 = __attribute__((ext_vector_type(16))) float;
using u32x4  = __attribute__((ext_vector_type(4))) unsigned;
using u32x2  = __attribute__((ext_vector_type(2))) unsigned;

constexpr int DM = 1024, NB = 2, SEQ = 8192, NTOK = NB * SEQ, CTXL = 256, NCTX = NB * CTXL, NROW = NTOK + NCTX, NKEY = SEQ + CTXL;
constexpr int INW = 4544, INWP = 4608;
constexpr int NPRE = 2560;
constexpr float EPS = 1e-6f;
constexpr int NTHR = 512, NWAVE = 8;
constexpr int LDS_BYTES = 147456;

constexpr size_t al256(size_t x) { return (x + 255) / 256 * 256; }
constexpr size_t O_WIN   = 0;
constexpr size_t O_WUQ   = O_WIN  + al256((size_t)INWP * 1024 * 2);
constexpr size_t O_WUKV  = O_WUQ  + al256((size_t)1536 * 256 * 2);
constexpr size_t O_WPA   = O_WUKV + al256((size_t)2048 * 128 * 2);
constexpr size_t O_WPB   = O_WPA  + al256((size_t)1024 * 1024 * 2);
constexpr size_t O_WO    = O_WPB  + al256((size_t)1024 * 1024 * 2);
constexpr size_t O_WPQ   = O_WO   + al256((size_t)1024 * 1024 * 2);
constexpr size_t O_WS    = O_WPQ  + al256((size_t)2048 * 1024 * 2);
constexpr size_t O_K1    = O_WS   + al256((size_t)8 * 128 * 128 * 2);
constexpr size_t O_K2    = O_K1   + al256((size_t)128 * 128 * 2);
constexpr size_t O_MOD   = O_K2   + al256((size_t)128 * 128 * 2);
constexpr size_t O_ROPE  = O_MOD  + al256((size_t)3 * 6144 * 4);
constexpr size_t O_BAR   = O_ROPE + al256((size_t)128 * 16 * 2 * 4);
constexpr size_t O_RSSV  = O_BAR + al256((size_t)3456 * 4);
constexpr size_t O_RSSQ  = O_RSSV + (size_t)NTOK * 32 * 4;
constexpr size_t O_RSSKV = O_RSSQ + (size_t)NTOK * 8 * 4;
constexpr size_t O_RSSY  = O_RSSKV + (size_t)NROW * 4 * 4;
constexpr size_t O_RSSEND = O_RSSY + (size_t)NTOK * 32 * 4;
constexpr size_t O_RA    = al256(O_RSSEND);
constexpr size_t O_RB    = O_RA  + al256((size_t)NROW * 1024 * 2);
constexpr size_t O_RC    = O_RB  + al256((size_t)NTOK * 1024 * 2);
constexpr size_t O_CQ    = O_RC  + al256((size_t)NTOK * 1024 * 2);
constexpr size_t O_CKV   = O_CQ  + al256((size_t)NTOK * 256 * 2);
constexpr size_t O_KR    = O_CKV + al256((size_t)NROW * 128 * 2);
constexpr size_t O_RQ    = O_KR  + al256((size_t)NROW * 64 * 2);
constexpr size_t O_RKV   = O_RQ  + al256((size_t)NTOK * 1536 * 2);
constexpr size_t O_END   = O_RKV + al256((size_t)NROW * 2048 * 2);
static_assert(O_END <= (size_t)258 * 1024 * 1024, "workspace too large");

struct Params {
  const float *x, *c, *ctx, *c_ctx, *w_mod, *b_mod, *g_pre1, *g_post1, *g_pre2, *g_post2, *w_in, *g_q, *g_kv, *w_uq, *w_ukv, *g_sgu, *w_s, *b_s,
      *w_pa, *w_pb, *w_o, *w_pq, *k1, *k2, *u_exp, *v_exp;
  float* out; char* ws;
};

DEVI float bf2f(unsigned short h) { return __uint_as_float(((unsigned)h) << 16); }
DEVI unsigned short f2bf(float f) { unsigned u = __float_as_uint(f); u += 0x7fffu + ((u >> 16) & 1u); return (unsigned short)(u >> 16); }
DEVI unsigned pack2(float a, float b) { return (unsigned)f2bf(a) | ((unsigned)f2bf(b) << 16); }
DEVI float lo2f(unsigned w) { return __uint_as_float(w << 16); }
DEVI float hi2f(unsigned w) { return __uint_as_float(w & 0xffff0000u); }
DEVI void unpack8(const u32x4& w, float* f) {
  f[0] = lo2f(w[0]); f[1] = hi2f(w[0]); f[2] = lo2f(w[1]); f[3] = hi2f(w[1]); f[4] = lo2f(w[2]); f[5] = hi2f(w[2]); f[6] = lo2f(w[3]); f[7] = hi2f(w[3]);
}
DEVI float gelu_t(float x) { float z = 0.7978845608028654f * (x + 0.044715f * x * x * x); return x / (1.f + __expf(-2.f * z)); }
DEVI float sigmoidf_(float x) { return 1.f / (1.f + __expf(-x)); }
DEVI float wave_sum(float v) { for (int o = 32; o > 0; o >>= 1) v += __shfl_xor(v, o); return v; }
DEVI float wave_max(float v) { for (int o = 32; o > 0; o >>= 1) v = fmaxf(v, __shfl_xor(v, o)); return v; }
DEVI int keyrow(int row) { if (row < NTOK) return (row >> 13) * NKEY + (row & 8191); int c = row - NTOK; return (c >> 8) * NKEY + SEQ + (c & 255); }

__device__ const float ROPE_FREQ[16] = {1.0f, 0.5623413324356079f, 0.3162277638912201f, 0.17782793939113617f, 0.10000000149011612f, 0.05623413249850273f, 0.03162277489900589f, 0.017782794311642647f, 0.009999999776482582f, 0.005623413249850273f, 0.003162277629598975f, 0.0017782794311642647f, 0.0010000000474974513f, 0.000562341301701963f, 0.0003162277571391314f, 0.00017782794020604342f};
DEVI void sincos_small(double a, double& cs, double& sn) {
  const double k = rint(a * 0.15915494309189535); const double r = fma(-k, 6.283185307179586, a) - k * 2.4492935982947064e-16;
  const double r2 = r * r; double s = 0.0, c = 0.0;
#pragma unroll
  for (int n = 12; n >= 1; --n) { s = (1.0 - s * r2 / (double)((2 * n) * (2 * n + 1))); c = (1.0 - c * r2 / (double)((2 * n - 1) * (2 * n))); }
  sn = r * s; cs = c;
}

DEVI void transpose_job(const float* __restrict__ src, int K, int N, bf16_t* __restrict__ dst, const float* __restrict__ gk, bool isWin, int ntiles, char* smem) {
  const int tid = threadIdx.x; bf16_t* tl = (bf16_t*)smem; const int kt = K / 64;
  for (int idx = blockIdx.x; idx < ntiles; idx += gridDim.x) {
    const int ktile = idx % kt, ntile = idx / kt, k0 = ktile * 64, n0d = ntile * 64;
    int n0s = n0d; bool zero = false;
    if (isWin) { if (n0d == 2496) zero = true; else if (n0d >= 2560) n0s = n0d - 64; }
    { const int kk = tid >> 3, nn8 = (tid & 7) * 8; f32x4 va = {0.f, 0.f, 0.f, 0.f}, vb = va;
      if (!zero) { const float* s = src + (size_t)(k0 + kk) * N + n0s + nn8; const float4 a = *(const float4*)s, b = *(const float4*)(s + 4);
        const float sc = gk ? gk[k0 + kk] : 1.f; va = (f32x4){a.x, a.y, a.z, a.w} * sc; vb = (f32x4){b.x, b.y, b.z, b.w} * sc; }
      bf16_t* tp = tl + nn8 * 72 + kk;
      tp[0] = f2bf(va[0]); tp[72] = f2bf(va[1]); tp[144] = f2bf(va[2]); tp[216] = f2bf(va[3]); tp[288] = f2bf(vb[0]); tp[360] = f2bf(vb[1]); tp[432] = f2bf(vb[2]); tp[504] = f2bf(vb[3]); }
    __syncthreads();
    { const int nn = tid >> 3, kk8 = (tid & 7) * 8;
      const u32x4 o = *(const u32x4*)(tl + nn * 72 + kk8);
      *(u32x4*)(dst + (size_t)(n0d + nn) * K + k0 + kk8) = o; }
    __syncthreads();
  }
}

DEVI void ph_prep(const Params& p, char* smem) {
  const int tid = threadIdx.x, bid = blockIdx.x, nb = gridDim.x;
  char* ws = p.ws;
  if (bid == 0) { float* rope = (float*)(ws + O_ROPE);
    for (int i = tid; i < 128 * 16; i += NTHR) { const int pos = i >> 4, f = i & 15; const float ang = (float)pos * ROPE_FREQ[f];
      double cs, sn; sincos_small((double)ang, cs, sn); rope[i * 2] = (float)cs; rope[i * 2 + 1] = (float)sn; } }
  { float* red = (float*)smem; float* MOD = (float*)(ws + O_MOD);
    for (int it = bid; it < 256; it += nb) {
      const int cgp = tid % 6, kg = tid / 6;
      f32x4 a0 = {0.f, 0.f, 0.f, 0.f}, a1 = a0, a2 = a0;
      if (tid < 510) {
        for (int k = kg; k < 1024; k += 85) {
          const float4 w4 = *(const float4*)(p.w_mod + (size_t)k * 6144 + it * 24 + cgp * 4);
          const f32x4 w = {w4.x, w4.y, w4.z, w4.w};
          const float c0 = p.c[k], c1 = p.c[1024 + k], c2 = p.c_ctx[k];
          a0 += w * (c0 / (1.f + __expf(-c0))); a1 += w * (c1 / (1.f + __expf(-c1))); a2 += w * (c2 / (1.f + __expf(-c2)));
        }
        float* rp = red + kg * 72 + cgp * 4;
        rp[0] = a0[0]; rp[1] = a0[1]; rp[2] = a0[2]; rp[3] = a0[3];
        rp[24] = a1[0]; rp[25] = a1[1]; rp[26] = a1[2]; rp[27] = a1[3];
        rp[48] = a2[0]; rp[49] = a2[1]; rp[50] = a2[2]; rp[51] = a2[3];
      }
      __syncthreads();
      if (tid < 72) { float s = 0.f; for (int g = 0; g < 85; ++g) s += red[g * 72 + tid]; int r = tid / 24, n = it * 24 + tid % 24; MOD[r * 6144 + n] = s + p.b_mod[n]; }
      __syncthreads();
    } }
  transpose_job(p.w_in,  1024, INW,  (bf16_t*)(ws + O_WIN),  nullptr, true,  1152, smem);
  transpose_job(p.w_uq,  256,  1536, (bf16_t*)(ws + O_WUQ),  p.g_q,   false, 96,   smem);
  transpose_job(p.w_ukv, 128,  2048, (bf16_t*)(ws + O_WUKV), p.g_kv,  false, 64,   smem);
  transpose_job(p.w_pa,  1024, 1024, (bf16_t*)(ws + O_WPA),  nullptr, false, 256,  smem);
  transpose_job(p.w_pb,  1024, 1024, (bf16_t*)(ws + O_WPB),  nullptr, false, 256,  smem);
  transpose_job(p.w_o,   1024, 1024, (bf16_t*)(ws + O_WO),   nullptr, false, 256,  smem);
  transpose_job(p.w_pq,  1024, 2048, (bf16_t*)(ws + O_WPQ),  nullptr, false, 512,  smem);
  { const int n8 = (131072 + 16384 + 16384) / 8;
    for (int i = bid * NTHR + tid; i < n8; i += nb * NTHR) {
      int e = i * 8; const float* s; bf16_t* d;
      if (e < 131072) { s = p.w_s + e; d = (bf16_t*)(ws + O_WS) + e; }
      else if (e < 131072 + 16384) { s = p.k1 + (e - 131072); d = (bf16_t*)(ws + O_K1) + (e - 131072); }
      else { s = p.k2 + (e - 131072 - 16384); d = (bf16_t*)(ws + O_K2) + (e - 131072 - 16384); }
      const float4 a = *(const float4*)s, b = *(const float4*)(s + 4);
      u32x4 o = {pack2(a.x, a.y), pack2(a.z, a.w), pack2(b.x, b.y), pack2(b.z, b.w)};
      *(u32x4*)d = o;
    } }
}


using f32x32 = __attribute__((ext_vector_type(32))) float;
using u32x6 = __attribute__((ext_vector_type(6))) unsigned;
typedef u32x4 __attribute__((aligned(4))) u32x4_u;
typedef u32x2 __attribute__((aligned(4))) u32x2_u;
DEVI void convert_table_fp6(const float* __restrict__ src, unsigned char* __restrict__ dst, float* __restrict__ scale) {
  const int wave = threadIdx.x >> 6, lane = threadIdx.x & 63, h = lane >> 5, g = lane & 31;
  for (int rp = blockIdx.x * NWAVE + wave; rp < 8192; rp += gridDim.x * NWAVE) {
    const int row = rp * 2 + h;
    const float* sp = src + (size_t)row * 1024 + g * 32;
    f32x16 a, b; float am = 0.f;
#pragma unroll
    for (int j = 0; j < 4; ++j) { const float4 t = *(const float4*)(sp + j * 4), u = *(const float4*)(sp + 16 + j * 4);
      a[j * 4] = t.x; a[j * 4 + 1] = t.y; a[j * 4 + 2] = t.z; a[j * 4 + 3] = t.w; b[j * 4] = u.x; b[j * 4 + 1] = u.y; b[j * 4 + 2] = u.z; b[j * 4 + 3] = u.w;
      am = fmaxf(am, fmaxf(fmaxf(fmaxf(fabsf(t.x), fabsf(t.y)), fmaxf(fabsf(t.z), fabsf(t.w))), fmaxf(fmaxf(fabsf(u.x), fabsf(u.y)), fmaxf(fabsf(u.z), fabsf(u.w))))); }
    for (int o = 16; o > 0; o >>= 1) am = fmaxf(am, __shfl_xor(am, o));
    const float inv = am > 0.f ? 7.5f / am : 0.f;
    const u32x6 w = __builtin_amdgcn_cvt_scalef32_2xpk16_fp6_f32(a * inv, b * inv, 1.0f);
    unsigned char* dp = dst + (size_t)row * 768 + g * 24;
    *(u32x4_u*)dp = (u32x4){w[0], w[1], w[2], w[3]}; *(u32x2_u*)(dp + 16) = (u32x2){w[4], w[5]};
    if (g == 0) scale[row] = am * (1.f / 7.5f);
  }
}

DEVI void ph_hx(const Params& p, char* smem) {
  const int tid = threadIdx.x, wave = tid >> 6, lane = tid & 63;
  float* mA = (float*)smem; float* mB = mA + 3 * 1024;
  const float* MOD = (const float*)(p.ws + O_MOD);
  for (int i = tid; i < 3072; i += NTHR) { int r = i >> 10, c = i & 1023; mA[i] = p.g_pre1[c] * (1.f + MOD[r * 6144 + 1024 + c]); mB[i] = MOD[r * 6144 + c]; }
  __syncthreads();
  bf16_t* HX = (bf16_t*)(p.ws + O_RA);
  for (int row = blockIdx.x * NWAVE + wave; row < NROW; row += gridDim.x * NWAVE) {
    const float* src = row < NTOK ? p.x + (size_t)row * 1024 : p.ctx + (size_t)(row - NTOK) * 1024;
    const int mr = row < NTOK ? (row >> 13) : 2;
    float4 v[4]; float ss = 0.f;
#pragma unroll
    for (int i = 0; i < 4; ++i) { v[i] = *(const float4*)(src + i * 256 + lane * 4); ss += v[i].x * v[i].x + v[i].y * v[i].y + v[i].z * v[i].z + v[i].w * v[i].w; }
    ss = wave_sum(ss); const float rstd = rsqrtf(ss * (1.f / 1024.f) + EPS);
#pragma unroll
    for (int i = 0; i < 4; ++i) { const int c = i * 256 + lane * 4; const float* a = mA + mr * 1024 + c; const float* b = mB + mr * 1024 + c;
      u32x2 o = {pack2(v[i].x * rstd * a[0] + b[0], v[i].y * rstd * a[1] + b[1]), pack2(v[i].z * rstd * a[2] + b[2], v[i].w * rstd * a[3] + b[3])};
      *(u32x2*)(HX + (size_t)row * 1024 + c) = o; }
  }
}

DEVI int lds_sw(int row, int c) { return row * 128 + ((c ^ (row & 7)) << 4); }
template <int BM, int BN, bool ACOLMAP, bool GLDS, class Epi>
DEVI void gemm_tile_mfma(const bf16_t* __restrict__ A, int lda, const bf16_t* __restrict__ Bm, int ldb, int K, int row0, int col0, const Epi& epi, const float* kscale, char* smem) {
  constexpr int WNW = BN / 64, WMW = 8 / WNW, WTM = BM / WMW, MI = WTM / 16, ACH = BM / 64, BCH = BN / 64, ABYTES = BM * 128, BBYTES = BN * 128, STAGE = ABYTES + BBYTES;
  int tid = threadIdx.x; asm volatile("" : "+v"(tid));
  const int wave = __builtin_amdgcn_readfirstlane(tid >> 6), lane = tid & 63, wm = wave / WNW, wn = wave % WNW, l15 = lane & 15, lq = lane >> 4;
  f32x4 acc[MI][4];
#pragma unroll
  for (int mi = 0; mi < MI; ++mi)
#pragma unroll
    for (int ni = 0; ni < 4; ++ni) acc[mi][ni] = (f32x4){0.f, 0.f, 0.f, 0.f};
  const int nk = K >> 6;
  const int sr = tid >> 3, scc = tid & 7;
  auto compute = [&](int buf) {
    const char* sa = smem + buf * STAGE; const char* sb = sa + ABYTES;
#pragma unroll
    for (int ks = 0; ks < 2; ++ks) { const int kc = ks * 4 + lq; bf16x8 bfr[4];
#pragma unroll
      for (int ni = 0; ni < 4; ++ni) bfr[ni] = *(const bf16x8*)(sb + lds_sw(wn * 64 + ni * 16 + l15, kc));
#pragma unroll
      for (int mi = 0; mi < MI; ++mi) { const bf16x8 af = *(const bf16x8*)(sa + lds_sw(wm * WTM + mi * 16 + l15, kc));
#pragma unroll
        for (int ni = 0; ni < 4; ++ni) acc[mi][ni] = __builtin_amdgcn_mfma_f32_16x16x32_bf16(bfr[ni], af, acc[mi][ni], 0, 0, 0); }
    }
  };
  if constexpr (GLDS) {
    const unsigned aoff = (unsigned)(sr * lda + ((scc ^ (sr & 7)) * 8)) * 2u, boff = (unsigned)(sr * ldb + ((scc ^ (sr & 7)) * 8)) * 2u;
    auto gstage = [&](int buf, int kt) {
      const int k0 = kt * 64, ka = ACOLMAP ? k0 + (k0 >> 7) * 64 : k0;
      char* sa = smem + buf * STAGE + wave * 1024; char* sb = sa + ABYTES;
#pragma unroll
      for (int i = 0; i < ACH; ++i) __builtin_amdgcn_global_load_lds((const unsigned*)((const char*)(A + (size_t)(64 * i) * lda + ka) + aoff), (unsigned*)(sa + i * 8192), 16, 0, 0);
#pragma unroll
      for (int i = 0; i < BCH; ++i) __builtin_amdgcn_global_load_lds((const unsigned*)((const char*)(Bm + (size_t)(64 * i) * ldb + k0) + boff), (unsigned*)(sb + i * 8192), 16, 0, 0);
    };
    gstage(0, 0); asm volatile("s_waitcnt vmcnt(0)" ::: "memory"); __syncthreads();
    for (int kt = 0; kt < nk; ++kt) {
      if (kt + 1 < nk) gstage((kt + 1) & 1, kt + 1);
      compute(kt & 1);
      asm volatile("s_waitcnt vmcnt(0)" ::: "memory"); __syncthreads();
    }
  } else {
    u32x4 ra[ACH], rb[BCH];
    const unsigned aoff = (unsigned)(sr * lda + scc * 8) * 2u, boff = (unsigned)(sr * ldb + scc * 8) * 2u;
    const int sdst = lds_sw(sr, scc);
    auto gload = [&](int kt) {
      const int k0 = kt * 64, ka = ACOLMAP ? k0 + (k0 >> 7) * 64 : k0;
#pragma unroll
      for (int i = 0; i < ACH; ++i) { const char* ub = (const char*)(A + (size_t)(64 * i) * lda + ka); ra[i] = *(const u32x4*)(ub + aoff); }
#pragma unroll
      for (int i = 0; i < BCH; ++i) { const char* ub = (const char*)(Bm + (size_t)(64 * i) * ldb + k0); rb[i] = *(const u32x4*)(ub + boff); }
    };
    auto lstore = [&](int buf, int kt) {
      char* sa = smem + buf * STAGE + sdst; char* sb = sa + ABYTES;
#pragma unroll
      for (int i = 0; i < ACH; ++i) { u32x4 v = ra[i];
        if (kscale) { float f[8]; unpack8(v, f); const float* ks = kscale + kt * 64 + scc * 8;
          v = (u32x4){pack2(f[0] * ks[0], f[1] * ks[1]), pack2(f[2] * ks[2], f[3] * ks[3]), pack2(f[4] * ks[4], f[5] * ks[5]), pack2(f[6] * ks[6], f[7] * ks[7])}; }
        *(u32x4*)(sa + i * 8192) = v; }
#pragma unroll
      for (int i = 0; i < BCH; ++i) *(u32x4*)(sb + i * 8192) = rb[i];
    };
    gload(0); lstore(0, 0); __syncthreads();
    for (int kt = 0; kt < nk; ++kt) {
      if (kt + 1 < nk) gload(kt + 1);
      compute(kt & 1);
      if (kt + 1 < nk) lstore((kt + 1) & 1, kt + 1);
      __syncthreads();
    }
  }
  int tide = threadIdx.x; asm volatile("" : "+v"(tide));
  const int l15e = tide & 15, lqe = (tide >> 4) & 3;
  float cs[4][4];
  if constexpr (Epi::SCALE_MODE == 2) {
#pragma unroll
    for (int ni = 0; ni < 4; ++ni)
#pragma unroll
      for (int j = 0; j < 4; ++j) cs[ni][j] = epi.colscale(col0 + wn * 64 + ni * 16 + lqe * 4 + j); }
#pragma unroll
  for (int mi = 0; mi < MI; ++mi) { const int row = row0 + wm * WTM + mi * 16 + l15e; float sq = 0.f; float rs = 1.f;
    if constexpr (Epi::SCALE_MODE == 1) rs = epi.rowscale(row);
#pragma unroll
    for (int ni = 0; ni < 4; ++ni) { float v[4] = {acc[mi][ni][0], acc[mi][ni][1], acc[mi][ni][2], acc[mi][ni][3]};
      if constexpr (Epi::SCALE_MODE == 1) { v[0] *= rs; v[1] *= rs; v[2] *= rs; v[3] *= rs; }
      if constexpr (Epi::SCALE_MODE == 2) { v[0] *= cs[ni][0]; v[1] *= cs[ni][1]; v[2] *= cs[ni][2]; v[3] *= cs[ni][3]; }
      const float q = epi(row, col0 + wn * 64 + ni * 16 + lqe * 4, v);
      if (Epi::RSS) { sq += q; if (ni & 1) { sq += __shfl_xor(sq, 16); sq += __shfl_xor(sq, 32); if (lqe == 0) epi.rss(row, col0 + wn * 64 + (ni >> 1) * 32, sq); sq = 0.f; } } }
    __builtin_amdgcn_sched_barrier(0); }
}


namespace g8 {
constexpr int BK = 64, HALF = 128, HT = HALF * BK;
DEVI int lds_byte(int r, int c) { const int st = (r >> 4) * 2 + (c >> 5), rr = r & 15, cc = c & 31, ob = rr * 64 + cc * 2; return st * 1024 + (ob ^ (((ob >> 9) & 1) << 5)); }
DEVI void stage_rc(int b, int& R, int& C) { const int st = b / 1024, sb = b % 1024, swz = sb ^ (((sb >> 9) & 1) << 5); R = (st >> 1) * 16 + swz / 64; C = (st & 1) * 32 + (swz % 64) / 2; }
}
template <bool ACOLMAP, class Epi>
DEVI void gemm_tile_8ph(const bf16_t* __restrict__ A, int lda, const bf16_t* __restrict__ Bt, int ldb, int K, int row0, int col0, const Epi& epi, char* smem) {
  using namespace g8;
  bf16_t* shm = (bf16_t*)smem;
#define SA(b, h) (shm + ((b) * 2 + (h)) * HT)
#define SB(b, h) (shm + (4 + (b) * 2 + (h)) * HT)
#define STAGE_A(P, r0, kt) do { const int _k0 = (kt) * BK, _ka = ACOLMAP ? _k0 + (_k0 >> 7) * 64 : _k0; \
    __builtin_amdgcn_global_load_lds((const unsigned*)((const char*)(A + (size_t)(r0) * lda + _ka) + ao0), (unsigned*)((char*)(P) + wid * 1024), 16, 0, 0); \
    __builtin_amdgcn_global_load_lds((const unsigned*)((const char*)(A + (size_t)((r0) + 64) * lda + _ka) + ao0), (unsigned*)((char*)(P) + wid * 1024 + 8192), 16, 0, 0); } while (0)
#define STAGE_B(P, r0, kt) do { const int _k0 = (kt) * BK; \
    __builtin_amdgcn_global_load_lds((const unsigned*)((const char*)(Bt + (size_t)(r0) * ldb + _k0) + bo0), (unsigned*)((char*)(P) + wid * 1024), 16, 0, 0); \
    __builtin_amdgcn_global_load_lds((const unsigned*)((const char*)(Bt + (size_t)((r0) + 64) * ldb + _k0) + bo0), (unsigned*)((char*)(P) + wid * 1024 + 8192), 16, 0, 0); } while (0)
#define LDA(dst, b, h) _Pragma("unroll") for (int m = 0; m < 4; ++m) _Pragma("unroll") for (int k = 0; k < 2; ++k) \
    dst[m][k] = *reinterpret_cast<const bf16x8*>((const char*)SA(b, h) + lds_byte(wr * 64 + m * 16 + fr, k * 32 + fq * 8))
#define LDB(dst, b, h) _Pragma("unroll") for (int n = 0; n < 2; ++n) _Pragma("unroll") for (int k = 0; k < 2; ++k) \
    dst[n][k] = *reinterpret_cast<const bf16x8*>((const char*)SB(b, h) + lds_byte(wc * 32 + n * 16 + fr, k * 32 + fq * 8))
#define MMA(ai, bj, At_, Bt_) do { __builtin_amdgcn_s_setprio(1); \
    _Pragma("unroll") for (int m = 0; m < 4; ++m) _Pragma("unroll") for (int n = 0; n < 2; ++n) _Pragma("unroll") for (int k = 0; k < 2; ++k) \
      acc[ai][bj][m][n] = __builtin_amdgcn_mfma_f32_16x16x32_bf16(Bt_[n][k], At_[m][k], acc[ai][bj][m][n], 0, 0, 0); \
    __builtin_amdgcn_s_setprio(0); } while (0)
#define WAIT_V(n) asm volatile("s_waitcnt vmcnt(" #n ")" ::: "memory")
#define WAIT_L(n) asm volatile("s_waitcnt lgkmcnt(" #n ")" ::: "memory")
#define BAR __builtin_amdgcn_s_barrier()
#define SCHED __builtin_amdgcn_sched_barrier(0)
  int tid = threadIdx.x; asm volatile("" : "+v"(tid));
  const int wid = __builtin_amdgcn_readfirstlane(tid >> 6), lane = tid & 63, wr = wid >> 2, wc = wid & 3, fr = lane & 15, fq = lane >> 4;
  unsigned ao0, bo0;
  { int r, c; stage_rc(tid * 16, r, c); ao0 = (unsigned)(r * lda + c) * 2u; bo0 = (unsigned)(r * ldb + c) * 2u; }
  f32x4 acc[2][2][4][2];
#pragma unroll
  for (int a = 0; a < 2; ++a)
#pragma unroll
    for (int b = 0; b < 2; ++b)
#pragma unroll
      for (int m = 0; m < 4; ++m)
#pragma unroll
        for (int n = 0; n < 2; ++n) acc[a][b][m][n] = (f32x4){0.f, 0.f, 0.f, 0.f};
  bf16x8 At[4][2], B0[2][2], B1[2][2];
  const int nt = K / BK;
  STAGE_B(SB(0, 0), 0, 0); STAGE_A(SA(0, 0), 0, 0);
  STAGE_B(SB(0, 1), HALF, 0); STAGE_A(SA(0, 1), HALF, 0);
  if (wr == 1) BAR;
  WAIT_V(4); BAR;
  STAGE_B(SB(1, 0), 0, 1); STAGE_A(SA(1, 0), 0, 1); STAGE_B(SB(1, 1), HALF, 1);
  WAIT_V(6); BAR;
  for (int t = 0; t < nt - 2; t += 2) {
    LDB(B0, 0, 0); SCHED; LDA(At, 0, 0); STAGE_A(SA(1, 1), HALF, t + 1);
    WAIT_L(8); BAR; WAIT_L(0); MMA(0, 0, At, B0); BAR; SCHED;
    LDB(B1, 0, 1); STAGE_B(SB(0, 0), 0, t + 2);
    BAR; WAIT_L(0); MMA(0, 1, At, B1); BAR;
    LDA(At, 0, 1); STAGE_A(SA(0, 0), 0, t + 2);
    BAR; WAIT_L(0); MMA(1, 0, At, B0); BAR; SCHED;
    STAGE_B(SB(0, 1), HALF, t + 2);
    WAIT_V(6); BAR; MMA(1, 1, At, B1); BAR;
    LDB(B0, 1, 0); SCHED; LDA(At, 1, 0); STAGE_A(SA(0, 1), HALF, t + 2);
    WAIT_L(8); BAR; WAIT_L(0); MMA(0, 0, At, B0); BAR; SCHED;
    LDB(B1, 1, 1); STAGE_B(SB(1, 0), 0, t + 3);
    BAR; WAIT_L(0); MMA(0, 1, At, B1); BAR;
    LDA(At, 1, 1); STAGE_A(SA(1, 0), 0, t + 3);
    BAR; WAIT_L(0); MMA(1, 0, At, B0); BAR; SCHED;
    STAGE_B(SB(1, 1), HALF, t + 3);
    WAIT_V(6); BAR; MMA(1, 1, At, B1); BAR;
  }
  { LDB(B0, 0, 0); LDA(At, 0, 0); STAGE_A(SA(1, 1), HALF, nt - 1);
    BAR; WAIT_L(0); MMA(0, 0, At, B0); BAR;
    LDB(B1, 0, 1); BAR; WAIT_L(0); MMA(0, 1, At, B1); BAR;
    LDA(At, 0, 1); WAIT_V(4); BAR; WAIT_L(0); MMA(1, 0, At, B0); MMA(1, 1, At, B1); BAR; }
  { LDB(B0, 1, 0); LDA(At, 1, 0); WAIT_V(2); BAR; WAIT_L(0); MMA(0, 0, At, B0); BAR;
    LDB(B1, 1, 1); WAIT_V(0); BAR; WAIT_L(0); MMA(0, 1, At, B1); BAR;
    LDA(At, 1, 1); BAR; WAIT_L(0); MMA(1, 0, At, B0); MMA(1, 1, At, B1); BAR; }
  if (wr == 0) BAR;
  int tide = threadIdx.x; asm volatile("" : "+v"(tide));
  const int fre = tide & 15, fqe = (tide >> 4) & 3;
#pragma unroll
  for (int ai = 0; ai < 2; ++ai)
#pragma unroll
    for (int m = 0; m < 4; ++m) { const int row = row0 + ai * HALF + wr * 64 + m * 16 + fre;
#pragma unroll
      for (int bj = 0; bj < 2; ++bj) { float sq = 0.f;
#pragma unroll
        for (int n = 0; n < 2; ++n) { const float v[4] = {acc[ai][bj][m][n][0], acc[ai][bj][m][n][1], acc[ai][bj][m][n][2], acc[ai][bj][m][n][3]};
          sq += epi(row, col0 + bj * HALF + wc * 32 + n * 16 + fqe * 4, v); }
        if (Epi::RSS) { sq += __shfl_xor(sq, 16); sq += __shfl_xor(sq, 32); if (fqe == 0) epi.rss(row, col0 + bj * HALF + wc * 32, sq); } }
      __builtin_amdgcn_sched_barrier(0); }
#undef SA
#undef SB
#undef STAGE_A
#undef STAGE_B
#undef LDA
#undef LDB
#undef MMA
#undef WAIT_V
#undef WAIT_L
#undef BAR
#undef SCHED
}

template <int BM, int BN, bool ACOLMAP, class Epi>
DEVI void gemm_tile(const bf16_t* A, int lda, const bf16_t* Bm, int ldb, int K, int row0, int col0, const Epi& epi, const float* kss, char* smem) {
  if constexpr (BM == 256 && BN == 256) gemm_tile_8ph<ACOLMAP>(A, lda, Bm, ldb, K, row0, col0, epi, smem);
  else if (kss) gemm_tile_mfma<BM, BN, ACOLMAP, false>(A, lda, Bm, ldb, K, row0, col0, epi, kss, smem);
  else gemm_tile_mfma<BM, BN, ACOLMAP, true>(A, lda, Bm, ldb, K, row0, col0, epi, nullptr, smem);
}

DEVI void st4bf(bf16_t* d, float a, float b, float c, float e) { u32x2 o = {pack2(a, b), pack2(c, e)}; *(u32x2*)d = o; }

struct EpiIn { static constexpr bool RSS = true; static constexpr int SCALE_MODE = 0; bf16_t *GU, *GVT, *CQ, *CKV, *KR; float *rssv, *rssq, *rsskv;
  DEVI float operator()(int row, int col, const float (&v)[4]) const {
    if (col < 1024) { st4bf(GU + (size_t)row * 1024 + col, gelu_t(v[0]), gelu_t(v[1]), gelu_t(v[2]), gelu_t(v[3])); return 0.f; }
    else if (col < 2048) { const int c = col - 1024, chunk = row >> 7, q = row & 127; float s = 0.f;
#pragma unroll
      for (int j = 0; j < 4; ++j) { const float g = gelu_t(v[j]); s += g * g; GVT[((size_t)chunk * 1024 + c + j) * 128 + q] = f2bf(g); }
      return s; }
    else if (col < 2304) { st4bf(CQ + (size_t)row * 256 + (col - 2048), v[0], v[1], v[2], v[3]); return v[0] * v[0] + v[1] * v[1] + v[2] * v[2] + v[3] * v[3]; }
    else if (col < 2432) { st4bf(CKV + (size_t)row * 128 + (col - 2304), v[0], v[1], v[2], v[3]); return v[0] * v[0] + v[1] * v[1] + v[2] * v[2] + v[3] * v[3]; }
    else if (col < 2496) { st4bf(KR + (size_t)keyrow(row) * 64 + (col - 2432), v[0], v[1], v[2], v[3]); return 0.f; }
    return 0.f; }
  DEVI void rss(int row, int col, float s) const {
    if (col >= 1024 && col < 2048) rssv[row * 32 + ((col - 1024) >> 5)] = s; else if (col >= 2048 && col < 2304) rssq[row * 8 + ((col - 2048) >> 5)] = s; else if (col >= 2304 && col < 2432) rsskv[row * 4 + ((col - 2304) >> 5)] = s; }
};
struct EpiQ { static constexpr bool RSS = false; static constexpr int SCALE_MODE = 1; bf16_t* Q; const float* rssq;
  DEVI float rowscale(int row) const { const float4 ps = *(const float4*)(rssq + row * 8), pt = *(const float4*)(rssq + row * 8 + 4); return rsqrtf((((ps.x + ps.y) + (ps.z + ps.w)) + ((pt.x + pt.y) + (pt.z + pt.w))) * (1.f / 256.f) + EPS); }
  DEVI float operator()(int row, int col, const float (&v)[4]) const { st4bf(Q + (size_t)row * 1536 + col, v[0], v[1], v[2], v[3]); return 0.f; }
  DEVI void rss(int, int, float) const {} };
DEVI int pk4_fp8(float a, float b, float c, float d) { int w = __builtin_amdgcn_cvt_pk_fp8_f32(a, b, 0, false); return __builtin_amdgcn_cvt_pk_fp8_f32(c, d, w, true); }
constexpr size_t O_K8 = O_RKV, O_V8T = O_RKV + al256((size_t)NB * 8 * NKEY * 192);
struct EpiK8 { static constexpr bool RSS = false; static constexpr int SCALE_MODE = 1; unsigned char* K8; const float* rsskv;
  DEVI float rowscale(int row) const { const float4 pk = *(const float4*)(rsskv + row * 4); return rsqrtf(((pk.x + pk.y) + (pk.z + pk.w)) * (1.f / 128.f) + EPS); }
  DEVI float operator()(int row, int col, const float (&v)[4]) const {
    const int kr = keyrow(row), b = kr / NKEY, key = kr - b * NKEY, h = col >> 7, d = col & 127;
    *(int*)(K8 + ((size_t)(b * 8 + h) * NKEY + key) * 192 + d) = pk4_fp8(v[0], v[1], v[2], v[3]); return 0.f; }
  DEVI void rss(int, int, float) const {} };
struct EpiV8T { static constexpr bool RSS = false; static constexpr int SCALE_MODE = 2; unsigned char* V8; const float* rsskv;
  DEVI float colscale(int col) const { const float4 pk = *(const float4*)(rsskv + col * 4); return rsqrtf(((pk.x + pk.y) + (pk.z + pk.w)) * (1.f / 128.f) + EPS); }
  DEVI float operator()(int row, int col, const float (&v)[4]) const {
    const int kr = keyrow(col), b = kr / NKEY, key = kr - b * NKEY, h = row >> 7, d = row & 127, kk = key & 63;
    const int off = 32 * ((kk >> 2) & 1) + 16 * (kk >> 5) + 4 * ((kk >> 3) & 3);
    *(int*)(V8 + ((size_t)(b * 8 + h) * 128 + d) * NKEY + (key & ~63) + off) = pk4_fp8(v[0], v[1], v[2], v[3]); return 0.f; }
  DEVI void rss(int, int, float) const {} };
struct EpiSgu { static constexpr bool RSS = false; static constexpr int SCALE_MODE = 0; bf16_t* GUOA; const float* g_sgu; const float* b_s; int chunk, g;
  DEVI float operator()(int row, int col, const float (&v)[4]) const { const int token = chunk * 128 + row, ch = g * 128 + col; const float bias = b_s[g * 128 + row];
    bf16_t* ptr = GUOA + (size_t)token * 1024 + ch; const u32x2 gu = *(const u32x2*)ptr;
    st4bf(ptr, lo2f(gu[0]) * (g_sgu[ch] * v[0] + bias), hi2f(gu[0]) * (g_sgu[ch + 1] * v[1] + bias), lo2f(gu[1]) * (g_sgu[ch + 2] * v[2] + bias), hi2f(gu[1]) * (g_sgu[ch + 3] * v[3] + bias));
    return 0.f; }
  DEVI void rss(int, int, float) const {} };
struct EpiGate { static constexpr bool RSS = false; static constexpr int SCALE_MODE = 0; bf16_t* G;
  DEVI float operator()(int row, int col, const float (&v)[4]) const { st4bf(G + (size_t)row * 2048 + col, sigmoidf_(v[0]), sigmoidf_(v[1]), sigmoidf_(v[2]), sigmoidf_(v[3])); return 0.f; }
  DEVI void rss(int, int, float) const {} };
template <bool SECOND> struct EpiMerge { static constexpr bool RSS = false; static constexpr int SCALE_MODE = 0; bf16_t* M; const bf16_t* G;
  DEVI float operator()(int row, int col, const float (&v)[4]) const { const u32x2 g = *(const u32x2*)(G + (size_t)row * 2048 + (SECOND ? 1024 : 0) + col);
    float o0 = lo2f(g[0]) * v[0], o1 = hi2f(g[0]) * v[1], o2 = lo2f(g[1]) * v[2], o3 = hi2f(g[1]) * v[3];
    bf16_t* ptr = M + (size_t)row * 1024 + col;
    if (SECOND) { const u32x2 m = *(const u32x2*)ptr; o0 += lo2f(m[0]); o1 += hi2f(m[0]); o2 += lo2f(m[1]); o3 += hi2f(m[1]); }
    st4bf(ptr, o0, o1, o2, o3); return 0.f; }
  DEVI void rss(int, int, float) const {} };
struct EpiO { static constexpr bool RSS = true; static constexpr int SCALE_MODE = 0; bf16_t* Y; float* rssy;
  DEVI float operator()(int row, int col, const float (&v)[4]) const { st4bf(Y + (size_t)row * 1024 + col, v[0], v[1], v[2], v[3]); return v[0] * v[0] + v[1] * v[1] + v[2] * v[2] + v[3] * v[3]; }
  DEVI void rss(int row, int col, float s) const { rssy[row * 32 + (col >> 5)] = s; } };
struct EpiPq { static constexpr bool RSS = false; static constexpr int SCALE_MODE = 0; bf16_t* QP;
  DEVI float operator()(int row, int col, const float (&v)[4]) const { st4bf(QP + (size_t)row * 2048 + col, v[0], v[1], v[2], v[3]); return 0.f; }
  DEVI void rss(int, int, float) const {} };

template <class F> DEVI void for_tiles_xcd(int MT, int NT, F f) {
  const int nb = gridDim.x;
  if ((nb & 7) == 0 && (MT & 7) == 0) { const int xcd = blockIdx.x & 7, slot = blockIdx.x >> 3, slots = nb >> 3, mper = MT >> 3, tot = mper * NT;
    for (int j = slot; j < tot; j += slots) f(xcd * mper + j / NT, j % NT); }
  else for (int i = blockIdx.x; i < MT * NT; i += nb) f(i / NT, i % NT);
}

DEVI void ph_inproj(const Params& p, char* smem) {
  char* ws = p.ws;
  EpiIn epi{(bf16_t*)(ws + O_RB), (bf16_t*)(ws + O_RC), (bf16_t*)(ws + O_CQ), (bf16_t*)(ws + O_CKV), (bf16_t*)(ws + O_KR), (float*)(ws + O_RSSV), (float*)(ws + O_RSSQ), (float*)(ws + O_RSSKV)};
  const bf16_t* HX = (const bf16_t*)(ws + O_RA); const bf16_t* W = (const bf16_t*)(ws + O_WIN);
  auto tile = [&](int mt, int nt) { gemm_tile<256, 256, false>(HX + (size_t)mt * 256 * 1024, 1024, W + (size_t)nt * 256 * 1024, 1024, 1024, mt * 256, nt * 256, epi, nullptr, smem); };
  for_tiles_xcd(64, 10, tile);
  for (int i = (int)gridDim.x - 1 - (int)blockIdx.x; i < 2; i += gridDim.x) tile(64 + i, 9);
}
DEVI void rope_kr_fp8(const Params& p) {
  const bf16_t* KR = (const bf16_t*)(p.ws + O_KR); const float* rope = (const float*)(p.ws + O_ROPE); unsigned char* K8 = (unsigned char*)(p.ws + O_K8);
  for (int i = blockIdx.x * NTHR + threadIdx.x; i < NROW * 2; i += gridDim.x * NTHR) {
    const int row = i >> 1, which = i & 1, kr = keyrow(row), b = kr / NKEY, key = kr - b * NKEY;
    float x[32];
    const bf16_t* src = KR + (size_t)kr * 64 + which * 32;
#pragma unroll
    for (int q = 0; q < 4; ++q) unpack8(*(const u32x4*)(src + q * 8), x + q * 8);
    if (row < NTOK) { const int pos = row & 8191, pp = which ? (pos & 63) : (pos >> 6); const float* cs = rope + pp * 32;
#pragma unroll
      for (int j = 0; j < 16; ++j) { const float c = cs[j * 2], sn = cs[j * 2 + 1], x1 = x[j], x2 = x[16 + j]; x[j] = x1 * c - x2 * sn; x[16 + j] = x1 * sn + x2 * c; } }
    u32x4 o0, o1;
#pragma unroll
    for (int q = 0; q < 4; ++q) { o0[q] = (unsigned)pk4_fp8(x[q * 4], x[q * 4 + 1], x[q * 4 + 2], x[q * 4 + 3]); o1[q] = (unsigned)pk4_fp8(x[16 + q * 4], x[17 + q * 4], x[18 + q * 4], x[19 + q * 4]); }
#pragma unroll
    for (int h = 0; h < 8; ++h) { unsigned char* d = K8 + ((size_t)(b * 8 + h) * NKEY + key) * 192 + 128 + which * 32; *(u32x4*)d = o0; *(u32x4*)(d + 16) = o1; }
  }
}
DEVI void ph_mid(const Params& p, char* smem) {
  char* ws = p.ws;
  { EpiQ epi{(bf16_t*)(ws + O_RQ), (const float*)(ws + O_RSSQ)};
    const bf16_t* A = (const bf16_t*)(ws + O_CQ); const bf16_t* W = (const bf16_t*)(ws + O_WUQ);
    for_tiles_xcd(64, 12, [&](int mt, int nt) { gemm_tile<256, 128, false>(A + (size_t)mt * 256 * 256, 256, W + (size_t)nt * 128 * 256, 256, 256, mt * 256, nt * 128, epi, nullptr, smem); }); }
  { EpiK8 epi{(unsigned char*)(ws + O_K8), (const float*)(ws + O_RSSKV)};
    const bf16_t* A = (const bf16_t*)(ws + O_CKV); const bf16_t* W = (const bf16_t*)(ws + O_WUKV);
    auto tile = [&](int mt, int nt) { gemm_tile<256, 128, false>(A + (size_t)mt * 256 * 128, 128, W + (size_t)nt * 256 * 128, 128, 128, mt * 256, nt * 128, epi, nullptr, smem); };
    for_tiles_xcd(64, 8, tile);
    for (int i = blockIdx.x; i < 16; i += gridDim.x) tile(64 + (i >> 3), i & 7); }
  { EpiV8T epi{(unsigned char*)(ws + O_V8T), (const float*)(ws + O_RSSKV)};
    const bf16_t* A = (const bf16_t*)(ws + O_WUKV); const bf16_t* Bc = (const bf16_t*)(ws + O_CKV);
    for (int i = blockIdx.x; i < 8 * 132; i += gridDim.x) { const int mt = i & 7, nt = i >> 3;
      gemm_tile<128, 128, false>(A + (size_t)(mt * 256 + 128) * 128, 128, Bc + (size_t)nt * 128 * 128, 128, 128, mt * 128, nt * 128, epi, nullptr, smem); } }
  { const bf16_t* WS = (const bf16_t*)(ws + O_WS); const bf16_t* GVT = (const bf16_t*)(ws + O_RC);
    float* ksc = (float*)(smem + LDS_BYTES - 1024); const float* rssv = (const float*)(ws + O_RSSV);
    for (int i = blockIdx.x; i < 1024; i += gridDim.x) { const int chunk = i >> 3, g = i & 7;
      __syncthreads();
      if (threadIdx.x < 128) { const float* pr = rssv + (size_t)(chunk * 128 + threadIdx.x) * 32; float t = 0.f;
#pragma unroll
        for (int j = 0; j < 32; ++j) t += pr[j];
        ksc[threadIdx.x] = rsqrtf(t * (1.f / 1024.f) + EPS); }
      __syncthreads();
      EpiSgu epi{(bf16_t*)(ws + O_RB), p.g_sgu, p.b_s, chunk, g};
      gemm_tile<128, 128, false>(WS + (size_t)g * 16384, 128, GVT + ((size_t)chunk * 1024 + g * 128) * 128, 128, 128, 0, 0, epi, ksc, smem); } }
  rope_kr_fp8(p);
}
DEVI void ph_gates(const Params& p, char* smem) {
  char* ws = p.ws; EpiGate epi{(bf16_t*)(ws + O_RKV)};
  const bf16_t* HX = (const bf16_t*)(ws + O_RA); const bf16_t* W = (const bf16_t*)(ws + O_WIN) + (size_t)NPRE * 1024;
  for_tiles_xcd(64, 8, [&](int mt, int nt) { gemm_tile<256, 256, false>(HX + (size_t)mt * 256 * 1024, 1024, W + (size_t)nt * 256 * 1024, 1024, 1024, mt * 256, nt * 256, epi, nullptr, smem); });
}
DEVI void ph_merge(const Params& p, char* smem) {
  char* ws = p.ws; bf16_t* M = (bf16_t*)(ws + O_RC); const bf16_t* G = (const bf16_t*)(ws + O_RKV);
  EpiMerge<false> e1{M, G}; EpiMerge<true> e2{M, G};
  const bf16_t* OA = (const bf16_t*)(ws + O_RB); const bf16_t* OB = (const bf16_t*)(ws + O_RQ);
  const bf16_t* WA = (const bf16_t*)(ws + O_WPA); const bf16_t* WB = (const bf16_t*)(ws + O_WPB);
  for_tiles_xcd(64, 4, [&](int mt, int nt) { gemm_tile<256, 256, false>(OA + (size_t)mt * 256 * 1024, 1024, WA + (size_t)nt * 256 * 1024, 1024, 1024, mt * 256, nt * 256, e1, nullptr, smem); });
  for_tiles_xcd(64, 4, [&](int mt, int nt) { gemm_tile<256, 256, true>(OB + (size_t)mt * 256 * 1536, 1536, WB + (size_t)nt * 256 * 1024, 1024, 1024, mt * 256, nt * 256, e2, nullptr, smem); });
}
DEVI void ph_wo(const Params& p, char* smem) {
  char* ws = p.ws; EpiO epi{(bf16_t*)(ws + O_RA), (float*)(ws + O_RSSY)};
  const bf16_t* M = (const bf16_t*)(ws + O_RC); const bf16_t* W = (const bf16_t*)(ws + O_WO);
  for_tiles_xcd(64, 4, [&](int mt, int nt) { gemm_tile<256, 256, false>(M + (size_t)mt * 256 * 1024, 1024, W + (size_t)nt * 256 * 1024, 1024, 1024, mt * 256, nt * 256, epi, nullptr, smem); });
}
DEVI void ph_wpq(const Params& p, char* smem) {
  char* ws = p.ws; EpiPq epi{(bf16_t*)(ws + O_RKV)};
  const bf16_t* A = (const bf16_t*)(ws + O_RB); const bf16_t* W = (const bf16_t*)(ws + O_WPQ);
  for_tiles_xcd(64, 8, [&](int mt, int nt) { gemm_tile<256, 256, false>(A + (size_t)mt * 256 * 1024, 1024, W + (size_t)nt * 256 * 1024, 1024, 1024, mt * 256, nt * 256, epi, nullptr, smem); });
  convert_table_fp6(p.v_exp, (unsigned char*)(ws + O_RA), (float*)(ws + O_RA + (size_t)16384 * 1024));
}

namespace a8 {
constexpr int KVBLK = 64, SHM_K = KVBLK * 192, SHM_V = 128 * KVBLK;
constexpr int SHM_K2 = 2 * SHM_K, SHM_V2 = 2 * SHM_V;
constexpr float SCALE = 0.07216878364870322f, THR = 1.5f;
using i32x8 = __attribute__((ext_vector_type(8))) int;
DEVI int crow(int r, int hi) { return (r & 3) + 8 * (r >> 2) + 4 * hi; }
DEVI f32x16 mma(const i32x8& a, const i32x8& b, const f32x16& c) { return __builtin_amdgcn_mfma_scale_f32_32x32x64_f8f6f4(a, b, c, 0, 0, 0, 0x7f7f7f7f, 0, 0x7f7f7f7f); }
DEVI void partialSM(f32x16& p0, f32x16& p1, float& m_reg, float& mn, float& alpha) {
  constexpr float C = SCALE * 1.4426950408889634f;
  float pmax = p0[0];
#pragma unroll
  for (int r = 1; r < 16; ++r) pmax = fmaxf(pmax, p0[r]);
#pragma unroll
  for (int r = 0; r < 16; ++r) pmax = fmaxf(pmax, p1[r]);
  { auto rr = __builtin_amdgcn_permlane32_swap(__float_as_uint(pmax), __float_as_uint(pmax), false, false);
    pmax = fmaxf(__uint_as_float(rr[0]), __uint_as_float(rr[1])); }
  if (__builtin_expect(__all(pmax - m_reg <= THR / SCALE), 1)) { mn = m_reg; alpha = 1.f; }
  else { mn = fmaxf(m_reg, pmax); alpha = __builtin_amdgcn_exp2f((m_reg - mn) * C); m_reg = mn; }
  const float mnC = 6.f - mn * C;
#pragma unroll
  for (int r = 0; r < 16; ++r) p0[r] = fmaf(p0[r], C, mnC);
#pragma unroll
  for (int r = 0; r < 16; ++r) p1[r] = fmaf(p1[r], C, mnC);
#pragma unroll
  for (int r = 0; r < 16; ++r) p0[r] = __builtin_amdgcn_exp2f(p0[r]);
}
DEVI void finishSM(f32x16& p0, f32x16& p1, float alpha, float& l_reg, i32x8& pa) {
#pragma unroll
  for (int r = 0; r < 16; ++r) p1[r] = __builtin_amdgcn_exp2f(p1[r]);
  float ps = 0;
#pragma unroll
  for (int r = 0; r < 16; ++r) ps += p0[r];
#pragma unroll
  for (int r = 0; r < 16; ++r) ps += p1[r];
  { auto rr = __builtin_amdgcn_permlane32_swap(__float_as_uint(ps), __float_as_uint(ps), false, false);
    ps = __uint_as_float(rr[0]) + __uint_as_float(rr[1]); }
  l_reg = l_reg * alpha + ps;
#pragma unroll
  for (int j = 0; j < 4; ++j) { pa[j] = pk4_fp8(p0[4 * j], p0[4 * j + 1], p0[4 * j + 2], p0[4 * j + 3]); pa[4 + j] = pk4_fp8(p1[4 * j], p1[4 * j + 1], p1[4 * j + 2], p1[4 * j + 3]); }
}
DEVI i32x8 ld32(const char* p0, const char* p1) { const u32x4 a = *(const u32x4*)p0, b = *(const u32x4*)p1; return (i32x8){(int)a[0], (int)a[1], (int)a[2], (int)a[3], (int)b[0], (int)b[1], (int)b[2], (int)b[3]}; }
DEVI void qkt(f32x16& p0, f32x16& p1, const char* Ks, const i32x8* qf, int r32, int hi) {
  p0 = f32x16{}; p1 = f32x16{};
  const int sw = (r32 >> 2) & 3; const char* k0 = Ks + r32 * 192; const char* k1 = k0 + 32 * 192;
#pragma unroll
  for (int m = 0; m < 3; ++m) { const int c0 = ((4 * m + 2 * hi) ^ sw) << 4, c1 = ((4 * m + 2 * hi + 1) ^ sw) << 4;
    p0 = mma(ld32(k0 + c0, k0 + c1), qf[m], p0);
    p1 = mma(ld32(k1 + c0, k1 + c1), qf[m], p1); }
}
DEVI void pv(f32x16* o, const char* Vs, int tile, const i32x8& pa, int r32, int hi) {
  const int sw = (r32 >> 1) & 7, c0 = ((4 * tile + 2 * hi) ^ sw) << 4, c1 = ((4 * tile + 2 * hi + 1) ^ sw) << 4;
#pragma unroll
  for (int db = 0; db < 4; ++db) { const char* vr = Vs + (32 * db + r32) * 128; o[db] = mma(pa, ld32(vr + c0, vr + c1), o[db]); }
}
DEVI void attn_item(bf16_t* __restrict__ Qb, const unsigned char* __restrict__ Kg, const unsigned char* __restrict__ Vg, const float* __restrict__ rope, int pos0, char* lds) {
  const int tid = threadIdx.x, wid = tid >> 6, lane = tid & 63, r32 = lane & 31, hi = lane >> 5;
  char* V_lds = lds; char* K_lds = lds + 3 * SHM_V2;
  float* wsl = (float*)(lds + 3 * SHM_V2 + 3 * SHM_K2) + wid * 64; float* li_l = wsl; float* al_l = wsl + 32;
  float m_reg = -1e30f, l_reg = 0; f32x16 o[4] = {}; i32x8 qf[3];
  { const bf16_t* Qw = Qb + (size_t)(wid * 32 + r32) * 1536 + hi * 32;
#pragma unroll
    for (int m = 0; m < 3; ++m) { float x[32];
#pragma unroll
      for (int q = 0; q < 4; ++q) unpack8(*(const u32x4*)(Qw + m * 64 + q * 8), x + q * 8);
      if (m == 2) { const int pos = pos0 + wid * 32 + r32, pp = hi ? (pos & 63) : (pos >> 6); const float* cs = rope + pp * 32;
#pragma unroll
        for (int j = 0; j < 16; ++j) { const float c = cs[j * 2], sn = cs[j * 2 + 1], x1 = x[j], x2 = x[16 + j]; x[j] = x1 * c - x2 * sn; x[16 + j] = x1 * sn + x2 * c; } }
#pragma unroll
      for (int q = 0; q < 8; ++q) qf[m][q] = pk4_fp8(x[q * 4], x[q * 4 + 1], x[q * 4 + 2], x[q * 4 + 3]);
      __builtin_amdgcn_sched_barrier(0); } }
  unsigned koff[3], voff[2];
#pragma unroll
  for (int i = 0; i < 3; ++i) { const int pp = wid * 64 + lane + 512 * i, key = pp / 12, c = pp - key * 12; koff[i] = (unsigned)(key * 192 + ((c ^ ((key >> 2) & 3)) << 4)); }
#pragma unroll
  for (int i = 0; i < 2; ++i) { const int pp = wid * 64 + lane + 512 * i, d = pp >> 3, c = pp & 7; voff[i] = (unsigned)(d * NKEY + ((c ^ ((d >> 1) & 7)) << 4)); }
#define GSTAGE(s_, kb, vb) do { const unsigned char* ks = Kg + (size_t)(s_) * SHM_K2; const unsigned char* vs = Vg + (s_) * 128; \
    _Pragma("unroll") for (int i = 0; i < 3; ++i) __builtin_amdgcn_global_load_lds((const unsigned*)(ks + koff[i]), (unsigned*)(K_lds + (kb) + i * 8192 + wid * 1024), 16, 0, 0); \
    _Pragma("unroll") for (int i = 0; i < 2; ++i) __builtin_amdgcn_global_load_lds((const unsigned*)(vs + voff[i]), (unsigned*)(V_lds + (vb) + i * 8192 + wid * 1024), 16, 0, 0); } while (0)
#define SWAIT() asm volatile("s_waitcnt vmcnt(0)" ::: "memory")
#define SBAR() __builtin_amdgcn_sched_barrier(0)
#define RESC(a) do { if (__any((a) < 1.f)) { if (hi == 0) al_l[r32] = (a); asm volatile("s_waitcnt lgkmcnt(0)" ::: "memory"); \
    _Pragma("unroll") for (int d = 0; d < 4; ++d) _Pragma("unroll") for (int r = 0; r < 16; ++r) o[d][r] *= al_l[crow(r, hi)]; } } while (0)
  f32x16 pA0, pA1, pB0, pB1; float mnA, mnB, alA, alB; i32x8 pa; constexpr int NS = NKEY / 128;
  int kp = 0, kc = SHM_K2, kn = 2 * SHM_K2, vp = 0, vc = SHM_V2, vn = 2 * SHM_V2;
  GSTAGE(0, kp, vp); GSTAGE(1, kc, vc); SWAIT(); __syncthreads();
  qkt(pA0, pA1, K_lds + kp, qf, r32, hi); partialSM(pA0, pA1, m_reg, mnA, alA);
  SBAR(); qkt(pB0, pB1, K_lds + kp + SHM_K, qf, r32, hi);
  finishSM(pA0, pA1, alA, l_reg, pa); SBAR();
  pv(o, V_lds + vp, 0, pa, r32, hi); partialSM(pB0, pB1, m_reg, mnB, alB);
  RESC(alB);
  for (int s_ = 1; s_ < NS; ++s_) {
    if (s_ + 1 < NS) GSTAGE(s_ + 1, kn, vn);
    SBAR(); qkt(pA0, pA1, K_lds + kc, qf, r32, hi);
    finishSM(pB0, pB1, alB, l_reg, pa); SBAR();
    pv(o, V_lds + vp, 1, pa, r32, hi); partialSM(pA0, pA1, m_reg, mnA, alA);
    RESC(alA);
    SBAR(); qkt(pB0, pB1, K_lds + kc + SHM_K, qf, r32, hi);
    finishSM(pA0, pA1, alA, l_reg, pa); SBAR();
    pv(o, V_lds + vc, 0, pa, r32, hi); partialSM(pB0, pB1, m_reg, mnB, alB);
    SWAIT(); __syncthreads();
    RESC(alB);
    { const int tk = kp; kp = kc; kc = kn; kn = tk; const int tv = vp; vp = vc; vc = vn; vn = tv; }
  }
  finishSM(pB0, pB1, alB, l_reg, pa); SBAR();
  pv(o, V_lds + vp, 1, pa, r32, hi);
  if (hi == 0) li_l[r32] = l_reg; asm volatile("s_waitcnt lgkmcnt(0)" ::: "memory");
  float rli[16];
#pragma unroll
  for (int r = 0; r < 16; ++r) rli[r] = __builtin_amdgcn_rcpf(li_l[crow(r, hi)]);
  bf16_t* Ow = Qb + (size_t)(wid * 32) * 1536;
#pragma unroll
  for (int r = 0; r < 16; ++r) { const int orow = crow(r, hi);
#pragma unroll
    for (int d0 = 0; d0 < 4; ++d0) Ow[(size_t)orow * 1536 + d0 * 32 + r32] = f2bf(o[d0][r] * rli[r]); }
  __syncthreads();
#undef GSTAGE
#undef SWAIT
#undef SBAR
#undef RESC
}
}
DEVI void attn_fp8(const Params& p, char* smem) {
  bf16_t* Q = (bf16_t*)(p.ws + O_RQ); const unsigned char* K8 = (const unsigned char*)(p.ws + O_K8); const unsigned char* V8 = (const unsigned char*)(p.ws + O_V8T);
  const float* rope = (const float*)(p.ws + O_ROPE);
  for (int it = blockIdx.x; it < NB * 8 * (SEQ / 256); it += gridDim.x) {
    const int bh = (it >> 8) * 8 + (it & 7), qb = (it & 255) >> 3, b = bh >> 3, h = bh & 7;
    a8::attn_item(Q + (size_t)(b * SEQ + qb * 256) * 1536 + h * 192, K8 + (size_t)bh * NKEY * 192, V8 + (size_t)bh * 128 * NKEY, rope, qb * 256, smem);
  }
}
DEVI void ph_attn(const Params& p, char* smem) { attn_fp8(p, smem); }

DEVI void ph_rows(const Params& p, char* smem) {
  const int tid = threadIdx.x, wave = tid >> 6, lane = tid & 63;
  const float* MOD = (const float*)(p.ws + O_MOD); const bf16_t* Y = (const bf16_t*)(p.ws + O_RA); const float* rssy = (const float*)(p.ws + O_RSSY);
  bf16_t* HX2 = (bf16_t*)(p.ws + O_RB);
  for (int row = blockIdx.x * NWAVE + wave; row < NTOK; row += gridDim.x * NWAVE) {
    const int b = row >> 13; const float* md = MOD + b * 6144;
    float ty = 0.f; { const float* pr = rssy + (size_t)row * 32;
#pragma unroll
      for (int j = 0; j < 32; ++j) ty += pr[j]; }
    const float ry = rsqrtf(ty * (1.f / 1024.f) + EPS);
    float x1[16]; float ss = 0.f;
#pragma unroll
    for (int i = 0; i < 4; ++i) { const int c = i * 256 + lane * 4; const float4 xv = *(const float4*)(p.x + (size_t)row * 1024 + c); const u32x2 yv = *(const u32x2*)(Y + (size_t)row * 1024 + c);
      const float4 gp = *(const float4*)(p.g_post1 + c), gt = *(const float4*)(md + 2048 + c);
      x1[i * 4 + 0] = xv.x + gt.x * (lo2f(yv[0]) * ry * gp.x); x1[i * 4 + 1] = xv.y + gt.y * (hi2f(yv[0]) * ry * gp.y);
      x1[i * 4 + 2] = xv.z + gt.z * (lo2f(yv[1]) * ry * gp.z); x1[i * 4 + 3] = xv.w + gt.w * (hi2f(yv[1]) * ry * gp.w);
#pragma unroll
      for (int j = 0; j < 4; ++j) ss += x1[i * 4 + j] * x1[i * 4 + j];
      *(float4*)(p.out + (size_t)row * 1024 + c) = make_float4(x1[i * 4], x1[i * 4 + 1], x1[i * 4 + 2], x1[i * 4 + 3]); }
    ss = wave_sum(ss); const float r2 = rsqrtf(ss * (1.f / 1024.f) + EPS);
#pragma unroll
    for (int i = 0; i < 4; ++i) { const int c = i * 256 + lane * 4; const float4 g2 = *(const float4*)(p.g_pre2 + c), sc = *(const float4*)(md + 4096 + c), sh = *(const float4*)(md + 3072 + c);
      st4bf(HX2 + (size_t)row * 1024 + c, x1[i * 4] * r2 * g2.x * (1.f + sc.x) + sh.x, x1[i * 4 + 1] * r2 * g2.y * (1.f + sc.y) + sh.y,
            x1[i * 4 + 2] * r2 * g2.z * (1.f + sc.z) + sh.z, x1[i * 4 + 3] * r2 * g2.w * (1.f + sc.w) + sh.w); }
  }
  convert_table_fp6(p.u_exp, (unsigned char*)(p.ws + O_RC), (float*)(p.ws + O_RC + (size_t)16384 * 1024));
}

namespace tk {
DEVI int f2sort(float f) { const int i = __float_as_int(f); return i ^ ((i >> 31) & 0x7fffffff); }
DEVI float sort2f(int s) { return __int_as_float(s ^ ((s >> 31) & 0x7fffffff)); }
DEVI void ce_desc(int& a, int& b) { const int hi = max(a, b), lo = min(a, b); a = hi; b = lo; }
DEVI void sort16_desc(int* a) {
#pragma unroll
  for (int lk = 1; lk <= 4; ++lk)
#pragma unroll
    for (int lj = lk - 1; lj >= 0; --lj)
#pragma unroll
      for (int i = 0; i < 16; ++i) { const int j = 1 << lj, k = 1 << lk, l = i ^ j;
        if (l > i) { const int hi = max(a[i], a[l]), lo = min(a[i], a[l]); if ((i & k) == 0) { a[i] = hi; a[l] = lo; } else { a[i] = lo; a[l] = hi; } } }
}
DEVI void bitonic_merge16_desc(int* a) {
#pragma unroll
  for (int lj = 3; lj >= 0; --lj)
#pragma unroll
    for (int i = 0; i < 16; ++i) { const int l = i ^ (1 << lj); if (l > i) ce_desc(a[i], a[l]); }
}
DEVI void merge_top16(int* a, const int* b) {
#pragma unroll
  for (int i = 0; i < 16; ++i) a[i] = max(a[i], b[15 - i]);
  bitonic_merge16_desc(a);
}
DEVI void half_top16(const bf16_t* __restrict__ qrow, const char* Kl, int r32, int hi, int* out) {
  bf16x8 qf[8];
#pragma unroll
  for (int d0 = 0; d0 < 8; ++d0) qf[d0] = *reinterpret_cast<const bf16x8*>(qrow + d0 * 16 + hi * 8);
  int a[64]; const int hi4 = 4 * hi;
#pragma unroll
  for (int kt = 0; kt < 4; ++kt) { f32x16 acc = {};
    const int key = kt * 32 + r32;
#pragma unroll
    for (int d0 = 0; d0 < 8; ++d0) { const bf16x8 kf = *reinterpret_cast<const bf16x8*>(Kl + key * 256 + (((d0 * 2 + hi) ^ (key & 15)) << 4));
      acc = __builtin_amdgcn_mfma_f32_32x32x16_bf16(kf, qf[d0], acc, 0, 0, 0); }
#pragma unroll
    for (int r = 0; r < 16; ++r) { const int kc = kt * 32 + (r & 3) + 8 * (r >> 2); a[kt * 16 + r] = ((f2sort(acc[r]) & ~127) | (127 - kc)) - hi4; } }
  sort16_desc(a); sort16_desc(a + 16); sort16_desc(a + 32); sort16_desc(a + 48);
  merge_top16(a, a + 16); merge_top16(a + 32, a + 48); merge_top16(a, a + 32);
  int L[16], H[16];
#pragma unroll
  for (int i = 0; i < 16; ++i) { auto rr = __builtin_amdgcn_permlane32_swap((unsigned)a[i], (unsigned)a[i], false, false); L[i] = (int)rr[0]; H[i] = (int)rr[1]; }
  merge_top16(L, H);
#pragma unroll
  for (int i = 0; i < 16; ++i) out[i] = L[i];
}
}
DEVI void gather_token_fp6(const Params& p, int t, const int* idx, const float* gw, float* xs, const int* sig);
DEVI void fp6_sigma(int* sig);
DEVI void topk_fast(const Params& p, char* smem) {
  const int tid = threadIdx.x, wave = __builtin_amdgcn_readfirstlane(tid >> 6), lane = tid & 63, r32 = lane & 31, hi = lane >> 5;
  const bf16_t* QP = (const bf16_t*)(p.ws + O_RKV);
  char* K1l = smem; char* K2l = smem + 32768; int* tab = (int*)(smem + 65536) + wave * (32 * 33);
  int* idxl = (int*)(smem + 65536 + 8 * 32 * 33 * 4) + wave * 512; float* gwl = (float*)(smem + 65536 + 8 * 32 * 33 * 4 + 8 * 2048) + wave * 512;
  int* sigl = (int*)(smem + 65536 + 8 * 32 * 33 * 4 + 16 * 2048) + wave * 32;
  fp6_sigma(sigl);
  __syncthreads();
  { const bf16_t* K1 = (const bf16_t*)(p.ws + O_K1);
    for (int id = tid; id < 4096; id += NTHR) { const int key = id >> 4, c = id & 15; const u32x4 v = *(const u32x4*)(K1 + (size_t)key * 128 + c * 8);
      *(u32x4*)(smem + key * 256 + ((c ^ (key & 15)) << 4)) = v; } }
  __syncthreads();
  for (int item = blockIdx.x; item < NTOK * 8 / 256; item += gridDim.x) {
    const int row = item * 256 + wave * 32 + r32;
    const bf16_t* qrow = QP + (size_t)row * 256;
    int t1[16], t2[16];
    tk::half_top16(qrow, K1l, r32, hi, t1);
    __builtin_amdgcn_sched_barrier(0);
    tk::half_top16(qrow + 128, K2l, r32, hi, t2);
    __builtin_amdgcn_sched_barrier(0);
    float v1[16], v2[16];
#pragma unroll
    for (int i = 0; i < 16; ++i) { v1[i] = tk::sort2f(t1[i] & ~127); v2[i] = tk::sort2f(t2[i] & ~127); }
    if (hi == 0) {
#pragma unroll
      for (int i = 0; i < 16; ++i) { tab[r32 * 33 + i] = 127 - (t1[i] & 127); tab[r32 * 33 + 16 + i] = 127 - (t2[i] & 127); } }
#define CAND(i, j) ((tk::f2sort(v1[i] + v2[j]) & ~255) | (255 - ((i) * 16 + (j))))
    int g0[16], g1[16], g2[16];
#pragma unroll
    for (int j = 0; j < 16; ++j) g0[j] = CAND(0, j);
#pragma unroll
    for (int j = 0; j < 8; ++j) g1[j] = CAND(1, j);
#pragma unroll
    for (int j = 0; j < 5; ++j) g1[8 + j] = CAND(2, j);
#pragma unroll
    for (int j = 0; j < 3; ++j) g1[13 + j] = CAND(4, j);
#pragma unroll
    for (int j = 0; j < 4; ++j) g2[j] = CAND(3, j);
    g2[4] = CAND(5, 0); g2[5] = CAND(5, 1); g2[6] = CAND(6, 0); g2[7] = CAND(6, 1); g2[8] = CAND(7, 0); g2[9] = CAND(7, 1);
    g2[10] = CAND(8, 0); g2[11] = CAND(9, 0); g2[12] = CAND(10, 0); g2[13] = CAND(11, 0); g2[14] = CAND(12, 0); g2[15] = CAND(13, 0);
    tk::sort16_desc(g1); tk::sort16_desc(g2);
    tk::merge_top16(g0, g1); tk::merge_top16(g0, g2);
    { int x = CAND(14, 0);
#pragma unroll
      for (int i = 0; i < 16; ++i) { const int h = max(g0[i], x); x = min(g0[i], x); g0[i] = h; }
      x = CAND(15, 0);
#pragma unroll
      for (int i = 0; i < 16; ++i) { const int h = max(g0[i], x); x = min(g0[i], x); g0[i] = h; } }
#undef CAND
    asm volatile("s_waitcnt lgkmcnt(0)" ::: "memory");
    if (hi == 0) {
      int ex[16];
#pragma unroll
      for (int k = 0; k < 16; ++k) { const int pos = 255 - (g0[k] & 255); ex[k] = tab[r32 * 33 + (pos >> 4)] * 128 + tab[r32 * 33 + 16 + (pos & 15)]; }
      int* dst = idxl + r32 * 16;
#pragma unroll
      for (int q = 0; q < 4; ++q) *(int4*)(dst + q * 4) = make_int4(ex[q * 4], ex[q * 4 + 1], ex[q * 4 + 2], ex[q * 4 + 3]);
    } else {
      float e[16]; const float vmax = tk::sort2f(g0[0] & ~255); float sum = 0.f;
#pragma unroll
      for (int k = 0; k < 16; ++k) { e[k] = __expf(tk::sort2f(g0[k] & ~255) - vmax); sum += e[k]; }
      const float inv = 1.f / sum; float* dst = gwl + r32 * 16;
#pragma unroll
      for (int q = 0; q < 4; ++q) *(float4*)(dst + q * 4) = make_float4(e[q * 4] * inv, e[q * 4 + 1] * inv, e[q * 4 + 2] * inv, e[q * 4 + 3] * inv);
    }
    asm volatile("s_waitcnt lgkmcnt(0)" ::: "memory"); __builtin_amdgcn_sched_barrier(0);
#pragma unroll 1
    for (int tl = 0; tl < 4; ++tl) gather_token_fp6(p, item * 32 + wave * 4 + tl, idxl + tl * 128, gwl + tl * 128, (float*)tab, sigl);
    asm volatile("s_waitcnt lgkmcnt(0)" ::: "memory"); __builtin_amdgcn_sched_barrier(0);
  }
}
DEVI void ph_topk(const Params& p, char* smem) { topk_fast(p, smem); }

DEVI void fp6_sigma(int* sig) {
  f32x16 ra, rb;
#pragma unroll
  for (int i = 0; i < 16; ++i) { ra[i] = i < 8 ? i * 0.125f : 1.f + (i - 8) * 0.125f; rb[i] = i < 8 ? 2.f + i * 0.25f : 4.f + (i - 8) * 0.5f; }
  const u32x6 w = __builtin_amdgcn_cvt_scalef32_2xpk16_fp6_f32(ra, rb, 1.0f);
  const f32x32 d = __builtin_amdgcn_cvt_scalef32_pk32_f32_fp6(w, 1.0f);
  if ((threadIdx.x & 63) == 0) {
#pragma unroll
    for (int i = 0; i < 32; ++i) { const float v = d[i]; sig[i] = v < 1.f ? (int)(v * 8.f + 0.5f) : v < 2.f ? 8 + (int)((v - 1.f) * 8.f + 0.5f) : v < 4.f ? 16 + (int)((v - 2.f) * 4.f + 0.5f) : 24 + (int)((v - 4.f) * 2.f + 0.5f); } }
}
constexpr int G6 = 4;
DEVI void gather_token_fp6(const Params& p, int t, const int* idx, const float* gw, float* xs, const int* sig) {
  int lane = threadIdx.x & 63; asm volatile("" : "+v"(lane));
  const int h = lane >> 5, g = lane & 31;
  const bf16_t* HX2 = (const bf16_t*)(p.ws + O_RB);
  const unsigned char* UT = (const unsigned char*)(p.ws + O_RC); const float* SU = (const float*)(p.ws + O_RC + (size_t)16384 * 1024);
  const unsigned char* VT = (const unsigned char*)(p.ws + O_RA); const float* SV = (const float*)(p.ws + O_RA + (size_t)16384 * 1024);
  const float* MOD = (const float*)(p.ws + O_MOD);
  if (h == 0) { float xf[32];
#pragma unroll
    for (int q = 0; q < 4; ++q) unpack8(*(const u32x4*)(HX2 + (size_t)t * 1024 + g * 32 + q * 8), xf + q * 8);
#pragma unroll
    for (int j = 0; j < 32; ++j) xs[j * 32 + g] = xf[j]; }
  asm volatile("s_waitcnt lgkmcnt(0)" ::: "memory"); __builtin_amdgcn_sched_barrier(0);
  float xp[32], acc[32];
#pragma unroll
  for (int i = 0; i < 32; ++i) { xp[i] = xs[sig[i] * 32 + g]; acc[i] = 0.f; }
#pragma unroll 1
  for (int half = 0; half < 2; ++half) {
    const int my_i = idx[half * 64 + lane]; const float my_g = gw[half * 64 + lane];
    const float my_su = SU[my_i], my_sv = SV[my_i];
#pragma unroll 1
    for (int e0 = 0; e0 < 64; e0 += 2 * G6) {
      u32x6 uq[G6], vq[G6]; float cs[G6];
#pragma unroll
      for (int j = 0; j < G6; ++j) { const int ia = __builtin_amdgcn_readlane(my_i, e0 + 2 * j), ib = __builtin_amdgcn_readlane(my_i, e0 + 2 * j + 1); const int id = h ? ib : ia;
        const unsigned char* up = UT + (size_t)id * 768 + g * 24; const unsigned char* vp = VT + (size_t)id * 768 + g * 24;
        const u32x4 u0 = *(const u32x4_u*)up; const u32x2 u1 = *(const u32x2_u*)(up + 16); const u32x4 v0 = *(const u32x4_u*)vp; const u32x2 v1 = *(const u32x2_u*)(vp + 16);
        uq[j] = (u32x6){u0[0], u0[1], u0[2], u0[3], u1[0], u1[1]}; vq[j] = (u32x6){v0[0], v0[1], v0[2], v0[3], v1[0], v1[1]}; }
#pragma unroll
      for (int j = 0; j < G6; ++j) { const f32x32 uf = __builtin_amdgcn_cvt_scalef32_pk32_f32_fp6(uq[j], 1.0f); float d = 0.f;
#pragma unroll
        for (int k = 0; k < 32; ++k) d += xp[k] * uf[k];
        cs[j] = d; __builtin_amdgcn_sched_barrier(0); }
#pragma unroll
      for (int j = 0; j < G6; ++j) { float v = cs[j];
        v += __builtin_bit_cast(float, __builtin_amdgcn_update_dpp(0, __builtin_bit_cast(int, v), 0xB1, 0xf, 0xf, true));
        v += __builtin_bit_cast(float, __builtin_amdgcn_update_dpp(0, __builtin_bit_cast(int, v), 0x4E, 0xf, 0xf, true));
        v += __builtin_bit_cast(float, __builtin_amdgcn_update_dpp(0, __builtin_bit_cast(int, v), 0x141, 0xf, 0xf, true));
        v += __builtin_bit_cast(float, __builtin_amdgcn_update_dpp(0, __builtin_bit_cast(int, v), 0x140, 0xf, 0xf, true));
        const int iv = __builtin_bit_cast(int, v);
        const float s0 = __builtin_bit_cast(float, __builtin_amdgcn_readlane(iv, 0)) + __builtin_bit_cast(float, __builtin_amdgcn_readlane(iv, 16));
        const float s1 = __builtin_bit_cast(float, __builtin_amdgcn_readlane(iv, 32)) + __builtin_bit_cast(float, __builtin_amdgcn_readlane(iv, 48));
        const int ea = e0 + 2 * j, eb = ea + 1;
        const float ga = __builtin_bit_cast(float, __builtin_amdgcn_readlane(__builtin_bit_cast(int, my_g), ea)), gb = __builtin_bit_cast(float, __builtin_amdgcn_readlane(__builtin_bit_cast(int, my_g), eb));
        const float sua = __builtin_bit_cast(float, __builtin_amdgcn_readlane(__builtin_bit_cast(int, my_su), ea)), sub = __builtin_bit_cast(float, __builtin_amdgcn_readlane(__builtin_bit_cast(int, my_su), eb));
        const float sva = __builtin_bit_cast(float, __builtin_amdgcn_readlane(__builtin_bit_cast(int, my_sv), ea)), svb = __builtin_bit_cast(float, __builtin_amdgcn_readlane(__builtin_bit_cast(int, my_sv), eb));
        const float ca = ga * gelu_t(s0 * sua) * sva, cb = gb * gelu_t(s1 * sub) * svb;
        cs[j] = h ? cb : ca; }
#pragma unroll
      for (int j = 0; j < G6; ++j) { const f32x32 vf = __builtin_amdgcn_cvt_scalef32_pk32_f32_fp6(vq[j], 1.0f);
#pragma unroll
        for (int k = 0; k < 32; ++k) acc[k] += cs[j] * vf[k];
        __builtin_amdgcn_sched_barrier(0); }
    }
  }
#pragma unroll
  for (int i = 0; i < 32; ++i) { auto rr = __builtin_amdgcn_permlane32_swap(__float_as_uint(acc[i]), __float_as_uint(acc[i]), false, false); acc[i] = __uint_as_float(rr[0]) + __uint_as_float(rr[1]); }
  if (h == 0) {
#pragma unroll
    for (int i = 0; i < 32; ++i) xs[sig[i] * 32 + g] = acc[i]; }
  asm volatile("s_waitcnt lgkmcnt(0)" ::: "memory"); __builtin_amdgcn_sched_barrier(0);
  float o[16]; float ss = 0.f;
#pragma unroll
  for (int j = 0; j < 16; ++j) { o[j] = xs[(16 * h + j) * 32 + g]; ss += o[j] * o[j]; }
  ss = wave_sum(ss); const float rstd = rsqrtf(ss * (1.f / 1024.f) + EPS);
  const int b = t >> 13, c0 = g * 32 + h * 16; const float* gt2 = MOD + b * 6144 + 5120 + c0;
  float* op = p.out + (size_t)t * 1024 + c0;
#pragma unroll
  for (int q4 = 0; q4 < 4; ++q4) { float4 xv = *(const float4*)(op + q4 * 4); const float4 gt = *(const float4*)(gt2 + q4 * 4), gp = *(const float4*)(p.g_post2 + c0 + q4 * 4);
    xv.x += gt.x * (o[q4 * 4 + 0] * rstd * gp.x); xv.y += gt.y * (o[q4 * 4 + 1] * rstd * gp.y);
    xv.z += gt.z * (o[q4 * 4 + 2] * rstd * gp.z); xv.w += gt.w * (o[q4 * 4 + 3] * rstd * gp.w);
    *(float4*)(op + q4 * 4) = xv; }
  asm volatile("s_waitcnt lgkmcnt(0)" ::: "memory"); __builtin_amdgcn_sched_barrier(0);
}

#define XB_TMO      128
#define XB_XCNT(j)  (256  + 64 * (j))
#define XB_XSUB(j)  (1280 + 64 * (j))
#define XB_XGEN(j)  (2304 + 64 * (j))
#define XB_TOP      3328
#define XB_TOPGEN   3392
#define XCD_BAR_WORDS 3456
#define XB_SPIN_CAP (1u << 18)
#define LAS __attribute__((address_space(3)))
DEVI unsigned xb_ld(unsigned* p)              { return __hip_atomic_load(p, __ATOMIC_RELAXED, __HIP_MEMORY_SCOPE_AGENT); }
DEVI unsigned xb_add(unsigned* p, unsigned v) { return __hip_atomic_fetch_add(p, v, __ATOMIC_RELAXED, __HIP_MEMORY_SCOPE_AGENT); }
DEVI unsigned xb_xcc_id() { return (unsigned)__builtin_amdgcn_s_getreg((3 << 11) | 20) & 0xFu; }
#define XB_SPIN(cond, bar) do { unsigned _sp = 0; while (cond) { __builtin_amdgcn_s_sleep(1); \
    if ((++_sp & 255u) == 0u) { if (xb_ld(&(bar)[XB_TMO])) break; if (_sp > XB_SPIN_CAP) { atomicAdd(&(bar)[XB_TMO], 1u); break; } } } } while (0)
struct XcdBarrier { unsigned* bar; unsigned x; volatile LAS unsigned* st; };
DEVI XcdBarrier xcd_barrier_post(unsigned* bar, volatile LAS unsigned* st) {
  XcdBarrier b; b.bar = bar; b.x = xb_xcc_id(); b.st = st;
  if (threadIdx.x == 0) (void)xb_add(&bar[XB_XCNT(b.x)], 1u);
  return b;
}
DEVI void xcd_barrier_complete(unsigned* bar, unsigned x, unsigned& nloc, unsigned& nx) {
  const unsigned G = gridDim.x * gridDim.y * gridDim.z;
  unsigned sum, cnt, mine, sp = 0u;
  for (;;) {
    sum = 0u; cnt = 0u; mine = 0u;
#pragma unroll
    for (unsigned j = 0; j < 16; ++j) { const unsigned c = xb_ld(&bar[XB_XCNT(j)]); sum += c; cnt += (c > 0u) ? 1u : 0u; mine = (j == x) ? c : mine; }
    if (sum == G) break;
    __builtin_amdgcn_s_sleep(1);
    if ((++sp & 255u) == 0u) { if (xb_ld(&bar[XB_TMO])) break; if (sp > XB_SPIN_CAP) { atomicAdd(&bar[XB_TMO], 1u); break; } }
  }
  nloc = mine > 0u ? mine : 1u; nx = cnt > 0u ? cnt : 1u;
}
DEVI void xcd_barrier(const XcdBarrier& b) {
  asm volatile("s_waitcnt vmcnt(0)" ::: "memory");
  __syncthreads();
  if (threadIdx.x == 0) {
    unsigned* bar = b.bar;
    __builtin_amdgcn_s_waitcnt(0);
    unsigned nloc = b.st[0], nx = b.st[1];
    if (nloc == 0u) { xcd_barrier_complete(bar, b.x, nloc, nx); b.st[0] = nloc; b.st[1] = nx; }
    const unsigned old = xb_add(&bar[XB_XSUB(b.x)], 1u);
    const unsigned gen = old / nloc;
    if (old + 1u == (gen + 1u) * nloc) {
      __builtin_amdgcn_fence(__ATOMIC_RELEASE, "agent");
      asm volatile("s_waitcnt vmcnt(0)" ::: "memory");
      const unsigned og = xb_add(&bar[XB_TOP], 1u);
      const unsigned tg = og / nx;
      if (og + 1u == (tg + 1u) * nx) xb_add(&bar[XB_TOPGEN], 1u);
      else XB_SPIN(xb_ld(&bar[XB_TOPGEN]) == tg, bar);
      __builtin_amdgcn_fence(__ATOMIC_ACQUIRE, "agent");
      xb_add(&bar[XB_XGEN(b.x)], 1u);
      asm volatile("s_waitcnt vmcnt(0)" ::: "memory");
    } else {
      XB_SPIN(xb_ld(&bar[XB_XGEN(b.x)]) == gen, bar);
      __builtin_amdgcn_fence(__ATOMIC_ACQUIRE, "agent");
      asm volatile("s_waitcnt vmcnt(0)" ::: "memory");
    }
  }
  __syncthreads();
}

constexpr int NPHASE = 11;
template <int PH> DEVI void run_phase(const Params& p, char* smem) {
  if constexpr (PH == 0) ph_prep(p, smem);
  else if constexpr (PH == 1) ph_hx(p, smem);
  else if constexpr (PH == 2) ph_inproj(p, smem);
  else if constexpr (PH == 3) ph_mid(p, smem);
  else if constexpr (PH == 4) ph_attn(p, smem);
  else if constexpr (PH == 5) ph_gates(p, smem);
  else if constexpr (PH == 6) ph_merge(p, smem);
  else if constexpr (PH == 7) ph_wo(p, smem);
  else if constexpr (PH == 8) ph_rows(p, smem);
  else if constexpr (PH == 9) ph_wpq(p, smem);
  else if constexpr (PH == 10) ph_topk(p, smem);
}

#ifndef PROBE_PH
#define PROBE_PH -1
#endif
#define RUNPH(N) do { if (PROBE_PH == N) t0 = __builtin_amdgcn_s_memrealtime(); run_phase<N>(p, smem); if (N < NPHASE - 1) xcd_barrier(xb); \
    if (PROBE_PH == N) t1 = __builtin_amdgcn_s_memrealtime(); } while (0)
__global__ __launch_bounds__(NTHR) void k_mega(Params p) {
  extern __shared__ __attribute__((aligned(16))) char smem[];
  cg::grid_group grid = cg::this_grid();
  unsigned long long t0 = 0, t1 = 0;
  unsigned* bar = (unsigned*)(p.ws + O_BAR);
  volatile LAS unsigned* xst = (volatile LAS unsigned*)(smem + LDS_BYTES - 16);
  if (threadIdx.x == 0) { xst[0] = 0u; xst[1] = 0u; }
  __syncthreads();
  const XcdBarrier xb = xcd_barrier_post(bar, xst);
  if (p.out == nullptr) grid.sync();
  RUNPH(0);
  RUNPH(1); RUNPH(2); RUNPH(3); RUNPH(4); RUNPH(5); RUNPH(6); RUNPH(7); RUNPH(8); RUNPH(9); RUNPH(10);
  if (PROBE_PH >= 0) { __syncthreads(); if (blockIdx.x == 0 && threadIdx.x == 0) p.out[0] += exp2f(rintf(log2f((float)(t1 - t0) * 1e-3f) * 5.f) * 0.2f); }
}

extern "C" void kernel_launch(void* const* d_in, const int* in_sizes, int n_in, void* d_out, int out_size, void* d_ws, size_t ws_size, hipStream_t stream) {
  static int grid = 0;
  if (grid == 0) {
    if (n_in != 26 || out_size != NTOK * DM || ws_size < O_END) { fprintf(stderr, "kernel_launch: unexpected shapes n_in %d out %d ws %zu (need %zu)\n", n_in, out_size, ws_size, (size_t)O_END); grid = -1; return; }
    (void)hipFuncSetAttribute((const void*)k_mega, hipFuncAttributeMaxDynamicSharedMemorySize, LDS_BYTES);
    int dev = 0, cus = 0, per_cu = 0; (void)hipGetDevice(&dev); (void)hipDeviceGetAttribute(&cus, hipDeviceAttributeMultiprocessorCount, dev);
    (void)hipOccupancyMaxActiveBlocksPerMultiprocessor(&per_cu, (const void*)k_mega, NTHR, LDS_BYTES);
    if (per_cu < 1) { fprintf(stderr, "kernel_launch: occupancy query says %d blocks per CU\n", per_cu); grid = -1; return; }
    grid = cus;
  }
  if (grid < 0) return;
  Params p{};
  const float** pp = (const float**)&p;
  for (int i = 0; i < 26; ++i) pp[i] = (const float*)d_in[i];
  p.out = (float*)d_out; p.ws = (char*)d_ws;
  (void)hipMemsetAsync((char*)d_ws + O_BAR, 0, (size_t)XCD_BAR_WORDS * 4, stream);
  void* args[] = {&p};
  hipError_t e = hipLaunchCooperativeKernel((const void*)k_mega, dim3(grid), dim3(NTHR), args, LDS_BYTES, stream);
  if (e != hipSuccess) fprintf(stderr, "cooperative launch failed: %s (grid %d)\n", hipGetErrorString(e), grid);
}
```

```cpp
#include <hip/hip_runtime.h>
#include <hip/hip_cooperative_groups.h>
#include <cstdint>
#include <cstdio>
namespace cg = cooperative_groups;

#define DEVI __device__ __forceinline__
typedef unsigned short bf16_t;
using bf16x8 = __attribute__((ext_vector_type(8))) short;
using bf16x4 = __attribute__((ext_vector_type(4))) short;
using f32x4  = __attribute__((ext_vector_type(4))) float;
using f32x16 = __attribute__((ext_vector_type(16))) float;
using u32x4  = __attribute__((ext_vector_type(4))) unsigned;
using u32x2  = __attribute__((ext_vector_type(2))) unsigned;

constexpr int DM = 1024, NB = 2, SEQ = 8192, NTOK = NB * SEQ, CTXL = 256, NCTX = NB * CTXL, NROW = NTOK + NCTX, NKEY = SEQ + CTXL;
constexpr int INW = 4544, INWP = 4608;
constexpr int NPRE = 2560;
constexpr float EPS = 1e-6f;
constexpr int NTHR = 512, NWAVE = 8;
constexpr int LDS_BYTES = 147456;

constexpr size_t al256(size_t x) { return (x + 255) / 256 * 256; }
constexpr size_t O_WIN   = 0;
constexpr size_t O_WUQ   = O_WIN  + al256((size_t)INWP * 1024 * 2);
constexpr size_t O_WUKV  = O_WUQ  + al256((size_t)1536 * 256 * 2);
constexpr size_t O_WPA   = O_WUKV + al256((size_t)2048 * 128 * 2);
constexpr size_t O_WPB   = O_WPA  + al256((size_t)1024 * 1024 * 2);
constexpr size_t O_WO    = O_WPB  + al256((size_t)1024 * 1024 * 2);
constexpr size_t O_WPQ   = O_WO   + al256((size_t)1024 * 1024 * 2);
constexpr size_t O_WS    = O_WPQ  + al256((size_t)2048 * 1024 * 2);
constexpr size_t O_K1    = O_WS   + al256((size_t)8 * 128 * 128 * 2);
constexpr size_t O_K2    = O_K1   + al256((size_t)128 * 128 * 2);
constexpr size_t O_MOD   = O_K2   + al256((size_t)128 * 128 * 2);
constexpr size_t O_ROPE  = O_MOD  + al256((size_t)3 * 6144 * 4);
constexpr size_t O_BAR   = O_ROPE + al256((size_t)128 * 16 * 2 * 4);
constexpr size_t O_RSSV  = O_BAR + al256((size_t)3456 * 4);
constexpr size_t O_RSSQ  = O_RSSV + (size_t)NTOK * 32 * 4;
constexpr size_t O_RSSKV = O_RSSQ + (size_t)NTOK * 8 * 4;
constexpr size_t O_RSSY  = O_RSSKV + (size_t)NROW * 4 * 4;
constexpr size_t O_RSSEND = O_RSSY + (size_t)NTOK * 32 * 4;
constexpr size_t O_RA    = al256(O_RSSEND);
constexpr size_t O_RB    = O_RA  + al256((size_t)NROW * 1024 * 2);
constexpr size_t O_RC    = O_RB  + al256((size_t)NTOK * 1024 * 2);
constexpr size_t O_CQ    = O_RC  + al256((size_t)NTOK * 1024 * 2);
constexpr size_t O_CKV   = O_CQ  + al256((size_t)NTOK * 256 * 2);
constexpr size_t O_KR    = O_CKV + al256((size_t)NROW * 128 * 2);
constexpr size_t O_RQ    = O_KR  + al256((size_t)NROW * 64 * 2);
constexpr size_t O_RKV   = O_RQ  + al256((size_t)NTOK * 1536 * 2);
constexpr size_t O_END   = O_RKV + al256((size_t)NROW * 2048 * 2);
static_assert(O_END <= (size_t)258 * 1024 * 1024, "workspace too large");

struct Params {
  const float *x, *c, *ctx, *c_ctx, *w_mod, *b_mod, *g_pre1, *g_post1, *g_pre2, *g_post2, *w_in, *g_q, *g_kv, *w_uq, *w_ukv, *g_sgu, *w_s, *b_s,
      *w_pa, *w_pb, *w_o, *w_pq, *k1, *k2, *u_exp, *v_exp;
  float* out; char* ws;
};

DEVI float bf2f(unsigned short h) { return __uint_as_float(((unsigned)h) << 16); }
DEVI unsigned short f2bf(float f) { unsigned u = __float_as_uint(f); u += 0x7fffu + ((u >> 16) & 1u); return (unsigned short)(u >> 16); }
DEVI unsigned pack2(float a, float b) { unsigned r; asm("v_cvt_pk_bf16_f32 %0, %1, %2" : "=v"(r) : "v"(a), "v"(b)); return r; }
DEVI float lo2f(unsigned w) { return __uint_as_float(w << 16); }
DEVI float hi2f(unsigned w) { return __uint_as_float(w & 0xffff0000u); }
DEVI void unpack8(const u32x4& w, float* f) {
  f[0] = lo2f(w[0]); f[1] = hi2f(w[0]); f[2] = lo2f(w[1]); f[3] = hi2f(w[1]); f[4] = lo2f(w[2]); f[5] = hi2f(w[2]); f[6] = lo2f(w[3]); f[7] = hi2f(w[3]);
}
DEVI float gelu_t(float x) { float z = 0.7978845608028654f * (x + 0.044715f * x * x * x); return x / (1.f + __expf(-2.f * z)); }
DEVI float sigmoidf_(float x) { return 1.f / (1.f + __expf(-x)); }
DEVI float wave_sum(float v) { for (int o = 32; o > 0; o >>= 1) v += __shfl_xor(v, o); return v; }
DEVI float wave_max(float v) { for (int o = 32; o > 0; o >>= 1) v = fmaxf(v, __shfl_xor(v, o)); return v; }
DEVI void keyrow2(int row, int& b, int& key) { if (row < NTOK) { b = row >> 13; key = row & 8191; } else { const int c = row - NTOK; b = c >> 8; key = SEQ + (c & 255); } }
DEVI int keyrow(int row) { if (row < NTOK) return (row >> 13) * NKEY + (row & 8191); int c = row - NTOK; return (c >> 8) * NKEY + SEQ + (c & 255); }

__device__ const float ROPE_FREQ[16] = {1.0f, 0.5623413324356079f, 0.3162277638912201f, 0.17782793939113617f, 0.10000000149011612f, 0.05623413249850273f, 0.03162277489900589f, 0.017782794311642647f, 0.009999999776482582f, 0.005623413249850273f, 0.003162277629598975f, 0.0017782794311642647f, 0.0010000000474974513f, 0.000562341301701963f, 0.0003162277571391314f, 0.00017782794020604342f};
DEVI void sincos_small(double a, double& cs, double& sn) {
  const double k = rint(a * 0.15915494309189535); const double r = fma(-k, 6.283185307179586, a) - k * 2.4492935982947064e-16;
  const double r2 = r * r; double s = 0.0, c = 0.0;
#pragma unroll
  for (int n = 12; n >= 1; --n) { s = (1.0 - s * r2 / (double)((2 * n) * (2 * n + 1))); c = (1.0 - c * r2 / (double)((2 * n - 1) * (2 * n))); }
  sn = r * s; cs = c;
}

DEVI void transpose_job(const float* __restrict__ src, int K, int N, bf16_t* __restrict__ dst, const float* __restrict__ gk, bool isWin, int ntiles, char* smem) {
  const int tid = threadIdx.x; bf16_t* tl = (bf16_t*)smem; const int kt = K / 64;
  for (int idx = blockIdx.x; idx < ntiles; idx += gridDim.x) {
    const int ktile = idx % kt, ntile = idx / kt, k0 = ktile * 64, n0d = ntile * 64;
    int n0s = n0d; bool zero = false;
    if (isWin) { if (n0d == 2496) zero = true; else if (n0d >= 2560) n0s = n0d - 64; }
    { const int kk = tid >> 3, nn8 = (tid & 7) * 8; f32x4 va = {0.f, 0.f, 0.f, 0.f}, vb = va;
      if (!zero) { const float* s = src + (size_t)(k0 + kk) * N + n0s + nn8; const float4 a = *(const float4*)s, b = *(const float4*)(s + 4);
        const float sc = gk ? gk[k0 + kk] : 1.f; va = (f32x4){a.x, a.y, a.z, a.w} * sc; vb = (f32x4){b.x, b.y, b.z, b.w} * sc; }
      bf16_t* tp = tl + nn8 * 72 + kk;
      tp[0] = f2bf(va[0]); tp[72] = f2bf(va[1]); tp[144] = f2bf(va[2]); tp[216] = f2bf(va[3]); tp[288] = f2bf(vb[0]); tp[360] = f2bf(vb[1]); tp[432] = f2bf(vb[2]); tp[504] = f2bf(vb[3]); }
    __syncthreads();
    { const int nn = tid >> 3, kk8 = (tid & 7) * 8;
      const u32x4 o = *(const u32x4*)(tl + nn * 72 + kk8);
      *(u32x4*)(dst + (size_t)(n0d + nn) * K + k0 + kk8) = o; }
    __syncthreads();
  }
}

DEVI void ph_prep(const Params& p, char* smem) {
  const int tid = threadIdx.x, bid = blockIdx.x, nb = gridDim.x;
  char* ws = p.ws;
  if (bid == 0) { float* rope = (float*)(ws + O_ROPE);
    for (int i = tid; i < 128 * 16; i += NTHR) { const int pos = i >> 4, f = i & 15; const float ang = (float)pos * ROPE_FREQ[f];
      double cs, sn; sincos_small((double)ang, cs, sn); rope[i * 2] = (float)cs; rope[i * 2 + 1] = (float)sn; } }
  { float* red = (float*)smem; float* MOD = (float*)(ws + O_MOD);
    for (int it = bid; it < 256; it += nb) {
      const int cgp = tid % 6, kg = tid / 6;
      f32x4 a0 = {0.f, 0.f, 0.f, 0.f}, a1 = a0, a2 = a0;
      if (tid < 510) {
        for (int k = kg; k < 1024; k += 85) {
          const float4 w4 = *(const float4*)(p.w_mod + (size_t)k * 6144 + it * 24 + cgp * 4);
          const f32x4 w = {w4.x, w4.y, w4.z, w4.w};
          const float c0 = p.c[k], c1 = p.c[1024 + k], c2 = p.c_ctx[k];
          a0 += w * (c0 / (1.f + __expf(-c0))); a1 += w * (c1 / (1.f + __expf(-c1))); a2 += w * (c2 / (1.f + __expf(-c2)));
        }
        float* rp = red + kg * 72 + cgp * 4;
        rp[0] = a0[0]; rp[1] = a0[1]; rp[2] = a0[2]; rp[3] = a0[3];
        rp[24] = a1[0]; rp[25] = a1[1]; rp[26] = a1[2]; rp[27] = a1[3];
        rp[48] = a2[0]; rp[49] = a2[1]; rp[50] = a2[2]; rp[51] = a2[3];
      }
      __syncthreads();
      if (tid < 72) { float s = 0.f; for (int g = 0; g < 85; ++g) s += red[g * 72 + tid]; int r = tid / 24, n = it * 24 + tid % 24; MOD[r * 6144 + n] = s + p.b_mod[n]; }
      __syncthreads();
    } }
  transpose_job(p.w_in,  1024, INW,  (bf16_t*)(ws + O_WIN),  nullptr, true,  1152, smem);
  transpose_job(p.w_uq,  256,  1536, (bf16_t*)(ws + O_WUQ),  p.g_q,   false, 96,   smem);
  transpose_job(p.w_ukv, 128,  2048, (bf16_t*)(ws + O_WUKV), p.g_kv,  false, 64,   smem);
  transpose_job(p.w_pa,  1024, 1024, (bf16_t*)(ws + O_WPA),  nullptr, false, 256,  smem);
  transpose_job(p.w_pb,  1024, 1024, (bf16_t*)(ws + O_WPB),  nullptr, false, 256,  smem);
  transpose_job(p.w_o,   1024, 1024, (bf16_t*)(ws + O_WO),   nullptr, false, 256,  smem);
  transpose_job(p.w_pq,  1024, 2048, (bf16_t*)(ws + O_WPQ),  nullptr, false, 512,  smem);
  { const int n8 = (131072 + 16384 + 16384) / 8;
    for (int i = bid * NTHR + tid; i < n8; i += nb * NTHR) {
      int e = i * 8; const float* s; bf16_t* d;
      if (e < 131072) { s = p.w_s + e; d = (bf16_t*)(ws + O_WS) + e; }
      else if (e < 131072 + 16384) { s = p.k1 + (e - 131072); d = (bf16_t*)(ws + O_K1) + (e - 131072); }
      else { s = p.k2 + (e - 131072 - 16384); d = (bf16_t*)(ws + O_K2) + (e - 131072 - 16384); }
      const float4 a = *(const float4*)s, b = *(const float4*)(s + 4);
      u32x4 o = {pack2(a.x, a.y), pack2(a.z, a.w), pack2(b.x, b.y), pack2(b.z, b.w)};
      *(u32x4*)d = o;
    } }
}


using f32x32 = __attribute__((ext_vector_type(32))) float;
using u32x6 = __attribute__((ext_vector_type(6))) unsigned;
typedef u32x4 __attribute__((aligned(4))) u32x4_u;
typedef u32x2 __attribute__((aligned(4))) u32x2_u;
DEVI void convert_table_fp6(const float* __restrict__ src, unsigned char* __restrict__ dst, float* __restrict__ scale) {
  const int wave = threadIdx.x >> 6, lane = threadIdx.x & 63, h = lane >> 5, g = lane & 31;
  for (int rp = blockIdx.x * NWAVE + wave; rp < 8192; rp += gridDim.x * NWAVE) {
    const int row = rp * 2 + h;
    const float* sp = src + (size_t)row * 1024 + g * 32;
    f32x16 a, b; float am = 0.f;
#pragma unroll
    for (int j = 0; j < 4; ++j) { const float4 t = *(const float4*)(sp + j * 4), u = *(const float4*)(sp + 16 + j * 4);
      a[j * 4] = t.x; a[j * 4 + 1] = t.y; a[j * 4 + 2] = t.z; a[j * 4 + 3] = t.w; b[j * 4] = u.x; b[j * 4 + 1] = u.y; b[j * 4 + 2] = u.z; b[j * 4 + 3] = u.w;
      am = fmaxf(am, fmaxf(fmaxf(fmaxf(fabsf(t.x), fabsf(t.y)), fmaxf(fabsf(t.z), fabsf(t.w))), fmaxf(fmaxf(fabsf(u.x), fabsf(u.y)), fmaxf(fabsf(u.z), fabsf(u.w))))); }
    for (int o = 16; o > 0; o >>= 1) am = fmaxf(am, __shfl_xor(am, o));
    const float inv = am > 0.f ? 7.5f / am : 0.f;
    const u32x6 w = __builtin_amdgcn_cvt_scalef32_2xpk16_fp6_f32(a * inv, b * inv, 1.0f);
    unsigned char* dp = dst + (size_t)row * 768 + g * 24;
    *(u32x4_u*)dp = (u32x4){w[0], w[1], w[2], w[3]}; *(u32x2_u*)(dp + 16) = (u32x2){w[4], w[5]};
    if (g == 0) scale[row] = am * (1.f / 7.5f);
  }
}

DEVI void ph_hx(const Params& p, char* smem) {
  const int tid = threadIdx.x, wave = tid >> 6, lane = tid & 63;
  float* mA = (float*)smem; float* mB = mA + 3 * 1024;
  const float* MOD = (const float*)(p.ws + O_MOD);
  for (int i = tid; i < 3072; i += NTHR) { int r = i >> 10, c = i & 1023; mA[i] = p.g_pre1[c] * (1.f + MOD[r * 6144 + 1024 + c]); mB[i] = MOD[r * 6144 + c]; }
  __syncthreads();
  bf16_t* HX = (bf16_t*)(p.ws + O_RA);
  for (int row = blockIdx.x * NWAVE + wave; row < NROW; row += gridDim.x * NWAVE) {
    const float* src = row < NTOK ? p.x + (size_t)row * 1024 : p.ctx + (size_t)(row - NTOK) * 1024;
    const int mr = row < NTOK ? (row >> 13) : 2;
    float4 v[4]; float ss = 0.f;
#pragma unroll
    for (int i = 0; i < 4; ++i) { v[i] = *(const float4*)(src + i * 256 + lane * 4); ss += v[i].x * v[i].x + v[i].y * v[i].y + v[i].z * v[i].z + v[i].w * v[i].w; }
    ss = wave_sum(ss); const float rstd = rsqrtf(ss * (1.f / 1024.f) + EPS);
#pragma unroll
    for (int i = 0; i < 4; ++i) { const int c = i * 256 + lane * 4; const float* a = mA + mr * 1024 + c; const float* b = mB + mr * 1024 + c;
      u32x2 o = {pack2(v[i].x * rstd * a[0] + b[0], v[i].y * rstd * a[1] + b[1]), pack2(v[i].z * rstd * a[2] + b[2], v[i].w * rstd * a[3] + b[3])};
      *(u32x2*)(HX + (size_t)row * 1024 + c) = o; }
  }
}

DEVI int lds_sw(int row, int c) { return row * 128 + ((c ^ (row & 7)) << 4); }
template <int BM, int BN, bool ACOLMAP, bool GLDS, class Epi>
DEVI void gemm_tile_mfma(const bf16_t* __restrict__ A, int lda, const bf16_t* __restrict__ Bm, int ldb, int K, int row0, int col0, const Epi& epi, const float* kscale, char* smem) {
  constexpr int WNW = BN / 64, WMW = 8 / WNW, WTM = BM / WMW, MI = WTM / 16, ACH = BM / 64, BCH = BN / 64, ABYTES = BM * 128, BBYTES = BN * 128, STAGE = ABYTES + BBYTES;
  int tid = threadIdx.x; asm volatile("" : "+v"(tid));
  const int wave = __builtin_amdgcn_readfirstlane(tid >> 6), lane = tid & 63, wm = wave / WNW, wn = wave % WNW, l15 = lane & 15, lq = lane >> 4;
  f32x4 acc[MI][4];
#pragma unroll
  for (int mi = 0; mi < MI; ++mi)
#pragma unroll
    for (int ni = 0; ni < 4; ++ni) acc[mi][ni] = (f32x4){0.f, 0.f, 0.f, 0.f};
  const int nk = K >> 6;
  const int sr = tid >> 3, scc = tid & 7;
  auto compute = [&](int buf) {
    const char* sa = smem + buf * STAGE; const char* sb = sa + ABYTES;
#pragma unroll
    for (int ks = 0; ks < 2; ++ks) { const int kc = ks * 4 + lq; bf16x8 bfr[4];
#pragma unroll
      for (int ni = 0; ni < 4; ++ni) bfr[ni] = *(const bf16x8*)(sb + lds_sw(wn * 64 + ni * 16 + l15, kc));
#pragma unroll
      for (int mi = 0; mi < MI; ++mi) { const bf16x8 af = *(const bf16x8*)(sa + lds_sw(wm * WTM + mi * 16 + l15, kc));
#pragma unroll
        for (int ni = 0; ni < 4; ++ni) acc[mi][ni] = __builtin_amdgcn_mfma_f32_16x16x32_bf16(bfr[ni], af, acc[mi][ni], 0, 0, 0); }
    }
  };
  if constexpr (GLDS) {
    const unsigned aoff = (unsigned)(sr * lda + ((scc ^ (sr & 7)) * 8)) * 2u, boff = (unsigned)(sr * ldb + ((scc ^ (sr & 7)) * 8)) * 2u;
    auto gstage = [&](int buf, int kt) {
      const int k0 = kt * 64, ka = ACOLMAP ? k0 + (k0 >> 7) * 64 : k0;
      char* sa = smem + buf * STAGE + wave * 1024; char* sb = sa + ABYTES;
#pragma unroll
      for (int i = 0; i < ACH; ++i) __builtin_amdgcn_global_load_lds((const unsigned*)((const char*)(A + (size_t)(64 * i) * lda + ka) + aoff), (unsigned*)(sa + i * 8192), 16, 0, 0);
#pragma unroll
      for (int i = 0; i < BCH; ++i) __builtin_amdgcn_global_load_lds((const unsigned*)((const char*)(Bm + (size_t)(64 * i) * ldb + k0) + boff), (unsigned*)(sb + i * 8192), 16, 0, 0);
    };
    gstage(0, 0); asm volatile("s_waitcnt vmcnt(0)" ::: "memory"); __syncthreads();
    for (int kt = 0; kt < nk; ++kt) {
      if (kt + 1 < nk) gstage((kt + 1) & 1, kt + 1);
      compute(kt & 1);
      asm volatile("s_waitcnt vmcnt(0)" ::: "memory"); __syncthreads();
    }
  } else {
    u32x4 ra[ACH], rb[BCH];
    const unsigned aoff = (unsigned)(sr * lda + scc * 8) * 2u, boff = (unsigned)(sr * ldb + scc * 8) * 2u;
    const int sdst = lds_sw(sr, scc);
    auto gload = [&](int kt) {
      const int k0 = kt * 64, ka = ACOLMAP ? k0 + (k0 >> 7) * 64 : k0;
#pragma unroll
      for (int i = 0; i < ACH; ++i) { const char* ub = (const char*)(A + (size_t)(64 * i) * lda + ka); ra[i] = *(const u32x4*)(ub + aoff); }
#pragma unroll
      for (int i = 0; i < BCH; ++i) { const char* ub = (const char*)(Bm + (size_t)(64 * i) * ldb + k0); rb[i] = *(const u32x4*)(ub + boff); }
    };
    auto lstore = [&](int buf, int kt) {
      char* sa = smem + buf * STAGE + sdst; char* sb = sa + ABYTES;
#pragma unroll
      for (int i = 0; i < ACH; ++i) { u32x4 v = ra[i];
        if (kscale) { float f[8]; unpack8(v, f); const float* ks = kscale + kt * 64 + scc * 8;
          v = (u32x4){pack2(f[0] * ks[0], f[1] * ks[1]), pack2(f[2] * ks[2], f[3] * ks[3]), pack2(f[4] * ks[4], f[5] * ks[5]), pack2(f[6] * ks[6], f[7] * ks[7])}; }
        *(u32x4*)(sa + i * 8192) = v; }
#pragma unroll
      for (int i = 0; i < BCH; ++i) *(u32x4*)(sb + i * 8192) = rb[i];
    };
    gload(0); lstore(0, 0); __syncthreads();
    for (int kt = 0; kt < nk; ++kt) {
      if (kt + 1 < nk) gload(kt + 1);
      compute(kt & 1);
      if (kt + 1 < nk) lstore((kt + 1) & 1, kt + 1);
      __syncthreads();
    }
  }
  int tide = threadIdx.x; asm volatile("" : "+v"(tide));
  const int l15e = tide & 15, lqe = (tide >> 4) & 3;
  float cs[4][4];
  if constexpr (Epi::SCALE_MODE == 2) {
#pragma unroll
    for (int ni = 0; ni < 4; ++ni)
#pragma unroll
      for (int j = 0; j < 4; ++j) cs[ni][j] = epi.colscale(col0 + wn * 64 + ni * 16 + lqe * 4 + j); }
#pragma unroll
  for (int mi = 0; mi < MI; ++mi) { const int row = row0 + wm * WTM + mi * 16 + l15e; float sq = 0.f; float rs = 1.f;
    if constexpr (Epi::SCALE_MODE == 1) rs = epi.rowscale(row);
#pragma unroll
    for (int ni = 0; ni < 4; ++ni) { float v[4] = {acc[mi][ni][0], acc[mi][ni][1], acc[mi][ni][2], acc[mi][ni][3]};
      if constexpr (Epi::SCALE_MODE == 1) { v[0] *= rs; v[1] *= rs; v[2] *= rs; v[3] *= rs; }
      if constexpr (Epi::SCALE_MODE == 2) { v[0] *= cs[ni][0]; v[1] *= cs[ni][1]; v[2] *= cs[ni][2]; v[3] *= cs[ni][3]; }
      const float q = epi(row, col0 + wn * 64 + ni * 16 + lqe * 4, v);
      if (Epi::RSS) { sq += q; if (ni & 1) { sq += __shfl_xor(sq, 16); sq += __shfl_xor(sq, 32); if (lqe == 0) epi.rss(row, col0 + wn * 64 + (ni >> 1) * 32, sq); sq = 0.f; } } }
    __builtin_amdgcn_sched_barrier(0); }
}


namespace g8 {
constexpr int BK = 64, HALF = 128, HT = HALF * BK;
DEVI int lds_byte(int r, int c) { const int st = (r >> 4) * 2 + (c >> 5), rr = r & 15, cc = c & 31, ob = rr * 64 + cc * 2; return st * 1024 + (ob ^ (((ob >> 9) & 1) << 5)); }
DEVI void stage_rc(int b, int& R, int& C) { const int st = b / 1024, sb = b % 1024, swz = sb ^ (((sb >> 9) & 1) << 5); R = (st >> 1) * 16 + swz / 64; C = (st & 1) * 32 + (swz % 64) / 2; }
}
template <bool ACOLMAP, class Epi>
DEVI void gemm_tile_8ph(const bf16_t* __restrict__ A, int lda, const bf16_t* __restrict__ Bt, int ldb, int K, int row0, int col0, const Epi& epi, char* smem) {
  using namespace g8;
  bf16_t* shm = (bf16_t*)smem;
#define SA(b, h) (shm + ((b) * 2 + (h)) * HT)
#define SB(b, h) (shm + (4 + (b) * 2 + (h)) * HT)
#define STAGE_A(P, r0, kt) do { const int _k0 = (kt) * BK, _ka = ACOLMAP ? _k0 + (_k0 >> 7) * 64 : _k0; \
    __builtin_amdgcn_global_load_lds((const unsigned*)((const char*)(A + (size_t)(r0) * lda + _ka) + ao0), (unsigned*)((char*)(P) + wid * 1024), 16, 0, 0); \
    __builtin_amdgcn_global_load_lds((const unsigned*)((const char*)(A + (size_t)((r0) + 64) * lda + _ka) + ao0), (unsigned*)((char*)(P) + wid * 1024 + 8192), 16, 0, 0); } while (0)
#define STAGE_B(P, r0, kt) do { const int _k0 = (kt) * BK; \
    __builtin_amdgcn_global_load_lds((const unsigned*)((const char*)(Bt + (size_t)(r0) * ldb + _k0) + bo0), (unsigned*)((char*)(P) + wid * 1024), 16, 0, 0); \
    __builtin_amdgcn_global_load_lds((const unsigned*)((const char*)(Bt + (size_t)((r0) + 64) * ldb + _k0) + bo0), (unsigned*)((char*)(P) + wid * 1024 + 8192), 16, 0, 0); } while (0)
#define LDA(dst, b, h) _Pragma("unroll") for (int m = 0; m < 4; ++m) _Pragma("unroll") for (int k = 0; k < 2; ++k) \
    dst[m][k] = *reinterpret_cast<const bf16x8*>((const char*)SA(b, h) + lds_byte(wr * 64 + m * 16 + fr, k * 32 + fq * 8))
#define LDB(dst, b, h) _Pragma("unroll") for (int n = 0; n < 2; ++n) _Pragma("unroll") for (int k = 0; k < 2; ++k) \
    dst[n][k] = *reinterpret_cast<const bf16x8*>((const char*)SB(b, h) + lds_byte(wc * 32 + n * 16 + fr, k * 32 + fq * 8))
#define MMA(ai, bj, At_, Bt_) do { __builtin_amdgcn_s_setprio(1); \
    _Pragma("unroll") for (int m = 0; m < 4; ++m) _Pragma("unroll") for (int n = 0; n < 2; ++n) _Pragma("unroll") for (int k = 0; k < 2; ++k) \
      acc[ai][bj][m][n] = __builtin_amdgcn_mfma_f32_16x16x32_bf16(Bt_[n][k], At_[m][k], acc[ai][bj][m][n], 0, 0, 0); \
    __builtin_amdgcn_s_setprio(0); } while (0)
#define WAIT_V(n) asm volatile("s_waitcnt vmcnt(" #n ")" ::: "memory")
#define WAIT_L(n) asm volatile("s_waitcnt lgkmcnt(" #n ")" ::: "memory")
#define BAR __builtin_amdgcn_s_barrier()
#define SCHED __builtin_amdgcn_sched_barrier(0)
  int tid = threadIdx.x; asm volatile("" : "+v"(tid));
  const int wid = __builtin_amdgcn_readfirstlane(tid >> 6), lane = tid & 63, wr = wid >> 2, wc = wid & 3, fr = lane & 15, fq = lane >> 4;
  unsigned ao0, bo0;
  { int r, c; stage_rc(tid * 16, r, c); ao0 = (unsigned)(r * lda + c) * 2u; bo0 = (unsigned)(r * ldb + c) * 2u; }
  f32x4 acc[2][2][4][2];
#pragma unroll
  for (int a = 0; a < 2; ++a)
#pragma unroll
    for (int b = 0; b < 2; ++b)
#pragma unroll
      for (int m = 0; m < 4; ++m)
#pragma unroll
        for (int n = 0; n < 2; ++n) acc[a][b][m][n] = (f32x4){0.f, 0.f, 0.f, 0.f};
  bf16x8 At[4][2], B0[2][2], B1[2][2];
  const int nt = K / BK;
  STAGE_B(SB(0, 0), 0, 0); STAGE_A(SA(0, 0), 0, 0);
  STAGE_B(SB(0, 1), HALF, 0); STAGE_A(SA(0, 1), HALF, 0);
  if (wr == 1) BAR;
  WAIT_V(4); BAR;
  STAGE_B(SB(1, 0), 0, 1); STAGE_A(SA(1, 0), 0, 1); STAGE_B(SB(1, 1), HALF, 1);
  WAIT_V(6); BAR;
  for (int t = 0; t < nt - 2; t += 2) {
    LDB(B0, 0, 0); SCHED; LDA(At, 0, 0); STAGE_A(SA(1, 1), HALF, t + 1);
    WAIT_L(8); BAR; WAIT_L(0); MMA(0, 0, At, B0); BAR; SCHED;
    LDB(B1, 0, 1); STAGE_B(SB(0, 0), 0, t + 2);
    BAR; WAIT_L(0); MMA(0, 1, At, B1); BAR;
    LDA(At, 0, 1); STAGE_A(SA(0, 0), 0, t + 2);
    BAR; WAIT_L(0); MMA(1, 0, At, B0); BAR; SCHED;
    STAGE_B(SB(0, 1), HALF, t + 2);
    WAIT_V(6); BAR; MMA(1, 1, At, B1); BAR;
    LDB(B0, 1, 0); SCHED; LDA(At, 1, 0); STAGE_A(SA(0, 1), HALF, t + 2);
    WAIT_L(8); BAR; WAIT_L(0); MMA(0, 0, At, B0); BAR; SCHED;
    LDB(B1, 1, 1); STAGE_B(SB(1, 0), 0, t + 3);
    BAR; WAIT_L(0); MMA(0, 1, At, B1); BAR;
    LDA(At, 1, 1); STAGE_A(SA(1, 0), 0, t + 3);
    BAR; WAIT_L(0); MMA(1, 0, At, B0); BAR; SCHED;
    STAGE_B(SB(1, 1), HALF, t + 3);
    WAIT_V(6); BAR; MMA(1, 1, At, B1); BAR;
  }
  { LDB(B0, 0, 0); LDA(At, 0, 0); STAGE_A(SA(1, 1), HALF, nt - 1);
    BAR; WAIT_L(0); MMA(0, 0, At, B0); BAR;
    LDB(B1, 0, 1); BAR; WAIT_L(0); MMA(0, 1, At, B1); BAR;
    LDA(At, 0, 1); WAIT_V(4); BAR; WAIT_L(0); MMA(1, 0, At, B0); MMA(1, 1, At, B1); BAR; }
  { LDB(B0, 1, 0); LDA(At, 1, 0); WAIT_V(2); BAR; WAIT_L(0); MMA(0, 0, At, B0); BAR;
    LDB(B1, 1, 1); WAIT_V(0); BAR; WAIT_L(0); MMA(0, 1, At, B1); BAR;
    LDA(At, 1, 1); BAR; WAIT_L(0); MMA(1, 0, At, B0); MMA(1, 1, At, B1); BAR; }
  if (wr == 0) BAR;
  int tide = threadIdx.x; asm volatile("" : "+v"(tide));
  const int fre = tide & 15, fqe = (tide >> 4) & 3;
#pragma unroll
  for (int ai = 0; ai < 2; ++ai)
#pragma unroll
    for (int m = 0; m < 4; ++m) { const int row = row0 + ai * HALF + wr * 64 + m * 16 + fre;
#pragma unroll
      for (int bj = 0; bj < 2; ++bj) { float sq = 0.f;
#pragma unroll
        for (int n = 0; n < 2; ++n) { const float v[4] = {acc[ai][bj][m][n][0], acc[ai][bj][m][n][1], acc[ai][bj][m][n][2], acc[ai][bj][m][n][3]};
          sq += epi(row, col0 + bj * HALF + wc * 32 + n * 16 + fqe * 4, v); }
        if (Epi::RSS) { sq += __shfl_xor(sq, 16); sq += __shfl_xor(sq, 32); if (fqe == 0) epi.rss(row, col0 + bj * HALF + wc * 32, sq); } }
      __builtin_amdgcn_sched_barrier(0); }
#undef SA
#undef SB
#undef STAGE_A
#undef STAGE_B
#undef LDA
#undef LDB
#undef MMA
#undef WAIT_V
#undef WAIT_L
#undef BAR
#undef SCHED
}

template <int BM, int BN, bool ACOLMAP, class Epi>
DEVI void gemm_tile(const bf16_t* A, int lda, const bf16_t* Bm, int ldb, int K, int row0, int col0, const Epi& epi, const float* kss, char* smem) {
  if constexpr (BM == 256 && BN == 256) gemm_tile_8ph<ACOLMAP>(A, lda, Bm, ldb, K, row0, col0, epi, smem);
  else if (kss) gemm_tile_mfma<BM, BN, ACOLMAP, false>(A, lda, Bm, ldb, K, row0, col0, epi, kss, smem);
  else gemm_tile_mfma<BM, BN, ACOLMAP, true>(A, lda, Bm, ldb, K, row0, col0, epi, nullptr, smem);
}

DEVI void st4bf(bf16_t* d, float a, float b, float c, float e) { u32x2 o = {pack2(a, b), pack2(c, e)}; *(u32x2*)d = o; }

struct EpiIn { static constexpr bool RSS = true; static constexpr int SCALE_MODE = 0; bf16_t *GU, *GVT, *CQ, *CKV, *KR; float *rssv, *rssq, *rsskv;
  DEVI float operator()(int row, int col, const float (&v)[4]) const {
    if (col < 1024) { st4bf(GU + (size_t)row * 1024 + col, gelu_t(v[0]), gelu_t(v[1]), gelu_t(v[2]), gelu_t(v[3])); return 0.f; }
    else if (col < 2048) { const int c = col - 1024, chunk = row >> 7, q = row & 127; float s = 0.f;
#pragma unroll
      for (int j = 0; j < 4; ++j) { const float g = gelu_t(v[j]); s += g * g; GVT[((size_t)chunk * 1024 + c + j) * 128 + q] = f2bf(g); }
      return s; }
    else if (col < 2304) { st4bf(CQ + (size_t)row * 256 + (col - 2048), v[0], v[1], v[2], v[3]); return v[0] * v[0] + v[1] * v[1] + v[2] * v[2] + v[3] * v[3]; }
    else if (col < 2432) { st4bf(CKV + (size_t)row * 128 + (col - 2304), v[0], v[1], v[2], v[3]); return v[0] * v[0] + v[1] * v[1] + v[2] * v[2] + v[3] * v[3]; }
    else if (col < 2496) { st4bf(KR + (size_t)keyrow(row) * 64 + (col - 2432), v[0], v[1], v[2], v[3]); return 0.f; }
    return 0.f; }
  DEVI void rss(int row, int col, float s) const {
    if (col >= 1024 && col < 2048) rssv[row * 32 + ((col - 1024) >> 5)] = s; else if (col >= 2048 && col < 2304) rssq[row * 8 + ((col - 2048) >> 5)] = s; else if (col >= 2304 && col < 2432) rsskv[row * 4 + ((col - 2304) >> 5)] = s; }
};
struct EpiQ { static constexpr bool RSS = false; static constexpr int SCALE_MODE = 1; bf16_t* Q; const float* rssq;
  DEVI float rowscale(int row) const { const float4 ps = *(const float4*)(rssq + row * 8), pt = *(const float4*)(rssq + row * 8 + 4); return rsqrtf((((ps.x + ps.y) + (ps.z + ps.w)) + ((pt.x + pt.y) + (pt.z + pt.w))) * (1.f / 256.f) + EPS); }
  DEVI float operator()(int row, int col, const float (&v)[4]) const { st4bf(Q + (size_t)row * 1536 + col, v[0], v[1], v[2], v[3]); return 0.f; }
  DEVI void rss(int, int, float) const {} };
DEVI int pk4_fp8(float a, float b, float c, float d) { int w = __builtin_amdgcn_cvt_pk_fp8_f32(a, b, 0, false); return __builtin_amdgcn_cvt_pk_fp8_f32(c, d, w, true); }
constexpr size_t O_K8 = O_RKV, O_V8T = O_RKV + al256((size_t)NB * 8 * NKEY * 192);
struct EpiK8 { static constexpr bool RSS = false; static constexpr int SCALE_MODE = 1; unsigned char* K8; const float* rsskv;
  DEVI float rowscale(int row) const { const float4 pk = *(const float4*)(rsskv + row * 4); return rsqrtf(((pk.x + pk.y) + (pk.z + pk.w)) * (1.f / 128.f) + EPS); }
  DEVI float operator()(int row, int col, const float (&v)[4]) const {
    int b, key; keyrow2(row, b, key); const int h = col >> 7, d = col & 127;
    *(int*)(K8 + ((size_t)(b * 8 + h) * NKEY + key) * 192 + d) = pk4_fp8(v[0], v[1], v[2], v[3]); return 0.f; }
  DEVI void rss(int, int, float) const {} };
struct EpiV8T { static constexpr bool RSS = false; static constexpr int SCALE_MODE = 2; unsigned char* V8; const float* rsskv;
  DEVI float colscale(int col) const { const float4 pk = *(const float4*)(rsskv + col * 4); return rsqrtf(((pk.x + pk.y) + (pk.z + pk.w)) * (1.f / 128.f) + EPS); }
  DEVI float operator()(int row, int col, const float (&v)[4]) const {
    int b, key; keyrow2(col, b, key); const int h = row >> 7, d = row & 127, kk = key & 63;
    const int off = 32 * ((kk >> 2) & 1) + 16 * (kk >> 5) + 4 * ((kk >> 3) & 3);
    *(int*)(V8 + ((size_t)(b * 8 + h) * 128 + d) * NKEY + (key & ~63) + off) = pk4_fp8(v[0], v[1], v[2], v[3]); return 0.f; }
  DEVI void rss(int, int, float) const {} };
struct EpiSgu { static constexpr bool RSS = false; static constexpr int SCALE_MODE = 0; bf16_t* GUOA; const float* g_sgu; const float* b_s; int chunk, g;
  DEVI float operator()(int row, int col, const float (&v)[4]) const { const int token = chunk * 128 + row, ch = g * 128 + col; const float bias = b_s[g * 128 + row];
    bf16_t* ptr = GUOA + (size_t)token * 1024 + ch; const u32x2 gu = *(const u32x2*)ptr;
    st4bf(ptr, lo2f(gu[0]) * (g_sgu[ch] * v[0] + bias), hi2f(gu[0]) * (g_sgu[ch + 1] * v[1] + bias), lo2f(gu[1]) * (g_sgu[ch + 2] * v[2] + bias), hi2f(gu[1]) * (g_sgu[ch + 3] * v[3] + bias));
    return 0.f; }
  DEVI void rss(int, int, float) const {} };
struct EpiGate { static constexpr bool RSS = false; static constexpr int SCALE_MODE = 0; bf16_t* G;
  DEVI float operator()(int row, int col, const float (&v)[4]) const { st4bf(G + (size_t)row * 2048 + col, sigmoidf_(v[0]), sigmoidf_(v[1]), sigmoidf_(v[2]), sigmoidf_(v[3])); return 0.f; }
  DEVI void rss(int, int, float) const {} };
template <bool SECOND> struct EpiMerge { static constexpr bool RSS = false; static constexpr int SCALE_MODE = 0; bf16_t* M; const bf16_t* G;
  DEVI float operator()(int row, int col, const float (&v)[4]) const { const u32x2 g = *(const u32x2*)(G + (size_t)row * 2048 + (SECOND ? 1024 : 0) + col);
    float o0 = lo2f(g[0]) * v[0], o1 = hi2f(g[0]) * v[1], o2 = lo2f(g[1]) * v[2], o3 = hi2f(g[1]) * v[3];
    bf16_t* ptr = M + (size_t)row * 1024 + col;
    if (SECOND) { const u32x2 m = *(const u32x2*)ptr; o0 += lo2f(m[0]); o1 += hi2f(m[0]); o2 += lo2f(m[1]); o3 += hi2f(m[1]); }
    st4bf(ptr, o0, o1, o2, o3); return 0.f; }
  DEVI void rss(int, int, float) const {} };
struct EpiO { static constexpr bool RSS = true; static constexpr int SCALE_MODE = 0; bf16_t* Y; float* rssy;
  DEVI float operator()(int row, int col, const float (&v)[4]) const { st4bf(Y + (size_t)row * 1024 + col, v[0], v[1], v[2], v[3]); return v[0] * v[0] + v[1] * v[1] + v[2] * v[2] + v[3] * v[3]; }
  DEVI void rss(int row, int col, float s) const { rssy[row * 32 + (col >> 5)] = s; } };
struct EpiPq { static constexpr bool RSS = false; static constexpr int SCALE_MODE = 0; bf16_t* QP;
  DEVI float operator()(int row, int col, const float (&v)[4]) const { st4bf(QP + (size_t)row * 2048 + col, v[0], v[1], v[2], v[3]); return 0.f; }
  DEVI void rss(int, int, float) const {} };

template <class F> DEVI void for_tiles_xcd(int MT, int NT, F f) {
  const int nb = gridDim.x;
  if ((nb & 7) == 0 && (MT & 7) == 0) { const int xcd = blockIdx.x & 7, slot = blockIdx.x >> 3, slots = nb >> 3, mper = MT >> 3, tot = mper * NT;
    for (int j = slot; j < tot; j += slots) f(xcd * mper + j / NT, j % NT); }
  else for (int i = blockIdx.x; i < MT * NT; i += nb) f(i / NT, i % NT);
}

DEVI void ph_inproj(const Params& p, char* smem) {
  char* ws = p.ws;
  EpiIn epi{(bf16_t*)(ws + O_RB), (bf16_t*)(ws + O_RC), (bf16_t*)(ws + O_CQ), (bf16_t*)(ws + O_CKV), (bf16_t*)(ws + O_KR), (float*)(ws + O_RSSV), (float*)(ws + O_RSSQ), (float*)(ws + O_RSSKV)};
  const bf16_t* HX = (const bf16_t*)(ws + O_RA); const bf16_t* W = (const bf16_t*)(ws + O_WIN);
  auto tile = [&](int mt, int nt) { gemm_tile<256, 256, false>(HX + (size_t)mt * 256 * 1024, 1024, W + (size_t)nt * 256 * 1024, 1024, 1024, mt * 256, nt * 256, epi, nullptr, smem); };
  for_tiles_xcd(64, 10, tile);
  for (int i = (int)gridDim.x - 1 - (int)blockIdx.x; i < 2; i += gridDim.x) tile(64 + i, 9);
}
DEVI void rope_kr_fp8(const Params& p) {
  const bf16_t* KR = (const bf16_t*)(p.ws + O_KR); const float* rope = (const float*)(p.ws + O_ROPE); unsigned char* K8 = (unsigned char*)(p.ws + O_K8);
  for (int i = blockIdx.x * NTHR + threadIdx.x; i < NROW * 2; i += gridDim.x * NTHR) {
    const int row = i >> 1, which = i & 1, kr = keyrow(row); int b, key; keyrow2(row, b, key);
    float x[32];
    const bf16_t* src = KR + (size_t)kr * 64 + which * 32;
#pragma unroll
    for (int q = 0; q < 4; ++q) unpack8(*(const u32x4*)(src + q * 8), x + q * 8);
    if (row < NTOK) { const int pos = row & 8191, pp = which ? (pos & 63) : (pos >> 6); const float* cs = rope + pp * 32;
#pragma unroll
      for (int j = 0; j < 16; ++j) { const float c = cs[j * 2], sn = cs[j * 2 + 1], x1 = x[j], x2 = x[16 + j]; x[j] = x1 * c - x2 * sn; x[16 + j] = x1 * sn + x2 * c; } }
    u32x4 o0, o1;
#pragma unroll
    for (int q = 0; q < 4; ++q) { o0[q] = (unsigned)pk4_fp8(x[q * 4], x[q * 4 + 1], x[q * 4 + 2], x[q * 4 + 3]); o1[q] = (unsigned)pk4_fp8(x[16 + q * 4], x[17 + q * 4], x[18 + q * 4], x[19 + q * 4]); }
#pragma unroll
    for (int h = 0; h < 8; ++h) { unsigned char* d = K8 + ((size_t)(b * 8 + h) * NKEY + key) * 192 + 128 + which * 32; *(u32x4*)d = o0; *(u32x4*)(d + 16) = o1; }
  }
}
DEVI void ph_mid(const Params& p, char* smem) {
  char* ws = p.ws;
  { EpiQ epi{(bf16_t*)(ws + O_RQ), (const float*)(ws + O_RSSQ)};
    const bf16_t* A = (const bf16_t*)(ws + O_CQ); const bf16_t* W = (const bf16_t*)(ws + O_WUQ);
    for_tiles_xcd(64, 12, [&](int mt, int nt) { gemm_tile<256, 128, false>(A + (size_t)mt * 256 * 256, 256, W + (size_t)nt * 128 * 256, 256, 256, mt * 256, nt * 128, epi, nullptr, smem); }); }
  { EpiK8 epi{(unsigned char*)(ws + O_K8), (const float*)(ws + O_RSSKV)};
    const bf16_t* A = (const bf16_t*)(ws + O_CKV); const bf16_t* W = (const bf16_t*)(ws + O_WUKV);
    auto tile = [&](int mt, int nt) { gemm_tile<256, 128, false>(A + (size_t)mt * 256 * 128, 128, W + (size_t)nt * 256 * 128, 128, 128, mt * 256, nt * 128, epi, nullptr, smem); };
    for_tiles_xcd(64, 8, tile);
    for (int i = blockIdx.x; i < 16; i += gridDim.x) tile(64 + (i >> 3), i & 7); }
  { EpiV8T epi{(unsigned char*)(ws + O_V8T), (const float*)(ws + O_RSSKV)};
    const bf16_t* A = (const bf16_t*)(ws + O_WUKV); const bf16_t* Bc = (const bf16_t*)(ws + O_CKV);
    for (int i = blockIdx.x; i < 8 * 132; i += gridDim.x) { const int mt = i & 7, nt = i >> 3;
      gemm_tile<128, 128, false>(A + (size_t)(mt * 256 + 128) * 128, 128, Bc + (size_t)nt * 128 * 128, 128, 128, mt * 128, nt * 128, epi, nullptr, smem); } }
  { const bf16_t* WS = (const bf16_t*)(ws + O_WS); const bf16_t* GVT = (const bf16_t*)(ws + O_RC);
    float* ksc = (float*)(smem + LDS_BYTES - 1024); const float* rssv = (const float*)(ws + O_RSSV);
    for (int i = blockIdx.x; i < 1024; i += gridDim.x) { const int chunk = i >> 3, g = i & 7;
      __syncthreads();
      if (threadIdx.x < 128) { const float* pr = rssv + (size_t)(chunk * 128 + threadIdx.x) * 32; float t = 0.f;
#pragma unroll
        for (int j = 0; j < 32; ++j) t += pr[j];
        ksc[threadIdx.x] = rsqrtf(t * (1.f / 1024.f) + EPS); }
      __syncthreads();
      EpiSgu epi{(bf16_t*)(ws + O_RB), p.g_sgu, p.b_s, chunk, g};
      gemm_tile<128, 128, false>(WS + (size_t)g * 16384, 128, GVT + ((size_t)chunk * 1024 + g * 128) * 128, 128, 128, 0, 0, epi, ksc, smem); } }
  rope_kr_fp8(p);
}
DEVI void ph_gates(const Params& p, char* smem) {
  char* ws = p.ws; EpiGate epi{(bf16_t*)(ws + O_RKV)};
  const bf16_t* HX = (const bf16_t*)(ws + O_RA); const bf16_t* W = (const bf16_t*)(ws + O_WIN) + (size_t)NPRE * 1024;
  for_tiles_xcd(64, 8, [&](int mt, int nt) { gemm_tile<256, 256, false>(HX + (size_t)mt * 256 * 1024, 1024, W + (size_t)nt * 256 * 1024, 1024, 1024, mt * 256, nt * 256, epi, nullptr, smem); });
}
DEVI void ph_merge(const Params& p, char* smem) {
  char* ws = p.ws; bf16_t* M = (bf16_t*)(ws + O_RC); const bf16_t* G = (const bf16_t*)(ws + O_RKV);
  EpiMerge<false> e1{M, G}; EpiMerge<true> e2{M, G};
  const bf16_t* OA = (const bf16_t*)(ws + O_RB); const bf16_t* OB = (const bf16_t*)(ws + O_RQ);
  const bf16_t* WA = (const bf16_t*)(ws + O_WPA); const bf16_t* WB = (const bf16_t*)(ws + O_WPB);
  for_tiles_xcd(64, 4, [&](int mt, int nt) { gemm_tile<256, 256, false>(OA + (size_t)mt * 256 * 1024, 1024, WA + (size_t)nt * 256 * 1024, 1024, 1024, mt * 256, nt * 256, e1, nullptr, smem); });
  for_tiles_xcd(64, 4, [&](int mt, int nt) { gemm_tile<256, 256, true>(OB + (size_t)mt * 256 * 1536, 1536, WB + (size_t)nt * 256 * 1024, 1024, 1024, mt * 256, nt * 256, e2, nullptr, smem); });
}
DEVI void ph_wo(const Params& p, char* smem) {
  char* ws = p.ws; EpiO epi{(bf16_t*)(ws + O_RA), (float*)(ws + O_RSSY)};
  const bf16_t* M = (const bf16_t*)(ws + O_RC); const bf16_t* W = (const bf16_t*)(ws + O_WO);
  for_tiles_xcd(64, 4, [&](int mt, int nt) { gemm_tile<256, 256, false>(M + (size_t)mt * 256 * 1024, 1024, W + (size_t)nt * 256 * 1024, 1024, 1024, mt * 256, nt * 256, epi, nullptr, smem); });
}
DEVI void ph_wpq(const Params& p, char* smem) {
  char* ws = p.ws; EpiPq epi{(bf16_t*)(ws + O_RKV)};
  const bf16_t* A = (const bf16_t*)(ws + O_RB); const bf16_t* W = (const bf16_t*)(ws + O_WPQ);
  for_tiles_xcd(64, 8, [&](int mt, int nt) { gemm_tile<256, 256, false>(A + (size_t)mt * 256 * 1024, 1024, W + (size_t)nt * 256 * 1024, 1024, 1024, mt * 256, nt * 256, epi, nullptr, smem); });
  convert_table_fp6(p.v_exp, (unsigned char*)(ws + O_RA), (float*)(ws + O_RA + (size_t)16384 * 1024));
}

namespace a8 {
constexpr int KVBLK = 64, SHM_K = KVBLK * 192, SHM_V = 128 * KVBLK;
constexpr int SHM_K2 = 2 * SHM_K, SHM_V2 = 2 * SHM_V;
constexpr float SCALE = 0.07216878364870322f, THR = 1.5f;
using i32x8 = __attribute__((ext_vector_type(8))) int;
DEVI int crow(int r, int hi) { return (r & 3) + 8 * (r >> 2) + 4 * hi; }
DEVI f32x16 mma(const i32x8& a, const i32x8& b, const f32x16& c) { return __builtin_amdgcn_mfma_scale_f32_32x32x64_f8f6f4(a, b, c, 0, 0, 0, 0x7f7f7f7f, 0, 0x7f7f7f7f); }
DEVI void partialSM(f32x16& p0, f32x16& p1, float& m_reg, float& mn, float& alpha) {
  constexpr float C = SCALE * 1.4426950408889634f;
  float pmax = p0[0];
#pragma unroll
  for (int r = 1; r < 16; ++r) pmax = fmaxf(pmax, p0[r]);
#pragma unroll
  for (int r = 0; r < 16; ++r) pmax = fmaxf(pmax, p1[r]);
  { auto rr = __builtin_amdgcn_permlane32_swap(__float_as_uint(pmax), __float_as_uint(pmax), false, false);
    pmax = fmaxf(__uint_as_float(rr[0]), __uint_as_float(rr[1])); }
  if (__builtin_expect(__all(pmax - m_reg <= THR / SCALE), 1)) { mn = m_reg; alpha = 1.f; }
  else { mn = fmaxf(m_reg, pmax); alpha = __builtin_amdgcn_exp2f((m_reg - mn) * C); m_reg = mn; }
  const float mnC = 6.f - mn * C;
#pragma unroll
  for (int r = 0; r < 16; ++r) p0[r] = fmaf(p0[r], C, mnC);
#pragma unroll
  for (int r = 0; r < 16; ++r) p1[r] = fmaf(p1[r], C, mnC);
#pragma unroll
  for (int r = 0; r < 16; ++r) p0[r] = __builtin_amdgcn_exp2f(p0[r]);
}
DEVI void finishSM(f32x16& p0, f32x16& p1, float alpha, float& l_reg, i32x8& pa) {
#pragma unroll
  for (int r = 0; r < 16; ++r) p1[r] = __builtin_amdgcn_exp2f(p1[r]);
  float ps = 0;
#pragma unroll
  for (int r = 0; r < 16; ++r) ps += p0[r];
#pragma unroll
  for (int r = 0; r < 16; ++r) ps += p1[r];
  { auto rr = __builtin_amdgcn_permlane32_swap(__float_as_uint(ps), __float_as_uint(ps), false, false);
    ps = __uint_as_float(rr[0]) + __uint_as_float(rr[1]); }
  l_reg = l_reg * alpha + ps;
#pragma unroll
  for (int j = 0; j < 4; ++j) { pa[j] = pk4_fp8(p0[4 * j], p0[4 * j + 1], p0[4 * j + 2], p0[4 * j + 3]); pa[4 + j] = pk4_fp8(p1[4 * j], p1[4 * j + 1], p1[4 * j + 2], p1[4 * j + 3]); }
}
DEVI i32x8 ld32(const char* p0, const char* p1) { const u32x4 a = *(const u32x4*)p0, b = *(const u32x4*)p1; return (i32x8){(int)a[0], (int)a[1], (int)a[2], (int)a[3], (int)b[0], (int)b[1], (int)b[2], (int)b[3]}; }
DEVI void qkt(f32x16& p0, f32x16& p1, const char* Ks, const i32x8* qf, int r32, int hi) {
  p0 = f32x16{}; p1 = f32x16{};
  const int sw = (r32 >> 2) & 3; const char* k0 = Ks + r32 * 192; const char* k1 = k0 + 32 * 192;
#pragma unroll
  for (int m = 0; m < 3; ++m) { const int c0 = ((4 * m + 2 * hi) ^ sw) << 4, c1 = ((4 * m + 2 * hi + 1) ^ sw) << 4;
    p0 = mma(ld32(k0 + c0, k0 + c1), qf[m], p0);
    p1 = mma(ld32(k1 + c0, k1 + c1), qf[m], p1); }
}
DEVI void pv(f32x16* o, const char* Vs, int tile, const i32x8& pa, int r32, int hi) {
  const int sw = (r32 >> 1) & 7, c0 = ((4 * tile + 2 * hi) ^ sw) << 4, c1 = ((4 * tile + 2 * hi + 1) ^ sw) << 4;
#pragma unroll
  for (int db = 0; db < 4; ++db) { const char* vr = Vs + (32 * db + r32) * 128; o[db] = mma(pa, ld32(vr + c0, vr + c1), o[db]); }
}
DEVI void attn_item(bf16_t* __restrict__ Qb, const unsigned char* __restrict__ Kg, const unsigned char* __restrict__ Vg, const float* __restrict__ rope, int pos0, char* lds) {
  const int tid = threadIdx.x, wid = tid >> 6, lane = tid & 63, r32 = lane & 31, hi = lane >> 5;
  char* V_lds = lds; char* K_lds = lds + 3 * SHM_V2;
  float* wsl = (float*)(lds + 3 * SHM_V2 + 3 * SHM_K2) + wid * 64; float* li_l = wsl; float* al_l = wsl + 32;
  float m_reg = -1e30f, l_reg = 0; f32x16 o[4] = {}; i32x8 qf[3];
  { const bf16_t* Qw = Qb + (size_t)(wid * 32 + r32) * 1536 + hi * 32;
#pragma unroll
    for (int m = 0; m < 3; ++m) { float x[32];
#pragma unroll
      for (int q = 0; q < 4; ++q) unpack8(*(const u32x4*)(Qw + m * 64 + q * 8), x + q * 8);
      if (m == 2) { const int pos = pos0 + wid * 32 + r32, pp = hi ? (pos & 63) : (pos >> 6); const float* cs = rope + pp * 32;
#pragma unroll
        for (int j = 0; j < 16; ++j) { const float c = cs[j * 2], sn = cs[j * 2 + 1], x1 = x[j], x2 = x[16 + j]; x[j] = x1 * c - x2 * sn; x[16 + j] = x1 * sn + x2 * c; } }
#pragma unroll
      for (int q = 0; q < 8; ++q) qf[m][q] = pk4_fp8(x[q * 4], x[q * 4 + 1], x[q * 4 + 2], x[q * 4 + 3]);
      __builtin_amdgcn_sched_barrier(0); } }
  unsigned koff[3], voff[2];
#pragma unroll
  for (int i = 0; i < 3; ++i) { const int pp = wid * 64 + lane + 512 * i, key = pp / 12, c = pp - key * 12; koff[i] = (unsigned)(key * 192 + ((c ^ ((key >> 2) & 3)) << 4)); }
#pragma unroll
  for (int i = 0; i < 2; ++i) { const int pp = wid * 64 + lane + 512 * i, d = pp >> 3, c = pp & 7; voff[i] = (unsigned)(d * NKEY + ((c ^ ((d >> 1) & 7)) << 4)); }
#define GSTAGE(s_, kb, vb) do { const unsigned char* ks = Kg + (size_t)(s_) * SHM_K2; const unsigned char* vs = Vg + (s_) * 128; \
    _Pragma("unroll") for (int i = 0; i < 3; ++i) __builtin_amdgcn_global_load_lds((const unsigned*)(ks + koff[i]), (unsigned*)(K_lds + (kb) + i * 8192 + wid * 1024), 16, 0, 0); \
    _Pragma("unroll") for (int i = 0; i < 2; ++i) __builtin_amdgcn_global_load_lds((const unsigned*)(vs + voff[i]), (unsigned*)(V_lds + (vb) + i * 8192 + wid * 1024), 16, 0, 0); } while (0)
#define SWAIT() asm volatile("s_waitcnt vmcnt(0)" ::: "memory")
#define SBAR() __builtin_amdgcn_sched_barrier(0)
#define RESC(a) do { if (__any((a) < 1.f)) { if (hi == 0) al_l[r32] = (a); asm volatile("s_waitcnt lgkmcnt(0)" ::: "memory"); \
    _Pragma("unroll") for (int d = 0; d < 4; ++d) _Pragma("unroll") for (int r = 0; r < 16; ++r) o[d][r] *= al_l[crow(r, hi)]; } } while (0)
  f32x16 pA0, pA1, pB0, pB1; float mnA, mnB, alA, alB; i32x8 pa; constexpr int NS = NKEY / 128;
  int kp = 0, kc = SHM_K2, kn = 2 * SHM_K2, vp = 0, vc = SHM_V2, vn = 2 * SHM_V2;
  GSTAGE(0, kp, vp); GSTAGE(1, kc, vc); SWAIT(); __syncthreads();
  qkt(pA0, pA1, K_lds + kp, qf, r32, hi); partialSM(pA0, pA1, m_reg, mnA, alA);
  SBAR(); qkt(pB0, pB1, K_lds + kp + SHM_K, qf, r32, hi);
  finishSM(pA0, pA1, alA, l_reg, pa); SBAR();
  pv(o, V_lds + vp, 0, pa, r32, hi); partialSM(pB0, pB1, m_reg, mnB, alB);
  RESC(alB);
  for (int s_ = 1; s_ < NS; ++s_) {
    if (s_ + 1 < NS) GSTAGE(s_ + 1, kn, vn);
    SBAR(); qkt(pA0, pA1, K_lds + kc, qf, r32, hi);
    finishSM(pB0, pB1, alB, l_reg, pa); SBAR();
    pv(o, V_lds + vp, 1, pa, r32, hi); partialSM(pA0, pA1, m_reg, mnA, alA);
    RESC(alA);
    SBAR(); qkt(pB0, pB1, K_lds + kc + SHM_K, qf, r32, hi);
    finishSM(pA0, pA1, alA, l_reg, pa); SBAR();
    pv(o, V_lds + vc, 0, pa, r32, hi); partialSM(pB0, pB1, m_reg, mnB, alB);
    SWAIT(); __syncthreads();
    RESC(alB);
    { const int tk = kp; kp = kc; kc = kn; kn = tk; const int tv = vp; vp = vc; vc = vn; vn = tv; }
  }
  finishSM(pB0, pB1, alB, l_reg, pa); SBAR();
  pv(o, V_lds + vp, 1, pa, r32, hi);
  if (hi == 0) li_l[r32] = l_reg; asm volatile("s_waitcnt lgkmcnt(0)" ::: "memory");
  float rli[16];
#pragma unroll
  for (int r = 0; r < 16; ++r) rli[r] = __builtin_amdgcn_rcpf(li_l[crow(r, hi)]);
  bf16_t* Ow = Qb + (size_t)(wid * 32) * 1536;
#pragma unroll
  for (int r = 0; r < 16; ++r) { const int orow = crow(r, hi);
#pragma unroll
    for (int d0 = 0; d0 < 4; ++d0) Ow[(size_t)orow * 1536 + d0 * 32 + r32] = f2bf(o[d0][r] * rli[r]); }
  __syncthreads();
#undef GSTAGE
#undef SWAIT
#undef SBAR
#undef RESC
}
}
DEVI void attn_fp8(const Params& p, char* smem) {
  bf16_t* Q = (bf16_t*)(p.ws + O_RQ); const unsigned char* K8 = (const unsigned char*)(p.ws + O_K8); const unsigned char* V8 = (const unsigned char*)(p.ws + O_V8T);
  const float* rope = (const float*)(p.ws + O_ROPE);
  for (int it = blockIdx.x; it < NB * 8 * (SEQ / 256); it += gridDim.x) {
    const int bh = (it >> 8) * 8 + (it & 7), qb = (it & 255) >> 3, b = bh >> 3, h = bh & 7;
    a8::attn_item(Q + (size_t)(b * SEQ + qb * 256) * 1536 + h * 192, K8 + (size_t)bh * NKEY * 192, V8 + (size_t)bh * 128 * NKEY, rope, qb * 256, smem);
  }
}
DEVI void ph_attn(const Params& p, char* smem) { attn_fp8(p, smem); }

DEVI void ph_rows(const Params& p, char* smem) {
  const int tid = threadIdx.x, wave = tid >> 6, lane = tid & 63;
  const float* MOD = (const float*)(p.ws + O_MOD); const bf16_t* Y = (const bf16_t*)(p.ws + O_RA); const float* rssy = (const float*)(p.ws + O_RSSY);
  bf16_t* HX2 = (bf16_t*)(p.ws + O_RB);
  for (int row = blockIdx.x * NWAVE + wave; row < NTOK; row += gridDim.x * NWAVE) {
    const int b = row >> 13; const float* md = MOD + b * 6144;
    float ty = 0.f; { const float* pr = rssy + (size_t)row * 32;
#pragma unroll
      for (int j = 0; j < 32; ++j) ty += pr[j]; }
    const float ry = rsqrtf(ty * (1.f / 1024.f) + EPS);
    float x1[16]; float ss = 0.f;
#pragma unroll
    for (int i = 0; i < 4; ++i) { const int c = i * 256 + lane * 4; const float4 xv = *(const float4*)(p.x + (size_t)row * 1024 + c); const u32x2 yv = *(const u32x2*)(Y + (size_t)row * 1024 + c);
      const float4 gp = *(const float4*)(p.g_post1 + c), gt = *(const float4*)(md + 2048 + c);
      x1[i * 4 + 0] = xv.x + gt.x * (lo2f(yv[0]) * ry * gp.x); x1[i * 4 + 1] = xv.y + gt.y * (hi2f(yv[0]) * ry * gp.y);
      x1[i * 4 + 2] = xv.z + gt.z * (lo2f(yv[1]) * ry * gp.z); x1[i * 4 + 3] = xv.w + gt.w * (hi2f(yv[1]) * ry * gp.w);
#pragma unroll
      for (int j = 0; j < 4; ++j) ss += x1[i * 4 + j] * x1[i * 4 + j];
      *(float4*)(p.out + (size_t)row * 1024 + c) = make_float4(x1[i * 4], x1[i * 4 + 1], x1[i * 4 + 2], x1[i * 4 + 3]); }
    ss = wave_sum(ss); const float r2 = rsqrtf(ss * (1.f / 1024.f) + EPS);
#pragma unroll
    for (int i = 0; i < 4; ++i) { const int c = i * 256 + lane * 4; const float4 g2 = *(const float4*)(p.g_pre2 + c), sc = *(const float4*)(md + 4096 + c), sh = *(const float4*)(md + 3072 + c);
      st4bf(HX2 + (size_t)row * 1024 + c, x1[i * 4] * r2 * g2.x * (1.f + sc.x) + sh.x, x1[i * 4 + 1] * r2 * g2.y * (1.f + sc.y) + sh.y,
            x1[i * 4 + 2] * r2 * g2.z * (1.f + sc.z) + sh.z, x1[i * 4 + 3] * r2 * g2.w * (1.f + sc.w) + sh.w); }
  }
  convert_table_fp6(p.u_exp, (unsigned char*)(p.ws + O_RC), (float*)(p.ws + O_RC + (size_t)16384 * 1024));
}

namespace tk {
DEVI int f2sort(float f) { const int i = __float_as_int(f); return i ^ ((i >> 31) & 0x7fffffff); }
DEVI float sort2f(int s) { return __int_as_float(s ^ ((s >> 31) & 0x7fffffff)); }
DEVI void ce_desc(int& a, int& b) { const int hi = max(a, b), lo = min(a, b); a = hi; b = lo; }
DEVI void sort16_desc(int* a) {
#pragma unroll
  for (int lk = 1; lk <= 4; ++lk)
#pragma unroll
    for (int lj = lk - 1; lj >= 0; --lj)
#pragma unroll
      for (int i = 0; i < 16; ++i) { const int j = 1 << lj, k = 1 << lk, l = i ^ j;
        if (l > i) { const int hi = max(a[i], a[l]), lo = min(a[i], a[l]); if ((i & k) == 0) { a[i] = hi; a[l] = lo; } else { a[i] = lo; a[l] = hi; } } }
}
DEVI void bitonic_merge16_desc(int* a) {
#pragma unroll
  for (int lj = 3; lj >= 0; --lj)
#pragma unroll
    for (int i = 0; i < 16; ++i) { const int l = i ^ (1 << lj); if (l > i) ce_desc(a[i], a[l]); }
}
DEVI void merge_top16(int* a, const int* b) {
#pragma unroll
  for (int i = 0; i < 16; ++i) a[i] = max(a[i], b[15 - i]);
  bitonic_merge16_desc(a);
}
DEVI void half_top16(const bf16_t* __restrict__ qrow, const char* Kl, int r32, int hi, int* out) {
  bf16x8 qf[8];
#pragma unroll
  for (int d0 = 0; d0 < 8; ++d0) qf[d0] = *reinterpret_cast<const bf16x8*>(qrow + d0 * 16 + hi * 8);
  int a[64]; const int hi4 = 4 * hi;
#pragma unroll
  for (int kt = 0; kt < 4; ++kt) { f32x16 acc = {};
    const int key = kt * 32 + r32;
#pragma unroll
    for (int d0 = 0; d0 < 8; ++d0) { const bf16x8 kf = *reinterpret_cast<const bf16x8*>(Kl + key * 256 + (((d0 * 2 + hi) ^ (key & 15)) << 4));
      acc = __builtin_amdgcn_mfma_f32_32x32x16_bf16(kf, qf[d0], acc, 0, 0, 0); }
#pragma unroll
    for (int r = 0; r < 16; ++r) { const int kc = kt * 32 + (r & 3) + 8 * (r >> 2); a[kt * 16 + r] = ((f2sort(acc[r]) & ~127) | (127 - kc)) - hi4; } }
  sort16_desc(a); sort16_desc(a + 16); sort16_desc(a + 32); sort16_desc(a + 48);
  merge_top16(a, a + 16); merge_top16(a + 32, a + 48); merge_top16(a, a + 32);
  int L[16], H[16];
#pragma unroll
  for (int i = 0; i < 16; ++i) { auto rr = __builtin_amdgcn_permlane32_swap((unsigned)a[i], (unsigned)a[i], false, false); L[i] = (int)rr[0]; H[i] = (int)rr[1]; }
  merge_top16(L, H);
#pragma unroll
  for (int i = 0; i < 16; ++i) out[i] = L[i];
}
}
DEVI void gather_token_fp6(const Params& p, int t, const int* idx, const float* gw, float* xs, const int* sig);
DEVI void fp6_sigma(int* sig);
DEVI void topk_fast(const Params& p, char* smem) {
  const int tid = threadIdx.x, wave = __builtin_amdgcn_readfirstlane(tid >> 6), lane = tid & 63, r32 = lane & 31, hi = lane >> 5;
  const bf16_t* QP = (const bf16_t*)(p.ws + O_RKV);
  char* K1l = smem; char* K2l = smem + 32768; int* tab = (int*)(smem + 65536) + wave * (32 * 33);
  int* idxl = (int*)(smem + 65536 + 8 * 32 * 33 * 4) + wave * 512; float* gwl = (float*)(smem + 65536 + 8 * 32 * 33 * 4 + 8 * 2048) + wave * 512;
  int* sigl = (int*)(smem + 65536 + 8 * 32 * 33 * 4 + 16 * 2048) + wave * 32;
  fp6_sigma(sigl);
  __syncthreads();
  { const bf16_t* K1 = (const bf16_t*)(p.ws + O_K1);
    for (int id = tid; id < 4096; id += NTHR) { const int key = id >> 4, c = id & 15; const u32x4 v = *(const u32x4*)(K1 + (size_t)key * 128 + c * 8);
      *(u32x4*)(smem + key * 256 + ((c ^ (key & 15)) << 4)) = v; } }
  __syncthreads();
  for (int item = blockIdx.x; item < NTOK * 8 / 256; item += gridDim.x) {
    const int row = item * 256 + wave * 32 + r32;
    const bf16_t* qrow = QP + (size_t)row * 256;
    int t1[16], t2[16];
    tk::half_top16(qrow, K1l, r32, hi, t1);
    __builtin_amdgcn_sched_barrier(0);
    tk::half_top16(qrow + 128, K2l, r32, hi, t2);
    __builtin_amdgcn_sched_barrier(0);
    float v1[16], v2[16];
#pragma unroll
    for (int i = 0; i < 16; ++i) { v1[i] = tk::sort2f(t1[i] & ~127); v2[i] = tk::sort2f(t2[i] & ~127); }
    if (hi == 0) {
#pragma unroll
      for (int i = 0; i < 16; ++i) { tab[r32 * 33 + i] = 127 - (t1[i] & 127); tab[r32 * 33 + 16 + i] = 127 - (t2[i] & 127); } }
#define CAND(i, j) ((tk::f2sort(v1[i] + v2[j]) & ~255) | (255 - ((i) * 16 + (j))))
    int g0[16], g1[16], g2[16];
#pragma unroll
    for (int j = 0; j < 16; ++j) g0[j] = CAND(0, j);
#pragma unroll
    for (int j = 0; j < 8; ++j) g1[j] = CAND(1, j);
#pragma unroll
    for (int j = 0; j < 5; ++j) g1[8 + j] = CAND(2, j);
#pragma unroll
    for (int j = 0; j < 3; ++j) g1[13 + j] = CAND(4, j);
#pragma unroll
    for (int j = 0; j < 4; ++j) g2[j] = CAND(3, j);
    g2[4] = CAND(5, 0); g2[5] = CAND(5, 1); g2[6] = CAND(6, 0); g2[7] = CAND(6, 1); g2[8] = CAND(7, 0); g2[9] = CAND(7, 1);
    g2[10] = CAND(8, 0); g2[11] = CAND(9, 0); g2[12] = CAND(10, 0); g2[13] = CAND(11, 0); g2[14] = CAND(12, 0); g2[15] = CAND(13, 0);
    tk::sort16_desc(g1); tk::sort16_desc(g2);
    tk::merge_top16(g0, g1); tk::merge_top16(g0, g2);
    { int x = CAND(14, 0);
#pragma unroll
      for (int i = 0; i < 16; ++i) { const int h = max(g0[i], x); x = min(g0[i], x); g0[i] = h; }
      x = CAND(15, 0);
#pragma unroll
      for (int i = 0; i < 16; ++i) { const int h = max(g0[i], x); x = min(g0[i], x); g0[i] = h; } }
#undef CAND
    asm volatile("s_waitcnt lgkmcnt(0)" ::: "memory");
    if (hi == 0) {
      int ex[16];
#pragma unroll
      for (int k = 0; k < 16; ++k) { const int pos = 255 - (g0[k] & 255); ex[k] = tab[r32 * 33 + (pos >> 4)] * 128 + tab[r32 * 33 + 16 + (pos & 15)]; }
      int* dst = idxl + r32 * 16;
#pragma unroll
      for (int q = 0; q < 4; ++q) *(int4*)(dst + q * 4) = make_int4(ex[q * 4], ex[q * 4 + 1], ex[q * 4 + 2], ex[q * 4 + 3]);
    } else {
      float e[16]; const float vmax = tk::sort2f(g0[0] & ~255); float sum = 0.f;
#pragma unroll
      for (int k = 0; k < 16; ++k) { e[k] = __expf(tk::sort2f(g0[k] & ~255) - vmax); sum += e[k]; }
      const float inv = 1.f / sum; float* dst = gwl + r32 * 16;
#pragma unroll
      for (int q = 0; q < 4; ++q) *(float4*)(dst + q * 4) = make_float4(e[q * 4] * inv, e[q * 4 + 1] * inv, e[q * 4 + 2] * inv, e[q * 4 + 3] * inv);
    }
    asm volatile("s_waitcnt lgkmcnt(0)" ::: "memory"); __builtin_amdgcn_sched_barrier(0);
#pragma unroll 1
    for (int tl = 0; tl < 4; ++tl) gather_token_fp6(p, item * 32 + wave * 4 + tl, idxl + tl * 128, gwl + tl * 128, (float*)tab, sigl);
    asm volatile("s_waitcnt lgkmcnt(0)" ::: "memory"); __builtin_amdgcn_sched_barrier(0);
  }
}
DEVI void ph_topk(const Params& p, char* smem) { topk_fast(p, smem); }

DEVI void fp6_sigma(int* sig) {
  f32x16 ra, rb;
#pragma unroll
  for (int i = 0; i < 16; ++i) { ra[i] = i < 8 ? i * 0.125f : 1.f + (i - 8) * 0.125f; rb[i] = i < 8 ? 2.f + i * 0.25f : 4.f + (i - 8) * 0.5f; }
  const u32x6 w = __builtin_amdgcn_cvt_scalef32_2xpk16_fp6_f32(ra, rb, 1.0f);
  const f32x32 d = __builtin_amdgcn_cvt_scalef32_pk32_f32_fp6(w, 1.0f);
  if ((threadIdx.x & 63) == 0) {
#pragma unroll
    for (int i = 0; i < 32; ++i) { const float v = d[i]; sig[i] = v < 1.f ? (int)(v * 8.f + 0.5f) : v < 2.f ? 8 + (int)((v - 1.f) * 8.f + 0.5f) : v < 4.f ? 16 + (int)((v - 2.f) * 4.f + 0.5f) : 24 + (int)((v - 4.f) * 2.f + 0.5f); } }
}
constexpr int G6 = 4;
DEVI void gather_token_fp6(const Params& p, int t, const int* idx, const float* gw, float* xs, const int* sig) {
  int lane = threadIdx.x & 63; asm volatile("" : "+v"(lane));
  const int h = lane >> 5, g = lane & 31;
  const bf16_t* HX2 = (const bf16_t*)(p.ws + O_RB);
  const unsigned char* UT = (const unsigned char*)(p.ws + O_RC); const float* SU = (const float*)(p.ws + O_RC + (size_t)16384 * 1024);
  const unsigned char* VT = (const unsigned char*)(p.ws + O_RA); const float* SV = (const float*)(p.ws + O_RA + (size_t)16384 * 1024);
  const float* MOD = (const float*)(p.ws + O_MOD);
  if (h == 0) { float xf[32];
#pragma unroll
    for (int q = 0; q < 4; ++q) unpack8(*(const u32x4*)(HX2 + (size_t)t * 1024 + g * 32 + q * 8), xf + q * 8);
#pragma unroll
    for (int j = 0; j < 32; ++j) xs[j * 32 + g] = xf[j]; }
  asm volatile("s_waitcnt lgkmcnt(0)" ::: "memory"); __builtin_amdgcn_sched_barrier(0);
  float xp[32], acc[32];
#pragma unroll
  for (int i = 0; i < 32; ++i) { xp[i] = xs[sig[i] * 32 + g]; acc[i] = 0.f; }
#pragma unroll 1
  for (int half = 0; half < 2; ++half) {
    const int my_i = idx[half * 64 + lane]; const float my_g = gw[half * 64 + lane];
    const float my_su = SU[my_i], my_sv = SV[my_i];
#pragma unroll 1
    for (int e0 = 0; e0 < 64; e0 += 2 * G6) {
      u32x6 uq[G6], vq[G6]; float cs[G6];
#pragma unroll
      for (int j = 0; j < G6; ++j) { const int ia = __builtin_amdgcn_readlane(my_i, e0 + 2 * j), ib = __builtin_amdgcn_readlane(my_i, e0 + 2 * j + 1); const int id = h ? ib : ia;
        const unsigned char* up = UT + (size_t)id * 768 + g * 24; const unsigned char* vp = VT + (size_t)id * 768 + g * 24;
        const u32x4 u0 = *(const u32x4_u*)up; const u32x2 u1 = *(const u32x2_u*)(up + 16); const u32x4 v0 = *(const u32x4_u*)vp; const u32x2 v1 = *(const u32x2_u*)(vp + 16);
        uq[j] = (u32x6){u0[0], u0[1], u0[2], u0[3], u1[0], u1[1]}; vq[j] = (u32x6){v0[0], v0[1], v0[2], v0[3], v1[0], v1[1]}; }
#pragma unroll
      for (int j = 0; j < G6; ++j) { const f32x32 uf = __builtin_amdgcn_cvt_scalef32_pk32_f32_fp6(uq[j], 1.0f); float d = 0.f;
#pragma unroll
        for (int k = 0; k < 32; ++k) d += xp[k] * uf[k];
        cs[j] = d; __builtin_amdgcn_sched_barrier(0); }
#pragma unroll
      for (int j = 0; j < G6; ++j) { float v = cs[j];
        v += __builtin_bit_cast(float, __builtin_amdgcn_update_dpp(0, __builtin_bit_cast(int, v), 0xB1, 0xf, 0xf, true));
        v += __builtin_bit_cast(float, __builtin_amdgcn_update_dpp(0, __builtin_bit_cast(int, v), 0x4E, 0xf, 0xf, true));
        v += __builtin_bit_cast(float, __builtin_amdgcn_update_dpp(0, __builtin_bit_cast(int, v), 0x141, 0xf, 0xf, true));
        v += __builtin_bit_cast(float, __builtin_amdgcn_update_dpp(0, __builtin_bit_cast(int, v), 0x140, 0xf, 0xf, true));
        const int iv = __builtin_bit_cast(int, v);
        const float s0 = __builtin_bit_cast(float, __builtin_amdgcn_readlane(iv, 0)) + __builtin_bit_cast(float, __builtin_amdgcn_readlane(iv, 16));
        const float s1 = __builtin_bit_cast(float, __builtin_amdgcn_readlane(iv, 32)) + __builtin_bit_cast(float, __builtin_amdgcn_readlane(iv, 48));
        const int ea = e0 + 2 * j, eb = ea + 1;
        const float ga = __builtin_bit_cast(float, __builtin_amdgcn_readlane(__builtin_bit_cast(int, my_g), ea)), gb = __builtin_bit_cast(float, __builtin_amdgcn_readlane(__builtin_bit_cast(int, my_g), eb));
        const float sua = __builtin_bit_cast(float, __builtin_amdgcn_readlane(__builtin_bit_cast(int, my_su), ea)), sub = __builtin_bit_cast(float, __builtin_amdgcn_readlane(__builtin_bit_cast(int, my_su), eb));
        const float sva = __builtin_bit_cast(float, __builtin_amdgcn_readlane(__builtin_bit_cast(int, my_sv), ea)), svb = __builtin_bit_cast(float, __builtin_amdgcn_readlane(__builtin_bit_cast(int, my_sv), eb));
        const float ca = ga * gelu_t(s0 * sua) * sva, cb = gb * gelu_t(s1 * sub) * svb;
        cs[j] = h ? cb : ca; }
#pragma unroll
      for (int j = 0; j < G6; ++j) { const f32x32 vf = __builtin_amdgcn_cvt_scalef32_pk32_f32_fp6(vq[j], 1.0f);
#pragma unroll
        for (int k = 0; k < 32; ++k) acc[k] += cs[j] * vf[k];
        __builtin_amdgcn_sched_barrier(0); }
    }
  }
#pragma unroll
  for (int i = 0; i < 32; ++i) { auto rr = __builtin_amdgcn_permlane32_swap(__float_as_uint(acc[i]), __float_as_uint(acc[i]), false, false); acc[i] = __uint_as_float(rr[0]) + __uint_as_float(rr[1]); }
  if (h == 0) {
#pragma unroll
    for (int i = 0; i < 32; ++i) xs[sig[i] * 32 + g] = acc[i]; }
  asm volatile("s_waitcnt lgkmcnt(0)" ::: "memory"); __builtin_amdgcn_sched_barrier(0);
  float o[16]; float ss = 0.f;
#pragma unroll
  for (int j = 0; j < 16; ++j) { o[j] = xs[(16 * h + j) * 32 + g]; ss += o[j] * o[j]; }
  ss = wave_sum(ss); const float rstd = rsqrtf(ss * (1.f / 1024.f) + EPS);
  const int b = t >> 13, c0 = g * 32 + h * 16; const float* gt2 = MOD + b * 6144 + 5120 + c0;
  float* op = p.out + (size_t)t * 1024 + c0;
#pragma unroll
  for (int q4 = 0; q4 < 4; ++q4) { float4 xv = *(const float4*)(op + q4 * 4); const float4 gt = *(const float4*)(gt2 + q4 * 4), gp = *(const float4*)(p.g_post2 + c0 + q4 * 4);
    xv.x += gt.x * (o[q4 * 4 + 0] * rstd * gp.x); xv.y += gt.y * (o[q4 * 4 + 1] * rstd * gp.y);
    xv.z += gt.z * (o[q4 * 4 + 2] * rstd * gp.z); xv.w += gt.w * (o[q4 * 4 + 3] * rstd * gp.w);
    *(float4*)(op + q4 * 4) = xv; }
  asm volatile("s_waitcnt lgkmcnt(0)" ::: "memory"); __builtin_amdgcn_sched_barrier(0);
}

#define XB_TMO      128
#define XB_XCNT(j)  (256  + 64 * (j))
#define XB_XSUB(j)  (1280 + 64 * (j))
#define XB_XGEN(j)  (2304 + 64 * (j))
#define XB_TOP      3328
#define XB_TOPGEN   3392
#define XCD_BAR_WORDS 3456
#define XB_SPIN_CAP (1u << 18)
#define LAS __attribute__((address_space(3)))
DEVI unsigned xb_ld(unsigned* p)              { return __hip_atomic_load(p, __ATOMIC_RELAXED, __HIP_MEMORY_SCOPE_AGENT); }
DEVI unsigned xb_add(unsigned* p, unsigned v) { return __hip_atomic_fetch_add(p, v, __ATOMIC_RELAXED, __HIP_MEMORY_SCOPE_AGENT); }
DEVI unsigned xb_xcc_id() { return (unsigned)__builtin_amdgcn_s_getreg((3 << 11) | 20) & 0xFu; }
#define XB_SPIN(cond, bar) do { unsigned _sp = 0; while (cond) { __builtin_amdgcn_s_sleep(1); \
    if ((++_sp & 255u) == 0u) { if (xb_ld(&(bar)[XB_TMO])) break; if (_sp > XB_SPIN_CAP) { atomicAdd(&(bar)[XB_TMO], 1u); break; } } } } while (0)
struct XcdBarrier { unsigned* bar; unsigned x; volatile LAS unsigned* st; };
DEVI XcdBarrier xcd_barrier_post(unsigned* bar, volatile LAS unsigned* st) {
  XcdBarrier b; b.bar = bar; b.x = xb_xcc_id(); b.st = st;
  if (threadIdx.x == 0) (void)xb_add(&bar[XB_XCNT(b.x)], 1u);
  return b;
}
DEVI void xcd_barrier_complete(unsigned* bar, unsigned x, unsigned& nloc, unsigned& nx) {
  const unsigned G = gridDim.x * gridDim.y * gridDim.z;
  unsigned sum, cnt, mine, sp = 0u;
  for (;;) {
    sum = 0u; cnt = 0u; mine = 0u;
#pragma unroll
    for (unsigned j = 0; j < 16; ++j) { const unsigned c = xb_ld(&bar[XB_XCNT(j)]); sum += c; cnt += (c > 0u) ? 1u : 0u; mine = (j == x) ? c : mine; }
    if (sum == G) break;
    __builtin_amdgcn_s_sleep(1);
    if ((++sp & 255u) == 0u) { if (xb_ld(&bar[XB_TMO])) break; if (sp > XB_SPIN_CAP) { atomicAdd(&bar[XB_TMO], 1u); break; } }
  }
  nloc = mine > 0u ? mine : 1u; nx = cnt > 0u ? cnt : 1u;
}
DEVI void xcd_barrier(const XcdBarrier& b) {
  asm volatile("s_waitcnt vmcnt(0)" ::: "memory");
  __syncthreads();
  if (threadIdx.x == 0) {
    unsigned* bar = b.bar;
    __builtin_amdgcn_s_waitcnt(0);
    unsigned nloc = b.st[0], nx = b.st[1];
    if (nloc == 0u) { xcd_barrier_complete(bar, b.x, nloc, nx); b.st[0] = nloc; b.st[1] = nx; }
    const unsigned old = xb_add(&bar[XB_XSUB(b.x)], 1u);
    const unsigned gen = old / nloc;
    if (old + 1u == (gen + 1u) * nloc) {
      __builtin_amdgcn_fence(__ATOMIC_RELEASE, "agent");
      asm volatile("s_waitcnt vmcnt(0)" ::: "memory");
      const unsigned og = xb_add(&bar[XB_TOP], 1u);
      const unsigned tg = og / nx;
      if (og + 1u == (tg + 1u) * nx) xb_add(&bar[XB_TOPGEN], 1u);
      else XB_SPIN(xb_ld(&bar[XB_TOPGEN]) == tg, bar);
      __builtin_amdgcn_fence(__ATOMIC_ACQUIRE, "agent");
      xb_add(&bar[XB_XGEN(b.x)], 1u);
      asm volatile("s_waitcnt vmcnt(0)" ::: "memory");
    } else {
      XB_SPIN(xb_ld(&bar[XB_XGEN(b.x)]) == gen, bar);
      __builtin_amdgcn_fence(__ATOMIC_ACQUIRE, "agent");
      asm volatile("s_waitcnt vmcnt(0)" ::: "memory");
    }
  }
  __syncthreads();
}

constexpr int NPHASE = 11;
template <int PH> DEVI void run_phase(const Params& p, char* smem) {
  if constexpr (PH == 0) ph_prep(p, smem);
  else if constexpr (PH == 1) ph_hx(p, smem);
  else if constexpr (PH == 2) ph_inproj(p, smem);
  else if constexpr (PH == 3) ph_mid(p, smem);
  else if constexpr (PH == 4) ph_attn(p, smem);
  else if constexpr (PH == 5) ph_gates(p, smem);
  else if constexpr (PH == 6) ph_merge(p, smem);
  else if constexpr (PH == 7) ph_wo(p, smem);
  else if constexpr (PH == 8) ph_rows(p, smem);
  else if constexpr (PH == 9) ph_wpq(p, smem);
  else if constexpr (PH == 10) ph_topk(p, smem);
}

#ifndef PROBE_PH
#define PROBE_PH -1
#endif
#define RUNPH(N) do { if (PROBE_PH == N) t0 = __builtin_amdgcn_s_memrealtime(); run_phase<N>(p, smem); if (N < NPHASE - 1) xcd_barrier(xb); \
    if (PROBE_PH == N) t1 = __builtin_amdgcn_s_memrealtime(); } while (0)
__global__ __launch_bounds__(NTHR) void k_mega(Params p) {
  extern __shared__ __attribute__((aligned(16))) char smem[];
  cg::grid_group grid = cg::this_grid();
  unsigned long long t0 = 0, t1 = 0;
  unsigned* bar = (unsigned*)(p.ws + O_BAR);
  volatile LAS unsigned* xst = (volatile LAS unsigned*)(smem + LDS_BYTES - 16);
  if (threadIdx.x == 0) { xst[0] = 0u; xst[1] = 0u; }
  __syncthreads();
  const XcdBarrier xb = xcd_barrier_post(bar, xst);
  if (p.out == nullptr) grid.sync();
  RUNPH(0);
  RUNPH(1); RUNPH(2); RUNPH(3); RUNPH(4); RUNPH(5); RUNPH(6); RUNPH(7); RUNPH(8); RUNPH(9); RUNPH(10);
  if (PROBE_PH >= 0) { __syncthreads(); if (blockIdx.x == 0 && threadIdx.x == 0) p.out[0] += exp2f(rintf(log2f((float)(t1 - t0) * 1e-3f) * 5.f) * 0.2f); }
}

extern "C" void kernel_launch(void* const* d_in, const int* in_sizes, int n_in, void* d_out, int out_size, void* d_ws, size_t ws_size, hipStream_t stream) {
  static int grid = 0;
  if (grid == 0) {
    if (n_in != 26 || out_size != NTOK * DM || ws_size < O_END) { fprintf(stderr, "kernel_launch: unexpected shapes n_in %d out %d ws %zu (need %zu)\n", n_in, out_size, ws_size, (size_t)O_END); grid = -1; return; }
    (void)hipFuncSetAttribute((const void*)k_mega, hipFuncAttributeMaxDynamicSharedMemorySize, LDS_BYTES);
    int dev = 0, cus = 0, per_cu = 0; (void)hipGetDevice(&dev); (void)hipDeviceGetAttribute(&cus, hipDeviceAttributeMultiprocessorCount, dev);
    (void)hipOccupancyMaxActiveBlocksPerMultiprocessor(&per_cu, (const void*)k_mega, NTHR, LDS_BYTES);
    if (per_cu < 1) { fprintf(stderr, "kernel_launch: occupancy query says %d blocks per CU\n", per_cu); grid = -1; return; }
    grid = cus;
  }
  if (grid < 0) return;
  Params p{};
  const float** pp = (const float**)&p;
  for (int i = 0; i < 26; ++i) pp[i] = (const float*)d_in[i];
  p.out = (float*)d_out; p.ws = (char*)d_ws;
  (void)hipMemsetAsync((char*)d_ws + O_BAR, 0, (size_t)XCD_BAR_WORDS * 4, stream);
  void* args[] = {&p};
  hipError_t e = hipLaunchCooperativeKernel((const void*)k_mega, dim3(grid), dim3(NTHR), args, LDS_BYTES, stream);
  if (e != hipSuccess) fprintf(stderr, "cooperative launch failed: %s (grid %d)\n", hipGetErrorString(e), grid);
}
```

```cpp
#include <hip/hip_runtime.h>
#include <hip/hip_cooperative_groups.h>
#include <cstdint>
#include <cstdio>
namespace cg = cooperative_groups;

#define DEVI __device__ __forceinline__
typedef unsigned short bf16_t;
using bf16x8 = __attribute__((ext_vector_type(8))) short;
using bf16x4 = __attribute__((ext_vector_type(4))) short;
using f32x4  = __attribute__((ext_vector_type(4))) float;
using f32x16 = __attribute__((ext_vector_type(16))) float;
using u32x4  = __attribute__((ext_vector_type(4))) unsigned;
using u32x2  = __attribute__((ext_vector_type(2))) unsigned;

constexpr int DM = 1024, NB = 2, SEQ = 8192, NTOK = NB * SEQ, CTXL = 256, NCTX = NB * CTXL, NROW = NTOK + NCTX, NKEY = SEQ + CTXL;
constexpr int INW = 4544, INWP = 4608;
constexpr int NPRE = 2560;
constexpr float EPS = 1e-6f;
constexpr int NTHR = 512, NWAVE = 8;
constexpr int LDS_BYTES = 147456;

constexpr size_t al256(size_t x) { return (x + 255) / 256 * 256; }
constexpr size_t O_WIN   = 0;
constexpr size_t O_WUQ   = O_WIN  + al256((size_t)INWP * 1024 * 2);
constexpr size_t O_WUKV  = O_WUQ  + al256((size_t)1536 * 256 * 2);
constexpr size_t O_WPA   = O_WUKV + al256((size_t)2048 * 128 * 2);
constexpr size_t O_WPB   = O_WPA  + al256((size_t)1024 * 1024 * 2);
constexpr size_t O_WO    = O_WPB  + al256((size_t)1024 * 1024 * 2);
constexpr size_t O_WPQ   = O_WO   + al256((size_t)1024 * 1024 * 2);
constexpr size_t O_WS    = O_WPQ  + al256((size_t)2048 * 1024 * 2);
constexpr size_t O_K1    = O_WS   + al256((size_t)8 * 128 * 128 * 2);
constexpr size_t O_K2    = O_K1   + al256((size_t)128 * 128 * 2);
constexpr size_t O_MOD   = O_K2   + al256((size_t)128 * 128 * 2);
constexpr size_t O_ROPE  = O_MOD  + al256((size_t)3 * 6144 * 4);
constexpr size_t O_BAR   = O_ROPE + al256((size_t)128 * 16 * 2 * 4);
constexpr size_t O_RSSV  = O_BAR + al256((size_t)3456 * 4);
constexpr size_t O_RSSQ  = O_RSSV + (size_t)NTOK * 32 * 4;
constexpr size_t O_RSSKV = O_RSSQ + (size_t)NTOK * 8 * 4;
constexpr size_t O_RSSY  = O_RSSKV + (size_t)NROW * 4 * 4;
constexpr size_t O_RSSEND = O_RSSY + (size_t)NTOK * 32 * 4;
constexpr size_t O_RA    = al256(O_RSSEND);
constexpr size_t O_RB    = O_RA  + al256((size_t)NROW * 1024 * 2);
constexpr size_t O_RC    = O_RB  + al256((size_t)NTOK * 1024 * 2);
constexpr size_t O_CQ    = O_RC  + al256((size_t)NTOK * 1024 * 2);
constexpr size_t O_CKV   = O_CQ  + al256((size_t)NTOK * 256 * 2);
constexpr size_t O_KR    = O_CKV + al256((size_t)NROW * 128 * 2);
constexpr size_t O_RQ    = O_KR  + al256((size_t)NROW * 64 * 2);
constexpr size_t O_RKV   = O_RQ  + al256((size_t)NTOK * 1536 * 2);
constexpr size_t O_END   = O_RKV + al256((size_t)NROW * 2048 * 2);
static_assert(O_END <= (size_t)258 * 1024 * 1024, "workspace too large");

struct Params {
  const float *x, *c, *ctx, *c_ctx, *w_mod, *b_mod, *g_pre1, *g_post1, *g_pre2, *g_post2, *w_in, *g_q, *g_kv, *w_uq, *w_ukv, *g_sgu, *w_s, *b_s,
      *w_pa, *w_pb, *w_o, *w_pq, *k1, *k2, *u_exp, *v_exp;
  float* out; char* ws;
};

DEVI float bf2f(unsigned short h) { return __uint_as_float(((unsigned)h) << 16); }
DEVI unsigned short f2bf(float f) { unsigned u = __float_as_uint(f); u += 0x7fffu + ((u >> 16) & 1u); return (unsigned short)(u >> 16); }
typedef __bf16 bf16x2_t __attribute__((ext_vector_type(2)));
typedef float f32x2v_t __attribute__((ext_vector_type(2)));
DEVI unsigned pack2(float a, float b) { const f32x2v_t v = {a, b}; return __builtin_bit_cast(unsigned, __builtin_convertvector(v, bf16x2_t)); }
DEVI float lo2f(unsigned w) { return __uint_as_float(w << 16); }
DEVI float hi2f(unsigned w) { return __uint_as_float(w & 0xffff0000u); }
DEVI void unpack8(const u32x4& w, float* f) {
  f[0] = lo2f(w[0]); f[1] = hi2f(w[0]); f[2] = lo2f(w[1]); f[3] = hi2f(w[1]); f[4] = lo2f(w[2]); f[5] = hi2f(w[2]); f[6] = lo2f(w[3]); f[7] = hi2f(w[3]);
}
DEVI float gelu_t(float x) { const float z = 0.7978845608028654f * (x + 0.044715f * x * x * x); return x * __builtin_amdgcn_rcpf(1.f + __expf(-2.f * z)); }
DEVI float sigmoidf_(float x) { return __builtin_amdgcn_rcpf(1.f + __expf(-x)); }
DEVI float wave_sum(float v) { for (int o = 32; o > 0; o >>= 1) v += __shfl_xor(v, o); return v; }
DEVI float wave_max(float v) { for (int o = 32; o > 0; o >>= 1) v = fmaxf(v, __shfl_xor(v, o)); return v; }
DEVI void keyrow2(int row, int& b, int& key) { if (row < NTOK) { b = row >> 13; key = row & 8191; } else { const int c = row - NTOK; b = c >> 8; key = SEQ + (c & 255); } }
DEVI int keyrow(int row) { if (row < NTOK) return (row >> 13) * NKEY + (row & 8191); int c = row - NTOK; return (c >> 8) * NKEY + SEQ + (c & 255); }

__device__ const float ROPE_FREQ[16] = {1.0f, 0.5623413324356079f, 0.3162277638912201f, 0.17782793939113617f, 0.10000000149011612f, 0.05623413249850273f, 0.03162277489900589f, 0.017782794311642647f, 0.009999999776482582f, 0.005623413249850273f, 0.003162277629598975f, 0.0017782794311642647f, 0.0010000000474974513f, 0.000562341301701963f, 0.0003162277571391314f, 0.00017782794020604342f};
DEVI void sincos_small(double a, double& cs, double& sn) {
  const double k = rint(a * 0.15915494309189535); const double r = fma(-k, 6.283185307179586, a) - k * 2.4492935982947064e-16;
  const double r2 = r * r; double s = 0.0, c = 0.0;
#pragma unroll
  for (int n = 12; n >= 1; --n) { s = (1.0 - s * r2 / (double)((2 * n) * (2 * n + 1))); c = (1.0 - c * r2 / (double)((2 * n - 1) * (2 * n))); }
  sn = r * s; cs = c;
}

DEVI void transpose_job(const float* __restrict__ src, int K, int N, bf16_t* __restrict__ dst, const float* __restrict__ gk, bool isWin, int ntiles, char* smem) {
  const int tid = threadIdx.x; bf16_t* tl = (bf16_t*)smem; const int kt = K / 64;
  for (int idx = blockIdx.x; idx < ntiles; idx += gridDim.x) {
    const int ktile = idx % kt, ntile = idx / kt, k0 = ktile * 64, n0d = ntile * 64;
    int n0s = n0d; bool zero = false;
    if (isWin) { if (n0d == 2496) zero = true; else if (n0d >= 2560) n0s = n0d - 64; }
    { const int kk = tid >> 3, nn8 = (tid & 7) * 8; f32x4 va = {0.f, 0.f, 0.f, 0.f}, vb = va;
      if (!zero) { const float* s = src + (size_t)(k0 + kk) * N + n0s + nn8; const float4 a = *(const float4*)s, b = *(const float4*)(s + 4);
        const float sc = gk ? gk[k0 + kk] : 1.f; va = (f32x4){a.x, a.y, a.z, a.w} * sc; vb = (f32x4){b.x, b.y, b.z, b.w} * sc; }
      bf16_t* tp = tl + nn8 * 72 + kk;
      tp[0] = f2bf(va[0]); tp[72] = f2bf(va[1]); tp[144] = f2bf(va[2]); tp[216] = f2bf(va[3]); tp[288] = f2bf(vb[0]); tp[360] = f2bf(vb[1]); tp[432] = f2bf(vb[2]); tp[504] = f2bf(vb[3]); }
    __syncthreads();
    { const int nn = tid >> 3, kk8 = (tid & 7) * 8;
      const u32x4 o = *(const u32x4*)(tl + nn * 72 + kk8);
      *(u32x4*)(dst + (size_t)(n0d + nn) * K + k0 + kk8) = o; }
    __syncthreads();
  }
}

DEVI void ph_prep(const Params& p, char* smem) {
  const int tid = threadIdx.x, bid = blockIdx.x, nb = gridDim.x;
  char* ws = p.ws;
  if (bid == 0) { float* rope = (float*)(ws + O_ROPE);
    for (int i = tid; i < 128 * 16; i += NTHR) { const int pos = i >> 4, f = i & 15; const float ang = (float)pos * ROPE_FREQ[f];
      double cs, sn; sincos_small((double)ang, cs, sn); rope[i * 2] = (float)cs; rope[i * 2 + 1] = (float)sn; } }
  { float* red = (float*)smem; float* MOD = (float*)(ws + O_MOD);
    for (int it = bid; it < 256; it += nb) {
      const int cgp = tid % 6, kg = tid / 6;
      f32x4 a0 = {0.f, 0.f, 0.f, 0.f}, a1 = a0, a2 = a0;
      if (tid < 510) {
        for (int k = kg; k < 1024; k += 85) {
          const float4 w4 = *(const float4*)(p.w_mod + (size_t)k * 6144 + it * 24 + cgp * 4);
          const f32x4 w = {w4.x, w4.y, w4.z, w4.w};
          const float c0 = p.c[k], c1 = p.c[1024 + k], c2 = p.c_ctx[k];
          a0 += w * (c0 / (1.f + __expf(-c0))); a1 += w * (c1 / (1.f + __expf(-c1))); a2 += w * (c2 / (1.f + __expf(-c2)));
        }
        float* rp = red + kg * 72 + cgp * 4;
        rp[0] = a0[0]; rp[1] = a0[1]; rp[2] = a0[2]; rp[3] = a0[3];
        rp[24] = a1[0]; rp[25] = a1[1]; rp[26] = a1[2]; rp[27] = a1[3];
        rp[48] = a2[0]; rp[49] = a2[1]; rp[50] = a2[2]; rp[51] = a2[3];
      }
      __syncthreads();
      if (tid < 72) { float s = 0.f; for (int g = 0; g < 85; ++g) s += red[g * 72 + tid]; int r = tid / 24, n = it * 24 + tid % 24; MOD[r * 6144 + n] = s + p.b_mod[n]; }
      __syncthreads();
    } }
  transpose_job(p.w_in,  1024, INW,  (bf16_t*)(ws + O_WIN),  nullptr, true,  1152, smem);
  transpose_job(p.w_uq,  256,  1536, (bf16_t*)(ws + O_WUQ),  p.g_q,   false, 96,   smem);
  transpose_job(p.w_ukv, 128,  2048, (bf16_t*)(ws + O_WUKV), p.g_kv,  false, 64,   smem);
  transpose_job(p.w_pa,  1024, 1024, (bf16_t*)(ws + O_WPA),  nullptr, false, 256,  smem);
  transpose_job(p.w_pb,  1024, 1024, (bf16_t*)(ws + O_WPB),  nullptr, false, 256,  smem);
  transpose_job(p.w_o,   1024, 1024, (bf16_t*)(ws + O_WO),   nullptr, false, 256,  smem);
  transpose_job(p.w_pq,  1024, 2048, (bf16_t*)(ws + O_WPQ),  nullptr, false, 512,  smem);
  { const int n8 = (131072 + 16384 + 16384) / 8;
    for (int i = bid * NTHR + tid; i < n8; i += nb * NTHR) {
      int e = i * 8; const float* s; bf16_t* d;
      if (e < 131072) { s = p.w_s + e; d = (bf16_t*)(ws + O_WS) + e; }
      else if (e < 131072 + 16384) { s = p.k1 + (e - 131072); d = (bf16_t*)(ws + O_K1) + (e - 131072); }
      else { s = p.k2 + (e - 131072 - 16384); d = (bf16_t*)(ws + O_K2) + (e - 131072 - 16384); }
      const float4 a = *(const float4*)s, b = *(const float4*)(s + 4);
      u32x4 o = {pack2(a.x, a.y), pack2(a.z, a.w), pack2(b.x, b.y), pack2(b.z, b.w)};
      *(u32x4*)d = o;
    } }
}


using f32x32 = __attribute__((ext_vector_type(32))) float;
using u32x6 = __attribute__((ext_vector_type(6))) unsigned;
typedef u32x4 __attribute__((aligned(4))) u32x4_u;
typedef u32x2 __attribute__((aligned(4))) u32x2_u;
DEVI void convert_table_fp6(const float* __restrict__ src, unsigned char* __restrict__ dst, float* __restrict__ scale) {
  const int wave = threadIdx.x >> 6, lane = threadIdx.x & 63, h = lane >> 5, g = lane & 31;
  for (int rp = blockIdx.x * NWAVE + wave; rp < 8192; rp += gridDim.x * NWAVE) {
    const int row = rp * 2 + h;
    const float* sp = src + (size_t)row * 1024 + g * 32;
    f32x16 a, b; float am = 0.f;
#pragma unroll
    for (int j = 0; j < 4; ++j) { const float4 t = *(const float4*)(sp + j * 4), u = *(const float4*)(sp + 16 + j * 4);
      a[j * 4] = t.x; a[j * 4 + 1] = t.y; a[j * 4 + 2] = t.z; a[j * 4 + 3] = t.w; b[j * 4] = u.x; b[j * 4 + 1] = u.y; b[j * 4 + 2] = u.z; b[j * 4 + 3] = u.w;
      am = fmaxf(am, fmaxf(fmaxf(fmaxf(fabsf(t.x), fabsf(t.y)), fmaxf(fabsf(t.z), fabsf(t.w))), fmaxf(fmaxf(fabsf(u.x), fabsf(u.y)), fmaxf(fabsf(u.z), fabsf(u.w))))); }
    for (int o = 16; o > 0; o >>= 1) am = fmaxf(am, __shfl_xor(am, o));
    const float inv = am > 0.f ? 7.5f / am : 0.f;
    const u32x6 w = __builtin_amdgcn_cvt_scalef32_2xpk16_fp6_f32(a * inv, b * inv, 1.0f);
    unsigned char* dp = dst + (size_t)row * 768 + g * 24;
    *(u32x4_u*)dp = (u32x4){w[0], w[1], w[2], w[3]}; *(u32x2_u*)(dp + 16) = (u32x2){w[4], w[5]};
    if (g == 0) scale[row] = am * (1.f / 7.5f);
  }
}

DEVI void ph_hx(const Params& p, char* smem) {
  const int tid = threadIdx.x, wave = tid >> 6, lane = tid & 63;
  float* mA = (float*)smem; float* mB = mA + 3 * 1024;
  const float* MOD = (const float*)(p.ws + O_MOD);
  for (int i = tid; i < 3072; i += NTHR) { int r = i >> 10, c = i & 1023; mA[i] = p.g_pre1[c] * (1.f + MOD[r * 6144 + 1024 + c]); mB[i] = MOD[r * 6144 + c]; }
  __syncthreads();
  bf16_t* HX = (bf16_t*)(p.ws + O_RA);
  for (int row = blockIdx.x * NWAVE + wave; row < NROW; row += gridDim.x * NWAVE) {
    const float* src = row < NTOK ? p.x + (size_t)row * 1024 : p.ctx + (size_t)(row - NTOK) * 1024;
    const int mr = row < NTOK ? (row >> 13) : 2;
    float4 v[4]; float ss = 0.f;
#pragma unroll
    for (int i = 0; i < 4; ++i) { v[i] = *(const float4*)(src + i * 256 + lane * 4); ss += v[i].x * v[i].x + v[i].y * v[i].y + v[i].z * v[i].z + v[i].w * v[i].w; }
    ss = wave_sum(ss); const float rstd = rsqrtf(ss * (1.f / 1024.f) + EPS);
#pragma unroll
    for (int i = 0; i < 4; ++i) { const int c = i * 256 + lane * 4; const float* a = mA + mr * 1024 + c; const float* b = mB + mr * 1024 + c;
      u32x2 o = {pack2(v[i].x * rstd * a[0] + b[0], v[i].y * rstd * a[1] + b[1]), pack2(v[i].z * rstd * a[2] + b[2], v[i].w * rstd * a[3] + b[3])};
      *(u32x2*)(HX + (size_t)row * 1024 + c) = o; }
  }
}

DEVI int lds_sw(int row, int c) { return row * 128 + ((c ^ (row & 7)) << 4); }
template <int BM, int BN, bool ACOLMAP, bool GLDS, class Epi>
DEVI void gemm_tile_mfma(const bf16_t* __restrict__ A, int lda, const bf16_t* __restrict__ Bm, int ldb, int K, int row0, int col0, const Epi& epi, const float* kscale, char* smem) {
  constexpr int WNW = BN / 64, WMW = 8 / WNW, WTM = BM / WMW, MI = WTM / 16, ACH = BM / 64, BCH = BN / 64, ABYTES = BM * 128, BBYTES = BN * 128, STAGE = ABYTES + BBYTES;
  int tid = threadIdx.x; asm volatile("" : "+v"(tid));
  const int wave = __builtin_amdgcn_readfirstlane(tid >> 6), lane = tid & 63, wm = wave / WNW, wn = wave % WNW, l15 = lane & 15, lq = lane >> 4;
  f32x4 acc[MI][4];
#pragma unroll
  for (int mi = 0; mi < MI; ++mi)
#pragma unroll
    for (int ni = 0; ni < 4; ++ni) acc[mi][ni] = (f32x4){0.f, 0.f, 0.f, 0.f};
  const int nk = K >> 6;
  const int sr = tid >> 3, scc = tid & 7;
  auto compute = [&](int buf) {
    const char* sa = smem + buf * STAGE; const char* sb = sa + ABYTES;
#pragma unroll
    for (int ks = 0; ks < 2; ++ks) { const int kc = ks * 4 + lq; bf16x8 bfr[4];
#pragma unroll
      for (int ni = 0; ni < 4; ++ni) bfr[ni] = *(const bf16x8*)(sb + lds_sw(wn * 64 + ni * 16 + l15, kc));
#pragma unroll
      for (int mi = 0; mi < MI; ++mi) { const bf16x8 af = *(const bf16x8*)(sa + lds_sw(wm * WTM + mi * 16 + l15, kc));
#pragma unroll
        for (int ni = 0; ni < 4; ++ni) acc[mi][ni] = __builtin_amdgcn_mfma_f32_16x16x32_bf16(bfr[ni], af, acc[mi][ni], 0, 0, 0); }
    }
  };
  if constexpr (GLDS) {
    const unsigned aoff = (unsigned)(sr * lda + ((scc ^ (sr & 7)) * 8)) * 2u, boff = (unsigned)(sr * ldb + ((scc ^ (sr & 7)) * 8)) * 2u;
    auto gstage = [&](int buf, int kt) {
      const int k0 = kt * 64, ka = ACOLMAP ? k0 + (k0 >> 7) * 64 : k0;
      char* sa = smem + buf * STAGE + wave * 1024; char* sb = sa + ABYTES;
#pragma unroll
      for (int i = 0; i < ACH; ++i) __builtin_amdgcn_global_load_lds((const unsigned*)((const char*)(A + (size_t)(64 * i) * lda + ka) + aoff), (unsigned*)(sa + i * 8192), 16, 0, 0);
#pragma unroll
      for (int i = 0; i < BCH; ++i) __builtin_amdgcn_global_load_lds((const unsigned*)((const char*)(Bm + (size_t)(64 * i) * ldb + k0) + boff), (unsigned*)(sb + i * 8192), 16, 0, 0);
    };
    gstage(0, 0); asm volatile("s_waitcnt vmcnt(0)" ::: "memory"); __syncthreads();
    for (int kt = 0; kt < nk; ++kt) {
      if (kt + 1 < nk) gstage((kt + 1) & 1, kt + 1);
      compute(kt & 1);
      asm volatile("s_waitcnt vmcnt(0)" ::: "memory"); __syncthreads();
    }
  } else {
    u32x4 ra[ACH], rb[BCH];
    const unsigned aoff = (unsigned)(sr * lda + scc * 8) * 2u, boff = (unsigned)(sr * ldb + scc * 8) * 2u;
    const int sdst = lds_sw(sr, scc);
    auto gload = [&](int kt) {
      const int k0 = kt * 64, ka = ACOLMAP ? k0 + (k0 >> 7) * 64 : k0;
#pragma unroll
      for (int i = 0; i < ACH; ++i) { const char* ub = (const char*)(A + (size_t)(64 * i) * lda + ka); ra[i] = *(const u32x4*)(ub + aoff); }
#pragma unroll
      for (int i = 0; i < BCH; ++i) { const char* ub = (const char*)(Bm + (size_t)(64 * i) * ldb + k0); rb[i] = *(const u32x4*)(ub + boff); }
    };
    auto lstore = [&](int buf, int kt) {
      char* sa = smem + buf * STAGE + sdst; char* sb = sa + ABYTES;
#pragma unroll
      for (int i = 0; i < ACH; ++i) { u32x4 v = ra[i];
        if (kscale) { float f[8]; unpack8(v, f); const float* ks = kscale + kt * 64 + scc * 8;
          v = (u32x4){pack2(f[0] * ks[0], f[1] * ks[1]), pack2(f[2] * ks[2], f[3] * ks[3]), pack2(f[4] * ks[4], f[5] * ks[5]), pack2(f[6] * ks[6], f[7] * ks[7])}; }
        *(u32x4*)(sa + i * 8192) = v; }
#pragma unroll
      for (int i = 0; i < BCH; ++i) *(u32x4*)(sb + i * 8192) = rb[i];
    };
    gload(0); lstore(0, 0); __syncthreads();
    for (int kt = 0; kt < nk; ++kt) {
      if (kt + 1 < nk) gload(kt + 1);
      compute(kt & 1);
      if (kt + 1 < nk) lstore((kt + 1) & 1, kt + 1);
      __syncthreads();
    }
  }
  int tide = threadIdx.x; asm volatile("" : "+v"(tide));
  const int l15e = tide & 15, lqe = (tide >> 4) & 3;
  float cs[4][4];
  if constexpr (Epi::SCALE_MODE == 2) {
#pragma unroll
    for (int ni = 0; ni < 4; ++ni)
#pragma unroll
      for (int j = 0; j < 4; ++j) cs[ni][j] = epi.colscale(col0 + wn * 64 + ni * 16 + lqe * 4 + j); }
#pragma unroll
  for (int mi = 0; mi < MI; ++mi) { const int row = row0 + wm * WTM + mi * 16 + l15e; float sq = 0.f; float rs = 1.f;
    if constexpr (Epi::SCALE_MODE == 1) rs = epi.rowscale(row);
#pragma unroll
    for (int ni = 0; ni < 4; ++ni) { float v[4] = {acc[mi][ni][0], acc[mi][ni][1], acc[mi][ni][2], acc[mi][ni][3]};
      if constexpr (Epi::SCALE_MODE == 1) { v[0] *= rs; v[1] *= rs; v[2] *= rs; v[3] *= rs; }
      if constexpr (Epi::SCALE_MODE == 2) { v[0] *= cs[ni][0]; v[1] *= cs[ni][1]; v[2] *= cs[ni][2]; v[3] *= cs[ni][3]; }
      const float q = epi(row, col0 + wn * 64 + ni * 16 + lqe * 4, v);
      if (Epi::RSS) { sq += q; if (ni & 1) { sq += __shfl_xor(sq, 16); sq += __shfl_xor(sq, 32); if (lqe == 0) epi.rss(row, col0 + wn * 64 + (ni >> 1) * 32, sq); sq = 0.f; } } }
    __builtin_amdgcn_sched_barrier(0); }
}


namespace g8 {
constexpr int BK = 64, HALF = 128, HT = HALF * BK;
DEVI int lds_byte(int r, int c) { const int st = (r >> 4) * 2 + (c >> 5), rr = r & 15, cc = c & 31, ob = rr * 64 + cc * 2; return st * 1024 + (ob ^ (((ob >> 9) & 1) << 5)); }
DEVI void stage_rc(int b, int& R, int& C) { const int st = b / 1024, sb = b % 1024, swz = sb ^ (((sb >> 9) & 1) << 5); R = (st >> 1) * 16 + swz / 64; C = (st & 1) * 32 + (swz % 64) / 2; }
}
template <bool ACOLMAP, class Epi>
DEVI void gemm_tile_8ph(const bf16_t* __restrict__ A, int lda, const bf16_t* __restrict__ Bt, int ldb, int K, int row0, int col0, const Epi& epi, char* smem) {
  using namespace g8;
  bf16_t* shm = (bf16_t*)smem;
#define SA(b, h) (shm + ((b) * 2 + (h)) * HT)
#define SB(b, h) (shm + (4 + (b) * 2 + (h)) * HT)
#define STAGE_A(P, r0, kt) do { const int _k0 = (kt) * BK, _ka = ACOLMAP ? _k0 + (_k0 >> 7) * 64 : _k0; \
    __builtin_amdgcn_global_load_lds((const unsigned*)((const char*)(A + (size_t)(r0) * lda + _ka) + ao0), (unsigned*)((char*)(P) + wid * 1024), 16, 0, 0); \
    __builtin_amdgcn_global_load_lds((const unsigned*)((const char*)(A + (size_t)((r0) + 64) * lda + _ka) + ao0), (unsigned*)((char*)(P) + wid * 1024 + 8192), 16, 0, 0); } while (0)
#define STAGE_B(P, r0, kt) do { const int _k0 = (kt) * BK; \
    __builtin_amdgcn_global_load_lds((const unsigned*)((const char*)(Bt + (size_t)(r0) * ldb + _k0) + bo0), (unsigned*)((char*)(P) + wid * 1024), 16, 0, 0); \
    __builtin_amdgcn_global_load_lds((const unsigned*)((const char*)(Bt + (size_t)((r0) + 64) * ldb + _k0) + bo0), (unsigned*)((char*)(P) + wid * 1024 + 8192), 16, 0, 0); } while (0)
#define LDA(dst, b, h) _Pragma("unroll") for (int m = 0; m < 4; ++m) _Pragma("unroll") for (int k = 0; k < 2; ++k) \
    dst[m][k] = *reinterpret_cast<const bf16x8*>((const char*)SA(b, h) + lds_byte(wr * 64 + m * 16 + fr, k * 32 + fq * 8))
#define LDB(dst, b, h) _Pragma("unroll") for (int n = 0; n < 2; ++n) _Pragma("unroll") for (int k = 0; k < 2; ++k) \
    dst[n][k] = *reinterpret_cast<const bf16x8*>((const char*)SB(b, h) + lds_byte(wc * 32 + n * 16 + fr, k * 32 + fq * 8))
#define MMA(ai, bj, At_, Bt_) do { __builtin_amdgcn_s_setprio(1); \
    _Pragma("unroll") for (int m = 0; m < 4; ++m) _Pragma("unroll") for (int n = 0; n < 2; ++n) _Pragma("unroll") for (int k = 0; k < 2; ++k) \
      acc[ai][bj][m][n] = __builtin_amdgcn_mfma_f32_16x16x32_bf16(Bt_[n][k], At_[m][k], acc[ai][bj][m][n], 0, 0, 0); \
    __builtin_amdgcn_s_setprio(0); } while (0)
#define WAIT_V(n) asm volatile("s_waitcnt vmcnt(" #n ")" ::: "memory")
#define WAIT_L(n) asm volatile("s_waitcnt lgkmcnt(" #n ")" ::: "memory")
#define BAR __builtin_amdgcn_s_barrier()
#define SCHED __builtin_amdgcn_sched_barrier(0)
  int tid = threadIdx.x; asm volatile("" : "+v"(tid));
  const int wid = __builtin_amdgcn_readfirstlane(tid >> 6), lane = tid & 63, wr = wid >> 2, wc = wid & 3, fr = lane & 15, fq = lane >> 4;
  unsigned ao0, bo0;
  { int r, c; stage_rc(tid * 16, r, c); ao0 = (unsigned)(r * lda + c) * 2u; bo0 = (unsigned)(r * ldb + c) * 2u; }
  f32x4 acc[2][2][4][2];
#pragma unroll
  for (int a = 0; a < 2; ++a)
#pragma unroll
    for (int b = 0; b < 2; ++b)
#pragma unroll
      for (int m = 0; m < 4; ++m)
#pragma unroll
        for (int n = 0; n < 2; ++n) acc[a][b][m][n] = (f32x4){0.f, 0.f, 0.f, 0.f};
  bf16x8 At[4][2], B0[2][2], B1[2][2];
  const int nt = K / BK;
  STAGE_B(SB(0, 0), 0, 0); STAGE_A(SA(0, 0), 0, 0);
  STAGE_B(SB(0, 1), HALF, 0); STAGE_A(SA(0, 1), HALF, 0);
  if (wr == 1) BAR;
  WAIT_V(4); BAR;
  STAGE_B(SB(1, 0), 0, 1); STAGE_A(SA(1, 0), 0, 1); STAGE_B(SB(1, 1), HALF, 1);
  WAIT_V(6); BAR;
  for (int t = 0; t < nt - 2; t += 2) {
    LDB(B0, 0, 0); SCHED; LDA(At, 0, 0); STAGE_A(SA(1, 1), HALF, t + 1);
    WAIT_L(8); BAR; WAIT_L(0); MMA(0, 0, At, B0); BAR; SCHED;
    LDB(B1, 0, 1); STAGE_B(SB(0, 0), 0, t + 2);
    BAR; WAIT_L(0); MMA(0, 1, At, B1); BAR;
    LDA(At, 0, 1); STAGE_A(SA(0, 0), 0, t + 2);
    BAR; WAIT_L(0); MMA(1, 0, At, B0); BAR; SCHED;
    STAGE_B(SB(0, 1), HALF, t + 2);
    WAIT_V(6); BAR; MMA(1, 1, At, B1); BAR;
    LDB(B0, 1, 0); SCHED; LDA(At, 1, 0); STAGE_A(SA(0, 1), HALF, t + 2);
    WAIT_L(8); BAR; WAIT_L(0); MMA(0, 0, At, B0); BAR; SCHED;
    LDB(B1, 1, 1); STAGE_B(SB(1, 0), 0, t + 3);
    BAR; WAIT_L(0); MMA(0, 1, At, B1); BAR;
    LDA(At, 1, 1); STAGE_A(SA(1, 0), 0, t + 3);
    BAR; WAIT_L(0); MMA(1, 0, At, B0); BAR; SCHED;
    STAGE_B(SB(1, 1), HALF, t + 3);
    WAIT_V(6); BAR; MMA(1, 1, At, B1); BAR;
  }
  { LDB(B0, 0, 0); LDA(At, 0, 0); STAGE_A(SA(1, 1), HALF, nt - 1);
    BAR; WAIT_L(0); MMA(0, 0, At, B0); BAR;
    LDB(B1, 0, 1); BAR; WAIT_L(0); MMA(0, 1, At, B1); BAR;
    LDA(At, 0, 1); WAIT_V(4); BAR; WAIT_L(0); MMA(1, 0, At, B0); MMA(1, 1, At, B1); BAR; }
  { LDB(B0, 1, 0); LDA(At, 1, 0); WAIT_V(2); BAR; WAIT_L(0); MMA(0, 0, At, B0); BAR;
    LDB(B1, 1, 1); WAIT_V(0); BAR; WAIT_L(0); MMA(0, 1, At, B1); BAR;
    LDA(At, 1, 1); BAR; WAIT_L(0); MMA(1, 0, At, B0); MMA(1, 1, At, B1); BAR; }
  if (wr == 0) BAR;
  int tide = threadIdx.x; asm volatile("" : "+v"(tide));
  const int fre = tide & 15, fqe = (tide >> 4) & 3;
#pragma unroll
  for (int ai = 0; ai < 2; ++ai)
#pragma unroll
    for (int m = 0; m < 4; ++m) { const int row = row0 + ai * HALF + wr * 64 + m * 16 + fre;
#pragma unroll
      for (int bj = 0; bj < 2; ++bj) { float sq = 0.f;
#pragma unroll
        for (int n = 0; n < 2; ++n) { const float v[4] = {acc[ai][bj][m][n][0], acc[ai][bj][m][n][1], acc[ai][bj][m][n][2], acc[ai][bj][m][n][3]};
          sq += epi(row, col0 + bj * HALF + wc * 32 + n * 16 + fqe * 4, v); }
        if (Epi::RSS) { sq += __shfl_xor(sq, 16); sq += __shfl_xor(sq, 32); if (fqe == 0) epi.rss(row, col0 + bj * HALF + wc * 32, sq); } }
      __builtin_amdgcn_sched_barrier(0); }
#undef SA
#undef SB
#undef STAGE_A
#undef STAGE_B
#undef LDA
#undef LDB
#undef MMA
#undef WAIT_V
#undef WAIT_L
#undef BAR
#undef SCHED
}

template <int BM, int BN, bool ACOLMAP, class Epi>
DEVI void gemm_tile(const bf16_t* A, int lda, const bf16_t* Bm, int ldb, int K, int row0, int col0, const Epi& epi, const float* kss, char* smem) {
  if constexpr (BM == 256 && BN == 256) gemm_tile_8ph<ACOLMAP>(A, lda, Bm, ldb, K, row0, col0, epi, smem);
  else if (kss) gemm_tile_mfma<BM, BN, ACOLMAP, false>(A, lda, Bm, ldb, K, row0, col0, epi, kss, smem);
  else gemm_tile_mfma<BM, BN, ACOLMAP, true>(A, lda, Bm, ldb, K, row0, col0, epi, nullptr, smem);
}

DEVI void st4bf(bf16_t* d, float a, float b, float c, float e) { u32x2 o = {pack2(a, b), pack2(c, e)}; *(u32x2*)d = o; }

struct EpiIn { static constexpr bool RSS = true; static constexpr int SCALE_MODE = 0; bf16_t *GU, *GVT, *CQ, *CKV, *KR; float *rssv, *rssq, *rsskv;
  DEVI float operator()(int row, int col, const float (&v)[4]) const {
    if (col < 1024) { st4bf(GU + (size_t)row * 1024 + col, gelu_t(v[0]), gelu_t(v[1]), gelu_t(v[2]), gelu_t(v[3])); return 0.f; }
    else if (col < 2048) { const int c = col - 1024, chunk = row >> 7, q = row & 127; float s = 0.f;
#pragma unroll
      for (int j = 0; j < 4; ++j) { const float g = gelu_t(v[j]); s += g * g; GVT[((size_t)chunk * 1024 + c + j) * 128 + q] = f2bf(g); }
      return s; }
    else if (col < 2304) { st4bf(CQ + (size_t)row * 256 + (col - 2048), v[0], v[1], v[2], v[3]); return v[0] * v[0] + v[1] * v[1] + v[2] * v[2] + v[3] * v[3]; }
    else if (col < 2432) { st4bf(CKV + (size_t)row * 128 + (col - 2304), v[0], v[1], v[2], v[3]); return v[0] * v[0] + v[1] * v[1] + v[2] * v[2] + v[3] * v[3]; }
    else if (col < 2496) { st4bf(KR + (size_t)keyrow(row) * 64 + (col - 2432), v[0], v[1], v[2], v[3]); return 0.f; }
    return 0.f; }
  DEVI void rss(int row, int col, float s) const {
    if (col >= 1024 && col < 2048) rssv[row * 32 + ((col - 1024) >> 5)] = s; else if (col >= 2048 && col < 2304) rssq[row * 8 + ((col - 2048) >> 5)] = s; else if (col >= 2304 && col < 2432) rsskv[row * 4 + ((col - 2304) >> 5)] = s; }
};
struct EpiQ { static constexpr bool RSS = false; static constexpr int SCALE_MODE = 1; bf16_t* Q; const float* rssq;
  DEVI float rowscale(int row) const { const float4 ps = *(const float4*)(rssq + row * 8), pt = *(const float4*)(rssq + row * 8 + 4); return rsqrtf((((ps.x + ps.y) + (ps.z + ps.w)) + ((pt.x + pt.y) + (pt.z + pt.w))) * (1.f / 256.f) + EPS); }
  DEVI float operator()(int row, int col, const float (&v)[4]) const { st4bf(Q + (size_t)row * 1536 + col, v[0], v[1], v[2], v[3]); return 0.f; }
  DEVI void rss(int, int, float) const {} };
DEVI int pk4_fp8(float a, float b, float c, float d) { int w = __builtin_amdgcn_cvt_pk_fp8_f32(a, b, 0, false); return __builtin_amdgcn_cvt_pk_fp8_f32(c, d, w, true); }
constexpr size_t O_K8 = O_RKV, O_V8T = O_RKV + al256((size_t)NB * 8 * NKEY * 192);
struct EpiK8 { static constexpr bool RSS = false; static constexpr int SCALE_MODE = 1; unsigned char* K8; const float* rsskv;
  DEVI float rowscale(int row) const { const float4 pk = *(const float4*)(rsskv + row * 4); return rsqrtf(((pk.x + pk.y) + (pk.z + pk.w)) * (1.f / 128.f) + EPS); }
  DEVI float operator()(int row, int col, const float (&v)[4]) const {
    int b, key; keyrow2(row, b, key); const int h = col >> 7, d = col & 127;
    *(int*)(K8 + ((size_t)(b * 8 + h) * NKEY + key) * 192 + d) = pk4_fp8(v[0], v[1], v[2], v[3]); return 0.f; }
  DEVI void rss(int, int, float) const {} };
struct EpiV8T { static constexpr bool RSS = false; static constexpr int SCALE_MODE = 2; unsigned char* V8; const float* rsskv;
  DEVI float colscale(int col) const { const float4 pk = *(const float4*)(rsskv + col * 4); return rsqrtf(((pk.x + pk.y) + (pk.z + pk.w)) * (1.f / 128.f) + EPS); }
  DEVI float operator()(int row, int col, const float (&v)[4]) const {
    int b, key; keyrow2(col, b, key); const int h = row >> 7, d = row & 127, kk = key & 63;
    const int off = 32 * ((kk >> 2) & 1) + 16 * (kk >> 5) + 4 * ((kk >> 3) & 3);
    *(int*)(V8 + ((size_t)(b * 8 + h) * 128 + d) * NKEY + (key & ~63) + off) = pk4_fp8(v[0], v[1], v[2], v[3]); return 0.f; }
  DEVI void rss(int, int, float) const {} };
struct EpiSgu { static constexpr bool RSS = false; static constexpr int SCALE_MODE = 0; bf16_t* GUOA; const float* g_sgu; const float* b_s; int chunk, g;
  DEVI float operator()(int row, int col, const float (&v)[4]) const { const int token = chunk * 128 + row, ch = g * 128 + col; const float bias = b_s[g * 128 + row];
    bf16_t* ptr = GUOA + (size_t)token * 1024 + ch; const u32x2 gu = *(const u32x2*)ptr;
    st4bf(ptr, lo2f(gu[0]) * (g_sgu[ch] * v[0] + bias), hi2f(gu[0]) * (g_sgu[ch + 1] * v[1] + bias), lo2f(gu[1]) * (g_sgu[ch + 2] * v[2] + bias), hi2f(gu[1]) * (g_sgu[ch + 3] * v[3] + bias));
    return 0.f; }
  DEVI void rss(int, int, float) const {} };
struct EpiGate { static constexpr bool RSS = false; static constexpr int SCALE_MODE = 0; bf16_t* G;
  DEVI float operator()(int row, int col, const float (&v)[4]) const { st4bf(G + (size_t)row * 2048 + col, sigmoidf_(v[0]), sigmoidf_(v[1]), sigmoidf_(v[2]), sigmoidf_(v[3])); return 0.f; }
  DEVI void rss(int, int, float) const {} };
template <bool SECOND> struct EpiMerge { static constexpr bool RSS = false; static constexpr int SCALE_MODE = 0; bf16_t* M; const bf16_t* G;
  DEVI float operator()(int row, int col, const float (&v)[4]) const { const u32x2 g = *(const u32x2*)(G + (size_t)row * 2048 + (SECOND ? 1024 : 0) + col);
    float o0 = lo2f(g[0]) * v[0], o1 = hi2f(g[0]) * v[1], o2 = lo2f(g[1]) * v[2], o3 = hi2f(g[1]) * v[3];
    bf16_t* ptr = M + (size_t)row * 1024 + col;
    if (SECOND) { const u32x2 m = *(const u32x2*)ptr; o0 += lo2f(m[0]); o1 += hi2f(m[0]); o2 += lo2f(m[1]); o3 += hi2f(m[1]); }
    st4bf(ptr, o0, o1, o2, o3); return 0.f; }
  DEVI void rss(int, int, float) const {} };
struct EpiO { static constexpr bool RSS = true; static constexpr int SCALE_MODE = 0; bf16_t* Y; float* rssy;
  DEVI float operator()(int row, int col, const float (&v)[4]) const { st4bf(Y + (size_t)row * 1024 + col, v[0], v[1], v[2], v[3]); return v[0] * v[0] + v[1] * v[1] + v[2] * v[2] + v[3] * v[3]; }
  DEVI void rss(int row, int col, float s) const { rssy[row * 32 + (col >> 5)] = s; } };
struct EpiPq { static constexpr bool RSS = false; static constexpr int SCALE_MODE = 0; bf16_t* QP;
  DEVI float operator()(int row, int col, const float (&v)[4]) const { st4bf(QP + (size_t)row * 2048 + col, v[0], v[1], v[2], v[3]); return 0.f; }
  DEVI void rss(int, int, float) const {} };

template <class F> DEVI void for_tiles_xcd(int MT, int NT, F f) {
  const int nb = gridDim.x;
  if ((nb & 7) == 0 && (MT & 7) == 0) { const int xcd = blockIdx.x & 7, slot = blockIdx.x >> 3, slots = nb >> 3, mper = MT >> 3, tot = mper * NT;
    for (int j = slot; j < tot; j += slots) f(xcd * mper + j / NT, j % NT); }
  else for (int i = blockIdx.x; i < MT * NT; i += nb) f(i / NT, i % NT);
}

DEVI void ph_inproj(const Params& p, char* smem) {
  char* ws = p.ws;
  EpiIn epi{(bf16_t*)(ws + O_RB), (bf16_t*)(ws + O_RC), (bf16_t*)(ws + O_CQ), (bf16_t*)(ws + O_CKV), (bf16_t*)(ws + O_KR), (float*)(ws + O_RSSV), (float*)(ws + O_RSSQ), (float*)(ws + O_RSSKV)};
  const bf16_t* HX = (const bf16_t*)(ws + O_RA); const bf16_t* W = (const bf16_t*)(ws + O_WIN);
  auto tile = [&](int mt, int nt) { gemm_tile<256, 256, false>(HX + (size_t)mt * 256 * 1024, 1024, W + (size_t)nt * 256 * 1024, 1024, 1024, mt * 256, nt * 256, epi, nullptr, smem); };
  for_tiles_xcd(64, 10, tile);
  for (int i = (int)gridDim.x - 1 - (int)blockIdx.x; i < 2; i += gridDim.x) tile(64 + i, 9);
}
DEVI void rope_kr_fp8(const Params& p) {
  const bf16_t* KR = (const bf16_t*)(p.ws + O_KR); const float* rope = (const float*)(p.ws + O_ROPE); unsigned char* K8 = (unsigned char*)(p.ws + O_K8);
  for (int i = blockIdx.x * NTHR + threadIdx.x; i < NROW * 2; i += gridDim.x * NTHR) {
    const int row = i >> 1, which = i & 1, kr = keyrow(row); int b, key; keyrow2(row, b, key);
    float x[32];
    const bf16_t* src = KR + (size_t)kr * 64 + which * 32;
#pragma unroll
    for (int q = 0; q < 4; ++q) unpack8(*(const u32x4*)(src + q * 8), x + q * 8);
    if (row < NTOK) { const int pos = row & 8191, pp = which ? (pos & 63) : (pos >> 6); const float* cs = rope + pp * 32;
#pragma unroll
      for (int j = 0; j < 16; ++j) { const float c = cs[j * 2], sn = cs[j * 2 + 1], x1 = x[j], x2 = x[16 + j]; x[j] = x1 * c - x2 * sn; x[16 + j] = x1 * sn + x2 * c; } }
    u32x4 o0, o1;
#pragma unroll
    for (int q = 0; q < 4; ++q) { o0[q] = (unsigned)pk4_fp8(x[q * 4], x[q * 4 + 1], x[q * 4 + 2], x[q * 4 + 3]); o1[q] = (unsigned)pk4_fp8(x[16 + q * 4], x[17 + q * 4], x[18 + q * 4], x[19 + q * 4]); }
#pragma unroll
    for (int h = 0; h < 8; ++h) { unsigned char* d = K8 + ((size_t)(b * 8 + h) * NKEY + key) * 192 + 128 + which * 32; *(u32x4*)d = o0; *(u32x4*)(d + 16) = o1; }
  }
}
DEVI void ph_mid(const Params& p, char* smem) {
  char* ws = p.ws;
  { EpiQ epi{(bf16_t*)(ws + O_RQ), (const float*)(ws + O_RSSQ)};
    const bf16_t* A = (const bf16_t*)(ws + O_CQ); const bf16_t* W = (const bf16_t*)(ws + O_WUQ);
    for_tiles_xcd(64, 12, [&](int mt, int nt) { gemm_tile<256, 128, false>(A + (size_t)mt * 256 * 256, 256, W + (size_t)nt * 128 * 256, 256, 256, mt * 256, nt * 128, epi, nullptr, smem); }); }
  { EpiK8 epi{(unsigned char*)(ws + O_K8), (const float*)(ws + O_RSSKV)};
    const bf16_t* A = (const bf16_t*)(ws + O_CKV); const bf16_t* W = (const bf16_t*)(ws + O_WUKV);
    auto tile = [&](int mt, int nt) { gemm_tile<256, 128, false>(A + (size_t)mt * 256 * 128, 128, W + (size_t)nt * 256 * 128, 128, 128, mt * 256, nt * 128, epi, nullptr, smem); };
    for_tiles_xcd(64, 8, tile);
    for (int i = blockIdx.x; i < 16; i += gridDim.x) tile(64 + (i >> 3), i & 7); }
  { EpiV8T epi{(unsigned char*)(ws + O_V8T), (const float*)(ws + O_RSSKV)};
    const bf16_t* A = (const bf16_t*)(ws + O_WUKV); const bf16_t* Bc = (const bf16_t*)(ws + O_CKV);
    for (int i = blockIdx.x; i < 8 * 132; i += gridDim.x) { const int mt = i & 7, nt = i >> 3;
      gemm_tile<128, 128, false>(A + (size_t)(mt * 256 + 128) * 128, 128, Bc + (size_t)nt * 128 * 128, 128, 128, mt * 128, nt * 128, epi, nullptr, smem); } }
  { const bf16_t* WS = (const bf16_t*)(ws + O_WS); const bf16_t* GVT = (const bf16_t*)(ws + O_RC);
    float* ksc = (float*)(smem + LDS_BYTES - 1024); const float* rssv = (const float*)(ws + O_RSSV);
    for (int i = blockIdx.x; i < 1024; i += gridDim.x) { const int chunk = i >> 3, g = i & 7;
      __syncthreads();
      if (threadIdx.x < 128) { const float* pr = rssv + (size_t)(chunk * 128 + threadIdx.x) * 32; float t = 0.f;
#pragma unroll
        for (int j = 0; j < 32; ++j) t += pr[j];
        ksc[threadIdx.x] = rsqrtf(t * (1.f / 1024.f) + EPS); }
      __syncthreads();
      EpiSgu epi{(bf16_t*)(ws + O_RB), p.g_sgu, p.b_s, chunk, g};
      gemm_tile<128, 128, false>(WS + (size_t)g * 16384, 128, GVT + ((size_t)chunk * 1024 + g * 128) * 128, 128, 128, 0, 0, epi, ksc, smem); } }
  rope_kr_fp8(p);
}
DEVI void ph_gates(const Params& p, char* smem) {
  char* ws = p.ws; EpiGate epi{(bf16_t*)(ws + O_RKV)};
  const bf16_t* HX = (const bf16_t*)(ws + O_RA); const bf16_t* W = (const bf16_t*)(ws + O_WIN) + (size_t)NPRE * 1024;
  for_tiles_xcd(64, 8, [&](int mt, int nt) { gemm_tile<256, 256, false>(HX + (size_t)mt * 256 * 1024, 1024, W + (size_t)nt * 256 * 1024, 1024, 1024, mt * 256, nt * 256, epi, nullptr, smem); });
}
DEVI void ph_merge(const Params& p, char* smem) {
  char* ws = p.ws; bf16_t* M = (bf16_t*)(ws + O_RC); const bf16_t* G = (const bf16_t*)(ws + O_RKV);
  EpiMerge<false> e1{M, G}; EpiMerge<true> e2{M, G};
  const bf16_t* OA = (const bf16_t*)(ws + O_RB); const bf16_t* OB = (const bf16_t*)(ws + O_RQ);
  const bf16_t* WA = (const bf16_t*)(ws + O_WPA); const bf16_t* WB = (const bf16_t*)(ws + O_WPB);
  for_tiles_xcd(64, 4, [&](int mt, int nt) { gemm_tile<256, 256, false>(OA + (size_t)mt * 256 * 1024, 1024, WA + (size_t)nt * 256 * 1024, 1024, 1024, mt * 256, nt * 256, e1, nullptr, smem); });
  for_tiles_xcd(64, 4, [&](int mt, int nt) { gemm_tile<256, 256, true>(OB + (size_t)mt * 256 * 1536, 1536, WB + (size_t)nt * 256 * 1024, 1024, 1024, mt * 256, nt * 256, e2, nullptr, smem); });
}
DEVI void ph_wo(const Params& p, char* smem) {
  char* ws = p.ws; EpiO epi{(bf16_t*)(ws + O_RA), (float*)(ws + O_RSSY)};
  const bf16_t* M = (const bf16_t*)(ws + O_RC); const bf16_t* W = (const bf16_t*)(ws + O_WO);
  for_tiles_xcd(64, 4, [&](int mt, int nt) { gemm_tile<256, 256, false>(M + (size_t)mt * 256 * 1024, 1024, W + (size_t)nt * 256 * 1024, 1024, 1024, mt * 256, nt * 256, epi, nullptr, smem); });
}
DEVI void ph_wpq(const Params& p, char* smem) {
  char* ws = p.ws; EpiPq epi{(bf16_t*)(ws + O_RKV)};
  const bf16_t* A = (const bf16_t*)(ws + O_RB); const bf16_t* W = (const bf16_t*)(ws + O_WPQ);
  for_tiles_xcd(64, 8, [&](int mt, int nt) { gemm_tile<256, 256, false>(A + (size_t)mt * 256 * 1024, 1024, W + (size_t)nt * 256 * 1024, 1024, 1024, mt * 256, nt * 256, epi, nullptr, smem); });
  convert_table_fp6(p.v_exp, (unsigned char*)(ws + O_RA), (float*)(ws + O_RA + (size_t)16384 * 1024));
}

namespace a8 {
constexpr int KVBLK = 64, SHM_K = KVBLK * 192, SHM_V = 128 * KVBLK;
constexpr int SHM_K2 = 2 * SHM_K, SHM_V2 = 2 * SHM_V;
constexpr float SCALE = 0.07216878364870322f, THR = 1.5f;
using i32x8 = __attribute__((ext_vector_type(8))) int;
DEVI int crow(int r, int hi) { return (r & 3) + 8 * (r >> 2) + 4 * hi; }
DEVI f32x16 mma(const i32x8& a, const i32x8& b, const f32x16& c) { return __builtin_amdgcn_mfma_scale_f32_32x32x64_f8f6f4(a, b, c, 0, 0, 0, 0x7f7f7f7f, 0, 0x7f7f7f7f); }
DEVI void partialSM(f32x16& p0, f32x16& p1, float& m_reg, float& mn, float& alpha) {
  constexpr float C = SCALE * 1.4426950408889634f;
  float pmax = p0[0];
#pragma unroll
  for (int r = 1; r < 16; ++r) pmax = fmaxf(pmax, p0[r]);
#pragma unroll
  for (int r = 0; r < 16; ++r) pmax = fmaxf(pmax, p1[r]);
  { auto rr = __builtin_amdgcn_permlane32_swap(__float_as_uint(pmax), __float_as_uint(pmax), false, false);
    pmax = fmaxf(__uint_as_float(rr[0]), __uint_as_float(rr[1])); }
  if (__builtin_expect(__all(pmax - m_reg <= THR / SCALE), 1)) { mn = m_reg; alpha = 1.f; }
  else { mn = fmaxf(m_reg, pmax); alpha = __builtin_amdgcn_exp2f((m_reg - mn) * C); m_reg = mn; }
  const float mnC = 6.f - mn * C;
#pragma unroll
  for (int r = 0; r < 16; ++r) p0[r] = fmaf(p0[r], C, mnC);
#pragma unroll
  for (int r = 0; r < 16; ++r) p1[r] = fmaf(p1[r], C, mnC);
#pragma unroll
  for (int r = 0; r < 16; ++r) p0[r] = __builtin_amdgcn_exp2f(p0[r]);
}
DEVI void finishSM(f32x16& p0, f32x16& p1, float alpha, float& l_reg, i32x8& pa) {
#pragma unroll
  for (int r = 0; r < 16; ++r) p1[r] = __builtin_amdgcn_exp2f(p1[r]);
  float ps = 0;
#pragma unroll
  for (int r = 0; r < 16; ++r) ps += p0[r];
#pragma unroll
  for (int r = 0; r < 16; ++r) ps += p1[r];
  { auto rr = __builtin_amdgcn_permlane32_swap(__float_as_uint(ps), __float_as_uint(ps), false, false);
    ps = __uint_as_float(rr[0]) + __uint_as_float(rr[1]); }
  l_reg = l_reg * alpha + ps;
#pragma unroll
  for (int j = 0; j < 4; ++j) { pa[j] = pk4_fp8(p0[4 * j], p0[4 * j + 1], p0[4 * j + 2], p0[4 * j + 3]); pa[4 + j] = pk4_fp8(p1[4 * j], p1[4 * j + 1], p1[4 * j + 2], p1[4 * j + 3]); }
}
DEVI i32x8 ld32(const char* p0, const char* p1) { const u32x4 a = *(const u32x4*)p0, b = *(const u32x4*)p1; return (i32x8){(int)a[0], (int)a[1], (int)a[2], (int)a[3], (int)b[0], (int)b[1], (int)b[2], (int)b[3]}; }
DEVI void qkt(f32x16& p0, f32x16& p1, const char* Ks, const i32x8* qf, int r32, int hi) {
  p0 = f32x16{}; p1 = f32x16{};
  const int sw = (r32 >> 2) & 3; const char* k0 = Ks + r32 * 192; const char* k1 = k0 + 32 * 192;
#pragma unroll
  for (int m = 0; m < 3; ++m) { const int c0 = ((4 * m + 2 * hi) ^ sw) << 4, c1 = ((4 * m + 2 * hi + 1) ^ sw) << 4;
    p0 = mma(ld32(k0 + c0, k0 + c1), qf[m], p0);
    p1 = mma(ld32(k1 + c0, k1 + c1), qf[m], p1); }
}
DEVI void pv(f32x16* o, const char* Vs, int tile, const i32x8& pa, int r32, int hi) {
  const int sw = (r32 >> 1) & 7, c0 = ((4 * tile + 2 * hi) ^ sw) << 4, c1 = ((4 * tile + 2 * hi + 1) ^ sw) << 4;
#pragma unroll
  for (int db = 0; db < 4; ++db) { const char* vr = Vs + (32 * db + r32) * 128; o[db] = mma(pa, ld32(vr + c0, vr + c1), o[db]); }
}
DEVI void attn_item(bf16_t* __restrict__ Qb, const unsigned char* __restrict__ Kg, const unsigned char* __restrict__ Vg, const float* __restrict__ rope, int pos0, char* lds) {
  const int tid = threadIdx.x, wid = tid >> 6, lane = tid & 63, r32 = lane & 31, hi = lane >> 5;
  char* V_lds = lds; char* K_lds = lds + 3 * SHM_V2;
  float* wsl = (float*)(lds + 3 * SHM_V2 + 3 * SHM_K2) + wid * 64; float* li_l = wsl; float* al_l = wsl + 32;
  float m_reg = -1e30f, l_reg = 0; f32x16 o[4] = {}; i32x8 qf[3];
  { const bf16_t* Qw = Qb + (size_t)(wid * 32 + r32) * 1536 + hi * 32;
#pragma unroll
    for (int m = 0; m < 3; ++m) { float x[32];
#pragma unroll
      for (int q = 0; q < 4; ++q) unpack8(*(const u32x4*)(Qw + m * 64 + q * 8), x + q * 8);
      if (m == 2) { const int pos = pos0 + wid * 32 + r32, pp = hi ? (pos & 63) : (pos >> 6); const float* cs = rope + pp * 32;
#pragma unroll
        for (int j = 0; j < 16; ++j) { const float c = cs[j * 2], sn = cs[j * 2 + 1], x1 = x[j], x2 = x[16 + j]; x[j] = x1 * c - x2 * sn; x[16 + j] = x1 * sn + x2 * c; } }
#pragma unroll
      for (int q = 0; q < 8; ++q) qf[m][q] = pk4_fp8(x[q * 4], x[q * 4 + 1], x[q * 4 + 2], x[q * 4 + 3]);
      __builtin_amdgcn_sched_barrier(0); } }
  unsigned koff[3], voff[2];
#pragma unroll
  for (int i = 0; i < 3; ++i) { const int pp = wid * 64 + lane + 512 * i, key = pp / 12, c = pp - key * 12; koff[i] = (unsigned)(key * 192 + ((c ^ ((key >> 2) & 3)) << 4)); }
#pragma unroll
  for (int i = 0; i < 2; ++i) { const int pp = wid * 64 + lane + 512 * i, d = pp >> 3, c = pp & 7; voff[i] = (unsigned)(d * NKEY + ((c ^ ((d >> 1) & 7)) << 4)); }
#define GSTAGE(s_, kb, vb) do { const unsigned char* ks = Kg + (size_t)(s_) * SHM_K2; const unsigned char* vs = Vg + (s_) * 128; \
    _Pragma("unroll") for (int i = 0; i < 3; ++i) __builtin_amdgcn_global_load_lds((const unsigned*)(ks + koff[i]), (unsigned*)(K_lds + (kb) + i * 8192 + wid * 1024), 16, 0, 0); \
    _Pragma("unroll") for (int i = 0; i < 2; ++i) __builtin_amdgcn_global_load_lds((const unsigned*)(vs + voff[i]), (unsigned*)(V_lds + (vb) + i * 8192 + wid * 1024), 16, 0, 0); } while (0)
#define SWAIT() asm volatile("s_waitcnt vmcnt(0)" ::: "memory")
#define SBAR() __builtin_amdgcn_sched_barrier(0)
#define RESC(a) do { if (__any((a) < 1.f)) { if (hi == 0) al_l[r32] = (a); asm volatile("s_waitcnt lgkmcnt(0)" ::: "memory"); \
    _Pragma("unroll") for (int d = 0; d < 4; ++d) _Pragma("unroll") for (int r = 0; r < 16; ++r) o[d][r] *= al_l[crow(r, hi)]; } } while (0)
  f32x16 pA0, pA1, pB0, pB1; float mnA, mnB, alA, alB; i32x8 pa; constexpr int NS = NKEY / 128;
  int kp = 0, kc = SHM_K2, kn = 2 * SHM_K2, vp = 0, vc = SHM_V2, vn = 2 * SHM_V2;
  GSTAGE(0, kp, vp); GSTAGE(1, kc, vc); SWAIT(); __syncthreads();
  qkt(pA0, pA1, K_lds + kp, qf, r32, hi); partialSM(pA0, pA1, m_reg, mnA, alA);
  SBAR(); qkt(pB0, pB1, K_lds + kp + SHM_K, qf, r32, hi);
  finishSM(pA0, pA1, alA, l_reg, pa); SBAR();
  pv(o, V_lds + vp, 0, pa, r32, hi); partialSM(pB0, pB1, m_reg, mnB, alB);
  RESC(alB);
  for (int s_ = 1; s_ < NS; ++s_) {
    if (s_ + 1 < NS) GSTAGE(s_ + 1, kn, vn);
    SBAR(); qkt(pA0, pA1, K_lds + kc, qf, r32, hi);
    finishSM(pB0, pB1, alB, l_reg, pa); SBAR();
    pv(o, V_lds + vp, 1, pa, r32, hi); partialSM(pA0, pA1, m_reg, mnA, alA);
    RESC(alA);
    SBAR(); qkt(pB0, pB1, K_lds + kc + SHM_K, qf, r32, hi);
    finishSM(pA0, pA1, alA, l_reg, pa); SBAR();
    pv(o, V_lds + vc, 0, pa, r32, hi); partialSM(pB0, pB1, m_reg, mnB, alB);
    SWAIT(); __syncthreads();
    RESC(alB);
    { const int tk = kp; kp = kc; kc = kn; kn = tk; const int tv = vp; vp = vc; vc = vn; vn = tv; }
  }
  finishSM(pB0, pB1, alB, l_reg, pa); SBAR();
  pv(o, V_lds + vp, 1, pa, r32, hi);
  if (hi == 0) li_l[r32] = l_reg; asm volatile("s_waitcnt lgkmcnt(0)" ::: "memory");
  float rli[16];
#pragma unroll
  for (int r = 0; r < 16; ++r) rli[r] = __builtin_amdgcn_rcpf(li_l[crow(r, hi)]);
  bf16_t* Ow = Qb + (size_t)(wid * 32) * 1536;
#pragma unroll
  for (int r = 0; r < 16; ++r) { const int orow = crow(r, hi);
#pragma unroll
    for (int d0 = 0; d0 < 4; ++d0) Ow[(size_t)orow * 1536 + d0 * 32 + r32] = f2bf(o[d0][r] * rli[r]); }
  __syncthreads();
#undef GSTAGE
#undef SWAIT
#undef SBAR
#undef RESC
}
}
DEVI void attn_fp8(const Params& p, char* smem) {
  bf16_t* Q = (bf16_t*)(p.ws + O_RQ); const unsigned char* K8 = (const unsigned char*)(p.ws + O_K8); const unsigned char* V8 = (const unsigned char*)(p.ws + O_V8T);
  const float* rope = (const float*)(p.ws + O_ROPE);
  for (int it = blockIdx.x; it < NB * 8 * (SEQ / 256); it += gridDim.x) {
    const int bh = (it >> 8) * 8 + (it & 7), qb = (it & 255) >> 3, b = bh >> 3, h = bh & 7;
    a8::attn_item(Q + (size_t)(b * SEQ + qb * 256) * 1536 + h * 192, K8 + (size_t)bh * NKEY * 192, V8 + (size_t)bh * 128 * NKEY, rope, qb * 256, smem);
  }
}
DEVI void ph_attn(const Params& p, char* smem) { attn_fp8(p, smem); }

DEVI void ph_rows(const Params& p, char* smem) {
  const int tid = threadIdx.x, wave = tid >> 6, lane = tid & 63;
  const float* MOD = (const float*)(p.ws + O_MOD); const bf16_t* Y = (const bf16_t*)(p.ws + O_RA); const float* rssy = (const float*)(p.ws + O_RSSY);
  bf16_t* HX2 = (bf16_t*)(p.ws + O_RB);
  for (int row = blockIdx.x * NWAVE + wave; row < NTOK; row += gridDim.x * NWAVE) {
    const int b = row >> 13; const float* md = MOD + b * 6144;
    float ty = 0.f; { const float* pr = rssy + (size_t)row * 32;
#pragma unroll
      for (int j = 0; j < 32; ++j) ty += pr[j]; }
    const float ry = rsqrtf(ty * (1.f / 1024.f) + EPS);
    float x1[16]; float ss = 0.f;
#pragma unroll
    for (int i = 0; i < 4; ++i) { const int c = i * 256 + lane * 4; const float4 xv = *(const float4*)(p.x + (size_t)row * 1024 + c); const u32x2 yv = *(const u32x2*)(Y + (size_t)row * 1024 + c);
      const float4 gp = *(const float4*)(p.g_post1 + c), gt = *(const float4*)(md + 2048 + c);
      x1[i * 4 + 0] = xv.x + gt.x * (lo2f(yv[0]) * ry * gp.x); x1[i * 4 + 1] = xv.y + gt.y * (hi2f(yv[0]) * ry * gp.y);
      x1[i * 4 + 2] = xv.z + gt.z * (lo2f(yv[1]) * ry * gp.z); x1[i * 4 + 3] = xv.w + gt.w * (hi2f(yv[1]) * ry * gp.w);
#pragma unroll
      for (int j = 0; j < 4; ++j) ss += x1[i * 4 + j] * x1[i * 4 + j];
      *(float4*)(p.out + (size_t)row * 1024 + c) = make_float4(x1[i * 4], x1[i * 4 + 1], x1[i * 4 + 2], x1[i * 4 + 3]); }
    ss = wave_sum(ss); const float r2 = rsqrtf(ss * (1.f / 1024.f) + EPS);
#pragma unroll
    for (int i = 0; i < 4; ++i) { const int c = i * 256 + lane * 4; const float4 g2 = *(const float4*)(p.g_pre2 + c), sc = *(const float4*)(md + 4096 + c), sh = *(const float4*)(md + 3072 + c);
      st4bf(HX2 + (size_t)row * 1024 + c, x1[i * 4] * r2 * g2.x * (1.f + sc.x) + sh.x, x1[i * 4 + 1] * r2 * g2.y * (1.f + sc.y) + sh.y,
            x1[i * 4 + 2] * r2 * g2.z * (1.f + sc.z) + sh.z, x1[i * 4 + 3] * r2 * g2.w * (1.f + sc.w) + sh.w); }
  }
  convert_table_fp6(p.u_exp, (unsigned char*)(p.ws + O_RC), (float*)(p.ws + O_RC + (size_t)16384 * 1024));
}

namespace tk {
DEVI int f2sort(float f) { const int i = __float_as_int(f); return i ^ ((i >> 31) & 0x7fffffff); }
DEVI float sort2f(int s) { return __int_as_float(s ^ ((s >> 31) & 0x7fffffff)); }
DEVI void ce_desc(int& a, int& b) { const int hi = max(a, b), lo = min(a, b); a = hi; b = lo; }
DEVI void sort16_desc(int* a) {
#pragma unroll
  for (int lk = 1; lk <= 4; ++lk)
#pragma unroll
    for (int lj = lk - 1; lj >= 0; --lj)
#pragma unroll
      for (int i = 0; i < 16; ++i) { const int j = 1 << lj, k = 1 << lk, l = i ^ j;
        if (l > i) { const int hi = max(a[i], a[l]), lo = min(a[i], a[l]); if ((i & k) == 0) { a[i] = hi; a[l] = lo; } else { a[i] = lo; a[l] = hi; } } }
}
DEVI void bitonic_merge16_desc(int* a) {
#pragma unroll
  for (int lj = 3; lj >= 0; --lj)
#pragma unroll
    for (int i = 0; i < 16; ++i) { const int l = i ^ (1 << lj); if (l > i) ce_desc(a[i], a[l]); }
}
DEVI void merge_top16(int* a, const int* b) {
#pragma unroll
  for (int i = 0; i < 16; ++i) a[i] = max(a[i], b[15 - i]);
  bitonic_merge16_desc(a);
}
DEVI void half_top16(const bf16_t* __restrict__ qrow, const char* Kl, int r32, int hi, int* out) {
  bf16x8 qf[8];
#pragma unroll
  for (int d0 = 0; d0 < 8; ++d0) qf[d0] = *reinterpret_cast<const bf16x8*>(qrow + d0 * 16 + hi * 8);
  int a[64]; const int hi4 = 4 * hi;
#pragma unroll
  for (int kt = 0; kt < 4; ++kt) { f32x16 acc = {};
    const int key = kt * 32 + r32;
#pragma unroll
    for (int d0 = 0; d0 < 8; ++d0) { const bf16x8 kf = *reinterpret_cast<const bf16x8*>(Kl + key * 256 + (((d0 * 2 + hi) ^ (key & 15)) << 4));
      acc = __builtin_amdgcn_mfma_f32_32x32x16_bf16(kf, qf[d0], acc, 0, 0, 0); }
#pragma unroll
    for (int r = 0; r < 16; ++r) { const int kc = kt * 32 + (r & 3) + 8 * (r >> 2); a[kt * 16 + r] = ((f2sort(acc[r]) & ~127) | (127 - kc)) - hi4; } }
  sort16_desc(a); sort16_desc(a + 16); sort16_desc(a + 32); sort16_desc(a + 48);
  merge_top16(a, a + 16); merge_top16(a + 32, a + 48); merge_top16(a, a + 32);
  int L[16], H[16];
#pragma unroll
  for (int i = 0; i < 16; ++i) { auto rr = __builtin_amdgcn_permlane32_swap((unsigned)a[i], (unsigned)a[i], false, false); L[i] = (int)rr[0]; H[i] = (int)rr[1]; }
  merge_top16(L, H);
#pragma unroll
  for (int i = 0; i < 16; ++i) out[i] = L[i];
}
}
DEVI void gather_token_fp6(const Params& p, int t, const int* idx, const float* gw, float* xs, const int* sig);
DEVI void fp6_sigma(int* sig);
DEVI void topk_fast(const Params& p, char* smem) {
  const int tid = threadIdx.x, wave = __builtin_amdgcn_readfirstlane(tid >> 6), lane = tid & 63, r32 = lane & 31, hi = lane >> 5;
  const bf16_t* QP = (const bf16_t*)(p.ws + O_RKV);
  char* K1l = smem; char* K2l = smem + 32768; int* tab = (int*)(smem + 65536) + wave * (32 * 33);
  int* idxl = (int*)(smem + 65536 + 8 * 32 * 33 * 4) + wave * 512; float* gwl = (float*)(smem + 65536 + 8 * 32 * 33 * 4 + 8 * 2048) + wave * 512;
  int* sigl = (int*)(smem + 65536 + 8 * 32 * 33 * 4 + 16 * 2048) + wave * 32;
  fp6_sigma(sigl);
  __syncthreads();
  { const bf16_t* K1 = (const bf16_t*)(p.ws + O_K1);
    for (int id = tid; id < 4096; id += NTHR) { const int key = id >> 4, c = id & 15; const u32x4 v = *(const u32x4*)(K1 + (size_t)key * 128 + c * 8);
      *(u32x4*)(smem + key * 256 + ((c ^ (key & 15)) << 4)) = v; } }
  __syncthreads();
  for (int item = blockIdx.x; item < NTOK * 8 / 256; item += gridDim.x) {
    const int row = item * 256 + wave * 32 + r32;
    const bf16_t* qrow = QP + (size_t)row * 256;
    int t1[16], t2[16];
    tk::half_top16(qrow, K1l, r32, hi, t1);
    __builtin_amdgcn_sched_barrier(0);
    tk::half_top16(qrow + 128, K2l, r32, hi, t2);
    __builtin_amdgcn_sched_barrier(0);
    float v1[16], v2[16];
#pragma unroll
    for (int i = 0; i < 16; ++i) { v1[i] = tk::sort2f(t1[i] & ~127); v2[i] = tk::sort2f(t2[i] & ~127); }
    if (hi == 0) {
#pragma unroll
      for (int i = 0; i < 16; ++i) { tab[r32 * 33 + i] = 127 - (t1[i] & 127); tab[r32 * 33 + 16 + i] = 127 - (t2[i] & 127); } }
#define CAND(i, j) ((tk::f2sort(v1[i] + v2[j]) & ~255) | (255 - ((i) * 16 + (j))))
    int g0[16], g1[16], g2[16];
#pragma unroll
    for (int j = 0; j < 16; ++j) g0[j] = CAND(0, j);
#pragma unroll
    for (int j = 0; j < 8; ++j) g1[j] = CAND(1, j);
#pragma unroll
    for (int j = 0; j < 5; ++j) g1[8 + j] = CAND(2, j);
#pragma unroll
    for (int j = 0; j < 3; ++j) g1[13 + j] = CAND(4, j);
#pragma unroll
    for (int j = 0; j < 4; ++j) g2[j] = CAND(3, j);
    g2[4] = CAND(5, 0); g2[5] = CAND(5, 1); g2[6] = CAND(6, 0); g2[7] = CAND(6, 1); g2[8] = CAND(7, 0); g2[9] = CAND(7, 1);
    g2[10] = CAND(8, 0); g2[11] = CAND(9, 0); g2[12] = CAND(10, 0); g2[13] = CAND(11, 0); g2[14] = CAND(12, 0); g2[15] = CAND(13, 0);
    tk::sort16_desc(g1); tk::sort16_desc(g2);
    tk::merge_top16(g0, g1); tk::merge_top16(g0, g2);
    { int x = CAND(14, 0);
#pragma unroll
      for (int i = 0; i < 16; ++i) { const int h = max(g0[i], x); x = min(g0[i], x); g0[i] = h; }
      x = CAND(15, 0);
#pragma unroll
      for (int i = 0; i < 16; ++i) { const int h = max(g0[i], x); x = min(g0[i], x); g0[i] = h; } }
#undef CAND
    asm volatile("s_waitcnt lgkmcnt(0)" ::: "memory");
    if (hi == 0) {
      int ex[16];
#pragma unroll
      for (int k = 0; k < 16; ++k) { const int pos = 255 - (g0[k] & 255); ex[k] = tab[r32 * 33 + (pos >> 4)] * 128 + tab[r32 * 33 + 16 + (pos & 15)]; }
      int* dst = idxl + r32 * 16;
#pragma unroll
      for (int q = 0; q < 4; ++q) *(int4*)(dst + q * 4) = make_int4(ex[q * 4], ex[q * 4 + 1], ex[q * 4 + 2], ex[q * 4 + 3]);
    } else {
      float e[16]; const float vmax = tk::sort2f(g0[0] & ~255); float sum = 0.f;
#pragma unroll
      for (int k = 0; k < 16; ++k) { e[k] = __expf(tk::sort2f(g0[k] & ~255) - vmax); sum += e[k]; }
      const float inv = 1.f / sum; float* dst = gwl + r32 * 16;
#pragma unroll
      for (int q = 0; q < 4; ++q) *(float4*)(dst + q * 4) = make_float4(e[q * 4] * inv, e[q * 4 + 1] * inv, e[q * 4 + 2] * inv, e[q * 4 + 3] * inv);
    }
    asm volatile("s_waitcnt lgkmcnt(0)" ::: "memory"); __builtin_amdgcn_sched_barrier(0);
#pragma unroll 1
    for (int tl = 0; tl < 4; ++tl) gather_token_fp6(p, item * 32 + wave * 4 + tl, idxl + tl * 128, gwl + tl * 128, (float*)tab, sigl);
    asm volatile("s_waitcnt lgkmcnt(0)" ::: "memory"); __builtin_amdgcn_sched_barrier(0);
  }
}
DEVI void ph_topk(const Params& p, char* smem) { topk_fast(p, smem); }

DEVI void fp6_sigma(int* sig) {
  f32x16 ra, rb;
#pragma unroll
  for (int i = 0; i < 16; ++i) { ra[i] = i < 8 ? i * 0.125f : 1.f + (i - 8) * 0.125f; rb[i] = i < 8 ? 2.f + i * 0.25f : 4.f + (i - 8) * 0.5f; }
  const u32x6 w = __builtin_amdgcn_cvt_scalef32_2xpk16_fp6_f32(ra, rb, 1.0f);
  const f32x32 d = __builtin_amdgcn_cvt_scalef32_pk32_f32_fp6(w, 1.0f);
  if ((threadIdx.x & 63) == 0) {
#pragma unroll
    for (int i = 0; i < 32; ++i) { const float v = d[i]; sig[i] = v < 1.f ? (int)(v * 8.f + 0.5f) : v < 2.f ? 8 + (int)((v - 1.f) * 8.f + 0.5f) : v < 4.f ? 16 + (int)((v - 2.f) * 4.f + 0.5f) : 24 + (int)((v - 4.f) * 2.f + 0.5f); } }
}
constexpr int G6 = 4;
DEVI void gather_token_fp6(const Params& p, int t, const int* idx, const float* gw, float* xs, const int* sig) {
  int lane = threadIdx.x & 63; asm volatile("" : "+v"(lane));
  const int h = lane >> 5, g = lane & 31;
  const bf16_t* HX2 = (const bf16_t*)(p.ws + O_RB);
  const unsigned char* UT = (const unsigned char*)(p.ws + O_RC); const float* SU = (const float*)(p.ws + O_RC + (size_t)16384 * 1024);
  const unsigned char* VT = (const unsigned char*)(p.ws + O_RA); const float* SV = (const float*)(p.ws + O_RA + (size_t)16384 * 1024);
  const float* MOD = (const float*)(p.ws + O_MOD);
  if (h == 0) { float xf[32];
#pragma unroll
    for (int q = 0; q < 4; ++q) unpack8(*(const u32x4*)(HX2 + (size_t)t * 1024 + g * 32 + q * 8), xf + q * 8);
#pragma unroll
    for (int j = 0; j < 32; ++j) xs[j * 32 + g] = xf[j]; }
  asm volatile("s_waitcnt lgkmcnt(0)" ::: "memory"); __builtin_amdgcn_sched_barrier(0);
  float xp[32], acc[32];
#pragma unroll
  for (int i = 0; i < 32; ++i) { xp[i] = xs[sig[i] * 32 + g]; acc[i] = 0.f; }
#pragma unroll 1
  for (int half = 0; half < 2; ++half) {
    const int my_i = idx[half * 64 + lane]; const float my_g = gw[half * 64 + lane];
    const float my_su = SU[my_i], my_sv = SV[my_i];
#pragma unroll 1
    for (int e0 = 0; e0 < 64; e0 += 2 * G6) {
      u32x6 uq[G6], vq[G6]; float cs[G6];
#pragma unroll
      for (int j = 0; j < G6; ++j) { const int ia = __builtin_amdgcn_readlane(my_i, e0 + 2 * j), ib = __builtin_amdgcn_readlane(my_i, e0 + 2 * j + 1); const int id = h ? ib : ia;
        const unsigned char* up = UT + (size_t)id * 768 + g * 24; const unsigned char* vp = VT + (size_t)id * 768 + g * 24;
        const u32x4 u0 = *(const u32x4_u*)up; const u32x2 u1 = *(const u32x2_u*)(up + 16); const u32x4 v0 = *(const u32x4_u*)vp; const u32x2 v1 = *(const u32x2_u*)(vp + 16);
        uq[j] = (u32x6){u0[0], u0[1], u0[2], u0[3], u1[0], u1[1]}; vq[j] = (u32x6){v0[0], v0[1], v0[2], v0[3], v1[0], v1[1]}; }
#pragma unroll
      for (int j = 0; j < G6; ++j) { const f32x32 uf = __builtin_amdgcn_cvt_scalef32_pk32_f32_fp6(uq[j], 1.0f); float d = 0.f;
#pragma unroll
        for (int k = 0; k < 32; ++k) d += xp[k] * uf[k];
        cs[j] = d; __builtin_amdgcn_sched_barrier(0); }
#pragma unroll
      for (int j = 0; j < G6; ++j) { float v = cs[j];
        v += __builtin_bit_cast(float, __builtin_amdgcn_update_dpp(0, __builtin_bit_cast(int, v), 0xB1, 0xf, 0xf, true));
        v += __builtin_bit_cast(float, __builtin_amdgcn_update_dpp(0, __builtin_bit_cast(int, v), 0x4E, 0xf, 0xf, true));
        v += __builtin_bit_cast(float, __builtin_amdgcn_update_dpp(0, __builtin_bit_cast(int, v), 0x141, 0xf, 0xf, true));
        v += __builtin_bit_cast(float, __builtin_amdgcn_update_dpp(0, __builtin_bit_cast(int, v), 0x140, 0xf, 0xf, true));
        const int iv = __builtin_bit_cast(int, v);
        const float s0 = __builtin_bit_cast(float, __builtin_amdgcn_readlane(iv, 0)) + __builtin_bit_cast(float, __builtin_amdgcn_readlane(iv, 16));
        const float s1 = __builtin_bit_cast(float, __builtin_amdgcn_readlane(iv, 32)) + __builtin_bit_cast(float, __builtin_amdgcn_readlane(iv, 48));
        const int ea = e0 + 2 * j, eb = ea + 1;
        const float ga = __builtin_bit_cast(float, __builtin_amdgcn_readlane(__builtin_bit_cast(int, my_g), ea)), gb = __builtin_bit_cast(float, __builtin_amdgcn_readlane(__builtin_bit_cast(int, my_g), eb));
        const float sua = __builtin_bit_cast(float, __builtin_amdgcn_readlane(__builtin_bit_cast(int, my_su), ea)), sub = __builtin_bit_cast(float, __builtin_amdgcn_readlane(__builtin_bit_cast(int, my_su), eb));
        const float sva = __builtin_bit_cast(float, __builtin_amdgcn_readlane(__builtin_bit_cast(int, my_sv), ea)), svb = __builtin_bit_cast(float, __builtin_amdgcn_readlane(__builtin_bit_cast(int, my_sv), eb));
        const float ca = ga * gelu_t(s0 * sua) * sva, cb = gb * gelu_t(s1 * sub) * svb;
        cs[j] = h ? cb : ca; }
#pragma unroll
      for (int j = 0; j < G6; ++j) { const f32x32 vf = __builtin_amdgcn_cvt_scalef32_pk32_f32_fp6(vq[j], 1.0f);
#pragma unroll
        for (int k = 0; k < 32; ++k) acc[k] += cs[j] * vf[k];
        __builtin_amdgcn_sched_barrier(0); }
    }
  }
#pragma unroll
  for (int i = 0; i < 32; ++i) { auto rr = __builtin_amdgcn_permlane32_swap(__float_as_uint(acc[i]), __float_as_uint(acc[i]), false, false); acc[i] = __uint_as_float(rr[0]) + __uint_as_float(rr[1]); }
  if (h == 0) {
#pragma unroll
    for (int i = 0; i < 32; ++i) xs[sig[i] * 32 + g] = acc[i]; }
  asm volatile("s_waitcnt lgkmcnt(0)" ::: "memory"); __builtin_amdgcn_sched_barrier(0);
  float o[16]; float ss = 0.f;
#pragma unroll
  for (int j = 0; j < 16; ++j) { o[j] = xs[(16 * h + j) * 32 + g]; ss += o[j] * o[j]; }
  ss = wave_sum(ss); const float rstd = rsqrtf(ss * (1.f / 1024.f) + EPS);
  const int b = t >> 13, c0 = g * 32 + h * 16; const float* gt2 = MOD + b * 6144 + 5120 + c0;
  float* op = p.out + (size_t)t * 1024 + c0;
#pragma unroll
  for (int q4 = 0; q4 < 4; ++q4) { float4 xv = *(const float4*)(op + q4 * 4); const float4 gt = *(const float4*)(gt2 + q4 * 4), gp = *(const float4*)(p.g_post2 + c0 + q4 * 4);
    xv.x += gt.x * (o[q4 * 4 + 0] * rstd * gp.x); xv.y += gt.y * (o[q4 * 4 + 1] * rstd * gp.y);
    xv.z += gt.z * (o[q4 * 4 + 2] * rstd * gp.z); xv.w += gt.w * (o[q4 * 4 + 3] * rstd * gp.w);
    *(float4*)(op + q4 * 4) = xv; }
  asm volatile("s_waitcnt lgkmcnt(0)" ::: "memory"); __builtin_amdgcn_sched_barrier(0);
}

#define XB_TMO      128
#define XB_XCNT(j)  (256  + 64 * (j))
#define XB_XSUB(j)  (1280 + 64 * (j))
#define XB_XGEN(j)  (2304 + 64 * (j))
#define XB_TOP      3328
#define XB_TOPGEN   3392
#define XCD_BAR_WORDS 3456
#define XB_SPIN_CAP (1u << 18)
#define LAS __attribute__((address_space(3)))
DEVI unsigned xb_ld(unsigned* p)              { return __hip_atomic_load(p, __ATOMIC_RELAXED, __HIP_MEMORY_SCOPE_AGENT); }
DEVI unsigned xb_add(unsigned* p, unsigned v) { return __hip_atomic_fetch_add(p, v, __ATOMIC_RELAXED, __HIP_MEMORY_SCOPE_AGENT); }
DEVI unsigned xb_xcc_id() { return (unsigned)__builtin_amdgcn_s_getreg((3 << 11) | 20) & 0xFu; }
#define XB_SPIN(cond, bar) do { unsigned _sp = 0; while (cond) { __builtin_amdgcn_s_sleep(1); \
    if ((++_sp & 255u) == 0u) { if (xb_ld(&(bar)[XB_TMO])) break; if (_sp > XB_SPIN_CAP) { atomicAdd(&(bar)[XB_TMO], 1u); break; } } } } while (0)
struct XcdBarrier { unsigned* bar; unsigned x; volatile LAS unsigned* st; };
DEVI XcdBarrier xcd_barrier_post(unsigned* bar, volatile LAS unsigned* st) {
  XcdBarrier b; b.bar = bar; b.x = xb_xcc_id(); b.st = st;
  if (threadIdx.x == 0) (void)xb_add(&bar[XB_XCNT(b.x)], 1u);
  return b;
}
DEVI void xcd_barrier_complete(unsigned* bar, unsigned x, unsigned& nloc, unsigned& nx) {
  const unsigned G = gridDim.x * gridDim.y * gridDim.z;
  unsigned sum, cnt, mine, sp = 0u;
  for (;;) {
    sum = 0u; cnt = 0u; mine = 0u;
#pragma unroll
    for (unsigned j = 0; j < 16; ++j) { const unsigned c = xb_ld(&bar[XB_XCNT(j)]); sum += c; cnt += (c > 0u) ? 1u : 0u; mine = (j == x) ? c : mine; }
    if (sum == G) break;
    __builtin_amdgcn_s_sleep(1);
    if ((++sp & 255u) == 0u) { if (xb_ld(&bar[XB_TMO])) break; if (sp > XB_SPIN_CAP) { atomicAdd(&bar[XB_TMO], 1u); break; } }
  }
  nloc = mine > 0u ? mine : 1u; nx = cnt > 0u ? cnt : 1u;
}
DEVI void xcd_barrier(const XcdBarrier& b) {
  asm volatile("s_waitcnt vmcnt(0)" ::: "memory");
  __syncthreads();
  if (threadIdx.x == 0) {
    unsigned* bar = b.bar;
    __builtin_amdgcn_s_waitcnt(0);
    unsigned nloc = b.st[0], nx = b.st[1];
    if (nloc == 0u) { xcd_barrier_complete(bar, b.x, nloc, nx); b.st[0] = nloc; b.st[1] = nx; }
    const unsigned old = xb_add(&bar[XB_XSUB(b.x)], 1u);
    const unsigned gen = old / nloc;
    if (old + 1u == (gen + 1u) * nloc) {
      __builtin_amdgcn_fence(__ATOMIC_RELEASE, "agent");
      asm volatile("s_waitcnt vmcnt(0)" ::: "memory");
      const unsigned og = xb_add(&bar[XB_TOP], 1u);
      const unsigned tg = og / nx;
      if (og + 1u == (tg + 1u) * nx) xb_add(&bar[XB_TOPGEN], 1u);
      else XB_SPIN(xb_ld(&bar[XB_TOPGEN]) == tg, bar);
      __builtin_amdgcn_fence(__ATOMIC_ACQUIRE, "agent");
      xb_add(&bar[XB_XGEN(b.x)], 1u);
      asm volatile("s_waitcnt vmcnt(0)" ::: "memory");
    } else {
      XB_SPIN(xb_ld(&bar[XB_XGEN(b.x)]) == gen, bar);
      __builtin_amdgcn_fence(__ATOMIC_ACQUIRE, "agent");
      asm volatile("s_waitcnt vmcnt(0)" ::: "memory");
    }
  }
  __syncthreads();
}

constexpr int NPHASE = 11;
template <int PH> DEVI void run_phase(const Params& p, char* smem) {
  if constexpr (PH == 0) ph_prep(p, smem);
  else if constexpr (PH == 1) ph_hx(p, smem);
  else if constexpr (PH == 2) ph_inproj(p, smem);
  else if constexpr (PH == 3) ph_mid(p, smem);
  else if constexpr (PH == 4) ph_attn(p, smem);
  else if constexpr (PH == 5) ph_gates(p, smem);
  else if constexpr (PH == 6) ph_merge(p, smem);
  else if constexpr (PH == 7) ph_wo(p, smem);
  else if constexpr (PH == 8) ph_rows(p, smem);
  else if constexpr (PH == 9) ph_wpq(p, smem);
  else if constexpr (PH == 10) ph_topk(p, smem);
}

#ifndef PROBE_PH
#define PROBE_PH -1
#endif
#define RUNPH(N) do { if (PROBE_PH == N) t0 = __builtin_amdgcn_s_memrealtime(); run_phase<N>(p, smem); if (N < NPHASE - 1) xcd_barrier(xb); \
    if (PROBE_PH == N) t1 = __builtin_amdgcn_s_memrealtime(); } while (0)
__global__ __launch_bounds__(NTHR) void k_mega(Params p) {
  extern __shared__ __attribute__((aligned(16))) char smem[];
  cg::grid_group grid = cg::this_grid();
  unsigned long long t0 = 0, t1 = 0;
  unsigned* bar = (unsigned*)(p.ws + O_BAR);
  volatile LAS unsigned* xst = (volatile LAS unsigned*)(smem + LDS_BYTES - 16);
  if (threadIdx.x == 0) { xst[0] = 0u; xst[1] = 0u; }
  __syncthreads();
  const XcdBarrier xb = xcd_barrier_post(bar, xst);
  if (p.out == nullptr) grid.sync();
  RUNPH(0);
  RUNPH(1); RUNPH(2); RUNPH(3); RUNPH(4); RUNPH(5); RUNPH(6); RUNPH(7); RUNPH(8); RUNPH(9); RUNPH(10);
  if (PROBE_PH >= 0) { __syncthreads(); if (blockIdx.x == 0 && threadIdx.x == 0) p.out[0] += exp2f(rintf(log2f((float)(t1 - t0) * 1e-3f) * 5.f) * 0.2f); }
}

extern "C" void kernel_launch(void* const* d_in, const int* in_sizes, int n_in, void* d_out, int out_size, void* d_ws, size_t ws_size, hipStream_t stream) {
  static int grid = 0;
  if (grid == 0) {
    if (n_in != 26 || out_size != NTOK * DM || ws_size < O_END) { fprintf(stderr, "kernel_launch: unexpected shapes n_in %d out %d ws %zu (need %zu)\n", n_in, out_size, ws_size, (size_t)O_END); grid = -1; return; }
    (void)hipFuncSetAttribute((const void*)k_mega, hipFuncAttributeMaxDynamicSharedMemorySize, LDS_BYTES);
    int dev = 0, cus = 0, per_cu = 0; (void)hipGetDevice(&dev); (void)hipDeviceGetAttribute(&cus, hipDeviceAttributeMultiprocessorCount, dev);
    (void)hipOccupancyMaxActiveBlocksPerMultiprocessor(&per_cu, (const void*)k_mega, NTHR, LDS_BYTES);
    if (per_cu < 1) { fprintf(stderr, "kernel_launch: occupancy query says %d blocks per CU\n", per_cu); grid = -1; return; }
    grid = cus;
  }
  if (grid < 0) return;
  Params p{};
  const float** pp = (const float**)&p;
  for (int i = 0; i < 26; ++i) pp[i] = (const float*)d_in[i];
  p.out = (float*)d_out; p.ws = (char*)d_ws;
  (void)hipMemsetAsync((char*)d_ws + O_BAR, 0, (size_t)XCD_BAR_WORDS * 4, stream);
  void* args[] = {&p};
  hipError_t e = hipLaunchCooperativeKernel((const void*)k_mega, dim3(grid), dim3(NTHR), args, LDS_BYTES, stream);
  if (e != hipSuccess) fprintf(stderr, "cooperative launch failed: %s (grid %d)\n", hipGetErrorString(e), grid);
}
```

```cpp
#include <hip/hip_runtime.h>
#include <hip/hip_cooperative_groups.h>
#include <cstdint>
#include <cstdio>
namespace cg = cooperative_groups;

#define DEVI __device__ __forceinline__
typedef unsigned short bf16_t;
using bf16x8 = __attribute__((ext_vector_type(8))) short;
using bf16x4 = __attribute__((ext_vector_type(4))) short;
using f32x4  = __attribute__((ext_vector_type(4))) float;
using f32x16 = __attribute__((ext_vector_type(16))) float;
using u32x4  = __attribute__((ext_vector_type(4))) unsigned;
using u32x2  = __attribute__((ext_vector_type(2))) unsigned;

constexpr int DM = 1024, NB = 2, SEQ = 8192, NTOK = NB * SEQ, CTXL = 256, NCTX = NB * CTXL, NROW = NTOK + NCTX, NKEY = SEQ + CTXL;
constexpr int INW = 4544, INWP = 4608;
constexpr int NPRE = 2560;
constexpr float EPS = 1e-6f;
constexpr int NTHR = 512, NWAVE = 8;
constexpr int LDS_BYTES = 147456;

constexpr size_t al256(size_t x) { return (x + 255) / 256 * 256; }
constexpr size_t O_WIN   = 0;
constexpr size_t O_WUQ   = O_WIN  + al256((size_t)INWP * 1024 * 2);
constexpr size_t O_WUKV  = O_WUQ  + al256((size_t)1536 * 256 * 2);
constexpr size_t O_WPA   = O_WUKV + al256((size_t)2048 * 128 * 2);
constexpr size_t O_WPB   = O_WPA  + al256((size_t)1024 * 1024 * 2);
constexpr size_t O_WO    = O_WPB  + al256((size_t)1024 * 1024 * 2);
constexpr size_t O_WPQ   = O_WO   + al256((size_t)1024 * 1024 * 2);
constexpr size_t O_WS    = O_WPQ  + al256((size_t)2048 * 1024 * 2);
constexpr size_t O_K1    = O_WS   + al256((size_t)8 * 128 * 128 * 2);
constexpr size_t O_K2    = O_K1   + al256((size_t)128 * 128 * 2);
constexpr size_t O_MOD   = O_K2   + al256((size_t)128 * 128 * 2);
constexpr size_t O_ROPE  = O_MOD  + al256((size_t)3 * 6144 * 4);
constexpr size_t O_BAR   = O_ROPE + al256((size_t)128 * 16 * 2 * 4);
constexpr size_t O_RSSV  = O_BAR + al256((size_t)3456 * 4);
constexpr size_t O_RSSQ  = O_RSSV + (size_t)NTOK * 32 * 4;
constexpr size_t O_RSSKV = O_RSSQ + (size_t)NTOK * 8 * 4;
constexpr size_t O_RSSY  = O_RSSKV + (size_t)NROW * 4 * 4;
constexpr size_t O_RSSEND = O_RSSY + (size_t)NTOK * 32 * 4;
constexpr size_t O_RA    = al256(O_RSSEND);
constexpr size_t O_RB    = O_RA  + al256((size_t)NROW * 1024 * 2);
constexpr size_t O_RC    = O_RB  + al256((size_t)NTOK * 1024 * 2);
constexpr size_t O_CQ    = O_RC  + al256((size_t)NTOK * 1024 * 2);
constexpr size_t O_CKV   = O_CQ  + al256((size_t)NTOK * 256 * 2);
constexpr size_t O_KR    = O_CKV + al256((size_t)NROW * 128 * 2);
constexpr size_t O_RQ    = O_KR  + al256((size_t)NROW * 64 * 2);
constexpr size_t O_RKV   = O_RQ  + al256((size_t)NTOK * 1536 * 2);
constexpr size_t O_END   = O_RKV + al256((size_t)NROW * 2048 * 2);
static_assert(O_END <= (size_t)258 * 1024 * 1024, "workspace too large");

struct Params {
  const float *x, *c, *ctx, *c_ctx, *w_mod, *b_mod, *g_pre1, *g_post1, *g_pre2, *g_post2, *w_in, *g_q, *g_kv, *w_uq, *w_ukv, *g_sgu, *w_s, *b_s,
      *w_pa, *w_pb, *w_o, *w_pq, *k1, *k2, *u_exp, *v_exp;
  float* out; char* ws;
};

DEVI float bf2f(unsigned short h) { return __uint_as_float(((unsigned)h) << 16); }
DEVI unsigned short f2bf(float f) { unsigned u = __float_as_uint(f); u += 0x7fffu + ((u >> 16) & 1u); return (unsigned short)(u >> 16); }
typedef __bf16 bf16x2_t __attribute__((ext_vector_type(2)));
typedef float f32x2v_t __attribute__((ext_vector_type(2)));
DEVI unsigned pack2(float a, float b) { const f32x2v_t v = {a, b}; return __builtin_bit_cast(unsigned, __builtin_convertvector(v, bf16x2_t)); }
DEVI float lo2f(unsigned w) { return __uint_as_float(w << 16); }
DEVI float hi2f(unsigned w) { return __uint_as_float(w & 0xffff0000u); }
DEVI void unpack8(const u32x4& w, float* f) {
  f[0] = lo2f(w[0]); f[1] = hi2f(w[0]); f[2] = lo2f(w[1]); f[3] = hi2f(w[1]); f[4] = lo2f(w[2]); f[5] = hi2f(w[2]); f[6] = lo2f(w[3]); f[7] = hi2f(w[3]);
}
DEVI float gelu_t(float x) { const float z = 0.7978845608028654f * (x + 0.044715f * x * x * x); return x * __builtin_amdgcn_rcpf(1.f + __expf(-2.f * z)); }
DEVI float sigmoidf_(float x) { return __builtin_amdgcn_rcpf(1.f + __expf(-x)); }
DEVI float wave_sum(float v) { for (int o = 32; o > 0; o >>= 1) v += __shfl_xor(v, o); return v; }
DEVI float wave_max(float v) { for (int o = 32; o > 0; o >>= 1) v = fmaxf(v, __shfl_xor(v, o)); return v; }
DEVI void keyrow2(int row, int& b, int& key) { if (row < NTOK) { b = row >> 13; key = row & 8191; } else { const int c = row - NTOK; b = c >> 8; key = SEQ + (c & 255); } }
DEVI int keyrow(int row) { if (row < NTOK) return (row >> 13) * NKEY + (row & 8191); int c = row - NTOK; return (c >> 8) * NKEY + SEQ + (c & 255); }

__device__ const float ROPE_FREQ[16] = {1.0f, 0.5623413324356079f, 0.3162277638912201f, 0.17782793939113617f, 0.10000000149011612f, 0.05623413249850273f, 0.03162277489900589f, 0.017782794311642647f, 0.009999999776482582f, 0.005623413249850273f, 0.003162277629598975f, 0.0017782794311642647f, 0.0010000000474974513f, 0.000562341301701963f, 0.0003162277571391314f, 0.00017782794020604342f};
DEVI void sincos_small(double a, double& cs, double& sn) {
  const double k = rint(a * 0.15915494309189535); const double r = fma(-k, 6.283185307179586, a) - k * 2.4492935982947064e-16;
  const double r2 = r * r; double s = 0.0, c = 0.0;
#pragma unroll
  for (int n = 12; n >= 1; --n) { s = (1.0 - s * r2 / (double)((2 * n) * (2 * n + 1))); c = (1.0 - c * r2 / (double)((2 * n - 1) * (2 * n))); }
  sn = r * s; cs = c;
}

DEVI void transpose_job(const float* __restrict__ src, int K, int N, bf16_t* __restrict__ dst, const float* __restrict__ gk, bool isWin, int ntiles, char* smem) {
  const int tid = threadIdx.x; bf16_t* tl = (bf16_t*)smem; const int kt = K / 64;
  for (int idx = blockIdx.x; idx < ntiles; idx += gridDim.x) {
    const int ktile = idx % kt, ntile = idx / kt, k0 = ktile * 64, n0d = ntile * 64;
    int n0s = n0d; bool zero = false;
    if (isWin) { if (n0d == 2496) zero = true; else if (n0d >= 2560) n0s = n0d - 64; }
    { const int kk = tid >> 3, nn8 = (tid & 7) * 8; f32x4 va = {0.f, 0.f, 0.f, 0.f}, vb = va;
      if (!zero) { const float* s = src + (size_t)(k0 + kk) * N + n0s + nn8; const float4 a = *(const float4*)s, b = *(const float4*)(s + 4);
        const float sc = gk ? gk[k0 + kk] : 1.f; va = (f32x4){a.x, a.y, a.z, a.w} * sc; vb = (f32x4){b.x, b.y, b.z, b.w} * sc; }
      bf16_t* tp = tl + nn8 * 72 + kk;
      tp[0] = f2bf(va[0]); tp[72] = f2bf(va[1]); tp[144] = f2bf(va[2]); tp[216] = f2bf(va[3]); tp[288] = f2bf(vb[0]); tp[360] = f2bf(vb[1]); tp[432] = f2bf(vb[2]); tp[504] = f2bf(vb[3]); }
    __syncthreads();
    { const int nn = tid >> 3, kk8 = (tid & 7) * 8;
      const u32x4 o = *(const u32x4*)(tl + nn * 72 + kk8);
      *(u32x4*)(dst + (size_t)(n0d + nn) * K + k0 + kk8) = o; }
    __syncthreads();
  }
}

DEVI void ph_prep(const Params& p, char* smem) {
  const int tid = threadIdx.x, bid = blockIdx.x, nb = gridDim.x;
  char* ws = p.ws;
  if (bid == 0) { float* rope = (float*)(ws + O_ROPE);
    for (int i = tid; i < 128 * 16; i += NTHR) { const int pos = i >> 4, f = i & 15; const float ang = (float)pos * ROPE_FREQ[f];
      double cs, sn; sincos_small((double)ang, cs, sn); rope[i * 2] = (float)cs; rope[i * 2 + 1] = (float)sn; } }
  { float* red = (float*)smem; float* MOD = (float*)(ws + O_MOD);
    for (int it = bid; it < 256; it += nb) {
      const int cgp = tid % 6, kg = tid / 6;
      f32x4 a0 = {0.f, 0.f, 0.f, 0.f}, a1 = a0, a2 = a0;
      if (tid < 510) {
        for (int k = kg; k < 1024; k += 85) {
          const float4 w4 = *(const float4*)(p.w_mod + (size_t)k * 6144 + it * 24 + cgp * 4);
          const f32x4 w = {w4.x, w4.y, w4.z, w4.w};
          const float c0 = p.c[k], c1 = p.c[1024 + k], c2 = p.c_ctx[k];
          a0 += w * (c0 / (1.f + __expf(-c0))); a1 += w * (c1 / (1.f + __expf(-c1))); a2 += w * (c2 / (1.f + __expf(-c2)));
        }
        float* rp = red + kg * 72 + cgp * 4;
        rp[0] = a0[0]; rp[1] = a0[1]; rp[2] = a0[2]; rp[3] = a0[3];
        rp[24] = a1[0]; rp[25] = a1[1]; rp[26] = a1[2]; rp[27] = a1[3];
        rp[48] = a2[0]; rp[49] = a2[1]; rp[50] = a2[2]; rp[51] = a2[3];
      }
      __syncthreads();
      if (tid < 72) { float s = 0.f; for (int g = 0; g < 85; ++g) s += red[g * 72 + tid]; int r = tid / 24, n = it * 24 + tid % 24; MOD[r * 6144 + n] = s + p.b_mod[n]; }
      __syncthreads();
    } }
  transpose_job(p.w_in,  1024, INW,  (bf16_t*)(ws + O_WIN),  nullptr, true,  1152, smem);
  transpose_job(p.w_uq,  256,  1536, (bf16_t*)(ws + O_WUQ),  p.g_q,   false, 96,   smem);
  transpose_job(p.w_ukv, 128,  2048, (bf16_t*)(ws + O_WUKV), p.g_kv,  false, 64,   smem);
  transpose_job(p.w_pa,  1024, 1024, (bf16_t*)(ws + O_WPA),  nullptr, false, 256,  smem);
  transpose_job(p.w_pb,  1024, 1024, (bf16_t*)(ws + O_WPB),  nullptr, false, 256,  smem);
  transpose_job(p.w_o,   1024, 1024, (bf16_t*)(ws + O_WO),   nullptr, false, 256,  smem);
  transpose_job(p.w_pq,  1024, 2048, (bf16_t*)(ws + O_WPQ),  nullptr, false, 512,  smem);
  { const int n8 = (131072 + 16384 + 16384) / 8;
    for (int i = bid * NTHR + tid; i < n8; i += nb * NTHR) {
      int e = i * 8; const float* s; bf16_t* d;
      if (e < 131072) { s = p.w_s + e; d = (bf16_t*)(ws + O_WS) + e; }
      else if (e < 131072 + 16384) { s = p.k1 + (e - 131072); d = (bf16_t*)(ws + O_K1) + (e - 131072); }
      else { s = p.k2 + (e - 131072 - 16384); d = (bf16_t*)(ws + O_K2) + (e - 131072 - 16384); }
      const float4 a = *(const float4*)s, b = *(const float4*)(s + 4);
      u32x4 o = {pack2(a.x, a.y), pack2(a.z, a.w), pack2(b.x, b.y), pack2(b.z, b.w)};
      *(u32x4*)d = o;
    } }
}


using f32x32 = __attribute__((ext_vector_type(32))) float;
using u32x6 = __attribute__((ext_vector_type(6))) unsigned;
typedef u32x4 __attribute__((aligned(4))) u32x4_u;
typedef u32x2 __attribute__((aligned(4))) u32x2_u;
DEVI void convert_table_fp6(const float* __restrict__ src, unsigned char* __restrict__ dst, float* __restrict__ scale) {
  const int wave = threadIdx.x >> 6, lane = threadIdx.x & 63, h = lane >> 5, g = lane & 31;
  for (int rp = blockIdx.x * NWAVE + wave; rp < 8192; rp += gridDim.x * NWAVE) {
    const int row = rp * 2 + h;
    const float* sp = src + (size_t)row * 1024 + g * 32;
    f32x16 a, b; float am = 0.f;
#pragma unroll
    for (int j = 0; j < 4; ++j) { const float4 t = *(const float4*)(sp + j * 4), u = *(const float4*)(sp + 16 + j * 4);
      a[j * 4] = t.x; a[j * 4 + 1] = t.y; a[j * 4 + 2] = t.z; a[j * 4 + 3] = t.w; b[j * 4] = u.x; b[j * 4 + 1] = u.y; b[j * 4 + 2] = u.z; b[j * 4 + 3] = u.w;
      am = fmaxf(am, fmaxf(fmaxf(fmaxf(fabsf(t.x), fabsf(t.y)), fmaxf(fabsf(t.z), fabsf(t.w))), fmaxf(fmaxf(fabsf(u.x), fabsf(u.y)), fmaxf(fabsf(u.z), fabsf(u.w))))); }
    for (int o = 16; o > 0; o >>= 1) am = fmaxf(am, __shfl_xor(am, o));
    const float inv = am > 0.f ? 7.5f / am : 0.f;
    const u32x6 w = __builtin_amdgcn_cvt_scalef32_2xpk16_fp6_f32(a * inv, b * inv, 1.0f);
    unsigned char* dp = dst + (size_t)row * 768 + g * 24;
    *(u32x4_u*)dp = (u32x4){w[0], w[1], w[2], w[3]}; *(u32x2_u*)(dp + 16) = (u32x2){w[4], w[5]};
    if (g == 0) scale[row] = am * (1.f / 7.5f);
  }
}

DEVI void ph_hx(const Params& p, char* smem) {
  const int tid = threadIdx.x, wave = tid >> 6, lane = tid & 63;
  float* mA = (float*)smem; float* mB = mA + 3 * 1024;
  const float* MOD = (const float*)(p.ws + O_MOD);
  for (int i = tid; i < 3072; i += NTHR) { int r = i >> 10, c = i & 1023; mA[i] = p.g_pre1[c] * (1.f + MOD[r * 6144 + 1024 + c]); mB[i] = MOD[r * 6144 + c]; }
  __syncthreads();
  bf16_t* HX = (bf16_t*)(p.ws + O_RA);
  for (int row = blockIdx.x * NWAVE + wave; row < NROW; row += gridDim.x * NWAVE) {
    const float* src = row < NTOK ? p.x + (size_t)row * 1024 : p.ctx + (size_t)(row - NTOK) * 1024;
    const int mr = row < NTOK ? (row >> 13) : 2;
    float4 v[4]; float ss = 0.f;
#pragma unroll
    for (int i = 0; i < 4; ++i) { v[i] = *(const float4*)(src + i * 256 + lane * 4); ss += v[i].x * v[i].x + v[i].y * v[i].y + v[i].z * v[i].z + v[i].w * v[i].w; }
    ss = wave_sum(ss); const float rstd = rsqrtf(ss * (1.f / 1024.f) + EPS);
#pragma unroll
    for (int i = 0; i < 4; ++i) { const int c = i * 256 + lane * 4; const float* a = mA + mr * 1024 + c; const float* b = mB + mr * 1024 + c;
      u32x2 o = {pack2(v[i].x * rstd * a[0] + b[0], v[i].y * rstd * a[1] + b[1]), pack2(v[i].z * rstd * a[2] + b[2], v[i].w * rstd * a[3] + b[3])};
      *(u32x2*)(HX + (size_t)row * 1024 + c) = o; }
  }
}

DEVI int lds_sw(int row, int c) { return row * 128 + ((c ^ (row & 7)) << 4); }
template <int BM, int BN, bool ACOLMAP, bool GLDS, class Epi>
DEVI void gemm_tile_mfma(const bf16_t* __restrict__ A, int lda, const bf16_t* __restrict__ Bm, int ldb, int K, int row0, int col0, const Epi& epi, const float* kscale, char* smem) {
  constexpr int WNW = BN / 64, WMW = 8 / WNW, WTM = BM / WMW, MI = WTM / 16, ACH = BM / 64, BCH = BN / 64, ABYTES = BM * 128, BBYTES = BN * 128, STAGE = ABYTES + BBYTES;
  int tid = threadIdx.x; asm volatile("" : "+v"(tid));
  const int wave = __builtin_amdgcn_readfirstlane(tid >> 6), lane = tid & 63, wm = wave / WNW, wn = wave % WNW, l15 = lane & 15, lq = lane >> 4;
  f32x4 acc[MI][4];
#pragma unroll
  for (int mi = 0; mi < MI; ++mi)
#pragma unroll
    for (int ni = 0; ni < 4; ++ni) acc[mi][ni] = (f32x4){0.f, 0.f, 0.f, 0.f};
  const int nk = K >> 6;
  const int sr = tid >> 3, scc = tid & 7;
  auto compute = [&](int buf) {
    const char* sa = smem + buf * STAGE; const char* sb = sa + ABYTES;
#pragma unroll
    for (int ks = 0; ks < 2; ++ks) { const int kc = ks * 4 + lq; bf16x8 bfr[4];
#pragma unroll
      for (int ni = 0; ni < 4; ++ni) bfr[ni] = *(const bf16x8*)(sb + lds_sw(wn * 64 + ni * 16 + l15, kc));
#pragma unroll
      for (int mi = 0; mi < MI; ++mi) { const bf16x8 af = *(const bf16x8*)(sa + lds_sw(wm * WTM + mi * 16 + l15, kc));
#pragma unroll
        for (int ni = 0; ni < 4; ++ni) acc[mi][ni] = __builtin_amdgcn_mfma_f32_16x16x32_bf16(bfr[ni], af, acc[mi][ni], 0, 0, 0); }
    }
  };
  if constexpr (GLDS) {
    const unsigned aoff = (unsigned)(sr * lda + ((scc ^ (sr & 7)) * 8)) * 2u, boff = (unsigned)(sr * ldb + ((scc ^ (sr & 7)) * 8)) * 2u;
    auto gstage = [&](int buf, int kt) {
      const int k0 = kt * 64, ka = ACOLMAP ? k0 + (k0 >> 7) * 64 : k0;
      char* sa = smem + buf * STAGE + wave * 1024; char* sb = sa + ABYTES;
#pragma unroll
      for (int i = 0; i < ACH; ++i) __builtin_amdgcn_global_load_lds((const unsigned*)((const char*)(A + (size_t)(64 * i) * lda + ka) + aoff), (unsigned*)(sa + i * 8192), 16, 0, 0);
#pragma unroll
      for (int i = 0; i < BCH; ++i) __builtin_amdgcn_global_load_lds((const unsigned*)((const char*)(Bm + (size_t)(64 * i) * ldb + k0) + boff), (unsigned*)(sb + i * 8192), 16, 0, 0);
    };
    gstage(0, 0); asm volatile("s_waitcnt vmcnt(0)" ::: "memory"); __syncthreads();
    for (int kt = 0; kt < nk; ++kt) {
      if (kt + 1 < nk) gstage((kt + 1) & 1, kt + 1);
      compute(kt & 1);
      asm volatile("s_waitcnt vmcnt(0)" ::: "memory"); __syncthreads();
    }
  } else {
    u32x4 ra[ACH], rb[BCH];
    const unsigned aoff = (unsigned)(sr * lda + scc * 8) * 2u, boff = (unsigned)(sr * ldb + scc * 8) * 2u;
    const int sdst = lds_sw(sr, scc);
    auto gload = [&](int kt) {
      const int k0 = kt * 64, ka = ACOLMAP ? k0 + (k0 >> 7) * 64 : k0;
#pragma unroll
      for (int i = 0; i < ACH; ++i) { const char* ub = (const char*)(A + (size_t)(64 * i) * lda + ka); ra[i] = *(const u32x4*)(ub + aoff); }
#pragma unroll
      for (int i = 0; i < BCH; ++i) { const char* ub = (const char*)(Bm + (size_t)(64 * i) * ldb + k0); rb[i] = *(const u32x4*)(ub + boff); }
    };
    auto lstore = [&](int buf, int kt) {
      char* sa = smem + buf * STAGE + sdst; char* sb = sa + ABYTES;
#pragma unroll
      for (int i = 0; i < ACH; ++i) { u32x4 v = ra[i];
        if (kscale) { float f[8]; unpack8(v, f); const float* ks = kscale + kt * 64 + scc * 8;
          v = (u32x4){pack2(f[0] * ks[0], f[1] * ks[1]), pack2(f[2] * ks[2], f[3] * ks[3]), pack2(f[4] * ks[4], f[5] * ks[5]), pack2(f[6] * ks[6], f[7] * ks[7])}; }
        *(u32x4*)(sa + i * 8192) = v; }
#pragma unroll
      for (int i = 0; i < BCH; ++i) *(u32x4*)(sb + i * 8192) = rb[i];
    };
    gload(0); lstore(0, 0); __syncthreads();
    for (int kt = 0; kt < nk; ++kt) {
      if (kt + 1 < nk) gload(kt + 1);
      compute(kt & 1);
      if (kt + 1 < nk) lstore((kt + 1) & 1, kt + 1);
      __syncthreads();
    }
  }
  int tide = threadIdx.x; asm volatile("" : "+v"(tide));
  const int l15e = tide & 15, lqe = (tide >> 4) & 3;
  float cs[4][4];
  if constexpr (Epi::SCALE_MODE == 2) {
#pragma unroll
    for (int ni = 0; ni < 4; ++ni)
#pragma unroll
      for (int j = 0; j < 4; ++j) cs[ni][j] = epi.colscale(col0 + wn * 64 + ni * 16 + lqe * 4 + j); }
#pragma unroll
  for (int mi = 0; mi < MI; ++mi) { const int row = row0 + wm * WTM + mi * 16 + l15e; float sq = 0.f; float rs = 1.f;
    if constexpr (Epi::SCALE_MODE == 1) rs = epi.rowscale(row);
#pragma unroll
    for (int ni = 0; ni < 4; ++ni) { float v[4] = {acc[mi][ni][0], acc[mi][ni][1], acc[mi][ni][2], acc[mi][ni][3]};
      if constexpr (Epi::SCALE_MODE == 1) { v[0] *= rs; v[1] *= rs; v[2] *= rs; v[3] *= rs; }
      if constexpr (Epi::SCALE_MODE == 2) { v[0] *= cs[ni][0]; v[1] *= cs[ni][1]; v[2] *= cs[ni][2]; v[3] *= cs[ni][3]; }
      const float q = epi(row, col0 + wn * 64 + ni * 16 + lqe * 4, v);
      if (Epi::RSS) { sq += q; if (ni & 1) { sq += __shfl_xor(sq, 16); sq += __shfl_xor(sq, 32); if (lqe == 0) epi.rss(row, col0 + wn * 64 + (ni >> 1) * 32, sq); sq = 0.f; } } }
    __builtin_amdgcn_sched_barrier(0); }
}


namespace g8 {
constexpr int BK = 64, HALF = 128, HT = HALF * BK;
DEVI int lds_byte(int r, int c) { const int st = (r >> 4) * 2 + (c >> 5), rr = r & 15, cc = c & 31, ob = rr * 64 + cc * 2; return st * 1024 + (ob ^ (((ob >> 9) & 1) << 5)); }
DEVI void stage_rc(int b, int& R, int& C) { const int st = b / 1024, sb = b % 1024, swz = sb ^ (((sb >> 9) & 1) << 5); R = (st >> 1) * 16 + swz / 64; C = (st & 1) * 32 + (swz % 64) / 2; }
}
template <bool ACOLMAP, class Epi>
DEVI void gemm_tile_8ph(const bf16_t* __restrict__ A, int lda, const bf16_t* __restrict__ Bt, int ldb, int K, int row0, int col0, const Epi& epi, char* smem) {
  using namespace g8;
  bf16_t* shm = (bf16_t*)smem;
#define SA(b, h) (shm + ((b) * 2 + (h)) * HT)
#define SB(b, h) (shm + (4 + (b) * 2 + (h)) * HT)
#define STAGE_A(P, r0, kt) do { const int _k0 = (kt) * BK, _ka = ACOLMAP ? _k0 + (_k0 >> 7) * 64 : _k0; \
    __builtin_amdgcn_global_load_lds((const unsigned*)((const char*)(A + (size_t)(r0) * lda + _ka) + ao0), (unsigned*)((char*)(P) + wid * 1024), 16, 0, 0); \
    __builtin_amdgcn_global_load_lds((const unsigned*)((const char*)(A + (size_t)((r0) + 64) * lda + _ka) + ao0), (unsigned*)((char*)(P) + wid * 1024 + 8192), 16, 0, 0); } while (0)
#define STAGE_B(P, r0, kt) do { const int _k0 = (kt) * BK; \
    __builtin_amdgcn_global_load_lds((const unsigned*)((const char*)(Bt + (size_t)(r0) * ldb + _k0) + bo0), (unsigned*)((char*)(P) + wid * 1024), 16, 0, 0); \
    __builtin_amdgcn_global_load_lds((const unsigned*)((const char*)(Bt + (size_t)((r0) + 64) * ldb + _k0) + bo0), (unsigned*)((char*)(P) + wid * 1024 + 8192), 16, 0, 0); } while (0)
#define LDA(dst, b, h) _Pragma("unroll") for (int m = 0; m < 4; ++m) _Pragma("unroll") for (int k = 0; k < 2; ++k) \
    dst[m][k] = *reinterpret_cast<const bf16x8*>((const char*)SA(b, h) + lds_byte(wr * 64 + m * 16 + fr, k * 32 + fq * 8))
#define LDB(dst, b, h) _Pragma("unroll") for (int n = 0; n < 2; ++n) _Pragma("unroll") for (int k = 0; k < 2; ++k) \
    dst[n][k] = *reinterpret_cast<const bf16x8*>((const char*)SB(b, h) + lds_byte(wc * 32 + n * 16 + fr, k * 32 + fq * 8))
#define MMA(ai, bj, At_, Bt_) do { __builtin_amdgcn_s_setprio(1); \
    _Pragma("unroll") for (int m = 0; m < 4; ++m) _Pragma("unroll") for (int n = 0; n < 2; ++n) _Pragma("unroll") for (int k = 0; k < 2; ++k) \
      acc[ai][bj][m][n] = __builtin_amdgcn_mfma_f32_16x16x32_bf16(Bt_[n][k], At_[m][k], acc[ai][bj][m][n], 0, 0, 0); \
    __builtin_amdgcn_s_setprio(0); } while (0)
#define WAIT_V(n) asm volatile("s_waitcnt vmcnt(" #n ")" ::: "memory")
#define WAIT_L(n) asm volatile("s_waitcnt lgkmcnt(" #n ")" ::: "memory")
#define BAR __builtin_amdgcn_s_barrier()
#define SCHED __builtin_amdgcn_sched_barrier(0)
  int tid = threadIdx.x; asm volatile("" : "+v"(tid));
  const int wid = __builtin_amdgcn_readfirstlane(tid >> 6), lane = tid & 63, wr = wid >> 2, wc = wid & 3, fr = lane & 15, fq = lane >> 4;
  unsigned ao0, bo0;
  { int r, c; stage_rc(tid * 16, r, c); ao0 = (unsigned)(r * lda + c) * 2u; bo0 = (unsigned)(r * ldb + c) * 2u; }
  f32x4 acc[2][2][4][2];
#pragma unroll
  for (int a = 0; a < 2; ++a)
#pragma unroll
    for (int b = 0; b < 2; ++b)
#pragma unroll
      for (int m = 0; m < 4; ++m)
#pragma unroll
        for (int n = 0; n < 2; ++n) acc[a][b][m][n] = (f32x4){0.f, 0.f, 0.f, 0.f};
  bf16x8 At[4][2], B0[2][2], B1[2][2];
  const int nt = K / BK;
  STAGE_B(SB(0, 0), 0, 0); STAGE_A(SA(0, 0), 0, 0);
  STAGE_B(SB(0, 1), HALF, 0); STAGE_A(SA(0, 1), HALF, 0);
  if (wr == 1) BAR;
  WAIT_V(4); BAR;
  STAGE_B(SB(1, 0), 0, 1); STAGE_A(SA(1, 0), 0, 1); STAGE_B(SB(1, 1), HALF, 1);
  WAIT_V(6); BAR;
  for (int t = 0; t < nt - 2; t += 2) {
    LDB(B0, 0, 0); SCHED; LDA(At, 0, 0); STAGE_A(SA(1, 1), HALF, t + 1);
    WAIT_L(8); BAR; WAIT_L(0); MMA(0, 0, At, B0); BAR; SCHED;
    LDB(B1, 0, 1); STAGE_B(SB(0, 0), 0, t + 2);
    BAR; WAIT_L(0); MMA(0, 1, At, B1); BAR;
    LDA(At, 0, 1); STAGE_A(SA(0, 0), 0, t + 2);
    BAR; WAIT_L(0); MMA(1, 0, At, B0); BAR; SCHED;
    STAGE_B(SB(0, 1), HALF, t + 2);
    WAIT_V(6); BAR; MMA(1, 1, At, B1); BAR;
    LDB(B0, 1, 0); SCHED; LDA(At, 1, 0); STAGE_A(SA(0, 1), HALF, t + 2);
    WAIT_L(8); BAR; WAIT_L(0); MMA(0, 0, At, B0); BAR; SCHED;
    LDB(B1, 1, 1); STAGE_B(SB(1, 0), 0, t + 3);
    BAR; WAIT_L(0); MMA(0, 1, At, B1); BAR;
    LDA(At, 1, 1); STAGE_A(SA(1, 0), 0, t + 3);
    BAR; WAIT_L(0); MMA(1, 0, At, B0); BAR; SCHED;
    STAGE_B(SB(1, 1), HALF, t + 3);
    WAIT_V(6); BAR; MMA(1, 1, At, B1); BAR;
  }
  { LDB(B0, 0, 0); LDA(At, 0, 0); STAGE_A(SA(1, 1), HALF, nt - 1);
    BAR; WAIT_L(0); MMA(0, 0, At, B0); BAR;
    LDB(B1, 0, 1); BAR; WAIT_L(0); MMA(0, 1, At, B1); BAR;
    LDA(At, 0, 1); WAIT_V(4); BAR; WAIT_L(0); MMA(1, 0, At, B0); MMA(1, 1, At, B1); BAR; }
  { LDB(B0, 1, 0); LDA(At, 1, 0); WAIT_V(2); BAR; WAIT_L(0); MMA(0, 0, At, B0); BAR;
    LDB(B1, 1, 1); WAIT_V(0); BAR; WAIT_L(0); MMA(0, 1, At, B1); BAR;
    LDA(At, 1, 1); BAR; WAIT_L(0); MMA(1, 0, At, B0); MMA(1, 1, At, B1); BAR; }
  if (wr == 0) BAR;
  int tide = threadIdx.x; asm volatile("" : "+v"(tide));
  const int fre = tide & 15, fqe = (tide >> 4) & 3;
#pragma unroll
  for (int ai = 0; ai < 2; ++ai)
#pragma unroll
    for (int m = 0; m < 4; ++m) { const int row = row0 + ai * HALF + wr * 64 + m * 16 + fre;
#pragma unroll
      for (int bj = 0; bj < 2; ++bj) { float sq = 0.f;
#pragma unroll
        for (int n = 0; n < 2; ++n) { const float v[4] = {acc[ai][bj][m][n][0], acc[ai][bj][m][n][1], acc[ai][bj][m][n][2], acc[ai][bj][m][n][3]};
          sq += epi(row, col0 + bj * HALF + wc * 32 + n * 16 + fqe * 4, v); }
        if (Epi::RSS) { sq += __shfl_xor(sq, 16); sq += __shfl_xor(sq, 32); if (fqe == 0) epi.rss(row, col0 + bj * HALF + wc * 32, sq); } }
      if (Epi::EPI_SBAR) __builtin_amdgcn_sched_barrier(0); }
#undef SA
#undef SB
#undef STAGE_A
#undef STAGE_B
#undef LDA
#undef LDB
#undef MMA
#undef WAIT_V
#undef WAIT_L
#undef BAR
#undef SCHED
}

template <int BM, int BN, bool ACOLMAP, class Epi>
DEVI void gemm_tile(const bf16_t* A, int lda, const bf16_t* Bm, int ldb, int K, int row0, int col0, const Epi& epi, const float* kss, char* smem) {
  if constexpr (BM == 256 && BN == 256) gemm_tile_8ph<ACOLMAP>(A, lda, Bm, ldb, K, row0, col0, epi, smem);
  else if (kss) gemm_tile_mfma<BM, BN, ACOLMAP, false>(A, lda, Bm, ldb, K, row0, col0, epi, kss, smem);
  else gemm_tile_mfma<BM, BN, ACOLMAP, true>(A, lda, Bm, ldb, K, row0, col0, epi, nullptr, smem);
}

DEVI void st4bf(bf16_t* d, float a, float b, float c, float e) { u32x2 o = {pack2(a, b), pack2(c, e)}; *(u32x2*)d = o; }

struct EpiIn { static constexpr bool RSS = true; static constexpr int SCALE_MODE = 0; static constexpr bool EPI_SBAR = false; bf16_t *GU, *GVT, *CQ, *CKV, *KR; float *rssv, *rssq, *rsskv;
  DEVI float operator()(int row, int col, const float (&v)[4]) const {
    if (col < 1024) { st4bf(GU + (size_t)row * 1024 + col, gelu_t(v[0]), gelu_t(v[1]), gelu_t(v[2]), gelu_t(v[3])); return 0.f; }
    else if (col < 2048) { const int c = col - 1024, chunk = row >> 7, q = row & 127; float s = 0.f;
#pragma unroll
      for (int j = 0; j < 4; ++j) { const float g = gelu_t(v[j]); s += g * g; GVT[((size_t)chunk * 1024 + c + j) * 128 + q] = f2bf(g); }
      return s; }
    else if (col < 2304) { st4bf(CQ + (size_t)row * 256 + (col - 2048), v[0], v[1], v[2], v[3]); return v[0] * v[0] + v[1] * v[1] + v[2] * v[2] + v[3] * v[3]; }
    else if (col < 2432) { st4bf(CKV + (size_t)row * 128 + (col - 2304), v[0], v[1], v[2], v[3]); return v[0] * v[0] + v[1] * v[1] + v[2] * v[2] + v[3] * v[3]; }
    else if (col < 2496) { st4bf(KR + (size_t)keyrow(row) * 64 + (col - 2432), v[0], v[1], v[2], v[3]); return 0.f; }
    return 0.f; }
  DEVI void rss(int row, int col, float s) const {
    if (col >= 1024 && col < 2048) rssv[row * 32 + ((col - 1024) >> 5)] = s; else if (col >= 2048 && col < 2304) rssq[row * 8 + ((col - 2048) >> 5)] = s; else if (col >= 2304 && col < 2432) rsskv[row * 4 + ((col - 2304) >> 5)] = s; }
};
struct EpiQ { static constexpr bool RSS = false; static constexpr int SCALE_MODE = 1; static constexpr bool EPI_SBAR = false; bf16_t* Q; const float* rssq;
  DEVI float rowscale(int row) const { const float4 ps = *(const float4*)(rssq + row * 8), pt = *(const float4*)(rssq + row * 8 + 4); return rsqrtf((((ps.x + ps.y) + (ps.z + ps.w)) + ((pt.x + pt.y) + (pt.z + pt.w))) * (1.f / 256.f) + EPS); }
  DEVI float operator()(int row, int col, const float (&v)[4]) const { st4bf(Q + (size_t)row * 1536 + col, v[0], v[1], v[2], v[3]); return 0.f; }
  DEVI void rss(int, int, float) const {} };
DEVI int pk4_fp8(float a, float b, float c, float d) { int w = __builtin_amdgcn_cvt_pk_fp8_f32(a, b, 0, false); return __builtin_amdgcn_cvt_pk_fp8_f32(c, d, w, true); }
constexpr size_t O_K8 = O_RKV, O_V8T = O_RKV + al256((size_t)NB * 8 * NKEY * 192);
struct EpiK8 { static constexpr bool RSS = false; static constexpr int SCALE_MODE = 1; static constexpr bool EPI_SBAR = false; unsigned char* K8; const float* rsskv;
  DEVI float rowscale(int row) const { const float4 pk = *(const float4*)(rsskv + row * 4); return rsqrtf(((pk.x + pk.y) + (pk.z + pk.w)) * (1.f / 128.f) + EPS); }
  DEVI float operator()(int row, int col, const float (&v)[4]) const {
    int b, key; keyrow2(row, b, key); const int h = col >> 7, d = col & 127;
    *(int*)(K8 + ((size_t)(b * 8 + h) * NKEY + key) * 192 + d) = pk4_fp8(v[0], v[1], v[2], v[3]); return 0.f; }
  DEVI void rss(int, int, float) const {} };
struct EpiV8T { static constexpr bool RSS = false; static constexpr int SCALE_MODE = 2; static constexpr bool EPI_SBAR = false; unsigned char* V8; const float* rsskv;
  DEVI float colscale(int col) const { const float4 pk = *(const float4*)(rsskv + col * 4); return rsqrtf(((pk.x + pk.y) + (pk.z + pk.w)) * (1.f / 128.f) + EPS); }
  DEVI float operator()(int row, int col, const float (&v)[4]) const {
    int b, key; keyrow2(col, b, key); const int h = row >> 7, d = row & 127, kk = key & 63;
    const int off = 32 * ((kk >> 2) & 1) + 16 * (kk >> 5) + 4 * ((kk >> 3) & 3);
    *(int*)(V8 + ((size_t)(b * 8 + h) * 128 + d) * NKEY + (key & ~63) + off) = pk4_fp8(v[0], v[1], v[2], v[3]); return 0.f; }
  DEVI void rss(int, int, float) const {} };
struct EpiSgu { static constexpr bool RSS = false; static constexpr int SCALE_MODE = 0; static constexpr bool EPI_SBAR = false; bf16_t* GUOA; const float* g_sgu; const float* b_s; int chunk, g;
  DEVI float operator()(int row, int col, const float (&v)[4]) const { const int token = chunk * 128 + row, ch = g * 128 + col; const float bias = b_s[g * 128 + row];
    bf16_t* ptr = GUOA + (size_t)token * 1024 + ch; const u32x2 gu = *(const u32x2*)ptr;
    st4bf(ptr, lo2f(gu[0]) * (g_sgu[ch] * v[0] + bias), hi2f(gu[0]) * (g_sgu[ch + 1] * v[1] + bias), lo2f(gu[1]) * (g_sgu[ch + 2] * v[2] + bias), hi2f(gu[1]) * (g_sgu[ch + 3] * v[3] + bias));
    return 0.f; }
  DEVI void rss(int, int, float) const {} };
struct EpiGate { static constexpr bool RSS = false; static constexpr int SCALE_MODE = 0; static constexpr bool EPI_SBAR = false; bf16_t* G;
  DEVI float operator()(int row, int col, const float (&v)[4]) const { st4bf(G + (size_t)row * 2048 + col, sigmoidf_(v[0]), sigmoidf_(v[1]), sigmoidf_(v[2]), sigmoidf_(v[3])); return 0.f; }
  DEVI void rss(int, int, float) const {} };
template <bool SECOND> struct EpiMerge { static constexpr bool RSS = false; static constexpr int SCALE_MODE = 0; static constexpr bool EPI_SBAR = false;   bf16_t* M; const bf16_t* G;
  DEVI float operator()(int row, int col, const float (&v)[4]) const { const u32x2 g = *(const u32x2*)(G + (size_t)row * 2048 + (SECOND ? 1024 : 0) + col);
    float o0 = lo2f(g[0]) * v[0], o1 = hi2f(g[0]) * v[1], o2 = lo2f(g[1]) * v[2], o3 = hi2f(g[1]) * v[3];
    bf16_t* ptr = M + (size_t)row * 1024 + col;
    if (SECOND) { const u32x2 m = *(const u32x2*)ptr; o0 += lo2f(m[0]); o1 += hi2f(m[0]); o2 += lo2f(m[1]); o3 += hi2f(m[1]); }
    st4bf(ptr, o0, o1, o2, o3); return 0.f; }
  DEVI void rss(int, int, float) const {} };
struct EpiO { static constexpr bool RSS = true; static constexpr int SCALE_MODE = 0; static constexpr bool EPI_SBAR = false; bf16_t* Y; float* rssy;
  DEVI float operator()(int row, int col, const float (&v)[4]) const { st4bf(Y + (size_t)row * 1024 + col, v[0], v[1], v[2], v[3]); return v[0] * v[0] + v[1] * v[1] + v[2] * v[2] + v[3] * v[3]; }
  DEVI void rss(int row, int col, float s) const { rssy[row * 32 + (col >> 5)] = s; } };
struct EpiPq { static constexpr bool RSS = false; static constexpr int SCALE_MODE = 0; static constexpr bool EPI_SBAR = false; bf16_t* QP;
  DEVI float operator()(int row, int col, const float (&v)[4]) const { st4bf(QP + (size_t)row * 2048 + col, v[0], v[1], v[2], v[3]); return 0.f; }
  DEVI void rss(int, int, float) const {} };

template <class F> DEVI void for_tiles_xcd(int MT, int NT, F f) {
  const int nb = gridDim.x;
  if ((nb & 7) == 0 && (MT & 7) == 0) { const int xcd = blockIdx.x & 7, slot = blockIdx.x >> 3, slots = nb >> 3, mper = MT >> 3, tot = mper * NT;
    for (int j = slot; j < tot; j += slots) f(xcd * mper + j / NT, j % NT); }
  else for (int i = blockIdx.x; i < MT * NT; i += nb) f(i / NT, i % NT);
}

DEVI void ph_inproj(const Params& p, char* smem) {
  char* ws = p.ws;
  EpiIn epi{(bf16_t*)(ws + O_RB), (bf16_t*)(ws + O_RC), (bf16_t*)(ws + O_CQ), (bf16_t*)(ws + O_CKV), (bf16_t*)(ws + O_KR), (float*)(ws + O_RSSV), (float*)(ws + O_RSSQ), (float*)(ws + O_RSSKV)};
  const bf16_t* HX = (const bf16_t*)(ws + O_RA); const bf16_t* W = (const bf16_t*)(ws + O_WIN);
  auto tile = [&](int mt, int nt) { gemm_tile<256, 256, false>(HX + (size_t)mt * 256 * 1024, 1024, W + (size_t)nt * 256 * 1024, 1024, 1024, mt * 256, nt * 256, epi, nullptr, smem); };
  for_tiles_xcd(64, 10, tile);
  for (int i = (int)gridDim.x - 1 - (int)blockIdx.x; i < 2; i += gridDim.x) tile(64 + i, 9);
}
DEVI void rope_kr_fp8(const Params& p) {
  const bf16_t* KR = (const bf16_t*)(p.ws + O_KR); const float* rope = (const float*)(p.ws + O_ROPE); unsigned char* K8 = (unsigned char*)(p.ws + O_K8);
  for (int i = blockIdx.x * NTHR + threadIdx.x; i < NROW * 2; i += gridDim.x * NTHR) {
    const int row = i >> 1, which = i & 1, kr = keyrow(row); int b, key; keyrow2(row, b, key);
    float x[32];
    const bf16_t* src = KR + (size_t)kr * 64 + which * 32;
#pragma unroll
    for (int q = 0; q < 4; ++q) unpack8(*(const u32x4*)(src + q * 8), x + q * 8);
    if (row < NTOK) { const int pos = row & 8191, pp = which ? (pos & 63) : (pos >> 6); const float* cs = rope + pp * 32;
#pragma unroll
      for (int j = 0; j < 16; ++j) { const float c = cs[j * 2], sn = cs[j * 2 + 1], x1 = x[j], x2 = x[16 + j]; x[j] = x1 * c - x2 * sn; x[16 + j] = x1 * sn + x2 * c; } }
    u32x4 o0, o1;
#pragma unroll
    for (int q = 0; q < 4; ++q) { o0[q] = (unsigned)pk4_fp8(x[q * 4], x[q * 4 + 1], x[q * 4 + 2], x[q * 4 + 3]); o1[q] = (unsigned)pk4_fp8(x[16 + q * 4], x[17 + q * 4], x[18 + q * 4], x[19 + q * 4]); }
#pragma unroll
    for (int h = 0; h < 8; ++h) { unsigned char* d = K8 + ((size_t)(b * 8 + h) * NKEY + key) * 192 + 128 + which * 32; *(u32x4*)d = o0; *(u32x4*)(d + 16) = o1; }
  }
}
DEVI void ph_mid(const Params& p, char* smem) {
  char* ws = p.ws;
  { EpiQ epi{(bf16_t*)(ws + O_RQ), (const float*)(ws + O_RSSQ)};
    const bf16_t* A = (const bf16_t*)(ws + O_CQ); const bf16_t* W = (const bf16_t*)(ws + O_WUQ);
    for_tiles_xcd(64, 12, [&](int mt, int nt) { gemm_tile<256, 128, false>(A + (size_t)mt * 256 * 256, 256, W + (size_t)nt * 128 * 256, 256, 256, mt * 256, nt * 128, epi, nullptr, smem); }); }
  { EpiK8 epi{(unsigned char*)(ws + O_K8), (const float*)(ws + O_RSSKV)};
    const bf16_t* A = (const bf16_t*)(ws + O_CKV); const bf16_t* W = (const bf16_t*)(ws + O_WUKV);
    auto tile = [&](int mt, int nt) { gemm_tile<256, 128, false>(A + (size_t)mt * 256 * 128, 128, W + (size_t)nt * 256 * 128, 128, 128, mt * 256, nt * 128, epi, nullptr, smem); };
    for_tiles_xcd(64, 8, tile);
    for (int i = blockIdx.x; i < 16; i += gridDim.x) tile(64 + (i >> 3), i & 7); }
  { EpiV8T epi{(unsigned char*)(ws + O_V8T), (const float*)(ws + O_RSSKV)};
    const bf16_t* A = (const bf16_t*)(ws + O_WUKV); const bf16_t* Bc = (const bf16_t*)(ws + O_CKV);
    for (int i = blockIdx.x; i < 8 * 132; i += gridDim.x) { const int mt = i & 7, nt = i >> 3;
      gemm_tile<128, 128, false>(A + (size_t)(mt * 256 + 128) * 128, 128, Bc + (size_t)nt * 128 * 128, 128, 128, mt * 128, nt * 128, epi, nullptr, smem); } }
  { const bf16_t* WS = (const bf16_t*)(ws + O_WS); const bf16_t* GVT = (const bf16_t*)(ws + O_RC);
    float* ksc = (float*)(smem + LDS_BYTES - 1024); const float* rssv = (const float*)(ws + O_RSSV);
    for (int i = blockIdx.x; i < 1024; i += gridDim.x) { const int chunk = i >> 3, g = i & 7;
      __syncthreads();
      if (threadIdx.x < 128) { const float* pr = rssv + (size_t)(chunk * 128 + threadIdx.x) * 32; float t = 0.f;
#pragma unroll
        for (int j = 0; j < 32; ++j) t += pr[j];
        ksc[threadIdx.x] = rsqrtf(t * (1.f / 1024.f) + EPS); }
      __syncthreads();
      EpiSgu epi{(bf16_t*)(ws + O_RB), p.g_sgu, p.b_s, chunk, g};
      gemm_tile<128, 128, false>(WS + (size_t)g * 16384, 128, GVT + ((size_t)chunk * 1024 + g * 128) * 128, 128, 128, 0, 0, epi, ksc, smem); } }
  rope_kr_fp8(p);
}
DEVI void ph_gates(const Params& p, char* smem) {
  char* ws = p.ws; EpiGate epi{(bf16_t*)(ws + O_RKV)};
  const bf16_t* HX = (const bf16_t*)(ws + O_RA); const bf16_t* W = (const bf16_t*)(ws + O_WIN) + (size_t)NPRE * 1024;
  for_tiles_xcd(64, 8, [&](int mt, int nt) { gemm_tile<256, 256, false>(HX + (size_t)mt * 256 * 1024, 1024, W + (size_t)nt * 256 * 1024, 1024, 1024, mt * 256, nt * 256, epi, nullptr, smem); });
}
DEVI void ph_merge(const Params& p, char* smem) {
  char* ws = p.ws; bf16_t* M = (bf16_t*)(ws + O_RC); const bf16_t* G = (const bf16_t*)(ws + O_RKV);
  EpiMerge<false> e1{M, G}; EpiMerge<true> e2{M, G};
  const bf16_t* OA = (const bf16_t*)(ws + O_RB); const bf16_t* OB = (const bf16_t*)(ws + O_RQ);
  const bf16_t* WA = (const bf16_t*)(ws + O_WPA); const bf16_t* WB = (const bf16_t*)(ws + O_WPB);
  for_tiles_xcd(64, 4, [&](int mt, int nt) { gemm_tile<256, 256, false>(OA + (size_t)mt * 256 * 1024, 1024, WA + (size_t)nt * 256 * 1024, 1024, 1024, mt * 256, nt * 256, e1, nullptr, smem); });
  for_tiles_xcd(64, 4, [&](int mt, int nt) { gemm_tile<256, 256, true>(OB + (size_t)mt * 256 * 1536, 1536, WB + (size_t)nt * 256 * 1024, 1024, 1024, mt * 256, nt * 256, e2, nullptr, smem); });
}
DEVI void ph_wo(const Params& p, char* smem) {
  char* ws = p.ws; EpiO epi{(bf16_t*)(ws + O_RA), (float*)(ws + O_RSSY)};
  const bf16_t* M = (const bf16_t*)(ws + O_RC); const bf16_t* W = (const bf16_t*)(ws + O_WO);
  for_tiles_xcd(64, 4, [&](int mt, int nt) { gemm_tile<256, 256, false>(M + (size_t)mt * 256 * 1024, 1024, W + (size_t)nt * 256 * 1024, 1024, 1024, mt * 256, nt * 256, epi, nullptr, smem); });
}
DEVI void ph_wpq(const Params& p, char* smem) {
  char* ws = p.ws; EpiPq epi{(bf16_t*)(ws + O_RKV)};
  const bf16_t* A = (const bf16_t*)(ws + O_RB); const bf16_t* W = (const bf16_t*)(ws + O_WPQ);
  for_tiles_xcd(64, 8, [&](int mt, int nt) { gemm_tile<256, 256, false>(A + (size_t)mt * 256 * 1024, 1024, W + (size_t)nt * 256 * 1024, 1024, 1024, mt * 256, nt * 256, epi, nullptr, smem); });
  convert_table_fp6(p.v_exp, (unsigned char*)(ws + O_RA), (float*)(ws + O_RA + (size_t)16384 * 1024));
}

namespace a8 {
constexpr int KVBLK = 64, SHM_K = KVBLK * 192, SHM_V = 128 * KVBLK;
constexpr int SHM_K2 = 2 * SHM_K, SHM_V2 = 2 * SHM_V;
constexpr float SCALE = 0.07216878364870322f, THR = 1.5f;
using i32x8 = __attribute__((ext_vector_type(8))) int;
DEVI int crow(int r, int hi) { return (r & 3) + 8 * (r >> 2) + 4 * hi; }
DEVI f32x16 mma(const i32x8& a, const i32x8& b, const f32x16& c) { return __builtin_amdgcn_mfma_scale_f32_32x32x64_f8f6f4(a, b, c, 0, 0, 0, 0x7f7f7f7f, 0, 0x7f7f7f7f); }
DEVI void partialSM(f32x16& p0, f32x16& p1, float& m_reg, float& mn, float& alpha) {
  constexpr float C = SCALE * 1.4426950408889634f;
  float pmax = p0[0];
#pragma unroll
  for (int r = 1; r < 16; ++r) pmax = fmaxf(pmax, p0[r]);
#pragma unroll
  for (int r = 0; r < 16; ++r) pmax = fmaxf(pmax, p1[r]);
  { auto rr = __builtin_amdgcn_permlane32_swap(__float_as_uint(pmax), __float_as_uint(pmax), false, false);
    pmax = fmaxf(__uint_as_float(rr[0]), __uint_as_float(rr[1])); }
  if (__builtin_expect(__all(pmax - m_reg <= THR / SCALE), 1)) { mn = m_reg; alpha = 1.f; }
  else { mn = fmaxf(m_reg, pmax); alpha = __builtin_amdgcn_exp2f((m_reg - mn) * C); m_reg = mn; }
  const float mnC = 6.f - mn * C;
#pragma unroll
  for (int r = 0; r < 16; ++r) p0[r] = fmaf(p0[r], C, mnC);
#pragma unroll
  for (int r = 0; r < 16; ++r) p1[r] = fmaf(p1[r], C, mnC);
#pragma unroll
  for (int r = 0; r < 16; ++r) p0[r] = __builtin_amdgcn_exp2f(p0[r]);
}
DEVI void finishSM(f32x16& p0, f32x16& p1, float alpha, float& l_reg, i32x8& pa) {
#pragma unroll
  for (int r = 0; r < 16; ++r) p1[r] = __builtin_amdgcn_exp2f(p1[r]);
  float ps = 0;
#pragma unroll
  for (int r = 0; r < 16; ++r) ps += p0[r];
#pragma unroll
  for (int r = 0; r < 16; ++r) ps += p1[r];
  { auto rr = __builtin_amdgcn_permlane32_swap(__float_as_uint(ps), __float_as_uint(ps), false, false);
    ps = __uint_as_float(rr[0]) + __uint_as_float(rr[1]); }
  l_reg = l_reg * alpha + ps;
#pragma unroll
  for (int j = 0; j < 4; ++j) { pa[j] = pk4_fp8(p0[4 * j], p0[4 * j + 1], p0[4 * j + 2], p0[4 * j + 3]); pa[4 + j] = pk4_fp8(p1[4 * j], p1[4 * j + 1], p1[4 * j + 2], p1[4 * j + 3]); }
}
DEVI i32x8 ld32(const char* p0, const char* p1) { const u32x4 a = *(const u32x4*)p0, b = *(const u32x4*)p1; return (i32x8){(int)a[0], (int)a[1], (int)a[2], (int)a[3], (int)b[0], (int)b[1], (int)b[2], (int)b[3]}; }
DEVI void qkt(f32x16& p0, f32x16& p1, const char* Ks, const i32x8* qf, int r32, int hi) {
  p0 = f32x16{}; p1 = f32x16{};
  const int sw = (r32 >> 2) & 3; const char* k0 = Ks + r32 * 192; const char* k1 = k0 + 32 * 192;
#pragma unroll
  for (int m = 0; m < 3; ++m) { const int c0 = ((4 * m + 2 * hi) ^ sw) << 4, c1 = ((4 * m + 2 * hi + 1) ^ sw) << 4;
    p0 = mma(ld32(k0 + c0, k0 + c1), qf[m], p0);
    p1 = mma(ld32(k1 + c0, k1 + c1), qf[m], p1); }
}
DEVI void pv(f32x16* o, const char* Vs, int tile, const i32x8& pa, int r32, int hi) {
  const int sw = (r32 >> 1) & 7, c0 = ((4 * tile + 2 * hi) ^ sw) << 4, c1 = ((4 * tile + 2 * hi + 1) ^ sw) << 4;
#pragma unroll
  for (int db = 0; db < 4; ++db) { const char* vr = Vs + (32 * db + r32) * 128; o[db] = mma(pa, ld32(vr + c0, vr + c1), o[db]); }
}
DEVI void attn_item(bf16_t* __restrict__ Qb, const unsigned char* __restrict__ Kg, const unsigned char* __restrict__ Vg, const float* __restrict__ rope, int pos0, char* lds) {
  const int tid = threadIdx.x, wid = tid >> 6, lane = tid & 63, r32 = lane & 31, hi = lane >> 5;
  char* V_lds = lds; char* K_lds = lds + 3 * SHM_V2;
  float* wsl = (float*)(lds + 3 * SHM_V2 + 3 * SHM_K2) + wid * 64; float* li_l = wsl; float* al_l = wsl + 32;
  float m_reg = -1e30f, l_reg = 0; f32x16 o[4] = {}; i32x8 qf[3];
  { const bf16_t* Qw = Qb + (size_t)(wid * 32 + r32) * 1536 + hi * 32;
#pragma unroll
    for (int m = 0; m < 3; ++m) { float x[32];
#pragma unroll
      for (int q = 0; q < 4; ++q) unpack8(*(const u32x4*)(Qw + m * 64 + q * 8), x + q * 8);
      if (m == 2) { const int pos = pos0 + wid * 32 + r32, pp = hi ? (pos & 63) : (pos >> 6); const float* cs = rope + pp * 32;
#pragma unroll
        for (int j = 0; j < 16; ++j) { const float c = cs[j * 2], sn = cs[j * 2 + 1], x1 = x[j], x2 = x[16 + j]; x[j] = x1 * c - x2 * sn; x[16 + j] = x1 * sn + x2 * c; } }
#pragma unroll
      for (int q = 0; q < 8; ++q) qf[m][q] = pk4_fp8(x[q * 4], x[q * 4 + 1], x[q * 4 + 2], x[q * 4 + 3]);
      __builtin_amdgcn_sched_barrier(0); } }
  unsigned koff[3], voff[2];
#pragma unroll
  for (int i = 0; i < 3; ++i) { const int pp = wid * 64 + lane + 512 * i, key = pp / 12, c = pp - key * 12; koff[i] = (unsigned)(key * 192 + ((c ^ ((key >> 2) & 3)) << 4)); }
#pragma unroll
  for (int i = 0; i < 2; ++i) { const int pp = wid * 64 + lane + 512 * i, d = pp >> 3, c = pp & 7; voff[i] = (unsigned)(d * NKEY + ((c ^ ((d >> 1) & 7)) << 4)); }
#define GSTAGE(s_, kb, vb) do { const unsigned char* ks = Kg + (size_t)(s_) * SHM_K2; const unsigned char* vs = Vg + (s_) * 128; \
    _Pragma("unroll") for (int i = 0; i < 3; ++i) __builtin_amdgcn_global_load_lds((const unsigned*)(ks + koff[i]), (unsigned*)(K_lds + (kb) + i * 8192 + wid * 1024), 16, 0, 0); \
    _Pragma("unroll") for (int i = 0; i < 2; ++i) __builtin_amdgcn_global_load_lds((const unsigned*)(vs + voff[i]), (unsigned*)(V_lds + (vb) + i * 8192 + wid * 1024), 16, 0, 0); } while (0)
#define SWAIT() asm volatile("s_waitcnt vmcnt(0)" ::: "memory")
#define SBAR() __builtin_amdgcn_sched_barrier(0)
#define RESC(a) do { if (__any((a) < 1.f)) { if (hi == 0) al_l[r32] = (a); asm volatile("s_waitcnt lgkmcnt(0)" ::: "memory"); \
    _Pragma("unroll") for (int d = 0; d < 4; ++d) _Pragma("unroll") for (int r = 0; r < 16; ++r) o[d][r] *= al_l[crow(r, hi)]; } } while (0)
  f32x16 pA0, pA1, pB0, pB1; float mnA, mnB, alA, alB; i32x8 pa; constexpr int NS = NKEY / 128;
  int kp = 0, kc = SHM_K2, kn = 2 * SHM_K2, vp = 0, vc = SHM_V2, vn = 2 * SHM_V2;
  GSTAGE(0, kp, vp); GSTAGE(1, kc, vc); SWAIT(); __syncthreads();
  qkt(pA0, pA1, K_lds + kp, qf, r32, hi); partialSM(pA0, pA1, m_reg, mnA, alA);
  SBAR(); qkt(pB0, pB1, K_lds + kp + SHM_K, qf, r32, hi);
  finishSM(pA0, pA1, alA, l_reg, pa); SBAR();
  pv(o, V_lds + vp, 0, pa, r32, hi); partialSM(pB0, pB1, m_reg, mnB, alB);
  RESC(alB);
  for (int s_ = 1; s_ < NS; ++s_) {
    if (s_ + 1 < NS) GSTAGE(s_ + 1, kn, vn);
    SBAR(); qkt(pA0, pA1, K_lds + kc, qf, r32, hi);
    finishSM(pB0, pB1, alB, l_reg, pa); SBAR();
    pv(o, V_lds + vp, 1, pa, r32, hi); partialSM(pA0, pA1, m_reg, mnA, alA);
    RESC(alA);
    SBAR(); qkt(pB0, pB1, K_lds + kc + SHM_K, qf, r32, hi);
    finishSM(pA0, pA1, alA, l_reg, pa); SBAR();
    pv(o, V_lds + vc, 0, pa, r32, hi); partialSM(pB0, pB1, m_reg, mnB, alB);
    SWAIT(); __syncthreads();
    RESC(alB);
    { const int tk = kp; kp = kc; kc = kn; kn = tk; const int tv = vp; vp = vc; vc = vn; vn = tv; }
  }
  finishSM(pB0, pB1, alB, l_reg, pa); SBAR();
  pv(o, V_lds + vp, 1, pa, r32, hi);
  if (hi == 0) li_l[r32] = l_reg; asm volatile("s_waitcnt lgkmcnt(0)" ::: "memory");
  float rli[16];
#pragma unroll
  for (int r = 0; r < 16; ++r) rli[r] = __builtin_amdgcn_rcpf(li_l[crow(r, hi)]);
  bf16_t* Ow = Qb + (size_t)(wid * 32) * 1536;
#pragma unroll
  for (int r = 0; r < 16; ++r) { const int orow = crow(r, hi);
#pragma unroll
    for (int d0 = 0; d0 < 4; ++d0) Ow[(size_t)orow * 1536 + d0 * 32 + r32] = f2bf(o[d0][r] * rli[r]); }
  __syncthreads();
#undef GSTAGE
#undef SWAIT
#undef SBAR
#undef RESC
}
}
DEVI void attn_fp8(const Params& p, char* smem) {
  bf16_t* Q = (bf16_t*)(p.ws + O_RQ); const unsigned char* K8 = (const unsigned char*)(p.ws + O_K8); const unsigned char* V8 = (const unsigned char*)(p.ws + O_V8T);
  const float* rope = (const float*)(p.ws + O_ROPE);
  for (int it = blockIdx.x; it < NB * 8 * (SEQ / 256); it += gridDim.x) {
    const int bh = (it >> 8) * 8 + (it & 7), qb = (it & 255) >> 3, b = bh >> 3, h = bh & 7;
    a8::attn_item(Q + (size_t)(b * SEQ + qb * 256) * 1536 + h * 192, K8 + (size_t)bh * NKEY * 192, V8 + (size_t)bh * 128 * NKEY, rope, qb * 256, smem);
  }
}
DEVI void ph_attn(const Params& p, char* smem) { attn_fp8(p, smem); }

DEVI void ph_rows(const Params& p, char* smem) {
  const int tid = threadIdx.x, wave = tid >> 6, lane = tid & 63;
  const float* MOD = (const float*)(p.ws + O_MOD); const bf16_t* Y = (const bf16_t*)(p.ws + O_RA); const float* rssy = (const float*)(p.ws + O_RSSY);
  bf16_t* HX2 = (bf16_t*)(p.ws + O_RB);
  for (int row = blockIdx.x * NWAVE + wave; row < NTOK; row += gridDim.x * NWAVE) {
    const int b = row >> 13; const float* md = MOD + b * 6144;
    float ty = 0.f; { const float* pr = rssy + (size_t)row * 32;
#pragma unroll
      for (int j = 0; j < 32; ++j) ty += pr[j]; }
    const float ry = rsqrtf(ty * (1.f / 1024.f) + EPS);
    float x1[16]; float ss = 0.f;
#pragma unroll
    for (int i = 0; i < 4; ++i) { const int c = i * 256 + lane * 4; const float4 xv = *(const float4*)(p.x + (size_t)row * 1024 + c); const u32x2 yv = *(const u32x2*)(Y + (size_t)row * 1024 + c);
      const float4 gp = *(const float4*)(p.g_post1 + c), gt = *(const float4*)(md + 2048 + c);
      x1[i * 4 + 0] = xv.x + gt.x * (lo2f(yv[0]) * ry * gp.x); x1[i * 4 + 1] = xv.y + gt.y * (hi2f(yv[0]) * ry * gp.y);
      x1[i * 4 + 2] = xv.z + gt.z * (lo2f(yv[1]) * ry * gp.z); x1[i * 4 + 3] = xv.w + gt.w * (hi2f(yv[1]) * ry * gp.w);
#pragma unroll
      for (int j = 0; j < 4; ++j) ss += x1[i * 4 + j] * x1[i * 4 + j];
      *(float4*)(p.out + (size_t)row * 1024 + c) = make_float4(x1[i * 4], x1[i * 4 + 1], x1[i * 4 + 2], x1[i * 4 + 3]); }
    ss = wave_sum(ss); const float r2 = rsqrtf(ss * (1.f / 1024.f) + EPS);
#pragma unroll
    for (int i = 0; i < 4; ++i) { const int c = i * 256 + lane * 4; const float4 g2 = *(const float4*)(p.g_pre2 + c), sc = *(const float4*)(md + 4096 + c), sh = *(const float4*)(md + 3072 + c);
      st4bf(HX2 + (size_t)row * 1024 + c, x1[i * 4] * r2 * g2.x * (1.f + sc.x) + sh.x, x1[i * 4 + 1] * r2 * g2.y * (1.f + sc.y) + sh.y,
            x1[i * 4 + 2] * r2 * g2.z * (1.f + sc.z) + sh.z, x1[i * 4 + 3] * r2 * g2.w * (1.f + sc.w) + sh.w); }
  }
  convert_table_fp6(p.u_exp, (unsigned char*)(p.ws + O_RC), (float*)(p.ws + O_RC + (size_t)16384 * 1024));
}

namespace tk {
DEVI int f2sort(float f) { const int i = __float_as_int(f); return i ^ ((i >> 31) & 0x7fffffff); }
DEVI float sort2f(int s) { return __int_as_float(s ^ ((s >> 31) & 0x7fffffff)); }
DEVI void ce_desc(int& a, int& b) { const int hi = max(a, b), lo = min(a, b); a = hi; b = lo; }
DEVI void sort16_desc(int* a) {
#pragma unroll
  for (int lk = 1; lk <= 4; ++lk)
#pragma unroll
    for (int lj = lk - 1; lj >= 0; --lj)
#pragma unroll
      for (int i = 0; i < 16; ++i) { const int j = 1 << lj, k = 1 << lk, l = i ^ j;
        if (l > i) { const int hi = max(a[i], a[l]), lo = min(a[i], a[l]); if ((i & k) == 0) { a[i] = hi; a[l] = lo; } else { a[i] = lo; a[l] = hi; } } }
}
DEVI void bitonic_merge16_desc(int* a) {
#pragma unroll
  for (int lj = 3; lj >= 0; --lj)
#pragma unroll
    for (int i = 0; i < 16; ++i) { const int l = i ^ (1 << lj); if (l > i) ce_desc(a[i], a[l]); }
}
DEVI void merge_top16(int* a, const int* b) {
#pragma unroll
  for (int i = 0; i < 16; ++i) a[i] = max(a[i], b[15 - i]);
  bitonic_merge16_desc(a);
}
DEVI void half_top16(const bf16_t* __restrict__ qrow, const char* Kl, int r32, int hi, int* out) {
  bf16x8 qf[8];
#pragma unroll
  for (int d0 = 0; d0 < 8; ++d0) qf[d0] = *reinterpret_cast<const bf16x8*>(qrow + d0 * 16 + hi * 8);
  int a[64]; const int hi4 = 4 * hi;
#pragma unroll
  for (int kt = 0; kt < 4; ++kt) { f32x16 acc = {};
    const int key = kt * 32 + r32;
#pragma unroll
    for (int d0 = 0; d0 < 8; ++d0) { const bf16x8 kf = *reinterpret_cast<const bf16x8*>(Kl + key * 256 + (((d0 * 2 + hi) ^ (key & 15)) << 4));
      acc = __builtin_amdgcn_mfma_f32_32x32x16_bf16(kf, qf[d0], acc, 0, 0, 0); }
#pragma unroll
    for (int r = 0; r < 16; ++r) { const int kc = kt * 32 + (r & 3) + 8 * (r >> 2); a[kt * 16 + r] = ((f2sort(acc[r]) & ~127) | (127 - kc)) - hi4; } }
  sort16_desc(a); sort16_desc(a + 16); sort16_desc(a + 32); sort16_desc(a + 48);
  merge_top16(a, a + 16); merge_top16(a + 32, a + 48); merge_top16(a, a + 32);
  int L[16], H[16];
#pragma unroll
  for (int i = 0; i < 16; ++i) { auto rr = __builtin_amdgcn_permlane32_swap((unsigned)a[i], (unsigned)a[i], false, false); L[i] = (int)rr[0]; H[i] = (int)rr[1]; }
  merge_top16(L, H);
#pragma unroll
  for (int i = 0; i < 16; ++i) out[i] = L[i];
}
}
DEVI void gather_token_fp6(const Params& p, int t, const int* idx, const float* gw, float* xs, const int* sig);
DEVI void fp6_sigma(int* sig);
DEVI void topk_fast(const Params& p, char* smem) {
  const int tid = threadIdx.x, wave = __builtin_amdgcn_readfirstlane(tid >> 6), lane = tid & 63, r32 = lane & 31, hi = lane >> 5;
  const bf16_t* QP = (const bf16_t*)(p.ws + O_RKV);
  char* K1l = smem; char* K2l = smem + 32768; int* tab = (int*)(smem + 65536) + wave * (32 * 33);
  int* idxl = (int*)(smem + 65536 + 8 * 32 * 33 * 4) + wave * 512; float* gwl = (float*)(smem + 65536 + 8 * 32 * 33 * 4 + 8 * 2048) + wave * 512;
  int* sigl = (int*)(smem + 65536 + 8 * 32 * 33 * 4 + 16 * 2048) + wave * 32;
  fp6_sigma(sigl);
  __syncthreads();
  { const bf16_t* K1 = (const bf16_t*)(p.ws + O_K1);
    for (int id = tid; id < 4096; id += NTHR) { const int key = id >> 4, c = id & 15; const u32x4 v = *(const u32x4*)(K1 + (size_t)key * 128 + c * 8);
      *(u32x4*)(smem + key * 256 + ((c ^ (key & 15)) << 4)) = v; } }
  __syncthreads();
  for (int item = blockIdx.x; item < NTOK * 8 / 256; item += gridDim.x) {
    const int row = item * 256 + wave * 32 + r32;
    const bf16_t* qrow = QP + (size_t)row * 256;
    int t1[16], t2[16];
    tk::half_top16(qrow, K1l, r32, hi, t1);
    __builtin_amdgcn_sched_barrier(0);
    tk::half_top16(qrow + 128, K2l, r32, hi, t2);
    __builtin_amdgcn_sched_barrier(0);
    float v1[16], v2[16];
#pragma unroll
    for (int i = 0; i < 16; ++i) { v1[i] = tk::sort2f(t1[i] & ~127); v2[i] = tk::sort2f(t2[i] & ~127); }
    if (hi == 0) {
#pragma unroll
      for (int i = 0; i < 16; ++i) { tab[r32 * 33 + i] = 127 - (t1[i] & 127); tab[r32 * 33 + 16 + i] = 127 - (t2[i] & 127); } }
#define CAND(i, j) ((tk::f2sort(v1[i] + v2[j]) & ~255) | (255 - ((i) * 16 + (j))))
    int g0[16], g1[16], g2[16];
#pragma unroll
    for (int j = 0; j < 16; ++j) g0[j] = CAND(0, j);
#pragma unroll
    for (int j = 0; j < 8; ++j) g1[j] = CAND(1, j);
#pragma unroll
    for (int j = 0; j < 5; ++j) g1[8 + j] = CAND(2, j);
#pragma unroll
    for (int j = 0; j < 3; ++j) g1[13 + j] = CAND(4, j);
#pragma unroll
    for (int j = 0; j < 4; ++j) g2[j] = CAND(3, j);
    g2[4] = CAND(5, 0); g2[5] = CAND(5, 1); g2[6] = CAND(6, 0); g2[7] = CAND(6, 1); g2[8] = CAND(7, 0); g2[9] = CAND(7, 1);
    g2[10] = CAND(8, 0); g2[11] = CAND(9, 0); g2[12] = CAND(10, 0); g2[13] = CAND(11, 0); g2[14] = CAND(12, 0); g2[15] = CAND(13, 0);
    tk::sort16_desc(g1); tk::sort16_desc(g2);
    tk::merge_top16(g0, g1); tk::merge_top16(g0, g2);
    { int x = CAND(14, 0);
#pragma unroll
      for (int i = 0; i < 16; ++i) { const int h = max(g0[i], x); x = min(g0[i], x); g0[i] = h; }
      x = CAND(15, 0);
#pragma unroll
      for (int i = 0; i < 16; ++i) { const int h = max(g0[i], x); x = min(g0[i], x); g0[i] = h; } }
#undef CAND
    asm volatile("s_waitcnt lgkmcnt(0)" ::: "memory");
    if (hi == 0) {
      int ex[16];
#pragma unroll
      for (int k = 0; k < 16; ++k) { const int pos = 255 - (g0[k] & 255); ex[k] = tab[r32 * 33 + (pos >> 4)] * 128 + tab[r32 * 33 + 16 + (pos & 15)]; }
      int* dst = idxl + r32 * 16;
#pragma unroll
      for (int q = 0; q < 4; ++q) *(int4*)(dst + q * 4) = make_int4(ex[q * 4], ex[q * 4 + 1], ex[q * 4 + 2], ex[q * 4 + 3]);
    } else {
      float e[16]; const float vmax = tk::sort2f(g0[0] & ~255); float sum = 0.f;
#pragma unroll
      for (int k = 0; k < 16; ++k) { e[k] = __expf(tk::sort2f(g0[k] & ~255) - vmax); sum += e[k]; }
      const float inv = 1.f / sum; float* dst = gwl + r32 * 16;
#pragma unroll
      for (int q = 0; q < 4; ++q) *(float4*)(dst + q * 4) = make_float4(e[q * 4] * inv, e[q * 4 + 1] * inv, e[q * 4 + 2] * inv, e[q * 4 + 3] * inv);
    }
    asm volatile("s_waitcnt lgkmcnt(0)" ::: "memory"); __builtin_amdgcn_sched_barrier(0);
#pragma unroll 1
    for (int tl = 0; tl < 4; ++tl) gather_token_fp6(p, item * 32 + wave * 4 + tl, idxl + tl * 128, gwl + tl * 128, (float*)tab, sigl);
    asm volatile("s_waitcnt lgkmcnt(0)" ::: "memory"); __builtin_amdgcn_sched_barrier(0);
  }
}
DEVI void ph_topk(const Params& p, char* smem) { topk_fast(p, smem); }

DEVI void fp6_sigma(int* sig) {
  f32x16 ra, rb;
#pragma unroll
  for (int i = 0; i < 16; ++i) { ra[i] = i < 8 ? i * 0.125f : 1.f + (i - 8) * 0.125f; rb[i] = i < 8 ? 2.f + i * 0.25f : 4.f + (i - 8) * 0.5f; }
  const u32x6 w = __builtin_amdgcn_cvt_scalef32_2xpk16_fp6_f32(ra, rb, 1.0f);
  const f32x32 d = __builtin_amdgcn_cvt_scalef32_pk32_f32_fp6(w, 1.0f);
  if ((threadIdx.x & 63) == 0) {
#pragma unroll
    for (int i = 0; i < 32; ++i) { const float v = d[i]; sig[i] = v < 1.f ? (int)(v * 8.f + 0.5f) : v < 2.f ? 8 + (int)((v - 1.f) * 8.f + 0.5f) : v < 4.f ? 16 + (int)((v - 2.f) * 4.f + 0.5f) : 24 + (int)((v - 4.f) * 2.f + 0.5f); } }
}
constexpr int G6 = 4;
DEVI void gather_token_fp6(const Params& p, int t, const int* idx, const float* gw, float* xs, const int* sig) {
  int lane = threadIdx.x & 63; asm volatile("" : "+v"(lane));
  const int h = lane >> 5, g = lane & 31;
  const bf16_t* HX2 = (const bf16_t*)(p.ws + O_RB);
  const unsigned char* UT = (const unsigned char*)(p.ws + O_RC); const float* SU = (const float*)(p.ws + O_RC + (size_t)16384 * 1024);
  const unsigned char* VT = (const unsigned char*)(p.ws + O_RA); const float* SV = (const float*)(p.ws + O_RA + (size_t)16384 * 1024);
  const float* MOD = (const float*)(p.ws + O_MOD);
  if (h == 0) { float xf[32];
#pragma unroll
    for (int q = 0; q < 4; ++q) unpack8(*(const u32x4*)(HX2 + (size_t)t * 1024 + g * 32 + q * 8), xf + q * 8);
#pragma unroll
    for (int j = 0; j < 32; ++j) xs[j * 32 + g] = xf[j]; }
  asm volatile("s_waitcnt lgkmcnt(0)" ::: "memory"); __builtin_amdgcn_sched_barrier(0);
  float xp[32], acc[32];
#pragma unroll
  for (int i = 0; i < 32; ++i) { xp[i] = xs[sig[i] * 32 + g]; acc[i] = 0.f; }
#pragma unroll 1
  for (int half = 0; half < 2; ++half) {
    const int my_i = idx[half * 64 + lane]; const float my_g = gw[half * 64 + lane];
    const float my_su = SU[my_i], my_sv = SV[my_i];
#pragma unroll 1
    for (int e0 = 0; e0 < 64; e0 += 2 * G6) {
      u32x6 uq[G6], vq[G6]; float cs[G6];
#pragma unroll
      for (int j = 0; j < G6; ++j) { const int ia = __builtin_amdgcn_readlane(my_i, e0 + 2 * j), ib = __builtin_amdgcn_readlane(my_i, e0 + 2 * j + 1); const int id = h ? ib : ia;
        const unsigned char* up = UT + (size_t)id * 768 + g * 24; const unsigned char* vp = VT + (size_t)id * 768 + g * 24;
        const u32x4 u0 = *(const u32x4_u*)up; const u32x2 u1 = *(const u32x2_u*)(up + 16); const u32x4 v0 = *(const u32x4_u*)vp; const u32x2 v1 = *(const u32x2_u*)(vp + 16);
        uq[j] = (u32x6){u0[0], u0[1], u0[2], u0[3], u1[0], u1[1]}; vq[j] = (u32x6){v0[0], v0[1], v0[2], v0[3], v1[0], v1[1]}; }
#pragma unroll
      for (int j = 0; j < G6; ++j) { const f32x32 uf = __builtin_amdgcn_cvt_scalef32_pk32_f32_fp6(uq[j], 1.0f); float d = 0.f;
#pragma unroll
        for (int k = 0; k < 32; ++k) d += xp[k] * uf[k];
        cs[j] = d; __builtin_amdgcn_sched_barrier(0); }
#pragma unroll
      for (int j = 0; j < G6; ++j) { float v = cs[j];
        v += __builtin_bit_cast(float, __builtin_amdgcn_update_dpp(0, __builtin_bit_cast(int, v), 0xB1, 0xf, 0xf, true));
        v += __builtin_bit_cast(float, __builtin_amdgcn_update_dpp(0, __builtin_bit_cast(int, v), 0x4E, 0xf, 0xf, true));
        v += __builtin_bit_cast(float, __builtin_amdgcn_update_dpp(0, __builtin_bit_cast(int, v), 0x141, 0xf, 0xf, true));
        v += __builtin_bit_cast(float, __builtin_amdgcn_update_dpp(0, __builtin_bit_cast(int, v), 0x140, 0xf, 0xf, true));
        const int iv = __builtin_bit_cast(int, v);
        const float s0 = __builtin_bit_cast(float, __builtin_amdgcn_readlane(iv, 0)) + __builtin_bit_cast(float, __builtin_amdgcn_readlane(iv, 16));
        const float s1 = __builtin_bit_cast(float, __builtin_amdgcn_readlane(iv, 32)) + __builtin_bit_cast(float, __builtin_amdgcn_readlane(iv, 48));
        const int ea = e0 + 2 * j, eb = ea + 1;
        const float ga = __builtin_bit_cast(float, __builtin_amdgcn_readlane(__builtin_bit_cast(int, my_g), ea)), gb = __builtin_bit_cast(float, __builtin_amdgcn_readlane(__builtin_bit_cast(int, my_g), eb));
        const float sua = __builtin_bit_cast(float, __builtin_amdgcn_readlane(__builtin_bit_cast(int, my_su), ea)), sub = __builtin_bit_cast(float, __builtin_amdgcn_readlane(__builtin_bit_cast(int, my_su), eb));
        const float sva = __builtin_bit_cast(float, __builtin_amdgcn_readlane(__builtin_bit_cast(int, my_sv), ea)), svb = __builtin_bit_cast(float, __builtin_amdgcn_readlane(__builtin_bit_cast(int, my_sv), eb));
        const float ca = ga * gelu_t(s0 * sua) * sva, cb = gb * gelu_t(s1 * sub) * svb;
        cs[j] = h ? cb : ca; }
#pragma unroll
      for (int j = 0; j < G6; ++j) { const f32x32 vf = __builtin_amdgcn_cvt_scalef32_pk32_f32_fp6(vq[j], 1.0f);
#pragma unroll
        for (int k = 0; k < 32; ++k) acc[k] += cs[j] * vf[k];
        __builtin_amdgcn_sched_barrier(0); }
    }
  }
#pragma unroll
  for (int i = 0; i < 32; ++i) { auto rr = __builtin_amdgcn_permlane32_swap(__float_as_uint(acc[i]), __float_as_uint(acc[i]), false, false); acc[i] = __uint_as_float(rr[0]) + __uint_as_float(rr[1]); }
  if (h == 0) {
#pragma unroll
    for (int i = 0; i < 32; ++i) xs[sig[i] * 32 + g] = acc[i]; }
  asm volatile("s_waitcnt lgkmcnt(0)" ::: "memory"); __builtin_amdgcn_sched_barrier(0);
  float o[16]; float ss = 0.f;
#pragma unroll
  for (int j = 0; j < 16; ++j) { o[j] = xs[(16 * h + j) * 32 + g]; ss += o[j] * o[j]; }
  ss = wave_sum(ss); const float rstd = rsqrtf(ss * (1.f / 1024.f) + EPS);
  const int b = t >> 13, c0 = g * 32 + h * 16; const float* gt2 = MOD + b * 6144 + 5120 + c0;
  float* op = p.out + (size_t)t * 1024 + c0;
#pragma unroll
  for (int q4 = 0; q4 < 4; ++q4) { float4 xv = *(const float4*)(op + q4 * 4); const float4 gt = *(const float4*)(gt2 + q4 * 4), gp = *(const float4*)(p.g_post2 + c0 + q4 * 4);
    xv.x += gt.x * (o[q4 * 4 + 0] * rstd * gp.x); xv.y += gt.y * (o[q4 * 4 + 1] * rstd * gp.y);
    xv.z += gt.z * (o[q4 * 4 + 2] * rstd * gp.z); xv.w += gt.w * (o[q4 * 4 + 3] * rstd * gp.w);
    *(float4*)(op + q4 * 4) = xv; }
  asm volatile("s_waitcnt lgkmcnt(0)" ::: "memory"); __builtin_amdgcn_sched_barrier(0);
}

#define XB_TMO      128
#define XB_XCNT(j)  (256  + 64 * (j))
#define XB_XSUB(j)  (1280 + 64 * (j))
#define XB_XGEN(j)  (2304 + 64 * (j))
#define XB_TOP      3328
#define XB_TOPGEN   3392
#define XCD_BAR_WORDS 3456
#define XB_SPIN_CAP (1u << 18)
#define LAS __attribute__((address_space(3)))
DEVI unsigned xb_ld(unsigned* p)              { return __hip_atomic_load(p, __ATOMIC_RELAXED, __HIP_MEMORY_SCOPE_AGENT); }
DEVI unsigned xb_add(unsigned* p, unsigned v) { return __hip_atomic_fetch_add(p, v, __ATOMIC_RELAXED, __HIP_MEMORY_SCOPE_AGENT); }
DEVI unsigned xb_xcc_id() { return (unsigned)__builtin_amdgcn_s_getreg((3 << 11) | 20) & 0xFu; }
#define XB_SPIN(cond, bar) do { unsigned _sp = 0; while (cond) { __builtin_amdgcn_s_sleep(1); \
    if ((++_sp & 255u) == 0u) { if (xb_ld(&(bar)[XB_TMO])) break; if (_sp > XB_SPIN_CAP) { atomicAdd(&(bar)[XB_TMO], 1u); break; } } } } while (0)
struct XcdBarrier { unsigned* bar; unsigned x; volatile LAS unsigned* st; };
DEVI XcdBarrier xcd_barrier_post(unsigned* bar, volatile LAS unsigned* st) {
  XcdBarrier b; b.bar = bar; b.x = xb_xcc_id(); b.st = st;
  if (threadIdx.x == 0) (void)xb_add(&bar[XB_XCNT(b.x)], 1u);
  return b;
}
DEVI void xcd_barrier_complete(unsigned* bar, unsigned x, unsigned& nloc, unsigned& nx) {
  const unsigned G = gridDim.x * gridDim.y * gridDim.z;
  unsigned sum, cnt, mine, sp = 0u;
  for (;;) {
    sum = 0u; cnt = 0u; mine = 0u;
#pragma unroll
    for (unsigned j = 0; j < 16; ++j) { const unsigned c = xb_ld(&bar[XB_XCNT(j)]); sum += c; cnt += (c > 0u) ? 1u : 0u; mine = (j == x) ? c : mine; }
    if (sum == G) break;
    __builtin_amdgcn_s_sleep(1);
    if ((++sp & 255u) == 0u) { if (xb_ld(&bar[XB_TMO])) break; if (sp > XB_SPIN_CAP) { atomicAdd(&bar[XB_TMO], 1u); break; } }
  }
  nloc = mine > 0u ? mine : 1u; nx = cnt > 0u ? cnt : 1u;
}
DEVI void xcd_barrier(const XcdBarrier& b) {
  asm volatile("s_waitcnt vmcnt(0)" ::: "memory");
  __syncthreads();
  if (threadIdx.x == 0) {
    unsigned* bar = b.bar;
    __builtin_amdgcn_s_waitcnt(0);
    unsigned nloc = b.st[0], nx = b.st[1];
    if (nloc == 0u) { xcd_barrier_complete(bar, b.x, nloc, nx); b.st[0] = nloc; b.st[1] = nx; }
    const unsigned old = xb_add(&bar[XB_XSUB(b.x)], 1u);
    const unsigned gen = old / nloc;
    if (old + 1u == (gen + 1u) * nloc) {
      __builtin_amdgcn_fence(__ATOMIC_RELEASE, "agent");
      asm volatile("s_waitcnt vmcnt(0)" ::: "memory");
      const unsigned og = xb_add(&bar[XB_TOP], 1u);
      const unsigned tg = og / nx;
      if (og + 1u == (tg + 1u) * nx) xb_add(&bar[XB_TOPGEN], 1u);
      else XB_SPIN(xb_ld(&bar[XB_TOPGEN]) == tg, bar);
      __builtin_amdgcn_fence(__ATOMIC_ACQUIRE, "agent");
      xb_add(&bar[XB_XGEN(b.x)], 1u);
      asm volatile("s_waitcnt vmcnt(0)" ::: "memory");
    } else {
      XB_SPIN(xb_ld(&bar[XB_XGEN(b.x)]) == gen, bar);
      __builtin_amdgcn_fence(__ATOMIC_ACQUIRE, "agent");
      asm volatile("s_waitcnt vmcnt(0)" ::: "memory");
    }
  }
  __syncthreads();
}

constexpr int NPHASE = 11;
template <int PH> DEVI void run_phase(const Params& p, char* smem) {
  if constexpr (PH == 0) ph_prep(p, smem);
  else if constexpr (PH == 1) ph_hx(p, smem);
  else if constexpr (PH == 2) ph_inproj(p, smem);
  else if constexpr (PH == 3) ph_mid(p, smem);
  else if constexpr (PH == 4) ph_attn(p, smem);
  else if constexpr (PH == 5) ph_gates(p, smem);
  else if constexpr (PH == 6) ph_merge(p, smem);
  else if constexpr (PH == 7) ph_wo(p, smem);
  else if constexpr (PH == 8) ph_rows(p, smem);
  else if constexpr (PH == 9) ph_wpq(p, smem);
  else if constexpr (PH == 10) ph_topk(p, smem);
}

#ifndef PROBE_PH
#define PROBE_PH -1
#endif
#define RUNPH(N) do { if (PROBE_PH == N) t0 = __builtin_amdgcn_s_memrealtime(); run_phase<N>(p, smem); if (N < NPHASE - 1) xcd_barrier(xb); \
    if (PROBE_PH == N) t1 = __builtin_amdgcn_s_memrealtime(); } while (0)
__global__ __launch_bounds__(NTHR) void k_mega(Params p) {
  extern __shared__ __attribute__((aligned(16))) char smem[];
  cg::grid_group grid = cg::this_grid();
  unsigned long long t0 = 0, t1 = 0;
  unsigned* bar = (unsigned*)(p.ws + O_BAR);
  volatile LAS unsigned* xst = (volatile LAS unsigned*)(smem + LDS_BYTES - 16);
  if (threadIdx.x == 0) { xst[0] = 0u; xst[1] = 0u; }
  __syncthreads();
  const XcdBarrier xb = xcd_barrier_post(bar, xst);
  if (p.out == nullptr) grid.sync();
  RUNPH(0);
  RUNPH(1); RUNPH(2); RUNPH(3); RUNPH(4); RUNPH(5); RUNPH(6); RUNPH(7); RUNPH(8); RUNPH(9); RUNPH(10);
  if (PROBE_PH >= 0) { __syncthreads(); if (blockIdx.x == 0 && threadIdx.x == 0) p.out[0] += exp2f(rintf(log2f((float)(t1 - t0) * 1e-3f) * 5.f) * 0.2f); }
}

extern "C" void kernel_launch(void* const* d_in, const int* in_sizes, int n_in, void* d_out, int out_size, void* d_ws, size_t ws_size, hipStream_t stream) {
  static int grid = 0;
  if (grid == 0) {
    if (n_in != 26 || out_size != NTOK * DM || ws_size < O_END) { fprintf(stderr, "kernel_launch: unexpected shapes n_in %d out %d ws %zu (need %zu)\n", n_in, out_size, ws_size, (size_t)O_END); grid = -1; return; }
    (void)hipFuncSetAttribute((const void*)k_mega, hipFuncAttributeMaxDynamicSharedMemorySize, LDS_BYTES);
    int dev = 0, cus = 0, per_cu = 0; (void)hipGetDevice(&dev); (void)hipDeviceGetAttribute(&cus, hipDeviceAttributeMultiprocessorCount, dev);
    (void)hipOccupancyMaxActiveBlocksPerMultiprocessor(&per_cu, (const void*)k_mega, NTHR, LDS_BYTES);
    if (per_cu < 1) { fprintf(stderr, "kernel_launch: occupancy query says %d blocks per CU\n", per_cu); grid = -1; return; }
    grid = cus;
  }
  if (grid < 0) return;
  Params p{};
  const float** pp = (const float**)&p;
  for (int i = 0; i < 26; ++i) pp[i] = (const float*)d_in[i];
  p.out = (float*)d_out; p.ws = (char*)d_ws;
  (void)hipMemsetAsync((char*)d_ws + O_BAR, 0, (size_t)XCD_BAR_WORDS * 4, stream);
  void* args[] = {&p};
  hipError_t e = hipLaunchCooperativeKernel((const void*)k_mega, dim3(grid), dim3(NTHR), args, LDS_BYTES, stream);
  if (e != hipSuccess) fprintf(stderr, "cooperative launch failed: %s (grid %d)\n", hipGetErrorString(e), grid);
}
```

```cpp
#include <hip/hip_runtime.h>
#include <hip/hip_cooperative_groups.h>
#include <cstdint>
#include <cstdio>
namespace cg = cooperative_groups;

#define DEVI __device__ __forceinline__
typedef unsigned short bf16_t;
using bf16x8 = __attribute__((ext_vector_type(8))) short;
using bf16x4 = __attribute__((ext_vector_type(4))) short;
using f32x4  = __attribute__((ext_vector_type(4))) float;
using f32x16 = __attribute__((ext_vector_type(16))) float;
using u32x4  = __attribute__((ext_vector_type(4))) unsigned;
using u32x2  = __attribute__((ext_vector_type(2))) unsigned;

constexpr int DM = 1024, NB = 2, SEQ = 8192, NTOK = NB * SEQ, CTXL = 256, NCTX = NB * CTXL, NROW = NTOK + NCTX, NKEY = SEQ + CTXL;
constexpr int INW = 4544, INWP = 4608;
constexpr int NPRE = 2560;
constexpr float EPS = 1e-6f;
constexpr int NTHR = 512, NWAVE = 8;
constexpr int LDS_BYTES = 147456;

constexpr size_t al256(size_t x) { return (x + 255) / 256 * 256; }
constexpr size_t O_WIN   = 0;
constexpr size_t O_WUQ   = O_WIN  + al256((size_t)INWP * 1024 * 2);
constexpr size_t O_WUKV  = O_WUQ  + al256((size_t)1536 * 256 * 2);
constexpr size_t O_WPA   = O_WUKV + al256((size_t)2048 * 128 * 2);
constexpr size_t O_WPB   = O_WPA  + al256((size_t)1024 * 1024 * 2);
constexpr size_t O_WO    = O_WPB  + al256((size_t)1024 * 1024 * 2);
constexpr size_t O_WPQ   = O_WO   + al256((size_t)1024 * 1024 * 2);
constexpr size_t O_WS    = O_WPQ  + al256((size_t)2048 * 1024 * 2);
constexpr size_t O_K1    = O_WS   + al256((size_t)8 * 128 * 128 * 2);
constexpr size_t O_K2    = O_K1   + al256((size_t)128 * 128 * 2);
constexpr size_t O_MOD   = O_K2   + al256((size_t)128 * 128 * 2);
constexpr size_t O_ROPE  = O_MOD  + al256((size_t)3 * 6144 * 4);
constexpr size_t O_BAR   = O_ROPE + al256((size_t)128 * 16 * 2 * 4);
constexpr size_t O_RSSV  = O_BAR + al256((size_t)3456 * 4);
constexpr size_t O_RSSQ  = O_RSSV + (size_t)NTOK * 32 * 4;
constexpr size_t O_RSSKV = O_RSSQ + (size_t)NTOK * 8 * 4;
constexpr size_t O_RSSY  = O_RSSKV + (size_t)NROW * 4 * 4;
constexpr size_t O_RSSEND = O_RSSY + (size_t)NTOK * 32 * 4;
constexpr size_t O_RA    = al256(O_RSSEND);
constexpr size_t O_RB    = O_RA  + al256((size_t)NROW * 1024 * 2);
constexpr size_t O_RC    = O_RB  + al256((size_t)NTOK * 1024 * 2);
constexpr size_t O_CQ    = O_RC  + al256((size_t)NTOK * 1024 * 2);
constexpr size_t O_CKV   = O_CQ  + al256((size_t)NTOK * 256 * 2);
constexpr size_t O_KR    = O_CKV + al256((size_t)NROW * 128 * 2);
constexpr size_t O_RQ    = O_KR  + al256((size_t)NROW * 64 * 2);
constexpr size_t O_RKV   = O_RQ  + al256((size_t)NTOK * 1536 * 2);
constexpr size_t O_END   = O_RKV + al256((size_t)NROW * 2048 * 2);
static_assert(O_END <= (size_t)258 * 1024 * 1024, "workspace too large");

struct Params {
  const float *x, *c, *ctx, *c_ctx, *w_mod, *b_mod, *g_pre1, *g_post1, *g_pre2, *g_post2, *w_in, *g_q, *g_kv, *w_uq, *w_ukv, *g_sgu, *w_s, *b_s,
      *w_pa, *w_pb, *w_o, *w_pq, *k1, *k2, *u_exp, *v_exp;
  float* out; char* ws;
};

DEVI float bf2f(unsigned short h) { return __uint_as_float(((unsigned)h) << 16); }
DEVI unsigned short f2bf(float f) { unsigned u = __float_as_uint(f); u += 0x7fffu + ((u >> 16) & 1u); return (unsigned short)(u >> 16); }
typedef __bf16 bf16x2_t __attribute__((ext_vector_type(2)));
typedef float f32x2v_t __attribute__((ext_vector_type(2)));
DEVI unsigned pack2(float a, float b) { const f32x2v_t v = {a, b}; return __builtin_bit_cast(unsigned, __builtin_convertvector(v, bf16x2_t)); }
DEVI float lo2f(unsigned w) { return __uint_as_float(w << 16); }
DEVI float hi2f(unsigned w) { return __uint_as_float(w & 0xffff0000u); }
DEVI void unpack8(const u32x4& w, float* f) {
  f[0] = lo2f(w[0]); f[1] = hi2f(w[0]); f[2] = lo2f(w[1]); f[3] = hi2f(w[1]); f[4] = lo2f(w[2]); f[5] = hi2f(w[2]); f[6] = lo2f(w[3]); f[7] = hi2f(w[3]);
}
DEVI float gelu_t(float x) { const float z = 0.7978845608028654f * (x + 0.044715f * x * x * x); return x * __builtin_amdgcn_rcpf(1.f + __expf(-2.f * z)); }
DEVI float sigmoidf_(float x) { return __builtin_amdgcn_rcpf(1.f + __expf(-x)); }
DEVI float wave_sum(float v) { for (int o = 32; o > 0; o >>= 1) v += __shfl_xor(v, o); return v; }
DEVI float wave_max(float v) { for (int o = 32; o > 0; o >>= 1) v = fmaxf(v, __shfl_xor(v, o)); return v; }
DEVI void keyrow2(int row, int& b, int& key) { if (row < NTOK) { b = row >> 13; key = row & 8191; } else { const int c = row - NTOK; b = c >> 8; key = SEQ + (c & 255); } }
DEVI int keyrow(int row) { if (row < NTOK) return (row >> 13) * NKEY + (row & 8191); int c = row - NTOK; return (c >> 8) * NKEY + SEQ + (c & 255); }

__device__ const float ROPE_FREQ[16] = {1.0f, 0.5623413324356079f, 0.3162277638912201f, 0.17782793939113617f, 0.10000000149011612f, 0.05623413249850273f, 0.03162277489900589f, 0.017782794311642647f, 0.009999999776482582f, 0.005623413249850273f, 0.003162277629598975f, 0.0017782794311642647f, 0.0010000000474974513f, 0.000562341301701963f, 0.0003162277571391314f, 0.00017782794020604342f};
DEVI void sincos_small(double a, double& cs, double& sn) {
  const double k = rint(a * 0.15915494309189535); const double r = fma(-k, 6.283185307179586, a) - k * 2.4492935982947064e-16;
  const double r2 = r * r; double s = 0.0, c = 0.0;
#pragma unroll
  for (int n = 12; n >= 1; --n) { s = (1.0 - s * r2 / (double)((2 * n) * (2 * n + 1))); c = (1.0 - c * r2 / (double)((2 * n - 1) * (2 * n))); }
  sn = r * s; cs = c;
}

DEVI void transpose_job(const float* __restrict__ src, int K, int N, bf16_t* __restrict__ dst, const float* __restrict__ gk, bool isWin, int ntiles, char* smem) {
  const int tid = threadIdx.x; bf16_t* tl = (bf16_t*)smem; const int kt = K / 64;
  for (int idx = blockIdx.x; idx < ntiles; idx += gridDim.x) {
    const int ktile = idx % kt, ntile = idx / kt, k0 = ktile * 64, n0d = ntile * 64;
    int n0s = n0d; bool zero = false;
    if (isWin) { if (n0d == 2496) zero = true; else if (n0d >= 2560) n0s = n0d - 64; }
    { const int kk = tid >> 3, nn8 = (tid & 7) * 8; f32x4 va = {0.f, 0.f, 0.f, 0.f}, vb = va;
      if (!zero) { const float* s = src + (size_t)(k0 + kk) * N + n0s + nn8; const float4 a = *(const float4*)s, b = *(const float4*)(s + 4);
        const float sc = gk ? gk[k0 + kk] : 1.f; va = (f32x4){a.x, a.y, a.z, a.w} * sc; vb = (f32x4){b.x, b.y, b.z, b.w} * sc; }
      bf16_t* tp = tl + nn8 * 72 + kk;
      tp[0] = f2bf(va[0]); tp[72] = f2bf(va[1]); tp[144] = f2bf(va[2]); tp[216] = f2bf(va[3]); tp[288] = f2bf(vb[0]); tp[360] = f2bf(vb[1]); tp[432] = f2bf(vb[2]); tp[504] = f2bf(vb[3]); }
    __syncthreads();
    { const int nn = tid >> 3, kk8 = (tid & 7) * 8;
      const u32x4 o = *(const u32x4*)(tl + nn * 72 + kk8);
      *(u32x4*)(dst + (size_t)(n0d + nn) * K + k0 + kk8) = o; }
    __syncthreads();
  }
}

DEVI void ph_prep(const Params& p, char* smem) {
  const int tid = threadIdx.x, bid = blockIdx.x, nb = gridDim.x;
  char* ws = p.ws;
  if (bid == 0) { float* rope = (float*)(ws + O_ROPE);
    for (int i = tid; i < 128 * 16; i += NTHR) { const int pos = i >> 4, f = i & 15; const float ang = (float)pos * ROPE_FREQ[f];
      double cs, sn; sincos_small((double)ang, cs, sn); rope[i * 2] = (float)cs; rope[i * 2 + 1] = (float)sn; } }
  { float* red = (float*)smem; float* MOD = (float*)(ws + O_MOD);
    for (int it = bid; it < 256; it += nb) {
      const int cgp = tid % 6, kg = tid / 6;
      f32x4 a0 = {0.f, 0.f, 0.f, 0.f}, a1 = a0, a2 = a0;
      if (tid < 510) {
        for (int k = kg; k < 1024; k += 85) {
          const float4 w4 = *(const float4*)(p.w_mod + (size_t)k * 6144 + it * 24 + cgp * 4);
          const f32x4 w = {w4.x, w4.y, w4.z, w4.w};
          const float c0 = p.c[k], c1 = p.c[1024 + k], c2 = p.c_ctx[k];
          a0 += w * (c0 / (1.f + __expf(-c0))); a1 += w * (c1 / (1.f + __expf(-c1))); a2 += w * (c2 / (1.f + __expf(-c2)));
        }
        float* rp = red + kg * 72 + cgp * 4;
        rp[0] = a0[0]; rp[1] = a0[1]; rp[2] = a0[2]; rp[3] = a0[3];
        rp[24] = a1[0]; rp[25] = a1[1]; rp[26] = a1[2]; rp[27] = a1[3];
        rp[48] = a2[0]; rp[49] = a2[1]; rp[50] = a2[2]; rp[51] = a2[3];
      }
      __syncthreads();
      if (tid < 72) { float s = 0.f; for (int g = 0; g < 85; ++g) s += red[g * 72 + tid]; int r = tid / 24, n = it * 24 + tid % 24; MOD[r * 6144 + n] = s + p.b_mod[n]; }
      __syncthreads();
    } }
  transpose_job(p.w_in,  1024, INW,  (bf16_t*)(ws + O_WIN),  nullptr, true,  1152, smem);
  transpose_job(p.w_uq,  256,  1536, (bf16_t*)(ws + O_WUQ),  p.g_q,   false, 96,   smem);
  transpose_job(p.w_ukv, 128,  2048, (bf16_t*)(ws + O_WUKV), p.g_kv,  false, 64,   smem);
  transpose_job(p.w_pa,  1024, 1024, (bf16_t*)(ws + O_WPA),  nullptr, false, 256,  smem);
  transpose_job(p.w_pb,  1024, 1024, (bf16_t*)(ws + O_WPB),  nullptr, false, 256,  smem);
  transpose_job(p.w_o,   1024, 1024, (bf16_t*)(ws + O_WO),   nullptr, false, 256,  smem);
  transpose_job(p.w_pq,  1024, 2048, (bf16_t*)(ws + O_WPQ),  nullptr, false, 512,  smem);
  { const int n8 = (131072 + 16384 + 16384) / 8;
    for (int i = bid * NTHR + tid; i < n8; i += nb * NTHR) {
      int e = i * 8; const float* s; bf16_t* d;
      if (e < 131072) { s = p.w_s + e; d = (bf16_t*)(ws + O_WS) + e; }
      else if (e < 131072 + 16384) { s = p.k1 + (e - 131072); d = (bf16_t*)(ws + O_K1) + (e - 131072); }
      else { s = p.k2 + (e - 131072 - 16384); d = (bf16_t*)(ws + O_K2) + (e - 131072 - 16384); }
      const float4 a = *(const float4*)s, b = *(const float4*)(s + 4);
      u32x4 o = {pack2(a.x, a.y), pack2(a.z, a.w), pack2(b.x, b.y), pack2(b.z, b.w)};
      *(u32x4*)d = o;
    } }
}


using f32x32 = __attribute__((ext_vector_type(32))) float;
using u32x6 = __attribute__((ext_vector_type(6))) unsigned;
typedef u32x4 __attribute__((aligned(4))) u32x4_u;
typedef u32x2 __attribute__((aligned(4))) u32x2_u;
DEVI void convert_table_fp6(const float* __restrict__ src, unsigned char* __restrict__ dst, float* __restrict__ scale) {
  const int wave = threadIdx.x >> 6, lane = threadIdx.x & 63, h = lane >> 5, g = lane & 31;
  for (int rp = blockIdx.x * NWAVE + wave; rp < 8192; rp += gridDim.x * NWAVE) {
    const int row = rp * 2 + h;
    const float* sp = src + (size_t)row * 1024 + g * 32;
    f32x16 a, b; float am = 0.f;
#pragma unroll
    for (int j = 0; j < 4; ++j) { const float4 t = *(const float4*)(sp + j * 4), u = *(const float4*)(sp + 16 + j * 4);
      a[j * 4] = t.x; a[j * 4 + 1] = t.y; a[j * 4 + 2] = t.z; a[j * 4 + 3] = t.w; b[j * 4] = u.x; b[j * 4 + 1] = u.y; b[j * 4 + 2] = u.z; b[j * 4 + 3] = u.w;
      am = fmaxf(am, fmaxf(fmaxf(fmaxf(fabsf(t.x), fabsf(t.y)), fmaxf(fabsf(t.z), fabsf(t.w))), fmaxf(fmaxf(fabsf(u.x), fabsf(u.y)), fmaxf(fabsf(u.z), fabsf(u.w))))); }
    for (int o = 16; o > 0; o >>= 1) am = fmaxf(am, __shfl_xor(am, o));
    const float inv = am > 0.f ? 7.5f / am : 0.f;
    const u32x6 w = __builtin_amdgcn_cvt_scalef32_2xpk16_fp6_f32(a * inv, b * inv, 1.0f);
    unsigned char* dp = dst + (size_t)row * 768 + g * 24;
    *(u32x4_u*)dp = (u32x4){w[0], w[1], w[2], w[3]}; *(u32x2_u*)(dp + 16) = (u32x2){w[4], w[5]};
    if (g == 0) scale[row] = am * (1.f / 7.5f);
  }
}

DEVI void ph_hx(const Params& p, char* smem) {
  const int tid = threadIdx.x, wave = tid >> 6, lane = tid & 63;
  float* mA = (float*)smem; float* mB = mA + 3 * 1024;
  const float* MOD = (const float*)(p.ws + O_MOD);
  for (int i = tid; i < 3072; i += NTHR) { int r = i >> 10, c = i & 1023; mA[i] = p.g_pre1[c] * (1.f + MOD[r * 6144 + 1024 + c]); mB[i] = MOD[r * 6144 + c]; }
  __syncthreads();
  bf16_t* HX = (bf16_t*)(p.ws + O_RA);
  for (int row = blockIdx.x * NWAVE + wave; row < NROW; row += gridDim.x * NWAVE) {
    const float* src = row < NTOK ? p.x + (size_t)row * 1024 : p.ctx + (size_t)(row - NTOK) * 1024;
    const int mr = row < NTOK ? (row >> 13) : 2;
    float4 v[4]; float ss = 0.f;
#pragma unroll
    for (int i = 0; i < 4; ++i) { v[i] = *(const float4*)(src + i * 256 + lane * 4); ss += v[i].x * v[i].x + v[i].y * v[i].y + v[i].z * v[i].z + v[i].w * v[i].w; }
    ss = wave_sum(ss); const float rstd = rsqrtf(ss * (1.f / 1024.f) + EPS);
#pragma unroll
    for (int i = 0; i < 4; ++i) { const int c = i * 256 + lane * 4; const float* a = mA + mr * 1024 + c; const float* b = mB + mr * 1024 + c;
      u32x2 o = {pack2(v[i].x * rstd * a[0] + b[0], v[i].y * rstd * a[1] + b[1]), pack2(v[i].z * rstd * a[2] + b[2], v[i].w * rstd * a[3] + b[3])};
      *(u32x2*)(HX + (size_t)row * 1024 + c) = o; }
  }
}

DEVI int lds_sw(int row, int c) { return row * 128 + ((c ^ (row & 7)) << 4); }
template <int BM, int BN, bool ACOLMAP, bool GLDS, class Epi>
DEVI void gemm_tile_mfma(const bf16_t* __restrict__ A, int lda, const bf16_t* __restrict__ Bm, int ldb, int K, int row0, int col0, const Epi& epi, const float* kscale, char* smem) {
  constexpr int WNW = BN / 64, WMW = 8 / WNW, WTM = BM / WMW, MI = WTM / 16, ACH = BM / 64, BCH = BN / 64, ABYTES = BM * 128, BBYTES = BN * 128, STAGE = ABYTES + BBYTES;
  int tid = threadIdx.x; asm volatile("" : "+v"(tid));
  const int wave = __builtin_amdgcn_readfirstlane(tid >> 6), lane = tid & 63, wm = wave / WNW, wn = wave % WNW, l15 = lane & 15, lq = lane >> 4;
  f32x4 acc[MI][4];
#pragma unroll
  for (int mi = 0; mi < MI; ++mi)
#pragma unroll
    for (int ni = 0; ni < 4; ++ni) acc[mi][ni] = (f32x4){0.f, 0.f, 0.f, 0.f};
  const int nk = K >> 6;
  const int sr = tid >> 3, scc = tid & 7;
  auto compute = [&](int buf) {
    const char* sa = smem + buf * STAGE; const char* sb = sa + ABYTES;
#pragma unroll
    for (int ks = 0; ks < 2; ++ks) { const int kc = ks * 4 + lq; bf16x8 bfr[4];
#pragma unroll
      for (int ni = 0; ni < 4; ++ni) bfr[ni] = *(const bf16x8*)(sb + lds_sw(wn * 64 + ni * 16 + l15, kc));
#pragma unroll
      for (int mi = 0; mi < MI; ++mi) { const bf16x8 af = *(const bf16x8*)(sa + lds_sw(wm * WTM + mi * 16 + l15, kc));
#pragma unroll
        for (int ni = 0; ni < 4; ++ni) acc[mi][ni] = __builtin_amdgcn_mfma_f32_16x16x32_bf16(bfr[ni], af, acc[mi][ni], 0, 0, 0); }
    }
  };
  if constexpr (GLDS) {
    const unsigned aoff = (unsigned)(sr * lda + ((scc ^ (sr & 7)) * 8)) * 2u, boff = (unsigned)(sr * ldb + ((scc ^ (sr & 7)) * 8)) * 2u;
    auto gstage = [&](int buf, int kt) {
      const int k0 = kt * 64, ka = ACOLMAP ? k0 + (k0 >> 7) * 64 : k0;
      char* sa = smem + buf * STAGE + wave * 1024; char* sb = sa + ABYTES;
#pragma unroll
      for (int i = 0; i < ACH; ++i) __builtin_amdgcn_global_load_lds((const unsigned*)((const char*)(A + (size_t)(64 * i) * lda + ka) + aoff), (unsigned*)(sa + i * 8192), 16, 0, 0);
#pragma unroll
      for (int i = 0; i < BCH; ++i) __builtin_amdgcn_global_load_lds((const unsigned*)((const char*)(Bm + (size_t)(64 * i) * ldb + k0) + boff), (unsigned*)(sb + i * 8192), 16, 0, 0);
    };
    gstage(0, 0); asm volatile("s_waitcnt vmcnt(0)" ::: "memory"); __syncthreads();
    for (int kt = 0; kt < nk; ++kt) {
      if (kt + 1 < nk) gstage((kt + 1) & 1, kt + 1);
      compute(kt & 1);
      asm volatile("s_waitcnt vmcnt(0)" ::: "memory"); __syncthreads();
    }
  } else {
    u32x4 ra[ACH], rb[BCH];
    const unsigned aoff = (unsigned)(sr * lda + scc * 8) * 2u, boff = (unsigned)(sr * ldb + scc * 8) * 2u;
    const int sdst = lds_sw(sr, scc);
    auto gload = [&](int kt) {
      const int k0 = kt * 64, ka = ACOLMAP ? k0 + (k0 >> 7) * 64 : k0;
#pragma unroll
      for (int i = 0; i < ACH; ++i) { const char* ub = (const char*)(A + (size_t)(64 * i) * lda + ka); ra[i] = *(const u32x4*)(ub + aoff); }
#pragma unroll
      for (int i = 0; i < BCH; ++i) { const char* ub = (const char*)(Bm + (size_t)(64 * i) * ldb + k0); rb[i] = *(const u32x4*)(ub + boff); }
    };
    auto lstore = [&](int buf, int kt) {
      char* sa = smem + buf * STAGE + sdst; char* sb = sa + ABYTES;
#pragma unroll
      for (int i = 0; i < ACH; ++i) { u32x4 v = ra[i];
        if (kscale) { float f[8]; unpack8(v, f); const float* ks = kscale + kt * 64 + scc * 8;
          v = (u32x4){pack2(f[0] * ks[0], f[1] * ks[1]), pack2(f[2] * ks[2], f[3] * ks[3]), pack2(f[4] * ks[4], f[5] * ks[5]), pack2(f[6] * ks[6], f[7] * ks[7])}; }
        *(u32x4*)(sa + i * 8192) = v; }
#pragma unroll
      for (int i = 0; i < BCH; ++i) *(u32x4*)(sb + i * 8192) = rb[i];
    };
    gload(0); lstore(0, 0); __syncthreads();
    for (int kt = 0; kt < nk; ++kt) {
      if (kt + 1 < nk) gload(kt + 1);
      compute(kt & 1);
      if (kt + 1 < nk) lstore((kt + 1) & 1, kt + 1);
      __syncthreads();
    }
  }
  int tide = threadIdx.x; asm volatile("" : "+v"(tide));
  const int l15e = tide & 15, lqe = (tide >> 4) & 3;
  float cs[4][4];
  if constexpr (Epi::SCALE_MODE == 2) {
#pragma unroll
    for (int ni = 0; ni < 4; ++ni)
#pragma unroll
      for (int j = 0; j < 4; ++j) cs[ni][j] = epi.colscale(col0 + wn * 64 + ni * 16 + lqe * 4 + j); }
#pragma unroll
  for (int mi = 0; mi < MI; ++mi) { const int row = row0 + wm * WTM + mi * 16 + l15e; float sq = 0.f; float rs = 1.f;
    if constexpr (Epi::SCALE_MODE == 1) rs = epi.rowscale(row);
#pragma unroll
    for (int ni = 0; ni < 4; ++ni) { float v[4] = {acc[mi][ni][0], acc[mi][ni][1], acc[mi][ni][2], acc[mi][ni][3]};
      if constexpr (Epi::SCALE_MODE == 1) { v[0] *= rs; v[1] *= rs; v[2] *= rs; v[3] *= rs; }
      if constexpr (Epi::SCALE_MODE == 2) { v[0] *= cs[ni][0]; v[1] *= cs[ni][1]; v[2] *= cs[ni][2]; v[3] *= cs[ni][3]; }
      const float q = epi(row, col0 + wn * 64 + ni * 16 + lqe * 4, v);
      if (Epi::RSS) { sq += q; if (ni & 1) { sq += __shfl_xor(sq, 16); sq += __shfl_xor(sq, 32); if (lqe == 0) epi.rss(row, col0 + wn * 64 + (ni >> 1) * 32, sq); sq = 0.f; } } }
    __builtin_amdgcn_sched_barrier(0); }
}


namespace g8 {
constexpr int BK = 64, HALF = 128, HT = HALF * BK;
DEVI int lds_byte(int r, int c) { const int st = (r >> 4) * 2 + (c >> 5), rr = r & 15, cc = c & 31, ob = rr * 64 + cc * 2; return st * 1024 + (ob ^ (((ob >> 9) & 1) << 5)); }
DEVI void stage_rc(int b, int& R, int& C) { const int st = b / 1024, sb = b % 1024, swz = sb ^ (((sb >> 9) & 1) << 5); R = (st >> 1) * 16 + swz / 64; C = (st & 1) * 32 + (swz % 64) / 2; }
}
template <bool ACOLMAP, class Epi>
DEVI void gemm_tile_8ph(const bf16_t* __restrict__ A, int lda, const bf16_t* __restrict__ Bt, int ldb, int K, int row0, int col0, const Epi& epi, char* smem) {
  using namespace g8;
  bf16_t* shm = (bf16_t*)smem;
#define SA(b, h) (shm + ((b) * 2 + (h)) * HT)
#define SB(b, h) (shm + (4 + (b) * 2 + (h)) * HT)
#define STAGE_A(P, r0, kt) do { const int _k0 = (kt) * BK, _ka = ACOLMAP ? _k0 + (_k0 >> 7) * 64 : _k0; \
    __builtin_amdgcn_global_load_lds((const unsigned*)((const char*)(A + (size_t)(r0) * lda + _ka) + ao0), (unsigned*)((char*)(P) + wid * 1024), 16, 0, 0); \
    __builtin_amdgcn_global_load_lds((const unsigned*)((const char*)(A + (size_t)((r0) + 64) * lda + _ka) + ao0), (unsigned*)((char*)(P) + wid * 1024 + 8192), 16, 0, 0); } while (0)
#define STAGE_B(P, r0, kt) do { const int _k0 = (kt) * BK; \
    __builtin_amdgcn_global_load_lds((const unsigned*)((const char*)(Bt + (size_t)(r0) * ldb + _k0) + bo0), (unsigned*)((char*)(P) + wid * 1024), 16, 0, 0); \
    __builtin_amdgcn_global_load_lds((const unsigned*)((const char*)(Bt + (size_t)((r0) + 64) * ldb + _k0) + bo0), (unsigned*)((char*)(P) + wid * 1024 + 8192), 16, 0, 0); } while (0)
#define LDA(dst, b, h) _Pragma("unroll") for (int m = 0; m < 4; ++m) _Pragma("unroll") for (int k = 0; k < 2; ++k) \
    dst[m][k] = *reinterpret_cast<const bf16x8*>((const char*)SA(b, h) + lds_byte(wr * 64 + m * 16 + fr, k * 32 + fq * 8))
#define LDB(dst, b, h) _Pragma("unroll") for (int n = 0; n < 2; ++n) _Pragma("unroll") for (int k = 0; k < 2; ++k) \
    dst[n][k] = *reinterpret_cast<const bf16x8*>((const char*)SB(b, h) + lds_byte(wc * 32 + n * 16 + fr, k * 32 + fq * 8))
#define MMA(ai, bj, At_, Bt_) do { __builtin_amdgcn_s_setprio(1); \
    _Pragma("unroll") for (int m = 0; m < 4; ++m) _Pragma("unroll") for (int n = 0; n < 2; ++n) _Pragma("unroll") for (int k = 0; k < 2; ++k) \
      acc[ai][bj][m][n] = __builtin_amdgcn_mfma_f32_16x16x32_bf16(Bt_[n][k], At_[m][k], acc[ai][bj][m][n], 0, 0, 0); \
    __builtin_amdgcn_s_setprio(0); } while (0)
#define WAIT_V(n) asm volatile("s_waitcnt vmcnt(" #n ")" ::: "memory")
#define WAIT_L(n) asm volatile("s_waitcnt lgkmcnt(" #n ")" ::: "memory")
#define BAR __builtin_amdgcn_s_barrier()
#define SCHED __builtin_amdgcn_sched_barrier(0)
  int tid = threadIdx.x; asm volatile("" : "+v"(tid));
  const int wid = __builtin_amdgcn_readfirstlane(tid >> 6), lane = tid & 63, wr = wid >> 2, wc = wid & 3, fr = lane & 15, fq = lane >> 4;
  unsigned ao0, bo0;
  { int r, c; stage_rc(tid * 16, r, c); ao0 = (unsigned)(r * lda + c) * 2u; bo0 = (unsigned)(r * ldb + c) * 2u; }
  f32x4 acc[2][2][4][2];
#pragma unroll
  for (int a = 0; a < 2; ++a)
#pragma unroll
    for (int b = 0; b < 2; ++b)
#pragma unroll
      for (int m = 0; m < 4; ++m)
#pragma unroll
        for (int n = 0; n < 2; ++n) acc[a][b][m][n] = (f32x4){0.f, 0.f, 0.f, 0.f};
  bf16x8 At[4][2], B0[2][2], B1[2][2];
  const int nt = K / BK;
  STAGE_B(SB(0, 0), 0, 0); STAGE_A(SA(0, 0), 0, 0);
  STAGE_B(SB(0, 1), HALF, 0); STAGE_A(SA(0, 1), HALF, 0);
  if (wr == 1) BAR;
  WAIT_V(4); BAR;
  STAGE_B(SB(1, 0), 0, 1); STAGE_A(SA(1, 0), 0, 1); STAGE_B(SB(1, 1), HALF, 1);
  WAIT_V(6); BAR;
  for (int t = 0; t < nt - 2; t += 2) {
    LDB(B0, 0, 0); SCHED; LDA(At, 0, 0); STAGE_A(SA(1, 1), HALF, t + 1);
    WAIT_L(8); BAR; WAIT_L(0); MMA(0, 0, At, B0); BAR; SCHED;
    LDB(B1, 0, 1); STAGE_B(SB(0, 0), 0, t + 2);
    BAR; WAIT_L(0); MMA(0, 1, At, B1); BAR;
    LDA(At, 0, 1); STAGE_A(SA(0, 0), 0, t + 2);
    BAR; WAIT_L(0); MMA(1, 0, At, B0); BAR; SCHED;
    STAGE_B(SB(0, 1), HALF, t + 2);
    WAIT_V(6); BAR; MMA(1, 1, At, B1); BAR;
    LDB(B0, 1, 0); SCHED; LDA(At, 1, 0); STAGE_A(SA(0, 1), HALF, t + 2);
    WAIT_L(8); BAR; WAIT_L(0); MMA(0, 0, At, B0); BAR; SCHED;
    LDB(B1, 1, 1); STAGE_B(SB(1, 0), 0, t + 3);
    BAR; WAIT_L(0); MMA(0, 1, At, B1); BAR;
    LDA(At, 1, 1); STAGE_A(SA(1, 0), 0, t + 3);
    BAR; WAIT_L(0); MMA(1, 0, At, B0); BAR; SCHED;
    STAGE_B(SB(1, 1), HALF, t + 3);
    WAIT_V(6); BAR; MMA(1, 1, At, B1); BAR;
  }
  { LDB(B0, 0, 0); LDA(At, 0, 0); STAGE_A(SA(1, 1), HALF, nt - 1);
    BAR; WAIT_L(0); MMA(0, 0, At, B0); BAR;
    LDB(B1, 0, 1); BAR; WAIT_L(0); MMA(0, 1, At, B1); BAR;
    LDA(At, 0, 1); WAIT_V(4); BAR; WAIT_L(0); MMA(1, 0, At, B0); MMA(1, 1, At, B1); BAR; }
  { LDB(B0, 1, 0); LDA(At, 1, 0); WAIT_V(2); BAR; WAIT_L(0); MMA(0, 0, At, B0); BAR;
    LDB(B1, 1, 1); WAIT_V(0); BAR; WAIT_L(0); MMA(0, 1, At, B1); BAR;
    LDA(At, 1, 1); BAR; WAIT_L(0); MMA(1, 0, At, B0); MMA(1, 1, At, B1); BAR; }
  if (wr == 0) BAR;
  int tide = threadIdx.x; asm volatile("" : "+v"(tide));
  const int fre = tide & 15, fqe = (tide >> 4) & 3;
#pragma unroll
  for (int ai = 0; ai < 2; ++ai)
#pragma unroll
    for (int m = 0; m < 4; ++m) { const int row = row0 + ai * HALF + wr * 64 + m * 16 + fre;
#pragma unroll
      for (int bj = 0; bj < 2; ++bj) { float sq = 0.f;
#pragma unroll
        for (int n = 0; n < 2; ++n) { const float v[4] = {acc[ai][bj][m][n][0], acc[ai][bj][m][n][1], acc[ai][bj][m][n][2], acc[ai][bj][m][n][3]};
          sq += epi(row, col0 + bj * HALF + wc * 32 + n * 16 + fqe * 4, v); }
        if (Epi::RSS) { sq += __shfl_xor(sq, 16); sq += __shfl_xor(sq, 32); if (fqe == 0) epi.rss(row, col0 + bj * HALF + wc * 32, sq); } }
      if (Epi::EPI_SBAR) __builtin_amdgcn_sched_barrier(0); }
#undef SA
#undef SB
#undef STAGE_A
#undef STAGE_B
#undef LDA
#undef LDB
#undef MMA
#undef WAIT_V
#undef WAIT_L
#undef BAR
#undef SCHED
}

template <int BM, int BN, bool ACOLMAP, class Epi>
DEVI void gemm_tile(const bf16_t* A, int lda, const bf16_t* Bm, int ldb, int K, int row0, int col0, const Epi& epi, const float* kss, char* smem) {
  if constexpr (BM == 256 && BN == 256) gemm_tile_8ph<ACOLMAP>(A, lda, Bm, ldb, K, row0, col0, epi, smem);
  else if (kss) gemm_tile_mfma<BM, BN, ACOLMAP, false>(A, lda, Bm, ldb, K, row0, col0, epi, kss, smem);
  else gemm_tile_mfma<BM, BN, ACOLMAP, true>(A, lda, Bm, ldb, K, row0, col0, epi, nullptr, smem);
}

DEVI void st4bf(bf16_t* d, float a, float b, float c, float e) { u32x2 o = {pack2(a, b), pack2(c, e)}; *(u32x2*)d = o; }

struct EpiIn { static constexpr bool RSS = true; static constexpr int SCALE_MODE = 0; static constexpr bool EPI_SBAR = false; bf16_t *GU, *GVT, *CQ, *CKV, *KR; float *rssv, *rssq, *rsskv;
  DEVI float operator()(int row, int col, const float (&v)[4]) const {
    if (col < 1024) { st4bf(GU + (size_t)row * 1024 + col, gelu_t(v[0]), gelu_t(v[1]), gelu_t(v[2]), gelu_t(v[3])); return 0.f; }
    else if (col < 2048) { const int c = col - 1024, chunk = row >> 7, q = row & 127; float s = 0.f;
#pragma unroll
      for (int j = 0; j < 4; ++j) { const float g = gelu_t(v[j]); s += g * g; GVT[((size_t)chunk * 1024 + c + j) * 128 + q] = f2bf(g); }
      return s; }
    else if (col < 2304) { st4bf(CQ + (size_t)row * 256 + (col - 2048), v[0], v[1], v[2], v[3]); return v[0] * v[0] + v[1] * v[1] + v[2] * v[2] + v[3] * v[3]; }
    else if (col < 2432) { st4bf(CKV + (size_t)row * 128 + (col - 2304), v[0], v[1], v[2], v[3]); return v[0] * v[0] + v[1] * v[1] + v[2] * v[2] + v[3] * v[3]; }
    else if (col < 2496) { st4bf(KR + (size_t)keyrow(row) * 64 + (col - 2432), v[0], v[1], v[2], v[3]); return 0.f; }
    return 0.f; }
  DEVI void rss(int row, int col, float s) const {
    if (col >= 1024 && col < 2048) rssv[row * 32 + ((col - 1024) >> 5)] = s; else if (col >= 2048 && col < 2304) rssq[row * 8 + ((col - 2048) >> 5)] = s; else if (col >= 2304 && col < 2432) rsskv[row * 4 + ((col - 2304) >> 5)] = s; }
};
struct EpiQ { static constexpr bool RSS = false; static constexpr int SCALE_MODE = 1; static constexpr bool EPI_SBAR = false; bf16_t* Q; const float* rssq;
  DEVI float rowscale(int row) const { const float4 ps = *(const float4*)(rssq + row * 8), pt = *(const float4*)(rssq + row * 8 + 4); return rsqrtf((((ps.x + ps.y) + (ps.z + ps.w)) + ((pt.x + pt.y) + (pt.z + pt.w))) * (1.f / 256.f) + EPS); }
  DEVI float operator()(int row, int col, const float (&v)[4]) const { st4bf(Q + (size_t)row * 1536 + col, v[0], v[1], v[2], v[3]); return 0.f; }
  DEVI void rss(int, int, float) const {} };
DEVI int pk4_fp8(float a, float b, float c, float d) { int w = __builtin_amdgcn_cvt_pk_fp8_f32(a, b, 0, false); return __builtin_amdgcn_cvt_pk_fp8_f32(c, d, w, true); }
constexpr size_t O_K8 = O_RKV, O_V8T = O_RKV + al256((size_t)NB * 8 * NKEY * 192);
struct EpiK8 { static constexpr bool RSS = false; static constexpr int SCALE_MODE = 1; static constexpr bool EPI_SBAR = false; unsigned char* K8; const float* rsskv;
  DEVI float rowscale(int row) const { const float4 pk = *(const float4*)(rsskv + row * 4); return rsqrtf(((pk.x + pk.y) + (pk.z + pk.w)) * (1.f / 128.f) + EPS); }
  DEVI float operator()(int row, int col, const float (&v)[4]) const {
    int b, key; keyrow2(row, b, key); const int h = col >> 7, d = col & 127;
    *(int*)(K8 + ((size_t)(b * 8 + h) * NKEY + key) * 192 + d) = pk4_fp8(v[0], v[1], v[2], v[3]); return 0.f; }
  DEVI void rss(int, int, float) const {} };
struct EpiV8T { static constexpr bool RSS = false; static constexpr int SCALE_MODE = 2; static constexpr bool EPI_SBAR = false; unsigned char* V8; const float* rsskv;
  DEVI float colscale(int col) const { const float4 pk = *(const float4*)(rsskv + col * 4); return rsqrtf(((pk.x + pk.y) + (pk.z + pk.w)) * (1.f / 128.f) + EPS); }
  DEVI float operator()(int row, int col, const float (&v)[4]) const {
    int b, key; keyrow2(col, b, key); const int h = row >> 7, d = row & 127, kk = key & 63;
    const int off = 32 * ((kk >> 2) & 1) + 16 * (kk >> 5) + 4 * ((kk >> 3) & 3);
    *(int*)(V8 + ((size_t)(b * 8 + h) * 128 + d) * NKEY + (key & ~63) + off) = pk4_fp8(v[0], v[1], v[2], v[3]); return 0.f; }
  DEVI void rss(int, int, float) const {} };
struct EpiSgu { static constexpr bool RSS = false; static constexpr int SCALE_MODE = 0; static constexpr bool EPI_SBAR = false; bf16_t* GUOA; const float* g_sgu; const float* b_s; int chunk, g;
  DEVI float operator()(int row, int col, const float (&v)[4]) const { const int token = chunk * 128 + row, ch = g * 128 + col; const float bias = b_s[g * 128 + row];
    bf16_t* ptr = GUOA + (size_t)token * 1024 + ch; const u32x2 gu = *(const u32x2*)ptr;
    st4bf(ptr, lo2f(gu[0]) * (g_sgu[ch] * v[0] + bias), hi2f(gu[0]) * (g_sgu[ch + 1] * v[1] + bias), lo2f(gu[1]) * (g_sgu[ch + 2] * v[2] + bias), hi2f(gu[1]) * (g_sgu[ch + 3] * v[3] + bias));
    return 0.f; }
  DEVI void rss(int, int, float) const {} };
struct EpiGate { static constexpr bool RSS = false; static constexpr int SCALE_MODE = 0; static constexpr bool EPI_SBAR = false; bf16_t* G;
  DEVI float operator()(int row, int col, const float (&v)[4]) const { st4bf(G + (size_t)row * 2048 + col, sigmoidf_(v[0]), sigmoidf_(v[1]), sigmoidf_(v[2]), sigmoidf_(v[3])); return 0.f; }
  DEVI void rss(int, int, float) const {} };
template <bool SECOND> struct EpiMerge { static constexpr bool RSS = false; static constexpr int SCALE_MODE = 0; static constexpr bool EPI_SBAR = false;   bf16_t* M; const bf16_t* G;
  DEVI float operator()(int row, int col, const float (&v)[4]) const { const u32x2 g = *(const u32x2*)(G + (size_t)row * 2048 + (SECOND ? 1024 : 0) + col);
    float o0 = lo2f(g[0]) * v[0], o1 = hi2f(g[0]) * v[1], o2 = lo2f(g[1]) * v[2], o3 = hi2f(g[1]) * v[3];
    bf16_t* ptr = M + (size_t)row * 1024 + col;
    if (SECOND) { const u32x2 m = *(const u32x2*)ptr; o0 += lo2f(m[0]); o1 += hi2f(m[0]); o2 += lo2f(m[1]); o3 += hi2f(m[1]); }
    st4bf(ptr, o0, o1, o2, o3); return 0.f; }
  DEVI void rss(int, int, float) const {} };
struct EpiO { static constexpr bool RSS = true; static constexpr int SCALE_MODE = 0; static constexpr bool EPI_SBAR = false; bf16_t* Y; float* rssy;
  DEVI float operator()(int row, int col, const float (&v)[4]) const { st4bf(Y + (size_t)row * 1024 + col, v[0], v[1], v[2], v[3]); return v[0] * v[0] + v[1] * v[1] + v[2] * v[2] + v[3] * v[3]; }
  DEVI void rss(int row, int col, float s) const { rssy[row * 32 + (col >> 5)] = s; } };
struct EpiPq { static constexpr bool RSS = false; static constexpr int SCALE_MODE = 0; static constexpr bool EPI_SBAR = false; bf16_t* QP;
  DEVI float operator()(int row, int col, const float (&v)[4]) const { st4bf(QP + (size_t)row * 2048 + col, v[0], v[1], v[2], v[3]); return 0.f; }
  DEVI void rss(int, int, float) const {} };

template <class F> DEVI void for_tiles_xcd(int MT, int NT, F f) {
  const int nb = gridDim.x;
  if ((nb & 7) == 0 && (MT & 7) == 0) { const int xcd = blockIdx.x & 7, slot = blockIdx.x >> 3, slots = nb >> 3, mper = MT >> 3, tot = mper * NT;
    for (int j = slot; j < tot; j += slots) f(xcd * mper + j / NT, j % NT); }
  else for (int i = blockIdx.x; i < MT * NT; i += nb) f(i / NT, i % NT);
}

DEVI void ph_inproj(const Params& p, char* smem) {
  char* ws = p.ws;
  EpiIn epi{(bf16_t*)(ws + O_RB), (bf16_t*)(ws + O_RC), (bf16_t*)(ws + O_CQ), (bf16_t*)(ws + O_CKV), (bf16_t*)(ws + O_KR), (float*)(ws + O_RSSV), (float*)(ws + O_RSSQ), (float*)(ws + O_RSSKV)};
  const bf16_t* HX = (const bf16_t*)(ws + O_RA); const bf16_t* W = (const bf16_t*)(ws + O_WIN);
  auto tile = [&](int mt, int nt) { gemm_tile<256, 256, false>(HX + (size_t)mt * 256 * 1024, 1024, W + (size_t)nt * 256 * 1024, 1024, 1024, mt * 256, nt * 256, epi, nullptr, smem); };
  for_tiles_xcd(64, 10, tile);
  for (int i = (int)gridDim.x - 1 - (int)blockIdx.x; i < 2; i += gridDim.x) tile(64 + i, 9);
}
DEVI void rope_kr_fp8(const Params& p) {
  const bf16_t* KR = (const bf16_t*)(p.ws + O_KR); const float* rope = (const float*)(p.ws + O_ROPE); unsigned char* K8 = (unsigned char*)(p.ws + O_K8);
  for (int i = blockIdx.x * NTHR + threadIdx.x; i < NROW * 2; i += gridDim.x * NTHR) {
    const int row = i >> 1, which = i & 1, kr = keyrow(row); int b, key; keyrow2(row, b, key);
    float x[32];
    const bf16_t* src = KR + (size_t)kr * 64 + which * 32;
#pragma unroll
    for (int q = 0; q < 4; ++q) unpack8(*(const u32x4*)(src + q * 8), x + q * 8);
    if (row < NTOK) { const int pos = row & 8191, pp = which ? (pos & 63) : (pos >> 6); const float* cs = rope + pp * 32;
#pragma unroll
      for (int j = 0; j < 16; ++j) { const float c = cs[j * 2], sn = cs[j * 2 + 1], x1 = x[j], x2 = x[16 + j]; x[j] = x1 * c - x2 * sn; x[16 + j] = x1 * sn + x2 * c; } }
    u32x4 o0, o1;
#pragma unroll
    for (int q = 0; q < 4; ++q) { o0[q] = (unsigned)pk4_fp8(x[q * 4], x[q * 4 + 1], x[q * 4 + 2], x[q * 4 + 3]); o1[q] = (unsigned)pk4_fp8(x[16 + q * 4], x[17 + q * 4], x[18 + q * 4], x[19 + q * 4]); }
#pragma unroll
    for (int h = 0; h < 8; ++h) { unsigned char* d = K8 + ((size_t)(b * 8 + h) * NKEY + key) * 192 + 128 + which * 32; *(u32x4*)d = o0; *(u32x4*)(d + 16) = o1; }
  }
}
DEVI void ph_mid(const Params& p, char* smem) {
  char* ws = p.ws;
  { EpiQ epi{(bf16_t*)(ws + O_RQ), (const float*)(ws + O_RSSQ)};
    const bf16_t* A = (const bf16_t*)(ws + O_CQ); const bf16_t* W = (const bf16_t*)(ws + O_WUQ);
    for_tiles_xcd(64, 12, [&](int mt, int nt) { gemm_tile<256, 128, false>(A + (size_t)mt * 256 * 256, 256, W + (size_t)nt * 128 * 256, 256, 256, mt * 256, nt * 128, epi, nullptr, smem); }); }
  { EpiK8 epi{(unsigned char*)(ws + O_K8), (const float*)(ws + O_RSSKV)};
    const bf16_t* A = (const bf16_t*)(ws + O_CKV); const bf16_t* W = (const bf16_t*)(ws + O_WUKV);
    auto tile = [&](int mt, int nt) { gemm_tile<256, 128, false>(A + (size_t)mt * 256 * 128, 128, W + (size_t)nt * 256 * 128, 128, 128, mt * 256, nt * 128, epi, nullptr, smem); };
    for_tiles_xcd(64, 8, tile);
    for (int i = blockIdx.x; i < 16; i += gridDim.x) tile(64 + (i >> 3), i & 7); }
  { EpiV8T epi{(unsigned char*)(ws + O_V8T), (const float*)(ws + O_RSSKV)};
    const bf16_t* A = (const bf16_t*)(ws + O_WUKV); const bf16_t* Bc = (const bf16_t*)(ws + O_CKV);
    for (int i = blockIdx.x; i < 8 * 132; i += gridDim.x) { const int mt = i & 7, nt = i >> 3;
      gemm_tile<128, 128, false>(A + (size_t)(mt * 256 + 128) * 128, 128, Bc + (size_t)nt * 128 * 128, 128, 128, mt * 128, nt * 128, epi, nullptr, smem); } }
  { const bf16_t* WS = (const bf16_t*)(ws + O_WS); const bf16_t* GVT = (const bf16_t*)(ws + O_RC);
    float* ksc = (float*)(smem + LDS_BYTES - 1024); const float* rssv = (const float*)(ws + O_RSSV);
    for (int i = blockIdx.x; i < 1024; i += gridDim.x) { const int chunk = i >> 3, g = i & 7;
      __syncthreads();
      if (threadIdx.x < 128) { const float* pr = rssv + (size_t)(chunk * 128 + threadIdx.x) * 32; float t = 0.f;
#pragma unroll
        for (int j = 0; j < 32; ++j) t += pr[j];
        ksc[threadIdx.x] = rsqrtf(t * (1.f / 1024.f) + EPS); }
      __syncthreads();
      EpiSgu epi{(bf16_t*)(ws + O_RB), p.g_sgu, p.b_s, chunk, g};
      gemm_tile<128, 128, false>(WS + (size_t)g * 16384, 128, GVT + ((size_t)chunk * 1024 + g * 128) * 128, 128, 128, 0, 0, epi, ksc, smem); } }
  rope_kr_fp8(p);
}
DEVI void ph_gates(const Params& p, char* smem) {
  char* ws = p.ws; EpiGate epi{(bf16_t*)(ws + O_RKV)};
  const bf16_t* HX = (const bf16_t*)(ws + O_RA); const bf16_t* W = (const bf16_t*)(ws + O_WIN) + (size_t)NPRE * 1024;
  for_tiles_xcd(64, 8, [&](int mt, int nt) { gemm_tile<256, 256, false>(HX + (size_t)mt * 256 * 1024, 1024, W + (size_t)nt * 256 * 1024, 1024, 1024, mt * 256, nt * 256, epi, nullptr, smem); });
}
DEVI void ph_merge(const Params& p, char* smem) {
  char* ws = p.ws; bf16_t* M = (bf16_t*)(ws + O_RC); const bf16_t* G = (const bf16_t*)(ws + O_RKV);
  EpiMerge<false> e1{M, G}; EpiMerge<true> e2{M, G};
  const bf16_t* OA = (const bf16_t*)(ws + O_RB); const bf16_t* OB = (const bf16_t*)(ws + O_RQ);
  const bf16_t* WA = (const bf16_t*)(ws + O_WPA); const bf16_t* WB = (const bf16_t*)(ws + O_WPB);
  for_tiles_xcd(64, 4, [&](int mt, int nt) { gemm_tile<256, 256, false>(OA + (size_t)mt * 256 * 1024, 1024, WA + (size_t)nt * 256 * 1024, 1024, 1024, mt * 256, nt * 256, e1, nullptr, smem); });
  for_tiles_xcd(64, 4, [&](int mt, int nt) { gemm_tile<256, 256, true>(OB + (size_t)mt * 256 * 1536, 1536, WB + (size_t)nt * 256 * 1024, 1024, 1024, mt * 256, nt * 256, e2, nullptr, smem); });
}
DEVI void ph_wo(const Params& p, char* smem) {
  char* ws = p.ws; EpiO epi{(bf16_t*)(ws + O_RA), (float*)(ws + O_RSSY)};
  const bf16_t* M = (const bf16_t*)(ws + O_RC); const bf16_t* W = (const bf16_t*)(ws + O_WO);
  for_tiles_xcd(64, 4, [&](int mt, int nt) { gemm_tile<256, 256, false>(M + (size_t)mt * 256 * 1024, 1024, W + (size_t)nt * 256 * 1024, 1024, 1024, mt * 256, nt * 256, epi, nullptr, smem); });
}
DEVI void ph_wpq(const Params& p, char* smem) {
  char* ws = p.ws; EpiPq epi{(bf16_t*)(ws + O_RKV)};
  const bf16_t* A = (const bf16_t*)(ws + O_RB); const bf16_t* W = (const bf16_t*)(ws + O_WPQ);
  for_tiles_xcd(64, 8, [&](int mt, int nt) { gemm_tile<256, 256, false>(A + (size_t)mt * 256 * 1024, 1024, W + (size_t)nt * 256 * 1024, 1024, 1024, mt * 256, nt * 256, epi, nullptr, smem); });
  convert_table_fp6(p.v_exp, (unsigned char*)(ws + O_RA), (float*)(ws + O_RA + (size_t)16384 * 1024));
}

namespace a8 {
constexpr int KVBLK = 64, SHM_K = KVBLK * 192, SHM_V = 128 * KVBLK;
constexpr int SHM_K2 = 2 * SHM_K, SHM_V2 = 2 * SHM_V;
constexpr float SCALE = 0.07216878364870322f, THR = 1.5f;
using i32x8 = __attribute__((ext_vector_type(8))) int;
DEVI int crow(int r, int hi) { return (r & 3) + 8 * (r >> 2) + 4 * hi; }
DEVI f32x16 mma(const i32x8& a, const i32x8& b, const f32x16& c) { return __builtin_amdgcn_mfma_scale_f32_32x32x64_f8f6f4(a, b, c, 0, 0, 0, 0x7f7f7f7f, 0, 0x7f7f7f7f); }
DEVI void partialSM(f32x16& p0, f32x16& p1, float& m_reg, float& mn, float& alpha) {
  constexpr float C = SCALE * 1.4426950408889634f;
  float pmax = p0[0];
#pragma unroll
  for (int r = 1; r < 16; ++r) pmax = fmaxf(pmax, p0[r]);
#pragma unroll
  for (int r = 0; r < 16; ++r) pmax = fmaxf(pmax, p1[r]);
  { auto rr = __builtin_amdgcn_permlane32_swap(__float_as_uint(pmax), __float_as_uint(pmax), false, false);
    pmax = fmaxf(__uint_as_float(rr[0]), __uint_as_float(rr[1])); }
  if (__builtin_expect(__all(pmax - m_reg <= THR / SCALE), 1)) { mn = m_reg; alpha = 1.f; }
  else { mn = fmaxf(m_reg, pmax); alpha = __builtin_amdgcn_exp2f((m_reg - mn) * C); m_reg = mn; }
  const float mnC = 6.f - mn * C;
#pragma unroll
  for (int r = 0; r < 16; ++r) p0[r] = fmaf(p0[r], C, mnC);
#pragma unroll
  for (int r = 0; r < 16; ++r) p1[r] = fmaf(p1[r], C, mnC);
#pragma unroll
  for (int r = 0; r < 16; ++r) p0[r] = __builtin_amdgcn_exp2f(p0[r]);
}
DEVI void finishSM(f32x16& p0, f32x16& p1, float alpha, float& l_reg, i32x8& pa) {
#pragma unroll
  for (int r = 0; r < 16; ++r) p1[r] = __builtin_amdgcn_exp2f(p1[r]);
  float ps = 0;
#pragma unroll
  for (int r = 0; r < 16; ++r) ps += p0[r];
#pragma unroll
  for (int r = 0; r < 16; ++r) ps += p1[r];
  { auto rr = __builtin_amdgcn_permlane32_swap(__float_as_uint(ps), __float_as_uint(ps), false, false);
    ps = __uint_as_float(rr[0]) + __uint_as_float(rr[1]); }
  l_reg = l_reg * alpha + ps;
#pragma unroll
  for (int j = 0; j < 4; ++j) { pa[j] = pk4_fp8(p0[4 * j], p0[4 * j + 1], p0[4 * j + 2], p0[4 * j + 3]); pa[4 + j] = pk4_fp8(p1[4 * j], p1[4 * j + 1], p1[4 * j + 2], p1[4 * j + 3]); }
}
DEVI i32x8 ld32(const char* p0, const char* p1) { const u32x4 a = *(const u32x4*)p0, b = *(const u32x4*)p1; return (i32x8){(int)a[0], (int)a[1], (int)a[2], (int)a[3], (int)b[0], (int)b[1], (int)b[2], (int)b[3]}; }
DEVI void qkt(f32x16& p0, f32x16& p1, const char* Ks, const i32x8* qf, int r32, int hi) {
  p0 = f32x16{}; p1 = f32x16{};
  const int sw = (r32 >> 2) & 3; const char* k0 = Ks + r32 * 192; const char* k1 = k0 + 32 * 192;
#pragma unroll
  for (int m = 0; m < 3; ++m) { const int c0 = ((4 * m + 2 * hi) ^ sw) << 4, c1 = ((4 * m + 2 * hi + 1) ^ sw) << 4;
    p0 = mma(ld32(k0 + c0, k0 + c1), qf[m], p0);
    p1 = mma(ld32(k1 + c0, k1 + c1), qf[m], p1); }
}
DEVI void pv(f32x16* o, const char* Vs, int tile, const i32x8& pa, int r32, int hi) {
  const int sw = (r32 >> 1) & 7, c0 = ((4 * tile + 2 * hi) ^ sw) << 4, c1 = ((4 * tile + 2 * hi + 1) ^ sw) << 4;
#pragma unroll
  for (int db = 0; db < 4; ++db) { const char* vr = Vs + (32 * db + r32) * 128; o[db] = mma(pa, ld32(vr + c0, vr + c1), o[db]); }
}
DEVI void attn_item(bf16_t* __restrict__ Qb, const unsigned char* __restrict__ Kg, const unsigned char* __restrict__ Vg, const float* __restrict__ rope, int pos0, char* lds) {
  const int tid = threadIdx.x, wid = tid >> 6, lane = tid & 63, r32 = lane & 31, hi = lane >> 5;
  char* V_lds = lds; char* K_lds = lds + 3 * SHM_V2;
  float* wsl = (float*)(lds + 3 * SHM_V2 + 3 * SHM_K2) + wid * 64; float* li_l = wsl; float* al_l = wsl + 32;
  float m_reg = -1e30f, l_reg = 0; f32x16 o[4] = {}; i32x8 qf[3];
  { const bf16_t* Qw = Qb + (size_t)(wid * 32 + r32) * 1536 + hi * 32;
#pragma unroll
    for (int m = 0; m < 3; ++m) { float x[32];
#pragma unroll
      for (int q = 0; q < 4; ++q) unpack8(*(const u32x4*)(Qw + m * 64 + q * 8), x + q * 8);
      if (m == 2) { const int pos = pos0 + wid * 32 + r32, pp = hi ? (pos & 63) : (pos >> 6); const float* cs = rope + pp * 32;
#pragma unroll
        for (int j = 0; j < 16; ++j) { const float c = cs[j * 2], sn = cs[j * 2 + 1], x1 = x[j], x2 = x[16 + j]; x[j] = x1 * c - x2 * sn; x[16 + j] = x1 * sn + x2 * c; } }
#pragma unroll
      for (int q = 0; q < 8; ++q) qf[m][q] = pk4_fp8(x[q * 4], x[q * 4 + 1], x[q * 4 + 2], x[q * 4 + 3]);
      __builtin_amdgcn_sched_barrier(0); } }
  unsigned koff[3], voff[2];
#pragma unroll
  for (int i = 0; i < 3; ++i) { const int pp = wid * 64 + lane + 512 * i, key = pp / 12, c = pp - key * 12; koff[i] = (unsigned)(key * 192 + ((c ^ ((key >> 2) & 3)) << 4)); }
#pragma unroll
  for (int i = 0; i < 2; ++i) { const int pp = wid * 64 + lane + 512 * i, d = pp >> 3, c = pp & 7; voff[i] = (unsigned)(d * NKEY + ((c ^ ((d >> 1) & 7)) << 4)); }
#define GSTAGE(s_, kb, vb) do { const unsigned char* ks = Kg + (size_t)(s_) * SHM_K2; const unsigned char* vs = Vg + (s_) * 128; \
    _Pragma("unroll") for (int i = 0; i < 3; ++i) __builtin_amdgcn_global_load_lds((const unsigned*)(ks + koff[i]), (unsigned*)(K_lds + (kb) + i * 8192 + wid * 1024), 16, 0, 0); \
    _Pragma("unroll") for (int i = 0; i < 2; ++i) __builtin_amdgcn_global_load_lds((const unsigned*)(vs + voff[i]), (unsigned*)(V_lds + (vb) + i * 8192 + wid * 1024), 16, 0, 0); } while (0)
#define SWAIT() asm volatile("s_waitcnt vmcnt(0)" ::: "memory")
#define SBAR() __builtin_amdgcn_sched_barrier(0)
#define RESC(a) do { if (__any((a) < 1.f)) { if (hi == 0) al_l[r32] = (a); asm volatile("s_waitcnt lgkmcnt(0)" ::: "memory"); \
    _Pragma("unroll") for (int d = 0; d < 4; ++d) _Pragma("unroll") for (int r = 0; r < 16; ++r) o[d][r] *= al_l[crow(r, hi)]; } } while (0)
  f32x16 pA0, pA1, pB0, pB1; float mnA, mnB, alA, alB; i32x8 pa; constexpr int NS = NKEY / 128;
  int kp = 0, kc = SHM_K2, kn = 2 * SHM_K2, vp = 0, vc = SHM_V2, vn = 2 * SHM_V2;
  GSTAGE(0, kp, vp); GSTAGE(1, kc, vc); SWAIT(); __syncthreads();
  qkt(pA0, pA1, K_lds + kp, qf, r32, hi); partialSM(pA0, pA1, m_reg, mnA, alA);
  SBAR(); qkt(pB0, pB1, K_lds + kp + SHM_K, qf, r32, hi);
  finishSM(pA0, pA1, alA, l_reg, pa); SBAR();
  pv(o, V_lds + vp, 0, pa, r32, hi); partialSM(pB0, pB1, m_reg, mnB, alB);
  RESC(alB);
  for (int s_ = 1; s_ < NS; ++s_) {
    if (s_ + 1 < NS) GSTAGE(s_ + 1, kn, vn);
    SBAR(); qkt(pA0, pA1, K_lds + kc, qf, r32, hi);
    finishSM(pB0, pB1, alB, l_reg, pa); SBAR();
    pv(o, V_lds + vp, 1, pa, r32, hi); partialSM(pA0, pA1, m_reg, mnA, alA);
    RESC(alA);
    SBAR(); qkt(pB0, pB1, K_lds + kc + SHM_K, qf, r32, hi);
    finishSM(pA0, pA1, alA, l_reg, pa); SBAR();
    pv(o, V_lds + vc, 0, pa, r32, hi); partialSM(pB0, pB1, m_reg, mnB, alB);
    SWAIT(); __syncthreads();
    RESC(alB);
    { const int tk = kp; kp = kc; kc = kn; kn = tk; const int tv = vp; vp = vc; vc = vn; vn = tv; }
  }
  finishSM(pB0, pB1, alB, l_reg, pa); SBAR();
  pv(o, V_lds + vp, 1, pa, r32, hi);
  if (hi == 0) li_l[r32] = l_reg; asm volatile("s_waitcnt lgkmcnt(0)" ::: "memory");
  float rli[16];
#pragma unroll
  for (int r = 0; r < 16; ++r) rli[r] = __builtin_amdgcn_rcpf(li_l[crow(r, hi)]);
  bf16_t* Ow = Qb + (size_t)(wid * 32) * 1536;
#pragma unroll
  for (int r = 0; r < 16; ++r) { const int orow = crow(r, hi);
#pragma unroll
    for (int d0 = 0; d0 < 4; ++d0) Ow[(size_t)orow * 1536 + d0 * 32 + r32] = f2bf(o[d0][r] * rli[r]); }
  __syncthreads();
#undef GSTAGE
#undef SWAIT
#undef SBAR
#undef RESC
}
}
DEVI void attn_fp8(const Params& p, char* smem) {
  bf16_t* Q = (bf16_t*)(p.ws + O_RQ); const unsigned char* K8 = (const unsigned char*)(p.ws + O_K8); const unsigned char* V8 = (const unsigned char*)(p.ws + O_V8T);
  const float* rope = (const float*)(p.ws + O_ROPE);
  for (int it = blockIdx.x; it < NB * 8 * (SEQ / 256); it += gridDim.x) {
    const int bh = (it >> 8) * 8 + (it & 7), qb = (it & 255) >> 3, b = bh >> 3, h = bh & 7;
    a8::attn_item(Q + (size_t)(b * SEQ + qb * 256) * 1536 + h * 192, K8 + (size_t)bh * NKEY * 192, V8 + (size_t)bh * 128 * NKEY, rope, qb * 256, smem);
  }
}
DEVI void ph_attn(const Params& p, char* smem) { attn_fp8(p, smem); }

DEVI void ph_rows(const Params& p, char* smem) {
  const int tid = threadIdx.x, wave = tid >> 6, lane = tid & 63;
  const float* MOD = (const float*)(p.ws + O_MOD); const bf16_t* Y = (const bf16_t*)(p.ws + O_RA); const float* rssy = (const float*)(p.ws + O_RSSY);
  bf16_t* HX2 = (bf16_t*)(p.ws + O_RB);
  for (int row = blockIdx.x * NWAVE + wave; row < NTOK; row += gridDim.x * NWAVE) {
    const int b = row >> 13; const float* md = MOD + b * 6144;
    float ty = 0.f; { const float* pr = rssy + (size_t)row * 32;
#pragma unroll
      for (int j = 0; j < 32; ++j) ty += pr[j]; }
    const float ry = rsqrtf(ty * (1.f / 1024.f) + EPS);
    float x1[16]; float ss = 0.f;
#pragma unroll
    for (int i = 0; i < 4; ++i) { const int c = i * 256 + lane * 4; const float4 xv = *(const float4*)(p.x + (size_t)row * 1024 + c); const u32x2 yv = *(const u32x2*)(Y + (size_t)row * 1024 + c);
      const float4 gp = *(const float4*)(p.g_post1 + c), gt = *(const float4*)(md + 2048 + c);
      x1[i * 4 + 0] = xv.x + gt.x * (lo2f(yv[0]) * ry * gp.x); x1[i * 4 + 1] = xv.y + gt.y * (hi2f(yv[0]) * ry * gp.y);
      x1[i * 4 + 2] = xv.z + gt.z * (lo2f(yv[1]) * ry * gp.z); x1[i * 4 + 3] = xv.w + gt.w * (hi2f(yv[1]) * ry * gp.w);
#pragma unroll
      for (int j = 0; j < 4; ++j) ss += x1[i * 4 + j] * x1[i * 4 + j];
      *(float4*)(p.out + (size_t)row * 1024 + c) = make_float4(x1[i * 4], x1[i * 4 + 1], x1[i * 4 + 2], x1[i * 4 + 3]); }
    ss = wave_sum(ss); const float r2 = rsqrtf(ss * (1.f / 1024.f) + EPS);
#pragma unroll
    for (int i = 0; i < 4; ++i) { const int c = i * 256 + lane * 4; const float4 g2 = *(const float4*)(p.g_pre2 + c), sc = *(const float4*)(md + 4096 + c), sh = *(const float4*)(md + 3072 + c);
      st4bf(HX2 + (size_t)row * 1024 + c, x1[i * 4] * r2 * g2.x * (1.f + sc.x) + sh.x, x1[i * 4 + 1] * r2 * g2.y * (1.f + sc.y) + sh.y,
            x1[i * 4 + 2] * r2 * g2.z * (1.f + sc.z) + sh.z, x1[i * 4 + 3] * r2 * g2.w * (1.f + sc.w) + sh.w); }
  }
  convert_table_fp6(p.u_exp, (unsigned char*)(p.ws + O_RC), (float*)(p.ws + O_RC + (size_t)16384 * 1024));
}

namespace tk {
DEVI int f2sort(float f) { const int i = __float_as_int(f); return i ^ ((i >> 31) & 0x7fffffff); }
DEVI float sort2f(int s) { return __int_as_float(s ^ ((s >> 31) & 0x7fffffff)); }
DEVI void ce_desc(int& a, int& b) { const int hi = max(a, b), lo = min(a, b); a = hi; b = lo; }
DEVI void sort16_desc(int* a) {
#pragma unroll
  for (int lk = 1; lk <= 4; ++lk)
#pragma unroll
    for (int lj = lk - 1; lj >= 0; --lj)
#pragma unroll
      for (int i = 0; i < 16; ++i) { const int j = 1 << lj, k = 1 << lk, l = i ^ j;
        if (l > i) { const int hi = max(a[i], a[l]), lo = min(a[i], a[l]); if ((i & k) == 0) { a[i] = hi; a[l] = lo; } else { a[i] = lo; a[l] = hi; } } }
}
DEVI void bitonic_merge16_desc(int* a) {
#pragma unroll
  for (int lj = 3; lj >= 0; --lj)
#pragma unroll
    for (int i = 0; i < 16; ++i) { const int l = i ^ (1 << lj); if (l > i) ce_desc(a[i], a[l]); }
}
DEVI void merge_top16(int* a, const int* b) {
#pragma unroll
  for (int i = 0; i < 16; ++i) a[i] = max(a[i], b[15 - i]);
  bitonic_merge16_desc(a);
}
DEVI void half_top16(const bf16_t* __restrict__ qrow, const char* Kl, int r32, int hi, int* out) {
  bf16x8 qf[8];
#pragma unroll
  for (int d0 = 0; d0 < 8; ++d0) qf[d0] = *reinterpret_cast<const bf16x8*>(qrow + d0 * 16 + hi * 8);
  int a[64]; const int hi4 = 4 * hi;
#pragma unroll
  for (int kt = 0; kt < 4; ++kt) { f32x16 acc = {};
    const int key = kt * 32 + r32;
#pragma unroll
    for (int d0 = 0; d0 < 8; ++d0) { const bf16x8 kf = *reinterpret_cast<const bf16x8*>(Kl + key * 256 + (((d0 * 2 + hi) ^ (key & 15)) << 4));
      acc = __builtin_amdgcn_mfma_f32_32x32x16_bf16(kf, qf[d0], acc, 0, 0, 0); }
#pragma unroll
    for (int r = 0; r < 16; ++r) { const int kc = kt * 32 + (r & 3) + 8 * (r >> 2); a[kt * 16 + r] = ((f2sort(acc[r]) & ~127) | (127 - kc)) - hi4; } }
  sort16_desc(a); sort16_desc(a + 16); sort16_desc(a + 32); sort16_desc(a + 48);
  merge_top16(a, a + 16); merge_top16(a + 32, a + 48); merge_top16(a, a + 32);
  int L[16], H[16];
#pragma unroll
  for (int i = 0; i < 16; ++i) { auto rr = __builtin_amdgcn_permlane32_swap((unsigned)a[i], (unsigned)a[i], false, false); L[i] = (int)rr[0]; H[i] = (int)rr[1]; }
  merge_top16(L, H);
#pragma unroll
  for (int i = 0; i < 16; ++i) out[i] = L[i];
}
}
DEVI void gather_tokens4(const Params& p, int t0, const int* idxw, float* gww, float* xs, const int* sig);
DEVI void fp6_sigma(int* sig);
DEVI void topk_fast(const Params& p, char* smem) {
  const int tid = threadIdx.x, wave = __builtin_amdgcn_readfirstlane(tid >> 6), lane = tid & 63, r32 = lane & 31, hi = lane >> 5;
  const bf16_t* QP = (const bf16_t*)(p.ws + O_RKV);
  char* K1l = smem; char* K2l = smem + 32768; int* tab = (int*)(smem + 65536) + wave * (32 * 33);
  int* idxl = (int*)(smem + 65536 + 8 * 32 * 33 * 4) + wave * 512; float* gwl = (float*)(smem + 65536 + 8 * 32 * 33 * 4 + 8 * 2048) + wave * 512;
  int* sigl = (int*)(smem + 65536 + 8 * 32 * 33 * 4 + 16 * 2048) + wave * 32;
  fp6_sigma(sigl);
  __syncthreads();
  { const bf16_t* K1 = (const bf16_t*)(p.ws + O_K1);
    for (int id = tid; id < 4096; id += NTHR) { const int key = id >> 4, c = id & 15; const u32x4 v = *(const u32x4*)(K1 + (size_t)key * 128 + c * 8);
      *(u32x4*)(smem + key * 256 + ((c ^ (key & 15)) << 4)) = v; } }
  __syncthreads();
  for (int item = blockIdx.x; item < NTOK * 8 / 256; item += gridDim.x) {
    int tid_ = threadIdx.x; asm volatile("" : "+v"(tid_));
    const int lane = tid_ & 63, r32 = lane & 31, hi = lane >> 5;
    const int row = item * 256 + wave * 32 + r32;
    const bf16_t* qrow = QP + (size_t)row * 256;
    int t1[16], t2[16];
    tk::half_top16(qrow, K1l, r32, hi, t1);
    __builtin_amdgcn_sched_barrier(0);
    tk::half_top16(qrow + 128, K2l, r32, hi, t2);
    __builtin_amdgcn_sched_barrier(0);
    float v1[16], v2[16];
#pragma unroll
    for (int i = 0; i < 16; ++i) { v1[i] = tk::sort2f(t1[i] & ~127); v2[i] = tk::sort2f(t2[i] & ~127); }
    if (hi == 0) {
#pragma unroll
      for (int i = 0; i < 16; ++i) { tab[r32 * 33 + i] = 127 - (t1[i] & 127); tab[r32 * 33 + 16 + i] = 127 - (t2[i] & 127); } }
#define CAND(i, j) ((tk::f2sort(v1[i] + v2[j]) & ~255) | (255 - ((i) * 16 + (j))))
    int g0[16], g1[16], g2[16];
#pragma unroll
    for (int j = 0; j < 16; ++j) g0[j] = CAND(0, j);
#pragma unroll
    for (int j = 0; j < 8; ++j) g1[j] = CAND(1, j);
#pragma unroll
    for (int j = 0; j < 5; ++j) g1[8 + j] = CAND(2, j);
#pragma unroll
    for (int j = 0; j < 3; ++j) g1[13 + j] = CAND(4, j);
#pragma unroll
    for (int j = 0; j < 4; ++j) g2[j] = CAND(3, j);
    g2[4] = CAND(5, 0); g2[5] = CAND(5, 1); g2[6] = CAND(6, 0); g2[7] = CAND(6, 1); g2[8] = CAND(7, 0); g2[9] = CAND(7, 1);
    g2[10] = CAND(8, 0); g2[11] = CAND(9, 0); g2[12] = CAND(10, 0); g2[13] = CAND(11, 0); g2[14] = CAND(12, 0); g2[15] = CAND(13, 0);
    tk::sort16_desc(g1); tk::sort16_desc(g2);
    tk::merge_top16(g0, g1); tk::merge_top16(g0, g2);
    { int x = CAND(14, 0);
#pragma unroll
      for (int i = 0; i < 16; ++i) { const int h = max(g0[i], x); x = min(g0[i], x); g0[i] = h; }
      x = CAND(15, 0);
#pragma unroll
      for (int i = 0; i < 16; ++i) { const int h = max(g0[i], x); x = min(g0[i], x); g0[i] = h; } }
#undef CAND
    asm volatile("s_waitcnt lgkmcnt(0)" ::: "memory");
    if (hi == 0) {
      int ex[16];
#pragma unroll
      for (int k = 0; k < 16; ++k) { const int pos = 255 - (g0[k] & 255); ex[k] = tab[r32 * 33 + (pos >> 4)] * 128 + tab[r32 * 33 + 16 + (pos & 15)]; }
      int* dst = idxl + r32 * 16;
#pragma unroll
      for (int q = 0; q < 4; ++q) *(int4*)(dst + q * 4) = make_int4(ex[q * 4], ex[q * 4 + 1], ex[q * 4 + 2], ex[q * 4 + 3]);
    } else {
      float e[16]; const float vmax = tk::sort2f(g0[0] & ~255); float sum = 0.f;
#pragma unroll
      for (int k = 0; k < 16; ++k) { e[k] = __expf(tk::sort2f(g0[k] & ~255) - vmax); sum += e[k]; }
      const float inv = 1.f / sum; float* dst = gwl + r32 * 16;
#pragma unroll
      for (int q = 0; q < 4; ++q) *(float4*)(dst + q * 4) = make_float4(e[q * 4] * inv, e[q * 4 + 1] * inv, e[q * 4 + 2] * inv, e[q * 4 + 3] * inv);
    }
    asm volatile("s_waitcnt lgkmcnt(0)" ::: "memory"); __builtin_amdgcn_sched_barrier(0);
    gather_tokens4(p, item * 32 + wave * 4, idxl, gwl, (float*)tab, sigl);
    asm volatile("s_waitcnt lgkmcnt(0)" ::: "memory"); __builtin_amdgcn_sched_barrier(0);
  }
}
DEVI void ph_topk(const Params& p, char* smem) { topk_fast(p, smem); }

DEVI void fp6_sigma(int* sig) {
  f32x16 ra, rb;
#pragma unroll
  for (int i = 0; i < 16; ++i) { ra[i] = i < 8 ? i * 0.125f : 1.f + (i - 8) * 0.125f; rb[i] = i < 8 ? 2.f + i * 0.25f : 4.f + (i - 8) * 0.5f; }
  const u32x6 w = __builtin_amdgcn_cvt_scalef32_2xpk16_fp6_f32(ra, rb, 1.0f);
  const f32x32 d = __builtin_amdgcn_cvt_scalef32_pk32_f32_fp6(w, 1.0f);
  if ((threadIdx.x & 63) == 0) {
#pragma unroll
    for (int i = 0; i < 32; ++i) { const float v = d[i]; sig[i] = v < 1.f ? (int)(v * 8.f + 0.5f) : v < 2.f ? 8 + (int)((v - 1.f) * 8.f + 0.5f) : v < 4.f ? 16 + (int)((v - 2.f) * 4.f + 0.5f) : 24 + (int)((v - 4.f) * 2.f + 0.5f); } }
}
using f32x2 = __attribute__((ext_vector_type(2))) float;
#define DPPF(x, ctrl) __builtin_bit_cast(float, __builtin_amdgcn_update_dpp(0, __builtin_bit_cast(int, (x)), ctrl, 0xf, 0xf, true))
DEVI float reduce_t32(const float (&D)[32], int lane) {
  float S[16];
#pragma unroll
  for (int i = 0; i < 16; ++i) { auto rr = __builtin_amdgcn_permlane16_swap(__float_as_uint(D[i]), __float_as_uint(D[i + 16]), false, false); S[i] = __uint_as_float(rr[0]) + __uint_as_float(rr[1]); }
  const bool b3 = lane & 8, b2 = lane & 4, b1 = lane & 2, b0 = lane & 1;
  float T[8], U[4], V[2];
#pragma unroll
  for (int i = 0; i < 8; ++i) { const float keep = b3 ? S[i + 8] : S[i], send = b3 ? S[i] : S[i + 8]; T[i] = keep + DPPF(send, 0x128); }
#pragma unroll
  for (int i = 0; i < 4; ++i) { const float keep = b2 ? T[i + 4] : T[i], send = b2 ? T[i] : T[i + 4]; U[i] = keep + DPPF(send, 0x141); }
#pragma unroll
  for (int i = 0; i < 2; ++i) { const float keep = b1 ? U[i + 2] : U[i], send = b1 ? U[i] : U[i + 2]; V[i] = keep + DPPF(send, 0x4E); }
  const float keep = b0 ? V[1] : V[0], send = b0 ? V[0] : V[1];
  return keep + DPPF(send, 0xB1);
}
DEVI void gload8(u32x6 (&B)[8], const unsigned char* tab, const int* ids, int g24) {
  const int4 i0 = *(const int4*)ids, i1 = *(const int4*)(ids + 4);
  const int id[8] = {i0.x, i0.y, i0.z, i0.w, i1.x, i1.y, i1.z, i1.w};
#pragma unroll
  for (int j = 0; j < 8; ++j) { const unsigned char* rp = tab + (unsigned)(id[j] * 768 + g24);
    const u32x4 a = *(const u32x4_u*)rp; const u32x2 c = *(const u32x2_u*)(rp + 16); B[j] = (u32x6){a[0], a[1], a[2], a[3], c[0], c[1]}; }
  asm volatile("" ::: "memory"); __builtin_amdgcn_sched_barrier(0);
}
template <int O>
DEVI void gdot8(const u32x6 (&B)[8], const f32x2 (&xp2)[16], float (&D)[32]) {
#pragma unroll
  for (int j = 0; j < 8; ++j) { const f32x32 uf = __builtin_amdgcn_cvt_scalef32_pk32_f32_fp6(B[j], 1.0f); f32x2 da = {0.f, 0.f}, db = {0.f, 0.f};
#pragma unroll
    for (int k = 0; k < 16; k += 2) { da += xp2[k] * (f32x2){uf[2 * k], uf[2 * k + 1]}; db += xp2[k + 1] * (f32x2){uf[2 * k + 2], uf[2 * k + 3]}; }
    da += db; D[O + j] = da[0] + da[1]; asm volatile("" : "+v"(D[O + j]) :: "memory"); __builtin_amdgcn_sched_barrier(0); }
}
DEVI void gaxpy8(const u32x6 (&B)[8], const float* cs, f32x2 (&acc2)[16]) {
  const float4 c0 = *(const float4*)cs, c1 = *(const float4*)(cs + 4);
  const float c[8] = {c0.x, c0.y, c0.z, c0.w, c1.x, c1.y, c1.z, c1.w};
#pragma unroll
  for (int j = 0; j < 8; ++j) { const f32x32 vf = __builtin_amdgcn_cvt_scalef32_pk32_f32_fp6(B[j], 1.0f); const f32x2 cj = {c[j], c[j]};
#pragma unroll
    for (int k = 0; k < 16; ++k) acc2[k] += cj * (f32x2){vf[2 * k], vf[2 * k + 1]};
    asm volatile("" : "+v"(acc2[0]), "+v"(acc2[1]), "+v"(acc2[2]), "+v"(acc2[3]), "+v"(acc2[4]), "+v"(acc2[5]), "+v"(acc2[6]), "+v"(acc2[7]) :: "memory");
    asm volatile("" : "+v"(acc2[8]), "+v"(acc2[9]), "+v"(acc2[10]), "+v"(acc2[11]), "+v"(acc2[12]), "+v"(acc2[13]), "+v"(acc2[14]), "+v"(acc2[15]) :: "memory");
    __builtin_amdgcn_sched_barrier(0); }
}
DEVI void gather_tokens4(const Params& p, int t0, const int* idxw, float* gww, float* xs, const int* sig) {
  int lane = threadIdx.x & 63; asm volatile("" : "+v"(lane));
  const int h = lane >> 5, g = lane & 31, g24 = g * 24;
  const bf16_t* HX2 = (const bf16_t*)(p.ws + O_RB);
  const unsigned char* UT = (const unsigned char*)(p.ws + O_RC); const float* SU = (const float*)(p.ws + O_RC + (size_t)16384 * 1024);
  const unsigned char* VT = (const unsigned char*)(p.ws + O_RA); const float* SV = (const float*)(p.ws + O_RA + (size_t)16384 * 1024);
  const float* MOD = (const float*)(p.ws + O_MOD);
  u32x6 B0[8], B1[8]; u32x4 xr[4];
  gload8(B0, UT, idxw + h * 32, g24);
#pragma unroll
  for (int q = 0; q < 4; ++q) xr[q] = *(const u32x4*)(HX2 + (size_t)t0 * 1024 + g * 32 + q * 8);
#pragma unroll 1
  for (int tl = 0; tl < 4; ++tl) {
    const int t = t0 + tl; const int* idx = idxw + tl * 128; float* gw = gww + tl * 128; const int* idh = idx + h * 32;
    if (h == 0) { float xf[32];
#pragma unroll
      for (int q = 0; q < 4; ++q) unpack8(xr[q], xf + q * 8);
#pragma unroll
      for (int j = 0; j < 32; ++j) xs[j * 32 + g] = xf[j]; }
    asm volatile("s_waitcnt lgkmcnt(0)" ::: "memory"); __builtin_amdgcn_sched_barrier(0);
    f32x2 xp2[16];
#pragma unroll
    for (int i = 0; i < 16; ++i) xp2[i] = (f32x2){xs[sig[2 * i] * 32 + g], xs[sig[2 * i + 1] * 32 + g]};
    const int my_i0 = idx[lane], my_i1 = idx[64 + lane];
    const float su0 = SU[my_i0], sv0 = SV[my_i0], su1 = SU[my_i1], sv1 = SV[my_i1];
    { float D[32];
      gload8(B1, UT, idh + 8, g24);  gdot8<0>(B0, xp2, D);
      gload8(B0, UT, idh + 16, g24); gdot8<8>(B1, xp2, D);
      gload8(B1, UT, idh + 24, g24); gdot8<16>(B0, xp2, D);
      gload8(B0, UT, idh + 64, g24); gdot8<24>(B1, xp2, D);
      { const float val = reduce_t32(D, lane); gw[lane] = gw[lane] * gelu_t(val * su0) * sv0; }
      __builtin_amdgcn_sched_barrier(0);
      gload8(B1, UT, idh + 72, g24); gdot8<0>(B0, xp2, D);
      gload8(B0, UT, idh + 80, g24); gdot8<8>(B1, xp2, D);
      gload8(B1, UT, idh + 88, g24); gdot8<16>(B0, xp2, D);
      gload8(B0, VT, idh, g24);      gdot8<24>(B1, xp2, D);
      { const float val = reduce_t32(D, lane); gw[64 + lane] = gw[64 + lane] * gelu_t(val * su1) * sv1; }
      __builtin_amdgcn_sched_barrier(0); }
    f32x2 acc2[16];
#pragma unroll
    for (int i = 0; i < 16; ++i) acc2[i] = (f32x2){0.f, 0.f};
    const int b = t >> 13, c0 = g * 32 + h * 16;
    float* op = p.out + (size_t)t * 1024 + c0;
    float4 xv[4];
#pragma unroll
    for (int q4 = 0; q4 < 4; ++q4) xv[q4] = *(const float4*)(op + q4 * 4);
    const float* cw = gw + h * 32;
    gload8(B1, VT, idh + 8, g24);  gaxpy8(B0, cw, acc2);
    gload8(B0, VT, idh + 16, g24); gaxpy8(B1, cw + 8, acc2);
    gload8(B1, VT, idh + 24, g24); gaxpy8(B0, cw + 16, acc2);
    gload8(B0, VT, idh + 64, g24); gaxpy8(B1, cw + 24, acc2);
    gload8(B1, VT, idh + 72, g24); gaxpy8(B0, cw + 64, acc2);
    gload8(B0, VT, idh + 80, g24); gaxpy8(B1, cw + 72, acc2);
    gload8(B1, VT, idh + 88, g24); gaxpy8(B0, cw + 80, acc2);
    if (tl < 3) { gload8(B0, UT, idh + 128, g24);
#pragma unroll
      for (int q = 0; q < 4; ++q) xr[q] = *(const u32x4*)(HX2 + (size_t)(t + 1) * 1024 + g * 32 + q * 8); }
    gaxpy8(B1, cw + 88, acc2);
    float acc[32];
#pragma unroll
    for (int i = 0; i < 16; ++i) { acc[2 * i] = acc2[i][0]; acc[2 * i + 1] = acc2[i][1]; }
#pragma unroll
    for (int i = 0; i < 32; ++i) { auto rr = __builtin_amdgcn_permlane32_swap(__float_as_uint(acc[i]), __float_as_uint(acc[i]), false, false); acc[i] = __uint_as_float(rr[0]) + __uint_as_float(rr[1]); }
    if (h == 0) {
#pragma unroll
      for (int i = 0; i < 32; ++i) xs[sig[i] * 32 + g] = acc[i]; }
    asm volatile("s_waitcnt lgkmcnt(0)" ::: "memory"); __builtin_amdgcn_sched_barrier(0);
    float o[16]; float ss = 0.f;
#pragma unroll
    for (int j = 0; j < 16; ++j) { o[j] = xs[(16 * h + j) * 32 + g]; ss += o[j] * o[j]; }
    ss = wave_sum(ss); const float rstd = rsqrtf(ss * (1.f / 1024.f) + EPS);
    const float* gt2 = MOD + b * 6144 + 5120 + c0;
#pragma unroll
    for (int q4 = 0; q4 < 4; ++q4) { float4 x4 = xv[q4]; const float4 gt = *(const float4*)(gt2 + q4 * 4), gp = *(const float4*)(p.g_post2 + c0 + q4 * 4);
      x4.x += gt.x * (o[q4 * 4 + 0] * rstd * gp.x); x4.y += gt.y * (o[q4 * 4 + 1] * rstd * gp.y);
      x4.z += gt.z * (o[q4 * 4 + 2] * rstd * gp.z); x4.w += gt.w * (o[q4 * 4 + 3] * rstd * gp.w);
      *(float4*)(op + q4 * 4) = x4; }
    asm volatile("s_waitcnt lgkmcnt(0)" ::: "memory"); __builtin_amdgcn_sched_barrier(0);
  }
}

#define XB_TMO      128
#define XB_XCNT(j)  (256  + 64 * (j))
#define XB_XSUB(j)  (1280 + 64 * (j))
#define XB_XGEN(j)  (2304 + 64 * (j))
#define XB_TOP      3328
#define XB_TOPGEN   3392
#define XCD_BAR_WORDS 3456
#define XB_SPIN_CAP (1u << 18)
#define LAS __attribute__((address_space(3)))
DEVI unsigned xb_ld(unsigned* p)              { return __hip_atomic_load(p, __ATOMIC_RELAXED, __HIP_MEMORY_SCOPE_AGENT); }
DEVI unsigned xb_add(unsigned* p, unsigned v) { return __hip_atomic_fetch_add(p, v, __ATOMIC_RELAXED, __HIP_MEMORY_SCOPE_AGENT); }
DEVI unsigned xb_xcc_id() { return (unsigned)__builtin_amdgcn_s_getreg((3 << 11) | 20) & 0xFu; }
#define XB_SPIN(cond, bar) do { unsigned _sp = 0; while (cond) { __builtin_amdgcn_s_sleep(1); \
    if ((++_sp & 255u) == 0u) { if (xb_ld(&(bar)[XB_TMO])) break; if (_sp > XB_SPIN_CAP) { atomicAdd(&(bar)[XB_TMO], 1u); break; } } } } while (0)
struct XcdBarrier { unsigned* bar; unsigned x; volatile LAS unsigned* st; };
DEVI XcdBarrier xcd_barrier_post(unsigned* bar, volatile LAS unsigned* st) {
  XcdBarrier b; b.bar = bar; b.x = xb_xcc_id(); b.st = st;
  if (threadIdx.x == 0) (void)xb_add(&bar[XB_XCNT(b.x)], 1u);
  return b;
}
DEVI void xcd_barrier_complete(unsigned* bar, unsigned x, unsigned& nloc, unsigned& nx) {
  const unsigned G = gridDim.x * gridDim.y * gridDim.z;
  unsigned sum, cnt, mine, sp = 0u;
  for (;;) {
    sum = 0u; cnt = 0u; mine = 0u;
#pragma unroll
    for (unsigned j = 0; j < 16; ++j) { const unsigned c = xb_ld(&bar[XB_XCNT(j)]); sum += c; cnt += (c > 0u) ? 1u : 0u; mine = (j == x) ? c : mine; }
    if (sum == G) break;
    __builtin_amdgcn_s_sleep(1);
    if ((++sp & 255u) == 0u) { if (xb_ld(&bar[XB_TMO])) break; if (sp > XB_SPIN_CAP) { atomicAdd(&bar[XB_TMO], 1u); break; } }
  }
  nloc = mine > 0u ? mine : 1u; nx = cnt > 0u ? cnt : 1u;
}
DEVI void xcd_barrier(const XcdBarrier& b) {
  asm volatile("s_waitcnt vmcnt(0)" ::: "memory");
  __syncthreads();
  if (threadIdx.x == 0) {
    unsigned* bar = b.bar;
    __builtin_amdgcn_s_waitcnt(0);
    unsigned nloc = b.st[0], nx = b.st[1];
    if (nloc == 0u) { xcd_barrier_complete(bar, b.x, nloc, nx); b.st[0] = nloc; b.st[1] = nx; }
    const unsigned old = xb_add(&bar[XB_XSUB(b.x)], 1u);
    const unsigned gen = old / nloc;
    if (old + 1u == (gen + 1u) * nloc) {
      __builtin_amdgcn_fence(__ATOMIC_RELEASE, "agent");
      asm volatile("s_waitcnt vmcnt(0)" ::: "memory");
      const unsigned og = xb_add(&bar[XB_TOP], 1u);
      const unsigned tg = og / nx;
      if (og + 1u == (tg + 1u) * nx) xb_add(&bar[XB_TOPGEN], 1u);
      else XB_SPIN(xb_ld(&bar[XB_TOPGEN]) == tg, bar);
      __builtin_amdgcn_fence(__ATOMIC_ACQUIRE, "agent");
      xb_add(&bar[XB_XGEN(b.x)], 1u);
      asm volatile("s_waitcnt vmcnt(0)" ::: "memory");
    } else {
      XB_SPIN(xb_ld(&bar[XB_XGEN(b.x)]) == gen, bar);
      __builtin_amdgcn_fence(__ATOMIC_ACQUIRE, "agent");
      asm volatile("s_waitcnt vmcnt(0)" ::: "memory");
    }
  }
  __syncthreads();
}

constexpr int NPHASE = 11;
template <int PH> DEVI void run_phase(const Params& p, char* smem) {
  if constexpr (PH == 0) ph_prep(p, smem);
  else if constexpr (PH == 1) ph_hx(p, smem);
  else if constexpr (PH == 2) ph_inproj(p, smem);
  else if constexpr (PH == 3) ph_mid(p, smem);
  else if constexpr (PH == 4) ph_attn(p, smem);
  else if constexpr (PH == 5) ph_gates(p, smem);
  else if constexpr (PH == 6) ph_merge(p, smem);
  else if constexpr (PH == 7) ph_wo(p, smem);
  else if constexpr (PH == 8) ph_rows(p, smem);
  else if constexpr (PH == 9) ph_wpq(p, smem);
  else if constexpr (PH == 10) ph_topk(p, smem);
}

#define RUNPH(N) do { run_phase<N>(p, smem); if (N < NPHASE - 1) xcd_barrier(xb); } while (0)
__global__ __launch_bounds__(NTHR) void k_mega(Params p) {
  extern __shared__ __attribute__((aligned(16))) char smem[];
  cg::grid_group grid = cg::this_grid();
  unsigned* bar = (unsigned*)(p.ws + O_BAR);
  volatile LAS unsigned* xst = (volatile LAS unsigned*)(smem + LDS_BYTES - 16);
  if (threadIdx.x == 0) { xst[0] = 0u; xst[1] = 0u; }
  __syncthreads();
  const XcdBarrier xb = xcd_barrier_post(bar, xst);
  if (p.out == nullptr) grid.sync();
  RUNPH(0);
  RUNPH(1); RUNPH(2); RUNPH(3); RUNPH(4); RUNPH(5); RUNPH(6); RUNPH(7); RUNPH(8); RUNPH(9); RUNPH(10);
}

extern "C" void kernel_launch(void* const* d_in, const int* in_sizes, int n_in, void* d_out, int out_size, void* d_ws, size_t ws_size, hipStream_t stream) {
  static int grid = 0;
  if (grid == 0) {
    if (n_in != 26 || out_size != NTOK * DM || ws_size < O_END) { fprintf(stderr, "kernel_launch: unexpected shapes n_in %d out %d ws %zu (need %zu)\n", n_in, out_size, ws_size, (size_t)O_END); grid = -1; return; }
    (void)hipFuncSetAttribute((const void*)k_mega, hipFuncAttributeMaxDynamicSharedMemorySize, LDS_BYTES);
    int dev = 0, cus = 0, per_cu = 0; (void)hipGetDevice(&dev); (void)hipDeviceGetAttribute(&cus, hipDeviceAttributeMultiprocessorCount, dev);
    (void)hipOccupancyMaxActiveBlocksPerMultiprocessor(&per_cu, (const void*)k_mega, NTHR, LDS_BYTES);
    if (per_cu < 1) { fprintf(stderr, "kernel_launch: occupancy query says %d blocks per CU\n", per_cu); grid = -1; return; }
    grid = cus;
  }
  if (grid < 0) return;
  Params p{};
  const float** pp = (const float**)&p;
  for (int i = 0; i < 26; ++i) pp[i] = (const float*)d_in[i];
  p.out = (float*)d_out; p.ws = (char*)d_ws;
  (void)hipMemsetAsync((char*)d_ws + O_BAR, 0, (size_t)XCD_BAR_WORDS * 4, stream);
  void* args[] = {&p};
  hipError_t e = hipLaunchCooperativeKernel((const void*)k_mega, dim3(grid), dim3(NTHR), args, LDS_BYTES, stream);
  if (e != hipSuccess) fprintf(stderr, "cooperative launch failed: %s (grid %d)\n", hipGetErrorString(e), grid);
}
```

```cpp
#include <hip/hip_runtime.h>
#include <hip/hip_cooperative_groups.h>
#include <cstdint>
#include <cstdio>
namespace cg = cooperative_groups;

#define DEVI __device__ __forceinline__
typedef unsigned short bf16_t;
using bf16x8 = __attribute__((ext_vector_type(8))) short;
using bf16x4 = __attribute__((ext_vector_type(4))) short;
using f32x4  = __attribute__((ext_vector_type(4))) float;
using f32x16 = __attribute__((ext_vector_type(16))) float;
using u32x4  = __attribute__((ext_vector_type(4))) unsigned;
using u32x2  = __attribute__((ext_vector_type(2))) unsigned;

constexpr int DM = 1024, NB = 2, SEQ = 8192, NTOK = NB * SEQ, CTXL = 256, NCTX = NB * CTXL, NROW = NTOK + NCTX, NKEY = SEQ + CTXL;
constexpr int INW = 4544, INWP = 4608;
constexpr int NPRE = 2560;
constexpr float EPS = 1e-6f;
constexpr int NTHR = 512, NWAVE = 8;
constexpr int LDS_BYTES = 147456;

constexpr size_t al256(size_t x) { return (x + 255) / 256 * 256; }
constexpr size_t O_WIN   = 0;
constexpr size_t O_WUQ   = O_WIN  + al256((size_t)INWP * 1024 * 2);
constexpr size_t O_WUKV  = O_WUQ  + al256((size_t)1536 * 256 * 2);
constexpr size_t O_WPA   = O_WUKV + al256((size_t)2048 * 128 * 2);
constexpr size_t O_WPB   = O_WPA  + al256((size_t)1024 * 1024 * 2);
constexpr size_t O_WO    = O_WPB  + al256((size_t)1024 * 1024 * 2);
constexpr size_t O_WPQ   = O_WO   + al256((size_t)1024 * 1024 * 2);
constexpr size_t O_WS    = O_WPQ  + al256((size_t)2048 * 1024 * 2);
constexpr size_t O_K1    = O_WS   + al256((size_t)8 * 128 * 128 * 2);
constexpr size_t O_K2    = O_K1   + al256((size_t)128 * 128 * 2);
constexpr size_t O_MOD   = O_K2   + al256((size_t)128 * 128 * 2);
constexpr size_t O_ROPE  = O_MOD  + al256((size_t)3 * 6144 * 4);
constexpr size_t O_BAR   = O_ROPE + al256((size_t)128 * 16 * 2 * 4);
constexpr size_t O_RSSV  = O_BAR + al256((size_t)3456 * 4);
constexpr size_t O_RSSQ  = O_RSSV + (size_t)NTOK * 32 * 4;
constexpr size_t O_RSSKV = O_RSSQ + (size_t)NTOK * 8 * 4;
constexpr size_t O_RSSY  = O_RSSKV + (size_t)NROW * 4 * 4;
constexpr size_t O_RSSEND = O_RSSY + (size_t)NTOK * 32 * 4;
constexpr size_t O_RA    = al256(O_RSSEND);
constexpr size_t O_RB    = O_RA  + al256((size_t)NROW * 1024 * 2);
constexpr size_t O_RC    = O_RB  + al256((size_t)NTOK * 1024 * 2);
constexpr size_t O_CQ    = O_RC  + al256((size_t)NTOK * 1024 * 2);
constexpr size_t O_CKV   = O_CQ  + al256((size_t)NTOK * 256 * 2);
constexpr size_t O_KR    = O_CKV + al256((size_t)NROW * 128 * 2);
constexpr size_t O_RQ    = O_KR  + al256((size_t)NROW * 64 * 2);
constexpr size_t O_RKV   = O_RQ  + al256((size_t)NTOK * 1536 * 2);
constexpr size_t O_END   = O_RKV + al256((size_t)NROW * 2048 * 2);
static_assert(O_END <= (size_t)258 * 1024 * 1024, "workspace too large");

struct Params {
  const float *x, *c, *ctx, *c_ctx, *w_mod, *b_mod, *g_pre1, *g_post1, *g_pre2, *g_post2, *w_in, *g_q, *g_kv, *w_uq, *w_ukv, *g_sgu, *w_s, *b_s,
      *w_pa, *w_pb, *w_o, *w_pq, *k1, *k2, *u_exp, *v_exp;
  float* out; char* ws;
};

DEVI float bf2f(unsigned short h) { return __uint_as_float(((unsigned)h) << 16); }
DEVI unsigned short f2bf(float f) { unsigned u = __float_as_uint(f); u += 0x7fffu + ((u >> 16) & 1u); return (unsigned short)(u >> 16); }
typedef __bf16 bf16x2_t __attribute__((ext_vector_type(2)));
typedef float f32x2v_t __attribute__((ext_vector_type(2)));
DEVI unsigned pack2(float a, float b) { const f32x2v_t v = {a, b}; return __builtin_bit_cast(unsigned, __builtin_convertvector(v, bf16x2_t)); }
DEVI float lo2f(unsigned w) { return __uint_as_float(w << 16); }
DEVI float hi2f(unsigned w) { return __uint_as_float(w & 0xffff0000u); }
DEVI void unpack8(const u32x4& w, float* f) {
  f[0] = lo2f(w[0]); f[1] = hi2f(w[0]); f[2] = lo2f(w[1]); f[3] = hi2f(w[1]); f[4] = lo2f(w[2]); f[5] = hi2f(w[2]); f[6] = lo2f(w[3]); f[7] = hi2f(w[3]);
}
DEVI float gelu_t(float x) { const float z = 0.7978845608028654f * (x + 0.044715f * x * x * x); return x * __builtin_amdgcn_rcpf(1.f + __expf(-2.f * z)); }
DEVI float sigmoidf_(float x) { return __builtin_amdgcn_rcpf(1.f + __expf(-x)); }
DEVI float wave_sum(float v) { for (int o = 32; o > 0; o >>= 1) v += __shfl_xor(v, o); return v; }
DEVI float wave_max(float v) { for (int o = 32; o > 0; o >>= 1) v = fmaxf(v, __shfl_xor(v, o)); return v; }
DEVI void keyrow2(int row, int& b, int& key) { if (row < NTOK) { b = row >> 13; key = row & 8191; } else { const int c = row - NTOK; b = c >> 8; key = SEQ + (c & 255); } }
DEVI int keyrow(int row) { if (row < NTOK) return (row >> 13) * NKEY + (row & 8191); int c = row - NTOK; return (c >> 8) * NKEY + SEQ + (c & 255); }

__device__ const float ROPE_FREQ[16] = {1.0f, 0.5623413324356079f, 0.3162277638912201f, 0.17782793939113617f, 0.10000000149011612f, 0.05623413249850273f, 0.03162277489900589f, 0.017782794311642647f, 0.009999999776482582f, 0.005623413249850273f, 0.003162277629598975f, 0.0017782794311642647f, 0.0010000000474974513f, 0.000562341301701963f, 0.0003162277571391314f, 0.00017782794020604342f};
DEVI void sincos_small(double a, double& cs, double& sn) {
  const double k = rint(a * 0.15915494309189535); const double r = fma(-k, 6.283185307179586, a) - k * 2.4492935982947064e-16;
  const double r2 = r * r; double s = 0.0, c = 0.0;
#pragma unroll
  for (int n = 12; n >= 1; --n) { s = (1.0 - s * r2 / (double)((2 * n) * (2 * n + 1))); c = (1.0 - c * r2 / (double)((2 * n - 1) * (2 * n))); }
  sn = r * s; cs = c;
}

DEVI void transpose_job(const float* __restrict__ src, int K, int N, bf16_t* __restrict__ dst, const float* __restrict__ gk, bool isWin, int ntiles, char* smem) {
  const int tid = threadIdx.x; bf16_t* tl = (bf16_t*)smem; const int kt = K / 64;
  for (int idx = blockIdx.x; idx < ntiles; idx += gridDim.x) {
    const int ktile = idx % kt, ntile = idx / kt, k0 = ktile * 64, n0d = ntile * 64;
    int n0s = n0d; bool zero = false;
    if (isWin) { if (n0d == 2496) zero = true; else if (n0d >= 2560) n0s = n0d - 64; }
    { const int kk = tid >> 3, nn8 = (tid & 7) * 8; f32x4 va = {0.f, 0.f, 0.f, 0.f}, vb = va;
      if (!zero) { const float* s = src + (size_t)(k0 + kk) * N + n0s + nn8; const float4 a = *(const float4*)s, b = *(const float4*)(s + 4);
        const float sc = gk ? gk[k0 + kk] : 1.f; va = (f32x4){a.x, a.y, a.z, a.w} * sc; vb = (f32x4){b.x, b.y, b.z, b.w} * sc; }
      bf16_t* tp = tl + nn8 * 72 + kk;
      tp[0] = f2bf(va[0]); tp[72] = f2bf(va[1]); tp[144] = f2bf(va[2]); tp[216] = f2bf(va[3]); tp[288] = f2bf(vb[0]); tp[360] = f2bf(vb[1]); tp[432] = f2bf(vb[2]); tp[504] = f2bf(vb[3]); }
    __syncthreads();
    { const int nn = tid >> 3, kk8 = (tid & 7) * 8;
      const u32x4 o = *(const u32x4*)(tl + nn * 72 + kk8);
      *(u32x4*)(dst + (size_t)(n0d + nn) * K + k0 + kk8) = o; }
    __syncthreads();
  }
}

DEVI void ph_prep(const Params& p, char* smem) {
  const int tid = threadIdx.x, bid = blockIdx.x, nb = gridDim.x;
  char* ws = p.ws;
  if (bid == 0) { float* rope = (float*)(ws + O_ROPE);
    for (int i = tid; i < 128 * 16; i += NTHR) { const int pos = i >> 4, f = i & 15; const float ang = (float)pos * ROPE_FREQ[f];
      double cs, sn; sincos_small((double)ang, cs, sn); rope[i * 2] = (float)cs; rope[i * 2 + 1] = (float)sn; } }
  { float* red = (float*)smem; float* MOD = (float*)(ws + O_MOD);
    for (int it = bid; it < 256; it += nb) {
      const int cgp = tid % 6, kg = tid / 6;
      f32x4 a0 = {0.f, 0.f, 0.f, 0.f}, a1 = a0, a2 = a0;
      if (tid < 510) {
        for (int k = kg; k < 1024; k += 85) {
          const float4 w4 = *(const float4*)(p.w_mod + (size_t)k * 6144 + it * 24 + cgp * 4);
          const f32x4 w = {w4.x, w4.y, w4.z, w4.w};
          const float c0 = p.c[k], c1 = p.c[1024 + k], c2 = p.c_ctx[k];
          a0 += w * (c0 / (1.f + __expf(-c0))); a1 += w * (c1 / (1.f + __expf(-c1))); a2 += w * (c2 / (1.f + __expf(-c2)));
        }
        float* rp = red + kg * 72 + cgp * 4;
        rp[0] = a0[0]; rp[1] = a0[1]; rp[2] = a0[2]; rp[3] = a0[3];
        rp[24] = a1[0]; rp[25] = a1[1]; rp[26] = a1[2]; rp[27] = a1[3];
        rp[48] = a2[0]; rp[49] = a2[1]; rp[50] = a2[2]; rp[51] = a2[3];
      }
      __syncthreads();
      if (tid < 72) { float s = 0.f; for (int g = 0; g < 85; ++g) s += red[g * 72 + tid]; int r = tid / 24, n = it * 24 + tid % 24; MOD[r * 6144 + n] = s + p.b_mod[n]; }
      __syncthreads();
    } }
  transpose_job(p.w_in,  1024, INW,  (bf16_t*)(ws + O_WIN),  nullptr, true,  1152, smem);
  transpose_job(p.w_uq,  256,  1536, (bf16_t*)(ws + O_WUQ),  p.g_q,   false, 96,   smem);
  transpose_job(p.w_ukv, 128,  2048, (bf16_t*)(ws + O_WUKV), p.g_kv,  false, 64,   smem);
  transpose_job(p.w_pa,  1024, 1024, (bf16_t*)(ws + O_WPA),  nullptr, false, 256,  smem);
  transpose_job(p.w_pb,  1024, 1024, (bf16_t*)(ws + O_WPB),  nullptr, false, 256,  smem);
  transpose_job(p.w_o,   1024, 1024, (bf16_t*)(ws + O_WO),   nullptr, false, 256,  smem);
  transpose_job(p.w_pq,  1024, 2048, (bf16_t*)(ws + O_WPQ),  nullptr, false, 512,  smem);
  { const int n8 = (131072 + 16384 + 16384) / 8;
    for (int i = bid * NTHR + tid; i < n8; i += nb * NTHR) {
      int e = i * 8; const float* s; bf16_t* d;
      if (e < 131072) { s = p.w_s + e; d = (bf16_t*)(ws + O_WS) + e; }
      else if (e < 131072 + 16384) { s = p.k1 + (e - 131072); d = (bf16_t*)(ws + O_K1) + (e - 131072); }
      else { s = p.k2 + (e - 131072 - 16384); d = (bf16_t*)(ws + O_K2) + (e - 131072 - 16384); }
      const float4 a = *(const float4*)s, b = *(const float4*)(s + 4);
      u32x4 o = {pack2(a.x, a.y), pack2(a.z, a.w), pack2(b.x, b.y), pack2(b.z, b.w)};
      *(u32x4*)d = o;
    } }
}


using f32x32 = __attribute__((ext_vector_type(32))) float;
using u32x6 = __attribute__((ext_vector_type(6))) unsigned;
typedef u32x4 __attribute__((aligned(4))) u32x4_u;
typedef u32x2 __attribute__((aligned(4))) u32x2_u;
DEVI void convert_table_fp6(const float* __restrict__ src, unsigned char* __restrict__ dst, float* __restrict__ scale) {
  const int wave = threadIdx.x >> 6, lane = threadIdx.x & 63, h = lane >> 5, g = lane & 31;
  for (int rp = blockIdx.x * NWAVE + wave; rp < 8192; rp += gridDim.x * NWAVE) {
    const int row = rp * 2 + h;
    const float* sp = src + (size_t)row * 1024 + g * 32;
    f32x16 a, b; float am = 0.f;
#pragma unroll
    for (int j = 0; j < 4; ++j) { const float4 t = *(const float4*)(sp + j * 4), u = *(const float4*)(sp + 16 + j * 4);
      a[j * 4] = t.x; a[j * 4 + 1] = t.y; a[j * 4 + 2] = t.z; a[j * 4 + 3] = t.w; b[j * 4] = u.x; b[j * 4 + 1] = u.y; b[j * 4 + 2] = u.z; b[j * 4 + 3] = u.w;
      am = fmaxf(am, fmaxf(fmaxf(fmaxf(fabsf(t.x), fabsf(t.y)), fmaxf(fabsf(t.z), fabsf(t.w))), fmaxf(fmaxf(fabsf(u.x), fabsf(u.y)), fmaxf(fabsf(u.z), fabsf(u.w))))); }
    for (int o = 16; o > 0; o >>= 1) am = fmaxf(am, __shfl_xor(am, o));
    const float inv = am > 0.f ? 7.5f / am : 0.f;
    const u32x6 w = __builtin_amdgcn_cvt_scalef32_2xpk16_fp6_f32(a * inv, b * inv, 1.0f);
    unsigned char* dp = dst + (size_t)row * 768 + g * 24;
    *(u32x4_u*)dp = (u32x4){w[0], w[1], w[2], w[3]}; *(u32x2_u*)(dp + 16) = (u32x2){w[4], w[5]};
    if (g == 0) scale[row] = am * (1.f / 7.5f);
  }
}

DEVI void ph_hx(const Params& p, char* smem) {
  const int tid = threadIdx.x, wave = tid >> 6, lane = tid & 63;
  float* mA = (float*)smem; float* mB = mA + 3 * 1024;
  const float* MOD = (const float*)(p.ws + O_MOD);
  for (int i = tid; i < 3072; i += NTHR) { int r = i >> 10, c = i & 1023; mA[i] = p.g_pre1[c] * (1.f + MOD[r * 6144 + 1024 + c]); mB[i] = MOD[r * 6144 + c]; }
  __syncthreads();
  bf16_t* HX = (bf16_t*)(p.ws + O_RA);
  for (int row = blockIdx.x * NWAVE + wave; row < NROW; row += gridDim.x * NWAVE) {
    const float* src = row < NTOK ? p.x + (size_t)row * 1024 : p.ctx + (size_t)(row - NTOK) * 1024;
    const int mr = row < NTOK ? (row >> 13) : 2;
    float4 v[4]; float ss = 0.f;
#pragma unroll
    for (int i = 0; i < 4; ++i) { v[i] = *(const float4*)(src + i * 256 + lane * 4); ss += v[i].x * v[i].x + v[i].y * v[i].y + v[i].z * v[i].z + v[i].w * v[i].w; }
    ss = wave_sum(ss); const float rstd = rsqrtf(ss * (1.f / 1024.f) + EPS);
#pragma unroll
    for (int i = 0; i < 4; ++i) { const int c = i * 256 + lane * 4; const float* a = mA + mr * 1024 + c; const float* b = mB + mr * 1024 + c;
      u32x2 o = {pack2(v[i].x * rstd * a[0] + b[0], v[i].y * rstd * a[1] + b[1]), pack2(v[i].z * rstd * a[2] + b[2], v[i].w * rstd * a[3] + b[3])};
      *(u32x2*)(HX + (size_t)row * 1024 + c) = o; }
  }
}

DEVI int lds_sw(int row, int c) { return row * 128 + ((c ^ (row & 7)) << 4); }
template <int BM, int BN, bool ACOLMAP, bool GLDS, class Epi>
DEVI void gemm_tile_mfma(const bf16_t* __restrict__ A, int lda, const bf16_t* __restrict__ Bm, int ldb, int K, int row0, int col0, const Epi& epi, const float* kscale, char* smem) {
  constexpr int WNW = BN / 64, WMW = 8 / WNW, WTM = BM / WMW, MI = WTM / 16, ACH = BM / 64, BCH = BN / 64, ABYTES = BM * 128, BBYTES = BN * 128, STAGE = ABYTES + BBYTES;
  int tid = threadIdx.x; asm volatile("" : "+v"(tid));
  const int wave = __builtin_amdgcn_readfirstlane(tid >> 6), lane = tid & 63, wm = wave / WNW, wn = wave % WNW, l15 = lane & 15, lq = lane >> 4;
  f32x4 acc[MI][4];
#pragma unroll
  for (int mi = 0; mi < MI; ++mi)
#pragma unroll
    for (int ni = 0; ni < 4; ++ni) acc[mi][ni] = (f32x4){0.f, 0.f, 0.f, 0.f};
  const int nk = K >> 6;
  const int sr = tid >> 3, scc = tid & 7;
  auto compute = [&](int buf) {
    const char* sa = smem + buf * STAGE; const char* sb = sa + ABYTES;
#pragma unroll
    for (int ks = 0; ks < 2; ++ks) { const int kc = ks * 4 + lq; bf16x8 bfr[4];
#pragma unroll
      for (int ni = 0; ni < 4; ++ni) bfr[ni] = *(const bf16x8*)(sb + lds_sw(wn * 64 + ni * 16 + l15, kc));
#pragma unroll
      for (int mi = 0; mi < MI; ++mi) { const bf16x8 af = *(const bf16x8*)(sa + lds_sw(wm * WTM + mi * 16 + l15, kc));
#pragma unroll
        for (int ni = 0; ni < 4; ++ni) acc[mi][ni] = __builtin_amdgcn_mfma_f32_16x16x32_bf16(bfr[ni], af, acc[mi][ni], 0, 0, 0); }
    }
  };
  if constexpr (GLDS) {
    const unsigned aoff = (unsigned)(sr * lda + ((scc ^ (sr & 7)) * 8)) * 2u, boff = (unsigned)(sr * ldb + ((scc ^ (sr & 7)) * 8)) * 2u;
    auto gstage = [&](int buf, int kt) {
      const int k0 = kt * 64, ka = ACOLMAP ? k0 + (k0 >> 7) * 64 : k0;
      char* sa = smem + buf * STAGE + wave * 1024; char* sb = sa + ABYTES;
#pragma unroll
      for (int i = 0; i < ACH; ++i) __builtin_amdgcn_global_load_lds((const unsigned*)((const char*)(A + (size_t)(64 * i) * lda + ka) + aoff), (unsigned*)(sa + i * 8192), 16, 0, 0);
#pragma unroll
      for (int i = 0; i < BCH; ++i) __builtin_amdgcn_global_load_lds((const unsigned*)((const char*)(Bm + (size_t)(64 * i) * ldb + k0) + boff), (unsigned*)(sb + i * 8192), 16, 0, 0);
    };
    gstage(0, 0); asm volatile("s_waitcnt vmcnt(0)" ::: "memory"); __syncthreads();
    for (int kt = 0; kt < nk; ++kt) {
      if (kt + 1 < nk) gstage((kt + 1) & 1, kt + 1);
      compute(kt & 1);
      asm volatile("s_waitcnt vmcnt(0)" ::: "memory"); __syncthreads();
    }
  } else {
    u32x4 ra[ACH], rb[BCH];
    const unsigned aoff = (unsigned)(sr * lda + scc * 8) * 2u, boff = (unsigned)(sr * ldb + scc * 8) * 2u;
    const int sdst = lds_sw(sr, scc);
    auto gload = [&](int kt) {
      const int k0 = kt * 64, ka = ACOLMAP ? k0 + (k0 >> 7) * 64 : k0;
#pragma unroll
      for (int i = 0; i < ACH; ++i) { const char* ub = (const char*)(A + (size_t)(64 * i) * lda + ka); ra[i] = *(const u32x4*)(ub + aoff); }
#pragma unroll
      for (int i = 0; i < BCH; ++i) { const char* ub = (const char*)(Bm + (size_t)(64 * i) * ldb + k0); rb[i] = *(const u32x4*)(ub + boff); }
    };
    auto lstore = [&](int buf, int kt) {
      char* sa = smem + buf * STAGE + sdst; char* sb = sa + ABYTES;
#pragma unroll
      for (int i = 0; i < ACH; ++i) { u32x4 v = ra[i];
        if (kscale) { float f[8]; unpack8(v, f); const float* ks = kscale + kt * 64 + scc * 8;
          v = (u32x4){pack2(f[0] * ks[0], f[1] * ks[1]), pack2(f[2] * ks[2], f[3] * ks[3]), pack2(f[4] * ks[4], f[5] * ks[5]), pack2(f[6] * ks[6], f[7] * ks[7])}; }
        *(u32x4*)(sa + i * 8192) = v; }
#pragma unroll
      for (int i = 0; i < BCH; ++i) *(u32x4*)(sb + i * 8192) = rb[i];
    };
    gload(0); lstore(0, 0); __syncthreads();
    for (int kt = 0; kt < nk; ++kt) {
      if (kt + 1 < nk) gload(kt + 1);
      compute(kt & 1);
      if (kt + 1 < nk) lstore((kt + 1) & 1, kt + 1);
      __syncthreads();
    }
  }
  int tide = threadIdx.x; asm volatile("" : "+v"(tide));
  const int l15e = tide & 15, lqe = (tide >> 4) & 3;
  float cs[4][4];
  if constexpr (Epi::SCALE_MODE == 2) {
#pragma unroll
    for (int ni = 0; ni < 4; ++ni)
#pragma unroll
      for (int j = 0; j < 4; ++j) cs[ni][j] = epi.colscale(col0 + wn * 64 + ni * 16 + lqe * 4 + j); }
#pragma unroll
  for (int mi = 0; mi < MI; ++mi) { const int row = row0 + wm * WTM + mi * 16 + l15e; float sq = 0.f; float rs = 1.f;
    if constexpr (Epi::SCALE_MODE == 1) rs = epi.rowscale(row);
#pragma unroll
    for (int ni = 0; ni < 4; ++ni) { float v[4] = {acc[mi][ni][0], acc[mi][ni][1], acc[mi][ni][2], acc[mi][ni][3]};
      if constexpr (Epi::SCALE_MODE == 1) { v[0] *= rs; v[1] *= rs; v[2] *= rs; v[3] *= rs; }
      if constexpr (Epi::SCALE_MODE == 2) { v[0] *= cs[ni][0]; v[1] *= cs[ni][1]; v[2] *= cs[ni][2]; v[3] *= cs[ni][3]; }
      const float q = epi(row, col0 + wn * 64 + ni * 16 + lqe * 4, v);
      if (Epi::RSS) { sq += q; if (ni & 1) { sq += __shfl_xor(sq, 16); sq += __shfl_xor(sq, 32); if (lqe == 0) epi.rss(row, col0 + wn * 64 + (ni >> 1) * 32, sq); sq = 0.f; } } }
    __builtin_amdgcn_sched_barrier(0); }
}


namespace g8 {
constexpr int BK = 64, HALF = 128, HT = HALF * BK;
DEVI int lds_byte(int r, int c) { const int st = (r >> 4) * 2 + (c >> 5), rr = r & 15, cc = c & 31, ob = rr * 64 + cc * 2; return st * 1024 + (ob ^ (((ob >> 9) & 1) << 5)); }
DEVI void stage_rc(int b, int& R, int& C) { const int st = b / 1024, sb = b % 1024, swz = sb ^ (((sb >> 9) & 1) << 5); R = (st >> 1) * 16 + swz / 64; C = (st & 1) * 32 + (swz % 64) / 2; }
}
template <bool ACOLMAP, class Epi>
DEVI void gemm_tile_8ph(const bf16_t* __restrict__ A, int lda, const bf16_t* __restrict__ Bt, int ldb, int K, int row0, int col0, const Epi& epi, char* smem) {
  using namespace g8;
  bf16_t* shm = (bf16_t*)smem;
#define SA(b, h) (shm + ((b) * 2 + (h)) * HT)
#define SB(b, h) (shm + (4 + (b) * 2 + (h)) * HT)
#define STAGE_A(P, r0, kt) do { const int _k0 = (kt) * BK, _ka = ACOLMAP ? _k0 + (_k0 >> 7) * 64 : _k0; \
    __builtin_amdgcn_global_load_lds((const unsigned*)((const char*)(A + (size_t)(r0) * lda + _ka) + ao0), (unsigned*)((char*)(P) + wid * 1024), 16, 0, 0); \
    __builtin_amdgcn_global_load_lds((const unsigned*)((const char*)(A + (size_t)((r0) + 64) * lda + _ka) + ao0), (unsigned*)((char*)(P) + wid * 1024 + 8192), 16, 0, 0); } while (0)
#define STAGE_B(P, r0, kt) do { const int _k0 = (kt) * BK; \
    __builtin_amdgcn_global_load_lds((const unsigned*)((const char*)(Bt + (size_t)(r0) * ldb + _k0) + bo0), (unsigned*)((char*)(P) + wid * 1024), 16, 0, 0); \
    __builtin_amdgcn_global_load_lds((const unsigned*)((const char*)(Bt + (size_t)((r0) + 64) * ldb + _k0) + bo0), (unsigned*)((char*)(P) + wid * 1024 + 8192), 16, 0, 0); } while (0)
#define LDA(dst, b, h) _Pragma("unroll") for (int m = 0; m < 4; ++m) _Pragma("unroll") for (int k = 0; k < 2; ++k) \
    dst[m][k] = *reinterpret_cast<const bf16x8*>((const char*)SA(b, h) + lds_byte(wr * 64 + m * 16 + fr, k * 32 + fq * 8))
#define LDB(dst, b, h) _Pragma("unroll") for (int n = 0; n < 2; ++n) _Pragma("unroll") for (int k = 0; k < 2; ++k) \
    dst[n][k] = *reinterpret_cast<const bf16x8*>((const char*)SB(b, h) + lds_byte(wc * 32 + n * 16 + fr, k * 32 + fq * 8))
#define MMA(ai, bj, At_, Bt_) do { __builtin_amdgcn_s_setprio(1); \
    _Pragma("unroll") for (int m = 0; m < 4; ++m) _Pragma("unroll") for (int n = 0; n < 2; ++n) _Pragma("unroll") for (int k = 0; k < 2; ++k) \
      acc[ai][bj][m][n] = __builtin_amdgcn_mfma_f32_16x16x32_bf16(Bt_[n][k], At_[m][k], acc[ai][bj][m][n], 0, 0, 0); \
    __builtin_amdgcn_s_setprio(0); } while (0)
#define WAIT_V(n) asm volatile("s_waitcnt vmcnt(" #n ")" ::: "memory")
#define WAIT_L(n) asm volatile("s_waitcnt lgkmcnt(" #n ")" ::: "memory")
#define BAR __builtin_amdgcn_s_barrier()
#define SCHED __builtin_amdgcn_sched_barrier(0)
  int tid = threadIdx.x; asm volatile("" : "+v"(tid));
  const int wid = __builtin_amdgcn_readfirstlane(tid >> 6), lane = tid & 63, wr = wid >> 2, wc = wid & 3, fr = lane & 15, fq = lane >> 4;
  unsigned ao0, bo0;
  { int r, c; stage_rc(tid * 16, r, c); ao0 = (unsigned)(r * lda + c) * 2u; bo0 = (unsigned)(r * ldb + c) * 2u; }
  f32x4 acc[2][2][4][2];
#pragma unroll
  for (int a = 0; a < 2; ++a)
#pragma unroll
    for (int b = 0; b < 2; ++b)
#pragma unroll
      for (int m = 0; m < 4; ++m)
#pragma unroll
        for (int n = 0; n < 2; ++n) acc[a][b][m][n] = (f32x4){0.f, 0.f, 0.f, 0.f};
  bf16x8 At[4][2], B0[2][2], B1[2][2];
  const int nt = K / BK;
  STAGE_B(SB(0, 0), 0, 0); STAGE_A(SA(0, 0), 0, 0);
  STAGE_B(SB(0, 1), HALF, 0); STAGE_A(SA(0, 1), HALF, 0);
  if (wr == 1) BAR;
  WAIT_V(4); BAR;
  STAGE_B(SB(1, 0), 0, 1); STAGE_A(SA(1, 0), 0, 1); STAGE_B(SB(1, 1), HALF, 1);
  WAIT_V(6); BAR;
  for (int t = 0; t < nt - 2; t += 2) {
    LDB(B0, 0, 0); SCHED; LDA(At, 0, 0); STAGE_A(SA(1, 1), HALF, t + 1);
    WAIT_L(8); BAR; WAIT_L(0); MMA(0, 0, At, B0); BAR; SCHED;
    LDB(B1, 0, 1); STAGE_B(SB(0, 0), 0, t + 2);
    BAR; WAIT_L(0); MMA(0, 1, At, B1); BAR;
    LDA(At, 0, 1); STAGE_A(SA(0, 0), 0, t + 2);
    BAR; WAIT_L(0); MMA(1, 0, At, B0); BAR; SCHED;
    STAGE_B(SB(0, 1), HALF, t + 2);
    WAIT_V(6); BAR; MMA(1, 1, At, B1); BAR;
    LDB(B0, 1, 0); SCHED; LDA(At, 1, 0); STAGE_A(SA(0, 1), HALF, t + 2);
    WAIT_L(8); BAR; WAIT_L(0); MMA(0, 0, At, B0); BAR; SCHED;
    LDB(B1, 1, 1); STAGE_B(SB(1, 0), 0, t + 3);
    BAR; WAIT_L(0); MMA(0, 1, At, B1); BAR;
    LDA(At, 1, 1); STAGE_A(SA(1, 0), 0, t + 3);
    BAR; WAIT_L(0); MMA(1, 0, At, B0); BAR; SCHED;
    STAGE_B(SB(1, 1), HALF, t + 3);
    WAIT_V(6); BAR; MMA(1, 1, At, B1); BAR;
  }
  { LDB(B0, 0, 0); LDA(At, 0, 0); STAGE_A(SA(1, 1), HALF, nt - 1);
    BAR; WAIT_L(0); MMA(0, 0, At, B0); BAR;
    LDB(B1, 0, 1); BAR; WAIT_L(0); MMA(0, 1, At, B1); BAR;
    LDA(At, 0, 1); WAIT_V(4); BAR; WAIT_L(0); MMA(1, 0, At, B0); MMA(1, 1, At, B1); BAR; }
  { LDB(B0, 1, 0); LDA(At, 1, 0); WAIT_V(2); BAR; WAIT_L(0); MMA(0, 0, At, B0); BAR;
    LDB(B1, 1, 1); WAIT_V(0); BAR; WAIT_L(0); MMA(0, 1, At, B1); BAR;
    LDA(At, 1, 1); BAR; WAIT_L(0); MMA(1, 0, At, B0); MMA(1, 1, At, B1); BAR; }
  if (wr == 0) BAR;
  int tide = threadIdx.x; asm volatile("" : "+v"(tide));
  const int fre = tide & 15, fqe = (tide >> 4) & 3;
#pragma unroll
  for (int ai = 0; ai < 2; ++ai)
#pragma unroll
    for (int m = 0; m < 4; ++m) { const int row = row0 + ai * HALF + wr * 64 + m * 16 + fre;
#pragma unroll
      for (int bj = 0; bj < 2; ++bj) { float sq = 0.f;
#pragma unroll
        for (int n = 0; n < 2; ++n) { const float v[4] = {acc[ai][bj][m][n][0], acc[ai][bj][m][n][1], acc[ai][bj][m][n][2], acc[ai][bj][m][n][3]};
          sq += epi(row, col0 + bj * HALF + wc * 32 + n * 16 + fqe * 4, v); }
        if (Epi::RSS) { sq += __shfl_xor(sq, 16); sq += __shfl_xor(sq, 32); if (fqe == 0) epi.rss(row, col0 + bj * HALF + wc * 32, sq); } }
      if (Epi::EPI_SBAR) __builtin_amdgcn_sched_barrier(0); }
#undef SA
#undef SB
#undef STAGE_A
#undef STAGE_B
#undef LDA
#undef LDB
#undef MMA
#undef WAIT_V
#undef WAIT_L
#undef BAR
#undef SCHED
}

template <int BM, int BN, bool ACOLMAP, class Epi>
DEVI void gemm_tile(const bf16_t* A, int lda, const bf16_t* Bm, int ldb, int K, int row0, int col0, const Epi& epi, const float* kss, char* smem) {
  if constexpr (BM == 256 && BN == 256) gemm_tile_8ph<ACOLMAP>(A, lda, Bm, ldb, K, row0, col0, epi, smem);
  else if (kss) gemm_tile_mfma<BM, BN, ACOLMAP, false>(A, lda, Bm, ldb, K, row0, col0, epi, kss, smem);
  else gemm_tile_mfma<BM, BN, ACOLMAP, true>(A, lda, Bm, ldb, K, row0, col0, epi, nullptr, smem);
}

DEVI void st4bf(bf16_t* d, float a, float b, float c, float e) { u32x2 o = {pack2(a, b), pack2(c, e)}; *(u32x2*)d = o; }

struct EpiIn { static constexpr bool RSS = true; static constexpr int SCALE_MODE = 0; static constexpr bool EPI_SBAR = false; bf16_t *GU, *GVT, *CQ, *CKV, *KR; float *rssv, *rssq, *rsskv;
  DEVI float operator()(int row, int col, const float (&v)[4]) const {
    if (col < 1024) { st4bf(GU + (size_t)row * 1024 + col, gelu_t(v[0]), gelu_t(v[1]), gelu_t(v[2]), gelu_t(v[3])); return 0.f; }
    else if (col < 2048) { const int c = col - 1024, chunk = row >> 7, q = row & 127; float s = 0.f;
#pragma unroll
      for (int j = 0; j < 4; ++j) { const float g = gelu_t(v[j]); s += g * g; GVT[((size_t)chunk * 1024 + c + j) * 128 + q] = f2bf(g); }
      return s; }
    else if (col < 2304) { st4bf(CQ + (size_t)row * 256 + (col - 2048), v[0], v[1], v[2], v[3]); return v[0] * v[0] + v[1] * v[1] + v[2] * v[2] + v[3] * v[3]; }
    else if (col < 2432) { st4bf(CKV + (size_t)row * 128 + (col - 2304), v[0], v[1], v[2], v[3]); return v[0] * v[0] + v[1] * v[1] + v[2] * v[2] + v[3] * v[3]; }
    else if (col < 2496) { st4bf(KR + (size_t)keyrow(row) * 64 + (col - 2432), v[0], v[1], v[2], v[3]); return 0.f; }
    return 0.f; }
  DEVI void rss(int row, int col, float s) const {
    if (col >= 1024 && col < 2048) rssv[row * 32 + ((col - 1024) >> 5)] = s; else if (col >= 2048 && col < 2304) rssq[row * 8 + ((col - 2048) >> 5)] = s; else if (col >= 2304 && col < 2432) rsskv[row * 4 + ((col - 2304) >> 5)] = s; }
};
struct EpiQ { static constexpr bool RSS = false; static constexpr int SCALE_MODE = 1; static constexpr bool EPI_SBAR = false; bf16_t* Q; const float* rssq;
  DEVI float rowscale(int row) const { const float4 ps = *(const float4*)(rssq + row * 8), pt = *(const float4*)(rssq + row * 8 + 4); return rsqrtf((((ps.x + ps.y) + (ps.z + ps.w)) + ((pt.x + pt.y) + (pt.z + pt.w))) * (1.f / 256.f) + EPS); }
  DEVI float operator()(int row, int col, const float (&v)[4]) const { st4bf(Q + (size_t)row * 1536 + col, v[0], v[1], v[2], v[3]); return 0.f; }
  DEVI void rss(int, int, float) const {} };
DEVI int pk4_fp8(float a, float b, float c, float d) { int w = __builtin_amdgcn_cvt_pk_fp8_f32(a, b, 0, false); return __builtin_amdgcn_cvt_pk_fp8_f32(c, d, w, true); }
constexpr size_t O_K8 = O_RKV, O_V8T = O_RKV + al256((size_t)NB * 8 * NKEY * 192);
struct EpiK8 { static constexpr bool RSS = false; static constexpr int SCALE_MODE = 1; static constexpr bool EPI_SBAR = false; unsigned char* K8; const float* rsskv;
  DEVI float rowscale(int row) const { const float4 pk = *(const float4*)(rsskv + row * 4); return rsqrtf(((pk.x + pk.y) + (pk.z + pk.w)) * (1.f / 128.f) + EPS); }
  DEVI float operator()(int row, int col, const float (&v)[4]) const {
    int b, key; keyrow2(row, b, key); const int h = col >> 7, d = col & 127;
    *(int*)(K8 + ((size_t)(b * 8 + h) * NKEY + key) * 192 + d) = pk4_fp8(v[0], v[1], v[2], v[3]); return 0.f; }
  DEVI void rss(int, int, float) const {} };
struct EpiV8T { static constexpr bool RSS = false; static constexpr int SCALE_MODE = 2; static constexpr bool EPI_SBAR = false; unsigned char* V8; const float* rsskv;
  DEVI float colscale(int col) const { const float4 pk = *(const float4*)(rsskv + col * 4); return rsqrtf(((pk.x + pk.y) + (pk.z + pk.w)) * (1.f / 128.f) + EPS); }
  DEVI float operator()(int row, int col, const float (&v)[4]) const {
    int b, key; keyrow2(col, b, key); const int h = row >> 7, d = row & 127, kk = key & 63;
    const int off = 32 * ((kk >> 2) & 1) + 16 * (kk >> 5) + 4 * ((kk >> 3) & 3);
    *(int*)(V8 + ((size_t)(b * 8 + h) * 128 + d) * NKEY + (key & ~63) + off) = pk4_fp8(v[0], v[1], v[2], v[3]); return 0.f; }
  DEVI void rss(int, int, float) const {} };
struct EpiSgu { static constexpr bool RSS = false; static constexpr int SCALE_MODE = 0; static constexpr bool EPI_SBAR = false; bf16_t* GUOA; const float* g_sgu; const float* b_s; int chunk, g;
  DEVI float operator()(int row, int col, const float (&v)[4]) const { const int token = chunk * 128 + row, ch = g * 128 + col; const float bias = b_s[g * 128 + row];
    bf16_t* ptr = GUOA + (size_t)token * 1024 + ch; const u32x2 gu = *(const u32x2*)ptr;
    st4bf(ptr, lo2f(gu[0]) * (g_sgu[ch] * v[0] + bias), hi2f(gu[0]) * (g_sgu[ch + 1] * v[1] + bias), lo2f(gu[1]) * (g_sgu[ch + 2] * v[2] + bias), hi2f(gu[1]) * (g_sgu[ch + 3] * v[3] + bias));
    return 0.f; }
  DEVI void rss(int, int, float) const {} };
struct EpiGate { static constexpr bool RSS = false; static constexpr int SCALE_MODE = 0; static constexpr bool EPI_SBAR = false; bf16_t* G;
  DEVI float operator()(int row, int col, const float (&v)[4]) const { st4bf(G + (size_t)row * 2048 + col, sigmoidf_(v[0]), sigmoidf_(v[1]), sigmoidf_(v[2]), sigmoidf_(v[3])); return 0.f; }
  DEVI void rss(int, int, float) const {} };
template <bool SECOND> struct EpiMerge { static constexpr bool RSS = false; static constexpr int SCALE_MODE = 0; static constexpr bool EPI_SBAR = false;   bf16_t* M; const bf16_t* G;
  DEVI float operator()(int row, int col, const float (&v)[4]) const { const u32x2 g = *(const u32x2*)(G + (size_t)row * 2048 + (SECOND ? 1024 : 0) + col);
    float o0 = lo2f(g[0]) * v[0], o1 = hi2f(g[0]) * v[1], o2 = lo2f(g[1]) * v[2], o3 = hi2f(g[1]) * v[3];
    bf16_t* ptr = M + (size_t)row * 1024 + col;
    if (SECOND) { const u32x2 m = *(const u32x2*)ptr; o0 += lo2f(m[0]); o1 += hi2f(m[0]); o2 += lo2f(m[1]); o3 += hi2f(m[1]); }
    st4bf(ptr, o0, o1, o2, o3); return 0.f; }
  DEVI void rss(int, int, float) const {} };
struct EpiO { static constexpr bool RSS = true; static constexpr int SCALE_MODE = 0; static constexpr bool EPI_SBAR = false; bf16_t* Y; float* rssy;
  DEVI float operator()(int row, int col, const float (&v)[4]) const { st4bf(Y + (size_t)row * 1024 + col, v[0], v[1], v[2], v[3]); return v[0] * v[0] + v[1] * v[1] + v[2] * v[2] + v[3] * v[3]; }
  DEVI void rss(int row, int col, float s) const { rssy[row * 32 + (col >> 5)] = s; } };
struct EpiPq { static constexpr bool RSS = false; static constexpr int SCALE_MODE = 0; static constexpr bool EPI_SBAR = false; bf16_t* QP;
  DEVI float operator()(int row, int col, const float (&v)[4]) const { st4bf(QP + (size_t)row * 2048 + col, v[0], v[1], v[2], v[3]); return 0.f; }
  DEVI void rss(int, int, float) const {} };

template <class F> DEVI void for_tiles_xcd(int MT, int NT, F f) {
  const int nb = gridDim.x;
  if ((nb & 7) == 0 && (MT & 7) == 0) { const int xcd = blockIdx.x & 7, slot = blockIdx.x >> 3, slots = nb >> 3, mper = MT >> 3, tot = mper * NT;
    for (int j = slot; j < tot; j += slots) f(xcd * mper + j / NT, j % NT); }
  else for (int i = blockIdx.x; i < MT * NT; i += nb) f(i / NT, i % NT);
}

DEVI void ph_inproj(const Params& p, char* smem) {
  char* ws = p.ws;
  EpiIn epi{(bf16_t*)(ws + O_RB), (bf16_t*)(ws + O_RC), (bf16_t*)(ws + O_CQ), (bf16_t*)(ws + O_CKV), (bf16_t*)(ws + O_KR), (float*)(ws + O_RSSV), (float*)(ws + O_RSSQ), (float*)(ws + O_RSSKV)};
  const bf16_t* HX = (const bf16_t*)(ws + O_RA); const bf16_t* W = (const bf16_t*)(ws + O_WIN);
  auto tile = [&](int mt, int nt) { gemm_tile<256, 256, false>(HX + (size_t)mt * 256 * 1024, 1024, W + (size_t)nt * 256 * 1024, 1024, 1024, mt * 256, nt * 256, epi, nullptr, smem); };
  for_tiles_xcd(64, 10, tile);
  for (int i = (int)gridDim.x - 1 - (int)blockIdx.x; i < 2; i += gridDim.x) tile(64 + i, 9);
}
DEVI void rope_kr_fp8(const Params& p) {
  const bf16_t* KR = (const bf16_t*)(p.ws + O_KR); const float* rope = (const float*)(p.ws + O_ROPE); unsigned char* K8 = (unsigned char*)(p.ws + O_K8);
  for (int i = blockIdx.x * NTHR + threadIdx.x; i < NROW * 2; i += gridDim.x * NTHR) {
    const int row = i >> 1, which = i & 1, kr = keyrow(row); int b, key; keyrow2(row, b, key);
    float x[32];
    const bf16_t* src = KR + (size_t)kr * 64 + which * 32;
#pragma unroll
    for (int q = 0; q < 4; ++q) unpack8(*(const u32x4*)(src + q * 8), x + q * 8);
    if (row < NTOK) { const int pos = row & 8191, pp = which ? (pos & 63) : (pos >> 6); const float* cs = rope + pp * 32;
#pragma unroll
      for (int j = 0; j < 16; ++j) { const float c = cs[j * 2], sn = cs[j * 2 + 1], x1 = x[j], x2 = x[16 + j]; x[j] = x1 * c - x2 * sn; x[16 + j] = x1 * sn + x2 * c; } }
    u32x4 o0, o1;
#pragma unroll
    for (int q = 0; q < 4; ++q) { o0[q] = (unsigned)pk4_fp8(x[q * 4], x[q * 4 + 1], x[q * 4 + 2], x[q * 4 + 3]); o1[q] = (unsigned)pk4_fp8(x[16 + q * 4], x[17 + q * 4], x[18 + q * 4], x[19 + q * 4]); }
#pragma unroll
    for (int h = 0; h < 8; ++h) { unsigned char* d = K8 + ((size_t)(b * 8 + h) * NKEY + key) * 192 + 128 + which * 32; *(u32x4*)d = o0; *(u32x4*)(d + 16) = o1; }
  }
}
DEVI void ph_mid(const Params& p, char* smem) {
  char* ws = p.ws;
  { EpiQ epi{(bf16_t*)(ws + O_RQ), (const float*)(ws + O_RSSQ)};
    const bf16_t* A = (const bf16_t*)(ws + O_CQ); const bf16_t* W = (const bf16_t*)(ws + O_WUQ);
    for_tiles_xcd(64, 12, [&](int mt, int nt) { gemm_tile<256, 128, false>(A + (size_t)mt * 256 * 256, 256, W + (size_t)nt * 128 * 256, 256, 256, mt * 256, nt * 128, epi, nullptr, smem); }); }
  { EpiK8 epi{(unsigned char*)(ws + O_K8), (const float*)(ws + O_RSSKV)};
    const bf16_t* A = (const bf16_t*)(ws + O_CKV); const bf16_t* W = (const bf16_t*)(ws + O_WUKV);
    auto tile = [&](int mt, int nt) { gemm_tile<256, 128, false>(A + (size_t)mt * 256 * 128, 128, W + (size_t)nt * 256 * 128, 128, 128, mt * 256, nt * 128, epi, nullptr, smem); };
    for_tiles_xcd(64, 8, tile);
    for (int i = blockIdx.x; i < 16; i += gridDim.x) tile(64 + (i >> 3), i & 7); }
  { EpiV8T epi{(unsigned char*)(ws + O_V8T), (const float*)(ws + O_RSSKV)};
    const bf16_t* A = (const bf16_t*)(ws + O_WUKV); const bf16_t* Bc = (const bf16_t*)(ws + O_CKV);
    for (int i = blockIdx.x; i < 8 * 132; i += gridDim.x) { const int mt = i & 7, nt = i >> 3;
      gemm_tile<128, 128, false>(A + (size_t)(mt * 256 + 128) * 128, 128, Bc + (size_t)nt * 128 * 128, 128, 128, mt * 128, nt * 128, epi, nullptr, smem); } }
  { const bf16_t* WS = (const bf16_t*)(ws + O_WS); const bf16_t* GVT = (const bf16_t*)(ws + O_RC);
    float* ksc = (float*)(smem + LDS_BYTES - 1024); const float* rssv = (const float*)(ws + O_RSSV);
    for (int i = blockIdx.x; i < 1024; i += gridDim.x) { const int chunk = i >> 3, g = i & 7;
      __syncthreads();
      if (threadIdx.x < 128) { const float* pr = rssv + (size_t)(chunk * 128 + threadIdx.x) * 32; float t = 0.f;
#pragma unroll
        for (int j = 0; j < 32; ++j) t += pr[j];
        ksc[threadIdx.x] = rsqrtf(t * (1.f / 1024.f) + EPS); }
      __syncthreads();
      EpiSgu epi{(bf16_t*)(ws + O_RB), p.g_sgu, p.b_s, chunk, g};
      gemm_tile<128, 128, false>(WS + (size_t)g * 16384, 128, GVT + ((size_t)chunk * 1024 + g * 128) * 128, 128, 128, 0, 0, epi, ksc, smem); } }
  rope_kr_fp8(p);
}
DEVI void ph_gates(const Params& p, char* smem) {
  char* ws = p.ws; EpiGate epi{(bf16_t*)(ws + O_RKV)};
  const bf16_t* HX = (const bf16_t*)(ws + O_RA); const bf16_t* W = (const bf16_t*)(ws + O_WIN) + (size_t)NPRE * 1024;
  for_tiles_xcd(64, 8, [&](int mt, int nt) { gemm_tile<256, 256, false>(HX + (size_t)mt * 256 * 1024, 1024, W + (size_t)nt * 256 * 1024, 1024, 1024, mt * 256, nt * 256, epi, nullptr, smem); });
}
DEVI void ph_merge(const Params& p, char* smem) {
  char* ws = p.ws; bf16_t* M = (bf16_t*)(ws + O_RC); const bf16_t* G = (const bf16_t*)(ws + O_RKV);
  EpiMerge<false> e1{M, G}; EpiMerge<true> e2{M, G};
  const bf16_t* OA = (const bf16_t*)(ws + O_RB); const bf16_t* OB = (const bf16_t*)(ws + O_RQ);
  const bf16_t* WA = (const bf16_t*)(ws + O_WPA); const bf16_t* WB = (const bf16_t*)(ws + O_WPB);
  for_tiles_xcd(64, 4, [&](int mt, int nt) { gemm_tile<256, 256, false>(OA + (size_t)mt * 256 * 1024, 1024, WA + (size_t)nt * 256 * 1024, 1024, 1024, mt * 256, nt * 256, e1, nullptr, smem); });
  for_tiles_xcd(64, 4, [&](int mt, int nt) { gemm_tile<256, 256, true>(OB + (size_t)mt * 256 * 1536, 1536, WB + (size_t)nt * 256 * 1024, 1024, 1024, mt * 256, nt * 256, e2, nullptr, smem); });
}
DEVI void ph_wo(const Params& p, char* smem) {
  char* ws = p.ws; EpiO epi{(bf16_t*)(ws + O_RA), (float*)(ws + O_RSSY)};
  const bf16_t* M = (const bf16_t*)(ws + O_RC); const bf16_t* W = (const bf16_t*)(ws + O_WO);
  for_tiles_xcd(64, 4, [&](int mt, int nt) { gemm_tile<256, 256, false>(M + (size_t)mt * 256 * 1024, 1024, W + (size_t)nt * 256 * 1024, 1024, 1024, mt * 256, nt * 256, epi, nullptr, smem); });
}
DEVI void ph_wpq(const Params& p, char* smem) {
  char* ws = p.ws; EpiPq epi{(bf16_t*)(ws + O_RKV)};
  const bf16_t* A = (const bf16_t*)(ws + O_RB); const bf16_t* W = (const bf16_t*)(ws + O_WPQ);
  for_tiles_xcd(64, 8, [&](int mt, int nt) { gemm_tile<256, 256, false>(A + (size_t)mt * 256 * 1024, 1024, W + (size_t)nt * 256 * 1024, 1024, 1024, mt * 256, nt * 256, epi, nullptr, smem); });
  convert_table_fp6(p.v_exp, (unsigned char*)(ws + O_RA), (float*)(ws + O_RA + (size_t)16384 * 1024));
}

namespace a8 {
constexpr int KVBLK = 64, SHM_K = KVBLK * 192, SHM_V = 128 * KVBLK;
constexpr int SHM_K2 = 2 * SHM_K, SHM_V2 = 2 * SHM_V;
constexpr float SCALE = 0.07216878364870322f, THR = 1.5f;
using i32x8 = __attribute__((ext_vector_type(8))) int;
DEVI int crow(int r, int hi) { return (r & 3) + 8 * (r >> 2) + 4 * hi; }
DEVI f32x16 mma(const i32x8& a, const i32x8& b, const f32x16& c) { return __builtin_amdgcn_mfma_scale_f32_32x32x64_f8f6f4(a, b, c, 0, 0, 0, 0x7f7f7f7f, 0, 0x7f7f7f7f); }
DEVI void partialSM(f32x16& p0, f32x16& p1, float& m_reg, float& mn, float& alpha) {
  constexpr float C = SCALE * 1.4426950408889634f;
  float pmax = p0[0];
#pragma unroll
  for (int r = 1; r < 16; ++r) pmax = fmaxf(pmax, p0[r]);
#pragma unroll
  for (int r = 0; r < 16; ++r) pmax = fmaxf(pmax, p1[r]);
  { auto rr = __builtin_amdgcn_permlane32_swap(__float_as_uint(pmax), __float_as_uint(pmax), false, false);
    pmax = fmaxf(__uint_as_float(rr[0]), __uint_as_float(rr[1])); }
  if (__builtin_expect(__all(pmax - m_reg <= THR / SCALE), 1)) { mn = m_reg; alpha = 1.f; }
  else { mn = fmaxf(m_reg, pmax); alpha = __builtin_amdgcn_exp2f((m_reg - mn) * C); m_reg = mn; }
  const float mnC = 6.f - mn * C;
#pragma unroll
  for (int r = 0; r < 16; ++r) p0[r] = fmaf(p0[r], C, mnC);
#pragma unroll
  for (int r = 0; r < 16; ++r) p1[r] = fmaf(p1[r], C, mnC);
#pragma unroll
  for (int r = 0; r < 16; ++r) p0[r] = __builtin_amdgcn_exp2f(p0[r]);
}
DEVI void finishSM(f32x16& p0, f32x16& p1, float alpha, float& l_reg, i32x8& pa) {
#pragma unroll
  for (int r = 0; r < 16; ++r) p1[r] = __builtin_amdgcn_exp2f(p1[r]);
  float ps = 0;
#pragma unroll
  for (int r = 0; r < 16; ++r) ps += p0[r];
#pragma unroll
  for (int r = 0; r < 16; ++r) ps += p1[r];
  { auto rr = __builtin_amdgcn_permlane32_swap(__float_as_uint(ps), __float_as_uint(ps), false, false);
    ps = __uint_as_float(rr[0]) + __uint_as_float(rr[1]); }
  l_reg = l_reg * alpha + ps;
#pragma unroll
  for (int j = 0; j < 4; ++j) { pa[j] = pk4_fp8(p0[4 * j], p0[4 * j + 1], p0[4 * j + 2], p0[4 * j + 3]); pa[4 + j] = pk4_fp8(p1[4 * j], p1[4 * j + 1], p1[4 * j + 2], p1[4 * j + 3]); }
}
DEVI i32x8 ld32(const char* p0, const char* p1) { const u32x4 a = *(const u32x4*)p0, b = *(const u32x4*)p1; return (i32x8){(int)a[0], (int)a[1], (int)a[2], (int)a[3], (int)b[0], (int)b[1], (int)b[2], (int)b[3]}; }
DEVI void qkt(f32x16& p0, f32x16& p1, const char* Ks, const i32x8* qf, int r32, int hi) {
  p0 = f32x16{}; p1 = f32x16{};
  const int sw = (r32 >> 2) & 3; const char* k0 = Ks + r32 * 192; const char* k1 = k0 + 32 * 192;
#pragma unroll
  for (int m = 0; m < 3; ++m) { const int c0 = ((4 * m + 2 * hi) ^ sw) << 4, c1 = ((4 * m + 2 * hi + 1) ^ sw) << 4;
    p0 = mma(ld32(k0 + c0, k0 + c1), qf[m], p0);
    p1 = mma(ld32(k1 + c0, k1 + c1), qf[m], p1); }
}
DEVI void pv(f32x16* o, const char* Vs, int tile, const i32x8& pa, int r32, int hi) {
  const int sw = (r32 >> 1) & 7, c0 = ((4 * tile + 2 * hi) ^ sw) << 4, c1 = ((4 * tile + 2 * hi + 1) ^ sw) << 4;
#pragma unroll
  for (int db = 0; db < 4; ++db) { const char* vr = Vs + (32 * db + r32) * 128; o[db] = mma(pa, ld32(vr + c0, vr + c1), o[db]); }
}
DEVI void attn_item(bf16_t* __restrict__ Qb, const unsigned char* __restrict__ Kg, const unsigned char* __restrict__ Vg, const float* __restrict__ rope, int pos0, char* lds) {
  const int tid = threadIdx.x, wid = tid >> 6, lane = tid & 63, r32 = lane & 31, hi = lane >> 5;
  char* V_lds = lds; char* K_lds = lds + 3 * SHM_V2;
  float* wsl = (float*)(lds + 3 * SHM_V2 + 3 * SHM_K2) + wid * 64; float* li_l = wsl; float* al_l = wsl + 32;
  float m_reg = -1e30f, l_reg = 0; f32x16 o[4] = {}; i32x8 qf[3];
  { const bf16_t* Qw = Qb + (size_t)(wid * 32 + r32) * 1536 + hi * 32;
#pragma unroll
    for (int m = 0; m < 3; ++m) { float x[32];
#pragma unroll
      for (int q = 0; q < 4; ++q) unpack8(*(const u32x4*)(Qw + m * 64 + q * 8), x + q * 8);
      if (m == 2) { const int pos = pos0 + wid * 32 + r32, pp = hi ? (pos & 63) : (pos >> 6); const float* cs = rope + pp * 32;
#pragma unroll
        for (int j = 0; j < 16; ++j) { const float c = cs[j * 2], sn = cs[j * 2 + 1], x1 = x[j], x2 = x[16 + j]; x[j] = x1 * c - x2 * sn; x[16 + j] = x1 * sn + x2 * c; } }
#pragma unroll
      for (int q = 0; q < 8; ++q) qf[m][q] = pk4_fp8(x[q * 4], x[q * 4 + 1], x[q * 4 + 2], x[q * 4 + 3]);
      __builtin_amdgcn_sched_barrier(0); } }
  unsigned koff[3], voff[2];
#pragma unroll
  for (int i = 0; i < 3; ++i) { const int pp = wid * 64 + lane + 512 * i, key = pp / 12, c = pp - key * 12; koff[i] = (unsigned)(key * 192 + ((c ^ ((key >> 2) & 3)) << 4)); }
#pragma unroll
  for (int i = 0; i < 2; ++i) { const int pp = wid * 64 + lane + 512 * i, d = pp >> 3, c = pp & 7; voff[i] = (unsigned)(d * NKEY + ((c ^ ((d >> 1) & 7)) << 4)); }
#define GSTAGE(s_, kb, vb) do { const unsigned char* ks = Kg + (size_t)(s_) * SHM_K2; const unsigned char* vs = Vg + (s_) * 128; \
    _Pragma("unroll") for (int i = 0; i < 3; ++i) __builtin_amdgcn_global_load_lds((const unsigned*)(ks + koff[i]), (unsigned*)(K_lds + (kb) + i * 8192 + wid * 1024), 16, 0, 0); \
    _Pragma("unroll") for (int i = 0; i < 2; ++i) __builtin_amdgcn_global_load_lds((const unsigned*)(vs + voff[i]), (unsigned*)(V_lds + (vb) + i * 8192 + wid * 1024), 16, 0, 0); } while (0)
#define SWAIT() asm volatile("s_waitcnt vmcnt(0)" ::: "memory")
#define SBAR() __builtin_amdgcn_sched_barrier(0)
#define RESC(a) do { if (__any((a) < 1.f)) { if (hi == 0) al_l[r32] = (a); asm volatile("s_waitcnt lgkmcnt(0)" ::: "memory"); \
    _Pragma("unroll") for (int d = 0; d < 4; ++d) _Pragma("unroll") for (int r = 0; r < 16; ++r) o[d][r] *= al_l[crow(r, hi)]; } } while (0)
  f32x16 pA0, pA1, pB0, pB1; float mnA, mnB, alA, alB; i32x8 pa; constexpr int NS = NKEY / 128;
  int kp = 0, kc = SHM_K2, kn = 2 * SHM_K2, vp = 0, vc = SHM_V2, vn = 2 * SHM_V2;
  GSTAGE(0, kp, vp); GSTAGE(1, kc, vc); SWAIT(); __syncthreads();
  qkt(pA0, pA1, K_lds + kp, qf, r32, hi); partialSM(pA0, pA1, m_reg, mnA, alA);
  SBAR(); qkt(pB0, pB1, K_lds + kp + SHM_K, qf, r32, hi);
  finishSM(pA0, pA1, alA, l_reg, pa); SBAR();
  pv(o, V_lds + vp, 0, pa, r32, hi); partialSM(pB0, pB1, m_reg, mnB, alB);
  RESC(alB);
  for (int s_ = 1; s_ < NS; ++s_) {
    if (s_ + 1 < NS) GSTAGE(s_ + 1, kn, vn);
    SBAR(); qkt(pA0, pA1, K_lds + kc, qf, r32, hi);
    finishSM(pB0, pB1, alB, l_reg, pa); SBAR();
    pv(o, V_lds + vp, 1, pa, r32, hi); partialSM(pA0, pA1, m_reg, mnA, alA);
    RESC(alA);
    SBAR(); qkt(pB0, pB1, K_lds + kc + SHM_K, qf, r32, hi);
    finishSM(pA0, pA1, alA, l_reg, pa); SBAR();
    pv(o, V_lds + vc, 0, pa, r32, hi); partialSM(pB0, pB1, m_reg, mnB, alB);
    SWAIT(); __syncthreads();
    RESC(alB);
    { const int tk = kp; kp = kc; kc = kn; kn = tk; const int tv = vp; vp = vc; vc = vn; vn = tv; }
  }
  finishSM(pB0, pB1, alB, l_reg, pa); SBAR();
  pv(o, V_lds + vp, 1, pa, r32, hi);
  if (hi == 0) li_l[r32] = l_reg; asm volatile("s_waitcnt lgkmcnt(0)" ::: "memory");
  float rli[16];
#pragma unroll
  for (int r = 0; r < 16; ++r) rli[r] = __builtin_amdgcn_rcpf(li_l[crow(r, hi)]);
  bf16_t* Ow = Qb + (size_t)(wid * 32) * 1536;
#pragma unroll
  for (int r = 0; r < 16; ++r) { const int orow = crow(r, hi);
#pragma unroll
    for (int d0 = 0; d0 < 4; ++d0) Ow[(size_t)orow * 1536 + d0 * 32 + r32] = f2bf(o[d0][r] * rli[r]); }
  __syncthreads();
#undef GSTAGE
#undef SWAIT
#undef SBAR
#undef RESC
}
}
DEVI void attn_fp8(const Params& p, char* smem) {
  bf16_t* Q = (bf16_t*)(p.ws + O_RQ); const unsigned char* K8 = (const unsigned char*)(p.ws + O_K8); const unsigned char* V8 = (const unsigned char*)(p.ws + O_V8T);
  const float* rope = (const float*)(p.ws + O_ROPE);
  for (int it = blockIdx.x; it < NB * 8 * (SEQ / 256); it += gridDim.x) {
    const int bh = (it >> 8) * 8 + (it & 7), qb = (it & 255) >> 3, b = bh >> 3, h = bh & 7;
    a8::attn_item(Q + (size_t)(b * SEQ + qb * 256) * 1536 + h * 192, K8 + (size_t)bh * NKEY * 192, V8 + (size_t)bh * 128 * NKEY, rope, qb * 256, smem);
  }
}
DEVI void ph_attn(const Params& p, char* smem) { attn_fp8(p, smem); }

DEVI void ph_rows(const Params& p, char* smem) {
  const int tid = threadIdx.x, wave = tid >> 6, lane = tid & 63;
  const float* MOD = (const float*)(p.ws + O_MOD); const bf16_t* Y = (const bf16_t*)(p.ws + O_RA); const float* rssy = (const float*)(p.ws + O_RSSY);
  bf16_t* HX2 = (bf16_t*)(p.ws + O_RB);
  for (int row = blockIdx.x * NWAVE + wave; row < NTOK; row += gridDim.x * NWAVE) {
    const int b = row >> 13; const float* md = MOD + b * 6144;
    float ty = 0.f; { const float* pr = rssy + (size_t)row * 32;
#pragma unroll
      for (int j = 0; j < 32; ++j) ty += pr[j]; }
    const float ry = rsqrtf(ty * (1.f / 1024.f) + EPS);
    float x1[16]; float ss = 0.f;
#pragma unroll
    for (int i = 0; i < 4; ++i) { const int c = i * 256 + lane * 4; const float4 xv = *(const float4*)(p.x + (size_t)row * 1024 + c); const u32x2 yv = *(const u32x2*)(Y + (size_t)row * 1024 + c);
      const float4 gp = *(const float4*)(p.g_post1 + c), gt = *(const float4*)(md + 2048 + c);
      x1[i * 4 + 0] = xv.x + gt.x * (lo2f(yv[0]) * ry * gp.x); x1[i * 4 + 1] = xv.y + gt.y * (hi2f(yv[0]) * ry * gp.y);
      x1[i * 4 + 2] = xv.z + gt.z * (lo2f(yv[1]) * ry * gp.z); x1[i * 4 + 3] = xv.w + gt.w * (hi2f(yv[1]) * ry * gp.w);
#pragma unroll
      for (int j = 0; j < 4; ++j) ss += x1[i * 4 + j] * x1[i * 4 + j];
      *(float4*)(p.out + (size_t)row * 1024 + c) = make_float4(x1[i * 4], x1[i * 4 + 1], x1[i * 4 + 2], x1[i * 4 + 3]); }
    ss = wave_sum(ss); const float r2 = rsqrtf(ss * (1.f / 1024.f) + EPS);
#pragma unroll
    for (int i = 0; i < 4; ++i) { const int c = i * 256 + lane * 4; const float4 g2 = *(const float4*)(p.g_pre2 + c), sc = *(const float4*)(md + 4096 + c), sh = *(const float4*)(md + 3072 + c);
      st4bf(HX2 + (size_t)row * 1024 + c, x1[i * 4] * r2 * g2.x * (1.f + sc.x) + sh.x, x1[i * 4 + 1] * r2 * g2.y * (1.f + sc.y) + sh.y,
            x1[i * 4 + 2] * r2 * g2.z * (1.f + sc.z) + sh.z, x1[i * 4 + 3] * r2 * g2.w * (1.f + sc.w) + sh.w); }
  }
  convert_table_fp6(p.u_exp, (unsigned char*)(p.ws + O_RC), (float*)(p.ws + O_RC + (size_t)16384 * 1024));
}

namespace tk {
DEVI int f2sort(float f) { const int i = __float_as_int(f); return i ^ ((i >> 31) & 0x7fffffff); }
DEVI float sort2f(int s) { return __int_as_float(s ^ ((s >> 31) & 0x7fffffff)); }
DEVI void ce_desc(int& a, int& b) { const int hi = max(a, b), lo = min(a, b); a = hi; b = lo; }
DEVI void sort16_desc(int* a) {
#pragma unroll
  for (int lk = 1; lk <= 4; ++lk)
#pragma unroll
    for (int lj = lk - 1; lj >= 0; --lj)
#pragma unroll
      for (int i = 0; i < 16; ++i) { const int j = 1 << lj, k = 1 << lk, l = i ^ j;
        if (l > i) { const int hi = max(a[i], a[l]), lo = min(a[i], a[l]); if ((i & k) == 0) { a[i] = hi; a[l] = lo; } else { a[i] = lo; a[l] = hi; } } }
}
DEVI void bitonic_merge16_desc(int* a) {
#pragma unroll
  for (int lj = 3; lj >= 0; --lj)
#pragma unroll
    for (int i = 0; i < 16; ++i) { const int l = i ^ (1 << lj); if (l > i) ce_desc(a[i], a[l]); }
}
DEVI void merge_top16(int* a, const int* b) {
#pragma unroll
  for (int i = 0; i < 16; ++i) a[i] = max(a[i], b[15 - i]);
  bitonic_merge16_desc(a);
}
DEVI void half_top16(const bf16_t* __restrict__ qrow, const char* Kl, int r32, int hi, int* out) {
  bf16x8 qf[8];
#pragma unroll
  for (int d0 = 0; d0 < 8; ++d0) qf[d0] = *reinterpret_cast<const bf16x8*>(qrow + d0 * 16 + hi * 8);
  int a[64]; const int hi4 = 4 * hi;
#pragma unroll
  for (int kt = 0; kt < 4; ++kt) { f32x16 acc = {};
    const int key = kt * 32 + r32;
#pragma unroll
    for (int d0 = 0; d0 < 8; ++d0) { const bf16x8 kf = *reinterpret_cast<const bf16x8*>(Kl + key * 256 + (((d0 * 2 + hi) ^ (key & 15)) << 4));
      acc = __builtin_amdgcn_mfma_f32_32x32x16_bf16(kf, qf[d0], acc, 0, 0, 0); }
#pragma unroll
    for (int r = 0; r < 16; ++r) { const int kc = kt * 32 + (r & 3) + 8 * (r >> 2); a[kt * 16 + r] = ((f2sort(acc[r]) & ~127) | (127 - kc)) - hi4; } }
  sort16_desc(a); sort16_desc(a + 16); sort16_desc(a + 32); sort16_desc(a + 48);
  merge_top16(a, a + 16); merge_top16(a + 32, a + 48); merge_top16(a, a + 32);
  int L[16], H[16];
#pragma unroll
  for (int i = 0; i < 16; ++i) { auto rr = __builtin_amdgcn_permlane32_swap((unsigned)a[i], (unsigned)a[i], false, false); L[i] = (int)rr[0]; H[i] = (int)rr[1]; }
  merge_top16(L, H);
#pragma unroll
  for (int i = 0; i < 16; ++i) out[i] = L[i];
}
}
DEVI void peer_pass1_tokens4(const Params& p, int t0, const int* idxw, float* gww, float* xs, const int* sig);
DEVI void fp6_sigma(int* sig);
DEVI void topk_fast(const Params& p, char* smem) {
  const int tid = threadIdx.x, wave = __builtin_amdgcn_readfirstlane(tid >> 6), lane = tid & 63, r32 = lane & 31, hi = lane >> 5;
  const bf16_t* QP = (const bf16_t*)(p.ws + O_RKV);
  char* K1l = smem; char* K2l = smem + 32768; int* tab = (int*)(smem + 65536) + wave * (32 * 33);
  int* idxl = (int*)(smem + 65536 + 8 * 32 * 33 * 4) + wave * 512; float* gwl = (float*)(smem + 65536 + 8 * 32 * 33 * 4 + 8 * 2048) + wave * 512;
  int* sigl = (int*)(smem + 65536 + 8 * 32 * 33 * 4 + 16 * 2048) + wave * 32;
  fp6_sigma(sigl);
  __syncthreads();
  { const bf16_t* K1 = (const bf16_t*)(p.ws + O_K1);
    for (int id = tid; id < 4096; id += NTHR) { const int key = id >> 4, c = id & 15; const u32x4 v = *(const u32x4*)(K1 + (size_t)key * 128 + c * 8);
      *(u32x4*)(smem + key * 256 + ((c ^ (key & 15)) << 4)) = v; } }
  __syncthreads();
  for (int item = blockIdx.x; item < NTOK * 8 / 256; item += gridDim.x) {
    int tid_ = threadIdx.x; asm volatile("" : "+v"(tid_));
    const int lane = tid_ & 63, r32 = lane & 31, hi = lane >> 5;
    const int row = item * 256 + wave * 32 + r32;
    const bf16_t* qrow = QP + (size_t)row * 256;
    int t1[16], t2[16];
    tk::half_top16(qrow, K1l, r32, hi, t1);
    __builtin_amdgcn_sched_barrier(0);
    tk::half_top16(qrow + 128, K2l, r32, hi, t2);
    __builtin_amdgcn_sched_barrier(0);
    float v1[16], v2[16];
#pragma unroll
    for (int i = 0; i < 16; ++i) { v1[i] = tk::sort2f(t1[i] & ~127); v2[i] = tk::sort2f(t2[i] & ~127); }
    if (hi == 0) {
#pragma unroll
      for (int i = 0; i < 16; ++i) { tab[r32 * 33 + i] = 127 - (t1[i] & 127); tab[r32 * 33 + 16 + i] = 127 - (t2[i] & 127); } }
#define CAND(i, j) ((tk::f2sort(v1[i] + v2[j]) & ~255) | (255 - ((i) * 16 + (j))))
    int g0[16], g1[16], g2[16];
#pragma unroll
    for (int j = 0; j < 16; ++j) g0[j] = CAND(0, j);
#pragma unroll
    for (int j = 0; j < 8; ++j) g1[j] = CAND(1, j);
#pragma unroll
    for (int j = 0; j < 5; ++j) g1[8 + j] = CAND(2, j);
#pragma unroll
    for (int j = 0; j < 3; ++j) g1[13 + j] = CAND(4, j);
#pragma unroll
    for (int j = 0; j < 4; ++j) g2[j] = CAND(3, j);
    g2[4] = CAND(5, 0); g2[5] = CAND(5, 1); g2[6] = CAND(6, 0); g2[7] = CAND(6, 1); g2[8] = CAND(7, 0); g2[9] = CAND(7, 1);
    g2[10] = CAND(8, 0); g2[11] = CAND(9, 0); g2[12] = CAND(10, 0); g2[13] = CAND(11, 0); g2[14] = CAND(12, 0); g2[15] = CAND(13, 0);
    tk::sort16_desc(g1); tk::sort16_desc(g2);
    tk::merge_top16(g0, g1); tk::merge_top16(g0, g2);
    { int x = CAND(14, 0);
#pragma unroll
      for (int i = 0; i < 16; ++i) { const int h = max(g0[i], x); x = min(g0[i], x); g0[i] = h; }
      x = CAND(15, 0);
#pragma unroll
      for (int i = 0; i < 16; ++i) { const int h = max(g0[i], x); x = min(g0[i], x); g0[i] = h; } }
#undef CAND
    asm volatile("s_waitcnt lgkmcnt(0)" ::: "memory");
    if (hi == 0) {
      int ex[16];
#pragma unroll
      for (int k = 0; k < 16; ++k) { const int pos = 255 - (g0[k] & 255); ex[k] = tab[r32 * 33 + (pos >> 4)] * 128 + tab[r32 * 33 + 16 + (pos & 15)]; }
      int* dst = idxl + r32 * 16;
#pragma unroll
      for (int q = 0; q < 4; ++q) *(int4*)(dst + q * 4) = make_int4(ex[q * 4], ex[q * 4 + 1], ex[q * 4 + 2], ex[q * 4 + 3]);
    } else {
      float e[16]; const float vmax = tk::sort2f(g0[0] & ~255); float sum = 0.f;
#pragma unroll
      for (int k = 0; k < 16; ++k) { e[k] = __expf(tk::sort2f(g0[k] & ~255) - vmax); sum += e[k]; }
      const float inv = 1.f / sum; float* dst = gwl + r32 * 16;
#pragma unroll
      for (int q = 0; q < 4; ++q) *(float4*)(dst + q * 4) = make_float4(e[q * 4] * inv, e[q * 4 + 1] * inv, e[q * 4 + 2] * inv, e[q * 4 + 3] * inv);
    }
    asm volatile("s_waitcnt lgkmcnt(0)" ::: "memory"); __builtin_amdgcn_sched_barrier(0);
    peer_pass1_tokens4(p, item * 32 + wave * 4, idxl, gwl, (float*)tab, sigl);
    asm volatile("s_waitcnt lgkmcnt(0)" ::: "memory"); __builtin_amdgcn_sched_barrier(0);
  }
}
DEVI void ph_topk(const Params& p, char* smem) { topk_fast(p, smem); }

DEVI void fp6_sigma(int* sig) {
  float one = 1.0f; asm volatile("" : "+v"(one));
  f32x16 ra, rb;
#pragma unroll
  for (int i = 0; i < 16; ++i) { ra[i] = i < 8 ? i * 0.125f : 1.f + (i - 8) * 0.125f; rb[i] = i < 8 ? 2.f + i * 0.25f : 4.f + (i - 8) * 0.5f; }
  const u32x6 w = __builtin_amdgcn_cvt_scalef32_2xpk16_fp6_f32(ra, rb, one);
  const f32x32 d = __builtin_amdgcn_cvt_scalef32_pk32_f32_fp6(w, one);
  if ((threadIdx.x & 63) == 0) {
#pragma unroll
    for (int i = 0; i < 32; ++i) { const float v = d[i]; sig[i] = v < 1.f ? (int)(v * 8.f + 0.5f) : v < 2.f ? 8 + (int)((v - 1.f) * 8.f + 0.5f) : v < 4.f ? 16 + (int)((v - 2.f) * 4.f + 0.5f) : 24 + (int)((v - 4.f) * 2.f + 0.5f); } }
}
using f32x2 = __attribute__((ext_vector_type(2))) float;
#define DPPF(x, ctrl) __builtin_bit_cast(float, __builtin_amdgcn_update_dpp(0, __builtin_bit_cast(int, (x)), ctrl, 0xf, 0xf, true))
DEVI float reduce_t32(const float (&D)[32], int lane) {
  float S[16];
#pragma unroll
  for (int i = 0; i < 16; ++i) { auto rr = __builtin_amdgcn_permlane16_swap(__float_as_uint(D[i]), __float_as_uint(D[i + 16]), false, false); S[i] = __uint_as_float(rr[0]) + __uint_as_float(rr[1]); }
  const bool b3 = lane & 8, b2 = lane & 4, b1 = lane & 2, b0 = lane & 1;
  float T[8], U[4], V[2];
#pragma unroll
  for (int i = 0; i < 8; ++i) { const float keep = b3 ? S[i + 8] : S[i], send = b3 ? S[i] : S[i + 8]; T[i] = keep + DPPF(send, 0x128); }
#pragma unroll
  for (int i = 0; i < 4; ++i) { const float keep = b2 ? T[i + 4] : T[i], send = b2 ? T[i] : T[i + 4]; U[i] = keep + DPPF(send, 0x141); }
#pragma unroll
  for (int i = 0; i < 2; ++i) { const float keep = b1 ? U[i + 2] : U[i], send = b1 ? U[i] : U[i + 2]; V[i] = keep + DPPF(send, 0x4E); }
  const float keep = b0 ? V[1] : V[0], send = b0 ? V[0] : V[1];
  return keep + DPPF(send, 0xB1);
}
DEVI void gload8(u32x6 (&B)[8], const unsigned char* tab, const int* ids, int g24) {
  const int4 i0 = *(const int4*)ids, i1 = *(const int4*)(ids + 4);
  const int id[8] = {i0.x, i0.y, i0.z, i0.w, i1.x, i1.y, i1.z, i1.w};
#pragma unroll
  for (int j = 0; j < 8; ++j) { const unsigned char* rp = tab + (unsigned)(id[j] * 768 + g24);
    const u32x4 a = *(const u32x4_u*)rp; const u32x2 c = *(const u32x2_u*)(rp + 16); B[j] = (u32x6){a[0], a[1], a[2], a[3], c[0], c[1]}; }
  asm volatile("" ::: "memory"); __builtin_amdgcn_sched_barrier(0);
}
template <int O>
DEVI void gdot8(const u32x6 (&B)[8], const f32x2 (&xp2)[16], float (&D)[32]) {
#pragma unroll
  for (int j = 0; j < 8; ++j) { const f32x32 uf = __builtin_amdgcn_cvt_scalef32_pk32_f32_fp6(B[j], 1.0f); f32x2 da = {0.f, 0.f}, db = {0.f, 0.f};
#pragma unroll
    for (int k = 0; k < 16; k += 2) { da += xp2[k] * (f32x2){uf[2 * k], uf[2 * k + 1]}; db += xp2[k + 1] * (f32x2){uf[2 * k + 2], uf[2 * k + 3]}; }
    da += db; D[O + j] = da[0] + da[1]; asm volatile("" : "+v"(D[O + j]) :: "memory"); __builtin_amdgcn_sched_barrier(0); }
}
DEVI void gaxpy8(const u32x6 (&B)[8], const float* cs, f32x2 (&acc2)[16]) {
  const float4 c0 = *(const float4*)cs, c1 = *(const float4*)(cs + 4);
  const float c[8] = {c0.x, c0.y, c0.z, c0.w, c1.x, c1.y, c1.z, c1.w};
#pragma unroll
  for (int j = 0; j < 8; ++j) { const f32x32 vf = __builtin_amdgcn_cvt_scalef32_pk32_f32_fp6(B[j], 1.0f); const f32x2 cj = {c[j], c[j]};
#pragma unroll
    for (int k = 0; k < 16; ++k) acc2[k] += cj * (f32x2){vf[2 * k], vf[2 * k + 1]};
    asm volatile("" : "+v"(acc2[0]), "+v"(acc2[1]), "+v"(acc2[2]), "+v"(acc2[3]), "+v"(acc2[4]), "+v"(acc2[5]), "+v"(acc2[6]), "+v"(acc2[7]) :: "memory");
    asm volatile("" : "+v"(acc2[8]), "+v"(acc2[9]), "+v"(acc2[10]), "+v"(acc2[11]), "+v"(acc2[12]), "+v"(acc2[13]), "+v"(acc2[14]), "+v"(acc2[15]) :: "memory");
    __builtin_amdgcn_sched_barrier(0); }
}
DEVI void peer_pass1_tokens4(const Params& p, int t0, const int* idxw, float* gww, float* xs, const int* sig) {
  int lane = threadIdx.x & 63; asm volatile("" : "+v"(lane));
  const int h = lane >> 5, g = lane & 31, g24 = g * 24;
  const bf16_t* HX2 = (const bf16_t*)(p.ws + O_RB);
  const unsigned char* UT = (const unsigned char*)(p.ws + O_RC); const float* SU = (const float*)(p.ws + O_RC + (size_t)16384 * 1024);
  const float* SV = (const float*)(p.ws + O_RA + (size_t)16384 * 1024);
  int* IDG = (int*)(p.ws + O_RQ); float* CG = (float*)(p.ws + O_RQ + (size_t)NTOK * 128 * 4);
  u32x6 B0[8], B1[8]; u32x4 xr[4];
  gload8(B0, UT, idxw + h * 32, g24);
#pragma unroll
  for (int q = 0; q < 4; ++q) xr[q] = *(const u32x4*)(HX2 + (size_t)t0 * 1024 + g * 32 + q * 8);
#pragma unroll 1
  for (int tl = 0; tl < 4; ++tl) {
    const int t = t0 + tl; const int* idx = idxw + tl * 128; float* gw = gww + tl * 128; const int* idh = idx + h * 32;
    if (h == 0) { float xf[32];
#pragma unroll
      for (int q = 0; q < 4; ++q) unpack8(xr[q], xf + q * 8);
#pragma unroll
      for (int j = 0; j < 32; ++j) xs[j * 32 + g] = xf[j]; }
    asm volatile("s_waitcnt lgkmcnt(0)" ::: "memory"); __builtin_amdgcn_sched_barrier(0);
    f32x2 xp2[16];
#pragma unroll
    for (int i = 0; i < 16; ++i) xp2[i] = (f32x2){xs[sig[2 * i] * 32 + g], xs[sig[2 * i + 1] * 32 + g]};
    const int my_i0 = idx[lane], my_i1 = idx[64 + lane];
    const float su0 = SU[my_i0], sv0 = SV[my_i0], su1 = SU[my_i1], sv1 = SV[my_i1];
    IDG[(size_t)t * 128 + lane] = my_i0; IDG[(size_t)t * 128 + 64 + lane] = my_i1;
    float D[32];
    gload8(B1, UT, idh + 8, g24);  gdot8<0>(B0, xp2, D);
    gload8(B0, UT, idh + 16, g24); gdot8<8>(B1, xp2, D);
    gload8(B1, UT, idh + 24, g24); gdot8<16>(B0, xp2, D);
    gload8(B0, UT, idh + 64, g24); gdot8<24>(B1, xp2, D);
    { const float val = reduce_t32(D, lane); CG[(size_t)t * 128 + lane] = gw[lane] * gelu_t(val * su0) * sv0; }
    asm volatile("" ::: "memory"); __builtin_amdgcn_sched_barrier(0);
    gload8(B1, UT, idh + 72, g24); gdot8<0>(B0, xp2, D);
    gload8(B0, UT, idh + 80, g24); gdot8<8>(B1, xp2, D);
    gload8(B1, UT, idh + 88, g24); gdot8<16>(B0, xp2, D);
    if (tl < 3) { gload8(B0, UT, idh + 128, g24);
#pragma unroll
      for (int q = 0; q < 4; ++q) xr[q] = *(const u32x4*)(HX2 + (size_t)(t + 1) * 1024 + g * 32 + q * 8); }
    gdot8<24>(B1, xp2, D);
    { const float val = reduce_t32(D, lane); CG[(size_t)t * 128 + 64 + lane] = gw[64 + lane] * gelu_t(val * su1) * sv1; }
    asm volatile("s_waitcnt lgkmcnt(0)" ::: "memory"); __builtin_amdgcn_sched_barrier(0);
  }
}
DEVI void ph_peer2(const Params& p, char* smem) {
  const int wave = __builtin_amdgcn_readfirstlane(threadIdx.x >> 6);
  float* xs = (float*)((int*)(smem + 65536) + wave * (32 * 33));
  int* idxw = (int*)(smem + 65536 + 8 * 32 * 33 * 4) + wave * 512; float* gww = (float*)(smem + 65536 + 8 * 32 * 33 * 4 + 8 * 2048) + wave * 512;
  int* sig = (int*)(smem + 65536 + 8 * 32 * 33 * 4 + 16 * 2048) + wave * 32;
  fp6_sigma(sig);
  const unsigned char* VT = (const unsigned char*)(p.ws + O_RA);
  const float* MOD = (const float*)(p.ws + O_MOD);
  const int* IDG = (const int*)(p.ws + O_RQ); const float* CG = (const float*)(p.ws + O_RQ + (size_t)NTOK * 128 * 4);
  for (int item = blockIdx.x; item < NTOK * 8 / 256; item += gridDim.x) {
    int lane = threadIdx.x & 63; asm volatile("" : "+v"(lane));
    const int h = lane >> 5, g = lane & 31, g24 = g * 24;
    const int t0 = item * 32 + wave * 4;
#pragma unroll
    for (int q = 0; q < 2; ++q) { *(int4*)(idxw + q * 256 + lane * 4) = *(const int4*)(IDG + (size_t)t0 * 128 + q * 256 + lane * 4);
      *(float4*)(gww + q * 256 + lane * 4) = *(const float4*)(CG + (size_t)t0 * 128 + q * 256 + lane * 4); }
    asm volatile("s_waitcnt vmcnt(0) lgkmcnt(0)" ::: "memory"); __builtin_amdgcn_sched_barrier(0);
    u32x6 B0[8], B1[8];
    gload8(B0, VT, idxw + h * 32, g24);
#pragma unroll 1
    for (int tl = 0; tl < 4; ++tl) {
      const int t = t0 + tl; const int* idh = idxw + tl * 128 + h * 32; const float* cw = gww + tl * 128 + h * 32;
      f32x2 acc2[16];
#pragma unroll
      for (int i = 0; i < 16; ++i) acc2[i] = (f32x2){0.f, 0.f};
      const int b = t >> 13, c0 = g * 32 + h * 16;
      float* op = p.out + (size_t)t * 1024 + c0;
      float4 xv[4];
#pragma unroll
      for (int q4 = 0; q4 < 4; ++q4) xv[q4] = *(const float4*)(op + q4 * 4);
      asm volatile("" ::: "memory"); __builtin_amdgcn_sched_barrier(0);
      gload8(B1, VT, idh + 8, g24);  gaxpy8(B0, cw, acc2);
      gload8(B0, VT, idh + 16, g24); gaxpy8(B1, cw + 8, acc2);
      gload8(B1, VT, idh + 24, g24); gaxpy8(B0, cw + 16, acc2);
      gload8(B0, VT, idh + 64, g24); gaxpy8(B1, cw + 24, acc2);
      gload8(B1, VT, idh + 72, g24); gaxpy8(B0, cw + 64, acc2);
      gload8(B0, VT, idh + 80, g24); gaxpy8(B1, cw + 72, acc2);
      gload8(B1, VT, idh + 88, g24); gaxpy8(B0, cw + 80, acc2);
      if (tl < 3) gload8(B0, VT, idh + 128, g24);
      gaxpy8(B1, cw + 88, acc2);
      float acc[32];
#pragma unroll
      for (int i = 0; i < 16; ++i) { acc[2 * i] = acc2[i][0]; acc[2 * i + 1] = acc2[i][1]; }
#pragma unroll
      for (int i = 0; i < 32; ++i) { auto rr = __builtin_amdgcn_permlane32_swap(__float_as_uint(acc[i]), __float_as_uint(acc[i]), false, false); acc[i] = __uint_as_float(rr[0]) + __uint_as_float(rr[1]); }
      if (h == 0) {
#pragma unroll
        for (int i = 0; i < 32; ++i) xs[sig[i] * 32 + g] = acc[i]; }
      asm volatile("s_waitcnt lgkmcnt(0)" ::: "memory"); __builtin_amdgcn_sched_barrier(0);
      float o[16]; float ss = 0.f;
#pragma unroll
      for (int j = 0; j < 16; ++j) { o[j] = xs[(16 * h + j) * 32 + g]; ss += o[j] * o[j]; }
      ss = wave_sum(ss); const float rstd = rsqrtf(ss * (1.f / 1024.f) + EPS);
      const float* gt2 = MOD + b * 6144 + 5120 + c0;
#pragma unroll
      for (int q4 = 0; q4 < 4; ++q4) { float4 x4 = xv[q4]; const float4 gt = *(const float4*)(gt2 + q4 * 4), gp = *(const float4*)(p.g_post2 + c0 + q4 * 4);
        x4.x += gt.x * (o[q4 * 4 + 0] * rstd * gp.x); x4.y += gt.y * (o[q4 * 4 + 1] * rstd * gp.y);
        x4.z += gt.z * (o[q4 * 4 + 2] * rstd * gp.z); x4.w += gt.w * (o[q4 * 4 + 3] * rstd * gp.w);
        *(float4*)(op + q4 * 4) = x4; }
      asm volatile("s_waitcnt lgkmcnt(0)" ::: "memory"); __builtin_amdgcn_sched_barrier(0);
    }
  }
}

#define XB_TMO      128
#define XB_XCNT(j)  (256  + 64 * (j))
#define XB_XSUB(j)  (1280 + 64 * (j))
#define XB_XGEN(j)  (2304 + 64 * (j))
#define XB_TOP      3328
#define XB_TOPGEN   3392
#define XCD_BAR_WORDS 3456
#define XB_SPIN_CAP (1u << 18)
#define LAS __attribute__((address_space(3)))
DEVI unsigned xb_ld(unsigned* p)              { return __hip_atomic_load(p, __ATOMIC_RELAXED, __HIP_MEMORY_SCOPE_AGENT); }
DEVI unsigned xb_add(unsigned* p, unsigned v) { return __hip_atomic_fetch_add(p, v, __ATOMIC_RELAXED, __HIP_MEMORY_SCOPE_AGENT); }
DEVI unsigned xb_xcc_id() { return (unsigned)__builtin_amdgcn_s_getreg((3 << 11) | 20) & 0xFu; }
#define XB_SPIN(cond, bar) do { unsigned _sp = 0; while (cond) { __builtin_amdgcn_s_sleep(1); \
    if ((++_sp & 255u) == 0u) { if (xb_ld(&(bar)[XB_TMO])) break; if (_sp > XB_SPIN_CAP) { atomicAdd(&(bar)[XB_TMO], 1u); break; } } } } while (0)
struct XcdBarrier { unsigned* bar; unsigned x; volatile LAS unsigned* st; };
DEVI XcdBarrier xcd_barrier_post(unsigned* bar, volatile LAS unsigned* st) {
  XcdBarrier b; b.bar = bar; b.x = xb_xcc_id(); b.st = st;
  if (threadIdx.x == 0) (void)xb_add(&bar[XB_XCNT(b.x)], 1u);
  return b;
}
DEVI void xcd_barrier_complete(unsigned* bar, unsigned x, unsigned& nloc, unsigned& nx) {
  const unsigned G = gridDim.x * gridDim.y * gridDim.z;
  unsigned sum, cnt, mine, sp = 0u;
  for (;;) {
    sum = 0u; cnt = 0u; mine = 0u;
#pragma unroll
    for (unsigned j = 0; j < 16; ++j) { const unsigned c = xb_ld(&bar[XB_XCNT(j)]); sum += c; cnt += (c > 0u) ? 1u : 0u; mine = (j == x) ? c : mine; }
    if (sum == G) break;
    __builtin_amdgcn_s_sleep(1);
    if ((++sp & 255u) == 0u) { if (xb_ld(&bar[XB_TMO])) break; if (sp > XB_SPIN_CAP) { atomicAdd(&bar[XB_TMO], 1u); break; } }
  }
  nloc = mine > 0u ? mine : 1u; nx = cnt > 0u ? cnt : 1u;
}
DEVI void xcd_barrier(const XcdBarrier& b) {
  asm volatile("s_waitcnt vmcnt(0)" ::: "memory");
  __syncthreads();
  if (threadIdx.x == 0) {
    unsigned* bar = b.bar;
    __builtin_amdgcn_s_waitcnt(0);
    unsigned nloc = b.st[0], nx = b.st[1];
    if (nloc == 0u) { xcd_barrier_complete(bar, b.x, nloc, nx); b.st[0] = nloc; b.st[1] = nx; }
    const unsigned old = xb_add(&bar[XB_XSUB(b.x)], 1u);
    const unsigned gen = old / nloc;
    if (old + 1u == (gen + 1u) * nloc) {
      __builtin_amdgcn_fence(__ATOMIC_RELEASE, "agent");
      asm volatile("s_waitcnt vmcnt(0)" ::: "memory");
      const unsigned og = xb_add(&bar[XB_TOP], 1u);
      const unsigned tg = og / nx;
      if (og + 1u == (tg + 1u) * nx) xb_add(&bar[XB_TOPGEN], 1u);
      else XB_SPIN(xb_ld(&bar[XB_TOPGEN]) == tg, bar);
      __builtin_amdgcn_fence(__ATOMIC_ACQUIRE, "agent");
      xb_add(&bar[XB_XGEN(b.x)], 1u);
      asm volatile("s_waitcnt vmcnt(0)" ::: "memory");
    } else {
      XB_SPIN(xb_ld(&bar[XB_XGEN(b.x)]) == gen, bar);
      __builtin_amdgcn_fence(__ATOMIC_ACQUIRE, "agent");
      asm volatile("s_waitcnt vmcnt(0)" ::: "memory");
    }
  }
  __syncthreads();
}

constexpr int NPHASE = 12;
template <int PH> DEVI void run_phase(const Params& p, char* smem) {
  if constexpr (PH == 0) ph_prep(p, smem);
  else if constexpr (PH == 1) ph_hx(p, smem);
  else if constexpr (PH == 2) ph_inproj(p, smem);
  else if constexpr (PH == 3) ph_mid(p, smem);
  else if constexpr (PH == 4) ph_attn(p, smem);
  else if constexpr (PH == 5) ph_gates(p, smem);
  else if constexpr (PH == 6) ph_merge(p, smem);
  else if constexpr (PH == 7) ph_wo(p, smem);
  else if constexpr (PH == 8) ph_rows(p, smem);
  else if constexpr (PH == 9) ph_wpq(p, smem);
  else if constexpr (PH == 10) ph_topk(p, smem);
  else if constexpr (PH == 11) ph_peer2(p, smem);
}

#define RUNPH(N) do { run_phase<N>(p, smem); if (N < NPHASE - 1) xcd_barrier(xb); } while (0)
__global__ __launch_bounds__(NTHR) void k_mega(Params p) {
  extern __shared__ __attribute__((aligned(16))) char smem[];
  cg::grid_group grid = cg::this_grid();
  unsigned* bar = (unsigned*)(p.ws + O_BAR);
  volatile LAS unsigned* xst = (volatile LAS unsigned*)(smem + LDS_BYTES - 16);
  if (threadIdx.x == 0) { xst[0] = 0u; xst[1] = 0u; }
  __syncthreads();
  const XcdBarrier xb = xcd_barrier_post(bar, xst);
  if (p.out == nullptr) grid.sync();
  RUNPH(0);
  RUNPH(1); RUNPH(2); RUNPH(3); RUNPH(4); RUNPH(5); RUNPH(6); RUNPH(7); RUNPH(8); RUNPH(9); RUNPH(10); RUNPH(11);
}

extern "C" void kernel_launch(void* const* d_in, const int* in_sizes, int n_in, void* d_out, int out_size, void* d_ws, size_t ws_size, hipStream_t stream) {
  static int grid = 0;
  if (grid == 0) {
    if (n_in != 26 || out_size != NTOK * DM || ws_size < O_END) { fprintf(stderr, "kernel_launch: unexpected shapes n_in %d out %d ws %zu (need %zu)\n", n_in, out_size, ws_size, (size_t)O_END); grid = -1; return; }
    (void)hipFuncSetAttribute((const void*)k_mega, hipFuncAttributeMaxDynamicSharedMemorySize, LDS_BYTES);
    int dev = 0, cus = 0, per_cu = 0; (void)hipGetDevice(&dev); (void)hipDeviceGetAttribute(&cus, hipDeviceAttributeMultiprocessorCount, dev);
    (void)hipOccupancyMaxActiveBlocksPerMultiprocessor(&per_cu, (const void*)k_mega, NTHR, LDS_BYTES);
    if (per_cu < 1) { fprintf(stderr, "kernel_launch: occupancy query says %d blocks per CU\n", per_cu); grid = -1; return; }
    grid = cus;
  }
  if (grid < 0) return;
  Params p{};
  const float** pp = (const float**)&p;
  for (int i = 0; i < 26; ++i) pp[i] = (const float*)d_in[i];
  p.out = (float*)d_out; p.ws = (char*)d_ws;
  (void)hipMemsetAsync((char*)d_ws + O_BAR, 0, (size_t)XCD_BAR_WORDS * 4, stream);
  void* args[] = {&p};
  hipError_t e = hipLaunchCooperativeKernel((const void*)k_mega, dim3(grid), dim3(NTHR), args, LDS_BYTES, stream);
  if (e != hipSuccess) fprintf(stderr, "cooperative launch failed: %s (grid %d)\n", hipGetErrorString(e), grid);
}
```

```cpp
#include <hip/hip_runtime.h>
#include <hip/hip_cooperative_groups.h>
#include <cstdint>
#include <cstdio>
namespace cg = cooperative_groups;

#define DEVI __device__ __forceinline__
typedef unsigned short bf16_t;
using bf16x8 = __attribute__((ext_vector_type(8))) short;
using bf16x4 = __attribute__((ext_vector_type(4))) short;
using f32x4  = __attribute__((ext_vector_type(4))) float;
using f32x16 = __attribute__((ext_vector_type(16))) float;
using u32x4  = __attribute__((ext_vector_type(4))) unsigned;
using u32x2  = __attribute__((ext_vector_type(2))) unsigned;

constexpr int DM = 1024, NB = 2, SEQ = 8192, NTOK = NB * SEQ, CTXL = 256, NCTX = NB * CTXL, NROW = NTOK + NCTX, NKEY = SEQ + CTXL;
constexpr int INW = 4544, INWP = 4608;
constexpr int NPRE = 2560;
constexpr float EPS = 1e-6f;
constexpr int NTHR = 512, NWAVE = 8;
constexpr int LDS_BYTES = 147456;

constexpr size_t al256(size_t x) { return (x + 255) / 256 * 256; }
constexpr size_t O_WIN   = 0;
constexpr size_t O_WUQ   = O_WIN  + al256((size_t)INWP * 1024 * 2);
constexpr size_t O_WUKV  = O_WUQ  + al256((size_t)1536 * 256 * 2);
constexpr size_t O_WPA   = O_WUKV + al256((size_t)2048 * 128 * 2);
constexpr size_t O_WPB   = O_WPA  + al256((size_t)1024 * 1024 * 2);
constexpr size_t O_WO    = O_WPB  + al256((size_t)1024 * 1024 * 2);
constexpr size_t O_WPQ   = O_WO   + al256((size_t)1024 * 1024 * 2);
constexpr size_t O_WS    = O_WPQ  + al256((size_t)2048 * 1024 * 2);
constexpr size_t O_K1    = O_WS   + al256((size_t)8 * 128 * 128 * 2);
constexpr size_t O_K2    = O_K1   + al256((size_t)128 * 128 * 2);
constexpr size_t O_MOD   = O_K2   + al256((size_t)128 * 128 * 2);
constexpr size_t O_ROPE  = O_MOD  + al256((size_t)3 * 6144 * 4);
constexpr size_t O_BAR   = O_ROPE + al256((size_t)128 * 16 * 2 * 4);
constexpr size_t O_RSSV  = O_BAR + al256((size_t)3456 * 4);
constexpr size_t O_RSSQ  = O_RSSV + (size_t)NTOK * 32 * 4;
constexpr size_t O_RSSKV = O_RSSQ + (size_t)NTOK * 8 * 4;
constexpr size_t O_RSSY  = O_RSSKV + (size_t)NROW * 4 * 4;
constexpr size_t O_RSSEND = O_RSSY + (size_t)NTOK * 32 * 4;
constexpr size_t O_RA    = al256(O_RSSEND);
constexpr size_t O_RB    = O_RA  + al256((size_t)NROW * 1024 * 2);
constexpr size_t O_RC    = O_RB  + al256((size_t)NTOK * 1024 * 2);
constexpr size_t O_CQ    = O_RC  + al256((size_t)NTOK * 1024 * 2);
constexpr size_t O_CKV   = O_CQ  + al256((size_t)NTOK * 256 * 2);
constexpr size_t O_KR    = O_CKV + al256((size_t)NROW * 128 * 2);
constexpr size_t O_RQ    = O_KR  + al256((size_t)NROW * 64 * 2);
constexpr size_t O_RKV   = O_RQ  + al256((size_t)NTOK * 1536 * 2);
constexpr size_t O_END   = O_RKV + al256((size_t)NROW * 2048 * 2);
static_assert(O_END <= (size_t)258 * 1024 * 1024, "workspace too large");

struct Params {
  const float *x, *c, *ctx, *c_ctx, *w_mod, *b_mod, *g_pre1, *g_post1, *g_pre2, *g_post2, *w_in, *g_q, *g_kv, *w_uq, *w_ukv, *g_sgu, *w_s, *b_s,
      *w_pa, *w_pb, *w_o, *w_pq, *k1, *k2, *u_exp, *v_exp;
  float* out; char* ws;
};

DEVI float bf2f(unsigned short h) { return __uint_as_float(((unsigned)h) << 16); }
DEVI unsigned short f2bf(float f) { unsigned u = __float_as_uint(f); u += 0x7fffu + ((u >> 16) & 1u); return (unsigned short)(u >> 16); }
typedef __bf16 bf16x2_t __attribute__((ext_vector_type(2)));
typedef float f32x2v_t __attribute__((ext_vector_type(2)));
DEVI unsigned pack2(float a, float b) { const f32x2v_t v = {a, b}; return __builtin_bit_cast(unsigned, __builtin_convertvector(v, bf16x2_t)); }
DEVI float lo2f(unsigned w) { return __uint_as_float(w << 16); }
DEVI float hi2f(unsigned w) { return __uint_as_float(w & 0xffff0000u); }
DEVI void unpack8(const u32x4& w, float* f) {
  f[0] = lo2f(w[0]); f[1] = hi2f(w[0]); f[2] = lo2f(w[1]); f[3] = hi2f(w[1]); f[4] = lo2f(w[2]); f[5] = hi2f(w[2]); f[6] = lo2f(w[3]); f[7] = hi2f(w[3]);
}
DEVI float gelu_t(float x) { const float z = 0.7978845608028654f * (x + 0.044715f * x * x * x); return x * __builtin_amdgcn_rcpf(1.f + __expf(-2.f * z)); }
DEVI float sigmoidf_(float x) { return __builtin_amdgcn_rcpf(1.f + __expf(-x)); }
DEVI float wave_sum(float v) { for (int o = 32; o > 0; o >>= 1) v += __shfl_xor(v, o); return v; }
DEVI float wave_max(float v) { for (int o = 32; o > 0; o >>= 1) v = fmaxf(v, __shfl_xor(v, o)); return v; }
DEVI void keyrow2(int row, int& b, int& key) { if (row < NTOK) { b = row >> 13; key = row & 8191; } else { const int c = row - NTOK; b = c >> 8; key = SEQ + (c & 255); } }
DEVI int keyrow(int row) { if (row < NTOK) return (row >> 13) * NKEY + (row & 8191); int c = row - NTOK; return (c >> 8) * NKEY + SEQ + (c & 255); }

__device__ const float ROPE_FREQ[16] = {1.0f, 0.5623413324356079f, 0.3162277638912201f, 0.17782793939113617f, 0.10000000149011612f, 0.05623413249850273f, 0.03162277489900589f, 0.017782794311642647f, 0.009999999776482582f, 0.005623413249850273f, 0.003162277629598975f, 0.0017782794311642647f, 0.0010000000474974513f, 0.000562341301701963f, 0.0003162277571391314f, 0.00017782794020604342f};
DEVI void sincos_small(double a, double& cs, double& sn) {
  const double k = rint(a * 0.15915494309189535); const double r = fma(-k, 6.283185307179586, a) - k * 2.4492935982947064e-16;
  const double r2 = r * r; double s = 0.0, c = 0.0;
#pragma unroll
  for (int n = 12; n >= 1; --n) { s = (1.0 - s * r2 / (double)((2 * n) * (2 * n + 1))); c = (1.0 - c * r2 / (double)((2 * n - 1) * (2 * n))); }
  sn = r * s; cs = c;
}

DEVI void transpose_job(const float* __restrict__ src, int K, int N, bf16_t* __restrict__ dst, const float* __restrict__ gk, bool isWin, int ntiles, char* smem) {
  const int tid = threadIdx.x; bf16_t* tl = (bf16_t*)smem; const int kt = K / 64;
  for (int idx = blockIdx.x; idx < ntiles; idx += gridDim.x) {
    const int ktile = idx % kt, ntile = idx / kt, k0 = ktile * 64, n0d = ntile * 64;
    int n0s = n0d; bool zero = false;
    if (isWin) { if (n0d == 2496) zero = true; else if (n0d >= 2560) n0s = n0d - 64; }
    { const int kk = tid >> 3, nn8 = (tid & 7) * 8; f32x4 va = {0.f, 0.f, 0.f, 0.f}, vb = va;
      if (!zero) { const float* s = src + (size_t)(k0 + kk) * N + n0s + nn8; const float4 a = *(const float4*)s, b = *(const float4*)(s + 4);
        const float sc = gk ? gk[k0 + kk] : 1.f; va = (f32x4){a.x, a.y, a.z, a.w} * sc; vb = (f32x4){b.x, b.y, b.z, b.w} * sc; }
      bf16_t* tp = tl + nn8 * 72 + kk;
      tp[0] = f2bf(va[0]); tp[72] = f2bf(va[1]); tp[144] = f2bf(va[2]); tp[216] = f2bf(va[3]); tp[288] = f2bf(vb[0]); tp[360] = f2bf(vb[1]); tp[432] = f2bf(vb[2]); tp[504] = f2bf(vb[3]); }
    __syncthreads();
    { const int nn = tid >> 3, kk8 = (tid & 7) * 8;
      const u32x4 o = *(const u32x4*)(tl + nn * 72 + kk8);
      *(u32x4*)(dst + (size_t)(n0d + nn) * K + k0 + kk8) = o; }
    __syncthreads();
  }
}

DEVI void ph_prep(const Params& p, char* smem) {
  const int tid = threadIdx.x, bid = blockIdx.x, nb = gridDim.x;
  char* ws = p.ws;
  if (bid == 0) { float* rope = (float*)(ws + O_ROPE);
    for (int i = tid; i < 128 * 16; i += NTHR) { const int pos = i >> 4, f = i & 15; const float ang = (float)pos * ROPE_FREQ[f];
      double cs, sn; sincos_small((double)ang, cs, sn); rope[i * 2] = (float)cs; rope[i * 2 + 1] = (float)sn; } }
  { float* red = (float*)smem; float* MOD = (float*)(ws + O_MOD);
    for (int it = bid; it < 256; it += nb) {
      const int cgp = tid % 6, kg = tid / 6;
      f32x4 a0 = {0.f, 0.f, 0.f, 0.f}, a1 = a0, a2 = a0;
      if (tid < 510) {
        for (int k = kg; k < 1024; k += 85) {
          const float4 w4 = *(const float4*)(p.w_mod + (size_t)k * 6144 + it * 24 + cgp * 4);
          const f32x4 w = {w4.x, w4.y, w4.z, w4.w};
          const float c0 = p.c[k], c1 = p.c[1024 + k], c2 = p.c_ctx[k];
          a0 += w * (c0 / (1.f + __expf(-c0))); a1 += w * (c1 / (1.f + __expf(-c1))); a2 += w * (c2 / (1.f + __expf(-c2)));
        }
        float* rp = red + kg * 72 + cgp * 4;
        rp[0] = a0[0]; rp[1] = a0[1]; rp[2] = a0[2]; rp[3] = a0[3];
        rp[24] = a1[0]; rp[25] = a1[1]; rp[26] = a1[2]; rp[27] = a1[3];
        rp[48] = a2[0]; rp[49] = a2[1]; rp[50] = a2[2]; rp[51] = a2[3];
      }
      __syncthreads();
      if (tid < 72) { float s = 0.f; for (int g = 0; g < 85; ++g) s += red[g * 72 + tid]; int r = tid / 24, n = it * 24 + tid % 24; MOD[r * 6144 + n] = s + p.b_mod[n]; }
      __syncthreads();
    } }
  transpose_job(p.w_in,  1024, INW,  (bf16_t*)(ws + O_WIN),  nullptr, true,  1152, smem);
  transpose_job(p.w_uq,  256,  1536, (bf16_t*)(ws + O_WUQ),  p.g_q,   false, 96,   smem);
  transpose_job(p.w_ukv, 128,  2048, (bf16_t*)(ws + O_WUKV), p.g_kv,  false, 64,   smem);
  transpose_job(p.w_pa,  1024, 1024, (bf16_t*)(ws + O_WPA),  nullptr, false, 256,  smem);
  transpose_job(p.w_pb,  1024, 1024, (bf16_t*)(ws + O_WPB),  nullptr, false, 256,  smem);
  transpose_job(p.w_o,   1024, 1024, (bf16_t*)(ws + O_WO),   nullptr, false, 256,  smem);
  transpose_job(p.w_pq,  1024, 2048, (bf16_t*)(ws + O_WPQ),  nullptr, false, 512,  smem);
  { const int n8 = (131072 + 16384 + 16384) / 8;
    for (int i = bid * NTHR + tid; i < n8; i += nb * NTHR) {
      int e = i * 8; const float* s; bf16_t* d;
      if (e < 131072) { s = p.w_s + e; d = (bf16_t*)(ws + O_WS) + e; }
      else if (e < 131072 + 16384) { s = p.k1 + (e - 131072); d = (bf16_t*)(ws + O_K1) + (e - 131072); }
      else { s = p.k2 + (e - 131072 - 16384); d = (bf16_t*)(ws + O_K2) + (e - 131072 - 16384); }
      const float4 a = *(const float4*)s, b = *(const float4*)(s + 4);
      u32x4 o = {pack2(a.x, a.y), pack2(a.z, a.w), pack2(b.x, b.y), pack2(b.z, b.w)};
      *(u32x4*)d = o;
    } }
}


using f32x32 = __attribute__((ext_vector_type(32))) float;
using u32x6 = __attribute__((ext_vector_type(6))) unsigned;
typedef u32x4 __attribute__((aligned(4))) u32x4_u;
typedef u32x2 __attribute__((aligned(4))) u32x2_u;
DEVI void convert_table_fp6(const float* __restrict__ src, unsigned char* __restrict__ dst, float* __restrict__ scale) {
  const int wave = threadIdx.x >> 6, lane = threadIdx.x & 63, h = lane >> 5, g = lane & 31;
  for (int rp = blockIdx.x * NWAVE + wave; rp < 8192; rp += gridDim.x * NWAVE) {
    const int row = rp * 2 + h;
    const float* sp = src + (size_t)row * 1024 + g * 4;
    f32x16 a, b; float am = 0.f;
#pragma unroll
    for (int j = 0; j < 8; ++j) { const float4 t = *(const float4*)(sp + 128 * j);
      a[2 * j] = t.x; b[2 * j] = t.y; a[2 * j + 1] = t.z; b[2 * j + 1] = t.w;
      am = fmaxf(am, fmaxf(fmaxf(fabsf(t.x), fabsf(t.y)), fmaxf(fabsf(t.z), fabsf(t.w)))); }
    for (int o = 16; o > 0; o >>= 1) am = fmaxf(am, __shfl_xor(am, o));
    const float inv = am > 0.f ? 7.5f / am : 0.f;
    const u32x6 w = __builtin_amdgcn_cvt_scalef32_2xpk16_fp6_f32(a * inv, b * inv, 1.0f);
    unsigned char* dp = dst + (size_t)row * 768 + g * 24;
    *(u32x4_u*)dp = (u32x4){w[0], w[1], w[2], w[3]}; *(u32x2_u*)(dp + 16) = (u32x2){w[4], w[5]};
    if (g == 0) scale[row] = am * (1.f / 7.5f);
  }
}

DEVI void ph_hx(const Params& p, char* smem) {
  const int tid = threadIdx.x, wave = tid >> 6, lane = tid & 63;
  float* mA = (float*)smem; float* mB = mA + 3 * 1024;
  const float* MOD = (const float*)(p.ws + O_MOD);
  for (int i = tid; i < 3072; i += NTHR) { int r = i >> 10, c = i & 1023; mA[i] = p.g_pre1[c] * (1.f + MOD[r * 6144 + 1024 + c]); mB[i] = MOD[r * 6144 + c]; }
  __syncthreads();
  bf16_t* HX = (bf16_t*)(p.ws + O_RA);
  for (int row = blockIdx.x * NWAVE + wave; row < NROW; row += gridDim.x * NWAVE) {
    const float* src = row < NTOK ? p.x + (size_t)row * 1024 : p.ctx + (size_t)(row - NTOK) * 1024;
    const int mr = row < NTOK ? (row >> 13) : 2;
    float4 v[4]; float ss = 0.f;
#pragma unroll
    for (int i = 0; i < 4; ++i) { v[i] = *(const float4*)(src + i * 256 + lane * 4); ss += v[i].x * v[i].x + v[i].y * v[i].y + v[i].z * v[i].z + v[i].w * v[i].w; }
    ss = wave_sum(ss); const float rstd = rsqrtf(ss * (1.f / 1024.f) + EPS);
#pragma unroll
    for (int i = 0; i < 4; ++i) { const int c = i * 256 + lane * 4; const float* a = mA + mr * 1024 + c; const float* b = mB + mr * 1024 + c;
      u32x2 o = {pack2(v[i].x * rstd * a[0] + b[0], v[i].y * rstd * a[1] + b[1]), pack2(v[i].z * rstd * a[2] + b[2], v[i].w * rstd * a[3] + b[3])};
      *(u32x2*)(HX + (size_t)row * 1024 + c) = o; }
  }
}

DEVI int lds_sw(int row, int c) { return row * 128 + ((c ^ (row & 7)) << 4); }
template <int BM, int BN, bool ACOLMAP, bool GLDS, class Epi>
DEVI void gemm_tile_mfma(const bf16_t* __restrict__ A, int lda, const bf16_t* __restrict__ Bm, int ldb, int K, int row0, int col0, const Epi& epi, const float* kscale, char* smem) {
  constexpr int WNW = BN / 64, WMW = 8 / WNW, WTM = BM / WMW, MI = WTM / 16, ACH = BM / 64, BCH = BN / 64, ABYTES = BM * 128, BBYTES = BN * 128, STAGE = ABYTES + BBYTES;
  int tid = threadIdx.x; asm volatile("" : "+v"(tid));
  const int wave = __builtin_amdgcn_readfirstlane(tid >> 6), lane = tid & 63, wm = wave / WNW, wn = wave % WNW, l15 = lane & 15, lq = lane >> 4;
  f32x4 acc[MI][4];
#pragma unroll
  for (int mi = 0; mi < MI; ++mi)
#pragma unroll
    for (int ni = 0; ni < 4; ++ni) acc[mi][ni] = (f32x4){0.f, 0.f, 0.f, 0.f};
  const int nk = K >> 6;
  const int sr = tid >> 3, scc = tid & 7;
  auto compute = [&](int buf) {
    const char* sa = smem + buf * STAGE; const char* sb = sa + ABYTES;
#pragma unroll
    for (int ks = 0; ks < 2; ++ks) { const int kc = ks * 4 + lq; bf16x8 bfr[4];
#pragma unroll
      for (int ni = 0; ni < 4; ++ni) bfr[ni] = *(const bf16x8*)(sb + lds_sw(wn * 64 + ni * 16 + l15, kc));
#pragma unroll
      for (int mi = 0; mi < MI; ++mi) { const bf16x8 af = *(const bf16x8*)(sa + lds_sw(wm * WTM + mi * 16 + l15, kc));
#pragma unroll
        for (int ni = 0; ni < 4; ++ni) acc[mi][ni] = __builtin_amdgcn_mfma_f32_16x16x32_bf16(bfr[ni], af, acc[mi][ni], 0, 0, 0); }
    }
  };
  if constexpr (GLDS) {
    const unsigned aoff = (unsigned)(sr * lda + ((scc ^ (sr & 7)) * 8)) * 2u, boff = (unsigned)(sr * ldb + ((scc ^ (sr & 7)) * 8)) * 2u;
    auto gstage = [&](int buf, int kt) {
      const int k0 = kt * 64, ka = ACOLMAP ? k0 + (k0 >> 7) * 64 : k0;
      char* sa = smem + buf * STAGE + wave * 1024; char* sb = sa + ABYTES;
#pragma unroll
      for (int i = 0; i < ACH; ++i) __builtin_amdgcn_global_load_lds((const unsigned*)((const char*)(A + (size_t)(64 * i) * lda + ka) + aoff), (unsigned*)(sa + i * 8192), 16, 0, 0);
#pragma unroll
      for (int i = 0; i < BCH; ++i) __builtin_amdgcn_global_load_lds((const unsigned*)((const char*)(Bm + (size_t)(64 * i) * ldb + k0) + boff), (unsigned*)(sb + i * 8192), 16, 0, 0);
    };
    gstage(0, 0); asm volatile("s_waitcnt vmcnt(0)" ::: "memory"); __syncthreads();
    for (int kt = 0; kt < nk; ++kt) {
      if (kt + 1 < nk) gstage((kt + 1) & 1, kt + 1);
      compute(kt & 1);
      asm volatile("s_waitcnt vmcnt(0)" ::: "memory"); __syncthreads();
    }
  } else {
    u32x4 ra[ACH], rb[BCH];
    const unsigned aoff = (unsigned)(sr * lda + scc * 8) * 2u, boff = (unsigned)(sr * ldb + scc * 8) * 2u;
    const int sdst = lds_sw(sr, scc);
    auto gload = [&](int kt) {
      const int k0 = kt * 64, ka = ACOLMAP ? k0 + (k0 >> 7) * 64 : k0;
#pragma unroll
      for (int i = 0; i < ACH; ++i) { const char* ub = (const char*)(A + (size_t)(64 * i) * lda + ka); ra[i] = *(const u32x4*)(ub + aoff); }
#pragma unroll
      for (int i = 0; i < BCH; ++i) { const char* ub = (const char*)(Bm + (size_t)(64 * i) * ldb + k0); rb[i] = *(const u32x4*)(ub + boff); }
    };
    auto lstore = [&](int buf, int kt) {
      char* sa = smem + buf * STAGE + sdst; char* sb = sa + ABYTES;
#pragma unroll
      for (int i = 0; i < ACH; ++i) { u32x4 v = ra[i];
        if (kscale) { float f[8]; unpack8(v, f); const float* ks = kscale + kt * 64 + scc * 8;
          v = (u32x4){pack2(f[0] * ks[0], f[1] * ks[1]), pack2(f[2] * ks[2], f[3] * ks[3]), pack2(f[4] * ks[4], f[5] * ks[5]), pack2(f[6] * ks[6], f[7] * ks[7])}; }
        *(u32x4*)(sa + i * 8192) = v; }
#pragma unroll
      for (int i = 0; i < BCH; ++i) *(u32x4*)(sb + i * 8192) = rb[i];
    };
    gload(0); lstore(0, 0); __syncthreads();
    for (int kt = 0; kt < nk; ++kt) {
      if (kt + 1 < nk) gload(kt + 1);
      compute(kt & 1);
      if (kt + 1 < nk) lstore((kt + 1) & 1, kt + 1);
      __syncthreads();
    }
  }
  int tide = threadIdx.x; asm volatile("" : "+v"(tide));
  const int l15e = tide & 15, lqe = (tide >> 4) & 3;
  float cs[4][4];
  if constexpr (Epi::SCALE_MODE == 2) {
#pragma unroll
    for (int ni = 0; ni < 4; ++ni)
#pragma unroll
      for (int j = 0; j < 4; ++j) cs[ni][j] = epi.colscale(col0 + wn * 64 + ni * 16 + lqe * 4 + j); }
#pragma unroll
  for (int mi = 0; mi < MI; ++mi) { const int row = row0 + wm * WTM + mi * 16 + l15e; float sq = 0.f; float rs = 1.f;
    if constexpr (Epi::SCALE_MODE == 1) rs = epi.rowscale(row);
#pragma unroll
    for (int ni = 0; ni < 4; ++ni) { float v[4] = {acc[mi][ni][0], acc[mi][ni][1], acc[mi][ni][2], acc[mi][ni][3]};
      if constexpr (Epi::SCALE_MODE == 1) { v[0] *= rs; v[1] *= rs; v[2] *= rs; v[3] *= rs; }
      if constexpr (Epi::SCALE_MODE == 2) { v[0] *= cs[ni][0]; v[1] *= cs[ni][1]; v[2] *= cs[ni][2]; v[3] *= cs[ni][3]; }
      const float q = epi(row, col0 + wn * 64 + ni * 16 + lqe * 4, v);
      if (Epi::RSS) { sq += q; if (ni & 1) { sq += __shfl_xor(sq, 16); sq += __shfl_xor(sq, 32); if (lqe == 0) epi.rss(row, col0 + wn * 64 + (ni >> 1) * 32, sq); sq = 0.f; } } }
    __builtin_amdgcn_sched_barrier(0); }
}


namespace g8 {
constexpr int BK = 64, HALF = 128, HT = HALF * BK;
DEVI int lds_byte(int r, int c) { const int st = (r >> 4) * 2 + (c >> 5), rr = r & 15, cc = c & 31, ob = rr * 64 + cc * 2; return st * 1024 + (ob ^ (((ob >> 9) & 1) << 5)); }
DEVI void stage_rc(int b, int& R, int& C) { const int st = b / 1024, sb = b % 1024, swz = sb ^ (((sb >> 9) & 1) << 5); R = (st >> 1) * 16 + swz / 64; C = (st & 1) * 32 + (swz % 64) / 2; }
}
template <bool ACOLMAP, class Epi>
DEVI void gemm_tile_8ph(const bf16_t* __restrict__ A, int lda, const bf16_t* __restrict__ Bt, int ldb, int K, int row0, int col0, const Epi& epi, char* smem) {
  using namespace g8;
  bf16_t* shm = (bf16_t*)smem;
#define SA(b, h) (shm + ((b) * 2 + (h)) * HT)
#define SB(b, h) (shm + (4 + (b) * 2 + (h)) * HT)
#define STAGE_A(P, r0, kt) do { const int _k0 = (kt) * BK, _ka = ACOLMAP ? _k0 + (_k0 >> 7) * 64 : _k0; \
    __builtin_amdgcn_global_load_lds((const unsigned*)((const char*)(A + (size_t)(r0) * lda + _ka) + ao0), (unsigned*)((char*)(P) + wid * 1024), 16, 0, 0); \
    __builtin_amdgcn_global_load_lds((const unsigned*)((const char*)(A + (size_t)((r0) + 64) * lda + _ka) + ao0), (unsigned*)((char*)(P) + wid * 1024 + 8192), 16, 0, 0); } while (0)
#define STAGE_B(P, r0, kt) do { const int _k0 = (kt) * BK; \
    __builtin_amdgcn_global_load_lds((const unsigned*)((const char*)(Bt + (size_t)(r0) * ldb + _k0) + bo0), (unsigned*)((char*)(P) + wid * 1024), 16, 0, 0); \
    __builtin_amdgcn_global_load_lds((const unsigned*)((const char*)(Bt + (size_t)((r0) + 64) * ldb + _k0) + bo0), (unsigned*)((char*)(P) + wid * 1024 + 8192), 16, 0, 0); } while (0)
#define LDA(dst, b, h) _Pragma("unroll") for (int m = 0; m < 4; ++m) _Pragma("unroll") for (int k = 0; k < 2; ++k) \
    dst[m][k] = *reinterpret_cast<const bf16x8*>((const char*)SA(b, h) + lds_byte(wr * 64 + m * 16 + fr, k * 32 + fq * 8))
#define LDB(dst, b, h) _Pragma("unroll") for (int n = 0; n < 2; ++n) _Pragma("unroll") for (int k = 0; k < 2; ++k) \
    dst[n][k] = *reinterpret_cast<const bf16x8*>((const char*)SB(b, h) + lds_byte(wc * 32 + n * 16 + fr, k * 32 + fq * 8))
#define MMA(ai, bj, At_, Bt_) do { __builtin_amdgcn_s_setprio(1); \
    _Pragma("unroll") for (int m = 0; m < 4; ++m) _Pragma("unroll") for (int n = 0; n < 2; ++n) _Pragma("unroll") for (int k = 0; k < 2; ++k) \
      acc[ai][bj][m][n] = __builtin_amdgcn_mfma_f32_16x16x32_bf16(Bt_[n][k], At_[m][k], acc[ai][bj][m][n], 0, 0, 0); \
    __builtin_amdgcn_s_setprio(0); } while (0)
#define WAIT_V(n) asm volatile("s_waitcnt vmcnt(" #n ")" ::: "memory")
#define WAIT_L(n) asm volatile("s_waitcnt lgkmcnt(" #n ")" ::: "memory")
#define BAR __builtin_amdgcn_s_barrier()
#define SCHED __builtin_amdgcn_sched_barrier(0)
  int tid = threadIdx.x; asm volatile("" : "+v"(tid));
  const int wid = __builtin_amdgcn_readfirstlane(tid >> 6), lane = tid & 63, wr = wid >> 2, wc = wid & 3, fr = lane & 15, fq = lane >> 4;
  unsigned ao0, bo0;
  { int r, c; stage_rc(tid * 16, r, c); ao0 = (unsigned)(r * lda + c) * 2u; bo0 = (unsigned)(r * ldb + c) * 2u; }
  f32x4 acc[2][2][4][2];
#pragma unroll
  for (int a = 0; a < 2; ++a)
#pragma unroll
    for (int b = 0; b < 2; ++b)
#pragma unroll
      for (int m = 0; m < 4; ++m)
#pragma unroll
        for (int n = 0; n < 2; ++n) acc[a][b][m][n] = (f32x4){0.f, 0.f, 0.f, 0.f};
  bf16x8 At[4][2], B0[2][2], B1[2][2];
  const int nt = K / BK;
  STAGE_B(SB(0, 0), 0, 0); STAGE_A(SA(0, 0), 0, 0);
  STAGE_B(SB(0, 1), HALF, 0); STAGE_A(SA(0, 1), HALF, 0);
  if (wr == 1) BAR;
  WAIT_V(4); BAR;
  STAGE_B(SB(1, 0), 0, 1); STAGE_A(SA(1, 0), 0, 1); STAGE_B(SB(1, 1), HALF, 1);
  WAIT_V(6); BAR;
  for (int t = 0; t < nt - 2; t += 2) {
    LDB(B0, 0, 0); SCHED; LDA(At, 0, 0); STAGE_A(SA(1, 1), HALF, t + 1);
    WAIT_L(8); BAR; WAIT_L(0); MMA(0, 0, At, B0); BAR; SCHED;
    LDB(B1, 0, 1); STAGE_B(SB(0, 0), 0, t + 2);
    BAR; WAIT_L(0); MMA(0, 1, At, B1); BAR;
    LDA(At, 0, 1); STAGE_A(SA(0, 0), 0, t + 2);
    BAR; WAIT_L(0); MMA(1, 0, At, B0); BAR; SCHED;
    STAGE_B(SB(0, 1), HALF, t + 2);
    WAIT_V(6); BAR; MMA(1, 1, At, B1); BAR;
    LDB(B0, 1, 0); SCHED; LDA(At, 1, 0); STAGE_A(SA(0, 1), HALF, t + 2);
    WAIT_L(8); BAR; WAIT_L(0); MMA(0, 0, At, B0); BAR; SCHED;
    LDB(B1, 1, 1); STAGE_B(SB(1, 0), 0, t + 3);
    BAR; WAIT_L(0); MMA(0, 1, At, B1); BAR;
    LDA(At, 1, 1); STAGE_A(SA(1, 0), 0, t + 3);
    BAR; WAIT_L(0); MMA(1, 0, At, B0); BAR; SCHED;
    STAGE_B(SB(1, 1), HALF, t + 3);
    WAIT_V(6); BAR; MMA(1, 1, At, B1); BAR;
  }
  { LDB(B0, 0, 0); LDA(At, 0, 0); STAGE_A(SA(1, 1), HALF, nt - 1);
    BAR; WAIT_L(0); MMA(0, 0, At, B0); BAR;
    LDB(B1, 0, 1); BAR; WAIT_L(0); MMA(0, 1, At, B1); BAR;
    LDA(At, 0, 1); WAIT_V(4); BAR; WAIT_L(0); MMA(1, 0, At, B0); MMA(1, 1, At, B1); BAR; }
  { LDB(B0, 1, 0); LDA(At, 1, 0); WAIT_V(2); BAR; WAIT_L(0); MMA(0, 0, At, B0); BAR;
    LDB(B1, 1, 1); WAIT_V(0); BAR; WAIT_L(0); MMA(0, 1, At, B1); BAR;
    LDA(At, 1, 1); BAR; WAIT_L(0); MMA(1, 0, At, B0); MMA(1, 1, At, B1); BAR; }
  if (wr == 0) BAR;
  int tide = threadIdx.x; asm volatile("" : "+v"(tide));
  const int fre = tide & 15, fqe = (tide >> 4) & 3;
#pragma unroll
  for (int ai = 0; ai < 2; ++ai)
#pragma unroll
    for (int m = 0; m < 4; ++m) { const int row = row0 + ai * HALF + wr * 64 + m * 16 + fre;
#pragma unroll
      for (int bj = 0; bj < 2; ++bj) { float sq = 0.f;
#pragma unroll
        for (int n = 0; n < 2; ++n) { const float v[4] = {acc[ai][bj][m][n][0], acc[ai][bj][m][n][1], acc[ai][bj][m][n][2], acc[ai][bj][m][n][3]};
          sq += epi(row, col0 + bj * HALF + wc * 32 + n * 16 + fqe * 4, v); }
        if (Epi::RSS) { sq += __shfl_xor(sq, 16); sq += __shfl_xor(sq, 32); if (fqe == 0) epi.rss(row, col0 + bj * HALF + wc * 32, sq); } }
      if (Epi::EPI_SBAR) __builtin_amdgcn_sched_barrier(0); }
#undef SA
#undef SB
#undef STAGE_A
#undef STAGE_B
#undef LDA
#undef LDB
#undef MMA
#undef WAIT_V
#undef WAIT_L
#undef BAR
#undef SCHED
}

template <int BM, int BN, bool ACOLMAP, class Epi>
DEVI void gemm_tile(const bf16_t* A, int lda, const bf16_t* Bm, int ldb, int K, int row0, int col0, const Epi& epi, const float* kss, char* smem) {
  if constexpr (BM == 256 && BN == 256) gemm_tile_8ph<ACOLMAP>(A, lda, Bm, ldb, K, row0, col0, epi, smem);
  else if (kss) gemm_tile_mfma<BM, BN, ACOLMAP, false>(A, lda, Bm, ldb, K, row0, col0, epi, kss, smem);
  else gemm_tile_mfma<BM, BN, ACOLMAP, true>(A, lda, Bm, ldb, K, row0, col0, epi, nullptr, smem);
}

DEVI void st4bf(bf16_t* d, float a, float b, float c, float e) { u32x2 o = {pack2(a, b), pack2(c, e)}; *(u32x2*)d = o; }

struct EpiIn { static constexpr bool RSS = true; static constexpr int SCALE_MODE = 0; static constexpr bool EPI_SBAR = false; bf16_t *GU, *GVT, *CQ, *CKV, *KR; float *rssv, *rssq, *rsskv;
  DEVI float operator()(int row, int col, const float (&v)[4]) const {
    if (col < 1024) { st4bf(GU + (size_t)row * 1024 + col, gelu_t(v[0]), gelu_t(v[1]), gelu_t(v[2]), gelu_t(v[3])); return 0.f; }
    else if (col < 2048) { const int c = col - 1024, chunk = row >> 7, q = row & 127; float s = 0.f;
#pragma unroll
      for (int j = 0; j < 4; ++j) { const float g = gelu_t(v[j]); s += g * g; GVT[((size_t)chunk * 1024 + c + j) * 128 + q] = f2bf(g); }
      return s; }
    else if (col < 2304) { st4bf(CQ + (size_t)row * 256 + (col - 2048), v[0], v[1], v[2], v[3]); return v[0] * v[0] + v[1] * v[1] + v[2] * v[2] + v[3] * v[3]; }
    else if (col < 2432) { st4bf(CKV + (size_t)row * 128 + (col - 2304), v[0], v[1], v[2], v[3]); return v[0] * v[0] + v[1] * v[1] + v[2] * v[2] + v[3] * v[3]; }
    else if (col < 2496) { st4bf(KR + (size_t)keyrow(row) * 64 + (col - 2432), v[0], v[1], v[2], v[3]); return 0.f; }
    return 0.f; }
  DEVI void rss(int row, int col, float s) const {
    if (col >= 1024 && col < 2048) rssv[row * 32 + ((col - 1024) >> 5)] = s; else if (col >= 2048 && col < 2304) rssq[row * 8 + ((col - 2048) >> 5)] = s; else if (col >= 2304 && col < 2432) rsskv[row * 4 + ((col - 2304) >> 5)] = s; }
};
struct EpiQ { static constexpr bool RSS = false; static constexpr int SCALE_MODE = 1; static constexpr bool EPI_SBAR = false; bf16_t* Q; const float* rssq;
  DEVI float rowscale(int row) const { const float4 ps = *(const float4*)(rssq + row * 8), pt = *(const float4*)(rssq + row * 8 + 4); return rsqrtf((((ps.x + ps.y) + (ps.z + ps.w)) + ((pt.x + pt.y) + (pt.z + pt.w))) * (1.f / 256.f) + EPS); }
  DEVI float operator()(int row, int col, const float (&v)[4]) const { st4bf(Q + (size_t)row * 1536 + col, v[0], v[1], v[2], v[3]); return 0.f; }
  DEVI void rss(int, int, float) const {} };
DEVI int pk4_fp8(float a, float b, float c, float d) { int w = __builtin_amdgcn_cvt_pk_fp8_f32(a, b, 0, false); return __builtin_amdgcn_cvt_pk_fp8_f32(c, d, w, true); }
constexpr size_t O_K8 = O_RKV, O_V8T = O_RKV + al256((size_t)NB * 8 * NKEY * 192);
struct EpiK8 { static constexpr bool RSS = false; static constexpr int SCALE_MODE = 1; static constexpr bool EPI_SBAR = false; unsigned char* K8; const float* rsskv;
  DEVI float rowscale(int row) const { const float4 pk = *(const float4*)(rsskv + row * 4); return rsqrtf(((pk.x + pk.y) + (pk.z + pk.w)) * (1.f / 128.f) + EPS); }
  DEVI float operator()(int row, int col, const float (&v)[4]) const {
    int b, key; keyrow2(row, b, key); const int h = col >> 7, d = col & 127;
    *(int*)(K8 + ((size_t)(b * 8 + h) * NKEY + key) * 192 + d) = pk4_fp8(v[0], v[1], v[2], v[3]); return 0.f; }
  DEVI void rss(int, int, float) const {} };
struct EpiV8T { static constexpr bool RSS = false; static constexpr int SCALE_MODE = 2; static constexpr bool EPI_SBAR = false; unsigned char* V8; const float* rsskv;
  DEVI float colscale(int col) const { const float4 pk = *(const float4*)(rsskv + col * 4); return rsqrtf(((pk.x + pk.y) + (pk.z + pk.w)) * (1.f / 128.f) + EPS); }
  DEVI float operator()(int row, int col, const float (&v)[4]) const {
    int b, key; keyrow2(col, b, key); const int h = row >> 7, d = row & 127, kk = key & 63;
    const int off = 32 * ((kk >> 2) & 1) + 16 * (kk >> 5) + 4 * ((kk >> 3) & 3);
    *(int*)(V8 + ((size_t)(b * 8 + h) * 128 + d) * NKEY + (key & ~63) + off) = pk4_fp8(v[0], v[1], v[2], v[3]); return 0.f; }
  DEVI void rss(int, int, float) const {} };
struct EpiSgu { static constexpr bool RSS = false; static constexpr int SCALE_MODE = 0; static constexpr bool EPI_SBAR = false; bf16_t* GUOA; const float* g_sgu; const float* b_s; int chunk, g;
  DEVI float operator()(int row, int col, const float (&v)[4]) const { const int token = chunk * 128 + row, ch = g * 128 + col; const float bias = b_s[g * 128 + row];
    bf16_t* ptr = GUOA + (size_t)token * 1024 + ch; const u32x2 gu = *(const u32x2*)ptr;
    st4bf(ptr, lo2f(gu[0]) * (g_sgu[ch] * v[0] + bias), hi2f(gu[0]) * (g_sgu[ch + 1] * v[1] + bias), lo2f(gu[1]) * (g_sgu[ch + 2] * v[2] + bias), hi2f(gu[1]) * (g_sgu[ch + 3] * v[3] + bias));
    return 0.f; }
  DEVI void rss(int, int, float) const {} };
struct EpiGate { static constexpr bool RSS = false; static constexpr int SCALE_MODE = 0; static constexpr bool EPI_SBAR = false; bf16_t* G;
  DEVI float operator()(int row, int col, const float (&v)[4]) const { st4bf(G + (size_t)row * 2048 + col, sigmoidf_(v[0]), sigmoidf_(v[1]), sigmoidf_(v[2]), sigmoidf_(v[3])); return 0.f; }
  DEVI void rss(int, int, float) const {} };
template <bool SECOND> struct EpiMerge { static constexpr bool RSS = false; static constexpr int SCALE_MODE = 0; static constexpr bool EPI_SBAR = false;   bf16_t* M; const bf16_t* G;
  DEVI float operator()(int row, int col, const float (&v)[4]) const { const u32x2 g = *(const u32x2*)(G + (size_t)row * 2048 + (SECOND ? 1024 : 0) + col);
    float o0 = lo2f(g[0]) * v[0], o1 = hi2f(g[0]) * v[1], o2 = lo2f(g[1]) * v[2], o3 = hi2f(g[1]) * v[3];
    bf16_t* ptr = M + (size_t)row * 1024 + col;
    if (SECOND) { const u32x2 m = *(const u32x2*)ptr; o0 += lo2f(m[0]); o1 += hi2f(m[0]); o2 += lo2f(m[1]); o3 += hi2f(m[1]); }
    st4bf(ptr, o0, o1, o2, o3); return 0.f; }
  DEVI void rss(int, int, float) const {} };
struct EpiO { static constexpr bool RSS = true; static constexpr int SCALE_MODE = 0; static constexpr bool EPI_SBAR = false; bf16_t* Y; float* rssy;
  DEVI float operator()(int row, int col, const float (&v)[4]) const { st4bf(Y + (size_t)row * 1024 + col, v[0], v[1], v[2], v[3]); return v[0] * v[0] + v[1] * v[1] + v[2] * v[2] + v[3] * v[3]; }
  DEVI void rss(int row, int col, float s) const { rssy[row * 32 + (col >> 5)] = s; } };
struct EpiPq { static constexpr bool RSS = false; static constexpr int SCALE_MODE = 0; static constexpr bool EPI_SBAR = false; bf16_t* QP;
  DEVI float operator()(int row, int col, const float (&v)[4]) const { st4bf(QP + (size_t)row * 2048 + col, v[0], v[1], v[2], v[3]); return 0.f; }
  DEVI void rss(int, int, float) const {} };

template <class F> DEVI void for_tiles_xcd(int MT, int NT, F f) {
  const int nb = gridDim.x;
  if ((nb & 7) == 0 && (MT & 7) == 0) { const int xcd = blockIdx.x & 7, slot = blockIdx.x >> 3, slots = nb >> 3, mper = MT >> 3, tot = mper * NT;
    for (int j = slot; j < tot; j += slots) f(xcd * mper + j / NT, j % NT); }
  else for (int i = blockIdx.x; i < MT * NT; i += nb) f(i / NT, i % NT);
}

DEVI void ph_inproj(const Params& p, char* smem) {
  char* ws = p.ws;
  EpiIn epi{(bf16_t*)(ws + O_RB), (bf16_t*)(ws + O_RC), (bf16_t*)(ws + O_CQ), (bf16_t*)(ws + O_CKV), (bf16_t*)(ws + O_KR), (float*)(ws + O_RSSV), (float*)(ws + O_RSSQ), (float*)(ws + O_RSSKV)};
  const bf16_t* HX = (const bf16_t*)(ws + O_RA); const bf16_t* W = (const bf16_t*)(ws + O_WIN);
  auto tile = [&](int mt, int nt) { gemm_tile<256, 256, false>(HX + (size_t)mt * 256 * 1024, 1024, W + (size_t)nt * 256 * 1024, 1024, 1024, mt * 256, nt * 256, epi, nullptr, smem); };
  for_tiles_xcd(64, 10, tile);
  for (int i = (int)gridDim.x - 1 - (int)blockIdx.x; i < 2; i += gridDim.x) tile(64 + i, 9);
}
DEVI void rope_kr_fp8(const Params& p) {
  const bf16_t* KR = (const bf16_t*)(p.ws + O_KR); const float* rope = (const float*)(p.ws + O_ROPE); unsigned char* K8 = (unsigned char*)(p.ws + O_K8);
  for (int i = blockIdx.x * NTHR + threadIdx.x; i < NROW * 2; i += gridDim.x * NTHR) {
    const int row = i >> 1, which = i & 1, kr = keyrow(row); int b, key; keyrow2(row, b, key);
    float x[32];
    const bf16_t* src = KR + (size_t)kr * 64 + which * 32;
#pragma unroll
    for (int q = 0; q < 4; ++q) unpack8(*(const u32x4*)(src + q * 8), x + q * 8);
    if (row < NTOK) { const int pos = row & 8191, pp = which ? (pos & 63) : (pos >> 6); const float* cs = rope + pp * 32;
#pragma unroll
      for (int j = 0; j < 16; ++j) { const float c = cs[j * 2], sn = cs[j * 2 + 1], x1 = x[j], x2 = x[16 + j]; x[j] = x1 * c - x2 * sn; x[16 + j] = x1 * sn + x2 * c; } }
    u32x4 o0, o1;
#pragma unroll
    for (int q = 0; q < 4; ++q) { o0[q] = (unsigned)pk4_fp8(x[q * 4], x[q * 4 + 1], x[q * 4 + 2], x[q * 4 + 3]); o1[q] = (unsigned)pk4_fp8(x[16 + q * 4], x[17 + q * 4], x[18 + q * 4], x[19 + q * 4]); }
#pragma unroll
    for (int h = 0; h < 8; ++h) { unsigned char* d = K8 + ((size_t)(b * 8 + h) * NKEY + key) * 192 + 128 + which * 32; *(u32x4*)d = o0; *(u32x4*)(d + 16) = o1; }
  }
}
DEVI void ph_mid(const Params& p, char* smem) {
  char* ws = p.ws;
  { EpiQ epi{(bf16_t*)(ws + O_RQ), (const float*)(ws + O_RSSQ)};
    const bf16_t* A = (const bf16_t*)(ws + O_CQ); const bf16_t* W = (const bf16_t*)(ws + O_WUQ);
    for_tiles_xcd(64, 12, [&](int mt, int nt) { gemm_tile<256, 128, false>(A + (size_t)mt * 256 * 256, 256, W + (size_t)nt * 128 * 256, 256, 256, mt * 256, nt * 128, epi, nullptr, smem); }); }
  { EpiK8 epi{(unsigned char*)(ws + O_K8), (const float*)(ws + O_RSSKV)};
    const bf16_t* A = (const bf16_t*)(ws + O_CKV); const bf16_t* W = (const bf16_t*)(ws + O_WUKV);
    auto tile = [&](int mt, int nt) { gemm_tile<256, 128, false>(A + (size_t)mt * 256 * 128, 128, W + (size_t)nt * 256 * 128, 128, 128, mt * 256, nt * 128, epi, nullptr, smem); };
    for_tiles_xcd(64, 8, tile);
    for (int i = blockIdx.x; i < 16; i += gridDim.x) tile(64 + (i >> 3), i & 7); }
  { EpiV8T epi{(unsigned char*)(ws + O_V8T), (const float*)(ws + O_RSSKV)};
    const bf16_t* A = (const bf16_t*)(ws + O_WUKV); const bf16_t* Bc = (const bf16_t*)(ws + O_CKV);
    for (int i = blockIdx.x; i < 8 * 132; i += gridDim.x) { const int mt = i & 7, nt = i >> 3;
      gemm_tile<128, 128, false>(A + (size_t)(mt * 256 + 128) * 128, 128, Bc + (size_t)nt * 128 * 128, 128, 128, mt * 128, nt * 128, epi, nullptr, smem); } }
  { const bf16_t* WS = (const bf16_t*)(ws + O_WS); const bf16_t* GVT = (const bf16_t*)(ws + O_RC);
    float* ksc = (float*)(smem + LDS_BYTES - 1024); const float* rssv = (const float*)(ws + O_RSSV);
    for (int i = blockIdx.x; i < 1024; i += gridDim.x) { const int chunk = i >> 3, g = i & 7;
      __syncthreads();
      if (threadIdx.x < 128) { const float* pr = rssv + (size_t)(chunk * 128 + threadIdx.x) * 32; float t = 0.f;
#pragma unroll
        for (int j = 0; j < 32; ++j) t += pr[j];
        ksc[threadIdx.x] = rsqrtf(t * (1.f / 1024.f) + EPS); }
      __syncthreads();
      EpiSgu epi{(bf16_t*)(ws + O_RB), p.g_sgu, p.b_s, chunk, g};
      gemm_tile<128, 128, false>(WS + (size_t)g * 16384, 128, GVT + ((size_t)chunk * 1024 + g * 128) * 128, 128, 128, 0, 0, epi, ksc, smem); } }
  rope_kr_fp8(p);
}
DEVI void ph_gates(const Params& p, char* smem) {
  char* ws = p.ws; EpiGate epi{(bf16_t*)(ws + O_RKV)};
  const bf16_t* HX = (const bf16_t*)(ws + O_RA); const bf16_t* W = (const bf16_t*)(ws + O_WIN) + (size_t)NPRE * 1024;
  for_tiles_xcd(64, 8, [&](int mt, int nt) { gemm_tile<256, 256, false>(HX + (size_t)mt * 256 * 1024, 1024, W + (size_t)nt * 256 * 1024, 1024, 1024, mt * 256, nt * 256, epi, nullptr, smem); });
}
DEVI void ph_merge(const Params& p, char* smem) {
  char* ws = p.ws; bf16_t* M = (bf16_t*)(ws + O_RC); const bf16_t* G = (const bf16_t*)(ws + O_RKV);
  EpiMerge<false> e1{M, G}; EpiMerge<true> e2{M, G};
  const bf16_t* OA = (const bf16_t*)(ws + O_RB); const bf16_t* OB = (const bf16_t*)(ws + O_RQ);
  const bf16_t* WA = (const bf16_t*)(ws + O_WPA); const bf16_t* WB = (const bf16_t*)(ws + O_WPB);
  for_tiles_xcd(64, 4, [&](int mt, int nt) { gemm_tile<256, 256, false>(OA + (size_t)mt * 256 * 1024, 1024, WA + (size_t)nt * 256 * 1024, 1024, 1024, mt * 256, nt * 256, e1, nullptr, smem); });
  for_tiles_xcd(64, 4, [&](int mt, int nt) { gemm_tile<256, 256, true>(OB + (size_t)mt * 256 * 1536, 1536, WB + (size_t)nt * 256 * 1024, 1024, 1024, mt * 256, nt * 256, e2, nullptr, smem); });
}
DEVI void ph_wo(const Params& p, char* smem) {
  char* ws = p.ws; EpiO epi{(bf16_t*)(ws + O_RA), (float*)(ws + O_RSSY)};
  const bf16_t* M = (const bf16_t*)(ws + O_RC); const bf16_t* W = (const bf16_t*)(ws + O_WO);
  for_tiles_xcd(64, 4, [&](int mt, int nt) { gemm_tile<256, 256, false>(M + (size_t)mt * 256 * 1024, 1024, W + (size_t)nt * 256 * 1024, 1024, 1024, mt * 256, nt * 256, epi, nullptr, smem); });
}
DEVI void ph_wpq(const Params& p, char* smem) {
  char* ws = p.ws; EpiPq epi{(bf16_t*)(ws + O_RKV)};
  const bf16_t* A = (const bf16_t*)(ws + O_RB); const bf16_t* W = (const bf16_t*)(ws + O_WPQ);
  for_tiles_xcd(64, 8, [&](int mt, int nt) { gemm_tile<256, 256, false>(A + (size_t)mt * 256 * 1024, 1024, W + (size_t)nt * 256 * 1024, 1024, 1024, mt * 256, nt * 256, epi, nullptr, smem); });
  convert_table_fp6(p.v_exp, (unsigned char*)(ws + O_RA), (float*)(ws + O_RA + (size_t)16384 * 1024));
}

namespace a8 {
constexpr int KVBLK = 64, SHM_K = KVBLK * 192, SHM_V = 128 * KVBLK;
constexpr int SHM_K2 = 2 * SHM_K, SHM_V2 = 2 * SHM_V;
constexpr float SCALE = 0.07216878364870322f, THR = 1.5f;
using i32x8 = __attribute__((ext_vector_type(8))) int;
DEVI int crow(int r, int hi) { return (r & 3) + 8 * (r >> 2) + 4 * hi; }
DEVI f32x16 mma(const i32x8& a, const i32x8& b, const f32x16& c) { return __builtin_amdgcn_mfma_scale_f32_32x32x64_f8f6f4(a, b, c, 0, 0, 0, 0x7f7f7f7f, 0, 0x7f7f7f7f); }
DEVI void partialSM(f32x16& p0, f32x16& p1, float& m_reg, float& mn, float& alpha) {
  constexpr float C = SCALE * 1.4426950408889634f;
  float pmax = p0[0];
#pragma unroll
  for (int r = 1; r < 16; ++r) pmax = fmaxf(pmax, p0[r]);
#pragma unroll
  for (int r = 0; r < 16; ++r) pmax = fmaxf(pmax, p1[r]);
  { auto rr = __builtin_amdgcn_permlane32_swap(__float_as_uint(pmax), __float_as_uint(pmax), false, false);
    pmax = fmaxf(__uint_as_float(rr[0]), __uint_as_float(rr[1])); }
  if (__builtin_expect(__all(pmax - m_reg <= THR / SCALE), 1)) { mn = m_reg; alpha = 1.f; }
  else { mn = fmaxf(m_reg, pmax); alpha = __builtin_amdgcn_exp2f((m_reg - mn) * C); m_reg = mn; }
  const float mnC = 6.f - mn * C;
#pragma unroll
  for (int r = 0; r < 16; ++r) p0[r] = fmaf(p0[r], C, mnC);
#pragma unroll
  for (int r = 0; r < 16; ++r) p1[r] = fmaf(p1[r], C, mnC);
#pragma unroll
  for (int r = 0; r < 16; ++r) p0[r] = __builtin_amdgcn_exp2f(p0[r]);
}
DEVI void finishSM(f32x16& p0, f32x16& p1, float alpha, float& l_reg, i32x8& pa) {
#pragma unroll
  for (int r = 0; r < 16; ++r) p1[r] = __builtin_amdgcn_exp2f(p1[r]);
  float ps = 0;
#pragma unroll
  for (int r = 0; r < 16; ++r) ps += p0[r];
#pragma unroll
  for (int r = 0; r < 16; ++r) ps += p1[r];
  { auto rr = __builtin_amdgcn_permlane32_swap(__float_as_uint(ps), __float_as_uint(ps), false, false);
    ps = __uint_as_float(rr[0]) + __uint_as_float(rr[1]); }
  l_reg = l_reg * alpha + ps;
#pragma unroll
  for (int j = 0; j < 4; ++j) { pa[j] = pk4_fp8(p0[4 * j], p0[4 * j + 1], p0[4 * j + 2], p0[4 * j + 3]); pa[4 + j] = pk4_fp8(p1[4 * j], p1[4 * j + 1], p1[4 * j + 2], p1[4 * j + 3]); }
}
DEVI i32x8 ld32(const char* p0, const char* p1) { const u32x4 a = *(const u32x4*)p0, b = *(const u32x4*)p1; return (i32x8){(int)a[0], (int)a[1], (int)a[2], (int)a[3], (int)b[0], (int)b[1], (int)b[2], (int)b[3]}; }
DEVI void qkt(f32x16& p0, f32x16& p1, const char* Ks, const i32x8* qf, int r32, int hi) {
  p0 = f32x16{}; p1 = f32x16{};
  const int sw = (r32 >> 2) & 3; const char* k0 = Ks + r32 * 192; const char* k1 = k0 + 32 * 192;
#pragma unroll
  for (int m = 0; m < 3; ++m) { const int c0 = ((4 * m + 2 * hi) ^ sw) << 4, c1 = ((4 * m + 2 * hi + 1) ^ sw) << 4;
    p0 = mma(ld32(k0 + c0, k0 + c1), qf[m], p0);
    p1 = mma(ld32(k1 + c0, k1 + c1), qf[m], p1); }
}
DEVI void pv(f32x16* o, const char* Vs, int tile, const i32x8& pa, int r32, int hi) {
  const int sw = (r32 >> 1) & 7, c0 = ((4 * tile + 2 * hi) ^ sw) << 4, c1 = ((4 * tile + 2 * hi + 1) ^ sw) << 4;
#pragma unroll
  for (int db = 0; db < 4; ++db) { const char* vr = Vs + (32 * db + r32) * 128; o[db] = mma(pa, ld32(vr + c0, vr + c1), o[db]); }
}
DEVI void attn_item(bf16_t* __restrict__ Qb, const unsigned char* __restrict__ Kg, const unsigned char* __restrict__ Vg, const float* __restrict__ rope, int pos0, char* lds) {
  const int tid = threadIdx.x, wid = tid >> 6, lane = tid & 63, r32 = lane & 31, hi = lane >> 5;
  char* V_lds = lds; char* K_lds = lds + 3 * SHM_V2;
  float* wsl = (float*)(lds + 3 * SHM_V2 + 3 * SHM_K2) + wid * 64; float* li_l = wsl; float* al_l = wsl + 32;
  float m_reg = -1e30f, l_reg = 0; f32x16 o[4] = {}; i32x8 qf[3];
  { const bf16_t* Qw = Qb + (size_t)(wid * 32 + r32) * 1536 + hi * 32;
#pragma unroll
    for (int m = 0; m < 3; ++m) { float x[32];
#pragma unroll
      for (int q = 0; q < 4; ++q) unpack8(*(const u32x4*)(Qw + m * 64 + q * 8), x + q * 8);
      if (m == 2) { const int pos = pos0 + wid * 32 + r32, pp = hi ? (pos & 63) : (pos >> 6); const float* cs = rope + pp * 32;
#pragma unroll
        for (int j = 0; j < 16; ++j) { const float c = cs[j * 2], sn = cs[j * 2 + 1], x1 = x[j], x2 = x[16 + j]; x[j] = x1 * c - x2 * sn; x[16 + j] = x1 * sn + x2 * c; } }
#pragma unroll
      for (int q = 0; q < 8; ++q) qf[m][q] = pk4_fp8(x[q * 4], x[q * 4 + 1], x[q * 4 + 2], x[q * 4 + 3]);
      __builtin_amdgcn_sched_barrier(0); } }
  unsigned koff[3], voff[2];
#pragma unroll
  for (int i = 0; i < 3; ++i) { const int pp = wid * 64 + lane + 512 * i, key = pp / 12, c = pp - key * 12; koff[i] = (unsigned)(key * 192 + ((c ^ ((key >> 2) & 3)) << 4)); }
#pragma unroll
  for (int i = 0; i < 2; ++i) { const int pp = wid * 64 + lane + 512 * i, d = pp >> 3, c = pp & 7; voff[i] = (unsigned)(d * NKEY + ((c ^ ((d >> 1) & 7)) << 4)); }
#define GSTAGE(s_, kb, vb) do { const unsigned char* ks = Kg + (size_t)(s_) * SHM_K2; const unsigned char* vs = Vg + (s_) * 128; \
    _Pragma("unroll") for (int i = 0; i < 3; ++i) __builtin_amdgcn_global_load_lds((const unsigned*)(ks + koff[i]), (unsigned*)(K_lds + (kb) + i * 8192 + wid * 1024), 16, 0, 0); \
    _Pragma("unroll") for (int i = 0; i < 2; ++i) __builtin_amdgcn_global_load_lds((const unsigned*)(vs + voff[i]), (unsigned*)(V_lds + (vb) + i * 8192 + wid * 1024), 16, 0, 0); } while (0)
#define SWAIT() asm volatile("s_waitcnt vmcnt(0)" ::: "memory")
#define SBAR() __builtin_amdgcn_sched_barrier(0)
#define RESC(a) do { if (__any((a) < 1.f)) { if (hi == 0) al_l[r32] = (a); asm volatile("s_waitcnt lgkmcnt(0)" ::: "memory"); \
    _Pragma("unroll") for (int d = 0; d < 4; ++d) _Pragma("unroll") for (int r = 0; r < 16; ++r) o[d][r] *= al_l[crow(r, hi)]; } } while (0)
  f32x16 pA0, pA1, pB0, pB1; float mnA, mnB, alA, alB; i32x8 pa; constexpr int NS = NKEY / 128;
  int kp = 0, kc = SHM_K2, kn = 2 * SHM_K2, vp = 0, vc = SHM_V2, vn = 2 * SHM_V2;
  GSTAGE(0, kp, vp); GSTAGE(1, kc, vc); SWAIT(); __syncthreads();
  qkt(pA0, pA1, K_lds + kp, qf, r32, hi); partialSM(pA0, pA1, m_reg, mnA, alA);
  SBAR(); qkt(pB0, pB1, K_lds + kp + SHM_K, qf, r32, hi);
  finishSM(pA0, pA1, alA, l_reg, pa); SBAR();
  pv(o, V_lds + vp, 0, pa, r32, hi); partialSM(pB0, pB1, m_reg, mnB, alB);
  RESC(alB);
  for (int s_ = 1; s_ < NS; ++s_) {
    if (s_ + 1 < NS) GSTAGE(s_ + 1, kn, vn);
    SBAR(); qkt(pA0, pA1, K_lds + kc, qf, r32, hi);
    finishSM(pB0, pB1, alB, l_reg, pa); SBAR();
    pv(o, V_lds + vp, 1, pa, r32, hi); partialSM(pA0, pA1, m_reg, mnA, alA);
    RESC(alA);
    SBAR(); qkt(pB0, pB1, K_lds + kc + SHM_K, qf, r32, hi);
    finishSM(pA0, pA1, alA, l_reg, pa); SBAR();
    pv(o, V_lds + vc, 0, pa, r32, hi); partialSM(pB0, pB1, m_reg, mnB, alB);
    SWAIT(); __syncthreads();
    RESC(alB);
    { const int tk = kp; kp = kc; kc = kn; kn = tk; const int tv = vp; vp = vc; vc = vn; vn = tv; }
  }
  finishSM(pB0, pB1, alB, l_reg, pa); SBAR();
  pv(o, V_lds + vp, 1, pa, r32, hi);
  if (hi == 0) li_l[r32] = l_reg; asm volatile("s_waitcnt lgkmcnt(0)" ::: "memory");
  float rli[16];
#pragma unroll
  for (int r = 0; r < 16; ++r) rli[r] = __builtin_amdgcn_rcpf(li_l[crow(r, hi)]);
  bf16_t* Ow = Qb + (size_t)(wid * 32) * 1536;
#pragma unroll
  for (int r = 0; r < 16; ++r) { const int orow = crow(r, hi);
#pragma unroll
    for (int d0 = 0; d0 < 4; ++d0) Ow[(size_t)orow * 1536 + d0 * 32 + r32] = f2bf(o[d0][r] * rli[r]); }
  __syncthreads();
#undef GSTAGE
#undef SWAIT
#undef SBAR
#undef RESC
}
}
DEVI void attn_fp8(const Params& p, char* smem) {
  bf16_t* Q = (bf16_t*)(p.ws + O_RQ); const unsigned char* K8 = (const unsigned char*)(p.ws + O_K8); const unsigned char* V8 = (const unsigned char*)(p.ws + O_V8T);
  const float* rope = (const float*)(p.ws + O_ROPE);
  for (int it = blockIdx.x; it < NB * 8 * (SEQ / 256); it += gridDim.x) {
    const int bh = (it >> 8) * 8 + (it & 7), qb = (it & 255) >> 3, b = bh >> 3, h = bh & 7;
    a8::attn_item(Q + (size_t)(b * SEQ + qb * 256) * 1536 + h * 192, K8 + (size_t)bh * NKEY * 192, V8 + (size_t)bh * 128 * NKEY, rope, qb * 256, smem);
  }
}
DEVI void ph_attn(const Params& p, char* smem) { attn_fp8(p, smem); }

DEVI void ph_rows(const Params& p, char* smem) {
  const int tid = threadIdx.x, wave = tid >> 6, lane = tid & 63;
  const float* MOD = (const float*)(p.ws + O_MOD); const bf16_t* Y = (const bf16_t*)(p.ws + O_RA); const float* rssy = (const float*)(p.ws + O_RSSY);
  bf16_t* HX2 = (bf16_t*)(p.ws + O_RB);
  for (int row = blockIdx.x * NWAVE + wave; row < NTOK; row += gridDim.x * NWAVE) {
    const int b = row >> 13; const float* md = MOD + b * 6144;
    float ty = 0.f; { const float* pr = rssy + (size_t)row * 32;
#pragma unroll
      for (int j = 0; j < 32; ++j) ty += pr[j]; }
    const float ry = rsqrtf(ty * (1.f / 1024.f) + EPS);
    float x1[16]; float ss = 0.f;
#pragma unroll
    for (int i = 0; i < 4; ++i) { const int c = i * 256 + lane * 4; const float4 xv = *(const float4*)(p.x + (size_t)row * 1024 + c); const u32x2 yv = *(const u32x2*)(Y + (size_t)row * 1024 + c);
      const float4 gp = *(const float4*)(p.g_post1 + c), gt = *(const float4*)(md + 2048 + c);
      x1[i * 4 + 0] = xv.x + gt.x * (lo2f(yv[0]) * ry * gp.x); x1[i * 4 + 1] = xv.y + gt.y * (hi2f(yv[0]) * ry * gp.y);
      x1[i * 4 + 2] = xv.z + gt.z * (lo2f(yv[1]) * ry * gp.z); x1[i * 4 + 3] = xv.w + gt.w * (hi2f(yv[1]) * ry * gp.w);
#pragma unroll
      for (int j = 0; j < 4; ++j) ss += x1[i * 4 + j] * x1[i * 4 + j];
      *(float4*)(p.out + (size_t)row * 1024 + c) = make_float4(x1[i * 4], x1[i * 4 + 1], x1[i * 4 + 2], x1[i * 4 + 3]); }
    ss = wave_sum(ss); const float r2 = rsqrtf(ss * (1.f / 1024.f) + EPS);
#pragma unroll
    for (int i = 0; i < 4; ++i) { const int c = i * 256 + lane * 4; const float4 g2 = *(const float4*)(p.g_pre2 + c), sc = *(const float4*)(md + 4096 + c), sh = *(const float4*)(md + 3072 + c);
      st4bf(HX2 + (size_t)row * 1024 + c, x1[i * 4] * r2 * g2.x * (1.f + sc.x) + sh.x, x1[i * 4 + 1] * r2 * g2.y * (1.f + sc.y) + sh.y,
            x1[i * 4 + 2] * r2 * g2.z * (1.f + sc.z) + sh.z, x1[i * 4 + 3] * r2 * g2.w * (1.f + sc.w) + sh.w); }
  }
  convert_table_fp6(p.u_exp, (unsigned char*)(p.ws + O_RC), (float*)(p.ws + O_RC + (size_t)16384 * 1024));
}

namespace tk {
DEVI int f2sort(float f) { const int i = __float_as_int(f); return i ^ ((i >> 31) & 0x7fffffff); }
DEVI float sort2f(int s) { return __int_as_float(s ^ ((s >> 31) & 0x7fffffff)); }
DEVI void ce_desc(int& a, int& b) { const int hi = max(a, b), lo = min(a, b); a = hi; b = lo; }
DEVI void sort16_desc(int* a) {
#pragma unroll
  for (int lk = 1; lk <= 4; ++lk)
#pragma unroll
    for (int lj = lk - 1; lj >= 0; --lj)
#pragma unroll
      for (int i = 0; i < 16; ++i) { const int j = 1 << lj, k = 1 << lk, l = i ^ j;
        if (l > i) { const int hi = max(a[i], a[l]), lo = min(a[i], a[l]); if ((i & k) == 0) { a[i] = hi; a[l] = lo; } else { a[i] = lo; a[l] = hi; } } }
}
DEVI void bitonic_merge16_desc(int* a) {
#pragma unroll
  for (int lj = 3; lj >= 0; --lj)
#pragma unroll
    for (int i = 0; i < 16; ++i) { const int l = i ^ (1 << lj); if (l > i) ce_desc(a[i], a[l]); }
}
DEVI void merge_top16(int* a, const int* b) {
#pragma unroll
  for (int i = 0; i < 16; ++i) a[i] = max(a[i], b[15 - i]);
  bitonic_merge16_desc(a);
}
DEVI void half_top16(const bf16_t* __restrict__ qrow, const char* Kl, int r32, int hi, int* out) {
  bf16x8 qf[8];
#pragma unroll
  for (int d0 = 0; d0 < 8; ++d0) qf[d0] = *reinterpret_cast<const bf16x8*>(qrow + d0 * 16 + hi * 8);
  int a[64]; const int hi4 = 4 * hi;
#pragma unroll
  for (int kt = 0; kt < 4; ++kt) { f32x16 acc = {};
    const int key = kt * 32 + r32;
#pragma unroll
    for (int d0 = 0; d0 < 8; ++d0) { const bf16x8 kf = *reinterpret_cast<const bf16x8*>(Kl + key * 256 + (((d0 * 2 + hi) ^ (key & 15)) << 4));
      acc = __builtin_amdgcn_mfma_f32_32x32x16_bf16(kf, qf[d0], acc, 0, 0, 0); }
#pragma unroll
    for (int r = 0; r < 16; ++r) { const int kc = kt * 32 + (r & 3) + 8 * (r >> 2); a[kt * 16 + r] = ((f2sort(acc[r]) & ~127) | (127 - kc)) - hi4; } }
  sort16_desc(a); sort16_desc(a + 16); sort16_desc(a + 32); sort16_desc(a + 48);
  merge_top16(a, a + 16); merge_top16(a + 32, a + 48); merge_top16(a, a + 32);
  int L[16], H[16];
#pragma unroll
  for (int i = 0; i < 16; ++i) { auto rr = __builtin_amdgcn_permlane32_swap((unsigned)a[i], (unsigned)a[i], false, false); L[i] = (int)rr[0]; H[i] = (int)rr[1]; }
  merge_top16(L, H);
#pragma unroll
  for (int i = 0; i < 16; ++i) out[i] = L[i];
}
}
DEVI void peer_pass1_tokens4(const Params& p, int t0, const int* idxw, float* gww);
DEVI void topk_fast(const Params& p, char* smem) {
  const int tid = threadIdx.x, wave = __builtin_amdgcn_readfirstlane(tid >> 6), lane = tid & 63, r32 = lane & 31, hi = lane >> 5;
  const bf16_t* QP = (const bf16_t*)(p.ws + O_RKV);
  char* K1l = smem; char* K2l = smem + 32768; int* tab = (int*)(smem + 65536) + wave * (32 * 33);
  int* idxl = (int*)(smem + 65536 + 8 * 32 * 33 * 4) + wave * 512; float* gwl = (float*)(smem + 65536 + 8 * 32 * 33 * 4 + 8 * 2048) + wave * 512;
  __syncthreads();
  { const bf16_t* K1 = (const bf16_t*)(p.ws + O_K1);
    for (int id = tid; id < 4096; id += NTHR) { const int key = id >> 4, c = id & 15; const u32x4 v = *(const u32x4*)(K1 + (size_t)key * 128 + c * 8);
      *(u32x4*)(smem + key * 256 + ((c ^ (key & 15)) << 4)) = v; } }
  __syncthreads();
  for (int item = blockIdx.x; item < NTOK * 8 / 256; item += gridDim.x) {
    int tid_ = threadIdx.x; asm volatile("" : "+v"(tid_));
    const int lane = tid_ & 63, r32 = lane & 31, hi = lane >> 5;
    const int row = item * 256 + wave * 32 + r32;
    const bf16_t* qrow = QP + (size_t)row * 256;
    int t1[16], t2[16];
    tk::half_top16(qrow, K1l, r32, hi, t1);
    __builtin_amdgcn_sched_barrier(0);
    tk::half_top16(qrow + 128, K2l, r32, hi, t2);
    __builtin_amdgcn_sched_barrier(0);
    float v1[16], v2[16];
#pragma unroll
    for (int i = 0; i < 16; ++i) { v1[i] = tk::sort2f(t1[i] & ~127); v2[i] = tk::sort2f(t2[i] & ~127); }
    if (hi == 0) {
#pragma unroll
      for (int i = 0; i < 16; ++i) { tab[r32 * 33 + i] = 127 - (t1[i] & 127); tab[r32 * 33 + 16 + i] = 127 - (t2[i] & 127); } }
#define CAND(i, j) ((tk::f2sort(v1[i] + v2[j]) & ~255) | (255 - ((i) * 16 + (j))))
    int g0[16], g1[16], g2[16];
#pragma unroll
    for (int j = 0; j < 16; ++j) g0[j] = CAND(0, j);
#pragma unroll
    for (int j = 0; j < 8; ++j) g1[j] = CAND(1, j);
#pragma unroll
    for (int j = 0; j < 5; ++j) g1[8 + j] = CAND(2, j);
#pragma unroll
    for (int j = 0; j < 3; ++j) g1[13 + j] = CAND(4, j);
#pragma unroll
    for (int j = 0; j < 4; ++j) g2[j] = CAND(3, j);
    g2[4] = CAND(5, 0); g2[5] = CAND(5, 1); g2[6] = CAND(6, 0); g2[7] = CAND(6, 1); g2[8] = CAND(7, 0); g2[9] = CAND(7, 1);
    g2[10] = CAND(8, 0); g2[11] = CAND(9, 0); g2[12] = CAND(10, 0); g2[13] = CAND(11, 0); g2[14] = CAND(12, 0); g2[15] = CAND(13, 0);
    tk::sort16_desc(g1); tk::sort16_desc(g2);
    tk::merge_top16(g0, g1); tk::merge_top16(g0, g2);
    { int x = CAND(14, 0);
#pragma unroll
      for (int i = 0; i < 16; ++i) { const int h = max(g0[i], x); x = min(g0[i], x); g0[i] = h; }
      x = CAND(15, 0);
#pragma unroll
      for (int i = 0; i < 16; ++i) { const int h = max(g0[i], x); x = min(g0[i], x); g0[i] = h; } }
#undef CAND
    asm volatile("s_waitcnt lgkmcnt(0)" ::: "memory");
    if (hi == 0) {
      int ex[16];
#pragma unroll
      for (int k = 0; k < 16; ++k) { const int pos = 255 - (g0[k] & 255); ex[k] = tab[r32 * 33 + (pos >> 4)] * 128 + tab[r32 * 33 + 16 + (pos & 15)]; }
      int* dst = idxl + r32 * 16;
#pragma unroll
      for (int q = 0; q < 4; ++q) *(int4*)(dst + q * 4) = make_int4(ex[q * 4], ex[q * 4 + 1], ex[q * 4 + 2], ex[q * 4 + 3]);
    } else {
      float e[16]; const float vmax = tk::sort2f(g0[0] & ~255); float sum = 0.f;
#pragma unroll
      for (int k = 0; k < 16; ++k) { e[k] = __expf(tk::sort2f(g0[k] & ~255) - vmax); sum += e[k]; }
      const float inv = 1.f / sum; float* dst = gwl + r32 * 16;
#pragma unroll
      for (int q = 0; q < 4; ++q) *(float4*)(dst + q * 4) = make_float4(e[q * 4] * inv, e[q * 4 + 1] * inv, e[q * 4 + 2] * inv, e[q * 4 + 3] * inv);
    }
    asm volatile("s_waitcnt lgkmcnt(0)" ::: "memory"); __builtin_amdgcn_sched_barrier(0);
    peer_pass1_tokens4(p, item * 32 + wave * 4, idxl, gwl);
    asm volatile("s_waitcnt lgkmcnt(0)" ::: "memory"); __builtin_amdgcn_sched_barrier(0);
  }
}
DEVI void ph_topk(const Params& p, char* smem) { topk_fast(p, smem); }

using f32x2 = __attribute__((ext_vector_type(2))) float;
#define DPPF(x, ctrl) __builtin_bit_cast(float, __builtin_amdgcn_update_dpp(0, __builtin_bit_cast(int, (x)), ctrl, 0xf, 0xf, true))
DEVI float reduce_t32(const float (&D)[32], int lane) {
  float S[16];
#pragma unroll
  for (int i = 0; i < 16; ++i) { auto rr = __builtin_amdgcn_permlane16_swap(__float_as_uint(D[i]), __float_as_uint(D[i + 16]), false, false); S[i] = __uint_as_float(rr[0]) + __uint_as_float(rr[1]); }
  const bool b3 = lane & 8, b2 = lane & 4, b1 = lane & 2, b0 = lane & 1;
  float T[8], U[4], V[2];
#pragma unroll
  for (int i = 0; i < 8; ++i) { const float keep = b3 ? S[i + 8] : S[i], send = b3 ? S[i] : S[i + 8]; T[i] = keep + DPPF(send, 0x128); }
#pragma unroll
  for (int i = 0; i < 4; ++i) { const float keep = b2 ? T[i + 4] : T[i], send = b2 ? T[i] : T[i + 4]; U[i] = keep + DPPF(send, 0x141); }
#pragma unroll
  for (int i = 0; i < 2; ++i) { const float keep = b1 ? U[i + 2] : U[i], send = b1 ? U[i] : U[i + 2]; V[i] = keep + DPPF(send, 0x4E); }
  const float keep = b0 ? V[1] : V[0], send = b0 ? V[0] : V[1];
  return keep + DPPF(send, 0xB1);
}
DEVI void gload8(u32x6 (&B)[8], const unsigned char* tab, const int* ids, int g24) {
  const int4 i0 = *(const int4*)ids, i1 = *(const int4*)(ids + 4);
  const int id[8] = {i0.x, i0.y, i0.z, i0.w, i1.x, i1.y, i1.z, i1.w};
#pragma unroll
  for (int j = 0; j < 8; ++j) { const unsigned char* rp = tab + (unsigned)(id[j] * 768 + g24);
    const u32x4 a = *(const u32x4_u*)rp; const u32x2 c = *(const u32x2_u*)(rp + 16); B[j] = (u32x6){a[0], a[1], a[2], a[3], c[0], c[1]}; }
  asm volatile("" ::: "memory"); __builtin_amdgcn_sched_barrier(0);
}
template <int O>
DEVI void gdot8(const u32x6 (&B)[8], const f32x2 (&xp2)[16], float (&D)[32]) {
#pragma unroll
  for (int j = 0; j < 8; ++j) { const f32x32 uf = __builtin_amdgcn_cvt_scalef32_pk32_f32_fp6(B[j], 1.0f); f32x2 da = {0.f, 0.f}, db = {0.f, 0.f};
#pragma unroll
    for (int k = 0; k < 16; k += 2) { da += xp2[k] * (f32x2){uf[2 * k], uf[2 * k + 1]}; db += xp2[k + 1] * (f32x2){uf[2 * k + 2], uf[2 * k + 3]}; }
    da += db; D[O + j] = da[0] + da[1]; asm volatile("" : "+v"(D[O + j]) :: "memory"); __builtin_amdgcn_sched_barrier(0); }
}
DEVI void gaxpy8(const u32x6 (&B)[8], const float* cs, f32x2 (&acc2)[16]) {
  const float4 c0 = *(const float4*)cs, c1 = *(const float4*)(cs + 4);
  const float c[8] = {c0.x, c0.y, c0.z, c0.w, c1.x, c1.y, c1.z, c1.w};
#pragma unroll
  for (int j = 0; j < 8; ++j) { const f32x32 vf = __builtin_amdgcn_cvt_scalef32_pk32_f32_fp6(B[j], 1.0f); const f32x2 cj = {c[j], c[j]};
#pragma unroll
    for (int k = 0; k < 16; ++k) acc2[k] += cj * (f32x2){vf[2 * k], vf[2 * k + 1]};
    asm volatile("" : "+v"(acc2[0]), "+v"(acc2[1]), "+v"(acc2[2]), "+v"(acc2[3]), "+v"(acc2[4]), "+v"(acc2[5]), "+v"(acc2[6]), "+v"(acc2[7]) :: "memory");
    asm volatile("" : "+v"(acc2[8]), "+v"(acc2[9]), "+v"(acc2[10]), "+v"(acc2[11]), "+v"(acc2[12]), "+v"(acc2[13]), "+v"(acc2[14]), "+v"(acc2[15]) :: "memory");
    __builtin_amdgcn_sched_barrier(0); }
}
DEVI void peer_pass1_tokens4(const Params& p, int t0, const int* idxw, float* gww) {
  int lane = threadIdx.x & 63; asm volatile("" : "+v"(lane));
  const int h = lane >> 5, g = lane & 31, g24 = g * 24;
  const bf16_t* HX2 = (const bf16_t*)(p.ws + O_RB);
  const unsigned char* UT = (const unsigned char*)(p.ws + O_RC); const float* SU = (const float*)(p.ws + O_RC + (size_t)16384 * 1024);
  const float* SV = (const float*)(p.ws + O_RA + (size_t)16384 * 1024);
  int* IDG = (int*)(p.ws + O_RQ); float* CG = (float*)(p.ws + O_RQ + (size_t)NTOK * 128 * 4);
  u32x6 B0[8], B1[8]; u32x2 xr[8];
  gload8(B0, UT, idxw + h * 32, g24);
#pragma unroll
  for (int j = 0; j < 8; ++j) xr[j] = *(const u32x2*)(HX2 + (size_t)t0 * 1024 + 128 * j + 4 * g);
#pragma unroll 1
  for (int tl = 0; tl < 4; ++tl) {
    const int t = t0 + tl; const int* idx = idxw + tl * 128; float* gw = gww + tl * 128; const int* idh = idx + h * 32;
    f32x2 xp2[16];
#pragma unroll
    for (int j = 0; j < 8; ++j) { xp2[2 * j] = (f32x2){lo2f(xr[j][0]), hi2f(xr[j][0])}; xp2[2 * j + 1] = (f32x2){lo2f(xr[j][1]), hi2f(xr[j][1])}; }
    const int my_i0 = idx[lane], my_i1 = idx[64 + lane];
    const float su0 = SU[my_i0], sv0 = SV[my_i0], su1 = SU[my_i1], sv1 = SV[my_i1];
    IDG[(size_t)t * 128 + lane] = my_i0; IDG[(size_t)t * 128 + 64 + lane] = my_i1;
    float D[32];
    gload8(B1, UT, idh + 8, g24);  gdot8<0>(B0, xp2, D);
    gload8(B0, UT, idh + 16, g24); gdot8<8>(B1, xp2, D);
    gload8(B1, UT, idh + 24, g24); gdot8<16>(B0, xp2, D);
    gload8(B0, UT, idh + 64, g24); gdot8<24>(B1, xp2, D);
    { const float val = reduce_t32(D, lane); CG[(size_t)t * 128 + lane] = gw[lane] * gelu_t(val * su0) * sv0; }
    asm volatile("" ::: "memory"); __builtin_amdgcn_sched_barrier(0);
    gload8(B1, UT, idh + 72, g24); gdot8<0>(B0, xp2, D);
    gload8(B0, UT, idh + 80, g24); gdot8<8>(B1, xp2, D);
    gload8(B1, UT, idh + 88, g24); gdot8<16>(B0, xp2, D);
    if (tl < 3) { gload8(B0, UT, idh + 128, g24);
#pragma unroll
      for (int j = 0; j < 8; ++j) xr[j] = *(const u32x2*)(HX2 + (size_t)(t + 1) * 1024 + 128 * j + 4 * g); }
    gdot8<24>(B1, xp2, D);
    { const float val = reduce_t32(D, lane); CG[(size_t)t * 128 + 64 + lane] = gw[64 + lane] * gelu_t(val * su1) * sv1; }
    asm volatile("s_waitcnt lgkmcnt(0)" ::: "memory"); __builtin_amdgcn_sched_barrier(0);
  }
}
DEVI void ph_peer2(const Params& p, char* smem) {
  const int wave = __builtin_amdgcn_readfirstlane(threadIdx.x >> 6);
  int* idxw = (int*)(smem + 65536 + 8 * 32 * 33 * 4) + wave * 512; float* gww = (float*)(smem + 65536 + 8 * 32 * 33 * 4 + 8 * 2048) + wave * 512;
  const unsigned char* VT = (const unsigned char*)(p.ws + O_RA);
  const float* MOD = (const float*)(p.ws + O_MOD);
  const int* IDG = (const int*)(p.ws + O_RQ); const float* CG = (const float*)(p.ws + O_RQ + (size_t)NTOK * 128 * 4);
  for (int item = blockIdx.x; item < NTOK * 8 / 256; item += gridDim.x) {
    int lane = threadIdx.x & 63; asm volatile("" : "+v"(lane));
    const int h = lane >> 5, g = lane & 31, g24 = g * 24;
    const int t0 = item * 32 + wave * 4;
#pragma unroll
    for (int q = 0; q < 2; ++q) { *(int4*)(idxw + q * 256 + lane * 4) = *(const int4*)(IDG + (size_t)t0 * 128 + q * 256 + lane * 4);
      *(float4*)(gww + q * 256 + lane * 4) = *(const float4*)(CG + (size_t)t0 * 128 + q * 256 + lane * 4); }
    asm volatile("s_waitcnt vmcnt(0) lgkmcnt(0)" ::: "memory"); __builtin_amdgcn_sched_barrier(0);
    u32x6 B0[8], B1[8];
    gload8(B0, VT, idxw + h * 32, g24);
#pragma unroll 1
    for (int tl = 0; tl < 4; ++tl) {
      const int t = t0 + tl; const int* idh = idxw + tl * 128 + h * 32; const float* cw = gww + tl * 128 + h * 32;
      f32x2 acc2[16];
#pragma unroll
      for (int i = 0; i < 16; ++i) acc2[i] = (f32x2){0.f, 0.f};
      const int b = t >> 13, c0 = 512 * h + 4 * g;
      float* op = p.out + (size_t)t * 1024 + c0;
      float4 xv[4];
#pragma unroll
      for (int q4 = 0; q4 < 4; ++q4) xv[q4] = *(const float4*)(op + q4 * 128);
      asm volatile("" ::: "memory"); __builtin_amdgcn_sched_barrier(0);
      gload8(B1, VT, idh + 8, g24);  gaxpy8(B0, cw, acc2);
      gload8(B0, VT, idh + 16, g24); gaxpy8(B1, cw + 8, acc2);
      gload8(B1, VT, idh + 24, g24); gaxpy8(B0, cw + 16, acc2);
      gload8(B0, VT, idh + 64, g24); gaxpy8(B1, cw + 24, acc2);
      gload8(B1, VT, idh + 72, g24); gaxpy8(B0, cw + 64, acc2);
      gload8(B0, VT, idh + 80, g24); gaxpy8(B1, cw + 72, acc2);
      gload8(B1, VT, idh + 88, g24); gaxpy8(B0, cw + 80, acc2);
      if (tl < 3) gload8(B0, VT, idh + 128, g24);
      gaxpy8(B1, cw + 88, acc2);
      float o[16]; float ss = 0.f;
#pragma unroll
      for (int i = 0; i < 16; ++i) { const float lo = i & 1 ? acc2[i >> 1][1] : acc2[i >> 1][0], hi = i & 1 ? acc2[8 + (i >> 1)][1] : acc2[8 + (i >> 1)][0];
        auto rr = __builtin_amdgcn_permlane32_swap(__float_as_uint(lo), __float_as_uint(hi), false, false); o[i] = __uint_as_float(rr[0]) + __uint_as_float(rr[1]); ss += o[i] * o[i]; }
      ss = wave_sum(ss); const float rstd = rsqrtf(ss * (1.f / 1024.f) + EPS);
      const float* gt2 = MOD + b * 6144 + 5120 + c0;
#pragma unroll
      for (int q4 = 0; q4 < 4; ++q4) { float4 x4 = xv[q4]; const float4 gt = *(const float4*)(gt2 + q4 * 128), gp = *(const float4*)(p.g_post2 + c0 + q4 * 128);
        x4.x += gt.x * (o[q4 * 4 + 0] * rstd * gp.x); x4.y += gt.y * (o[q4 * 4 + 1] * rstd * gp.y);
        x4.z += gt.z * (o[q4 * 4 + 2] * rstd * gp.z); x4.w += gt.w * (o[q4 * 4 + 3] * rstd * gp.w);
        *(float4*)(op + q4 * 128) = x4; }
      asm volatile("s_waitcnt lgkmcnt(0)" ::: "memory"); __builtin_amdgcn_sched_barrier(0);
    }
  }
}

#define XB_TMO      128
#define XB_XCNT(j)  (256  + 64 * (j))
#define XB_XSUB(j)  (1280 + 64 * (j))
#define XB_XGEN(j)  (2304 + 64 * (j))
#define XB_TOP      3328
#define XB_TOPGEN   3392
#define XCD_BAR_WORDS 3456
#define XB_SPIN_CAP (1u << 18)
#define LAS __attribute__((address_space(3)))
DEVI unsigned xb_ld(unsigned* p)              { return __hip_atomic_load(p, __ATOMIC_RELAXED, __HIP_MEMORY_SCOPE_AGENT); }
DEVI unsigned xb_add(unsigned* p, unsigned v) { return __hip_atomic_fetch_add(p, v, __ATOMIC_RELAXED, __HIP_MEMORY_SCOPE_AGENT); }
DEVI unsigned xb_xcc_id() { return (unsigned)__builtin_amdgcn_s_getreg((3 << 11) | 20) & 0xFu; }
#define XB_SPIN(cond, bar) do { unsigned _sp = 0; while (cond) { __builtin_amdgcn_s_sleep(1); \
    if ((++_sp & 255u) == 0u) { if (xb_ld(&(bar)[XB_TMO])) break; if (_sp > XB_SPIN_CAP) { atomicAdd(&(bar)[XB_TMO], 1u); break; } } } } while (0)
struct XcdBarrier { unsigned* bar; unsigned x; volatile LAS unsigned* st; };
DEVI XcdBarrier xcd_barrier_post(unsigned* bar, volatile LAS unsigned* st) {
  XcdBarrier b; b.bar = bar; b.x = xb_xcc_id(); b.st = st;
  if (threadIdx.x == 0) (void)xb_add(&bar[XB_XCNT(b.x)], 1u);
  return b;
}
DEVI void xcd_barrier_complete(unsigned* bar, unsigned x, unsigned& nloc, unsigned& nx) {
  const unsigned G = gridDim.x * gridDim.y * gridDim.z;
  unsigned sum, cnt, mine, sp = 0u;
  for (;;) {
    sum = 0u; cnt = 0u; mine = 0u;
#pragma unroll
    for (unsigned j = 0; j < 16; ++j) { const unsigned c = xb_ld(&bar[XB_XCNT(j)]); sum += c; cnt += (c > 0u) ? 1u : 0u; mine = (j == x) ? c : mine; }
    if (sum == G) break;
    __builtin_amdgcn_s_sleep(1);
    if ((++sp & 255u) == 0u) { if (xb_ld(&bar[XB_TMO])) break; if (sp > XB_SPIN_CAP) { atomicAdd(&bar[XB_TMO], 1u); break; } }
  }
  nloc = mine > 0u ? mine : 1u; nx = cnt > 0u ? cnt : 1u;
}
DEVI void xcd_barrier(const XcdBarrier& b) {
  asm volatile("s_waitcnt vmcnt(0)" ::: "memory");
  __syncthreads();
  if (threadIdx.x == 0) {
    unsigned* bar = b.bar;
    __builtin_amdgcn_s_waitcnt(0);
    unsigned nloc = b.st[0], nx = b.st[1];
    if (nloc == 0u) { xcd_barrier_complete(bar, b.x, nloc, nx); b.st[0] = nloc; b.st[1] = nx; }
    const unsigned old = xb_add(&bar[XB_XSUB(b.x)], 1u);
    const unsigned gen = old / nloc;
    if (old + 1u == (gen + 1u) * nloc) {
      __builtin_amdgcn_fence(__ATOMIC_RELEASE, "agent");
      asm volatile("s_waitcnt vmcnt(0)" ::: "memory");
      const unsigned og = xb_add(&bar[XB_TOP], 1u);
      const unsigned tg = og / nx;
      if (og + 1u == (tg + 1u) * nx) xb_add(&bar[XB_TOPGEN], 1u);
      else XB_SPIN(xb_ld(&bar[XB_TOPGEN]) == tg, bar);
      __builtin_amdgcn_fence(__ATOMIC_ACQUIRE, "agent");
      xb_add(&bar[XB_XGEN(b.x)], 1u);
      asm volatile("s_waitcnt vmcnt(0)" ::: "memory");
    } else {
      XB_SPIN(xb_ld(&bar[XB_XGEN(b.x)]) == gen, bar);
      __builtin_amdgcn_fence(__ATOMIC_ACQUIRE, "agent");
      asm volatile("s_waitcnt vmcnt(0)" ::: "memory");
    }
  }
  __syncthreads();
}

constexpr int NPHASE = 12;
template <int PH> DEVI void run_phase(const Params& p, char* smem) {
  if constexpr (PH == 0) ph_prep(p, smem);
  else if constexpr (PH == 1) ph_hx(p, smem);
  else if constexpr (PH == 2) ph_inproj(p, smem);
  else if constexpr (PH == 3) ph_mid(p, smem);
  else if constexpr (PH == 4) ph_attn(p, smem);
  else if constexpr (PH == 5) ph_gates(p, smem);
  else if constexpr (PH == 6) ph_merge(p, smem);
  else if constexpr (PH == 7) ph_wo(p, smem);
  else if constexpr (PH == 8) ph_rows(p, smem);
  else if constexpr (PH == 9) ph_wpq(p, smem);
  else if constexpr (PH == 10) ph_topk(p, smem);
  else if constexpr (PH == 11) ph_peer2(p, smem);
}

#define RUNPH(N) do { run_phase<N>(p, smem); if (N < NPHASE - 1) xcd_barrier(xb); } while (0)
__global__ __launch_bounds__(NTHR) void k_mega(Params p) {
  extern __shared__ __attribute__((aligned(16))) char smem[];
  cg::grid_group grid = cg::this_grid();
  unsigned* bar = (unsigned*)(p.ws + O_BAR);
  volatile LAS unsigned* xst = (volatile LAS unsigned*)(smem + LDS_BYTES - 16);
  if (threadIdx.x == 0) { xst[0] = 0u; xst[1] = 0u; }
  __syncthreads();
  const XcdBarrier xb = xcd_barrier_post(bar, xst);
  if (p.out == nullptr) grid.sync();
  RUNPH(0);
  RUNPH(1); RUNPH(2); RUNPH(3); RUNPH(4); RUNPH(5); RUNPH(6); RUNPH(7); RUNPH(8); RUNPH(9); RUNPH(10); RUNPH(11);
}

extern "C" void kernel_launch(void* const* d_in, const int* in_sizes, int n_in, void* d_out, int out_size, void* d_ws, size_t ws_size, hipStream_t stream) {
  static int grid = 0;
  if (grid == 0) {
    if (n_in != 26 || out_size != NTOK * DM || ws_size < O_END) { fprintf(stderr, "kernel_launch: unexpected shapes n_in %d out %d ws %zu (need %zu)\n", n_in, out_size, ws_size, (size_t)O_END); grid = -1; return; }
    (void)hipFuncSetAttribute((const void*)k_mega, hipFuncAttributeMaxDynamicSharedMemorySize, LDS_BYTES);
    int dev = 0, cus = 0, per_cu = 0; (void)hipGetDevice(&dev); (void)hipDeviceGetAttribute(&cus, hipDeviceAttributeMultiprocessorCount, dev);
    (void)hipOccupancyMaxActiveBlocksPerMultiprocessor(&per_cu, (const void*)k_mega, NTHR, LDS_BYTES);
    if (per_cu < 1) { fprintf(stderr, "kernel_launch: occupancy query says %d blocks per CU\n", per_cu); grid = -1; return; }
    grid = cus;
  }
  if (grid < 0) return;
  Params p{};
  const float** pp = (const float**)&p;
  for (int i = 0; i < 26; ++i) pp[i] = (const float*)d_in[i];
  p.out = (float*)d_out; p.ws = (char*)d_ws;
  (void)hipMemsetAsync((char*)d_ws + O_BAR, 0, (size_t)XCD_BAR_WORDS * 4, stream);
  void* args[] = {&p};
  hipError_t e = hipLaunchCooperativeKernel((const void*)k_mega, dim3(grid), dim3(NTHR), args, LDS_BYTES, stream);
  if (e != hipSuccess) fprintf(stderr, "cooperative launch failed: %s (grid %d)\n", hipGetErrorString(e), grid);
}
```

```cpp
#include <hip/hip_runtime.h>
#include <hip/hip_cooperative_groups.h>
#include <cstdint>
#include <cstdio>
namespace cg = cooperative_groups;

#define DEVI __device__ __forceinline__
typedef unsigned short bf16_t;
using bf16x8 = __attribute__((ext_vector_type(8))) short;
using bf16x4 = __attribute__((ext_vector_type(4))) short;
using f32x4  = __attribute__((ext_vector_type(4))) float;
using f32x16 = __attribute__((ext_vector_type(16))) float;
using u32x4  = __attribute__((ext_vector_type(4))) unsigned;
using u32x2  = __attribute__((ext_vector_type(2))) unsigned;

constexpr int DM = 1024, NB = 2, SEQ = 8192, NTOK = NB * SEQ, CTXL = 256, NCTX = NB * CTXL, NROW = NTOK + NCTX, NKEY = SEQ + CTXL;
constexpr int INW = 4544, INWP = 4608;
constexpr int NPRE = 2560;
constexpr float EPS = 1e-6f;
constexpr int NTHR = 512, NWAVE = 8;
constexpr int LDS_BYTES = 147456;

constexpr size_t al256(size_t x) { return (x + 255) / 256 * 256; }
constexpr size_t O_WIN   = 0;
constexpr size_t O_WUQ   = O_WIN  + al256((size_t)INWP * 1024 * 2);
constexpr size_t O_WUKV  = O_WUQ  + al256((size_t)1536 * 256 * 2);
constexpr size_t O_WPA   = O_WUKV + al256((size_t)2048 * 128 * 2);
constexpr size_t O_WPB   = O_WPA  + al256((size_t)1024 * 1024 * 2);
constexpr size_t O_WO    = O_WPB  + al256((size_t)1024 * 1024 * 2);
constexpr size_t O_WPQ   = O_WO   + al256((size_t)1024 * 1024 * 2);
constexpr size_t O_WS    = O_WPQ  + al256((size_t)2048 * 1024 * 2);
constexpr size_t O_K1    = O_WS   + al256((size_t)8 * 128 * 128 * 2);
constexpr size_t O_K2    = O_K1   + al256((size_t)128 * 128 * 2);
constexpr size_t O_MOD   = O_K2   + al256((size_t)128 * 128 * 2);
constexpr size_t O_ROPE  = O_MOD  + al256((size_t)3 * 6144 * 4);
constexpr size_t O_BAR   = O_ROPE + al256((size_t)128 * 16 * 2 * 4);
constexpr size_t O_RSSV  = O_BAR + al256((size_t)3456 * 4);
constexpr size_t O_RSSQ  = O_RSSV + (size_t)NTOK * 32 * 4;
constexpr size_t O_RSSKV = O_RSSQ + (size_t)NTOK * 8 * 4;
constexpr size_t O_RSSY  = O_RSSKV + (size_t)NROW * 4 * 4;
constexpr size_t O_RSSEND = O_RSSY + (size_t)NTOK * 32 * 4;
constexpr size_t O_RA    = al256(O_RSSEND);
constexpr size_t O_RB    = O_RA  + al256((size_t)NROW * 1024 * 2);
constexpr size_t O_RC    = O_RB  + al256((size_t)NTOK * 1024 * 2);
constexpr size_t O_CQ    = O_RC  + al256((size_t)NTOK * 1024 * 2);
constexpr size_t O_CKV   = O_CQ  + al256((size_t)NTOK * 256 * 2);
constexpr size_t O_KR    = O_CKV + al256((size_t)NROW * 128 * 2);
constexpr size_t O_RQ    = O_KR  + al256((size_t)NROW * 64 * 2);
constexpr size_t O_RKV   = O_RQ  + al256((size_t)NTOK * 1536 * 2);
constexpr size_t O_END   = O_RKV + al256((size_t)NROW * 2048 * 2);
static_assert(O_END <= (size_t)258 * 1024 * 1024, "workspace too large");

struct Params {
  const float *x, *c, *ctx, *c_ctx, *w_mod, *b_mod, *g_pre1, *g_post1, *g_pre2, *g_post2, *w_in, *g_q, *g_kv, *w_uq, *w_ukv, *g_sgu, *w_s, *b_s,
      *w_pa, *w_pb, *w_o, *w_pq, *k1, *k2, *u_exp, *v_exp;
  float* out; char* ws;
};

DEVI float bf2f(unsigned short h) { return __uint_as_float(((unsigned)h) << 16); }
DEVI unsigned short f2bf(float f) { unsigned u = __float_as_uint(f); u += 0x7fffu + ((u >> 16) & 1u); return (unsigned short)(u >> 16); }
typedef __bf16 bf16x2_t __attribute__((ext_vector_type(2)));
typedef float f32x2v_t __attribute__((ext_vector_type(2)));
DEVI unsigned pack2(float a, float b) { const f32x2v_t v = {a, b}; return __builtin_bit_cast(unsigned, __builtin_convertvector(v, bf16x2_t)); }
DEVI float lo2f(unsigned w) { return __uint_as_float(w << 16); }
DEVI float hi2f(unsigned w) { return __uint_as_float(w & 0xffff0000u); }
DEVI void unpack8(const u32x4& w, float* f) {
  f[0] = lo2f(w[0]); f[1] = hi2f(w[0]); f[2] = lo2f(w[1]); f[3] = hi2f(w[1]); f[4] = lo2f(w[2]); f[5] = hi2f(w[2]); f[6] = lo2f(w[3]); f[7] = hi2f(w[3]);
}
DEVI float gelu_t(float x) { const float z = 0.7978845608028654f * (x + 0.044715f * x * x * x); return x * __builtin_amdgcn_rcpf(1.f + __expf(-2.f * z)); }
DEVI float sigmoidf_(float x) { return __builtin_amdgcn_rcpf(1.f + __expf(-x)); }
DEVI float wave_sum(float v) { for (int o = 32; o > 0; o >>= 1) v += __shfl_xor(v, o); return v; }
DEVI float wave_max(float v) { for (int o = 32; o > 0; o >>= 1) v = fmaxf(v, __shfl_xor(v, o)); return v; }
DEVI void keyrow2(int row, int& b, int& key) { if (row < NTOK) { b = row >> 13; key = row & 8191; } else { const int c = row - NTOK; b = c >> 8; key = SEQ + (c & 255); } }
DEVI int keyrow(int row) { if (row < NTOK) return (row >> 13) * NKEY + (row & 8191); int c = row - NTOK; return (c >> 8) * NKEY + SEQ + (c & 255); }

__device__ const float ROPE_FREQ[16] = {1.0f, 0.5623413324356079f, 0.3162277638912201f, 0.17782793939113617f, 0.10000000149011612f, 0.05623413249850273f, 0.03162277489900589f, 0.017782794311642647f, 0.009999999776482582f, 0.005623413249850273f, 0.003162277629598975f, 0.0017782794311642647f, 0.0010000000474974513f, 0.000562341301701963f, 0.0003162277571391314f, 0.00017782794020604342f};
DEVI void sincos_small(double a, double& cs, double& sn) {
  const double k = rint(a * 0.15915494309189535); const double r = fma(-k, 6.283185307179586, a) - k * 2.4492935982947064e-16;
  const double r2 = r * r; double s = 0.0, c = 0.0;
#pragma unroll
  for (int n = 12; n >= 1; --n) { s = (1.0 - s * r2 / (double)((2 * n) * (2 * n + 1))); c = (1.0 - c * r2 / (double)((2 * n - 1) * (2 * n))); }
  sn = r * s; cs = c;
}

DEVI void transpose_job(const float* __restrict__ src, int K, int N, bf16_t* __restrict__ dst, const float* __restrict__ gk, bool isWin, int ntiles, char* smem) {
  const int tid = threadIdx.x; bf16_t* tl = (bf16_t*)smem; const int kt = K / 64;
  for (int idx = blockIdx.x; idx < ntiles; idx += gridDim.x) {
    const int ktile = idx % kt, ntile = idx / kt, k0 = ktile * 64, n0d = ntile * 64;
    int n0s = n0d; bool zero = false;
    if (isWin) { if (n0d == 2496) zero = true; else if (n0d >= 2560) n0s = n0d - 64; }
    { const int kk = tid >> 3, nn8 = (tid & 7) * 8; f32x4 va = {0.f, 0.f, 0.f, 0.f}, vb = va;
      if (!zero) { const float* s = src + (size_t)(k0 + kk) * N + n0s + nn8; const float4 a = *(const float4*)s, b = *(const float4*)(s + 4);
        const float sc = gk ? gk[k0 + kk] : 1.f; va = (f32x4){a.x, a.y, a.z, a.w} * sc; vb = (f32x4){b.x, b.y, b.z, b.w} * sc; }
      bf16_t* tp = tl + nn8 * 72 + kk;
      tp[0] = f2bf(va[0]); tp[72] = f2bf(va[1]); tp[144] = f2bf(va[2]); tp[216] = f2bf(va[3]); tp[288] = f2bf(vb[0]); tp[360] = f2bf(vb[1]); tp[432] = f2bf(vb[2]); tp[504] = f2bf(vb[3]); }
    __syncthreads();
    { const int nn = tid >> 3, kk8 = (tid & 7) * 8;
      const u32x4 o = *(const u32x4*)(tl + nn * 72 + kk8);
      *(u32x4*)(dst + (size_t)(n0d + nn) * K + k0 + kk8) = o; }
    __syncthreads();
  }
}

DEVI void ph_prep(const Params& p, char* smem) {
  const int tid = threadIdx.x, bid = blockIdx.x, nb = gridDim.x;
  char* ws = p.ws;
  if (bid == 0) { float* rope = (float*)(ws + O_ROPE);
    for (int i = tid; i < 128 * 16; i += NTHR) { const int pos = i >> 4, f = i & 15; const float ang = (float)pos * ROPE_FREQ[f];
      double cs, sn; sincos_small((double)ang, cs, sn); rope[i * 2] = (float)cs; rope[i * 2 + 1] = (float)sn; } }
  { float* red = (float*)smem; float* MOD = (float*)(ws + O_MOD);
    for (int it = bid; it < 256; it += nb) {
      const int cgp = tid % 6, kg = tid / 6;
      f32x4 a0 = {0.f, 0.f, 0.f, 0.f}, a1 = a0, a2 = a0;
      if (tid < 510) {
        for (int k = kg; k < 1024; k += 85) {
          const float4 w4 = *(const float4*)(p.w_mod + (size_t)k * 6144 + it * 24 + cgp * 4);
          const f32x4 w = {w4.x, w4.y, w4.z, w4.w};
          const float c0 = p.c[k], c1 = p.c[1024 + k], c2 = p.c_ctx[k];
          a0 += w * (c0 / (1.f + __expf(-c0))); a1 += w * (c1 / (1.f + __expf(-c1))); a2 += w * (c2 / (1.f + __expf(-c2)));
        }
        float* rp = red + kg * 72 + cgp * 4;
        rp[0] = a0[0]; rp[1] = a0[1]; rp[2] = a0[2]; rp[3] = a0[3];
        rp[24] = a1[0]; rp[25] = a1[1]; rp[26] = a1[2]; rp[27] = a1[3];
        rp[48] = a2[0]; rp[49] = a2[1]; rp[50] = a2[2]; rp[51] = a2[3];
      }
      __syncthreads();
      if (tid < 72) { float s = 0.f; for (int g = 0; g < 85; ++g) s += red[g * 72 + tid]; int r = tid / 24, n = it * 24 + tid % 24; MOD[r * 6144 + n] = s + p.b_mod[n]; }
      __syncthreads();
    } }
  transpose_job(p.w_in,  1024, INW,  (bf16_t*)(ws + O_WIN),  nullptr, true,  1152, smem);
  transpose_job(p.w_uq,  256,  1536, (bf16_t*)(ws + O_WUQ),  p.g_q,   false, 96,   smem);
  transpose_job(p.w_ukv, 128,  2048, (bf16_t*)(ws + O_WUKV), p.g_kv,  false, 64,   smem);
  transpose_job(p.w_pa,  1024, 1024, (bf16_t*)(ws + O_WPA),  nullptr, false, 256,  smem);
  transpose_job(p.w_pb,  1024, 1024, (bf16_t*)(ws + O_WPB),  nullptr, false, 256,  smem);
  transpose_job(p.w_o,   1024, 1024, (bf16_t*)(ws + O_WO),   nullptr, false, 256,  smem);
  transpose_job(p.w_pq,  1024, 2048, (bf16_t*)(ws + O_WPQ),  nullptr, false, 512,  smem);
  { const int n8 = (131072 + 16384 + 16384) / 8;
    for (int i = bid * NTHR + tid; i < n8; i += nb * NTHR) {
      int e = i * 8; const float* s; bf16_t* d;
      if (e < 131072) { s = p.w_s + e; d = (bf16_t*)(ws + O_WS) + e; }
      else if (e < 131072 + 16384) { s = p.k1 + (e - 131072); d = (bf16_t*)(ws + O_K1) + (e - 131072); }
      else { s = p.k2 + (e - 131072 - 16384); d = (bf16_t*)(ws + O_K2) + (e - 131072 - 16384); }
      const float4 a = *(const float4*)s, b = *(const float4*)(s + 4);
      u32x4 o = {pack2(a.x, a.y), pack2(a.z, a.w), pack2(b.x, b.y), pack2(b.z, b.w)};
      *(u32x4*)d = o;
    } }
}


using f32x32 = __attribute__((ext_vector_type(32))) float;
using u32x6 = __attribute__((ext_vector_type(6))) unsigned;
typedef u32x4 __attribute__((aligned(4))) u32x4_u;
typedef u32x2 __attribute__((aligned(4))) u32x2_u;
DEVI void convert_table_fp6(const float* __restrict__ src, unsigned char* __restrict__ dst, float* __restrict__ scale) {
  const int wave = threadIdx.x >> 6, lane = threadIdx.x & 63, h = lane >> 5, g = lane & 31;
  for (int rp = blockIdx.x * NWAVE + wave; rp < 8192; rp += gridDim.x * NWAVE) {
    const int row = rp * 2 + h;
    const float* sp = src + (size_t)row * 1024 + g * 4;
    f32x16 a, b; float am = 0.f;
#pragma unroll
    for (int j = 0; j < 8; ++j) { const float4 t = *(const float4*)(sp + 128 * j);
      a[2 * j] = t.x; b[2 * j] = t.y; a[2 * j + 1] = t.z; b[2 * j + 1] = t.w;
      am = fmaxf(am, fmaxf(fmaxf(fabsf(t.x), fabsf(t.y)), fmaxf(fabsf(t.z), fabsf(t.w)))); }
    for (int o = 16; o > 0; o >>= 1) am = fmaxf(am, __shfl_xor(am, o));
    const float inv = am > 0.f ? 7.5f / am : 0.f;
    const u32x6 w = __builtin_amdgcn_cvt_scalef32_2xpk16_fp6_f32(a * inv, b * inv, 1.0f);
    unsigned char* dp = dst + (size_t)row * 768 + g * 24;
    *(u32x4_u*)dp = (u32x4){w[0], w[1], w[2], w[3]}; *(u32x2_u*)(dp + 16) = (u32x2){w[4], w[5]};
    if (g == 0) scale[row] = am * (1.f / 7.5f);
  }
}

DEVI void ph_hx(const Params& p, char* smem) {
  const int tid = threadIdx.x, wave = tid >> 6, lane = tid & 63;
  float* mA = (float*)smem; float* mB = mA + 3 * 1024;
  const float* MOD = (const float*)(p.ws + O_MOD);
  for (int i = tid; i < 3072; i += NTHR) { int r = i >> 10, c = i & 1023; mA[i] = p.g_pre1[c] * (1.f + MOD[r * 6144 + 1024 + c]); mB[i] = MOD[r * 6144 + c]; }
  __syncthreads();
  bf16_t* HX = (bf16_t*)(p.ws + O_RA);
  for (int row = blockIdx.x * NWAVE + wave; row < NROW; row += gridDim.x * NWAVE) {
    const float* src = row < NTOK ? p.x + (size_t)row * 1024 : p.ctx + (size_t)(row - NTOK) * 1024;
    const int mr = row < NTOK ? (row >> 13) : 2;
    float4 v[4]; float ss = 0.f;
#pragma unroll
    for (int i = 0; i < 4; ++i) { v[i] = *(const float4*)(src + i * 256 + lane * 4); ss += v[i].x * v[i].x + v[i].y * v[i].y + v[i].z * v[i].z + v[i].w * v[i].w; }
    ss = wave_sum(ss); const float rstd = rsqrtf(ss * (1.f / 1024.f) + EPS);
#pragma unroll
    for (int i = 0; i < 4; ++i) { const int c = i * 256 + lane * 4; const float* a = mA + mr * 1024 + c; const float* b = mB + mr * 1024 + c;
      u32x2 o = {pack2(v[i].x * rstd * a[0] + b[0], v[i].y * rstd * a[1] + b[1]), pack2(v[i].z * rstd * a[2] + b[2], v[i].w * rstd * a[3] + b[3])};
      *(u32x2*)(HX + (size_t)row * 1024 + c) = o; }
  }
}

DEVI int lds_sw(int row, int c) { return row * 128 + ((c ^ (row & 7)) << 4); }
template <int BM, int BN, bool ACOLMAP, bool GLDS, class Epi>
DEVI void gemm_tile_mfma(const bf16_t* __restrict__ A, int lda, const bf16_t* __restrict__ Bm, int ldb, int K, int row0, int col0, const Epi& epi, const float* kscale, char* smem) {
  constexpr int WNW = BN / 64, WMW = 8 / WNW, WTM = BM / WMW, MI = WTM / 16, ACH = BM / 64, BCH = BN / 64, ABYTES = BM * 128, BBYTES = BN * 128, STAGE = ABYTES + BBYTES;
  int tid = threadIdx.x; asm volatile("" : "+v"(tid));
  const int wave = __builtin_amdgcn_readfirstlane(tid >> 6), lane = tid & 63, wm = wave / WNW, wn = wave % WNW, l15 = lane & 15, lq = lane >> 4;
  f32x4 acc[MI][4];
#pragma unroll
  for (int mi = 0; mi < MI; ++mi)
#pragma unroll
    for (int ni = 0; ni < 4; ++ni) acc[mi][ni] = (f32x4){0.f, 0.f, 0.f, 0.f};
  const int nk = K >> 6;
  const int sr = tid >> 3, scc = tid & 7;
  auto compute = [&](int buf) {
    const char* sa = smem + buf * STAGE; const char* sb = sa + ABYTES;
#pragma unroll
    for (int ks = 0; ks < 2; ++ks) { const int kc = ks * 4 + lq; bf16x8 bfr[4];
#pragma unroll
      for (int ni = 0; ni < 4; ++ni) bfr[ni] = *(const bf16x8*)(sb + lds_sw(wn * 64 + ni * 16 + l15, kc));
#pragma unroll
      for (int mi = 0; mi < MI; ++mi) { const bf16x8 af = *(const bf16x8*)(sa + lds_sw(wm * WTM + mi * 16 + l15, kc));
#pragma unroll
        for (int ni = 0; ni < 4; ++ni) acc[mi][ni] = __builtin_amdgcn_mfma_f32_16x16x32_bf16(bfr[ni], af, acc[mi][ni], 0, 0, 0); }
    }
  };
  if constexpr (GLDS) {
    const unsigned aoff = (unsigned)(sr * lda + ((scc ^ (sr & 7)) * 8)) * 2u, boff = (unsigned)(sr * ldb + ((scc ^ (sr & 7)) * 8)) * 2u;
    auto gstage = [&](int buf, int kt) {
      const int k0 = kt * 64, ka = ACOLMAP ? k0 + (k0 >> 7) * 64 : k0;
      char* sa = smem + buf * STAGE + wave * 1024; char* sb = sa + ABYTES;
#pragma unroll
      for (int i = 0; i < ACH; ++i) __builtin_amdgcn_global_load_lds((const unsigned*)((const char*)(A + (size_t)(64 * i) * lda + ka) + aoff), (unsigned*)(sa + i * 8192), 16, 0, 0);
#pragma unroll
      for (int i = 0; i < BCH; ++i) __builtin_amdgcn_global_load_lds((const unsigned*)((const char*)(Bm + (size_t)(64 * i) * ldb + k0) + boff), (unsigned*)(sb + i * 8192), 16, 0, 0);
    };
    gstage(0, 0); asm volatile("s_waitcnt vmcnt(0)" ::: "memory"); __syncthreads();
    for (int kt = 0; kt < nk; ++kt) {
      if (kt + 1 < nk) gstage((kt + 1) & 1, kt + 1);
      compute(kt & 1);
      asm volatile("s_waitcnt vmcnt(0)" ::: "memory"); __syncthreads();
    }
  } else {
    u32x4 ra[ACH], rb[BCH];
    const unsigned aoff = (unsigned)(sr * lda + scc * 8) * 2u, boff = (unsigned)(sr * ldb + scc * 8) * 2u;
    const int sdst = lds_sw(sr, scc);
    auto gload = [&](int kt) {
      const int k0 = kt * 64, ka = ACOLMAP ? k0 + (k0 >> 7) * 64 : k0;
#pragma unroll
      for (int i = 0; i < ACH; ++i) { const char* ub = (const char*)(A + (size_t)(64 * i) * lda + ka); ra[i] = *(const u32x4*)(ub + aoff); }
#pragma unroll
      for (int i = 0; i < BCH; ++i) { const char* ub = (const char*)(Bm + (size_t)(64 * i) * ldb + k0); rb[i] = *(const u32x4*)(ub + boff); }
    };
    auto lstore = [&](int buf, int kt) {
      char* sa = smem + buf * STAGE + sdst; char* sb = sa + ABYTES;
#pragma unroll
      for (int i = 0; i < ACH; ++i) { u32x4 v = ra[i];
        if (kscale) { float f[8]; unpack8(v, f); const float* ks = kscale + kt * 64 + scc * 8;
          v = (u32x4){pack2(f[0] * ks[0], f[1] * ks[1]), pack2(f[2] * ks[2], f[3] * ks[3]), pack2(f[4] * ks[4], f[5] * ks[5]), pack2(f[6] * ks[6], f[7] * ks[7])}; }
        *(u32x4*)(sa + i * 8192) = v; }
#pragma unroll
      for (int i = 0; i < BCH; ++i) *(u32x4*)(sb + i * 8192) = rb[i];
    };
    gload(0); lstore(0, 0); __syncthreads();
    for (int kt = 0; kt < nk; ++kt) {
      if (kt + 1 < nk) gload(kt + 1);
      compute(kt & 1);
      if (kt + 1 < nk) lstore((kt + 1) & 1, kt + 1);
      __syncthreads();
    }
  }
  int tide = threadIdx.x; asm volatile("" : "+v"(tide));
  const int l15e = tide & 15, lqe = (tide >> 4) & 3;
  float cs[4][4];
  if constexpr (Epi::SCALE_MODE == 2) {
#pragma unroll
    for (int ni = 0; ni < 4; ++ni)
#pragma unroll
      for (int j = 0; j < 4; ++j) cs[ni][j] = epi.colscale(col0 + wn * 64 + ni * 16 + lqe * 4 + j); }
#pragma unroll
  for (int mi = 0; mi < MI; ++mi) { const int row = row0 + wm * WTM + mi * 16 + l15e; float sq = 0.f; float rs = 1.f;
    if constexpr (Epi::SCALE_MODE == 1) rs = epi.rowscale(row);
#pragma unroll
    for (int ni = 0; ni < 4; ++ni) { float v[4] = {acc[mi][ni][0], acc[mi][ni][1], acc[mi][ni][2], acc[mi][ni][3]};
      if constexpr (Epi::SCALE_MODE == 1) { v[0] *= rs; v[1] *= rs; v[2] *= rs; v[3] *= rs; }
      if constexpr (Epi::SCALE_MODE == 2) { v[0] *= cs[ni][0]; v[1] *= cs[ni][1]; v[2] *= cs[ni][2]; v[3] *= cs[ni][3]; }
      const float q = epi(row, col0 + wn * 64 + ni * 16 + lqe * 4, v);
      if (Epi::RSS) { sq += q; if (ni & 1) { sq += __shfl_xor(sq, 16); sq += __shfl_xor(sq, 32); if (lqe == 0) epi.rss(row, col0 + wn * 64 + (ni >> 1) * 32, sq); sq = 0.f; } } }
    __builtin_amdgcn_sched_barrier(0); }
}


namespace g8 {
constexpr int BK = 64, HALF = 128, HT = HALF * BK;
DEVI int lds_byte(int r, int c) { const int st = (r >> 4) * 2 + (c >> 5), rr = r & 15, cc = c & 31, ob = rr * 64 + cc * 2; return st * 1024 + (ob ^ (((ob >> 9) & 1) << 5)); }
DEVI void stage_rc(int b, int& R, int& C) { const int st = b / 1024, sb = b % 1024, swz = sb ^ (((sb >> 9) & 1) << 5); R = (st >> 1) * 16 + swz / 64; C = (st & 1) * 32 + (swz % 64) / 2; }
}
template <bool ACOLMAP, int AH2 = 128, int BH2 = 128, class Epi>
DEVI void gemm_tile_8ph(const bf16_t* __restrict__ A, int lda, const bf16_t* __restrict__ Bt, int ldb, int K, int row0, int col0, const Epi& epi, char* smem) {
  using namespace g8;
  bf16_t* shm = (bf16_t*)smem;
#define SA(b, h) (shm + ((b) * 2 + (h)) * HT)
#define SB(b, h) (shm + (4 + (b) * 2 + (h)) * HT)
#define STAGE_A(P, r0, kt) do { const int _k0 = (kt) * BK, _ka = ACOLMAP ? _k0 + (_k0 >> 7) * 64 : _k0; \
    const int _r = (r0) ? AH2 : 0; \
    __builtin_amdgcn_global_load_lds((const unsigned*)((const char*)(A + (size_t)(_r) * lda + _ka) + ao0), (unsigned*)((char*)(P) + wid * 1024), 16, 0, 0); \
    __builtin_amdgcn_global_load_lds((const unsigned*)((const char*)(A + (size_t)(_r + 64) * lda + _ka) + ao0), (unsigned*)((char*)(P) + wid * 1024 + 8192), 16, 0, 0); } while (0)
#define STAGE_B(P, r0, kt) do { const int _k0 = (kt) * BK; \
    const int _r = (r0) ? BH2 : 0; \
    __builtin_amdgcn_global_load_lds((const unsigned*)((const char*)(Bt + (size_t)(_r) * ldb + _k0) + bo0), (unsigned*)((char*)(P) + wid * 1024), 16, 0, 0); \
    __builtin_amdgcn_global_load_lds((const unsigned*)((const char*)(Bt + (size_t)(_r + 64) * ldb + _k0) + bo0), (unsigned*)((char*)(P) + wid * 1024 + 8192), 16, 0, 0); } while (0)
#define LDA(dst, b, h) _Pragma("unroll") for (int m = 0; m < 4; ++m) _Pragma("unroll") for (int k = 0; k < 2; ++k) \
    dst[m][k] = *reinterpret_cast<const bf16x8*>((const char*)SA(b, h) + lds_byte(wr * 64 + m * 16 + fr, k * 32 + fq * 8))
#define LDB(dst, b, h) _Pragma("unroll") for (int n = 0; n < 2; ++n) _Pragma("unroll") for (int k = 0; k < 2; ++k) \
    dst[n][k] = *reinterpret_cast<const bf16x8*>((const char*)SB(b, h) + lds_byte(wc * 32 + n * 16 + fr, k * 32 + fq * 8))
#define MMA(ai, bj, At_, Bt_) do { __builtin_amdgcn_s_setprio(1); \
    _Pragma("unroll") for (int m = 0; m < 4; ++m) _Pragma("unroll") for (int n = 0; n < 2; ++n) _Pragma("unroll") for (int k = 0; k < 2; ++k) \
      acc[ai][bj][m][n] = __builtin_amdgcn_mfma_f32_16x16x32_bf16(Bt_[n][k], At_[m][k], acc[ai][bj][m][n], 0, 0, 0); \
    __builtin_amdgcn_s_setprio(0); } while (0)
#define WAIT_V(n) asm volatile("s_waitcnt vmcnt(" #n ")" ::: "memory")
#define WAIT_L(n) asm volatile("s_waitcnt lgkmcnt(" #n ")" ::: "memory")
#define BAR __builtin_amdgcn_s_barrier()
#define SCHED __builtin_amdgcn_sched_barrier(0)
  int tid = threadIdx.x; asm volatile("" : "+v"(tid));
  const int wid = __builtin_amdgcn_readfirstlane(tid >> 6), lane = tid & 63, wr = wid >> 2, wc = wid & 3, fr = lane & 15, fq = lane >> 4;
  unsigned ao0, bo0;
  { int r, c; stage_rc(tid * 16, r, c); ao0 = (unsigned)(r * lda + c) * 2u; bo0 = (unsigned)(r * ldb + c) * 2u; }
  f32x4 acc[2][2][4][2];
#pragma unroll
  for (int a = 0; a < 2; ++a)
#pragma unroll
    for (int b = 0; b < 2; ++b)
#pragma unroll
      for (int m = 0; m < 4; ++m)
#pragma unroll
        for (int n = 0; n < 2; ++n) acc[a][b][m][n] = (f32x4){0.f, 0.f, 0.f, 0.f};
  bf16x8 At[4][2], B0[2][2], B1[2][2];
  const int nt = K / BK;
  STAGE_B(SB(0, 0), 0, 0); STAGE_A(SA(0, 0), 0, 0);
  STAGE_B(SB(0, 1), HALF, 0); STAGE_A(SA(0, 1), HALF, 0);
  if (wr == 1) BAR;
  WAIT_V(4); BAR;
  STAGE_B(SB(1, 0), 0, 1); STAGE_A(SA(1, 0), 0, 1); STAGE_B(SB(1, 1), HALF, 1);
  WAIT_V(6); BAR;
  for (int t = 0; t < nt - 2; t += 2) {
    LDB(B0, 0, 0); SCHED; LDA(At, 0, 0); STAGE_A(SA(1, 1), HALF, t + 1);
    WAIT_L(8); BAR; WAIT_L(0); MMA(0, 0, At, B0); BAR; SCHED;
    LDB(B1, 0, 1); STAGE_B(SB(0, 0), 0, t + 2);
    BAR; WAIT_L(0); MMA(0, 1, At, B1); BAR;
    LDA(At, 0, 1); STAGE_A(SA(0, 0), 0, t + 2);
    BAR; WAIT_L(0); MMA(1, 0, At, B0); BAR; SCHED;
    STAGE_B(SB(0, 1), HALF, t + 2);
    WAIT_V(6); BAR; MMA(1, 1, At, B1); BAR;
    LDB(B0, 1, 0); SCHED; LDA(At, 1, 0); STAGE_A(SA(0, 1), HALF, t + 2);
    WAIT_L(8); BAR; WAIT_L(0); MMA(0, 0, At, B0); BAR; SCHED;
    LDB(B1, 1, 1); STAGE_B(SB(1, 0), 0, t + 3);
    BAR; WAIT_L(0); MMA(0, 1, At, B1); BAR;
    LDA(At, 1, 1); STAGE_A(SA(1, 0), 0, t + 3);
    BAR; WAIT_L(0); MMA(1, 0, At, B0); BAR; SCHED;
    STAGE_B(SB(1, 1), HALF, t + 3);
    WAIT_V(6); BAR; MMA(1, 1, At, B1); BAR;
  }
  { LDB(B0, 0, 0); LDA(At, 0, 0); STAGE_A(SA(1, 1), HALF, nt - 1);
    BAR; WAIT_L(0); MMA(0, 0, At, B0); BAR;
    LDB(B1, 0, 1); BAR; WAIT_L(0); MMA(0, 1, At, B1); BAR;
    LDA(At, 0, 1); WAIT_V(4); BAR; WAIT_L(0); MMA(1, 0, At, B0); MMA(1, 1, At, B1); BAR; }
  { LDB(B0, 1, 0); LDA(At, 1, 0); WAIT_V(2); BAR; WAIT_L(0); MMA(0, 0, At, B0); BAR;
    LDB(B1, 1, 1); WAIT_V(0); BAR; WAIT_L(0); MMA(0, 1, At, B1); BAR;
    LDA(At, 1, 1); BAR; WAIT_L(0); MMA(1, 0, At, B0); MMA(1, 1, At, B1); BAR; }
  if (wr == 0) BAR;
  int tide = threadIdx.x; asm volatile("" : "+v"(tide));
  const int fre = tide & 15, fqe = (tide >> 4) & 3;
  float csc[2][2][4];
  if constexpr (Epi::SCALE_MODE == 2) {
#pragma unroll
    for (int bj = 0; bj < 2; ++bj)
#pragma unroll
      for (int n = 0; n < 2; ++n)
#pragma unroll
        for (int j = 0; j < 4; ++j) csc[bj][n][j] = epi.colscale(col0 + bj * HALF + wc * 32 + n * 16 + fqe * 4 + j); }
#pragma unroll
  for (int ai = 0; ai < 2; ++ai)
#pragma unroll
    for (int m = 0; m < 4; ++m) { const int row = row0 + ai * HALF + wr * 64 + m * 16 + fre;
      float rsc = 1.f; if constexpr (Epi::SCALE_MODE == 1) rsc = epi.rowscale(row);
#pragma unroll
      for (int bj = 0; bj < 2; ++bj) { float sq = 0.f;
#pragma unroll
        for (int n = 0; n < 2; ++n) { float v[4] = {acc[ai][bj][m][n][0], acc[ai][bj][m][n][1], acc[ai][bj][m][n][2], acc[ai][bj][m][n][3]};
          if constexpr (Epi::SCALE_MODE == 1) { v[0] *= rsc; v[1] *= rsc; v[2] *= rsc; v[3] *= rsc; }
          if constexpr (Epi::SCALE_MODE == 2) { v[0] *= csc[bj][n][0]; v[1] *= csc[bj][n][1]; v[2] *= csc[bj][n][2]; v[3] *= csc[bj][n][3]; }
          sq += epi(row, col0 + bj * HALF + wc * 32 + n * 16 + fqe * 4, v); }
        if (Epi::RSS) { sq += __shfl_xor(sq, 16); sq += __shfl_xor(sq, 32); if (fqe == 0) epi.rss(row, col0 + bj * HALF + wc * 32, sq); } }
      if (Epi::EPI_SBAR) __builtin_amdgcn_sched_barrier(0); }
#undef SA
#undef SB
#undef STAGE_A
#undef STAGE_B
#undef LDA
#undef LDB
#undef MMA
#undef WAIT_V
#undef WAIT_L
#undef BAR
#undef SCHED
}

template <int BM, int BN, bool ACOLMAP, class Epi>
DEVI void gemm_tile(const bf16_t* A, int lda, const bf16_t* Bm, int ldb, int K, int row0, int col0, const Epi& epi, const float* kss, char* smem) {
  if constexpr (BM == 256 && BN == 256) gemm_tile_8ph<ACOLMAP, 128, 128>(A, lda, Bm, ldb, K, row0, col0, epi, smem);
  else if (kss) gemm_tile_mfma<BM, BN, ACOLMAP, false>(A, lda, Bm, ldb, K, row0, col0, epi, kss, smem);
  else gemm_tile_mfma<BM, BN, ACOLMAP, true>(A, lda, Bm, ldb, K, row0, col0, epi, nullptr, smem);
}

DEVI void st4bf(bf16_t* d, float a, float b, float c, float e) { u32x2 o = {pack2(a, b), pack2(c, e)}; *(u32x2*)d = o; }

struct EpiIn { static constexpr bool RSS = true; static constexpr int SCALE_MODE = 0; static constexpr bool EPI_SBAR = false; bf16_t *GU, *GVT, *CQ, *CKV, *KR; float *rssv, *rssq, *rsskv;
  DEVI float operator()(int row, int col, const float (&v)[4]) const {
    if (col < 1024) { st4bf(GU + (size_t)row * 1024 + col, gelu_t(v[0]), gelu_t(v[1]), gelu_t(v[2]), gelu_t(v[3])); return 0.f; }
    else if (col < 2048) { const int c = col - 1024, chunk = row >> 7, q = row & 127; float s = 0.f;
#pragma unroll
      for (int j = 0; j < 4; ++j) { const float g = gelu_t(v[j]); s += g * g; GVT[((size_t)chunk * 1024 + c + j) * 128 + q] = f2bf(g); }
      return s; }
    else if (col < 2304) { st4bf(CQ + (size_t)row * 256 + (col - 2048), v[0], v[1], v[2], v[3]); return v[0] * v[0] + v[1] * v[1] + v[2] * v[2] + v[3] * v[3]; }
    else if (col < 2432) { st4bf(CKV + (size_t)row * 128 + (col - 2304), v[0], v[1], v[2], v[3]); return v[0] * v[0] + v[1] * v[1] + v[2] * v[2] + v[3] * v[3]; }
    else if (col < 2496) { st4bf(KR + (size_t)keyrow(row) * 64 + (col - 2432), v[0], v[1], v[2], v[3]); return 0.f; }
    return 0.f; }
  DEVI void rss(int row, int col, float s) const {
    if (col >= 1024 && col < 2048) rssv[row * 32 + ((col - 1024) >> 5)] = s; else if (col >= 2048 && col < 2304) rssq[row * 8 + ((col - 2048) >> 5)] = s; else if (col >= 2304 && col < 2432) rsskv[row * 4 + ((col - 2304) >> 5)] = s; }
};
struct EpiQ { static constexpr bool RSS = false; static constexpr int SCALE_MODE = 1; static constexpr bool EPI_SBAR = false; bf16_t* Q; const float* rssq;
  DEVI float rowscale(int row) const { const float4 ps = *(const float4*)(rssq + row * 8), pt = *(const float4*)(rssq + row * 8 + 4); return rsqrtf((((ps.x + ps.y) + (ps.z + ps.w)) + ((pt.x + pt.y) + (pt.z + pt.w))) * (1.f / 256.f) + EPS); }
  DEVI float operator()(int row, int col, const float (&v)[4]) const { st4bf(Q + (size_t)row * 1536 + col, v[0], v[1], v[2], v[3]); return 0.f; }
  DEVI void rss(int, int, float) const {} };
DEVI int pk4_fp8(float a, float b, float c, float d) { int w = __builtin_amdgcn_cvt_pk_fp8_f32(a, b, 0, false); return __builtin_amdgcn_cvt_pk_fp8_f32(c, d, w, true); }
constexpr size_t O_K8 = O_RKV, O_V8T = O_RKV + al256((size_t)NB * 8 * NKEY * 192);
struct EpiK8 { static constexpr bool RSS = false; static constexpr int SCALE_MODE = 1; static constexpr bool EPI_SBAR = false; unsigned char* K8; const float* rsskv;
  DEVI float rowscale(int row) const { const float4 pk = *(const float4*)(rsskv + row * 4); return rsqrtf(((pk.x + pk.y) + (pk.z + pk.w)) * (1.f / 128.f) + EPS); }
  DEVI float operator()(int row, int col, const float (&v)[4]) const {
    int b, key; keyrow2(row, b, key); const int h = col >> 7, d = col & 127;
    *(int*)(K8 + ((size_t)(b * 8 + h) * NKEY + key) * 192 + d) = pk4_fp8(v[0], v[1], v[2], v[3]); return 0.f; }
  DEVI void rss(int, int, float) const {} };
struct EpiV8T { static constexpr bool RSS = false; static constexpr int SCALE_MODE = 2; static constexpr bool EPI_SBAR = false; unsigned char* V8; const float* rsskv;
  DEVI float colscale(int col) const { const float4 pk = *(const float4*)(rsskv + col * 4); return rsqrtf(((pk.x + pk.y) + (pk.z + pk.w)) * (1.f / 128.f) + EPS); }
  DEVI float operator()(int row, int col, const float (&v)[4]) const {
    int b, key; keyrow2(col, b, key); const int h = row >> 7, d = row & 127, kk = key & 63;
    const int off = 32 * ((kk >> 2) & 1) + 16 * (kk >> 5) + 4 * ((kk >> 3) & 3);
    *(int*)(V8 + ((size_t)(b * 8 + h) * 128 + d) * NKEY + (key & ~63) + off) = pk4_fp8(v[0], v[1], v[2], v[3]); return 0.f; }
  DEVI void rss(int, int, float) const {} };
struct EpiSgu { static constexpr bool RSS = false; static constexpr int SCALE_MODE = 0; static constexpr bool EPI_SBAR = false; bf16_t* GUOA; const float* g_sgu; const float* b_s; int chunk, g;
  DEVI float operator()(int row, int col, const float (&v)[4]) const { const int token = chunk * 128 + row, ch = g * 128 + col; const float bias = b_s[g * 128 + row];
    bf16_t* ptr = GUOA + (size_t)token * 1024 + ch; const u32x2 gu = *(const u32x2*)ptr;
    st4bf(ptr, lo2f(gu[0]) * (g_sgu[ch] * v[0] + bias), hi2f(gu[0]) * (g_sgu[ch + 1] * v[1] + bias), lo2f(gu[1]) * (g_sgu[ch + 2] * v[2] + bias), hi2f(gu[1]) * (g_sgu[ch + 3] * v[3] + bias));
    return 0.f; }
  DEVI void rss(int, int, float) const {} };
struct EpiGate { static constexpr bool RSS = false; static constexpr int SCALE_MODE = 0; static constexpr bool EPI_SBAR = false; bf16_t* G;
  DEVI float operator()(int row, int col, const float (&v)[4]) const { st4bf(G + (size_t)row * 2048 + col, sigmoidf_(v[0]), sigmoidf_(v[1]), sigmoidf_(v[2]), sigmoidf_(v[3])); return 0.f; }
  DEVI void rss(int, int, float) const {} };
template <bool SECOND> struct EpiMerge { static constexpr bool RSS = false; static constexpr int SCALE_MODE = 0; static constexpr bool EPI_SBAR = false;   bf16_t* M; const bf16_t* G;
  DEVI float operator()(int row, int col, const float (&v)[4]) const { const u32x2 g = *(const u32x2*)(G + (size_t)row * 2048 + (SECOND ? 1024 : 0) + col);
    float o0 = lo2f(g[0]) * v[0], o1 = hi2f(g[0]) * v[1], o2 = lo2f(g[1]) * v[2], o3 = hi2f(g[1]) * v[3];
    bf16_t* ptr = M + (size_t)row * 1024 + col;
    if (SECOND) { const u32x2 m = *(const u32x2*)ptr; o0 += lo2f(m[0]); o1 += hi2f(m[0]); o2 += lo2f(m[1]); o3 += hi2f(m[1]); }
    st4bf(ptr, o0, o1, o2, o3); return 0.f; }
  DEVI void rss(int, int, float) const {} };
struct EpiO { static constexpr bool RSS = true; static constexpr int SCALE_MODE = 0; static constexpr bool EPI_SBAR = false; bf16_t* Y; float* rssy;
  DEVI float operator()(int row, int col, const float (&v)[4]) const { st4bf(Y + (size_t)row * 1024 + col, v[0], v[1], v[2], v[3]); return v[0] * v[0] + v[1] * v[1] + v[2] * v[2] + v[3] * v[3]; }
  DEVI void rss(int row, int col, float s) const { rssy[row * 32 + (col >> 5)] = s; } };
struct EpiPq { static constexpr bool RSS = false; static constexpr int SCALE_MODE = 0; static constexpr bool EPI_SBAR = false; bf16_t* QP;
  DEVI float operator()(int row, int col, const float (&v)[4]) const { st4bf(QP + (size_t)row * 2048 + col, v[0], v[1], v[2], v[3]); return 0.f; }
  DEVI void rss(int, int, float) const {} };

template <class F> DEVI void for_tiles_xcd(int MT, int NT, F f) {
  const int nb = gridDim.x;
  if ((nb & 7) == 0 && (MT & 7) == 0) { const int xcd = blockIdx.x & 7, slot = blockIdx.x >> 3, slots = nb >> 3, mper = MT >> 3, tot = mper * NT;
    for (int j = slot; j < tot; j += slots) f(xcd * mper + j / NT, j % NT); }
  else for (int i = blockIdx.x; i < MT * NT; i += nb) f(i / NT, i % NT);
}

DEVI void ph_inproj(const Params& p, char* smem) {
  char* ws = p.ws;
  EpiIn epi{(bf16_t*)(ws + O_RB), (bf16_t*)(ws + O_RC), (bf16_t*)(ws + O_CQ), (bf16_t*)(ws + O_CKV), (bf16_t*)(ws + O_KR), (float*)(ws + O_RSSV), (float*)(ws + O_RSSQ), (float*)(ws + O_RSSKV)};
  const bf16_t* HX = (const bf16_t*)(ws + O_RA); const bf16_t* W = (const bf16_t*)(ws + O_WIN);
  auto tile = [&](int mt, int nt) { gemm_tile<256, 256, false>(HX + (size_t)mt * 256 * 1024, 1024, W + (size_t)nt * 256 * 1024, 1024, 1024, mt * 256, nt * 256, epi, nullptr, smem); };
  for_tiles_xcd(64, 10, tile);
  for (int i = (int)gridDim.x - 1 - (int)blockIdx.x; i < 2; i += gridDim.x) tile(64 + i, 9);
}
DEVI void rope_kr_fp8(const Params& p) {
  const bf16_t* KR = (const bf16_t*)(p.ws + O_KR); const float* rope = (const float*)(p.ws + O_ROPE); unsigned char* K8 = (unsigned char*)(p.ws + O_K8);
  for (int i = blockIdx.x * NTHR + threadIdx.x; i < NROW * 2; i += gridDim.x * NTHR) {
    const int row = i >> 1, which = i & 1, kr = keyrow(row); int b, key; keyrow2(row, b, key);
    float x[32];
    const bf16_t* src = KR + (size_t)kr * 64 + which * 32;
#pragma unroll
    for (int q = 0; q < 4; ++q) unpack8(*(const u32x4*)(src + q * 8), x + q * 8);
    if (row < NTOK) { const int pos = row & 8191, pp = which ? (pos & 63) : (pos >> 6); const float* cs = rope + pp * 32;
#pragma unroll
      for (int j = 0; j < 16; ++j) { const float c = cs[j * 2], sn = cs[j * 2 + 1], x1 = x[j], x2 = x[16 + j]; x[j] = x1 * c - x2 * sn; x[16 + j] = x1 * sn + x2 * c; } }
    u32x4 o0, o1;
#pragma unroll
    for (int q = 0; q < 4; ++q) { o0[q] = (unsigned)pk4_fp8(x[q * 4], x[q * 4 + 1], x[q * 4 + 2], x[q * 4 + 3]); o1[q] = (unsigned)pk4_fp8(x[16 + q * 4], x[17 + q * 4], x[18 + q * 4], x[19 + q * 4]); }
#pragma unroll
    for (int h = 0; h < 8; ++h) { unsigned char* d = K8 + ((size_t)(b * 8 + h) * NKEY + key) * 192 + 128 + which * 32; *(u32x4*)d = o0; *(u32x4*)(d + 16) = o1; }
  }
}
DEVI void ph_mid(const Params& p, char* smem) {
  char* ws = p.ws;
  { EpiQ eq{(bf16_t*)(ws + O_RQ), (const float*)(ws + O_RSSQ)};
    EpiK8 ek{(unsigned char*)(ws + O_K8), (const float*)(ws + O_RSSKV)};
    EpiV8T ev{(unsigned char*)(ws + O_V8T), (const float*)(ws + O_RSSKV)};
    const bf16_t* CQ = (const bf16_t*)(ws + O_CQ); const bf16_t* WQ = (const bf16_t*)(ws + O_WUQ);
    const bf16_t* CKV = (const bf16_t*)(ws + O_CKV); const bf16_t* WKV = (const bf16_t*)(ws + O_WUKV);
    for (int i = blockIdx.x; i < 384 + 264 + 264; i += gridDim.x) {
      if (i < 384) { const int mt = i / 6, nt = i % 6;
        gemm_tile_8ph<false, 128, 128>(CQ + (size_t)mt * 256 * 256, 256, WQ + (size_t)nt * 256 * 256, 256, 256, mt * 256, nt * 256, eq, smem); }
      else if (i < 648) { const int j = i - 384, mt = j >> 2, nt = j & 3;
        gemm_tile_8ph<false, 128, 256>(CKV + (size_t)mt * 256 * 128, 128, WKV + (size_t)nt * 512 * 128, 128, 128, mt * 256, nt * 256, ek, smem); }
      else { const int j = i - 648, mt = j & 3, nt = j >> 2;
        gemm_tile_8ph<false, 256, 128>(WKV + (size_t)(mt * 512 + 128) * 128, 128, CKV + (size_t)nt * 256 * 128, 128, 128, mt * 256, nt * 256, ev, smem); } } }
  { const bf16_t* WS = (const bf16_t*)(ws + O_WS); const bf16_t* GVT = (const bf16_t*)(ws + O_RC);
    float* ksc = (float*)(smem + LDS_BYTES - 1024); const float* rssv = (const float*)(ws + O_RSSV);
    for (int i = blockIdx.x; i < 1024; i += gridDim.x) { const int chunk = i >> 3, g = i & 7;
      __syncthreads();
      if (threadIdx.x < 128) { const float* pr = rssv + (size_t)(chunk * 128 + threadIdx.x) * 32; float t = 0.f;
#pragma unroll
        for (int j = 0; j < 32; ++j) t += pr[j];
        ksc[threadIdx.x] = rsqrtf(t * (1.f / 1024.f) + EPS); }
      __syncthreads();
      EpiSgu epi{(bf16_t*)(ws + O_RB), p.g_sgu, p.b_s, chunk, g};
      gemm_tile<128, 128, false>(WS + (size_t)g * 16384, 128, GVT + ((size_t)chunk * 1024 + g * 128) * 128, 128, 128, 0, 0, epi, ksc, smem); } }
  rope_kr_fp8(p);
}
DEVI void ph_gates(const Params& p, char* smem) {
  char* ws = p.ws; EpiGate epi{(bf16_t*)(ws + O_RKV)};
  const bf16_t* HX = (const bf16_t*)(ws + O_RA); const bf16_t* W = (const bf16_t*)(ws + O_WIN) + (size_t)NPRE * 1024;
  for_tiles_xcd(64, 8, [&](int mt, int nt) { gemm_tile<256, 256, false>(HX + (size_t)mt * 256 * 1024, 1024, W + (size_t)nt * 256 * 1024, 1024, 1024, mt * 256, nt * 256, epi, nullptr, smem); });
}
DEVI void ph_merge(const Params& p, char* smem) {
  char* ws = p.ws; bf16_t* M = (bf16_t*)(ws + O_RC); const bf16_t* G = (const bf16_t*)(ws + O_RKV);
  EpiMerge<false> e1{M, G}; EpiMerge<true> e2{M, G};
  const bf16_t* OA = (const bf16_t*)(ws + O_RB); const bf16_t* OB = (const bf16_t*)(ws + O_RQ);
  const bf16_t* WA = (const bf16_t*)(ws + O_WPA); const bf16_t* WB = (const bf16_t*)(ws + O_WPB);
  for_tiles_xcd(64, 4, [&](int mt, int nt) { gemm_tile<256, 256, false>(OA + (size_t)mt * 256 * 1024, 1024, WA + (size_t)nt * 256 * 1024, 1024, 1024, mt * 256, nt * 256, e1, nullptr, smem); });
  for_tiles_xcd(64, 4, [&](int mt, int nt) { gemm_tile<256, 256, true>(OB + (size_t)mt * 256 * 1536, 1536, WB + (size_t)nt * 256 * 1024, 1024, 1024, mt * 256, nt * 256, e2, nullptr, smem); });
}
DEVI void ph_wo(const Params& p, char* smem) {
  char* ws = p.ws; EpiO epi{(bf16_t*)(ws + O_RA), (float*)(ws + O_RSSY)};
  const bf16_t* M = (const bf16_t*)(ws + O_RC); const bf16_t* W = (const bf16_t*)(ws + O_WO);
  for_tiles_xcd(64, 4, [&](int mt, int nt) { gemm_tile<256, 256, false>(M + (size_t)mt * 256 * 1024, 1024, W + (size_t)nt * 256 * 1024, 1024, 1024, mt * 256, nt * 256, epi, nullptr, smem); });
}
DEVI void ph_wpq(const Params& p, char* smem) {
  char* ws = p.ws; EpiPq epi{(bf16_t*)(ws + O_RKV)};
  const bf16_t* A = (const bf16_t*)(ws + O_RB); const bf16_t* W = (const bf16_t*)(ws + O_WPQ);
  for_tiles_xcd(64, 8, [&](int mt, int nt) { gemm_tile<256, 256, false>(A + (size_t)mt * 256 * 1024, 1024, W + (size_t)nt * 256 * 1024, 1024, 1024, mt * 256, nt * 256, epi, nullptr, smem); });
  convert_table_fp6(p.v_exp, (unsigned char*)(ws + O_RA), (float*)(ws + O_RA + (size_t)16384 * 1024));
}

namespace a8 {
constexpr int KVBLK = 64, SHM_K = KVBLK * 192, SHM_V = 128 * KVBLK;
constexpr int SHM_K2 = 2 * SHM_K, SHM_V2 = 2 * SHM_V;
constexpr float SCALE = 0.07216878364870322f, THR = 1.5f;
using i32x8 = __attribute__((ext_vector_type(8))) int;
DEVI int crow(int r, int hi) { return (r & 3) + 8 * (r >> 2) + 4 * hi; }
DEVI f32x16 mma(const i32x8& a, const i32x8& b, const f32x16& c) { return __builtin_amdgcn_mfma_scale_f32_32x32x64_f8f6f4(a, b, c, 0, 0, 0, 0x7f7f7f7f, 0, 0x7f7f7f7f); }
DEVI void partialSM(f32x16& p0, f32x16& p1, float& m_reg, float& mn, float& alpha) {
  constexpr float C = SCALE * 1.4426950408889634f;
  float pmax = p0[0];
#pragma unroll
  for (int r = 1; r < 16; ++r) pmax = fmaxf(pmax, p0[r]);
#pragma unroll
  for (int r = 0; r < 16; ++r) pmax = fmaxf(pmax, p1[r]);
  { auto rr = __builtin_amdgcn_permlane32_swap(__float_as_uint(pmax), __float_as_uint(pmax), false, false);
    pmax = fmaxf(__uint_as_float(rr[0]), __uint_as_float(rr[1])); }
  if (__builtin_expect(__all(pmax - m_reg <= THR / SCALE), 1)) { mn = m_reg; alpha = 1.f; }
  else { mn = fmaxf(m_reg, pmax); alpha = __builtin_amdgcn_exp2f((m_reg - mn) * C); m_reg = mn; }
  const float mnC = 6.f - mn * C;
#pragma unroll
  for (int r = 0; r < 16; ++r) p0[r] = fmaf(p0[r], C, mnC);
#pragma unroll
  for (int r = 0; r < 16; ++r) p1[r] = fmaf(p1[r], C, mnC);
#pragma unroll
  for (int r = 0; r < 16; ++r) p0[r] = __builtin_amdgcn_exp2f(p0[r]);
}
DEVI void finishSM(f32x16& p0, f32x16& p1, float alpha, float& l_reg, i32x8& pa) {
#pragma unroll
  for (int r = 0; r < 16; ++r) p1[r] = __builtin_amdgcn_exp2f(p1[r]);
  float ps = 0;
#pragma unroll
  for (int r = 0; r < 16; ++r) ps += p0[r];
#pragma unroll
  for (int r = 0; r < 16; ++r) ps += p1[r];
  { auto rr = __builtin_amdgcn_permlane32_swap(__float_as_uint(ps), __float_as_uint(ps), false, false);
    ps = __uint_as_float(rr[0]) + __uint_as_float(rr[1]); }
  l_reg = l_reg * alpha + ps;
#pragma unroll
  for (int j = 0; j < 4; ++j) { pa[j] = pk4_fp8(p0[4 * j], p0[4 * j + 1], p0[4 * j + 2], p0[4 * j + 3]); pa[4 + j] = pk4_fp8(p1[4 * j], p1[4 * j + 1], p1[4 * j + 2], p1[4 * j + 3]); }
}
DEVI i32x8 ld32(const char* p0, const char* p1) { const u32x4 a = *(const u32x4*)p0, b = *(const u32x4*)p1; return (i32x8){(int)a[0], (int)a[1], (int)a[2], (int)a[3], (int)b[0], (int)b[1], (int)b[2], (int)b[3]}; }
DEVI void qkt(f32x16& p0, f32x16& p1, const char* Ks, const i32x8* qf, int r32, int hi) {
  p0 = f32x16{}; p1 = f32x16{};
  const int sw = (r32 >> 2) & 3; const char* k0 = Ks + r32 * 192; const char* k1 = k0 + 32 * 192;
#pragma unroll
  for (int m = 0; m < 3; ++m) { const int c0 = ((4 * m + 2 * hi) ^ sw) << 4, c1 = ((4 * m + 2 * hi + 1) ^ sw) << 4;
    p0 = mma(ld32(k0 + c0, k0 + c1), qf[m], p0);
    p1 = mma(ld32(k1 + c0, k1 + c1), qf[m], p1); }
}
DEVI void pv(f32x16* o, const char* Vs, int tile, const i32x8& pa, int r32, int hi) {
  const int sw = (r32 >> 1) & 7, c0 = ((4 * tile + 2 * hi) ^ sw) << 4, c1 = ((4 * tile + 2 * hi + 1) ^ sw) << 4;
#pragma unroll
  for (int db = 0; db < 4; ++db) { const char* vr = Vs + (32 * db + r32) * 128; o[db] = mma(pa, ld32(vr + c0, vr + c1), o[db]); }
}
DEVI void attn_item(bf16_t* __restrict__ Qb, const unsigned char* __restrict__ Kg, const unsigned char* __restrict__ Vg, const float* __restrict__ rope, int pos0, char* lds) {
  const int tid = threadIdx.x, wid = tid >> 6, lane = tid & 63, r32 = lane & 31, hi = lane >> 5;
  char* V_lds = lds; char* K_lds = lds + 3 * SHM_V2;
  float* wsl = (float*)(lds + 3 * SHM_V2 + 3 * SHM_K2) + wid * 64; float* li_l = wsl; float* al_l = wsl + 32;
  float m_reg = -1e30f, l_reg = 0; f32x16 o[4] = {}; i32x8 qf[3];
  { const bf16_t* Qw = Qb + (size_t)(wid * 32 + r32) * 1536 + hi * 32;
#pragma unroll
    for (int m = 0; m < 3; ++m) { float x[32];
#pragma unroll
      for (int q = 0; q < 4; ++q) unpack8(*(const u32x4*)(Qw + m * 64 + q * 8), x + q * 8);
      if (m == 2) { const int pos = pos0 + wid * 32 + r32, pp = hi ? (pos & 63) : (pos >> 6); const float* cs = rope + pp * 32;
#pragma unroll
        for (int j = 0; j < 16; ++j) { const float c = cs[j * 2], sn = cs[j * 2 + 1], x1 = x[j], x2 = x[16 + j]; x[j] = x1 * c - x2 * sn; x[16 + j] = x1 * sn + x2 * c; } }
#pragma unroll
      for (int q = 0; q < 8; ++q) qf[m][q] = pk4_fp8(x[q * 4], x[q * 4 + 1], x[q * 4 + 2], x[q * 4 + 3]);
      __builtin_amdgcn_sched_barrier(0); } }
  unsigned koff[3], voff[2];
#pragma unroll
  for (int i = 0; i < 3; ++i) { const int pp = wid * 64 + lane + 512 * i, key = pp / 12, c = pp - key * 12; koff[i] = (unsigned)(key * 192 + ((c ^ ((key >> 2) & 3)) << 4)); }
#pragma unroll
  for (int i = 0; i < 2; ++i) { const int pp = wid * 64 + lane + 512 * i, d = pp >> 3, c = pp & 7; voff[i] = (unsigned)(d * NKEY + ((c ^ ((d >> 1) & 7)) << 4)); }
#define GSTAGE(s_, kb, vb) do { const unsigned char* ks = Kg + (size_t)(s_) * SHM_K2; const unsigned char* vs = Vg + (s_) * 128; \
    _Pragma("unroll") for (int i = 0; i < 3; ++i) __builtin_amdgcn_global_load_lds((const unsigned*)(ks + koff[i]), (unsigned*)(K_lds + (kb) + i * 8192 + wid * 1024), 16, 0, 0); \
    _Pragma("unroll") for (int i = 0; i < 2; ++i) __builtin_amdgcn_global_load_lds((const unsigned*)(vs + voff[i]), (unsigned*)(V_lds + (vb) + i * 8192 + wid * 1024), 16, 0, 0); } while (0)
#define SWAIT() asm volatile("s_waitcnt vmcnt(0)" ::: "memory")
#define SBAR() __builtin_amdgcn_sched_barrier(0)
#define RESC(a) do { if (__any((a) < 1.f)) { if (hi == 0) al_l[r32] = (a); asm volatile("s_waitcnt lgkmcnt(0)" ::: "memory"); \
    _Pragma("unroll") for (int d = 0; d < 4; ++d) _Pragma("unroll") for (int r = 0; r < 16; ++r) o[d][r] *= al_l[crow(r, hi)]; } } while (0)
  f32x16 pA0, pA1, pB0, pB1; float mnA, mnB, alA, alB; i32x8 pa; constexpr int NS = NKEY / 128;
  int kp = 0, kc = SHM_K2, kn = 2 * SHM_K2, vp = 0, vc = SHM_V2, vn = 2 * SHM_V2;
  GSTAGE(0, kp, vp); GSTAGE(1, kc, vc); SWAIT(); __syncthreads();
  qkt(pA0, pA1, K_lds + kp, qf, r32, hi); partialSM(pA0, pA1, m_reg, mnA, alA);
  SBAR(); qkt(pB0, pB1, K_lds + kp + SHM_K, qf, r32, hi);
  finishSM(pA0, pA1, alA, l_reg, pa); SBAR();
  pv(o, V_lds + vp, 0, pa, r32, hi); partialSM(pB0, pB1, m_reg, mnB, alB);
  RESC(alB);
  for (int s_ = 1; s_ < NS; ++s_) {
    if (s_ + 1 < NS) GSTAGE(s_ + 1, kn, vn);
    SBAR(); qkt(pA0, pA1, K_lds + kc, qf, r32, hi);
    finishSM(pB0, pB1, alB, l_reg, pa); SBAR();
    pv(o, V_lds + vp, 1, pa, r32, hi); partialSM(pA0, pA1, m_reg, mnA, alA);
    RESC(alA);
    SBAR(); qkt(pB0, pB1, K_lds + kc + SHM_K, qf, r32, hi);
    finishSM(pA0, pA1, alA, l_reg, pa); SBAR();
    pv(o, V_lds + vc, 0, pa, r32, hi); partialSM(pB0, pB1, m_reg, mnB, alB);
    SWAIT(); __syncthreads();
    RESC(alB);
    { const int tk = kp; kp = kc; kc = kn; kn = tk; const int tv = vp; vp = vc; vc = vn; vn = tv; }
  }
  finishSM(pB0, pB1, alB, l_reg, pa); SBAR();
  pv(o, V_lds + vp, 1, pa, r32, hi);
  if (hi == 0) li_l[r32] = l_reg; asm volatile("s_waitcnt lgkmcnt(0)" ::: "memory");
  float rli[16];
#pragma unroll
  for (int r = 0; r < 16; ++r) rli[r] = __builtin_amdgcn_rcpf(li_l[crow(r, hi)]);
  bf16_t* Ow = Qb + (size_t)(wid * 32) * 1536;
#pragma unroll
  for (int r = 0; r < 16; ++r) { const int orow = crow(r, hi);
#pragma unroll
    for (int d0 = 0; d0 < 4; ++d0) Ow[(size_t)orow * 1536 + d0 * 32 + r32] = f2bf(o[d0][r] * rli[r]); }
  __syncthreads();
#undef GSTAGE
#undef SWAIT
#undef SBAR
#undef RESC
}
}
DEVI void attn_fp8(const Params& p, char* smem) {
  bf16_t* Q = (bf16_t*)(p.ws + O_RQ); const unsigned char* K8 = (const unsigned char*)(p.ws + O_K8); const unsigned char* V8 = (const unsigned char*)(p.ws + O_V8T);
  const float* rope = (const float*)(p.ws + O_ROPE);
  for (int it = blockIdx.x; it < NB * 8 * (SEQ / 256); it += gridDim.x) {
    const int bh = (it >> 8) * 8 + (it & 7), qb = (it & 255) >> 3, b = bh >> 3, h = bh & 7;
    a8::attn_item(Q + (size_t)(b * SEQ + qb * 256) * 1536 + h * 192, K8 + (size_t)bh * NKEY * 192, V8 + (size_t)bh * 128 * NKEY, rope, qb * 256, smem);
  }
}
DEVI void ph_attn(const Params& p, char* smem) { attn_fp8(p, smem); }

DEVI void ph_rows(const Params& p, char* smem) {
  const int tid = threadIdx.x, wave = tid >> 6, lane = tid & 63;
  const float* MOD = (const float*)(p.ws + O_MOD); const bf16_t* Y = (const bf16_t*)(p.ws + O_RA); const float* rssy = (const float*)(p.ws + O_RSSY);
  bf16_t* HX2 = (bf16_t*)(p.ws + O_RB);
  for (int row = blockIdx.x * NWAVE + wave; row < NTOK; row += gridDim.x * NWAVE) {
    const int b = row >> 13; const float* md = MOD + b * 6144;
    float ty = 0.f; { const float* pr = rssy + (size_t)row * 32;
#pragma unroll
      for (int j = 0; j < 32; ++j) ty += pr[j]; }
    const float ry = rsqrtf(ty * (1.f / 1024.f) + EPS);
    float x1[16]; float ss = 0.f;
#pragma unroll
    for (int i = 0; i < 4; ++i) { const int c = i * 256 + lane * 4; const float4 xv = *(const float4*)(p.x + (size_t)row * 1024 + c); const u32x2 yv = *(const u32x2*)(Y + (size_t)row * 1024 + c);
      const float4 gp = *(const float4*)(p.g_post1 + c), gt = *(const float4*)(md + 2048 + c);
      x1[i * 4 + 0] = xv.x + gt.x * (lo2f(yv[0]) * ry * gp.x); x1[i * 4 + 1] = xv.y + gt.y * (hi2f(yv[0]) * ry * gp.y);
      x1[i * 4 + 2] = xv.z + gt.z * (lo2f(yv[1]) * ry * gp.z); x1[i * 4 + 3] = xv.w + gt.w * (hi2f(yv[1]) * ry * gp.w);
#pragma unroll
      for (int j = 0; j < 4; ++j) ss += x1[i * 4 + j] * x1[i * 4 + j];
      *(float4*)(p.out + (size_t)row * 1024 + c) = make_float4(x1[i * 4], x1[i * 4 + 1], x1[i * 4 + 2], x1[i * 4 + 3]); }
    ss = wave_sum(ss); const float r2 = rsqrtf(ss * (1.f / 1024.f) + EPS);
#pragma unroll
    for (int i = 0; i < 4; ++i) { const int c = i * 256 + lane * 4; const float4 g2 = *(const float4*)(p.g_pre2 + c), sc = *(const float4*)(md + 4096 + c), sh = *(const float4*)(md + 3072 + c);
      st4bf(HX2 + (size_t)row * 1024 + c, x1[i * 4] * r2 * g2.x * (1.f + sc.x) + sh.x, x1[i * 4 + 1] * r2 * g2.y * (1.f + sc.y) + sh.y,
            x1[i * 4 + 2] * r2 * g2.z * (1.f + sc.z) + sh.z, x1[i * 4 + 3] * r2 * g2.w * (1.f + sc.w) + sh.w); }
  }
  convert_table_fp6(p.u_exp, (unsigned char*)(p.ws + O_RC), (float*)(p.ws + O_RC + (size_t)16384 * 1024));
}

namespace tk {
DEVI int f2sort(float f) { const int i = __float_as_int(f); return i ^ ((i >> 31) & 0x7fffffff); }
DEVI float sort2f(int s) { return __int_as_float(s ^ ((s >> 31) & 0x7fffffff)); }
DEVI void ce_desc(int& a, int& b) { const int hi = max(a, b), lo = min(a, b); a = hi; b = lo; }
DEVI void sort16_desc(int* a) {
#pragma unroll
  for (int lk = 1; lk <= 4; ++lk)
#pragma unroll
    for (int lj = lk - 1; lj >= 0; --lj)
#pragma unroll
      for (int i = 0; i < 16; ++i) { const int j = 1 << lj, k = 1 << lk, l = i ^ j;
        if (l > i) { const int hi = max(a[i], a[l]), lo = min(a[i], a[l]); if ((i & k) == 0) { a[i] = hi; a[l] = lo; } else { a[i] = lo; a[l] = hi; } } }
}
DEVI void bitonic_merge16_desc(int* a) {
#pragma unroll
  for (int lj = 3; lj >= 0; --lj)
#pragma unroll
    for (int i = 0; i < 16; ++i) { const int l = i ^ (1 << lj); if (l > i) ce_desc(a[i], a[l]); }
}
DEVI void merge_top16(int* a, const int* b) {
#pragma unroll
  for (int i = 0; i < 16; ++i) a[i] = max(a[i], b[15 - i]);
  bitonic_merge16_desc(a);
}
DEVI void half_top16(const bf16_t* __restrict__ qrow, const char* Kl, int r32, int hi, int* out) {
  bf16x8 qf[8];
#pragma unroll
  for (int d0 = 0; d0 < 8; ++d0) qf[d0] = *reinterpret_cast<const bf16x8*>(qrow + d0 * 16 + hi * 8);
  int a[64]; const int hi4 = 4 * hi;
#pragma unroll
  for (int kt = 0; kt < 4; ++kt) { f32x16 acc = {};
    const int key = kt * 32 + r32;
#pragma unroll
    for (int d0 = 0; d0 < 8; ++d0) { const bf16x8 kf = *reinterpret_cast<const bf16x8*>(Kl + key * 256 + (((d0 * 2 + hi) ^ (key & 15)) << 4));
      acc = __builtin_amdgcn_mfma_f32_32x32x16_bf16(kf, qf[d0], acc, 0, 0, 0); }
#pragma unroll
    for (int r = 0; r < 16; ++r) { const int kc = kt * 32 + (r & 3) + 8 * (r >> 2); a[kt * 16 + r] = ((f2sort(acc[r]) & ~127) | (127 - kc)) - hi4; } }
  sort16_desc(a); sort16_desc(a + 16); sort16_desc(a + 32); sort16_desc(a + 48);
  merge_top16(a, a + 16); merge_top16(a + 32, a + 48); merge_top16(a, a + 32);
  int L[16], H[16];
#pragma unroll
  for (int i = 0; i < 16; ++i) { auto rr = __builtin_amdgcn_permlane32_swap((unsigned)a[i], (unsigned)a[i], false, false); L[i] = (int)rr[0]; H[i] = (int)rr[1]; }
  merge_top16(L, H);
#pragma unroll
  for (int i = 0; i < 16; ++i) out[i] = L[i];
}
}
DEVI void peer_pass1_tokens4(const Params& p, int t0, const int* idxw, float* gww);
DEVI void topk_fast(const Params& p, char* smem) {
  const int tid = threadIdx.x, wave = __builtin_amdgcn_readfirstlane(tid >> 6), lane = tid & 63, r32 = lane & 31, hi = lane >> 5;
  const bf16_t* QP = (const bf16_t*)(p.ws + O_RKV);
  char* K1l = smem; char* K2l = smem + 32768; int* tab = (int*)(smem + 65536) + wave * (32 * 33);
  int* idxl = (int*)(smem + 65536 + 8 * 32 * 33 * 4) + wave * 512; float* gwl = (float*)(smem + 65536 + 8 * 32 * 33 * 4 + 8 * 2048) + wave * 512;
  __syncthreads();
  { const bf16_t* K1 = (const bf16_t*)(p.ws + O_K1);
    for (int id = tid; id < 4096; id += NTHR) { const int key = id >> 4, c = id & 15; const u32x4 v = *(const u32x4*)(K1 + (size_t)key * 128 + c * 8);
      *(u32x4*)(smem + key * 256 + ((c ^ (key & 15)) << 4)) = v; } }
  __syncthreads();
  for (int item = blockIdx.x; item < NTOK * 8 / 256; item += gridDim.x) {
    int tid_ = threadIdx.x; asm volatile("" : "+v"(tid_));
    const int lane = tid_ & 63, r32 = lane & 31, hi = lane >> 5;
    const int row = item * 256 + wave * 32 + r32;
    const bf16_t* qrow = QP + (size_t)row * 256;
    int t1[16], t2[16];
    tk::half_top16(qrow, K1l, r32, hi, t1);
    __builtin_amdgcn_sched_barrier(0);
    tk::half_top16(qrow + 128, K2l, r32, hi, t2);
    __builtin_amdgcn_sched_barrier(0);
    float v1[16], v2[16];
#pragma unroll
    for (int i = 0; i < 16; ++i) { v1[i] = tk::sort2f(t1[i] & ~127); v2[i] = tk::sort2f(t2[i] & ~127); }
    if (hi == 0) {
#pragma unroll
      for (int i = 0; i < 16; ++i) { tab[r32 * 33 + i] = 127 - (t1[i] & 127); tab[r32 * 33 + 16 + i] = 127 - (t2[i] & 127); } }
#define CAND(i, j) ((tk::f2sort(v1[i] + v2[j]) & ~255) | (255 - ((i) * 16 + (j))))
    int g0[16], g1[16], g2[16];
#pragma unroll
    for (int j = 0; j < 16; ++j) g0[j] = CAND(0, j);
#pragma unroll
    for (int j = 0; j < 8; ++j) g1[j] = CAND(1, j);
#pragma unroll
    for (int j = 0; j < 5; ++j) g1[8 + j] = CAND(2, j);
#pragma unroll
    for (int j = 0; j < 3; ++j) g1[13 + j] = CAND(4, j);
#pragma unroll
    for (int j = 0; j < 4; ++j) g2[j] = CAND(3, j);
    g2[4] = CAND(5, 0); g2[5] = CAND(5, 1); g2[6] = CAND(6, 0); g2[7] = CAND(6, 1); g2[8] = CAND(7, 0); g2[9] = CAND(7, 1);
    g2[10] = CAND(8, 0); g2[11] = CAND(9, 0); g2[12] = CAND(10, 0); g2[13] = CAND(11, 0); g2[14] = CAND(12, 0); g2[15] = CAND(13, 0);
    tk::sort16_desc(g1); tk::sort16_desc(g2);
    tk::merge_top16(g0, g1); tk::merge_top16(g0, g2);
    { int x = CAND(14, 0);
#pragma unroll
      for (int i = 0; i < 16; ++i) { const int h = max(g0[i], x); x = min(g0[i], x); g0[i] = h; }
      x = CAND(15, 0);
#pragma unroll
      for (int i = 0; i < 16; ++i) { const int h = max(g0[i], x); x = min(g0[i], x); g0[i] = h; } }
#undef CAND
    asm volatile("s_waitcnt lgkmcnt(0)" ::: "memory");
    if (hi == 0) {
      int ex[16];
#pragma unroll
      for (int k = 0; k < 16; ++k) { const int pos = 255 - (g0[k] & 255); ex[k] = tab[r32 * 33 + (pos >> 4)] * 128 + tab[r32 * 33 + 16 + (pos & 15)]; }
      int* dst = idxl + r32 * 16;
#pragma unroll
      for (int q = 0; q < 4; ++q) *(int4*)(dst + q * 4) = make_int4(ex[q * 4], ex[q * 4 + 1], ex[q * 4 + 2], ex[q * 4 + 3]);
    } else {
      float e[16]; const float vmax = tk::sort2f(g0[0] & ~255); float sum = 0.f;
#pragma unroll
      for (int k = 0; k < 16; ++k) { e[k] = __expf(tk::sort2f(g0[k] & ~255) - vmax); sum += e[k]; }
      const float inv = 1.f / sum; float* dst = gwl + r32 * 16;
#pragma unroll
      for (int q = 0; q < 4; ++q) *(float4*)(dst + q * 4) = make_float4(e[q * 4] * inv, e[q * 4 + 1] * inv, e[q * 4 + 2] * inv, e[q * 4 + 3] * inv);
    }
    asm volatile("s_waitcnt lgkmcnt(0)" ::: "memory"); __builtin_amdgcn_sched_barrier(0);
    peer_pass1_tokens4(p, item * 32 + wave * 4, idxl, gwl);
    asm volatile("s_waitcnt lgkmcnt(0)" ::: "memory"); __builtin_amdgcn_sched_barrier(0);
  }
}
DEVI void ph_topk(const Params& p, char* smem) { topk_fast(p, smem); }

using f32x2 = __attribute__((ext_vector_type(2))) float;
#define DPPF(x, ctrl) __builtin_bit_cast(float, __builtin_amdgcn_update_dpp(0, __builtin_bit_cast(int, (x)), ctrl, 0xf, 0xf, true))
DEVI float reduce_t32(const float (&D)[32], int lane) {
  float S[16];
#pragma unroll
  for (int i = 0; i < 16; ++i) { auto rr = __builtin_amdgcn_permlane16_swap(__float_as_uint(D[i]), __float_as_uint(D[i + 16]), false, false); S[i] = __uint_as_float(rr[0]) + __uint_as_float(rr[1]); }
  const bool b3 = lane & 8, b2 = lane & 4, b1 = lane & 2, b0 = lane & 1;
  float T[8], U[4], V[2];
#pragma unroll
  for (int i = 0; i < 8; ++i) { const float keep = b3 ? S[i + 8] : S[i], send = b3 ? S[i] : S[i + 8]; T[i] = keep + DPPF(send, 0x128); }
#pragma unroll
  for (int i = 0; i < 4; ++i) { const float keep = b2 ? T[i + 4] : T[i], send = b2 ? T[i] : T[i + 4]; U[i] = keep + DPPF(send, 0x141); }
#pragma unroll
  for (int i = 0; i < 2; ++i) { const float keep = b1 ? U[i + 2] : U[i], send = b1 ? U[i] : U[i + 2]; V[i] = keep + DPPF(send, 0x4E); }
  const float keep = b0 ? V[1] : V[0], send = b0 ? V[0] : V[1];
  return keep + DPPF(send, 0xB1);
}
DEVI void gload8(u32x6 (&B)[8], const unsigned char* tab, const int* ids, int g24) {
  const int4 i0 = *(const int4*)ids, i1 = *(const int4*)(ids + 4);
  const int id[8] = {i0.x, i0.y, i0.z, i0.w, i1.x, i1.y, i1.z, i1.w};
#pragma unroll
  for (int j = 0; j < 8; ++j) { const unsigned char* rp = tab + (unsigned)(id[j] * 768 + g24);
    const u32x4 a = *(const u32x4_u*)rp; const u32x2 c = *(const u32x2_u*)(rp + 16); B[j] = (u32x6){a[0], a[1], a[2], a[3], c[0], c[1]}; }
  asm volatile("" ::: "memory"); __builtin_amdgcn_sched_barrier(0);
}
template <int O>
DEVI void gdot8(const u32x6 (&B)[8], const f32x2 (&xp2)[16], float (&D)[32]) {
#pragma unroll
  for (int j = 0; j < 8; ++j) { const f32x32 uf = __builtin_amdgcn_cvt_scalef32_pk32_f32_fp6(B[j], 1.0f); f32x2 da = {0.f, 0.f}, db = {0.f, 0.f};
#pragma unroll
    for (int k = 0; k < 16; k += 2) { da += xp2[k] * (f32x2){uf[2 * k], uf[2 * k + 1]}; db += xp2[k + 1] * (f32x2){uf[2 * k + 2], uf[2 * k + 3]}; }
    da += db; D[O + j] = da[0] + da[1]; asm volatile("" : "+v"(D[O + j]) :: "memory"); __builtin_amdgcn_sched_barrier(0); }
}
DEVI void gaxpy8(const u32x6 (&B)[8], const float* cs, f32x2 (&acc2)[16]) {
  const float4 c0 = *(const float4*)cs, c1 = *(const float4*)(cs + 4);
  const float c[8] = {c0.x, c0.y, c0.z, c0.w, c1.x, c1.y, c1.z, c1.w};
#pragma unroll
  for (int j = 0; j < 8; ++j) { const f32x32 vf = __builtin_amdgcn_cvt_scalef32_pk32_f32_fp6(B[j], 1.0f); const f32x2 cj = {c[j], c[j]};
#pragma unroll
    for (int k = 0; k < 16; ++k) acc2[k] += cj * (f32x2){vf[2 * k], vf[2 * k + 1]};
    asm volatile("" : "+v"(acc2[0]), "+v"(acc2[1]), "+v"(acc2[2]), "+v"(acc2[3]), "+v"(acc2[4]), "+v"(acc2[5]), "+v"(acc2[6]), "+v"(acc2[7]) :: "memory");
    asm volatile("" : "+v"(acc2[8]), "+v"(acc2[9]), "+v"(acc2[10]), "+v"(acc2[11]), "+v"(acc2[12]), "+v"(acc2[13]), "+v"(acc2[14]), "+v"(acc2[15]) :: "memory");
    __builtin_amdgcn_sched_barrier(0); }
}
DEVI void peer_pass1_tokens4(const Params& p, int t0, const int* idxw, float* gww) {
  int lane = threadIdx.x & 63; asm volatile("" : "+v"(lane));
  const int h = lane >> 5, g = lane & 31, g24 = g * 24;
  const bf16_t* HX2 = (const bf16_t*)(p.ws + O_RB);
  const unsigned char* UT = (const unsigned char*)(p.ws + O_RC); const float* SU = (const float*)(p.ws + O_RC + (size_t)16384 * 1024);
  const float* SV = (const float*)(p.ws + O_RA + (size_t)16384 * 1024);
  int* IDG = (int*)(p.ws + O_RQ); float* CG = (float*)(p.ws + O_RQ + (size_t)NTOK * 128 * 4);
  u32x6 B0[8], B1[8]; u32x2 xr[8];
  gload8(B0, UT, idxw + h * 32, g24);
#pragma unroll
  for (int j = 0; j < 8; ++j) xr[j] = *(const u32x2*)(HX2 + (size_t)t0 * 1024 + 128 * j + 4 * g);
#pragma unroll 1
  for (int tl = 0; tl < 4; ++tl) {
    const int t = t0 + tl; const int* idx = idxw + tl * 128; float* gw = gww + tl * 128; const int* idh = idx + h * 32;
    f32x2 xp2[16];
#pragma unroll
    for (int j = 0; j < 8; ++j) { xp2[2 * j] = (f32x2){lo2f(xr[j][0]), hi2f(xr[j][0])}; xp2[2 * j + 1] = (f32x2){lo2f(xr[j][1]), hi2f(xr[j][1])}; }
    const int my_i0 = idx[lane], my_i1 = idx[64 + lane];
    const float su0 = SU[my_i0], sv0 = SV[my_i0], su1 = SU[my_i1], sv1 = SV[my_i1];
    IDG[(size_t)t * 128 + lane] = my_i0; IDG[(size_t)t * 128 + 64 + lane] = my_i1;
    float D[32];
    gload8(B1, UT, idh + 8, g24);  gdot8<0>(B0, xp2, D);
    gload8(B0, UT, idh + 16, g24); gdot8<8>(B1, xp2, D);
    gload8(B1, UT, idh + 24, g24); gdot8<16>(B0, xp2, D);
    gload8(B0, UT, idh + 64, g24); gdot8<24>(B1, xp2, D);
    { const float val = reduce_t32(D, lane); CG[(size_t)t * 128 + lane] = gw[lane] * gelu_t(val * su0) * sv0; }
    asm volatile("" ::: "memory"); __builtin_amdgcn_sched_barrier(0);
    gload8(B1, UT, idh + 72, g24); gdot8<0>(B0, xp2, D);
    gload8(B0, UT, idh + 80, g24); gdot8<8>(B1, xp2, D);
    gload8(B1, UT, idh + 88, g24); gdot8<16>(B0, xp2, D);
    if (tl < 3) { gload8(B0, UT, idh + 128, g24);
#pragma unroll
      for (int j = 0; j < 8; ++j) xr[j] = *(const u32x2*)(HX2 + (size_t)(t + 1) * 1024 + 128 * j + 4 * g); }
    gdot8<24>(B1, xp2, D);
    { const float val = reduce_t32(D, lane); CG[(size_t)t * 128 + 64 + lane] = gw[64 + lane] * gelu_t(val * su1) * sv1; }
    asm volatile("s_waitcnt lgkmcnt(0)" ::: "memory"); __builtin_amdgcn_sched_barrier(0);
  }
}
DEVI void ph_peer2(const Params& p, char* smem) {
  const int wave = __builtin_amdgcn_readfirstlane(threadIdx.x >> 6);
  int* idxw = (int*)(smem + 65536 + 8 * 32 * 33 * 4) + wave * 512; float* gww = (float*)(smem + 65536 + 8 * 32 * 33 * 4 + 8 * 2048) + wave * 512;
  const unsigned char* VT = (const unsigned char*)(p.ws + O_RA);
  const float* MOD = (const float*)(p.ws + O_MOD);
  const int* IDG = (const int*)(p.ws + O_RQ); const float* CG = (const float*)(p.ws + O_RQ + (size_t)NTOK * 128 * 4);
  for (int item = blockIdx.x; item < NTOK * 8 / 256; item += gridDim.x) {
    int lane = threadIdx.x & 63; asm volatile("" : "+v"(lane));
    const int h = lane >> 5, g = lane & 31, g24 = g * 24;
    const int t0 = item * 32 + wave * 4;
#pragma unroll
    for (int q = 0; q < 2; ++q) { *(int4*)(idxw + q * 256 + lane * 4) = *(const int4*)(IDG + (size_t)t0 * 128 + q * 256 + lane * 4);
      *(float4*)(gww + q * 256 + lane * 4) = *(const float4*)(CG + (size_t)t0 * 128 + q * 256 + lane * 4); }
    asm volatile("s_waitcnt vmcnt(0) lgkmcnt(0)" ::: "memory"); __builtin_amdgcn_sched_barrier(0);
    u32x6 B0[8], B1[8];
    gload8(B0, VT, idxw + h * 32, g24);
#pragma unroll 1
    for (int tl = 0; tl < 4; ++tl) {
      const int t = t0 + tl; const int* idh = idxw + tl * 128 + h * 32; const float* cw = gww + tl * 128 + h * 32;
      f32x2 acc2[16];
#pragma unroll
      for (int i = 0; i < 16; ++i) acc2[i] = (f32x2){0.f, 0.f};
      const int b = t >> 13, c0 = 512 * h + 4 * g;
      float* op = p.out + (size_t)t * 1024 + c0;
      float4 xv[4];
#pragma unroll
      for (int q4 = 0; q4 < 4; ++q4) xv[q4] = *(const float4*)(op + q4 * 128);
      asm volatile("" ::: "memory"); __builtin_amdgcn_sched_barrier(0);
      gload8(B1, VT, idh + 8, g24);  gaxpy8(B0, cw, acc2);
      gload8(B0, VT, idh + 16, g24); gaxpy8(B1, cw + 8, acc2);
      gload8(B1, VT, idh + 24, g24); gaxpy8(B0, cw + 16, acc2);
      gload8(B0, VT, idh + 64, g24); gaxpy8(B1, cw + 24, acc2);
      gload8(B1, VT, idh + 72, g24); gaxpy8(B0, cw + 64, acc2);
      gload8(B0, VT, idh + 80, g24); gaxpy8(B1, cw + 72, acc2);
      gload8(B1, VT, idh + 88, g24); gaxpy8(B0, cw + 80, acc2);
      if (tl < 3) gload8(B0, VT, idh + 128, g24);
      gaxpy8(B1, cw + 88, acc2);
      float o[16]; float ss = 0.f;
#pragma unroll
      for (int i = 0; i < 16; ++i) { const float lo = i & 1 ? acc2[i >> 1][1] : acc2[i >> 1][0], hi = i & 1 ? acc2[8 + (i >> 1)][1] : acc2[8 + (i >> 1)][0];
        auto rr = __builtin_amdgcn_permlane32_swap(__float_as_uint(lo), __float_as_uint(hi), false, false); o[i] = __uint_as_float(rr[0]) + __uint_as_float(rr[1]); ss += o[i] * o[i]; }
      ss = wave_sum(ss); const float rstd = rsqrtf(ss * (1.f / 1024.f) + EPS);
      const float* gt2 = MOD + b * 6144 + 5120 + c0;
#pragma unroll
      for (int q4 = 0; q4 < 4; ++q4) { float4 x4 = xv[q4]; const float4 gt = *(const float4*)(gt2 + q4 * 128), gp = *(const float4*)(p.g_post2 + c0 + q4 * 128);
        x4.x += gt.x * (o[q4 * 4 + 0] * rstd * gp.x); x4.y += gt.y * (o[q4 * 4 + 1] * rstd * gp.y);
        x4.z += gt.z * (o[q4 * 4 + 2] * rstd * gp.z); x4.w += gt.w * (o[q4 * 4 + 3] * rstd * gp.w);
        *(float4*)(op + q4 * 128) = x4; }
      asm volatile("s_waitcnt lgkmcnt(0)" ::: "memory"); __builtin_amdgcn_sched_barrier(0);
    }
  }
}

#define XB_TMO      128
#define XB_XCNT(j)  (256  + 64 * (j))
#define XB_XSUB(j)  (1280 + 64 * (j))
#define XB_XGEN(j)  (2304 + 64 * (j))
#define XB_TOP      3328
#define XB_TOPGEN   3392
#define XCD_BAR_WORDS 3456
#define XB_SPIN_CAP (1u << 18)
#define LAS __attribute__((address_space(3)))
DEVI unsigned xb_ld(unsigned* p)              { return __hip_atomic_load(p, __ATOMIC_RELAXED, __HIP_MEMORY_SCOPE_AGENT); }
DEVI unsigned xb_add(unsigned* p, unsigned v) { return __hip_atomic_fetch_add(p, v, __ATOMIC_RELAXED, __HIP_MEMORY_SCOPE_AGENT); }
DEVI unsigned xb_xcc_id() { return (unsigned)__builtin_amdgcn_s_getreg((3 << 11) | 20) & 0xFu; }
#define XB_SPIN(cond, bar) do { unsigned _sp = 0; while (cond) { __builtin_amdgcn_s_sleep(1); \
    if ((++_sp & 255u) == 0u) { if (xb_ld(&(bar)[XB_TMO])) break; if (_sp > XB_SPIN_CAP) { atomicAdd(&(bar)[XB_TMO], 1u); break; } } } } while (0)
struct XcdBarrier { unsigned* bar; unsigned x; volatile LAS unsigned* st; };
DEVI XcdBarrier xcd_barrier_post(unsigned* bar, volatile LAS unsigned* st) {
  XcdBarrier b; b.bar = bar; b.x = xb_xcc_id(); b.st = st;
  if (threadIdx.x == 0) (void)xb_add(&bar[XB_XCNT(b.x)], 1u);
  return b;
}
DEVI void xcd_barrier_complete(unsigned* bar, unsigned x, unsigned& nloc, unsigned& nx) {
  const unsigned G = gridDim.x * gridDim.y * gridDim.z;
  unsigned sum, cnt, mine, sp = 0u;
  for (;;) {
    sum = 0u; cnt = 0u; mine = 0u;
#pragma unroll
    for (unsigned j = 0; j < 16; ++j) { const unsigned c = xb_ld(&bar[XB_XCNT(j)]); sum += c; cnt += (c > 0u) ? 1u : 0u; mine = (j == x) ? c : mine; }
    if (sum == G) break;
    __builtin_amdgcn_s_sleep(1);
    if ((++sp & 255u) == 0u) { if (xb_ld(&bar[XB_TMO])) break; if (sp > XB_SPIN_CAP) { atomicAdd(&bar[XB_TMO], 1u); break; } }
  }
  nloc = mine > 0u ? mine : 1u; nx = cnt > 0u ? cnt : 1u;
}
DEVI void xcd_barrier(const XcdBarrier& b) {
  asm volatile("s_waitcnt vmcnt(0)" ::: "memory");
  __syncthreads();
  if (threadIdx.x == 0) {
    unsigned* bar = b.bar;
    __builtin_amdgcn_s_waitcnt(0);
    unsigned nloc = b.st[0], nx = b.st[1];
    if (nloc == 0u) { xcd_barrier_complete(bar, b.x, nloc, nx); b.st[0] = nloc; b.st[1] = nx; }
    const unsigned old = xb_add(&bar[XB_XSUB(b.x)], 1u);
    const unsigned gen = old / nloc;
    if (old + 1u == (gen + 1u) * nloc) {
      __builtin_amdgcn_fence(__ATOMIC_RELEASE, "agent");
      asm volatile("s_waitcnt vmcnt(0)" ::: "memory");
      const unsigned og = xb_add(&bar[XB_TOP], 1u);
      const unsigned tg = og / nx;
      if (og + 1u == (tg + 1u) * nx) xb_add(&bar[XB_TOPGEN], 1u);
      else XB_SPIN(xb_ld(&bar[XB_TOPGEN]) == tg, bar);
      __builtin_amdgcn_fence(__ATOMIC_ACQUIRE, "agent");
      xb_add(&bar[XB_XGEN(b.x)], 1u);
      asm volatile("s_waitcnt vmcnt(0)" ::: "memory");
    } else {
      XB_SPIN(xb_ld(&bar[XB_XGEN(b.x)]) == gen, bar);
      __builtin_amdgcn_fence(__ATOMIC_ACQUIRE, "agent");
      asm volatile("s_waitcnt vmcnt(0)" ::: "memory");
    }
  }
  __syncthreads();
}

constexpr int NPHASE = 12;
template <int PH> DEVI void run_phase(const Params& p, char* smem) {
  if constexpr (PH == 0) ph_prep(p, smem);
  else if constexpr (PH == 1) ph_hx(p, smem);
  else if constexpr (PH == 2) ph_inproj(p, smem);
  else if constexpr (PH == 3) ph_mid(p, smem);
  else if constexpr (PH == 4) ph_attn(p, smem);
  else if constexpr (PH == 5) ph_gates(p, smem);
  else if constexpr (PH == 6) ph_merge(p, smem);
  else if constexpr (PH == 7) ph_wo(p, smem);
  else if constexpr (PH == 8) ph_rows(p, smem);
  else if constexpr (PH == 9) ph_wpq(p, smem);
  else if constexpr (PH == 10) ph_topk(p, smem);
  else if constexpr (PH == 11) ph_peer2(p, smem);
}

#define RUNPH(N) do { run_phase<N>(p, smem); if (N < NPHASE - 1) xcd_barrier(xb); } while (0)
__global__ __launch_bounds__(NTHR) void k_mega(Params p) {
  extern __shared__ __attribute__((aligned(16))) char smem[];
  cg::grid_group grid = cg::this_grid();
  unsigned* bar = (unsigned*)(p.ws + O_BAR);
  volatile LAS unsigned* xst = (volatile LAS unsigned*)(smem + LDS_BYTES - 16);
  if (threadIdx.x == 0) { xst[0] = 0u; xst[1] = 0u; }
  __syncthreads();
  const XcdBarrier xb = xcd_barrier_post(bar, xst);
  if (p.out == nullptr) grid.sync();
  RUNPH(0);
  RUNPH(1); RUNPH(2); RUNPH(3); RUNPH(4); RUNPH(5); RUNPH(6); RUNPH(7); RUNPH(8); RUNPH(9); RUNPH(10); RUNPH(11);
}

extern "C" void kernel_launch(void* const* d_in, const int* in_sizes, int n_in, void* d_out, int out_size, void* d_ws, size_t ws_size, hipStream_t stream) {
  static int grid = 0;
  if (grid == 0) {
    if (n_in != 26 || out_size != NTOK * DM || ws_size < O_END) { fprintf(stderr, "kernel_launch: unexpected shapes n_in %d out %d ws %zu (need %zu)\n", n_in, out_size, ws_size, (size_t)O_END); grid = -1; return; }
    (void)hipFuncSetAttribute((const void*)k_mega, hipFuncAttributeMaxDynamicSharedMemorySize, LDS_BYTES);
    int dev = 0, cus = 0, per_cu = 0; (void)hipGetDevice(&dev); (void)hipDeviceGetAttribute(&cus, hipDeviceAttributeMultiprocessorCount, dev);
    (void)hipOccupancyMaxActiveBlocksPerMultiprocessor(&per_cu, (const void*)k_mega, NTHR, LDS_BYTES);
    if (per_cu < 1) { fprintf(stderr, "kernel_launch: occupancy query says %d blocks per CU\n", per_cu); grid = -1; return; }
    grid = cus;
  }
  if (grid < 0) return;
  Params p{};
  const float** pp = (const float**)&p;
  for (int i = 0; i < 26; ++i) pp[i] = (const float*)d_in[i];
  p.out = (float*)d_out; p.ws = (char*)d_ws;
  (void)hipMemsetAsync((char*)d_ws + O_BAR, 0, (size_t)XCD_BAR_WORDS * 4, stream);
  void* args[] = {&p};
  hipError_t e = hipLaunchCooperativeKernel((const void*)k_mega, dim3(grid), dim3(NTHR), args, LDS_BYTES, stream);
  if (e != hipSuccess) fprintf(stderr, "cooperative launch failed: %s (grid %d)\n", hipGetErrorString(e), grid);
}
```

```cpp
#include <hip/hip_runtime.h>
#include <hip/hip_cooperative_groups.h>
#include <cstdint>
#include <cstdio>
namespace cg = cooperative_groups;

#define DEVI __device__ __forceinline__
typedef unsigned short bf16_t;
using bf16x8 = __attribute__((ext_vector_type(8))) short;
using bf16x4 = __attribute__((ext_vector_type(4))) short;
using f32x4  = __attribute__((ext_vector_type(4))) float;
using f32x16 = __attribute__((ext_vector_type(16))) float;
using u32x4  = __attribute__((ext_vector_type(4))) unsigned;
using u32x2  = __attribute__((ext_vector_type(2))) unsigned;

constexpr int DM = 1024, NB = 2, SEQ = 8192, NTOK = NB * SEQ, CTXL = 256, NCTX = NB * CTXL, NROW = NTOK + NCTX, NKEY = SEQ + CTXL;
constexpr int INW = 4544, INWP = 4608;
constexpr int NPRE = 2560;
constexpr float EPS = 1e-6f;
constexpr int NTHR = 512, NWAVE = 8;
constexpr int LDS_BYTES = 147456;

constexpr size_t al256(size_t x) { return (x + 255) / 256 * 256; }
constexpr size_t O_WIN   = 0;
constexpr size_t O_WUQ   = O_WIN  + al256((size_t)INWP * 1024 * 2);
constexpr size_t O_WUKV  = O_WUQ  + al256((size_t)1536 * 256 * 2);
constexpr size_t O_WPA   = O_WUKV + al256((size_t)2048 * 128 * 2);
constexpr size_t O_WPB   = O_WPA  + al256((size_t)1024 * 1024 * 2);
constexpr size_t O_WO    = O_WPB  + al256((size_t)1024 * 1024 * 2);
constexpr size_t O_WPQ   = O_WO   + al256((size_t)1024 * 1024 * 2);
constexpr size_t O_WS    = O_WPQ  + al256((size_t)2048 * 1024 * 2);
constexpr size_t O_K1    = O_WS   + al256((size_t)8 * 128 * 128 * 2);
constexpr size_t O_K2    = O_K1   + al256((size_t)128 * 128 * 2);
constexpr size_t O_MOD   = O_K2   + al256((size_t)128 * 128 * 2);
constexpr size_t O_ROPE  = O_MOD  + al256((size_t)3 * 6144 * 4);
constexpr size_t O_BAR   = O_ROPE + al256((size_t)128 * 16 * 2 * 4);
constexpr size_t O_RSSV  = O_BAR + al256((size_t)3456 * 4);
constexpr size_t O_RSSQ  = O_RSSV + (size_t)NTOK * 32 * 4;
constexpr size_t O_RSSKV = O_RSSQ + (size_t)NTOK * 8 * 4;
constexpr size_t O_RSSY  = O_RSSKV + (size_t)NROW * 4 * 4;
constexpr size_t O_RSSEND = O_RSSY + (size_t)NTOK * 32 * 4;
constexpr size_t O_RA    = al256(O_RSSEND);
constexpr size_t O_RB    = O_RA  + al256((size_t)NROW * 1024 * 2);
constexpr size_t O_RC    = O_RB  + al256((size_t)NTOK * 1024 * 2);
constexpr size_t O_CQ    = O_RC  + al256((size_t)NTOK * 1024 * 2);
constexpr size_t O_CKV   = O_CQ  + al256((size_t)NTOK * 256 * 2);
constexpr size_t O_KR    = O_CKV + al256((size_t)NROW * 128 * 2);
constexpr size_t O_RQ    = O_KR  + al256((size_t)NROW * 64 * 2);
constexpr size_t O_RKV   = O_RQ  + al256((size_t)NTOK * 1536 * 2);
constexpr size_t O_END   = O_RKV + al256((size_t)NROW * 2048 * 2);
static_assert(O_END <= (size_t)258 * 1024 * 1024, "workspace too large");

struct Params {
  const float *x, *c, *ctx, *c_ctx, *w_mod, *b_mod, *g_pre1, *g_post1, *g_pre2, *g_post2, *w_in, *g_q, *g_kv, *w_uq, *w_ukv, *g_sgu, *w_s, *b_s,
      *w_pa, *w_pb, *w_o, *w_pq, *k1, *k2, *u_exp, *v_exp;
  float* out; char* ws;
};

DEVI float bf2f(unsigned short h) { return __uint_as_float(((unsigned)h) << 16); }
DEVI unsigned short f2bf(float f) { unsigned u = __float_as_uint(f); u += 0x7fffu + ((u >> 16) & 1u); return (unsigned short)(u >> 16); }
typedef __bf16 bf16x2_t __attribute__((ext_vector_type(2)));
typedef float f32x2v_t __attribute__((ext_vector_type(2)));
DEVI unsigned pack2(float a, float b) { const f32x2v_t v = {a, b}; return __builtin_bit_cast(unsigned, __builtin_convertvector(v, bf16x2_t)); }
DEVI float lo2f(unsigned w) { return __uint_as_float(w << 16); }
DEVI float hi2f(unsigned w) { return __uint_as_float(w & 0xffff0000u); }
DEVI void unpack8(const u32x4& w, float* f) {
  f[0] = lo2f(w[0]); f[1] = hi2f(w[0]); f[2] = lo2f(w[1]); f[3] = hi2f(w[1]); f[4] = lo2f(w[2]); f[5] = hi2f(w[2]); f[6] = lo2f(w[3]); f[7] = hi2f(w[3]);
}
DEVI float gelu_t(float x) { const float z = 0.7978845608028654f * (x + 0.044715f * x * x * x); return x * __builtin_amdgcn_rcpf(1.f + __expf(-2.f * z)); }
DEVI float sigmoidf_(float x) { return __builtin_amdgcn_rcpf(1.f + __expf(-x)); }
DEVI float wave_sum(float v) { for (int o = 32; o > 0; o >>= 1) v += __shfl_xor(v, o); return v; }
DEVI float wave_max(float v) { for (int o = 32; o > 0; o >>= 1) v = fmaxf(v, __shfl_xor(v, o)); return v; }
DEVI void keyrow2(int row, int& b, int& key) { if (row < NTOK) { b = row >> 13; key = row & 8191; } else { const int c = row - NTOK; b = c >> 8; key = SEQ + (c & 255); } }
DEVI int keyrow(int row) { if (row < NTOK) return (row >> 13) * NKEY + (row & 8191); int c = row - NTOK; return (c >> 8) * NKEY + SEQ + (c & 255); }

__device__ const float ROPE_FREQ[16] = {1.0f, 0.5623413324356079f, 0.3162277638912201f, 0.17782793939113617f, 0.10000000149011612f, 0.05623413249850273f, 0.03162277489900589f, 0.017782794311642647f, 0.009999999776482582f, 0.005623413249850273f, 0.003162277629598975f, 0.0017782794311642647f, 0.0010000000474974513f, 0.000562341301701963f, 0.0003162277571391314f, 0.00017782794020604342f};
DEVI void sincos_small(double a, double& cs, double& sn) {
  const double k = rint(a * 0.15915494309189535); const double r = fma(-k, 6.283185307179586, a) - k * 2.4492935982947064e-16;
  const double r2 = r * r; double s = 0.0, c = 0.0;
#pragma unroll
  for (int n = 12; n >= 1; --n) { s = (1.0 - s * r2 / (double)((2 * n) * (2 * n + 1))); c = (1.0 - c * r2 / (double)((2 * n - 1) * (2 * n))); }
  sn = r * s; cs = c;
}

DEVI void transpose_job(const float* __restrict__ src, int K, int N, bf16_t* __restrict__ dst, const float* __restrict__ gk, bool isWin, int ntiles, char* smem) {
  const int tid = threadIdx.x; bf16_t* tl = (bf16_t*)smem; const int kt = K / 64;
  for (int idx = blockIdx.x; idx < ntiles; idx += gridDim.x) {
    const int ktile = idx % kt, ntile = idx / kt, k0 = ktile * 64, n0d = ntile * 64;
    int n0s = n0d; bool zero = false;
    if (isWin) { if (n0d == 2496) zero = true; else if (n0d >= 2560) n0s = n0d - 64; }
    { const int kk = tid >> 3, nn8 = (tid & 7) * 8; f32x4 va = {0.f, 0.f, 0.f, 0.f}, vb = va;
      if (!zero) { const float* s = src + (size_t)(k0 + kk) * N + n0s + nn8; const float4 a = *(const float4*)s, b = *(const float4*)(s + 4);
        const float sc = gk ? gk[k0 + kk] : 1.f; va = (f32x4){a.x, a.y, a.z, a.w} * sc; vb = (f32x4){b.x, b.y, b.z, b.w} * sc; }
      bf16_t* tp = tl + nn8 * 72 + kk;
      tp[0] = f2bf(va[0]); tp[72] = f2bf(va[1]); tp[144] = f2bf(va[2]); tp[216] = f2bf(va[3]); tp[288] = f2bf(vb[0]); tp[360] = f2bf(vb[1]); tp[432] = f2bf(vb[2]); tp[504] = f2bf(vb[3]); }
    __syncthreads();
    { const int nn = tid >> 3, kk8 = (tid & 7) * 8;
      const u32x4 o = *(const u32x4*)(tl + nn * 72 + kk8);
      *(u32x4*)(dst + (size_t)(n0d + nn) * K + k0 + kk8) = o; }
    __syncthreads();
  }
}

DEVI void ph_prep(const Params& p, char* smem) {
  const int tid = threadIdx.x, bid = blockIdx.x, nb = gridDim.x;
  char* ws = p.ws;
  if (bid == 0) { float* rope = (float*)(ws + O_ROPE);
    for (int i = tid; i < 128 * 16; i += NTHR) { const int pos = i >> 4, f = i & 15; const float ang = (float)pos * ROPE_FREQ[f];
      double cs, sn; sincos_small((double)ang, cs, sn); rope[i * 2] = (float)cs; rope[i * 2 + 1] = (float)sn; } }
  { float* red = (float*)smem; float* MOD = (float*)(ws + O_MOD);
    for (int it = bid; it < 256; it += nb) {
      const int cgp = tid % 6, kg = tid / 6;
      f32x4 a0 = {0.f, 0.f, 0.f, 0.f}, a1 = a0, a2 = a0;
      if (tid < 510) {
        for (int k = kg; k < 1024; k += 85) {
          const float4 w4 = *(const float4*)(p.w_mod + (size_t)k * 6144 + it * 24 + cgp * 4);
          const f32x4 w = {w4.x, w4.y, w4.z, w4.w};
          const float c0 = p.c[k], c1 = p.c[1024 + k], c2 = p.c_ctx[k];
          a0 += w * (c0 / (1.f + __expf(-c0))); a1 += w * (c1 / (1.f + __expf(-c1))); a2 += w * (c2 / (1.f + __expf(-c2)));
        }
        float* rp = red + kg * 72 + cgp * 4;
        rp[0] = a0[0]; rp[1] = a0[1]; rp[2] = a0[2]; rp[3] = a0[3];
        rp[24] = a1[0]; rp[25] = a1[1]; rp[26] = a1[2]; rp[27] = a1[3];
        rp[48] = a2[0]; rp[49] = a2[1]; rp[50] = a2[2]; rp[51] = a2[3];
      }
      __syncthreads();
      if (tid < 72) { float s = 0.f; for (int g = 0; g < 85; ++g) s += red[g * 72 + tid]; int r = tid / 24, n = it * 24 + tid % 24; MOD[r * 6144 + n] = s + p.b_mod[n]; }
      __syncthreads();
    } }
  transpose_job(p.w_in,  1024, INW,  (bf16_t*)(ws + O_WIN),  nullptr, true,  1152, smem);
  transpose_job(p.w_uq,  256,  1536, (bf16_t*)(ws + O_WUQ),  p.g_q,   false, 96,   smem);
  transpose_job(p.w_ukv, 128,  2048, (bf16_t*)(ws + O_WUKV), p.g_kv,  false, 64,   smem);
  transpose_job(p.w_pa,  1024, 1024, (bf16_t*)(ws + O_WPA),  nullptr, false, 256,  smem);
  transpose_job(p.w_pb,  1024, 1024, (bf16_t*)(ws + O_WPB),  nullptr, false, 256,  smem);
  transpose_job(p.w_o,   1024, 1024, (bf16_t*)(ws + O_WO),   nullptr, false, 256,  smem);
  transpose_job(p.w_pq,  1024, 2048, (bf16_t*)(ws + O_WPQ),  nullptr, false, 512,  smem);
  { const int n8 = (131072 + 16384 + 16384) / 8;
    for (int i = bid * NTHR + tid; i < n8; i += nb * NTHR) {
      int e = i * 8; const float* s; bf16_t* d;
      if (e < 131072) { s = p.w_s + e; d = (bf16_t*)(ws + O_WS) + e; }
      else if (e < 131072 + 16384) { s = p.k1 + (e - 131072); d = (bf16_t*)(ws + O_K1) + (e - 131072); }
      else { s = p.k2 + (e - 131072 - 16384); d = (bf16_t*)(ws + O_K2) + (e - 131072 - 16384); }
      const float4 a = *(const float4*)s, b = *(const float4*)(s + 4);
      u32x4 o = {pack2(a.x, a.y), pack2(a.z, a.w), pack2(b.x, b.y), pack2(b.z, b.w)};
      *(u32x4*)d = o;
    } }
}


using f32x32 = __attribute__((ext_vector_type(32))) float;
using u32x6 = __attribute__((ext_vector_type(6))) unsigned;
typedef u32x4 __attribute__((aligned(4))) u32x4_u;
typedef u32x2 __attribute__((aligned(4))) u32x2_u;
DEVI void convert_table_fp6(const float* __restrict__ src, unsigned char* __restrict__ dst, float* __restrict__ scale) {
  const int wave = threadIdx.x >> 6, lane = threadIdx.x & 63, h = lane >> 5, g = lane & 31;
  for (int rp = blockIdx.x * NWAVE + wave; rp < 8192; rp += gridDim.x * NWAVE) {
    const int row = rp * 2 + h;
    const float* sp = src + (size_t)row * 1024 + g * 4;
    f32x16 a, b; float am = 0.f;
#pragma unroll
    for (int j = 0; j < 8; ++j) { const float4 t = *(const float4*)(sp + 128 * j);
      a[2 * j] = t.x; b[2 * j] = t.y; a[2 * j + 1] = t.z; b[2 * j + 1] = t.w;
      am = fmaxf(am, fmaxf(fmaxf(fabsf(t.x), fabsf(t.y)), fmaxf(fabsf(t.z), fabsf(t.w)))); }
    for (int o = 16; o > 0; o >>= 1) am = fmaxf(am, __shfl_xor(am, o));
    const float inv = am > 0.f ? 7.5f / am : 0.f;
    const u32x6 w = __builtin_amdgcn_cvt_scalef32_2xpk16_fp6_f32(a * inv, b * inv, 1.0f);
    unsigned char* dp = dst + (size_t)row * 768 + g * 24;
    *(u32x4_u*)dp = (u32x4){w[0], w[1], w[2], w[3]}; *(u32x2_u*)(dp + 16) = (u32x2){w[4], w[5]};
    if (g == 0) scale[row] = am * (1.f / 7.5f);
  }
}

DEVI void ph_hx(const Params& p, char* smem) {
  const int tid = threadIdx.x, wave = tid >> 6, lane = tid & 63;
  float* mA = (float*)smem; float* mB = mA + 3 * 1024;
  const float* MOD = (const float*)(p.ws + O_MOD);
  for (int i = tid; i < 3072; i += NTHR) { int r = i >> 10, c = i & 1023; mA[i] = p.g_pre1[c] * (1.f + MOD[r * 6144 + 1024 + c]); mB[i] = MOD[r * 6144 + c]; }
  __syncthreads();
  bf16_t* HX = (bf16_t*)(p.ws + O_RA);
  for (int row = blockIdx.x * NWAVE + wave; row < NROW; row += gridDim.x * NWAVE) {
    const float* src = row < NTOK ? p.x + (size_t)row * 1024 : p.ctx + (size_t)(row - NTOK) * 1024;
    const int mr = row < NTOK ? (row >> 13) : 2;
    float4 v[4]; float ss = 0.f;
#pragma unroll
    for (int i = 0; i < 4; ++i) { v[i] = *(const float4*)(src + i * 256 + lane * 4); ss += v[i].x * v[i].x + v[i].y * v[i].y + v[i].z * v[i].z + v[i].w * v[i].w; }
    ss = wave_sum(ss); const float rstd = rsqrtf(ss * (1.f / 1024.f) + EPS);
#pragma unroll
    for (int i = 0; i < 4; ++i) { const int c = i * 256 + lane * 4; const float* a = mA + mr * 1024 + c; const float* b = mB + mr * 1024 + c;
      u32x2 o = {pack2(v[i].x * rstd * a[0] + b[0], v[i].y * rstd * a[1] + b[1]), pack2(v[i].z * rstd * a[2] + b[2], v[i].w * rstd * a[3] + b[3])};
      *(u32x2*)(HX + (size_t)row * 1024 + c) = o; }
  }
}

DEVI int lds_sw(int row, int c) { return row * 128 + ((c ^ (row & 7)) << 4); }
template <int BM, int BN, bool ACOLMAP, bool GLDS, class Epi>
DEVI void gemm_tile_mfma(const bf16_t* __restrict__ A, int lda, const bf16_t* __restrict__ Bm, int ldb, int K, int row0, int col0, const Epi& epi, const float* kscale, char* smem) {
  constexpr int WNW = BN / 64, WMW = 8 / WNW, WTM = BM / WMW, MI = WTM / 16, ACH = BM / 64, BCH = BN / 64, ABYTES = BM * 128, BBYTES = BN * 128, STAGE = ABYTES + BBYTES;
  int tid = threadIdx.x; asm volatile("" : "+v"(tid));
  const int wave = __builtin_amdgcn_readfirstlane(tid >> 6), lane = tid & 63, wm = wave / WNW, wn = wave % WNW, l15 = lane & 15, lq = lane >> 4;
  f32x4 acc[MI][4];
#pragma unroll
  for (int mi = 0; mi < MI; ++mi)
#pragma unroll
    for (int ni = 0; ni < 4; ++ni) acc[mi][ni] = (f32x4){0.f, 0.f, 0.f, 0.f};
  const int nk = K >> 6;
  const int sr = tid >> 3, scc = tid & 7;
  auto compute = [&](int buf) {
    const char* sa = smem + buf * STAGE; const char* sb = sa + ABYTES;
#pragma unroll
    for (int ks = 0; ks < 2; ++ks) { const int kc = ks * 4 + lq; bf16x8 bfr[4];
#pragma unroll
      for (int ni = 0; ni < 4; ++ni) bfr[ni] = *(const bf16x8*)(sb + lds_sw(wn * 64 + ni * 16 + l15, kc));
#pragma unroll
      for (int mi = 0; mi < MI; ++mi) { const bf16x8 af = *(const bf16x8*)(sa + lds_sw(wm * WTM + mi * 16 + l15, kc));
#pragma unroll
        for (int ni = 0; ni < 4; ++ni) acc[mi][ni] = __builtin_amdgcn_mfma_f32_16x16x32_bf16(bfr[ni], af, acc[mi][ni], 0, 0, 0); }
    }
  };
  if constexpr (GLDS) {
    const unsigned aoff = (unsigned)(sr * lda + ((scc ^ (sr & 7)) * 8)) * 2u, boff = (unsigned)(sr * ldb + ((scc ^ (sr & 7)) * 8)) * 2u;
    auto gstage = [&](int buf, int kt) {
      const int k0 = kt * 64, ka = ACOLMAP ? k0 + (k0 >> 7) * 64 : k0;
      char* sa = smem + buf * STAGE + wave * 1024; char* sb = sa + ABYTES;
#pragma unroll
      for (int i = 0; i < ACH; ++i) __builtin_amdgcn_global_load_lds((const unsigned*)((const char*)(A + (size_t)(64 * i) * lda + ka) + aoff), (unsigned*)(sa + i * 8192), 16, 0, 0);
#pragma unroll
      for (int i = 0; i < BCH; ++i) __builtin_amdgcn_global_load_lds((const unsigned*)((const char*)(Bm + (size_t)(64 * i) * ldb + k0) + boff), (unsigned*)(sb + i * 8192), 16, 0, 0);
    };
    gstage(0, 0); asm volatile("s_waitcnt vmcnt(0)" ::: "memory"); __syncthreads();
    for (int kt = 0; kt < nk; ++kt) {
      if (kt + 1 < nk) gstage((kt + 1) & 1, kt + 1);
      compute(kt & 1);
      asm volatile("s_waitcnt vmcnt(0)" ::: "memory"); __syncthreads();
    }
  } else {
    u32x4 ra[ACH], rb[BCH];
    const unsigned aoff = (unsigned)(sr * lda + scc * 8) * 2u, boff = (unsigned)(sr * ldb + scc * 8) * 2u;
    const int sdst = lds_sw(sr, scc);
    auto gload = [&](int kt) {
      const int k0 = kt * 64, ka = ACOLMAP ? k0 + (k0 >> 7) * 64 : k0;
#pragma unroll
      for (int i = 0; i < ACH; ++i) { const char* ub = (const char*)(A + (size_t)(64 * i) * lda + ka); ra[i] = *(const u32x4*)(ub + aoff); }
#pragma unroll
      for (int i = 0; i < BCH; ++i) { const char* ub = (const char*)(Bm + (size_t)(64 * i) * ldb + k0); rb[i] = *(const u32x4*)(ub + boff); }
    };
    auto lstore = [&](int buf, int kt) {
      char* sa = smem + buf * STAGE + sdst; char* sb = sa + ABYTES;
#pragma unroll
      for (int i = 0; i < ACH; ++i) { u32x4 v = ra[i];
        if (kscale) { float f[8]; unpack8(v, f); const float* ks = kscale + kt * 64 + scc * 8;
          v = (u32x4){pack2(f[0] * ks[0], f[1] * ks[1]), pack2(f[2] * ks[2], f[3] * ks[3]), pack2(f[4] * ks[4], f[5] * ks[5]), pack2(f[6] * ks[6], f[7] * ks[7])}; }
        *(u32x4*)(sa + i * 8192) = v; }
#pragma unroll
      for (int i = 0; i < BCH; ++i) *(u32x4*)(sb + i * 8192) = rb[i];
    };
    gload(0); lstore(0, 0); __syncthreads();
    for (int kt = 0; kt < nk; ++kt) {
      if (kt + 1 < nk) gload(kt + 1);
      compute(kt & 1);
      if (kt + 1 < nk) lstore((kt + 1) & 1, kt + 1);
      __syncthreads();
    }
  }
  int tide = threadIdx.x; asm volatile("" : "+v"(tide));
  const int l15e = tide & 15, lqe = (tide >> 4) & 3;
  float cs[4][4];
  if constexpr (Epi::SCALE_MODE == 2) {
#pragma unroll
    for (int ni = 0; ni < 4; ++ni)
#pragma unroll
      for (int j = 0; j < 4; ++j) cs[ni][j] = epi.colscale(col0 + wn * 64 + ni * 16 + lqe * 4 + j); }
#pragma unroll
  for (int mi = 0; mi < MI; ++mi) { const int row = row0 + wm * WTM + mi * 16 + l15e; float sq = 0.f; float rs = 1.f;
    if constexpr (Epi::SCALE_MODE == 1) rs = epi.rowscale(row);
#pragma unroll
    for (int ni = 0; ni < 4; ++ni) { float v[4] = {acc[mi][ni][0], acc[mi][ni][1], acc[mi][ni][2], acc[mi][ni][3]};
      if constexpr (Epi::SCALE_MODE == 1) { v[0] *= rs; v[1] *= rs; v[2] *= rs; v[3] *= rs; }
      if constexpr (Epi::SCALE_MODE == 2) { v[0] *= cs[ni][0]; v[1] *= cs[ni][1]; v[2] *= cs[ni][2]; v[3] *= cs[ni][3]; }
      const float q = epi(row, col0 + wn * 64 + ni * 16 + lqe * 4, v);
      if (Epi::RSS) { sq += q; if (ni & 1) { sq += __shfl_xor(sq, 16); sq += __shfl_xor(sq, 32); if (lqe == 0) epi.rss(row, col0 + wn * 64 + (ni >> 1) * 32, sq); sq = 0.f; } } }
    __builtin_amdgcn_sched_barrier(0); }
}


namespace g8 {
constexpr int BK = 64, HALF = 128, HT = HALF * BK;
DEVI int lds_byte(int r, int c) { const int st = (r >> 4) * 2 + (c >> 5), rr = r & 15, cc = c & 31, ob = rr * 64 + cc * 2; return st * 1024 + (ob ^ (((ob >> 9) & 1) << 5)); }
DEVI void stage_rc(int b, int& R, int& C) { const int st = b / 1024, sb = b % 1024, swz = sb ^ (((sb >> 9) & 1) << 5); R = (st >> 1) * 16 + swz / 64; C = (st & 1) * 32 + (swz % 64) / 2; }
}
template <bool ACOLMAP, int AH2 = 128, int BH2 = 128, class Epi>
DEVI void gemm_tile_8ph(const bf16_t* __restrict__ A, int lda, const bf16_t* __restrict__ Bt, int ldb, int K, int row0, int col0, const Epi& epi, char* smem) {
  using namespace g8;
  bf16_t* shm = (bf16_t*)smem;
#define SA(b, h) (shm + ((b) * 2 + (h)) * HT)
#define SB(b, h) (shm + (4 + (b) * 2 + (h)) * HT)
#define STAGE_A(P, r0, kt) do { const int _k0 = (kt) * BK, _ka = ACOLMAP ? _k0 + (_k0 >> 7) * 64 : _k0; \
    const int _r = (r0) ? AH2 : 0; \
    __builtin_amdgcn_global_load_lds((const unsigned*)((const char*)(A + (size_t)(_r) * lda + _ka) + ao0), (unsigned*)((char*)(P) + wid * 1024), 16, 0, 0); \
    __builtin_amdgcn_global_load_lds((const unsigned*)((const char*)(A + (size_t)(_r + 64) * lda + _ka) + ao0), (unsigned*)((char*)(P) + wid * 1024 + 8192), 16, 0, 0); } while (0)
#define STAGE_B(P, r0, kt) do { const int _k0 = (kt) * BK; \
    const int _r = (r0) ? BH2 : 0; \
    __builtin_amdgcn_global_load_lds((const unsigned*)((const char*)(Bt + (size_t)(_r) * ldb + _k0) + bo0), (unsigned*)((char*)(P) + wid * 1024), 16, 0, 0); \
    __builtin_amdgcn_global_load_lds((const unsigned*)((const char*)(Bt + (size_t)(_r + 64) * ldb + _k0) + bo0), (unsigned*)((char*)(P) + wid * 1024 + 8192), 16, 0, 0); } while (0)
#define LDA(dst, b, h) _Pragma("unroll") for (int m = 0; m < 4; ++m) _Pragma("unroll") for (int k = 0; k < 2; ++k) \
    dst[m][k] = *reinterpret_cast<const bf16x8*>((const char*)SA(b, h) + lds_byte(wr * 64 + m * 16 + fr, k * 32 + fq * 8))
#define LDB(dst, b, h) _Pragma("unroll") for (int n = 0; n < 2; ++n) _Pragma("unroll") for (int k = 0; k < 2; ++k) \
    dst[n][k] = *reinterpret_cast<const bf16x8*>((const char*)SB(b, h) + lds_byte(wc * 32 + n * 16 + fr, k * 32 + fq * 8))
#define MMA(ai, bj, At_, Bt_) do { __builtin_amdgcn_s_setprio(1); \
    _Pragma("unroll") for (int m = 0; m < 4; ++m) _Pragma("unroll") for (int n = 0; n < 2; ++n) _Pragma("unroll") for (int k = 0; k < 2; ++k) \
      acc[ai][bj][m][n] = __builtin_amdgcn_mfma_f32_16x16x32_bf16(Bt_[n][k], At_[m][k], acc[ai][bj][m][n], 0, 0, 0); \
    __builtin_amdgcn_s_setprio(0); } while (0)
#define WAIT_V(n) asm volatile("s_waitcnt vmcnt(" #n ")" ::: "memory")
#define WAIT_L(n) asm volatile("s_waitcnt lgkmcnt(" #n ")" ::: "memory")
#define BAR __builtin_amdgcn_s_barrier()
#define SCHED __builtin_amdgcn_sched_barrier(0)
  int tid = threadIdx.x; asm volatile("" : "+v"(tid));
  const int wid = __builtin_amdgcn_readfirstlane(tid >> 6), lane = tid & 63, wr = wid >> 2, wc = wid & 3, fr = lane & 15, fq = lane >> 4;
  unsigned ao0, bo0;
  { int r, c; stage_rc(tid * 16, r, c); ao0 = (unsigned)(r * lda + c) * 2u;
    const int rp = (r & ~31) | (((r >> 2) & 3) * 8 + ((r >> 4) & 1) * 4 + (r & 3));
    bo0 = (unsigned)(rp * ldb + c) * 2u; }
  f32x4 acc[2][2][4][2];
#pragma unroll
  for (int a = 0; a < 2; ++a)
#pragma unroll
    for (int b = 0; b < 2; ++b)
#pragma unroll
      for (int m = 0; m < 4; ++m)
#pragma unroll
        for (int n = 0; n < 2; ++n) acc[a][b][m][n] = (f32x4){0.f, 0.f, 0.f, 0.f};
  bf16x8 At[4][2], B0[2][2], B1[2][2];
  const int nt = K / BK;
  STAGE_B(SB(0, 0), 0, 0); STAGE_A(SA(0, 0), 0, 0);
  STAGE_B(SB(0, 1), HALF, 0); STAGE_A(SA(0, 1), HALF, 0);
  if (wr == 1) BAR;
  WAIT_V(4); BAR;
  STAGE_B(SB(1, 0), 0, 1); STAGE_A(SA(1, 0), 0, 1); STAGE_B(SB(1, 1), HALF, 1);
  WAIT_V(6); BAR;
  for (int t = 0; t < nt - 2; t += 2) {
    LDB(B0, 0, 0); SCHED; LDA(At, 0, 0); STAGE_A(SA(1, 1), HALF, t + 1);
    WAIT_L(8); BAR; WAIT_L(0); MMA(0, 0, At, B0); BAR; SCHED;
    LDB(B1, 0, 1); STAGE_B(SB(0, 0), 0, t + 2);
    BAR; WAIT_L(0); MMA(0, 1, At, B1); BAR;
    LDA(At, 0, 1); STAGE_A(SA(0, 0), 0, t + 2);
    BAR; WAIT_L(0); MMA(1, 0, At, B0); BAR; SCHED;
    STAGE_B(SB(0, 1), HALF, t + 2);
    WAIT_V(6); BAR; MMA(1, 1, At, B1); BAR;
    LDB(B0, 1, 0); SCHED; LDA(At, 1, 0); STAGE_A(SA(0, 1), HALF, t + 2);
    WAIT_L(8); BAR; WAIT_L(0); MMA(0, 0, At, B0); BAR; SCHED;
    LDB(B1, 1, 1); STAGE_B(SB(1, 0), 0, t + 3);
    BAR; WAIT_L(0); MMA(0, 1, At, B1); BAR;
    LDA(At, 1, 1); STAGE_A(SA(1, 0), 0, t + 3);
    BAR; WAIT_L(0); MMA(1, 0, At, B0); BAR; SCHED;
    STAGE_B(SB(1, 1), HALF, t + 3);
    WAIT_V(6); BAR; MMA(1, 1, At, B1); BAR;
  }
  { LDB(B0, 0, 0); LDA(At, 0, 0); STAGE_A(SA(1, 1), HALF, nt - 1);
    BAR; WAIT_L(0); MMA(0, 0, At, B0); BAR;
    LDB(B1, 0, 1); BAR; WAIT_L(0); MMA(0, 1, At, B1); BAR;
    LDA(At, 0, 1); WAIT_V(4); BAR; WAIT_L(0); MMA(1, 0, At, B0); MMA(1, 1, At, B1); BAR; }
  { LDB(B0, 1, 0); LDA(At, 1, 0); WAIT_V(2); BAR; WAIT_L(0); MMA(0, 0, At, B0); BAR;
    LDB(B1, 1, 1); WAIT_V(0); BAR; WAIT_L(0); MMA(0, 1, At, B1); BAR;
    LDA(At, 1, 1); BAR; WAIT_L(0); MMA(1, 0, At, B0); MMA(1, 1, At, B1); BAR; }
  if (wr == 0) BAR;
  int tide = threadIdx.x; asm volatile("" : "+v"(tide));
  const int fre = tide & 15, fqe = (tide >> 4) & 3;
  float csc[2][2][4];
  if constexpr (Epi::SCALE_MODE == 2) {
#pragma unroll
    for (int bj = 0; bj < 2; ++bj)
#pragma unroll
      for (int n = 0; n < 2; ++n)
#pragma unroll
        for (int j = 0; j < 4; ++j) csc[bj][n][j] = epi.colscale(col0 + bj * HALF + wc * 32 + fqe * 8 + n * 4 + j); }
#pragma unroll
  for (int ai = 0; ai < 2; ++ai)
#pragma unroll
    for (int m = 0; m < 4; ++m) { const int row = row0 + ai * HALF + wr * 64 + m * 16 + fre;
      float rsc = 1.f; if constexpr (Epi::SCALE_MODE == 1) rsc = epi.rowscale(row);
#pragma unroll
      for (int bj = 0; bj < 2; ++bj) { float sq = 0.f;
#pragma unroll
        for (int n = 0; n < 2; ++n) { float v[4] = {acc[ai][bj][m][n][0], acc[ai][bj][m][n][1], acc[ai][bj][m][n][2], acc[ai][bj][m][n][3]};
          if constexpr (Epi::SCALE_MODE == 1) { v[0] *= rsc; v[1] *= rsc; v[2] *= rsc; v[3] *= rsc; }
          if constexpr (Epi::SCALE_MODE == 2) { v[0] *= csc[bj][n][0]; v[1] *= csc[bj][n][1]; v[2] *= csc[bj][n][2]; v[3] *= csc[bj][n][3]; }
          sq += epi(row, col0 + bj * HALF + wc * 32 + fqe * 8 + n * 4, v); }
        if (Epi::RSS) { sq += __shfl_xor(sq, 16); sq += __shfl_xor(sq, 32); if (fqe == 0) epi.rss(row, col0 + bj * HALF + wc * 32, sq); } }
      if (Epi::EPI_SBAR) __builtin_amdgcn_sched_barrier(0); }
#undef SA
#undef SB
#undef STAGE_A
#undef STAGE_B
#undef LDA
#undef LDB
#undef MMA
#undef WAIT_V
#undef WAIT_L
#undef BAR
#undef SCHED
}

template <int BM, int BN, bool ACOLMAP, class Epi>
DEVI void gemm_tile(const bf16_t* A, int lda, const bf16_t* Bm, int ldb, int K, int row0, int col0, const Epi& epi, const float* kss, char* smem) {
  if constexpr (BM == 256 && BN == 256) gemm_tile_8ph<ACOLMAP, 128, 128>(A, lda, Bm, ldb, K, row0, col0, epi, smem);
  else if (kss) gemm_tile_mfma<BM, BN, ACOLMAP, false>(A, lda, Bm, ldb, K, row0, col0, epi, kss, smem);
  else gemm_tile_mfma<BM, BN, ACOLMAP, true>(A, lda, Bm, ldb, K, row0, col0, epi, nullptr, smem);
}

DEVI void st4bf(bf16_t* d, float a, float b, float c, float e) { u32x2 o = {pack2(a, b), pack2(c, e)}; *(u32x2*)d = o; }

struct EpiIn { static constexpr bool RSS = true; static constexpr int SCALE_MODE = 0; static constexpr bool EPI_SBAR = false; bf16_t *GU, *GVT, *CQ, *CKV, *KR; float *rssv, *rssq, *rsskv;
  DEVI float operator()(int row, int col, const float (&v)[4]) const {
    if (col < 1024) { st4bf(GU + (size_t)row * 1024 + col, gelu_t(v[0]), gelu_t(v[1]), gelu_t(v[2]), gelu_t(v[3])); return 0.f; }
    else if (col < 2048) { const int c = col - 1024, chunk = row >> 7, q = row & 127; float s = 0.f;
#pragma unroll
      for (int j = 0; j < 4; ++j) { const float g = gelu_t(v[j]); s += g * g; GVT[((size_t)chunk * 1024 + c + j) * 128 + q] = f2bf(g); }
      return s; }
    else if (col < 2304) { st4bf(CQ + (size_t)row * 256 + (col - 2048), v[0], v[1], v[2], v[3]); return v[0] * v[0] + v[1] * v[1] + v[2] * v[2] + v[3] * v[3]; }
    else if (col < 2432) { st4bf(CKV + (size_t)row * 128 + (col - 2304), v[0], v[1], v[2], v[3]); return v[0] * v[0] + v[1] * v[1] + v[2] * v[2] + v[3] * v[3]; }
    else if (col < 2496) { st4bf(KR + (size_t)keyrow(row) * 64 + (col - 2432), v[0], v[1], v[2], v[3]); return 0.f; }
    return 0.f; }
  DEVI void rss(int row, int col, float s) const {
    if (col >= 1024 && col < 2048) rssv[row * 32 + ((col - 1024) >> 5)] = s; else if (col >= 2048 && col < 2304) rssq[row * 8 + ((col - 2048) >> 5)] = s; else if (col >= 2304 && col < 2432) rsskv[row * 4 + ((col - 2304) >> 5)] = s; }
};
struct EpiQ { static constexpr bool RSS = false; static constexpr int SCALE_MODE = 1; static constexpr bool EPI_SBAR = false; bf16_t* Q; const float* rssq;
  DEVI float rowscale(int row) const { const float4 ps = *(const float4*)(rssq + row * 8), pt = *(const float4*)(rssq + row * 8 + 4); return rsqrtf((((ps.x + ps.y) + (ps.z + ps.w)) + ((pt.x + pt.y) + (pt.z + pt.w))) * (1.f / 256.f) + EPS); }
  DEVI float operator()(int row, int col, const float (&v)[4]) const { st4bf(Q + (size_t)row * 1536 + col, v[0], v[1], v[2], v[3]); return 0.f; }
  DEVI void rss(int, int, float) const {} };
DEVI int pk4_fp8(float a, float b, float c, float d) { int w = __builtin_amdgcn_cvt_pk_fp8_f32(a, b, 0, false); return __builtin_amdgcn_cvt_pk_fp8_f32(c, d, w, true); }
constexpr size_t O_K8 = O_RKV, O_V8T = O_RKV + al256((size_t)NB * 8 * NKEY * 192);
struct EpiK8 { static constexpr bool RSS = false; static constexpr int SCALE_MODE = 1; static constexpr bool EPI_SBAR = false; unsigned char* K8; const float* rsskv;
  DEVI float rowscale(int row) const { const float4 pk = *(const float4*)(rsskv + row * 4); return rsqrtf(((pk.x + pk.y) + (pk.z + pk.w)) * (1.f / 128.f) + EPS); }
  DEVI float operator()(int row, int col, const float (&v)[4]) const {
    int b, key; keyrow2(row, b, key); const int h = col >> 7, d = col & 127;
    *(int*)(K8 + ((size_t)(b * 8 + h) * NKEY + key) * 192 + d) = pk4_fp8(v[0], v[1], v[2], v[3]); return 0.f; }
  DEVI void rss(int, int, float) const {} };
struct EpiV8T { static constexpr bool RSS = false; static constexpr int SCALE_MODE = 2; static constexpr bool EPI_SBAR = false; unsigned char* V8; const float* rsskv;
  DEVI float colscale(int col) const { const float4 pk = *(const float4*)(rsskv + col * 4); return rsqrtf(((pk.x + pk.y) + (pk.z + pk.w)) * (1.f / 128.f) + EPS); }
  DEVI float operator()(int row, int col, const float (&v)[4]) const {
    int b, key; keyrow2(col, b, key); const int h = row >> 7, d = row & 127, kk = key & 63;
    const int off = 32 * ((kk >> 2) & 1) + 16 * (kk >> 5) + 4 * ((kk >> 3) & 3);
    *(int*)(V8 + ((size_t)(b * 8 + h) * 128 + d) * NKEY + (key & ~63) + off) = pk4_fp8(v[0], v[1], v[2], v[3]); return 0.f; }
  DEVI void rss(int, int, float) const {} };
struct EpiSgu { static constexpr bool RSS = false; static constexpr int SCALE_MODE = 0; static constexpr bool EPI_SBAR = false; bf16_t* GUOA; const float* g_sgu; const float* b_s; int chunk, g;
  DEVI float operator()(int row, int col, const float (&v)[4]) const { const int token = chunk * 128 + row, ch = g * 128 + col; const float bias = b_s[g * 128 + row];
    bf16_t* ptr = GUOA + (size_t)token * 1024 + ch; const u32x2 gu = *(const u32x2*)ptr;
    st4bf(ptr, lo2f(gu[0]) * (g_sgu[ch] * v[0] + bias), hi2f(gu[0]) * (g_sgu[ch + 1] * v[1] + bias), lo2f(gu[1]) * (g_sgu[ch + 2] * v[2] + bias), hi2f(gu[1]) * (g_sgu[ch + 3] * v[3] + bias));
    return 0.f; }
  DEVI void rss(int, int, float) const {} };
struct EpiGate { static constexpr bool RSS = false; static constexpr int SCALE_MODE = 0; static constexpr bool EPI_SBAR = false; bf16_t* G;
  DEVI float operator()(int row, int col, const float (&v)[4]) const { st4bf(G + (size_t)row * 2048 + col, sigmoidf_(v[0]), sigmoidf_(v[1]), sigmoidf_(v[2]), sigmoidf_(v[3])); return 0.f; }
  DEVI void rss(int, int, float) const {} };
template <bool SECOND> struct EpiMerge { static constexpr bool RSS = false; static constexpr int SCALE_MODE = 0; static constexpr bool EPI_SBAR = false;   bf16_t* M; const bf16_t* G;
  DEVI float operator()(int row, int col, const float (&v)[4]) const { const u32x2 g = *(const u32x2*)(G + (size_t)row * 2048 + (SECOND ? 1024 : 0) + col);
    float o0 = lo2f(g[0]) * v[0], o1 = hi2f(g[0]) * v[1], o2 = lo2f(g[1]) * v[2], o3 = hi2f(g[1]) * v[3];
    bf16_t* ptr = M + (size_t)row * 1024 + col;
    if (SECOND) { const u32x2 m = *(const u32x2*)ptr; o0 += lo2f(m[0]); o1 += hi2f(m[0]); o2 += lo2f(m[1]); o3 += hi2f(m[1]); }
    st4bf(ptr, o0, o1, o2, o3); return 0.f; }
  DEVI void rss(int, int, float) const {} };
struct EpiO { static constexpr bool RSS = true; static constexpr int SCALE_MODE = 0; static constexpr bool EPI_SBAR = false; bf16_t* Y; float* rssy;
  DEVI float operator()(int row, int col, const float (&v)[4]) const { st4bf(Y + (size_t)row * 1024 + col, v[0], v[1], v[2], v[3]); return v[0] * v[0] + v[1] * v[1] + v[2] * v[2] + v[3] * v[3]; }
  DEVI void rss(int row, int col, float s) const { rssy[row * 32 + (col >> 5)] = s; } };
struct EpiPq { static constexpr bool RSS = false; static constexpr int SCALE_MODE = 0; static constexpr bool EPI_SBAR = false; bf16_t* QP;
  DEVI float operator()(int row, int col, const float (&v)[4]) const { st4bf(QP + (size_t)row * 2048 + col, v[0], v[1], v[2], v[3]); return 0.f; }
  DEVI void rss(int, int, float) const {} };

template <class F> DEVI void for_tiles_xcd(int MT, int NT, F f) {
  const int nb = gridDim.x;
  if ((nb & 7) == 0 && (MT & 7) == 0) { const int xcd = blockIdx.x & 7, slot = blockIdx.x >> 3, slots = nb >> 3, mper = MT >> 3, tot = mper * NT;
    for (int j = slot; j < tot; j += slots) f(xcd * mper + j / NT, j % NT); }
  else for (int i = blockIdx.x; i < MT * NT; i += nb) f(i / NT, i % NT);
}

DEVI void ph_inproj(const Params& p, char* smem) {
  char* ws = p.ws;
  EpiIn epi{(bf16_t*)(ws + O_RB), (bf16_t*)(ws + O_RC), (bf16_t*)(ws + O_CQ), (bf16_t*)(ws + O_CKV), (bf16_t*)(ws + O_KR), (float*)(ws + O_RSSV), (float*)(ws + O_RSSQ), (float*)(ws + O_RSSKV)};
  const bf16_t* HX = (const bf16_t*)(ws + O_RA); const bf16_t* W = (const bf16_t*)(ws + O_WIN);
  auto tile = [&](int mt, int nt) { gemm_tile<256, 256, false>(HX + (size_t)mt * 256 * 1024, 1024, W + (size_t)nt * 256 * 1024, 1024, 1024, mt * 256, nt * 256, epi, nullptr, smem); };
  for_tiles_xcd(64, 10, tile);
  for (int i = (int)gridDim.x - 1 - (int)blockIdx.x; i < 2; i += gridDim.x) tile(64 + i, 9);
}
DEVI void rope_kr_fp8(const Params& p) {
  const bf16_t* KR = (const bf16_t*)(p.ws + O_KR); const float* rope = (const float*)(p.ws + O_ROPE); unsigned char* K8 = (unsigned char*)(p.ws + O_K8);
  for (int i = blockIdx.x * NTHR + threadIdx.x; i < NROW * 2; i += gridDim.x * NTHR) {
    const int row = i >> 1, which = i & 1, kr = keyrow(row); int b, key; keyrow2(row, b, key);
    float x[32];
    const bf16_t* src = KR + (size_t)kr * 64 + which * 32;
#pragma unroll
    for (int q = 0; q < 4; ++q) unpack8(*(const u32x4*)(src + q * 8), x + q * 8);
    if (row < NTOK) { const int pos = row & 8191, pp = which ? (pos & 63) : (pos >> 6); const float* cs = rope + pp * 32;
#pragma unroll
      for (int j = 0; j < 16; ++j) { const float c = cs[j * 2], sn = cs[j * 2 + 1], x1 = x[j], x2 = x[16 + j]; x[j] = x1 * c - x2 * sn; x[16 + j] = x1 * sn + x2 * c; } }
    u32x4 o0, o1;
#pragma unroll
    for (int q = 0; q < 4; ++q) { o0[q] = (unsigned)pk4_fp8(x[q * 4], x[q * 4 + 1], x[q * 4 + 2], x[q * 4 + 3]); o1[q] = (unsigned)pk4_fp8(x[16 + q * 4], x[17 + q * 4], x[18 + q * 4], x[19 + q * 4]); }
#pragma unroll
    for (int h = 0; h < 8; ++h) { unsigned char* d = K8 + ((size_t)(b * 8 + h) * NKEY + key) * 192 + 128 + which * 32; *(u32x4*)d = o0; *(u32x4*)(d + 16) = o1; }
  }
}
DEVI void ph_mid(const Params& p, char* smem) {
  char* ws = p.ws;
  { EpiQ eq{(bf16_t*)(ws + O_RQ), (const float*)(ws + O_RSSQ)};
    EpiK8 ek{(unsigned char*)(ws + O_K8), (const float*)(ws + O_RSSKV)};
    EpiV8T ev{(unsigned char*)(ws + O_V8T), (const float*)(ws + O_RSSKV)};
    const bf16_t* CQ = (const bf16_t*)(ws + O_CQ); const bf16_t* WQ = (const bf16_t*)(ws + O_WUQ);
    const bf16_t* CKV = (const bf16_t*)(ws + O_CKV); const bf16_t* WKV = (const bf16_t*)(ws + O_WUKV);
    for (int i = blockIdx.x; i < 384 + 264 + 264; i += gridDim.x) {
      if (i < 384) { const int mt = i / 6, nt = i % 6;
        gemm_tile_8ph<false, 128, 128>(CQ + (size_t)mt * 256 * 256, 256, WQ + (size_t)nt * 256 * 256, 256, 256, mt * 256, nt * 256, eq, smem); }
      else if (i < 648) { const int j = i - 384, mt = j >> 2, nt = j & 3;
        gemm_tile_8ph<false, 128, 256>(CKV + (size_t)mt * 256 * 128, 128, WKV + (size_t)nt * 512 * 128, 128, 128, mt * 256, nt * 256, ek, smem); }
      else { const int j = i - 648, mt = j & 3, nt = j >> 2;
        gemm_tile_8ph<false, 256, 128>(WKV + (size_t)(mt * 512 + 128) * 128, 128, CKV + (size_t)nt * 256 * 128, 128, 128, mt * 256, nt * 256, ev, smem); } } }
  { const bf16_t* WS = (const bf16_t*)(ws + O_WS); const bf16_t* GVT = (const bf16_t*)(ws + O_RC);
    float* ksc = (float*)(smem + LDS_BYTES - 1024); const float* rssv = (const float*)(ws + O_RSSV);
    for (int i = blockIdx.x; i < 1024; i += gridDim.x) { const int chunk = i >> 3, g = i & 7;
      __syncthreads();
      if (threadIdx.x < 128) { const float* pr = rssv + (size_t)(chunk * 128 + threadIdx.x) * 32; float t = 0.f;
#pragma unroll
        for (int j = 0; j < 32; ++j) t += pr[j];
        ksc[threadIdx.x] = rsqrtf(t * (1.f / 1024.f) + EPS); }
      __syncthreads();
      EpiSgu epi{(bf16_t*)(ws + O_RB), p.g_sgu, p.b_s, chunk, g};
      gemm_tile<128, 128, false>(WS + (size_t)g * 16384, 128, GVT + ((size_t)chunk * 1024 + g * 128) * 128, 128, 128, 0, 0, epi, ksc, smem); } }
  rope_kr_fp8(p);
}
DEVI void ph_gates(const Params& p, char* smem) {
  char* ws = p.ws; EpiGate epi{(bf16_t*)(ws + O_RKV)};
  const bf16_t* HX = (const bf16_t*)(ws + O_RA); const bf16_t* W = (const bf16_t*)(ws + O_WIN) + (size_t)NPRE * 1024;
  for_tiles_xcd(64, 8, [&](int mt, int nt) { gemm_tile<256, 256, false>(HX + (size_t)mt * 256 * 1024, 1024, W + (size_t)nt * 256 * 1024, 1024, 1024, mt * 256, nt * 256, epi, nullptr, smem); });
}
DEVI void ph_merge(const Params& p, char* smem) {
  char* ws = p.ws; bf16_t* M = (bf16_t*)(ws + O_RC); const bf16_t* G = (const bf16_t*)(ws + O_RKV);
  EpiMerge<false> e1{M, G}; EpiMerge<true> e2{M, G};
  const bf16_t* OA = (const bf16_t*)(ws + O_RB); const bf16_t* OB = (const bf16_t*)(ws + O_RQ);
  const bf16_t* WA = (const bf16_t*)(ws + O_WPA); const bf16_t* WB = (const bf16_t*)(ws + O_WPB);
  for_tiles_xcd(64, 4, [&](int mt, int nt) { gemm_tile<256, 256, false>(OA + (size_t)mt * 256 * 1024, 1024, WA + (size_t)nt * 256 * 1024, 1024, 1024, mt * 256, nt * 256, e1, nullptr, smem); });
  for_tiles_xcd(64, 4, [&](int mt, int nt) { gemm_tile<256, 256, true>(OB + (size_t)mt * 256 * 1536, 1536, WB + (size_t)nt * 256 * 1024, 1024, 1024, mt * 256, nt * 256, e2, nullptr, smem); });
}
DEVI void ph_wo(const Params& p, char* smem) {
  char* ws = p.ws; EpiO epi{(bf16_t*)(ws + O_RA), (float*)(ws + O_RSSY)};
  const bf16_t* M = (const bf16_t*)(ws + O_RC); const bf16_t* W = (const bf16_t*)(ws + O_WO);
  for_tiles_xcd(64, 4, [&](int mt, int nt) { gemm_tile<256, 256, false>(M + (size_t)mt * 256 * 1024, 1024, W + (size_t)nt * 256 * 1024, 1024, 1024, mt * 256, nt * 256, epi, nullptr, smem); });
}
DEVI void ph_wpq(const Params& p, char* smem) {
  char* ws = p.ws; EpiPq epi{(bf16_t*)(ws + O_RKV)};
  const bf16_t* A = (const bf16_t*)(ws + O_RB); const bf16_t* W = (const bf16_t*)(ws + O_WPQ);
  for_tiles_xcd(64, 8, [&](int mt, int nt) { gemm_tile<256, 256, false>(A + (size_t)mt * 256 * 1024, 1024, W + (size_t)nt * 256 * 1024, 1024, 1024, mt * 256, nt * 256, epi, nullptr, smem); });
  convert_table_fp6(p.v_exp, (unsigned char*)(ws + O_RA), (float*)(ws + O_RA + (size_t)16384 * 1024));
}

namespace a8 {
constexpr int KVBLK = 64, SHM_K = KVBLK * 192, SHM_V = 128 * KVBLK;
constexpr int SHM_K2 = 2 * SHM_K, SHM_V2 = 2 * SHM_V;
constexpr float SCALE = 0.07216878364870322f, THR = 1.5f;
using i32x8 = __attribute__((ext_vector_type(8))) int;
DEVI int crow(int r, int hi) { return (r & 3) + 8 * (r >> 2) + 4 * hi; }
DEVI f32x16 mma(const i32x8& a, const i32x8& b, const f32x16& c) { return __builtin_amdgcn_mfma_scale_f32_32x32x64_f8f6f4(a, b, c, 0, 0, 0, 0x7f7f7f7f, 0, 0x7f7f7f7f); }
DEVI void partialSM(f32x16& p0, f32x16& p1, float& m_reg, float& mn, float& alpha) {
  constexpr float C = SCALE * 1.4426950408889634f;
  float pmax = p0[0];
#pragma unroll
  for (int r = 1; r < 16; ++r) pmax = fmaxf(pmax, p0[r]);
#pragma unroll
  for (int r = 0; r < 16; ++r) pmax = fmaxf(pmax, p1[r]);
  { auto rr = __builtin_amdgcn_permlane32_swap(__float_as_uint(pmax), __float_as_uint(pmax), false, false);
    pmax = fmaxf(__uint_as_float(rr[0]), __uint_as_float(rr[1])); }
  if (__builtin_expect(__all(pmax - m_reg <= THR / SCALE), 1)) { mn = m_reg; alpha = 1.f; }
  else { mn = fmaxf(m_reg, pmax); alpha = __builtin_amdgcn_exp2f((m_reg - mn) * C); m_reg = mn; }
  const float mnC = 6.f - mn * C;
#pragma unroll
  for (int r = 0; r < 16; ++r) p0[r] = fmaf(p0[r], C, mnC);
#pragma unroll
  for (int r = 0; r < 16; ++r) p1[r] = fmaf(p1[r], C, mnC);
#pragma unroll
  for (int r = 0; r < 16; ++r) p0[r] = __builtin_amdgcn_exp2f(p0[r]);
}
DEVI void finishSM(f32x16& p0, f32x16& p1, float alpha, float& l_reg, i32x8& pa) {
#pragma unroll
  for (int r = 0; r < 16; ++r) p1[r] = __builtin_amdgcn_exp2f(p1[r]);
  float ps = 0;
#pragma unroll
  for (int r = 0; r < 16; ++r) ps += p0[r];
#pragma unroll
  for (int r = 0; r < 16; ++r) ps += p1[r];
  { auto rr = __builtin_amdgcn_permlane32_swap(__float_as_uint(ps), __float_as_uint(ps), false, false);
    ps = __uint_as_float(rr[0]) + __uint_as_float(rr[1]); }
  l_reg = l_reg * alpha + ps;
#pragma unroll
  for (int j = 0; j < 4; ++j) { pa[j] = pk4_fp8(p0[4 * j], p0[4 * j + 1], p0[4 * j + 2], p0[4 * j + 3]); pa[4 + j] = pk4_fp8(p1[4 * j], p1[4 * j + 1], p1[4 * j + 2], p1[4 * j + 3]); }
}
DEVI i32x8 ld32(const char* p0, const char* p1) { const u32x4 a = *(const u32x4*)p0, b = *(const u32x4*)p1; return (i32x8){(int)a[0], (int)a[1], (int)a[2], (int)a[3], (int)b[0], (int)b[1], (int)b[2], (int)b[3]}; }
DEVI void qkt(f32x16& p0, f32x16& p1, const char* Ks, const i32x8* qf, int r32, int hi) {
  p0 = f32x16{}; p1 = f32x16{};
  const int sw = (r32 >> 2) & 3; const char* k0 = Ks + r32 * 192; const char* k1 = k0 + 32 * 192;
#pragma unroll
  for (int m = 0; m < 3; ++m) { const int c0 = ((4 * m + 2 * hi) ^ sw) << 4, c1 = ((4 * m + 2 * hi + 1) ^ sw) << 4;
    p0 = mma(ld32(k0 + c0, k0 + c1), qf[m], p0);
    p1 = mma(ld32(k1 + c0, k1 + c1), qf[m], p1); }
}
DEVI void pv(f32x16* o, const char* Vs, int tile, const i32x8& pa, int r32, int hi) {
  const int sw = (r32 >> 1) & 7, c0 = ((4 * tile + 2 * hi) ^ sw) << 4, c1 = ((4 * tile + 2 * hi + 1) ^ sw) << 4;
#pragma unroll
  for (int db = 0; db < 4; ++db) { const char* vr = Vs + (32 * db + r32) * 128; o[db] = mma(pa, ld32(vr + c0, vr + c1), o[db]); }
}
DEVI void attn_item(bf16_t* __restrict__ Qb, const unsigned char* __restrict__ Kg, const unsigned char* __restrict__ Vg, const float* __restrict__ rope, int pos0, char* lds) {
  const int tid = threadIdx.x, wid = tid >> 6, lane = tid & 63, r32 = lane & 31, hi = lane >> 5;
  char* V_lds = lds; char* K_lds = lds + 3 * SHM_V2;
  float* wsl = (float*)(lds + 3 * SHM_V2 + 3 * SHM_K2) + wid * 64; float* li_l = wsl; float* al_l = wsl + 32;
  float m_reg = -1e30f, l_reg = 0; f32x16 o[4] = {}; i32x8 qf[3];
  { const bf16_t* Qw = Qb + (size_t)(wid * 32 + r32) * 1536 + hi * 32;
#pragma unroll
    for (int m = 0; m < 3; ++m) { float x[32];
#pragma unroll
      for (int q = 0; q < 4; ++q) unpack8(*(const u32x4*)(Qw + m * 64 + q * 8), x + q * 8);
      if (m == 2) { const int pos = pos0 + wid * 32 + r32, pp = hi ? (pos & 63) : (pos >> 6); const float* cs = rope + pp * 32;
#pragma unroll
        for (int j = 0; j < 16; ++j) { const float c = cs[j * 2], sn = cs[j * 2 + 1], x1 = x[j], x2 = x[16 + j]; x[j] = x1 * c - x2 * sn; x[16 + j] = x1 * sn + x2 * c; } }
#pragma unroll
      for (int q = 0; q < 8; ++q) qf[m][q] = pk4_fp8(x[q * 4], x[q * 4 + 1], x[q * 4 + 2], x[q * 4 + 3]);
      __builtin_amdgcn_sched_barrier(0); } }
  unsigned koff[3], voff[2];
#pragma unroll
  for (int i = 0; i < 3; ++i) { const int pp = wid * 64 + lane + 512 * i, key = pp / 12, c = pp - key * 12; koff[i] = (unsigned)(key * 192 + ((c ^ ((key >> 2) & 3)) << 4)); }
#pragma unroll
  for (int i = 0; i < 2; ++i) { const int pp = wid * 64 + lane + 512 * i, d = pp >> 3, c = pp & 7; voff[i] = (unsigned)(d * NKEY + ((c ^ ((d >> 1) & 7)) << 4)); }
#define GSTAGE(s_, kb, vb) do { const unsigned char* ks = Kg + (size_t)(s_) * SHM_K2; const unsigned char* vs = Vg + (s_) * 128; \
    _Pragma("unroll") for (int i = 0; i < 3; ++i) __builtin_amdgcn_global_load_lds((const unsigned*)(ks + koff[i]), (unsigned*)(K_lds + (kb) + i * 8192 + wid * 1024), 16, 0, 0); \
    _Pragma("unroll") for (int i = 0; i < 2; ++i) __builtin_amdgcn_global_load_lds((const unsigned*)(vs + voff[i]), (unsigned*)(V_lds + (vb) + i * 8192 + wid * 1024), 16, 0, 0); } while (0)
#define SWAIT() asm volatile("s_waitcnt vmcnt(0)" ::: "memory")
#define SBAR() __builtin_amdgcn_sched_barrier(0)
#define RESC(a) do { if (__any((a) < 1.f)) { if (hi == 0) al_l[r32] = (a); asm volatile("s_waitcnt lgkmcnt(0)" ::: "memory"); \
    _Pragma("unroll") for (int d = 0; d < 4; ++d) _Pragma("unroll") for (int r = 0; r < 16; ++r) o[d][r] *= al_l[crow(r, hi)]; } } while (0)
  f32x16 pA0, pA1, pB0, pB1; float mnA, mnB, alA, alB; i32x8 pa; constexpr int NS = NKEY / 128;
  int kp = 0, kc = SHM_K2, kn = 2 * SHM_K2, vp = 0, vc = SHM_V2, vn = 2 * SHM_V2;
  GSTAGE(0, kp, vp); GSTAGE(1, kc, vc); SWAIT(); __syncthreads();
  qkt(pA0, pA1, K_lds + kp, qf, r32, hi); partialSM(pA0, pA1, m_reg, mnA, alA);
  SBAR(); qkt(pB0, pB1, K_lds + kp + SHM_K, qf, r32, hi);
  finishSM(pA0, pA1, alA, l_reg, pa); SBAR();
  pv(o, V_lds + vp, 0, pa, r32, hi); partialSM(pB0, pB1, m_reg, mnB, alB);
  RESC(alB);
  for (int s_ = 1; s_ < NS; ++s_) {
    if (s_ + 1 < NS) GSTAGE(s_ + 1, kn, vn);
    SBAR(); qkt(pA0, pA1, K_lds + kc, qf, r32, hi);
    finishSM(pB0, pB1, alB, l_reg, pa); SBAR();
    pv(o, V_lds + vp, 1, pa, r32, hi); partialSM(pA0, pA1, m_reg, mnA, alA);
    RESC(alA);
    SBAR(); qkt(pB0, pB1, K_lds + kc + SHM_K, qf, r32, hi);
    finishSM(pA0, pA1, alA, l_reg, pa); SBAR();
    pv(o, V_lds + vc, 0, pa, r32, hi); partialSM(pB0, pB1, m_reg, mnB, alB);
    SWAIT(); __syncthreads();
    RESC(alB);
    { const int tk = kp; kp = kc; kc = kn; kn = tk; const int tv = vp; vp = vc; vc = vn; vn = tv; }
  }
  finishSM(pB0, pB1, alB, l_reg, pa); SBAR();
  pv(o, V_lds + vp, 1, pa, r32, hi);
  if (hi == 0) li_l[r32] = l_reg; asm volatile("s_waitcnt lgkmcnt(0)" ::: "memory");
  float rli[16];
#pragma unroll
  for (int r = 0; r < 16; ++r) rli[r] = __builtin_amdgcn_rcpf(li_l[crow(r, hi)]);
  bf16_t* Ow = Qb + (size_t)(wid * 32) * 1536;
#pragma unroll
  for (int r = 0; r < 16; ++r) { const int orow = crow(r, hi);
#pragma unroll
    for (int d0 = 0; d0 < 4; ++d0) Ow[(size_t)orow * 1536 + d0 * 32 + r32] = f2bf(o[d0][r] * rli[r]); }
  __syncthreads();
#undef GSTAGE
#undef SWAIT
#undef SBAR
#undef RESC
}
}
DEVI void attn_fp8(const Params& p, char* smem) {
  bf16_t* Q = (bf16_t*)(p.ws + O_RQ); const unsigned char* K8 = (const unsigned char*)(p.ws + O_K8); const unsigned char* V8 = (const unsigned char*)(p.ws + O_V8T);
  const float* rope = (const float*)(p.ws + O_ROPE);
  for (int it = blockIdx.x; it < NB * 8 * (SEQ / 256); it += gridDim.x) {
    const int bh = (it >> 8) * 8 + (it & 7), qb = (it & 255) >> 3, b = bh >> 3, h = bh & 7;
    a8::attn_item(Q + (size_t)(b * SEQ + qb * 256) * 1536 + h * 192, K8 + (size_t)bh * NKEY * 192, V8 + (size_t)bh * 128 * NKEY, rope, qb * 256, smem);
  }
}
DEVI void ph_attn(const Params& p, char* smem) { attn_fp8(p, smem); }

DEVI void ph_rows(const Params& p, char* smem) {
  const int tid = threadIdx.x, wave = tid >> 6, lane = tid & 63;
  const float* MOD = (const float*)(p.ws + O_MOD); const bf16_t* Y = (const bf16_t*)(p.ws + O_RA); const float* rssy = (const float*)(p.ws + O_RSSY);
  bf16_t* HX2 = (bf16_t*)(p.ws + O_RB);
  for (int row = blockIdx.x * NWAVE + wave; row < NTOK; row += gridDim.x * NWAVE) {
    const int b = row >> 13; const float* md = MOD + b * 6144;
    float ty = 0.f; { const float* pr = rssy + (size_t)row * 32;
#pragma unroll
      for (int j = 0; j < 32; ++j) ty += pr[j]; }
    const float ry = rsqrtf(ty * (1.f / 1024.f) + EPS);
    float x1[16]; float ss = 0.f;
#pragma unroll
    for (int i = 0; i < 4; ++i) { const int c = i * 256 + lane * 4; const float4 xv = *(const float4*)(p.x + (size_t)row * 1024 + c); const u32x2 yv = *(const u32x2*)(Y + (size_t)row * 1024 + c);
      const float4 gp = *(const float4*)(p.g_post1 + c), gt = *(const float4*)(md + 2048 + c);
      x1[i * 4 + 0] = xv.x + gt.x * (lo2f(yv[0]) * ry * gp.x); x1[i * 4 + 1] = xv.y + gt.y * (hi2f(yv[0]) * ry * gp.y);
      x1[i * 4 + 2] = xv.z + gt.z * (lo2f(yv[1]) * ry * gp.z); x1[i * 4 + 3] = xv.w + gt.w * (hi2f(yv[1]) * ry * gp.w);
#pragma unroll
      for (int j = 0; j < 4; ++j) ss += x1[i * 4 + j] * x1[i * 4 + j];
      *(float4*)(p.out + (size_t)row * 1024 + c) = make_float4(x1[i * 4], x1[i * 4 + 1], x1[i * 4 + 2], x1[i * 4 + 3]); }
    ss = wave_sum(ss); const float r2 = rsqrtf(ss * (1.f / 1024.f) + EPS);
#pragma unroll
    for (int i = 0; i < 4; ++i) { const int c = i * 256 + lane * 4; const float4 g2 = *(const float4*)(p.g_pre2 + c), sc = *(const float4*)(md + 4096 + c), sh = *(const float4*)(md + 3072 + c);
      st4bf(HX2 + (size_t)row * 1024 + c, x1[i * 4] * r2 * g2.x * (1.f + sc.x) + sh.x, x1[i * 4 + 1] * r2 * g2.y * (1.f + sc.y) + sh.y,
            x1[i * 4 + 2] * r2 * g2.z * (1.f + sc.z) + sh.z, x1[i * 4 + 3] * r2 * g2.w * (1.f + sc.w) + sh.w); }
  }
  convert_table_fp6(p.u_exp, (unsigned char*)(p.ws + O_RC), (float*)(p.ws + O_RC + (size_t)16384 * 1024));
}

namespace tk {
DEVI int f2sort(float f) { const int i = __float_as_int(f); return i ^ ((i >> 31) & 0x7fffffff); }
DEVI float sort2f(int s) { return __int_as_float(s ^ ((s >> 31) & 0x7fffffff)); }
DEVI void ce_desc(int& a, int& b) { const int hi = max(a, b), lo = min(a, b); a = hi; b = lo; }
DEVI void sort16_desc(int* a) {
#pragma unroll
  for (int lk = 1; lk <= 4; ++lk)
#pragma unroll
    for (int lj = lk - 1; lj >= 0; --lj)
#pragma unroll
      for (int i = 0; i < 16; ++i) { const int j = 1 << lj, k = 1 << lk, l = i ^ j;
        if (l > i) { const int hi = max(a[i], a[l]), lo = min(a[i], a[l]); if ((i & k) == 0) { a[i] = hi; a[l] = lo; } else { a[i] = lo; a[l] = hi; } } }
}
DEVI void bitonic_merge16_desc(int* a) {
#pragma unroll
  for (int lj = 3; lj >= 0; --lj)
#pragma unroll
    for (int i = 0; i < 16; ++i) { const int l = i ^ (1 << lj); if (l > i) ce_desc(a[i], a[l]); }
}
DEVI void merge_top16(int* a, const int* b) {
#pragma unroll
  for (int i = 0; i < 16; ++i) a[i] = max(a[i], b[15 - i]);
  bitonic_merge16_desc(a);
}
DEVI void half_top16(const bf16_t* __restrict__ qrow, const char* Kl, int r32, int hi, int* out) {
  bf16x8 qf[8];
#pragma unroll
  for (int d0 = 0; d0 < 8; ++d0) qf[d0] = *reinterpret_cast<const bf16x8*>(qrow + d0 * 16 + hi * 8);
  int a[64]; const int hi4 = 4 * hi;
#pragma unroll
  for (int kt = 0; kt < 4; ++kt) { f32x16 acc = {};
    const int key = kt * 32 + r32;
#pragma unroll
    for (int d0 = 0; d0 < 8; ++d0) { const bf16x8 kf = *reinterpret_cast<const bf16x8*>(Kl + key * 256 + (((d0 * 2 + hi) ^ (key & 15)) << 4));
      acc = __builtin_amdgcn_mfma_f32_32x32x16_bf16(kf, qf[d0], acc, 0, 0, 0); }
#pragma unroll
    for (int r = 0; r < 16; ++r) { const int kc = kt * 32 + (r & 3) + 8 * (r >> 2); a[kt * 16 + r] = ((f2sort(acc[r]) & ~127) | (127 - kc)) - hi4; } }
  sort16_desc(a); sort16_desc(a + 16); sort16_desc(a + 32); sort16_desc(a + 48);
  merge_top16(a, a + 16); merge_top16(a + 32, a + 48); merge_top16(a, a + 32);
  int L[16], H[16];
#pragma unroll
  for (int i = 0; i < 16; ++i) { auto rr = __builtin_amdgcn_permlane32_swap((unsigned)a[i], (unsigned)a[i], false, false); L[i] = (int)rr[0]; H[i] = (int)rr[1]; }
  merge_top16(L, H);
#pragma unroll
  for (int i = 0; i < 16; ++i) out[i] = L[i];
}
}
DEVI void peer_pass1_tokens4(const Params& p, int t0, const int* idxw, float* gww);
DEVI void topk_fast(const Params& p, char* smem) {
  const int tid = threadIdx.x, wave = __builtin_amdgcn_readfirstlane(tid >> 6), lane = tid & 63, r32 = lane & 31, hi = lane >> 5;
  const bf16_t* QP = (const bf16_t*)(p.ws + O_RKV);
  char* K1l = smem; char* K2l = smem + 32768; int* tab = (int*)(smem + 65536) + wave * (32 * 33);
  int* idxl = (int*)(smem + 65536 + 8 * 32 * 33 * 4) + wave * 512; float* gwl = (float*)(smem + 65536 + 8 * 32 * 33 * 4 + 8 * 2048) + wave * 512;
  __syncthreads();
  { const bf16_t* K1 = (const bf16_t*)(p.ws + O_K1);
    for (int id = tid; id < 4096; id += NTHR) { const int key = id >> 4, c = id & 15; const u32x4 v = *(const u32x4*)(K1 + (size_t)key * 128 + c * 8);
      *(u32x4*)(smem + key * 256 + ((c ^ (key & 15)) << 4)) = v; } }
  __syncthreads();
  for (int item = blockIdx.x; item < NTOK * 8 / 256; item += gridDim.x) {
    int tid_ = threadIdx.x; asm volatile("" : "+v"(tid_));
    const int lane = tid_ & 63, r32 = lane & 31, hi = lane >> 5;
    const int row = item * 256 + wave * 32 + r32;
    const bf16_t* qrow = QP + (size_t)row * 256;
    int t1[16], t2[16];
    tk::half_top16(qrow, K1l, r32, hi, t1);
    __builtin_amdgcn_sched_barrier(0);
    tk::half_top16(qrow + 128, K2l, r32, hi, t2);
    __builtin_amdgcn_sched_barrier(0);
    float v1[16], v2[16];
#pragma unroll
    for (int i = 0; i < 16; ++i) { v1[i] = tk::sort2f(t1[i] & ~127); v2[i] = tk::sort2f(t2[i] & ~127); }
    if (hi == 0) {
#pragma unroll
      for (int i = 0; i < 16; ++i) { tab[r32 * 33 + i] = 127 - (t1[i] & 127); tab[r32 * 33 + 16 + i] = 127 - (t2[i] & 127); } }
#define CAND(i, j) ((tk::f2sort(v1[i] + v2[j]) & ~255) | (255 - ((i) * 16 + (j))))
    int g0[16], g1[16], g2[16];
#pragma unroll
    for (int j = 0; j < 16; ++j) g0[j] = CAND(0, j);
#pragma unroll
    for (int j = 0; j < 8; ++j) g1[j] = CAND(1, j);
#pragma unroll
    for (int j = 0; j < 5; ++j) g1[8 + j] = CAND(2, j);
#pragma unroll
    for (int j = 0; j < 3; ++j) g1[13 + j] = CAND(4, j);
#pragma unroll
    for (int j = 0; j < 4; ++j) g2[j] = CAND(3, j);
    g2[4] = CAND(5, 0); g2[5] = CAND(5, 1); g2[6] = CAND(6, 0); g2[7] = CAND(6, 1); g2[8] = CAND(7, 0); g2[9] = CAND(7, 1);
    g2[10] = CAND(8, 0); g2[11] = CAND(9, 0); g2[12] = CAND(10, 0); g2[13] = CAND(11, 0); g2[14] = CAND(12, 0); g2[15] = CAND(13, 0);
    tk::sort16_desc(g1); tk::sort16_desc(g2);
    tk::merge_top16(g0, g1); tk::merge_top16(g0, g2);
    { int x = CAND(14, 0);
#pragma unroll
      for (int i = 0; i < 16; ++i) { const int h = max(g0[i], x); x = min(g0[i], x); g0[i] = h; }
      x = CAND(15, 0);
#pragma unroll
      for (int i = 0; i < 16; ++i) { const int h = max(g0[i], x); x = min(g0[i], x); g0[i] = h; } }
#undef CAND
    asm volatile("s_waitcnt lgkmcnt(0)" ::: "memory");
    if (hi == 0) {
      int ex[16];
#pragma unroll
      for (int k = 0; k < 16; ++k) { const int pos = 255 - (g0[k] & 255); ex[k] = tab[r32 * 33 + (pos >> 4)] * 128 + tab[r32 * 33 + 16 + (pos & 15)]; }
      int* dst = idxl + r32 * 16;
#pragma unroll
      for (int q = 0; q < 4; ++q) *(int4*)(dst + q * 4) = make_int4(ex[q * 4], ex[q * 4 + 1], ex[q * 4 + 2], ex[q * 4 + 3]);
    } else {
      float e[16]; const float vmax = tk::sort2f(g0[0] & ~255); float sum = 0.f;
#pragma unroll
      for (int k = 0; k < 16; ++k) { e[k] = __expf(tk::sort2f(g0[k] & ~255) - vmax); sum += e[k]; }
      const float inv = 1.f / sum; float* dst = gwl + r32 * 16;
#pragma unroll
      for (int q = 0; q < 4; ++q) *(float4*)(dst + q * 4) = make_float4(e[q * 4] * inv, e[q * 4 + 1] * inv, e[q * 4 + 2] * inv, e[q * 4 + 3] * inv);
    }
    asm volatile("s_waitcnt lgkmcnt(0)" ::: "memory"); __builtin_amdgcn_sched_barrier(0);
    peer_pass1_tokens4(p, item * 32 + wave * 4, idxl, gwl);
    asm volatile("s_waitcnt lgkmcnt(0)" ::: "memory"); __builtin_amdgcn_sched_barrier(0);
  }
}
DEVI void ph_topk(const Params& p, char* smem) { topk_fast(p, smem); }

using f32x2 = __attribute__((ext_vector_type(2))) float;
#define DPPF(x, ctrl) __builtin_bit_cast(float, __builtin_amdgcn_update_dpp(0, __builtin_bit_cast(int, (x)), ctrl, 0xf, 0xf, true))
DEVI float reduce_t32(const float (&D)[32], int lane) {
  float S[16];
#pragma unroll
  for (int i = 0; i < 16; ++i) { auto rr = __builtin_amdgcn_permlane16_swap(__float_as_uint(D[i]), __float_as_uint(D[i + 16]), false, false); S[i] = __uint_as_float(rr[0]) + __uint_as_float(rr[1]); }
  const bool b3 = lane & 8, b2 = lane & 4, b1 = lane & 2, b0 = lane & 1;
  float T[8], U[4], V[2];
#pragma unroll
  for (int i = 0; i < 8; ++i) { const float keep = b3 ? S[i + 8] : S[i], send = b3 ? S[i] : S[i + 8]; T[i] = keep + DPPF(send, 0x128); }
#pragma unroll
  for (int i = 0; i < 4; ++i) { const float keep = b2 ? T[i + 4] : T[i], send = b2 ? T[i] : T[i + 4]; U[i] = keep + DPPF(send, 0x141); }
#pragma unroll
  for (int i = 0; i < 2; ++i) { const float keep = b1 ? U[i + 2] : U[i], send = b1 ? U[i] : U[i + 2]; V[i] = keep + DPPF(send, 0x4E); }
  const float keep = b0 ? V[1] : V[0], send = b0 ? V[0] : V[1];
  return keep + DPPF(send, 0xB1);
}
DEVI void gload8(u32x6 (&B)[8], const unsigned char* tab, const int* ids, int g24) {
  const int4 i0 = *(const int4*)ids, i1 = *(const int4*)(ids + 4);
  const int id[8] = {i0.x, i0.y, i0.z, i0.w, i1.x, i1.y, i1.z, i1.w};
#pragma unroll
  for (int j = 0; j < 8; ++j) { const unsigned char* rp = tab + (unsigned)(id[j] * 768 + g24);
    const u32x4 a = *(const u32x4_u*)rp; const u32x2 c = *(const u32x2_u*)(rp + 16); B[j] = (u32x6){a[0], a[1], a[2], a[3], c[0], c[1]}; }
  asm volatile("" ::: "memory"); __builtin_amdgcn_sched_barrier(0);
}
template <int O>
DEVI void gdot8(const u32x6 (&B)[8], const f32x2 (&xp2)[16], float (&D)[32]) {
#pragma unroll
  for (int j = 0; j < 8; ++j) { const f32x32 uf = __builtin_amdgcn_cvt_scalef32_pk32_f32_fp6(B[j], 1.0f); f32x2 da = {0.f, 0.f}, db = {0.f, 0.f};
#pragma unroll
    for (int k = 0; k < 16; k += 2) { da += xp2[k] * (f32x2){uf[2 * k], uf[2 * k + 1]}; db += xp2[k + 1] * (f32x2){uf[2 * k + 2], uf[2 * k + 3]}; }
    da += db; D[O + j] = da[0] + da[1]; asm volatile("" : "+v"(D[O + j]) :: "memory"); __builtin_amdgcn_sched_barrier(0); }
}
DEVI void gaxpy8(const u32x6 (&B)[8], const float* cs, f32x2 (&acc2)[16]) {
  const float4 c0 = *(const float4*)cs, c1 = *(const float4*)(cs + 4);
  const float c[8] = {c0.x, c0.y, c0.z, c0.w, c1.x, c1.y, c1.z, c1.w};
#pragma unroll
  for (int j = 0; j < 8; ++j) { const f32x32 vf = __builtin_amdgcn_cvt_scalef32_pk32_f32_fp6(B[j], 1.0f); const f32x2 cj = {c[j], c[j]};
#pragma unroll
    for (int k = 0; k < 16; ++k) acc2[k] += cj * (f32x2){vf[2 * k], vf[2 * k + 1]};
    asm volatile("" : "+v"(acc2[0]), "+v"(acc2[1]), "+v"(acc2[2]), "+v"(acc2[3]), "+v"(acc2[4]), "+v"(acc2[5]), "+v"(acc2[6]), "+v"(acc2[7]) :: "memory");
    asm volatile("" : "+v"(acc2[8]), "+v"(acc2[9]), "+v"(acc2[10]), "+v"(acc2[11]), "+v"(acc2[12]), "+v"(acc2[13]), "+v"(acc2[14]), "+v"(acc2[15]) :: "memory");
    __builtin_amdgcn_sched_barrier(0); }
}
DEVI void peer_pass1_tokens4(const Params& p, int t0, const int* idxw, float* gww) {
  int lane = threadIdx.x & 63; asm volatile("" : "+v"(lane));
  const int h = lane >> 5, g = lane & 31, g24 = g * 24;
  const bf16_t* HX2 = (const bf16_t*)(p.ws + O_RB);
  const unsigned char* UT = (const unsigned char*)(p.ws + O_RC); const float* SU = (const float*)(p.ws + O_RC + (size_t)16384 * 1024);
  const float* SV = (const float*)(p.ws + O_RA + (size_t)16384 * 1024);
  int* IDG = (int*)(p.ws + O_RQ); float* CG = (float*)(p.ws + O_RQ + (size_t)NTOK * 128 * 4);
  u32x6 B0[8], B1[8]; u32x2 xr[8];
  gload8(B0, UT, idxw + h * 32, g24);
#pragma unroll
  for (int j = 0; j < 8; ++j) xr[j] = *(const u32x2*)(HX2 + (size_t)t0 * 1024 + 128 * j + 4 * g);
#pragma unroll 1
  for (int tl = 0; tl < 4; ++tl) {
    const int t = t0 + tl; const int* idx = idxw + tl * 128; float* gw = gww + tl * 128; const int* idh = idx + h * 32;
    f32x2 xp2[16];
#pragma unroll
    for (int j = 0; j < 8; ++j) { xp2[2 * j] = (f32x2){lo2f(xr[j][0]), hi2f(xr[j][0])}; xp2[2 * j + 1] = (f32x2){lo2f(xr[j][1]), hi2f(xr[j][1])}; }
    const int my_i0 = idx[lane], my_i1 = idx[64 + lane];
    const float su0 = SU[my_i0], sv0 = SV[my_i0], su1 = SU[my_i1], sv1 = SV[my_i1];
    IDG[(size_t)t * 128 + lane] = my_i0; IDG[(size_t)t * 128 + 64 + lane] = my_i1;
    float D[32];
    gload8(B1, UT, idh + 8, g24);  gdot8<0>(B0, xp2, D);
    gload8(B0, UT, idh + 16, g24); gdot8<8>(B1, xp2, D);
    gload8(B1, UT, idh + 24, g24); gdot8<16>(B0, xp2, D);
    gload8(B0, UT, idh + 64, g24); gdot8<24>(B1, xp2, D);
    { const float val = reduce_t32(D, lane); CG[(size_t)t * 128 + lane] = gw[lane] * gelu_t(val * su0) * sv0; }
    asm volatile("" ::: "memory"); __builtin_amdgcn_sched_barrier(0);
    gload8(B1, UT, idh + 72, g24); gdot8<0>(B0, xp2, D);
    gload8(B0, UT, idh + 80, g24); gdot8<8>(B1, xp2, D);
    gload8(B1, UT, idh + 88, g24); gdot8<16>(B0, xp2, D);
    if (tl < 3) { gload8(B0, UT, idh + 128, g24);
#pragma unroll
      for (int j = 0; j < 8; ++j) xr[j] = *(const u32x2*)(HX2 + (size_t)(t + 1) * 1024 + 128 * j + 4 * g); }
    gdot8<24>(B1, xp2, D);
    { const float val = reduce_t32(D, lane); CG[(size_t)t * 128 + 64 + lane] = gw[64 + lane] * gelu_t(val * su1) * sv1; }
    asm volatile("s_waitcnt lgkmcnt(0)" ::: "memory"); __builtin_amdgcn_sched_barrier(0);
  }
}
DEVI void ph_peer2(const Params& p, char* smem) {
  const int wave = __builtin_amdgcn_readfirstlane(threadIdx.x >> 6);
  int* idxw = (int*)(smem + 65536 + 8 * 32 * 33 * 4) + wave * 512; float* gww = (float*)(smem + 65536 + 8 * 32 * 33 * 4 + 8 * 2048) + wave * 512;
  const unsigned char* VT = (const unsigned char*)(p.ws + O_RA);
  const float* MOD = (const float*)(p.ws + O_MOD);
  const int* IDG = (const int*)(p.ws + O_RQ); const float* CG = (const float*)(p.ws + O_RQ + (size_t)NTOK * 128 * 4);
  for (int item = blockIdx.x; item < NTOK * 8 / 256; item += gridDim.x) {
    int lane = threadIdx.x & 63; asm volatile("" : "+v"(lane));
    const int h = lane >> 5, g = lane & 31, g24 = g * 24;
    const int t0 = item * 32 + wave * 4;
#pragma unroll
    for (int q = 0; q < 2; ++q) { *(int4*)(idxw + q * 256 + lane * 4) = *(const int4*)(IDG + (size_t)t0 * 128 + q * 256 + lane * 4);
      *(float4*)(gww + q * 256 + lane * 4) = *(const float4*)(CG + (size_t)t0 * 128 + q * 256 + lane * 4); }
    asm volatile("s_waitcnt vmcnt(0) lgkmcnt(0)" ::: "memory"); __builtin_amdgcn_sched_barrier(0);
    u32x6 B0[8], B1[8];
    gload8(B0, VT, idxw + h * 32, g24);
#pragma unroll 1
    for (int tl = 0; tl < 4; ++tl) {
      const int t = t0 + tl; const int* idh = idxw + tl * 128 + h * 32; const float* cw = gww + tl * 128 + h * 32;
      f32x2 acc2[16];
#pragma unroll
      for (int i = 0; i < 16; ++i) acc2[i] = (f32x2){0.f, 0.f};
      const int b = t >> 13, c0 = 512 * h + 4 * g;
      float* op = p.out + (size_t)t * 1024 + c0;
      float4 xv[4];
#pragma unroll
      for (int q4 = 0; q4 < 4; ++q4) xv[q4] = *(const float4*)(op + q4 * 128);
      asm volatile("" ::: "memory"); __builtin_amdgcn_sched_barrier(0);
      gload8(B1, VT, idh + 8, g24);  gaxpy8(B0, cw, acc2);
      gload8(B0, VT, idh + 16, g24); gaxpy8(B1, cw + 8, acc2);
      gload8(B1, VT, idh + 24, g24); gaxpy8(B0, cw + 16, acc2);
      gload8(B0, VT, idh + 64, g24); gaxpy8(B1, cw + 24, acc2);
      gload8(B1, VT, idh + 72, g24); gaxpy8(B0, cw + 64, acc2);
      gload8(B0, VT, idh + 80, g24); gaxpy8(B1, cw + 72, acc2);
      gload8(B1, VT, idh + 88, g24); gaxpy8(B0, cw + 80, acc2);
      if (tl < 3) gload8(B0, VT, idh + 128, g24);
      gaxpy8(B1, cw + 88, acc2);
      float o[16]; float ss = 0.f;
#pragma unroll
      for (int i = 0; i < 16; ++i) { const float lo = i & 1 ? acc2[i >> 1][1] : acc2[i >> 1][0], hi = i & 1 ? acc2[8 + (i >> 1)][1] : acc2[8 + (i >> 1)][0];
        auto rr = __builtin_amdgcn_permlane32_swap(__float_as_uint(lo), __float_as_uint(hi), false, false); o[i] = __uint_as_float(rr[0]) + __uint_as_float(rr[1]); ss += o[i] * o[i]; }
      ss = wave_sum(ss); const float rstd = rsqrtf(ss * (1.f / 1024.f) + EPS);
      const float* gt2 = MOD + b * 6144 + 5120 + c0;
#pragma unroll
      for (int q4 = 0; q4 < 4; ++q4) { float4 x4 = xv[q4]; const float4 gt = *(const float4*)(gt2 + q4 * 128), gp = *(const float4*)(p.g_post2 + c0 + q4 * 128);
        x4.x += gt.x * (o[q4 * 4 + 0] * rstd * gp.x); x4.y += gt.y * (o[q4 * 4 + 1] * rstd * gp.y);
        x4.z += gt.z * (o[q4 * 4 + 2] * rstd * gp.z); x4.w += gt.w * (o[q4 * 4 + 3] * rstd * gp.w);
        *(float4*)(op + q4 * 128) = x4; }
      asm volatile("s_waitcnt lgkmcnt(0)" ::: "memory"); __builtin_amdgcn_sched_barrier(0);
    }
  }
}

#define XB_TMO      128
#define XB_XCNT(j)  (256  + 64 * (j))
#define XB_XSUB(j)  (1280 + 64 * (j))
#define XB_XGEN(j)  (2304 + 64 * (j))
#define XB_TOP      3328
#define XB_TOPGEN   3392
#define XCD_BAR_WORDS 3456
#define XB_SPIN_CAP (1u << 18)
#define LAS __attribute__((address_space(3)))
DEVI unsigned xb_ld(unsigned* p)              { return __hip_atomic_load(p, __ATOMIC_RELAXED, __HIP_MEMORY_SCOPE_AGENT); }
DEVI unsigned xb_add(unsigned* p, unsigned v) { return __hip_atomic_fetch_add(p, v, __ATOMIC_RELAXED, __HIP_MEMORY_SCOPE_AGENT); }
DEVI unsigned xb_xcc_id() { return (unsigned)__builtin_amdgcn_s_getreg((3 << 11) | 20) & 0xFu; }
#define XB_SPIN(cond, bar) do { unsigned _sp = 0; while (cond) { __builtin_amdgcn_s_sleep(1); \
    if ((++_sp & 255u) == 0u) { if (xb_ld(&(bar)[XB_TMO])) break; if (_sp > XB_SPIN_CAP) { atomicAdd(&(bar)[XB_TMO], 1u); break; } } } } while (0)
struct XcdBarrier { unsigned* bar; unsigned x; volatile LAS unsigned* st; };
DEVI XcdBarrier xcd_barrier_post(unsigned* bar, volatile LAS unsigned* st) {
  XcdBarrier b; b.bar = bar; b.x = xb_xcc_id(); b.st = st;
  if (threadIdx.x == 0) (void)xb_add(&bar[XB_XCNT(b.x)], 1u);
  return b;
}
DEVI void xcd_barrier_complete(unsigned* bar, unsigned x, unsigned& nloc, unsigned& nx) {
  const unsigned G = gridDim.x * gridDim.y * gridDim.z;
  unsigned sum, cnt, mine, sp = 0u;
  for (;;) {
    sum = 0u; cnt = 0u; mine = 0u;
#pragma unroll
    for (unsigned j = 0; j < 16; ++j) { const unsigned c = xb_ld(&bar[XB_XCNT(j)]); sum += c; cnt += (c > 0u) ? 1u : 0u; mine = (j == x) ? c : mine; }
    if (sum == G) break;
    __builtin_amdgcn_s_sleep(1);
    if ((++sp & 255u) == 0u) { if (xb_ld(&bar[XB_TMO])) break; if (sp > XB_SPIN_CAP) { atomicAdd(&bar[XB_TMO], 1u); break; } }
  }
  nloc = mine > 0u ? mine : 1u; nx = cnt > 0u ? cnt : 1u;
}
DEVI void xcd_barrier(const XcdBarrier& b) {
  asm volatile("s_waitcnt vmcnt(0)" ::: "memory");
  __syncthreads();
  if (threadIdx.x == 0) {
    unsigned* bar = b.bar;
    __builtin_amdgcn_s_waitcnt(0);
    unsigned nloc = b.st[0], nx = b.st[1];
    if (nloc == 0u) { xcd_barrier_complete(bar, b.x, nloc, nx); b.st[0] = nloc; b.st[1] = nx; }
    const unsigned old = xb_add(&bar[XB_XSUB(b.x)], 1u);
    const unsigned gen = old / nloc;
    if (old + 1u == (gen + 1u) * nloc) {
      __builtin_amdgcn_fence(__ATOMIC_RELEASE, "agent");
      asm volatile("s_waitcnt vmcnt(0)" ::: "memory");
      const unsigned og = xb_add(&bar[XB_TOP], 1u);
      const unsigned tg = og / nx;
      if (og + 1u == (tg + 1u) * nx) xb_add(&bar[XB_TOPGEN], 1u);
      else XB_SPIN(xb_ld(&bar[XB_TOPGEN]) == tg, bar);
      __builtin_amdgcn_fence(__ATOMIC_ACQUIRE, "agent");
      xb_add(&bar[XB_XGEN(b.x)], 1u);
      asm volatile("s_waitcnt vmcnt(0)" ::: "memory");
    } else {
      XB_SPIN(xb_ld(&bar[XB_XGEN(b.x)]) == gen, bar);
      __builtin_amdgcn_fence(__ATOMIC_ACQUIRE, "agent");
      asm volatile("s_waitcnt vmcnt(0)" ::: "memory");
    }
  }
  __syncthreads();
}

constexpr int NPHASE = 12;
template <int PH> DEVI void run_phase(const Params& p, char* smem) {
  if constexpr (PH == 0) ph_prep(p, smem);
  else if constexpr (PH == 1) ph_hx(p, smem);
  else if constexpr (PH == 2) ph_inproj(p, smem);
  else if constexpr (PH == 3) ph_mid(p, smem);
  else if constexpr (PH == 4) ph_attn(p, smem);
  else if constexpr (PH == 5) ph_gates(p, smem);
  else if constexpr (PH == 6) ph_merge(p, smem);
  else if constexpr (PH == 7) ph_wo(p, smem);
  else if constexpr (PH == 8) ph_rows(p, smem);
  else if constexpr (PH == 9) ph_wpq(p, smem);
  else if constexpr (PH == 10) ph_topk(p, smem);
  else if constexpr (PH == 11) ph_peer2(p, smem);
}

#define RUNPH(N) do { run_phase<N>(p, smem); if (N < NPHASE - 1) xcd_barrier(xb); } while (0)
__global__ __launch_bounds__(NTHR) void k_mega(Params p) {
  extern __shared__ __attribute__((aligned(16))) char smem[];
  cg::grid_group grid = cg::this_grid();
  unsigned* bar = (unsigned*)(p.ws + O_BAR);
  volatile LAS unsigned* xst = (volatile LAS unsigned*)(smem + LDS_BYTES - 16);
  if (threadIdx.x == 0) { xst[0] = 0u; xst[1] = 0u; }
  __syncthreads();
  const XcdBarrier xb = xcd_barrier_post(bar, xst);
  if (p.out == nullptr) grid.sync();
  RUNPH(0);
  RUNPH(1); RUNPH(2); RUNPH(3); RUNPH(4); RUNPH(5); RUNPH(6); RUNPH(7); RUNPH(8); RUNPH(9); RUNPH(10); RUNPH(11);
}

extern "C" void kernel_launch(void* const* d_in, const int* in_sizes, int n_in, void* d_out, int out_size, void* d_ws, size_t ws_size, hipStream_t stream) {
  static int grid = 0;
  if (grid == 0) {
    if (n_in != 26 || out_size != NTOK * DM || ws_size < O_END) { fprintf(stderr, "kernel_launch: unexpected shapes n_in %d out %d ws %zu (need %zu)\n", n_in, out_size, ws_size, (size_t)O_END); grid = -1; return; }
    (void)hipFuncSetAttribute((const void*)k_mega, hipFuncAttributeMaxDynamicSharedMemorySize, LDS_BYTES);
    int dev = 0, cus = 0, per_cu = 0; (void)hipGetDevice(&dev); (void)hipDeviceGetAttribute(&cus, hipDeviceAttributeMultiprocessorCount, dev);
    (void)hipOccupancyMaxActiveBlocksPerMultiprocessor(&per_cu, (const void*)k_mega, NTHR, LDS_BYTES);
    if (per_cu < 1) { fprintf(stderr, "kernel_launch: occupancy query says %d blocks per CU\n", per_cu); grid = -1; return; }
    grid = cus;
  }
  if (grid < 0) return;
  Params p{};
  const float** pp = (const float**)&p;
  for (int i = 0; i < 26; ++i) pp[i] = (const float*)d_in[i];
  p.out = (float*)d_out; p.ws = (char*)d_ws;
  (void)hipMemsetAsync((char*)d_ws + O_BAR, 0, (size_t)XCD_BAR_WORDS * 4, stream);
  void* args[] = {&p};
  hipError_t e = hipLaunchCooperativeKernel((const void*)k_mega, dim3(grid), dim3(NTHR), args, LDS_BYTES, stream);
  if (e != hipSuccess) fprintf(stderr, "cooperative launch failed: %s (grid %d)\n", hipGetErrorString(e), grid);
}
```
